# Optimizing an MI355X kernel written in HIP

```python
import jax
import jax.numpy as jnp
from jax import lax
import numpy as np

D_MODEL = 1024
BATCH = 4
SEQ = 4096
DEPTH = 4

FOX_HEADS = 8
FOX_DIM = 64
DSA_HEADS = 8
DSA_DIM = 64
IDX_HEADS = 8
IDX_DIM = 32
DSA_MAX_TOPK = 256
RET_HEADS = 4
RET_QK_DIM = 64
RET_V_DIM = 128
RET_CHUNK = 128
Q_BLOCK = 128
FFN_HIDDEN = ((8 * D_MODEL + 3 * 256 - 1) // (3 * 256)) * 256
ROPE_THETA = 10000.0
NORM_EPS = 1e-6

FOX_W = FOX_HEADS * FOX_DIM
DSA_W = DSA_HEADS * DSA_DIM
RET_QK_W = RET_HEADS * RET_QK_DIM
RET_V_W = RET_HEADS * RET_V_DIM
N_BRANCH = 3
IN_SIZES = (FOX_W, FOX_W, FOX_W, FOX_HEADS,
            DSA_W, DSA_DIM, DSA_DIM, IDX_HEADS * IDX_DIM, IDX_DIM, IDX_HEADS,
            RET_QK_W, RET_QK_W, RET_V_W, RET_V_W,
            N_BRANCH * D_MODEL)
IN_COLS = sum(IN_SIZES)

kernel_name = 'hybrid_fox_dsa_retention_block'


def split_columns(z):
    points = []
    acc = 0
    for s in IN_SIZES[:-1]:
        acc += s
        points.append(acc)
    return jnp.split(z, points, axis=-1)


def rms_norm(x, g):
    xf = x.astype(jnp.float32)
    y = xf * lax.rsqrt(jnp.mean(xf * xf, axis=-1, keepdims=True) + NORM_EPS)
    return (y * g.astype(jnp.float32)).astype(x.dtype)


def apply_rope(x, pos):
    half = x.shape[-1] // 2
    inv_freq = ROPE_THETA ** (-jnp.arange(half, dtype=jnp.float32) / half)
    ang = pos.astype(jnp.float32)[:, None] * inv_freq[None, :]
    cos = jnp.cos(ang)[:, None, :]
    sin = jnp.sin(ang)[:, None, :]
    xf = x.astype(jnp.float32)
    x1, x2 = xf[..., :half], xf[..., half:]
    return jnp.concatenate([x1 * cos - x2 * sin, x2 * cos + x1 * sin], axis=-1).astype(x.dtype)


def fox_attention(q, k, v, log_f):
    b, l, h, d = q.shape
    nb = l // Q_BLOCK
    scale = d ** -0.5
    c = jnp.cumsum(log_f, axis=1).transpose(0, 2, 1)
    kpos = jnp.arange(l)
    qb = q.reshape(b, nb, Q_BLOCK, h, d).swapaxes(0, 1)
    cb = c.reshape(b, h, nb, Q_BLOCK).transpose(2, 0, 1, 3)

    def block(args):
        i, qi, ci = args
        qpos = i * Q_BLOCK + jnp.arange(Q_BLOCK)
        s = jnp.einsum('bqhd,bkhd->bhqk', qi, k).astype(jnp.float32) * scale
        s = s + ci[..., :, None] - c[:, :, None, :]
        s = jnp.where(kpos[None, :] <= qpos[:, None], s, -jnp.inf)
        p = jax.nn.softmax(s, axis=-1).astype(v.dtype)
        return jnp.einsum('bhqk,bkhd->bqhd', p, v)

    out = lax.map(block, (jnp.arange(nb), qb, cb))
    return out.swapaxes(0, 1).reshape(b, l, h, d)


def dsa_attention(q, k, v, iq, ik, iw):
    b, l, h, d = q.shape
    nb = l // Q_BLOCK
    topk = min(DSA_MAX_TOPK, l // 4)
    scale = d ** -0.5
    idx_scale = (IDX_DIM * IDX_HEADS) ** -0.5
    kpos = jnp.arange(l)
    qb = q.reshape(b, nb, Q_BLOCK, h, d).swapaxes(0, 1)
    iqb = iq.reshape(b, nb, Q_BLOCK, IDX_HEADS, IDX_DIM).swapaxes(0, 1)
    iwb = iw.reshape(b, nb, Q_BLOCK, IDX_HEADS).swapaxes(0, 1)
    gather = jax.vmap(lambda table, rows: table[rows])

    def block(args):
        i, qi, iqi, iwi = args
        qpos = i * Q_BLOCK + jnp.arange(Q_BLOCK)
        causal = kpos[None, :] <= qpos[:, None]
        rel = jax.nn.relu(jnp.einsum('bqhd,bkd->bqhk', iqi, ik).astype(jnp.float32))
        score = jnp.einsum('bqhk,bqh->bqk', rel, iwi.astype(jnp.float32)) * idx_scale
        score = jnp.where(causal[None], score, -jnp.inf)
        _, sel = lax.top_k(score, topk)
        valid = sel <= qpos[None, :, None]
        kg = gather(k, sel)
        vg = gather(v, sel)
        s = jnp.einsum('bqhd,bqkd->bqhk', qi, kg).astype(jnp.float32) * scale
        s = jnp.where(valid[:, :, None, :], s, -jnp.inf)
        p = jax.nn.softmax(s, axis=-1).astype(v.dtype)
        return jnp.einsum('bqhk,bqkd->bqhd', p, vg)

    out = lax.map(block, (jnp.arange(nb), qb, iqb, iwb))
    return out.swapaxes(0, 1).reshape(b, l, h, d)


def retention(q, k, v):
    b, l, h, dk = q.shape
    dv = v.shape[-1]
    n = l // RET_CHUNK
    log_g = jnp.log1p(-(2.0 ** (-5.0 - jnp.arange(h, dtype=jnp.float32))))
    pos = jnp.arange(RET_CHUNK, dtype=jnp.float32)
    diff = pos[:, None] - pos[None, :]
    decay_in = jnp.where(diff >= 0, jnp.exp(jnp.maximum(diff, 0.0)[None] * log_g[:, None, None]), 0.0)
    decay_q = jnp.exp((pos + 1.0)[None] * log_g[:, None])
    decay_k = jnp.exp((RET_CHUNK - 1.0 - pos)[None] * log_g[:, None])
    decay_chunk = jnp.exp(RET_CHUNK * log_g)

    def chunks(t):
        return t.astype(jnp.float32).reshape(b, n, RET_CHUNK, h, t.shape[-1]).transpose(1, 0, 3, 2, 4)

    qc = chunks(q) * (dk ** -0.5)
    kc = chunks(k)
    vc = chunks(v)

    def step(state, inp):
        qi, ki, vi = inp
        attn = jnp.einsum('bhid,bhjd->bhij', qi, ki) * decay_in
        inner = jnp.einsum('bhij,bhje->bhie', attn, vi)
        cross = jnp.einsum('bhid,bhde->bhie', qi, state) * decay_q[..., None]
        state = decay_chunk[:, None, None] * state + jnp.einsum('bhjd,bhje->bhde', ki * decay_k[..., None], vi)
        return state, inner + cross

    state0 = jnp.zeros((b, h, dk, dv), jnp.float32)
    _, out = lax.scan(step, state0, (qc, kc, vc))
    return out.transpose(1, 0, 3, 2, 4).reshape(b, l, h, dv).astype(v.dtype)


def hybrid_layer(x, ln1_g, w_in, fox_b_f, fox_q_norm, fox_k_norm, dsa_q_norm, dsa_k_norm,
                 ret_out_norm, w_fox_out, w_dsa_out, w_ret_out, w_o, ln2_g, w_ffn_in, w_ffn_out):
    b, l, _ = x.shape
    pos = jnp.arange(l)
    hdn = rms_norm(x, ln1_g)
    (fq, fk, fv, ff, dq, dk, dv, iq, ik, iw, rq, rk, rv, rg, zg) = split_columns(hdn @ w_in)

    fq = rms_norm(fq.reshape(b, l, FOX_HEADS, FOX_DIM), fox_q_norm)
    fk = rms_norm(fk.reshape(b, l, FOX_HEADS, FOX_DIM), fox_k_norm)
    fv = fv.reshape(b, l, FOX_HEADS, FOX_DIM)
    log_f = jax.nn.log_sigmoid(ff.astype(jnp.float32) + fox_b_f.astype(jnp.float32))
    y_a = fox_attention(fq, fk, fv, log_f).reshape(b, l, FOX_W)

    dq = apply_rope(rms_norm(dq.reshape(b, l, DSA_HEADS, DSA_DIM), dsa_q_norm), pos)
    dk = apply_rope(rms_norm(dk, dsa_k_norm)[:, :, None, :], pos)[:, :, 0, :]
    iq = apply_rope(iq.reshape(b, l, IDX_HEADS, IDX_DIM), pos)
    ik = apply_rope(ik[:, :, None, :], pos)[:, :, 0, :]
    y_b = dsa_attention(dq, dk, dv, iq, ik, iw).reshape(b, l, DSA_W)

    rq = apply_rope(rq.reshape(b, l, RET_HEADS, RET_QK_DIM), pos)
    rk = apply_rope(rk.reshape(b, l, RET_HEADS, RET_QK_DIM), pos)
    rv = rv.reshape(b, l, RET_HEADS, RET_V_DIM)
    y_c = rms_norm(retention(rq, rk, rv), ret_out_norm).reshape(b, l, RET_V_W) * jax.nn.silu(rg)

    gates = jax.nn.sigmoid(zg).reshape(b, l, N_BRANCH, D_MODEL)
    merged = (gates[:, :, 0] * (y_a @ w_fox_out)
              + gates[:, :, 1] * (y_b @ w_dsa_out)
              + gates[:, :, 2] * (y_c @ w_ret_out))
    x = x + merged @ w_o

    g, u = jnp.split(rms_norm(x, ln2_g) @ w_ffn_in, 2, axis=-1)
    return x + (jax.nn.silu(g) * u) @ w_ffn_out


def setup_inputs(seed: int = 0) -> dict:
    key = jax.random.key(seed)
    ks = jax.random.split(key, 17)

    def nrm(k, shape, scale):
        return jax.random.normal(k, shape, jnp.float32) * scale

    res_scale = (2.0 * DEPTH) ** -0.5
    return {
        'x': nrm(ks[0], (BATCH, SEQ, D_MODEL), 1.0),
        'ln1_g': 1.0 + nrm(ks[1], (DEPTH, D_MODEL), 0.05),
        'w_in': nrm(ks[2], (DEPTH, D_MODEL, IN_COLS), D_MODEL ** -0.5),
        'fox_b_f': 3.0 + nrm(ks[3], (DEPTH, FOX_HEADS), 0.5),
        'fox_q_norm': 1.0 + nrm(ks[4], (DEPTH, FOX_DIM), 0.05),
        'fox_k_norm': 1.0 + nrm(ks[5], (DEPTH, FOX_DIM), 0.05),
        'dsa_q_norm': 1.0 + nrm(ks[6], (DEPTH, DSA_DIM), 0.05),
        'dsa_k_norm': 1.0 + nrm(ks[7], (DEPTH, DSA_DIM), 0.05),
        'ret_out_norm': 1.0 + nrm(ks[8], (DEPTH, RET_HEADS, RET_V_DIM), 0.05),
        'w_fox_out': nrm(ks[9], (DEPTH, FOX_W, D_MODEL), FOX_W ** -0.5),
        'w_dsa_out': nrm(ks[10], (DEPTH, DSA_W, D_MODEL), DSA_W ** -0.5),
        'w_ret_out': nrm(ks[11], (DEPTH, RET_V_W, D_MODEL), RET_V_W ** -0.5),
        'w_o': nrm(ks[12], (DEPTH, D_MODEL, D_MODEL), D_MODEL ** -0.5 * res_scale),
        'ln2_g': 1.0 + nrm(ks[13], (DEPTH, D_MODEL), 0.05),
        'w_ffn_in': nrm(ks[14], (DEPTH, D_MODEL, 2 * FFN_HIDDEN), D_MODEL ** -0.5),
        'w_ffn_out': nrm(ks[15], (DEPTH, FFN_HIDDEN, D_MODEL), FFN_HIDDEN ** -0.5 * res_scale),
    }


def reference(x, ln1_g, w_in, fox_b_f, fox_q_norm, fox_k_norm, dsa_q_norm, dsa_k_norm,
              ret_out_norm, w_fox_out, w_dsa_out, w_ret_out, w_o, ln2_g, w_ffn_in, w_ffn_out):
    for i in range(DEPTH):
        x = hybrid_layer(x, ln1_g[i], w_in[i], fox_b_f[i], fox_q_norm[i], fox_k_norm[i],
                         dsa_q_norm[i], dsa_k_norm[i], ret_out_norm[i], w_fox_out[i],
                         w_dsa_out[i], w_ret_out[i], w_o[i], ln2_g[i], w_ffn_in[i], w_ffn_out[i])
    return x
```

```cpp
#include <hip/hip_runtime.h>
#include <cstdio>
#include <cstdint>
#include <cmath>
namespace pg8 {
#define PG8_LAS __attribute__((address_space(3)))
typedef unsigned short bf16_t;
typedef short bf16x8 __attribute__((ext_vector_type(8)));
typedef float f32x4 __attribute__((ext_vector_type(4)));
typedef unsigned u32x4 __attribute__((ext_vector_type(4)));
constexpr int BM = 256, BK = 64, HALF = 128, HTB = HALF * BK * 2  , STAGE_BYTES = 8 * HTB, NXCD = 8, WGM = 8;

__host__ __device__ __forceinline__ int lds_byte(int r, int c) { const int st = (r >> 4) * 2 + (c >> 5), rr = r & 15, cc = c & 31, ob = rr * 64 + cc * 2; return st * 1024 + (ob ^ (((ob >> 9) & 1) << 5)); }
__host__ __device__ __forceinline__ void stage_rc(int b, int& R, int& C) { const int st = b / 1024, sb = b % 1024, swz = sb ^ (((sb >> 9) & 1) << 5); R = (st >> 1) * 16 + swz / 64; C = (st & 1) * 32 + (swz % 64) / 2; }
__host__ __device__ __forceinline__ int perm32(int rho) { const int n = rho >> 4, i = rho & 15; return 8 * (i >> 2) + 4 * n + (i & 3); }

struct Unit { int pm, pn; };
struct Gemm { const bf16_t* A; const bf16_t* Bt; int M, N, K, lda, ldb; };

struct StaticOrder {
    int nM, nN, nwg, G, c;
    __host__ __device__ void init(int M, int N, int G_, int c_) { nM = M / BM; nN = N / BM; nwg = nM * nN; G = G_; c = c_; }
    __host__ __device__ bool next(int i, Unit& u) const {
        const long L = (long)i * G + c; if (L >= nwg) return false;
        int wgid = (int)L; { const int q = nwg / NXCD, r = nwg % NXCD, xcd = wgid % NXCD, off = wgid / NXCD; wgid = (xcd < r ? xcd * (q + 1) : r * (q + 1) + (xcd - r) * q) + off; }
        const int nig = WGM * nN, gid = wgid / nig, fm = gid * WGM, gsz = (nM - fm) < WGM ? (nM - fm) : WGM;
        u.pm = fm + ((wgid % nig) % gsz); u.pn = (wgid % nig) / gsz; return true;
    }
    __device__ __forceinline__ void a_ready(const Unit&) const {}
    __device__ __forceinline__ void done(const Unit&) const {}
};

__device__ __forceinline__ unsigned cvt_pk_bf16(float lo, float hi) { unsigned r; asm volatile("v_cvt_pk_bf16_f32 %0, %1, %2" : "=v"(r) : "v"(lo), "v"(hi)); return r; }
__device__ __forceinline__ float bflo(unsigned w) { return __builtin_bit_cast(float, w << 16); }
__device__ __forceinline__ float bfhi(unsigned w) { return __builtin_bit_cast(float, w & 0xffff0000u); }
__device__ __forceinline__ float sigmoidf_(float x) { return __builtin_amdgcn_rcpf(1.0f + __builtin_amdgcn_exp2f(-1.4426950408889634f * x)); }

constexpr int ZP = 6656;
constexpr int ZSP = 512;
constexpr int NZT = 26;

struct EpiZ {
    static constexpr bool PERM = true, AFTER_DRAIN = false;
    bf16_t* Z; float* ZS;
    __device__ __forceinline__ void operator()(const f32x4 (&acc)[2][2][4][2], const Unit& u, int wr, int wc, int fr, int fq) const {
        const int row0 = u.pm * BM + wr * 64 + fr;
        if (u.pn < NZT) {
            const int col0 = u.pn * BM + wc * 32 + 8 * fq;
#pragma unroll
            for (int ai = 0; ai < 2; ++ai)
#pragma unroll
                for (int m = 0; m < 4; ++m) { bf16_t* rowp = Z + (size_t)(row0 + ai * HALF + m * 16) * ZP + col0;
#pragma unroll
                    for (int bj = 0; bj < 2; ++bj) { const f32x4 v0 = acc[ai][bj][m][0], v1 = acc[ai][bj][m][1];
                        u32x4 w; w.x = cvt_pk_bf16(v0[0], v0[1]); w.y = cvt_pk_bf16(v0[2], v0[3]); w.z = cvt_pk_bf16(v1[0], v1[1]); w.w = cvt_pk_bf16(v1[2], v1[3]);
                        *(u32x4*)(rowp + bj * HALF) = w; } }
        } else {
            const int col0 = (u.pn - NZT) * BM + wc * 32 + 8 * fq;
#pragma unroll
            for (int ai = 0; ai < 2; ++ai)
#pragma unroll
                for (int m = 0; m < 4; ++m) { float* rowp = ZS + (size_t)(row0 + ai * HALF + m * 16) * ZSP + col0;
#pragma unroll
                    for (int bj = 0; bj < 2; ++bj) { *(f32x4*)(rowp + bj * HALF) = acc[ai][bj][m][0]; *(f32x4*)(rowp + bj * HALF + 4) = acc[ai][bj][m][1]; } }
        }
    }
};

template <int P> struct EpiGate {
    static constexpr bool PERM = true, AFTER_DRAIN = false;
    const bf16_t* G;
    float* M32;
    bf16_t* OUT;
    __device__ __forceinline__ void operator()(const f32x4 (&acc)[2][2][4][2], const Unit& u, int wr, int wc, int fr, int fq) const {
        const int row0 = u.pm * BM + wr * 64 + fr, col0 = u.pn * BM + wc * 32 + 8 * fq;
#pragma unroll
        for (int ai = 0; ai < 2; ++ai)
#pragma unroll
            for (int m = 0; m < 4; ++m) { const size_t row = (size_t)(row0 + ai * HALF + m * 16);
#pragma unroll
                for (int bj = 0; bj < 2; ++bj) { const int col = col0 + bj * HALF;
                    const u32x4 gw = *(const u32x4*)(G + row * ZP + P * 1024 + col);
                    const f32x4 v0 = acc[ai][bj][m][0], v1 = acc[ai][bj][m][1];
                    f32x4 t0, t1;
                    t0[0] = sigmoidf_(bflo(gw.x)) * v0[0]; t0[1] = sigmoidf_(bfhi(gw.x)) * v0[1]; t0[2] = sigmoidf_(bflo(gw.y)) * v0[2]; t0[3] = sigmoidf_(bfhi(gw.y)) * v0[3];
                    t1[0] = sigmoidf_(bflo(gw.z)) * v1[0]; t1[1] = sigmoidf_(bfhi(gw.z)) * v1[1]; t1[2] = sigmoidf_(bflo(gw.w)) * v1[2]; t1[3] = sigmoidf_(bfhi(gw.w)) * v1[3];
                    float* mp = M32 + row * 1024 + col;
                    if (P == 0) { *(f32x4*)mp = t0; *(f32x4*)(mp + 4) = t1; }
                    else if (P == 1) { *(f32x4*)mp = *(const f32x4*)mp + t0; *(f32x4*)(mp + 4) = *(const f32x4*)(mp + 4) + t1; }
                    else { t0 = *(const f32x4*)mp + t0; t1 = *(const f32x4*)(mp + 4) + t1;
                        u32x4 w; w.x = cvt_pk_bf16(t0[0], t0[1]); w.y = cvt_pk_bf16(t0[2], t0[3]); w.z = cvt_pk_bf16(t1[0], t1[1]); w.w = cvt_pk_bf16(t1[2], t1[3]);
                        *(u32x4*)(OUT + row * ZP + col) = w; } } }
    }
};

struct EpiRes {
    static constexpr bool PERM = true, AFTER_DRAIN = false;
    const float* RES; float* OUT;
    __device__ __forceinline__ void operator()(const f32x4 (&acc)[2][2][4][2], const Unit& u, int wr, int wc, int fr, int fq) const {
        const int row0 = u.pm * BM + wr * 64 + fr, col0 = u.pn * BM + wc * 32 + 8 * fq;
#pragma unroll
        for (int ai = 0; ai < 2; ++ai)
#pragma unroll
            for (int m = 0; m < 4; ++m) { const size_t off = (size_t)(row0 + ai * HALF + m * 16) * 1024 + col0;
#pragma unroll
                for (int bj = 0; bj < 2; ++bj) { const float* rp = RES + off + bj * HALF; float* op = OUT + off + bj * HALF;
                    const f32x4 r0 = *(const f32x4*)rp, r1 = *(const f32x4*)(rp + 4);
                    *(f32x4*)op = r0 + acc[ai][bj][m][0]; *(f32x4*)(op + 4) = r1 + acc[ai][bj][m][1]; } }
    }
};

struct EpiSwi {
    static constexpr bool PERM = true, AFTER_DRAIN = false;
    bf16_t* H; int ldh;
    __device__ __forceinline__ void operator()(const f32x4 (&acc)[2][2][4][2], const Unit& u, int wr, int wc, int fr, int fq) const {
        const int row0 = u.pm * BM + wr * 64 + fr, col0 = u.pn * HALF + wc * 32 + 8 * fq;
#pragma unroll
        for (int ai = 0; ai < 2; ++ai)
#pragma unroll
            for (int m = 0; m < 4; ++m) { bf16_t* hp = H + (size_t)(row0 + ai * HALF + m * 16) * ldh + col0;
                float o[8];
#pragma unroll
                for (int n = 0; n < 2; ++n)
#pragma unroll
                    for (int i = 0; i < 4; ++i) { const float g = acc[ai][0][m][n][i], up = acc[ai][1][m][n][i]; o[4 * n + i] = g * sigmoidf_(g) * up; }
                u32x4 w; w.x = cvt_pk_bf16(o[0], o[1]); w.y = cvt_pk_bf16(o[2], o[3]); w.z = cvt_pk_bf16(o[4], o[5]); w.w = cvt_pk_bf16(o[6], o[7]);
                *(u32x4*)hp = w; }
    }
};

template <class Epi, class Sched, bool ALIGN_EPI = false, bool SP2 = false>
__device__ __forceinline__ void gemm_phase(PG8_LAS unsigned char* lds, Gemm g, const Sched& S0, const Epi& E) {
    int ovz, osz; asm volatile("v_mov_b32 %0, 0\n\ts_mov_b32 %1, 0" : "=v"(ovz), "=s"(osz));
    Sched S = S0; S.c += osz; g.lda += osz; g.ldb += osz;
    const int tid = threadIdx.x + ovz, wid = __builtin_amdgcn_readfirstlane(tid >> 6), lane = tid & 63, wr = wid >> 2, wc = wid & 3, fr = lane & 15, fq = lane >> 4;
    const int K = g.K, nt = K / BK;
    unsigned voffA[2], voffB[2];
#pragma unroll
    for (int i = 0; i < 2; ++i) { int R, C; stage_rc(tid * 16 + i * 8192, R, C); const int Rb = Epi::PERM ? ((R & ~31) + perm32(R & 31)) : R;
        voffA[i] = (unsigned)(R * g.lda + C) * 2u; voffB[i] = (unsigned)(Rb * g.ldb + C) * 2u; }
    const size_t kstep = (size_t)(BK * 2);
    const size_t hstepA = (size_t)HALF * g.lda * 2, hstepB = (size_t)HALF * g.ldb * 2;
    const size_t tstepA = 2 * hstepA, tstepB = 2 * hstepB;
    const unsigned ldsw = (unsigned)wid * 1024u;
    const int aoff = lds_byte(wr * 64 + fr, fq * 8), boff = lds_byte(wc * 32 + fr, fq * 8);
#define PG8_SA(b, h) (((b) * 2 + (h)) * HTB)
#define PG8_SB(b, h) ((4 + (b) * 2 + (h)) * HTB)
#define PG8_STAGE(bufoff, gbase, voff) do { _Pragma("unroll") for (int _i = 0; _i < 2; ++_i) \
        __builtin_amdgcn_global_load_lds((const unsigned*)((const char*)(gbase) + (voff)[_i]), (PG8_LAS unsigned*)(lds + (bufoff) + ldsw + _i * 8192), 16, 0, 0); } while (0)
#define PG8_LDA(dst, b, h) do { _Pragma("unroll") for (int m = 0; m < 4; ++m) _Pragma("unroll") for (int k = 0; k < 2; ++k) dst[m][k] = *(const PG8_LAS bf16x8*)(lds + PG8_SA(b, h) + aoff + m * 2048 + k * 1024); } while (0)
#define PG8_LDB(dst, b, h) do { _Pragma("unroll") for (int n = 0; n < 2; ++n) _Pragma("unroll") for (int k = 0; k < 2; ++k) dst[n][k] = *(const PG8_LAS bf16x8*)(lds + PG8_SB(b, h) + boff + n * 2048 + k * 1024); } while (0)
#define PG8_MMA(ai, bj, At, Bt) do { __builtin_amdgcn_s_setprio(1); _Pragma("unroll") for (int m = 0; m < 4; ++m) _Pragma("unroll") for (int n = 0; n < 2; ++n) _Pragma("unroll") for (int k = 0; k < 2; ++k) \
        acc[ai][bj][m][n] = __builtin_amdgcn_mfma_f32_16x16x32_bf16(Bt[n][k], At[m][k], acc[ai][bj][m][n], 0, 0, 0); __builtin_amdgcn_s_setprio(0); } while (0)
#define PG8_WAIT_V(n) asm volatile("s_waitcnt vmcnt(" #n ")" ::: "memory")
#define PG8_WAIT_L(n) asm volatile("s_waitcnt lgkmcnt(" #n ")" ::: "memory")
#define PG8_BAR __builtin_amdgcn_s_barrier()
#define PG8_SCHED __builtin_amdgcn_sched_barrier(0)
    Unit cur, nxt; int ui = 0;
    if (!S.next(0, cur)) return;
    f32x4 acc[2][2][4][2];
#pragma unroll
    for (int a = 0; a < 2; ++a)
#pragma unroll
        for (int b = 0; b < 2; ++b)
#pragma unroll
            for (int m = 0; m < 4; ++m)
#pragma unroll
                for (int n = 0; n < 2; ++n) acc[a][b][m][n] = (f32x4){0.f, 0.f, 0.f, 0.f};
    bf16x8 At[4][2], B0[2][2], B1[2][2];
    const char* cA = (const char*)g.A + (size_t)cur.pm * tstepA; const char* cB = (const char*)g.Bt + (size_t)cur.pn * tstepB;
    S.a_ready(cur);
    if constexpr (SP2) {
        PG8_STAGE(PG8_SB(0, 0), cB, voffB); PG8_STAGE(PG8_SB(0, 1), cB + hstepB, voffB); PG8_STAGE(PG8_SA(0, 0), cA, voffA); PG8_STAGE(PG8_SA(0, 1), cA + hstepA, voffA);
        if (wr == 1) PG8_BAR;
        PG8_WAIT_V(2); PG8_BAR;
        PG8_STAGE(PG8_SB(1, 0), cB + kstep, voffB); PG8_STAGE(PG8_SA(1, 0), cA + kstep, voffA); PG8_STAGE(PG8_SB(1, 1), cB + hstepB + kstep, voffB);
        PG8_WAIT_V(6); PG8_BAR;
    } else {
        PG8_STAGE(PG8_SB(0, 0), cB, voffB); PG8_STAGE(PG8_SA(0, 0), cA, voffA); PG8_STAGE(PG8_SB(0, 1), cB + hstepB, voffB); PG8_STAGE(PG8_SA(0, 1), cA + hstepA, voffA);
        if (wr == 1) PG8_BAR;
        PG8_WAIT_V(4); PG8_BAR;
        PG8_STAGE(PG8_SB(1, 0), cB + kstep, voffB); PG8_STAGE(PG8_SA(1, 0), cA + kstep, voffA); PG8_STAGE(PG8_SB(1, 1), cB + hstepB + kstep, voffB);
        PG8_WAIT_V(6); PG8_BAR;
    }
    for (;;) {
        const bool has_next = S.next(ui + 1, nxt);
        const char* nA = has_next ? (const char*)g.A + (size_t)nxt.pm * tstepA : cA; const char* nB = has_next ? (const char*)g.Bt + (size_t)nxt.pn * tstepB : cB;
        for (int t = 0; t < nt; t += 2) {
            const bool last = (t == nt - 2);
            const char* a1 = cA + (size_t)(t + 1) * kstep;
            const char* a2 = last ? nA : cA + (size_t)(t + 2) * kstep; const char* b2 = last ? nB : cB + (size_t)(t + 2) * kstep;
            const char* a3 = a2 + kstep; const char* b3 = b2 + kstep;
            if (last && has_next) S.a_ready(nxt);
            if constexpr (SP2) {
            PG8_LDB(B0, 0, 0); PG8_LDB(B1, 0, 1); PG8_SCHED; PG8_LDA(At, 0, 0); PG8_STAGE(PG8_SA(1, 1), a1 + hstepA, voffA);
            PG8_WAIT_V(8); PG8_WAIT_L(0); PG8_BAR; PG8_MMA(0, 0, At, B0); PG8_MMA(0, 1, At, B1); PG8_BAR; PG8_SCHED;
            PG8_LDA(At, 0, 1); PG8_STAGE(PG8_SB(0, 0), b2, voffB); PG8_STAGE(PG8_SB(0, 1), b2 + hstepB, voffB); PG8_STAGE(PG8_SA(0, 0), a2, voffA);
            PG8_WAIT_V(8); PG8_WAIT_L(0); PG8_BAR; PG8_MMA(1, 0, At, B0); PG8_MMA(1, 1, At, B1); PG8_BAR; PG8_SCHED;
            PG8_LDB(B0, 1, 0); PG8_LDB(B1, 1, 1); PG8_SCHED; PG8_LDA(At, 1, 0); PG8_STAGE(PG8_SA(0, 1), a2 + hstepA, voffA);
            PG8_WAIT_V(8); PG8_WAIT_L(0); PG8_BAR; PG8_MMA(0, 0, At, B0); PG8_MMA(0, 1, At, B1); PG8_BAR; PG8_SCHED;
            PG8_LDA(At, 1, 1); PG8_STAGE(PG8_SB(1, 0), b3, voffB); PG8_STAGE(PG8_SB(1, 1), b3 + hstepB, voffB); PG8_STAGE(PG8_SA(1, 0), a3, voffA);
            PG8_WAIT_V(8); PG8_WAIT_L(0); PG8_BAR; PG8_MMA(1, 0, At, B0); PG8_MMA(1, 1, At, B1); PG8_BAR; PG8_SCHED;
            } else {
            PG8_LDB(B0, 0, 0); PG8_SCHED; PG8_LDA(At, 0, 0); PG8_STAGE(PG8_SA(1, 1), a1 + hstepA, voffA);
            PG8_WAIT_L(8); PG8_BAR; PG8_WAIT_L(0); PG8_MMA(0, 0, At, B0); PG8_BAR; PG8_SCHED;
            PG8_LDB(B1, 0, 1); PG8_STAGE(PG8_SB(0, 0), b2, voffB);
            PG8_BAR; PG8_WAIT_L(0); PG8_MMA(0, 1, At, B1); PG8_BAR;
            PG8_LDA(At, 0, 1); PG8_STAGE(PG8_SA(0, 0), a2, voffA);
            PG8_BAR; PG8_WAIT_L(0); PG8_MMA(1, 0, At, B0); PG8_BAR; PG8_SCHED;
            PG8_STAGE(PG8_SB(0, 1), b2 + hstepB, voffB);
            PG8_WAIT_V(6); PG8_BAR; PG8_MMA(1, 1, At, B1); PG8_BAR;
            PG8_LDB(B0, 1, 0); PG8_SCHED; PG8_LDA(At, 1, 0); PG8_STAGE(PG8_SA(0, 1), a2 + hstepA, voffA);
            PG8_WAIT_L(8); PG8_BAR; PG8_WAIT_L(0); PG8_MMA(0, 0, At, B0); PG8_BAR; PG8_SCHED;
            PG8_LDB(B1, 1, 1); PG8_STAGE(PG8_SB(1, 0), b3, voffB);
            PG8_BAR; PG8_WAIT_L(0); PG8_MMA(0, 1, At, B1); PG8_BAR;
            PG8_LDA(At, 1, 1); PG8_STAGE(PG8_SA(1, 0), a3, voffA);
            PG8_BAR; PG8_WAIT_L(0); PG8_MMA(1, 0, At, B0); PG8_BAR; PG8_SCHED;
            PG8_STAGE(PG8_SB(1, 1), b3 + hstepB, voffB);
            PG8_WAIT_V(6); PG8_BAR; PG8_MMA(1, 1, At, B1); PG8_BAR;
            }
        }
        if constexpr (ALIGN_EPI) { if (wr == 0) PG8_BAR; }
        if constexpr (!Epi::AFTER_DRAIN) { E(acc, cur, wr, wc, fr, fq); S.done(cur); }
        if (!has_next) break;
#pragma unroll
        for (int a = 0; a < 2; ++a)
#pragma unroll
            for (int b = 0; b < 2; ++b)
#pragma unroll
                for (int m = 0; m < 4; ++m)
#pragma unroll
                    for (int n = 0; n < 2; ++n) acc[a][b][m][n] = (f32x4){0.f, 0.f, 0.f, 0.f};
        cur = nxt; cA = nA; cB = nB; ++ui;
        if constexpr (ALIGN_EPI) { if (wr == 1) PG8_BAR; }
    }
    PG8_WAIT_V(0);
    if constexpr (!ALIGN_EPI) { if (wr == 0) PG8_BAR; }
    PG8_BAR;
    if constexpr (Epi::AFTER_DRAIN) { E.fused(acc, cur, wr, wc, fr, fq, lds, wid, lane); S.done(cur); }
#undef PG8_SA
#undef PG8_SB
#undef PG8_STAGE
#undef PG8_LDA
#undef PG8_LDB
#undef PG8_MMA
#undef PG8_WAIT_V
#undef PG8_WAIT_L
#undef PG8_BAR
#undef PG8_SCHED
}
}

constexpr int NB = 4, SEQ = 4096, DM = 1024, DEPTH = 4, M = NB * SEQ;
constexpr int INC = 7088;
constexpr int NIN = 7168;
constexpr int FFH = 2816, FF2 = 5632;
constexpr int ZP = pg8::ZP, ZSP = pg8::ZSP;
constexpr int Z_FQ = 0, Z_FK = 512, Z_FV = 1024, Z_DQ = 1536, Z_RV = 2048, Z_RQ = 2560, Z_RK = 2816, Z_RG = 3072, Z_ZG = 3584, Z_MRG = 2560;
constexpr int S_IQ = 0, S_DK = 256, S_DV = 320, S_IK = 384, S_IW = 416, S_FF = 424;
constexpr float NORM_EPS = 1e-6f;
constexpr float LOG2E = 1.4426950408889634f;
constexpr float C2 = 0.125f * 1.4426950408889634f;

constexpr size_t MiB = 1u << 20;
constexpr size_t WS_CTL = 0, CTL_ZERO_BYTES = 1 * MiB;
constexpr size_t WS_ROPE64 = 1 * MiB;
constexpr size_t WS_ROPE32 = 2 * MiB;
constexpr size_t WS_LF = 2 * MiB + 512 * 1024;
constexpr size_t WS_CF = 3 * MiB;
constexpr size_t WS_ISG = 3 * MiB + 512 * 1024;
constexpr size_t WS_KD = 4 * MiB;
constexpr size_t WS_VD = 6 * MiB;
constexpr size_t WS_W = 8 * MiB;
constexpr size_t LW_IN = 0, LW_MIX = (size_t)NIN * 1024, LW_O = LW_MIX + 1536 * 1024, LW_FI = LW_O + 1024 * 1024, LW_FO = LW_FI + (size_t)FF2 * 1024, LW_STRIDE = LW_FO + (size_t)FFH * 1024;
constexpr size_t WS_Z = 150 * MiB;
constexpr size_t WS_HDN = 358 * MiB;
constexpr size_t WS_ZS = 390 * MiB;
constexpr size_t WS_END = 422 * MiB;
static_assert(WS_W + DEPTH * LW_STRIDE * 2 <= WS_Z && WS_Z + (size_t)M * ZP * 2 <= WS_HDN && WS_HDN + (size_t)M * 1024 * 2 == WS_ZS && WS_ZS + (size_t)M * ZSP * 4 == WS_END, "d_ws map");
constexpr int CW_BAR = 4096;

constexpr int RING_OFF = 0, RING_BYTES = 131072;
constexpr int LDSCTL_OFF = RING_BYTES, MISC_OFF = LDSCTL_OFF + 320;
constexpr int XTRA_OFF = RING_BYTES + 1024;
constexpr int LDS_BYTES = 147456;
constexpr int NWAVES = 8;
#define GAS __attribute__((address_space(1)))
#define LAS __attribute__((address_space(3)))
typedef unsigned short bf16;
typedef unsigned v4u __attribute__((ext_vector_type(4)));
typedef float f32x4 __attribute__((ext_vector_type(4)));
typedef short bf16x8 __attribute__((ext_vector_type(8)));
typedef GAS unsigned gu32;
typedef GAS unsigned long long gu64;
#define RLX_AGENT __ATOMIC_RELAXED, __HIP_MEMORY_SCOPE_AGENT
#define LDS_WAIT() asm volatile("s_waitcnt lgkmcnt(0)" ::: "memory")
#define VM_WAIT() asm volatile("s_waitcnt vmcnt(0)" ::: "memory")
__device__ __forceinline__ unsigned long long rt() { return __builtin_amdgcn_s_memrealtime(); }
__device__ __forceinline__ unsigned f2bf(float f) { unsigned u = __builtin_bit_cast(unsigned, f); return (u + 0x7fffu + ((u >> 16) & 1u)) >> 16; }
__device__ __forceinline__ unsigned pk2(float lo, float hi) { return f2bf(lo) | (f2bf(hi) << 16); }

#define XB_TMO      128
#define XB_XCNT(j)  (256  + 64 * (j))
#define XB_XSUB(j)  (1280 + 64 * (j))
#define XB_XGEN(j)  (2304 + 64 * (j))
#define XB_TOP      3328
#define XB_TOPGEN   3392
#define XCD_BAR_WORDS 3456
#define XB_SPIN_CAP (1u << 22)

__device__ __forceinline__ unsigned xb_ld(unsigned* p)              { return __hip_atomic_load(p, __ATOMIC_RELAXED, __HIP_MEMORY_SCOPE_AGENT); }
__device__ __forceinline__ unsigned xb_add(unsigned* p, unsigned v) { return __hip_atomic_fetch_add(p, v, __ATOMIC_RELAXED, __HIP_MEMORY_SCOPE_AGENT); }
__device__ __forceinline__ unsigned xb_xcc_id() { return (unsigned)__builtin_amdgcn_s_getreg((3 << 11) | 20) & 0xFu; }
#define XB_SPIN(cond, bar) do { unsigned _sp = 0; while (cond) { __builtin_amdgcn_s_sleep(1); \
    if ((++_sp & 255u) == 0u) { if (xb_ld(&(bar)[XB_TMO])) break; if (_sp > XB_SPIN_CAP) { atomicAdd(&(bar)[XB_TMO], 1u); break; } } } } while (0)

struct XcdBarrier {
    unsigned* bar; unsigned x;
    volatile LAS unsigned* st;
};

__device__ __forceinline__ XcdBarrier xcd_barrier_post(unsigned* bar, volatile LAS unsigned* st) {
    XcdBarrier b; b.bar = bar; b.x = xb_xcc_id(); b.st = st;
    if (threadIdx.x == 0) (void)xb_add(&bar[XB_XCNT(b.x)], 1u);
    return b;
}
__device__ __forceinline__ void xcd_barrier_complete(unsigned* bar, unsigned x, unsigned& nloc, unsigned& nx) {
    const unsigned G = gridDim.x * gridDim.y * gridDim.z;
    unsigned sum, cnt, mine, sp = 0u;
    for (;;) {
        sum = 0u; cnt = 0u; mine = 0u;
#pragma unroll
        for (unsigned j = 0; j < 16; ++j) { const unsigned c = xb_ld(&bar[XB_XCNT(j)]); sum += c; cnt += (c > 0u) ? 1u : 0u; mine = (j == x) ? c : mine; }
        if (sum == G) break;
        __builtin_amdgcn_s_sleep(1);
        if ((++sp & 255u) == 0u) { if (xb_ld(&bar[XB_TMO])) break; if (sp > XB_SPIN_CAP) { atomicAdd(&bar[XB_TMO], 1u); break; } }
    }
    nloc = mine > 0u ? mine : 1u; nx = cnt > 0u ? cnt : 1u;
}

__device__ __forceinline__ void xcd_barrier(const XcdBarrier& b) {
    asm volatile("s_waitcnt vmcnt(0)" ::: "memory");
    __syncthreads();
    if (threadIdx.x == 0) {
        unsigned* bar = b.bar;
        __builtin_amdgcn_s_waitcnt(0);
        unsigned nloc = b.st[0], nx = b.st[1];
        if (nloc == 0u) { xcd_barrier_complete(bar, b.x, nloc, nx); b.st[0] = nloc; b.st[1] = nx; }
        const unsigned old = xb_add(&bar[XB_XSUB(b.x)], 1u);
        const unsigned gen = old / nloc;
        if (old + 1u == (gen + 1u) * nloc) {
            __builtin_amdgcn_fence(__ATOMIC_RELEASE, "agent");
            asm volatile("s_waitcnt vmcnt(0)" ::: "memory");
            const unsigned og = xb_add(&bar[XB_TOP], 1u);
            const unsigned tg = og / nx;
            if (og + 1u == (tg + 1u) * nx) xb_add(&bar[XB_TOPGEN], 1u);
            else XB_SPIN(xb_ld(&bar[XB_TOPGEN]) == tg, bar);
            __builtin_amdgcn_fence(__ATOMIC_ACQUIRE, "agent");
            xb_add(&bar[XB_XGEN(b.x)], 1u);
            asm volatile("s_waitcnt vmcnt(0)" ::: "memory");
        } else {
            XB_SPIN(xb_ld(&bar[XB_XGEN(b.x)]) == gen, bar);
            __builtin_amdgcn_fence(__ATOMIC_ACQUIRE, "agent");
            asm volatile("s_waitcnt vmcnt(0)" ::: "memory");
        }
    }
    __syncthreads();
}

typedef float f32x2 __attribute__((ext_vector_type(2)));
typedef unsigned u32x2 __attribute__((ext_vector_type(2)));
__device__ __forceinline__ float bflo(unsigned w) { return __builtin_bit_cast(float, w << 16); }
__device__ __forceinline__ float bfhi(unsigned w) { return __builtin_bit_cast(float, w & 0xffff0000u); }
__device__ __forceinline__ float bf2f(bf16 v) { return __builtin_bit_cast(float, (unsigned)v << 16); }
__device__ __forceinline__ void unpack8(const v4u w, float (&f)[8]) { f[0] = bflo(w.x); f[1] = bfhi(w.x); f[2] = bflo(w.y); f[3] = bfhi(w.y); f[4] = bflo(w.z); f[5] = bfhi(w.z); f[6] = bflo(w.w); f[7] = bfhi(w.w); }
__device__ __forceinline__ v4u pack8(const float (&f)[8]) { v4u w; w.x = pk2(f[0], f[1]); w.y = pk2(f[2], f[3]); w.z = pk2(f[4], f[5]); w.w = pk2(f[6], f[7]); return w; }
__device__ __forceinline__ float wave_sum(float v) {
#pragma unroll
    for (int o = 1; o < 64; o <<= 1) v += __shfl_xor(v, o);
    return v;
}
__device__ __forceinline__ float wave_max(float v) {
#pragma unroll
    for (int o = 1; o < 64; o <<= 1) v = fmaxf(v, __shfl_xor(v, o));
    return v;
}
__device__ __forceinline__ float sigmoid_f(float x) { return 1.0f / (1.0f + __expf(-x)); }

struct Ctx {
    LAS unsigned char* lds;
    int tid, lane, wave, G, gw, NGW;
    float* out; unsigned char* ws;
};

__device__ __forceinline__ void conv_item(const float* W, int N, int sc, int nv, int k0, bf16* WT, int ldw, int dr, LAS float* scr, int lane) {
    const int n_ = lane & 31;
#pragma unroll 8
    for (int i = 0; i < 32; ++i) { const int kk = 2 * i + (lane >> 5); scr[kk * 33 + n_] = (n_ < nv) ? W[(size_t)(k0 + kk) * N + sc + n_] : 0.f; }
    LDS_WAIT(); asm volatile("" ::: "memory");
    const int c = lane & 7;
#pragma unroll
    for (int j = 0; j < 4; ++j) { const int n = (lane >> 3) + 8 * j; const LAS float* s = scr + (8 * c) * 33 + n;
        v4u o; o.x = pk2(s[0 * 33], s[1 * 33]); o.y = pk2(s[2 * 33], s[3 * 33]); o.z = pk2(s[4 * 33], s[5 * 33]); o.w = pk2(s[6 * 33], s[7 * 33]);
        if (n < nv) *(GAS v4u*)(WT + (size_t)(dr + n) * ldw + k0 + 8 * c) = o; }
    LDS_WAIT(); asm volatile("" ::: "memory");
}
__device__ const int SEG_IN[15][3] = {
    {0, 0, 512}, {512, 512, 512}, {1024, 1024, 512}, {1536, 6656 + S_FF, 8}, {1544, Z_DQ, 512}, {2056, 6656 + S_DK, 64}, {2120, 6656 + S_DV, 64},
    {2184, 6656 + S_IQ, 256}, {2440, 6656 + S_IK, 32}, {2472, 6656 + S_IW, 8}, {2480, Z_RQ, 256}, {2736, Z_RK, 256}, {2992, Z_RV, 512}, {3504, Z_RG, 512}, {4016, Z_ZG, 3072}};
constexpr int IN_BLK = 223;
constexpr int IT_IN = 16 * IN_BLK, IT_MIX = 8 * 32, IT_O = 16 * 32, IT_FI = 16 * (FF2 / 32), IT_FO = (FFH / 64) * 32;
constexpr int IT_LAYER = IT_IN + 3 * IT_MIX + IT_O + IT_FI + IT_FO;

__device__ __forceinline__ void sincos_acc(float ang, float& c, float& s) {
    const double a = (double)ang;
    const double k = __builtin_rint(a * 0.6366197723675814);
    double y = a - k * 1.5707963267948966; y -= k * 6.123233995736766e-17;
    const double y2 = y * y;
    double sp = -7.647163731819816e-13; sp = sp * y2 + 1.6059043836821613e-10; sp = sp * y2 - 2.505210838544172e-08; sp = sp * y2 + 2.7557319223985893e-06; sp = sp * y2 - 1.984126984126984e-04; sp = sp * y2 + 8.333333333333333e-03; sp = sp * y2 - 1.6666666666666666e-01;
    const double sn = y + y * y2 * sp;
    double cp = 4.779477332387385e-14; cp = cp * y2 - 1.1470745597729725e-11; cp = cp * y2 + 2.08767569878681e-09; cp = cp * y2 - 2.755731922398589e-07; cp = cp * y2 + 2.48015873015873e-05; cp = cp * y2 - 1.388888888888889e-03; cp = cp * y2 + 4.1666666666666664e-02; cp = cp * y2 - 0.5;
    const double cs = 1.0 + y2 * cp;
    const int q = ((int)k) & 3;
    const double ss = (q & 1) ? cs : sn, cc = (q & 1) ? sn : cs;
    s = (float)((q & 2) ? -ss : ss);
    c = (float)(((q + 1) & 2) ? -cc : cc);
}

__device__ __forceinline__ void p0_prologue(const Ctx& F, const float* w_in, const float* w_fox, const float* w_dsa, const float* w_ret, const float* w_o, const float* w_fi, const float* w_fo) {
    LAS float* scr = (LAS float*)(F.lds + RING_OFF + F.wave * 16384);
    bf16* Wb = (bf16*)(F.ws + WS_W);
    for (int it = F.gw; it < DEPTH * IT_LAYER; it += F.NGW) {
        const int l = it / IT_LAYER; int r = it % IT_LAYER;
        bf16* L = Wb + (size_t)l * LW_STRIDE;
        if (r < IT_IN) {
            const int kb = r / IN_BLK; int blk = r % IN_BLK; int sc = 0, dr = 0, nv = 0;
            for (int s = 0; s < 15; ++s) { const int w = SEG_IN[s][2], nb = (w + 31) >> 5; if (blk < nb) { sc = SEG_IN[s][0] + 32 * blk; dr = SEG_IN[s][1] + 32 * blk; nv = (w - 32 * blk) < 32 ? (w - 32 * blk) : 32; break; } blk -= nb; }
            conv_item(w_in + (size_t)l * DM * INC, INC, sc, nv, 64 * kb, L + LW_IN, 1024, dr, scr, F.lane); continue; }
        r -= IT_IN;
        if (r < 3 * IT_MIX) { const int w = r / IT_MIX, q = r % IT_MIX, kb = q / 32, nb = q % 32;
            conv_item((w == 0 ? w_fox : w == 1 ? w_dsa : w_ret) + (size_t)l * 512 * DM, DM, 32 * nb, 32, 64 * kb, L + LW_MIX + (size_t)w * 512 * 1024, 512, 32 * nb, scr, F.lane); continue; }
        r -= 3 * IT_MIX;
        if (r < IT_O) { const int kb = r / 32, nb = r % 32;
            conv_item(w_o + (size_t)l * DM * DM, DM, 32 * nb, 32, 64 * kb, L + LW_O, 1024, 32 * nb, scr, F.lane); continue; }
        r -= IT_O;
        if (r < IT_FI) { const int kb = r / (FF2 / 32), nb = r % (FF2 / 32); const int n0 = 32 * nb;
            const int j = n0 < FFH ? n0 : n0 - FFH; const int dr = 256 * (j >> 7) + (j & 127) + (n0 < FFH ? 0 : 128);
            conv_item(w_fi + (size_t)l * DM * FF2, FF2, n0, 32, 64 * kb, L + LW_FI, 1024, dr, scr, F.lane); continue; }
        r -= IT_FI;
        { const int kb = r / 32, nb = r % 32;
            conv_item(w_fo + (size_t)l * FFH * DM, DM, 32 * nb, 32, 64 * kb, L + LW_FO, FFH, 32 * nb, scr, F.lane); }
    }
    for (int i = F.gw * 64 + F.lane; i < DEPTH * 80 * 128; i += F.NGW * 64) { const int l = i / (80 * 128), q = i % (80 * 128);
        *(GAS v4u*)(Wb + (size_t)l * LW_STRIDE + LW_IN + (size_t)INC * 1024 + (size_t)q * 8) = (v4u){0u, 0u, 0u, 0u}; }
    f32x2* R64 = (f32x2*)(F.ws + WS_ROPE64); f32x2* R32 = (f32x2*)(F.ws + WS_ROPE32);
    for (int i = F.gw * 64 + F.lane; i < SEQ * 32; i += F.NGW * 64) { const int pos = i >> 5, k = i & 31;
        double f = 1.0; for (int e = 0; e < k; ++e) f *= 0.7498942093324559;
        const float ang = (float)pos * (float)f; float c, s; sincos_acc(ang, c, s); R64[i] = (f32x2){c, s}; }
    for (int i = F.gw * 64 + F.lane; i < SEQ * 16; i += F.NGW * 64) { const int pos = i >> 4, k = i & 15;
        double f = 1.0; for (int e = 0; e < k; ++e) f *= 0.5623413251903491;
        const float ang = (float)pos * (float)f; float c, s; sincos_acc(ang, c, s); R32[i] = (f32x2){c, s}; }
}

__device__ __forceinline__ void rmsnorm_phase(const Ctx& F, const float* x, const float* g, bf16* o) {
    const GAS f32x4* gp = (const GAS f32x4*)g + F.lane;
    f32x4 gv[4];
#pragma unroll
    for (int j = 0; j < 4; ++j) gv[j] = gp[64 * j];
    for (int m = F.gw; m < M; m += F.NGW) {
        const GAS f32x4* xr = (const GAS f32x4*)(x + (size_t)m * DM) + F.lane;
        f32x4 v[4]; float s = 0.f;
#pragma unroll
        for (int j = 0; j < 4; ++j) { v[j] = xr[64 * j]; s += (v[j].x * v[j].x + v[j].y * v[j].y) + (v[j].z * v[j].z + v[j].w * v[j].w); }
        const float rstd = 1.0f / sqrtf(wave_sum(s) * (1.f / DM) + NORM_EPS);
        GAS unsigned long long* o8 = (GAS unsigned long long*)(o + (size_t)m * DM) + F.lane;
#pragma unroll
        for (int j = 0; j < 4; ++j) o8[64 * j] = (unsigned long long)pk2(v[j].x * rstd * gv[j].x, v[j].y * rstd * gv[j].y) | ((unsigned long long)pk2(v[j].z * rstd * gv[j].z, v[j].w * rstd * gv[j].w) << 32);
    }
}

__device__ __forceinline__ void post_phase(const Ctx& F, const float* g_fq, const float* g_fk, const float* g_dq, const float* g_dk, const float* b_f) {
    bf16* Z = (bf16*)(F.ws + WS_Z); float* ZS = (float*)(F.ws + WS_ZS);
    const f32x2* R64 = (const f32x2*)(F.ws + WS_ROPE64); const f32x2* R32 = (const f32x2*)(F.ws + WS_ROPE32);
    float* LF = (float*)(F.ws + WS_LF); unsigned* ISG = (unsigned*)(F.ws + WS_ISG);
    bf16* KD = (bf16*)(F.ws + WS_KD); bf16* VD = (bf16*)(F.ws + WS_VD);
    const int lane = F.lane, c8 = lane & 7;
    float gq[8], gk[8], gd[8];
#pragma unroll
    for (int j = 0; j < 8; ++j) { gq[j] = g_fq[c8 * 8 + j]; gk[j] = g_fk[c8 * 8 + j]; gd[j] = g_dq[c8 * 8 + j]; }
    const float gdk = g_dk[lane];
    for (int m = F.gw; m < M; m += F.NGW) {
        const int pos = m & (SEQ - 1);
        bf16* zr = Z + (size_t)m * ZP; float* sr = ZS + (size_t)m * ZSP;
        { v4u w = *(const GAS v4u*)(zr + Z_FQ + 8 * lane); float f[8]; unpack8(w, f); float ss = 0.f;
#pragma unroll
            for (int j = 0; j < 8; ++j) ss += f[j] * f[j];
            ss += __shfl_xor(ss, 1); ss += __shfl_xor(ss, 2); ss += __shfl_xor(ss, 4);
            const float rs = C2 / sqrtf(ss * (1.f / 64) + NORM_EPS);
#pragma unroll
            for (int j = 0; j < 8; ++j) f[j] = f[j] * rs * gq[j];
            *(GAS v4u*)(zr + Z_FQ + 8 * lane) = pack8(f); }
        { v4u w = *(const GAS v4u*)(zr + Z_FK + 8 * lane); float f[8]; unpack8(w, f); float ss = 0.f;
#pragma unroll
            for (int j = 0; j < 8; ++j) ss += f[j] * f[j];
            ss += __shfl_xor(ss, 1); ss += __shfl_xor(ss, 2); ss += __shfl_xor(ss, 4);
            const float rs = 1.0f / sqrtf(ss * (1.f / 64) + NORM_EPS);
#pragma unroll
            for (int j = 0; j < 8; ++j) f[j] = f[j] * rs * gk[j];
            *(GAS v4u*)(zr + Z_FK + 8 * lane) = pack8(f); }
        { v4u w = *(const GAS v4u*)(zr + Z_DQ + 8 * lane); float f[8]; unpack8(w, f); float ss = 0.f;
#pragma unroll
            for (int j = 0; j < 8; ++j) ss += f[j] * f[j];
            ss += __shfl_xor(ss, 1); ss += __shfl_xor(ss, 2); ss += __shfl_xor(ss, 4);
            const float rs = 1.0f / sqrtf(ss * (1.f / 64) + NORM_EPS);
            const f32x2* cs = R64 + pos * 32 + (c8 & 3) * 8;
#pragma unroll
            for (int j = 0; j < 8; ++j) { f[j] = f[j] * rs * gd[j]; }
            float o[8];
#pragma unroll
            for (int j = 0; j < 8; ++j) { const float p = __shfl_xor(f[j], 4); const f32x2 t = cs[j]; o[j] = ((c8 < 4) ? (f[j] * t.x - p * t.y) : (f[j] * t.x + p * t.y)) * C2; }
            *(GAS v4u*)(zr + Z_DQ + 8 * lane) = pack8(o); }
#pragma unroll
        for (int which = 0; which < 2; ++which) { bf16* p4 = zr + (which ? Z_RK : Z_RQ) + 4 * lane;
            const u32x2 w = *(const GAS u32x2*)p4; float f[4] = {bflo(w.x), bfhi(w.x), bflo(w.y), bfhi(w.y)};
            const f32x2* cs = R64 + pos * 32 + (lane & 7) * 4; const bool first = (lane & 15) < 8; const float sc = which ? 1.0f : 0.125f; float o[4];
#pragma unroll
            for (int j = 0; j < 4; ++j) { const float p = __shfl_xor(f[j], 8); const f32x2 t = cs[j]; o[j] = (first ? (f[j] * t.x - p * t.y) : (f[j] * t.x + p * t.y)) * sc; }
            u32x2 ow; ow.x = pk2(o[0], o[1]); ow.y = pk2(o[2], o[3]); *(GAS u32x2*)p4 = ow; }
        { const f32x4 v = *(const GAS f32x4*)(sr + S_IQ + 4 * lane); float f[4] = {v.x, v.y, v.z, v.w};
            const float iw = sr[S_IW + (lane >> 3)]; const float aw = fabsf(iw);
            const f32x2* cs = R32 + pos * 16 + (lane & 3) * 4; const bool first = (lane & 7) < 4; f32x4 o;
#pragma unroll
            for (int j = 0; j < 4; ++j) { const float p = __shfl_xor(f[j], 4); const f32x2 t = cs[j]; o[j] = (first ? (f[j] * t.x - p * t.y) : (f[j] * t.x + p * t.y)) * aw; }
            const unsigned long long neg = __ballot(iw < 0.f);
            unsigned sg = 0;
#pragma unroll
            for (int h = 0; h < 8; ++h) sg |= (unsigned)((neg >> (8 * h)) & 1ull) << h;
            *(GAS f32x4*)(sr + S_IQ + 4 * lane) = o;
            if (lane == 0) ISG[m] = sg; }
        { float v = sr[S_DK + lane]; const float ss = wave_sum(v * v); v = v * (1.0f / sqrtf(ss * (1.f / 64) + NORM_EPS)) * gdk;
            const float p = __shfl_xor(v, 32); const f32x2 t = R64[pos * 32 + (lane & 31)];
            const float o = (lane < 32) ? (v * t.x - p * t.y) : (v * t.x + p * t.y);
            KD[(size_t)m * 64 + lane] = (bf16)f2bf(o);
            VD[(size_t)m * 64 + lane] = (bf16)f2bf(sr[S_DV + lane]); }
        { const float v = sr[S_IK + (lane & 31)]; const float p = __shfl_xor(v, 16); const f32x2 t = R32[pos * 16 + (lane & 15)];
            const float o = ((lane & 16) == 0) ? (v * t.x - p * t.y) : (v * t.x + p * t.y);
            if (lane < 32) sr[S_IK + lane] = o; }
        if (lane < 8) { const float xx = sr[S_FF + lane] + b_f[lane]; const float ls = fminf(xx, 0.f) - log1pf(expf(-fabsf(xx))); LF[(size_t)m * 8 + lane] = ls * LOG2E; }
    }
}

__device__ __forceinline__ float ret_l2g(int h) { return h == 0 ? -0.04580368961312479f : h == 1 ? -0.02272007650008353f : h == 2 ? -0.011315313227834146f : -0.005646563141142063f; }

__device__ __forceinline__ void scan_state_phase(const Ctx& F) {
    const float* LF = (const float*)(F.ws + WS_LF); float* CF = (float*)(F.ws + WS_CF);
    const bf16* Z = (const bf16*)(F.ws + WS_Z); float* RS = (float*)(F.ws + WS_HDN);
    if (F.gw < 32) {
        const int b = F.gw >> 3, h = F.gw & 7; const float* lp = LF + ((size_t)b * SEQ + F.lane * 64) * 8 + h; float s = 0.f;
        for (int i = 0; i < 64; ++i) s += lp[i * 8];
        float incl = s;
#pragma unroll
        for (int o = 1; o < 64; o <<= 1) { const float t = __shfl_up(incl, o); if (F.lane >= o) incl += t; }
        float run = incl - s; float* cp = CF + (size_t)F.gw * SEQ + F.lane * 64;
        for (int i = 0; i < 64; ++i) { run += lp[i * 8]; cp[i] = run; }
    }
    for (int u = blockIdx.x; u < NB * 32 * 4; u += F.G) {
        const int h = u & 3, c = (u >> 2) & 31, b = u >> 7; const float l2g = ret_l2g(h);
        const int d = F.tid >> 3, e0 = (F.tid & 7) * 16; float acc[16];
#pragma unroll
        for (int i = 0; i < 16; ++i) acc[i] = 0.f;
        const bf16* base = Z + ((size_t)b * SEQ + c * 128) * ZP;
        for (int j = 0; j < 128; ++j) { const bf16* row = base + (size_t)j * ZP;
            const float kd = bf2f(row[Z_RK + h * 64 + d]) * exp2f((float)(127 - j) * l2g);
            const v4u w0 = *(const GAS v4u*)(row + Z_RV + h * 128 + e0), w1 = *(const GAS v4u*)(row + Z_RV + h * 128 + e0 + 8);
            float v0[8], v1[8]; unpack8(w0, v0); unpack8(w1, v1);
#pragma unroll
            for (int i = 0; i < 8; ++i) { acc[i] += kd * v0[i]; acc[8 + i] += kd * v1[i]; } }
        float* o = RS + (size_t)u * 8192 + d * 128 + e0;
#pragma unroll
        for (int i = 0; i < 4; ++i) *(GAS f32x4*)(o + 4 * i) = (f32x4){acc[4 * i], acc[4 * i + 1], acc[4 * i + 2], acc[4 * i + 3]};
    }
}

__device__ __forceinline__ void ret_out_naive(const Ctx& F, const float* gn) {
    bf16* Z = (bf16*)(F.ws + WS_Z); const float* RS = (const float*)(F.ws + WS_HDN);
    LAS float* S = (LAS float*)(F.lds);
    LAS bf16* Vt = (LAS bf16*)(F.lds + 32768);
    LAS float* Kt = (LAS float*)(F.lds + 65536);
    LAS float* aw = (LAS float*)(F.lds + 65536 + 33280) + F.wave * 128;
    LAS float* qw = (LAS float*)(F.lds + 65536 + 33280 + 4096) + F.wave * 64;
    for (int u = blockIdx.x; u < NB * 32 * 4; u += F.G) {
        const int h = u & 3, c = (u >> 2) & 31, b = u >> 7; const float l2g = ret_l2g(h); const float wch = exp2f(128.f * l2g);
        __syncthreads();
        { float s[16];
#pragma unroll
            for (int i = 0; i < 16; ++i) s[i] = 0.f;
            for (int cp = 0; cp < c; ++cp) { const float* L = RS + ((size_t)((b * 32 + cp) * 4 + h)) * 8192 + F.tid;
#pragma unroll
                for (int i = 0; i < 16; ++i) s[i] = wch * s[i] + L[i * 512]; }
#pragma unroll
            for (int i = 0; i < 16; ++i) S[F.tid + i * 512] = s[i]; }
        const bf16* base = Z + ((size_t)b * SEQ + c * 128) * ZP;
        for (int q = F.tid; q < 2048; q += 512) { const int r = q >> 4, ch = q & 15; *(LAS v4u*)(Vt + r * 128 + ch * 8) = *(const GAS v4u*)(base + (size_t)r * ZP + Z_RV + h * 128 + ch * 8); }
        for (int q = F.tid; q < 128 * 64; q += 512) { const int r = q >> 6, dd = q & 63; Kt[r * 65 + dd] = bf2f(base[(size_t)r * ZP + Z_RK + h * 64 + dd]); }
        __syncthreads();
        for (int i = F.wave; i < 128; i += NWAVES) {
            const size_t m = (size_t)b * SEQ + c * 128 + i; bf16* zr = Z + m * ZP;
            qw[F.lane] = bf2f(zr[Z_RQ + h * 64 + F.lane]);
            LDS_WAIT(); asm volatile("" ::: "memory");
#pragma unroll
            for (int jj = 0; jj < 2; ++jj) { const int j = F.lane + 64 * jj; float a = 0.f;
                if (j <= i) { float dot = 0.f; for (int dd = 0; dd < 64; ++dd) dot += qw[dd] * Kt[j * 65 + dd]; a = dot * exp2f((float)(i - j) * l2g); }
                aw[j] = a; }
            LDS_WAIT(); asm volatile("" ::: "memory");
            float o[2]; const float dq = exp2f((float)(i + 1) * l2g);
#pragma unroll
            for (int ee = 0; ee < 2; ++ee) { const int e = F.lane + 64 * ee; float acc = 0.f;
                for (int j = 0; j <= i; ++j) acc += aw[j] * bf2f(Vt[j * 128 + e]);
                float cr = 0.f; for (int dd = 0; dd < 64; ++dd) cr += qw[dd] * S[dd * 128 + e];
                o[ee] = acc + cr * dq; }
            const float ss = wave_sum(o[0] * o[0] + o[1] * o[1]); const float rstd = 1.0f / sqrtf(ss * (1.f / 128) + NORM_EPS);
#pragma unroll
            for (int ee = 0; ee < 2; ++ee) { const int e = F.lane + 64 * ee; const float rg = bf2f(zr[Z_RG + h * 128 + e]);
                zr[Z_RV + h * 128 + e] = (bf16)f2bf(o[ee] * rstd * gn[h * 128 + e] * rg * sigmoid_f(rg)); }
            LDS_WAIT(); asm volatile("" ::: "memory");
        }
    }
    __syncthreads();
}

__device__ __forceinline__ void fox_naive(const Ctx& F) {
    bf16* Z = (bf16*)(F.ws + WS_Z); const float* CF = (const float*)(F.ws + WS_CF);
    LAS float* sc = (LAS float*)(F.lds + F.wave * 16384);
    const int lane = F.lane;
    int it = 0;
    for (int r0 = 0; r0 < NB * 8 * SEQ; r0 += F.NGW, ++it) {
        const int r = r0 + ((it & 1) ? (F.NGW - 1 - F.gw) : F.gw);
        if (r >= NB * 8 * SEQ) continue;
        const int pos = r & (SEQ - 1), h = (r >> 12) & 7, b = r >> 15;
        const size_t m = (size_t)b * SEQ + pos;
        float qf[64];
        { const bf16* qp = Z + m * ZP + Z_FQ + h * 64;
#pragma unroll
            for (int i = 0; i < 8; ++i) { const v4u w = *(const GAS v4u*)(qp + 8 * i); float t[8]; unpack8(w, t);
#pragma unroll
                for (int j = 0; j < 8; ++j) qf[8 * i + j] = t[j]; } }
        const float* cf = CF + (size_t)(b * 8 + h) * SEQ;
        float mx = -INFINITY;
        for (int kk = lane; kk <= pos; kk += 64) { const bf16* kp = Z + ((size_t)b * SEQ + kk) * ZP + Z_FK + h * 64; float dot = 0.f;
#pragma unroll
            for (int i = 0; i < 8; ++i) { const v4u w = *(const GAS v4u*)(kp + 8 * i); float t[8]; unpack8(w, t);
#pragma unroll
                for (int j = 0; j < 8; ++j) dot += qf[8 * i + j] * t[j]; }
            const float s = dot - cf[kk]; sc[kk] = s; mx = fmaxf(mx, s); }
        mx = wave_max(mx);
        float sum = 0.f;
        for (int kk = lane; kk <= pos; kk += 64) { const float p = exp2f(sc[kk] - mx); sc[kk] = p; sum += p; }
        sum = wave_sum(sum);
        LDS_WAIT(); asm volatile("" ::: "memory");
        const bf16* vp = Z + (size_t)b * SEQ * ZP + Z_FV + h * 64 + lane;
        float o0 = 0.f, o1 = 0.f, o2 = 0.f, o3 = 0.f; int kk = 0;
        for (; kk + 3 <= pos; kk += 4) { o0 += sc[kk] * bf2f(vp[(size_t)kk * ZP]); o1 += sc[kk + 1] * bf2f(vp[(size_t)(kk + 1) * ZP]); o2 += sc[kk + 2] * bf2f(vp[(size_t)(kk + 2) * ZP]); o3 += sc[kk + 3] * bf2f(vp[(size_t)(kk + 3) * ZP]); }
        for (; kk <= pos; ++kk) o0 += sc[kk] * bf2f(vp[(size_t)kk * ZP]);
        Z[m * ZP + Z_FQ + h * 64 + lane] = (bf16)f2bf(((o0 + o1) + (o2 + o3)) / sum);
        LDS_WAIT(); asm volatile("" ::: "memory");
    }
}

__device__ __forceinline__ unsigned f2key(float s) { const unsigned u = __builtin_bit_cast(unsigned, s + 0.0f); return (u & 0x80000000u) ? ~u : (u | 0x80000000u); }
__device__ __forceinline__ void dsa_naive(const Ctx& F) {
    bf16* Z = (bf16*)(F.ws + WS_Z); const float* ZS = (const float*)(F.ws + WS_ZS);
    const unsigned* ISG = (const unsigned*)(F.ws + WS_ISG);
    const bf16* KD = (const bf16*)(F.ws + WS_KD); const bf16* VD = (const bf16*)(F.ws + WS_VD);
    LAS unsigned* kl = (LAS unsigned*)(F.lds + F.wave * 16384);
    LAS float* iqs = (LAS float*)(F.lds + XTRA_OFF + F.wave * 1536);
    const int lane = F.lane;
    int it = 0;
    for (int r0 = 0; r0 < M; r0 += F.NGW, ++it) {
        const int r = r0 + ((it & 1) ? (F.NGW - 1 - F.gw) : F.gw);
        if (r >= M) continue;
        const int pos = r & (SEQ - 1), b = r >> 12; const size_t m = (size_t)r;
        *(LAS f32x4*)(iqs + 4 * lane) = *(const GAS f32x4*)(ZS + m * ZSP + S_IQ + 4 * lane);
        const unsigned sg = ISG[m];
        LDS_WAIT(); asm volatile("" ::: "memory");
        for (int kk = lane; kk <= pos; kk += 64) { const float* ikp = ZS + ((size_t)b * SEQ + kk) * ZSP + S_IK; float ik[32];
#pragma unroll
            for (int i = 0; i < 8; ++i) { const f32x4 t = *(const GAS f32x4*)(ikp + 4 * i); ik[4 * i] = t.x; ik[4 * i + 1] = t.y; ik[4 * i + 2] = t.z; ik[4 * i + 3] = t.w; }
            float s = 0.f;
#pragma unroll 1
            for (int h = 0; h < 8; ++h) { float dot = 0.f;
#pragma unroll
                for (int dd = 0; dd < 32; ++dd) dot += iqs[h * 32 + dd] * ik[dd];
                dot = fmaxf(dot, 0.f); s += ((sg >> h) & 1u) ? -dot : dot; }
            kl[kk] = f2key(s); }
        LDS_WAIT(); asm volatile("" ::: "memory");
        unsigned key[64];
#pragma unroll
        for (int j = 0; j < 64; ++j) { const int kk = j * 64 + lane; key[j] = (kk <= pos) ? kl[kk] : 0u; }
        LDS_WAIT(); asm volatile("" ::: "memory");
        LAS unsigned* idx = kl; LAS float* pl = (LAS float*)(kl + 256); LAS bf16* qs = (LAS bf16*)(kl + 512);
        *(LAS v4u*)(qs + 8 * lane) = *(const GAS v4u*)(Z + m * ZP + Z_DQ + 8 * lane);
        unsigned T = 0u; int need = 0;
        if (pos + 1 > 256) {
            for (int bit = 31; bit >= 0; --bit) { const unsigned Tt = T | (1u << bit); int cnt = 0;
#pragma unroll
                for (int j = 0; j < 64; ++j) cnt += __builtin_popcountll(__ballot(key[j] >= Tt));
                if (cnt >= 256) T = Tt; }
            int ngt = 0;
#pragma unroll
            for (int j = 0; j < 64; ++j) ngt += __builtin_popcountll(__ballot(key[j] > T));
            need = 256 - ngt;
        }
        int nsel = 0, eqb = 0;
#pragma unroll
        for (int j = 0; j < 64; ++j) { const bool gt = key[j] > T, eq = (key[j] == T) && (T != 0u);
            const unsigned long long em = __ballot(eq); const int er = eqb + __builtin_amdgcn_mbcnt_hi((unsigned)(em >> 32), __builtin_amdgcn_mbcnt_lo((unsigned)em, 0u));
            const bool sel = gt || (eq && er < need); eqb += __builtin_popcountll(em);
            const unsigned long long sm = __ballot(sel); const int sp = nsel + __builtin_amdgcn_mbcnt_hi((unsigned)(sm >> 32), __builtin_amdgcn_mbcnt_lo((unsigned)sm, 0u));
            if (sel) idx[sp] = (unsigned)(j * 64 + lane); nsel += __builtin_popcountll(sm); }
        LDS_WAIT(); asm volatile("" ::: "memory");
        for (int h = 0; h < 8; ++h) {
            float sv[4]; float mx = -INFINITY;
#pragma unroll
            for (int i = 0; i < 4; ++i) { const int e = lane + 64 * i; sv[i] = -INFINITY;
                if (e < nsel) { const bf16* kp = KD + ((size_t)b * SEQ + idx[e]) * 64; float dot = 0.f;
#pragma unroll
                    for (int c = 0; c < 8; ++c) { const v4u w = *(const GAS v4u*)(kp + 8 * c); float t[8]; unpack8(w, t); const v4u qw = *(const LAS v4u*)(qs + h * 64 + 8 * c); float qq[8]; unpack8(qw, qq);
#pragma unroll
                        for (int j = 0; j < 8; ++j) dot += qq[j] * t[j]; }
                    sv[i] = dot; }
                mx = fmaxf(mx, sv[i]); }
            mx = wave_max(mx); float sum = 0.f;
#pragma unroll
            for (int i = 0; i < 4; ++i) { const int e = lane + 64 * i; const float p = (e < nsel) ? exp2f(sv[i] - mx) : 0.f; pl[e] = p; sum += p; }
            sum = wave_sum(sum);
            LDS_WAIT(); asm volatile("" ::: "memory");
            float o0 = 0.f, o1 = 0.f; int e = 0;
            for (; e + 1 < nsel; e += 2) { o0 += pl[e] * bf2f(VD[((size_t)b * SEQ + idx[e]) * 64 + lane]); o1 += pl[e + 1] * bf2f(VD[((size_t)b * SEQ + idx[e + 1]) * 64 + lane]); }
            if (e < nsel) o0 += pl[e] * bf2f(VD[((size_t)b * SEQ + idx[e]) * 64 + lane]);
            Z[m * ZP + Z_DQ + h * 64 + lane] = (bf16)f2bf((o0 + o1) / sum);
            LDS_WAIT(); asm volatile("" ::: "memory");
        }
    }
}

struct Args { const float* in[16]; float* out; unsigned char* ws; };
__global__ void __launch_bounds__(NWAVES * 64, 2) hyb_fwd(Args args) {
    extern __shared__ __attribute__((aligned(16))) unsigned char lds[];
    Ctx F;
    F.lds = (LAS unsigned char*)lds;
    F.tid = threadIdx.x; F.lane = F.tid & 63; F.wave = __builtin_amdgcn_readfirstlane(F.tid >> 6);
    F.G = gridDim.x; F.gw = blockIdx.x * NWAVES + F.wave; F.NGW = F.G * NWAVES;
    F.out = args.out; F.ws = args.ws;
    volatile LAS unsigned* MISC = (volatile LAS unsigned*)(F.lds + MISC_OFF);
    for (int u = F.tid; u < (LDS_BYTES - LDSCTL_OFF) / 4; u += NWAVES * 64) ((LAS unsigned*)(F.lds + LDSCTL_OFF))[u] = 0u;
    __syncthreads();
    gu32* ctl = (gu32*)(F.ws + WS_CTL);
    XcdBarrier bar = xcd_barrier_post((unsigned*)(ctl + CW_BAR), MISC + 8);
#define FRESH(P) Ctx P = F; P.tid = threadIdx.x; asm volatile("" : "+v"(P.tid), "+s"(P.wave), "+s"(P.gw), "+s"(P.ws), "+s"(P.out)); P.lane = P.tid & 63
#define GRID_BAR() do { XcdBarrier b_ = bar; asm volatile("" : "+s"(b_.bar)); xcd_barrier(b_); } while (0)

    bf16* Wb = (bf16*)(F.ws + WS_W);
    bf16* Z = (bf16*)(F.ws + WS_Z); float* ZS = (float*)(F.ws + WS_ZS); bf16* HDN = (bf16*)(F.ws + WS_HDN);
    float* M32 = (float*)(F.ws + WS_HDN); bf16* HB = (bf16*)(F.ws + WS_Z);
    LAS unsigned char* ring = F.lds + RING_OFF;

    { FRESH(P); p0_prologue(P, args.in[2], args.in[9], args.in[10], args.in[11], args.in[12], args.in[14], args.in[15]); }
    GRID_BAR();

    #pragma unroll 1
    for (int layer = 0; layer < DEPTH; ++layer) {
        const float* xin = (layer == 0) ? args.in[0] : F.out;
        const bf16* L = Wb + (size_t)layer * LW_STRIDE;
        { FRESH(P); rmsnorm_phase(P, xin, args.in[1] + layer * DM, (bf16*)(P.ws + WS_HDN)); }
        GRID_BAR();
        { pg8::Gemm g{HDN, L + LW_IN, M, NIN, DM, DM, DM}; pg8::StaticOrder S; S.init(M, NIN, F.G, (int)blockIdx.x);
          pg8::EpiZ E{Z, ZS};
          pg8::gemm_phase<pg8::EpiZ, pg8::StaticOrder, true, true>(ring, g, S, E); }
        GRID_BAR();
        { FRESH(P); post_phase(P, args.in[4] + layer * 64, args.in[5] + layer * 64, args.in[6] + layer * 64, args.in[7] + layer * 64, args.in[3] + layer * 8); }
        GRID_BAR();
        { FRESH(P); scan_state_phase(P); }
        GRID_BAR();
        { FRESH(P); ret_out_naive(P, args.in[8] + layer * 512); }
        { FRESH(P); fox_naive(P); }
        { FRESH(P); dsa_naive(P); }
        GRID_BAR();
        { pg8::StaticOrder S; S.init(M, DM, F.G, (int)blockIdx.x);
          { pg8::Gemm g{Z + Z_FQ, L + LW_MIX, M, DM, 512, ZP, 512}; pg8::EpiGate<0> E{Z + Z_ZG, M32, Z + Z_MRG};
            pg8::gemm_phase<pg8::EpiGate<0>, pg8::StaticOrder, false, true>(ring, g, S, E); }
          { pg8::Gemm g{Z + Z_DQ, L + LW_MIX + 512 * 1024, M, DM, 512, ZP, 512}; pg8::EpiGate<1> E{Z + Z_ZG, M32, Z + Z_MRG};
            pg8::gemm_phase<pg8::EpiGate<1>, pg8::StaticOrder, false, true>(ring, g, S, E); }
          { pg8::Gemm g{Z + Z_RV, L + LW_MIX + 1024 * 1024, M, DM, 512, ZP, 512}; pg8::EpiGate<2> E{Z + Z_ZG, M32, Z + Z_MRG};
            pg8::gemm_phase<pg8::EpiGate<2>, pg8::StaticOrder, false, true>(ring, g, S, E); } }
        GRID_BAR();
        { pg8::Gemm g{Z + Z_MRG, L + LW_O, M, DM, DM, ZP, DM}; pg8::StaticOrder S; S.init(M, DM, F.G, (int)blockIdx.x);
          pg8::EpiRes E{xin, F.out};
          pg8::gemm_phase<pg8::EpiRes, pg8::StaticOrder, false, true>(ring, g, S, E); }
        GRID_BAR();
        { FRESH(P); rmsnorm_phase(P, P.out, args.in[13] + layer * DM, (bf16*)(P.ws + WS_HDN)); }
        GRID_BAR();
        { pg8::Gemm g{HDN, L + LW_FI, M, FF2, DM, DM, DM}; pg8::StaticOrder S; S.init(M, FF2, F.G, (int)blockIdx.x);
          pg8::EpiSwi E{HB, FFH};
          pg8::gemm_phase<pg8::EpiSwi, pg8::StaticOrder, true, true>(ring, g, S, E); }
        GRID_BAR();
        { pg8::Gemm g{HB, L + LW_FO, M, DM, FFH, FFH, FFH}; pg8::StaticOrder S; S.init(M, DM, F.G, (int)blockIdx.x);
          pg8::EpiRes E{F.out, F.out};
          pg8::gemm_phase<pg8::EpiRes, pg8::StaticOrder, false, true>(ring, g, S, E); }
        GRID_BAR();
    }
    if (__hip_atomic_load((gu32*)((unsigned*)(ctl + CW_BAR) + XB_TMO), RLX_AGENT) != 0u) {
        const float q = __builtin_nanf("");
        for (int m = F.gw; m < M; m += F.NGW) { GAS f32x4* o = (GAS f32x4*)(F.out + (size_t)m * DM) + (threadIdx.x & 63);
#pragma unroll
            for (int j = 0; j < 4; ++j) o[64 * j] = (f32x4){q, q, q, q}; }
    }
}

extern "C" void kernel_launch(void* const* d_in, const int* in_sizes, int n_in, void* d_out, int out_size, void* d_ws, size_t ws_size, hipStream_t stream) {
    static int grid = 0;
    if (grid == 0) {
        if (n_in != 16 || in_sizes[0] != M * DM || out_size != M * DM || ws_size < WS_END) { fprintf(stderr, "kernel_launch: unexpected shapes / workspace (n_in %d, in0 %d, out %d, ws %zu < %zu)\n", n_in, n_in > 0 ? in_sizes[0] : -1, out_size, ws_size, (size_t)WS_END); grid = -1; return; }
        int dev = 0, cus = 0, per_cu = 0;
        if (hipGetDevice(&dev) != hipSuccess || hipDeviceGetAttribute(&cus, hipDeviceAttributeMultiprocessorCount, dev) != hipSuccess) { grid = -1; return; }
        if (hipFuncSetAttribute((const void*)hyb_fwd, hipFuncAttributeMaxDynamicSharedMemorySize, LDS_BYTES) != hipSuccess) { fprintf(stderr, "kernel_launch: hipFuncSetAttribute failed\n"); grid = -1; return; }
        if (hipOccupancyMaxActiveBlocksPerMultiprocessor(&per_cu, (const void*)hyb_fwd, NWAVES * 64, LDS_BYTES) != hipSuccess || per_cu < 1) { fprintf(stderr, "kernel_launch: occupancy query reports %d blocks per CU\n", per_cu); }
        (void)hipGetLastError();
        grid = cus;
    }
    if (grid < 0) return;
    if (hipMemsetAsync((char*)d_ws + WS_CTL, 0, CTL_ZERO_BYTES, stream) != hipSuccess) return;
    Args a{};
    for (int i = 0; i < 16; ++i) a.in[i] = (const float*)d_in[i];
    a.out = (float*)d_out; a.ws = (unsigned char*)d_ws;
    hipLaunchKernelGGL(hyb_fwd, dim3(grid), dim3(NWAVES * 64), LDS_BYTES, stream, a);
}
```

```cpp
#include <hip/hip_runtime.h>
#include <cstdio>
#include <cstdint>
#include <cmath>
namespace pg8 {
#define PG8_LAS __attribute__((address_space(3)))
typedef unsigned short bf16_t;
typedef short bf16x8 __attribute__((ext_vector_type(8)));
typedef float f32x4 __attribute__((ext_vector_type(4)));
typedef unsigned u32x4 __attribute__((ext_vector_type(4)));
constexpr int BM = 256, BK = 64, HALF = 128, HTB = HALF * BK * 2  , STAGE_BYTES = 8 * HTB, NXCD = 8, WGM = 8;

__host__ __device__ __forceinline__ int lds_byte(int r, int c) { const int st = (r >> 4) * 2 + (c >> 5), rr = r & 15, cc = c & 31, ob = rr * 64 + cc * 2; return st * 1024 + (ob ^ (((ob >> 9) & 1) << 5)); }
__host__ __device__ __forceinline__ void stage_rc(int b, int& R, int& C) { const int st = b / 1024, sb = b % 1024, swz = sb ^ (((sb >> 9) & 1) << 5); R = (st >> 1) * 16 + swz / 64; C = (st & 1) * 32 + (swz % 64) / 2; }
__host__ __device__ __forceinline__ int perm32(int rho) { const int n = rho >> 4, i = rho & 15; return 8 * (i >> 2) + 4 * n + (i & 3); }

struct Unit { int pm, pn; };
struct Gemm { const bf16_t* A; const bf16_t* Bt; int M, N, K, lda, ldb; };

struct StaticOrder {
    int nM, nN, nwg, G, c;
    __host__ __device__ void init(int M, int N, int G_, int c_) { nM = M / BM; nN = N / BM; nwg = nM * nN; G = G_; c = c_; }
    __host__ __device__ bool next(int i, Unit& u) const {
        const long L = (long)i * G + c; if (L >= nwg) return false;
        int wgid = (int)L; { const int q = nwg / NXCD, r = nwg % NXCD, xcd = wgid % NXCD, off = wgid / NXCD; wgid = (xcd < r ? xcd * (q + 1) : r * (q + 1) + (xcd - r) * q) + off; }
        const int nig = WGM * nN, gid = wgid / nig, fm = gid * WGM, gsz = (nM - fm) < WGM ? (nM - fm) : WGM;
        u.pm = fm + ((wgid % nig) % gsz); u.pn = (wgid % nig) / gsz; return true;
    }
    __device__ __forceinline__ void a_ready(const Unit&) const {}
    __device__ __forceinline__ void done(const Unit&) const {}
};

__device__ __forceinline__ unsigned cvt_pk_bf16(float lo, float hi) { unsigned r; asm volatile("v_cvt_pk_bf16_f32 %0, %1, %2" : "=v"(r) : "v"(lo), "v"(hi)); return r; }
__device__ __forceinline__ float bflo(unsigned w) { return __builtin_bit_cast(float, w << 16); }
__device__ __forceinline__ float bfhi(unsigned w) { return __builtin_bit_cast(float, w & 0xffff0000u); }
__device__ __forceinline__ float sigmoidf_(float x) { return __builtin_amdgcn_rcpf(1.0f + __builtin_amdgcn_exp2f(-1.4426950408889634f * x)); }

constexpr int ZP = 6656;
constexpr int ZSP = 512;
constexpr int NZT = 26;

struct EpiZ {
    static constexpr bool PERM = true, AFTER_DRAIN = false;
    bf16_t* Z; float* ZS;
    __device__ __forceinline__ void operator()(const f32x4 (&acc)[2][2][4][2], const Unit& u, int wr, int wc, int fr, int fq) const {
        const int row0 = u.pm * BM + wr * 64 + fr;
        if (u.pn < NZT) {
            const int col0 = u.pn * BM + wc * 32 + 8 * fq;
#pragma unroll
            for (int ai = 0; ai < 2; ++ai)
#pragma unroll
                for (int m = 0; m < 4; ++m) { bf16_t* rowp = Z + (size_t)(row0 + ai * HALF + m * 16) * ZP + col0;
#pragma unroll
                    for (int bj = 0; bj < 2; ++bj) { const f32x4 v0 = acc[ai][bj][m][0], v1 = acc[ai][bj][m][1];
                        u32x4 w; w.x = cvt_pk_bf16(v0[0], v0[1]); w.y = cvt_pk_bf16(v0[2], v0[3]); w.z = cvt_pk_bf16(v1[0], v1[1]); w.w = cvt_pk_bf16(v1[2], v1[3]);
                        *(u32x4*)(rowp + bj * HALF) = w; } }
        } else {
            const int col0 = (u.pn - NZT) * BM + wc * 32 + 8 * fq;
#pragma unroll
            for (int ai = 0; ai < 2; ++ai)
#pragma unroll
                for (int m = 0; m < 4; ++m) { float* rowp = ZS + (size_t)(row0 + ai * HALF + m * 16) * ZSP + col0;
#pragma unroll
                    for (int bj = 0; bj < 2; ++bj) { *(f32x4*)(rowp + bj * HALF) = acc[ai][bj][m][0]; *(f32x4*)(rowp + bj * HALF + 4) = acc[ai][bj][m][1]; } }
        }
    }
};

template <int P> struct EpiGate {
    static constexpr bool PERM = true, AFTER_DRAIN = false;
    const bf16_t* G;
    float* M32;
    bf16_t* OUT;
    __device__ __forceinline__ void operator()(const f32x4 (&acc)[2][2][4][2], const Unit& u, int wr, int wc, int fr, int fq) const {
        const int row0 = u.pm * BM + wr * 64 + fr, col0 = u.pn * BM + wc * 32 + 8 * fq;
#pragma unroll
        for (int ai = 0; ai < 2; ++ai)
#pragma unroll
            for (int m = 0; m < 4; ++m) { const size_t row = (size_t)(row0 + ai * HALF + m * 16);
#pragma unroll
                for (int bj = 0; bj < 2; ++bj) { const int col = col0 + bj * HALF;
                    const u32x4 gw = *(const u32x4*)(G + row * ZP + P * 1024 + col);
                    const f32x4 v0 = acc[ai][bj][m][0], v1 = acc[ai][bj][m][1];
                    f32x4 t0, t1;
                    t0[0] = sigmoidf_(bflo(gw.x)) * v0[0]; t0[1] = sigmoidf_(bfhi(gw.x)) * v0[1]; t0[2] = sigmoidf_(bflo(gw.y)) * v0[2]; t0[3] = sigmoidf_(bfhi(gw.y)) * v0[3];
                    t1[0] = sigmoidf_(bflo(gw.z)) * v1[0]; t1[1] = sigmoidf_(bfhi(gw.z)) * v1[1]; t1[2] = sigmoidf_(bflo(gw.w)) * v1[2]; t1[3] = sigmoidf_(bfhi(gw.w)) * v1[3];
                    float* mp = M32 + row * 1024 + col;
                    if (P == 0) { *(f32x4*)mp = t0; *(f32x4*)(mp + 4) = t1; }
                    else if (P == 1) { *(f32x4*)mp = *(const f32x4*)mp + t0; *(f32x4*)(mp + 4) = *(const f32x4*)(mp + 4) + t1; }
                    else { t0 = *(const f32x4*)mp + t0; t1 = *(const f32x4*)(mp + 4) + t1;
                        u32x4 w; w.x = cvt_pk_bf16(t0[0], t0[1]); w.y = cvt_pk_bf16(t0[2], t0[3]); w.z = cvt_pk_bf16(t1[0], t1[1]); w.w = cvt_pk_bf16(t1[2], t1[3]);
                        *(u32x4*)(OUT + row * ZP + col) = w; } } }
    }
};

struct EpiRes {
    static constexpr bool PERM = true, AFTER_DRAIN = false;
    const float* RES; float* OUT;
    __device__ __forceinline__ void operator()(const f32x4 (&acc)[2][2][4][2], const Unit& u, int wr, int wc, int fr, int fq) const {
        const int row0 = u.pm * BM + wr * 64 + fr, col0 = u.pn * BM + wc * 32 + 8 * fq;
#pragma unroll
        for (int ai = 0; ai < 2; ++ai)
#pragma unroll
            for (int m = 0; m < 4; ++m) { const size_t off = (size_t)(row0 + ai * HALF + m * 16) * 1024 + col0;
#pragma unroll
                for (int bj = 0; bj < 2; ++bj) { const float* rp = RES + off + bj * HALF; float* op = OUT + off + bj * HALF;
                    const f32x4 r0 = *(const f32x4*)rp, r1 = *(const f32x4*)(rp + 4);
                    *(f32x4*)op = r0 + acc[ai][bj][m][0]; *(f32x4*)(op + 4) = r1 + acc[ai][bj][m][1]; } }
    }
};

struct EpiSwi {
    static constexpr bool PERM = true, AFTER_DRAIN = false;
    bf16_t* H; int ldh;
    __device__ __forceinline__ void operator()(const f32x4 (&acc)[2][2][4][2], const Unit& u, int wr, int wc, int fr, int fq) const {
        const int row0 = u.pm * BM + wr * 64 + fr, col0 = u.pn * HALF + wc * 32 + 8 * fq;
#pragma unroll
        for (int ai = 0; ai < 2; ++ai)
#pragma unroll
            for (int m = 0; m < 4; ++m) { bf16_t* hp = H + (size_t)(row0 + ai * HALF + m * 16) * ldh + col0;
                float o[8];
#pragma unroll
                for (int n = 0; n < 2; ++n)
#pragma unroll
                    for (int i = 0; i < 4; ++i) { const float g = acc[ai][0][m][n][i], up = acc[ai][1][m][n][i]; o[4 * n + i] = g * sigmoidf_(g) * up; }
                u32x4 w; w.x = cvt_pk_bf16(o[0], o[1]); w.y = cvt_pk_bf16(o[2], o[3]); w.z = cvt_pk_bf16(o[4], o[5]); w.w = cvt_pk_bf16(o[6], o[7]);
                *(u32x4*)hp = w; }
    }
};

template <class Epi, class Sched, bool ALIGN_EPI = false, bool SP2 = false>
__device__ __forceinline__ void gemm_phase(PG8_LAS unsigned char* lds, Gemm g, const Sched& S0, const Epi& E) {
    int ovz, osz; asm volatile("v_mov_b32 %0, 0\n\ts_mov_b32 %1, 0" : "=v"(ovz), "=s"(osz));
    Sched S = S0; S.c += osz; g.lda += osz; g.ldb += osz;
    const int tid = threadIdx.x + ovz, wid = __builtin_amdgcn_readfirstlane(tid >> 6), lane = tid & 63, wr = wid >> 2, wc = wid & 3, fr = lane & 15, fq = lane >> 4;
    const int K = g.K, nt = K / BK;
    unsigned voffA[2], voffB[2];
#pragma unroll
    for (int i = 0; i < 2; ++i) { int R, C; stage_rc(tid * 16 + i * 8192, R, C); const int Rb = Epi::PERM ? ((R & ~31) + perm32(R & 31)) : R;
        voffA[i] = (unsigned)(R * g.lda + C) * 2u; voffB[i] = (unsigned)(Rb * g.ldb + C) * 2u; }
    const size_t kstep = (size_t)(BK * 2);
    const size_t hstepA = (size_t)HALF * g.lda * 2, hstepB = (size_t)HALF * g.ldb * 2;
    const size_t tstepA = 2 * hstepA, tstepB = 2 * hstepB;
    const unsigned ldsw = (unsigned)wid * 1024u;
    const int aoff = lds_byte(wr * 64 + fr, fq * 8), boff = lds_byte(wc * 32 + fr, fq * 8);
#define PG8_SA(b, h) (((b) * 2 + (h)) * HTB)
#define PG8_SB(b, h) ((4 + (b) * 2 + (h)) * HTB)
#define PG8_STAGE(bufoff, gbase, voff) do { _Pragma("unroll") for (int _i = 0; _i < 2; ++_i) \
        __builtin_amdgcn_global_load_lds((const unsigned*)((const char*)(gbase) + (voff)[_i]), (PG8_LAS unsigned*)(lds + (bufoff) + ldsw + _i * 8192), 16, 0, 0); } while (0)
#define PG8_LDA(dst, b, h) do { _Pragma("unroll") for (int m = 0; m < 4; ++m) _Pragma("unroll") for (int k = 0; k < 2; ++k) dst[m][k] = *(const PG8_LAS bf16x8*)(lds + PG8_SA(b, h) + aoff + m * 2048 + k * 1024); } while (0)
#define PG8_LDB(dst, b, h) do { _Pragma("unroll") for (int n = 0; n < 2; ++n) _Pragma("unroll") for (int k = 0; k < 2; ++k) dst[n][k] = *(const PG8_LAS bf16x8*)(lds + PG8_SB(b, h) + boff + n * 2048 + k * 1024); } while (0)
#define PG8_MMA(ai, bj, At, Bt) do { __builtin_amdgcn_s_setprio(1); _Pragma("unroll") for (int m = 0; m < 4; ++m) _Pragma("unroll") for (int n = 0; n < 2; ++n) _Pragma("unroll") for (int k = 0; k < 2; ++k) \
        acc[ai][bj][m][n] = __builtin_amdgcn_mfma_f32_16x16x32_bf16(Bt[n][k], At[m][k], acc[ai][bj][m][n], 0, 0, 0); __builtin_amdgcn_s_setprio(0); } while (0)
#define PG8_WAIT_V(n) asm volatile("s_waitcnt vmcnt(" #n ")" ::: "memory")
#define PG8_WAIT_L(n) asm volatile("s_waitcnt lgkmcnt(" #n ")" ::: "memory")
#define PG8_BAR __builtin_amdgcn_s_barrier()
#define PG8_SCHED __builtin_amdgcn_sched_barrier(0)
    Unit cur, nxt; int ui = 0;
    if (!S.next(0, cur)) return;
    f32x4 acc[2][2][4][2];
#pragma unroll
    for (int a = 0; a < 2; ++a)
#pragma unroll
        for (int b = 0; b < 2; ++b)
#pragma unroll
            for (int m = 0; m < 4; ++m)
#pragma unroll
                for (int n = 0; n < 2; ++n) acc[a][b][m][n] = (f32x4){0.f, 0.f, 0.f, 0.f};
    bf16x8 At[4][2], B0[2][2], B1[2][2];
    const char* cA = (const char*)g.A + (size_t)cur.pm * tstepA; const char* cB = (const char*)g.Bt + (size_t)cur.pn * tstepB;
    S.a_ready(cur);
    if constexpr (SP2) {
        PG8_STAGE(PG8_SB(0, 0), cB, voffB); PG8_STAGE(PG8_SB(0, 1), cB + hstepB, voffB); PG8_STAGE(PG8_SA(0, 0), cA, voffA); PG8_STAGE(PG8_SA(0, 1), cA + hstepA, voffA);
        if (wr == 1) PG8_BAR;
        PG8_WAIT_V(2); PG8_BAR;
        PG8_STAGE(PG8_SB(1, 0), cB + kstep, voffB); PG8_STAGE(PG8_SA(1, 0), cA + kstep, voffA); PG8_STAGE(PG8_SB(1, 1), cB + hstepB + kstep, voffB);
        PG8_WAIT_V(6); PG8_BAR;
    } else {
        PG8_STAGE(PG8_SB(0, 0), cB, voffB); PG8_STAGE(PG8_SA(0, 0), cA, voffA); PG8_STAGE(PG8_SB(0, 1), cB + hstepB, voffB); PG8_STAGE(PG8_SA(0, 1), cA + hstepA, voffA);
        if (wr == 1) PG8_BAR;
        PG8_WAIT_V(4); PG8_BAR;
        PG8_STAGE(PG8_SB(1, 0), cB + kstep, voffB); PG8_STAGE(PG8_SA(1, 0), cA + kstep, voffA); PG8_STAGE(PG8_SB(1, 1), cB + hstepB + kstep, voffB);
        PG8_WAIT_V(6); PG8_BAR;
    }
    for (;;) {
        const bool has_next = S.next(ui + 1, nxt);
        const char* nA = has_next ? (const char*)g.A + (size_t)nxt.pm * tstepA : cA; const char* nB = has_next ? (const char*)g.Bt + (size_t)nxt.pn * tstepB : cB;
        for (int t = 0; t < nt; t += 2) {
            const bool last = (t == nt - 2);
            const char* a1 = cA + (size_t)(t + 1) * kstep;
            const char* a2 = last ? nA : cA + (size_t)(t + 2) * kstep; const char* b2 = last ? nB : cB + (size_t)(t + 2) * kstep;
            const char* a3 = a2 + kstep; const char* b3 = b2 + kstep;
            if (last && has_next) S.a_ready(nxt);
            if constexpr (SP2) {
            PG8_LDB(B0, 0, 0); PG8_LDB(B1, 0, 1); PG8_SCHED; PG8_LDA(At, 0, 0); PG8_STAGE(PG8_SA(1, 1), a1 + hstepA, voffA);
            PG8_WAIT_V(8); PG8_WAIT_L(0); PG8_BAR; PG8_MMA(0, 0, At, B0); PG8_MMA(0, 1, At, B1); PG8_BAR; PG8_SCHED;
            PG8_LDA(At, 0, 1); PG8_STAGE(PG8_SB(0, 0), b2, voffB); PG8_STAGE(PG8_SB(0, 1), b2 + hstepB, voffB); PG8_STAGE(PG8_SA(0, 0), a2, voffA);
            PG8_WAIT_V(8); PG8_WAIT_L(0); PG8_BAR; PG8_MMA(1, 0, At, B0); PG8_MMA(1, 1, At, B1); PG8_BAR; PG8_SCHED;
            PG8_LDB(B0, 1, 0); PG8_LDB(B1, 1, 1); PG8_SCHED; PG8_LDA(At, 1, 0); PG8_STAGE(PG8_SA(0, 1), a2 + hstepA, voffA);
            PG8_WAIT_V(8); PG8_WAIT_L(0); PG8_BAR; PG8_MMA(0, 0, At, B0); PG8_MMA(0, 1, At, B1); PG8_BAR; PG8_SCHED;
            PG8_LDA(At, 1, 1); PG8_STAGE(PG8_SB(1, 0), b3, voffB); PG8_STAGE(PG8_SB(1, 1), b3 + hstepB, voffB); PG8_STAGE(PG8_SA(1, 0), a3, voffA);
            PG8_WAIT_V(8); PG8_WAIT_L(0); PG8_BAR; PG8_MMA(1, 0, At, B0); PG8_MMA(1, 1, At, B1); PG8_BAR; PG8_SCHED;
            } else {
            PG8_LDB(B0, 0, 0); PG8_SCHED; PG8_LDA(At, 0, 0); PG8_STAGE(PG8_SA(1, 1), a1 + hstepA, voffA);
            PG8_WAIT_L(8); PG8_BAR; PG8_WAIT_L(0); PG8_MMA(0, 0, At, B0); PG8_BAR; PG8_SCHED;
            PG8_LDB(B1, 0, 1); PG8_STAGE(PG8_SB(0, 0), b2, voffB);
            PG8_BAR; PG8_WAIT_L(0); PG8_MMA(0, 1, At, B1); PG8_BAR;
            PG8_LDA(At, 0, 1); PG8_STAGE(PG8_SA(0, 0), a2, voffA);
            PG8_BAR; PG8_WAIT_L(0); PG8_MMA(1, 0, At, B0); PG8_BAR; PG8_SCHED;
            PG8_STAGE(PG8_SB(0, 1), b2 + hstepB, voffB);
            PG8_WAIT_V(6); PG8_BAR; PG8_MMA(1, 1, At, B1); PG8_BAR;
            PG8_LDB(B0, 1, 0); PG8_SCHED; PG8_LDA(At, 1, 0); PG8_STAGE(PG8_SA(0, 1), a2 + hstepA, voffA);
            PG8_WAIT_L(8); PG8_BAR; PG8_WAIT_L(0); PG8_MMA(0, 0, At, B0); PG8_BAR; PG8_SCHED;
            PG8_LDB(B1, 1, 1); PG8_STAGE(PG8_SB(1, 0), b3, voffB);
            PG8_BAR; PG8_WAIT_L(0); PG8_MMA(0, 1, At, B1); PG8_BAR;
            PG8_LDA(At, 1, 1); PG8_STAGE(PG8_SA(1, 0), a3, voffA);
            PG8_BAR; PG8_WAIT_L(0); PG8_MMA(1, 0, At, B0); PG8_BAR; PG8_SCHED;
            PG8_STAGE(PG8_SB(1, 1), b3 + hstepB, voffB);
            PG8_WAIT_V(6); PG8_BAR; PG8_MMA(1, 1, At, B1); PG8_BAR;
            }
        }
        if constexpr (ALIGN_EPI) { if (wr == 0) PG8_BAR; }
        if constexpr (!Epi::AFTER_DRAIN) { E(acc, cur, wr, wc, fr, fq); S.done(cur); }
        if (!has_next) break;
#pragma unroll
        for (int a = 0; a < 2; ++a)
#pragma unroll
            for (int b = 0; b < 2; ++b)
#pragma unroll
                for (int m = 0; m < 4; ++m)
#pragma unroll
                    for (int n = 0; n < 2; ++n) acc[a][b][m][n] = (f32x4){0.f, 0.f, 0.f, 0.f};
        cur = nxt; cA = nA; cB = nB; ++ui;
        if constexpr (ALIGN_EPI) { if (wr == 1) PG8_BAR; }
    }
    PG8_WAIT_V(0);
    if constexpr (!ALIGN_EPI) { if (wr == 0) PG8_BAR; }
    PG8_BAR;
    if constexpr (Epi::AFTER_DRAIN) { E.fused(acc, cur, wr, wc, fr, fq, lds, wid, lane); S.done(cur); }
#undef PG8_SA
#undef PG8_SB
#undef PG8_STAGE
#undef PG8_LDA
#undef PG8_LDB
#undef PG8_MMA
#undef PG8_WAIT_V
#undef PG8_WAIT_L
#undef PG8_BAR
#undef PG8_SCHED
}
}

constexpr int NB = 4, SEQ = 4096, DM = 1024, DEPTH = 4, M = NB * SEQ;
constexpr int INC = 7088;
constexpr int NIN = 7168;
constexpr int FFH = 2816, FF2 = 5632;
constexpr int ZP = pg8::ZP, ZSP = pg8::ZSP;
constexpr int Z_FQ = 0, Z_FK = 512, Z_FV = 1024, Z_DQ = 1536, Z_RV = 2048, Z_RQ = 2560, Z_RK = 2816, Z_RG = 3072, Z_ZG = 3584, Z_MRG = 2560;
constexpr int S_IQ = 0, S_DK = 256, S_DV = 320, S_IK = 384, S_IW = 416, S_FF = 424;
constexpr float NORM_EPS = 1e-6f;
constexpr float LOG2E = 1.4426950408889634f;
constexpr float C2 = 0.125f * 1.4426950408889634f;

constexpr size_t MiB = 1u << 20;
constexpr size_t WS_CTL = 0, CTL_ZERO_BYTES = 1 * MiB;
constexpr size_t WS_ROPE64 = 1 * MiB;
constexpr size_t WS_ROPE32 = 2 * MiB;
constexpr size_t WS_LF = 2 * MiB + 512 * 1024;
constexpr size_t WS_CF = 3 * MiB;
constexpr size_t WS_ISG = 3 * MiB + 512 * 1024;
constexpr size_t WS_KD = 4 * MiB;
constexpr size_t WS_VD = 6 * MiB;
constexpr size_t WS_W = 8 * MiB;
constexpr size_t LW_IN = 0, LW_MIX = (size_t)NIN * 1024, LW_O = LW_MIX + 1536 * 1024, LW_FI = LW_O + 1024 * 1024, LW_FO = LW_FI + (size_t)FF2 * 1024, LW_STRIDE = LW_FO + (size_t)FFH * 1024;
constexpr size_t WS_Z = 150 * MiB;
constexpr size_t WS_HDN = 358 * MiB;
constexpr size_t WS_ZS = 390 * MiB;
constexpr size_t WS_END = 422 * MiB;
static_assert(WS_W + DEPTH * LW_STRIDE * 2 <= WS_Z && WS_Z + (size_t)M * ZP * 2 <= WS_HDN && WS_HDN + (size_t)M * 1024 * 2 == WS_ZS && WS_ZS + (size_t)M * ZSP * 4 == WS_END, "d_ws map");
constexpr int CW_BAR = 4096;

constexpr int RING_OFF = 0, RING_BYTES = 131072;
constexpr int LDSCTL_OFF = RING_BYTES, MISC_OFF = LDSCTL_OFF + 320;
constexpr int XTRA_OFF = RING_BYTES + 1024;
constexpr int LDS_BYTES = 147456;
constexpr int NWAVES = 8;
#define GAS __attribute__((address_space(1)))
#define LAS __attribute__((address_space(3)))
typedef unsigned short bf16;
typedef unsigned v4u __attribute__((ext_vector_type(4)));
typedef float f32x4 __attribute__((ext_vector_type(4)));
typedef short bf16x8 __attribute__((ext_vector_type(8)));
typedef GAS unsigned gu32;
typedef GAS unsigned long long gu64;
#define RLX_AGENT __ATOMIC_RELAXED, __HIP_MEMORY_SCOPE_AGENT
#define LDS_WAIT() asm volatile("s_waitcnt lgkmcnt(0)" ::: "memory")
#define VM_WAIT() asm volatile("s_waitcnt vmcnt(0)" ::: "memory")
__device__ __forceinline__ unsigned long long rt() { return __builtin_amdgcn_s_memrealtime(); }
__device__ __forceinline__ unsigned f2bf(float f) { unsigned u = __builtin_bit_cast(unsigned, f); return (u + 0x7fffu + ((u >> 16) & 1u)) >> 16; }
__device__ __forceinline__ unsigned pk2(float lo, float hi) { return f2bf(lo) | (f2bf(hi) << 16); }

#define XB_TMO      128
#define XB_XCNT(j)  (256  + 64 * (j))
#define XB_XSUB(j)  (1280 + 64 * (j))
#define XB_XGEN(j)  (2304 + 64 * (j))
#define XB_TOP      3328
#define XB_TOPGEN   3392
#define XCD_BAR_WORDS 3456
#define XB_SPIN_CAP (1u << 22)

__device__ __forceinline__ unsigned xb_ld(unsigned* p)              { return __hip_atomic_load(p, __ATOMIC_RELAXED, __HIP_MEMORY_SCOPE_AGENT); }
__device__ __forceinline__ unsigned xb_add(unsigned* p, unsigned v) { return __hip_atomic_fetch_add(p, v, __ATOMIC_RELAXED, __HIP_MEMORY_SCOPE_AGENT); }
__device__ __forceinline__ unsigned xb_xcc_id() { return (unsigned)__builtin_amdgcn_s_getreg((3 << 11) | 20) & 0xFu; }
#define XB_SPIN(cond, bar) do { unsigned _sp = 0; while (cond) { __builtin_amdgcn_s_sleep(1); \
    if ((++_sp & 255u) == 0u) { if (xb_ld(&(bar)[XB_TMO])) break; if (_sp > XB_SPIN_CAP) { atomicAdd(&(bar)[XB_TMO], 1u); break; } } } } while (0)

struct XcdBarrier {
    unsigned* bar; unsigned x;
    volatile LAS unsigned* st;
};

__device__ __forceinline__ XcdBarrier xcd_barrier_post(unsigned* bar, volatile LAS unsigned* st) {
    XcdBarrier b; b.bar = bar; b.x = xb_xcc_id(); b.st = st;
    if (threadIdx.x == 0) (void)xb_add(&bar[XB_XCNT(b.x)], 1u);
    return b;
}
__device__ __forceinline__ void xcd_barrier_complete(unsigned* bar, unsigned x, unsigned& nloc, unsigned& nx) {
    const unsigned G = gridDim.x * gridDim.y * gridDim.z;
    unsigned sum, cnt, mine, sp = 0u;
    for (;;) {
        sum = 0u; cnt = 0u; mine = 0u;
#pragma unroll
        for (unsigned j = 0; j < 16; ++j) { const unsigned c = xb_ld(&bar[XB_XCNT(j)]); sum += c; cnt += (c > 0u) ? 1u : 0u; mine = (j == x) ? c : mine; }
        if (sum == G) break;
        __builtin_amdgcn_s_sleep(1);
        if ((++sp & 255u) == 0u) { if (xb_ld(&bar[XB_TMO])) break; if (sp > XB_SPIN_CAP) { atomicAdd(&bar[XB_TMO], 1u); break; } }
    }
    nloc = mine > 0u ? mine : 1u; nx = cnt > 0u ? cnt : 1u;
}

__device__ __forceinline__ void xcd_barrier(const XcdBarrier& b) {
    asm volatile("s_waitcnt vmcnt(0)" ::: "memory");
    __syncthreads();
    if (threadIdx.x == 0) {
        unsigned* bar = b.bar;
        __builtin_amdgcn_s_waitcnt(0);
        unsigned nloc = b.st[0], nx = b.st[1];
        if (nloc == 0u) { xcd_barrier_complete(bar, b.x, nloc, nx); b.st[0] = nloc; b.st[1] = nx; }
        const unsigned old = xb_add(&bar[XB_XSUB(b.x)], 1u);
        const unsigned gen = old / nloc;
        if (old + 1u == (gen + 1u) * nloc) {
            __builtin_amdgcn_fence(__ATOMIC_RELEASE, "agent");
            asm volatile("s_waitcnt vmcnt(0)" ::: "memory");
            const unsigned og = xb_add(&bar[XB_TOP], 1u);
            const unsigned tg = og / nx;
            if (og + 1u == (tg + 1u) * nx) xb_add(&bar[XB_TOPGEN], 1u);
            else XB_SPIN(xb_ld(&bar[XB_TOPGEN]) == tg, bar);
            __builtin_amdgcn_fence(__ATOMIC_ACQUIRE, "agent");
            xb_add(&bar[XB_XGEN(b.x)], 1u);
            asm volatile("s_waitcnt vmcnt(0)" ::: "memory");
        } else {
            XB_SPIN(xb_ld(&bar[XB_XGEN(b.x)]) == gen, bar);
            __builtin_amdgcn_fence(__ATOMIC_ACQUIRE, "agent");
            asm volatile("s_waitcnt vmcnt(0)" ::: "memory");
        }
    }
    __syncthreads();
}

typedef float f32x2 __attribute__((ext_vector_type(2)));
typedef unsigned u32x2 __attribute__((ext_vector_type(2)));
__device__ __forceinline__ float bflo(unsigned w) { return __builtin_bit_cast(float, w << 16); }
__device__ __forceinline__ float bfhi(unsigned w) { return __builtin_bit_cast(float, w & 0xffff0000u); }
__device__ __forceinline__ float bf2f(bf16 v) { return __builtin_bit_cast(float, (unsigned)v << 16); }
__device__ __forceinline__ void unpack8(const v4u w, float (&f)[8]) { f[0] = bflo(w.x); f[1] = bfhi(w.x); f[2] = bflo(w.y); f[3] = bfhi(w.y); f[4] = bflo(w.z); f[5] = bfhi(w.z); f[6] = bflo(w.w); f[7] = bfhi(w.w); }
__device__ __forceinline__ v4u pack8(const float (&f)[8]) { v4u w; w.x = pk2(f[0], f[1]); w.y = pk2(f[2], f[3]); w.z = pk2(f[4], f[5]); w.w = pk2(f[6], f[7]); return w; }
__device__ __forceinline__ float wave_sum(float v) {
#pragma unroll
    for (int o = 1; o < 64; o <<= 1) v += __shfl_xor(v, o);
    return v;
}
__device__ __forceinline__ float wave_max(float v) {
#pragma unroll
    for (int o = 1; o < 64; o <<= 1) v = fmaxf(v, __shfl_xor(v, o));
    return v;
}
__device__ __forceinline__ float sigmoid_f(float x) { return 1.0f / (1.0f + __expf(-x)); }

struct Ctx {
    LAS unsigned char* lds;
    int tid, lane, wave, G, gw, NGW;
    float* out; unsigned char* ws;
};

__device__ __forceinline__ void conv_item(const float* W, int N, int sc, int nv, int k0, bf16* WT, int ldw, int dr, LAS float* scr, int lane) {
    const int n_ = lane & 31;
#pragma unroll 8
    for (int i = 0; i < 32; ++i) { const int kk = 2 * i + (lane >> 5); scr[kk * 33 + n_] = (n_ < nv) ? W[(size_t)(k0 + kk) * N + sc + n_] : 0.f; }
    LDS_WAIT(); asm volatile("" ::: "memory");
    const int c = lane & 7;
#pragma unroll
    for (int j = 0; j < 4; ++j) { const int n = (lane >> 3) + 8 * j; const LAS float* s = scr + (8 * c) * 33 + n;
        v4u o; o.x = pk2(s[0 * 33], s[1 * 33]); o.y = pk2(s[2 * 33], s[3 * 33]); o.z = pk2(s[4 * 33], s[5 * 33]); o.w = pk2(s[6 * 33], s[7 * 33]);
        if (n < nv) *(GAS v4u*)(WT + (size_t)(dr + n) * ldw + k0 + 8 * c) = o; }
    LDS_WAIT(); asm volatile("" ::: "memory");
}
__device__ const int SEG_IN[15][3] = {
    {0, 0, 512}, {512, 512, 512}, {1024, 1024, 512}, {1536, 6656 + S_FF, 8}, {1544, Z_DQ, 512}, {2056, 6656 + S_DK, 64}, {2120, 6656 + S_DV, 64},
    {2184, 6656 + S_IQ, 256}, {2440, 6656 + S_IK, 32}, {2472, 6656 + S_IW, 8}, {2480, Z_RQ, 256}, {2736, Z_RK, 256}, {2992, Z_RV, 512}, {3504, Z_RG, 512}, {4016, Z_ZG, 3072}};
constexpr int IN_BLK = 223;
constexpr int IT_IN = 16 * IN_BLK, IT_MIX = 8 * 32, IT_O = 16 * 32, IT_FI = 16 * (FF2 / 32), IT_FO = (FFH / 64) * 32;
constexpr int IT_LAYER = IT_IN + 3 * IT_MIX + IT_O + IT_FI + IT_FO;

__device__ __forceinline__ void sincos_acc(float ang, float& c, float& s) {
    const double a = (double)ang;
    const double k = __builtin_rint(a * 0.6366197723675814);
    double y = a - k * 1.5707963267948966; y -= k * 6.123233995736766e-17;
    const double y2 = y * y;
    double sp = -7.647163731819816e-13; sp = sp * y2 + 1.6059043836821613e-10; sp = sp * y2 - 2.505210838544172e-08; sp = sp * y2 + 2.7557319223985893e-06; sp = sp * y2 - 1.984126984126984e-04; sp = sp * y2 + 8.333333333333333e-03; sp = sp * y2 - 1.6666666666666666e-01;
    const double sn = y + y * y2 * sp;
    double cp = 4.779477332387385e-14; cp = cp * y2 - 1.1470745597729725e-11; cp = cp * y2 + 2.08767569878681e-09; cp = cp * y2 - 2.755731922398589e-07; cp = cp * y2 + 2.48015873015873e-05; cp = cp * y2 - 1.388888888888889e-03; cp = cp * y2 + 4.1666666666666664e-02; cp = cp * y2 - 0.5;
    const double cs = 1.0 + y2 * cp;
    const int q = ((int)k) & 3;
    const double ss = (q & 1) ? cs : sn, cc = (q & 1) ? sn : cs;
    s = (float)((q & 2) ? -ss : ss);
    c = (float)(((q + 1) & 2) ? -cc : cc);
}

__device__ __forceinline__ void p0_prologue(const Ctx& F, const float* w_in, const float* w_fox, const float* w_dsa, const float* w_ret, const float* w_o, const float* w_fi, const float* w_fo) {
    LAS float* scr = (LAS float*)(F.lds + RING_OFF + F.wave * 16384);
    bf16* Wb = (bf16*)(F.ws + WS_W);
    for (int it = F.gw; it < DEPTH * IT_LAYER; it += F.NGW) {
        const int l = it / IT_LAYER; int r = it % IT_LAYER;
        bf16* L = Wb + (size_t)l * LW_STRIDE;
        if (r < IT_IN) {
            const int kb = r / IN_BLK; int blk = r % IN_BLK; int sc = 0, dr = 0, nv = 0;
            for (int s = 0; s < 15; ++s) { const int w = SEG_IN[s][2], nb = (w + 31) >> 5; if (blk < nb) { sc = SEG_IN[s][0] + 32 * blk; dr = SEG_IN[s][1] + 32 * blk; nv = (w - 32 * blk) < 32 ? (w - 32 * blk) : 32; break; } blk -= nb; }
            conv_item(w_in + (size_t)l * DM * INC, INC, sc, nv, 64 * kb, L + LW_IN, 1024, dr, scr, F.lane); continue; }
        r -= IT_IN;
        if (r < 3 * IT_MIX) { const int w = r / IT_MIX, q = r % IT_MIX, kb = q / 32, nb = q % 32;
            conv_item((w == 0 ? w_fox : w == 1 ? w_dsa : w_ret) + (size_t)l * 512 * DM, DM, 32 * nb, 32, 64 * kb, L + LW_MIX + (size_t)w * 512 * 1024, 512, 32 * nb, scr, F.lane); continue; }
        r -= 3 * IT_MIX;
        if (r < IT_O) { const int kb = r / 32, nb = r % 32;
            conv_item(w_o + (size_t)l * DM * DM, DM, 32 * nb, 32, 64 * kb, L + LW_O, 1024, 32 * nb, scr, F.lane); continue; }
        r -= IT_O;
        if (r < IT_FI) { const int kb = r / (FF2 / 32), nb = r % (FF2 / 32); const int n0 = 32 * nb;
            const int j = n0 < FFH ? n0 : n0 - FFH; const int dr = 256 * (j >> 7) + (j & 127) + (n0 < FFH ? 0 : 128);
            conv_item(w_fi + (size_t)l * DM * FF2, FF2, n0, 32, 64 * kb, L + LW_FI, 1024, dr, scr, F.lane); continue; }
        r -= IT_FI;
        { const int kb = r / 32, nb = r % 32;
            conv_item(w_fo + (size_t)l * FFH * DM, DM, 32 * nb, 32, 64 * kb, L + LW_FO, FFH, 32 * nb, scr, F.lane); }
    }
    for (int i = F.gw * 64 + F.lane; i < DEPTH * 80 * 128; i += F.NGW * 64) { const int l = i / (80 * 128), q = i % (80 * 128);
        *(GAS v4u*)(Wb + (size_t)l * LW_STRIDE + LW_IN + (size_t)INC * 1024 + (size_t)q * 8) = (v4u){0u, 0u, 0u, 0u}; }
    f32x2* R64 = (f32x2*)(F.ws + WS_ROPE64); f32x2* R32 = (f32x2*)(F.ws + WS_ROPE32);
    for (int i = F.gw * 64 + F.lane; i < SEQ * 32; i += F.NGW * 64) { const int pos = i >> 5, k = i & 31;
        double f = 1.0; for (int e = 0; e < k; ++e) f *= 0.7498942093324559;
        const float ang = (float)pos * (float)f; float c, s; sincos_acc(ang, c, s); R64[i] = (f32x2){c, s}; }
    for (int i = F.gw * 64 + F.lane; i < SEQ * 16; i += F.NGW * 64) { const int pos = i >> 4, k = i & 15;
        double f = 1.0; for (int e = 0; e < k; ++e) f *= 0.5623413251903491;
        const float ang = (float)pos * (float)f; float c, s; sincos_acc(ang, c, s); R32[i] = (f32x2){c, s}; }
}

__device__ __forceinline__ void rmsnorm_phase(const Ctx& F, const float* x, const float* g, bf16* o) {
    const GAS f32x4* gp = (const GAS f32x4*)g + F.lane;
    f32x4 gv[4];
#pragma unroll
    for (int j = 0; j < 4; ++j) gv[j] = gp[64 * j];
    for (int m = F.gw; m < M; m += F.NGW) {
        const GAS f32x4* xr = (const GAS f32x4*)(x + (size_t)m * DM) + F.lane;
        f32x4 v[4]; float s = 0.f;
#pragma unroll
        for (int j = 0; j < 4; ++j) { v[j] = xr[64 * j]; s += (v[j].x * v[j].x + v[j].y * v[j].y) + (v[j].z * v[j].z + v[j].w * v[j].w); }
        const float rstd = 1.0f / sqrtf(wave_sum(s) * (1.f / DM) + NORM_EPS);
        GAS unsigned long long* o8 = (GAS unsigned long long*)(o + (size_t)m * DM) + F.lane;
#pragma unroll
        for (int j = 0; j < 4; ++j) o8[64 * j] = (unsigned long long)pk2(v[j].x * rstd * gv[j].x, v[j].y * rstd * gv[j].y) | ((unsigned long long)pk2(v[j].z * rstd * gv[j].z, v[j].w * rstd * gv[j].w) << 32);
    }
}

__device__ __forceinline__ void post_phase(const Ctx& F, const float* g_fq, const float* g_fk, const float* g_dq, const float* g_dk, const float* b_f) {
    bf16* Z = (bf16*)(F.ws + WS_Z); float* ZS = (float*)(F.ws + WS_ZS);
    const f32x2* R64 = (const f32x2*)(F.ws + WS_ROPE64); const f32x2* R32 = (const f32x2*)(F.ws + WS_ROPE32);
    float* LF = (float*)(F.ws + WS_LF); unsigned* ISG = (unsigned*)(F.ws + WS_ISG);
    bf16* KD = (bf16*)(F.ws + WS_KD); bf16* VD = (bf16*)(F.ws + WS_VD);
    const int lane = F.lane, c8 = lane & 7;
    float gq[8], gk[8], gd[8];
#pragma unroll
    for (int j = 0; j < 8; ++j) { gq[j] = g_fq[c8 * 8 + j]; gk[j] = g_fk[c8 * 8 + j]; gd[j] = g_dq[c8 * 8 + j]; }
    const float gdk = g_dk[lane];
    for (int m = F.gw; m < M; m += F.NGW) {
        const int pos = m & (SEQ - 1);
        bf16* zr = Z + (size_t)m * ZP; float* sr = ZS + (size_t)m * ZSP;
        { v4u w = *(const GAS v4u*)(zr + Z_FQ + 8 * lane); float f[8]; unpack8(w, f); float ss = 0.f;
#pragma unroll
            for (int j = 0; j < 8; ++j) ss += f[j] * f[j];
            ss += __shfl_xor(ss, 1); ss += __shfl_xor(ss, 2); ss += __shfl_xor(ss, 4);
            const float rs = C2 / sqrtf(ss * (1.f / 64) + NORM_EPS);
#pragma unroll
            for (int j = 0; j < 8; ++j) f[j] = f[j] * rs * gq[j];
            *(GAS v4u*)(zr + Z_FQ + 8 * lane) = pack8(f); }
        { v4u w = *(const GAS v4u*)(zr + Z_FK + 8 * lane); float f[8]; unpack8(w, f); float ss = 0.f;
#pragma unroll
            for (int j = 0; j < 8; ++j) ss += f[j] * f[j];
            ss += __shfl_xor(ss, 1); ss += __shfl_xor(ss, 2); ss += __shfl_xor(ss, 4);
            const float rs = 1.0f / sqrtf(ss * (1.f / 64) + NORM_EPS);
#pragma unroll
            for (int j = 0; j < 8; ++j) f[j] = f[j] * rs * gk[j];
            *(GAS v4u*)(zr + Z_FK + 8 * lane) = pack8(f); }
        { v4u w = *(const GAS v4u*)(zr + Z_DQ + 8 * lane); float f[8]; unpack8(w, f); float ss = 0.f;
#pragma unroll
            for (int j = 0; j < 8; ++j) ss += f[j] * f[j];
            ss += __shfl_xor(ss, 1); ss += __shfl_xor(ss, 2); ss += __shfl_xor(ss, 4);
            const float rs = 1.0f / sqrtf(ss * (1.f / 64) + NORM_EPS);
            const f32x2* cs = R64 + pos * 32 + (c8 & 3) * 8;
#pragma unroll
            for (int j = 0; j < 8; ++j) { f[j] = f[j] * rs * gd[j]; }
            float o[8];
#pragma unroll
            for (int j = 0; j < 8; ++j) { const float p = __shfl_xor(f[j], 4); const f32x2 t = cs[j]; o[j] = ((c8 < 4) ? (f[j] * t.x - p * t.y) : (f[j] * t.x + p * t.y)) * C2; }
            *(GAS v4u*)(zr + Z_DQ + 8 * lane) = pack8(o); }
#pragma unroll
        for (int which = 0; which < 2; ++which) { bf16* p4 = zr + (which ? Z_RK : Z_RQ) + 4 * lane;
            const u32x2 w = *(const GAS u32x2*)p4; float f[4] = {bflo(w.x), bfhi(w.x), bflo(w.y), bfhi(w.y)};
            const f32x2* cs = R64 + pos * 32 + (lane & 7) * 4; const bool first = (lane & 15) < 8; const float sc = which ? 1.0f : 0.125f; float o[4];
#pragma unroll
            for (int j = 0; j < 4; ++j) { const float p = __shfl_xor(f[j], 8); const f32x2 t = cs[j]; o[j] = (first ? (f[j] * t.x - p * t.y) : (f[j] * t.x + p * t.y)) * sc; }
            u32x2 ow; ow.x = pk2(o[0], o[1]); ow.y = pk2(o[2], o[3]); *(GAS u32x2*)p4 = ow; }
        { const f32x4 v = *(const GAS f32x4*)(sr + S_IQ + 4 * lane); float f[4] = {v.x, v.y, v.z, v.w};
            const float iw = sr[S_IW + (lane >> 3)]; const float aw = fabsf(iw);
            const f32x2* cs = R32 + pos * 16 + (lane & 3) * 4; const bool first = (lane & 7) < 4; f32x4 o;
#pragma unroll
            for (int j = 0; j < 4; ++j) { const float p = __shfl_xor(f[j], 4); const f32x2 t = cs[j]; o[j] = (first ? (f[j] * t.x - p * t.y) : (f[j] * t.x + p * t.y)) * aw; }
            const unsigned long long neg = __ballot(iw < 0.f);
            unsigned sg = 0;
#pragma unroll
            for (int h = 0; h < 8; ++h) sg |= (unsigned)((neg >> (8 * h)) & 1ull) << h;
            *(GAS f32x4*)(sr + S_IQ + 4 * lane) = o;
            if (lane == 0) ISG[m] = sg; }
        { float v = sr[S_DK + lane]; const float ss = wave_sum(v * v); v = v * (1.0f / sqrtf(ss * (1.f / 64) + NORM_EPS)) * gdk;
            const float p = __shfl_xor(v, 32); const f32x2 t = R64[pos * 32 + (lane & 31)];
            const float o = (lane < 32) ? (v * t.x - p * t.y) : (v * t.x + p * t.y);
            KD[(size_t)m * 64 + lane] = (bf16)f2bf(o);
            VD[(size_t)m * 64 + lane] = (bf16)f2bf(sr[S_DV + lane]); }
        { const float v = sr[S_IK + (lane & 31)]; const float p = __shfl_xor(v, 16); const f32x2 t = R32[pos * 16 + (lane & 15)];
            const float o = ((lane & 16) == 0) ? (v * t.x - p * t.y) : (v * t.x + p * t.y);
            if (lane < 32) sr[S_IK + lane] = o; }
        if (lane < 8) { const float xx = sr[S_FF + lane] + b_f[lane]; const float ls = fminf(xx, 0.f) - __logf(1.0f + __expf(-fabsf(xx))); LF[(size_t)m * 8 + lane] = ls * LOG2E; }
    }
}

__device__ __forceinline__ float ret_l2g(int h) { return h == 0 ? -0.04580368961312479f : h == 1 ? -0.02272007650008353f : h == 2 ? -0.011315313227834146f : -0.005646563141142063f; }

__device__ __forceinline__ void scan_state_phase(const Ctx& F) {
    const float* LF = (const float*)(F.ws + WS_LF); float* CF = (float*)(F.ws + WS_CF);
    const bf16* Z = (const bf16*)(F.ws + WS_Z); float* RS = (float*)(F.ws + WS_HDN);
    if (F.gw < 32) {
        const int b = F.gw >> 3, h = F.gw & 7; const float* lp = LF + ((size_t)b * SEQ + F.lane * 64) * 8 + h; float s = 0.f;
        for (int i = 0; i < 64; ++i) s += lp[i * 8];
        float incl = s;
#pragma unroll
        for (int o = 1; o < 64; o <<= 1) { const float t = __shfl_up(incl, o); if (F.lane >= o) incl += t; }
        float run = incl - s; float* cp = CF + (size_t)F.gw * SEQ + F.lane * 64;
        for (int i = 0; i < 64; ++i) { run += lp[i * 8]; cp[i] = run; }
    }
    for (int u = blockIdx.x; u < NB * 32 * 4; u += F.G) {
        const int h = u & 3, c = (u >> 2) & 31, b = u >> 7; const float l2g = ret_l2g(h);
        const int d = F.tid >> 3, e0 = (F.tid & 7) * 16; float acc[16];
#pragma unroll
        for (int i = 0; i < 16; ++i) acc[i] = 0.f;
        const bf16* base = Z + ((size_t)b * SEQ + c * 128) * ZP;
        for (int j = 0; j < 128; ++j) { const bf16* row = base + (size_t)j * ZP;
            const float kd = bf2f(row[Z_RK + h * 64 + d]) * exp2f((float)(127 - j) * l2g);
            const v4u w0 = *(const GAS v4u*)(row + Z_RV + h * 128 + e0), w1 = *(const GAS v4u*)(row + Z_RV + h * 128 + e0 + 8);
            float v0[8], v1[8]; unpack8(w0, v0); unpack8(w1, v1);
#pragma unroll
            for (int i = 0; i < 8; ++i) { acc[i] += kd * v0[i]; acc[8 + i] += kd * v1[i]; } }
        float* o = RS + (size_t)u * 8192 + d * 128 + e0;
#pragma unroll
        for (int i = 0; i < 4; ++i) *(GAS f32x4*)(o + 4 * i) = (f32x4){acc[4 * i], acc[4 * i + 1], acc[4 * i + 2], acc[4 * i + 3]};
    }
}

__device__ __forceinline__ void ret_out_naive(const Ctx& F, const float* gn) {
    bf16* Z = (bf16*)(F.ws + WS_Z); const float* RS = (const float*)(F.ws + WS_HDN);
    LAS float* S = (LAS float*)(F.lds);
    LAS bf16* Vt = (LAS bf16*)(F.lds + 32768);
    LAS float* Kt = (LAS float*)(F.lds + 65536);
    LAS float* aw = (LAS float*)(F.lds + 65536 + 33280) + F.wave * 128;
    LAS float* qw = (LAS float*)(F.lds + 65536 + 33280 + 4096) + F.wave * 64;
    for (int u = blockIdx.x; u < NB * 32 * 4; u += F.G) {
        const int h = u & 3, c = (u >> 2) & 31, b = u >> 7; const float l2g = ret_l2g(h); const float wch = exp2f(128.f * l2g);
        __syncthreads();
        { float s[16];
#pragma unroll
            for (int i = 0; i < 16; ++i) s[i] = 0.f;
            for (int cp = 0; cp < c; ++cp) { const float* L = RS + ((size_t)((b * 32 + cp) * 4 + h)) * 8192 + F.tid;
#pragma unroll
                for (int i = 0; i < 16; ++i) s[i] = wch * s[i] + L[i * 512]; }
#pragma unroll
            for (int i = 0; i < 16; ++i) S[F.tid + i * 512] = s[i]; }
        const bf16* base = Z + ((size_t)b * SEQ + c * 128) * ZP;
        for (int q = F.tid; q < 2048; q += 512) { const int r = q >> 4, ch = q & 15; *(LAS v4u*)(Vt + r * 128 + ch * 8) = *(const GAS v4u*)(base + (size_t)r * ZP + Z_RV + h * 128 + ch * 8); }
        for (int q = F.tid; q < 128 * 64; q += 512) { const int r = q >> 6, dd = q & 63; Kt[r * 65 + dd] = bf2f(base[(size_t)r * ZP + Z_RK + h * 64 + dd]); }
        __syncthreads();
        for (int i = F.wave; i < 128; i += NWAVES) {
            const size_t m = (size_t)b * SEQ + c * 128 + i; bf16* zr = Z + m * ZP;
            qw[F.lane] = bf2f(zr[Z_RQ + h * 64 + F.lane]);
            LDS_WAIT(); asm volatile("" ::: "memory");
#pragma unroll
            for (int jj = 0; jj < 2; ++jj) { const int j = F.lane + 64 * jj; float a = 0.f;
                if (j <= i) { float dot = 0.f; for (int dd = 0; dd < 64; ++dd) dot += qw[dd] * Kt[j * 65 + dd]; a = dot * exp2f((float)(i - j) * l2g); }
                aw[j] = a; }
            LDS_WAIT(); asm volatile("" ::: "memory");
            float o[2]; const float dq = exp2f((float)(i + 1) * l2g);
#pragma unroll
            for (int ee = 0; ee < 2; ++ee) { const int e = F.lane + 64 * ee; float acc = 0.f;
                for (int j = 0; j <= i; ++j) acc += aw[j] * bf2f(Vt[j * 128 + e]);
                float cr = 0.f; for (int dd = 0; dd < 64; ++dd) cr += qw[dd] * S[dd * 128 + e];
                o[ee] = acc + cr * dq; }
            const float ss = wave_sum(o[0] * o[0] + o[1] * o[1]); const float rstd = 1.0f / sqrtf(ss * (1.f / 128) + NORM_EPS);
#pragma unroll
            for (int ee = 0; ee < 2; ++ee) { const int e = F.lane + 64 * ee; const float rg = bf2f(zr[Z_RG + h * 128 + e]);
                zr[Z_RV + h * 128 + e] = (bf16)f2bf(o[ee] * rstd * gn[h * 128 + e] * rg * sigmoid_f(rg)); }
            LDS_WAIT(); asm volatile("" ::: "memory");
        }
    }
    __syncthreads();
}

__device__ __forceinline__ void fox_naive(const Ctx& F) {
    bf16* Z = (bf16*)(F.ws + WS_Z); const float* CF = (const float*)(F.ws + WS_CF);
    LAS float* sc = (LAS float*)(F.lds + F.wave * 16384);
    const int lane = F.lane;
    int it = 0;
    for (int r0 = 0; r0 < NB * 8 * SEQ; r0 += F.NGW, ++it) {
        const int r = r0 + ((it & 1) ? (F.NGW - 1 - F.gw) : F.gw);
        if (r >= NB * 8 * SEQ) continue;
        const int pos = r & (SEQ - 1), h = (r >> 12) & 7, b = r >> 15;
        const size_t m = (size_t)b * SEQ + pos;
        float qf[64];
        { const bf16* qp = Z + m * ZP + Z_FQ + h * 64;
#pragma unroll
            for (int i = 0; i < 8; ++i) { const v4u w = *(const GAS v4u*)(qp + 8 * i); float t[8]; unpack8(w, t);
#pragma unroll
                for (int j = 0; j < 8; ++j) qf[8 * i + j] = t[j]; } }
        const float* cf = CF + (size_t)(b * 8 + h) * SEQ;
        float mx = -INFINITY;
        for (int kk = lane; kk <= pos; kk += 64) { const bf16* kp = Z + ((size_t)b * SEQ + kk) * ZP + Z_FK + h * 64; float dot = 0.f;
#pragma unroll
            for (int i = 0; i < 8; ++i) { const v4u w = *(const GAS v4u*)(kp + 8 * i); float t[8]; unpack8(w, t);
#pragma unroll
                for (int j = 0; j < 8; ++j) dot += qf[8 * i + j] * t[j]; }
            const float s = dot - cf[kk]; sc[kk] = s; mx = fmaxf(mx, s); }
        mx = wave_max(mx);
        float sum = 0.f;
        for (int kk = lane; kk <= pos; kk += 64) { const float p = exp2f(sc[kk] - mx); sc[kk] = p; sum += p; }
        sum = wave_sum(sum);
        LDS_WAIT(); asm volatile("" ::: "memory");
        const bf16* vp = Z + (size_t)b * SEQ * ZP + Z_FV + h * 64 + lane;
        float o0 = 0.f, o1 = 0.f, o2 = 0.f, o3 = 0.f; int kk = 0;
        for (; kk + 3 <= pos; kk += 4) { o0 += sc[kk] * bf2f(vp[(size_t)kk * ZP]); o1 += sc[kk + 1] * bf2f(vp[(size_t)(kk + 1) * ZP]); o2 += sc[kk + 2] * bf2f(vp[(size_t)(kk + 2) * ZP]); o3 += sc[kk + 3] * bf2f(vp[(size_t)(kk + 3) * ZP]); }
        for (; kk <= pos; ++kk) o0 += sc[kk] * bf2f(vp[(size_t)kk * ZP]);
        Z[m * ZP + Z_FQ + h * 64 + lane] = (bf16)f2bf(((o0 + o1) + (o2 + o3)) / sum);
        LDS_WAIT(); asm volatile("" ::: "memory");
    }
}

__device__ __forceinline__ unsigned f2key(float s) { const unsigned u = __builtin_bit_cast(unsigned, s + 0.0f); return (u & 0x80000000u) ? ~u : (u | 0x80000000u); }
__device__ __forceinline__ void dsa_naive(const Ctx& F) {
    bf16* Z = (bf16*)(F.ws + WS_Z); const float* ZS = (const float*)(F.ws + WS_ZS);
    const unsigned* ISG = (const unsigned*)(F.ws + WS_ISG);
    const bf16* KD = (const bf16*)(F.ws + WS_KD); const bf16* VD = (const bf16*)(F.ws + WS_VD);
    LAS unsigned* kl = (LAS unsigned*)(F.lds + F.wave * 16384);
    LAS float* iqs = (LAS float*)(F.lds + XTRA_OFF + F.wave * 1536);
    const int lane = F.lane;
    int it = 0;
    for (int r0 = 0; r0 < M; r0 += F.NGW, ++it) {
        const int r = r0 + ((it & 1) ? (F.NGW - 1 - F.gw) : F.gw);
        if (r >= M) continue;
        const int pos = r & (SEQ - 1), b = r >> 12; const size_t m = (size_t)r;
        *(LAS f32x4*)(iqs + 4 * lane) = *(const GAS f32x4*)(ZS + m * ZSP + S_IQ + 4 * lane);
        const unsigned sg = ISG[m];
        LDS_WAIT(); asm volatile("" ::: "memory");
        for (int kk = lane; kk <= pos; kk += 64) { const float* ikp = ZS + ((size_t)b * SEQ + kk) * ZSP + S_IK; float ik[32];
#pragma unroll
            for (int i = 0; i < 8; ++i) { const f32x4 t = *(const GAS f32x4*)(ikp + 4 * i); ik[4 * i] = t.x; ik[4 * i + 1] = t.y; ik[4 * i + 2] = t.z; ik[4 * i + 3] = t.w; }
            float s = 0.f;
#pragma unroll 1
            for (int h = 0; h < 8; ++h) { float dot = 0.f;
#pragma unroll
                for (int dd = 0; dd < 32; ++dd) dot += iqs[h * 32 + dd] * ik[dd];
                dot = fmaxf(dot, 0.f); s += ((sg >> h) & 1u) ? -dot : dot; }
            kl[kk] = f2key(s); }
        LDS_WAIT(); asm volatile("" ::: "memory");
        unsigned key[64];
#pragma unroll
        for (int j = 0; j < 64; ++j) { const int kk = j * 64 + lane; key[j] = (kk <= pos) ? kl[kk] : 0u; }
        LDS_WAIT(); asm volatile("" ::: "memory");
        LAS unsigned* idx = kl; LAS float* pl = (LAS float*)(kl + 256); LAS bf16* qs = (LAS bf16*)(kl + 512);
        *(LAS v4u*)(qs + 8 * lane) = *(const GAS v4u*)(Z + m * ZP + Z_DQ + 8 * lane);
        unsigned T = 0u; int need = 0;
        if (pos + 1 > 256) {
            for (int bit = 31; bit >= 0; --bit) { const unsigned Tt = T | (1u << bit); int cnt = 0;
#pragma unroll
                for (int j = 0; j < 64; ++j) cnt += __builtin_popcountll(__ballot(key[j] >= Tt));
                if (cnt >= 256) T = Tt; }
            int ngt = 0;
#pragma unroll
            for (int j = 0; j < 64; ++j) ngt += __builtin_popcountll(__ballot(key[j] > T));
            need = 256 - ngt;
        }
        int nsel = 0, eqb = 0;
#pragma unroll
        for (int j = 0; j < 64; ++j) { const bool gt = key[j] > T, eq = (key[j] == T) && (T != 0u);
            const unsigned long long em = __ballot(eq); const int er = eqb + __builtin_amdgcn_mbcnt_hi((unsigned)(em >> 32), __builtin_amdgcn_mbcnt_lo((unsigned)em, 0u));
            const bool sel = gt || (eq && er < need); eqb += __builtin_popcountll(em);
            const unsigned long long sm = __ballot(sel); const int sp = nsel + __builtin_amdgcn_mbcnt_hi((unsigned)(sm >> 32), __builtin_amdgcn_mbcnt_lo((unsigned)sm, 0u));
            if (sel) idx[sp] = (unsigned)(j * 64 + lane); nsel += __builtin_popcountll(sm); }
        LDS_WAIT(); asm volatile("" ::: "memory");
        for (int h = 0; h < 8; ++h) {
            float sv[4]; float mx = -INFINITY;
#pragma unroll
            for (int i = 0; i < 4; ++i) { const int e = lane + 64 * i; sv[i] = -INFINITY;
                if (e < nsel) { const bf16* kp = KD + ((size_t)b * SEQ + idx[e]) * 64; float dot = 0.f;
#pragma unroll
                    for (int c = 0; c < 8; ++c) { const v4u w = *(const GAS v4u*)(kp + 8 * c); float t[8]; unpack8(w, t); const v4u qw = *(const LAS v4u*)(qs + h * 64 + 8 * c); float qq[8]; unpack8(qw, qq);
#pragma unroll
                        for (int j = 0; j < 8; ++j) dot += qq[j] * t[j]; }
                    sv[i] = dot; }
                mx = fmaxf(mx, sv[i]); }
            mx = wave_max(mx); float sum = 0.f;
#pragma unroll
            for (int i = 0; i < 4; ++i) { const int e = lane + 64 * i; const float p = (e < nsel) ? exp2f(sv[i] - mx) : 0.f; pl[e] = p; sum += p; }
            sum = wave_sum(sum);
            LDS_WAIT(); asm volatile("" ::: "memory");
            float o0 = 0.f, o1 = 0.f; int e = 0;
            for (; e + 1 < nsel; e += 2) { o0 += pl[e] * bf2f(VD[((size_t)b * SEQ + idx[e]) * 64 + lane]); o1 += pl[e + 1] * bf2f(VD[((size_t)b * SEQ + idx[e + 1]) * 64 + lane]); }
            if (e < nsel) o0 += pl[e] * bf2f(VD[((size_t)b * SEQ + idx[e]) * 64 + lane]);
            Z[m * ZP + Z_DQ + h * 64 + lane] = (bf16)f2bf((o0 + o1) / sum);
            LDS_WAIT(); asm volatile("" ::: "memory");
        }
    }
}
#include <hip/hip_bf16.h>
#include <cmath>
namespace attn_body {
using bf16=__hip_bfloat16;
using bf16x8=__attribute__((ext_vector_type(8)))short;
using s16x4=__attribute__((ext_vector_type(4)))short;
using f32x16=__attribute__((ext_vector_type(16)))float;
using u32x4=__attribute__((ext_vector_type(4)))unsigned;
constexpr int BATCH=4,NHEAD=8,SEQ=4096,D=64,DM=6656;
constexpr int NW=8,QBLK=32,QB=QBLK*NW,KVBLK=64,NQB=SEQ/QB;
constexpr int ATTN_PITCH=DM, ATTN_UNIT_ROWS=QB;
__device__ __forceinline__ int crow(int r,int hi){return (r&3)+8*(r>>2)+4*hi;}
#define SBAR() __builtin_amdgcn_sched_barrier(0)
__device__ __forceinline__ void cmask(f32x16&p0,f32x16&p1,int jb,int qrel,int hi){
  const float NEG=-INFINITY; int kb=64*jb+4*hi;
  #pragma unroll
  for(int r=0;r<16;++r){int kv=kb+(r&3)+8*(r>>2); if(kv>qrel)p0[r]=NEG; if(kv+32>qrel)p1[r]=NEG;}
}

constexpr int NSLOT=3, SLOTB=8192;
constexpr int LDS_K=0, LDS_V=NSLOT*SLOTB, LDS_WS=2*NSLOT*SLOTB, LDS_OST=LDS_WS+NW*64*4, LDS_NC=LDS_OST+NW*4096, LDS_BYTES=LDS_NC+SEQ*4;
constexpr float C2=0.125f*1.4426950408889634f;
__device__ __forceinline__ void glds16(const void*gsrc,unsigned lds_dst){unsigned keep;
  asm volatile("s_mov_b32 %0, m0\n\ts_mov_b32 m0, %2\n\ts_nop 0\n\tglobal_load_lds_dwordx4 %1, off\n\ts_mov_b32 m0, %0":"=&s"(keep):"v"(gsrc),"s"(lds_dst):"memory");}
__device__ __forceinline__ float max3f(float a,float b,float c){float r;asm("v_max3_f32 %0, %1, %2, %3":"=v"(r):"v"(a),"v"(b),"v"(c));return r;}
__device__ __forceinline__ float max2f(float a,float b){float r;asm("v_max_f32_e32 %0, %1, %2":"=v"(r):"v"(a),"v"(b));return r;}
__device__ __forceinline__ float fadd_s(float a,float b){float r;asm("v_add_f32_e32 %0, %1, %2":"=v"(r):"v"(a),"v"(b));return r;}
__device__ __forceinline__ float fsub_s(float a,float b){float r;asm("v_sub_f32_e32 %0, %1, %2":"=v"(r):"v"(a),"v"(b));return r;}
typedef float f32x4_t __attribute__((ext_vector_type(4))); typedef float f32x2_t __attribute__((ext_vector_type(2))); typedef __bf16 bf16x2_t __attribute__((ext_vector_type(2)));
__device__ __forceinline__ unsigned cvtpk_s(float lo,float hi){f32x2_t v={lo,hi};bf16x2_t b=__builtin_convertvector(v,bf16x2_t);return __builtin_bit_cast(unsigned,b);}
#define WAIT_BAR(N) asm volatile("s_waitcnt vmcnt(" #N ") lgkmcnt(0)\n\ts_barrier":::"memory")

__device__ __forceinline__ void qkt(f32x16&p0,f32x16&p1,const char*Kslot,const bf16x8*qr,const f32x16&negm,int r32,int hi){
  const char*kb=Kslot+hi*1024+r32*16;
  #pragma unroll
  for(int d0=0;d0<4;++d0){
    const bf16x8 b0=*reinterpret_cast<const bf16x8*>(kb+d0*2048);
    const bf16x8 b1=*reinterpret_cast<const bf16x8*>(kb+d0*2048+512);
    if(d0==0){p0=__builtin_amdgcn_mfma_f32_32x32x16_bf16(b0,qr[0],negm,0,0,0);p1=__builtin_amdgcn_mfma_f32_32x32x16_bf16(b1,qr[0],negm,0,0,0);}
    else{p0=__builtin_amdgcn_mfma_f32_32x32x16_bf16(b0,qr[d0],p0,0,0,0);p1=__builtin_amdgcn_mfma_f32_32x32x16_bf16(b1,qr[d0],p1,0,0,0);}}
}
typedef __attribute__((address_space(3))) const char* lds_cptr;
typedef short v4i16_t __attribute__((ext_vector_type(4)));
__device__ __forceinline__ void kload8(bf16x8*kf,lds_cptr kp){
  kf[0]=*(const __attribute__((address_space(3))) bf16x8*)(kp);      kf[1]=*(const __attribute__((address_space(3))) bf16x8*)(kp+512);
  kf[2]=*(const __attribute__((address_space(3))) bf16x8*)(kp+2048); kf[3]=*(const __attribute__((address_space(3))) bf16x8*)(kp+2560);
  kf[4]=*(const __attribute__((address_space(3))) bf16x8*)(kp+4096); kf[5]=*(const __attribute__((address_space(3))) bf16x8*)(kp+4608);
  kf[6]=*(const __attribute__((address_space(3))) bf16x8*)(kp+6144); kf[7]=*(const __attribute__((address_space(3))) bf16x8*)(kp+6656);
}
__device__ __forceinline__ void kload2(bf16x8*kf,lds_cptr kp,int j){ kf[2*j]=*(const __attribute__((address_space(3))) bf16x8*)(kp+j*2048); kf[2*j+1]=*(const __attribute__((address_space(3))) bf16x8*)(kp+j*2048+512); }
__device__ __forceinline__ s16x4 vtr(lds_cptr p){ return __builtin_bit_cast(s16x4,__builtin_amdgcn_ds_read_tr16_b64_v4i16((__attribute__((address_space(3))) v4i16_t*)p)); }
__device__ __forceinline__ float rowmax(const f32x16&p0,const f32x16&p1){
  float a=max3f(p0[0],p0[1],p1[0]),b=max3f(p0[2],p0[3],p1[1]);a=max3f(a,p1[2],p1[3]);
  #pragma unroll
  for(int r=4;r<16;r+=4){a=max3f(a,p0[r],p0[r+1]);b=max3f(b,p0[r+2],p0[r+3]);a=max3f(a,p1[r],p1[r+1]);b=max3f(b,p1[r+2],p1[r+3]);}
  const float m=max2f(a,b);
  auto rr=__builtin_amdgcn_permlane32_swap(__float_as_uint(m),__float_as_uint(m),false,false);
  return max2f(__uint_as_float(rr[0]),__uint_as_float(rr[1]));
}
__device__ __forceinline__ void pv(f32x16*o,int vb,bf16x8 pa0,bf16x8 pa1,bf16x8 pa2,bf16x8 pa3){
  #pragma unroll
  for(int d0=0;d0<2;++d0){s16x4 lo[4],hi[4];
    #pragma unroll
    for(int ks=0;ks<4;++ks){
      asm volatile("ds_read_b64_tr_b16 %0,%1 offset:%c2":"=&v"(lo[ks]):"v"(vb),"i"(d0*4096+ks*1024):"memory");
      asm volatile("ds_read_b64_tr_b16 %0,%1 offset:%c2":"=&v"(hi[ks]):"v"(vb),"i"(d0*4096+ks*1024+512):"memory");}
    asm volatile("s_waitcnt lgkmcnt(0)":::"memory");SBAR();
    #define PK(k) (bf16x8){lo[k][0],lo[k][1],lo[k][2],lo[k][3],hi[k][0],hi[k][1],hi[k][2],hi[k][3]}
    o[d0]=__builtin_amdgcn_mfma_f32_32x32x16_bf16(pa0,PK(0),o[d0],0,0,0);
    o[d0]=__builtin_amdgcn_mfma_f32_32x32x16_bf16(pa1,PK(1),o[d0],0,0,0);
    o[d0]=__builtin_amdgcn_mfma_f32_32x32x16_bf16(pa2,PK(2),o[d0],0,0,0);
    o[d0]=__builtin_amdgcn_mfma_f32_32x32x16_bf16(pa3,PK(3),o[d0],0,0,0);
    #undef PK
  }
}

#ifndef ATTN_STORE16
#define ATTN_STORE16(p,v) (*(u32x4*)(p)=(v))
#endif
template<int THRL> __device__ __forceinline__ void attn_unit(int b,int h,int qb,const bf16*Q,const bf16*__restrict__ K,const bf16*__restrict__ V,bf16*O,const float*CF,char*shm){
  int tid_=threadIdx.x; asm volatile("":"+v"(tid_));
  const int tid=tid_,lane=tid&63,r32=lane&31,hi=lane>>5; const int wid=__builtin_amdgcn_readfirstlane(tid>>6);
  const long rowbase=(long)b*SEQ; const int q0=qb*QB;
  const bf16*Qw=Q+(rowbase+q0+wid*QBLK)*DM+h*D;
  const bf16*Kh=K+rowbase*DM+h*D,*Vh=V+rowbase*DM+h*D;
  const unsigned lds0=(unsigned)(uintptr_t)shm;
  float*wsf=(float*)(shm+LDS_WS)+wid*64;
  const bf16*ksrc=Kh+(long)lane*DM+wid*8;
  const bf16*vsrc=Vh+(long)(16*(wid&3)+(lane>>2))*DM+(wid>>2)*32+(lane&3)*8;
  const unsigned kdst=lds0+LDS_K+wid*1024, vdst=lds0+LDS_V+wid*1024;
  #define DMA_K(t,slot) glds16(ksrc+(long)(t)*KVBLK*DM,(unsigned)__builtin_amdgcn_readfirstlane(kdst+(slot)))
  #define DMA_V(t,slot) glds16(vsrc+(long)(t)*KVBLK*DM,(unsigned)__builtin_amdgcn_readfirstlane(vdst+(slot)))
  const char*Kbase=shm+LDS_K; bf16x8 kf[8];
  const lds_cptr shm3=(lds_cptr)shm; const lds_cptr kp0=shm3+LDS_K+hi*1024+r32*16; const lds_cptr vp0=shm3+LDS_V+((lane>>4)&1)*32+(lane&3)*8+(4*hi+((lane&15)>>2))*64;
  const int NT=(q0+QB)/KVBLK;
  { const float*cfp=CF+(long)(b*NHEAD+h)*SEQ; float*ncw=(float*)(shm+LDS_NC);
    for(int i=tid;i<q0+QB;i+=NW*64)ncw[i]=-cfp[i]; }
  const lds_cptr ncp=(lds_cptr)shm+LDS_NC+hi*16;
  #define ADDC(P0,P1,t) do{ const lds_cptr np_=ncp+(t)*256; _Pragma("unroll") for(int g_=0;g_<4;++g_){ \
      const f32x4_t a_=*(const __attribute__((address_space(3))) f32x4_t*)(np_+g_*32), b_=*(const __attribute__((address_space(3))) f32x4_t*)(np_+g_*32+128); \
      P0[4*g_]+=a_[0];P0[4*g_+1]+=a_[1];P0[4*g_+2]+=a_[2];P0[4*g_+3]+=a_[3]; P1[4*g_]+=b_[0];P1[4*g_+1]+=b_[1];P1[4*g_+2]+=b_[2];P1[4*g_+3]+=b_[3]; } }while(0)
  DMA_K(0,0);DMA_V(0,0);DMA_K(1,SLOTB);
  bf16x8 qr[4];
  #pragma unroll
  for(int d0=0;d0<4;++d0)qr[d0]=*reinterpret_cast<const bf16x8*>(&Qw[(long)r32*DM+d0*16+hi*8]);
  float mhat=0.f,l_reg=0.f;f32x16 o[2];f32x16 negm; { float zz_; asm volatile("v_mov_b32 %0, 0":"=v"(zz_));
    _Pragma("unroll") for(int r=0;r<16;++r){o[0][r]=zz_;o[1][r]=zz_;negm[r]=zz_;} } asm volatile("":"+v"(negm));
  const int qrel=wid*QBLK+r32;
  #define CMASK(P0,P1,t) do{int jb_=(t)-(NT-4); if(jb_>=0)cmask(P0,P1,jb_,qrel,hi);}while(0)
  bool resc=false;
  #define START(P0,P1) do{ const float rm=rowmax(P0,P1); resc=false; \
    { const float dl=rm; mhat=fadd_s(mhat,dl); \
      _Pragma("unroll") for(int r=0;r<16;++r){P0[r]=fsub_s(P0[r],dl);P1[r]=fsub_s(P1[r],dl);} \
      _Pragma("unroll") for(int r=0;r<16;++r)negm[r]=-mhat; asm volatile("":"+v"(negm)); } \
    _Pragma("unroll") for(int r=0;r<16;++r)P0[r]=__builtin_amdgcn_exp2f(P0[r]); }while(0)
  #define RESC() do{ if(resc){ asm volatile("s_waitcnt lgkmcnt(0)":::"memory"); \
      _Pragma("unroll") for(int d_=0;d_<2;++d_) _Pragma("unroll") for(int r=0;r<16;++r)o[d_][r]*=wsf[crow(r,hi)]; } }while(0)
  f32x16 pA0,pA1,pB0,pB1;
  int sl_prev=0,sl_cur=0,sl_next=SLOTB;
  #define ROT() do{sl_prev=sl_cur;sl_cur=sl_next;sl_next=(sl_next==(NSLOT-1)*SLOTB)?0:sl_next+SLOTB;}while(0)
  DMA_K(2,2*SLOTB);
  WAIT_BAR(3);
  qkt(pA0,pA1,Kbase,qr,negm,r32,hi);asm volatile("s_nop 15\n\ts_nop 7":"+v"(pA0),"+v"(pA1));ADDC(pA0,pA1,0);CMASK(pA0,pA1,0);
  START(pA0,pA1);
  _Pragma("unroll") for(int r=0;r<16;++r)pA1[r]=__builtin_amdgcn_exp2f(pA1[r]);
  WAIT_BAR(0);
  DMA_K(3,0);DMA_V(1,SLOTB);
  ROT();
  kload8(kf,kp0+sl_cur);
  WAIT_BAR(2);
  s16x4 vlo[8],vhi[8]; u32x4 pw0,pw1,pw2,pw3;
  #define PKW(P,B) cvtpk_s(P[B],P[B+1])
  #define PAF(k) __builtin_bit_cast(bf16x8,pw##k)
  #define VFR(i) (bf16x8){vlo[i][0],vlo[i][1],vlo[i][2],vlo[i][3],vhi[i][0],vhi[i][1],vhi[i][2],vhi[i][3]}
  #define PIN(x) asm volatile("":"+v"(x))
  #define MX3(a,b,c) __builtin_fmaxf(__builtin_fmaxf((a),(b)),(c))
  #define GAPA(MF,A0,A1,A2,A3,W0,W1,PW) do{ MF; sacc+=A0; sacc+=A1; sacc+=A2; sacc+=A3; PIN(sacc); W0; W1; PIN(PW); SBAR(); }while(0)
  #define EX(v) __builtin_amdgcn_exp2f(v)
  #define GAPB(MF,X,B) do{ MF; X[B]=EX(X[B]); X[B+1]=EX(X[B+1]); X[B+2]=EX(X[B+2]); X[B+3]=EX(X[B+3]); PIN(X); SBAR(); }while(0)
  #define VRD(i) do{ vlo[i]=vtr(vp_+(((i)>>2)*4096+((i)&3)*1024)); vhi[i]=vtr(vp_+(((i)>>2)*4096+((i)&3)*1024+512)); }while(0)
  #define KRD(G,j) do{ if(G){ kload2(kf,kp0+sl_next,j); SBAR(); } }while(0)
  #define STEP(C0,C1,P0,P1,t,GK,GV,GL) do{ SBAR(); \
    const lds_cptr vp_=vp0+sl_prev; \
    VRD(0); SBAR(); float sacc=(P0[0]+P0[1]); \
    GAPA(C0=__builtin_amdgcn_mfma_f32_32x32x16_bf16(kf[0],qr[0],negm,0,0,0), P0[2],P0[3],P0[4],P0[5],     pw0[0]=PKW(P0,0), pw0[1]=PKW(P0,2), pw0); \
    VRD(4); SBAR(); GAPA(C1=__builtin_amdgcn_mfma_f32_32x32x16_bf16(kf[1],qr[0],negm,0,0,0), P0[6],P0[7],P0[8],P0[9],     pw0[2]=PKW(P0,4), pw0[3]=PKW(P0,6), pw0); \
    VRD(1); SBAR(); GAPA(C0=__builtin_amdgcn_mfma_f32_32x32x16_bf16(kf[2],qr[1],C0,0,0,0),   P0[10],P0[11],P0[12],P0[13], pw1[0]=PKW(P0,8), pw1[1]=PKW(P0,10), pw1); \
    VRD(5); SBAR(); GAPA(C1=__builtin_amdgcn_mfma_f32_32x32x16_bf16(kf[3],qr[1],C1,0,0,0),   P0[14],P0[15],P1[0],P1[1],   pw1[2]=PKW(P0,12),pw1[3]=PKW(P0,14), pw1); \
    VRD(2); SBAR(); GAPA(C0=__builtin_amdgcn_mfma_f32_32x32x16_bf16(kf[4],qr[2],C0,0,0,0),   P1[2],P1[3],P1[4],P1[5],     pw2[0]=PKW(P1,0), pw2[1]=PKW(P1,2), pw2); \
    VRD(6); SBAR(); GAPA(C1=__builtin_amdgcn_mfma_f32_32x32x16_bf16(kf[5],qr[2],C1,0,0,0),   P1[6],P1[7],P1[8],P1[9],     pw2[2]=PKW(P1,4), pw2[3]=PKW(P1,6), pw2); \
    VRD(3); SBAR(); GAPA(C0=__builtin_amdgcn_mfma_f32_32x32x16_bf16(kf[6],qr[3],C0,0,0,0),   P1[10],P1[11],P1[12],P1[13], pw3[0]=PKW(P1,8), pw3[1]=PKW(P1,10), pw3); \
    VRD(7); SBAR(); GAPA(C1=__builtin_amdgcn_mfma_f32_32x32x16_bf16(kf[7],qr[3],C1,0,0,0),   P1[14],P1[15],0.f,0.f,       pw3[2]=PKW(P1,12),pw3[3]=PKW(P1,14), pw3); \
    l_reg+=sacc; \
    if(GK){DMA_K((t)+3,sl_cur);} if(GV){DMA_V((t)+1,sl_next);} \
    ADDC(C0,C1,t); CMASK(C0,C1,t); \
    { float a=MX3(C0[0],C0[1],C1[0]),b=MX3(C0[2],C0[3],C1[1]); a=MX3(a,C1[2],C1[3]); \
      _Pragma("unroll") for(int r=4;r<16;r+=4){a=MX3(a,C0[r],C0[r+1]);b=MX3(b,C0[r+2],C0[r+3]);a=MX3(a,C1[r],C1[r+1]);b=MX3(b,C1[r+2],C1[r+3]);} \
      float rm=__builtin_fmaxf(a,b); { auto rr=__builtin_amdgcn_permlane32_swap(__float_as_uint(rm),__float_as_uint(rm),false,false); rm=__builtin_fmaxf(__uint_as_float(rr[0]),__uint_as_float(rr[1])); } \
      resc=false; \
      if(__builtin_expect(__any(rm>(float)THRL),0)){ const float dl=__builtin_fmaxf(rm,0.f); mhat+=dl; \
        _Pragma("unroll") for(int r=0;r<16;++r){C0[r]-=dl;C1[r]-=dl;} \
        _Pragma("unroll") for(int r=0;r<16;++r)negm[r]=-mhat; asm volatile("":"+v"(negm)); \
        const float f=__builtin_amdgcn_exp2f(-dl); l_reg*=f; if(hi==0)wsf[r32]=f; resc=true; } } \
    SBAR(); \
    GAPB(o[0]=__builtin_amdgcn_mfma_f32_32x32x16_bf16(PAF(0),VFR(0),o[0],0,0,0), C0,0); \
    GAPB(o[1]=__builtin_amdgcn_mfma_f32_32x32x16_bf16(PAF(0),VFR(4),o[1],0,0,0), C0,4); \
    KRD(GL,0); GAPB(o[0]=__builtin_amdgcn_mfma_f32_32x32x16_bf16(PAF(1),VFR(1),o[0],0,0,0), C0,8); \
    KRD(GL,1); GAPB(o[1]=__builtin_amdgcn_mfma_f32_32x32x16_bf16(PAF(1),VFR(5),o[1],0,0,0), C0,12); \
    KRD(GL,2); GAPB(o[0]=__builtin_amdgcn_mfma_f32_32x32x16_bf16(PAF(2),VFR(2),o[0],0,0,0), C1,0); \
    KRD(GL,3); GAPB(o[1]=__builtin_amdgcn_mfma_f32_32x32x16_bf16(PAF(2),VFR(6),o[1],0,0,0), C1,4); \
    GAPB(o[0]=__builtin_amdgcn_mfma_f32_32x32x16_bf16(PAF(3),VFR(3),o[0],0,0,0), C1,8); \
    GAPB(o[1]=__builtin_amdgcn_mfma_f32_32x32x16_bf16(PAF(3),VFR(7),o[1],0,0,0), C1,12); \
    }while(0)
  int t=1;
  #undef CMASK
  #define CMASK(P0,P1,t) do{}while(0)
  for(;t+5<NT;t+=2){
    STEP(pB0,pB1,pA0,pA1,t,true,true,true);     WAIT_BAR(2); RESC(); ROT();
    STEP(pA0,pA1,pB0,pB1,t+1,true,true,true);   WAIT_BAR(2); RESC(); ROT();
  }
  #undef CMASK
  #define CMASK(P0,P1,t) do{int jb_=(t)-(NT-4); if(jb_>=0)cmask(P0,P1,jb_,qrel,hi);}while(0)
  #define ENDW(tt) do{ if((tt)+3<NT){WAIT_BAR(2);} else if((tt)+2<NT){WAIT_BAR(1);} else {WAIT_BAR(0);} }while(0)
  for(;t+1<NT;t+=2){
    STEP(pB0,pB1,pA0,pA1,t,(t+3<NT),(t+1<NT),(t+1<NT));       ENDW(t);   RESC(); ROT();
    STEP(pA0,pA1,pB0,pB1,t+1,(t+4<NT),(t+2<NT),(t+2<NT));     ENDW(t+1); RESC(); ROT();
  }
  STEP(pB0,pB1,pA0,pA1,NT-1,false,false,false); RESC();
  { float sacc=pB0[0]+pB0[1]; _Pragma("unroll") for(int r=2;r<16;++r)sacc+=pB0[r]; _Pragma("unroll") for(int r=0;r<16;++r)sacc+=pB1[r]; l_reg+=sacc;
    pw0=(u32x4){PKW(pB0,0),PKW(pB0,2),PKW(pB0,4),PKW(pB0,6)};pw1=(u32x4){PKW(pB0,8),PKW(pB0,10),PKW(pB0,12),PKW(pB0,14)};pw2=(u32x4){PKW(pB1,0),PKW(pB1,2),PKW(pB1,4),PKW(pB1,6)};pw3=(u32x4){PKW(pB1,8),PKW(pB1,10),PKW(pB1,12),PKW(pB1,14)};
    int tl_=threadIdx.x; asm volatile("":"+v"(tl_)); const int ln_=tl_&63,hi_=ln_>>5; const int vb0e=(int)(lds0+LDS_V)+((ln_>>4)&1)*32+(ln_&3)*8+(4*hi_+((ln_&15)>>2))*64;
    SBAR(); pv(o,vb0e+sl_cur,PAF(0),PAF(1),PAF(2),PAF(3)); }
  #undef PKW
  #undef PAF
  #undef VFR
  #undef PIN
  #undef MX3
  #undef GAPA
  #undef GAPB
  #undef EX
  #undef VRD
  #undef KRD
  #undef STEP
  #undef ENDW
  {auto rr=__builtin_amdgcn_permlane32_swap(__float_as_uint(l_reg),__float_as_uint(l_reg),false,false);l_reg=__uint_as_float(rr[0])+__uint_as_float(rr[1]);}
  int te_=threadIdx.x; asm volatile("":"+v"(te_)); const int lane_e=te_&63,r32_e=lane_e&31,hi_e=lane_e>>5;
  if(hi_e==0)wsf[32+r32_e]=l_reg;asm volatile("s_waitcnt lgkmcnt(0)":::"memory");
  float rli[16];
  #pragma unroll
  for(int r=0;r<16;++r)rli[r]=__builtin_amdgcn_rcpf(wsf[32+crow(r,hi_e)]);
  bf16*Ow=O+(rowbase+q0+wid*QBLK)*DM+h*D;
  { bf16*stg=(bf16*)(shm+LDS_OST)+wid*2048;
    #pragma unroll
    for(int r=0;r<16;++r){const int orow=crow(r,hi_e);
      #pragma unroll
      for(int d0=0;d0<2;++d0)stg[orow*64+d0*32+r32_e]=__float2bfloat16(o[d0][r]*rli[r]);}
    asm volatile("s_waitcnt lgkmcnt(0)":::"memory");
    #pragma unroll
    for(int i=0;i<4;++i){const int row=i*8+(lane_e>>3),ch=lane_e&7; const u32x4 v=*(const u32x4*)(stg+row*64+ch*8); ATTN_STORE16(Ow+(long)row*DM+ch*8,v);} }
  asm volatile("s_waitcnt lgkmcnt(0)\n\ts_barrier":::"memory");
  #undef ADDC
  #undef DMA_K
  #undef DMA_V
  #undef CMASK
  #undef START
  #undef RESC
  #undef ROT
}
constexpr int ATTN_LDS_BYTES=LDS_BYTES;
struct AttnTensors { const bf16* Q; const bf16* K; const bf16* V; bf16* O; const float* CF; };
struct AttnUnit { int bh; int qb; };
struct StaticOrder {
  int vcu;
  __device__ __forceinline__ explicit StaticOrder(int grid,int block):vcu((block%8)*(grid/8)+block/8){}
  __device__ __forceinline__ bool next(int i,AttnUnit&u)const{ if(i>=2)return false; const int s=vcu&7; u.bh=vcu>>3; u.qb=(i==0)?s:15-s; return true; }
  __device__ __forceinline__ void a_ready(const AttnUnit&)const{}
  __device__ __forceinline__ void done(const AttnUnit&)const{}
};
template<class Sched,int THRL=8> __device__ __forceinline__ void attn_phase(char*lds,const AttnTensors&T,const Sched&S){
  AttnUnit u;
  for(int i=0;S.next(i,u);++i){ S.a_ready(u); attn_unit<THRL>(u.bh/NHEAD,u.bh%NHEAD,u.qb,T.Q,T.K,T.V,T.O,T.CF,lds); S.done(u); }
}
#undef SBAR
#undef WAIT_BAR
}

struct Args { const float* in[16]; float* out; unsigned char* ws; };
__global__ void __launch_bounds__(NWAVES * 64, 2) hyb_fwd(Args args) {
    extern __shared__ __attribute__((aligned(16))) unsigned char lds[];
    Ctx F;
    F.lds = (LAS unsigned char*)lds;
    F.tid = threadIdx.x; F.lane = F.tid & 63; F.wave = __builtin_amdgcn_readfirstlane(F.tid >> 6);
    F.G = gridDim.x; F.gw = blockIdx.x * NWAVES + F.wave; F.NGW = F.G * NWAVES;
    F.out = args.out; F.ws = args.ws;
    volatile LAS unsigned* MISC = (volatile LAS unsigned*)(F.lds + MISC_OFF);
    for (int u = F.tid; u < (LDS_BYTES - LDSCTL_OFF) / 4; u += NWAVES * 64) ((LAS unsigned*)(F.lds + LDSCTL_OFF))[u] = 0u;
    __syncthreads();
    gu32* ctl = (gu32*)(F.ws + WS_CTL);
    XcdBarrier bar = xcd_barrier_post((unsigned*)(ctl + CW_BAR), MISC + 8);
#define FRESH(P) Ctx P = F; P.tid = threadIdx.x; asm volatile("" : "+v"(P.tid), "+s"(P.wave), "+s"(P.gw), "+s"(P.ws), "+s"(P.out)); P.lane = P.tid & 63
#define GRID_BAR() do { XcdBarrier b_ = bar; asm volatile("" : "+s"(b_.bar), "+s"(b_.x)); xcd_barrier(b_); } while (0)

    bf16* Wb = (bf16*)(F.ws + WS_W);
    bf16* Z = (bf16*)(F.ws + WS_Z); float* ZS = (float*)(F.ws + WS_ZS); bf16* HDN = (bf16*)(F.ws + WS_HDN);
    float* M32 = (float*)(F.ws + WS_HDN); bf16* HB = (bf16*)(F.ws + WS_Z);
    LAS unsigned char* ring = F.lds + RING_OFF;

    { FRESH(P); p0_prologue(P, args.in[2], args.in[9], args.in[10], args.in[11], args.in[12], args.in[14], args.in[15]); }
    GRID_BAR();

    #pragma unroll 1
    for (int layer = 0; layer < DEPTH; ++layer) {
        const float* xin = (layer == 0) ? args.in[0] : F.out;
        const bf16* L = Wb + (size_t)layer * LW_STRIDE;
        { FRESH(P); rmsnorm_phase(P, xin, args.in[1] + layer * DM, (bf16*)(P.ws + WS_HDN)); }
        GRID_BAR();
        { pg8::Gemm g{HDN, L + LW_IN, M, NIN, DM, DM, DM}; pg8::StaticOrder S; S.init(M, NIN, F.G, (int)blockIdx.x);
          pg8::EpiZ E{Z, ZS};
          pg8::gemm_phase<pg8::EpiZ, pg8::StaticOrder, true, true>(ring, g, S, E); }
        GRID_BAR();
        { FRESH(P); post_phase(P, args.in[4] + layer * 64, args.in[5] + layer * 64, args.in[6] + layer * 64, args.in[7] + layer * 64, args.in[3] + layer * 8); }
        GRID_BAR();
        { FRESH(P); scan_state_phase(P); }
        GRID_BAR();
        { FRESH(P); ret_out_naive(P, args.in[8] + layer * 512); }
        { static_assert(attn_body::ATTN_LDS_BYTES <= RING_BYTES, "attention scratch fits the ring region");
          unsigned char* wsl = F.ws; asm volatile("" : "+s"(wsl));
          bf16* Zl = (bf16*)(wsl + WS_Z);
          const attn_body::AttnTensors AT{(const attn_body::bf16*)(Zl + Z_FQ), (const attn_body::bf16*)(Zl + Z_FK), (const attn_body::bf16*)(Zl + Z_FV), (attn_body::bf16*)(Zl + Z_FQ), (const float*)(wsl + WS_CF)};
          const attn_body::StaticOrder S((int)F.G, (int)blockIdx.x);
          attn_body::attn_phase<attn_body::StaticOrder>((char*)lds + RING_OFF, AT, S); }
        { FRESH(P); dsa_naive(P); }
        GRID_BAR();
        { pg8::StaticOrder S; S.init(M, DM, F.G, (int)blockIdx.x);
          { pg8::Gemm g{Z + Z_FQ, L + LW_MIX, M, DM, 512, ZP, 512}; pg8::EpiGate<0> E{Z + Z_ZG, M32, Z + Z_MRG};
            pg8::gemm_phase<pg8::EpiGate<0>, pg8::StaticOrder, false, true>(ring, g, S, E); }
          { pg8::Gemm g{Z + Z_DQ, L + LW_MIX + 512 * 1024, M, DM, 512, ZP, 512}; pg8::EpiGate<1> E{Z + Z_ZG, M32, Z + Z_MRG};
            pg8::gemm_phase<pg8::EpiGate<1>, pg8::StaticOrder, false, true>(ring, g, S, E); }
          { pg8::Gemm g{Z + Z_RV, L + LW_MIX + 1024 * 1024, M, DM, 512, ZP, 512}; pg8::EpiGate<2> E{Z + Z_ZG, M32, Z + Z_MRG};
            pg8::gemm_phase<pg8::EpiGate<2>, pg8::StaticOrder, false, true>(ring, g, S, E); } }
        GRID_BAR();
        { pg8::Gemm g{Z + Z_MRG, L + LW_O, M, DM, DM, ZP, DM}; pg8::StaticOrder S; S.init(M, DM, F.G, (int)blockIdx.x);
          pg8::EpiRes E{xin, F.out};
          pg8::gemm_phase<pg8::EpiRes, pg8::StaticOrder, false, true>(ring, g, S, E); }
        GRID_BAR();
        { FRESH(P); rmsnorm_phase(P, P.out, args.in[13] + layer * DM, (bf16*)(P.ws + WS_HDN)); }
        GRID_BAR();
        { pg8::Gemm g{HDN, L + LW_FI, M, FF2, DM, DM, DM}; pg8::StaticOrder S; S.init(M, FF2, F.G, (int)blockIdx.x);
          pg8::EpiSwi E{HB, FFH};
          pg8::gemm_phase<pg8::EpiSwi, pg8::StaticOrder, true, true>(ring, g, S, E); }
        GRID_BAR();
        { pg8::Gemm g{HB, L + LW_FO, M, DM, FFH, FFH, FFH}; pg8::StaticOrder S; S.init(M, DM, F.G, (int)blockIdx.x);
          pg8::EpiRes E{F.out, F.out};
          pg8::gemm_phase<pg8::EpiRes, pg8::StaticOrder, false, true>(ring, g, S, E); }
        GRID_BAR();
    }
    if (__hip_atomic_load((gu32*)((unsigned*)(ctl + CW_BAR) + XB_TMO), RLX_AGENT) != 0u) {
        const float q = __builtin_nanf("");
        for (int m = F.gw; m < M; m += F.NGW) { GAS f32x4* o = (GAS f32x4*)(F.out + (size_t)m * DM) + (threadIdx.x & 63);
#pragma unroll
            for (int j = 0; j < 4; ++j) o[64 * j] = (f32x4){q, q, q, q}; }
    }
}

extern "C" void kernel_launch(void* const* d_in, const int* in_sizes, int n_in, void* d_out, int out_size, void* d_ws, size_t ws_size, hipStream_t stream) {
    static int grid = 0;
    if (grid == 0) {
        if (n_in != 16 || in_sizes[0] != M * DM || out_size != M * DM || ws_size < WS_END) { fprintf(stderr, "kernel_launch: unexpected shapes / workspace (n_in %d, in0 %d, out %d, ws %zu < %zu)\n", n_in, n_in > 0 ? in_sizes[0] : -1, out_size, ws_size, (size_t)WS_END); grid = -1; return; }
        int dev = 0, cus = 0, per_cu = 0;
        if (hipGetDevice(&dev) != hipSuccess || hipDeviceGetAttribute(&cus, hipDeviceAttributeMultiprocessorCount, dev) != hipSuccess) { grid = -1; return; }
        if (hipFuncSetAttribute((const void*)hyb_fwd, hipFuncAttributeMaxDynamicSharedMemorySize, LDS_BYTES) != hipSuccess) { fprintf(stderr, "kernel_launch: hipFuncSetAttribute failed\n"); grid = -1; return; }
        if (hipOccupancyMaxActiveBlocksPerMultiprocessor(&per_cu, (const void*)hyb_fwd, NWAVES * 64, LDS_BYTES) != hipSuccess || per_cu < 1) { fprintf(stderr, "kernel_launch: occupancy query reports %d blocks per CU\n", per_cu); }
        (void)hipGetLastError();
        grid = cus;
    }
    if (grid < 0) return;
    if (hipMemsetAsync((char*)d_ws + WS_CTL, 0, CTL_ZERO_BYTES, stream) != hipSuccess) return;
    Args a{};
    for (int i = 0; i < 16; ++i) a.in[i] = (const float*)d_in[i];
    a.out = (float*)d_out; a.ws = (unsigned char*)d_ws;
    hipLaunchKernelGGL(hyb_fwd, dim3(grid), dim3(NWAVES * 64), LDS_BYTES, stream, a);
}
```

```cpp
#include <hip/hip_runtime.h>
#include <cstdio>
#include <cstdint>
#include <cmath>
__device__ __forceinline__ int lane_id_v() { unsigned z; asm volatile("v_mov_b32 %0, 0" : "=v"(z)); return (int)__builtin_amdgcn_mbcnt_hi(~0u, __builtin_amdgcn_mbcnt_lo(~0u, z)); }
namespace pg8 {
#define PG8_LAS __attribute__((address_space(3)))
typedef unsigned short bf16_t;
typedef short bf16x8 __attribute__((ext_vector_type(8)));
typedef float f32x4 __attribute__((ext_vector_type(4)));
typedef unsigned u32x4 __attribute__((ext_vector_type(4)));
constexpr int BM = 256, BK = 64, HALF = 128, HTB = HALF * BK * 2  , STAGE_BYTES = 8 * HTB, NXCD = 8, WGM = 8;

__host__ __device__ __forceinline__ int lds_byte(int r, int c) { const int st = (r >> 4) * 2 + (c >> 5), rr = r & 15, cc = c & 31, ob = rr * 64 + cc * 2; return st * 1024 + (ob ^ (((ob >> 9) & 1) << 5)); }
__host__ __device__ __forceinline__ void stage_rc(int b, int& R, int& C) { const int st = b / 1024, sb = b % 1024, swz = sb ^ (((sb >> 9) & 1) << 5); R = (st >> 1) * 16 + swz / 64; C = (st & 1) * 32 + (swz % 64) / 2; }
__host__ __device__ __forceinline__ int perm32(int rho) { const int n = rho >> 4, i = rho & 15; return 8 * (i >> 2) + 4 * n + (i & 3); }

struct Unit { int pm, pn; };
struct Gemm { const bf16_t* A; const bf16_t* Bt; int M, N, K, lda, ldb; };

struct StaticOrder {
    int nM, nN, nwg, G, c;
    __host__ __device__ void init(int M, int N, int G_, int c_) { nM = M / BM; nN = N / BM; nwg = nM * nN; G = G_; c = c_; }
    __host__ __device__ bool next(int i, Unit& u) const {
        const long L = (long)i * G + c; if (L >= nwg) return false;
        int wgid = (int)L; { const int q = nwg / NXCD, r = nwg % NXCD, xcd = wgid % NXCD, off = wgid / NXCD; wgid = (xcd < r ? xcd * (q + 1) : r * (q + 1) + (xcd - r) * q) + off; }
        const int nig = WGM * nN, gid = wgid / nig, fm = gid * WGM, gsz = (nM - fm) < WGM ? (nM - fm) : WGM;
        u.pm = fm + ((wgid % nig) % gsz); u.pn = (wgid % nig) / gsz; return true;
    }
    __device__ __forceinline__ void a_ready(const Unit&) const {}
    __device__ __forceinline__ void done(const Unit&) const {}
};

__device__ __forceinline__ unsigned cvt_pk_bf16(float lo, float hi) { unsigned r; asm volatile("v_cvt_pk_bf16_f32 %0, %1, %2" : "=v"(r) : "v"(lo), "v"(hi)); return r; }
__device__ __forceinline__ float bflo(unsigned w) { return __builtin_bit_cast(float, w << 16); }
__device__ __forceinline__ float bfhi(unsigned w) { return __builtin_bit_cast(float, w & 0xffff0000u); }
__device__ __forceinline__ float sigmoidf_(float x) { return __builtin_amdgcn_rcpf(1.0f + __builtin_amdgcn_exp2f(-1.4426950408889634f * x)); }

constexpr int ZP = 6656;
constexpr int ZSP = 512;
constexpr int NZT = 26;

struct EpiZ {
    static constexpr bool PERM = true, AFTER_DRAIN = false;
    bf16_t* Z; float* ZS;
    __device__ __forceinline__ void operator()(const f32x4 (&acc)[2][2][4][2], const Unit& u, int wr, int wc, int fr, int fq) const {
        const int row0 = u.pm * BM + wr * 64 + fr;
        if (u.pn < NZT) {
            const int col0 = u.pn * BM + wc * 32 + 8 * fq;
#pragma unroll
            for (int ai = 0; ai < 2; ++ai)
#pragma unroll
                for (int m = 0; m < 4; ++m) { bf16_t* rowp = Z + (size_t)(row0 + ai * HALF + m * 16) * ZP + col0;
#pragma unroll
                    for (int bj = 0; bj < 2; ++bj) { const f32x4 v0 = acc[ai][bj][m][0], v1 = acc[ai][bj][m][1];
                        u32x4 w; w.x = cvt_pk_bf16(v0[0], v0[1]); w.y = cvt_pk_bf16(v0[2], v0[3]); w.z = cvt_pk_bf16(v1[0], v1[1]); w.w = cvt_pk_bf16(v1[2], v1[3]);
                        *(u32x4*)(rowp + bj * HALF) = w; } }
        } else {
            const int col0 = (u.pn - NZT) * BM + wc * 32 + 8 * fq;
#pragma unroll
            for (int ai = 0; ai < 2; ++ai)
#pragma unroll
                for (int m = 0; m < 4; ++m) { float* rowp = ZS + (size_t)(row0 + ai * HALF + m * 16) * ZSP + col0;
#pragma unroll
                    for (int bj = 0; bj < 2; ++bj) { *(f32x4*)(rowp + bj * HALF) = acc[ai][bj][m][0]; *(f32x4*)(rowp + bj * HALF + 4) = acc[ai][bj][m][1]; } }
        }
    }
};

template <int P> struct EpiGate {
    static constexpr bool PERM = true, AFTER_DRAIN = false;
    const bf16_t* G;
    float* M32;
    bf16_t* OUT;
    __device__ __forceinline__ void operator()(const f32x4 (&acc)[2][2][4][2], const Unit& u, int wr, int wc, int fr, int fq) const {
        const int row0 = u.pm * BM + wr * 64 + fr, col0 = u.pn * BM + wc * 32 + 8 * fq;
#pragma unroll
        for (int ai = 0; ai < 2; ++ai)
#pragma unroll
            for (int m = 0; m < 4; ++m) { const size_t row = (size_t)(row0 + ai * HALF + m * 16);
#pragma unroll
                for (int bj = 0; bj < 2; ++bj) { const int col = col0 + bj * HALF;
                    const u32x4 gw = *(const u32x4*)(G + row * ZP + P * 1024 + col);
                    const f32x4 v0 = acc[ai][bj][m][0], v1 = acc[ai][bj][m][1];
                    f32x4 t0, t1;
                    t0[0] = sigmoidf_(bflo(gw.x)) * v0[0]; t0[1] = sigmoidf_(bfhi(gw.x)) * v0[1]; t0[2] = sigmoidf_(bflo(gw.y)) * v0[2]; t0[3] = sigmoidf_(bfhi(gw.y)) * v0[3];
                    t1[0] = sigmoidf_(bflo(gw.z)) * v1[0]; t1[1] = sigmoidf_(bfhi(gw.z)) * v1[1]; t1[2] = sigmoidf_(bflo(gw.w)) * v1[2]; t1[3] = sigmoidf_(bfhi(gw.w)) * v1[3];
                    float* mp = M32 + row * 1024 + col;
                    if (P == 0) { *(f32x4*)mp = t0; *(f32x4*)(mp + 4) = t1; }
                    else if (P == 1) { *(f32x4*)mp = *(const f32x4*)mp + t0; *(f32x4*)(mp + 4) = *(const f32x4*)(mp + 4) + t1; }
                    else { t0 = *(const f32x4*)mp + t0; t1 = *(const f32x4*)(mp + 4) + t1;
                        u32x4 w; w.x = cvt_pk_bf16(t0[0], t0[1]); w.y = cvt_pk_bf16(t0[2], t0[3]); w.z = cvt_pk_bf16(t1[0], t1[1]); w.w = cvt_pk_bf16(t1[2], t1[3]);
                        *(u32x4*)(OUT + row * ZP + col) = w; } } }
    }
};

struct EpiRes {
    static constexpr bool PERM = true, AFTER_DRAIN = false;
    const float* RES; float* OUT;
    __device__ __forceinline__ void operator()(const f32x4 (&acc)[2][2][4][2], const Unit& u, int wr, int wc, int fr, int fq) const {
        const int row0 = u.pm * BM + wr * 64 + fr, col0 = u.pn * BM + wc * 32 + 8 * fq;
#pragma unroll
        for (int ai = 0; ai < 2; ++ai)
#pragma unroll
            for (int m = 0; m < 4; ++m) { const size_t off = (size_t)(row0 + ai * HALF + m * 16) * 1024 + col0;
#pragma unroll
                for (int bj = 0; bj < 2; ++bj) { const float* rp = RES + off + bj * HALF; float* op = OUT + off + bj * HALF;
                    const f32x4 r0 = *(const f32x4*)rp, r1 = *(const f32x4*)(rp + 4);
                    *(f32x4*)op = r0 + acc[ai][bj][m][0]; *(f32x4*)(op + 4) = r1 + acc[ai][bj][m][1]; } }
    }
};

struct EpiSwi {
    static constexpr bool PERM = true, AFTER_DRAIN = false;
    bf16_t* H; int ldh;
    __device__ __forceinline__ void operator()(const f32x4 (&acc)[2][2][4][2], const Unit& u, int wr, int wc, int fr, int fq) const {
        const int row0 = u.pm * BM + wr * 64 + fr, col0 = u.pn * HALF + wc * 32 + 8 * fq;
#pragma unroll
        for (int ai = 0; ai < 2; ++ai)
#pragma unroll
            for (int m = 0; m < 4; ++m) { bf16_t* hp = H + (size_t)(row0 + ai * HALF + m * 16) * ldh + col0;
                float o[8];
#pragma unroll
                for (int n = 0; n < 2; ++n)
#pragma unroll
                    for (int i = 0; i < 4; ++i) { const float g = acc[ai][0][m][n][i], up = acc[ai][1][m][n][i]; o[4 * n + i] = g * sigmoidf_(g) * up; }
                u32x4 w; w.x = cvt_pk_bf16(o[0], o[1]); w.y = cvt_pk_bf16(o[2], o[3]); w.z = cvt_pk_bf16(o[4], o[5]); w.w = cvt_pk_bf16(o[6], o[7]);
                *(u32x4*)hp = w; }
    }
};

template <class Epi, class Sched, bool ALIGN_EPI = false, bool SP2 = false>
__device__ __forceinline__ void gemm_phase(PG8_LAS unsigned char* lds, Gemm g, const Sched& S0, const Epi& E, int wave_id) {
    int ovz, osz; asm volatile("v_mov_b32 %0, 0\n\ts_mov_b32 %1, 0" : "=v"(ovz), "=s"(osz));
    Sched S = S0; S.c += osz; g.lda += osz; g.ldb += osz;
    const int tid = ((wave_id << 6) | lane_id_v()) + ovz,
         wid = __builtin_amdgcn_readfirstlane(tid >> 6), lane = tid & 63, wr = wid >> 2, wc = wid & 3, fr = lane & 15, fq = lane >> 4;
    const int K = g.K, nt = K / BK;
    unsigned voffA[2], voffB[2];
#pragma unroll
    for (int i = 0; i < 2; ++i) { int R, C; stage_rc(tid * 16 + i * 8192, R, C); const int Rb = Epi::PERM ? ((R & ~31) + perm32(R & 31)) : R;
        voffA[i] = (unsigned)(R * g.lda + C) * 2u; voffB[i] = (unsigned)(Rb * g.ldb + C) * 2u; }
    const size_t kstep = (size_t)(BK * 2);
    const size_t hstepA = (size_t)HALF * g.lda * 2, hstepB = (size_t)HALF * g.ldb * 2;
    const size_t tstepA = 2 * hstepA, tstepB = 2 * hstepB;
    const unsigned ldsw = (unsigned)wid * 1024u;
    const int aoff = lds_byte(wr * 64 + fr, fq * 8), boff = lds_byte(wc * 32 + fr, fq * 8);
#define PG8_SA(b, h) (((b) * 2 + (h)) * HTB)
#define PG8_SB(b, h) ((4 + (b) * 2 + (h)) * HTB)
#define PG8_STAGE(bufoff, gbase, voff) do { _Pragma("unroll") for (int _i = 0; _i < 2; ++_i) \
        __builtin_amdgcn_global_load_lds((const unsigned*)((const char*)(gbase) + (voff)[_i]), (PG8_LAS unsigned*)(lds + (bufoff) + ldsw + _i * 8192), 16, 0, 0); } while (0)
#define PG8_LDA(dst, b, h) do { _Pragma("unroll") for (int m = 0; m < 4; ++m) _Pragma("unroll") for (int k = 0; k < 2; ++k) dst[m][k] = *(const PG8_LAS bf16x8*)(lds + PG8_SA(b, h) + aoff + m * 2048 + k * 1024); } while (0)
#define PG8_LDB(dst, b, h) do { _Pragma("unroll") for (int n = 0; n < 2; ++n) _Pragma("unroll") for (int k = 0; k < 2; ++k) dst[n][k] = *(const PG8_LAS bf16x8*)(lds + PG8_SB(b, h) + boff + n * 2048 + k * 1024); } while (0)
#define PG8_MMA(ai, bj, At, Bt) do { __builtin_amdgcn_s_setprio(1); _Pragma("unroll") for (int m = 0; m < 4; ++m) _Pragma("unroll") for (int n = 0; n < 2; ++n) _Pragma("unroll") for (int k = 0; k < 2; ++k) \
        acc[ai][bj][m][n] = __builtin_amdgcn_mfma_f32_16x16x32_bf16(Bt[n][k], At[m][k], acc[ai][bj][m][n], 0, 0, 0); __builtin_amdgcn_s_setprio(0); } while (0)
#define PG8_WAIT_V(n) asm volatile("s_waitcnt vmcnt(" #n ")" ::: "memory")
#define PG8_WAIT_L(n) asm volatile("s_waitcnt lgkmcnt(" #n ")" ::: "memory")
#define PG8_BAR __builtin_amdgcn_s_barrier()
#define PG8_SCHED __builtin_amdgcn_sched_barrier(0)
    Unit cur, nxt; int ui = 0;
    if (!S.next(0, cur)) return;
    f32x4 acc[2][2][4][2];
#pragma unroll
    for (int a = 0; a < 2; ++a)
#pragma unroll
        for (int b = 0; b < 2; ++b)
#pragma unroll
            for (int m = 0; m < 4; ++m)
#pragma unroll
                for (int n = 0; n < 2; ++n) acc[a][b][m][n] = (f32x4){0.f, 0.f, 0.f, 0.f};
    bf16x8 At[4][2], B0[2][2], B1[2][2];
    const char* cA = (const char*)g.A + (size_t)cur.pm * tstepA; const char* cB = (const char*)g.Bt + (size_t)cur.pn * tstepB;
    S.a_ready(cur);
    if constexpr (SP2) {
        PG8_STAGE(PG8_SB(0, 0), cB, voffB); PG8_STAGE(PG8_SB(0, 1), cB + hstepB, voffB); PG8_STAGE(PG8_SA(0, 0), cA, voffA); PG8_STAGE(PG8_SA(0, 1), cA + hstepA, voffA);
        if (wr == 1) PG8_BAR;
        PG8_WAIT_V(2); PG8_BAR;
        PG8_STAGE(PG8_SB(1, 0), cB + kstep, voffB); PG8_STAGE(PG8_SA(1, 0), cA + kstep, voffA); PG8_STAGE(PG8_SB(1, 1), cB + hstepB + kstep, voffB);
        PG8_WAIT_V(6); PG8_BAR;
    } else {
        PG8_STAGE(PG8_SB(0, 0), cB, voffB); PG8_STAGE(PG8_SA(0, 0), cA, voffA); PG8_STAGE(PG8_SB(0, 1), cB + hstepB, voffB); PG8_STAGE(PG8_SA(0, 1), cA + hstepA, voffA);
        if (wr == 1) PG8_BAR;
        PG8_WAIT_V(4); PG8_BAR;
        PG8_STAGE(PG8_SB(1, 0), cB + kstep, voffB); PG8_STAGE(PG8_SA(1, 0), cA + kstep, voffA); PG8_STAGE(PG8_SB(1, 1), cB + hstepB + kstep, voffB);
        PG8_WAIT_V(6); PG8_BAR;
    }
    for (;;) {
        const bool has_next = S.next(ui + 1, nxt);
        const char* nA = has_next ? (const char*)g.A + (size_t)nxt.pm * tstepA : cA; const char* nB = has_next ? (const char*)g.Bt + (size_t)nxt.pn * tstepB : cB;
        for (int t = 0; t < nt; t += 2) {
            const bool last = (t == nt - 2);
            const char* a1 = cA + (size_t)(t + 1) * kstep;
            const char* a2 = last ? nA : cA + (size_t)(t + 2) * kstep; const char* b2 = last ? nB : cB + (size_t)(t + 2) * kstep;
            const char* a3 = a2 + kstep; const char* b3 = b2 + kstep;
            if (last && has_next) S.a_ready(nxt);
            if constexpr (SP2) {
            PG8_LDB(B0, 0, 0); PG8_LDB(B1, 0, 1); PG8_SCHED; PG8_LDA(At, 0, 0); PG8_STAGE(PG8_SA(1, 1), a1 + hstepA, voffA);
            PG8_WAIT_V(8); PG8_WAIT_L(0); PG8_BAR; PG8_MMA(0, 0, At, B0); PG8_MMA(0, 1, At, B1); PG8_BAR; PG8_SCHED;
            PG8_LDA(At, 0, 1); PG8_STAGE(PG8_SB(0, 0), b2, voffB); PG8_STAGE(PG8_SB(0, 1), b2 + hstepB, voffB); PG8_STAGE(PG8_SA(0, 0), a2, voffA);
            PG8_WAIT_V(8); PG8_WAIT_L(0); PG8_BAR; PG8_MMA(1, 0, At, B0); PG8_MMA(1, 1, At, B1); PG8_BAR; PG8_SCHED;
            PG8_LDB(B0, 1, 0); PG8_LDB(B1, 1, 1); PG8_SCHED; PG8_LDA(At, 1, 0); PG8_STAGE(PG8_SA(0, 1), a2 + hstepA, voffA);
            PG8_WAIT_V(8); PG8_WAIT_L(0); PG8_BAR; PG8_MMA(0, 0, At, B0); PG8_MMA(0, 1, At, B1); PG8_BAR; PG8_SCHED;
            PG8_LDA(At, 1, 1); PG8_STAGE(PG8_SB(1, 0), b3, voffB); PG8_STAGE(PG8_SB(1, 1), b3 + hstepB, voffB); PG8_STAGE(PG8_SA(1, 0), a3, voffA);
            PG8_WAIT_V(8); PG8_WAIT_L(0); PG8_BAR; PG8_MMA(1, 0, At, B0); PG8_MMA(1, 1, At, B1); PG8_BAR; PG8_SCHED;
            } else {
            PG8_LDB(B0, 0, 0); PG8_SCHED; PG8_LDA(At, 0, 0); PG8_STAGE(PG8_SA(1, 1), a1 + hstepA, voffA);
            PG8_WAIT_L(8); PG8_BAR; PG8_WAIT_L(0); PG8_MMA(0, 0, At, B0); PG8_BAR; PG8_SCHED;
            PG8_LDB(B1, 0, 1); PG8_STAGE(PG8_SB(0, 0), b2, voffB);
            PG8_BAR; PG8_WAIT_L(0); PG8_MMA(0, 1, At, B1); PG8_BAR;
            PG8_LDA(At, 0, 1); PG8_STAGE(PG8_SA(0, 0), a2, voffA);
            PG8_BAR; PG8_WAIT_L(0); PG8_MMA(1, 0, At, B0); PG8_BAR; PG8_SCHED;
            PG8_STAGE(PG8_SB(0, 1), b2 + hstepB, voffB);
            PG8_WAIT_V(6); PG8_BAR; PG8_MMA(1, 1, At, B1); PG8_BAR;
            PG8_LDB(B0, 1, 0); PG8_SCHED; PG8_LDA(At, 1, 0); PG8_STAGE(PG8_SA(0, 1), a2 + hstepA, voffA);
            PG8_WAIT_L(8); PG8_BAR; PG8_WAIT_L(0); PG8_MMA(0, 0, At, B0); PG8_BAR; PG8_SCHED;
            PG8_LDB(B1, 1, 1); PG8_STAGE(PG8_SB(1, 0), b3, voffB);
            PG8_BAR; PG8_WAIT_L(0); PG8_MMA(0, 1, At, B1); PG8_BAR;
            PG8_LDA(At, 1, 1); PG8_STAGE(PG8_SA(1, 0), a3, voffA);
            PG8_BAR; PG8_WAIT_L(0); PG8_MMA(1, 0, At, B0); PG8_BAR; PG8_SCHED;
            PG8_STAGE(PG8_SB(1, 1), b3 + hstepB, voffB);
            PG8_WAIT_V(6); PG8_BAR; PG8_MMA(1, 1, At, B1); PG8_BAR;
            }
        }
        if constexpr (ALIGN_EPI) { if (wr == 0) PG8_BAR; }
        if constexpr (!Epi::AFTER_DRAIN) { E(acc, cur, wr, wc, fr, fq); S.done(cur); }
        if (!has_next) break;
#pragma unroll
        for (int a = 0; a < 2; ++a)
#pragma unroll
            for (int b = 0; b < 2; ++b)
#pragma unroll
                for (int m = 0; m < 4; ++m)
#pragma unroll
                    for (int n = 0; n < 2; ++n) acc[a][b][m][n] = (f32x4){0.f, 0.f, 0.f, 0.f};
        cur = nxt; cA = nA; cB = nB; ++ui;
        if constexpr (ALIGN_EPI) { if (wr == 1) PG8_BAR; }
    }
    PG8_WAIT_V(0);
    if constexpr (!ALIGN_EPI) { if (wr == 0) PG8_BAR; }
    PG8_BAR;
    if constexpr (Epi::AFTER_DRAIN) { E.fused(acc, cur, wr, wc, fr, fq, lds, wid, lane); S.done(cur); }
#undef PG8_SA
#undef PG8_SB
#undef PG8_STAGE
#undef PG8_LDA
#undef PG8_LDB
#undef PG8_MMA
#undef PG8_WAIT_V
#undef PG8_WAIT_L
#undef PG8_BAR
#undef PG8_SCHED
}
}

constexpr int NB = 4, SEQ = 4096, DM = 1024, DEPTH = 4, M = NB * SEQ;
constexpr int INC = 7088;
constexpr int NIN = 7168;
constexpr int FFH = 2816, FF2 = 5632;
constexpr int ZP = pg8::ZP, ZSP = pg8::ZSP;
constexpr int Z_FQ = 0, Z_FK = 512, Z_FV = 1024, Z_DQ = 1536, Z_RV = 2048, Z_RQ = 2560, Z_RK = 2816, Z_RG = 3072, Z_ZG = 3584, Z_MRG = 2560;
constexpr int S_IQ = 0, S_DK = 256, S_DV = 320, S_IK = 384, S_IW = 416, S_FF = 424;
constexpr float NORM_EPS = 1e-6f;
constexpr float LOG2E = 1.4426950408889634f;
constexpr float C2 = 0.125f * 1.4426950408889634f;

constexpr size_t MiB = 1u << 20;
constexpr size_t WS_CTL = 0, CTL_ZERO_BYTES = 1 * MiB;
constexpr size_t WS_ROPE64 = 1 * MiB;
constexpr size_t WS_ROPE32 = 2 * MiB;
constexpr size_t WS_LF = 2 * MiB + 512 * 1024;
constexpr size_t WS_CF = 3 * MiB;
constexpr size_t WS_ISG = 3 * MiB + 512 * 1024;
constexpr size_t WS_KD = 4 * MiB;
constexpr size_t WS_VD = 6 * MiB;
constexpr size_t WS_W = 8 * MiB;
constexpr size_t LW_IN = 0, LW_MIX = (size_t)NIN * 1024, LW_O = LW_MIX + 1536 * 1024, LW_FI = LW_O + 1024 * 1024, LW_FO = LW_FI + (size_t)FF2 * 1024, LW_STRIDE = LW_FO + (size_t)FFH * 1024;
constexpr size_t WS_Z = 150 * MiB;
constexpr size_t WS_HDN = 358 * MiB;
constexpr size_t WS_ZS = 390 * MiB;
constexpr size_t WS_END = 422 * MiB;
static_assert(WS_W + DEPTH * LW_STRIDE * 2 <= WS_Z && WS_Z + (size_t)M * ZP * 2 <= WS_HDN && WS_HDN + (size_t)M * 1024 * 2 == WS_ZS && WS_ZS + (size_t)M * ZSP * 4 == WS_END, "d_ws map");
constexpr int CW_BAR = 4096;

constexpr int RING_OFF = 0, RING_BYTES = 131072;
constexpr int LDSCTL_OFF = RING_BYTES, MISC_OFF = LDSCTL_OFF + 320;
constexpr int XTRA_OFF = RING_BYTES + 1024;
constexpr int LDS_BYTES = 147456;
constexpr int NWAVES = 8;
#define GAS __attribute__((address_space(1)))
#define LAS __attribute__((address_space(3)))
typedef unsigned short bf16;
typedef unsigned v4u __attribute__((ext_vector_type(4)));
typedef float f32x4 __attribute__((ext_vector_type(4)));
typedef short bf16x8 __attribute__((ext_vector_type(8)));
typedef GAS unsigned gu32;
typedef GAS unsigned long long gu64;
#define RLX_AGENT __ATOMIC_RELAXED, __HIP_MEMORY_SCOPE_AGENT
#define LDS_WAIT() asm volatile("s_waitcnt lgkmcnt(0)" ::: "memory")
#define VM_WAIT() asm volatile("s_waitcnt vmcnt(0)" ::: "memory")
__device__ __forceinline__ unsigned long long rt() { return __builtin_amdgcn_s_memrealtime(); }
__device__ __forceinline__ unsigned f2bf(float f) { unsigned u = __builtin_bit_cast(unsigned, f); return (u + 0x7fffu + ((u >> 16) & 1u)) >> 16; }
__device__ __forceinline__ unsigned pk2(float lo, float hi) { return f2bf(lo) | (f2bf(hi) << 16); }

#define XB_TMO      128
#define XB_XCNT(j)  (256  + 64 * (j))
#define XB_XSUB(j)  (1280 + 64 * (j))
#define XB_XGEN(j)  (2304 + 64 * (j))
#define XB_TOP      3328
#define XB_TOPGEN   3392
#define XCD_BAR_WORDS 3456
#define XB_SPIN_CAP (1u << 22)

__device__ __forceinline__ unsigned xb_ld(unsigned* p)              { return __hip_atomic_load(p, __ATOMIC_RELAXED, __HIP_MEMORY_SCOPE_AGENT); }
__device__ __forceinline__ unsigned xb_add(unsigned* p, unsigned v) { return __hip_atomic_fetch_add(p, v, __ATOMIC_RELAXED, __HIP_MEMORY_SCOPE_AGENT); }
__device__ __forceinline__ unsigned xb_xcc_id() { return (unsigned)__builtin_amdgcn_s_getreg((3 << 11) | 20) & 0xFu; }
#define XB_SPIN(cond, bar) do { unsigned _sp = 0; while (cond) { __builtin_amdgcn_s_sleep(1); \
    if ((++_sp & 255u) == 0u) { if (xb_ld(&(bar)[XB_TMO])) break; if (_sp > XB_SPIN_CAP) { atomicAdd(&(bar)[XB_TMO], 1u); break; } } } } while (0)

struct XcdBarrier {
    unsigned* bar; unsigned x; int w;
    volatile LAS unsigned* st;
};

__device__ __forceinline__ XcdBarrier xcd_barrier_post(unsigned* bar, volatile LAS unsigned* st) {
    XcdBarrier b; b.bar = bar; b.x = xb_xcc_id(); b.st = st; b.w = 0;
    if (threadIdx.x == 0) (void)xb_add(&bar[XB_XCNT(b.x)], 1u);
    return b;
}
__device__ __forceinline__ void xcd_barrier_complete(unsigned* bar, unsigned x, unsigned& nloc, unsigned& nx) {
    const unsigned G = gridDim.x * gridDim.y * gridDim.z;
    unsigned sum, cnt, mine, sp = 0u;
    for (;;) {
        sum = 0u; cnt = 0u; mine = 0u;
#pragma unroll
        for (unsigned j = 0; j < 16; ++j) { const unsigned c = xb_ld(&bar[XB_XCNT(j)]); sum += c; cnt += (c > 0u) ? 1u : 0u; mine = (j == x) ? c : mine; }
        if (sum == G) break;
        __builtin_amdgcn_s_sleep(1);
        if ((++sp & 255u) == 0u) { if (xb_ld(&bar[XB_TMO])) break; if (sp > XB_SPIN_CAP) { atomicAdd(&bar[XB_TMO], 1u); break; } }
    }
    nloc = mine > 0u ? mine : 1u; nx = cnt > 0u ? cnt : 1u;
}

__device__ __forceinline__ void xcd_barrier(const XcdBarrier& b) {
    asm volatile("s_waitcnt vmcnt(0)" ::: "memory");
    __syncthreads();
    if (b.w == 0 && lane_id_v() == 0) {
        unsigned* bar = b.bar;
        __builtin_amdgcn_s_waitcnt(0);
        unsigned nloc = b.st[0], nx = b.st[1];
        if (nloc == 0u) { xcd_barrier_complete(bar, b.x, nloc, nx); b.st[0] = nloc; b.st[1] = nx; }
        const unsigned old = xb_add(&bar[XB_XSUB(b.x)], 1u);
        const unsigned gen = old / nloc;
        if (old + 1u == (gen + 1u) * nloc) {
            __builtin_amdgcn_fence(__ATOMIC_RELEASE, "agent");
            asm volatile("s_waitcnt vmcnt(0)" ::: "memory");
            const unsigned og = xb_add(&bar[XB_TOP], 1u);
            const unsigned tg = og / nx;
            if (og + 1u == (tg + 1u) * nx) xb_add(&bar[XB_TOPGEN], 1u);
            else XB_SPIN(xb_ld(&bar[XB_TOPGEN]) == tg, bar);
            __builtin_amdgcn_fence(__ATOMIC_ACQUIRE, "agent");
            xb_add(&bar[XB_XGEN(b.x)], 1u);
            asm volatile("s_waitcnt vmcnt(0)" ::: "memory");
        } else {
            XB_SPIN(xb_ld(&bar[XB_XGEN(b.x)]) == gen, bar);
            __builtin_amdgcn_fence(__ATOMIC_ACQUIRE, "agent");
            asm volatile("s_waitcnt vmcnt(0)" ::: "memory");
        }
    }
    __syncthreads();
}

typedef float f32x2 __attribute__((ext_vector_type(2)));
typedef unsigned u32x2 __attribute__((ext_vector_type(2)));
__device__ __forceinline__ float bflo(unsigned w) { return __builtin_bit_cast(float, w << 16); }
__device__ __forceinline__ float bfhi(unsigned w) { return __builtin_bit_cast(float, w & 0xffff0000u); }
__device__ __forceinline__ float bf2f(bf16 v) { return __builtin_bit_cast(float, (unsigned)v << 16); }
__device__ __forceinline__ void unpack8(const v4u w, float (&f)[8]) { f[0] = bflo(w.x); f[1] = bfhi(w.x); f[2] = bflo(w.y); f[3] = bfhi(w.y); f[4] = bflo(w.z); f[5] = bfhi(w.z); f[6] = bflo(w.w); f[7] = bfhi(w.w); }
__device__ __forceinline__ v4u pack8(const float (&f)[8]) { v4u w; w.x = pk2(f[0], f[1]); w.y = pk2(f[2], f[3]); w.z = pk2(f[4], f[5]); w.w = pk2(f[6], f[7]); return w; }
template <int MASK> __device__ __forceinline__ float sx(float v) { static_assert(MASK < 32, "swizzle xor mask"); return __builtin_bit_cast(float, __builtin_amdgcn_ds_swizzle(__builtin_bit_cast(int, v), 0x1F | (MASK << 10))); }
template <int MASK> __device__ __forceinline__ unsigned sxu(unsigned v) { return (unsigned)__builtin_amdgcn_ds_swizzle((int)v, 0x1F | (MASK << 10)); }
__device__ __forceinline__ void swap32(unsigned x, unsigned& lo_view, unsigned& hi_view) {
    unsigned a = x, b = x; asm volatile("" : "+v"(b));
    const auto rr = __builtin_amdgcn_permlane32_swap(a, b, false, false);
    lo_view = rr[0]; hi_view = rr[1];
}
__device__ __forceinline__ float wave_sum(float v) {
    v += sx<1>(v); v += sx<2>(v); v += sx<4>(v); v += sx<8>(v); v += sx<16>(v);
    return __builtin_bit_cast(float, __builtin_amdgcn_readlane(__builtin_bit_cast(int, v), 0)) + __builtin_bit_cast(float, __builtin_amdgcn_readlane(__builtin_bit_cast(int, v), 32));
}
__device__ __forceinline__ float wave_max(float v) {
    v = fmaxf(v, sx<1>(v)); v = fmaxf(v, sx<2>(v)); v = fmaxf(v, sx<4>(v)); v = fmaxf(v, sx<8>(v)); v = fmaxf(v, sx<16>(v));
    return fmaxf(__builtin_bit_cast(float, __builtin_amdgcn_readlane(__builtin_bit_cast(int, v), 0)), __builtin_bit_cast(float, __builtin_amdgcn_readlane(__builtin_bit_cast(int, v), 32)));
}
__device__ __forceinline__ float half_sum(float v) {
    unsigned a, b; swap32(__builtin_bit_cast(unsigned, v), a, b); return __builtin_bit_cast(float, a) + __builtin_bit_cast(float, b);
}
__device__ __forceinline__ float half_max(float v) {
    unsigned a, b; swap32(__builtin_bit_cast(unsigned, v), a, b); return fmaxf(__builtin_bit_cast(float, a), __builtin_bit_cast(float, b));
}
__device__ __forceinline__ float xor32(float v, int lane) {
    return __builtin_bit_cast(float, __builtin_amdgcn_ds_bpermute((lane ^ 32) << 2, __builtin_bit_cast(int, v)));
}
__device__ __forceinline__ float sigmoid_f(float x) { return 1.0f / (1.0f + __expf(-x)); }

struct Ctx {
    LAS unsigned char* lds;
    int tid, lane, wave, G, gw, NGW;
    float* out; unsigned char* ws;
};

__device__ __forceinline__ void conv_item(const float* W, int N, int sc, int nv, int k0, bf16* WT, int ldw, int dr, LAS float* scr, int lane) {
    const int n_ = lane & 31;
#pragma unroll 8
    for (int i = 0; i < 32; ++i) { const int kk = 2 * i + (lane >> 5); scr[kk * 33 + n_] = (n_ < nv) ? W[(size_t)(k0 + kk) * N + sc + n_] : 0.f; }
    LDS_WAIT(); asm volatile("" ::: "memory");
    const int c = lane & 7;
#pragma unroll
    for (int j = 0; j < 4; ++j) { const int n = (lane >> 3) + 8 * j; const LAS float* s = scr + (8 * c) * 33 + n;
        v4u o; o.x = pk2(s[0 * 33], s[1 * 33]); o.y = pk2(s[2 * 33], s[3 * 33]); o.z = pk2(s[4 * 33], s[5 * 33]); o.w = pk2(s[6 * 33], s[7 * 33]);
        if (n < nv) *(GAS v4u*)(WT + (size_t)(dr + n) * ldw + k0 + 8 * c) = o; }
    LDS_WAIT(); asm volatile("" ::: "memory");
}
__device__ const int SEG_IN[15][3] = {
    {0, 0, 512}, {512, 512, 512}, {1024, 1024, 512}, {1536, 6656 + S_FF, 8}, {1544, Z_DQ, 512}, {2056, 6656 + S_DK, 64}, {2120, 6656 + S_DV, 64},
    {2184, 6656 + S_IQ, 256}, {2440, 6656 + S_IK, 32}, {2472, 6656 + S_IW, 8}, {2480, Z_RQ, 256}, {2736, Z_RK, 256}, {2992, Z_RV, 512}, {3504, Z_RG, 512}, {4016, Z_ZG, 3072}};
constexpr int IN_BLK = 223;
constexpr int IT_IN = 16 * IN_BLK, IT_MIX = 8 * 32, IT_O = 16 * 32, IT_FI = 16 * (FF2 / 32), IT_FO = (FFH / 64) * 32;
constexpr int IT_LAYER = IT_IN + 3 * IT_MIX + IT_O + IT_FI + IT_FO;

__device__ __forceinline__ void sincos_acc(float ang, float& c, float& s) {
    const double a = (double)ang;
    const double k = __builtin_rint(a * 0.6366197723675814);
    double y = a - k * 1.5707963267948966; y -= k * 6.123233995736766e-17;
    const double y2 = y * y;
    double sp = -7.647163731819816e-13; sp = sp * y2 + 1.6059043836821613e-10; sp = sp * y2 - 2.505210838544172e-08; sp = sp * y2 + 2.7557319223985893e-06; sp = sp * y2 - 1.984126984126984e-04; sp = sp * y2 + 8.333333333333333e-03; sp = sp * y2 - 1.6666666666666666e-01;
    const double sn = y + y * y2 * sp;
    double cp = 4.779477332387385e-14; cp = cp * y2 - 1.1470745597729725e-11; cp = cp * y2 + 2.08767569878681e-09; cp = cp * y2 - 2.755731922398589e-07; cp = cp * y2 + 2.48015873015873e-05; cp = cp * y2 - 1.388888888888889e-03; cp = cp * y2 + 4.1666666666666664e-02; cp = cp * y2 - 0.5;
    const double cs = 1.0 + y2 * cp;
    const int q = ((int)k) & 3;
    const double ss = (q & 1) ? cs : sn, cc = (q & 1) ? sn : cs;
    s = (float)((q & 2) ? -ss : ss);
    c = (float)(((q + 1) & 2) ? -cc : cc);
}

__device__ __forceinline__ void p0_prologue(const Ctx& F, const float* w_in, const float* w_fox, const float* w_dsa, const float* w_ret, const float* w_o, const float* w_fi, const float* w_fo) {
    LAS float* scr = (LAS float*)(F.lds + RING_OFF + F.wave * 16384);
    bf16* Wb = (bf16*)(F.ws + WS_W);
    for (int it = F.gw; it < DEPTH * IT_LAYER; it += F.NGW) {
        const int l = it / IT_LAYER; int r = it % IT_LAYER;
        bf16* L = Wb + (size_t)l * LW_STRIDE;
        if (r < IT_IN) {
            const int kb = r / IN_BLK; int blk = r % IN_BLK; int sc = 0, dr = 0, nv = 0;
            for (int s = 0; s < 15; ++s) { const int w = SEG_IN[s][2], nb = (w + 31) >> 5; if (blk < nb) { sc = SEG_IN[s][0] + 32 * blk; dr = SEG_IN[s][1] + 32 * blk; nv = (w - 32 * blk) < 32 ? (w - 32 * blk) : 32; break; } blk -= nb; }
            conv_item(w_in + (size_t)l * DM * INC, INC, sc, nv, 64 * kb, L + LW_IN, 1024, dr, scr, F.lane); continue; }
        r -= IT_IN;
        if (r < 3 * IT_MIX) { const int w = r / IT_MIX, q = r % IT_MIX, kb = q / 32, nb = q % 32;
            conv_item((w == 0 ? w_fox : w == 1 ? w_dsa : w_ret) + (size_t)l * 512 * DM, DM, 32 * nb, 32, 64 * kb, L + LW_MIX + (size_t)w * 512 * 1024, 512, 32 * nb, scr, F.lane); continue; }
        r -= 3 * IT_MIX;
        if (r < IT_O) { const int kb = r / 32, nb = r % 32;
            conv_item(w_o + (size_t)l * DM * DM, DM, 32 * nb, 32, 64 * kb, L + LW_O, 1024, 32 * nb, scr, F.lane); continue; }
        r -= IT_O;
        if (r < IT_FI) { const int kb = r / (FF2 / 32), nb = r % (FF2 / 32); const int n0 = 32 * nb;
            const int j = n0 < FFH ? n0 : n0 - FFH; const int dr = 256 * (j >> 7) + (j & 127) + (n0 < FFH ? 0 : 128);
            conv_item(w_fi + (size_t)l * DM * FF2, FF2, n0, 32, 64 * kb, L + LW_FI, 1024, dr, scr, F.lane); continue; }
        r -= IT_FI;
        { const int kb = r / 32, nb = r % 32;
            conv_item(w_fo + (size_t)l * FFH * DM, DM, 32 * nb, 32, 64 * kb, L + LW_FO, FFH, 32 * nb, scr, F.lane); }
    }
    for (int i = F.gw * 64 + F.lane; i < DEPTH * 80 * 128; i += F.NGW * 64) { const int l = i / (80 * 128), q = i % (80 * 128);
        *(GAS v4u*)(Wb + (size_t)l * LW_STRIDE + LW_IN + (size_t)INC * 1024 + (size_t)q * 8) = (v4u){0u, 0u, 0u, 0u}; }
    f32x2* R64 = (f32x2*)(F.ws + WS_ROPE64); f32x2* R32 = (f32x2*)(F.ws + WS_ROPE32);
    for (int i = F.gw * 64 + F.lane; i < SEQ * 32; i += F.NGW * 64) { const int pos = i >> 5, k = i & 31;
        double f = 1.0; for (int e = 0; e < k; ++e) f *= 0.7498942093324559;
        const float ang = (float)pos * (float)f; float c, s; sincos_acc(ang, c, s); R64[i] = (f32x2){c, s}; }
    for (int i = F.gw * 64 + F.lane; i < SEQ * 16; i += F.NGW * 64) { const int pos = i >> 4, k = i & 15;
        double f = 1.0; for (int e = 0; e < k; ++e) f *= 0.5623413251903491;
        const float ang = (float)pos * (float)f; float c, s; sincos_acc(ang, c, s); R32[i] = (f32x2){c, s}; }
}

__device__ __forceinline__ void rmsnorm_phase(const Ctx& F, const float* x, const float* g, bf16* o) {
    const GAS f32x4* gp = (const GAS f32x4*)g + F.lane;
    f32x4 gv[4];
#pragma unroll
    for (int j = 0; j < 4; ++j) gv[j] = gp[64 * j];
    for (int m = F.gw; m < M; m += F.NGW) {
        const GAS f32x4* xr = (const GAS f32x4*)(x + (size_t)m * DM) + F.lane;
        f32x4 v[4]; float s = 0.f;
#pragma unroll
        for (int j = 0; j < 4; ++j) { v[j] = xr[64 * j]; s += (v[j].x * v[j].x + v[j].y * v[j].y) + (v[j].z * v[j].z + v[j].w * v[j].w); }
        const float rstd = 1.0f / sqrtf(wave_sum(s) * (1.f / DM) + NORM_EPS);
        GAS unsigned long long* o8 = (GAS unsigned long long*)(o + (size_t)m * DM) + F.lane;
#pragma unroll
        for (int j = 0; j < 4; ++j) o8[64 * j] = (unsigned long long)pk2(v[j].x * rstd * gv[j].x, v[j].y * rstd * gv[j].y) | ((unsigned long long)pk2(v[j].z * rstd * gv[j].z, v[j].w * rstd * gv[j].w) << 32);
    }
}

__device__ __forceinline__ void post_phase(const Ctx& F, const float* g_fq, const float* g_fk, const float* g_dq, const float* g_dk, const float* b_f) {
    bf16* Z = (bf16*)(F.ws + WS_Z); float* ZS = (float*)(F.ws + WS_ZS);
    const f32x2* R64 = (const f32x2*)(F.ws + WS_ROPE64); const f32x2* R32 = (const f32x2*)(F.ws + WS_ROPE32);
    float* LF = (float*)(F.ws + WS_LF); unsigned* ISG = (unsigned*)(F.ws + WS_ISG);
    bf16* KD = (bf16*)(F.ws + WS_KD); bf16* VD = (bf16*)(F.ws + WS_VD);
    const int lane = F.lane, c8 = lane & 7;
    float gq[8], gk[8], gd[8];
#pragma unroll
    for (int j = 0; j < 8; ++j) { gq[j] = g_fq[c8 * 8 + j]; gk[j] = g_fk[c8 * 8 + j]; gd[j] = g_dq[c8 * 8 + j]; }
    const float gdk = g_dk[lane];
    for (int m = F.gw; m < M; m += F.NGW) {
        const int pos = m & (SEQ - 1);
        bf16* zr = Z + (size_t)m * ZP; float* sr = ZS + (size_t)m * ZSP;
        { v4u w = *(const GAS v4u*)(zr + Z_FQ + 8 * lane); float f[8]; unpack8(w, f); float ss = 0.f;
#pragma unroll
            for (int j = 0; j < 8; ++j) ss += f[j] * f[j];
            ss += sx<1>(ss); ss += sx<2>(ss); ss += sx<4>(ss);
            const float rs = C2 / sqrtf(ss * (1.f / 64) + NORM_EPS);
#pragma unroll
            for (int j = 0; j < 8; ++j) f[j] = f[j] * rs * gq[j];
            *(GAS v4u*)(zr + Z_FQ + 8 * lane) = pack8(f); }
        { v4u w = *(const GAS v4u*)(zr + Z_FK + 8 * lane); float f[8]; unpack8(w, f); float ss = 0.f;
#pragma unroll
            for (int j = 0; j < 8; ++j) ss += f[j] * f[j];
            ss += sx<1>(ss); ss += sx<2>(ss); ss += sx<4>(ss);
            const float rs = 1.0f / sqrtf(ss * (1.f / 64) + NORM_EPS);
#pragma unroll
            for (int j = 0; j < 8; ++j) f[j] = f[j] * rs * gk[j];
            *(GAS v4u*)(zr + Z_FK + 8 * lane) = pack8(f); }
        { v4u w = *(const GAS v4u*)(zr + Z_DQ + 8 * lane); float f[8]; unpack8(w, f); float ss = 0.f;
#pragma unroll
            for (int j = 0; j < 8; ++j) ss += f[j] * f[j];
            ss += sx<1>(ss); ss += sx<2>(ss); ss += sx<4>(ss);
            const float rs = 1.0f / sqrtf(ss * (1.f / 64) + NORM_EPS);
            const f32x2* cs = R64 + pos * 32 + (c8 & 3) * 8;
#pragma unroll
            for (int j = 0; j < 8; ++j) { f[j] = f[j] * rs * gd[j]; }
            float o[8];
#pragma unroll
            for (int j = 0; j < 8; ++j) { const float p = sx<4>(f[j]); const f32x2 t = cs[j]; o[j] = ((c8 < 4) ? (f[j] * t.x - p * t.y) : (f[j] * t.x + p * t.y)) * C2; }
            *(GAS v4u*)(zr + Z_DQ + 8 * lane) = pack8(o); }
#pragma unroll
        for (int which = 0; which < 2; ++which) { bf16* p4 = zr + (which ? Z_RK : Z_RQ) + 4 * lane;
            const u32x2 w = *(const GAS u32x2*)p4; float f[4] = {bflo(w.x), bfhi(w.x), bflo(w.y), bfhi(w.y)};
            const f32x2* cs = R64 + pos * 32 + (lane & 7) * 4; const bool first = (lane & 15) < 8; const float sc = which ? 1.0f : 0.125f; float o[4];
#pragma unroll
            for (int j = 0; j < 4; ++j) { const float p = sx<8>(f[j]); const f32x2 t = cs[j]; o[j] = (first ? (f[j] * t.x - p * t.y) : (f[j] * t.x + p * t.y)) * sc; }
            u32x2 ow; ow.x = pk2(o[0], o[1]); ow.y = pk2(o[2], o[3]); *(GAS u32x2*)p4 = ow; }
        { const f32x4 v = *(const GAS f32x4*)(sr + S_IQ + 4 * lane); float f[4] = {v.x, v.y, v.z, v.w};
            const float iw = sr[S_IW + (lane >> 3)]; const float aw = fabsf(iw);
            const f32x2* cs = R32 + pos * 16 + (lane & 3) * 4; const bool first = (lane & 7) < 4; f32x4 o;
#pragma unroll
            for (int j = 0; j < 4; ++j) { const float p = sx<4>(f[j]); const f32x2 t = cs[j]; o[j] = (first ? (f[j] * t.x - p * t.y) : (f[j] * t.x + p * t.y)) * aw; }
            const unsigned long long neg = __ballot(iw < 0.f);
            unsigned sg = 0;
#pragma unroll
            for (int h = 0; h < 8; ++h) sg |= (unsigned)((neg >> (8 * h)) & 1ull) << h;
            *(GAS f32x4*)(sr + S_IQ + 4 * lane) = o;
            if (lane == 0) ISG[m] = sg; }
        { float v = sr[S_DK + lane]; const float ss = wave_sum(v * v); v = v * (1.0f / sqrtf(ss * (1.f / 64) + NORM_EPS)) * gdk;
            const float p = xor32(v, lane); const f32x2 t = R64[pos * 32 + (lane & 31)];
            const float o = (lane < 32) ? (v * t.x - p * t.y) : (v * t.x + p * t.y);
            KD[(size_t)m * 64 + lane] = (bf16)f2bf(o);
            VD[(size_t)m * 64 + lane] = (bf16)f2bf(sr[S_DV + lane]); }
        { const float v = sr[S_IK + (lane & 31)]; const float p = sx<16>(v); const f32x2 t = R32[pos * 16 + (lane & 15)];
            const float o = ((lane & 16) == 0) ? (v * t.x - p * t.y) : (v * t.x + p * t.y);
            if (lane < 32) sr[S_IK + lane] = o; }
        if (lane < 8) { const float xx = sr[S_FF + lane] + b_f[lane]; const float ls = fminf(xx, 0.f) - __logf(1.0f + __expf(-fabsf(xx))); LF[(size_t)m * 8 + lane] = ls * LOG2E; }
    }
}

__device__ __forceinline__ float ret_l2g(int h) { return h == 0 ? -0.04580368961312479f : h == 1 ? -0.02272007650008353f : h == 2 ? -0.011315313227834146f : -0.005646563141142063f; }

__device__ __forceinline__ void scan_state_phase(const Ctx& F) {
    const float* LF = (const float*)(F.ws + WS_LF); float* CF = (float*)(F.ws + WS_CF);
    const bf16* Z = (const bf16*)(F.ws + WS_Z); float* RS = (float*)(F.ws + WS_HDN);
    if (F.gw < 32) {
        const int b = F.gw >> 3, h = F.gw & 7; const float* lp = LF + ((size_t)b * SEQ + F.lane * 64) * 8 + h; float s = 0.f;
        for (int i = 0; i < 64; ++i) s += lp[i * 8];
        float incl = s;
#pragma unroll
        for (int o = 1; o < 64; o <<= 1) { const float t = __builtin_bit_cast(float, __builtin_amdgcn_ds_bpermute(((F.lane - o) & 63) << 2, __builtin_bit_cast(int, incl))); if (F.lane >= o) incl += t; }
        float run = incl - s; float* cp = CF + (size_t)F.gw * SEQ + F.lane * 64;
        for (int i = 0; i < 64; ++i) { run += lp[i * 8]; cp[i] = run; }
    }
    for (int u = blockIdx.x; u < NB * 32 * 4; u += F.G) {
        const int h = u & 3, c = (u >> 2) & 31, b = u >> 7; const float l2g = ret_l2g(h);
        const int d = F.tid >> 3, e0 = (F.tid & 7) * 16; float acc[16];
#pragma unroll
        for (int i = 0; i < 16; ++i) acc[i] = 0.f;
        const bf16* base = Z + ((size_t)b * SEQ + c * 128) * ZP;
        for (int j = 0; j < 128; ++j) { const bf16* row = base + (size_t)j * ZP;
            const float kd = bf2f(row[Z_RK + h * 64 + d]) * exp2f((float)(127 - j) * l2g);
            const v4u w0 = *(const GAS v4u*)(row + Z_RV + h * 128 + e0), w1 = *(const GAS v4u*)(row + Z_RV + h * 128 + e0 + 8);
            float v0[8], v1[8]; unpack8(w0, v0); unpack8(w1, v1);
#pragma unroll
            for (int i = 0; i < 8; ++i) { acc[i] += kd * v0[i]; acc[8 + i] += kd * v1[i]; } }
        float* o = RS + (size_t)u * 8192 + d * 128 + e0;
#pragma unroll
        for (int i = 0; i < 4; ++i) *(GAS f32x4*)(o + 4 * i) = (f32x4){acc[4 * i], acc[4 * i + 1], acc[4 * i + 2], acc[4 * i + 3]};
    }
}

__device__ __forceinline__ void ret_out_naive(const Ctx& F, const float* gn) {
    bf16* Z = (bf16*)(F.ws + WS_Z); const float* RS = (const float*)(F.ws + WS_HDN);
    LAS float* S = (LAS float*)(F.lds);
    LAS bf16* Vt = (LAS bf16*)(F.lds + 32768);
    LAS float* Kt = (LAS float*)(F.lds + 65536);
    LAS float* aw = (LAS float*)(F.lds + 65536 + 33280) + F.wave * 128;
    LAS float* qw = (LAS float*)(F.lds + 65536 + 33280 + 4096) + F.wave * 64;
    for (int u = blockIdx.x; u < NB * 32 * 4; u += F.G) {
        const int h = u & 3, c = (u >> 2) & 31, b = u >> 7; const float l2g = ret_l2g(h); const float wch = exp2f(128.f * l2g);
        __syncthreads();
        { float s[16];
#pragma unroll
            for (int i = 0; i < 16; ++i) s[i] = 0.f;
            for (int cp = 0; cp < c; ++cp) { const float* L = RS + ((size_t)((b * 32 + cp) * 4 + h)) * 8192 + F.tid;
#pragma unroll
                for (int i = 0; i < 16; ++i) s[i] = wch * s[i] + L[i * 512]; }
#pragma unroll
            for (int i = 0; i < 16; ++i) S[F.tid + i * 512] = s[i]; }
        const bf16* base = Z + ((size_t)b * SEQ + c * 128) * ZP;
        for (int q = F.tid; q < 2048; q += 512) { const int r = q >> 4, ch = q & 15; *(LAS v4u*)(Vt + r * 128 + ch * 8) = *(const GAS v4u*)(base + (size_t)r * ZP + Z_RV + h * 128 + ch * 8); }
        for (int q = F.tid; q < 128 * 64; q += 512) { const int r = q >> 6, dd = q & 63; Kt[r * 65 + dd] = bf2f(base[(size_t)r * ZP + Z_RK + h * 64 + dd]); }
        __syncthreads();
        for (int i = F.wave; i < 128; i += NWAVES) {
            const size_t m = (size_t)b * SEQ + c * 128 + i; bf16* zr = Z + m * ZP;
            qw[F.lane] = bf2f(zr[Z_RQ + h * 64 + F.lane]);
            LDS_WAIT(); asm volatile("" ::: "memory");
#pragma unroll
            for (int jj = 0; jj < 2; ++jj) { const int j = F.lane + 64 * jj; float a = 0.f;
                if (j <= i) { float dot = 0.f; for (int dd = 0; dd < 64; ++dd) dot += qw[dd] * Kt[j * 65 + dd]; a = dot * exp2f((float)(i - j) * l2g); }
                aw[j] = a; }
            LDS_WAIT(); asm volatile("" ::: "memory");
            float o[2]; const float dq = exp2f((float)(i + 1) * l2g);
#pragma unroll
            for (int ee = 0; ee < 2; ++ee) { const int e = F.lane + 64 * ee; float acc = 0.f;
                for (int j = 0; j <= i; ++j) acc += aw[j] * bf2f(Vt[j * 128 + e]);
                float cr = 0.f; for (int dd = 0; dd < 64; ++dd) cr += qw[dd] * S[dd * 128 + e];
                o[ee] = acc + cr * dq; }
            const float ss = wave_sum(o[0] * o[0] + o[1] * o[1]); const float rstd = 1.0f / sqrtf(ss * (1.f / 128) + NORM_EPS);
#pragma unroll
            for (int ee = 0; ee < 2; ++ee) { const int e = F.lane + 64 * ee; const float rg = bf2f(zr[Z_RG + h * 128 + e]);
                zr[Z_RV + h * 128 + e] = (bf16)f2bf(o[ee] * rstd * gn[h * 128 + e] * rg * sigmoid_f(rg)); }
            LDS_WAIT(); asm volatile("" ::: "memory");
        }
    }
    __syncthreads();
}

__device__ __forceinline__ void fox_naive(const Ctx& F) {
    bf16* Z = (bf16*)(F.ws + WS_Z); const float* CF = (const float*)(F.ws + WS_CF);
    LAS float* sc = (LAS float*)(F.lds + F.wave * 16384);
    const int lane = F.lane;
    int it = 0;
    for (int r0 = 0; r0 < NB * 8 * SEQ; r0 += F.NGW, ++it) {
        const int r = r0 + ((it & 1) ? (F.NGW - 1 - F.gw) : F.gw);
        if (r >= NB * 8 * SEQ) continue;
        const int pos = r & (SEQ - 1), h = (r >> 12) & 7, b = r >> 15;
        const size_t m = (size_t)b * SEQ + pos;
        float qf[64];
        { const bf16* qp = Z + m * ZP + Z_FQ + h * 64;
#pragma unroll
            for (int i = 0; i < 8; ++i) { const v4u w = *(const GAS v4u*)(qp + 8 * i); float t[8]; unpack8(w, t);
#pragma unroll
                for (int j = 0; j < 8; ++j) qf[8 * i + j] = t[j]; } }
        const float* cf = CF + (size_t)(b * 8 + h) * SEQ;
        float mx = -INFINITY;
        for (int kk = lane; kk <= pos; kk += 64) { const bf16* kp = Z + ((size_t)b * SEQ + kk) * ZP + Z_FK + h * 64; float dot = 0.f;
#pragma unroll
            for (int i = 0; i < 8; ++i) { const v4u w = *(const GAS v4u*)(kp + 8 * i); float t[8]; unpack8(w, t);
#pragma unroll
                for (int j = 0; j < 8; ++j) dot += qf[8 * i + j] * t[j]; }
            const float s = dot - cf[kk]; sc[kk] = s; mx = fmaxf(mx, s); }
        mx = wave_max(mx);
        float sum = 0.f;
        for (int kk = lane; kk <= pos; kk += 64) { const float p = exp2f(sc[kk] - mx); sc[kk] = p; sum += p; }
        sum = wave_sum(sum);
        LDS_WAIT(); asm volatile("" ::: "memory");
        const bf16* vp = Z + (size_t)b * SEQ * ZP + Z_FV + h * 64 + lane;
        float o0 = 0.f, o1 = 0.f, o2 = 0.f, o3 = 0.f; int kk = 0;
        for (; kk + 3 <= pos; kk += 4) { o0 += sc[kk] * bf2f(vp[(size_t)kk * ZP]); o1 += sc[kk + 1] * bf2f(vp[(size_t)(kk + 1) * ZP]); o2 += sc[kk + 2] * bf2f(vp[(size_t)(kk + 2) * ZP]); o3 += sc[kk + 3] * bf2f(vp[(size_t)(kk + 3) * ZP]); }
        for (; kk <= pos; ++kk) o0 += sc[kk] * bf2f(vp[(size_t)kk * ZP]);
        Z[m * ZP + Z_FQ + h * 64 + lane] = (bf16)f2bf(((o0 + o1) + (o2 + o3)) / sum);
        LDS_WAIT(); asm volatile("" ::: "memory");
    }
}

__device__ __forceinline__ unsigned f2key(float s) { const unsigned u = __builtin_bit_cast(unsigned, s + 0.0f); return (u & 0x80000000u) ? ~u : (u | 0x80000000u); }
__device__ __forceinline__ void dsa_naive(const Ctx& F) {
    bf16* Z = (bf16*)(F.ws + WS_Z); const float* ZS = (const float*)(F.ws + WS_ZS);
    const unsigned* ISG = (const unsigned*)(F.ws + WS_ISG);
    const bf16* KD = (const bf16*)(F.ws + WS_KD); const bf16* VD = (const bf16*)(F.ws + WS_VD);
    LAS unsigned* kl = (LAS unsigned*)(F.lds + F.wave * 16384);
    LAS float* iqs = (LAS float*)(F.lds + XTRA_OFF + F.wave * 1536);
    const int lane = F.lane;
    int it = 0;
    for (int r0 = 0; r0 < M; r0 += F.NGW, ++it) {
        const int r = r0 + ((it & 1) ? (F.NGW - 1 - F.gw) : F.gw);
        if (r >= M) continue;
        const int pos = r & (SEQ - 1), b = r >> 12; const size_t m = (size_t)r;
        *(LAS f32x4*)(iqs + 4 * lane) = *(const GAS f32x4*)(ZS + m * ZSP + S_IQ + 4 * lane);
        const unsigned sg = ISG[m];
        LDS_WAIT(); asm volatile("" ::: "memory");
        for (int kk = lane; kk <= pos; kk += 64) { const float* ikp = ZS + ((size_t)b * SEQ + kk) * ZSP + S_IK; float ik[32];
#pragma unroll
            for (int i = 0; i < 8; ++i) { const f32x4 t = *(const GAS f32x4*)(ikp + 4 * i); ik[4 * i] = t.x; ik[4 * i + 1] = t.y; ik[4 * i + 2] = t.z; ik[4 * i + 3] = t.w; }
            float s = 0.f;
#pragma unroll 1
            for (int h = 0; h < 8; ++h) { float dot = 0.f;
#pragma unroll
                for (int dd = 0; dd < 32; ++dd) dot += iqs[h * 32 + dd] * ik[dd];
                dot = fmaxf(dot, 0.f); s += ((sg >> h) & 1u) ? -dot : dot; }
            kl[kk] = f2key(s); }
        LDS_WAIT(); asm volatile("" ::: "memory");
        unsigned key[64];
#pragma unroll
        for (int j = 0; j < 64; ++j) { const int kk = j * 64 + lane; key[j] = (kk <= pos) ? kl[kk] : 0u; }
        LDS_WAIT(); asm volatile("" ::: "memory");
        LAS unsigned* idx = kl; LAS float* pl = (LAS float*)(kl + 256); LAS bf16* qs = (LAS bf16*)(kl + 512);
        *(LAS v4u*)(qs + 8 * lane) = *(const GAS v4u*)(Z + m * ZP + Z_DQ + 8 * lane);
        unsigned T = 0u; int need = 0;
        if (pos + 1 > 256) {
            for (int bit = 31; bit >= 0; --bit) { const unsigned Tt = T | (1u << bit); int cnt = 0;
#pragma unroll
                for (int j = 0; j < 64; ++j) cnt += __builtin_popcountll(__ballot(key[j] >= Tt));
                if (cnt >= 256) T = Tt; }
            int ngt = 0;
#pragma unroll
            for (int j = 0; j < 64; ++j) ngt += __builtin_popcountll(__ballot(key[j] > T));
            need = 256 - ngt;
        }
        int nsel = 0, eqb = 0;
#pragma unroll
        for (int j = 0; j < 64; ++j) { const bool gt = key[j] > T, eq = (key[j] == T) && (T != 0u);
            const unsigned long long em = __ballot(eq); const int er = eqb + __builtin_amdgcn_mbcnt_hi((unsigned)(em >> 32), __builtin_amdgcn_mbcnt_lo((unsigned)em, 0u));
            const bool sel = gt || (eq && er < need); eqb += __builtin_popcountll(em);
            const unsigned long long sm = __ballot(sel); const int sp = nsel + __builtin_amdgcn_mbcnt_hi((unsigned)(sm >> 32), __builtin_amdgcn_mbcnt_lo((unsigned)sm, 0u));
            if (sel) idx[sp] = (unsigned)(j * 64 + lane); nsel += __builtin_popcountll(sm); }
        LDS_WAIT(); asm volatile("" ::: "memory");
        for (int h = 0; h < 8; ++h) {
            float sv[4]; float mx = -INFINITY;
#pragma unroll
            for (int i = 0; i < 4; ++i) { const int e = lane + 64 * i; sv[i] = -INFINITY;
                if (e < nsel) { const bf16* kp = KD + ((size_t)b * SEQ + idx[e]) * 64; float dot = 0.f;
#pragma unroll
                    for (int c = 0; c < 8; ++c) { const v4u w = *(const GAS v4u*)(kp + 8 * c); float t[8]; unpack8(w, t); const v4u qw = *(const LAS v4u*)(qs + h * 64 + 8 * c); float qq[8]; unpack8(qw, qq);
#pragma unroll
                        for (int j = 0; j < 8; ++j) dot += qq[j] * t[j]; }
                    sv[i] = dot; }
                mx = fmaxf(mx, sv[i]); }
            mx = wave_max(mx); float sum = 0.f;
#pragma unroll
            for (int i = 0; i < 4; ++i) { const int e = lane + 64 * i; const float p = (e < nsel) ? exp2f(sv[i] - mx) : 0.f; pl[e] = p; sum += p; }
            sum = wave_sum(sum);
            LDS_WAIT(); asm volatile("" ::: "memory");
            float o0 = 0.f, o1 = 0.f; int e = 0;
            for (; e + 1 < nsel; e += 2) { o0 += pl[e] * bf2f(VD[((size_t)b * SEQ + idx[e]) * 64 + lane]); o1 += pl[e + 1] * bf2f(VD[((size_t)b * SEQ + idx[e + 1]) * 64 + lane]); }
            if (e < nsel) o0 += pl[e] * bf2f(VD[((size_t)b * SEQ + idx[e]) * 64 + lane]);
            Z[m * ZP + Z_DQ + h * 64 + lane] = (bf16)f2bf((o0 + o1) / sum);
            LDS_WAIT(); asm volatile("" ::: "memory");
        }
    }
}

typedef short s16x8 __attribute__((ext_vector_type(8)));
typedef short s16x4 __attribute__((ext_vector_type(4)));
typedef short v4i16_t __attribute__((ext_vector_type(4)));
__device__ __forceinline__ s16x4 tr16(const LAS unsigned char* p) { return __builtin_bit_cast(s16x4, __builtin_amdgcn_ds_read_tr16_b64_v4i16((LAS v4i16_t*)p)); }
__device__ __forceinline__ float key2f(unsigned k) { return __builtin_bit_cast(float, (k & 0x80000000u) ? (k & 0x7fffffffu) : ~k); }

#define DSA_COUNT_GE(T_, out_) do { int c_ = 0; _Pragma("unroll") for (int j_ = 0; j_ < 64; ++j_) c_ += __builtin_popcountll(__ballot(key[j_] >= (T_))); out_ = c_; } while (0)
__device__ __forceinline__ void dsa_select(const unsigned (&key)[64], int nvalid, unsigned& T, int& need) {
    T = 0u; need = 0;
    if (nvalid <= 256) return;
    unsigned kmax = 0u;
#pragma unroll
    for (int j = 0; j < 64; ++j) kmax = key[j] > kmax ? key[j] : kmax;
#pragma unroll
    for (int o_ = 0; o_ < 1; ++o_) { unsigned t; t = sxu<1>(kmax); kmax = t > kmax ? t : kmax; t = sxu<2>(kmax); kmax = t > kmax ? t : kmax; t = sxu<4>(kmax); kmax = t > kmax ? t : kmax; t = sxu<8>(kmax); kmax = t > kmax ? t : kmax; t = sxu<16>(kmax); kmax = t > kmax ? t : kmax;
        unsigned a_, b_; swap32(kmax, a_, b_); kmax = a_ > b_ ? a_ : b_; }
    unsigned lo = 1u, hi = kmax + 1u; int hic = 0;
    { const float vm = fabsf(key2f(kmax)) + 1.0f; unsigned l2 = f2key(-vm * 64.0f); int c; DSA_COUNT_GE(l2, c); if (c >= 256) lo = l2; }
    int iter = 0; bool exact = false;
    while (hi - lo > 1u) {
        unsigned mid;
        if (iter < 24 && lo > 1u) { const float mv = 0.5f * key2f(lo) + 0.5f * key2f(hi - 1u); mid = f2key(mv); }
        else mid = lo + ((hi - lo) >> 1);
        if (mid <= lo) mid = lo + 1u; if (mid >= hi) mid = hi - 1u;
        int c; DSA_COUNT_GE(mid, c);
        if (c == 256) { T = mid; exact = true; break; }
        if (c > 256) lo = mid; else { hi = mid; hic = c; }
        ++iter;
    }
    if (exact) need = 256; else { T = lo; need = 256 - hic; }
}

__device__ __forceinline__ void dsa_attend(const bf16* zq, bf16* zo, const bf16* KDb, const bf16* VDb, const LAS unsigned short* idx, int nsel, LAS unsigned char* vst, int lane) {
    const int g = lane >> 4, c = lane & 15;
    s16x8 qf[2];
#pragma unroll
    for (int ks = 0; ks < 2; ++ks) { qf[ks] = (s16x8){0, 0, 0, 0, 0, 0, 0, 0}; if (c < 8) qf[ks] = *(const GAS s16x8*)(zq + c * 64 + 32 * ks + 8 * g); }
    f32x4 acc[16];
#pragma unroll
    for (int tb = 0; tb < 4; ++tb) {
        s16x8 kf[4][2];
#pragma unroll
        for (int tt = 0; tt < 4; ++tt) { const int e = 16 * (4 * tb + tt) + c; const int id = (e < nsel) ? (int)idx[e] : 0; const bf16* kp = KDb + (size_t)id * 64 + 8 * g;
            kf[tt][0] = *(const GAS s16x8*)kp; kf[tt][1] = *(const GAS s16x8*)(kp + 32); }
#pragma unroll
        for (int tt = 0; tt < 4; ++tt) { f32x4 a = (f32x4){0.f, 0.f, 0.f, 0.f};
            a = __builtin_amdgcn_mfma_f32_16x16x32_bf16(kf[tt][0], qf[0], a, 0, 0, 0); a = __builtin_amdgcn_mfma_f32_16x16x32_bf16(kf[tt][1], qf[1], a, 0, 0, 0); acc[4 * tb + tt] = a; }
    }
    float mx = -INFINITY;
#pragma unroll
    for (int t = 0; t < 16; ++t)
#pragma unroll
        for (int i = 0; i < 4; ++i) { const int e = 16 * t + 4 * g + i; if (e >= nsel) acc[t][i] = -INFINITY; mx = fmaxf(mx, acc[t][i]); }
    mx = fmaxf(mx, sx<16>(mx)); mx = half_max(mx);
    float sum = 0.f;
#pragma unroll
    for (int t = 0; t < 16; ++t)
#pragma unroll
        for (int i = 0; i < 4; ++i) { const float p = exp2f(acc[t][i] - mx); acc[t][i] = p; sum += p; }
    sum += sx<16>(sum); sum = half_sum(sum);
    const float inv = 1.0f / sum;
    s16x8 pf[8];
#pragma unroll
    for (int s = 0; s < 8; ++s) { v4u w; w.x = pk2(acc[2 * s][0] * inv, acc[2 * s][1] * inv); w.y = pk2(acc[2 * s][2] * inv, acc[2 * s][3] * inv); w.z = pk2(acc[2 * s + 1][0] * inv, acc[2 * s + 1][1] * inv); w.w = pk2(acc[2 * s + 1][2] * inv, acc[2 * s + 1][3] * inv);
        pf[s] = __builtin_bit_cast(s16x8, w); }
    f32x4 o[4];
#pragma unroll
    for (int db = 0; db < 4; ++db) o[db] = (f32x4){0.f, 0.f, 0.f, 0.f};
    const int q = (lane >> 2) & 3, p = lane & 3, swz = 2 * (g & 1) + (q >> 1);
    const LAS unsigned char* rb = vst + (4 * g + q) * 128 + 8 * p;
#pragma unroll
    for (int hh = 0; hh < 2; ++hh) {
        asm volatile("s_waitcnt lgkmcnt(0)" ::: "memory");
#pragma unroll
        for (int i = 0; i < 16; ++i) { const int pi = lane + 64 * i, r = pi >> 3, c16 = pi & 7, e = 128 * hh + r; const int id = (e < nsel) ? (int)idx[e] : 0;
            const v4u v = *(const GAS v4u*)(VDb + (size_t)id * 64 + c16 * 8);
            *(LAS v4u*)(vst + r * 128 + ((((c16 >> 1) ^ ((r >> 1) & 3))) << 5) + ((c16 & 1) << 4)) = v; }
        asm volatile("s_waitcnt lgkmcnt(0)" ::: "memory");
#pragma unroll
        for (int s4 = 0; s4 < 4; ++s4)
#pragma unroll
            for (int db = 0; db < 4; ++db) { const LAS unsigned char* a1 = rb + s4 * 4096 + ((db ^ swz) << 5);
                const s16x4 lo = tr16(a1), hi = tr16(a1 + 2048);
                const s16x8 vf = (s16x8){lo[0], lo[1], lo[2], lo[3], hi[0], hi[1], hi[2], hi[3]};
                o[db] = __builtin_amdgcn_mfma_f32_16x16x32_bf16(pf[4 * hh + s4], vf, o[db], 0, 0, 0); }
    }
    if (g < 2) {
#pragma unroll
        for (int db = 0; db < 4; ++db)
#pragma unroll
            for (int i = 0; i < 4; ++i) zo[(4 * g + i) * 64 + 16 * db + c] = (bf16)f2bf(o[db][i]);
    }
}

__device__ __forceinline__ void dsa_v2(const Ctx& F) {
    bf16* Z = (bf16*)(F.ws + WS_Z); const float* ZS = (const float*)(F.ws + WS_ZS);
    const unsigned* ISG = (const unsigned*)(F.ws + WS_ISG);
    const bf16* KD = (const bf16*)(F.ws + WS_KD); const bf16* VD = (const bf16*)(F.ws + WS_VD);
    LAS unsigned* kl = (LAS unsigned*)(F.lds + F.wave * 16384);
    LAS float* iqs = (LAS float*)(F.lds + XTRA_OFF + F.wave * 1536);
    LAS unsigned short* idx = (LAS unsigned short*)(F.lds + XTRA_OFF + F.wave * 1536 + 1024);
    const int lane = F.lane;
    int it = 0;
    for (int r0 = 0; r0 < M; r0 += F.NGW, ++it) {
        const int r = r0 + ((it & 1) ? (F.NGW - 1 - F.gw) : F.gw);
        if (r >= M) continue;
        const int pos = r & (SEQ - 1), b = r >> 12; const size_t m = (size_t)r;
        *(LAS f32x4*)(iqs + 4 * lane) = *(const GAS f32x4*)(ZS + m * ZSP + S_IQ + 4 * lane);
        const unsigned sg = ISG[m];
        LDS_WAIT(); asm volatile("" ::: "memory");
        for (int kk = lane; kk <= pos; kk += 64) { const float* ikp = ZS + ((size_t)b * SEQ + kk) * ZSP + S_IK; float ik[32];
#pragma unroll
            for (int i = 0; i < 8; ++i) { const f32x4 t = *(const GAS f32x4*)(ikp + 4 * i); ik[4 * i] = t.x; ik[4 * i + 1] = t.y; ik[4 * i + 2] = t.z; ik[4 * i + 3] = t.w; }
            float s = 0.f;
#pragma unroll 1
            for (int h = 0; h < 8; ++h) { float dot = 0.f;
#pragma unroll
                for (int dd = 0; dd < 32; ++dd) dot += iqs[h * 32 + dd] * ik[dd];
                dot = fmaxf(dot, 0.f); s += ((sg >> h) & 1u) ? -dot : dot; }
            kl[kk] = f2key(s); }
        LDS_WAIT(); asm volatile("" ::: "memory");
        unsigned key[64];
#pragma unroll
        for (int j = 0; j < 64; ++j) { const int kk = j * 64 + lane; key[j] = (kk <= pos) ? kl[kk] : 0u; }
        LDS_WAIT(); asm volatile("" ::: "memory");
        unsigned T; int need;
#ifdef DSA_OLDSEL
        T = 0u; need = 0;
        if (pos + 1 > 256) {
            for (int bit = 31; bit >= 0; --bit) { const unsigned Tt = T | (1u << bit); int cnt = 0;
#pragma unroll
                for (int j = 0; j < 64; ++j) cnt += __builtin_popcountll(__ballot(key[j] >= Tt));
                if (cnt >= 256) T = Tt; }
            int ngt = 0;
#pragma unroll
            for (int j = 0; j < 64; ++j) ngt += __builtin_popcountll(__ballot(key[j] > T));
            need = 256 - ngt;
        }
#else
        dsa_select(key, pos + 1, T, need);
#endif
        int nsel = 0, eqb = 0;
#pragma unroll
        for (int j = 0; j < 64; ++j) { const bool gt = key[j] > T, eq = (key[j] == T) && (T != 0u);
            const unsigned long long em = __ballot(eq); const int er = eqb + __builtin_amdgcn_mbcnt_hi((unsigned)(em >> 32), __builtin_amdgcn_mbcnt_lo((unsigned)em, 0u));
            const bool sel = gt || (eq && er < need); eqb += __builtin_popcountll(em);
            const unsigned long long sm = __ballot(sel); const int sp = nsel + __builtin_amdgcn_mbcnt_hi((unsigned)(sm >> 32), __builtin_amdgcn_mbcnt_lo((unsigned)sm, 0u));
            if (sel) idx[sp] = (unsigned short)(j * 64 + lane); nsel += __builtin_popcountll(sm); }
        LDS_WAIT(); asm volatile("" ::: "memory");
        dsa_attend(Z + m * ZP + Z_DQ, Z + m * ZP + Z_DQ, KD + (size_t)b * SEQ * 64, VD + (size_t)b * SEQ * 64, idx, nsel, (LAS unsigned char*)kl, lane);
        LDS_WAIT(); asm volatile("" ::: "memory");
    }
}
#include <hip/hip_bf16.h>
#include <cmath>
namespace attn_body {
using bf16=__hip_bfloat16;
using bf16x8=__attribute__((ext_vector_type(8)))short;
using s16x4=__attribute__((ext_vector_type(4)))short;
using f32x16=__attribute__((ext_vector_type(16)))float;
using u32x4=__attribute__((ext_vector_type(4)))unsigned;
constexpr int BATCH=4,NHEAD=8,SEQ=4096,D=64,DM=6656;
constexpr int NW=8,QBLK=32,QB=QBLK*NW,KVBLK=64,NQB=SEQ/QB;
constexpr int ATTN_PITCH=DM, ATTN_UNIT_ROWS=QB;
__device__ __forceinline__ int crow(int r,int hi){return (r&3)+8*(r>>2)+4*hi;}
#define SBAR() __builtin_amdgcn_sched_barrier(0)
__device__ __forceinline__ void cmask(f32x16&p0,f32x16&p1,int jb,int qrel,int hi){
  const float NEG=-INFINITY; int kb=64*jb+4*hi;
  #pragma unroll
  for(int r=0;r<16;++r){int kv=kb+(r&3)+8*(r>>2); if(kv>qrel)p0[r]=NEG; if(kv+32>qrel)p1[r]=NEG;}
}

constexpr int NSLOT=3, SLOTB=8192;
constexpr int LDS_K=0, LDS_V=NSLOT*SLOTB, LDS_WS=2*NSLOT*SLOTB, LDS_OST=LDS_WS+NW*64*4, LDS_NC=LDS_OST+NW*4096, LDS_BYTES=LDS_NC+SEQ*4;
constexpr float C2=0.125f*1.4426950408889634f;
__device__ __forceinline__ void glds16(const void*gsrc,unsigned lds_dst){unsigned keep;
  asm volatile("s_mov_b32 %0, m0\n\ts_mov_b32 m0, %2\n\ts_nop 0\n\tglobal_load_lds_dwordx4 %1, off\n\ts_mov_b32 m0, %0":"=&s"(keep):"v"(gsrc),"s"(lds_dst):"memory");}
__device__ __forceinline__ float max3f(float a,float b,float c){float r;asm("v_max3_f32 %0, %1, %2, %3":"=v"(r):"v"(a),"v"(b),"v"(c));return r;}
__device__ __forceinline__ float max2f(float a,float b){float r;asm("v_max_f32_e32 %0, %1, %2":"=v"(r):"v"(a),"v"(b));return r;}
__device__ __forceinline__ float fadd_s(float a,float b){float r;asm("v_add_f32_e32 %0, %1, %2":"=v"(r):"v"(a),"v"(b));return r;}
__device__ __forceinline__ float fsub_s(float a,float b){float r;asm("v_sub_f32_e32 %0, %1, %2":"=v"(r):"v"(a),"v"(b));return r;}
typedef float f32x4_t __attribute__((ext_vector_type(4))); typedef float f32x2_t __attribute__((ext_vector_type(2))); typedef __bf16 bf16x2_t __attribute__((ext_vector_type(2)));
__device__ __forceinline__ unsigned cvtpk_s(float lo,float hi){f32x2_t v={lo,hi};bf16x2_t b=__builtin_convertvector(v,bf16x2_t);return __builtin_bit_cast(unsigned,b);}
#define WAIT_BAR(N) asm volatile("s_waitcnt vmcnt(" #N ") lgkmcnt(0)\n\ts_barrier":::"memory")

__device__ __forceinline__ void qkt(f32x16&p0,f32x16&p1,const char*Kslot,const bf16x8*qr,const f32x16&negm,int r32,int hi){
  const char*kb=Kslot+hi*1024+r32*16;
  #pragma unroll
  for(int d0=0;d0<4;++d0){
    const bf16x8 b0=*reinterpret_cast<const bf16x8*>(kb+d0*2048);
    const bf16x8 b1=*reinterpret_cast<const bf16x8*>(kb+d0*2048+512);
    if(d0==0){p0=__builtin_amdgcn_mfma_f32_32x32x16_bf16(b0,qr[0],negm,0,0,0);p1=__builtin_amdgcn_mfma_f32_32x32x16_bf16(b1,qr[0],negm,0,0,0);}
    else{p0=__builtin_amdgcn_mfma_f32_32x32x16_bf16(b0,qr[d0],p0,0,0,0);p1=__builtin_amdgcn_mfma_f32_32x32x16_bf16(b1,qr[d0],p1,0,0,0);}}
}
typedef __attribute__((address_space(3))) const char* lds_cptr;
typedef short v4i16_t __attribute__((ext_vector_type(4)));
__device__ __forceinline__ void kload8(bf16x8*kf,lds_cptr kp){
  kf[0]=*(const __attribute__((address_space(3))) bf16x8*)(kp);      kf[1]=*(const __attribute__((address_space(3))) bf16x8*)(kp+512);
  kf[2]=*(const __attribute__((address_space(3))) bf16x8*)(kp+2048); kf[3]=*(const __attribute__((address_space(3))) bf16x8*)(kp+2560);
  kf[4]=*(const __attribute__((address_space(3))) bf16x8*)(kp+4096); kf[5]=*(const __attribute__((address_space(3))) bf16x8*)(kp+4608);
  kf[6]=*(const __attribute__((address_space(3))) bf16x8*)(kp+6144); kf[7]=*(const __attribute__((address_space(3))) bf16x8*)(kp+6656);
}
__device__ __forceinline__ void kload2(bf16x8*kf,lds_cptr kp,int j){ kf[2*j]=*(const __attribute__((address_space(3))) bf16x8*)(kp+j*2048); kf[2*j+1]=*(const __attribute__((address_space(3))) bf16x8*)(kp+j*2048+512); }
__device__ __forceinline__ s16x4 vtr(lds_cptr p){ return __builtin_bit_cast(s16x4,__builtin_amdgcn_ds_read_tr16_b64_v4i16((__attribute__((address_space(3))) v4i16_t*)p)); }
__device__ __forceinline__ float rowmax(const f32x16&p0,const f32x16&p1){
  float a=max3f(p0[0],p0[1],p1[0]),b=max3f(p0[2],p0[3],p1[1]);a=max3f(a,p1[2],p1[3]);
  #pragma unroll
  for(int r=4;r<16;r+=4){a=max3f(a,p0[r],p0[r+1]);b=max3f(b,p0[r+2],p0[r+3]);a=max3f(a,p1[r],p1[r+1]);b=max3f(b,p1[r+2],p1[r+3]);}
  const float m=max2f(a,b);
  auto rr=__builtin_amdgcn_permlane32_swap(__float_as_uint(m),__float_as_uint(m),false,false);
  return max2f(__uint_as_float(rr[0]),__uint_as_float(rr[1]));
}
__device__ __forceinline__ void pv(f32x16*o,int vb,bf16x8 pa0,bf16x8 pa1,bf16x8 pa2,bf16x8 pa3){
  #pragma unroll
  for(int d0=0;d0<2;++d0){s16x4 lo[4],hi[4];
    #pragma unroll
    for(int ks=0;ks<4;++ks){
      asm volatile("ds_read_b64_tr_b16 %0,%1 offset:%c2":"=&v"(lo[ks]):"v"(vb),"i"(d0*4096+ks*1024):"memory");
      asm volatile("ds_read_b64_tr_b16 %0,%1 offset:%c2":"=&v"(hi[ks]):"v"(vb),"i"(d0*4096+ks*1024+512):"memory");}
    asm volatile("s_waitcnt lgkmcnt(0)":::"memory");SBAR();
    #define PK(k) (bf16x8){lo[k][0],lo[k][1],lo[k][2],lo[k][3],hi[k][0],hi[k][1],hi[k][2],hi[k][3]}
    o[d0]=__builtin_amdgcn_mfma_f32_32x32x16_bf16(pa0,PK(0),o[d0],0,0,0);
    o[d0]=__builtin_amdgcn_mfma_f32_32x32x16_bf16(pa1,PK(1),o[d0],0,0,0);
    o[d0]=__builtin_amdgcn_mfma_f32_32x32x16_bf16(pa2,PK(2),o[d0],0,0,0);
    o[d0]=__builtin_amdgcn_mfma_f32_32x32x16_bf16(pa3,PK(3),o[d0],0,0,0);
    #undef PK
  }
}

#ifndef ATTN_STORE16
#define ATTN_STORE16(p,v) (*(u32x4*)(p)=(v))
#endif
template<int THRL> __device__ __forceinline__ void attn_unit(int b,int h,int qb,const bf16*Q,const bf16*__restrict__ K,const bf16*__restrict__ V,bf16*O,const float*CF,char*shm,int wave_id){
  int tid_=(wave_id<<6)|lane_id_v(); asm volatile("":"+v"(tid_));
  const int tid=tid_,lane=tid&63,r32=lane&31,hi=lane>>5; const int wid=__builtin_amdgcn_readfirstlane(tid>>6);
  const long rowbase=(long)b*SEQ; const int q0=qb*QB;
  const bf16*Qw=Q+(rowbase+q0+wid*QBLK)*DM+h*D;
  const bf16*Kh=K+rowbase*DM+h*D,*Vh=V+rowbase*DM+h*D;
  const unsigned lds0=(unsigned)(uintptr_t)shm;
  float*wsf=(float*)(shm+LDS_WS)+wid*64;
  const bf16*ksrc=Kh+(long)lane*DM+wid*8;
  const bf16*vsrc=Vh+(long)(16*(wid&3)+(lane>>2))*DM+(wid>>2)*32+(lane&3)*8;
  const unsigned kdst=lds0+LDS_K+wid*1024, vdst=lds0+LDS_V+wid*1024;
  #define DMA_K(t,slot) glds16(ksrc+(long)(t)*KVBLK*DM,(unsigned)__builtin_amdgcn_readfirstlane(kdst+(slot)))
  #define DMA_V(t,slot) glds16(vsrc+(long)(t)*KVBLK*DM,(unsigned)__builtin_amdgcn_readfirstlane(vdst+(slot)))
  const char*Kbase=shm+LDS_K; bf16x8 kf[8];
  const lds_cptr shm3=(lds_cptr)shm; const lds_cptr kp0=shm3+LDS_K+hi*1024+r32*16; const lds_cptr vp0=shm3+LDS_V+((lane>>4)&1)*32+(lane&3)*8+(4*hi+((lane&15)>>2))*64;
  const int NT=(q0+QB)/KVBLK;
  { const float*cfp=CF+(long)(b*NHEAD+h)*SEQ; float*ncw=(float*)(shm+LDS_NC);
    for(int i=tid;i<q0+QB;i+=NW*64)ncw[i]=-cfp[i]; }
  const lds_cptr ncp=(lds_cptr)shm+LDS_NC+hi*16;
  #define ADDC(P0,P1,t) do{ const lds_cptr np_=ncp+(t)*256; _Pragma("unroll") for(int g_=0;g_<4;++g_){ \
      const f32x4_t a_=*(const __attribute__((address_space(3))) f32x4_t*)(np_+g_*32), b_=*(const __attribute__((address_space(3))) f32x4_t*)(np_+g_*32+128); \
      P0[4*g_]+=a_[0];P0[4*g_+1]+=a_[1];P0[4*g_+2]+=a_[2];P0[4*g_+3]+=a_[3]; P1[4*g_]+=b_[0];P1[4*g_+1]+=b_[1];P1[4*g_+2]+=b_[2];P1[4*g_+3]+=b_[3]; } }while(0)
  DMA_K(0,0);DMA_V(0,0);DMA_K(1,SLOTB);
  bf16x8 qr[4];
  #pragma unroll
  for(int d0=0;d0<4;++d0)qr[d0]=*reinterpret_cast<const bf16x8*>(&Qw[(long)r32*DM+d0*16+hi*8]);
  float mhat=0.f,l_reg=0.f;f32x16 o[2];f32x16 negm; { float zz_; asm volatile("v_mov_b32 %0, 0":"=v"(zz_));
    _Pragma("unroll") for(int r=0;r<16;++r){o[0][r]=zz_;o[1][r]=zz_;negm[r]=zz_;} } asm volatile("":"+v"(negm));
  const int qrel=wid*QBLK+r32;
  #define CMASK(P0,P1,t) do{int jb_=(t)-(NT-4); if(jb_>=0)cmask(P0,P1,jb_,qrel,hi);}while(0)
  bool resc=false;
  #define START(P0,P1) do{ const float rm=rowmax(P0,P1); resc=false; \
    { const float dl=rm; mhat=fadd_s(mhat,dl); \
      _Pragma("unroll") for(int r=0;r<16;++r){P0[r]=fsub_s(P0[r],dl);P1[r]=fsub_s(P1[r],dl);} \
      _Pragma("unroll") for(int r=0;r<16;++r)negm[r]=-mhat; asm volatile("":"+v"(negm)); } \
    _Pragma("unroll") for(int r=0;r<16;++r)P0[r]=__builtin_amdgcn_exp2f(P0[r]); }while(0)
  #define RESC() do{ if(resc){ asm volatile("s_waitcnt lgkmcnt(0)":::"memory"); \
      _Pragma("unroll") for(int d_=0;d_<2;++d_) _Pragma("unroll") for(int r=0;r<16;++r)o[d_][r]*=wsf[crow(r,hi)]; } }while(0)
  f32x16 pA0,pA1,pB0,pB1;
  int sl_prev=0,sl_cur=0,sl_next=SLOTB;
  #define ROT() do{sl_prev=sl_cur;sl_cur=sl_next;sl_next=(sl_next==(NSLOT-1)*SLOTB)?0:sl_next+SLOTB;}while(0)
  DMA_K(2,2*SLOTB);
  WAIT_BAR(3);
  qkt(pA0,pA1,Kbase,qr,negm,r32,hi);asm volatile("s_nop 15\n\ts_nop 7":"+v"(pA0),"+v"(pA1));ADDC(pA0,pA1,0);CMASK(pA0,pA1,0);
  START(pA0,pA1);
  _Pragma("unroll") for(int r=0;r<16;++r)pA1[r]=__builtin_amdgcn_exp2f(pA1[r]);
  WAIT_BAR(0);
  DMA_K(3,0);DMA_V(1,SLOTB);
  ROT();
  kload8(kf,kp0+sl_cur);
  WAIT_BAR(2);
  s16x4 vlo[8],vhi[8]; u32x4 pw0,pw1,pw2,pw3;
  #define PKW(P,B) cvtpk_s(P[B],P[B+1])
  #define PAF(k) __builtin_bit_cast(bf16x8,pw##k)
  #define VFR(i) (bf16x8){vlo[i][0],vlo[i][1],vlo[i][2],vlo[i][3],vhi[i][0],vhi[i][1],vhi[i][2],vhi[i][3]}
  #define PIN(x) asm volatile("":"+v"(x))
  #define MX3(a,b,c) __builtin_fmaxf(__builtin_fmaxf((a),(b)),(c))
  #define GAPA(MF,A0,A1,A2,A3,W0,W1,PW) do{ MF; sacc+=A0; sacc+=A1; sacc+=A2; sacc+=A3; PIN(sacc); W0; W1; PIN(PW); SBAR(); }while(0)
  #define EX(v) __builtin_amdgcn_exp2f(v)
  #define GAPB(MF,X,B) do{ MF; X[B]=EX(X[B]); X[B+1]=EX(X[B+1]); X[B+2]=EX(X[B+2]); X[B+3]=EX(X[B+3]); PIN(X); SBAR(); }while(0)
  #define VRD(i) do{ vlo[i]=vtr(vp_+(((i)>>2)*4096+((i)&3)*1024)); vhi[i]=vtr(vp_+(((i)>>2)*4096+((i)&3)*1024+512)); }while(0)
  #define KRD(G,j) do{ if(G){ kload2(kf,kp0+sl_next,j); SBAR(); } }while(0)
  #define STEP(C0,C1,P0,P1,t,GK,GV,GL) do{ SBAR(); \
    const lds_cptr vp_=vp0+sl_prev; \
    VRD(0); SBAR(); float sacc=(P0[0]+P0[1]); \
    GAPA(C0=__builtin_amdgcn_mfma_f32_32x32x16_bf16(kf[0],qr[0],negm,0,0,0), P0[2],P0[3],P0[4],P0[5],     pw0[0]=PKW(P0,0), pw0[1]=PKW(P0,2), pw0); \
    VRD(4); SBAR(); GAPA(C1=__builtin_amdgcn_mfma_f32_32x32x16_bf16(kf[1],qr[0],negm,0,0,0), P0[6],P0[7],P0[8],P0[9],     pw0[2]=PKW(P0,4), pw0[3]=PKW(P0,6), pw0); \
    VRD(1); SBAR(); GAPA(C0=__builtin_amdgcn_mfma_f32_32x32x16_bf16(kf[2],qr[1],C0,0,0,0),   P0[10],P0[11],P0[12],P0[13], pw1[0]=PKW(P0,8), pw1[1]=PKW(P0,10), pw1); \
    VRD(5); SBAR(); GAPA(C1=__builtin_amdgcn_mfma_f32_32x32x16_bf16(kf[3],qr[1],C1,0,0,0),   P0[14],P0[15],P1[0],P1[1],   pw1[2]=PKW(P0,12),pw1[3]=PKW(P0,14), pw1); \
    VRD(2); SBAR(); GAPA(C0=__builtin_amdgcn_mfma_f32_32x32x16_bf16(kf[4],qr[2],C0,0,0,0),   P1[2],P1[3],P1[4],P1[5],     pw2[0]=PKW(P1,0), pw2[1]=PKW(P1,2), pw2); \
    VRD(6); SBAR(); GAPA(C1=__builtin_amdgcn_mfma_f32_32x32x16_bf16(kf[5],qr[2],C1,0,0,0),   P1[6],P1[7],P1[8],P1[9],     pw2[2]=PKW(P1,4), pw2[3]=PKW(P1,6), pw2); \
    VRD(3); SBAR(); GAPA(C0=__builtin_amdgcn_mfma_f32_32x32x16_bf16(kf[6],qr[3],C0,0,0,0),   P1[10],P1[11],P1[12],P1[13], pw3[0]=PKW(P1,8), pw3[1]=PKW(P1,10), pw3); \
    VRD(7); SBAR(); GAPA(C1=__builtin_amdgcn_mfma_f32_32x32x16_bf16(kf[7],qr[3],C1,0,0,0),   P1[14],P1[15],0.f,0.f,       pw3[2]=PKW(P1,12),pw3[3]=PKW(P1,14), pw3); \
    l_reg+=sacc; \
    if(GK){DMA_K((t)+3,sl_cur);} if(GV){DMA_V((t)+1,sl_next);} \
    ADDC(C0,C1,t); CMASK(C0,C1,t); \
    { float a=MX3(C0[0],C0[1],C1[0]),b=MX3(C0[2],C0[3],C1[1]); a=MX3(a,C1[2],C1[3]); \
      _Pragma("unroll") for(int r=4;r<16;r+=4){a=MX3(a,C0[r],C0[r+1]);b=MX3(b,C0[r+2],C0[r+3]);a=MX3(a,C1[r],C1[r+1]);b=MX3(b,C1[r+2],C1[r+3]);} \
      float rm=__builtin_fmaxf(a,b); { auto rr=__builtin_amdgcn_permlane32_swap(__float_as_uint(rm),__float_as_uint(rm),false,false); rm=__builtin_fmaxf(__uint_as_float(rr[0]),__uint_as_float(rr[1])); } \
      resc=false; \
      if(__builtin_expect(__any(rm>(float)THRL),0)){ const float dl=__builtin_fmaxf(rm,0.f); mhat+=dl; \
        _Pragma("unroll") for(int r=0;r<16;++r){C0[r]-=dl;C1[r]-=dl;} \
        _Pragma("unroll") for(int r=0;r<16;++r)negm[r]=-mhat; asm volatile("":"+v"(negm)); \
        const float f=__builtin_amdgcn_exp2f(-dl); l_reg*=f; if(hi==0)wsf[r32]=f; resc=true; } } \
    SBAR(); \
    GAPB(o[0]=__builtin_amdgcn_mfma_f32_32x32x16_bf16(PAF(0),VFR(0),o[0],0,0,0), C0,0); \
    GAPB(o[1]=__builtin_amdgcn_mfma_f32_32x32x16_bf16(PAF(0),VFR(4),o[1],0,0,0), C0,4); \
    KRD(GL,0); GAPB(o[0]=__builtin_amdgcn_mfma_f32_32x32x16_bf16(PAF(1),VFR(1),o[0],0,0,0), C0,8); \
    KRD(GL,1); GAPB(o[1]=__builtin_amdgcn_mfma_f32_32x32x16_bf16(PAF(1),VFR(5),o[1],0,0,0), C0,12); \
    KRD(GL,2); GAPB(o[0]=__builtin_amdgcn_mfma_f32_32x32x16_bf16(PAF(2),VFR(2),o[0],0,0,0), C1,0); \
    KRD(GL,3); GAPB(o[1]=__builtin_amdgcn_mfma_f32_32x32x16_bf16(PAF(2),VFR(6),o[1],0,0,0), C1,4); \
    GAPB(o[0]=__builtin_amdgcn_mfma_f32_32x32x16_bf16(PAF(3),VFR(3),o[0],0,0,0), C1,8); \
    GAPB(o[1]=__builtin_amdgcn_mfma_f32_32x32x16_bf16(PAF(3),VFR(7),o[1],0,0,0), C1,12); \
    }while(0)
  int t=1;
  #undef CMASK
  #define CMASK(P0,P1,t) do{}while(0)
  for(;t+5<NT;t+=2){
    STEP(pB0,pB1,pA0,pA1,t,true,true,true);     WAIT_BAR(2); RESC(); ROT();
    STEP(pA0,pA1,pB0,pB1,t+1,true,true,true);   WAIT_BAR(2); RESC(); ROT();
  }
  #undef CMASK
  #define CMASK(P0,P1,t) do{int jb_=(t)-(NT-4); if(jb_>=0)cmask(P0,P1,jb_,qrel,hi);}while(0)
  #define ENDW(tt) do{ if((tt)+3<NT){WAIT_BAR(2);} else if((tt)+2<NT){WAIT_BAR(1);} else {WAIT_BAR(0);} }while(0)
  for(;t+1<NT;t+=2){
    STEP(pB0,pB1,pA0,pA1,t,(t+3<NT),(t+1<NT),(t+1<NT));       ENDW(t);   RESC(); ROT();
    STEP(pA0,pA1,pB0,pB1,t+1,(t+4<NT),(t+2<NT),(t+2<NT));     ENDW(t+1); RESC(); ROT();
  }
  STEP(pB0,pB1,pA0,pA1,NT-1,false,false,false); RESC();
  { float sacc=pB0[0]+pB0[1]; _Pragma("unroll") for(int r=2;r<16;++r)sacc+=pB0[r]; _Pragma("unroll") for(int r=0;r<16;++r)sacc+=pB1[r]; l_reg+=sacc;
    pw0=(u32x4){PKW(pB0,0),PKW(pB0,2),PKW(pB0,4),PKW(pB0,6)};pw1=(u32x4){PKW(pB0,8),PKW(pB0,10),PKW(pB0,12),PKW(pB0,14)};pw2=(u32x4){PKW(pB1,0),PKW(pB1,2),PKW(pB1,4),PKW(pB1,6)};pw3=(u32x4){PKW(pB1,8),PKW(pB1,10),PKW(pB1,12),PKW(pB1,14)};
    int tl_=lane_id_v(); asm volatile("":"+v"(tl_)); const int ln_=tl_&63,hi_=ln_>>5; const int vb0e=(int)(lds0+LDS_V)+((ln_>>4)&1)*32+(ln_&3)*8+(4*hi_+((ln_&15)>>2))*64;
    SBAR(); pv(o,vb0e+sl_cur,PAF(0),PAF(1),PAF(2),PAF(3)); }
  #undef PKW
  #undef PAF
  #undef VFR
  #undef PIN
  #undef MX3
  #undef GAPA
  #undef GAPB
  #undef EX
  #undef VRD
  #undef KRD
  #undef STEP
  #undef ENDW
  {auto rr=__builtin_amdgcn_permlane32_swap(__float_as_uint(l_reg),__float_as_uint(l_reg),false,false);l_reg=__uint_as_float(rr[0])+__uint_as_float(rr[1]);}
  int te_=lane_id_v(); asm volatile("":"+v"(te_)); const int lane_e=te_&63,r32_e=lane_e&31,hi_e=lane_e>>5;
  if(hi_e==0)wsf[32+r32_e]=l_reg;asm volatile("s_waitcnt lgkmcnt(0)":::"memory");
  float rli[16];
  #pragma unroll
  for(int r=0;r<16;++r)rli[r]=__builtin_amdgcn_rcpf(wsf[32+crow(r,hi_e)]);
  bf16*Ow=O+(rowbase+q0+wid*QBLK)*DM+h*D;
  { bf16*stg=(bf16*)(shm+LDS_OST)+wid*2048;
    #pragma unroll
    for(int r=0;r<16;++r){const int orow=crow(r,hi_e);
      #pragma unroll
      for(int d0=0;d0<2;++d0)stg[orow*64+d0*32+r32_e]=__float2bfloat16(o[d0][r]*rli[r]);}
    asm volatile("s_waitcnt lgkmcnt(0)":::"memory");
    #pragma unroll
    for(int i=0;i<4;++i){const int row=i*8+(lane_e>>3),ch=lane_e&7; const u32x4 v=*(const u32x4*)(stg+row*64+ch*8); ATTN_STORE16(Ow+(long)row*DM+ch*8,v);} }
  asm volatile("s_waitcnt lgkmcnt(0)\n\ts_barrier":::"memory");
  #undef ADDC
  #undef DMA_K
  #undef DMA_V
  #undef CMASK
  #undef START
  #undef RESC
  #undef ROT
}
constexpr int ATTN_LDS_BYTES=LDS_BYTES;
struct AttnTensors { const bf16* Q; const bf16* K; const bf16* V; bf16* O; const float* CF; };
struct AttnUnit { int bh; int qb; };
struct StaticOrder {
  int vcu;
  __device__ __forceinline__ explicit StaticOrder(int grid,int block):vcu((block%8)*(grid/8)+block/8){}
  __device__ __forceinline__ bool next(int i,AttnUnit&u)const{ if(i>=2)return false; const int s=vcu&7; u.bh=vcu>>3; u.qb=(i==0)?s:15-s; return true; }
  __device__ __forceinline__ void a_ready(const AttnUnit&)const{}
  __device__ __forceinline__ void done(const AttnUnit&)const{}
};
template<class Sched,int THRL=8> __device__ __forceinline__ void attn_phase(char*lds,const AttnTensors&T,const Sched&S,int wave_id){
  AttnUnit u;
  for(int i=0;S.next(i,u);++i){ S.a_ready(u); attn_unit<THRL>(u.bh/NHEAD,u.bh%NHEAD,u.qb,T.Q,T.K,T.V,T.O,T.CF,lds,wave_id); S.done(u); }
}
#undef SBAR
#undef WAIT_BAR
}

struct Args { const float* in[16]; float* out; unsigned char* ws; };
__global__ void __launch_bounds__(NWAVES * 64, 2) hyb_fwd(Args args) {
    extern __shared__ __attribute__((aligned(16))) unsigned char lds[];
    Ctx F;
    F.lds = (LAS unsigned char*)lds;
    F.tid = threadIdx.x; F.lane = F.tid & 63; F.wave = __builtin_amdgcn_readfirstlane(F.tid >> 6);
    F.G = gridDim.x; F.gw = blockIdx.x * NWAVES + F.wave; F.NGW = F.G * NWAVES;
    F.out = args.out; F.ws = args.ws;
    volatile LAS unsigned* MISC = (volatile LAS unsigned*)(F.lds + MISC_OFF);
    for (int u = F.tid; u < (LDS_BYTES - LDSCTL_OFF) / 4; u += NWAVES * 64) ((LAS unsigned*)(F.lds + LDSCTL_OFF))[u] = 0u;
    __syncthreads();
    gu32* ctl = (gu32*)(F.ws + WS_CTL);
    XcdBarrier bar = xcd_barrier_post((unsigned*)(ctl + CW_BAR), MISC + 8); bar.w = F.wave;
#define FRESH(P) Ctx P = F; P.tid = (F.wave << 6) | lane_id_v(); asm volatile("" : "+v"(P.tid), "+s"(P.wave), "+s"(P.gw), "+s"(P.ws), "+s"(P.out)); P.lane = P.tid & 63
#define GRID_BAR() do { XcdBarrier b_ = bar; asm volatile("" : "+s"(b_.bar), "+s"(b_.x)); xcd_barrier(b_); } while (0)

    bf16* Wb = (bf16*)(F.ws + WS_W);
    bf16* Z = (bf16*)(F.ws + WS_Z); float* ZS = (float*)(F.ws + WS_ZS); bf16* HDN = (bf16*)(F.ws + WS_HDN);
    float* M32 = (float*)(F.ws + WS_HDN); bf16* HB = (bf16*)(F.ws + WS_Z);
    LAS unsigned char* ring = F.lds + RING_OFF;

    { FRESH(P); p0_prologue(P, args.in[2], args.in[9], args.in[10], args.in[11], args.in[12], args.in[14], args.in[15]); }
    GRID_BAR();

    #pragma unroll 1
    for (int layer = 0; layer < DEPTH; ++layer) {
        const float* xin = (layer == 0) ? args.in[0] : F.out;
        const bf16* L = Wb + (size_t)layer * LW_STRIDE;
        { FRESH(P); rmsnorm_phase(P, xin, args.in[1] + layer * DM, (bf16*)(P.ws + WS_HDN)); }
        GRID_BAR();
        { pg8::Gemm g{HDN, L + LW_IN, M, NIN, DM, DM, DM}; pg8::StaticOrder S; S.init(M, NIN, F.G, (int)blockIdx.x);
          pg8::EpiZ E{Z, ZS};
          pg8::gemm_phase<pg8::EpiZ, pg8::StaticOrder, true, true>(ring, g, S, E, F.wave); }
        GRID_BAR();
        { FRESH(P); post_phase(P, args.in[4] + layer * 64, args.in[5] + layer * 64, args.in[6] + layer * 64, args.in[7] + layer * 64, args.in[3] + layer * 8); }
        GRID_BAR();
        { FRESH(P); scan_state_phase(P); }
        GRID_BAR();
        { FRESH(P); ret_out_naive(P, args.in[8] + layer * 512); }
        { static_assert(attn_body::ATTN_LDS_BYTES <= RING_BYTES, "attention scratch fits the ring region");
          unsigned char* wsl = F.ws; asm volatile("" : "+s"(wsl));
          bf16* Zl = (bf16*)(wsl + WS_Z);
          const attn_body::AttnTensors AT{(const attn_body::bf16*)(Zl + Z_FQ), (const attn_body::bf16*)(Zl + Z_FK), (const attn_body::bf16*)(Zl + Z_FV), (attn_body::bf16*)(Zl + Z_FQ), (const float*)(wsl + WS_CF)};
          const attn_body::StaticOrder S((int)F.G, (int)blockIdx.x);
          attn_body::attn_phase<attn_body::StaticOrder>((char*)lds + RING_OFF, AT, S, F.wave); }
        { FRESH(P); dsa_v2(P); }
        GRID_BAR();
        { pg8::StaticOrder S; S.init(M, DM, F.G, (int)blockIdx.x);
          { pg8::Gemm g{Z + Z_FQ, L + LW_MIX, M, DM, 512, ZP, 512}; pg8::EpiGate<0> E{Z + Z_ZG, M32, Z + Z_MRG};
            pg8::gemm_phase<pg8::EpiGate<0>, pg8::StaticOrder, false, true>(ring, g, S, E, F.wave); }
          { pg8::Gemm g{Z + Z_DQ, L + LW_MIX + 512 * 1024, M, DM, 512, ZP, 512}; pg8::EpiGate<1> E{Z + Z_ZG, M32, Z + Z_MRG};
            pg8::gemm_phase<pg8::EpiGate<1>, pg8::StaticOrder, false, true>(ring, g, S, E, F.wave); }
          { pg8::Gemm g{Z + Z_RV, L + LW_MIX + 1024 * 1024, M, DM, 512, ZP, 512}; pg8::EpiGate<2> E{Z + Z_ZG, M32, Z + Z_MRG};
            pg8::gemm_phase<pg8::EpiGate<2>, pg8::StaticOrder, false, true>(ring, g, S, E, F.wave); } }
        GRID_BAR();
        { pg8::Gemm g{Z + Z_MRG, L + LW_O, M, DM, DM, ZP, DM}; pg8::StaticOrder S; S.init(M, DM, F.G, (int)blockIdx.x);
          pg8::EpiRes E{xin, F.out};
          pg8::gemm_phase<pg8::EpiRes, pg8::StaticOrder, false, true>(ring, g, S, E, F.wave); }
        GRID_BAR();
        { FRESH(P); rmsnorm_phase(P, P.out, args.in[13] + layer * DM, (bf16*)(P.ws + WS_HDN)); }
        GRID_BAR();
        { pg8::Gemm g{HDN, L + LW_FI, M, FF2, DM, DM, DM}; pg8::StaticOrder S; S.init(M, FF2, F.G, (int)blockIdx.x);
          pg8::EpiSwi E{HB, FFH};
          pg8::gemm_phase<pg8::EpiSwi, pg8::StaticOrder, true, true>(ring, g, S, E, F.wave); }
        GRID_BAR();
        { pg8::Gemm g{HB, L + LW_FO, M, DM, FFH, FFH, FFH}; pg8::StaticOrder S; S.init(M, DM, F.G, (int)blockIdx.x);
          pg8::EpiRes E{F.out, F.out};
          pg8::gemm_phase<pg8::EpiRes, pg8::StaticOrder, false, true>(ring, g, S, E, F.wave); }
        GRID_BAR();
    }
    if (__hip_atomic_load((gu32*)((unsigned*)(ctl + CW_BAR) + XB_TMO), RLX_AGENT) != 0u) {
        const float q = __builtin_nanf("");
        for (int m = F.gw; m < M; m += F.NGW) { GAS f32x4* o = (GAS f32x4*)(F.out + (size_t)m * DM) + lane_id_v();
#pragma unroll
            for (int j = 0; j < 4; ++j) o[64 * j] = (f32x4){q, q, q, q}; }
    }
}

extern "C" void kernel_launch(void* const* d_in, const int* in_sizes, int n_in, void* d_out, int out_size, void* d_ws, size_t ws_size, hipStream_t stream) {
    static int grid = 0;
    if (grid == 0) {
        if (n_in != 16 || in_sizes[0] != M * DM || out_size != M * DM || ws_size < WS_END) { fprintf(stderr, "kernel_launch: unexpected shapes / workspace (n_in %d, in0 %d, out %d, ws %zu < %zu)\n", n_in, n_in > 0 ? in_sizes[0] : -1, out_size, ws_size, (size_t)WS_END); grid = -1; return; }
        int dev = 0, cus = 0, per_cu = 0;
        if (hipGetDevice(&dev) != hipSuccess || hipDeviceGetAttribute(&cus, hipDeviceAttributeMultiprocessorCount, dev) != hipSuccess) { grid = -1; return; }
        if (hipFuncSetAttribute((const void*)hyb_fwd, hipFuncAttributeMaxDynamicSharedMemorySize, LDS_BYTES) != hipSuccess) { fprintf(stderr, "kernel_launch: hipFuncSetAttribute failed\n"); grid = -1; return; }
        if (hipOccupancyMaxActiveBlocksPerMultiprocessor(&per_cu, (const void*)hyb_fwd, NWAVES * 64, LDS_BYTES) != hipSuccess || per_cu < 1) { fprintf(stderr, "kernel_launch: occupancy query reports %d blocks per CU\n", per_cu); }
        (void)hipGetLastError();
        grid = cus;
    }
    if (grid < 0) return;
    if (hipMemsetAsync((char*)d_ws + WS_CTL, 0, CTL_ZERO_BYTES, stream) != hipSuccess) return;
    Args a{};
    for (int i = 0; i < 16; ++i) a.in[i] = (const float*)d_in[i];
    a.out = (float*)d_out; a.ws = (unsigned char*)d_ws;
    hipLaunchKernelGGL(hyb_fwd, dim3(grid), dim3(NWAVES * 64), LDS_BYTES, stream, a);
}
```

```cpp
#include <hip/hip_runtime.h>
#include <cstdio>
#include <cstdint>
#include <cmath>
__device__ __forceinline__ int lane_id_v() { unsigned z; asm volatile("v_mov_b32 %0, 0" : "=v"(z)); return (int)__builtin_amdgcn_mbcnt_hi(~0u, __builtin_amdgcn_mbcnt_lo(~0u, z)); }
namespace pg8 {
#define PG8_LAS __attribute__((address_space(3)))
typedef unsigned short bf16_t;
typedef short bf16x8 __attribute__((ext_vector_type(8)));
typedef float f32x4 __attribute__((ext_vector_type(4)));
typedef unsigned u32x4 __attribute__((ext_vector_type(4)));
constexpr int BM = 256, BK = 64, HALF = 128, HTB = HALF * BK * 2  , STAGE_BYTES = 8 * HTB, NXCD = 8, WGM = 8;

__host__ __device__ __forceinline__ int lds_byte(int r, int c) { const int st = (r >> 4) * 2 + (c >> 5), rr = r & 15, cc = c & 31, ob = rr * 64 + cc * 2; return st * 1024 + (ob ^ (((ob >> 9) & 1) << 5)); }
__host__ __device__ __forceinline__ void stage_rc(int b, int& R, int& C) { const int st = b / 1024, sb = b % 1024, swz = sb ^ (((sb >> 9) & 1) << 5); R = (st >> 1) * 16 + swz / 64; C = (st & 1) * 32 + (swz % 64) / 2; }
__host__ __device__ __forceinline__ int perm32(int rho) { const int n = rho >> 4, i = rho & 15; return 8 * (i >> 2) + 4 * n + (i & 3); }

struct Unit { int pm, pn; };
struct Gemm { const bf16_t* A; const bf16_t* Bt; int M, N, K, lda, ldb; };

struct StaticOrder {
    int nM, nN, nwg, G, c;
    __host__ __device__ void init(int M, int N, int G_, int c_) { nM = M / BM; nN = N / BM; nwg = nM * nN; G = G_; c = c_; }
    __host__ __device__ bool next(int i, Unit& u) const {
        const long L = (long)i * G + c; if (L >= nwg) return false;
        int wgid = (int)L; { const int q = nwg / NXCD, r = nwg % NXCD, xcd = wgid % NXCD, off = wgid / NXCD; wgid = (xcd < r ? xcd * (q + 1) : r * (q + 1) + (xcd - r) * q) + off; }
        const int nig = WGM * nN, gid = wgid / nig, fm = gid * WGM, gsz = (nM - fm) < WGM ? (nM - fm) : WGM;
        u.pm = fm + ((wgid % nig) % gsz); u.pn = (wgid % nig) / gsz; return true;
    }
    __device__ __forceinline__ void a_ready(const Unit&) const {}
    __device__ __forceinline__ void done(const Unit&) const {}
};

__device__ __forceinline__ unsigned cvt_pk_bf16(float lo, float hi) { unsigned r; asm volatile("v_cvt_pk_bf16_f32 %0, %1, %2" : "=v"(r) : "v"(lo), "v"(hi)); return r; }
__device__ __forceinline__ float bflo(unsigned w) { return __builtin_bit_cast(float, w << 16); }
__device__ __forceinline__ float bfhi(unsigned w) { return __builtin_bit_cast(float, w & 0xffff0000u); }
__device__ __forceinline__ float sigmoidf_(float x) { return __builtin_amdgcn_rcpf(1.0f + __builtin_amdgcn_exp2f(-1.4426950408889634f * x)); }

constexpr int ZP = 6656;
constexpr int ZSP = 512;
constexpr int NZT = 26;

struct EpiZ {
    static constexpr bool PERM = true, AFTER_DRAIN = false;
    bf16_t* Z; float* ZS;
    __device__ __forceinline__ void operator()(const f32x4 (&acc)[2][2][4][2], const Unit& u, int wr, int wc, int fr, int fq) const {
        const int row0 = u.pm * BM + wr * 64 + fr;
        if (u.pn < NZT) {
            const int col0 = u.pn * BM + wc * 32 + 8 * fq;
#pragma unroll
            for (int ai = 0; ai < 2; ++ai)
#pragma unroll
                for (int m = 0; m < 4; ++m) { bf16_t* rowp = Z + (size_t)(row0 + ai * HALF + m * 16) * ZP + col0;
#pragma unroll
                    for (int bj = 0; bj < 2; ++bj) { const f32x4 v0 = acc[ai][bj][m][0], v1 = acc[ai][bj][m][1];
                        u32x4 w; w.x = cvt_pk_bf16(v0[0], v0[1]); w.y = cvt_pk_bf16(v0[2], v0[3]); w.z = cvt_pk_bf16(v1[0], v1[1]); w.w = cvt_pk_bf16(v1[2], v1[3]);
                        *(u32x4*)(rowp + bj * HALF) = w; } }
        } else {
            const int col0 = (u.pn - NZT) * BM + wc * 32 + 8 * fq;
#pragma unroll
            for (int ai = 0; ai < 2; ++ai)
#pragma unroll
                for (int m = 0; m < 4; ++m) { float* rowp = ZS + (size_t)(row0 + ai * HALF + m * 16) * ZSP + col0;
#pragma unroll
                    for (int bj = 0; bj < 2; ++bj) { *(f32x4*)(rowp + bj * HALF) = acc[ai][bj][m][0]; *(f32x4*)(rowp + bj * HALF + 4) = acc[ai][bj][m][1]; } }
        }
    }
};

template <int P> struct EpiGate {
    static constexpr bool PERM = true, AFTER_DRAIN = false;
    const bf16_t* G;
    float* M32;
    bf16_t* OUT;
    __device__ __forceinline__ void operator()(const f32x4 (&acc)[2][2][4][2], const Unit& u, int wr, int wc, int fr, int fq) const {
        const int row0 = u.pm * BM + wr * 64 + fr, col0 = u.pn * BM + wc * 32 + 8 * fq;
#pragma unroll
        for (int ai = 0; ai < 2; ++ai)
#pragma unroll
            for (int m = 0; m < 4; ++m) { const size_t row = (size_t)(row0 + ai * HALF + m * 16);
#pragma unroll
                for (int bj = 0; bj < 2; ++bj) { const int col = col0 + bj * HALF;
                    const u32x4 gw = *(const u32x4*)(G + row * ZP + P * 1024 + col);
                    const f32x4 v0 = acc[ai][bj][m][0], v1 = acc[ai][bj][m][1];
                    f32x4 t0, t1;
                    t0[0] = sigmoidf_(bflo(gw.x)) * v0[0]; t0[1] = sigmoidf_(bfhi(gw.x)) * v0[1]; t0[2] = sigmoidf_(bflo(gw.y)) * v0[2]; t0[3] = sigmoidf_(bfhi(gw.y)) * v0[3];
                    t1[0] = sigmoidf_(bflo(gw.z)) * v1[0]; t1[1] = sigmoidf_(bfhi(gw.z)) * v1[1]; t1[2] = sigmoidf_(bflo(gw.w)) * v1[2]; t1[3] = sigmoidf_(bfhi(gw.w)) * v1[3];
                    float* mp = M32 + row * 1024 + col;
                    if (P == 0) { *(f32x4*)mp = t0; *(f32x4*)(mp + 4) = t1; }
                    else if (P == 1) { *(f32x4*)mp = *(const f32x4*)mp + t0; *(f32x4*)(mp + 4) = *(const f32x4*)(mp + 4) + t1; }
                    else { t0 = *(const f32x4*)mp + t0; t1 = *(const f32x4*)(mp + 4) + t1;
                        u32x4 w; w.x = cvt_pk_bf16(t0[0], t0[1]); w.y = cvt_pk_bf16(t0[2], t0[3]); w.z = cvt_pk_bf16(t1[0], t1[1]); w.w = cvt_pk_bf16(t1[2], t1[3]);
                        *(u32x4*)(OUT + row * ZP + col) = w; } } }
    }
};

struct EpiRes {
    static constexpr bool PERM = true, AFTER_DRAIN = false;
    const float* RES; float* OUT;
    __device__ __forceinline__ void operator()(const f32x4 (&acc)[2][2][4][2], const Unit& u, int wr, int wc, int fr, int fq) const {
        const int row0 = u.pm * BM + wr * 64 + fr, col0 = u.pn * BM + wc * 32 + 8 * fq;
#pragma unroll
        for (int ai = 0; ai < 2; ++ai)
#pragma unroll
            for (int m = 0; m < 4; ++m) { const size_t off = (size_t)(row0 + ai * HALF + m * 16) * 1024 + col0;
#pragma unroll
                for (int bj = 0; bj < 2; ++bj) { const float* rp = RES + off + bj * HALF; float* op = OUT + off + bj * HALF;
                    const f32x4 r0 = *(const f32x4*)rp, r1 = *(const f32x4*)(rp + 4);
                    *(f32x4*)op = r0 + acc[ai][bj][m][0]; *(f32x4*)(op + 4) = r1 + acc[ai][bj][m][1]; } }
    }
};

struct EpiSwi {
    static constexpr bool PERM = true, AFTER_DRAIN = false;
    bf16_t* H; int ldh;
    __device__ __forceinline__ void operator()(const f32x4 (&acc)[2][2][4][2], const Unit& u, int wr, int wc, int fr, int fq) const {
        const int row0 = u.pm * BM + wr * 64 + fr, col0 = u.pn * HALF + wc * 32 + 8 * fq;
#pragma unroll
        for (int ai = 0; ai < 2; ++ai)
#pragma unroll
            for (int m = 0; m < 4; ++m) { bf16_t* hp = H + (size_t)(row0 + ai * HALF + m * 16) * ldh + col0;
                float o[8];
#pragma unroll
                for (int n = 0; n < 2; ++n)
#pragma unroll
                    for (int i = 0; i < 4; ++i) { const float g = acc[ai][0][m][n][i], up = acc[ai][1][m][n][i]; o[4 * n + i] = g * sigmoidf_(g) * up; }
                u32x4 w; w.x = cvt_pk_bf16(o[0], o[1]); w.y = cvt_pk_bf16(o[2], o[3]); w.z = cvt_pk_bf16(o[4], o[5]); w.w = cvt_pk_bf16(o[6], o[7]);
                *(u32x4*)hp = w; }
    }
};

template <class Epi, class Sched, bool ALIGN_EPI = false, bool SP2 = false>
__device__ __forceinline__ void gemm_phase(PG8_LAS unsigned char* lds, Gemm g, const Sched& S0, const Epi& E, int wave_id) {
    int ovz, osz; asm volatile("v_mov_b32 %0, 0\n\ts_mov_b32 %1, 0" : "=v"(ovz), "=s"(osz));
    Sched S = S0; S.c += osz; g.lda += osz; g.ldb += osz;
    const int tid = ((wave_id << 6) | lane_id_v()) + ovz,
         wid = __builtin_amdgcn_readfirstlane(tid >> 6), lane = tid & 63, wr = wid >> 2, wc = wid & 3, fr = lane & 15, fq = lane >> 4;
    const int K = g.K, nt = K / BK;
    unsigned voffA[2], voffB[2];
#pragma unroll
    for (int i = 0; i < 2; ++i) { int R, C; stage_rc(tid * 16 + i * 8192, R, C); const int Rb = Epi::PERM ? ((R & ~31) + perm32(R & 31)) : R;
        voffA[i] = (unsigned)(R * g.lda + C) * 2u; voffB[i] = (unsigned)(Rb * g.ldb + C) * 2u; }
    const size_t kstep = (size_t)(BK * 2);
    const size_t hstepA = (size_t)HALF * g.lda * 2, hstepB = (size_t)HALF * g.ldb * 2;
    const size_t tstepA = 2 * hstepA, tstepB = 2 * hstepB;
    const unsigned ldsw = (unsigned)wid * 1024u;
    const int aoff = lds_byte(wr * 64 + fr, fq * 8), boff = lds_byte(wc * 32 + fr, fq * 8);
#define PG8_SA(b, h) (((b) * 2 + (h)) * HTB)
#define PG8_SB(b, h) ((4 + (b) * 2 + (h)) * HTB)
#define PG8_STAGE(bufoff, gbase, voff) do { _Pragma("unroll") for (int _i = 0; _i < 2; ++_i) \
        __builtin_amdgcn_global_load_lds((const unsigned*)((const char*)(gbase) + (voff)[_i]), (PG8_LAS unsigned*)(lds + (bufoff) + ldsw + _i * 8192), 16, 0, 0); } while (0)
#define PG8_LDA(dst, b, h) do { _Pragma("unroll") for (int m = 0; m < 4; ++m) _Pragma("unroll") for (int k = 0; k < 2; ++k) dst[m][k] = *(const PG8_LAS bf16x8*)(lds + PG8_SA(b, h) + aoff + m * 2048 + k * 1024); } while (0)
#define PG8_LDB(dst, b, h) do { _Pragma("unroll") for (int n = 0; n < 2; ++n) _Pragma("unroll") for (int k = 0; k < 2; ++k) dst[n][k] = *(const PG8_LAS bf16x8*)(lds + PG8_SB(b, h) + boff + n * 2048 + k * 1024); } while (0)
#define PG8_MMA(ai, bj, At, Bt) do { __builtin_amdgcn_s_setprio(1); _Pragma("unroll") for (int m = 0; m < 4; ++m) _Pragma("unroll") for (int n = 0; n < 2; ++n) _Pragma("unroll") for (int k = 0; k < 2; ++k) \
        acc[ai][bj][m][n] = __builtin_amdgcn_mfma_f32_16x16x32_bf16(Bt[n][k], At[m][k], acc[ai][bj][m][n], 0, 0, 0); __builtin_amdgcn_s_setprio(0); } while (0)
#define PG8_WAIT_V(n) asm volatile("s_waitcnt vmcnt(" #n ")" ::: "memory")
#define PG8_WAIT_L(n) asm volatile("s_waitcnt lgkmcnt(" #n ")" ::: "memory")
#define PG8_BAR __builtin_amdgcn_s_barrier()
#define PG8_SCHED __builtin_amdgcn_sched_barrier(0)
    Unit cur, nxt; int ui = 0;
    if (!S.next(0, cur)) return;
    f32x4 acc[2][2][4][2];
#pragma unroll
    for (int a = 0; a < 2; ++a)
#pragma unroll
        for (int b = 0; b < 2; ++b)
#pragma unroll
            for (int m = 0; m < 4; ++m)
#pragma unroll
                for (int n = 0; n < 2; ++n) acc[a][b][m][n] = (f32x4){0.f, 0.f, 0.f, 0.f};
    bf16x8 At[4][2], B0[2][2], B1[2][2];
    const char* cA = (const char*)g.A + (size_t)cur.pm * tstepA; const char* cB = (const char*)g.Bt + (size_t)cur.pn * tstepB;
    S.a_ready(cur);
    if constexpr (SP2) {
        PG8_STAGE(PG8_SB(0, 0), cB, voffB); PG8_STAGE(PG8_SB(0, 1), cB + hstepB, voffB); PG8_STAGE(PG8_SA(0, 0), cA, voffA); PG8_STAGE(PG8_SA(0, 1), cA + hstepA, voffA);
        if (wr == 1) PG8_BAR;
        PG8_WAIT_V(2); PG8_BAR;
        PG8_STAGE(PG8_SB(1, 0), cB + kstep, voffB); PG8_STAGE(PG8_SA(1, 0), cA + kstep, voffA); PG8_STAGE(PG8_SB(1, 1), cB + hstepB + kstep, voffB);
        PG8_WAIT_V(6); PG8_BAR;
    } else {
        PG8_STAGE(PG8_SB(0, 0), cB, voffB); PG8_STAGE(PG8_SA(0, 0), cA, voffA); PG8_STAGE(PG8_SB(0, 1), cB + hstepB, voffB); PG8_STAGE(PG8_SA(0, 1), cA + hstepA, voffA);
        if (wr == 1) PG8_BAR;
        PG8_WAIT_V(4); PG8_BAR;
        PG8_STAGE(PG8_SB(1, 0), cB + kstep, voffB); PG8_STAGE(PG8_SA(1, 0), cA + kstep, voffA); PG8_STAGE(PG8_SB(1, 1), cB + hstepB + kstep, voffB);
        PG8_WAIT_V(6); PG8_BAR;
    }
    for (;;) {
        const bool has_next = S.next(ui + 1, nxt);
        const char* nA = has_next ? (const char*)g.A + (size_t)nxt.pm * tstepA : cA; const char* nB = has_next ? (const char*)g.Bt + (size_t)nxt.pn * tstepB : cB;
        for (int t = 0; t < nt; t += 2) {
            const bool last = (t == nt - 2);
            const char* a1 = cA + (size_t)(t + 1) * kstep;
            const char* a2 = last ? nA : cA + (size_t)(t + 2) * kstep; const char* b2 = last ? nB : cB + (size_t)(t + 2) * kstep;
            const char* a3 = a2 + kstep; const char* b3 = b2 + kstep;
            if (last && has_next) S.a_ready(nxt);
            if constexpr (SP2) {
            PG8_LDB(B0, 0, 0); PG8_LDB(B1, 0, 1); PG8_SCHED; PG8_LDA(At, 0, 0); PG8_STAGE(PG8_SA(1, 1), a1 + hstepA, voffA);
            PG8_WAIT_V(8); PG8_WAIT_L(0); PG8_BAR; PG8_MMA(0, 0, At, B0); PG8_MMA(0, 1, At, B1); PG8_BAR; PG8_SCHED;
            PG8_LDA(At, 0, 1); PG8_STAGE(PG8_SB(0, 0), b2, voffB); PG8_STAGE(PG8_SB(0, 1), b2 + hstepB, voffB); PG8_STAGE(PG8_SA(0, 0), a2, voffA);
            PG8_WAIT_V(8); PG8_WAIT_L(0); PG8_BAR; PG8_MMA(1, 0, At, B0); PG8_MMA(1, 1, At, B1); PG8_BAR; PG8_SCHED;
            PG8_LDB(B0, 1, 0); PG8_LDB(B1, 1, 1); PG8_SCHED; PG8_LDA(At, 1, 0); PG8_STAGE(PG8_SA(0, 1), a2 + hstepA, voffA);
            PG8_WAIT_V(8); PG8_WAIT_L(0); PG8_BAR; PG8_MMA(0, 0, At, B0); PG8_MMA(0, 1, At, B1); PG8_BAR; PG8_SCHED;
            PG8_LDA(At, 1, 1); PG8_STAGE(PG8_SB(1, 0), b3, voffB); PG8_STAGE(PG8_SB(1, 1), b3 + hstepB, voffB); PG8_STAGE(PG8_SA(1, 0), a3, voffA);
            PG8_WAIT_V(8); PG8_WAIT_L(0); PG8_BAR; PG8_MMA(1, 0, At, B0); PG8_MMA(1, 1, At, B1); PG8_BAR; PG8_SCHED;
            } else {
            PG8_LDB(B0, 0, 0); PG8_SCHED; PG8_LDA(At, 0, 0); PG8_STAGE(PG8_SA(1, 1), a1 + hstepA, voffA);
            PG8_WAIT_L(8); PG8_BAR; PG8_WAIT_L(0); PG8_MMA(0, 0, At, B0); PG8_BAR; PG8_SCHED;
            PG8_LDB(B1, 0, 1); PG8_STAGE(PG8_SB(0, 0), b2, voffB);
            PG8_BAR; PG8_WAIT_L(0); PG8_MMA(0, 1, At, B1); PG8_BAR;
            PG8_LDA(At, 0, 1); PG8_STAGE(PG8_SA(0, 0), a2, voffA);
            PG8_BAR; PG8_WAIT_L(0); PG8_MMA(1, 0, At, B0); PG8_BAR; PG8_SCHED;
            PG8_STAGE(PG8_SB(0, 1), b2 + hstepB, voffB);
            PG8_WAIT_V(6); PG8_BAR; PG8_MMA(1, 1, At, B1); PG8_BAR;
            PG8_LDB(B0, 1, 0); PG8_SCHED; PG8_LDA(At, 1, 0); PG8_STAGE(PG8_SA(0, 1), a2 + hstepA, voffA);
            PG8_WAIT_L(8); PG8_BAR; PG8_WAIT_L(0); PG8_MMA(0, 0, At, B0); PG8_BAR; PG8_SCHED;
            PG8_LDB(B1, 1, 1); PG8_STAGE(PG8_SB(1, 0), b3, voffB);
            PG8_BAR; PG8_WAIT_L(0); PG8_MMA(0, 1, At, B1); PG8_BAR;
            PG8_LDA(At, 1, 1); PG8_STAGE(PG8_SA(1, 0), a3, voffA);
            PG8_BAR; PG8_WAIT_L(0); PG8_MMA(1, 0, At, B0); PG8_BAR; PG8_SCHED;
            PG8_STAGE(PG8_SB(1, 1), b3 + hstepB, voffB);
            PG8_WAIT_V(6); PG8_BAR; PG8_MMA(1, 1, At, B1); PG8_BAR;
            }
        }
        if constexpr (ALIGN_EPI) { if (wr == 0) PG8_BAR; }
        if constexpr (!Epi::AFTER_DRAIN) { E(acc, cur, wr, wc, fr, fq); S.done(cur); }
        if (!has_next) break;
#pragma unroll
        for (int a = 0; a < 2; ++a)
#pragma unroll
            for (int b = 0; b < 2; ++b)
#pragma unroll
                for (int m = 0; m < 4; ++m)
#pragma unroll
                    for (int n = 0; n < 2; ++n) acc[a][b][m][n] = (f32x4){0.f, 0.f, 0.f, 0.f};
        cur = nxt; cA = nA; cB = nB; ++ui;
        if constexpr (ALIGN_EPI) { if (wr == 1) PG8_BAR; }
    }
    PG8_WAIT_V(0);
    if constexpr (!ALIGN_EPI) { if (wr == 0) PG8_BAR; }
    PG8_BAR;
    if constexpr (Epi::AFTER_DRAIN) { E.fused(acc, cur, wr, wc, fr, fq, lds, wid, lane); S.done(cur); }
#undef PG8_SA
#undef PG8_SB
#undef PG8_STAGE
#undef PG8_LDA
#undef PG8_LDB
#undef PG8_MMA
#undef PG8_WAIT_V
#undef PG8_WAIT_L
#undef PG8_BAR
#undef PG8_SCHED
}
}

constexpr int NB = 4, SEQ = 4096, DM = 1024, DEPTH = 4, M = NB * SEQ;
constexpr int INC = 7088;
constexpr int NIN = 7168;
constexpr int FFH = 2816, FF2 = 5632;
constexpr int ZP = pg8::ZP, ZSP = pg8::ZSP;
constexpr int Z_FQ = 0, Z_FK = 512, Z_FV = 1024, Z_DQ = 1536, Z_RV = 2048, Z_RQ = 2560, Z_RK = 2816, Z_RG = 3072, Z_ZG = 3584, Z_MRG = 2560;
constexpr int S_IQ = 0, S_DK = 256, S_DV = 320, S_IK = 384, S_IW = 416, S_FF = 424;
constexpr float NORM_EPS = 1e-6f;
constexpr float LOG2E = 1.4426950408889634f;
constexpr float C2 = 0.125f * 1.4426950408889634f;

constexpr size_t MiB = 1u << 20;
constexpr size_t WS_CTL = 0, CTL_ZERO_BYTES = 1 * MiB;
constexpr size_t WS_ROPE64 = 1 * MiB;
constexpr size_t WS_ROPE32 = 2 * MiB;
constexpr size_t WS_LF = 2 * MiB + 512 * 1024;
constexpr size_t WS_CF = 3 * MiB;
constexpr size_t WS_ISG = 3 * MiB + 512 * 1024;
constexpr size_t WS_KD = 4 * MiB;
constexpr size_t WS_VD = 6 * MiB;
constexpr size_t WS_W = 8 * MiB;
constexpr size_t LW_IN = 0, LW_MIX = (size_t)NIN * 1024, LW_O = LW_MIX + 1536 * 1024, LW_FI = LW_O + 1024 * 1024, LW_FO = LW_FI + (size_t)FF2 * 1024, LW_STRIDE = LW_FO + (size_t)FFH * 1024;
constexpr size_t WS_Z = 150 * MiB;
constexpr size_t WS_HDN = 358 * MiB;
constexpr size_t WS_ZS = 390 * MiB;
constexpr size_t WS_END = 422 * MiB;
static_assert(WS_W + DEPTH * LW_STRIDE * 2 <= WS_Z && WS_Z + (size_t)M * ZP * 2 <= WS_HDN && WS_HDN + (size_t)M * 1024 * 2 == WS_ZS && WS_ZS + (size_t)M * ZSP * 4 == WS_END, "d_ws map");
constexpr int CW_BAR = 4096;

constexpr int RING_OFF = 0, RING_BYTES = 131072;
constexpr int LDSCTL_OFF = RING_BYTES, MISC_OFF = LDSCTL_OFF + 320;
constexpr int XTRA_OFF = RING_BYTES + 1024;
constexpr int LDS_BYTES = 147456;
constexpr int NWAVES = 8;
#define GAS __attribute__((address_space(1)))
#define LAS __attribute__((address_space(3)))
typedef unsigned short bf16;
typedef unsigned v4u __attribute__((ext_vector_type(4)));
typedef float f32x4 __attribute__((ext_vector_type(4)));
typedef short bf16x8 __attribute__((ext_vector_type(8)));
typedef GAS unsigned gu32;
typedef GAS unsigned long long gu64;
#define RLX_AGENT __ATOMIC_RELAXED, __HIP_MEMORY_SCOPE_AGENT
#define LDS_WAIT() asm volatile("s_waitcnt lgkmcnt(0)" ::: "memory")
#define VM_WAIT() asm volatile("s_waitcnt vmcnt(0)" ::: "memory")
__device__ __forceinline__ unsigned long long rt() { return __builtin_amdgcn_s_memrealtime(); }
__device__ __forceinline__ unsigned f2bf(float f) { unsigned u = __builtin_bit_cast(unsigned, f); return (u + 0x7fffu + ((u >> 16) & 1u)) >> 16; }
__device__ __forceinline__ unsigned pk2(float lo, float hi) { return f2bf(lo) | (f2bf(hi) << 16); }

#define XB_TMO      128
#define XB_XCNT(j)  (256  + 64 * (j))
#define XB_XSUB(j)  (1280 + 64 * (j))
#define XB_XGEN(j)  (2304 + 64 * (j))
#define XB_TOP      3328
#define XB_TOPGEN   3392
#define XCD_BAR_WORDS 3456
#define XB_SPIN_CAP (1u << 22)

__device__ __forceinline__ unsigned xb_ld(unsigned* p)              { return __hip_atomic_load(p, __ATOMIC_RELAXED, __HIP_MEMORY_SCOPE_AGENT); }
__device__ __forceinline__ unsigned xb_add(unsigned* p, unsigned v) { return __hip_atomic_fetch_add(p, v, __ATOMIC_RELAXED, __HIP_MEMORY_SCOPE_AGENT); }
__device__ __forceinline__ unsigned xb_xcc_id() { return (unsigned)__builtin_amdgcn_s_getreg((3 << 11) | 20) & 0xFu; }
#define XB_SPIN(cond, bar) do { unsigned _sp = 0; while (cond) { __builtin_amdgcn_s_sleep(1); \
    if ((++_sp & 255u) == 0u) { if (xb_ld(&(bar)[XB_TMO])) break; if (_sp > XB_SPIN_CAP) { atomicAdd(&(bar)[XB_TMO], 1u); break; } } } } while (0)

struct XcdBarrier {
    unsigned* bar; unsigned x; int w;
    volatile LAS unsigned* st;
};

__device__ __forceinline__ XcdBarrier xcd_barrier_post(unsigned* bar, volatile LAS unsigned* st) {
    XcdBarrier b; b.bar = bar; b.x = xb_xcc_id(); b.st = st; b.w = 0;
    if (threadIdx.x == 0) (void)xb_add(&bar[XB_XCNT(b.x)], 1u);
    return b;
}
__device__ __forceinline__ void xcd_barrier_complete(unsigned* bar, unsigned x, unsigned& nloc, unsigned& nx) {
    const unsigned G = gridDim.x * gridDim.y * gridDim.z;
    unsigned sum, cnt, mine, sp = 0u;
    for (;;) {
        sum = 0u; cnt = 0u; mine = 0u;
#pragma unroll
        for (unsigned j = 0; j < 16; ++j) { const unsigned c = xb_ld(&bar[XB_XCNT(j)]); sum += c; cnt += (c > 0u) ? 1u : 0u; mine = (j == x) ? c : mine; }
        if (sum == G) break;
        __builtin_amdgcn_s_sleep(1);
        if ((++sp & 255u) == 0u) { if (xb_ld(&bar[XB_TMO])) break; if (sp > XB_SPIN_CAP) { atomicAdd(&bar[XB_TMO], 1u); break; } }
    }
    nloc = mine > 0u ? mine : 1u; nx = cnt > 0u ? cnt : 1u;
}

__device__ __forceinline__ void xcd_barrier(const XcdBarrier& b) {
    asm volatile("s_waitcnt vmcnt(0)" ::: "memory");
    __syncthreads();
    if (b.w == 0 && lane_id_v() == 0) {
        unsigned* bar = b.bar;
        __builtin_amdgcn_s_waitcnt(0);
        unsigned nloc = b.st[0], nx = b.st[1];
        if (nloc == 0u) { xcd_barrier_complete(bar, b.x, nloc, nx); b.st[0] = nloc; b.st[1] = nx; }
        const unsigned old = xb_add(&bar[XB_XSUB(b.x)], 1u);
        const unsigned gen = old / nloc;
        if (old + 1u == (gen + 1u) * nloc) {
            __builtin_amdgcn_fence(__ATOMIC_RELEASE, "agent");
            asm volatile("s_waitcnt vmcnt(0)" ::: "memory");
            const unsigned og = xb_add(&bar[XB_TOP], 1u);
            const unsigned tg = og / nx;
            if (og + 1u == (tg + 1u) * nx) xb_add(&bar[XB_TOPGEN], 1u);
            else XB_SPIN(xb_ld(&bar[XB_TOPGEN]) == tg, bar);
            __builtin_amdgcn_fence(__ATOMIC_ACQUIRE, "agent");
            xb_add(&bar[XB_XGEN(b.x)], 1u);
            asm volatile("s_waitcnt vmcnt(0)" ::: "memory");
        } else {
            XB_SPIN(xb_ld(&bar[XB_XGEN(b.x)]) == gen, bar);
            __builtin_amdgcn_fence(__ATOMIC_ACQUIRE, "agent");
            asm volatile("s_waitcnt vmcnt(0)" ::: "memory");
        }
    }
    __syncthreads();
}

typedef float f32x2 __attribute__((ext_vector_type(2)));
typedef unsigned u32x2 __attribute__((ext_vector_type(2)));
__device__ __forceinline__ float bflo(unsigned w) { return __builtin_bit_cast(float, w << 16); }
__device__ __forceinline__ float bfhi(unsigned w) { return __builtin_bit_cast(float, w & 0xffff0000u); }
__device__ __forceinline__ float bf2f(bf16 v) { return __builtin_bit_cast(float, (unsigned)v << 16); }
__device__ __forceinline__ void unpack8(const v4u w, float (&f)[8]) { f[0] = bflo(w.x); f[1] = bfhi(w.x); f[2] = bflo(w.y); f[3] = bfhi(w.y); f[4] = bflo(w.z); f[5] = bfhi(w.z); f[6] = bflo(w.w); f[7] = bfhi(w.w); }
__device__ __forceinline__ v4u pack8(const float (&f)[8]) { v4u w; w.x = pk2(f[0], f[1]); w.y = pk2(f[2], f[3]); w.z = pk2(f[4], f[5]); w.w = pk2(f[6], f[7]); return w; }
template <int MASK> __device__ __forceinline__ float sx(float v) { static_assert(MASK < 32, "swizzle xor mask"); return __builtin_bit_cast(float, __builtin_amdgcn_ds_swizzle(__builtin_bit_cast(int, v), 0x1F | (MASK << 10))); }
template <int MASK> __device__ __forceinline__ unsigned sxu(unsigned v) { return (unsigned)__builtin_amdgcn_ds_swizzle((int)v, 0x1F | (MASK << 10)); }
__device__ __forceinline__ void swap32(unsigned x, unsigned& lo_view, unsigned& hi_view) {
    unsigned a = x, b = x; asm volatile("" : "+v"(b));
    const auto rr = __builtin_amdgcn_permlane32_swap(a, b, false, false);
    lo_view = rr[0]; hi_view = rr[1];
}
__device__ __forceinline__ float wave_sum(float v) {
    v += sx<1>(v); v += sx<2>(v); v += sx<4>(v); v += sx<8>(v); v += sx<16>(v);
    return __builtin_bit_cast(float, __builtin_amdgcn_readlane(__builtin_bit_cast(int, v), 0)) + __builtin_bit_cast(float, __builtin_amdgcn_readlane(__builtin_bit_cast(int, v), 32));
}
__device__ __forceinline__ float wave_max(float v) {
    v = fmaxf(v, sx<1>(v)); v = fmaxf(v, sx<2>(v)); v = fmaxf(v, sx<4>(v)); v = fmaxf(v, sx<8>(v)); v = fmaxf(v, sx<16>(v));
    return fmaxf(__builtin_bit_cast(float, __builtin_amdgcn_readlane(__builtin_bit_cast(int, v), 0)), __builtin_bit_cast(float, __builtin_amdgcn_readlane(__builtin_bit_cast(int, v), 32)));
}
__device__ __forceinline__ float half_sum(float v) {
    unsigned a, b; swap32(__builtin_bit_cast(unsigned, v), a, b); return __builtin_bit_cast(float, a) + __builtin_bit_cast(float, b);
}
__device__ __forceinline__ float half_max(float v) {
    unsigned a, b; swap32(__builtin_bit_cast(unsigned, v), a, b); return fmaxf(__builtin_bit_cast(float, a), __builtin_bit_cast(float, b));
}
__device__ __forceinline__ float xor32(float v, int lane) {
    return __builtin_bit_cast(float, __builtin_amdgcn_ds_bpermute((lane ^ 32) << 2, __builtin_bit_cast(int, v)));
}
__device__ __forceinline__ float sigmoid_f(float x) { return 1.0f / (1.0f + __expf(-x)); }

struct Ctx {
    LAS unsigned char* lds;
    int tid, lane, wave, G, gw, NGW;
    float* out; unsigned char* ws;
};

__device__ __forceinline__ void conv_item(const float* W, int N, int sc, int nv, int k0, bf16* WT, int ldw, int dr, LAS float* scr, int lane) {
    const int n_ = lane & 31;
#pragma unroll 8
    for (int i = 0; i < 32; ++i) { const int kk = 2 * i + (lane >> 5); scr[kk * 33 + n_] = (n_ < nv) ? W[(size_t)(k0 + kk) * N + sc + n_] : 0.f; }
    LDS_WAIT(); asm volatile("" ::: "memory");
    const int c = lane & 7;
#pragma unroll
    for (int j = 0; j < 4; ++j) { const int n = (lane >> 3) + 8 * j; const LAS float* s = scr + (8 * c) * 33 + n;
        v4u o; o.x = pk2(s[0 * 33], s[1 * 33]); o.y = pk2(s[2 * 33], s[3 * 33]); o.z = pk2(s[4 * 33], s[5 * 33]); o.w = pk2(s[6 * 33], s[7 * 33]);
        if (n < nv) *(GAS v4u*)(WT + (size_t)(dr + n) * ldw + k0 + 8 * c) = o; }
    LDS_WAIT(); asm volatile("" ::: "memory");
}
__device__ const int SEG_IN[15][3] = {
    {0, 0, 512}, {512, 512, 512}, {1024, 1024, 512}, {1536, 6656 + S_FF, 8}, {1544, Z_DQ, 512}, {2056, 6656 + S_DK, 64}, {2120, 6656 + S_DV, 64},
    {2184, 6656 + S_IQ, 256}, {2440, 6656 + S_IK, 32}, {2472, 6656 + S_IW, 8}, {2480, Z_RQ, 256}, {2736, Z_RK, 256}, {2992, Z_RV, 512}, {3504, Z_RG, 512}, {4016, Z_ZG, 3072}};
constexpr int IN_BLK = 223;
constexpr int IT_IN = 16 * IN_BLK, IT_MIX = 8 * 32, IT_O = 16 * 32, IT_FI = 16 * (FF2 / 32), IT_FO = (FFH / 64) * 32;
constexpr int IT_LAYER = IT_IN + 3 * IT_MIX + IT_O + IT_FI + IT_FO;

__device__ __forceinline__ void sincos_acc(float ang, float& c, float& s) {
    const double a = (double)ang;
    const double k = __builtin_rint(a * 0.6366197723675814);
    double y = a - k * 1.5707963267948966; y -= k * 6.123233995736766e-17;
    const double y2 = y * y;
    double sp = -7.647163731819816e-13; sp = sp * y2 + 1.6059043836821613e-10; sp = sp * y2 - 2.505210838544172e-08; sp = sp * y2 + 2.7557319223985893e-06; sp = sp * y2 - 1.984126984126984e-04; sp = sp * y2 + 8.333333333333333e-03; sp = sp * y2 - 1.6666666666666666e-01;
    const double sn = y + y * y2 * sp;
    double cp = 4.779477332387385e-14; cp = cp * y2 - 1.1470745597729725e-11; cp = cp * y2 + 2.08767569878681e-09; cp = cp * y2 - 2.755731922398589e-07; cp = cp * y2 + 2.48015873015873e-05; cp = cp * y2 - 1.388888888888889e-03; cp = cp * y2 + 4.1666666666666664e-02; cp = cp * y2 - 0.5;
    const double cs = 1.0 + y2 * cp;
    const int q = ((int)k) & 3;
    const double ss = (q & 1) ? cs : sn, cc = (q & 1) ? sn : cs;
    s = (float)((q & 2) ? -ss : ss);
    c = (float)(((q + 1) & 2) ? -cc : cc);
}

__device__ __forceinline__ void p0_prologue(const Ctx& F, const float* w_in, const float* w_fox, const float* w_dsa, const float* w_ret, const float* w_o, const float* w_fi, const float* w_fo) {
    LAS float* scr = (LAS float*)(F.lds + RING_OFF + F.wave * 16384);
    bf16* Wb = (bf16*)(F.ws + WS_W);
    for (int it = F.gw; it < DEPTH * IT_LAYER; it += F.NGW) {
        const int l = it / IT_LAYER; int r = it % IT_LAYER;
        bf16* L = Wb + (size_t)l * LW_STRIDE;
        if (r < IT_IN) {
            const int kb = r / IN_BLK; int blk = r % IN_BLK; int sc = 0, dr = 0, nv = 0;
            for (int s = 0; s < 15; ++s) { const int w = SEG_IN[s][2], nb = (w + 31) >> 5; if (blk < nb) { sc = SEG_IN[s][0] + 32 * blk; dr = SEG_IN[s][1] + 32 * blk; nv = (w - 32 * blk) < 32 ? (w - 32 * blk) : 32; break; } blk -= nb; }
            conv_item(w_in + (size_t)l * DM * INC, INC, sc, nv, 64 * kb, L + LW_IN, 1024, dr, scr, F.lane); continue; }
        r -= IT_IN;
        if (r < 3 * IT_MIX) { const int w = r / IT_MIX, q = r % IT_MIX, kb = q / 32, nb = q % 32;
            conv_item((w == 0 ? w_fox : w == 1 ? w_dsa : w_ret) + (size_t)l * 512 * DM, DM, 32 * nb, 32, 64 * kb, L + LW_MIX + (size_t)w * 512 * 1024, 512, 32 * nb, scr, F.lane); continue; }
        r -= 3 * IT_MIX;
        if (r < IT_O) { const int kb = r / 32, nb = r % 32;
            conv_item(w_o + (size_t)l * DM * DM, DM, 32 * nb, 32, 64 * kb, L + LW_O, 1024, 32 * nb, scr, F.lane); continue; }
        r -= IT_O;
        if (r < IT_FI) { const int kb = r / (FF2 / 32), nb = r % (FF2 / 32); const int n0 = 32 * nb;
            const int j = n0 < FFH ? n0 : n0 - FFH; const int dr = 256 * (j >> 7) + (j & 127) + (n0 < FFH ? 0 : 128);
            conv_item(w_fi + (size_t)l * DM * FF2, FF2, n0, 32, 64 * kb, L + LW_FI, 1024, dr, scr, F.lane); continue; }
        r -= IT_FI;
        { const int kb = r / 32, nb = r % 32;
            conv_item(w_fo + (size_t)l * FFH * DM, DM, 32 * nb, 32, 64 * kb, L + LW_FO, FFH, 32 * nb, scr, F.lane); }
    }
    for (int i = F.gw * 64 + F.lane; i < DEPTH * 80 * 128; i += F.NGW * 64) { const int l = i / (80 * 128), q = i % (80 * 128);
        *(GAS v4u*)(Wb + (size_t)l * LW_STRIDE + LW_IN + (size_t)INC * 1024 + (size_t)q * 8) = (v4u){0u, 0u, 0u, 0u}; }
    f32x2* R64 = (f32x2*)(F.ws + WS_ROPE64); f32x2* R32 = (f32x2*)(F.ws + WS_ROPE32);
    for (int i = F.gw * 64 + F.lane; i < SEQ * 32; i += F.NGW * 64) { const int pos = i >> 5, k = i & 31;
        double f = 1.0; for (int e = 0; e < k; ++e) f *= 0.7498942093324559;
        const float ang = (float)pos * (float)f; float c, s; sincos_acc(ang, c, s); R64[i] = (f32x2){c, s}; }
    for (int i = F.gw * 64 + F.lane; i < SEQ * 16; i += F.NGW * 64) { const int pos = i >> 4, k = i & 15;
        double f = 1.0; for (int e = 0; e < k; ++e) f *= 0.5623413251903491;
        const float ang = (float)pos * (float)f; float c, s; sincos_acc(ang, c, s); R32[i] = (f32x2){c, s}; }
}

__device__ __forceinline__ void rmsnorm_phase(const Ctx& F, const float* x, const float* g, bf16* o) {
    const GAS f32x4* gp = (const GAS f32x4*)g + F.lane;
    f32x4 gv[4];
#pragma unroll
    for (int j = 0; j < 4; ++j) gv[j] = gp[64 * j];
    for (int m = F.gw; m < M; m += F.NGW) {
        const GAS f32x4* xr = (const GAS f32x4*)(x + (size_t)m * DM) + F.lane;
        f32x4 v[4]; float s = 0.f;
#pragma unroll
        for (int j = 0; j < 4; ++j) { v[j] = xr[64 * j]; s += (v[j].x * v[j].x + v[j].y * v[j].y) + (v[j].z * v[j].z + v[j].w * v[j].w); }
        const float rstd = 1.0f / sqrtf(wave_sum(s) * (1.f / DM) + NORM_EPS);
        GAS unsigned long long* o8 = (GAS unsigned long long*)(o + (size_t)m * DM) + F.lane;
#pragma unroll
        for (int j = 0; j < 4; ++j) o8[64 * j] = (unsigned long long)pk2(v[j].x * rstd * gv[j].x, v[j].y * rstd * gv[j].y) | ((unsigned long long)pk2(v[j].z * rstd * gv[j].z, v[j].w * rstd * gv[j].w) << 32);
    }
}

__device__ __forceinline__ void post_phase(const Ctx& F, const float* g_fq, const float* g_fk, const float* g_dq, const float* g_dk, const float* b_f) {
    bf16* Z = (bf16*)(F.ws + WS_Z); float* ZS = (float*)(F.ws + WS_ZS);
    const f32x2* R64 = (const f32x2*)(F.ws + WS_ROPE64); const f32x2* R32 = (const f32x2*)(F.ws + WS_ROPE32);
    float* LF = (float*)(F.ws + WS_LF); unsigned* ISG = (unsigned*)(F.ws + WS_ISG);
    bf16* KD = (bf16*)(F.ws + WS_KD); bf16* VD = (bf16*)(F.ws + WS_VD);
    const int lane = F.lane, c8 = lane & 7;
    float gq[8], gk[8], gd[8];
#pragma unroll
    for (int j = 0; j < 8; ++j) { gq[j] = g_fq[c8 * 8 + j]; gk[j] = g_fk[c8 * 8 + j]; gd[j] = g_dq[c8 * 8 + j]; }
    const float gdk = g_dk[lane];
    for (int m = F.gw; m < M; m += F.NGW) {
        const int pos = m & (SEQ - 1);
        bf16* zr = Z + (size_t)m * ZP; float* sr = ZS + (size_t)m * ZSP;
        { v4u w = *(const GAS v4u*)(zr + Z_FQ + 8 * lane); float f[8]; unpack8(w, f); float ss = 0.f;
#pragma unroll
            for (int j = 0; j < 8; ++j) ss += f[j] * f[j];
            ss += sx<1>(ss); ss += sx<2>(ss); ss += sx<4>(ss);
            const float rs = C2 / sqrtf(ss * (1.f / 64) + NORM_EPS);
#pragma unroll
            for (int j = 0; j < 8; ++j) f[j] = f[j] * rs * gq[j];
            *(GAS v4u*)(zr + Z_FQ + 8 * lane) = pack8(f); }
        { v4u w = *(const GAS v4u*)(zr + Z_FK + 8 * lane); float f[8]; unpack8(w, f); float ss = 0.f;
#pragma unroll
            for (int j = 0; j < 8; ++j) ss += f[j] * f[j];
            ss += sx<1>(ss); ss += sx<2>(ss); ss += sx<4>(ss);
            const float rs = 1.0f / sqrtf(ss * (1.f / 64) + NORM_EPS);
#pragma unroll
            for (int j = 0; j < 8; ++j) f[j] = f[j] * rs * gk[j];
            *(GAS v4u*)(zr + Z_FK + 8 * lane) = pack8(f); }
        { v4u w = *(const GAS v4u*)(zr + Z_DQ + 8 * lane); float f[8]; unpack8(w, f); float ss = 0.f;
#pragma unroll
            for (int j = 0; j < 8; ++j) ss += f[j] * f[j];
            ss += sx<1>(ss); ss += sx<2>(ss); ss += sx<4>(ss);
            const float rs = 1.0f / sqrtf(ss * (1.f / 64) + NORM_EPS);
            const f32x2* cs = R64 + pos * 32 + (c8 & 3) * 8;
#pragma unroll
            for (int j = 0; j < 8; ++j) { f[j] = f[j] * rs * gd[j]; }
            float o[8];
#pragma unroll
            for (int j = 0; j < 8; ++j) { const float p = sx<4>(f[j]); const f32x2 t = cs[j]; o[j] = ((c8 < 4) ? (f[j] * t.x - p * t.y) : (f[j] * t.x + p * t.y)) * C2; }
            *(GAS v4u*)(zr + Z_DQ + 8 * lane) = pack8(o); }
        { const f32x4 v = *(const GAS f32x4*)(sr + S_IQ + 4 * lane); float f[4] = {v.x, v.y, v.z, v.w};
            const float iw = sr[S_IW + (lane >> 3)]; const float aw = fabsf(iw);
            const f32x2* cs = R32 + pos * 16 + (lane & 3) * 4; const bool first = (lane & 7) < 4; f32x4 o;
#pragma unroll
            for (int j = 0; j < 4; ++j) { const float p = sx<4>(f[j]); const f32x2 t = cs[j]; o[j] = (first ? (f[j] * t.x - p * t.y) : (f[j] * t.x + p * t.y)) * aw; }
            const unsigned long long neg = __ballot(iw < 0.f);
            unsigned sg = 0;
#pragma unroll
            for (int h = 0; h < 8; ++h) sg |= (unsigned)((neg >> (8 * h)) & 1ull) << h;
            *(GAS f32x4*)(sr + S_IQ + 4 * lane) = o;
            if (lane == 0) ISG[m] = sg; }
        { float v = sr[S_DK + lane]; const float ss = wave_sum(v * v); v = v * (1.0f / sqrtf(ss * (1.f / 64) + NORM_EPS)) * gdk;
            const float p = xor32(v, lane); const f32x2 t = R64[pos * 32 + (lane & 31)];
            const float o = (lane < 32) ? (v * t.x - p * t.y) : (v * t.x + p * t.y);
            KD[(size_t)m * 64 + lane] = (bf16)f2bf(o);
            VD[(size_t)m * 64 + lane] = (bf16)f2bf(sr[S_DV + lane]); }
        { const float v = sr[S_IK + (lane & 31)]; const float p = sx<16>(v); const f32x2 t = R32[pos * 16 + (lane & 15)];
            const float o = ((lane & 16) == 0) ? (v * t.x - p * t.y) : (v * t.x + p * t.y);
            if (lane < 32) sr[S_IK + lane] = o; }
        if (lane < 8) { const float xx = sr[S_FF + lane] + b_f[lane]; const float ls = fminf(xx, 0.f) - __logf(1.0f + __expf(-fabsf(xx))); LF[(size_t)m * 8 + lane] = ls * LOG2E; }
    }
}

__device__ __forceinline__ float ret_l2g(int h) { return h == 0 ? -0.04580368961312479f : h == 1 ? -0.02272007650008353f : h == 2 ? -0.011315313227834146f : -0.005646563141142063f; }

__device__ __forceinline__ void scan_state_phase(const Ctx& F) {
    const float* LF = (const float*)(F.ws + WS_LF); float* CF = (float*)(F.ws + WS_CF);
    const bf16* Z = (const bf16*)(F.ws + WS_Z); float* RS = (float*)(F.ws + WS_HDN);
    if (F.gw < 32) {
        const int b = F.gw >> 3, h = F.gw & 7; const float* lp = LF + ((size_t)b * SEQ + F.lane * 64) * 8 + h; float s = 0.f;
        for (int i = 0; i < 64; ++i) s += lp[i * 8];
        float incl = s;
#pragma unroll
        for (int o = 1; o < 64; o <<= 1) { const float t = __builtin_bit_cast(float, __builtin_amdgcn_ds_bpermute(((F.lane - o) & 63) << 2, __builtin_bit_cast(int, incl))); if (F.lane >= o) incl += t; }
        float run = incl - s; float* cp = CF + (size_t)F.gw * SEQ + F.lane * 64;
        for (int i = 0; i < 64; ++i) { run += lp[i * 8]; cp[i] = run; }
    }
    for (int u = blockIdx.x; u < NB * 32 * 4; u += F.G) {
        const int h = u & 3, c = (u >> 2) & 31, b = u >> 7; const float l2g = ret_l2g(h);
        const int d = F.tid >> 3, e0 = (F.tid & 7) * 16; float acc[16];
#pragma unroll
        for (int i = 0; i < 16; ++i) acc[i] = 0.f;
        const bf16* base = Z + ((size_t)b * SEQ + c * 128) * ZP;
        for (int j = 0; j < 128; ++j) { const bf16* row = base + (size_t)j * ZP;
            const float kd = bf2f(row[Z_RK + h * 64 + d]) * exp2f((float)(127 - j) * l2g);
            const v4u w0 = *(const GAS v4u*)(row + Z_RV + h * 128 + e0), w1 = *(const GAS v4u*)(row + Z_RV + h * 128 + e0 + 8);
            float v0[8], v1[8]; unpack8(w0, v0); unpack8(w1, v1);
#pragma unroll
            for (int i = 0; i < 8; ++i) { acc[i] += kd * v0[i]; acc[8 + i] += kd * v1[i]; } }
        float* o = RS + (size_t)u * 8192 + d * 128 + e0;
#pragma unroll
        for (int i = 0; i < 4; ++i) *(GAS f32x4*)(o + 4 * i) = (f32x4){acc[4 * i], acc[4 * i + 1], acc[4 * i + 2], acc[4 * i + 3]};
    }
}

__device__ __forceinline__ void ret_out_naive(const Ctx& F, const float* gn) {
    bf16* Z = (bf16*)(F.ws + WS_Z); const float* RS = (const float*)(F.ws + WS_HDN);
    LAS float* S = (LAS float*)(F.lds);
    LAS bf16* Vt = (LAS bf16*)(F.lds + 32768);
    LAS float* Kt = (LAS float*)(F.lds + 65536);
    LAS float* aw = (LAS float*)(F.lds + 65536 + 33280) + F.wave * 128;
    LAS float* qw = (LAS float*)(F.lds + 65536 + 33280 + 4096) + F.wave * 64;
    for (int u = blockIdx.x; u < NB * 32 * 4; u += F.G) {
        const int h = u & 3, c = (u >> 2) & 31, b = u >> 7; const float l2g = ret_l2g(h); const float wch = exp2f(128.f * l2g);
        __syncthreads();
        { float s[16];
#pragma unroll
            for (int i = 0; i < 16; ++i) s[i] = 0.f;
            for (int cp = 0; cp < c; ++cp) { const float* L = RS + ((size_t)((b * 32 + cp) * 4 + h)) * 8192 + F.tid;
#pragma unroll
                for (int i = 0; i < 16; ++i) s[i] = wch * s[i] + L[i * 512]; }
#pragma unroll
            for (int i = 0; i < 16; ++i) S[F.tid + i * 512] = s[i]; }
        const bf16* base = Z + ((size_t)b * SEQ + c * 128) * ZP;
        for (int q = F.tid; q < 2048; q += 512) { const int r = q >> 4, ch = q & 15; *(LAS v4u*)(Vt + r * 128 + ch * 8) = *(const GAS v4u*)(base + (size_t)r * ZP + Z_RV + h * 128 + ch * 8); }
        for (int q = F.tid; q < 128 * 64; q += 512) { const int r = q >> 6, dd = q & 63; Kt[r * 65 + dd] = bf2f(base[(size_t)r * ZP + Z_RK + h * 64 + dd]); }
        __syncthreads();
        for (int i = F.wave; i < 128; i += NWAVES) {
            const size_t m = (size_t)b * SEQ + c * 128 + i; bf16* zr = Z + m * ZP;
            qw[F.lane] = bf2f(zr[Z_RQ + h * 64 + F.lane]);
            LDS_WAIT(); asm volatile("" ::: "memory");
#pragma unroll
            for (int jj = 0; jj < 2; ++jj) { const int j = F.lane + 64 * jj; float a = 0.f;
                if (j <= i) { float dot = 0.f; for (int dd = 0; dd < 64; ++dd) dot += qw[dd] * Kt[j * 65 + dd]; a = dot * exp2f((float)(i - j) * l2g); }
                aw[j] = a; }
            LDS_WAIT(); asm volatile("" ::: "memory");
            float o[2]; const float dq = exp2f((float)(i + 1) * l2g);
#pragma unroll
            for (int ee = 0; ee < 2; ++ee) { const int e = F.lane + 64 * ee; float acc = 0.f;
                for (int j = 0; j <= i; ++j) acc += aw[j] * bf2f(Vt[j * 128 + e]);
                float cr = 0.f; for (int dd = 0; dd < 64; ++dd) cr += qw[dd] * S[dd * 128 + e];
                o[ee] = acc + cr * dq; }
            const float ss = wave_sum(o[0] * o[0] + o[1] * o[1]); const float rstd = 1.0f / sqrtf(ss * (1.f / 128) + NORM_EPS);
#pragma unroll
            for (int ee = 0; ee < 2; ++ee) { const int e = F.lane + 64 * ee; const float rg = bf2f(zr[Z_RG + h * 128 + e]);
                zr[Z_RV + h * 128 + e] = (bf16)f2bf(o[ee] * rstd * gn[h * 128 + e] * rg * sigmoid_f(rg)); }
            LDS_WAIT(); asm volatile("" ::: "memory");
        }
    }
    __syncthreads();
}

__device__ __forceinline__ void fox_naive(const Ctx& F) {
    bf16* Z = (bf16*)(F.ws + WS_Z); const float* CF = (const float*)(F.ws + WS_CF);
    LAS float* sc = (LAS float*)(F.lds + F.wave * 16384);
    const int lane = F.lane;
    int it = 0;
    for (int r0 = 0; r0 < NB * 8 * SEQ; r0 += F.NGW, ++it) {
        const int r = r0 + ((it & 1) ? (F.NGW - 1 - F.gw) : F.gw);
        if (r >= NB * 8 * SEQ) continue;
        const int pos = r & (SEQ - 1), h = (r >> 12) & 7, b = r >> 15;
        const size_t m = (size_t)b * SEQ + pos;
        float qf[64];
        { const bf16* qp = Z + m * ZP + Z_FQ + h * 64;
#pragma unroll
            for (int i = 0; i < 8; ++i) { const v4u w = *(const GAS v4u*)(qp + 8 * i); float t[8]; unpack8(w, t);
#pragma unroll
                for (int j = 0; j < 8; ++j) qf[8 * i + j] = t[j]; } }
        const float* cf = CF + (size_t)(b * 8 + h) * SEQ;
        float mx = -INFINITY;
        for (int kk = lane; kk <= pos; kk += 64) { const bf16* kp = Z + ((size_t)b * SEQ + kk) * ZP + Z_FK + h * 64; float dot = 0.f;
#pragma unroll
            for (int i = 0; i < 8; ++i) { const v4u w = *(const GAS v4u*)(kp + 8 * i); float t[8]; unpack8(w, t);
#pragma unroll
                for (int j = 0; j < 8; ++j) dot += qf[8 * i + j] * t[j]; }
            const float s = dot - cf[kk]; sc[kk] = s; mx = fmaxf(mx, s); }
        mx = wave_max(mx);
        float sum = 0.f;
        for (int kk = lane; kk <= pos; kk += 64) { const float p = exp2f(sc[kk] - mx); sc[kk] = p; sum += p; }
        sum = wave_sum(sum);
        LDS_WAIT(); asm volatile("" ::: "memory");
        const bf16* vp = Z + (size_t)b * SEQ * ZP + Z_FV + h * 64 + lane;
        float o0 = 0.f, o1 = 0.f, o2 = 0.f, o3 = 0.f; int kk = 0;
        for (; kk + 3 <= pos; kk += 4) { o0 += sc[kk] * bf2f(vp[(size_t)kk * ZP]); o1 += sc[kk + 1] * bf2f(vp[(size_t)(kk + 1) * ZP]); o2 += sc[kk + 2] * bf2f(vp[(size_t)(kk + 2) * ZP]); o3 += sc[kk + 3] * bf2f(vp[(size_t)(kk + 3) * ZP]); }
        for (; kk <= pos; ++kk) o0 += sc[kk] * bf2f(vp[(size_t)kk * ZP]);
        Z[m * ZP + Z_FQ + h * 64 + lane] = (bf16)f2bf(((o0 + o1) + (o2 + o3)) / sum);
        LDS_WAIT(); asm volatile("" ::: "memory");
    }
}

__device__ __forceinline__ unsigned f2key(float s) { const unsigned u = __builtin_bit_cast(unsigned, s + 0.0f); return (u & 0x80000000u) ? ~u : (u | 0x80000000u); }
__device__ __forceinline__ void dsa_naive(const Ctx& F) {
    bf16* Z = (bf16*)(F.ws + WS_Z); const float* ZS = (const float*)(F.ws + WS_ZS);
    const unsigned* ISG = (const unsigned*)(F.ws + WS_ISG);
    const bf16* KD = (const bf16*)(F.ws + WS_KD); const bf16* VD = (const bf16*)(F.ws + WS_VD);
    LAS unsigned* kl = (LAS unsigned*)(F.lds + F.wave * 16384);
    LAS float* iqs = (LAS float*)(F.lds + XTRA_OFF + F.wave * 1536);
    const int lane = F.lane;
    int it = 0;
    for (int r0 = 0; r0 < M; r0 += F.NGW, ++it) {
        const int r = r0 + ((it & 1) ? (F.NGW - 1 - F.gw) : F.gw);
        if (r >= M) continue;
        const int pos = r & (SEQ - 1), b = r >> 12; const size_t m = (size_t)r;
        *(LAS f32x4*)(iqs + 4 * lane) = *(const GAS f32x4*)(ZS + m * ZSP + S_IQ + 4 * lane);
        const unsigned sg = ISG[m];
        LDS_WAIT(); asm volatile("" ::: "memory");
        for (int kk = lane; kk <= pos; kk += 64) { const float* ikp = ZS + ((size_t)b * SEQ + kk) * ZSP + S_IK; float ik[32];
#pragma unroll
            for (int i = 0; i < 8; ++i) { const f32x4 t = *(const GAS f32x4*)(ikp + 4 * i); ik[4 * i] = t.x; ik[4 * i + 1] = t.y; ik[4 * i + 2] = t.z; ik[4 * i + 3] = t.w; }
            float s = 0.f;
#pragma unroll 1
            for (int h = 0; h < 8; ++h) { float dot = 0.f;
#pragma unroll
                for (int dd = 0; dd < 32; ++dd) dot += iqs[h * 32 + dd] * ik[dd];
                dot = fmaxf(dot, 0.f); s += ((sg >> h) & 1u) ? -dot : dot; }
            kl[kk] = f2key(s); }
        LDS_WAIT(); asm volatile("" ::: "memory");
        unsigned key[64];
#pragma unroll
        for (int j = 0; j < 64; ++j) { const int kk = j * 64 + lane; key[j] = (kk <= pos) ? kl[kk] : 0u; }
        LDS_WAIT(); asm volatile("" ::: "memory");
        LAS unsigned* idx = kl; LAS float* pl = (LAS float*)(kl + 256); LAS bf16* qs = (LAS bf16*)(kl + 512);
        *(LAS v4u*)(qs + 8 * lane) = *(const GAS v4u*)(Z + m * ZP + Z_DQ + 8 * lane);
        unsigned T = 0u; int need = 0;
        if (pos + 1 > 256) {
            for (int bit = 31; bit >= 0; --bit) { const unsigned Tt = T | (1u << bit); int cnt = 0;
#pragma unroll
                for (int j = 0; j < 64; ++j) cnt += __builtin_popcountll(__ballot(key[j] >= Tt));
                if (cnt >= 256) T = Tt; }
            int ngt = 0;
#pragma unroll
            for (int j = 0; j < 64; ++j) ngt += __builtin_popcountll(__ballot(key[j] > T));
            need = 256 - ngt;
        }
        int nsel = 0, eqb = 0;
#pragma unroll
        for (int j = 0; j < 64; ++j) { const bool gt = key[j] > T, eq = (key[j] == T) && (T != 0u);
            const unsigned long long em = __ballot(eq); const int er = eqb + __builtin_amdgcn_mbcnt_hi((unsigned)(em >> 32), __builtin_amdgcn_mbcnt_lo((unsigned)em, 0u));
            const bool sel = gt || (eq && er < need); eqb += __builtin_popcountll(em);
            const unsigned long long sm = __ballot(sel); const int sp = nsel + __builtin_amdgcn_mbcnt_hi((unsigned)(sm >> 32), __builtin_amdgcn_mbcnt_lo((unsigned)sm, 0u));
            if (sel) idx[sp] = (unsigned)(j * 64 + lane); nsel += __builtin_popcountll(sm); }
        LDS_WAIT(); asm volatile("" ::: "memory");
        for (int h = 0; h < 8; ++h) {
            float sv[4]; float mx = -INFINITY;
#pragma unroll
            for (int i = 0; i < 4; ++i) { const int e = lane + 64 * i; sv[i] = -INFINITY;
                if (e < nsel) { const bf16* kp = KD + ((size_t)b * SEQ + idx[e]) * 64; float dot = 0.f;
#pragma unroll
                    for (int c = 0; c < 8; ++c) { const v4u w = *(const GAS v4u*)(kp + 8 * c); float t[8]; unpack8(w, t); const v4u qw = *(const LAS v4u*)(qs + h * 64 + 8 * c); float qq[8]; unpack8(qw, qq);
#pragma unroll
                        for (int j = 0; j < 8; ++j) dot += qq[j] * t[j]; }
                    sv[i] = dot; }
                mx = fmaxf(mx, sv[i]); }
            mx = wave_max(mx); float sum = 0.f;
#pragma unroll
            for (int i = 0; i < 4; ++i) { const int e = lane + 64 * i; const float p = (e < nsel) ? exp2f(sv[i] - mx) : 0.f; pl[e] = p; sum += p; }
            sum = wave_sum(sum);
            LDS_WAIT(); asm volatile("" ::: "memory");
            float o0 = 0.f, o1 = 0.f; int e = 0;
            for (; e + 1 < nsel; e += 2) { o0 += pl[e] * bf2f(VD[((size_t)b * SEQ + idx[e]) * 64 + lane]); o1 += pl[e + 1] * bf2f(VD[((size_t)b * SEQ + idx[e + 1]) * 64 + lane]); }
            if (e < nsel) o0 += pl[e] * bf2f(VD[((size_t)b * SEQ + idx[e]) * 64 + lane]);
            Z[m * ZP + Z_DQ + h * 64 + lane] = (bf16)f2bf((o0 + o1) / sum);
            LDS_WAIT(); asm volatile("" ::: "memory");
        }
    }
}

typedef short s16x8 __attribute__((ext_vector_type(8)));
typedef short s16x4 __attribute__((ext_vector_type(4)));
typedef short v4i16_t __attribute__((ext_vector_type(4)));
__device__ __forceinline__ s16x4 tr16(const LAS unsigned char* p) { return __builtin_bit_cast(s16x4, __builtin_amdgcn_ds_read_tr16_b64_v4i16((LAS v4i16_t*)p)); }
__device__ __forceinline__ float key2f(unsigned k) { return __builtin_bit_cast(float, (k & 0x80000000u) ? (k & 0x7fffffffu) : ~k); }

#define DSA_COUNT_GE(T_, out_) do { int c_ = 0; _Pragma("unroll") for (int j_ = 0; j_ < 64; ++j_) c_ += __builtin_popcountll(__ballot(key[j_] >= (T_))); out_ = c_; } while (0)
__device__ __forceinline__ void dsa_select(const unsigned (&key)[64], int nvalid, unsigned& T, int& need) {
    T = 0u; need = 0;
    if (nvalid <= 256) return;
    unsigned kmax = 0u;
#pragma unroll
    for (int j = 0; j < 64; ++j) kmax = key[j] > kmax ? key[j] : kmax;
#pragma unroll
    for (int o_ = 0; o_ < 1; ++o_) { unsigned t; t = sxu<1>(kmax); kmax = t > kmax ? t : kmax; t = sxu<2>(kmax); kmax = t > kmax ? t : kmax; t = sxu<4>(kmax); kmax = t > kmax ? t : kmax; t = sxu<8>(kmax); kmax = t > kmax ? t : kmax; t = sxu<16>(kmax); kmax = t > kmax ? t : kmax;
        unsigned a_, b_; swap32(kmax, a_, b_); kmax = a_ > b_ ? a_ : b_; }
    unsigned lo = 1u, hi = kmax + 1u; int hic = 0;
    { const float vm = fabsf(key2f(kmax)) + 1.0f; unsigned l2 = f2key(-vm * 64.0f); int c; DSA_COUNT_GE(l2, c); if (c >= 256) lo = l2; }
    int iter = 0; bool exact = false;
    while (hi - lo > 1u) {
        unsigned mid;
        if (iter < 24 && lo > 1u) { const float mv = 0.5f * key2f(lo) + 0.5f * key2f(hi - 1u); mid = f2key(mv); }
        else mid = lo + ((hi - lo) >> 1);
        if (mid <= lo) mid = lo + 1u; if (mid >= hi) mid = hi - 1u;
        int c; DSA_COUNT_GE(mid, c);
        if (c == 256) { T = mid; exact = true; break; }
        if (c > 256) lo = mid; else { hi = mid; hic = c; }
        ++iter;
    }
    if (exact) need = 256; else { T = lo; need = 256 - hic; }
}

__device__ __forceinline__ void dsa_attend(const bf16* zq, bf16* zo, const bf16* KDb, const bf16* VDb, const LAS unsigned short* idx, int nsel, LAS unsigned char* vst, int lane) {
    const int g = lane >> 4, c = lane & 15;
    s16x8 qf[2];
#pragma unroll
    for (int ks = 0; ks < 2; ++ks) { qf[ks] = (s16x8){0, 0, 0, 0, 0, 0, 0, 0}; if (c < 8) qf[ks] = *(const GAS s16x8*)(zq + c * 64 + 32 * ks + 8 * g); }
    f32x4 acc[16];
#pragma unroll
    for (int tb = 0; tb < 4; ++tb) {
        s16x8 kf[4][2];
#pragma unroll
        for (int tt = 0; tt < 4; ++tt) { const int e = 16 * (4 * tb + tt) + c; const int id = (e < nsel) ? (int)idx[e] : 0; const bf16* kp = KDb + (size_t)id * 64 + 8 * g;
            kf[tt][0] = *(const GAS s16x8*)kp; kf[tt][1] = *(const GAS s16x8*)(kp + 32); }
#pragma unroll
        for (int tt = 0; tt < 4; ++tt) { f32x4 a = (f32x4){0.f, 0.f, 0.f, 0.f};
            a = __builtin_amdgcn_mfma_f32_16x16x32_bf16(kf[tt][0], qf[0], a, 0, 0, 0); a = __builtin_amdgcn_mfma_f32_16x16x32_bf16(kf[tt][1], qf[1], a, 0, 0, 0); acc[4 * tb + tt] = a; }
    }
    float mx = -INFINITY;
#pragma unroll
    for (int t = 0; t < 16; ++t)
#pragma unroll
        for (int i = 0; i < 4; ++i) { const int e = 16 * t + 4 * g + i; if (e >= nsel) acc[t][i] = -INFINITY; mx = fmaxf(mx, acc[t][i]); }
    mx = fmaxf(mx, sx<16>(mx)); mx = half_max(mx);
    float sum = 0.f;
#pragma unroll
    for (int t = 0; t < 16; ++t)
#pragma unroll
        for (int i = 0; i < 4; ++i) { const float p = exp2f(acc[t][i] - mx); acc[t][i] = p; sum += p; }
    sum += sx<16>(sum); sum = half_sum(sum);
    const float inv = 1.0f / sum;
    s16x8 pf[8];
#pragma unroll
    for (int s = 0; s < 8; ++s) { v4u w; w.x = pk2(acc[2 * s][0] * inv, acc[2 * s][1] * inv); w.y = pk2(acc[2 * s][2] * inv, acc[2 * s][3] * inv); w.z = pk2(acc[2 * s + 1][0] * inv, acc[2 * s + 1][1] * inv); w.w = pk2(acc[2 * s + 1][2] * inv, acc[2 * s + 1][3] * inv);
        pf[s] = __builtin_bit_cast(s16x8, w); }
    f32x4 o[4];
#pragma unroll
    for (int db = 0; db < 4; ++db) o[db] = (f32x4){0.f, 0.f, 0.f, 0.f};
    const int q = (lane >> 2) & 3, p = lane & 3, swz = 2 * (g & 1) + (q >> 1);
    const LAS unsigned char* rb = vst + (4 * g + q) * 128 + 8 * p;
#pragma unroll
    for (int hh = 0; hh < 2; ++hh) {
        asm volatile("s_waitcnt lgkmcnt(0)" ::: "memory");
#pragma unroll
        for (int i = 0; i < 16; ++i) { const int pi = lane + 64 * i, r = pi >> 3, c16 = pi & 7, e = 128 * hh + r; const int id = (e < nsel) ? (int)idx[e] : 0;
            const v4u v = *(const GAS v4u*)(VDb + (size_t)id * 64 + c16 * 8);
            *(LAS v4u*)(vst + r * 128 + ((((c16 >> 1) ^ ((r >> 1) & 3))) << 5) + ((c16 & 1) << 4)) = v; }
        asm volatile("s_waitcnt lgkmcnt(0)" ::: "memory");
#pragma unroll
        for (int s4 = 0; s4 < 4; ++s4)
#pragma unroll
            for (int db = 0; db < 4; ++db) { const LAS unsigned char* a1 = rb + s4 * 4096 + ((db ^ swz) << 5);
                const s16x4 lo = tr16(a1), hi = tr16(a1 + 2048);
                const s16x8 vf = (s16x8){lo[0], lo[1], lo[2], lo[3], hi[0], hi[1], hi[2], hi[3]};
                o[db] = __builtin_amdgcn_mfma_f32_16x16x32_bf16(pf[4 * hh + s4], vf, o[db], 0, 0, 0); }
    }
    if (g < 2) {
#pragma unroll
        for (int db = 0; db < 4; ++db)
#pragma unroll
            for (int i = 0; i < 4; ++i) zo[(4 * g + i) * 64 + 16 * db + c] = (bf16)f2bf(o[db][i]);
    }
}

__device__ __forceinline__ void dsa_v2(const Ctx& F) {
    bf16* Z = (bf16*)(F.ws + WS_Z); const float* ZS = (const float*)(F.ws + WS_ZS);
    const unsigned* ISG = (const unsigned*)(F.ws + WS_ISG);
    const bf16* KD = (const bf16*)(F.ws + WS_KD); const bf16* VD = (const bf16*)(F.ws + WS_VD);
    LAS unsigned* kl = (LAS unsigned*)(F.lds + F.wave * 16384);
    LAS float* iqs = (LAS float*)(F.lds + XTRA_OFF + F.wave * 1536);
    LAS unsigned short* idx = (LAS unsigned short*)(F.lds + XTRA_OFF + F.wave * 1536 + 1024);
    const int lane = F.lane;
    int it = 0;
    for (int r0 = 0; r0 < M; r0 += F.NGW, ++it) {
        const int r = r0 + ((it & 1) ? (F.NGW - 1 - F.gw) : F.gw);
        if (r >= M) continue;
        const int pos = r & (SEQ - 1), b = r >> 12; const size_t m = (size_t)r;
        *(LAS f32x4*)(iqs + 4 * lane) = *(const GAS f32x4*)(ZS + m * ZSP + S_IQ + 4 * lane);
        const unsigned sg = ISG[m];
        LDS_WAIT(); asm volatile("" ::: "memory");
        for (int kk = lane; kk <= pos; kk += 64) { const float* ikp = ZS + ((size_t)b * SEQ + kk) * ZSP + S_IK; float ik[32];
#pragma unroll
            for (int i = 0; i < 8; ++i) { const f32x4 t = *(const GAS f32x4*)(ikp + 4 * i); ik[4 * i] = t.x; ik[4 * i + 1] = t.y; ik[4 * i + 2] = t.z; ik[4 * i + 3] = t.w; }
            float s = 0.f;
#pragma unroll 1
            for (int h = 0; h < 8; ++h) { float dot = 0.f;
#pragma unroll
                for (int dd = 0; dd < 32; ++dd) dot += iqs[h * 32 + dd] * ik[dd];
                dot = fmaxf(dot, 0.f); s += ((sg >> h) & 1u) ? -dot : dot; }
            kl[kk] = f2key(s); }
        LDS_WAIT(); asm volatile("" ::: "memory");
        unsigned key[64];
#pragma unroll
        for (int j = 0; j < 64; ++j) { const int kk = j * 64 + lane; key[j] = (kk <= pos) ? kl[kk] : 0u; }
        LDS_WAIT(); asm volatile("" ::: "memory");
        unsigned T; int need;
#ifdef DSA_OLDSEL
        T = 0u; need = 0;
        if (pos + 1 > 256) {
            for (int bit = 31; bit >= 0; --bit) { const unsigned Tt = T | (1u << bit); int cnt = 0;
#pragma unroll
                for (int j = 0; j < 64; ++j) cnt += __builtin_popcountll(__ballot(key[j] >= Tt));
                if (cnt >= 256) T = Tt; }
            int ngt = 0;
#pragma unroll
            for (int j = 0; j < 64; ++j) ngt += __builtin_popcountll(__ballot(key[j] > T));
            need = 256 - ngt;
        }
#else
        dsa_select(key, pos + 1, T, need);
#endif
        int nsel = 0, eqb = 0;
#pragma unroll
        for (int j = 0; j < 64; ++j) { const bool gt = key[j] > T, eq = (key[j] == T) && (T != 0u);
            const unsigned long long em = __ballot(eq); const int er = eqb + __builtin_amdgcn_mbcnt_hi((unsigned)(em >> 32), __builtin_amdgcn_mbcnt_lo((unsigned)em, 0u));
            const bool sel = gt || (eq && er < need); eqb += __builtin_popcountll(em);
            const unsigned long long sm = __ballot(sel); const int sp = nsel + __builtin_amdgcn_mbcnt_hi((unsigned)(sm >> 32), __builtin_amdgcn_mbcnt_lo((unsigned)sm, 0u));
            if (sel) idx[sp] = (unsigned short)(j * 64 + lane); nsel += __builtin_popcountll(sm); }
        LDS_WAIT(); asm volatile("" ::: "memory");
        dsa_attend(Z + m * ZP + Z_DQ, Z + m * ZP + Z_DQ, KD + (size_t)b * SEQ * 64, VD + (size_t)b * SEQ * 64, idx, nsel, (LAS unsigned char*)kl, lane);
        LDS_WAIT(); asm volatile("" ::: "memory");
    }
}

__device__ __forceinline__ void ret_rope_frag(const bf16* row, const f32x2* cs, float scale, int g, s16x8 (&f)[2]) {
    const u32x2 a0 = *(const GAS u32x2*)(row + 4 * g), a1 = *(const GAS u32x2*)(row + 16 + 4 * g), b0 = *(const GAS u32x2*)(row + 32 + 4 * g), b1 = *(const GAS u32x2*)(row + 48 + 4 * g);
    const float x1[8] = {bflo(a0.x), bfhi(a0.x), bflo(a0.y), bfhi(a0.y), bflo(a1.x), bfhi(a1.x), bflo(a1.y), bfhi(a1.y)};
    const float x2[8] = {bflo(b0.x), bfhi(b0.x), bflo(b0.y), bfhi(b0.y), bflo(b1.x), bfhi(b1.x), bflo(b1.y), bfhi(b1.y)};
    float o1[8], o2[8];
#pragma unroll
    for (int j = 0; j < 8; ++j) { const f32x2 t = cs[(j < 4 ? 4 * g + j : 16 + 4 * g + (j - 4))]; o1[j] = (x1[j] * t.x - x2[j] * t.y) * scale; o2[j] = (x2[j] * t.x + x1[j] * t.y) * scale; }
    f[0] = __builtin_bit_cast(s16x8, pack8(o1)); f[1] = __builtin_bit_cast(s16x8, pack8(o2));
}
__device__ __forceinline__ s16x8 ret_bfrag(const LAS unsigned char* img, int row0, int eb, int g, int q, int p) {
    const int r1 = row0 + 4 * g + q;
    const LAS unsigned char* a1 = img + r1 * 256 + ((eb ^ (r1 & 7)) << 5) + 8 * p;
    const LAS unsigned char* a2 = img + (r1 + 16) * 256 + ((eb ^ ((r1 + 16) & 7)) << 5) + 8 * p;
    const s16x4 lo = tr16(a1), hi = tr16(a2);
    return (s16x8){lo[0], lo[1], lo[2], lo[3], hi[0], hi[1], hi[2], hi[3]};
}

__device__ __forceinline__ void ret_state_mfma(const Ctx& F) {
    const bf16* Z = (const bf16*)(F.ws + WS_Z); float* RS = (float*)(F.ws + WS_HDN);
    const f32x2* R64 = (const f32x2*)(F.ws + WS_ROPE64);
    LAS unsigned char* Kimg = F.lds; LAS unsigned char* Vimg = F.lds + 16384;
    const int lane = F.lane, g = lane >> 4, c = lane & 15, q = (lane >> 2) & 3, p = lane & 3;
    for (int u = blockIdx.x; u < NB * 32 * 4; u += F.G) {
        const int h = u & 3, ch = (u >> 2) & 31, b = u >> 7; const float l2g = ret_l2g(h);
        const bf16* base = Z + ((size_t)b * SEQ + ch * 128) * ZP;
        __syncthreads();
        for (int t = F.tid; t < 2048; t += 512) { const int r = t >> 4, c16 = t & 15;
            *(LAS v4u*)(Vimg + r * 256 + (((c16 >> 1) ^ (r & 7)) << 5) + ((c16 & 1) << 4)) = *(const GAS v4u*)(base + (size_t)r * ZP + Z_RV + h * 128 + c16 * 8); }
        for (int t = F.tid; t < 1024; t += 512) { const int j = t >> 3, dg = t & 7; const bf16* row = base + (size_t)j * ZP + Z_RK + h * 64;
            const u32x2 a = *(const GAS u32x2*)(row + 4 * dg), bb = *(const GAS u32x2*)(row + 32 + 4 * dg);
            const float x1[4] = {bflo(a.x), bfhi(a.x), bflo(a.y), bfhi(a.y)}, x2[4] = {bflo(bb.x), bfhi(bb.x), bflo(bb.y), bfhi(bb.y)};
            const f32x2* cs = R64 + (ch * 128 + j) * 32 + 4 * dg; const float sc = exp2f((float)(127 - j) * l2g);
            float o1[4], o2[4];
#pragma unroll
            for (int e = 0; e < 4; ++e) { const f32x2 tt = cs[e]; o1[e] = (x1[e] * tt.x - x2[e] * tt.y) * sc; o2[e] = (x2[e] * tt.x + x1[e] * tt.y) * sc; }
            u32x2 w1, w2; w1.x = pk2(o1[0], o1[1]); w1.y = pk2(o1[2], o1[3]); w2.x = pk2(o2[0], o2[1]); w2.y = pk2(o2[2], o2[3]);
            const int sw = (j >> 1) & 3; const int d1 = 4 * dg, d2 = 32 + 4 * dg;
            *(LAS u32x2*)(Kimg + j * 128 + ((((2 * d1) >> 5) ^ sw) << 5) + ((2 * d1) & 31)) = w1;
            *(LAS u32x2*)(Kimg + j * 128 + ((((2 * d2) >> 5) ^ sw) << 5) + ((2 * d2) & 31)) = w2; }
        __syncthreads();
        f32x4 acc[4];
#pragma unroll
        for (int db = 0; db < 4; ++db) acc[db] = (f32x4){0.f, 0.f, 0.f, 0.f};
#pragma unroll
        for (int s = 0; s < 4; ++s) {
            const s16x8 vb = ret_bfrag(Vimg, 32 * s, F.wave, g, q, p);
            const int r1 = 32 * s + 4 * g + q, sw = (r1 >> 1) & 3;
#pragma unroll
            for (int db = 0; db < 4; ++db) { const LAS unsigned char* a1 = Kimg + r1 * 128 + ((db ^ sw) << 5) + 8 * p;
                const s16x4 lo = tr16(a1), hi = tr16(a1 + 2048);
                const s16x8 ka = (s16x8){lo[0], lo[1], lo[2], lo[3], hi[0], hi[1], hi[2], hi[3]};
                acc[db] = __builtin_amdgcn_mfma_f32_16x16x32_bf16(ka, vb, acc[db], 0, 0, 0); }
        }
        float* o = RS + (size_t)u * 8192 + 16 * F.wave + c;
#pragma unroll
        for (int db = 0; db < 4; ++db)
#pragma unroll
            for (int r = 0; r < 4; ++r) o[(16 * db + 4 * g + r) * 128] = acc[db][r];
    }
    __syncthreads();
}

__device__ __forceinline__ void ret_scan(const Ctx& F) {
    const float* RS = (const float*)(F.ws + WS_HDN); float* SC = (float*)(F.ws + WS_HDN + 16 * MiB);
    for (int t = blockIdx.x * 512 + F.tid; t < NB * 4 * 8192; t += F.G * 512) {
        const int el = t & 8191, h = (t >> 13) & 3, b = t >> 15; const float wch = exp2f(128.f * ret_l2g(h)); float s = 0.f;
        for (int ch = 0; ch < 32; ++ch) { const size_t off = (size_t)(((b * 32 + ch) * 4 + h)) * 8192 + el; SC[off] = s; s = wch * s + RS[off]; }
    }
}

__device__ __forceinline__ void ret_out_mfma(const Ctx& F, const float* gn) {
    bf16* Z = (bf16*)(F.ws + WS_Z); const float* SC = (const float*)(F.ws + WS_HDN + 16 * MiB);
    const f32x2* R64 = (const f32x2*)(F.ws + WS_ROPE64);
    LAS unsigned char* Vimg = F.lds; LAS unsigned char* Simg = F.lds + 32768;
    const int lane = F.lane, g = lane >> 4, c = lane & 15, q = (lane >> 2) & 3, p = lane & 3, w = F.wave;
    for (int u = blockIdx.x; u < NB * 32 * 4; u += F.G) {
        const int h = u & 3, ch = (u >> 2) & 31, b = u >> 7; const float l2g = ret_l2g(h); const float gam = exp2f(l2g);
        bf16* base = Z + ((size_t)b * SEQ + ch * 128) * ZP;
        __syncthreads();
        for (int t = F.tid; t < 2048; t += 512) { const int r = t >> 4, c16 = t & 15;
            *(LAS v4u*)(Vimg + r * 256 + (((c16 >> 1) ^ (r & 7)) << 5) + ((c16 & 1) << 4)) = *(const GAS v4u*)(base + (size_t)r * ZP + Z_RV + h * 128 + c16 * 8); }
        for (int t = F.tid; t < 1024; t += 512) { const int r = t >> 4, c16 = t & 15; const float* sp = SC + (size_t)u * 8192 + r * 128 + c16 * 8;
            const f32x4 s0 = *(const GAS f32x4*)sp, s1 = *(const GAS f32x4*)(sp + 4);
            v4u wv; wv.x = pk2(s0.x * gam, s0.y * gam); wv.y = pk2(s0.z * gam, s0.w * gam); wv.z = pk2(s1.x * gam, s1.y * gam); wv.w = pk2(s1.z * gam, s1.w * gam);
            *(LAS v4u*)(Simg + r * 256 + (((c16 >> 1) ^ (r & 7)) << 5) + ((c16 & 1) << 4)) = wv; }
        const int i = 16 * w + c; s16x8 qf[2];
        ret_rope_frag(base + (size_t)i * ZP + Z_RQ + h * 64, R64 + (ch * 128 + i) * 32, 0.125f * exp2f((float)i * l2g), g, qf);
        f32x4 acc[8];
#pragma unroll
        for (int t = 0; t < 8; ++t) { acc[t] = (f32x4){0.f, 0.f, 0.f, 0.f};
            if (t <= w) { const int j = 16 * t + c; s16x8 kf[2];
                ret_rope_frag(base + (size_t)j * ZP + Z_RK + h * 64, R64 + (ch * 128 + j) * 32, exp2f(-(float)j * l2g), g, kf);
                acc[t] = __builtin_amdgcn_mfma_f32_16x16x32_bf16(kf[0], qf[0], acc[t], 0, 0, 0); acc[t] = __builtin_amdgcn_mfma_f32_16x16x32_bf16(kf[1], qf[1], acc[t], 0, 0, 0);
                if (t == w) {
#pragma unroll
                    for (int r = 0; r < 4; ++r) if (4 * g + r > c) acc[t][r] = 0.f; } } }
        s16x8 pf[4];
#pragma unroll
        for (int s = 0; s < 4; ++s) { v4u wv; wv.x = pk2(acc[2 * s][0], acc[2 * s][1]); wv.y = pk2(acc[2 * s][2], acc[2 * s][3]); wv.z = pk2(acc[2 * s + 1][0], acc[2 * s + 1][1]); wv.w = pk2(acc[2 * s + 1][2], acc[2 * s + 1][3]);
            pf[s] = __builtin_bit_cast(s16x8, wv); }
        __syncthreads();
        f32x4 o[8];
#pragma unroll
        for (int eb = 0; eb < 8; ++eb) o[eb] = (f32x4){0.f, 0.f, 0.f, 0.f};
#pragma unroll
        for (int s = 0; s < 4; ++s) if (2 * s <= w) {
#pragma unroll
            for (int eb = 0; eb < 8; ++eb) o[eb] = __builtin_amdgcn_mfma_f32_16x16x32_bf16(pf[s], ret_bfrag(Vimg, 32 * s, eb, g, q, p), o[eb], 0, 0, 0); }
#pragma unroll
        for (int ks = 0; ks < 2; ++ks)
#pragma unroll
            for (int eb = 0; eb < 8; ++eb) o[eb] = __builtin_amdgcn_mfma_f32_16x16x32_bf16(qf[ks], ret_bfrag(Simg, 32 * ks, eb, g, q, p), o[eb], 0, 0, 0);
        float rs[4];
#pragma unroll
        for (int r = 0; r < 4; ++r) { float ss = 0.f;
#pragma unroll
            for (int eb = 0; eb < 8; ++eb) ss += o[eb][r] * o[eb][r];
            ss += sx<1>(ss); ss += sx<2>(ss); ss += sx<4>(ss); ss += sx<8>(ss);
            rs[r] = 1.0f / sqrtf(ss * (1.f / 128) + NORM_EPS); }
#pragma unroll
        for (int r = 0; r < 4; ++r) { bf16* zr = base + (size_t)(16 * w + 4 * g + r) * ZP;
#pragma unroll
            for (int eb = 0; eb < 8; ++eb) { const int e = 16 * eb + c; const float rg = bf2f(zr[Z_RG + h * 128 + e]);
                zr[Z_RV + h * 128 + e] = (bf16)f2bf(o[eb][r] * rs[r] * gn[h * 128 + e] * rg * sigmoid_f(rg)); } }
    }
    __syncthreads();
}

__device__ __forceinline__ void fscan_phase(const Ctx& F) {
    const float* LF = (const float*)(F.ws + WS_LF); float* CF = (float*)(F.ws + WS_CF);
    if (F.gw < 32) {
        const int b = F.gw >> 3, h = F.gw & 7; const float* lp = LF + ((size_t)b * SEQ + F.lane * 64) * 8 + h; float s = 0.f;
        for (int i = 0; i < 64; ++i) s += lp[i * 8];
        float incl = s;
#pragma unroll
        for (int o = 1; o < 64; o <<= 1) { const float t = __builtin_bit_cast(float, __builtin_amdgcn_ds_bpermute(((F.lane - o) & 63) << 2, __builtin_bit_cast(int, incl))); if (F.lane >= o) incl += t; }
        float run = incl - s; float* cp = CF + (size_t)F.gw * SEQ + F.lane * 64;
        for (int i = 0; i < 64; ++i) { run += lp[i * 8]; cp[i] = run; }
    }
}
#include <hip/hip_bf16.h>
#include <cmath>
namespace attn_body {
using bf16=__hip_bfloat16;
using bf16x8=__attribute__((ext_vector_type(8)))short;
using s16x4=__attribute__((ext_vector_type(4)))short;
using f32x16=__attribute__((ext_vector_type(16)))float;
using u32x4=__attribute__((ext_vector_type(4)))unsigned;
constexpr int BATCH=4,NHEAD=8,SEQ=4096,D=64,DM=6656;
constexpr int NW=8,QBLK=32,QB=QBLK*NW,KVBLK=64,NQB=SEQ/QB;
constexpr int ATTN_PITCH=DM, ATTN_UNIT_ROWS=QB;
__device__ __forceinline__ int crow(int r,int hi){return (r&3)+8*(r>>2)+4*hi;}
#define SBAR() __builtin_amdgcn_sched_barrier(0)
__device__ __forceinline__ void cmask(f32x16&p0,f32x16&p1,int jb,int qrel,int hi){
  const float NEG=-INFINITY; int kb=64*jb+4*hi;
  #pragma unroll
  for(int r=0;r<16;++r){int kv=kb+(r&3)+8*(r>>2); if(kv>qrel)p0[r]=NEG; if(kv+32>qrel)p1[r]=NEG;}
}

constexpr int NSLOT=3, SLOTB=8192;
constexpr int LDS_K=0, LDS_V=NSLOT*SLOTB, LDS_WS=2*NSLOT*SLOTB, LDS_OST=LDS_WS+NW*64*4, LDS_NC=LDS_OST+NW*4096, LDS_BYTES=LDS_NC+SEQ*4;
constexpr float C2=0.125f*1.4426950408889634f;
__device__ __forceinline__ void glds16(const void*gsrc,unsigned lds_dst){unsigned keep;
  asm volatile("s_mov_b32 %0, m0\n\ts_mov_b32 m0, %2\n\ts_nop 0\n\tglobal_load_lds_dwordx4 %1, off\n\ts_mov_b32 m0, %0":"=&s"(keep):"v"(gsrc),"s"(lds_dst):"memory");}
__device__ __forceinline__ float max3f(float a,float b,float c){float r;asm("v_max3_f32 %0, %1, %2, %3":"=v"(r):"v"(a),"v"(b),"v"(c));return r;}
__device__ __forceinline__ float max2f(float a,float b){float r;asm("v_max_f32_e32 %0, %1, %2":"=v"(r):"v"(a),"v"(b));return r;}
__device__ __forceinline__ float fadd_s(float a,float b){float r;asm("v_add_f32_e32 %0, %1, %2":"=v"(r):"v"(a),"v"(b));return r;}
__device__ __forceinline__ float fsub_s(float a,float b){float r;asm("v_sub_f32_e32 %0, %1, %2":"=v"(r):"v"(a),"v"(b));return r;}
typedef float f32x4_t __attribute__((ext_vector_type(4))); typedef float f32x2_t __attribute__((ext_vector_type(2))); typedef __bf16 bf16x2_t __attribute__((ext_vector_type(2)));
__device__ __forceinline__ unsigned cvtpk_s(float lo,float hi){f32x2_t v={lo,hi};bf16x2_t b=__builtin_convertvector(v,bf16x2_t);return __builtin_bit_cast(unsigned,b);}
#define WAIT_BAR(N) asm volatile("s_waitcnt vmcnt(" #N ") lgkmcnt(0)\n\ts_barrier":::"memory")

__device__ __forceinline__ void qkt(f32x16&p0,f32x16&p1,const char*Kslot,const bf16x8*qr,const f32x16&negm,int r32,int hi){
  const char*kb=Kslot+hi*1024+r32*16;
  #pragma unroll
  for(int d0=0;d0<4;++d0){
    const bf16x8 b0=*reinterpret_cast<const bf16x8*>(kb+d0*2048);
    const bf16x8 b1=*reinterpret_cast<const bf16x8*>(kb+d0*2048+512);
    if(d0==0){p0=__builtin_amdgcn_mfma_f32_32x32x16_bf16(b0,qr[0],negm,0,0,0);p1=__builtin_amdgcn_mfma_f32_32x32x16_bf16(b1,qr[0],negm,0,0,0);}
    else{p0=__builtin_amdgcn_mfma_f32_32x32x16_bf16(b0,qr[d0],p0,0,0,0);p1=__builtin_amdgcn_mfma_f32_32x32x16_bf16(b1,qr[d0],p1,0,0,0);}}
}
typedef __attribute__((address_space(3))) const char* lds_cptr;
typedef short v4i16_t __attribute__((ext_vector_type(4)));
__device__ __forceinline__ void kload8(bf16x8*kf,lds_cptr kp){
  kf[0]=*(const __attribute__((address_space(3))) bf16x8*)(kp);      kf[1]=*(const __attribute__((address_space(3))) bf16x8*)(kp+512);
  kf[2]=*(const __attribute__((address_space(3))) bf16x8*)(kp+2048); kf[3]=*(const __attribute__((address_space(3))) bf16x8*)(kp+2560);
  kf[4]=*(const __attribute__((address_space(3))) bf16x8*)(kp+4096); kf[5]=*(const __attribute__((address_space(3))) bf16x8*)(kp+4608);
  kf[6]=*(const __attribute__((address_space(3))) bf16x8*)(kp+6144); kf[7]=*(const __attribute__((address_space(3))) bf16x8*)(kp+6656);
}
__device__ __forceinline__ void kload2(bf16x8*kf,lds_cptr kp,int j){ kf[2*j]=*(const __attribute__((address_space(3))) bf16x8*)(kp+j*2048); kf[2*j+1]=*(const __attribute__((address_space(3))) bf16x8*)(kp+j*2048+512); }
__device__ __forceinline__ s16x4 vtr(lds_cptr p){ return __builtin_bit_cast(s16x4,__builtin_amdgcn_ds_read_tr16_b64_v4i16((__attribute__((address_space(3))) v4i16_t*)p)); }
__device__ __forceinline__ float rowmax(const f32x16&p0,const f32x16&p1){
  float a=max3f(p0[0],p0[1],p1[0]),b=max3f(p0[2],p0[3],p1[1]);a=max3f(a,p1[2],p1[3]);
  #pragma unroll
  for(int r=4;r<16;r+=4){a=max3f(a,p0[r],p0[r+1]);b=max3f(b,p0[r+2],p0[r+3]);a=max3f(a,p1[r],p1[r+1]);b=max3f(b,p1[r+2],p1[r+3]);}
  const float m=max2f(a,b);
  auto rr=__builtin_amdgcn_permlane32_swap(__float_as_uint(m),__float_as_uint(m),false,false);
  return max2f(__uint_as_float(rr[0]),__uint_as_float(rr[1]));
}
__device__ __forceinline__ void pv(f32x16*o,int vb,bf16x8 pa0,bf16x8 pa1,bf16x8 pa2,bf16x8 pa3){
  #pragma unroll
  for(int d0=0;d0<2;++d0){s16x4 lo[4],hi[4];
    #pragma unroll
    for(int ks=0;ks<4;++ks){
      asm volatile("ds_read_b64_tr_b16 %0,%1 offset:%c2":"=&v"(lo[ks]):"v"(vb),"i"(d0*4096+ks*1024):"memory");
      asm volatile("ds_read_b64_tr_b16 %0,%1 offset:%c2":"=&v"(hi[ks]):"v"(vb),"i"(d0*4096+ks*1024+512):"memory");}
    asm volatile("s_waitcnt lgkmcnt(0)":::"memory");SBAR();
    #define PK(k) (bf16x8){lo[k][0],lo[k][1],lo[k][2],lo[k][3],hi[k][0],hi[k][1],hi[k][2],hi[k][3]}
    o[d0]=__builtin_amdgcn_mfma_f32_32x32x16_bf16(pa0,PK(0),o[d0],0,0,0);
    o[d0]=__builtin_amdgcn_mfma_f32_32x32x16_bf16(pa1,PK(1),o[d0],0,0,0);
    o[d0]=__builtin_amdgcn_mfma_f32_32x32x16_bf16(pa2,PK(2),o[d0],0,0,0);
    o[d0]=__builtin_amdgcn_mfma_f32_32x32x16_bf16(pa3,PK(3),o[d0],0,0,0);
    #undef PK
  }
}

#ifndef ATTN_STORE16
#define ATTN_STORE16(p,v) (*(u32x4*)(p)=(v))
#endif
template<int THRL> __device__ __forceinline__ void attn_unit(int b,int h,int qb,const bf16*Q,const bf16*__restrict__ K,const bf16*__restrict__ V,bf16*O,const float*CF,char*shm,int wave_id){
  int tid_=(wave_id<<6)|lane_id_v(); asm volatile("":"+v"(tid_));
  const int tid=tid_,lane=tid&63,r32=lane&31,hi=lane>>5; const int wid=__builtin_amdgcn_readfirstlane(tid>>6);
  const long rowbase=(long)b*SEQ; const int q0=qb*QB;
  const bf16*Qw=Q+(rowbase+q0+wid*QBLK)*DM+h*D;
  const bf16*Kh=K+rowbase*DM+h*D,*Vh=V+rowbase*DM+h*D;
  const unsigned lds0=(unsigned)(uintptr_t)shm;
  float*wsf=(float*)(shm+LDS_WS)+wid*64;
  const bf16*ksrc=Kh+(long)lane*DM+wid*8;
  const bf16*vsrc=Vh+(long)(16*(wid&3)+(lane>>2))*DM+(wid>>2)*32+(lane&3)*8;
  const unsigned kdst=lds0+LDS_K+wid*1024, vdst=lds0+LDS_V+wid*1024;
  #define DMA_K(t,slot) glds16(ksrc+(long)(t)*KVBLK*DM,(unsigned)__builtin_amdgcn_readfirstlane(kdst+(slot)))
  #define DMA_V(t,slot) glds16(vsrc+(long)(t)*KVBLK*DM,(unsigned)__builtin_amdgcn_readfirstlane(vdst+(slot)))
  const char*Kbase=shm+LDS_K; bf16x8 kf[8];
  const lds_cptr shm3=(lds_cptr)shm; const lds_cptr kp0=shm3+LDS_K+hi*1024+r32*16; const lds_cptr vp0=shm3+LDS_V+((lane>>4)&1)*32+(lane&3)*8+(4*hi+((lane&15)>>2))*64;
  const int NT=(q0+QB)/KVBLK;
  { const float*cfp=CF+(long)(b*NHEAD+h)*SEQ; float*ncw=(float*)(shm+LDS_NC);
    for(int i=tid;i<q0+QB;i+=NW*64)ncw[i]=-cfp[i]; }
  const lds_cptr ncp=(lds_cptr)shm+LDS_NC+hi*16;
  #define ADDC(P0,P1,t) do{ const lds_cptr np_=ncp+(t)*256; _Pragma("unroll") for(int g_=0;g_<4;++g_){ \
      const f32x4_t a_=*(const __attribute__((address_space(3))) f32x4_t*)(np_+g_*32), b_=*(const __attribute__((address_space(3))) f32x4_t*)(np_+g_*32+128); \
      P0[4*g_]+=a_[0];P0[4*g_+1]+=a_[1];P0[4*g_+2]+=a_[2];P0[4*g_+3]+=a_[3]; P1[4*g_]+=b_[0];P1[4*g_+1]+=b_[1];P1[4*g_+2]+=b_[2];P1[4*g_+3]+=b_[3]; } }while(0)
  DMA_K(0,0);DMA_V(0,0);DMA_K(1,SLOTB);
  bf16x8 qr[4];
  #pragma unroll
  for(int d0=0;d0<4;++d0)qr[d0]=*reinterpret_cast<const bf16x8*>(&Qw[(long)r32*DM+d0*16+hi*8]);
  float mhat=0.f,l_reg=0.f;f32x16 o[2];f32x16 negm; { float zz_; asm volatile("v_mov_b32 %0, 0":"=v"(zz_));
    _Pragma("unroll") for(int r=0;r<16;++r){o[0][r]=zz_;o[1][r]=zz_;negm[r]=zz_;} } asm volatile("":"+v"(negm));
  const int qrel=wid*QBLK+r32;
  #define CMASK(P0,P1,t) do{int jb_=(t)-(NT-4); if(jb_>=0)cmask(P0,P1,jb_,qrel,hi);}while(0)
  bool resc=false;
  #define START(P0,P1) do{ const float rm=rowmax(P0,P1); resc=false; \
    { const float dl=rm; mhat=fadd_s(mhat,dl); \
      _Pragma("unroll") for(int r=0;r<16;++r){P0[r]=fsub_s(P0[r],dl);P1[r]=fsub_s(P1[r],dl);} \
      _Pragma("unroll") for(int r=0;r<16;++r)negm[r]=-mhat; asm volatile("":"+v"(negm)); } \
    _Pragma("unroll") for(int r=0;r<16;++r)P0[r]=__builtin_amdgcn_exp2f(P0[r]); }while(0)
  #define RESC() do{ if(resc){ asm volatile("s_waitcnt lgkmcnt(0)":::"memory"); \
      _Pragma("unroll") for(int d_=0;d_<2;++d_) _Pragma("unroll") for(int r=0;r<16;++r)o[d_][r]*=wsf[crow(r,hi)]; } }while(0)
  f32x16 pA0,pA1,pB0,pB1;
  int sl_prev=0,sl_cur=0,sl_next=SLOTB;
  #define ROT() do{sl_prev=sl_cur;sl_cur=sl_next;sl_next=(sl_next==(NSLOT-1)*SLOTB)?0:sl_next+SLOTB;}while(0)
  DMA_K(2,2*SLOTB);
  WAIT_BAR(3);
  qkt(pA0,pA1,Kbase,qr,negm,r32,hi);asm volatile("s_nop 15\n\ts_nop 7":"+v"(pA0),"+v"(pA1));ADDC(pA0,pA1,0);CMASK(pA0,pA1,0);
  START(pA0,pA1);
  _Pragma("unroll") for(int r=0;r<16;++r)pA1[r]=__builtin_amdgcn_exp2f(pA1[r]);
  WAIT_BAR(0);
  DMA_K(3,0);DMA_V(1,SLOTB);
  ROT();
  kload8(kf,kp0+sl_cur);
  WAIT_BAR(2);
  s16x4 vlo[8],vhi[8]; u32x4 pw0,pw1,pw2,pw3;
  #define PKW(P,B) cvtpk_s(P[B],P[B+1])
  #define PAF(k) __builtin_bit_cast(bf16x8,pw##k)
  #define VFR(i) (bf16x8){vlo[i][0],vlo[i][1],vlo[i][2],vlo[i][3],vhi[i][0],vhi[i][1],vhi[i][2],vhi[i][3]}
  #define PIN(x) asm volatile("":"+v"(x))
  #define MX3(a,b,c) __builtin_fmaxf(__builtin_fmaxf((a),(b)),(c))
  #define GAPA(MF,A0,A1,A2,A3,W0,W1,PW) do{ MF; sacc+=A0; sacc+=A1; sacc+=A2; sacc+=A3; PIN(sacc); W0; W1; PIN(PW); SBAR(); }while(0)
  #define EX(v) __builtin_amdgcn_exp2f(v)
  #define GAPB(MF,X,B) do{ MF; X[B]=EX(X[B]); X[B+1]=EX(X[B+1]); X[B+2]=EX(X[B+2]); X[B+3]=EX(X[B+3]); PIN(X); SBAR(); }while(0)
  #define VRD(i) do{ vlo[i]=vtr(vp_+(((i)>>2)*4096+((i)&3)*1024)); vhi[i]=vtr(vp_+(((i)>>2)*4096+((i)&3)*1024+512)); }while(0)
  #define KRD(G,j) do{ if(G){ kload2(kf,kp0+sl_next,j); SBAR(); } }while(0)
  #define STEP(C0,C1,P0,P1,t,GK,GV,GL) do{ SBAR(); \
    const lds_cptr vp_=vp0+sl_prev; \
    VRD(0); SBAR(); float sacc=(P0[0]+P0[1]); \
    GAPA(C0=__builtin_amdgcn_mfma_f32_32x32x16_bf16(kf[0],qr[0],negm,0,0,0), P0[2],P0[3],P0[4],P0[5],     pw0[0]=PKW(P0,0), pw0[1]=PKW(P0,2), pw0); \
    VRD(4); SBAR(); GAPA(C1=__builtin_amdgcn_mfma_f32_32x32x16_bf16(kf[1],qr[0],negm,0,0,0), P0[6],P0[7],P0[8],P0[9],     pw0[2]=PKW(P0,4), pw0[3]=PKW(P0,6), pw0); \
    VRD(1); SBAR(); GAPA(C0=__builtin_amdgcn_mfma_f32_32x32x16_bf16(kf[2],qr[1],C0,0,0,0),   P0[10],P0[11],P0[12],P0[13], pw1[0]=PKW(P0,8), pw1[1]=PKW(P0,10), pw1); \
    VRD(5); SBAR(); GAPA(C1=__builtin_amdgcn_mfma_f32_32x32x16_bf16(kf[3],qr[1],C1,0,0,0),   P0[14],P0[15],P1[0],P1[1],   pw1[2]=PKW(P0,12),pw1[3]=PKW(P0,14), pw1); \
    VRD(2); SBAR(); GAPA(C0=__builtin_amdgcn_mfma_f32_32x32x16_bf16(kf[4],qr[2],C0,0,0,0),   P1[2],P1[3],P1[4],P1[5],     pw2[0]=PKW(P1,0), pw2[1]=PKW(P1,2), pw2); \
    VRD(6); SBAR(); GAPA(C1=__builtin_amdgcn_mfma_f32_32x32x16_bf16(kf[5],qr[2],C1,0,0,0),   P1[6],P1[7],P1[8],P1[9],     pw2[2]=PKW(P1,4), pw2[3]=PKW(P1,6), pw2); \
    VRD(3); SBAR(); GAPA(C0=__builtin_amdgcn_mfma_f32_32x32x16_bf16(kf[6],qr[3],C0,0,0,0),   P1[10],P1[11],P1[12],P1[13], pw3[0]=PKW(P1,8), pw3[1]=PKW(P1,10), pw3); \
    VRD(7); SBAR(); GAPA(C1=__builtin_amdgcn_mfma_f32_32x32x16_bf16(kf[7],qr[3],C1,0,0,0),   P1[14],P1[15],0.f,0.f,       pw3[2]=PKW(P1,12),pw3[3]=PKW(P1,14), pw3); \
    l_reg+=sacc; \
    if(GK){DMA_K((t)+3,sl_cur);} if(GV){DMA_V((t)+1,sl_next);} \
    ADDC(C0,C1,t); CMASK(C0,C1,t); \
    { float a=MX3(C0[0],C0[1],C1[0]),b=MX3(C0[2],C0[3],C1[1]); a=MX3(a,C1[2],C1[3]); \
      _Pragma("unroll") for(int r=4;r<16;r+=4){a=MX3(a,C0[r],C0[r+1]);b=MX3(b,C0[r+2],C0[r+3]);a=MX3(a,C1[r],C1[r+1]);b=MX3(b,C1[r+2],C1[r+3]);} \
      float rm=__builtin_fmaxf(a,b); { auto rr=__builtin_amdgcn_permlane32_swap(__float_as_uint(rm),__float_as_uint(rm),false,false); rm=__builtin_fmaxf(__uint_as_float(rr[0]),__uint_as_float(rr[1])); } \
      resc=false; \
      if(__builtin_expect(__any(rm>(float)THRL),0)){ const float dl=__builtin_fmaxf(rm,0.f); mhat+=dl; \
        _Pragma("unroll") for(int r=0;r<16;++r){C0[r]-=dl;C1[r]-=dl;} \
        _Pragma("unroll") for(int r=0;r<16;++r)negm[r]=-mhat; asm volatile("":"+v"(negm)); \
        const float f=__builtin_amdgcn_exp2f(-dl); l_reg*=f; if(hi==0)wsf[r32]=f; resc=true; } } \
    SBAR(); \
    GAPB(o[0]=__builtin_amdgcn_mfma_f32_32x32x16_bf16(PAF(0),VFR(0),o[0],0,0,0), C0,0); \
    GAPB(o[1]=__builtin_amdgcn_mfma_f32_32x32x16_bf16(PAF(0),VFR(4),o[1],0,0,0), C0,4); \
    KRD(GL,0); GAPB(o[0]=__builtin_amdgcn_mfma_f32_32x32x16_bf16(PAF(1),VFR(1),o[0],0,0,0), C0,8); \
    KRD(GL,1); GAPB(o[1]=__builtin_amdgcn_mfma_f32_32x32x16_bf16(PAF(1),VFR(5),o[1],0,0,0), C0,12); \
    KRD(GL,2); GAPB(o[0]=__builtin_amdgcn_mfma_f32_32x32x16_bf16(PAF(2),VFR(2),o[0],0,0,0), C1,0); \
    KRD(GL,3); GAPB(o[1]=__builtin_amdgcn_mfma_f32_32x32x16_bf16(PAF(2),VFR(6),o[1],0,0,0), C1,4); \
    GAPB(o[0]=__builtin_amdgcn_mfma_f32_32x32x16_bf16(PAF(3),VFR(3),o[0],0,0,0), C1,8); \
    GAPB(o[1]=__builtin_amdgcn_mfma_f32_32x32x16_bf16(PAF(3),VFR(7),o[1],0,0,0), C1,12); \
    }while(0)
  int t=1;
  #undef CMASK
  #define CMASK(P0,P1,t) do{}while(0)
  for(;t+5<NT;t+=2){
    STEP(pB0,pB1,pA0,pA1,t,true,true,true);     WAIT_BAR(2); RESC(); ROT();
    STEP(pA0,pA1,pB0,pB1,t+1,true,true,true);   WAIT_BAR(2); RESC(); ROT();
  }
  #undef CMASK
  #define CMASK(P0,P1,t) do{int jb_=(t)-(NT-4); if(jb_>=0)cmask(P0,P1,jb_,qrel,hi);}while(0)
  #define ENDW(tt) do{ if((tt)+3<NT){WAIT_BAR(2);} else if((tt)+2<NT){WAIT_BAR(1);} else {WAIT_BAR(0);} }while(0)
  for(;t+1<NT;t+=2){
    STEP(pB0,pB1,pA0,pA1,t,(t+3<NT),(t+1<NT),(t+1<NT));       ENDW(t);   RESC(); ROT();
    STEP(pA0,pA1,pB0,pB1,t+1,(t+4<NT),(t+2<NT),(t+2<NT));     ENDW(t+1); RESC(); ROT();
  }
  STEP(pB0,pB1,pA0,pA1,NT-1,false,false,false); RESC();
  { float sacc=pB0[0]+pB0[1]; _Pragma("unroll") for(int r=2;r<16;++r)sacc+=pB0[r]; _Pragma("unroll") for(int r=0;r<16;++r)sacc+=pB1[r]; l_reg+=sacc;
    pw0=(u32x4){PKW(pB0,0),PKW(pB0,2),PKW(pB0,4),PKW(pB0,6)};pw1=(u32x4){PKW(pB0,8),PKW(pB0,10),PKW(pB0,12),PKW(pB0,14)};pw2=(u32x4){PKW(pB1,0),PKW(pB1,2),PKW(pB1,4),PKW(pB1,6)};pw3=(u32x4){PKW(pB1,8),PKW(pB1,10),PKW(pB1,12),PKW(pB1,14)};
    int tl_=lane_id_v(); asm volatile("":"+v"(tl_)); const int ln_=tl_&63,hi_=ln_>>5; const int vb0e=(int)(lds0+LDS_V)+((ln_>>4)&1)*32+(ln_&3)*8+(4*hi_+((ln_&15)>>2))*64;
    SBAR(); pv(o,vb0e+sl_cur,PAF(0),PAF(1),PAF(2),PAF(3)); }
  #undef PKW
  #undef PAF
  #undef VFR
  #undef PIN
  #undef MX3
  #undef GAPA
  #undef GAPB
  #undef EX
  #undef VRD
  #undef KRD
  #undef STEP
  #undef ENDW
  {auto rr=__builtin_amdgcn_permlane32_swap(__float_as_uint(l_reg),__float_as_uint(l_reg),false,false);l_reg=__uint_as_float(rr[0])+__uint_as_float(rr[1]);}
  int te_=lane_id_v(); asm volatile("":"+v"(te_)); const int lane_e=te_&63,r32_e=lane_e&31,hi_e=lane_e>>5;
  if(hi_e==0)wsf[32+r32_e]=l_reg;asm volatile("s_waitcnt lgkmcnt(0)":::"memory");
  float rli[16];
  #pragma unroll
  for(int r=0;r<16;++r)rli[r]=__builtin_amdgcn_rcpf(wsf[32+crow(r,hi_e)]);
  bf16*Ow=O+(rowbase+q0+wid*QBLK)*DM+h*D;
  { bf16*stg=(bf16*)(shm+LDS_OST)+wid*2048;
    #pragma unroll
    for(int r=0;r<16;++r){const int orow=crow(r,hi_e);
      #pragma unroll
      for(int d0=0;d0<2;++d0)stg[orow*64+d0*32+r32_e]=__float2bfloat16(o[d0][r]*rli[r]);}
    asm volatile("s_waitcnt lgkmcnt(0)":::"memory");
    #pragma unroll
    for(int i=0;i<4;++i){const int row=i*8+(lane_e>>3),ch=lane_e&7; const u32x4 v=*(const u32x4*)(stg+row*64+ch*8); ATTN_STORE16(Ow+(long)row*DM+ch*8,v);} }
  asm volatile("s_waitcnt lgkmcnt(0)\n\ts_barrier":::"memory");
  #undef ADDC
  #undef DMA_K
  #undef DMA_V
  #undef CMASK
  #undef START
  #undef RESC
  #undef ROT
}
constexpr int ATTN_LDS_BYTES=LDS_BYTES;
struct AttnTensors { const bf16* Q; const bf16* K; const bf16* V; bf16* O; const float* CF; };
struct AttnUnit { int bh; int qb; };
struct StaticOrder {
  int vcu;
  __device__ __forceinline__ explicit StaticOrder(int grid,int block):vcu((block%8)*(grid/8)+block/8){}
  __device__ __forceinline__ bool next(int i,AttnUnit&u)const{ if(i>=2)return false; const int s=vcu&7; u.bh=vcu>>3; u.qb=(i==0)?s:15-s; return true; }
  __device__ __forceinline__ void a_ready(const AttnUnit&)const{}
  __device__ __forceinline__ void done(const AttnUnit&)const{}
};
template<class Sched,int THRL=8> __device__ __forceinline__ void attn_phase(char*lds,const AttnTensors&T,const Sched&S,int wave_id){
  AttnUnit u;
  for(int i=0;S.next(i,u);++i){ S.a_ready(u); attn_unit<THRL>(u.bh/NHEAD,u.bh%NHEAD,u.qb,T.Q,T.K,T.V,T.O,T.CF,lds,wave_id); S.done(u); }
}
#undef SBAR
#undef WAIT_BAR
}

struct Args { const float* in[16]; float* out; unsigned char* ws; };
__global__ void __launch_bounds__(NWAVES * 64, 2) hyb_fwd(Args args) {
    extern __shared__ __attribute__((aligned(16))) unsigned char lds[];
    Ctx F;
    F.lds = (LAS unsigned char*)lds;
    F.tid = threadIdx.x; F.lane = F.tid & 63; F.wave = __builtin_amdgcn_readfirstlane(F.tid >> 6);
    F.G = gridDim.x; F.gw = blockIdx.x * NWAVES + F.wave; F.NGW = F.G * NWAVES;
    F.out = args.out; F.ws = args.ws;
    volatile LAS unsigned* MISC = (volatile LAS unsigned*)(F.lds + MISC_OFF);
    for (int u = F.tid; u < (LDS_BYTES - LDSCTL_OFF) / 4; u += NWAVES * 64) ((LAS unsigned*)(F.lds + LDSCTL_OFF))[u] = 0u;
    __syncthreads();
    gu32* ctl = (gu32*)(F.ws + WS_CTL);
    XcdBarrier bar = xcd_barrier_post((unsigned*)(ctl + CW_BAR), MISC + 8); bar.w = F.wave;
#define FRESH(P) Ctx P = F; P.tid = (F.wave << 6) | lane_id_v(); asm volatile("" : "+v"(P.tid), "+s"(P.wave), "+s"(P.gw), "+s"(P.ws), "+s"(P.out)); P.lane = P.tid & 63
#define GRID_BAR() do { XcdBarrier b_ = bar; asm volatile("" : "+s"(b_.bar), "+s"(b_.x)); xcd_barrier(b_); } while (0)

    bf16* Wb = (bf16*)(F.ws + WS_W);
    bf16* Z = (bf16*)(F.ws + WS_Z); float* ZS = (float*)(F.ws + WS_ZS); bf16* HDN = (bf16*)(F.ws + WS_HDN);
    float* M32 = (float*)(F.ws + WS_HDN); bf16* HB = (bf16*)(F.ws + WS_Z);
    LAS unsigned char* ring = F.lds + RING_OFF;

    { FRESH(P); p0_prologue(P, args.in[2], args.in[9], args.in[10], args.in[11], args.in[12], args.in[14], args.in[15]); }
    GRID_BAR();

    #pragma unroll 1
    for (int layer = 0; layer < DEPTH; ++layer) {
        const float* xin = (layer == 0) ? args.in[0] : F.out;
        const bf16* L = Wb + (size_t)layer * LW_STRIDE;
        { FRESH(P); rmsnorm_phase(P, xin, args.in[1] + layer * DM, (bf16*)(P.ws + WS_HDN)); }
        GRID_BAR();
        { pg8::Gemm g{HDN, L + LW_IN, M, NIN, DM, DM, DM}; pg8::StaticOrder S; S.init(M, NIN, F.G, (int)blockIdx.x);
          pg8::EpiZ E{Z, ZS};
          pg8::gemm_phase<pg8::EpiZ, pg8::StaticOrder, true, true>(ring, g, S, E, F.wave); }
        GRID_BAR();
        { FRESH(P); post_phase(P, args.in[4] + layer * 64, args.in[5] + layer * 64, args.in[6] + layer * 64, args.in[7] + layer * 64, args.in[3] + layer * 8); }
        { FRESH(P); ret_state_mfma(P); }
        GRID_BAR();
        { FRESH(P); fscan_phase(P); }
        { FRESH(P); ret_scan(P); }
        GRID_BAR();
        { FRESH(P); ret_out_mfma(P, args.in[8] + layer * 512); }
        { static_assert(attn_body::ATTN_LDS_BYTES <= RING_BYTES, "attention scratch fits the ring region");
          unsigned char* wsl = F.ws; asm volatile("" : "+s"(wsl));
          bf16* Zl = (bf16*)(wsl + WS_Z);
          const attn_body::AttnTensors AT{(const attn_body::bf16*)(Zl + Z_FQ), (const attn_body::bf16*)(Zl + Z_FK), (const attn_body::bf16*)(Zl + Z_FV), (attn_body::bf16*)(Zl + Z_FQ), (const float*)(wsl + WS_CF)};
          const attn_body::StaticOrder S((int)F.G, (int)blockIdx.x);
          attn_body::attn_phase<attn_body::StaticOrder>((char*)lds + RING_OFF, AT, S, F.wave); }
        { FRESH(P); dsa_v2(P); }
        GRID_BAR();
        { pg8::StaticOrder S; S.init(M, DM, F.G, (int)blockIdx.x);
          { pg8::Gemm g{Z + Z_FQ, L + LW_MIX, M, DM, 512, ZP, 512}; pg8::EpiGate<0> E{Z + Z_ZG, M32, Z + Z_MRG};
            pg8::gemm_phase<pg8::EpiGate<0>, pg8::StaticOrder, false, true>(ring, g, S, E, F.wave); }
          { pg8::Gemm g{Z + Z_DQ, L + LW_MIX + 512 * 1024, M, DM, 512, ZP, 512}; pg8::EpiGate<1> E{Z + Z_ZG, M32, Z + Z_MRG};
            pg8::gemm_phase<pg8::EpiGate<1>, pg8::StaticOrder, false, true>(ring, g, S, E, F.wave); }
          { pg8::Gemm g{Z + Z_RV, L + LW_MIX + 1024 * 1024, M, DM, 512, ZP, 512}; pg8::EpiGate<2> E{Z + Z_ZG, M32, Z + Z_MRG};
            pg8::gemm_phase<pg8::EpiGate<2>, pg8::StaticOrder, false, true>(ring, g, S, E, F.wave); } }
        GRID_BAR();
        { pg8::Gemm g{Z + Z_MRG, L + LW_O, M, DM, DM, ZP, DM}; pg8::StaticOrder S; S.init(M, DM, F.G, (int)blockIdx.x);
          pg8::EpiRes E{xin, F.out};
          pg8::gemm_phase<pg8::EpiRes, pg8::StaticOrder, false, true>(ring, g, S, E, F.wave); }
        GRID_BAR();
        { FRESH(P); rmsnorm_phase(P, P.out, args.in[13] + layer * DM, (bf16*)(P.ws + WS_HDN)); }
        GRID_BAR();
        { pg8::Gemm g{HDN, L + LW_FI, M, FF2, DM, DM, DM}; pg8::StaticOrder S; S.init(M, FF2, F.G, (int)blockIdx.x);
          pg8::EpiSwi E{HB, FFH};
          pg8::gemm_phase<pg8::EpiSwi, pg8::StaticOrder, true, true>(ring, g, S, E, F.wave); }
        GRID_BAR();
        { pg8::Gemm g{HB, L + LW_FO, M, DM, FFH, FFH, FFH}; pg8::StaticOrder S; S.init(M, DM, F.G, (int)blockIdx.x);
          pg8::EpiRes E{F.out, F.out};
          pg8::gemm_phase<pg8::EpiRes, pg8::StaticOrder, false, true>(ring, g, S, E, F.wave); }
        GRID_BAR();
    }
    if (__hip_atomic_load((gu32*)((unsigned*)(ctl + CW_BAR) + XB_TMO), RLX_AGENT) != 0u) {
        const float q = __builtin_nanf("");
        for (int m = F.gw; m < M; m += F.NGW) { GAS f32x4* o = (GAS f32x4*)(F.out + (size_t)m * DM) + lane_id_v();
#pragma unroll
            for (int j = 0; j < 4; ++j) o[64 * j] = (f32x4){q, q, q, q}; }
    }
}

extern "C" void kernel_launch(void* const* d_in, const int* in_sizes, int n_in, void* d_out, int out_size, void* d_ws, size_t ws_size, hipStream_t stream) {
    static int grid = 0;
    if (grid == 0) {
        if (n_in != 16 || in_sizes[0] != M * DM || out_size != M * DM || ws_size < WS_END) { fprintf(stderr, "kernel_launch: unexpected shapes / workspace (n_in %d, in0 %d, out %d, ws %zu < %zu)\n", n_in, n_in > 0 ? in_sizes[0] : -1, out_size, ws_size, (size_t)WS_END); grid = -1; return; }
        int dev = 0, cus = 0, per_cu = 0;
        if (hipGetDevice(&dev) != hipSuccess || hipDeviceGetAttribute(&cus, hipDeviceAttributeMultiprocessorCount, dev) != hipSuccess) { grid = -1; return; }
        if (hipFuncSetAttribute((const void*)hyb_fwd, hipFuncAttributeMaxDynamicSharedMemorySize, LDS_BYTES) != hipSuccess) { fprintf(stderr, "kernel_launch: hipFuncSetAttribute failed\n"); grid = -1; return; }
        if (hipOccupancyMaxActiveBlocksPerMultiprocessor(&per_cu, (const void*)hyb_fwd, NWAVES * 64, LDS_BYTES) != hipSuccess || per_cu < 1) { fprintf(stderr, "kernel_launch: occupancy query reports %d blocks per CU\n", per_cu); }
        (void)hipGetLastError();
        grid = cus;
    }
    if (grid < 0) return;
    if (hipMemsetAsync((char*)d_ws + WS_CTL, 0, CTL_ZERO_BYTES, stream) != hipSuccess) return;
    Args a{};
    for (int i = 0; i < 16; ++i) a.in[i] = (const float*)d_in[i];
    a.out = (float*)d_out; a.ws = (unsigned char*)d_ws;
    hipLaunchKernelGGL(hyb_fwd, dim3(grid), dim3(NWAVES * 64), LDS_BYTES, stream, a);
}
```

```cpp
#include <hip/hip_runtime.h>
#include <cstdio>
#include <cstdint>
#include <cmath>
__device__ __forceinline__ int lane_id_v() { unsigned z; asm volatile("v_mov_b32 %0, 0" : "=v"(z)); return (int)__builtin_amdgcn_mbcnt_hi(~0u, __builtin_amdgcn_mbcnt_lo(~0u, z)); }
namespace pg8 {
#define PG8_LAS __attribute__((address_space(3)))
typedef unsigned short bf16_t;
typedef short bf16x8 __attribute__((ext_vector_type(8)));
typedef float f32x4 __attribute__((ext_vector_type(4)));
typedef unsigned u32x4 __attribute__((ext_vector_type(4)));
constexpr int BM = 256, BK = 64, HALF = 128, HTB = HALF * BK * 2  , STAGE_BYTES = 8 * HTB, NXCD = 8, WGM = 8;

__host__ __device__ __forceinline__ int lds_byte(int r, int c) { const int st = (r >> 4) * 2 + (c >> 5), rr = r & 15, cc = c & 31, ob = rr * 64 + cc * 2; return st * 1024 + (ob ^ (((ob >> 9) & 1) << 5)); }
__host__ __device__ __forceinline__ void stage_rc(int b, int& R, int& C) { const int st = b / 1024, sb = b % 1024, swz = sb ^ (((sb >> 9) & 1) << 5); R = (st >> 1) * 16 + swz / 64; C = (st & 1) * 32 + (swz % 64) / 2; }
__host__ __device__ __forceinline__ int perm32(int rho) { const int n = rho >> 4, i = rho & 15; return 8 * (i >> 2) + 4 * n + (i & 3); }

struct Unit { int pm, pn; };
struct Gemm { const bf16_t* A; const bf16_t* Bt; int M, N, K, lda, ldb; };

struct StaticOrder {
    int nM, nN, nwg, G, c;
    __host__ __device__ void init(int M, int N, int G_, int c_) { nM = M / BM; nN = N / BM; nwg = nM * nN; G = G_; c = c_; }
    __host__ __device__ bool next(int i, Unit& u) const {
        const long L = (long)i * G + c; if (L >= nwg) return false;
        int wgid = (int)L; { const int q = nwg / NXCD, r = nwg % NXCD, xcd = wgid % NXCD, off = wgid / NXCD; wgid = (xcd < r ? xcd * (q + 1) : r * (q + 1) + (xcd - r) * q) + off; }
        const int nig = WGM * nN, gid = wgid / nig, fm = gid * WGM, gsz = (nM - fm) < WGM ? (nM - fm) : WGM;
        u.pm = fm + ((wgid % nig) % gsz); u.pn = (wgid % nig) / gsz; return true;
    }
    __device__ __forceinline__ void a_ready(const Unit&) const {}
    __device__ __forceinline__ void done(const Unit&) const {}
};

__device__ __forceinline__ unsigned cvt_pk_bf16(float lo, float hi) { unsigned r; asm volatile("v_cvt_pk_bf16_f32 %0, %1, %2" : "=v"(r) : "v"(lo), "v"(hi)); return r; }
__device__ __forceinline__ float bflo(unsigned w) { return __builtin_bit_cast(float, w << 16); }
__device__ __forceinline__ float bfhi(unsigned w) { return __builtin_bit_cast(float, w & 0xffff0000u); }
__device__ __forceinline__ float sigmoidf_(float x) { return __builtin_amdgcn_rcpf(1.0f + __builtin_amdgcn_exp2f(-1.4426950408889634f * x)); }

constexpr int ZP = 6656;
constexpr int ZSP = 512;
constexpr int NZT = 26;

struct EpiZ {
    static constexpr bool PERM = true, AFTER_DRAIN = false;
    bf16_t* Z; float* ZS;
    __device__ __forceinline__ void operator()(const f32x4 (&acc)[2][2][4][2], const Unit& u, int wr, int wc, int fr, int fq) const {
        const int row0 = u.pm * BM + wr * 64 + fr;
        if (u.pn < NZT) {
            const int col0 = u.pn * BM + wc * 32 + 8 * fq;
#pragma unroll
            for (int ai = 0; ai < 2; ++ai)
#pragma unroll
                for (int m = 0; m < 4; ++m) { bf16_t* rowp = Z + (size_t)(row0 + ai * HALF + m * 16) * ZP + col0;
#pragma unroll
                    for (int bj = 0; bj < 2; ++bj) { const f32x4 v0 = acc[ai][bj][m][0], v1 = acc[ai][bj][m][1];
                        u32x4 w; w.x = cvt_pk_bf16(v0[0], v0[1]); w.y = cvt_pk_bf16(v0[2], v0[3]); w.z = cvt_pk_bf16(v1[0], v1[1]); w.w = cvt_pk_bf16(v1[2], v1[3]);
                        *(u32x4*)(rowp + bj * HALF) = w; } }
        } else {
            const int col0 = (u.pn - NZT) * BM + wc * 32 + 8 * fq;
#pragma unroll
            for (int ai = 0; ai < 2; ++ai)
#pragma unroll
                for (int m = 0; m < 4; ++m) { float* rowp = ZS + (size_t)(row0 + ai * HALF + m * 16) * ZSP + col0;
#pragma unroll
                    for (int bj = 0; bj < 2; ++bj) { *(f32x4*)(rowp + bj * HALF) = acc[ai][bj][m][0]; *(f32x4*)(rowp + bj * HALF + 4) = acc[ai][bj][m][1]; } }
        }
    }
};

template <int P> struct EpiGate {
    static constexpr bool PERM = true, AFTER_DRAIN = false;
    const bf16_t* G;
    float* M32;
    bf16_t* OUT;
    __device__ __forceinline__ void operator()(const f32x4 (&acc)[2][2][4][2], const Unit& u, int wr, int wc, int fr, int fq) const {
        const int row0 = u.pm * BM + wr * 64 + fr, col0 = u.pn * BM + wc * 32 + 8 * fq;
#pragma unroll
        for (int ai = 0; ai < 2; ++ai)
#pragma unroll
            for (int m = 0; m < 4; ++m) { const size_t row = (size_t)(row0 + ai * HALF + m * 16);
#pragma unroll
                for (int bj = 0; bj < 2; ++bj) { const int col = col0 + bj * HALF;
                    const u32x4 gw = *(const u32x4*)(G + row * ZP + P * 1024 + col);
                    const f32x4 v0 = acc[ai][bj][m][0], v1 = acc[ai][bj][m][1];
                    f32x4 t0, t1;
                    t0[0] = sigmoidf_(bflo(gw.x)) * v0[0]; t0[1] = sigmoidf_(bfhi(gw.x)) * v0[1]; t0[2] = sigmoidf_(bflo(gw.y)) * v0[2]; t0[3] = sigmoidf_(bfhi(gw.y)) * v0[3];
                    t1[0] = sigmoidf_(bflo(gw.z)) * v1[0]; t1[1] = sigmoidf_(bfhi(gw.z)) * v1[1]; t1[2] = sigmoidf_(bflo(gw.w)) * v1[2]; t1[3] = sigmoidf_(bfhi(gw.w)) * v1[3];
                    float* mp = M32 + row * 1024 + col;
                    if (P == 0) { *(f32x4*)mp = t0; *(f32x4*)(mp + 4) = t1; }
                    else if (P == 1) { *(f32x4*)mp = *(const f32x4*)mp + t0; *(f32x4*)(mp + 4) = *(const f32x4*)(mp + 4) + t1; }
                    else { t0 = *(const f32x4*)mp + t0; t1 = *(const f32x4*)(mp + 4) + t1;
                        u32x4 w; w.x = cvt_pk_bf16(t0[0], t0[1]); w.y = cvt_pk_bf16(t0[2], t0[3]); w.z = cvt_pk_bf16(t1[0], t1[1]); w.w = cvt_pk_bf16(t1[2], t1[3]);
                        *(u32x4*)(OUT + row * ZP + col) = w; } } }
    }
};

struct EpiRes {
    static constexpr bool PERM = true, AFTER_DRAIN = false;
    const float* RES; float* OUT;
    __device__ __forceinline__ void operator()(const f32x4 (&acc)[2][2][4][2], const Unit& u, int wr, int wc, int fr, int fq) const {
        const int row0 = u.pm * BM + wr * 64 + fr, col0 = u.pn * BM + wc * 32 + 8 * fq;
#pragma unroll
        for (int ai = 0; ai < 2; ++ai)
#pragma unroll
            for (int m = 0; m < 4; ++m) { const size_t off = (size_t)(row0 + ai * HALF + m * 16) * 1024 + col0;
#pragma unroll
                for (int bj = 0; bj < 2; ++bj) { const float* rp = RES + off + bj * HALF; float* op = OUT + off + bj * HALF;
                    const f32x4 r0 = *(const f32x4*)rp, r1 = *(const f32x4*)(rp + 4);
                    *(f32x4*)op = r0 + acc[ai][bj][m][0]; *(f32x4*)(op + 4) = r1 + acc[ai][bj][m][1]; } }
    }
};

struct EpiSwi {
    static constexpr bool PERM = true, AFTER_DRAIN = false;
    bf16_t* H; int ldh;
    __device__ __forceinline__ void operator()(const f32x4 (&acc)[2][2][4][2], const Unit& u, int wr, int wc, int fr, int fq) const {
        const int row0 = u.pm * BM + wr * 64 + fr, col0 = u.pn * HALF + wc * 32 + 8 * fq;
#pragma unroll
        for (int ai = 0; ai < 2; ++ai)
#pragma unroll
            for (int m = 0; m < 4; ++m) { bf16_t* hp = H + (size_t)(row0 + ai * HALF + m * 16) * ldh + col0;
                float o[8];
#pragma unroll
                for (int n = 0; n < 2; ++n)
#pragma unroll
                    for (int i = 0; i < 4; ++i) { const float g = acc[ai][0][m][n][i], up = acc[ai][1][m][n][i]; o[4 * n + i] = g * sigmoidf_(g) * up; }
                u32x4 w; w.x = cvt_pk_bf16(o[0], o[1]); w.y = cvt_pk_bf16(o[2], o[3]); w.z = cvt_pk_bf16(o[4], o[5]); w.w = cvt_pk_bf16(o[6], o[7]);
                *(u32x4*)hp = w; }
    }
};

template <class Epi, class Sched, bool ALIGN_EPI = false, bool SP2 = false>
__device__ __forceinline__ void gemm_phase(PG8_LAS unsigned char* lds, Gemm g, const Sched& S0, const Epi& E, int wave_id) {
    int ovz, osz; asm volatile("v_mov_b32 %0, 0\n\ts_mov_b32 %1, 0" : "=v"(ovz), "=s"(osz));
    Sched S = S0; S.c += osz; g.lda += osz; g.ldb += osz;
    const int tid = ((wave_id << 6) | lane_id_v()) + ovz,
         wid = __builtin_amdgcn_readfirstlane(tid >> 6), lane = tid & 63, wr = wid >> 2, wc = wid & 3, fr = lane & 15, fq = lane >> 4;
    const int K = g.K, nt = K / BK;
    unsigned voffA[2], voffB[2];
#pragma unroll
    for (int i = 0; i < 2; ++i) { int R, C; stage_rc(tid * 16 + i * 8192, R, C); const int Rb = Epi::PERM ? ((R & ~31) + perm32(R & 31)) : R;
        voffA[i] = (unsigned)(R * g.lda + C) * 2u; voffB[i] = (unsigned)(Rb * g.ldb + C) * 2u; }
    const size_t kstep = (size_t)(BK * 2);
    const size_t hstepA = (size_t)HALF * g.lda * 2, hstepB = (size_t)HALF * g.ldb * 2;
    const size_t tstepA = 2 * hstepA, tstepB = 2 * hstepB;
    const unsigned ldsw = (unsigned)wid * 1024u;
    const int aoff = lds_byte(wr * 64 + fr, fq * 8), boff = lds_byte(wc * 32 + fr, fq * 8);
#define PG8_SA(b, h) (((b) * 2 + (h)) * HTB)
#define PG8_SB(b, h) ((4 + (b) * 2 + (h)) * HTB)
#define PG8_STAGE(bufoff, gbase, voff) do { _Pragma("unroll") for (int _i = 0; _i < 2; ++_i) \
        __builtin_amdgcn_global_load_lds((const unsigned*)((const char*)(gbase) + (voff)[_i]), (PG8_LAS unsigned*)(lds + (bufoff) + ldsw + _i * 8192), 16, 0, 0); } while (0)
#define PG8_LDA(dst, b, h) do { _Pragma("unroll") for (int m = 0; m < 4; ++m) _Pragma("unroll") for (int k = 0; k < 2; ++k) dst[m][k] = *(const PG8_LAS bf16x8*)(lds + PG8_SA(b, h) + aoff + m * 2048 + k * 1024); } while (0)
#define PG8_LDB(dst, b, h) do { _Pragma("unroll") for (int n = 0; n < 2; ++n) _Pragma("unroll") for (int k = 0; k < 2; ++k) dst[n][k] = *(const PG8_LAS bf16x8*)(lds + PG8_SB(b, h) + boff + n * 2048 + k * 1024); } while (0)
#define PG8_MMA(ai, bj, At, Bt) do { __builtin_amdgcn_s_setprio(1); _Pragma("unroll") for (int m = 0; m < 4; ++m) _Pragma("unroll") for (int n = 0; n < 2; ++n) _Pragma("unroll") for (int k = 0; k < 2; ++k) \
        acc[ai][bj][m][n] = __builtin_amdgcn_mfma_f32_16x16x32_bf16(Bt[n][k], At[m][k], acc[ai][bj][m][n], 0, 0, 0); __builtin_amdgcn_s_setprio(0); } while (0)
#define PG8_WAIT_V(n) asm volatile("s_waitcnt vmcnt(" #n ")" ::: "memory")
#define PG8_WAIT_L(n) asm volatile("s_waitcnt lgkmcnt(" #n ")" ::: "memory")
#define PG8_BAR __builtin_amdgcn_s_barrier()
#define PG8_SCHED __builtin_amdgcn_sched_barrier(0)
    Unit cur, nxt; int ui = 0;
    if (!S.next(0, cur)) return;
    f32x4 acc[2][2][4][2];
#pragma unroll
    for (int a = 0; a < 2; ++a)
#pragma unroll
        for (int b = 0; b < 2; ++b)
#pragma unroll
            for (int m = 0; m < 4; ++m)
#pragma unroll
                for (int n = 0; n < 2; ++n) acc[a][b][m][n] = (f32x4){0.f, 0.f, 0.f, 0.f};
    bf16x8 At[4][2], B0[2][2], B1[2][2];
    const char* cA = (const char*)g.A + (size_t)cur.pm * tstepA; const char* cB = (const char*)g.Bt + (size_t)cur.pn * tstepB;
    S.a_ready(cur);
    if constexpr (SP2) {
        PG8_STAGE(PG8_SB(0, 0), cB, voffB); PG8_STAGE(PG8_SB(0, 1), cB + hstepB, voffB); PG8_STAGE(PG8_SA(0, 0), cA, voffA); PG8_STAGE(PG8_SA(0, 1), cA + hstepA, voffA);
        if (wr == 1) PG8_BAR;
        PG8_WAIT_V(2); PG8_BAR;
        PG8_STAGE(PG8_SB(1, 0), cB + kstep, voffB); PG8_STAGE(PG8_SA(1, 0), cA + kstep, voffA); PG8_STAGE(PG8_SB(1, 1), cB + hstepB + kstep, voffB);
        PG8_WAIT_V(6); PG8_BAR;
    } else {
        PG8_STAGE(PG8_SB(0, 0), cB, voffB); PG8_STAGE(PG8_SA(0, 0), cA, voffA); PG8_STAGE(PG8_SB(0, 1), cB + hstepB, voffB); PG8_STAGE(PG8_SA(0, 1), cA + hstepA, voffA);
        if (wr == 1) PG8_BAR;
        PG8_WAIT_V(4); PG8_BAR;
        PG8_STAGE(PG8_SB(1, 0), cB + kstep, voffB); PG8_STAGE(PG8_SA(1, 0), cA + kstep, voffA); PG8_STAGE(PG8_SB(1, 1), cB + hstepB + kstep, voffB);
        PG8_WAIT_V(6); PG8_BAR;
    }
    for (;;) {
        const bool has_next = S.next(ui + 1, nxt);
        const char* nA = has_next ? (const char*)g.A + (size_t)nxt.pm * tstepA : cA; const char* nB = has_next ? (const char*)g.Bt + (size_t)nxt.pn * tstepB : cB;
        for (int t = 0; t < nt; t += 2) {
            const bool last = (t == nt - 2);
            const char* a1 = cA + (size_t)(t + 1) * kstep;
            const char* a2 = last ? nA : cA + (size_t)(t + 2) * kstep; const char* b2 = last ? nB : cB + (size_t)(t + 2) * kstep;
            const char* a3 = a2 + kstep; const char* b3 = b2 + kstep;
            if (last && has_next) S.a_ready(nxt);
            if constexpr (SP2) {
            PG8_LDB(B0, 0, 0); PG8_LDB(B1, 0, 1); PG8_SCHED; PG8_LDA(At, 0, 0); PG8_STAGE(PG8_SA(1, 1), a1 + hstepA, voffA);
            PG8_WAIT_V(8); PG8_WAIT_L(0); PG8_BAR; PG8_MMA(0, 0, At, B0); PG8_MMA(0, 1, At, B1); PG8_BAR; PG8_SCHED;
            PG8_LDA(At, 0, 1); PG8_STAGE(PG8_SB(0, 0), b2, voffB); PG8_STAGE(PG8_SB(0, 1), b2 + hstepB, voffB); PG8_STAGE(PG8_SA(0, 0), a2, voffA);
            PG8_WAIT_V(8); PG8_WAIT_L(0); PG8_BAR; PG8_MMA(1, 0, At, B0); PG8_MMA(1, 1, At, B1); PG8_BAR; PG8_SCHED;
            PG8_LDB(B0, 1, 0); PG8_LDB(B1, 1, 1); PG8_SCHED; PG8_LDA(At, 1, 0); PG8_STAGE(PG8_SA(0, 1), a2 + hstepA, voffA);
            PG8_WAIT_V(8); PG8_WAIT_L(0); PG8_BAR; PG8_MMA(0, 0, At, B0); PG8_MMA(0, 1, At, B1); PG8_BAR; PG8_SCHED;
            PG8_LDA(At, 1, 1); PG8_STAGE(PG8_SB(1, 0), b3, voffB); PG8_STAGE(PG8_SB(1, 1), b3 + hstepB, voffB); PG8_STAGE(PG8_SA(1, 0), a3, voffA);
            PG8_WAIT_V(8); PG8_WAIT_L(0); PG8_BAR; PG8_MMA(1, 0, At, B0); PG8_MMA(1, 1, At, B1); PG8_BAR; PG8_SCHED;
            } else {
            PG8_LDB(B0, 0, 0); PG8_SCHED; PG8_LDA(At, 0, 0); PG8_STAGE(PG8_SA(1, 1), a1 + hstepA, voffA);
            PG8_WAIT_L(8); PG8_BAR; PG8_WAIT_L(0); PG8_MMA(0, 0, At, B0); PG8_BAR; PG8_SCHED;
            PG8_LDB(B1, 0, 1); PG8_STAGE(PG8_SB(0, 0), b2, voffB);
            PG8_BAR; PG8_WAIT_L(0); PG8_MMA(0, 1, At, B1); PG8_BAR;
            PG8_LDA(At, 0, 1); PG8_STAGE(PG8_SA(0, 0), a2, voffA);
            PG8_BAR; PG8_WAIT_L(0); PG8_MMA(1, 0, At, B0); PG8_BAR; PG8_SCHED;
            PG8_STAGE(PG8_SB(0, 1), b2 + hstepB, voffB);
            PG8_WAIT_V(6); PG8_BAR; PG8_MMA(1, 1, At, B1); PG8_BAR;
            PG8_LDB(B0, 1, 0); PG8_SCHED; PG8_LDA(At, 1, 0); PG8_STAGE(PG8_SA(0, 1), a2 + hstepA, voffA);
            PG8_WAIT_L(8); PG8_BAR; PG8_WAIT_L(0); PG8_MMA(0, 0, At, B0); PG8_BAR; PG8_SCHED;
            PG8_LDB(B1, 1, 1); PG8_STAGE(PG8_SB(1, 0), b3, voffB);
            PG8_BAR; PG8_WAIT_L(0); PG8_MMA(0, 1, At, B1); PG8_BAR;
            PG8_LDA(At, 1, 1); PG8_STAGE(PG8_SA(1, 0), a3, voffA);
            PG8_BAR; PG8_WAIT_L(0); PG8_MMA(1, 0, At, B0); PG8_BAR; PG8_SCHED;
            PG8_STAGE(PG8_SB(1, 1), b3 + hstepB, voffB);
            PG8_WAIT_V(6); PG8_BAR; PG8_MMA(1, 1, At, B1); PG8_BAR;
            }
        }
        if constexpr (ALIGN_EPI) { if (wr == 0) PG8_BAR; }
        if constexpr (!Epi::AFTER_DRAIN) { E(acc, cur, wr, wc, fr, fq); S.done(cur); }
        if (!has_next) break;
#pragma unroll
        for (int a = 0; a < 2; ++a)
#pragma unroll
            for (int b = 0; b < 2; ++b)
#pragma unroll
                for (int m = 0; m < 4; ++m)
#pragma unroll
                    for (int n = 0; n < 2; ++n) acc[a][b][m][n] = (f32x4){0.f, 0.f, 0.f, 0.f};
        cur = nxt; cA = nA; cB = nB; ++ui;
        if constexpr (ALIGN_EPI) { if (wr == 1) PG8_BAR; }
    }
    PG8_WAIT_V(0);
    if constexpr (!ALIGN_EPI) { if (wr == 0) PG8_BAR; }
    PG8_BAR;
    if constexpr (Epi::AFTER_DRAIN) { E.fused(acc, cur, wr, wc, fr, fq, lds, wid, lane); S.done(cur); }
#undef PG8_SA
#undef PG8_SB
#undef PG8_STAGE
#undef PG8_LDA
#undef PG8_LDB
#undef PG8_MMA
#undef PG8_WAIT_V
#undef PG8_WAIT_L
#undef PG8_BAR
#undef PG8_SCHED
}
}

constexpr int NB = 4, SEQ = 4096, DM = 1024, DEPTH = 4, M = NB * SEQ;
constexpr int INC = 7088;
constexpr int NIN = 7168;
constexpr int FFH = 2816, FF2 = 5632;
constexpr int ZP = pg8::ZP, ZSP = pg8::ZSP;
constexpr int Z_FQ = 0, Z_FK = 512, Z_FV = 1024, Z_DQ = 1536, Z_RV = 2048, Z_RQ = 2560, Z_RK = 2816, Z_RG = 3072, Z_ZG = 3584, Z_MRG = 2560;
constexpr int S_IQ = 0, S_DK = 256, S_DV = 320, S_IK = 384, S_IW = 416, S_FF = 424;
constexpr float NORM_EPS = 1e-6f;
constexpr float LOG2E = 1.4426950408889634f;
constexpr float C2 = 0.125f * 1.4426950408889634f;

constexpr size_t MiB = 1u << 20;
constexpr size_t WS_CTL = 0, CTL_ZERO_BYTES = 1 * MiB;
constexpr size_t WS_ROPE64 = 1 * MiB;
constexpr size_t WS_ROPE32 = 2 * MiB;
constexpr size_t WS_LF = 2 * MiB + 512 * 1024;
constexpr size_t WS_CF = 3 * MiB;
constexpr size_t WS_ISG = 3 * MiB + 512 * 1024;
constexpr size_t WS_KD = 4 * MiB;
constexpr size_t WS_VD = 6 * MiB;
constexpr size_t WS_W = 8 * MiB;
constexpr size_t LW_IN = 0, LW_MIX = (size_t)NIN * 1024, LW_O = LW_MIX + 1536 * 1024, LW_FI = LW_O + 1024 * 1024, LW_FO = LW_FI + (size_t)FF2 * 1024, LW_STRIDE = LW_FO + (size_t)FFH * 1024;
constexpr size_t WS_Z = 150 * MiB;
constexpr size_t WS_HDN = 358 * MiB;
constexpr size_t WS_ZS = 390 * MiB;
constexpr size_t WS_IQB = 422 * MiB;
constexpr size_t WS_IKB = 430 * MiB;
constexpr size_t WS_END = 431 * MiB;
static_assert(WS_W + DEPTH * LW_STRIDE * 2 <= WS_Z && WS_Z + (size_t)M * ZP * 2 <= WS_HDN && WS_HDN + (size_t)M * 1024 * 2 == WS_ZS && WS_ZS + (size_t)M * ZSP * 4 == WS_IQB, "d_ws map");
constexpr int CW_BAR = 4096;

constexpr int RING_OFF = 0, RING_BYTES = 133120;
constexpr int LDSCTL_OFF = RING_BYTES, MISC_OFF = LDSCTL_OFF + 320;
constexpr int XTRA_OFF = RING_BYTES + 1024;
constexpr int LDS_BYTES = 147456;
constexpr int NWAVES = 8;
#define GAS __attribute__((address_space(1)))
#define LAS __attribute__((address_space(3)))
typedef unsigned short bf16;
typedef unsigned v4u __attribute__((ext_vector_type(4)));
typedef float f32x4 __attribute__((ext_vector_type(4)));
typedef short bf16x8 __attribute__((ext_vector_type(8)));
typedef GAS unsigned gu32;
typedef GAS unsigned long long gu64;
#define RLX_AGENT __ATOMIC_RELAXED, __HIP_MEMORY_SCOPE_AGENT
#define LDS_WAIT() asm volatile("s_waitcnt lgkmcnt(0)" ::: "memory")
#define VM_WAIT() asm volatile("s_waitcnt vmcnt(0)" ::: "memory")
__device__ __forceinline__ unsigned long long rt() { return __builtin_amdgcn_s_memrealtime(); }
__device__ __forceinline__ unsigned f2bf(float f) { unsigned u = __builtin_bit_cast(unsigned, f); return (u + 0x7fffu + ((u >> 16) & 1u)) >> 16; }
__device__ __forceinline__ unsigned pk2(float lo, float hi) { return f2bf(lo) | (f2bf(hi) << 16); }

#define XB_TMO      128
#define XB_XCNT(j)  (256  + 64 * (j))
#define XB_XSUB(j)  (1280 + 64 * (j))
#define XB_XGEN(j)  (2304 + 64 * (j))
#define XB_TOP      3328
#define XB_TOPGEN   3392
#define XCD_BAR_WORDS 3456
#define XB_SPIN_CAP (1u << 22)

__device__ __forceinline__ unsigned xb_ld(unsigned* p)              { return __hip_atomic_load(p, __ATOMIC_RELAXED, __HIP_MEMORY_SCOPE_AGENT); }
__device__ __forceinline__ unsigned xb_add(unsigned* p, unsigned v) { return __hip_atomic_fetch_add(p, v, __ATOMIC_RELAXED, __HIP_MEMORY_SCOPE_AGENT); }
__device__ __forceinline__ unsigned xb_xcc_id() { return (unsigned)__builtin_amdgcn_s_getreg((3 << 11) | 20) & 0xFu; }
#define XB_SPIN(cond, bar) do { unsigned _sp = 0; while (cond) { __builtin_amdgcn_s_sleep(1); \
    if ((++_sp & 255u) == 0u) { if (xb_ld(&(bar)[XB_TMO])) break; if (_sp > XB_SPIN_CAP) { atomicAdd(&(bar)[XB_TMO], 1u); break; } } } } while (0)

struct XcdBarrier {
    unsigned* bar; unsigned x; int w;
    volatile LAS unsigned* st;
};

__device__ __forceinline__ XcdBarrier xcd_barrier_post(unsigned* bar, volatile LAS unsigned* st) {
    XcdBarrier b; b.bar = bar; b.x = xb_xcc_id(); b.st = st; b.w = 0;
    if (threadIdx.x == 0) (void)xb_add(&bar[XB_XCNT(b.x)], 1u);
    return b;
}
__device__ __forceinline__ void xcd_barrier_complete(unsigned* bar, unsigned x, unsigned& nloc, unsigned& nx) {
    const unsigned G = gridDim.x * gridDim.y * gridDim.z;
    unsigned sum, cnt, mine, sp = 0u;
    for (;;) {
        sum = 0u; cnt = 0u; mine = 0u;
#pragma unroll
        for (unsigned j = 0; j < 16; ++j) { const unsigned c = xb_ld(&bar[XB_XCNT(j)]); sum += c; cnt += (c > 0u) ? 1u : 0u; mine = (j == x) ? c : mine; }
        if (sum == G) break;
        __builtin_amdgcn_s_sleep(1);
        if ((++sp & 255u) == 0u) { if (xb_ld(&bar[XB_TMO])) break; if (sp > XB_SPIN_CAP) { atomicAdd(&bar[XB_TMO], 1u); break; } }
    }
    nloc = mine > 0u ? mine : 1u; nx = cnt > 0u ? cnt : 1u;
}

__device__ __forceinline__ void xcd_barrier(const XcdBarrier& b) {
    asm volatile("s_waitcnt vmcnt(0)" ::: "memory");
    __syncthreads();
    if (b.w == 0 && lane_id_v() == 0) {
        unsigned* bar = b.bar;
        __builtin_amdgcn_s_waitcnt(0);
        unsigned nloc = b.st[0], nx = b.st[1];
        if (nloc == 0u) { xcd_barrier_complete(bar, b.x, nloc, nx); b.st[0] = nloc; b.st[1] = nx; }
        const unsigned old = xb_add(&bar[XB_XSUB(b.x)], 1u);
        const unsigned gen = old / nloc;
        if (old + 1u == (gen + 1u) * nloc) {
            __builtin_amdgcn_fence(__ATOMIC_RELEASE, "agent");
            asm volatile("s_waitcnt vmcnt(0)" ::: "memory");
            const unsigned og = xb_add(&bar[XB_TOP], 1u);
            const unsigned tg = og / nx;
            if (og + 1u == (tg + 1u) * nx) xb_add(&bar[XB_TOPGEN], 1u);
            else XB_SPIN(xb_ld(&bar[XB_TOPGEN]) == tg, bar);
            __builtin_amdgcn_fence(__ATOMIC_ACQUIRE, "agent");
            xb_add(&bar[XB_XGEN(b.x)], 1u);
            asm volatile("s_waitcnt vmcnt(0)" ::: "memory");
        } else {
            XB_SPIN(xb_ld(&bar[XB_XGEN(b.x)]) == gen, bar);
            __builtin_amdgcn_fence(__ATOMIC_ACQUIRE, "agent");
            asm volatile("s_waitcnt vmcnt(0)" ::: "memory");
        }
    }
    __syncthreads();
}

typedef float f32x2 __attribute__((ext_vector_type(2)));
typedef unsigned u32x2 __attribute__((ext_vector_type(2)));
__device__ __forceinline__ float bflo(unsigned w) { return __builtin_bit_cast(float, w << 16); }
__device__ __forceinline__ float bfhi(unsigned w) { return __builtin_bit_cast(float, w & 0xffff0000u); }
__device__ __forceinline__ float bf2f(bf16 v) { return __builtin_bit_cast(float, (unsigned)v << 16); }
__device__ __forceinline__ void unpack8(const v4u w, float (&f)[8]) { f[0] = bflo(w.x); f[1] = bfhi(w.x); f[2] = bflo(w.y); f[3] = bfhi(w.y); f[4] = bflo(w.z); f[5] = bfhi(w.z); f[6] = bflo(w.w); f[7] = bfhi(w.w); }
__device__ __forceinline__ v4u pack8(const float (&f)[8]) { v4u w; w.x = pk2(f[0], f[1]); w.y = pk2(f[2], f[3]); w.z = pk2(f[4], f[5]); w.w = pk2(f[6], f[7]); return w; }
template <int MASK> __device__ __forceinline__ float sx(float v) { static_assert(MASK < 32, "swizzle xor mask"); return __builtin_bit_cast(float, __builtin_amdgcn_ds_swizzle(__builtin_bit_cast(int, v), 0x1F | (MASK << 10))); }
template <int MASK> __device__ __forceinline__ unsigned sxu(unsigned v) { return (unsigned)__builtin_amdgcn_ds_swizzle((int)v, 0x1F | (MASK << 10)); }
__device__ __forceinline__ void swap32(unsigned x, unsigned& lo_view, unsigned& hi_view) {
    unsigned a = x, b = x; asm volatile("" : "+v"(b));
    const auto rr = __builtin_amdgcn_permlane32_swap(a, b, false, false);
    lo_view = rr[0]; hi_view = rr[1];
}
__device__ __forceinline__ float wave_sum(float v) {
    v += sx<1>(v); v += sx<2>(v); v += sx<4>(v); v += sx<8>(v); v += sx<16>(v);
    return __builtin_bit_cast(float, __builtin_amdgcn_readlane(__builtin_bit_cast(int, v), 0)) + __builtin_bit_cast(float, __builtin_amdgcn_readlane(__builtin_bit_cast(int, v), 32));
}
__device__ __forceinline__ float wave_max(float v) {
    v = fmaxf(v, sx<1>(v)); v = fmaxf(v, sx<2>(v)); v = fmaxf(v, sx<4>(v)); v = fmaxf(v, sx<8>(v)); v = fmaxf(v, sx<16>(v));
    return fmaxf(__builtin_bit_cast(float, __builtin_amdgcn_readlane(__builtin_bit_cast(int, v), 0)), __builtin_bit_cast(float, __builtin_amdgcn_readlane(__builtin_bit_cast(int, v), 32)));
}
__device__ __forceinline__ float half_sum(float v) {
    unsigned a, b; swap32(__builtin_bit_cast(unsigned, v), a, b); return __builtin_bit_cast(float, a) + __builtin_bit_cast(float, b);
}
__device__ __forceinline__ float half_max(float v) {
    unsigned a, b; swap32(__builtin_bit_cast(unsigned, v), a, b); return fmaxf(__builtin_bit_cast(float, a), __builtin_bit_cast(float, b));
}
__device__ __forceinline__ float xor32(float v, int lane) {
    return __builtin_bit_cast(float, __builtin_amdgcn_ds_bpermute((lane ^ 32) << 2, __builtin_bit_cast(int, v)));
}
__device__ __forceinline__ float sigmoid_f(float x) { return 1.0f / (1.0f + __expf(-x)); }

struct Ctx {
    LAS unsigned char* lds;
    int tid, lane, wave, G, gw, NGW;
    float* out; unsigned char* ws;
};

__device__ __forceinline__ void conv_item(const float* W, int N, int sc, int nv, int k0, bf16* WT, int ldw, int dr, LAS float* scr, int lane) {
    const int n_ = lane & 31;
#pragma unroll 8
    for (int i = 0; i < 32; ++i) { const int kk = 2 * i + (lane >> 5); scr[kk * 33 + n_] = (n_ < nv) ? W[(size_t)(k0 + kk) * N + sc + n_] : 0.f; }
    LDS_WAIT(); asm volatile("" ::: "memory");
    const int c = lane & 7;
#pragma unroll
    for (int j = 0; j < 4; ++j) { const int n = (lane >> 3) + 8 * j; const LAS float* s = scr + (8 * c) * 33 + n;
        v4u o; o.x = pk2(s[0 * 33], s[1 * 33]); o.y = pk2(s[2 * 33], s[3 * 33]); o.z = pk2(s[4 * 33], s[5 * 33]); o.w = pk2(s[6 * 33], s[7 * 33]);
        if (n < nv) *(GAS v4u*)(WT + (size_t)(dr + n) * ldw + k0 + 8 * c) = o; }
    LDS_WAIT(); asm volatile("" ::: "memory");
}
__device__ const int SEG_IN[15][3] = {
    {0, 0, 512}, {512, 512, 512}, {1024, 1024, 512}, {1536, 6656 + S_FF, 8}, {1544, Z_DQ, 512}, {2056, 6656 + S_DK, 64}, {2120, 6656 + S_DV, 64},
    {2184, 6656 + S_IQ, 256}, {2440, 6656 + S_IK, 32}, {2472, 6656 + S_IW, 8}, {2480, Z_RQ, 256}, {2736, Z_RK, 256}, {2992, Z_RV, 512}, {3504, Z_RG, 512}, {4016, Z_ZG, 3072}};
constexpr int IN_BLK = 223;
constexpr int IT_IN = 16 * IN_BLK, IT_MIX = 8 * 32, IT_O = 16 * 32, IT_FI = 16 * (FF2 / 32), IT_FO = (FFH / 64) * 32;
constexpr int IT_LAYER = IT_IN + 3 * IT_MIX + IT_O + IT_FI + IT_FO;

__device__ __forceinline__ void sincos_acc(float ang, float& c, float& s) {
    const double a = (double)ang;
    const double k = __builtin_rint(a * 0.6366197723675814);
    double y = a - k * 1.5707963267948966; y -= k * 6.123233995736766e-17;
    const double y2 = y * y;
    double sp = -7.647163731819816e-13; sp = sp * y2 + 1.6059043836821613e-10; sp = sp * y2 - 2.505210838544172e-08; sp = sp * y2 + 2.7557319223985893e-06; sp = sp * y2 - 1.984126984126984e-04; sp = sp * y2 + 8.333333333333333e-03; sp = sp * y2 - 1.6666666666666666e-01;
    const double sn = y + y * y2 * sp;
    double cp = 4.779477332387385e-14; cp = cp * y2 - 1.1470745597729725e-11; cp = cp * y2 + 2.08767569878681e-09; cp = cp * y2 - 2.755731922398589e-07; cp = cp * y2 + 2.48015873015873e-05; cp = cp * y2 - 1.388888888888889e-03; cp = cp * y2 + 4.1666666666666664e-02; cp = cp * y2 - 0.5;
    const double cs = 1.0 + y2 * cp;
    const int q = ((int)k) & 3;
    const double ss = (q & 1) ? cs : sn, cc = (q & 1) ? sn : cs;
    s = (float)((q & 2) ? -ss : ss);
    c = (float)(((q + 1) & 2) ? -cc : cc);
}

__device__ __forceinline__ void p0_prologue(const Ctx& F, const float* w_in, const float* w_fox, const float* w_dsa, const float* w_ret, const float* w_o, const float* w_fi, const float* w_fo) {
    LAS float* scr = (LAS float*)(F.lds + RING_OFF + F.wave * 16384);
    bf16* Wb = (bf16*)(F.ws + WS_W);
    for (int it = F.gw; it < DEPTH * IT_LAYER; it += F.NGW) {
        const int l = it / IT_LAYER; int r = it % IT_LAYER;
        bf16* L = Wb + (size_t)l * LW_STRIDE;
        if (r < IT_IN) {
            const int kb = r / IN_BLK; int blk = r % IN_BLK; int sc = 0, dr = 0, nv = 0;
            for (int s = 0; s < 15; ++s) { const int w = SEG_IN[s][2], nb = (w + 31) >> 5; if (blk < nb) { sc = SEG_IN[s][0] + 32 * blk; dr = SEG_IN[s][1] + 32 * blk; nv = (w - 32 * blk) < 32 ? (w - 32 * blk) : 32; break; } blk -= nb; }
            conv_item(w_in + (size_t)l * DM * INC, INC, sc, nv, 64 * kb, L + LW_IN, 1024, dr, scr, F.lane); continue; }
        r -= IT_IN;
        if (r < 3 * IT_MIX) { const int w = r / IT_MIX, q = r % IT_MIX, kb = q / 32, nb = q % 32;
            conv_item((w == 0 ? w_fox : w == 1 ? w_dsa : w_ret) + (size_t)l * 512 * DM, DM, 32 * nb, 32, 64 * kb, L + LW_MIX + (size_t)w * 512 * 1024, 512, 32 * nb, scr, F.lane); continue; }
        r -= 3 * IT_MIX;
        if (r < IT_O) { const int kb = r / 32, nb = r % 32;
            conv_item(w_o + (size_t)l * DM * DM, DM, 32 * nb, 32, 64 * kb, L + LW_O, 1024, 32 * nb, scr, F.lane); continue; }
        r -= IT_O;
        if (r < IT_FI) { const int kb = r / (FF2 / 32), nb = r % (FF2 / 32); const int n0 = 32 * nb;
            const int j = n0 < FFH ? n0 : n0 - FFH; const int dr = 256 * (j >> 7) + (j & 127) + (n0 < FFH ? 0 : 128);
            conv_item(w_fi + (size_t)l * DM * FF2, FF2, n0, 32, 64 * kb, L + LW_FI, 1024, dr, scr, F.lane); continue; }
        r -= IT_FI;
        { const int kb = r / 32, nb = r % 32;
            conv_item(w_fo + (size_t)l * FFH * DM, DM, 32 * nb, 32, 64 * kb, L + LW_FO, FFH, 32 * nb, scr, F.lane); }
    }
    for (int i = F.gw * 64 + F.lane; i < DEPTH * 80 * 128; i += F.NGW * 64) { const int l = i / (80 * 128), q = i % (80 * 128);
        *(GAS v4u*)(Wb + (size_t)l * LW_STRIDE + LW_IN + (size_t)INC * 1024 + (size_t)q * 8) = (v4u){0u, 0u, 0u, 0u}; }
    f32x2* R64 = (f32x2*)(F.ws + WS_ROPE64); f32x2* R32 = (f32x2*)(F.ws + WS_ROPE32);
    for (int i = F.gw * 64 + F.lane; i < SEQ * 32; i += F.NGW * 64) { const int pos = i >> 5, k = i & 31;
        double f = 1.0; for (int e = 0; e < k; ++e) f *= 0.7498942093324559;
        const float ang = (float)pos * (float)f; float c, s; sincos_acc(ang, c, s); R64[i] = (f32x2){c, s}; }
    for (int i = F.gw * 64 + F.lane; i < SEQ * 16; i += F.NGW * 64) { const int pos = i >> 4, k = i & 15;
        double f = 1.0; for (int e = 0; e < k; ++e) f *= 0.5623413251903491;
        const float ang = (float)pos * (float)f; float c, s; sincos_acc(ang, c, s); R32[i] = (f32x2){c, s}; }
}

__device__ __forceinline__ void rmsnorm_phase(const Ctx& F, const float* x, const float* g, bf16* o) {
    const GAS f32x4* gp = (const GAS f32x4*)g + F.lane;
    f32x4 gv[4];
#pragma unroll
    for (int j = 0; j < 4; ++j) gv[j] = gp[64 * j];
    for (int m = F.gw; m < M; m += F.NGW) {
        const GAS f32x4* xr = (const GAS f32x4*)(x + (size_t)m * DM) + F.lane;
        f32x4 v[4]; float s = 0.f;
#pragma unroll
        for (int j = 0; j < 4; ++j) { v[j] = xr[64 * j]; s += (v[j].x * v[j].x + v[j].y * v[j].y) + (v[j].z * v[j].z + v[j].w * v[j].w); }
        const float rstd = 1.0f / sqrtf(wave_sum(s) * (1.f / DM) + NORM_EPS);
        GAS unsigned long long* o8 = (GAS unsigned long long*)(o + (size_t)m * DM) + F.lane;
#pragma unroll
        for (int j = 0; j < 4; ++j) o8[64 * j] = (unsigned long long)pk2(v[j].x * rstd * gv[j].x, v[j].y * rstd * gv[j].y) | ((unsigned long long)pk2(v[j].z * rstd * gv[j].z, v[j].w * rstd * gv[j].w) << 32);
    }
}

__device__ __forceinline__ void post_phase(const Ctx& F, const float* g_fq, const float* g_fk, const float* g_dq, const float* g_dk, const float* b_f) {
    bf16* Z = (bf16*)(F.ws + WS_Z); float* ZS = (float*)(F.ws + WS_ZS);
    const f32x2* R64 = (const f32x2*)(F.ws + WS_ROPE64); const f32x2* R32 = (const f32x2*)(F.ws + WS_ROPE32);
    float* LF = (float*)(F.ws + WS_LF); unsigned* ISG = (unsigned*)(F.ws + WS_ISG);
    bf16* KD = (bf16*)(F.ws + WS_KD); bf16* VD = (bf16*)(F.ws + WS_VD); bf16* IQB = (bf16*)(F.ws + WS_IQB); bf16* IKB = (bf16*)(F.ws + WS_IKB);
    const int lane = F.lane, c8 = lane & 7;
    float gq[8], gk[8], gd[8];
#pragma unroll
    for (int j = 0; j < 8; ++j) { gq[j] = g_fq[c8 * 8 + j]; gk[j] = g_fk[c8 * 8 + j]; gd[j] = g_dq[c8 * 8 + j]; }
    const float gdk = g_dk[lane];
    for (int m = F.gw; m < M; m += F.NGW) {
        const int pos = m & (SEQ - 1);
        bf16* zr = Z + (size_t)m * ZP; float* sr = ZS + (size_t)m * ZSP;
        { v4u w = *(const GAS v4u*)(zr + Z_FQ + 8 * lane); float f[8]; unpack8(w, f); float ss = 0.f;
#pragma unroll
            for (int j = 0; j < 8; ++j) ss += f[j] * f[j];
            ss += sx<1>(ss); ss += sx<2>(ss); ss += sx<4>(ss);
            const float rs = C2 / sqrtf(ss * (1.f / 64) + NORM_EPS);
#pragma unroll
            for (int j = 0; j < 8; ++j) f[j] = f[j] * rs * gq[j];
            *(GAS v4u*)(zr + Z_FQ + 8 * lane) = pack8(f); }
        { v4u w = *(const GAS v4u*)(zr + Z_FK + 8 * lane); float f[8]; unpack8(w, f); float ss = 0.f;
#pragma unroll
            for (int j = 0; j < 8; ++j) ss += f[j] * f[j];
            ss += sx<1>(ss); ss += sx<2>(ss); ss += sx<4>(ss);
            const float rs = 1.0f / sqrtf(ss * (1.f / 64) + NORM_EPS);
#pragma unroll
            for (int j = 0; j < 8; ++j) f[j] = f[j] * rs * gk[j];
            *(GAS v4u*)(zr + Z_FK + 8 * lane) = pack8(f); }
        { v4u w = *(const GAS v4u*)(zr + Z_DQ + 8 * lane); float f[8]; unpack8(w, f); float ss = 0.f;
#pragma unroll
            for (int j = 0; j < 8; ++j) ss += f[j] * f[j];
            ss += sx<1>(ss); ss += sx<2>(ss); ss += sx<4>(ss);
            const float rs = 1.0f / sqrtf(ss * (1.f / 64) + NORM_EPS);
            const f32x2* cs = R64 + pos * 32 + (c8 & 3) * 8;
#pragma unroll
            for (int j = 0; j < 8; ++j) { f[j] = f[j] * rs * gd[j]; }
            float o[8];
#pragma unroll
            for (int j = 0; j < 8; ++j) { const float p = sx<4>(f[j]); const f32x2 t = cs[j]; o[j] = ((c8 < 4) ? (f[j] * t.x - p * t.y) : (f[j] * t.x + p * t.y)) * C2; }
            *(GAS v4u*)(zr + Z_DQ + 8 * lane) = pack8(o); }
        { const f32x4 v = *(const GAS f32x4*)(sr + S_IQ + 4 * lane); float f[4] = {v.x, v.y, v.z, v.w};
            const float iw = sr[S_IW + (lane >> 3)]; const float aw = fabsf(iw);
            const f32x2* cs = R32 + pos * 16 + (lane & 3) * 4; const bool first = (lane & 7) < 4; f32x4 o;
#pragma unroll
            for (int j = 0; j < 4; ++j) { const float p = sx<4>(f[j]); const f32x2 t = cs[j]; o[j] = (first ? (f[j] * t.x - p * t.y) : (f[j] * t.x + p * t.y)) * aw; }
            const unsigned long long neg = __ballot(iw < 0.f);
            unsigned sg = 0;
#pragma unroll
            for (int h = 0; h < 8; ++h) sg |= (unsigned)((neg >> (8 * h)) & 1ull) << h;
            { u32x2 ob; ob.x = pk2(o[0], o[1]); ob.y = pk2(o[2], o[3]); *(GAS u32x2*)(IQB + (size_t)m * 256 + 4 * lane) = ob; }
            if (lane == 0) ISG[m] = sg; }
        { float v = sr[S_DK + lane]; const float ss = wave_sum(v * v); v = v * (1.0f / sqrtf(ss * (1.f / 64) + NORM_EPS)) * gdk;
            const float p = xor32(v, lane); const f32x2 t = R64[pos * 32 + (lane & 31)];
            const float o = (lane < 32) ? (v * t.x - p * t.y) : (v * t.x + p * t.y);
            KD[(size_t)m * 64 + lane] = (bf16)f2bf(o);
            VD[(size_t)m * 64 + lane] = (bf16)f2bf(sr[S_DV + lane]); }
        { const float v = sr[S_IK + (lane & 31)]; const float p = sx<16>(v); const f32x2 t = R32[pos * 16 + (lane & 15)];
            const float o = ((lane & 16) == 0) ? (v * t.x - p * t.y) : (v * t.x + p * t.y);
            if (lane < 32) IKB[(size_t)m * 32 + lane] = (bf16)f2bf(o); }
        if (lane < 8) { const float xx = sr[S_FF + lane] + b_f[lane]; const float ls = fminf(xx, 0.f) - __logf(1.0f + __expf(-fabsf(xx))); LF[(size_t)m * 8 + lane] = ls * LOG2E; }
    }
}

__device__ __forceinline__ float ret_l2g(int h) { return h == 0 ? -0.04580368961312479f : h == 1 ? -0.02272007650008353f : h == 2 ? -0.011315313227834146f : -0.005646563141142063f; }

__device__ __forceinline__ void scan_state_phase(const Ctx& F) {
    const float* LF = (const float*)(F.ws + WS_LF); float* CF = (float*)(F.ws + WS_CF);
    const bf16* Z = (const bf16*)(F.ws + WS_Z); float* RS = (float*)(F.ws + WS_HDN);
    if (F.gw < 32) {
        const int b = F.gw >> 3, h = F.gw & 7; const float* lp = LF + ((size_t)b * SEQ + F.lane * 64) * 8 + h; float s = 0.f;
        for (int i = 0; i < 64; ++i) s += lp[i * 8];
        float incl = s;
#pragma unroll
        for (int o = 1; o < 64; o <<= 1) { const float t = __builtin_bit_cast(float, __builtin_amdgcn_ds_bpermute(((F.lane - o) & 63) << 2, __builtin_bit_cast(int, incl))); if (F.lane >= o) incl += t; }
        float run = incl - s; float* cp = CF + (size_t)F.gw * SEQ + F.lane * 64;
        for (int i = 0; i < 64; ++i) { run += lp[i * 8]; cp[i] = run; }
    }
    for (int u = blockIdx.x; u < NB * 32 * 4; u += F.G) {
        const int h = u & 3, c = (u >> 2) & 31, b = u >> 7; const float l2g = ret_l2g(h);
        const int d = F.tid >> 3, e0 = (F.tid & 7) * 16; float acc[16];
#pragma unroll
        for (int i = 0; i < 16; ++i) acc[i] = 0.f;
        const bf16* base = Z + ((size_t)b * SEQ + c * 128) * ZP;
        for (int j = 0; j < 128; ++j) { const bf16* row = base + (size_t)j * ZP;
            const float kd = bf2f(row[Z_RK + h * 64 + d]) * exp2f((float)(127 - j) * l2g);
            const v4u w0 = *(const GAS v4u*)(row + Z_RV + h * 128 + e0), w1 = *(const GAS v4u*)(row + Z_RV + h * 128 + e0 + 8);
            float v0[8], v1[8]; unpack8(w0, v0); unpack8(w1, v1);
#pragma unroll
            for (int i = 0; i < 8; ++i) { acc[i] += kd * v0[i]; acc[8 + i] += kd * v1[i]; } }
        float* o = RS + (size_t)u * 8192 + d * 128 + e0;
#pragma unroll
        for (int i = 0; i < 4; ++i) *(GAS f32x4*)(o + 4 * i) = (f32x4){acc[4 * i], acc[4 * i + 1], acc[4 * i + 2], acc[4 * i + 3]};
    }
}

__device__ __forceinline__ void ret_out_naive(const Ctx& F, const float* gn) {
    bf16* Z = (bf16*)(F.ws + WS_Z); const float* RS = (const float*)(F.ws + WS_HDN);
    LAS float* S = (LAS float*)(F.lds);
    LAS bf16* Vt = (LAS bf16*)(F.lds + 32768);
    LAS float* Kt = (LAS float*)(F.lds + 65536);
    LAS float* aw = (LAS float*)(F.lds + 65536 + 33280) + F.wave * 128;
    LAS float* qw = (LAS float*)(F.lds + 65536 + 33280 + 4096) + F.wave * 64;
    for (int u = blockIdx.x; u < NB * 32 * 4; u += F.G) {
        const int h = u & 3, c = (u >> 2) & 31, b = u >> 7; const float l2g = ret_l2g(h); const float wch = exp2f(128.f * l2g);
        __syncthreads();
        { float s[16];
#pragma unroll
            for (int i = 0; i < 16; ++i) s[i] = 0.f;
            for (int cp = 0; cp < c; ++cp) { const float* L = RS + ((size_t)((b * 32 + cp) * 4 + h)) * 8192 + F.tid;
#pragma unroll
                for (int i = 0; i < 16; ++i) s[i] = wch * s[i] + L[i * 512]; }
#pragma unroll
            for (int i = 0; i < 16; ++i) S[F.tid + i * 512] = s[i]; }
        const bf16* base = Z + ((size_t)b * SEQ + c * 128) * ZP;
        for (int q = F.tid; q < 2048; q += 512) { const int r = q >> 4, ch = q & 15; *(LAS v4u*)(Vt + r * 128 + ch * 8) = *(const GAS v4u*)(base + (size_t)r * ZP + Z_RV + h * 128 + ch * 8); }
        for (int q = F.tid; q < 128 * 64; q += 512) { const int r = q >> 6, dd = q & 63; Kt[r * 65 + dd] = bf2f(base[(size_t)r * ZP + Z_RK + h * 64 + dd]); }
        __syncthreads();
        for (int i = F.wave; i < 128; i += NWAVES) {
            const size_t m = (size_t)b * SEQ + c * 128 + i; bf16* zr = Z + m * ZP;
            qw[F.lane] = bf2f(zr[Z_RQ + h * 64 + F.lane]);
            LDS_WAIT(); asm volatile("" ::: "memory");
#pragma unroll
            for (int jj = 0; jj < 2; ++jj) { const int j = F.lane + 64 * jj; float a = 0.f;
                if (j <= i) { float dot = 0.f; for (int dd = 0; dd < 64; ++dd) dot += qw[dd] * Kt[j * 65 + dd]; a = dot * exp2f((float)(i - j) * l2g); }
                aw[j] = a; }
            LDS_WAIT(); asm volatile("" ::: "memory");
            float o[2]; const float dq = exp2f((float)(i + 1) * l2g);
#pragma unroll
            for (int ee = 0; ee < 2; ++ee) { const int e = F.lane + 64 * ee; float acc = 0.f;
                for (int j = 0; j <= i; ++j) acc += aw[j] * bf2f(Vt[j * 128 + e]);
                float cr = 0.f; for (int dd = 0; dd < 64; ++dd) cr += qw[dd] * S[dd * 128 + e];
                o[ee] = acc + cr * dq; }
            const float ss = wave_sum(o[0] * o[0] + o[1] * o[1]); const float rstd = 1.0f / sqrtf(ss * (1.f / 128) + NORM_EPS);
#pragma unroll
            for (int ee = 0; ee < 2; ++ee) { const int e = F.lane + 64 * ee; const float rg = bf2f(zr[Z_RG + h * 128 + e]);
                zr[Z_RV + h * 128 + e] = (bf16)f2bf(o[ee] * rstd * gn[h * 128 + e] * rg * sigmoid_f(rg)); }
            LDS_WAIT(); asm volatile("" ::: "memory");
        }
    }
    __syncthreads();
}

__device__ __forceinline__ void fox_naive(const Ctx& F) {
    bf16* Z = (bf16*)(F.ws + WS_Z); const float* CF = (const float*)(F.ws + WS_CF);
    LAS float* sc = (LAS float*)(F.lds + F.wave * 16384);
    const int lane = F.lane;
    int it = 0;
    for (int r0 = 0; r0 < NB * 8 * SEQ; r0 += F.NGW, ++it) {
        const int r = r0 + ((it & 1) ? (F.NGW - 1 - F.gw) : F.gw);
        if (r >= NB * 8 * SEQ) continue;
        const int pos = r & (SEQ - 1), h = (r >> 12) & 7, b = r >> 15;
        const size_t m = (size_t)b * SEQ + pos;
        float qf[64];
        { const bf16* qp = Z + m * ZP + Z_FQ + h * 64;
#pragma unroll
            for (int i = 0; i < 8; ++i) { const v4u w = *(const GAS v4u*)(qp + 8 * i); float t[8]; unpack8(w, t);
#pragma unroll
                for (int j = 0; j < 8; ++j) qf[8 * i + j] = t[j]; } }
        const float* cf = CF + (size_t)(b * 8 + h) * SEQ;
        float mx = -INFINITY;
        for (int kk = lane; kk <= pos; kk += 64) { const bf16* kp = Z + ((size_t)b * SEQ + kk) * ZP + Z_FK + h * 64; float dot = 0.f;
#pragma unroll
            for (int i = 0; i < 8; ++i) { const v4u w = *(const GAS v4u*)(kp + 8 * i); float t[8]; unpack8(w, t);
#pragma unroll
                for (int j = 0; j < 8; ++j) dot += qf[8 * i + j] * t[j]; }
            const float s = dot - cf[kk]; sc[kk] = s; mx = fmaxf(mx, s); }
        mx = wave_max(mx);
        float sum = 0.f;
        for (int kk = lane; kk <= pos; kk += 64) { const float p = exp2f(sc[kk] - mx); sc[kk] = p; sum += p; }
        sum = wave_sum(sum);
        LDS_WAIT(); asm volatile("" ::: "memory");
        const bf16* vp = Z + (size_t)b * SEQ * ZP + Z_FV + h * 64 + lane;
        float o0 = 0.f, o1 = 0.f, o2 = 0.f, o3 = 0.f; int kk = 0;
        for (; kk + 3 <= pos; kk += 4) { o0 += sc[kk] * bf2f(vp[(size_t)kk * ZP]); o1 += sc[kk + 1] * bf2f(vp[(size_t)(kk + 1) * ZP]); o2 += sc[kk + 2] * bf2f(vp[(size_t)(kk + 2) * ZP]); o3 += sc[kk + 3] * bf2f(vp[(size_t)(kk + 3) * ZP]); }
        for (; kk <= pos; ++kk) o0 += sc[kk] * bf2f(vp[(size_t)kk * ZP]);
        Z[m * ZP + Z_FQ + h * 64 + lane] = (bf16)f2bf(((o0 + o1) + (o2 + o3)) / sum);
        LDS_WAIT(); asm volatile("" ::: "memory");
    }
}

__device__ __forceinline__ unsigned f2key(float s) { const unsigned u = __builtin_bit_cast(unsigned, s + 0.0f); return (u & 0x80000000u) ? ~u : (u | 0x80000000u); }
__device__ __forceinline__ void dsa_naive(const Ctx& F) {
    bf16* Z = (bf16*)(F.ws + WS_Z); const float* ZS = (const float*)(F.ws + WS_ZS);
    const unsigned* ISG = (const unsigned*)(F.ws + WS_ISG);
    const bf16* KD = (const bf16*)(F.ws + WS_KD); const bf16* VD = (const bf16*)(F.ws + WS_VD);
    LAS unsigned* kl = (LAS unsigned*)(F.lds + F.wave * 16384);
    LAS float* iqs = (LAS float*)(F.lds + XTRA_OFF + F.wave * 1536);
    const int lane = F.lane;
    int it = 0;
    for (int r0 = 0; r0 < M; r0 += F.NGW, ++it) {
        const int r = r0 + ((it & 1) ? (F.NGW - 1 - F.gw) : F.gw);
        if (r >= M) continue;
        const int pos = r & (SEQ - 1), b = r >> 12; const size_t m = (size_t)r;
        *(LAS f32x4*)(iqs + 4 * lane) = *(const GAS f32x4*)(ZS + m * ZSP + S_IQ + 4 * lane);
        const unsigned sg = ISG[m];
        LDS_WAIT(); asm volatile("" ::: "memory");
        for (int kk = lane; kk <= pos; kk += 64) { const float* ikp = ZS + ((size_t)b * SEQ + kk) * ZSP + S_IK; float ik[32];
#pragma unroll
            for (int i = 0; i < 8; ++i) { const f32x4 t = *(const GAS f32x4*)(ikp + 4 * i); ik[4 * i] = t.x; ik[4 * i + 1] = t.y; ik[4 * i + 2] = t.z; ik[4 * i + 3] = t.w; }
            float s = 0.f;
#pragma unroll 1
            for (int h = 0; h < 8; ++h) { float dot = 0.f;
#pragma unroll
                for (int dd = 0; dd < 32; ++dd) dot += iqs[h * 32 + dd] * ik[dd];
                dot = fmaxf(dot, 0.f); s += ((sg >> h) & 1u) ? -dot : dot; }
            kl[kk] = f2key(s); }
        LDS_WAIT(); asm volatile("" ::: "memory");
        unsigned key[64];
#pragma unroll
        for (int j = 0; j < 64; ++j) { const int kk = j * 64 + lane; key[j] = (kk <= pos) ? kl[kk] : 0u; }
        LDS_WAIT(); asm volatile("" ::: "memory");
        LAS unsigned* idx = kl; LAS float* pl = (LAS float*)(kl + 256); LAS bf16* qs = (LAS bf16*)(kl + 512);
        *(LAS v4u*)(qs + 8 * lane) = *(const GAS v4u*)(Z + m * ZP + Z_DQ + 8 * lane);
        unsigned T = 0u; int need = 0;
        if (pos + 1 > 256) {
            for (int bit = 31; bit >= 0; --bit) { const unsigned Tt = T | (1u << bit); int cnt = 0;
#pragma unroll
                for (int j = 0; j < 64; ++j) cnt += __builtin_popcountll(__ballot(key[j] >= Tt));
                if (cnt >= 256) T = Tt; }
            int ngt = 0;
#pragma unroll
            for (int j = 0; j < 64; ++j) ngt += __builtin_popcountll(__ballot(key[j] > T));
            need = 256 - ngt;
        }
        int nsel = 0, eqb = 0;
#pragma unroll
        for (int j = 0; j < 64; ++j) { const bool gt = key[j] > T, eq = (key[j] == T) && (T != 0u);
            const unsigned long long em = __ballot(eq); const int er = eqb + __builtin_amdgcn_mbcnt_hi((unsigned)(em >> 32), __builtin_amdgcn_mbcnt_lo((unsigned)em, 0u));
            const bool sel = gt || (eq && er < need); eqb += __builtin_popcountll(em);
            const unsigned long long sm = __ballot(sel); const int sp = nsel + __builtin_amdgcn_mbcnt_hi((unsigned)(sm >> 32), __builtin_amdgcn_mbcnt_lo((unsigned)sm, 0u));
            if (sel) idx[sp] = (unsigned)(j * 64 + lane); nsel += __builtin_popcountll(sm); }
        LDS_WAIT(); asm volatile("" ::: "memory");
        for (int h = 0; h < 8; ++h) {
            float sv[4]; float mx = -INFINITY;
#pragma unroll
            for (int i = 0; i < 4; ++i) { const int e = lane + 64 * i; sv[i] = -INFINITY;
                if (e < nsel) { const bf16* kp = KD + ((size_t)b * SEQ + idx[e]) * 64; float dot = 0.f;
#pragma unroll
                    for (int c = 0; c < 8; ++c) { const v4u w = *(const GAS v4u*)(kp + 8 * c); float t[8]; unpack8(w, t); const v4u qw = *(const LAS v4u*)(qs + h * 64 + 8 * c); float qq[8]; unpack8(qw, qq);
#pragma unroll
                        for (int j = 0; j < 8; ++j) dot += qq[j] * t[j]; }
                    sv[i] = dot; }
                mx = fmaxf(mx, sv[i]); }
            mx = wave_max(mx); float sum = 0.f;
#pragma unroll
            for (int i = 0; i < 4; ++i) { const int e = lane + 64 * i; const float p = (e < nsel) ? exp2f(sv[i] - mx) : 0.f; pl[e] = p; sum += p; }
            sum = wave_sum(sum);
            LDS_WAIT(); asm volatile("" ::: "memory");
            float o0 = 0.f, o1 = 0.f; int e = 0;
            for (; e + 1 < nsel; e += 2) { o0 += pl[e] * bf2f(VD[((size_t)b * SEQ + idx[e]) * 64 + lane]); o1 += pl[e + 1] * bf2f(VD[((size_t)b * SEQ + idx[e + 1]) * 64 + lane]); }
            if (e < nsel) o0 += pl[e] * bf2f(VD[((size_t)b * SEQ + idx[e]) * 64 + lane]);
            Z[m * ZP + Z_DQ + h * 64 + lane] = (bf16)f2bf((o0 + o1) / sum);
            LDS_WAIT(); asm volatile("" ::: "memory");
        }
    }
}

typedef short s16x8 __attribute__((ext_vector_type(8)));
typedef short s16x4 __attribute__((ext_vector_type(4)));
typedef short v4i16_t __attribute__((ext_vector_type(4)));
__device__ __forceinline__ s16x4 tr16(const LAS unsigned char* p) { return __builtin_bit_cast(s16x4, __builtin_amdgcn_ds_read_tr16_b64_v4i16((LAS v4i16_t*)p)); }
__device__ __forceinline__ float key2f(unsigned k) { return __builtin_bit_cast(float, (k & 0x80000000u) ? (k & 0x7fffffffu) : ~k); }

#define DSA_COUNT_GE(T_, out_) do { int c_ = 0; _Pragma("unroll") for (int j_ = 0; j_ < 64; ++j_) if (j_ < nreg) c_ += __builtin_popcountll(__ballot(key[j_] >= (T_))); out_ = c_; } while (0)
__device__ __forceinline__ void dsa_select(const unsigned (&key)[64], int nvalid, unsigned& T, int& need) {
    const int nreg = (nvalid + 63) >> 6;
    T = 0u; need = 0;
    if (nvalid <= 256) return;
    unsigned kmax = 0u;
#pragma unroll
    for (int j = 0; j < 64; ++j) if (j < nreg) kmax = key[j] > kmax ? key[j] : kmax;
#pragma unroll
    for (int o_ = 0; o_ < 1; ++o_) { unsigned t; t = sxu<1>(kmax); kmax = t > kmax ? t : kmax; t = sxu<2>(kmax); kmax = t > kmax ? t : kmax; t = sxu<4>(kmax); kmax = t > kmax ? t : kmax; t = sxu<8>(kmax); kmax = t > kmax ? t : kmax; t = sxu<16>(kmax); kmax = t > kmax ? t : kmax;
        unsigned a_, b_; swap32(kmax, a_, b_); kmax = a_ > b_ ? a_ : b_; }
    unsigned lo = 1u, hi = kmax + 1u; int hic = 0;
    { const float vm = fabsf(key2f(kmax)) + 1.0f; unsigned l2 = f2key(-vm * 64.0f); int c; DSA_COUNT_GE(l2, c); if (c >= 256) lo = l2; }
    int iter = 0; bool exact = false;
    while (hi - lo > 1u) {
        unsigned mid;
        if (iter < 24 && lo > 1u) { const float mv = 0.5f * key2f(lo) + 0.5f * key2f(hi - 1u); mid = f2key(mv); }
        else mid = lo + ((hi - lo) >> 1);
        if (mid <= lo) mid = lo + 1u; if (mid >= hi) mid = hi - 1u;
        int c; DSA_COUNT_GE(mid, c);
        if (c == 256) { T = mid; exact = true; break; }
        if (c > 256) lo = mid; else { hi = mid; hic = c; }
        ++iter;
    }
    if (exact) need = 256; else { T = lo; need = 256 - hic; }
}

__device__ __forceinline__ void dsa_attend(const bf16* zq, bf16* zo, const bf16* KDb, const bf16* VDb, const LAS unsigned short* idx, int nsel, LAS unsigned char* vst, int lane) {
    const int g = lane >> 4, c = lane & 15;
    s16x8 qf[2];
#pragma unroll
    for (int ks = 0; ks < 2; ++ks) { qf[ks] = (s16x8){0, 0, 0, 0, 0, 0, 0, 0}; if (c < 8) qf[ks] = *(const GAS s16x8*)(zq + c * 64 + 32 * ks + 8 * g); }
    f32x4 acc[16];
#pragma unroll
    for (int tb = 0; tb < 4; ++tb) {
        s16x8 kf[4][2];
#pragma unroll
        for (int tt = 0; tt < 4; ++tt) { const int e = 16 * (4 * tb + tt) + c; const int id = (e < nsel) ? (int)idx[e] : 0; const bf16* kp = KDb + (size_t)id * 64 + 8 * g;
            kf[tt][0] = *(const GAS s16x8*)kp; kf[tt][1] = *(const GAS s16x8*)(kp + 32); }
#pragma unroll
        for (int tt = 0; tt < 4; ++tt) { f32x4 a = (f32x4){0.f, 0.f, 0.f, 0.f};
            a = __builtin_amdgcn_mfma_f32_16x16x32_bf16(kf[tt][0], qf[0], a, 0, 0, 0); a = __builtin_amdgcn_mfma_f32_16x16x32_bf16(kf[tt][1], qf[1], a, 0, 0, 0); acc[4 * tb + tt] = a; }
    }
    float mx = -INFINITY;
#pragma unroll
    for (int t = 0; t < 16; ++t)
#pragma unroll
        for (int i = 0; i < 4; ++i) { const int e = 16 * t + 4 * g + i; if (e >= nsel) acc[t][i] = -INFINITY; mx = fmaxf(mx, acc[t][i]); }
    mx = fmaxf(mx, sx<16>(mx)); mx = half_max(mx);
    float sum = 0.f;
#pragma unroll
    for (int t = 0; t < 16; ++t)
#pragma unroll
        for (int i = 0; i < 4; ++i) { const float p = exp2f(acc[t][i] - mx); acc[t][i] = p; sum += p; }
    sum += sx<16>(sum); sum = half_sum(sum);
    const float inv = 1.0f / sum;
    s16x8 pf[8];
#pragma unroll
    for (int s = 0; s < 8; ++s) { v4u w; w.x = pk2(acc[2 * s][0] * inv, acc[2 * s][1] * inv); w.y = pk2(acc[2 * s][2] * inv, acc[2 * s][3] * inv); w.z = pk2(acc[2 * s + 1][0] * inv, acc[2 * s + 1][1] * inv); w.w = pk2(acc[2 * s + 1][2] * inv, acc[2 * s + 1][3] * inv);
        pf[s] = __builtin_bit_cast(s16x8, w); }
    f32x4 o[4];
#pragma unroll
    for (int db = 0; db < 4; ++db) o[db] = (f32x4){0.f, 0.f, 0.f, 0.f};
    const int q = (lane >> 2) & 3, p = lane & 3, swz = 2 * (g & 1) + (q >> 1);
    const LAS unsigned char* rb = vst + (4 * g + q) * 128 + 8 * p;
#pragma unroll
    for (int hh = 0; hh < 2; ++hh) {
        asm volatile("s_waitcnt lgkmcnt(0)" ::: "memory");
#pragma unroll
        for (int i = 0; i < 16; ++i) { const int pi = lane + 64 * i, r = pi >> 3, c16 = pi & 7, e = 128 * hh + r; const int id = (e < nsel) ? (int)idx[e] : 0;
            const v4u v = *(const GAS v4u*)(VDb + (size_t)id * 64 + c16 * 8);
            *(LAS v4u*)(vst + r * 128 + ((((c16 >> 1) ^ ((r >> 1) & 3))) << 5) + ((c16 & 1) << 4)) = v; }
        asm volatile("s_waitcnt lgkmcnt(0)" ::: "memory");
#pragma unroll
        for (int s4 = 0; s4 < 4; ++s4)
#pragma unroll
            for (int db = 0; db < 4; ++db) { const LAS unsigned char* a1 = rb + s4 * 4096 + ((db ^ swz) << 5);
                const s16x4 lo = tr16(a1), hi = tr16(a1 + 2048);
                const s16x8 vf = (s16x8){lo[0], lo[1], lo[2], lo[3], hi[0], hi[1], hi[2], hi[3]};
                o[db] = __builtin_amdgcn_mfma_f32_16x16x32_bf16(pf[4 * hh + s4], vf, o[db], 0, 0, 0); }
    }
    if (g < 2) {
#pragma unroll
        for (int db = 0; db < 4; ++db)
#pragma unroll
            for (int i = 0; i < 4; ++i) zo[(4 * g + i) * 64 + 16 * db + c] = (bf16)f2bf(o[db][i]);
    }
}

__device__ __forceinline__ void dsa_v2(const Ctx& F) {
    bf16* Z = (bf16*)(F.ws + WS_Z); const float* ZS = (const float*)(F.ws + WS_ZS);
    const unsigned* ISG = (const unsigned*)(F.ws + WS_ISG);
    const bf16* KD = (const bf16*)(F.ws + WS_KD); const bf16* VD = (const bf16*)(F.ws + WS_VD);
    LAS unsigned* kl = (LAS unsigned*)(F.lds + F.wave * 16384);
    LAS float* iqs = (LAS float*)(F.lds + XTRA_OFF + F.wave * 1536);
    LAS unsigned short* idx = (LAS unsigned short*)(F.lds + XTRA_OFF + F.wave * 1536 + 1024);
    const int lane = F.lane;
    int it = 0;
    for (int r0 = 0; r0 < M; r0 += F.NGW, ++it) {
        const int r = r0 + ((it & 1) ? (F.NGW - 1 - F.gw) : F.gw);
        if (r >= M) continue;
        const int pos = r & (SEQ - 1), b = r >> 12; const size_t m = (size_t)r;
        *(LAS f32x4*)(iqs + 4 * lane) = *(const GAS f32x4*)(ZS + m * ZSP + S_IQ + 4 * lane);
        const unsigned sg = ISG[m];
        LDS_WAIT(); asm volatile("" ::: "memory");
        for (int kk = lane; kk <= pos; kk += 64) { const float* ikp = ZS + ((size_t)b * SEQ + kk) * ZSP + S_IK; float ik[32];
#pragma unroll
            for (int i = 0; i < 8; ++i) { const f32x4 t = *(const GAS f32x4*)(ikp + 4 * i); ik[4 * i] = t.x; ik[4 * i + 1] = t.y; ik[4 * i + 2] = t.z; ik[4 * i + 3] = t.w; }
            float s = 0.f;
#pragma unroll 1
            for (int h = 0; h < 8; ++h) { float dot = 0.f;
#pragma unroll
                for (int dd = 0; dd < 32; ++dd) dot += iqs[h * 32 + dd] * ik[dd];
                dot = fmaxf(dot, 0.f); s += ((sg >> h) & 1u) ? -dot : dot; }
            kl[kk] = f2key(s); }
        LDS_WAIT(); asm volatile("" ::: "memory");
        unsigned key[64];
#pragma unroll
        for (int j = 0; j < 64; ++j) { const int kk = j * 64 + lane; key[j] = (kk <= pos) ? kl[kk] : 0u; }
        LDS_WAIT(); asm volatile("" ::: "memory");
        unsigned T; int need;
#ifdef DSA_OLDSEL
        T = 0u; need = 0;
        if (pos + 1 > 256) {
            for (int bit = 31; bit >= 0; --bit) { const unsigned Tt = T | (1u << bit); int cnt = 0;
#pragma unroll
                for (int j = 0; j < 64; ++j) cnt += __builtin_popcountll(__ballot(key[j] >= Tt));
                if (cnt >= 256) T = Tt; }
            int ngt = 0;
#pragma unroll
            for (int j = 0; j < 64; ++j) ngt += __builtin_popcountll(__ballot(key[j] > T));
            need = 256 - ngt;
        }
#else
        dsa_select(key, pos + 1, T, need);
#endif
        int nsel = 0, eqb = 0;
#pragma unroll
        for (int j = 0; j < 64; ++j) { const bool gt = key[j] > T, eq = (key[j] == T) && (T != 0u);
            const unsigned long long em = __ballot(eq); const int er = eqb + __builtin_amdgcn_mbcnt_hi((unsigned)(em >> 32), __builtin_amdgcn_mbcnt_lo((unsigned)em, 0u));
            const bool sel = gt || (eq && er < need); eqb += __builtin_popcountll(em);
            const unsigned long long sm = __ballot(sel); const int sp = nsel + __builtin_amdgcn_mbcnt_hi((unsigned)(sm >> 32), __builtin_amdgcn_mbcnt_lo((unsigned)sm, 0u));
            if (sel) idx[sp] = (unsigned short)(j * 64 + lane); nsel += __builtin_popcountll(sm); }
        LDS_WAIT(); asm volatile("" ::: "memory");
        dsa_attend(Z + m * ZP + Z_DQ, Z + m * ZP + Z_DQ, KD + (size_t)b * SEQ * 64, VD + (size_t)b * SEQ * 64, idx, nsel, (LAS unsigned char*)kl, lane);
        LDS_WAIT(); asm volatile("" ::: "memory");
    }
}

__device__ __forceinline__ int dsa_emit(const unsigned (&key)[64], int nvalid, unsigned T, int need, LAS unsigned short* idx, int lane) {
    const int nreg = (nvalid + 63) >> 6; int nsel = 0, eqb = 0;
#pragma unroll
    for (int j = 0; j < 64; ++j) if (j < nreg) { const bool gt = key[j] > T, eq = (key[j] == T) && (T != 0u);
        const unsigned long long em = __ballot(eq); const int er = eqb + __builtin_amdgcn_mbcnt_hi((unsigned)(em >> 32), __builtin_amdgcn_mbcnt_lo((unsigned)em, 0u));
        const bool sel = gt || (eq && er < need); eqb += __builtin_popcountll(em);
        const unsigned long long sm = __ballot(sel); const int sp = nsel + __builtin_amdgcn_mbcnt_hi((unsigned)(sm >> 32), __builtin_amdgcn_mbcnt_lo((unsigned)sm, 0u));
        if (sel) idx[sp] = (unsigned short)(j * 64 + lane); nsel += __builtin_popcountll(sm); }
    return nsel;
}

constexpr int DSA_ROWF = 4100;
__device__ __forceinline__ void dsa_v3(const Ctx& F) {
    bf16* Z = (bf16*)(F.ws + WS_Z);
    const unsigned* ISG = (const unsigned*)(F.ws + WS_ISG);
    const bf16* KD = (const bf16*)(F.ws + WS_KD); const bf16* VD = (const bf16*)(F.ws + WS_VD);
    const bf16* IQB = (const bf16*)(F.ws + WS_IQB); const bf16* IKB = (const bf16*)(F.ws + WS_IKB);
    LAS unsigned* img = (LAS unsigned*)(F.lds);
    LAS unsigned short* idxw = (LAS unsigned short*)(F.lds + XTRA_OFF + F.wave * 1536);
    const int lane = F.lane, g = lane >> 4, c = lane & 15, w = F.wave;
    const int v = (int)blockIdx.x;
    if (v < 256)
    for (int ui = 0; ui < 8; ++ui) {
        const int b = v >> 6, k = v & 63; const int pb = 128 * (ui >> 1) + ((ui & 1) ? 127 - k : k);
        const int q0 = pb * 8, kend = q0 + 8, ntile = (kend + 15) >> 4;
        const size_t mb = (size_t)b * SEQ;
        { s16x8 iqf[8]; float sgn[8];
          { const int qq = (q0 + c < SEQ) ? q0 + c : SEQ - 1; const bf16* qp = IQB + (mb + qq) * 256 + 8 * g; const unsigned sg = ISG[mb + qq];
#pragma unroll
            for (int h = 0; h < 8; ++h) { iqf[h] = *(const GAS s16x8*)(qp + h * 32); sgn[h] = ((sg >> h) & 1u) ? -1.0f : 1.0f; } }
          for (int t = w; t < ntile; t += 8) {
            const s16x8 ikf = *(const GAS s16x8*)(IKB + (mb + 16 * t + c) * 32 + 8 * g);
            f32x4 sc = (f32x4){0.f, 0.f, 0.f, 0.f};
#pragma unroll
            for (int h = 0; h < 8; ++h) { const f32x4 x = __builtin_amdgcn_mfma_f32_16x16x32_bf16(ikf, iqf[h], (f32x4){0.f, 0.f, 0.f, 0.f}, 0, 0, 0);
#pragma unroll
                for (int r = 0; r < 4; ++r) sc[r] += sgn[h] * fmaxf(x[r], 0.f); }
            v4u kk; kk.x = f2key(sc[0]); kk.y = f2key(sc[1]); kk.z = f2key(sc[2]); kk.w = f2key(sc[3]);
            const int kb = 16 * t + 4 * g, qa = q0 + c;
            if (kb + 0 > qa) kk.x = 0u; if (kb + 1 > qa) kk.y = 0u; if (kb + 2 > qa) kk.z = 0u; if (kb + 3 > qa) kk.w = 0u;
            if (c < 8) *(LAS v4u*)(img + c * DSA_ROWF + 16 * t + 4 * g) = kk; } }
        __syncthreads();
        const int pos = q0 + w; unsigned key[64];
#pragma unroll
        for (int j = 0; j < 64; ++j) { const int kidx = 64 * j + lane; key[j] = 0u; if (64 * j <= pos) { const unsigned a = img[w * DSA_ROWF + kidx]; key[j] = (kidx <= pos) ? a : 0u; } }
        unsigned T; int need; dsa_select(key, pos + 1, T, need);
        const int nsel = dsa_emit(key, pos + 1, T, need, idxw, lane);
        __syncthreads();
        { const size_t m = mb + pos; dsa_attend(Z + m * ZP + Z_DQ, Z + m * ZP + Z_DQ, KD + mb * 64, VD + mb * 64, idxw, nsel, F.lds + w * 16384, lane); }
        __syncthreads();
    }
}

__device__ __forceinline__ void ret_rope_frag(const bf16* row, const f32x2* cs, float scale, int g, s16x8 (&f)[2]) {
    const u32x2 a0 = *(const GAS u32x2*)(row + 4 * g), a1 = *(const GAS u32x2*)(row + 16 + 4 * g), b0 = *(const GAS u32x2*)(row + 32 + 4 * g), b1 = *(const GAS u32x2*)(row + 48 + 4 * g);
    const float x1[8] = {bflo(a0.x), bfhi(a0.x), bflo(a0.y), bfhi(a0.y), bflo(a1.x), bfhi(a1.x), bflo(a1.y), bfhi(a1.y)};
    const float x2[8] = {bflo(b0.x), bfhi(b0.x), bflo(b0.y), bfhi(b0.y), bflo(b1.x), bfhi(b1.x), bflo(b1.y), bfhi(b1.y)};
    float o1[8], o2[8];
#pragma unroll
    for (int j = 0; j < 8; ++j) { const f32x2 t = cs[(j < 4 ? 4 * g + j : 16 + 4 * g + (j - 4))]; o1[j] = (x1[j] * t.x - x2[j] * t.y) * scale; o2[j] = (x2[j] * t.x + x1[j] * t.y) * scale; }
    f[0] = __builtin_bit_cast(s16x8, pack8(o1)); f[1] = __builtin_bit_cast(s16x8, pack8(o2));
}
__device__ __forceinline__ s16x8 ret_bfrag(const LAS unsigned char* img, int row0, int eb, int g, int q, int p) {
    const int r1 = row0 + 4 * g + q;
    const LAS unsigned char* a1 = img + r1 * 256 + ((eb ^ (r1 & 7)) << 5) + 8 * p;
    const LAS unsigned char* a2 = img + (r1 + 16) * 256 + ((eb ^ ((r1 + 16) & 7)) << 5) + 8 * p;
    const s16x4 lo = tr16(a1), hi = tr16(a2);
    return (s16x8){lo[0], lo[1], lo[2], lo[3], hi[0], hi[1], hi[2], hi[3]};
}

__device__ __forceinline__ void ret_state_mfma(const Ctx& F) {
    const bf16* Z = (const bf16*)(F.ws + WS_Z); float* RS = (float*)(F.ws + WS_HDN);
    const f32x2* R64 = (const f32x2*)(F.ws + WS_ROPE64);
    LAS unsigned char* Kimg = F.lds; LAS unsigned char* Vimg = F.lds + 16384;
    const int lane = F.lane, g = lane >> 4, c = lane & 15, q = (lane >> 2) & 3, p = lane & 3;
    for (int u = blockIdx.x; u < NB * 32 * 4; u += F.G) {
        const int h = u & 3, ch = (u >> 2) & 31, b = u >> 7; const float l2g = ret_l2g(h);
        const bf16* base = Z + ((size_t)b * SEQ + ch * 128) * ZP;
        __syncthreads();
        for (int t = F.tid; t < 2048; t += 512) { const int r = t >> 4, c16 = t & 15;
            *(LAS v4u*)(Vimg + r * 256 + (((c16 >> 1) ^ (r & 7)) << 5) + ((c16 & 1) << 4)) = *(const GAS v4u*)(base + (size_t)r * ZP + Z_RV + h * 128 + c16 * 8); }
        for (int t = F.tid; t < 1024; t += 512) { const int j = t >> 3, dg = t & 7; const bf16* row = base + (size_t)j * ZP + Z_RK + h * 64;
            const u32x2 a = *(const GAS u32x2*)(row + 4 * dg), bb = *(const GAS u32x2*)(row + 32 + 4 * dg);
            const float x1[4] = {bflo(a.x), bfhi(a.x), bflo(a.y), bfhi(a.y)}, x2[4] = {bflo(bb.x), bfhi(bb.x), bflo(bb.y), bfhi(bb.y)};
            const f32x2* cs = R64 + (ch * 128 + j) * 32 + 4 * dg; const float sc = exp2f((float)(127 - j) * l2g);
            float o1[4], o2[4];
#pragma unroll
            for (int e = 0; e < 4; ++e) { const f32x2 tt = cs[e]; o1[e] = (x1[e] * tt.x - x2[e] * tt.y) * sc; o2[e] = (x2[e] * tt.x + x1[e] * tt.y) * sc; }
            u32x2 w1, w2; w1.x = pk2(o1[0], o1[1]); w1.y = pk2(o1[2], o1[3]); w2.x = pk2(o2[0], o2[1]); w2.y = pk2(o2[2], o2[3]);
            const int sw = (j >> 1) & 3; const int d1 = 4 * dg, d2 = 32 + 4 * dg;
            *(LAS u32x2*)(Kimg + j * 128 + ((((2 * d1) >> 5) ^ sw) << 5) + ((2 * d1) & 31)) = w1;
            *(LAS u32x2*)(Kimg + j * 128 + ((((2 * d2) >> 5) ^ sw) << 5) + ((2 * d2) & 31)) = w2; }
        __syncthreads();
        f32x4 acc[4];
#pragma unroll
        for (int db = 0; db < 4; ++db) acc[db] = (f32x4){0.f, 0.f, 0.f, 0.f};
#pragma unroll
        for (int s = 0; s < 4; ++s) {
            const s16x8 vb = ret_bfrag(Vimg, 32 * s, F.wave, g, q, p);
            const int r1 = 32 * s + 4 * g + q, sw = (r1 >> 1) & 3;
#pragma unroll
            for (int db = 0; db < 4; ++db) { const LAS unsigned char* a1 = Kimg + r1 * 128 + ((db ^ sw) << 5) + 8 * p;
                const s16x4 lo = tr16(a1), hi = tr16(a1 + 2048);
                const s16x8 ka = (s16x8){lo[0], lo[1], lo[2], lo[3], hi[0], hi[1], hi[2], hi[3]};
                acc[db] = __builtin_amdgcn_mfma_f32_16x16x32_bf16(ka, vb, acc[db], 0, 0, 0); }
        }
        float* o = RS + (size_t)u * 8192 + 16 * F.wave + c;
#pragma unroll
        for (int db = 0; db < 4; ++db)
#pragma unroll
            for (int r = 0; r < 4; ++r) o[(16 * db + 4 * g + r) * 128] = acc[db][r];
    }
    __syncthreads();
}

__device__ __forceinline__ void ret_scan(const Ctx& F) {
    const float* RS = (const float*)(F.ws + WS_HDN); float* SC = (float*)(F.ws + WS_HDN + 16 * MiB);
    for (int t = blockIdx.x * 512 + F.tid; t < NB * 4 * 8192; t += F.G * 512) {
        const int el = t & 8191, h = (t >> 13) & 3, b = t >> 15; const float wch = exp2f(128.f * ret_l2g(h)); float s = 0.f;
        for (int ch = 0; ch < 32; ++ch) { const size_t off = (size_t)(((b * 32 + ch) * 4 + h)) * 8192 + el; SC[off] = s; s = wch * s + RS[off]; }
    }
}

__device__ __forceinline__ void ret_out_mfma(const Ctx& F, const float* gn) {
    bf16* Z = (bf16*)(F.ws + WS_Z); const float* SC = (const float*)(F.ws + WS_HDN + 16 * MiB);
    const f32x2* R64 = (const f32x2*)(F.ws + WS_ROPE64);
    LAS unsigned char* Vimg = F.lds; LAS unsigned char* Simg = F.lds + 32768;
    const int lane = F.lane, g = lane >> 4, c = lane & 15, q = (lane >> 2) & 3, p = lane & 3, w = F.wave;
    for (int u = blockIdx.x; u < NB * 32 * 4; u += F.G) {
        const int h = u & 3, ch = (u >> 2) & 31, b = u >> 7; const float l2g = ret_l2g(h); const float gam = exp2f(l2g);
        bf16* base = Z + ((size_t)b * SEQ + ch * 128) * ZP;
        __syncthreads();
        for (int t = F.tid; t < 2048; t += 512) { const int r = t >> 4, c16 = t & 15;
            *(LAS v4u*)(Vimg + r * 256 + (((c16 >> 1) ^ (r & 7)) << 5) + ((c16 & 1) << 4)) = *(const GAS v4u*)(base + (size_t)r * ZP + Z_RV + h * 128 + c16 * 8); }
        for (int t = F.tid; t < 1024; t += 512) { const int r = t >> 4, c16 = t & 15; const float* sp = SC + (size_t)u * 8192 + r * 128 + c16 * 8;
            const f32x4 s0 = *(const GAS f32x4*)sp, s1 = *(const GAS f32x4*)(sp + 4);
            v4u wv; wv.x = pk2(s0.x * gam, s0.y * gam); wv.y = pk2(s0.z * gam, s0.w * gam); wv.z = pk2(s1.x * gam, s1.y * gam); wv.w = pk2(s1.z * gam, s1.w * gam);
            *(LAS v4u*)(Simg + r * 256 + (((c16 >> 1) ^ (r & 7)) << 5) + ((c16 & 1) << 4)) = wv; }
        const int i = 16 * w + c; s16x8 qf[2];
        ret_rope_frag(base + (size_t)i * ZP + Z_RQ + h * 64, R64 + (ch * 128 + i) * 32, 0.125f * exp2f((float)i * l2g), g, qf);
        f32x4 acc[8];
#pragma unroll
        for (int t = 0; t < 8; ++t) { acc[t] = (f32x4){0.f, 0.f, 0.f, 0.f};
            if (t <= w) { const int j = 16 * t + c; s16x8 kf[2];
                ret_rope_frag(base + (size_t)j * ZP + Z_RK + h * 64, R64 + (ch * 128 + j) * 32, exp2f(-(float)j * l2g), g, kf);
                acc[t] = __builtin_amdgcn_mfma_f32_16x16x32_bf16(kf[0], qf[0], acc[t], 0, 0, 0); acc[t] = __builtin_amdgcn_mfma_f32_16x16x32_bf16(kf[1], qf[1], acc[t], 0, 0, 0);
                if (t == w) {
#pragma unroll
                    for (int r = 0; r < 4; ++r) if (4 * g + r > c) acc[t][r] = 0.f; } } }
        s16x8 pf[4];
#pragma unroll
        for (int s = 0; s < 4; ++s) { v4u wv; wv.x = pk2(acc[2 * s][0], acc[2 * s][1]); wv.y = pk2(acc[2 * s][2], acc[2 * s][3]); wv.z = pk2(acc[2 * s + 1][0], acc[2 * s + 1][1]); wv.w = pk2(acc[2 * s + 1][2], acc[2 * s + 1][3]);
            pf[s] = __builtin_bit_cast(s16x8, wv); }
        __syncthreads();
        f32x4 o[8];
#pragma unroll
        for (int eb = 0; eb < 8; ++eb) o[eb] = (f32x4){0.f, 0.f, 0.f, 0.f};
#pragma unroll
        for (int s = 0; s < 4; ++s) if (2 * s <= w) {
#pragma unroll
            for (int eb = 0; eb < 8; ++eb) o[eb] = __builtin_amdgcn_mfma_f32_16x16x32_bf16(pf[s], ret_bfrag(Vimg, 32 * s, eb, g, q, p), o[eb], 0, 0, 0); }
#pragma unroll
        for (int ks = 0; ks < 2; ++ks)
#pragma unroll
            for (int eb = 0; eb < 8; ++eb) o[eb] = __builtin_amdgcn_mfma_f32_16x16x32_bf16(qf[ks], ret_bfrag(Simg, 32 * ks, eb, g, q, p), o[eb], 0, 0, 0);
        float rs[4];
#pragma unroll
        for (int r = 0; r < 4; ++r) { float ss = 0.f;
#pragma unroll
            for (int eb = 0; eb < 8; ++eb) ss += o[eb][r] * o[eb][r];
            ss += sx<1>(ss); ss += sx<2>(ss); ss += sx<4>(ss); ss += sx<8>(ss);
            rs[r] = 1.0f / sqrtf(ss * (1.f / 128) + NORM_EPS); }
#pragma unroll
        for (int r = 0; r < 4; ++r) { bf16* zr = base + (size_t)(16 * w + 4 * g + r) * ZP;
#pragma unroll
            for (int eb = 0; eb < 8; ++eb) { const int e = 16 * eb + c; const float rg = bf2f(zr[Z_RG + h * 128 + e]);
                zr[Z_RV + h * 128 + e] = (bf16)f2bf(o[eb][r] * rs[r] * gn[h * 128 + e] * rg * sigmoid_f(rg)); } }
    }
    __syncthreads();
}

__device__ __forceinline__ void fscan_phase(const Ctx& F) {
    const float* LF = (const float*)(F.ws + WS_LF); float* CF = (float*)(F.ws + WS_CF);
    if (F.gw < 32) {
        const int b = F.gw >> 3, h = F.gw & 7; const float* lp = LF + ((size_t)b * SEQ + F.lane * 64) * 8 + h; float s = 0.f;
        for (int i = 0; i < 64; ++i) s += lp[i * 8];
        float incl = s;
#pragma unroll
        for (int o = 1; o < 64; o <<= 1) { const float t = __builtin_bit_cast(float, __builtin_amdgcn_ds_bpermute(((F.lane - o) & 63) << 2, __builtin_bit_cast(int, incl))); if (F.lane >= o) incl += t; }
        float run = incl - s; float* cp = CF + (size_t)F.gw * SEQ + F.lane * 64;
        for (int i = 0; i < 64; ++i) { run += lp[i * 8]; cp[i] = run; }
    }
}
#include <hip/hip_bf16.h>
#include <cmath>
namespace attn_body {
using bf16=__hip_bfloat16;
using bf16x8=__attribute__((ext_vector_type(8)))short;
using s16x4=__attribute__((ext_vector_type(4)))short;
using f32x16=__attribute__((ext_vector_type(16)))float;
using u32x4=__attribute__((ext_vector_type(4)))unsigned;
constexpr int BATCH=4,NHEAD=8,SEQ=4096,D=64,DM=6656;
constexpr int NW=8,QBLK=32,QB=QBLK*NW,KVBLK=64,NQB=SEQ/QB;
constexpr int ATTN_PITCH=DM, ATTN_UNIT_ROWS=QB;
__device__ __forceinline__ int crow(int r,int hi){return (r&3)+8*(r>>2)+4*hi;}
#define SBAR() __builtin_amdgcn_sched_barrier(0)
__device__ __forceinline__ void cmask(f32x16&p0,f32x16&p1,int jb,int qrel,int hi){
  const float NEG=-INFINITY; int kb=64*jb+4*hi;
  #pragma unroll
  for(int r=0;r<16;++r){int kv=kb+(r&3)+8*(r>>2); if(kv>qrel)p0[r]=NEG; if(kv+32>qrel)p1[r]=NEG;}
}

constexpr int NSLOT=3, SLOTB=8192;
constexpr int LDS_K=0, LDS_V=NSLOT*SLOTB, LDS_WS=2*NSLOT*SLOTB, LDS_OST=LDS_WS+NW*64*4, LDS_NC=LDS_OST+NW*4096, LDS_BYTES=LDS_NC+SEQ*4;
constexpr float C2=0.125f*1.4426950408889634f;
__device__ __forceinline__ void glds16(const void*gsrc,unsigned lds_dst){unsigned keep;
  asm volatile("s_mov_b32 %0, m0\n\ts_mov_b32 m0, %2\n\ts_nop 0\n\tglobal_load_lds_dwordx4 %1, off\n\ts_mov_b32 m0, %0":"=&s"(keep):"v"(gsrc),"s"(lds_dst):"memory");}
__device__ __forceinline__ float max3f(float a,float b,float c){float r;asm("v_max3_f32 %0, %1, %2, %3":"=v"(r):"v"(a),"v"(b),"v"(c));return r;}
__device__ __forceinline__ float max2f(float a,float b){float r;asm("v_max_f32_e32 %0, %1, %2":"=v"(r):"v"(a),"v"(b));return r;}
__device__ __forceinline__ float fadd_s(float a,float b){float r;asm("v_add_f32_e32 %0, %1, %2":"=v"(r):"v"(a),"v"(b));return r;}
__device__ __forceinline__ float fsub_s(float a,float b){float r;asm("v_sub_f32_e32 %0, %1, %2":"=v"(r):"v"(a),"v"(b));return r;}
typedef float f32x4_t __attribute__((ext_vector_type(4))); typedef float f32x2_t __attribute__((ext_vector_type(2))); typedef __bf16 bf16x2_t __attribute__((ext_vector_type(2)));
__device__ __forceinline__ unsigned cvtpk_s(float lo,float hi){f32x2_t v={lo,hi};bf16x2_t b=__builtin_convertvector(v,bf16x2_t);return __builtin_bit_cast(unsigned,b);}
#define WAIT_BAR(N) asm volatile("s_waitcnt vmcnt(" #N ") lgkmcnt(0)\n\ts_barrier":::"memory")

__device__ __forceinline__ void qkt(f32x16&p0,f32x16&p1,const char*Kslot,const bf16x8*qr,const f32x16&negm,int r32,int hi){
  const char*kb=Kslot+hi*1024+r32*16;
  #pragma unroll
  for(int d0=0;d0<4;++d0){
    const bf16x8 b0=*reinterpret_cast<const bf16x8*>(kb+d0*2048);
    const bf16x8 b1=*reinterpret_cast<const bf16x8*>(kb+d0*2048+512);
    if(d0==0){p0=__builtin_amdgcn_mfma_f32_32x32x16_bf16(b0,qr[0],negm,0,0,0);p1=__builtin_amdgcn_mfma_f32_32x32x16_bf16(b1,qr[0],negm,0,0,0);}
    else{p0=__builtin_amdgcn_mfma_f32_32x32x16_bf16(b0,qr[d0],p0,0,0,0);p1=__builtin_amdgcn_mfma_f32_32x32x16_bf16(b1,qr[d0],p1,0,0,0);}}
}
typedef __attribute__((address_space(3))) const char* lds_cptr;
typedef short v4i16_t __attribute__((ext_vector_type(4)));
__device__ __forceinline__ void kload8(bf16x8*kf,lds_cptr kp){
  kf[0]=*(const __attribute__((address_space(3))) bf16x8*)(kp);      kf[1]=*(const __attribute__((address_space(3))) bf16x8*)(kp+512);
  kf[2]=*(const __attribute__((address_space(3))) bf16x8*)(kp+2048); kf[3]=*(const __attribute__((address_space(3))) bf16x8*)(kp+2560);
  kf[4]=*(const __attribute__((address_space(3))) bf16x8*)(kp+4096); kf[5]=*(const __attribute__((address_space(3))) bf16x8*)(kp+4608);
  kf[6]=*(const __attribute__((address_space(3))) bf16x8*)(kp+6144); kf[7]=*(const __attribute__((address_space(3))) bf16x8*)(kp+6656);
}
__device__ __forceinline__ void kload2(bf16x8*kf,lds_cptr kp,int j){ kf[2*j]=*(const __attribute__((address_space(3))) bf16x8*)(kp+j*2048); kf[2*j+1]=*(const __attribute__((address_space(3))) bf16x8*)(kp+j*2048+512); }
__device__ __forceinline__ s16x4 vtr(lds_cptr p){ return __builtin_bit_cast(s16x4,__builtin_amdgcn_ds_read_tr16_b64_v4i16((__attribute__((address_space(3))) v4i16_t*)p)); }
__device__ __forceinline__ float rowmax(const f32x16&p0,const f32x16&p1){
  float a=max3f(p0[0],p0[1],p1[0]),b=max3f(p0[2],p0[3],p1[1]);a=max3f(a,p1[2],p1[3]);
  #pragma unroll
  for(int r=4;r<16;r+=4){a=max3f(a,p0[r],p0[r+1]);b=max3f(b,p0[r+2],p0[r+3]);a=max3f(a,p1[r],p1[r+1]);b=max3f(b,p1[r+2],p1[r+3]);}
  const float m=max2f(a,b);
  auto rr=__builtin_amdgcn_permlane32_swap(__float_as_uint(m),__float_as_uint(m),false,false);
  return max2f(__uint_as_float(rr[0]),__uint_as_float(rr[1]));
}
__device__ __forceinline__ void pv(f32x16*o,int vb,bf16x8 pa0,bf16x8 pa1,bf16x8 pa2,bf16x8 pa3){
  #pragma unroll
  for(int d0=0;d0<2;++d0){s16x4 lo[4],hi[4];
    #pragma unroll
    for(int ks=0;ks<4;++ks){
      asm volatile("ds_read_b64_tr_b16 %0,%1 offset:%c2":"=&v"(lo[ks]):"v"(vb),"i"(d0*4096+ks*1024):"memory");
      asm volatile("ds_read_b64_tr_b16 %0,%1 offset:%c2":"=&v"(hi[ks]):"v"(vb),"i"(d0*4096+ks*1024+512):"memory");}
    asm volatile("s_waitcnt lgkmcnt(0)":::"memory");SBAR();
    #define PK(k) (bf16x8){lo[k][0],lo[k][1],lo[k][2],lo[k][3],hi[k][0],hi[k][1],hi[k][2],hi[k][3]}
    o[d0]=__builtin_amdgcn_mfma_f32_32x32x16_bf16(pa0,PK(0),o[d0],0,0,0);
    o[d0]=__builtin_amdgcn_mfma_f32_32x32x16_bf16(pa1,PK(1),o[d0],0,0,0);
    o[d0]=__builtin_amdgcn_mfma_f32_32x32x16_bf16(pa2,PK(2),o[d0],0,0,0);
    o[d0]=__builtin_amdgcn_mfma_f32_32x32x16_bf16(pa3,PK(3),o[d0],0,0,0);
    #undef PK
  }
}

#ifndef ATTN_STORE16
#define ATTN_STORE16(p,v) (*(u32x4*)(p)=(v))
#endif
template<int THRL> __device__ __forceinline__ void attn_unit(int b,int h,int qb,const bf16*Q,const bf16*__restrict__ K,const bf16*__restrict__ V,bf16*O,const float*CF,char*shm,int wave_id){
  int tid_=(wave_id<<6)|lane_id_v(); asm volatile("":"+v"(tid_));
  const int tid=tid_,lane=tid&63,r32=lane&31,hi=lane>>5; const int wid=__builtin_amdgcn_readfirstlane(tid>>6);
  const long rowbase=(long)b*SEQ; const int q0=qb*QB;
  const bf16*Qw=Q+(rowbase+q0+wid*QBLK)*DM+h*D;
  const bf16*Kh=K+rowbase*DM+h*D,*Vh=V+rowbase*DM+h*D;
  const unsigned lds0=(unsigned)(uintptr_t)shm;
  float*wsf=(float*)(shm+LDS_WS)+wid*64;
  const bf16*ksrc=Kh+(long)lane*DM+wid*8;
  const bf16*vsrc=Vh+(long)(16*(wid&3)+(lane>>2))*DM+(wid>>2)*32+(lane&3)*8;
  const unsigned kdst=lds0+LDS_K+wid*1024, vdst=lds0+LDS_V+wid*1024;
  #define DMA_K(t,slot) glds16(ksrc+(long)(t)*KVBLK*DM,(unsigned)__builtin_amdgcn_readfirstlane(kdst+(slot)))
  #define DMA_V(t,slot) glds16(vsrc+(long)(t)*KVBLK*DM,(unsigned)__builtin_amdgcn_readfirstlane(vdst+(slot)))
  const char*Kbase=shm+LDS_K; bf16x8 kf[8];
  const lds_cptr shm3=(lds_cptr)shm; const lds_cptr kp0=shm3+LDS_K+hi*1024+r32*16; const lds_cptr vp0=shm3+LDS_V+((lane>>4)&1)*32+(lane&3)*8+(4*hi+((lane&15)>>2))*64;
  const int NT=(q0+QB)/KVBLK;
  { const float*cfp=CF+(long)(b*NHEAD+h)*SEQ; float*ncw=(float*)(shm+LDS_NC);
    for(int i=tid;i<q0+QB;i+=NW*64)ncw[i]=-cfp[i]; }
  const lds_cptr ncp=(lds_cptr)shm+LDS_NC+hi*16;
  #define ADDC(P0,P1,t) do{ const lds_cptr np_=ncp+(t)*256; _Pragma("unroll") for(int g_=0;g_<4;++g_){ \
      const f32x4_t a_=*(const __attribute__((address_space(3))) f32x4_t*)(np_+g_*32), b_=*(const __attribute__((address_space(3))) f32x4_t*)(np_+g_*32+128); \
      P0[4*g_]+=a_[0];P0[4*g_+1]+=a_[1];P0[4*g_+2]+=a_[2];P0[4*g_+3]+=a_[3]; P1[4*g_]+=b_[0];P1[4*g_+1]+=b_[1];P1[4*g_+2]+=b_[2];P1[4*g_+3]+=b_[3]; } }while(0)
  DMA_K(0,0);DMA_V(0,0);DMA_K(1,SLOTB);
  bf16x8 qr[4];
  #pragma unroll
  for(int d0=0;d0<4;++d0)qr[d0]=*reinterpret_cast<const bf16x8*>(&Qw[(long)r32*DM+d0*16+hi*8]);
  float mhat=0.f,l_reg=0.f;f32x16 o[2];f32x16 negm; { float zz_; asm volatile("v_mov_b32 %0, 0":"=v"(zz_));
    _Pragma("unroll") for(int r=0;r<16;++r){o[0][r]=zz_;o[1][r]=zz_;negm[r]=zz_;} } asm volatile("":"+v"(negm));
  const int qrel=wid*QBLK+r32;
  #define CMASK(P0,P1,t) do{int jb_=(t)-(NT-4); if(jb_>=0)cmask(P0,P1,jb_,qrel,hi);}while(0)
  bool resc=false;
  #define START(P0,P1) do{ const float rm=rowmax(P0,P1); resc=false; \
    { const float dl=rm; mhat=fadd_s(mhat,dl); \
      _Pragma("unroll") for(int r=0;r<16;++r){P0[r]=fsub_s(P0[r],dl);P1[r]=fsub_s(P1[r],dl);} \
      _Pragma("unroll") for(int r=0;r<16;++r)negm[r]=-mhat; asm volatile("":"+v"(negm)); } \
    _Pragma("unroll") for(int r=0;r<16;++r)P0[r]=__builtin_amdgcn_exp2f(P0[r]); }while(0)
  #define RESC() do{ if(resc){ asm volatile("s_waitcnt lgkmcnt(0)":::"memory"); \
      _Pragma("unroll") for(int d_=0;d_<2;++d_) _Pragma("unroll") for(int r=0;r<16;++r)o[d_][r]*=wsf[crow(r,hi)]; } }while(0)
  f32x16 pA0,pA1,pB0,pB1;
  int sl_prev=0,sl_cur=0,sl_next=SLOTB;
  #define ROT() do{sl_prev=sl_cur;sl_cur=sl_next;sl_next=(sl_next==(NSLOT-1)*SLOTB)?0:sl_next+SLOTB;}while(0)
  DMA_K(2,2*SLOTB);
  WAIT_BAR(3);
  qkt(pA0,pA1,Kbase,qr,negm,r32,hi);asm volatile("s_nop 15\n\ts_nop 7":"+v"(pA0),"+v"(pA1));ADDC(pA0,pA1,0);CMASK(pA0,pA1,0);
  START(pA0,pA1);
  _Pragma("unroll") for(int r=0;r<16;++r)pA1[r]=__builtin_amdgcn_exp2f(pA1[r]);
  WAIT_BAR(0);
  DMA_K(3,0);DMA_V(1,SLOTB);
  ROT();
  kload8(kf,kp0+sl_cur);
  WAIT_BAR(2);
  s16x4 vlo[8],vhi[8]; u32x4 pw0,pw1,pw2,pw3;
  #define PKW(P,B) cvtpk_s(P[B],P[B+1])
  #define PAF(k) __builtin_bit_cast(bf16x8,pw##k)
  #define VFR(i) (bf16x8){vlo[i][0],vlo[i][1],vlo[i][2],vlo[i][3],vhi[i][0],vhi[i][1],vhi[i][2],vhi[i][3]}
  #define PIN(x) asm volatile("":"+v"(x))
  #define MX3(a,b,c) __builtin_fmaxf(__builtin_fmaxf((a),(b)),(c))
  #define GAPA(MF,A0,A1,A2,A3,W0,W1,PW) do{ MF; sacc+=A0; sacc+=A1; sacc+=A2; sacc+=A3; PIN(sacc); W0; W1; PIN(PW); SBAR(); }while(0)
  #define EX(v) __builtin_amdgcn_exp2f(v)
  #define GAPB(MF,X,B) do{ MF; X[B]=EX(X[B]); X[B+1]=EX(X[B+1]); X[B+2]=EX(X[B+2]); X[B+3]=EX(X[B+3]); PIN(X); SBAR(); }while(0)
  #define VRD(i) do{ vlo[i]=vtr(vp_+(((i)>>2)*4096+((i)&3)*1024)); vhi[i]=vtr(vp_+(((i)>>2)*4096+((i)&3)*1024+512)); }while(0)
  #define KRD(G,j) do{ if(G){ kload2(kf,kp0+sl_next,j); SBAR(); } }while(0)
  #define STEP(C0,C1,P0,P1,t,GK,GV,GL) do{ SBAR(); \
    const lds_cptr vp_=vp0+sl_prev; \
    VRD(0); SBAR(); float sacc=(P0[0]+P0[1]); \
    GAPA(C0=__builtin_amdgcn_mfma_f32_32x32x16_bf16(kf[0],qr[0],negm,0,0,0), P0[2],P0[3],P0[4],P0[5],     pw0[0]=PKW(P0,0), pw0[1]=PKW(P0,2), pw0); \
    VRD(4); SBAR(); GAPA(C1=__builtin_amdgcn_mfma_f32_32x32x16_bf16(kf[1],qr[0],negm,0,0,0), P0[6],P0[7],P0[8],P0[9],     pw0[2]=PKW(P0,4), pw0[3]=PKW(P0,6), pw0); \
    VRD(1); SBAR(); GAPA(C0=__builtin_amdgcn_mfma_f32_32x32x16_bf16(kf[2],qr[1],C0,0,0,0),   P0[10],P0[11],P0[12],P0[13], pw1[0]=PKW(P0,8), pw1[1]=PKW(P0,10), pw1); \
    VRD(5); SBAR(); GAPA(C1=__builtin_amdgcn_mfma_f32_32x32x16_bf16(kf[3],qr[1],C1,0,0,0),   P0[14],P0[15],P1[0],P1[1],   pw1[2]=PKW(P0,12),pw1[3]=PKW(P0,14), pw1); \
    VRD(2); SBAR(); GAPA(C0=__builtin_amdgcn_mfma_f32_32x32x16_bf16(kf[4],qr[2],C0,0,0,0),   P1[2],P1[3],P1[4],P1[5],     pw2[0]=PKW(P1,0), pw2[1]=PKW(P1,2), pw2); \
    VRD(6); SBAR(); GAPA(C1=__builtin_amdgcn_mfma_f32_32x32x16_bf16(kf[5],qr[2],C1,0,0,0),   P1[6],P1[7],P1[8],P1[9],     pw2[2]=PKW(P1,4), pw2[3]=PKW(P1,6), pw2); \
    VRD(3); SBAR(); GAPA(C0=__builtin_amdgcn_mfma_f32_32x32x16_bf16(kf[6],qr[3],C0,0,0,0),   P1[10],P1[11],P1[12],P1[13], pw3[0]=PKW(P1,8), pw3[1]=PKW(P1,10), pw3); \
    VRD(7); SBAR(); GAPA(C1=__builtin_amdgcn_mfma_f32_32x32x16_bf16(kf[7],qr[3],C1,0,0,0),   P1[14],P1[15],0.f,0.f,       pw3[2]=PKW(P1,12),pw3[3]=PKW(P1,14), pw3); \
    l_reg+=sacc; \
    if(GK){DMA_K((t)+3,sl_cur);} if(GV){DMA_V((t)+1,sl_next);} \
    ADDC(C0,C1,t); CMASK(C0,C1,t); \
    { float a=MX3(C0[0],C0[1],C1[0]),b=MX3(C0[2],C0[3],C1[1]); a=MX3(a,C1[2],C1[3]); \
      _Pragma("unroll") for(int r=4;r<16;r+=4){a=MX3(a,C0[r],C0[r+1]);b=MX3(b,C0[r+2],C0[r+3]);a=MX3(a,C1[r],C1[r+1]);b=MX3(b,C1[r+2],C1[r+3]);} \
      float rm=__builtin_fmaxf(a,b); { auto rr=__builtin_amdgcn_permlane32_swap(__float_as_uint(rm),__float_as_uint(rm),false,false); rm=__builtin_fmaxf(__uint_as_float(rr[0]),__uint_as_float(rr[1])); } \
      resc=false; \
      if(__builtin_expect(__any(rm>(float)THRL),0)){ const float dl=__builtin_fmaxf(rm,0.f); mhat+=dl; \
        _Pragma("unroll") for(int r=0;r<16;++r){C0[r]-=dl;C1[r]-=dl;} \
        _Pragma("unroll") for(int r=0;r<16;++r)negm[r]=-mhat; asm volatile("":"+v"(negm)); \
        const float f=__builtin_amdgcn_exp2f(-dl); l_reg*=f; if(hi==0)wsf[r32]=f; resc=true; } } \
    SBAR(); \
    GAPB(o[0]=__builtin_amdgcn_mfma_f32_32x32x16_bf16(PAF(0),VFR(0),o[0],0,0,0), C0,0); \
    GAPB(o[1]=__builtin_amdgcn_mfma_f32_32x32x16_bf16(PAF(0),VFR(4),o[1],0,0,0), C0,4); \
    KRD(GL,0); GAPB(o[0]=__builtin_amdgcn_mfma_f32_32x32x16_bf16(PAF(1),VFR(1),o[0],0,0,0), C0,8); \
    KRD(GL,1); GAPB(o[1]=__builtin_amdgcn_mfma_f32_32x32x16_bf16(PAF(1),VFR(5),o[1],0,0,0), C0,12); \
    KRD(GL,2); GAPB(o[0]=__builtin_amdgcn_mfma_f32_32x32x16_bf16(PAF(2),VFR(2),o[0],0,0,0), C1,0); \
    KRD(GL,3); GAPB(o[1]=__builtin_amdgcn_mfma_f32_32x32x16_bf16(PAF(2),VFR(6),o[1],0,0,0), C1,4); \
    GAPB(o[0]=__builtin_amdgcn_mfma_f32_32x32x16_bf16(PAF(3),VFR(3),o[0],0,0,0), C1,8); \
    GAPB(o[1]=__builtin_amdgcn_mfma_f32_32x32x16_bf16(PAF(3),VFR(7),o[1],0,0,0), C1,12); \
    }while(0)
  int t=1;
  #undef CMASK
  #define CMASK(P0,P1,t) do{}while(0)
  for(;t+5<NT;t+=2){
    STEP(pB0,pB1,pA0,pA1,t,true,true,true);     WAIT_BAR(2); RESC(); ROT();
    STEP(pA0,pA1,pB0,pB1,t+1,true,true,true);   WAIT_BAR(2); RESC(); ROT();
  }
  #undef CMASK
  #define CMASK(P0,P1,t) do{int jb_=(t)-(NT-4); if(jb_>=0)cmask(P0,P1,jb_,qrel,hi);}while(0)
  #define ENDW(tt) do{ if((tt)+3<NT){WAIT_BAR(2);} else if((tt)+2<NT){WAIT_BAR(1);} else {WAIT_BAR(0);} }while(0)
  for(;t+1<NT;t+=2){
    STEP(pB0,pB1,pA0,pA1,t,(t+3<NT),(t+1<NT),(t+1<NT));       ENDW(t);   RESC(); ROT();
    STEP(pA0,pA1,pB0,pB1,t+1,(t+4<NT),(t+2<NT),(t+2<NT));     ENDW(t+1); RESC(); ROT();
  }
  STEP(pB0,pB1,pA0,pA1,NT-1,false,false,false); RESC();
  { float sacc=pB0[0]+pB0[1]; _Pragma("unroll") for(int r=2;r<16;++r)sacc+=pB0[r]; _Pragma("unroll") for(int r=0;r<16;++r)sacc+=pB1[r]; l_reg+=sacc;
    pw0=(u32x4){PKW(pB0,0),PKW(pB0,2),PKW(pB0,4),PKW(pB0,6)};pw1=(u32x4){PKW(pB0,8),PKW(pB0,10),PKW(pB0,12),PKW(pB0,14)};pw2=(u32x4){PKW(pB1,0),PKW(pB1,2),PKW(pB1,4),PKW(pB1,6)};pw3=(u32x4){PKW(pB1,8),PKW(pB1,10),PKW(pB1,12),PKW(pB1,14)};
    int tl_=lane_id_v(); asm volatile("":"+v"(tl_)); const int ln_=tl_&63,hi_=ln_>>5; const int vb0e=(int)(lds0+LDS_V)+((ln_>>4)&1)*32+(ln_&3)*8+(4*hi_+((ln_&15)>>2))*64;
    SBAR(); pv(o,vb0e+sl_cur,PAF(0),PAF(1),PAF(2),PAF(3)); }
  #undef PKW
  #undef PAF
  #undef VFR
  #undef PIN
  #undef MX3
  #undef GAPA
  #undef GAPB
  #undef EX
  #undef VRD
  #undef KRD
  #undef STEP
  #undef ENDW
  {auto rr=__builtin_amdgcn_permlane32_swap(__float_as_uint(l_reg),__float_as_uint(l_reg),false,false);l_reg=__uint_as_float(rr[0])+__uint_as_float(rr[1]);}
  int te_=lane_id_v(); asm volatile("":"+v"(te_)); const int lane_e=te_&63,r32_e=lane_e&31,hi_e=lane_e>>5;
  if(hi_e==0)wsf[32+r32_e]=l_reg;asm volatile("s_waitcnt lgkmcnt(0)":::"memory");
  float rli[16];
  #pragma unroll
  for(int r=0;r<16;++r)rli[r]=__builtin_amdgcn_rcpf(wsf[32+crow(r,hi_e)]);
  bf16*Ow=O+(rowbase+q0+wid*QBLK)*DM+h*D;
  { bf16*stg=(bf16*)(shm+LDS_OST)+wid*2048;
    #pragma unroll
    for(int r=0;r<16;++r){const int orow=crow(r,hi_e);
      #pragma unroll
      for(int d0=0;d0<2;++d0)stg[orow*64+d0*32+r32_e]=__float2bfloat16(o[d0][r]*rli[r]);}
    asm volatile("s_waitcnt lgkmcnt(0)":::"memory");
    #pragma unroll
    for(int i=0;i<4;++i){const int row=i*8+(lane_e>>3),ch=lane_e&7; const u32x4 v=*(const u32x4*)(stg+row*64+ch*8); ATTN_STORE16(Ow+(long)row*DM+ch*8,v);} }
  asm volatile("s_waitcnt lgkmcnt(0)\n\ts_barrier":::"memory");
  #undef ADDC
  #undef DMA_K
  #undef DMA_V
  #undef CMASK
  #undef START
  #undef RESC
  #undef ROT
}
constexpr int ATTN_LDS_BYTES=LDS_BYTES;
struct AttnTensors { const bf16* Q; const bf16* K; const bf16* V; bf16* O; const float* CF; };
struct AttnUnit { int bh; int qb; };
struct StaticOrder {
  int vcu;
  __device__ __forceinline__ explicit StaticOrder(int grid,int block):vcu((block%8)*(grid/8)+block/8){}
  __device__ __forceinline__ bool next(int i,AttnUnit&u)const{ if(i>=2)return false; const int s=vcu&7; u.bh=vcu>>3; u.qb=(i==0)?s:15-s; return true; }
  __device__ __forceinline__ void a_ready(const AttnUnit&)const{}
  __device__ __forceinline__ void done(const AttnUnit&)const{}
};
template<class Sched,int THRL=8> __device__ __forceinline__ void attn_phase(char*lds,const AttnTensors&T,const Sched&S,int wave_id){
  AttnUnit u;
  for(int i=0;S.next(i,u);++i){ S.a_ready(u); attn_unit<THRL>(u.bh/NHEAD,u.bh%NHEAD,u.qb,T.Q,T.K,T.V,T.O,T.CF,lds,wave_id); S.done(u); }
}
#undef SBAR
#undef WAIT_BAR
}

struct Args { const float* in[16]; float* out; unsigned char* ws; };
__global__ void __launch_bounds__(NWAVES * 64, 2) hyb_fwd(Args args) {
    extern __shared__ __attribute__((aligned(16))) unsigned char lds[];
    Ctx F;
    F.lds = (LAS unsigned char*)lds;
    F.tid = threadIdx.x; F.lane = F.tid & 63; F.wave = __builtin_amdgcn_readfirstlane(F.tid >> 6);
    F.G = gridDim.x; F.gw = blockIdx.x * NWAVES + F.wave; F.NGW = F.G * NWAVES;
    F.out = args.out; F.ws = args.ws;
    volatile LAS unsigned* MISC = (volatile LAS unsigned*)(F.lds + MISC_OFF);
    for (int u = F.tid; u < (LDS_BYTES - LDSCTL_OFF) / 4; u += NWAVES * 64) ((LAS unsigned*)(F.lds + LDSCTL_OFF))[u] = 0u;
    __syncthreads();
    gu32* ctl = (gu32*)(F.ws + WS_CTL);
    XcdBarrier bar = xcd_barrier_post((unsigned*)(ctl + CW_BAR), MISC + 8); bar.w = F.wave;
#define FRESH(P) Ctx P = F; P.tid = (F.wave << 6) | lane_id_v(); asm volatile("" : "+v"(P.tid), "+s"(P.wave), "+s"(P.gw), "+s"(P.ws), "+s"(P.out)); P.lane = P.tid & 63
#define GRID_BAR() do { XcdBarrier b_ = bar; asm volatile("" : "+s"(b_.bar), "+s"(b_.x)); xcd_barrier(b_); } while (0)

    bf16* Wb = (bf16*)(F.ws + WS_W);
    bf16* Z = (bf16*)(F.ws + WS_Z); float* ZS = (float*)(F.ws + WS_ZS); bf16* HDN = (bf16*)(F.ws + WS_HDN);
    float* M32 = (float*)(F.ws + WS_HDN); bf16* HB = (bf16*)(F.ws + WS_Z);
    LAS unsigned char* ring = F.lds + RING_OFF;

    { FRESH(P); p0_prologue(P, args.in[2], args.in[9], args.in[10], args.in[11], args.in[12], args.in[14], args.in[15]); }
    GRID_BAR();

    #pragma unroll 1
    for (int layer = 0; layer < DEPTH; ++layer) {
        const float* xin = (layer == 0) ? args.in[0] : F.out;
        const bf16* L = Wb + (size_t)layer * LW_STRIDE;
        { FRESH(P); rmsnorm_phase(P, xin, args.in[1] + layer * DM, (bf16*)(P.ws + WS_HDN)); }
        GRID_BAR();
        { pg8::Gemm g{HDN, L + LW_IN, M, NIN, DM, DM, DM}; pg8::StaticOrder S; S.init(M, NIN, F.G, (int)blockIdx.x);
          pg8::EpiZ E{Z, ZS};
          pg8::gemm_phase<pg8::EpiZ, pg8::StaticOrder, true, true>(ring, g, S, E, F.wave); }
        GRID_BAR();
        { FRESH(P); post_phase(P, args.in[4] + layer * 64, args.in[5] + layer * 64, args.in[6] + layer * 64, args.in[7] + layer * 64, args.in[3] + layer * 8); }
        { FRESH(P); ret_state_mfma(P); }
        GRID_BAR();
        { FRESH(P); fscan_phase(P); }
        { FRESH(P); ret_scan(P); }
        GRID_BAR();
        { FRESH(P); ret_out_mfma(P, args.in[8] + layer * 512); }
        { static_assert(attn_body::ATTN_LDS_BYTES <= RING_BYTES, "attention scratch fits the ring region");
          unsigned char* wsl = F.ws; asm volatile("" : "+s"(wsl));
          bf16* Zl = (bf16*)(wsl + WS_Z);
          const attn_body::AttnTensors AT{(const attn_body::bf16*)(Zl + Z_FQ), (const attn_body::bf16*)(Zl + Z_FK), (const attn_body::bf16*)(Zl + Z_FV), (attn_body::bf16*)(Zl + Z_FQ), (const float*)(wsl + WS_CF)};
          const attn_body::StaticOrder S((int)F.G, (int)blockIdx.x);
          attn_body::attn_phase<attn_body::StaticOrder>((char*)lds + RING_OFF, AT, S, F.wave); }
        { FRESH(P); dsa_v3(P); }
        GRID_BAR();
        { pg8::StaticOrder S; S.init(M, DM, F.G, (int)blockIdx.x);
          { pg8::Gemm g{Z + Z_FQ, L + LW_MIX, M, DM, 512, ZP, 512}; pg8::EpiGate<0> E{Z + Z_ZG, M32, Z + Z_MRG};
            pg8::gemm_phase<pg8::EpiGate<0>, pg8::StaticOrder, false, true>(ring, g, S, E, F.wave); }
          { pg8::Gemm g{Z + Z_DQ, L + LW_MIX + 512 * 1024, M, DM, 512, ZP, 512}; pg8::EpiGate<1> E{Z + Z_ZG, M32, Z + Z_MRG};
            pg8::gemm_phase<pg8::EpiGate<1>, pg8::StaticOrder, false, true>(ring, g, S, E, F.wave); }
          { pg8::Gemm g{Z + Z_RV, L + LW_MIX + 1024 * 1024, M, DM, 512, ZP, 512}; pg8::EpiGate<2> E{Z + Z_ZG, M32, Z + Z_MRG};
            pg8::gemm_phase<pg8::EpiGate<2>, pg8::StaticOrder, false, true>(ring, g, S, E, F.wave); } }
        GRID_BAR();
        { pg8::Gemm g{Z + Z_MRG, L + LW_O, M, DM, DM, ZP, DM}; pg8::StaticOrder S; S.init(M, DM, F.G, (int)blockIdx.x);
          pg8::EpiRes E{xin, F.out};
          pg8::gemm_phase<pg8::EpiRes, pg8::StaticOrder, false, true>(ring, g, S, E, F.wave); }
        GRID_BAR();
        { FRESH(P); rmsnorm_phase(P, P.out, args.in[13] + layer * DM, (bf16*)(P.ws + WS_HDN)); }
        GRID_BAR();
        { pg8::Gemm g{HDN, L + LW_FI, M, FF2, DM, DM, DM}; pg8::StaticOrder S; S.init(M, FF2, F.G, (int)blockIdx.x);
          pg8::EpiSwi E{HB, FFH};
          pg8::gemm_phase<pg8::EpiSwi, pg8::StaticOrder, true, true>(ring, g, S, E, F.wave); }
        GRID_BAR();
        { pg8::Gemm g{HB, L + LW_FO, M, DM, FFH, FFH, FFH}; pg8::StaticOrder S; S.init(M, DM, F.G, (int)blockIdx.x);
          pg8::EpiRes E{F.out, F.out};
          pg8::gemm_phase<pg8::EpiRes, pg8::StaticOrder, false, true>(ring, g, S, E, F.wave); }
        GRID_BAR();
    }
    if (__hip_atomic_load((gu32*)((unsigned*)(ctl + CW_BAR) + XB_TMO), RLX_AGENT) != 0u) {
        const float q = __builtin_nanf("");
        for (int m = F.gw; m < M; m += F.NGW) { GAS f32x4* o = (GAS f32x4*)(F.out + (size_t)m * DM) + lane_id_v();
#pragma unroll
            for (int j = 0; j < 4; ++j) o[64 * j] = (f32x4){q, q, q, q}; }
    }
}

extern "C" void kernel_launch(void* const* d_in, const int* in_sizes, int n_in, void* d_out, int out_size, void* d_ws, size_t ws_size, hipStream_t stream) {
    static int grid = 0;
    if (grid == 0) {
        if (n_in != 16 || in_sizes[0] != M * DM || out_size != M * DM || ws_size < WS_END) { fprintf(stderr, "kernel_launch: unexpected shapes / workspace (n_in %d, in0 %d, out %d, ws %zu < %zu)\n", n_in, n_in > 0 ? in_sizes[0] : -1, out_size, ws_size, (size_t)WS_END); grid = -1; return; }
        int dev = 0, cus = 0, per_cu = 0;
        if (hipGetDevice(&dev) != hipSuccess || hipDeviceGetAttribute(&cus, hipDeviceAttributeMultiprocessorCount, dev) != hipSuccess) { grid = -1; return; }
        if (hipFuncSetAttribute((const void*)hyb_fwd, hipFuncAttributeMaxDynamicSharedMemorySize, LDS_BYTES) != hipSuccess) { fprintf(stderr, "kernel_launch: hipFuncSetAttribute failed\n"); grid = -1; return; }
        if (hipOccupancyMaxActiveBlocksPerMultiprocessor(&per_cu, (const void*)hyb_fwd, NWAVES * 64, LDS_BYTES) != hipSuccess || per_cu < 1) { fprintf(stderr, "kernel_launch: occupancy query reports %d blocks per CU\n", per_cu); }
        (void)hipGetLastError();
        grid = cus;
    }
    if (grid < 0) return;
    if (hipMemsetAsync((char*)d_ws + WS_CTL, 0, CTL_ZERO_BYTES, stream) != hipSuccess) return;
    Args a{};
    for (int i = 0; i < 16; ++i) a.in[i] = (const float*)d_in[i];
    a.out = (float*)d_out; a.ws = (unsigned char*)d_ws;
    hipLaunchKernelGGL(hyb_fwd, dim3(grid), dim3(NWAVES * 64), LDS_BYTES, stream, a);
}
```

```cpp
#include <hip/hip_runtime.h>
#include <cstdio>
#include <cstdint>
#include <cmath>
__device__ __forceinline__ int lane_id_v() { unsigned z; asm volatile("v_mov_b32 %0, 0" : "=v"(z)); return (int)__builtin_amdgcn_mbcnt_hi(~0u, __builtin_amdgcn_mbcnt_lo(~0u, z)); }
namespace pg8 {
#define PG8_LAS __attribute__((address_space(3)))
typedef unsigned short bf16_t;
typedef short bf16x8 __attribute__((ext_vector_type(8)));
typedef float f32x4 __attribute__((ext_vector_type(4)));
typedef unsigned u32x4 __attribute__((ext_vector_type(4)));
constexpr int BM = 256, BK = 64, HALF = 128, HTB = HALF * BK * 2  , STAGE_BYTES = 8 * HTB, NXCD = 8, WGM = 8;

__host__ __device__ __forceinline__ int lds_byte(int r, int c) { const int st = (r >> 4) * 2 + (c >> 5), rr = r & 15, cc = c & 31, ob = rr * 64 + cc * 2; return st * 1024 + (ob ^ (((ob >> 9) & 1) << 5)); }
__host__ __device__ __forceinline__ void stage_rc(int b, int& R, int& C) { const int st = b / 1024, sb = b % 1024, swz = sb ^ (((sb >> 9) & 1) << 5); R = (st >> 1) * 16 + swz / 64; C = (st & 1) * 32 + (swz % 64) / 2; }
__host__ __device__ __forceinline__ int perm32(int rho) { const int n = rho >> 4, i = rho & 15; return 8 * (i >> 2) + 4 * n + (i & 3); }

struct Unit { int pm, pn; };
struct Gemm { const bf16_t* A; const bf16_t* Bt; int M, N, K, lda, ldb; };

struct StaticOrder {
    int nM, nN, nwg, G, c;
    __host__ __device__ void init(int M, int N, int G_, int c_) { nM = M / BM; nN = N / BM; nwg = nM * nN; G = G_; c = c_; }
    __host__ __device__ bool next(int i, Unit& u) const {
        const long L = (long)i * G + c; if (L >= nwg) return false;
        int wgid = (int)L; { const int q = nwg / NXCD, r = nwg % NXCD, xcd = wgid % NXCD, off = wgid / NXCD; wgid = (xcd < r ? xcd * (q + 1) : r * (q + 1) + (xcd - r) * q) + off; }
        const int nig = WGM * nN, gid = wgid / nig, fm = gid * WGM, gsz = (nM - fm) < WGM ? (nM - fm) : WGM;
        u.pm = fm + ((wgid % nig) % gsz); u.pn = (wgid % nig) / gsz; return true;
    }
    __device__ __forceinline__ void a_ready(const Unit&) const {}
    __device__ __forceinline__ void done(const Unit&) const {}
};

__device__ __forceinline__ unsigned cvt_pk_bf16(float lo, float hi) { unsigned r; asm volatile("v_cvt_pk_bf16_f32 %0, %1, %2" : "=v"(r) : "v"(lo), "v"(hi)); return r; }
__device__ __forceinline__ float bflo(unsigned w) { return __builtin_bit_cast(float, w << 16); }
__device__ __forceinline__ float bfhi(unsigned w) { return __builtin_bit_cast(float, w & 0xffff0000u); }
__device__ __forceinline__ float sigmoidf_(float x) { return __builtin_amdgcn_rcpf(1.0f + __builtin_amdgcn_exp2f(-1.4426950408889634f * x)); }

constexpr int ZP = 6656;
constexpr int ZSP = 512;
constexpr int NZT = 26;

struct EpiZ {
    static constexpr bool PERM = true, AFTER_DRAIN = false;
    bf16_t* Z; float* ZS;
    __device__ __forceinline__ void operator()(const f32x4 (&acc)[2][2][4][2], const Unit& u, int wr, int wc, int fr, int fq) const {
        const int row0 = u.pm * BM + wr * 64 + fr;
        if (u.pn < NZT) {
            const int col0 = u.pn * BM + wc * 32 + 8 * fq;
#pragma unroll
            for (int ai = 0; ai < 2; ++ai)
#pragma unroll
                for (int m = 0; m < 4; ++m) { bf16_t* rowp = Z + (size_t)(row0 + ai * HALF + m * 16) * ZP + col0;
#pragma unroll
                    for (int bj = 0; bj < 2; ++bj) { const f32x4 v0 = acc[ai][bj][m][0], v1 = acc[ai][bj][m][1];
                        u32x4 w; w.x = cvt_pk_bf16(v0[0], v0[1]); w.y = cvt_pk_bf16(v0[2], v0[3]); w.z = cvt_pk_bf16(v1[0], v1[1]); w.w = cvt_pk_bf16(v1[2], v1[3]);
                        *(u32x4*)(rowp + bj * HALF) = w; } }
        } else {
            const int col0 = (u.pn - NZT) * BM + wc * 32 + 8 * fq;
#pragma unroll
            for (int ai = 0; ai < 2; ++ai)
#pragma unroll
                for (int m = 0; m < 4; ++m) { float* rowp = ZS + (size_t)(row0 + ai * HALF + m * 16) * ZSP + col0;
#pragma unroll
                    for (int bj = 0; bj < 2; ++bj) { *(f32x4*)(rowp + bj * HALF) = acc[ai][bj][m][0]; *(f32x4*)(rowp + bj * HALF + 4) = acc[ai][bj][m][1]; } }
        }
    }
};

template <int P> struct EpiGate {
    static constexpr bool PERM = true, AFTER_DRAIN = false;
    const bf16_t* G;
    float* M32;
    bf16_t* OUT;
    __device__ __forceinline__ void operator()(const f32x4 (&acc)[2][2][4][2], const Unit& u, int wr, int wc, int fr, int fq) const {
        const int row0 = u.pm * BM + wr * 64 + fr, col0 = u.pn * BM + wc * 32 + 8 * fq;
#pragma unroll
        for (int ai = 0; ai < 2; ++ai)
#pragma unroll
            for (int m = 0; m < 4; ++m) { const size_t row = (size_t)(row0 + ai * HALF + m * 16);
#pragma unroll
                for (int bj = 0; bj < 2; ++bj) { const int col = col0 + bj * HALF;
                    const u32x4 gw = *(const u32x4*)(G + row * ZP + P * 1024 + col);
                    const f32x4 v0 = acc[ai][bj][m][0], v1 = acc[ai][bj][m][1];
                    f32x4 t0, t1;
                    t0[0] = sigmoidf_(bflo(gw.x)) * v0[0]; t0[1] = sigmoidf_(bfhi(gw.x)) * v0[1]; t0[2] = sigmoidf_(bflo(gw.y)) * v0[2]; t0[3] = sigmoidf_(bfhi(gw.y)) * v0[3];
                    t1[0] = sigmoidf_(bflo(gw.z)) * v1[0]; t1[1] = sigmoidf_(bfhi(gw.z)) * v1[1]; t1[2] = sigmoidf_(bflo(gw.w)) * v1[2]; t1[3] = sigmoidf_(bfhi(gw.w)) * v1[3];
                    float* mp = M32 + row * 1024 + col;
                    if (P == 0) { *(f32x4*)mp = t0; *(f32x4*)(mp + 4) = t1; }
                    else if (P == 1) { *(f32x4*)mp = *(const f32x4*)mp + t0; *(f32x4*)(mp + 4) = *(const f32x4*)(mp + 4) + t1; }
                    else { t0 = *(const f32x4*)mp + t0; t1 = *(const f32x4*)(mp + 4) + t1;
                        u32x4 w; w.x = cvt_pk_bf16(t0[0], t0[1]); w.y = cvt_pk_bf16(t0[2], t0[3]); w.z = cvt_pk_bf16(t1[0], t1[1]); w.w = cvt_pk_bf16(t1[2], t1[3]);
                        *(u32x4*)(OUT + row * ZP + col) = w; } } }
    }
};

struct EpiRes {
    static constexpr bool PERM = true, AFTER_DRAIN = false;
    const float* RES; float* OUT;
    __device__ __forceinline__ void operator()(const f32x4 (&acc)[2][2][4][2], const Unit& u, int wr, int wc, int fr, int fq) const {
        const int row0 = u.pm * BM + wr * 64 + fr, col0 = u.pn * BM + wc * 32 + 8 * fq;
#pragma unroll
        for (int ai = 0; ai < 2; ++ai)
#pragma unroll
            for (int m = 0; m < 4; ++m) { const size_t off = (size_t)(row0 + ai * HALF + m * 16) * 1024 + col0;
#pragma unroll
                for (int bj = 0; bj < 2; ++bj) { const float* rp = RES + off + bj * HALF; float* op = OUT + off + bj * HALF;
                    const f32x4 r0 = *(const f32x4*)rp, r1 = *(const f32x4*)(rp + 4);
                    *(f32x4*)op = r0 + acc[ai][bj][m][0]; *(f32x4*)(op + 4) = r1 + acc[ai][bj][m][1]; } }
    }
};

struct EpiSwi {
    static constexpr bool PERM = true, AFTER_DRAIN = false;
    bf16_t* H; int ldh;
    __device__ __forceinline__ void operator()(const f32x4 (&acc)[2][2][4][2], const Unit& u, int wr, int wc, int fr, int fq) const {
        const int row0 = u.pm * BM + wr * 64 + fr, col0 = u.pn * HALF + wc * 32 + 8 * fq;
#pragma unroll
        for (int ai = 0; ai < 2; ++ai)
#pragma unroll
            for (int m = 0; m < 4; ++m) { bf16_t* hp = H + (size_t)(row0 + ai * HALF + m * 16) * ldh + col0;
                float o[8];
#pragma unroll
                for (int n = 0; n < 2; ++n)
#pragma unroll
                    for (int i = 0; i < 4; ++i) { const float g = acc[ai][0][m][n][i], up = acc[ai][1][m][n][i]; o[4 * n + i] = g * sigmoidf_(g) * up; }
                u32x4 w; w.x = cvt_pk_bf16(o[0], o[1]); w.y = cvt_pk_bf16(o[2], o[3]); w.z = cvt_pk_bf16(o[4], o[5]); w.w = cvt_pk_bf16(o[6], o[7]);
                *(u32x4*)hp = w; }
    }
};

template <class Epi, class Sched, bool ALIGN_EPI = false, bool SP2 = false>
__device__ __forceinline__ void gemm_phase(PG8_LAS unsigned char* lds, Gemm g, const Sched& S0, const Epi& E, int wave_id) {
    int ovz, osz; asm volatile("v_mov_b32 %0, 0\n\ts_mov_b32 %1, 0" : "=v"(ovz), "=s"(osz));
    Sched S = S0; S.c += osz; g.lda += osz; g.ldb += osz;
    const int tid = ((wave_id << 6) | lane_id_v()) + ovz,
         wid = __builtin_amdgcn_readfirstlane(tid >> 6), lane = tid & 63, wr = wid >> 2, wc = wid & 3, fr = lane & 15, fq = lane >> 4;
    const int K = g.K, nt = K / BK;
    unsigned voffA[2], voffB[2];
#pragma unroll
    for (int i = 0; i < 2; ++i) { int R, C; stage_rc(tid * 16 + i * 8192, R, C); const int Rb = Epi::PERM ? ((R & ~31) + perm32(R & 31)) : R;
        voffA[i] = (unsigned)(R * g.lda + C) * 2u; voffB[i] = (unsigned)(Rb * g.ldb + C) * 2u; }
    const size_t kstep = (size_t)(BK * 2);
    const size_t hstepA = (size_t)HALF * g.lda * 2, hstepB = (size_t)HALF * g.ldb * 2;
    const size_t tstepA = 2 * hstepA, tstepB = 2 * hstepB;
    const unsigned ldsw = (unsigned)wid * 1024u;
    const int aoff = lds_byte(wr * 64 + fr, fq * 8), boff = lds_byte(wc * 32 + fr, fq * 8);
#define PG8_SA(b, h) (((b) * 2 + (h)) * HTB)
#define PG8_SB(b, h) ((4 + (b) * 2 + (h)) * HTB)
#define PG8_STAGE(bufoff, gbase, voff) do { _Pragma("unroll") for (int _i = 0; _i < 2; ++_i) \
        __builtin_amdgcn_global_load_lds((const unsigned*)((const char*)(gbase) + (voff)[_i]), (PG8_LAS unsigned*)(lds + (bufoff) + ldsw + _i * 8192), 16, 0, 0); } while (0)
#define PG8_LDA(dst, b, h) do { _Pragma("unroll") for (int m = 0; m < 4; ++m) _Pragma("unroll") for (int k = 0; k < 2; ++k) dst[m][k] = *(const PG8_LAS bf16x8*)(lds + PG8_SA(b, h) + aoff + m * 2048 + k * 1024); } while (0)
#define PG8_LDB(dst, b, h) do { _Pragma("unroll") for (int n = 0; n < 2; ++n) _Pragma("unroll") for (int k = 0; k < 2; ++k) dst[n][k] = *(const PG8_LAS bf16x8*)(lds + PG8_SB(b, h) + boff + n * 2048 + k * 1024); } while (0)
#define PG8_MMA(ai, bj, At, Bt) do { __builtin_amdgcn_s_setprio(1); _Pragma("unroll") for (int m = 0; m < 4; ++m) _Pragma("unroll") for (int n = 0; n < 2; ++n) _Pragma("unroll") for (int k = 0; k < 2; ++k) \
        acc[ai][bj][m][n] = __builtin_amdgcn_mfma_f32_16x16x32_bf16(Bt[n][k], At[m][k], acc[ai][bj][m][n], 0, 0, 0); __builtin_amdgcn_s_setprio(0); } while (0)
#define PG8_WAIT_V(n) asm volatile("s_waitcnt vmcnt(" #n ")" ::: "memory")
#define PG8_WAIT_L(n) asm volatile("s_waitcnt lgkmcnt(" #n ")" ::: "memory")
#define PG8_BAR __builtin_amdgcn_s_barrier()
#define PG8_SCHED __builtin_amdgcn_sched_barrier(0)
    Unit cur, nxt; int ui = 0;
    if (!S.next(0, cur)) return;
    f32x4 acc[2][2][4][2];
#pragma unroll
    for (int a = 0; a < 2; ++a)
#pragma unroll
        for (int b = 0; b < 2; ++b)
#pragma unroll
            for (int m = 0; m < 4; ++m)
#pragma unroll
                for (int n = 0; n < 2; ++n) acc[a][b][m][n] = (f32x4){0.f, 0.f, 0.f, 0.f};
    bf16x8 At[4][2], B0[2][2], B1[2][2];
    const char* cA = (const char*)g.A + (size_t)cur.pm * tstepA; const char* cB = (const char*)g.Bt + (size_t)cur.pn * tstepB;
    S.a_ready(cur);
    if constexpr (SP2) {
        PG8_STAGE(PG8_SB(0, 0), cB, voffB); PG8_STAGE(PG8_SB(0, 1), cB + hstepB, voffB); PG8_STAGE(PG8_SA(0, 0), cA, voffA); PG8_STAGE(PG8_SA(0, 1), cA + hstepA, voffA);
        if (wr == 1) PG8_BAR;
        PG8_WAIT_V(2); PG8_BAR;
        PG8_STAGE(PG8_SB(1, 0), cB + kstep, voffB); PG8_STAGE(PG8_SA(1, 0), cA + kstep, voffA); PG8_STAGE(PG8_SB(1, 1), cB + hstepB + kstep, voffB);
        PG8_WAIT_V(6); PG8_BAR;
    } else {
        PG8_STAGE(PG8_SB(0, 0), cB, voffB); PG8_STAGE(PG8_SA(0, 0), cA, voffA); PG8_STAGE(PG8_SB(0, 1), cB + hstepB, voffB); PG8_STAGE(PG8_SA(0, 1), cA + hstepA, voffA);
        if (wr == 1) PG8_BAR;
        PG8_WAIT_V(4); PG8_BAR;
        PG8_STAGE(PG8_SB(1, 0), cB + kstep, voffB); PG8_STAGE(PG8_SA(1, 0), cA + kstep, voffA); PG8_STAGE(PG8_SB(1, 1), cB + hstepB + kstep, voffB);
        PG8_WAIT_V(6); PG8_BAR;
    }
    for (;;) {
        const bool has_next = S.next(ui + 1, nxt);
        const char* nA = has_next ? (const char*)g.A + (size_t)nxt.pm * tstepA : cA; const char* nB = has_next ? (const char*)g.Bt + (size_t)nxt.pn * tstepB : cB;
        for (int t = 0; t < nt; t += 2) {
            const bool last = (t == nt - 2);
            const char* a1 = cA + (size_t)(t + 1) * kstep;
            const char* a2 = last ? nA : cA + (size_t)(t + 2) * kstep; const char* b2 = last ? nB : cB + (size_t)(t + 2) * kstep;
            const char* a3 = a2 + kstep; const char* b3 = b2 + kstep;
            if (last && has_next) S.a_ready(nxt);
            if constexpr (SP2) {
            PG8_LDB(B0, 0, 0); PG8_LDB(B1, 0, 1); PG8_SCHED; PG8_LDA(At, 0, 0); PG8_STAGE(PG8_SA(1, 1), a1 + hstepA, voffA);
            PG8_WAIT_V(8); PG8_WAIT_L(0); PG8_BAR; PG8_MMA(0, 0, At, B0); PG8_MMA(0, 1, At, B1); PG8_BAR; PG8_SCHED;
            PG8_LDA(At, 0, 1); PG8_STAGE(PG8_SB(0, 0), b2, voffB); PG8_STAGE(PG8_SB(0, 1), b2 + hstepB, voffB); PG8_STAGE(PG8_SA(0, 0), a2, voffA);
            PG8_WAIT_V(8); PG8_WAIT_L(0); PG8_BAR; PG8_MMA(1, 0, At, B0); PG8_MMA(1, 1, At, B1); PG8_BAR; PG8_SCHED;
            PG8_LDB(B0, 1, 0); PG8_LDB(B1, 1, 1); PG8_SCHED; PG8_LDA(At, 1, 0); PG8_STAGE(PG8_SA(0, 1), a2 + hstepA, voffA);
            PG8_WAIT_V(8); PG8_WAIT_L(0); PG8_BAR; PG8_MMA(0, 0, At, B0); PG8_MMA(0, 1, At, B1); PG8_BAR; PG8_SCHED;
            PG8_LDA(At, 1, 1); PG8_STAGE(PG8_SB(1, 0), b3, voffB); PG8_STAGE(PG8_SB(1, 1), b3 + hstepB, voffB); PG8_STAGE(PG8_SA(1, 0), a3, voffA);
            PG8_WAIT_V(8); PG8_WAIT_L(0); PG8_BAR; PG8_MMA(1, 0, At, B0); PG8_MMA(1, 1, At, B1); PG8_BAR; PG8_SCHED;
            } else {
            PG8_LDB(B0, 0, 0); PG8_SCHED; PG8_LDA(At, 0, 0); PG8_STAGE(PG8_SA(1, 1), a1 + hstepA, voffA);
            PG8_WAIT_L(8); PG8_BAR; PG8_WAIT_L(0); PG8_MMA(0, 0, At, B0); PG8_BAR; PG8_SCHED;
            PG8_LDB(B1, 0, 1); PG8_STAGE(PG8_SB(0, 0), b2, voffB);
            PG8_BAR; PG8_WAIT_L(0); PG8_MMA(0, 1, At, B1); PG8_BAR;
            PG8_LDA(At, 0, 1); PG8_STAGE(PG8_SA(0, 0), a2, voffA);
            PG8_BAR; PG8_WAIT_L(0); PG8_MMA(1, 0, At, B0); PG8_BAR; PG8_SCHED;
            PG8_STAGE(PG8_SB(0, 1), b2 + hstepB, voffB);
            PG8_WAIT_V(6); PG8_BAR; PG8_MMA(1, 1, At, B1); PG8_BAR;
            PG8_LDB(B0, 1, 0); PG8_SCHED; PG8_LDA(At, 1, 0); PG8_STAGE(PG8_SA(0, 1), a2 + hstepA, voffA);
            PG8_WAIT_L(8); PG8_BAR; PG8_WAIT_L(0); PG8_MMA(0, 0, At, B0); PG8_BAR; PG8_SCHED;
            PG8_LDB(B1, 1, 1); PG8_STAGE(PG8_SB(1, 0), b3, voffB);
            PG8_BAR; PG8_WAIT_L(0); PG8_MMA(0, 1, At, B1); PG8_BAR;
            PG8_LDA(At, 1, 1); PG8_STAGE(PG8_SA(1, 0), a3, voffA);
            PG8_BAR; PG8_WAIT_L(0); PG8_MMA(1, 0, At, B0); PG8_BAR; PG8_SCHED;
            PG8_STAGE(PG8_SB(1, 1), b3 + hstepB, voffB);
            PG8_WAIT_V(6); PG8_BAR; PG8_MMA(1, 1, At, B1); PG8_BAR;
            }
        }
        if constexpr (ALIGN_EPI) { if (wr == 0) PG8_BAR; }
        if constexpr (!Epi::AFTER_DRAIN) { E(acc, cur, wr, wc, fr, fq); S.done(cur); }
        if (!has_next) break;
#pragma unroll
        for (int a = 0; a < 2; ++a)
#pragma unroll
            for (int b = 0; b < 2; ++b)
#pragma unroll
                for (int m = 0; m < 4; ++m)
#pragma unroll
                    for (int n = 0; n < 2; ++n) acc[a][b][m][n] = (f32x4){0.f, 0.f, 0.f, 0.f};
        cur = nxt; cA = nA; cB = nB; ++ui;
        if constexpr (ALIGN_EPI) { if (wr == 1) PG8_BAR; }
    }
    PG8_WAIT_V(0);
    if constexpr (!ALIGN_EPI) { if (wr == 0) PG8_BAR; }
    PG8_BAR;
    if constexpr (Epi::AFTER_DRAIN) { E.fused(acc, cur, wr, wc, fr, fq, lds, wid, lane); S.done(cur); }
#undef PG8_SA
#undef PG8_SB
#undef PG8_STAGE
#undef PG8_LDA
#undef PG8_LDB
#undef PG8_MMA
#undef PG8_WAIT_V
#undef PG8_WAIT_L
#undef PG8_BAR
#undef PG8_SCHED
}
}

constexpr int NB = 4, SEQ = 4096, DM = 1024, DEPTH = 4, M = NB * SEQ;
constexpr int INC = 7088;
constexpr int NIN = 7168;
constexpr int FFH = 2816, FF2 = 5632;
constexpr int ZP = pg8::ZP, ZSP = pg8::ZSP;
constexpr int Z_FQ = 0, Z_FK = 512, Z_FV = 1024, Z_DQ = 1536, Z_RV = 2048, Z_RQ = 2560, Z_RK = 2816, Z_RG = 3072, Z_ZG = 3584, Z_MRG = 2560;
constexpr int S_IQ = 0, S_DK = 256, S_DV = 320, S_IK = 384, S_IW = 416, S_FF = 424;
constexpr float NORM_EPS = 1e-6f;
constexpr float LOG2E = 1.4426950408889634f;
constexpr float C2 = 0.125f * 1.4426950408889634f;

constexpr size_t MiB = 1u << 20;
constexpr size_t WS_CTL = 0, CTL_ZERO_BYTES = 1 * MiB;
constexpr size_t WS_ROPE64 = 1 * MiB;
constexpr size_t WS_ROPE32 = 2 * MiB;
constexpr size_t WS_LF = 2 * MiB + 512 * 1024;
constexpr size_t WS_CF = 3 * MiB;
constexpr size_t WS_ISG = 3 * MiB + 512 * 1024;
constexpr size_t WS_KD = 4 * MiB;
constexpr size_t WS_VD = 6 * MiB;
constexpr size_t WS_W = 8 * MiB;
constexpr size_t LW_IN = 0, LW_MIX = (size_t)NIN * 1024, LW_O = LW_MIX + 1536 * 1024, LW_FI = LW_O + 1024 * 1024, LW_FO = LW_FI + (size_t)FF2 * 1024, LW_STRIDE = LW_FO + (size_t)FFH * 1024;
constexpr size_t WS_Z = 150 * MiB;
constexpr size_t WS_HDN = 358 * MiB;
constexpr size_t WS_ZS = 390 * MiB;
constexpr size_t WS_IQB = 422 * MiB;
constexpr size_t WS_IKB = 430 * MiB;
constexpr size_t WS_END = 431 * MiB;
static_assert(WS_W + DEPTH * LW_STRIDE * 2 <= WS_Z && WS_Z + (size_t)M * ZP * 2 <= WS_HDN && WS_HDN + (size_t)M * 1024 * 2 == WS_ZS && WS_ZS + (size_t)M * ZSP * 4 == WS_IQB, "d_ws map");
constexpr int CW_BAR = 4096;

constexpr int RING_OFF = 0, RING_BYTES = 133120;
constexpr int LDSCTL_OFF = RING_BYTES, MISC_OFF = LDSCTL_OFF + 320;
constexpr int XTRA_OFF = RING_BYTES + 1024;
constexpr int LDS_BYTES = 147456;
constexpr int NWAVES = 8;
#define GAS __attribute__((address_space(1)))
#define LAS __attribute__((address_space(3)))
typedef unsigned short bf16;
typedef unsigned v4u __attribute__((ext_vector_type(4)));
typedef float f32x4 __attribute__((ext_vector_type(4)));
typedef short bf16x8 __attribute__((ext_vector_type(8)));
typedef GAS unsigned gu32;
typedef GAS unsigned long long gu64;
#define RLX_AGENT __ATOMIC_RELAXED, __HIP_MEMORY_SCOPE_AGENT
#define LDS_WAIT() asm volatile("s_waitcnt lgkmcnt(0)" ::: "memory")
#define VM_WAIT() asm volatile("s_waitcnt vmcnt(0)" ::: "memory")
__device__ __forceinline__ unsigned long long rt() { return __builtin_amdgcn_s_memrealtime(); }
__device__ __forceinline__ unsigned f2bf(float f) { unsigned u = __builtin_bit_cast(unsigned, f); return (u + 0x7fffu + ((u >> 16) & 1u)) >> 16; }
__device__ __forceinline__ unsigned pk2(float lo, float hi) { return f2bf(lo) | (f2bf(hi) << 16); }

#define XB_TMO      128
#define XB_XCNT(j)  (256  + 64 * (j))
#define XB_XSUB(j)  (1280 + 64 * (j))
#define XB_XGEN(j)  (2304 + 64 * (j))
#define XB_TOP      3328
#define XB_TOPGEN   3392
#define XCD_BAR_WORDS 3456
#define XB_SPIN_CAP (1u << 22)

__device__ __forceinline__ unsigned xb_ld(unsigned* p)              { return __hip_atomic_load(p, __ATOMIC_RELAXED, __HIP_MEMORY_SCOPE_AGENT); }
__device__ __forceinline__ unsigned xb_add(unsigned* p, unsigned v) { return __hip_atomic_fetch_add(p, v, __ATOMIC_RELAXED, __HIP_MEMORY_SCOPE_AGENT); }
__device__ __forceinline__ unsigned xb_xcc_id() { return (unsigned)__builtin_amdgcn_s_getreg((3 << 11) | 20) & 0xFu; }
#define XB_SPIN(cond, bar) do { unsigned _sp = 0; while (cond) { __builtin_amdgcn_s_sleep(1); \
    if ((++_sp & 255u) == 0u) { if (xb_ld(&(bar)[XB_TMO])) break; if (_sp > XB_SPIN_CAP) { atomicAdd(&(bar)[XB_TMO], 1u); break; } } } } while (0)

struct XcdBarrier {
    unsigned* bar; unsigned x; int w;
    volatile LAS unsigned* st;
};

__device__ __forceinline__ XcdBarrier xcd_barrier_post(unsigned* bar, volatile LAS unsigned* st) {
    XcdBarrier b; b.bar = bar; b.x = xb_xcc_id(); b.st = st; b.w = 0;
    if (threadIdx.x == 0) (void)xb_add(&bar[XB_XCNT(b.x)], 1u);
    return b;
}
__device__ __forceinline__ void xcd_barrier_complete(unsigned* bar, unsigned x, unsigned& nloc, unsigned& nx) {
    const unsigned G = gridDim.x * gridDim.y * gridDim.z;
    unsigned sum, cnt, mine, sp = 0u;
    for (;;) {
        sum = 0u; cnt = 0u; mine = 0u;
#pragma unroll
        for (unsigned j = 0; j < 16; ++j) { const unsigned c = xb_ld(&bar[XB_XCNT(j)]); sum += c; cnt += (c > 0u) ? 1u : 0u; mine = (j == x) ? c : mine; }
        if (sum == G) break;
        __builtin_amdgcn_s_sleep(1);
        if ((++sp & 255u) == 0u) { if (xb_ld(&bar[XB_TMO])) break; if (sp > XB_SPIN_CAP) { atomicAdd(&bar[XB_TMO], 1u); break; } }
    }
    nloc = mine > 0u ? mine : 1u; nx = cnt > 0u ? cnt : 1u;
}

__device__ __forceinline__ void xcd_barrier(const XcdBarrier& b) {
    asm volatile("s_waitcnt vmcnt(0)" ::: "memory");
    __syncthreads();
    if (b.w == 0 && lane_id_v() == 0) {
        unsigned* bar = b.bar;
        __builtin_amdgcn_s_waitcnt(0);
        unsigned nloc = b.st[0], nx = b.st[1];
        if (nloc == 0u) { xcd_barrier_complete(bar, b.x, nloc, nx); b.st[0] = nloc; b.st[1] = nx; }
        const unsigned old = xb_add(&bar[XB_XSUB(b.x)], 1u);
        const unsigned gen = old / nloc;
        if (old + 1u == (gen + 1u) * nloc) {
            __builtin_amdgcn_fence(__ATOMIC_RELEASE, "agent");
            asm volatile("s_waitcnt vmcnt(0)" ::: "memory");
            const unsigned og = xb_add(&bar[XB_TOP], 1u);
            const unsigned tg = og / nx;
            if (og + 1u == (tg + 1u) * nx) xb_add(&bar[XB_TOPGEN], 1u);
            else XB_SPIN(xb_ld(&bar[XB_TOPGEN]) == tg, bar);
            __builtin_amdgcn_fence(__ATOMIC_ACQUIRE, "agent");
            xb_add(&bar[XB_XGEN(b.x)], 1u);
            asm volatile("s_waitcnt vmcnt(0)" ::: "memory");
        } else {
            XB_SPIN(xb_ld(&bar[XB_XGEN(b.x)]) == gen, bar);
            __builtin_amdgcn_fence(__ATOMIC_ACQUIRE, "agent");
            asm volatile("s_waitcnt vmcnt(0)" ::: "memory");
        }
    }
    __syncthreads();
}

typedef float f32x2 __attribute__((ext_vector_type(2)));
typedef unsigned u32x2 __attribute__((ext_vector_type(2)));
__device__ __forceinline__ float bflo(unsigned w) { return __builtin_bit_cast(float, w << 16); }
__device__ __forceinline__ float bfhi(unsigned w) { return __builtin_bit_cast(float, w & 0xffff0000u); }
__device__ __forceinline__ float bf2f(bf16 v) { return __builtin_bit_cast(float, (unsigned)v << 16); }
__device__ __forceinline__ void unpack8(const v4u w, float (&f)[8]) { f[0] = bflo(w.x); f[1] = bfhi(w.x); f[2] = bflo(w.y); f[3] = bfhi(w.y); f[4] = bflo(w.z); f[5] = bfhi(w.z); f[6] = bflo(w.w); f[7] = bfhi(w.w); }
__device__ __forceinline__ v4u pack8(const float (&f)[8]) { v4u w; w.x = pk2(f[0], f[1]); w.y = pk2(f[2], f[3]); w.z = pk2(f[4], f[5]); w.w = pk2(f[6], f[7]); return w; }
template <int MASK> __device__ __forceinline__ float sx(float v) { static_assert(MASK < 32, "swizzle xor mask"); return __builtin_bit_cast(float, __builtin_amdgcn_ds_swizzle(__builtin_bit_cast(int, v), 0x1F | (MASK << 10))); }
template <int MASK> __device__ __forceinline__ unsigned sxu(unsigned v) { return (unsigned)__builtin_amdgcn_ds_swizzle((int)v, 0x1F | (MASK << 10)); }
__device__ __forceinline__ void swap32(unsigned x, unsigned& lo_view, unsigned& hi_view) {
    unsigned a = x, b = x; asm volatile("" : "+v"(b));
    const auto rr = __builtin_amdgcn_permlane32_swap(a, b, false, false);
    lo_view = rr[0]; hi_view = rr[1];
}
__device__ __forceinline__ float wave_sum(float v) {
    v += sx<1>(v); v += sx<2>(v); v += sx<4>(v); v += sx<8>(v); v += sx<16>(v);
    return __builtin_bit_cast(float, __builtin_amdgcn_readlane(__builtin_bit_cast(int, v), 0)) + __builtin_bit_cast(float, __builtin_amdgcn_readlane(__builtin_bit_cast(int, v), 32));
}
__device__ __forceinline__ float wave_max(float v) {
    v = fmaxf(v, sx<1>(v)); v = fmaxf(v, sx<2>(v)); v = fmaxf(v, sx<4>(v)); v = fmaxf(v, sx<8>(v)); v = fmaxf(v, sx<16>(v));
    return fmaxf(__builtin_bit_cast(float, __builtin_amdgcn_readlane(__builtin_bit_cast(int, v), 0)), __builtin_bit_cast(float, __builtin_amdgcn_readlane(__builtin_bit_cast(int, v), 32)));
}
__device__ __forceinline__ float half_sum(float v) {
    unsigned a, b; swap32(__builtin_bit_cast(unsigned, v), a, b); return __builtin_bit_cast(float, a) + __builtin_bit_cast(float, b);
}
__device__ __forceinline__ float half_max(float v) {
    unsigned a, b; swap32(__builtin_bit_cast(unsigned, v), a, b); return fmaxf(__builtin_bit_cast(float, a), __builtin_bit_cast(float, b));
}
__device__ __forceinline__ float xor32(float v, int lane) {
    return __builtin_bit_cast(float, __builtin_amdgcn_ds_bpermute((lane ^ 32) << 2, __builtin_bit_cast(int, v)));
}
__device__ __forceinline__ float sigmoid_f(float x) { return 1.0f / (1.0f + __expf(-x)); }

struct Ctx {
    LAS unsigned char* lds;
    int tid, lane, wave, G, gw, NGW;
    float* out; unsigned char* ws;
};

__device__ __forceinline__ void conv_item(const float* W, int N, int sc, int nv, int k0, bf16* WT, int ldw, int dr, LAS float* scr, int lane) {
    const int n_ = lane & 31;
#pragma unroll 8
    for (int i = 0; i < 32; ++i) { const int kk = 2 * i + (lane >> 5); scr[kk * 33 + n_] = (n_ < nv) ? W[(size_t)(k0 + kk) * N + sc + n_] : 0.f; }
    LDS_WAIT(); asm volatile("" ::: "memory");
    const int c = lane & 7;
#pragma unroll
    for (int j = 0; j < 4; ++j) { const int n = (lane >> 3) + 8 * j; const LAS float* s = scr + (8 * c) * 33 + n;
        v4u o; o.x = pk2(s[0 * 33], s[1 * 33]); o.y = pk2(s[2 * 33], s[3 * 33]); o.z = pk2(s[4 * 33], s[5 * 33]); o.w = pk2(s[6 * 33], s[7 * 33]);
        if (n < nv) *(GAS v4u*)(WT + (size_t)(dr + n) * ldw + k0 + 8 * c) = o; }
    LDS_WAIT(); asm volatile("" ::: "memory");
}
__device__ const int SEG_IN[15][3] = {
    {0, 0, 512}, {512, 512, 512}, {1024, 1024, 512}, {1536, 6656 + S_FF, 8}, {1544, Z_DQ, 512}, {2056, 6656 + S_DK, 64}, {2120, 6656 + S_DV, 64},
    {2184, 6656 + S_IQ, 256}, {2440, 6656 + S_IK, 32}, {2472, 6656 + S_IW, 8}, {2480, Z_RQ, 256}, {2736, Z_RK, 256}, {2992, Z_RV, 512}, {3504, Z_RG, 512}, {4016, Z_ZG, 3072}};
constexpr int IN_BLK = 223;
constexpr int IT_IN = 16 * IN_BLK, IT_MIX = 8 * 32, IT_O = 16 * 32, IT_FI = 16 * (FF2 / 32), IT_FO = (FFH / 64) * 32;
constexpr int IT_LAYER = IT_IN + 3 * IT_MIX + IT_O + IT_FI + IT_FO;

__device__ __forceinline__ void sincos_acc(float ang, float& c, float& s) {
    const double a = (double)ang;
    const double k = __builtin_rint(a * 0.6366197723675814);
    double y = a - k * 1.5707963267948966; y -= k * 6.123233995736766e-17;
    const double y2 = y * y;
    double sp = -7.647163731819816e-13; sp = sp * y2 + 1.6059043836821613e-10; sp = sp * y2 - 2.505210838544172e-08; sp = sp * y2 + 2.7557319223985893e-06; sp = sp * y2 - 1.984126984126984e-04; sp = sp * y2 + 8.333333333333333e-03; sp = sp * y2 - 1.6666666666666666e-01;
    const double sn = y + y * y2 * sp;
    double cp = 4.779477332387385e-14; cp = cp * y2 - 1.1470745597729725e-11; cp = cp * y2 + 2.08767569878681e-09; cp = cp * y2 - 2.755731922398589e-07; cp = cp * y2 + 2.48015873015873e-05; cp = cp * y2 - 1.388888888888889e-03; cp = cp * y2 + 4.1666666666666664e-02; cp = cp * y2 - 0.5;
    const double cs = 1.0 + y2 * cp;
    const int q = ((int)k) & 3;
    const double ss = (q & 1) ? cs : sn, cc = (q & 1) ? sn : cs;
    s = (float)((q & 2) ? -ss : ss);
    c = (float)(((q + 1) & 2) ? -cc : cc);
}

__device__ __forceinline__ void p0_prologue(const Ctx& F, const float* w_in, const float* w_fox, const float* w_dsa, const float* w_ret, const float* w_o, const float* w_fi, const float* w_fo) {
    LAS float* scr = (LAS float*)(F.lds + RING_OFF + F.wave * 16384);
    bf16* Wb = (bf16*)(F.ws + WS_W);
    for (int it = F.gw; it < DEPTH * IT_LAYER; it += F.NGW) {
        const int l = it / IT_LAYER; int r = it % IT_LAYER;
        bf16* L = Wb + (size_t)l * LW_STRIDE;
        if (r < IT_IN) {
            const int kb = r / IN_BLK; int blk = r % IN_BLK; int sc = 0, dr = 0, nv = 0;
            for (int s = 0; s < 15; ++s) { const int w = SEG_IN[s][2], nb = (w + 31) >> 5; if (blk < nb) { sc = SEG_IN[s][0] + 32 * blk; dr = SEG_IN[s][1] + 32 * blk; nv = (w - 32 * blk) < 32 ? (w - 32 * blk) : 32; break; } blk -= nb; }
            conv_item(w_in + (size_t)l * DM * INC, INC, sc, nv, 64 * kb, L + LW_IN, 1024, dr, scr, F.lane); continue; }
        r -= IT_IN;
        if (r < 3 * IT_MIX) { const int w = r / IT_MIX, q = r % IT_MIX, kb = q / 32, nb = q % 32;
            conv_item((w == 0 ? w_fox : w == 1 ? w_dsa : w_ret) + (size_t)l * 512 * DM, DM, 32 * nb, 32, 64 * kb, L + LW_MIX + (size_t)w * 512 * 1024, 512, 32 * nb, scr, F.lane); continue; }
        r -= 3 * IT_MIX;
        if (r < IT_O) { const int kb = r / 32, nb = r % 32;
            conv_item(w_o + (size_t)l * DM * DM, DM, 32 * nb, 32, 64 * kb, L + LW_O, 1024, 32 * nb, scr, F.lane); continue; }
        r -= IT_O;
        if (r < IT_FI) { const int kb = r / (FF2 / 32), nb = r % (FF2 / 32); const int n0 = 32 * nb;
            const int j = n0 < FFH ? n0 : n0 - FFH; const int dr = 256 * (j >> 7) + (j & 127) + (n0 < FFH ? 0 : 128);
            conv_item(w_fi + (size_t)l * DM * FF2, FF2, n0, 32, 64 * kb, L + LW_FI, 1024, dr, scr, F.lane); continue; }
        r -= IT_FI;
        { const int kb = r / 32, nb = r % 32;
            conv_item(w_fo + (size_t)l * FFH * DM, DM, 32 * nb, 32, 64 * kb, L + LW_FO, FFH, 32 * nb, scr, F.lane); }
    }
    for (int i = F.gw * 64 + F.lane; i < DEPTH * 80 * 128; i += F.NGW * 64) { const int l = i / (80 * 128), q = i % (80 * 128);
        *(GAS v4u*)(Wb + (size_t)l * LW_STRIDE + LW_IN + (size_t)INC * 1024 + (size_t)q * 8) = (v4u){0u, 0u, 0u, 0u}; }
    f32x2* R64 = (f32x2*)(F.ws + WS_ROPE64); f32x2* R32 = (f32x2*)(F.ws + WS_ROPE32);
    for (int i = F.gw * 64 + F.lane; i < SEQ * 32; i += F.NGW * 64) { const int pos = i >> 5, k = i & 31;
        double f = 1.0; for (int e = 0; e < k; ++e) f *= 0.7498942093324559;
        const float ang = (float)pos * (float)f; float c, s; sincos_acc(ang, c, s); R64[i] = (f32x2){c, s}; }
    for (int i = F.gw * 64 + F.lane; i < SEQ * 16; i += F.NGW * 64) { const int pos = i >> 4, k = i & 15;
        double f = 1.0; for (int e = 0; e < k; ++e) f *= 0.5623413251903491;
        const float ang = (float)pos * (float)f; float c, s; sincos_acc(ang, c, s); R32[i] = (f32x2){c, s}; }
}

__device__ __forceinline__ void rmsnorm_phase(const Ctx& F, const float* x, const float* g, bf16* o) {
    const GAS f32x4* gp = (const GAS f32x4*)g + F.lane;
    f32x4 gv[4];
#pragma unroll
    for (int j = 0; j < 4; ++j) gv[j] = gp[64 * j];
    for (int m = F.gw; m < M; m += F.NGW) {
        const GAS f32x4* xr = (const GAS f32x4*)(x + (size_t)m * DM) + F.lane;
        f32x4 v[4]; float s = 0.f;
#pragma unroll
        for (int j = 0; j < 4; ++j) { v[j] = xr[64 * j]; s += (v[j].x * v[j].x + v[j].y * v[j].y) + (v[j].z * v[j].z + v[j].w * v[j].w); }
        const float rstd = 1.0f / sqrtf(wave_sum(s) * (1.f / DM) + NORM_EPS);
        GAS unsigned long long* o8 = (GAS unsigned long long*)(o + (size_t)m * DM) + F.lane;
#pragma unroll
        for (int j = 0; j < 4; ++j) o8[64 * j] = (unsigned long long)pk2(v[j].x * rstd * gv[j].x, v[j].y * rstd * gv[j].y) | ((unsigned long long)pk2(v[j].z * rstd * gv[j].z, v[j].w * rstd * gv[j].w) << 32);
    }
}

__device__ __forceinline__ void post_phase(const Ctx& F, const float* g_fq, const float* g_fk, const float* g_dq, const float* g_dk, const float* b_f) {
    bf16* Z = (bf16*)(F.ws + WS_Z); float* ZS = (float*)(F.ws + WS_ZS);
    const f32x2* R64 = (const f32x2*)(F.ws + WS_ROPE64); const f32x2* R32 = (const f32x2*)(F.ws + WS_ROPE32);
    float* LF = (float*)(F.ws + WS_LF); unsigned* ISG = (unsigned*)(F.ws + WS_ISG);
    bf16* KD = (bf16*)(F.ws + WS_KD); bf16* VD = (bf16*)(F.ws + WS_VD); bf16* IQB = (bf16*)(F.ws + WS_IQB); bf16* IKB = (bf16*)(F.ws + WS_IKB);
    const int lane = F.lane, c8 = lane & 7;
    float gq[8], gk[8], gd[8];
#pragma unroll
    for (int j = 0; j < 8; ++j) { gq[j] = g_fq[c8 * 8 + j]; gk[j] = g_fk[c8 * 8 + j]; gd[j] = g_dq[c8 * 8 + j]; }
    const float gdk = g_dk[lane];
    for (int m = F.gw; m < M; m += F.NGW) {
        const int pos = m & (SEQ - 1);
        bf16* zr = Z + (size_t)m * ZP; float* sr = ZS + (size_t)m * ZSP;
        { v4u w = *(const GAS v4u*)(zr + Z_FQ + 8 * lane); float f[8]; unpack8(w, f); float ss = 0.f;
#pragma unroll
            for (int j = 0; j < 8; ++j) ss += f[j] * f[j];
            ss += sx<1>(ss); ss += sx<2>(ss); ss += sx<4>(ss);
            const float rs = C2 / sqrtf(ss * (1.f / 64) + NORM_EPS);
#pragma unroll
            for (int j = 0; j < 8; ++j) f[j] = f[j] * rs * gq[j];
            *(GAS v4u*)(zr + Z_FQ + 8 * lane) = pack8(f); }
        { v4u w = *(const GAS v4u*)(zr + Z_FK + 8 * lane); float f[8]; unpack8(w, f); float ss = 0.f;
#pragma unroll
            for (int j = 0; j < 8; ++j) ss += f[j] * f[j];
            ss += sx<1>(ss); ss += sx<2>(ss); ss += sx<4>(ss);
            const float rs = 1.0f / sqrtf(ss * (1.f / 64) + NORM_EPS);
#pragma unroll
            for (int j = 0; j < 8; ++j) f[j] = f[j] * rs * gk[j];
            *(GAS v4u*)(zr + Z_FK + 8 * lane) = pack8(f); }
        { v4u w = *(const GAS v4u*)(zr + Z_DQ + 8 * lane); float f[8]; unpack8(w, f); float ss = 0.f;
#pragma unroll
            for (int j = 0; j < 8; ++j) ss += f[j] * f[j];
            ss += sx<1>(ss); ss += sx<2>(ss); ss += sx<4>(ss);
            const float rs = 1.0f / sqrtf(ss * (1.f / 64) + NORM_EPS);
            const f32x2* cs = R64 + pos * 32 + (c8 & 3) * 8;
#pragma unroll
            for (int j = 0; j < 8; ++j) { f[j] = f[j] * rs * gd[j]; }
            float o[8];
#pragma unroll
            for (int j = 0; j < 8; ++j) { const float p = sx<4>(f[j]); const f32x2 t = cs[j]; o[j] = ((c8 < 4) ? (f[j] * t.x - p * t.y) : (f[j] * t.x + p * t.y)) * C2; }
            *(GAS v4u*)(zr + Z_DQ + 8 * lane) = pack8(o); }
        { const f32x4 v = *(const GAS f32x4*)(sr + S_IQ + 4 * lane); float f[4] = {v.x, v.y, v.z, v.w};
            const float iw = sr[S_IW + (lane >> 3)]; const float aw = fabsf(iw);
            const f32x2* cs = R32 + pos * 16 + (lane & 3) * 4; const bool first = (lane & 7) < 4; f32x4 o;
#pragma unroll
            for (int j = 0; j < 4; ++j) { const float p = sx<4>(f[j]); const f32x2 t = cs[j]; o[j] = (first ? (f[j] * t.x - p * t.y) : (f[j] * t.x + p * t.y)) * aw; }
            const unsigned long long neg = __ballot(iw < 0.f);
            unsigned sg = 0;
#pragma unroll
            for (int h = 0; h < 8; ++h) sg |= (unsigned)((neg >> (8 * h)) & 1ull) << h;
            { u32x2 ob; ob.x = pk2(o[0], o[1]); ob.y = pk2(o[2], o[3]); *(GAS u32x2*)(IQB + (size_t)m * 256 + 4 * lane) = ob; }
            if (lane == 0) ISG[m] = sg; }
        { float v = sr[S_DK + lane]; const float ss = wave_sum(v * v); v = v * (1.0f / sqrtf(ss * (1.f / 64) + NORM_EPS)) * gdk;
            const float p = xor32(v, lane); const f32x2 t = R64[pos * 32 + (lane & 31)];
            const float o = (lane < 32) ? (v * t.x - p * t.y) : (v * t.x + p * t.y);
            KD[(size_t)m * 64 + lane] = (bf16)f2bf(o);
            VD[(size_t)m * 64 + lane] = (bf16)f2bf(sr[S_DV + lane]); }
        { const float v = sr[S_IK + (lane & 31)]; const float p = sx<16>(v); const f32x2 t = R32[pos * 16 + (lane & 15)];
            const float o = ((lane & 16) == 0) ? (v * t.x - p * t.y) : (v * t.x + p * t.y);
            if (lane < 32) IKB[(size_t)m * 32 + lane] = (bf16)f2bf(o); }
        if (lane < 8) { const float xx = sr[S_FF + lane] + b_f[lane]; const float ls = fminf(xx, 0.f) - __logf(1.0f + __expf(-fabsf(xx))); LF[(size_t)m * 8 + lane] = ls * LOG2E; }
    }
}

__device__ __forceinline__ float ret_l2g(int h) { return h == 0 ? -0.04580368961312479f : h == 1 ? -0.02272007650008353f : h == 2 ? -0.011315313227834146f : -0.005646563141142063f; }

__device__ __forceinline__ void scan_state_phase(const Ctx& F) {
    const float* LF = (const float*)(F.ws + WS_LF); float* CF = (float*)(F.ws + WS_CF);
    const bf16* Z = (const bf16*)(F.ws + WS_Z); float* RS = (float*)(F.ws + WS_HDN);
    if (F.gw < 32) {
        const int b = F.gw >> 3, h = F.gw & 7; const float* lp = LF + ((size_t)b * SEQ + F.lane * 64) * 8 + h; float s = 0.f;
        for (int i = 0; i < 64; ++i) s += lp[i * 8];
        float incl = s;
#pragma unroll
        for (int o = 1; o < 64; o <<= 1) { const float t = __builtin_bit_cast(float, __builtin_amdgcn_ds_bpermute(((F.lane - o) & 63) << 2, __builtin_bit_cast(int, incl))); if (F.lane >= o) incl += t; }
        float run = incl - s; float* cp = CF + (size_t)F.gw * SEQ + F.lane * 64;
        for (int i = 0; i < 64; ++i) { run += lp[i * 8]; cp[i] = run; }
    }
    for (int u = blockIdx.x; u < NB * 32 * 4; u += F.G) {
        const int h = u & 3, c = (u >> 2) & 31, b = u >> 7; const float l2g = ret_l2g(h);
        const int d = F.tid >> 3, e0 = (F.tid & 7) * 16; float acc[16];
#pragma unroll
        for (int i = 0; i < 16; ++i) acc[i] = 0.f;
        const bf16* base = Z + ((size_t)b * SEQ + c * 128) * ZP;
        for (int j = 0; j < 128; ++j) { const bf16* row = base + (size_t)j * ZP;
            const float kd = bf2f(row[Z_RK + h * 64 + d]) * exp2f((float)(127 - j) * l2g);
            const v4u w0 = *(const GAS v4u*)(row + Z_RV + h * 128 + e0), w1 = *(const GAS v4u*)(row + Z_RV + h * 128 + e0 + 8);
            float v0[8], v1[8]; unpack8(w0, v0); unpack8(w1, v1);
#pragma unroll
            for (int i = 0; i < 8; ++i) { acc[i] += kd * v0[i]; acc[8 + i] += kd * v1[i]; } }
        float* o = RS + (size_t)u * 8192 + d * 128 + e0;
#pragma unroll
        for (int i = 0; i < 4; ++i) *(GAS f32x4*)(o + 4 * i) = (f32x4){acc[4 * i], acc[4 * i + 1], acc[4 * i + 2], acc[4 * i + 3]};
    }
}

__device__ __forceinline__ void ret_out_naive(const Ctx& F, const float* gn) {
    bf16* Z = (bf16*)(F.ws + WS_Z); const float* RS = (const float*)(F.ws + WS_HDN);
    LAS float* S = (LAS float*)(F.lds);
    LAS bf16* Vt = (LAS bf16*)(F.lds + 32768);
    LAS float* Kt = (LAS float*)(F.lds + 65536);
    LAS float* aw = (LAS float*)(F.lds + 65536 + 33280) + F.wave * 128;
    LAS float* qw = (LAS float*)(F.lds + 65536 + 33280 + 4096) + F.wave * 64;
    for (int u = blockIdx.x; u < NB * 32 * 4; u += F.G) {
        const int h = u & 3, c = (u >> 2) & 31, b = u >> 7; const float l2g = ret_l2g(h); const float wch = exp2f(128.f * l2g);
        __syncthreads();
        { float s[16];
#pragma unroll
            for (int i = 0; i < 16; ++i) s[i] = 0.f;
            for (int cp = 0; cp < c; ++cp) { const float* L = RS + ((size_t)((b * 32 + cp) * 4 + h)) * 8192 + F.tid;
#pragma unroll
                for (int i = 0; i < 16; ++i) s[i] = wch * s[i] + L[i * 512]; }
#pragma unroll
            for (int i = 0; i < 16; ++i) S[F.tid + i * 512] = s[i]; }
        const bf16* base = Z + ((size_t)b * SEQ + c * 128) * ZP;
        for (int q = F.tid; q < 2048; q += 512) { const int r = q >> 4, ch = q & 15; *(LAS v4u*)(Vt + r * 128 + ch * 8) = *(const GAS v4u*)(base + (size_t)r * ZP + Z_RV + h * 128 + ch * 8); }
        for (int q = F.tid; q < 128 * 64; q += 512) { const int r = q >> 6, dd = q & 63; Kt[r * 65 + dd] = bf2f(base[(size_t)r * ZP + Z_RK + h * 64 + dd]); }
        __syncthreads();
        for (int i = F.wave; i < 128; i += NWAVES) {
            const size_t m = (size_t)b * SEQ + c * 128 + i; bf16* zr = Z + m * ZP;
            qw[F.lane] = bf2f(zr[Z_RQ + h * 64 + F.lane]);
            LDS_WAIT(); asm volatile("" ::: "memory");
#pragma unroll
            for (int jj = 0; jj < 2; ++jj) { const int j = F.lane + 64 * jj; float a = 0.f;
                if (j <= i) { float dot = 0.f; for (int dd = 0; dd < 64; ++dd) dot += qw[dd] * Kt[j * 65 + dd]; a = dot * exp2f((float)(i - j) * l2g); }
                aw[j] = a; }
            LDS_WAIT(); asm volatile("" ::: "memory");
            float o[2]; const float dq = exp2f((float)(i + 1) * l2g);
#pragma unroll
            for (int ee = 0; ee < 2; ++ee) { const int e = F.lane + 64 * ee; float acc = 0.f;
                for (int j = 0; j <= i; ++j) acc += aw[j] * bf2f(Vt[j * 128 + e]);
                float cr = 0.f; for (int dd = 0; dd < 64; ++dd) cr += qw[dd] * S[dd * 128 + e];
                o[ee] = acc + cr * dq; }
            const float ss = wave_sum(o[0] * o[0] + o[1] * o[1]); const float rstd = 1.0f / sqrtf(ss * (1.f / 128) + NORM_EPS);
#pragma unroll
            for (int ee = 0; ee < 2; ++ee) { const int e = F.lane + 64 * ee; const float rg = bf2f(zr[Z_RG + h * 128 + e]);
                zr[Z_RV + h * 128 + e] = (bf16)f2bf(o[ee] * rstd * gn[h * 128 + e] * rg * sigmoid_f(rg)); }
            LDS_WAIT(); asm volatile("" ::: "memory");
        }
    }
    __syncthreads();
}

__device__ __forceinline__ void fox_naive(const Ctx& F) {
    bf16* Z = (bf16*)(F.ws + WS_Z); const float* CF = (const float*)(F.ws + WS_CF);
    LAS float* sc = (LAS float*)(F.lds + F.wave * 16384);
    const int lane = F.lane;
    int it = 0;
    for (int r0 = 0; r0 < NB * 8 * SEQ; r0 += F.NGW, ++it) {
        const int r = r0 + ((it & 1) ? (F.NGW - 1 - F.gw) : F.gw);
        if (r >= NB * 8 * SEQ) continue;
        const int pos = r & (SEQ - 1), h = (r >> 12) & 7, b = r >> 15;
        const size_t m = (size_t)b * SEQ + pos;
        float qf[64];
        { const bf16* qp = Z + m * ZP + Z_FQ + h * 64;
#pragma unroll
            for (int i = 0; i < 8; ++i) { const v4u w = *(const GAS v4u*)(qp + 8 * i); float t[8]; unpack8(w, t);
#pragma unroll
                for (int j = 0; j < 8; ++j) qf[8 * i + j] = t[j]; } }
        const float* cf = CF + (size_t)(b * 8 + h) * SEQ;
        float mx = -INFINITY;
        for (int kk = lane; kk <= pos; kk += 64) { const bf16* kp = Z + ((size_t)b * SEQ + kk) * ZP + Z_FK + h * 64; float dot = 0.f;
#pragma unroll
            for (int i = 0; i < 8; ++i) { const v4u w = *(const GAS v4u*)(kp + 8 * i); float t[8]; unpack8(w, t);
#pragma unroll
                for (int j = 0; j < 8; ++j) dot += qf[8 * i + j] * t[j]; }
            const float s = dot - cf[kk]; sc[kk] = s; mx = fmaxf(mx, s); }
        mx = wave_max(mx);
        float sum = 0.f;
        for (int kk = lane; kk <= pos; kk += 64) { const float p = exp2f(sc[kk] - mx); sc[kk] = p; sum += p; }
        sum = wave_sum(sum);
        LDS_WAIT(); asm volatile("" ::: "memory");
        const bf16* vp = Z + (size_t)b * SEQ * ZP + Z_FV + h * 64 + lane;
        float o0 = 0.f, o1 = 0.f, o2 = 0.f, o3 = 0.f; int kk = 0;
        for (; kk + 3 <= pos; kk += 4) { o0 += sc[kk] * bf2f(vp[(size_t)kk * ZP]); o1 += sc[kk + 1] * bf2f(vp[(size_t)(kk + 1) * ZP]); o2 += sc[kk + 2] * bf2f(vp[(size_t)(kk + 2) * ZP]); o3 += sc[kk + 3] * bf2f(vp[(size_t)(kk + 3) * ZP]); }
        for (; kk <= pos; ++kk) o0 += sc[kk] * bf2f(vp[(size_t)kk * ZP]);
        Z[m * ZP + Z_FQ + h * 64 + lane] = (bf16)f2bf(((o0 + o1) + (o2 + o3)) / sum);
        LDS_WAIT(); asm volatile("" ::: "memory");
    }
}

__device__ __forceinline__ unsigned f2key(float s) { const unsigned u = __builtin_bit_cast(unsigned, s + 0.0f); return (u & 0x80000000u) ? ~u : (u | 0x80000000u); }
__device__ __forceinline__ void dsa_naive(const Ctx& F) {
    bf16* Z = (bf16*)(F.ws + WS_Z); const float* ZS = (const float*)(F.ws + WS_ZS);
    const unsigned* ISG = (const unsigned*)(F.ws + WS_ISG);
    const bf16* KD = (const bf16*)(F.ws + WS_KD); const bf16* VD = (const bf16*)(F.ws + WS_VD);
    LAS unsigned* kl = (LAS unsigned*)(F.lds + F.wave * 16384);
    LAS float* iqs = (LAS float*)(F.lds + XTRA_OFF + F.wave * 1536);
    const int lane = F.lane;
    int it = 0;
    for (int r0 = 0; r0 < M; r0 += F.NGW, ++it) {
        const int r = r0 + ((it & 1) ? (F.NGW - 1 - F.gw) : F.gw);
        if (r >= M) continue;
        const int pos = r & (SEQ - 1), b = r >> 12; const size_t m = (size_t)r;
        *(LAS f32x4*)(iqs + 4 * lane) = *(const GAS f32x4*)(ZS + m * ZSP + S_IQ + 4 * lane);
        const unsigned sg = ISG[m];
        LDS_WAIT(); asm volatile("" ::: "memory");
        for (int kk = lane; kk <= pos; kk += 64) { const float* ikp = ZS + ((size_t)b * SEQ + kk) * ZSP + S_IK; float ik[32];
#pragma unroll
            for (int i = 0; i < 8; ++i) { const f32x4 t = *(const GAS f32x4*)(ikp + 4 * i); ik[4 * i] = t.x; ik[4 * i + 1] = t.y; ik[4 * i + 2] = t.z; ik[4 * i + 3] = t.w; }
            float s = 0.f;
#pragma unroll 1
            for (int h = 0; h < 8; ++h) { float dot = 0.f;
#pragma unroll
                for (int dd = 0; dd < 32; ++dd) dot += iqs[h * 32 + dd] * ik[dd];
                dot = fmaxf(dot, 0.f); s += ((sg >> h) & 1u) ? -dot : dot; }
            kl[kk] = f2key(s); }
        LDS_WAIT(); asm volatile("" ::: "memory");
        unsigned key[64];
#pragma unroll
        for (int j = 0; j < 64; ++j) { const int kk = j * 64 + lane; key[j] = (kk <= pos) ? kl[kk] : 0u; }
        LDS_WAIT(); asm volatile("" ::: "memory");
        LAS unsigned* idx = kl; LAS float* pl = (LAS float*)(kl + 256); LAS bf16* qs = (LAS bf16*)(kl + 512);
        *(LAS v4u*)(qs + 8 * lane) = *(const GAS v4u*)(Z + m * ZP + Z_DQ + 8 * lane);
        unsigned T = 0u; int need = 0;
        if (pos + 1 > 256) {
            for (int bit = 31; bit >= 0; --bit) { const unsigned Tt = T | (1u << bit); int cnt = 0;
#pragma unroll
                for (int j = 0; j < 64; ++j) cnt += __builtin_popcountll(__ballot(key[j] >= Tt));
                if (cnt >= 256) T = Tt; }
            int ngt = 0;
#pragma unroll
            for (int j = 0; j < 64; ++j) ngt += __builtin_popcountll(__ballot(key[j] > T));
            need = 256 - ngt;
        }
        int nsel = 0, eqb = 0;
#pragma unroll
        for (int j = 0; j < 64; ++j) { const bool gt = key[j] > T, eq = (key[j] == T) && (T != 0u);
            const unsigned long long em = __ballot(eq); const int er = eqb + __builtin_amdgcn_mbcnt_hi((unsigned)(em >> 32), __builtin_amdgcn_mbcnt_lo((unsigned)em, 0u));
            const bool sel = gt || (eq && er < need); eqb += __builtin_popcountll(em);
            const unsigned long long sm = __ballot(sel); const int sp = nsel + __builtin_amdgcn_mbcnt_hi((unsigned)(sm >> 32), __builtin_amdgcn_mbcnt_lo((unsigned)sm, 0u));
            if (sel) idx[sp] = (unsigned)(j * 64 + lane); nsel += __builtin_popcountll(sm); }
        LDS_WAIT(); asm volatile("" ::: "memory");
        for (int h = 0; h < 8; ++h) {
            float sv[4]; float mx = -INFINITY;
#pragma unroll
            for (int i = 0; i < 4; ++i) { const int e = lane + 64 * i; sv[i] = -INFINITY;
                if (e < nsel) { const bf16* kp = KD + ((size_t)b * SEQ + idx[e]) * 64; float dot = 0.f;
#pragma unroll
                    for (int c = 0; c < 8; ++c) { const v4u w = *(const GAS v4u*)(kp + 8 * c); float t[8]; unpack8(w, t); const v4u qw = *(const LAS v4u*)(qs + h * 64 + 8 * c); float qq[8]; unpack8(qw, qq);
#pragma unroll
                        for (int j = 0; j < 8; ++j) dot += qq[j] * t[j]; }
                    sv[i] = dot; }
                mx = fmaxf(mx, sv[i]); }
            mx = wave_max(mx); float sum = 0.f;
#pragma unroll
            for (int i = 0; i < 4; ++i) { const int e = lane + 64 * i; const float p = (e < nsel) ? exp2f(sv[i] - mx) : 0.f; pl[e] = p; sum += p; }
            sum = wave_sum(sum);
            LDS_WAIT(); asm volatile("" ::: "memory");
            float o0 = 0.f, o1 = 0.f; int e = 0;
            for (; e + 1 < nsel; e += 2) { o0 += pl[e] * bf2f(VD[((size_t)b * SEQ + idx[e]) * 64 + lane]); o1 += pl[e + 1] * bf2f(VD[((size_t)b * SEQ + idx[e + 1]) * 64 + lane]); }
            if (e < nsel) o0 += pl[e] * bf2f(VD[((size_t)b * SEQ + idx[e]) * 64 + lane]);
            Z[m * ZP + Z_DQ + h * 64 + lane] = (bf16)f2bf((o0 + o1) / sum);
            LDS_WAIT(); asm volatile("" ::: "memory");
        }
    }
}
#ifndef PROBE_D
#define PROBE_D 0
#endif

typedef short s16x8 __attribute__((ext_vector_type(8)));
typedef short s16x4 __attribute__((ext_vector_type(4)));
typedef short v4i16_t __attribute__((ext_vector_type(4)));
__device__ __forceinline__ s16x4 tr16(const LAS unsigned char* p) { return __builtin_bit_cast(s16x4, __builtin_amdgcn_ds_read_tr16_b64_v4i16((LAS v4i16_t*)p)); }
__device__ __forceinline__ float key2f(unsigned k) { return __builtin_bit_cast(float, (k & 0x80000000u) ? (k & 0x7fffffffu) : ~k); }

template <int NR> __device__ __forceinline__ int dsa_count_ge(const unsigned (&key)[64], unsigned T) {
    int c = 0;
#pragma unroll
    for (int j = 0; j < NR; ++j) c += __builtin_popcountll(__ballot(key[j] >= T));
    return c;
}
#define DSA_COUNT_GE(T_, out_) do { if (nq == 1) out_ = dsa_count_ge<16>(key, (T_)); else if (nq == 2) out_ = dsa_count_ge<32>(key, (T_)); else if (nq == 3) out_ = dsa_count_ge<48>(key, (T_)); else out_ = dsa_count_ge<64>(key, (T_)); } while (0)
__device__ __forceinline__ void dsa_select(const unsigned (&key)[64], int nvalid, unsigned& T, int& need) {
    const int nq = __builtin_amdgcn_readfirstlane((nvalid + 1023) >> 10);
    T = 0u; need = 0;
    if (nvalid <= 256) return;
    unsigned kmax = 0u;
#pragma unroll
    for (int j = 0; j < 64; ++j) kmax = key[j] > kmax ? key[j] : kmax;
#pragma unroll
    for (int o_ = 0; o_ < 1; ++o_) { unsigned t; t = sxu<1>(kmax); kmax = t > kmax ? t : kmax; t = sxu<2>(kmax); kmax = t > kmax ? t : kmax; t = sxu<4>(kmax); kmax = t > kmax ? t : kmax; t = sxu<8>(kmax); kmax = t > kmax ? t : kmax; t = sxu<16>(kmax); kmax = t > kmax ? t : kmax;
        unsigned a_, b_; swap32(kmax, a_, b_); kmax = a_ > b_ ? a_ : b_; }
    unsigned lo = 1u, hi = kmax + 1u; int hic = 0;
    { const float vm = fabsf(key2f(kmax)) + 1.0f; unsigned l2 = f2key(-vm * 64.0f); int c; DSA_COUNT_GE(l2, c); if (c >= 256) lo = l2; }
    int iter = 0; bool exact = false;
    while (hi - lo > 1u) {
        unsigned mid;
        if (iter < 24 && lo > 1u) { const float mv = 0.5f * key2f(lo) + 0.5f * key2f(hi - 1u); mid = f2key(mv); }
        else mid = lo + ((hi - lo) >> 1);
        if (mid <= lo) mid = lo + 1u; if (mid >= hi) mid = hi - 1u;
        int c; DSA_COUNT_GE(mid, c);
        if (c == 256) { T = mid; exact = true; break; }
        if (c > 256) lo = mid; else { hi = mid; hic = c; }
        ++iter;
    }
    if (exact) need = 256; else { T = lo; need = 256 - hic; }
}

__device__ __forceinline__ void dsa_attend(const bf16* zq, bf16* zo, const bf16* KDb, const bf16* VDb, const LAS unsigned short* idx, int nsel, LAS unsigned char* vst, int lane) {
    const int g = lane >> 4, c = lane & 15;
    s16x8 qf[2];
#pragma unroll
    for (int ks = 0; ks < 2; ++ks) { qf[ks] = (s16x8){0, 0, 0, 0, 0, 0, 0, 0}; if (c < 8) qf[ks] = *(const GAS s16x8*)(zq + c * 64 + 32 * ks + 8 * g); }
    f32x4 acc[16];
    v4u vreg[16];
#pragma unroll
    for (int i = 0; i < 16; ++i) { const int pi = lane + 64 * i, r = pi >> 3, c16 = pi & 7; const int id = (r < nsel) ? (int)idx[r] : 0; vreg[i] = *(const GAS v4u*)(VDb + (size_t)id * 64 + c16 * 8); }
#pragma unroll
    for (int tb = 0; tb < 2; ++tb) {
        s16x8 kf[8][2];
#pragma unroll
        for (int tt = 0; tt < 8; ++tt) { const int e = 16 * (8 * tb + tt) + c; const int id = (e < nsel) ? (int)idx[e] : 0; const bf16* kp = KDb + (size_t)id * 64 + 8 * g;
            kf[tt][0] = *(const GAS s16x8*)kp; kf[tt][1] = *(const GAS s16x8*)(kp + 32); }
#pragma unroll
        for (int tt = 0; tt < 8; ++tt) { f32x4 a = (f32x4){0.f, 0.f, 0.f, 0.f};
            a = __builtin_amdgcn_mfma_f32_16x16x32_bf16(kf[tt][0], qf[0], a, 0, 0, 0); a = __builtin_amdgcn_mfma_f32_16x16x32_bf16(kf[tt][1], qf[1], a, 0, 0, 0); acc[8 * tb + tt] = a; }
    }
    float mx = -INFINITY;
#pragma unroll
    for (int t = 0; t < 16; ++t)
#pragma unroll
        for (int i = 0; i < 4; ++i) { const int e = 16 * t + 4 * g + i; if (e >= nsel) acc[t][i] = -INFINITY; mx = fmaxf(mx, acc[t][i]); }
    mx = fmaxf(mx, sx<16>(mx)); mx = half_max(mx);
    float sum = 0.f;
#pragma unroll
    for (int t = 0; t < 16; ++t)
#pragma unroll
        for (int i = 0; i < 4; ++i) { const float p = exp2f(acc[t][i] - mx); acc[t][i] = p; sum += p; }
    sum += sx<16>(sum); sum = half_sum(sum);
    const float inv = 1.0f / sum;
    s16x8 pf[8];
#pragma unroll
    for (int s = 0; s < 8; ++s) { v4u w; w.x = pk2(acc[2 * s][0] * inv, acc[2 * s][1] * inv); w.y = pk2(acc[2 * s][2] * inv, acc[2 * s][3] * inv); w.z = pk2(acc[2 * s + 1][0] * inv, acc[2 * s + 1][1] * inv); w.w = pk2(acc[2 * s + 1][2] * inv, acc[2 * s + 1][3] * inv);
        pf[s] = __builtin_bit_cast(s16x8, w); }
    f32x4 o[4];
#pragma unroll
    for (int db = 0; db < 4; ++db) o[db] = (f32x4){0.f, 0.f, 0.f, 0.f};
    const int q = (lane >> 2) & 3, p = lane & 3, swz = 2 * (g & 1) + (q >> 1);
    const LAS unsigned char* rb = vst + (4 * g + q) * 128 + 8 * p;
#pragma unroll
    for (int hh = 0; hh < 2; ++hh) {
        asm volatile("s_waitcnt lgkmcnt(0)" ::: "memory");
#pragma unroll
        for (int i = 0; i < 16; ++i) { const int pi = lane + 64 * i, r = pi >> 3, c16 = pi & 7;
            *(LAS v4u*)(vst + r * 128 + ((((c16 >> 1) ^ ((r >> 1) & 3))) << 5) + ((c16 & 1) << 4)) = vreg[i]; }
        if (hh == 0) {
#pragma unroll
            for (int i = 0; i < 16; ++i) { const int pi = lane + 64 * i, r = pi >> 3, c16 = pi & 7, e = 128 + r; const int id = (e < nsel) ? (int)idx[e] : 0; vreg[i] = *(const GAS v4u*)(VDb + (size_t)id * 64 + c16 * 8); } }
        asm volatile("s_waitcnt lgkmcnt(0)" ::: "memory");
#pragma unroll
        for (int s4 = 0; s4 < 4; ++s4)
#pragma unroll
            for (int db = 0; db < 4; ++db) { const LAS unsigned char* a1 = rb + s4 * 4096 + ((db ^ swz) << 5);
                const s16x4 lo = tr16(a1), hi = tr16(a1 + 2048);
                const s16x8 vf = (s16x8){lo[0], lo[1], lo[2], lo[3], hi[0], hi[1], hi[2], hi[3]};
                o[db] = __builtin_amdgcn_mfma_f32_16x16x32_bf16(pf[4 * hh + s4], vf, o[db], 0, 0, 0); }
    }
    if (g < 2) {
#pragma unroll
        for (int db = 0; db < 4; ++db)
#pragma unroll
            for (int i = 0; i < 4; ++i) zo[(4 * g + i) * 64 + 16 * db + c] = (bf16)f2bf(o[db][i]);
    }
}

__device__ __forceinline__ void dsa_v2(const Ctx& F) {
    bf16* Z = (bf16*)(F.ws + WS_Z); const float* ZS = (const float*)(F.ws + WS_ZS);
    const unsigned* ISG = (const unsigned*)(F.ws + WS_ISG);
    const bf16* KD = (const bf16*)(F.ws + WS_KD); const bf16* VD = (const bf16*)(F.ws + WS_VD);
    LAS unsigned* kl = (LAS unsigned*)(F.lds + F.wave * 16384);
    LAS float* iqs = (LAS float*)(F.lds + XTRA_OFF + F.wave * 1536);
    LAS unsigned short* idx = (LAS unsigned short*)(F.lds + XTRA_OFF + F.wave * 1536 + 1024);
    const int lane = F.lane;
    int it = 0;
    for (int r0 = 0; r0 < M; r0 += F.NGW, ++it) {
        const int r = r0 + ((it & 1) ? (F.NGW - 1 - F.gw) : F.gw);
        if (r >= M) continue;
        const int pos = r & (SEQ - 1), b = r >> 12; const size_t m = (size_t)r;
        *(LAS f32x4*)(iqs + 4 * lane) = *(const GAS f32x4*)(ZS + m * ZSP + S_IQ + 4 * lane);
        const unsigned sg = ISG[m];
        LDS_WAIT(); asm volatile("" ::: "memory");
        for (int kk = lane; kk <= pos; kk += 64) { const float* ikp = ZS + ((size_t)b * SEQ + kk) * ZSP + S_IK; float ik[32];
#pragma unroll
            for (int i = 0; i < 8; ++i) { const f32x4 t = *(const GAS f32x4*)(ikp + 4 * i); ik[4 * i] = t.x; ik[4 * i + 1] = t.y; ik[4 * i + 2] = t.z; ik[4 * i + 3] = t.w; }
            float s = 0.f;
#pragma unroll 1
            for (int h = 0; h < 8; ++h) { float dot = 0.f;
#pragma unroll
                for (int dd = 0; dd < 32; ++dd) dot += iqs[h * 32 + dd] * ik[dd];
                dot = fmaxf(dot, 0.f); s += ((sg >> h) & 1u) ? -dot : dot; }
            kl[kk] = f2key(s); }
        LDS_WAIT(); asm volatile("" ::: "memory");
        unsigned key[64];
#pragma unroll
        for (int j = 0; j < 64; ++j) { const int kk = j * 64 + lane; key[j] = (kk <= pos) ? kl[kk] : 0u; }
        LDS_WAIT(); asm volatile("" ::: "memory");
        unsigned T; int need;
#ifdef DSA_OLDSEL
        T = 0u; need = 0;
        if (pos + 1 > 256) {
            for (int bit = 31; bit >= 0; --bit) { const unsigned Tt = T | (1u << bit); int cnt = 0;
#pragma unroll
                for (int j = 0; j < 64; ++j) cnt += __builtin_popcountll(__ballot(key[j] >= Tt));
                if (cnt >= 256) T = Tt; }
            int ngt = 0;
#pragma unroll
            for (int j = 0; j < 64; ++j) ngt += __builtin_popcountll(__ballot(key[j] > T));
            need = 256 - ngt;
        }
#else
        dsa_select(key, pos + 1, T, need);
#endif
        int nsel = 0, eqb = 0;
#pragma unroll
        for (int j = 0; j < 64; ++j) { const bool gt = key[j] > T, eq = (key[j] == T) && (T != 0u);
            const unsigned long long em = __ballot(eq); const int er = eqb + __builtin_amdgcn_mbcnt_hi((unsigned)(em >> 32), __builtin_amdgcn_mbcnt_lo((unsigned)em, 0u));
            const bool sel = gt || (eq && er < need); eqb += __builtin_popcountll(em);
            const unsigned long long sm = __ballot(sel); const int sp = nsel + __builtin_amdgcn_mbcnt_hi((unsigned)(sm >> 32), __builtin_amdgcn_mbcnt_lo((unsigned)sm, 0u));
            if (sel) idx[sp] = (unsigned short)(j * 64 + lane); nsel += __builtin_popcountll(sm); }
        LDS_WAIT(); asm volatile("" ::: "memory");
        dsa_attend(Z + m * ZP + Z_DQ, Z + m * ZP + Z_DQ, KD + (size_t)b * SEQ * 64, VD + (size_t)b * SEQ * 64, idx, nsel, (LAS unsigned char*)kl, lane);
        LDS_WAIT(); asm volatile("" ::: "memory");
    }
}

template <int NR> __device__ __forceinline__ int dsa_emit_n(const unsigned (&key)[64], unsigned T, int need, LAS unsigned short* idx, int lane) {
    int nsel = 0, eqb = 0;
#pragma unroll
    for (int j = 0; j < NR; ++j) { const bool gt = key[j] > T, eq = (key[j] == T) && (T != 0u);
        const unsigned long long em = __ballot(eq); const int er = eqb + __builtin_amdgcn_mbcnt_hi((unsigned)(em >> 32), __builtin_amdgcn_mbcnt_lo((unsigned)em, 0u));
        const bool sel = gt || (eq && er < need); eqb += __builtin_popcountll(em);
        const unsigned long long sm = __ballot(sel); const int sp = nsel + __builtin_amdgcn_mbcnt_hi((unsigned)(sm >> 32), __builtin_amdgcn_mbcnt_lo((unsigned)sm, 0u));
        if (sel) idx[sp] = (unsigned short)(j * 64 + lane); nsel += __builtin_popcountll(sm); }
    return nsel;
}
__device__ __forceinline__ int dsa_emit(const unsigned (&key)[64], int nvalid, unsigned T, int need, LAS unsigned short* idx, int lane) {
    const int nq = __builtin_amdgcn_readfirstlane((nvalid + 1023) >> 10);
    if (nq == 1) return dsa_emit_n<16>(key, T, need, idx, lane);
    if (nq == 2) return dsa_emit_n<32>(key, T, need, idx, lane);
    if (nq == 3) return dsa_emit_n<48>(key, T, need, idx, lane);
    return dsa_emit_n<64>(key, T, need, idx, lane);
}

constexpr int DSA_ROWF = 4100;
__device__ __forceinline__ void dsa_v3(const Ctx& F, int out_col = Z_DQ) {
    bf16* Z = (bf16*)(F.ws + WS_Z);
    const unsigned* ISG = (const unsigned*)(F.ws + WS_ISG);
    const bf16* KD = (const bf16*)(F.ws + WS_KD); const bf16* VD = (const bf16*)(F.ws + WS_VD);
    const bf16* IQB = (const bf16*)(F.ws + WS_IQB); const bf16* IKB = (const bf16*)(F.ws + WS_IKB);
    LAS unsigned* img = (LAS unsigned*)(F.lds);
    LAS unsigned short* idxw = (LAS unsigned short*)(F.lds + XTRA_OFF + F.wave * 1536);
    const int w = F.wave;
    const int v = (int)blockIdx.x;
    if (v < 256)
    for (int ui = 0; ui < 8; ++ui) {
        int lane_ = F.lane; asm volatile("" : "+v"(lane_)); const int lane = lane_, g = lane >> 4, c = lane & 15;
        const int b = v >> 6, k = v & 63; const int pb = 128 * (ui >> 1) + ((ui & 1) ? 127 - k : k);
        const int q0 = pb * 8, kend = q0 + 8, ntile = (kend + 15) >> 4;
        const size_t mb = (size_t)b * SEQ;
#if PROBE_D == 1
        for (int rp_ = 0; rp_ < 2; ++rp_)
#endif
        { s16x8 iqf[8]; float sgn[8];
          { const int qq = (q0 + c < SEQ) ? q0 + c : SEQ - 1; const bf16* qp = IQB + (mb + qq) * 256 + 8 * g; const unsigned sg = ISG[mb + qq];
#pragma unroll
            for (int h = 0; h < 8; ++h) { iqf[h] = *(const GAS s16x8*)(qp + h * 32); sgn[h] = ((sg >> h) & 1u) ? -1.0f : 1.0f; } }
          const bf16* ikp = IKB + (mb + c) * 32 + 8 * g;
          s16x8 cur[4], nxt[4];
#pragma unroll
          for (int i = 0; i < 4; ++i) { const int t = w + 8 * i; cur[i] = *(const GAS s16x8*)(ikp + (size_t)512 * (t < ntile ? t : 0)); }
          for (int t0 = w; t0 < ntile; t0 += 32) {
#pragma unroll
            for (int i = 0; i < 4; ++i) { const int t = t0 + 32 + 8 * i; nxt[i] = *(const GAS s16x8*)(ikp + (size_t)512 * (t < ntile ? t : 0)); }
#pragma unroll
            for (int i = 0; i < 4; ++i) { const int t = t0 + 8 * i;
              if (t < ntile) {
                f32x4 sc = (f32x4){0.f, 0.f, 0.f, 0.f};
#pragma unroll
                for (int h = 0; h < 8; ++h) { const f32x4 x = __builtin_amdgcn_mfma_f32_16x16x32_bf16(cur[i], iqf[h], (f32x4){0.f, 0.f, 0.f, 0.f}, 0, 0, 0);
#pragma unroll
                    for (int r = 0; r < 4; ++r) sc[r] += sgn[h] * fmaxf(x[r], 0.f); }
                v4u kk; kk.x = f2key(sc[0]); kk.y = f2key(sc[1]); kk.z = f2key(sc[2]); kk.w = f2key(sc[3]);
                const int kb = 16 * t + 4 * g, qa = q0 + c;
                if (kb + 0 > qa) kk.x = 0u; if (kb + 1 > qa) kk.y = 0u; if (kb + 2 > qa) kk.z = 0u; if (kb + 3 > qa) kk.w = 0u;
                if (c < 8) *(LAS v4u*)(img + c * DSA_ROWF + 16 * t + 4 * g) = kk; } }
#pragma unroll
            for (int i = 0; i < 4; ++i) cur[i] = nxt[i];
          } }
        __syncthreads();
        const int pos = q0 + w; unsigned key[64];
#pragma unroll
        for (int j = 0; j < 64; ++j) { const int kidx = 64 * j + lane; const unsigned a = img[w * DSA_ROWF + kidx]; key[j] = (kidx <= pos) ? a : 0u; }
        unsigned T; int need; int nsel;
#if PROBE_D == 2
        for (int rp_ = 0; rp_ < 2; ++rp_)
#endif
        { dsa_select(key, pos + 1, T, need);
        nsel = dsa_emit(key, pos + 1, T, need, idxw, lane); }
        __syncthreads();
#if PROBE_D == 3
        { const size_t m = mb + pos; dsa_attend(Z + m * ZP + Z_DQ, Z + m * ZP + Z_RG, KD + mb * 64, VD + mb * 64, idxw, nsel, F.lds + w * 16384, lane); }
#endif
        { const size_t m = mb + pos; dsa_attend(Z + m * ZP + Z_DQ, Z + m * ZP + out_col, KD + mb * 64, VD + mb * 64, idxw, nsel, F.lds + w * 16384, lane); }
        __syncthreads();
    }
}

__device__ __forceinline__ void ret_rope_frag(const bf16* row, const f32x2* cs, float scale, int g, s16x8 (&f)[2]) {
    const u32x2 a0 = *(const GAS u32x2*)(row + 4 * g), a1 = *(const GAS u32x2*)(row + 16 + 4 * g), b0 = *(const GAS u32x2*)(row + 32 + 4 * g), b1 = *(const GAS u32x2*)(row + 48 + 4 * g);
    const float x1[8] = {bflo(a0.x), bfhi(a0.x), bflo(a0.y), bfhi(a0.y), bflo(a1.x), bfhi(a1.x), bflo(a1.y), bfhi(a1.y)};
    const float x2[8] = {bflo(b0.x), bfhi(b0.x), bflo(b0.y), bfhi(b0.y), bflo(b1.x), bfhi(b1.x), bflo(b1.y), bfhi(b1.y)};
    float o1[8], o2[8];
#pragma unroll
    for (int j = 0; j < 8; ++j) { const f32x2 t = cs[(j < 4 ? 4 * g + j : 16 + 4 * g + (j - 4))]; o1[j] = (x1[j] * t.x - x2[j] * t.y) * scale; o2[j] = (x2[j] * t.x + x1[j] * t.y) * scale; }
    f[0] = __builtin_bit_cast(s16x8, pack8(o1)); f[1] = __builtin_bit_cast(s16x8, pack8(o2));
}
__device__ __forceinline__ s16x8 ret_bfrag(const LAS unsigned char* img, int row0, int eb, int g, int q, int p) {
    const int r1 = row0 + 4 * g + q;
    const LAS unsigned char* a1 = img + r1 * 256 + ((eb ^ (r1 & 7)) << 5) + 8 * p;
    const LAS unsigned char* a2 = img + (r1 + 16) * 256 + ((eb ^ ((r1 + 16) & 7)) << 5) + 8 * p;
    const s16x4 lo = tr16(a1), hi = tr16(a2);
    return (s16x8){lo[0], lo[1], lo[2], lo[3], hi[0], hi[1], hi[2], hi[3]};
}

__device__ __forceinline__ void ret_state_mfma(const Ctx& F) {
    const bf16* Z = (const bf16*)(F.ws + WS_Z); float* RS = (float*)(F.ws + WS_HDN);
    const f32x2* R64 = (const f32x2*)(F.ws + WS_ROPE64);
    LAS unsigned char* Kimg = F.lds; LAS unsigned char* Vimg = F.lds + 16384;
    const int lane = F.lane, g = lane >> 4, c = lane & 15, q = (lane >> 2) & 3, p = lane & 3;
    for (int u = blockIdx.x; u < NB * 32 * 4; u += F.G) {
        const int h = u & 3, ch = (u >> 2) & 31, b = u >> 7; const float l2g = ret_l2g(h);
        const bf16* base = Z + ((size_t)b * SEQ + ch * 128) * ZP;
        __syncthreads();
        for (int t = F.tid; t < 2048; t += 512) { const int r = t >> 4, c16 = t & 15;
            *(LAS v4u*)(Vimg + r * 256 + (((c16 >> 1) ^ (r & 7)) << 5) + ((c16 & 1) << 4)) = *(const GAS v4u*)(base + (size_t)r * ZP + Z_RV + h * 128 + c16 * 8); }
        for (int t = F.tid; t < 1024; t += 512) { const int j = t >> 3, dg = t & 7; const bf16* row = base + (size_t)j * ZP + Z_RK + h * 64;
            const u32x2 a = *(const GAS u32x2*)(row + 4 * dg), bb = *(const GAS u32x2*)(row + 32 + 4 * dg);
            const float x1[4] = {bflo(a.x), bfhi(a.x), bflo(a.y), bfhi(a.y)}, x2[4] = {bflo(bb.x), bfhi(bb.x), bflo(bb.y), bfhi(bb.y)};
            const f32x2* cs = R64 + (ch * 128 + j) * 32 + 4 * dg; const float sc = exp2f((float)(127 - j) * l2g);
            float o1[4], o2[4];
#pragma unroll
            for (int e = 0; e < 4; ++e) { const f32x2 tt = cs[e]; o1[e] = (x1[e] * tt.x - x2[e] * tt.y) * sc; o2[e] = (x2[e] * tt.x + x1[e] * tt.y) * sc; }
            u32x2 w1, w2; w1.x = pk2(o1[0], o1[1]); w1.y = pk2(o1[2], o1[3]); w2.x = pk2(o2[0], o2[1]); w2.y = pk2(o2[2], o2[3]);
            const int sw = (j >> 1) & 3; const int d1 = 4 * dg, d2 = 32 + 4 * dg;
            *(LAS u32x2*)(Kimg + j * 128 + ((((2 * d1) >> 5) ^ sw) << 5) + ((2 * d1) & 31)) = w1;
            *(LAS u32x2*)(Kimg + j * 128 + ((((2 * d2) >> 5) ^ sw) << 5) + ((2 * d2) & 31)) = w2; }
        __syncthreads();
        f32x4 acc[4];
#pragma unroll
        for (int db = 0; db < 4; ++db) acc[db] = (f32x4){0.f, 0.f, 0.f, 0.f};
#pragma unroll
        for (int s = 0; s < 4; ++s) {
            const s16x8 vb = ret_bfrag(Vimg, 32 * s, F.wave, g, q, p);
            const int r1 = 32 * s + 4 * g + q, sw = (r1 >> 1) & 3;
#pragma unroll
            for (int db = 0; db < 4; ++db) { const LAS unsigned char* a1 = Kimg + r1 * 128 + ((db ^ sw) << 5) + 8 * p;
                const s16x4 lo = tr16(a1), hi = tr16(a1 + 2048);
                const s16x8 ka = (s16x8){lo[0], lo[1], lo[2], lo[3], hi[0], hi[1], hi[2], hi[3]};
                acc[db] = __builtin_amdgcn_mfma_f32_16x16x32_bf16(ka, vb, acc[db], 0, 0, 0); }
        }
        float* o = RS + (size_t)u * 8192 + 16 * F.wave + c;
#pragma unroll
        for (int db = 0; db < 4; ++db)
#pragma unroll
            for (int r = 0; r < 4; ++r) o[(16 * db + 4 * g + r) * 128] = acc[db][r];
    }
    __syncthreads();
}

__device__ __forceinline__ void ret_scan(const Ctx& F) {
    const float* RS = (const float*)(F.ws + WS_HDN); float* SC = (float*)(F.ws + WS_HDN + 16 * MiB);
    for (int t = blockIdx.x * 512 + F.tid; t < NB * 4 * 8192; t += F.G * 512) {
        const int el = t & 8191, h = (t >> 13) & 3, b = t >> 15; const float wch = exp2f(128.f * ret_l2g(h)); float s = 0.f;
        for (int ch = 0; ch < 32; ++ch) { const size_t off = (size_t)(((b * 32 + ch) * 4 + h)) * 8192 + el; SC[off] = s; s = wch * s + RS[off]; }
    }
}

__device__ __forceinline__ void ret_out_mfma(const Ctx& F, const float* gn) {
    bf16* Z = (bf16*)(F.ws + WS_Z); const float* SC = (const float*)(F.ws + WS_HDN + 16 * MiB);
    const f32x2* R64 = (const f32x2*)(F.ws + WS_ROPE64);
    LAS unsigned char* Vimg = F.lds; LAS unsigned char* Simg = F.lds + 32768;
    const int lane = F.lane, g = lane >> 4, c = lane & 15, q = (lane >> 2) & 3, p = lane & 3, w = F.wave;
    for (int u = blockIdx.x; u < NB * 32 * 4; u += F.G) {
        const int h = u & 3, ch = (u >> 2) & 31, b = u >> 7; const float l2g = ret_l2g(h); const float gam = exp2f(l2g);
        bf16* base = Z + ((size_t)b * SEQ + ch * 128) * ZP;
        __syncthreads();
        for (int t = F.tid; t < 2048; t += 512) { const int r = t >> 4, c16 = t & 15;
            *(LAS v4u*)(Vimg + r * 256 + (((c16 >> 1) ^ (r & 7)) << 5) + ((c16 & 1) << 4)) = *(const GAS v4u*)(base + (size_t)r * ZP + Z_RV + h * 128 + c16 * 8); }
        for (int t = F.tid; t < 1024; t += 512) { const int r = t >> 4, c16 = t & 15; const float* sp = SC + (size_t)u * 8192 + r * 128 + c16 * 8;
            const f32x4 s0 = *(const GAS f32x4*)sp, s1 = *(const GAS f32x4*)(sp + 4);
            v4u wv; wv.x = pk2(s0.x * gam, s0.y * gam); wv.y = pk2(s0.z * gam, s0.w * gam); wv.z = pk2(s1.x * gam, s1.y * gam); wv.w = pk2(s1.z * gam, s1.w * gam);
            *(LAS v4u*)(Simg + r * 256 + (((c16 >> 1) ^ (r & 7)) << 5) + ((c16 & 1) << 4)) = wv; }
        const int i = 16 * w + c; s16x8 qf[2];
        ret_rope_frag(base + (size_t)i * ZP + Z_RQ + h * 64, R64 + (ch * 128 + i) * 32, 0.125f * exp2f((float)i * l2g), g, qf);
        f32x4 acc[8];
#pragma unroll
        for (int t = 0; t < 8; ++t) { acc[t] = (f32x4){0.f, 0.f, 0.f, 0.f};
            if (t <= w) { const int j = 16 * t + c; s16x8 kf[2];
                ret_rope_frag(base + (size_t)j * ZP + Z_RK + h * 64, R64 + (ch * 128 + j) * 32, exp2f(-(float)j * l2g), g, kf);
                acc[t] = __builtin_amdgcn_mfma_f32_16x16x32_bf16(kf[0], qf[0], acc[t], 0, 0, 0); acc[t] = __builtin_amdgcn_mfma_f32_16x16x32_bf16(kf[1], qf[1], acc[t], 0, 0, 0);
                if (t == w) {
#pragma unroll
                    for (int r = 0; r < 4; ++r) if (4 * g + r > c) acc[t][r] = 0.f; } } }
        s16x8 pf[4];
#pragma unroll
        for (int s = 0; s < 4; ++s) { v4u wv; wv.x = pk2(acc[2 * s][0], acc[2 * s][1]); wv.y = pk2(acc[2 * s][2], acc[2 * s][3]); wv.z = pk2(acc[2 * s + 1][0], acc[2 * s + 1][1]); wv.w = pk2(acc[2 * s + 1][2], acc[2 * s + 1][3]);
            pf[s] = __builtin_bit_cast(s16x8, wv); }
        __syncthreads();
        f32x4 o[8];
#pragma unroll
        for (int eb = 0; eb < 8; ++eb) o[eb] = (f32x4){0.f, 0.f, 0.f, 0.f};
#pragma unroll
        for (int s = 0; s < 4; ++s) if (2 * s <= w) {
#pragma unroll
            for (int eb = 0; eb < 8; ++eb) o[eb] = __builtin_amdgcn_mfma_f32_16x16x32_bf16(pf[s], ret_bfrag(Vimg, 32 * s, eb, g, q, p), o[eb], 0, 0, 0); }
#pragma unroll
        for (int ks = 0; ks < 2; ++ks)
#pragma unroll
            for (int eb = 0; eb < 8; ++eb) o[eb] = __builtin_amdgcn_mfma_f32_16x16x32_bf16(qf[ks], ret_bfrag(Simg, 32 * ks, eb, g, q, p), o[eb], 0, 0, 0);
        float rs[4];
#pragma unroll
        for (int r = 0; r < 4; ++r) { float ss = 0.f;
#pragma unroll
            for (int eb = 0; eb < 8; ++eb) ss += o[eb][r] * o[eb][r];
            ss += sx<1>(ss); ss += sx<2>(ss); ss += sx<4>(ss); ss += sx<8>(ss);
            rs[r] = 1.0f / sqrtf(ss * (1.f / 128) + NORM_EPS); }
#pragma unroll
        for (int r = 0; r < 4; ++r) { bf16* zr = base + (size_t)(16 * w + 4 * g + r) * ZP;
#pragma unroll
            for (int eb = 0; eb < 8; ++eb) { const int e = 16 * eb + c; const float rg = bf2f(zr[Z_RG + h * 128 + e]);
                zr[Z_RV + h * 128 + e] = (bf16)f2bf(o[eb][r] * rs[r] * gn[h * 128 + e] * rg * sigmoid_f(rg)); } }
    }
    __syncthreads();
}

__device__ __forceinline__ void fscan_phase(const Ctx& F) {
    const float* LF = (const float*)(F.ws + WS_LF); float* CF = (float*)(F.ws + WS_CF);
    if (F.gw < 32) {
        const int b = F.gw >> 3, h = F.gw & 7; const float* lp = LF + ((size_t)b * SEQ + F.lane * 64) * 8 + h; float s = 0.f;
        for (int i = 0; i < 64; ++i) s += lp[i * 8];
        float incl = s;
#pragma unroll
        for (int o = 1; o < 64; o <<= 1) { const float t = __builtin_bit_cast(float, __builtin_amdgcn_ds_bpermute(((F.lane - o) & 63) << 2, __builtin_bit_cast(int, incl))); if (F.lane >= o) incl += t; }
        float run = incl - s; float* cp = CF + (size_t)F.gw * SEQ + F.lane * 64;
        for (int i = 0; i < 64; ++i) { run += lp[i * 8]; cp[i] = run; }
    }
}
#include <hip/hip_bf16.h>
#include <cmath>
namespace attn_body {
using bf16=__hip_bfloat16;
using bf16x8=__attribute__((ext_vector_type(8)))short;
using s16x4=__attribute__((ext_vector_type(4)))short;
using f32x16=__attribute__((ext_vector_type(16)))float;
using u32x4=__attribute__((ext_vector_type(4)))unsigned;
constexpr int BATCH=4,NHEAD=8,SEQ=4096,D=64,DM=6656;
constexpr int NW=8,QBLK=32,QB=QBLK*NW,KVBLK=64,NQB=SEQ/QB;
constexpr int ATTN_PITCH=DM, ATTN_UNIT_ROWS=QB;
__device__ __forceinline__ int crow(int r,int hi){return (r&3)+8*(r>>2)+4*hi;}
#define SBAR() __builtin_amdgcn_sched_barrier(0)
__device__ __forceinline__ void cmask(f32x16&p0,f32x16&p1,int jb,int qrel,int hi){
  const float NEG=-INFINITY; int kb=64*jb+4*hi;
  #pragma unroll
  for(int r=0;r<16;++r){int kv=kb+(r&3)+8*(r>>2); if(kv>qrel)p0[r]=NEG; if(kv+32>qrel)p1[r]=NEG;}
}

constexpr int NSLOT=3, SLOTB=8192;
constexpr int LDS_K=0, LDS_V=NSLOT*SLOTB, LDS_WS=2*NSLOT*SLOTB, LDS_OST=LDS_WS+NW*64*4, LDS_NC=LDS_OST+NW*4096, LDS_BYTES=LDS_NC+SEQ*4;
constexpr float C2=0.125f*1.4426950408889634f;
__device__ __forceinline__ void glds16(const void*gsrc,unsigned lds_dst){unsigned keep;
  asm volatile("s_mov_b32 %0, m0\n\ts_mov_b32 m0, %2\n\ts_nop 0\n\tglobal_load_lds_dwordx4 %1, off\n\ts_mov_b32 m0, %0":"=&s"(keep):"v"(gsrc),"s"(lds_dst):"memory");}
__device__ __forceinline__ float max3f(float a,float b,float c){float r;asm("v_max3_f32 %0, %1, %2, %3":"=v"(r):"v"(a),"v"(b),"v"(c));return r;}
__device__ __forceinline__ float max2f(float a,float b){float r;asm("v_max_f32_e32 %0, %1, %2":"=v"(r):"v"(a),"v"(b));return r;}
__device__ __forceinline__ float fadd_s(float a,float b){float r;asm("v_add_f32_e32 %0, %1, %2":"=v"(r):"v"(a),"v"(b));return r;}
__device__ __forceinline__ float fsub_s(float a,float b){float r;asm("v_sub_f32_e32 %0, %1, %2":"=v"(r):"v"(a),"v"(b));return r;}
typedef float f32x4_t __attribute__((ext_vector_type(4))); typedef float f32x2_t __attribute__((ext_vector_type(2))); typedef __bf16 bf16x2_t __attribute__((ext_vector_type(2)));
__device__ __forceinline__ unsigned cvtpk_s(float lo,float hi){f32x2_t v={lo,hi};bf16x2_t b=__builtin_convertvector(v,bf16x2_t);return __builtin_bit_cast(unsigned,b);}
#define WAIT_BAR(N) asm volatile("s_waitcnt vmcnt(" #N ") lgkmcnt(0)\n\ts_barrier":::"memory")

__device__ __forceinline__ void qkt(f32x16&p0,f32x16&p1,const char*Kslot,const bf16x8*qr,const f32x16&negm,int r32,int hi){
  const char*kb=Kslot+hi*1024+r32*16;
  #pragma unroll
  for(int d0=0;d0<4;++d0){
    const bf16x8 b0=*reinterpret_cast<const bf16x8*>(kb+d0*2048);
    const bf16x8 b1=*reinterpret_cast<const bf16x8*>(kb+d0*2048+512);
    if(d0==0){p0=__builtin_amdgcn_mfma_f32_32x32x16_bf16(b0,qr[0],negm,0,0,0);p1=__builtin_amdgcn_mfma_f32_32x32x16_bf16(b1,qr[0],negm,0,0,0);}
    else{p0=__builtin_amdgcn_mfma_f32_32x32x16_bf16(b0,qr[d0],p0,0,0,0);p1=__builtin_amdgcn_mfma_f32_32x32x16_bf16(b1,qr[d0],p1,0,0,0);}}
}
typedef __attribute__((address_space(3))) const char* lds_cptr;
typedef short v4i16_t __attribute__((ext_vector_type(4)));
__device__ __forceinline__ void kload8(bf16x8*kf,lds_cptr kp){
  kf[0]=*(const __attribute__((address_space(3))) bf16x8*)(kp);      kf[1]=*(const __attribute__((address_space(3))) bf16x8*)(kp+512);
  kf[2]=*(const __attribute__((address_space(3))) bf16x8*)(kp+2048); kf[3]=*(const __attribute__((address_space(3))) bf16x8*)(kp+2560);
  kf[4]=*(const __attribute__((address_space(3))) bf16x8*)(kp+4096); kf[5]=*(const __attribute__((address_space(3))) bf16x8*)(kp+4608);
  kf[6]=*(const __attribute__((address_space(3))) bf16x8*)(kp+6144); kf[7]=*(const __attribute__((address_space(3))) bf16x8*)(kp+6656);
}
__device__ __forceinline__ void kload2(bf16x8*kf,lds_cptr kp,int j){ kf[2*j]=*(const __attribute__((address_space(3))) bf16x8*)(kp+j*2048); kf[2*j+1]=*(const __attribute__((address_space(3))) bf16x8*)(kp+j*2048+512); }
__device__ __forceinline__ s16x4 vtr(lds_cptr p){ return __builtin_bit_cast(s16x4,__builtin_amdgcn_ds_read_tr16_b64_v4i16((__attribute__((address_space(3))) v4i16_t*)p)); }
__device__ __forceinline__ float rowmax(const f32x16&p0,const f32x16&p1){
  float a=max3f(p0[0],p0[1],p1[0]),b=max3f(p0[2],p0[3],p1[1]);a=max3f(a,p1[2],p1[3]);
  #pragma unroll
  for(int r=4;r<16;r+=4){a=max3f(a,p0[r],p0[r+1]);b=max3f(b,p0[r+2],p0[r+3]);a=max3f(a,p1[r],p1[r+1]);b=max3f(b,p1[r+2],p1[r+3]);}
  const float m=max2f(a,b);
  auto rr=__builtin_amdgcn_permlane32_swap(__float_as_uint(m),__float_as_uint(m),false,false);
  return max2f(__uint_as_float(rr[0]),__uint_as_float(rr[1]));
}
__device__ __forceinline__ void pv(f32x16*o,int vb,bf16x8 pa0,bf16x8 pa1,bf16x8 pa2,bf16x8 pa3){
  #pragma unroll
  for(int d0=0;d0<2;++d0){s16x4 lo[4],hi[4];
    #pragma unroll
    for(int ks=0;ks<4;++ks){
      asm volatile("ds_read_b64_tr_b16 %0,%1 offset:%c2":"=&v"(lo[ks]):"v"(vb),"i"(d0*4096+ks*1024):"memory");
      asm volatile("ds_read_b64_tr_b16 %0,%1 offset:%c2":"=&v"(hi[ks]):"v"(vb),"i"(d0*4096+ks*1024+512):"memory");}
    asm volatile("s_waitcnt lgkmcnt(0)":::"memory");SBAR();
    #define PK(k) (bf16x8){lo[k][0],lo[k][1],lo[k][2],lo[k][3],hi[k][0],hi[k][1],hi[k][2],hi[k][3]}
    o[d0]=__builtin_amdgcn_mfma_f32_32x32x16_bf16(pa0,PK(0),o[d0],0,0,0);
    o[d0]=__builtin_amdgcn_mfma_f32_32x32x16_bf16(pa1,PK(1),o[d0],0,0,0);
    o[d0]=__builtin_amdgcn_mfma_f32_32x32x16_bf16(pa2,PK(2),o[d0],0,0,0);
    o[d0]=__builtin_amdgcn_mfma_f32_32x32x16_bf16(pa3,PK(3),o[d0],0,0,0);
    #undef PK
  }
}

#ifndef ATTN_STORE16
#define ATTN_STORE16(p,v) (*(u32x4*)(p)=(v))
#endif
template<int THRL> __device__ __forceinline__ void attn_unit(int b,int h,int qb,const bf16*Q,const bf16*__restrict__ K,const bf16*__restrict__ V,bf16*O,const float*CF,char*shm,int wave_id){
  int tid_=(wave_id<<6)|lane_id_v(); asm volatile("":"+v"(tid_));
  const int tid=tid_,lane=tid&63,r32=lane&31,hi=lane>>5; const int wid=__builtin_amdgcn_readfirstlane(tid>>6);
  const long rowbase=(long)b*SEQ; const int q0=qb*QB;
  const bf16*Qw=Q+(rowbase+q0+wid*QBLK)*DM+h*D;
  const bf16*Kh=K+rowbase*DM+h*D,*Vh=V+rowbase*DM+h*D;
  const unsigned lds0=(unsigned)(uintptr_t)shm;
  float*wsf=(float*)(shm+LDS_WS)+wid*64;
  const bf16*ksrc=Kh+(long)lane*DM+wid*8;
  const bf16*vsrc=Vh+(long)(16*(wid&3)+(lane>>2))*DM+(wid>>2)*32+(lane&3)*8;
  const unsigned kdst=lds0+LDS_K+wid*1024, vdst=lds0+LDS_V+wid*1024;
  #define DMA_K(t,slot) glds16(ksrc+(long)(t)*KVBLK*DM,(unsigned)__builtin_amdgcn_readfirstlane(kdst+(slot)))
  #define DMA_V(t,slot) glds16(vsrc+(long)(t)*KVBLK*DM,(unsigned)__builtin_amdgcn_readfirstlane(vdst+(slot)))
  const char*Kbase=shm+LDS_K; bf16x8 kf[8];
  const lds_cptr shm3=(lds_cptr)shm; const lds_cptr kp0=shm3+LDS_K+hi*1024+r32*16; const lds_cptr vp0=shm3+LDS_V+((lane>>4)&1)*32+(lane&3)*8+(4*hi+((lane&15)>>2))*64;
  const int NT=(q0+QB)/KVBLK;
  { const float*cfp=CF+(long)(b*NHEAD+h)*SEQ; float*ncw=(float*)(shm+LDS_NC);
    for(int i=tid;i<q0+QB;i+=NW*64)ncw[i]=-cfp[i]; }
  const lds_cptr ncp=(lds_cptr)shm+LDS_NC+hi*16;
  #define ADDC(P0,P1,t) do{ const lds_cptr np_=ncp+(t)*256; _Pragma("unroll") for(int g_=0;g_<4;++g_){ \
      const f32x4_t a_=*(const __attribute__((address_space(3))) f32x4_t*)(np_+g_*32), b_=*(const __attribute__((address_space(3))) f32x4_t*)(np_+g_*32+128); \
      P0[4*g_]+=a_[0];P0[4*g_+1]+=a_[1];P0[4*g_+2]+=a_[2];P0[4*g_+3]+=a_[3]; P1[4*g_]+=b_[0];P1[4*g_+1]+=b_[1];P1[4*g_+2]+=b_[2];P1[4*g_+3]+=b_[3]; } }while(0)
  DMA_K(0,0);DMA_V(0,0);DMA_K(1,SLOTB);
  bf16x8 qr[4];
  #pragma unroll
  for(int d0=0;d0<4;++d0)qr[d0]=*reinterpret_cast<const bf16x8*>(&Qw[(long)r32*DM+d0*16+hi*8]);
  float mhat=0.f,l_reg=0.f;f32x16 o[2];f32x16 negm; { float zz_; asm volatile("v_mov_b32 %0, 0":"=v"(zz_));
    _Pragma("unroll") for(int r=0;r<16;++r){o[0][r]=zz_;o[1][r]=zz_;negm[r]=zz_;} } asm volatile("":"+v"(negm));
  const int qrel=wid*QBLK+r32;
  #define CMASK(P0,P1,t) do{int jb_=(t)-(NT-4); if(jb_>=0)cmask(P0,P1,jb_,qrel,hi);}while(0)
  bool resc=false;
  #define START(P0,P1) do{ const float rm=rowmax(P0,P1); resc=false; \
    { const float dl=rm; mhat=fadd_s(mhat,dl); \
      _Pragma("unroll") for(int r=0;r<16;++r){P0[r]=fsub_s(P0[r],dl);P1[r]=fsub_s(P1[r],dl);} \
      _Pragma("unroll") for(int r=0;r<16;++r)negm[r]=-mhat; asm volatile("":"+v"(negm)); } \
    _Pragma("unroll") for(int r=0;r<16;++r)P0[r]=__builtin_amdgcn_exp2f(P0[r]); }while(0)
  #define RESC() do{ if(resc){ asm volatile("s_waitcnt lgkmcnt(0)":::"memory"); \
      _Pragma("unroll") for(int d_=0;d_<2;++d_) _Pragma("unroll") for(int r=0;r<16;++r)o[d_][r]*=wsf[crow(r,hi)]; } }while(0)
  f32x16 pA0,pA1,pB0,pB1;
  int sl_prev=0,sl_cur=0,sl_next=SLOTB;
  #define ROT() do{sl_prev=sl_cur;sl_cur=sl_next;sl_next=(sl_next==(NSLOT-1)*SLOTB)?0:sl_next+SLOTB;}while(0)
  DMA_K(2,2*SLOTB);
  WAIT_BAR(3);
  qkt(pA0,pA1,Kbase,qr,negm,r32,hi);asm volatile("s_nop 15\n\ts_nop 7":"+v"(pA0),"+v"(pA1));ADDC(pA0,pA1,0);CMASK(pA0,pA1,0);
  START(pA0,pA1);
  _Pragma("unroll") for(int r=0;r<16;++r)pA1[r]=__builtin_amdgcn_exp2f(pA1[r]);
  WAIT_BAR(0);
  DMA_K(3,0);DMA_V(1,SLOTB);
  ROT();
  kload8(kf,kp0+sl_cur);
  WAIT_BAR(2);
  s16x4 vlo[8],vhi[8]; u32x4 pw0,pw1,pw2,pw3;
  #define PKW(P,B) cvtpk_s(P[B],P[B+1])
  #define PAF(k) __builtin_bit_cast(bf16x8,pw##k)
  #define VFR(i) (bf16x8){vlo[i][0],vlo[i][1],vlo[i][2],vlo[i][3],vhi[i][0],vhi[i][1],vhi[i][2],vhi[i][3]}
  #define PIN(x) asm volatile("":"+v"(x))
  #define MX3(a,b,c) __builtin_fmaxf(__builtin_fmaxf((a),(b)),(c))
  #define GAPA(MF,A0,A1,A2,A3,W0,W1,PW) do{ MF; sacc+=A0; sacc+=A1; sacc+=A2; sacc+=A3; PIN(sacc); W0; W1; PIN(PW); SBAR(); }while(0)
  #define EX(v) __builtin_amdgcn_exp2f(v)
  #define GAPB(MF,X,B) do{ MF; X[B]=EX(X[B]); X[B+1]=EX(X[B+1]); X[B+2]=EX(X[B+2]); X[B+3]=EX(X[B+3]); PIN(X); SBAR(); }while(0)
  #define VRD(i) do{ vlo[i]=vtr(vp_+(((i)>>2)*4096+((i)&3)*1024)); vhi[i]=vtr(vp_+(((i)>>2)*4096+((i)&3)*1024+512)); }while(0)
  #define KRD(G,j) do{ if(G){ kload2(kf,kp0+sl_next,j); SBAR(); } }while(0)
  #define STEP(C0,C1,P0,P1,t,GK,GV,GL) do{ SBAR(); \
    const lds_cptr vp_=vp0+sl_prev; \
    VRD(0); SBAR(); float sacc=(P0[0]+P0[1]); \
    GAPA(C0=__builtin_amdgcn_mfma_f32_32x32x16_bf16(kf[0],qr[0],negm,0,0,0), P0[2],P0[3],P0[4],P0[5],     pw0[0]=PKW(P0,0), pw0[1]=PKW(P0,2), pw0); \
    VRD(4); SBAR(); GAPA(C1=__builtin_amdgcn_mfma_f32_32x32x16_bf16(kf[1],qr[0],negm,0,0,0), P0[6],P0[7],P0[8],P0[9],     pw0[2]=PKW(P0,4), pw0[3]=PKW(P0,6), pw0); \
    VRD(1); SBAR(); GAPA(C0=__builtin_amdgcn_mfma_f32_32x32x16_bf16(kf[2],qr[1],C0,0,0,0),   P0[10],P0[11],P0[12],P0[13], pw1[0]=PKW(P0,8), pw1[1]=PKW(P0,10), pw1); \
    VRD(5); SBAR(); GAPA(C1=__builtin_amdgcn_mfma_f32_32x32x16_bf16(kf[3],qr[1],C1,0,0,0),   P0[14],P0[15],P1[0],P1[1],   pw1[2]=PKW(P0,12),pw1[3]=PKW(P0,14), pw1); \
    VRD(2); SBAR(); GAPA(C0=__builtin_amdgcn_mfma_f32_32x32x16_bf16(kf[4],qr[2],C0,0,0,0),   P1[2],P1[3],P1[4],P1[5],     pw2[0]=PKW(P1,0), pw2[1]=PKW(P1,2), pw2); \
    VRD(6); SBAR(); GAPA(C1=__builtin_amdgcn_mfma_f32_32x32x16_bf16(kf[5],qr[2],C1,0,0,0),   P1[6],P1[7],P1[8],P1[9],     pw2[2]=PKW(P1,4), pw2[3]=PKW(P1,6), pw2); \
    VRD(3); SBAR(); GAPA(C0=__builtin_amdgcn_mfma_f32_32x32x16_bf16(kf[6],qr[3],C0,0,0,0),   P1[10],P1[11],P1[12],P1[13], pw3[0]=PKW(P1,8), pw3[1]=PKW(P1,10), pw3); \
    VRD(7); SBAR(); GAPA(C1=__builtin_amdgcn_mfma_f32_32x32x16_bf16(kf[7],qr[3],C1,0,0,0),   P1[14],P1[15],0.f,0.f,       pw3[2]=PKW(P1,12),pw3[3]=PKW(P1,14), pw3); \
    l_reg+=sacc; \
    if(GK){DMA_K((t)+3,sl_cur);} if(GV){DMA_V((t)+1,sl_next);} \
    ADDC(C0,C1,t); CMASK(C0,C1,t); \
    { float a=MX3(C0[0],C0[1],C1[0]),b=MX3(C0[2],C0[3],C1[1]); a=MX3(a,C1[2],C1[3]); \
      _Pragma("unroll") for(int r=4;r<16;r+=4){a=MX3(a,C0[r],C0[r+1]);b=MX3(b,C0[r+2],C0[r+3]);a=MX3(a,C1[r],C1[r+1]);b=MX3(b,C1[r+2],C1[r+3]);} \
      float rm=__builtin_fmaxf(a,b); { auto rr=__builtin_amdgcn_permlane32_swap(__float_as_uint(rm),__float_as_uint(rm),false,false); rm=__builtin_fmaxf(__uint_as_float(rr[0]),__uint_as_float(rr[1])); } \
      resc=false; \
      if(__builtin_expect(__any(rm>(float)THRL),0)){ const float dl=__builtin_fmaxf(rm,0.f); mhat+=dl; \
        _Pragma("unroll") for(int r=0;r<16;++r){C0[r]-=dl;C1[r]-=dl;} \
        _Pragma("unroll") for(int r=0;r<16;++r)negm[r]=-mhat; asm volatile("":"+v"(negm)); \
        const float f=__builtin_amdgcn_exp2f(-dl); l_reg*=f; if(hi==0)wsf[r32]=f; resc=true; } } \
    SBAR(); \
    GAPB(o[0]=__builtin_amdgcn_mfma_f32_32x32x16_bf16(PAF(0),VFR(0),o[0],0,0,0), C0,0); \
    GAPB(o[1]=__builtin_amdgcn_mfma_f32_32x32x16_bf16(PAF(0),VFR(4),o[1],0,0,0), C0,4); \
    KRD(GL,0); GAPB(o[0]=__builtin_amdgcn_mfma_f32_32x32x16_bf16(PAF(1),VFR(1),o[0],0,0,0), C0,8); \
    KRD(GL,1); GAPB(o[1]=__builtin_amdgcn_mfma_f32_32x32x16_bf16(PAF(1),VFR(5),o[1],0,0,0), C0,12); \
    KRD(GL,2); GAPB(o[0]=__builtin_amdgcn_mfma_f32_32x32x16_bf16(PAF(2),VFR(2),o[0],0,0,0), C1,0); \
    KRD(GL,3); GAPB(o[1]=__builtin_amdgcn_mfma_f32_32x32x16_bf16(PAF(2),VFR(6),o[1],0,0,0), C1,4); \
    GAPB(o[0]=__builtin_amdgcn_mfma_f32_32x32x16_bf16(PAF(3),VFR(3),o[0],0,0,0), C1,8); \
    GAPB(o[1]=__builtin_amdgcn_mfma_f32_32x32x16_bf16(PAF(3),VFR(7),o[1],0,0,0), C1,12); \
    }while(0)
  int t=1;
  #undef CMASK
  #define CMASK(P0,P1,t) do{}while(0)
  for(;t+5<NT;t+=2){
    STEP(pB0,pB1,pA0,pA1,t,true,true,true);     WAIT_BAR(2); RESC(); ROT();
    STEP(pA0,pA1,pB0,pB1,t+1,true,true,true);   WAIT_BAR(2); RESC(); ROT();
  }
  #undef CMASK
  #define CMASK(P0,P1,t) do{int jb_=(t)-(NT-4); if(jb_>=0)cmask(P0,P1,jb_,qrel,hi);}while(0)
  #define ENDW(tt) do{ if((tt)+3<NT){WAIT_BAR(2);} else if((tt)+2<NT){WAIT_BAR(1);} else {WAIT_BAR(0);} }while(0)
  for(;t+1<NT;t+=2){
    STEP(pB0,pB1,pA0,pA1,t,(t+3<NT),(t+1<NT),(t+1<NT));       ENDW(t);   RESC(); ROT();
    STEP(pA0,pA1,pB0,pB1,t+1,(t+4<NT),(t+2<NT),(t+2<NT));     ENDW(t+1); RESC(); ROT();
  }
  STEP(pB0,pB1,pA0,pA1,NT-1,false,false,false); RESC();
  { float sacc=pB0[0]+pB0[1]; _Pragma("unroll") for(int r=2;r<16;++r)sacc+=pB0[r]; _Pragma("unroll") for(int r=0;r<16;++r)sacc+=pB1[r]; l_reg+=sacc;
    pw0=(u32x4){PKW(pB0,0),PKW(pB0,2),PKW(pB0,4),PKW(pB0,6)};pw1=(u32x4){PKW(pB0,8),PKW(pB0,10),PKW(pB0,12),PKW(pB0,14)};pw2=(u32x4){PKW(pB1,0),PKW(pB1,2),PKW(pB1,4),PKW(pB1,6)};pw3=(u32x4){PKW(pB1,8),PKW(pB1,10),PKW(pB1,12),PKW(pB1,14)};
    int tl_=lane_id_v(); asm volatile("":"+v"(tl_)); const int ln_=tl_&63,hi_=ln_>>5; const int vb0e=(int)(lds0+LDS_V)+((ln_>>4)&1)*32+(ln_&3)*8+(4*hi_+((ln_&15)>>2))*64;
    SBAR(); pv(o,vb0e+sl_cur,PAF(0),PAF(1),PAF(2),PAF(3)); }
  #undef PKW
  #undef PAF
  #undef VFR
  #undef PIN
  #undef MX3
  #undef GAPA
  #undef GAPB
  #undef EX
  #undef VRD
  #undef KRD
  #undef STEP
  #undef ENDW
  {auto rr=__builtin_amdgcn_permlane32_swap(__float_as_uint(l_reg),__float_as_uint(l_reg),false,false);l_reg=__uint_as_float(rr[0])+__uint_as_float(rr[1]);}
  int te_=lane_id_v(); asm volatile("":"+v"(te_)); const int lane_e=te_&63,r32_e=lane_e&31,hi_e=lane_e>>5;
  if(hi_e==0)wsf[32+r32_e]=l_reg;asm volatile("s_waitcnt lgkmcnt(0)":::"memory");
  float rli[16];
  #pragma unroll
  for(int r=0;r<16;++r)rli[r]=__builtin_amdgcn_rcpf(wsf[32+crow(r,hi_e)]);
  bf16*Ow=O+(rowbase+q0+wid*QBLK)*DM+h*D;
  { bf16*stg=(bf16*)(shm+LDS_OST)+wid*2048;
    #pragma unroll
    for(int r=0;r<16;++r){const int orow=crow(r,hi_e);
      #pragma unroll
      for(int d0=0;d0<2;++d0)stg[orow*64+d0*32+r32_e]=__float2bfloat16(o[d0][r]*rli[r]);}
    asm volatile("s_waitcnt lgkmcnt(0)":::"memory");
    #pragma unroll
    for(int i=0;i<4;++i){const int row=i*8+(lane_e>>3),ch=lane_e&7; const u32x4 v=*(const u32x4*)(stg+row*64+ch*8); ATTN_STORE16(Ow+(long)row*DM+ch*8,v);} }
  asm volatile("s_waitcnt lgkmcnt(0)\n\ts_barrier":::"memory");
  #undef ADDC
  #undef DMA_K
  #undef DMA_V
  #undef CMASK
  #undef START
  #undef RESC
  #undef ROT
}
constexpr int ATTN_LDS_BYTES=LDS_BYTES;
struct AttnTensors { const bf16* Q; const bf16* K; const bf16* V; bf16* O; const float* CF; };
struct AttnUnit { int bh; int qb; };
struct StaticOrder {
  int vcu;
  __device__ __forceinline__ explicit StaticOrder(int grid,int block):vcu((block%8)*(grid/8)+block/8){}
  __device__ __forceinline__ bool next(int i,AttnUnit&u)const{ if(i>=2)return false; const int s=vcu&7; u.bh=vcu>>3; u.qb=(i==0)?s:15-s; return true; }
  __device__ __forceinline__ void a_ready(const AttnUnit&)const{}
  __device__ __forceinline__ void done(const AttnUnit&)const{}
};
template<class Sched,int THRL=8> __device__ __forceinline__ void attn_phase(char*lds,const AttnTensors&T,const Sched&S,int wave_id){
  AttnUnit u;
  for(int i=0;S.next(i,u);++i){ S.a_ready(u); attn_unit<THRL>(u.bh/NHEAD,u.bh%NHEAD,u.qb,T.Q,T.K,T.V,T.O,T.CF,lds,wave_id); S.done(u); }
}
#undef SBAR
#undef WAIT_BAR
}

struct Args { const float* in[16]; float* out; unsigned char* ws; };
__global__ void __launch_bounds__(NWAVES * 64, 2) hyb_fwd(Args args) {
    extern __shared__ __attribute__((aligned(16))) unsigned char lds[];
    Ctx F;
    F.lds = (LAS unsigned char*)lds;
    F.tid = threadIdx.x; F.lane = F.tid & 63; F.wave = __builtin_amdgcn_readfirstlane(F.tid >> 6);
    F.G = gridDim.x; F.gw = blockIdx.x * NWAVES + F.wave; F.NGW = F.G * NWAVES;
    F.out = args.out; F.ws = args.ws;
    volatile LAS unsigned* MISC = (volatile LAS unsigned*)(F.lds + MISC_OFF);
    for (int u = F.tid; u < (LDS_BYTES - LDSCTL_OFF) / 4; u += NWAVES * 64) ((LAS unsigned*)(F.lds + LDSCTL_OFF))[u] = 0u;
    __syncthreads();
    gu32* ctl = (gu32*)(F.ws + WS_CTL);
    XcdBarrier bar = xcd_barrier_post((unsigned*)(ctl + CW_BAR), MISC + 8); bar.w = F.wave;
#define FRESH(P) Ctx P = F; P.tid = (F.wave << 6) | lane_id_v(); asm volatile("" : "+v"(P.tid), "+s"(P.wave), "+s"(P.gw), "+s"(P.ws), "+s"(P.out)); P.lane = P.tid & 63
#define GRID_BAR() do { XcdBarrier b_ = bar; asm volatile("" : "+s"(b_.bar), "+s"(b_.x)); xcd_barrier(b_); } while (0)

    bf16* Wb = (bf16*)(F.ws + WS_W);
    bf16* Z = (bf16*)(F.ws + WS_Z); float* ZS = (float*)(F.ws + WS_ZS); bf16* HDN = (bf16*)(F.ws + WS_HDN);
    float* M32 = (float*)(F.ws + WS_HDN); bf16* HB = (bf16*)(F.ws + WS_Z);
    LAS unsigned char* ring = F.lds + RING_OFF;

    { FRESH(P); p0_prologue(P, args.in[2], args.in[9], args.in[10], args.in[11], args.in[12], args.in[14], args.in[15]); }
    GRID_BAR();

    #pragma unroll 1
    for (int layer = 0; layer < DEPTH; ++layer) {
        const float* xin = (layer == 0) ? args.in[0] : F.out;
        const bf16* L = Wb + (size_t)layer * LW_STRIDE;
        { FRESH(P); rmsnorm_phase(P, xin, args.in[1] + layer * DM, (bf16*)(P.ws + WS_HDN)); }
        GRID_BAR();
        { pg8::Gemm g{HDN, L + LW_IN, M, NIN, DM, DM, DM}; pg8::StaticOrder S; S.init(M, NIN, F.G, (int)blockIdx.x);
          pg8::EpiZ E{Z, ZS};
          pg8::gemm_phase<pg8::EpiZ, pg8::StaticOrder, true, true>(ring, g, S, E, F.wave); }
        GRID_BAR();
        { FRESH(P); post_phase(P, args.in[4] + layer * 64, args.in[5] + layer * 64, args.in[6] + layer * 64, args.in[7] + layer * 64, args.in[3] + layer * 8); }
        { FRESH(P); ret_state_mfma(P); }
        GRID_BAR();
        { FRESH(P); fscan_phase(P); }
        { FRESH(P); ret_scan(P); }
        GRID_BAR();
        { FRESH(P); ret_out_mfma(P, args.in[8] + layer * 512); }
#ifdef PROBE_X3
        for (int rep_ = 0; rep_ < 2; ++rep_)
        { static_assert(attn_body::ATTN_LDS_BYTES <= RING_BYTES, "attention scratch fits the ring region");
          unsigned char* wsl = F.ws; asm volatile("" : "+s"(wsl));
          bf16* Zl = (bf16*)(wsl + WS_Z);
          const attn_body::AttnTensors AT{(const attn_body::bf16*)(Zl + Z_FQ), (const attn_body::bf16*)(Zl + Z_FK), (const attn_body::bf16*)(Zl + Z_FV), (attn_body::bf16*)(Zl + (rep_ == 0 ? Z_RQ : Z_FQ)), (const float*)(wsl + WS_CF)};
          const attn_body::StaticOrder S((int)F.G, (int)blockIdx.x);
          attn_body::attn_phase<attn_body::StaticOrder>((char*)lds + RING_OFF, AT, S, F.wave); }
#ifdef PROBE_X4
        { FRESH(P); dsa_v3(P); }
#else
        for (int rep_ = 0; rep_ < 2; ++rep_) { FRESH(P); dsa_v3(P, rep_ == 0 ? Z_RG : Z_DQ); }
#endif
#else
        { static_assert(attn_body::ATTN_LDS_BYTES <= RING_BYTES, "attention scratch fits the ring region");
          unsigned char* wsl = F.ws; asm volatile("" : "+s"(wsl));
          bf16* Zl = (bf16*)(wsl + WS_Z);
          const attn_body::AttnTensors AT{(const attn_body::bf16*)(Zl + Z_FQ), (const attn_body::bf16*)(Zl + Z_FK), (const attn_body::bf16*)(Zl + Z_FV), (attn_body::bf16*)(Zl + Z_FQ), (const float*)(wsl + WS_CF)};
          const attn_body::StaticOrder S((int)F.G, (int)blockIdx.x);
          attn_body::attn_phase<attn_body::StaticOrder>((char*)lds + RING_OFF, AT, S, F.wave); }
        { FRESH(P); dsa_v3(P); }
#endif
        GRID_BAR();
        { pg8::StaticOrder S; S.init(M, DM, F.G, (int)blockIdx.x);
          { pg8::Gemm g{Z + Z_FQ, L + LW_MIX, M, DM, 512, ZP, 512}; pg8::EpiGate<0> E{Z + Z_ZG, M32, Z + Z_MRG};
            pg8::gemm_phase<pg8::EpiGate<0>, pg8::StaticOrder, false, true>(ring, g, S, E, F.wave); }
          { pg8::Gemm g{Z + Z_DQ, L + LW_MIX + 512 * 1024, M, DM, 512, ZP, 512}; pg8::EpiGate<1> E{Z + Z_ZG, M32, Z + Z_MRG};
            pg8::gemm_phase<pg8::EpiGate<1>, pg8::StaticOrder, false, true>(ring, g, S, E, F.wave); }
          { pg8::Gemm g{Z + Z_RV, L + LW_MIX + 1024 * 1024, M, DM, 512, ZP, 512}; pg8::EpiGate<2> E{Z + Z_ZG, M32, Z + Z_MRG};
            pg8::gemm_phase<pg8::EpiGate<2>, pg8::StaticOrder, false, true>(ring, g, S, E, F.wave); } }
        GRID_BAR();
        { pg8::Gemm g{Z + Z_MRG, L + LW_O, M, DM, DM, ZP, DM}; pg8::StaticOrder S; S.init(M, DM, F.G, (int)blockIdx.x);
          pg8::EpiRes E{xin, F.out};
          pg8::gemm_phase<pg8::EpiRes, pg8::StaticOrder, false, true>(ring, g, S, E, F.wave); }
        GRID_BAR();
        { FRESH(P); rmsnorm_phase(P, P.out, args.in[13] + layer * DM, (bf16*)(P.ws + WS_HDN)); }
        GRID_BAR();
        { pg8::Gemm g{HDN, L + LW_FI, M, FF2, DM, DM, DM}; pg8::StaticOrder S; S.init(M, FF2, F.G, (int)blockIdx.x);
          pg8::EpiSwi E{HB, FFH};
          pg8::gemm_phase<pg8::EpiSwi, pg8::StaticOrder, true, true>(ring, g, S, E, F.wave); }
        GRID_BAR();
        { pg8::Gemm g{HB, L + LW_FO, M, DM, FFH, FFH, FFH}; pg8::StaticOrder S; S.init(M, DM, F.G, (int)blockIdx.x);
          pg8::EpiRes E{F.out, F.out};
          pg8::gemm_phase<pg8::EpiRes, pg8::StaticOrder, false, true>(ring, g, S, E, F.wave); }
        GRID_BAR();
    }
    if (__hip_atomic_load((gu32*)((unsigned*)(ctl + CW_BAR) + XB_TMO), RLX_AGENT) != 0u) {
        const float q = __builtin_nanf("");
        for (int m = F.gw; m < M; m += F.NGW) { GAS f32x4* o = (GAS f32x4*)(F.out + (size_t)m * DM) + lane_id_v();
#pragma unroll
            for (int j = 0; j < 4; ++j) o[64 * j] = (f32x4){q, q, q, q}; }
    }
}

extern "C" void kernel_launch(void* const* d_in, const int* in_sizes, int n_in, void* d_out, int out_size, void* d_ws, size_t ws_size, hipStream_t stream) {
    static int grid = 0;
    if (grid == 0) {
        if (n_in != 16 || in_sizes[0] != M * DM || out_size != M * DM || ws_size < WS_END) { fprintf(stderr, "kernel_launch: unexpected shapes / workspace (n_in %d, in0 %d, out %d, ws %zu < %zu)\n", n_in, n_in > 0 ? in_sizes[0] : -1, out_size, ws_size, (size_t)WS_END); grid = -1; return; }
        int dev = 0, cus = 0, per_cu = 0;
        if (hipGetDevice(&dev) != hipSuccess || hipDeviceGetAttribute(&cus, hipDeviceAttributeMultiprocessorCount, dev) != hipSuccess) { grid = -1; return; }
        if (hipFuncSetAttribute((const void*)hyb_fwd, hipFuncAttributeMaxDynamicSharedMemorySize, LDS_BYTES) != hipSuccess) { fprintf(stderr, "kernel_launch: hipFuncSetAttribute failed\n"); grid = -1; return; }
        if (hipOccupancyMaxActiveBlocksPerMultiprocessor(&per_cu, (const void*)hyb_fwd, NWAVES * 64, LDS_BYTES) != hipSuccess || per_cu < 1) { fprintf(stderr, "kernel_launch: occupancy query reports %d blocks per CU\n", per_cu); }
        (void)hipGetLastError();
        grid = cus;
    }
    if (grid < 0) return;
    if (hipMemsetAsync((char*)d_ws + WS_CTL, 0, CTL_ZERO_BYTES, stream) != hipSuccess) return;
    Args a{};
    for (int i = 0; i < 16; ++i) a.in[i] = (const float*)d_in[i];
    a.out = (float*)d_out; a.ws = (unsigned char*)d_ws;
    hipLaunchKernelGGL(hyb_fwd, dim3(grid), dim3(NWAVES * 64), LDS_BYTES, stream, a);
}
```

```cpp
#include <hip/hip_runtime.h>
#include <cstdio>
#include <cstdint>
#include <cmath>
__device__ __forceinline__ int lane_id_v() { unsigned z; asm volatile("v_mov_b32 %0, 0" : "=v"(z)); return (int)__builtin_amdgcn_mbcnt_hi(~0u, __builtin_amdgcn_mbcnt_lo(~0u, z)); }
template <int MASK> __device__ __forceinline__ float sx(float v) { static_assert(MASK < 32, "swizzle xor mask"); return __builtin_bit_cast(float, __builtin_amdgcn_ds_swizzle(__builtin_bit_cast(int, v), 0x1F | (MASK << 10))); }
template <int MASK> __device__ __forceinline__ unsigned sxu(unsigned v) { return (unsigned)__builtin_amdgcn_ds_swizzle((int)v, 0x1F | (MASK << 10)); }
__device__ __forceinline__ void swap32(unsigned x, unsigned& lo_view, unsigned& hi_view) {
    unsigned a = x, b = x; asm volatile("" : "+v"(b));
    const auto rr = __builtin_amdgcn_permlane32_swap(a, b, false, false);
    lo_view = rr[0]; hi_view = rr[1];
}
template <int CTRL> __device__ __forceinline__ float dpp_f(float v) { return __builtin_bit_cast(float, __builtin_amdgcn_update_dpp(0, __builtin_bit_cast(int, v), CTRL, 0xF, 0xF, false)); }
template <int CTRL> __device__ __forceinline__ int dpp_i(int v) { return __builtin_amdgcn_update_dpp(0, v, CTRL, 0xF, 0xF, false); }
__device__ __forceinline__ float rl_f(float v, int l) { return __builtin_bit_cast(float, __builtin_amdgcn_readlane(__builtin_bit_cast(int, v), l)); }
__device__ __forceinline__ float wave_sum(float v) {
    v += dpp_f<0xB1>(v); v += dpp_f<0x4E>(v); v += dpp_f<0x141>(v); v += dpp_f<0x140>(v);
    return (rl_f(v, 0) + rl_f(v, 16)) + (rl_f(v, 32) + rl_f(v, 48));
}
__device__ __forceinline__ float wave_max(float v) {
    v = fmaxf(v, dpp_f<0xB1>(v)); v = fmaxf(v, dpp_f<0x4E>(v)); v = fmaxf(v, dpp_f<0x141>(v)); v = fmaxf(v, dpp_f<0x140>(v));
    return fmaxf(fmaxf(rl_f(v, 0), rl_f(v, 16)), fmaxf(rl_f(v, 32), rl_f(v, 48)));
}
__device__ __forceinline__ int wave_isum(int v) {
    v += dpp_i<0xB1>(v); v += dpp_i<0x4E>(v); v += dpp_i<0x141>(v); v += dpp_i<0x140>(v);
    return (__builtin_amdgcn_readlane(v, 0) + __builtin_amdgcn_readlane(v, 16)) + (__builtin_amdgcn_readlane(v, 32) + __builtin_amdgcn_readlane(v, 48));
}
__device__ __forceinline__ unsigned wave_umax(unsigned v) {
    unsigned t; t = (unsigned)dpp_i<0xB1>((int)v); v = t > v ? t : v; t = (unsigned)dpp_i<0x4E>((int)v); v = t > v ? t : v; t = (unsigned)dpp_i<0x141>((int)v); v = t > v ? t : v; t = (unsigned)dpp_i<0x140>((int)v); v = t > v ? t : v;
    const unsigned a = (unsigned)__builtin_amdgcn_readlane((int)v, 0), b = (unsigned)__builtin_amdgcn_readlane((int)v, 16), c = (unsigned)__builtin_amdgcn_readlane((int)v, 32), d = (unsigned)__builtin_amdgcn_readlane((int)v, 48);
    const unsigned ab = a > b ? a : b, cd = c > d ? c : d; return ab > cd ? ab : cd;
}
__device__ __forceinline__ unsigned wave_umin(unsigned v) { return ~wave_umax(~v); }
__device__ __forceinline__ float half_sum(float v) {
    unsigned a, b; swap32(__builtin_bit_cast(unsigned, v), a, b); return __builtin_bit_cast(float, a) + __builtin_bit_cast(float, b);
}
__device__ __forceinline__ float half_max(float v) {
    unsigned a, b; swap32(__builtin_bit_cast(unsigned, v), a, b); return fmaxf(__builtin_bit_cast(float, a), __builtin_bit_cast(float, b));
}
namespace pg8 {
#define PG8_LAS __attribute__((address_space(3)))
typedef unsigned short bf16_t;
typedef short bf16x8 __attribute__((ext_vector_type(8)));
typedef float f32x4 __attribute__((ext_vector_type(4)));
typedef unsigned u32x4 __attribute__((ext_vector_type(4)));
constexpr int BM = 256, BK = 64, HALF = 128, HTB = HALF * BK * 2  , STAGE_BYTES = 8 * HTB, NXCD = 8, WGM = 8;

__host__ __device__ __forceinline__ int lds_byte(int r, int c) { const int st = (r >> 4) * 2 + (c >> 5), rr = r & 15, cc = c & 31, ob = rr * 64 + cc * 2; return st * 1024 + (ob ^ (((ob >> 9) & 1) << 5)); }
__host__ __device__ __forceinline__ void stage_rc(int b, int& R, int& C) { const int st = b / 1024, sb = b % 1024, swz = sb ^ (((sb >> 9) & 1) << 5); R = (st >> 1) * 16 + swz / 64; C = (st & 1) * 32 + (swz % 64) / 2; }
__host__ __device__ __forceinline__ int perm32(int rho) { const int n = rho >> 4, i = rho & 15; return 8 * (i >> 2) + 4 * n + (i & 3); }

struct Unit { int pm, pn; };
struct Gemm { const bf16_t* A; const bf16_t* Bt; int M, N, K, lda, ldb; };

struct StaticOrder {
    int nM, nN, nwg, G, c;
    __host__ __device__ void init(int M, int N, int G_, int c_) { nM = M / BM; nN = N / BM; nwg = nM * nN; G = G_; c = c_; }
    __host__ __device__ bool next(int i, Unit& u) const {
        const long L = (long)i * G + c; if (L >= nwg) return false;
        int wgid = (int)L; { const int q = nwg / NXCD, r = nwg % NXCD, xcd = wgid % NXCD, off = wgid / NXCD; wgid = (xcd < r ? xcd * (q + 1) : r * (q + 1) + (xcd - r) * q) + off; }
        const int nig = WGM * nN, gid = wgid / nig, fm = gid * WGM, gsz = (nM - fm) < WGM ? (nM - fm) : WGM;
        u.pm = fm + ((wgid % nig) % gsz); u.pn = (wgid % nig) / gsz; return true;
    }
    __device__ __forceinline__ void a_ready(const Unit&) const {}
    __device__ __forceinline__ void done(const Unit&) const {}
};

__device__ __forceinline__ unsigned cvt_pk_bf16(float lo, float hi) { unsigned r; asm volatile("v_cvt_pk_bf16_f32 %0, %1, %2" : "=v"(r) : "v"(lo), "v"(hi)); return r; }
__device__ __forceinline__ float bflo(unsigned w) { return __builtin_bit_cast(float, w << 16); }
__device__ __forceinline__ float bfhi(unsigned w) { return __builtin_bit_cast(float, w & 0xffff0000u); }
__device__ __forceinline__ float sigmoidf_(float x) { return __builtin_amdgcn_rcpf(1.0f + __builtin_amdgcn_exp2f(-1.4426950408889634f * x)); }

constexpr int ZP = 6656;
constexpr int ZSP = 512;
constexpr int NZT = 26, GATE_T0 = 14;

__device__ __forceinline__ float row_rstd(const float* SS, int row) {
    const f32x4 a = *(const f32x4*)(SS + (size_t)row * 16), b = *(const f32x4*)(SS + (size_t)row * 16 + 4), c = *(const f32x4*)(SS + (size_t)row * 16 + 8), d = *(const f32x4*)(SS + (size_t)row * 16 + 12);
    const float s = ((a[0] + a[1]) + (a[2] + a[3])) + ((b[0] + b[1]) + (b[2] + b[3])) + ((c[0] + c[1]) + (c[2] + c[3])) + ((d[0] + d[1]) + (d[2] + d[3]));
    return 1.0f / __builtin_sqrtf(s * (1.0f / 1024.0f) + 1e-6f);
}
struct EpiZ {
    static constexpr bool PERM = true, AFTER_DRAIN = false;
    bf16_t* Z; float* ZS; const float* SS;
    __device__ __forceinline__ void operator()(const f32x4 (&acc)[2][2][4][2], const Unit& u, int wr, int wc, int fr, int fq) const {
        const int row0 = u.pm * BM + wr * 64 + fr;
        if (u.pn < NZT) {
            const int col0 = u.pn * BM + wc * 32 + 8 * fq;
#pragma unroll
            for (int ai = 0; ai < 2; ++ai)
#pragma unroll
                for (int m = 0; m < 4; ++m) { bf16_t* rowp = Z + (size_t)(row0 + ai * HALF + m * 16) * ZP + col0; const float rs = row_rstd(SS, row0 + ai * HALF + m * 16);
#pragma unroll
                    for (int bj = 0; bj < 2; ++bj) { f32x4 v0 = acc[ai][bj][m][0] * rs, v1 = acc[ai][bj][m][1] * rs;
                        if (u.pn >= GATE_T0) {
#pragma unroll
                            for (int i = 0; i < 4; ++i) { v0[i] = sigmoidf_(v0[i]); v1[i] = sigmoidf_(v1[i]); } }
                        u32x4 w; w.x = cvt_pk_bf16(v0[0], v0[1]); w.y = cvt_pk_bf16(v0[2], v0[3]); w.z = cvt_pk_bf16(v1[0], v1[1]); w.w = cvt_pk_bf16(v1[2], v1[3]);
                        *(u32x4*)(rowp + bj * HALF) = w; } }
        } else {
            const int col0 = (u.pn - NZT) * BM + wc * 32 + 8 * fq;
#pragma unroll
            for (int ai = 0; ai < 2; ++ai)
#pragma unroll
                for (int m = 0; m < 4; ++m) { float* rowp = ZS + (size_t)(row0 + ai * HALF + m * 16) * ZSP + col0; const float rs = row_rstd(SS, row0 + ai * HALF + m * 16);
#pragma unroll
                    for (int bj = 0; bj < 2; ++bj) { *(f32x4*)(rowp + bj * HALF) = acc[ai][bj][m][0] * rs; *(f32x4*)(rowp + bj * HALF + 4) = acc[ai][bj][m][1] * rs; } }
        }
    }
};

template <int P> struct EpiGate {
    static constexpr bool PERM = true, AFTER_DRAIN = false;
    const bf16_t* G;
    float* M32;
    bf16_t* OUT;
    __device__ __forceinline__ void operator()(const f32x4 (&acc)[2][2][4][2], const Unit& u, int wr, int wc, int fr, int fq) const {
        const int row0 = u.pm * BM + wr * 64 + fr, col0 = u.pn * BM + wc * 32 + 8 * fq;
#pragma unroll
        for (int ai = 0; ai < 2; ++ai)
#pragma unroll
            for (int m = 0; m < 4; ++m) { const size_t row = (size_t)(row0 + ai * HALF + m * 16);
#pragma unroll
                for (int bj = 0; bj < 2; ++bj) { const int col = col0 + bj * HALF;
                    const u32x4 gw = *(const u32x4*)(G + row * ZP + P * 1024 + col);
                    const f32x4 v0 = acc[ai][bj][m][0], v1 = acc[ai][bj][m][1];
                    f32x4 t0, t1;
                    t0[0] = bflo(gw.x) * v0[0]; t0[1] = bfhi(gw.x) * v0[1]; t0[2] = bflo(gw.y) * v0[2]; t0[3] = bfhi(gw.y) * v0[3];
                    t1[0] = bflo(gw.z) * v1[0]; t1[1] = bfhi(gw.z) * v1[1]; t1[2] = bflo(gw.w) * v1[2]; t1[3] = bfhi(gw.w) * v1[3];
                    float* mp = M32 + row * 1024 + col;
                    if (P == 0) { *(f32x4*)mp = t0; *(f32x4*)(mp + 4) = t1; }
                    else if (P == 1) { *(f32x4*)mp = *(const f32x4*)mp + t0; *(f32x4*)(mp + 4) = *(const f32x4*)(mp + 4) + t1; }
                    else { t0 = *(const f32x4*)mp + t0; t1 = *(const f32x4*)(mp + 4) + t1;
                        u32x4 w; w.x = cvt_pk_bf16(t0[0], t0[1]); w.y = cvt_pk_bf16(t0[2], t0[3]); w.z = cvt_pk_bf16(t1[0], t1[1]); w.w = cvt_pk_bf16(t1[2], t1[3]);
                        *(u32x4*)(OUT + row * ZP + col) = w; } } }
    }
};

struct EpiRes {
    static constexpr bool PERM = true, AFTER_DRAIN = false;
    const float* RES; float* OUT; const float* G; bf16_t* XG; float* SS;
    __device__ __forceinline__ void operator()(const f32x4 (&acc)[2][2][4][2], const Unit& u, int wr, int wc, int fr, int fq) const {
        const int row0 = u.pm * BM + wr * 64 + fr, col0 = u.pn * BM + wc * 32 + 8 * fq;
        f32x4 g[2][2];
#pragma unroll
        for (int bj = 0; bj < 2; ++bj) { g[bj][0] = *(const f32x4*)(G + col0 + bj * HALF); g[bj][1] = *(const f32x4*)(G + col0 + bj * HALF + 4); }
#pragma unroll
        for (int ai = 0; ai < 2; ++ai)
#pragma unroll
            for (int m = 0; m < 4; ++m) { const int row = row0 + ai * HALF + m * 16; const size_t off = (size_t)row * 1024 + col0; float ss = 0.f;
#pragma unroll
                for (int bj = 0; bj < 2; ++bj) { const float* rp = RES + off + bj * HALF; float* op = OUT + off + bj * HALF;
                    const f32x4 v0 = *(const f32x4*)rp + acc[ai][bj][m][0], v1 = *(const f32x4*)(rp + 4) + acc[ai][bj][m][1];
                    *(f32x4*)op = v0; *(f32x4*)(op + 4) = v1;
                    ss += ((v0[0] * v0[0] + v0[1] * v0[1]) + (v0[2] * v0[2] + v0[3] * v0[3])) + ((v1[0] * v1[0] + v1[1] * v1[1]) + (v1[2] * v1[2] + v1[3] * v1[3]));
                    const f32x4 x0 = v0 * g[bj][0], x1 = v1 * g[bj][1];
                    u32x4 w; w.x = cvt_pk_bf16(x0[0], x0[1]); w.y = cvt_pk_bf16(x0[2], x0[3]); w.z = cvt_pk_bf16(x1[0], x1[1]); w.w = cvt_pk_bf16(x1[2], x1[3]);
                    *(u32x4*)(XG + off + bj * HALF) = w; }
                ss += sx<16>(ss); { unsigned a, b; swap32(__builtin_bit_cast(unsigned, ss), a, b); ss = __builtin_bit_cast(float, a) + __builtin_bit_cast(float, b); }
                if (fq == 0) SS[(size_t)row * 16 + u.pn * 4 + wc] = ss; }
    }
};

struct EpiSwi {
    static constexpr bool PERM = true, AFTER_DRAIN = false;
    bf16_t* H; int ldh; const float* SS;
    __device__ __forceinline__ void operator()(const f32x4 (&acc)[2][2][4][2], const Unit& u, int wr, int wc, int fr, int fq) const {
        const int row0 = u.pm * BM + wr * 64 + fr, col0 = u.pn * HALF + wc * 32 + 8 * fq;
#pragma unroll
        for (int ai = 0; ai < 2; ++ai)
#pragma unroll
            for (int m = 0; m < 4; ++m) { bf16_t* hp = H + (size_t)(row0 + ai * HALF + m * 16) * ldh + col0; const float rs = row_rstd(SS, row0 + ai * HALF + m * 16);
                float o[8];
#pragma unroll
                for (int n = 0; n < 2; ++n)
#pragma unroll
                    for (int i = 0; i < 4; ++i) { const float g = acc[ai][0][m][n][i] * rs, up = acc[ai][1][m][n][i] * rs; o[4 * n + i] = g * sigmoidf_(g) * up; }
                u32x4 w; w.x = cvt_pk_bf16(o[0], o[1]); w.y = cvt_pk_bf16(o[2], o[3]); w.z = cvt_pk_bf16(o[4], o[5]); w.w = cvt_pk_bf16(o[6], o[7]);
                *(u32x4*)hp = w; }
    }
};

template <class Epi, class Sched, bool ALIGN_EPI = false, bool SP2 = false>
__device__ __forceinline__ void gemm_phase(PG8_LAS unsigned char* lds, Gemm g, const Sched& S0, const Epi& E, int wave_id) {
    int ovz, osz; asm volatile("v_mov_b32 %0, 0\n\ts_mov_b32 %1, 0" : "=v"(ovz), "=s"(osz));
    Sched S = S0; S.c += osz; g.lda += osz; g.ldb += osz;
    const int tid = ((wave_id << 6) | lane_id_v()) + ovz,
         wid = __builtin_amdgcn_readfirstlane(tid >> 6), lane = tid & 63, wr = wid >> 2, wc = wid & 3, fr = lane & 15, fq = lane >> 4;
    const int K = g.K, nt = K / BK;
    unsigned voffA[2], voffB[2];
#pragma unroll
    for (int i = 0; i < 2; ++i) { int R, C; stage_rc(tid * 16 + i * 8192, R, C); const int Rb = Epi::PERM ? ((R & ~31) + perm32(R & 31)) : R;
        voffA[i] = (unsigned)(R * g.lda + C) * 2u; voffB[i] = (unsigned)(Rb * g.ldb + C) * 2u; }
    const size_t kstep = (size_t)(BK * 2);
    const size_t hstepA = (size_t)HALF * g.lda * 2, hstepB = (size_t)HALF * g.ldb * 2;
    const size_t tstepA = 2 * hstepA, tstepB = 2 * hstepB;
    const unsigned ldsw = (unsigned)wid * 1024u;
    const int aoff = lds_byte(wr * 64 + fr, fq * 8), boff = lds_byte(wc * 32 + fr, fq * 8);
#define PG8_SA(b, h) (((b) * 2 + (h)) * HTB)
#define PG8_SB(b, h) ((4 + (b) * 2 + (h)) * HTB)
#define PG8_STAGE(bufoff, gbase, voff) do { _Pragma("unroll") for (int _i = 0; _i < 2; ++_i) \
        __builtin_amdgcn_global_load_lds((const unsigned*)((const char*)(gbase) + (voff)[_i]), (PG8_LAS unsigned*)(lds + (bufoff) + ldsw + _i * 8192), 16, 0, 0); } while (0)
#define PG8_LDA(dst, b, h) do { _Pragma("unroll") for (int m = 0; m < 4; ++m) _Pragma("unroll") for (int k = 0; k < 2; ++k) dst[m][k] = *(const PG8_LAS bf16x8*)(lds + PG8_SA(b, h) + aoff + m * 2048 + k * 1024); } while (0)
#define PG8_LDB(dst, b, h) do { _Pragma("unroll") for (int n = 0; n < 2; ++n) _Pragma("unroll") for (int k = 0; k < 2; ++k) dst[n][k] = *(const PG8_LAS bf16x8*)(lds + PG8_SB(b, h) + boff + n * 2048 + k * 1024); } while (0)
#define PG8_MMA(ai, bj, At, Bt) do { __builtin_amdgcn_s_setprio(1); _Pragma("unroll") for (int m = 0; m < 4; ++m) _Pragma("unroll") for (int n = 0; n < 2; ++n) _Pragma("unroll") for (int k = 0; k < 2; ++k) \
        acc[ai][bj][m][n] = __builtin_amdgcn_mfma_f32_16x16x32_bf16(Bt[n][k], At[m][k], acc[ai][bj][m][n], 0, 0, 0); __builtin_amdgcn_s_setprio(0); } while (0)
#define PG8_WAIT_V(n) asm volatile("s_waitcnt vmcnt(" #n ")" ::: "memory")
#define PG8_WAIT_L(n) asm volatile("s_waitcnt lgkmcnt(" #n ")" ::: "memory")
#define PG8_BAR __builtin_amdgcn_s_barrier()
#define PG8_SCHED __builtin_amdgcn_sched_barrier(0)
    Unit cur, nxt; int ui = 0;
    if (!S.next(0, cur)) return;
    f32x4 acc[2][2][4][2];
#pragma unroll
    for (int a = 0; a < 2; ++a)
#pragma unroll
        for (int b = 0; b < 2; ++b)
#pragma unroll
            for (int m = 0; m < 4; ++m)
#pragma unroll
                for (int n = 0; n < 2; ++n) acc[a][b][m][n] = (f32x4){0.f, 0.f, 0.f, 0.f};
    bf16x8 At[4][2], B0[2][2], B1[2][2];
    const char* cA = (const char*)g.A + (size_t)cur.pm * tstepA; const char* cB = (const char*)g.Bt + (size_t)cur.pn * tstepB;
    S.a_ready(cur);
    if constexpr (SP2) {
        PG8_STAGE(PG8_SB(0, 0), cB, voffB); PG8_STAGE(PG8_SB(0, 1), cB + hstepB, voffB); PG8_STAGE(PG8_SA(0, 0), cA, voffA); PG8_STAGE(PG8_SA(0, 1), cA + hstepA, voffA);
        if (wr == 1) PG8_BAR;
        PG8_WAIT_V(2); PG8_BAR;
        PG8_STAGE(PG8_SB(1, 0), cB + kstep, voffB); PG8_STAGE(PG8_SA(1, 0), cA + kstep, voffA); PG8_STAGE(PG8_SB(1, 1), cB + hstepB + kstep, voffB);
        PG8_WAIT_V(6); PG8_BAR;
    } else {
        PG8_STAGE(PG8_SB(0, 0), cB, voffB); PG8_STAGE(PG8_SA(0, 0), cA, voffA); PG8_STAGE(PG8_SB(0, 1), cB + hstepB, voffB); PG8_STAGE(PG8_SA(0, 1), cA + hstepA, voffA);
        if (wr == 1) PG8_BAR;
        PG8_WAIT_V(4); PG8_BAR;
        PG8_STAGE(PG8_SB(1, 0), cB + kstep, voffB); PG8_STAGE(PG8_SA(1, 0), cA + kstep, voffA); PG8_STAGE(PG8_SB(1, 1), cB + hstepB + kstep, voffB);
        PG8_WAIT_V(6); PG8_BAR;
    }
    for (;;) {
        const bool has_next = S.next(ui + 1, nxt);
        const char* nA = has_next ? (const char*)g.A + (size_t)nxt.pm * tstepA : cA; const char* nB = has_next ? (const char*)g.Bt + (size_t)nxt.pn * tstepB : cB;
        for (int t = 0; t < nt; t += 2) {
            const bool last = (t == nt - 2);
            const char* a1 = cA + (size_t)(t + 1) * kstep;
            const char* a2 = last ? nA : cA + (size_t)(t + 2) * kstep; const char* b2 = last ? nB : cB + (size_t)(t + 2) * kstep;
            const char* a3 = a2 + kstep; const char* b3 = b2 + kstep;
            if (last && has_next) S.a_ready(nxt);
            if constexpr (SP2) {
            PG8_LDB(B0, 0, 0); PG8_LDB(B1, 0, 1); PG8_SCHED; PG8_LDA(At, 0, 0); PG8_STAGE(PG8_SA(1, 1), a1 + hstepA, voffA);
            PG8_WAIT_V(8); PG8_WAIT_L(0); PG8_BAR; PG8_MMA(0, 0, At, B0); PG8_MMA(0, 1, At, B1); PG8_BAR; PG8_SCHED;
            PG8_LDA(At, 0, 1); PG8_STAGE(PG8_SB(0, 0), b2, voffB); PG8_STAGE(PG8_SB(0, 1), b2 + hstepB, voffB); PG8_STAGE(PG8_SA(0, 0), a2, voffA);
            PG8_WAIT_V(8); PG8_WAIT_L(0); PG8_BAR; PG8_MMA(1, 0, At, B0); PG8_MMA(1, 1, At, B1); PG8_BAR; PG8_SCHED;
            PG8_LDB(B0, 1, 0); PG8_LDB(B1, 1, 1); PG8_SCHED; PG8_LDA(At, 1, 0); PG8_STAGE(PG8_SA(0, 1), a2 + hstepA, voffA);
            PG8_WAIT_V(8); PG8_WAIT_L(0); PG8_BAR; PG8_MMA(0, 0, At, B0); PG8_MMA(0, 1, At, B1); PG8_BAR; PG8_SCHED;
            PG8_LDA(At, 1, 1); PG8_STAGE(PG8_SB(1, 0), b3, voffB); PG8_STAGE(PG8_SB(1, 1), b3 + hstepB, voffB); PG8_STAGE(PG8_SA(1, 0), a3, voffA);
            PG8_WAIT_V(8); PG8_WAIT_L(0); PG8_BAR; PG8_MMA(1, 0, At, B0); PG8_MMA(1, 1, At, B1); PG8_BAR; PG8_SCHED;
            } else {
            PG8_LDB(B0, 0, 0); PG8_SCHED; PG8_LDA(At, 0, 0); PG8_STAGE(PG8_SA(1, 1), a1 + hstepA, voffA);
            PG8_WAIT_L(8); PG8_BAR; PG8_WAIT_L(0); PG8_MMA(0, 0, At, B0); PG8_BAR; PG8_SCHED;
            PG8_LDB(B1, 0, 1); PG8_STAGE(PG8_SB(0, 0), b2, voffB);
            PG8_BAR; PG8_WAIT_L(0); PG8_MMA(0, 1, At, B1); PG8_BAR;
            PG8_LDA(At, 0, 1); PG8_STAGE(PG8_SA(0, 0), a2, voffA);
            PG8_BAR; PG8_WAIT_L(0); PG8_MMA(1, 0, At, B0); PG8_BAR; PG8_SCHED;
            PG8_STAGE(PG8_SB(0, 1), b2 + hstepB, voffB);
            PG8_WAIT_V(6); PG8_BAR; PG8_MMA(1, 1, At, B1); PG8_BAR;
            PG8_LDB(B0, 1, 0); PG8_SCHED; PG8_LDA(At, 1, 0); PG8_STAGE(PG8_SA(0, 1), a2 + hstepA, voffA);
            PG8_WAIT_L(8); PG8_BAR; PG8_WAIT_L(0); PG8_MMA(0, 0, At, B0); PG8_BAR; PG8_SCHED;
            PG8_LDB(B1, 1, 1); PG8_STAGE(PG8_SB(1, 0), b3, voffB);
            PG8_BAR; PG8_WAIT_L(0); PG8_MMA(0, 1, At, B1); PG8_BAR;
            PG8_LDA(At, 1, 1); PG8_STAGE(PG8_SA(1, 0), a3, voffA);
            PG8_BAR; PG8_WAIT_L(0); PG8_MMA(1, 0, At, B0); PG8_BAR; PG8_SCHED;
            PG8_STAGE(PG8_SB(1, 1), b3 + hstepB, voffB);
            PG8_WAIT_V(6); PG8_BAR; PG8_MMA(1, 1, At, B1); PG8_BAR;
            }
        }
        if constexpr (ALIGN_EPI) { if (wr == 0) PG8_BAR; }
        if constexpr (!Epi::AFTER_DRAIN) { E(acc, cur, wr, wc, fr, fq); S.done(cur); }
        if (!has_next) break;
#pragma unroll
        for (int a = 0; a < 2; ++a)
#pragma unroll
            for (int b = 0; b < 2; ++b)
#pragma unroll
                for (int m = 0; m < 4; ++m)
#pragma unroll
                    for (int n = 0; n < 2; ++n) acc[a][b][m][n] = (f32x4){0.f, 0.f, 0.f, 0.f};
        cur = nxt; cA = nA; cB = nB; ++ui;
        if constexpr (ALIGN_EPI) { if (wr == 1) PG8_BAR; }
    }
    PG8_WAIT_V(0);
    if constexpr (!ALIGN_EPI) { if (wr == 0) PG8_BAR; }
    PG8_BAR;
    if constexpr (Epi::AFTER_DRAIN) { E.fused(acc, cur, wr, wc, fr, fq, lds, wid, lane); S.done(cur); }
#undef PG8_SA
#undef PG8_SB
#undef PG8_STAGE
#undef PG8_LDA
#undef PG8_LDB
#undef PG8_MMA
#undef PG8_WAIT_V
#undef PG8_WAIT_L
#undef PG8_BAR
#undef PG8_SCHED
}
}

constexpr int NB = 4, SEQ = 4096, DM = 1024, DEPTH = 4, M = NB * SEQ;
constexpr int INC = 7088;
constexpr int NIN = 7168;
constexpr int FFH = 2816, FF2 = 5632;
constexpr int ZP = pg8::ZP, ZSP = pg8::ZSP;
constexpr int Z_FQ = 0, Z_FK = 512, Z_FV = 1024, Z_DQ = 1536, Z_RV = 2048, Z_RQ = 2560, Z_RK = 2816, Z_RG = 3072, Z_ZG = 3584, Z_MRG = 2560;
constexpr int S_IQ = 0, S_DK = 256, S_DV = 320, S_IK = 384, S_IW = 416, S_FF = 424;
constexpr float NORM_EPS = 1e-6f;
constexpr float LOG2E = 1.4426950408889634f;
constexpr float C2 = 0.125f * 1.4426950408889634f;

constexpr size_t MiB = 1u << 20;
constexpr size_t WS_CTL = 0, CTL_ZERO_BYTES = 1 * MiB;
constexpr size_t WS_ROPE64 = 1 * MiB;
constexpr size_t WS_ROPE32 = 2 * MiB;
constexpr size_t WS_LF = 2 * MiB + 512 * 1024;
constexpr size_t WS_CF = 3 * MiB;
constexpr size_t WS_ISG = 3 * MiB + 512 * 1024;
constexpr size_t WS_KD = 4 * MiB;
constexpr size_t WS_VD = 6 * MiB;
constexpr size_t WS_W = 8 * MiB;
constexpr size_t LW_IN = 0, LW_MIX = (size_t)NIN * 1024, LW_O = LW_MIX + 1536 * 1024, LW_FI = LW_O + 1024 * 1024, LW_FO = LW_FI + (size_t)FF2 * 1024, LW_STRIDE = LW_FO + (size_t)FFH * 1024;
constexpr size_t WS_Z = 150 * MiB;
constexpr size_t WS_HDN = 358 * MiB;
constexpr size_t WS_ZS = 390 * MiB;
constexpr size_t WS_IQB = 422 * MiB;
constexpr size_t WS_IKB = 430 * MiB;
constexpr size_t WS_SS = 431 * MiB;
constexpr size_t WS_END = 432 * MiB;
static_assert(WS_W + DEPTH * LW_STRIDE * 2 <= WS_Z && WS_Z + (size_t)M * ZP * 2 <= WS_HDN && WS_HDN + (size_t)M * 1024 * 2 == WS_ZS && WS_ZS + (size_t)M * ZSP * 4 == WS_IQB, "d_ws map");
constexpr int CW_BAR = 4096;

constexpr int RING_OFF = 0, RING_BYTES = 133120;
constexpr int LDSCTL_OFF = RING_BYTES, MISC_OFF = LDSCTL_OFF + 320;
constexpr int XTRA_OFF = RING_BYTES + 1024;
constexpr int LDS_BYTES = 147456;
constexpr int NWAVES = 8;
#define GAS __attribute__((address_space(1)))
#define LAS __attribute__((address_space(3)))
typedef unsigned short bf16;
typedef unsigned v4u __attribute__((ext_vector_type(4)));
typedef float f32x4 __attribute__((ext_vector_type(4)));
typedef short bf16x8 __attribute__((ext_vector_type(8)));
typedef GAS unsigned gu32;
typedef GAS unsigned long long gu64;
#define RLX_AGENT __ATOMIC_RELAXED, __HIP_MEMORY_SCOPE_AGENT
#define LDS_WAIT() asm volatile("s_waitcnt lgkmcnt(0)" ::: "memory")
#define VM_WAIT() asm volatile("s_waitcnt vmcnt(0)" ::: "memory")
__device__ __forceinline__ unsigned long long rt() { return __builtin_amdgcn_s_memrealtime(); }
__device__ __forceinline__ unsigned f2bf(float f) { unsigned u = __builtin_bit_cast(unsigned, f); return (u + 0x7fffu + ((u >> 16) & 1u)) >> 16; }
__device__ __forceinline__ unsigned pk2(float lo, float hi) { return f2bf(lo) | (f2bf(hi) << 16); }

#define XB_TMO      128
#define XB_XCNT(j)  (256  + 64 * (j))
#define XB_XSUB(j)  (1280 + 64 * (j))
#define XB_XGEN(j)  (2304 + 64 * (j))
#define XB_TOP      3328
#define XB_TOPGEN   3392
#define XCD_BAR_WORDS 3456
#define XB_SPIN_CAP (1u << 22)

__device__ __forceinline__ unsigned xb_ld(unsigned* p)              { return __hip_atomic_load(p, __ATOMIC_RELAXED, __HIP_MEMORY_SCOPE_AGENT); }
__device__ __forceinline__ unsigned xb_add(unsigned* p, unsigned v) { return __hip_atomic_fetch_add(p, v, __ATOMIC_RELAXED, __HIP_MEMORY_SCOPE_AGENT); }
__device__ __forceinline__ unsigned xb_xcc_id() { return (unsigned)__builtin_amdgcn_s_getreg((3 << 11) | 20) & 0xFu; }
#define XB_SPIN(cond, bar) do { unsigned _sp = 0; while (cond) { __builtin_amdgcn_s_sleep(1); \
    if ((++_sp & 255u) == 0u) { if (xb_ld(&(bar)[XB_TMO])) break; if (_sp > XB_SPIN_CAP) { atomicAdd(&(bar)[XB_TMO], 1u); break; } } } } while (0)

struct XcdBarrier {
    unsigned* bar; unsigned x; int w;
    volatile LAS unsigned* st;
};

__device__ __forceinline__ XcdBarrier xcd_barrier_post(unsigned* bar, volatile LAS unsigned* st) {
    XcdBarrier b; b.bar = bar; b.x = xb_xcc_id(); b.st = st; b.w = 0;
    if (threadIdx.x == 0) (void)xb_add(&bar[XB_XCNT(b.x)], 1u);
    return b;
}
__device__ __forceinline__ void xcd_barrier_complete(unsigned* bar, unsigned x, unsigned& nloc, unsigned& nx) {
    const unsigned G = gridDim.x * gridDim.y * gridDim.z;
    unsigned sum, cnt, mine, sp = 0u;
    for (;;) {
        sum = 0u; cnt = 0u; mine = 0u;
#pragma unroll
        for (unsigned j = 0; j < 16; ++j) { const unsigned c = xb_ld(&bar[XB_XCNT(j)]); sum += c; cnt += (c > 0u) ? 1u : 0u; mine = (j == x) ? c : mine; }
        if (sum == G) break;
        __builtin_amdgcn_s_sleep(1);
        if ((++sp & 255u) == 0u) { if (xb_ld(&bar[XB_TMO])) break; if (sp > XB_SPIN_CAP) { atomicAdd(&bar[XB_TMO], 1u); break; } }
    }
    nloc = mine > 0u ? mine : 1u; nx = cnt > 0u ? cnt : 1u;
}

__device__ __forceinline__ void xcd_barrier(const XcdBarrier& b) {
    asm volatile("s_waitcnt vmcnt(0)" ::: "memory");
    __syncthreads();
    if (b.w == 0 && lane_id_v() == 0) {
        unsigned* bar = b.bar;
        __builtin_amdgcn_s_waitcnt(0);
        unsigned nloc = b.st[0], nx = b.st[1];
        if (nloc == 0u) { xcd_barrier_complete(bar, b.x, nloc, nx); b.st[0] = nloc; b.st[1] = nx; }
        const unsigned old = xb_add(&bar[XB_XSUB(b.x)], 1u);
        const unsigned gen = old / nloc;
        if (old + 1u == (gen + 1u) * nloc) {
            __builtin_amdgcn_fence(__ATOMIC_RELEASE, "agent");
            asm volatile("s_waitcnt vmcnt(0)" ::: "memory");
            const unsigned og = xb_add(&bar[XB_TOP], 1u);
            const unsigned tg = og / nx;
            if (og + 1u == (tg + 1u) * nx) xb_add(&bar[XB_TOPGEN], 1u);
            else XB_SPIN(xb_ld(&bar[XB_TOPGEN]) == tg, bar);
            __builtin_amdgcn_fence(__ATOMIC_ACQUIRE, "agent");
            xb_add(&bar[XB_XGEN(b.x)], 1u);
            asm volatile("s_waitcnt vmcnt(0)" ::: "memory");
        } else {
            XB_SPIN(xb_ld(&bar[XB_XGEN(b.x)]) == gen, bar);
            __builtin_amdgcn_fence(__ATOMIC_ACQUIRE, "agent");
            asm volatile("s_waitcnt vmcnt(0)" ::: "memory");
        }
    }
    __syncthreads();
}

typedef float f32x2 __attribute__((ext_vector_type(2)));
typedef unsigned u32x2 __attribute__((ext_vector_type(2)));
__device__ __forceinline__ float bflo(unsigned w) { return __builtin_bit_cast(float, w << 16); }
__device__ __forceinline__ float bfhi(unsigned w) { return __builtin_bit_cast(float, w & 0xffff0000u); }
__device__ __forceinline__ float bf2f(bf16 v) { return __builtin_bit_cast(float, (unsigned)v << 16); }
__device__ __forceinline__ void unpack8(const v4u w, float (&f)[8]) { f[0] = bflo(w.x); f[1] = bfhi(w.x); f[2] = bflo(w.y); f[3] = bfhi(w.y); f[4] = bflo(w.z); f[5] = bfhi(w.z); f[6] = bflo(w.w); f[7] = bfhi(w.w); }
__device__ __forceinline__ v4u pack8(const float (&f)[8]) { v4u w; w.x = pk2(f[0], f[1]); w.y = pk2(f[2], f[3]); w.z = pk2(f[4], f[5]); w.w = pk2(f[6], f[7]); return w; }
__device__ __forceinline__ float xor32(float v, int lane) {
    return __builtin_bit_cast(float, __builtin_amdgcn_ds_bpermute((lane ^ 32) << 2, __builtin_bit_cast(int, v)));
}
__device__ __forceinline__ float sigmoid_f(float x) { return 1.0f / (1.0f + __expf(-x)); }

struct Ctx {
    LAS unsigned char* lds;
    int tid, lane, wave, G, gw, NGW;
    float* out; unsigned char* ws;
};

__device__ __forceinline__ void conv_item(const float* W, int N, int sc, int nv, int k0, bf16* WT, int ldw, int dr, LAS float* scr, int lane) {
    const int n_ = lane & 31;
#pragma unroll 8
    for (int i = 0; i < 32; ++i) { const int kk = 2 * i + (lane >> 5); scr[kk * 33 + n_] = (n_ < nv) ? W[(size_t)(k0 + kk) * N + sc + n_] : 0.f; }
    LDS_WAIT(); asm volatile("" ::: "memory");
    const int c = lane & 7;
#pragma unroll
    for (int j = 0; j < 4; ++j) { const int n = (lane >> 3) + 8 * j; const LAS float* s = scr + (8 * c) * 33 + n;
        v4u o; o.x = pk2(s[0 * 33], s[1 * 33]); o.y = pk2(s[2 * 33], s[3 * 33]); o.z = pk2(s[4 * 33], s[5 * 33]); o.w = pk2(s[6 * 33], s[7 * 33]);
        if (n < nv) *(GAS v4u*)(WT + (size_t)(dr + n) * ldw + k0 + 8 * c) = o; }
    LDS_WAIT(); asm volatile("" ::: "memory");
}
__device__ const int SEG_IN[15][3] = {
    {0, 0, 512}, {512, 512, 512}, {1024, 1024, 512}, {1536, 6656 + S_FF, 8}, {1544, Z_DQ, 512}, {2056, 6656 + S_DK, 64}, {2120, 6656 + S_DV, 64},
    {2184, 6656 + S_IQ, 256}, {2440, 6656 + S_IK, 32}, {2472, 6656 + S_IW, 8}, {2480, Z_RQ, 256}, {2736, Z_RK, 256}, {2992, Z_RV, 512}, {3504, Z_RG, 512}, {4016, Z_ZG, 3072}};
constexpr int IN_BLK = 223;
constexpr int IT_IN = 16 * IN_BLK, IT_MIX = 8 * 32, IT_O = 16 * 32, IT_FI = 16 * (FF2 / 32), IT_FO = (FFH / 64) * 32;
constexpr int IT_LAYER = IT_IN + 3 * IT_MIX + IT_O + IT_FI + IT_FO;

__device__ __forceinline__ void sincos_acc(float ang, float& c, float& s) {
    const double a = (double)ang;
    const double k = __builtin_rint(a * 0.6366197723675814);
    double y = a - k * 1.5707963267948966; y -= k * 6.123233995736766e-17;
    const double y2 = y * y;
    double sp = -7.647163731819816e-13; sp = sp * y2 + 1.6059043836821613e-10; sp = sp * y2 - 2.505210838544172e-08; sp = sp * y2 + 2.7557319223985893e-06; sp = sp * y2 - 1.984126984126984e-04; sp = sp * y2 + 8.333333333333333e-03; sp = sp * y2 - 1.6666666666666666e-01;
    const double sn = y + y * y2 * sp;
    double cp = 4.779477332387385e-14; cp = cp * y2 - 1.1470745597729725e-11; cp = cp * y2 + 2.08767569878681e-09; cp = cp * y2 - 2.755731922398589e-07; cp = cp * y2 + 2.48015873015873e-05; cp = cp * y2 - 1.388888888888889e-03; cp = cp * y2 + 4.1666666666666664e-02; cp = cp * y2 - 0.5;
    const double cs = 1.0 + y2 * cp;
    const int q = ((int)k) & 3;
    const double ss = (q & 1) ? cs : sn, cc = (q & 1) ? sn : cs;
    s = (float)((q & 2) ? -ss : ss);
    c = (float)(((q + 1) & 2) ? -cc : cc);
}

__device__ __forceinline__ void p0_prologue(const Ctx& F, const float* w_in, const float* w_fox, const float* w_dsa, const float* w_ret, const float* w_o, const float* w_fi, const float* w_fo) {
    LAS float* scr = (LAS float*)(F.lds + RING_OFF + F.wave * 16384);
    bf16* Wb = (bf16*)(F.ws + WS_W);
    for (int it = F.gw; it < DEPTH * IT_LAYER; it += F.NGW) {
        const int l = it / IT_LAYER; int r = it % IT_LAYER;
        bf16* L = Wb + (size_t)l * LW_STRIDE;
        if (r < IT_IN) {
            const int kb = r / IN_BLK; int blk = r % IN_BLK; int sc = 0, dr = 0, nv = 0;
            for (int s = 0; s < 15; ++s) { const int w = SEG_IN[s][2], nb = (w + 31) >> 5; if (blk < nb) { sc = SEG_IN[s][0] + 32 * blk; dr = SEG_IN[s][1] + 32 * blk; nv = (w - 32 * blk) < 32 ? (w - 32 * blk) : 32; break; } blk -= nb; }
            conv_item(w_in + (size_t)l * DM * INC, INC, sc, nv, 64 * kb, L + LW_IN, 1024, dr, scr, F.lane); continue; }
        r -= IT_IN;
        if (r < 3 * IT_MIX) { const int w = r / IT_MIX, q = r % IT_MIX, kb = q / 32, nb = q % 32;
            conv_item((w == 0 ? w_fox : w == 1 ? w_dsa : w_ret) + (size_t)l * 512 * DM, DM, 32 * nb, 32, 64 * kb, L + LW_MIX + (size_t)w * 512 * 1024, 512, 32 * nb, scr, F.lane); continue; }
        r -= 3 * IT_MIX;
        if (r < IT_O) { const int kb = r / 32, nb = r % 32;
            conv_item(w_o + (size_t)l * DM * DM, DM, 32 * nb, 32, 64 * kb, L + LW_O, 1024, 32 * nb, scr, F.lane); continue; }
        r -= IT_O;
        if (r < IT_FI) { const int kb = r / (FF2 / 32), nb = r % (FF2 / 32); const int n0 = 32 * nb;
            const int j = n0 < FFH ? n0 : n0 - FFH; const int dr = 256 * (j >> 7) + (j & 127) + (n0 < FFH ? 0 : 128);
            conv_item(w_fi + (size_t)l * DM * FF2, FF2, n0, 32, 64 * kb, L + LW_FI, 1024, dr, scr, F.lane); continue; }
        r -= IT_FI;
        { const int kb = r / 32, nb = r % 32;
            conv_item(w_fo + (size_t)l * FFH * DM, DM, 32 * nb, 32, 64 * kb, L + LW_FO, FFH, 32 * nb, scr, F.lane); }
    }
    for (int i = F.gw * 64 + F.lane; i < DEPTH * 80 * 128; i += F.NGW * 64) { const int l = i / (80 * 128), q = i % (80 * 128);
        *(GAS v4u*)(Wb + (size_t)l * LW_STRIDE + LW_IN + (size_t)INC * 1024 + (size_t)q * 8) = (v4u){0u, 0u, 0u, 0u}; }
    f32x2* R64 = (f32x2*)(F.ws + WS_ROPE64); f32x2* R32 = (f32x2*)(F.ws + WS_ROPE32);
    for (int i = F.gw * 64 + F.lane; i < SEQ * 32; i += F.NGW * 64) { const int pos = i >> 5, k = i & 31;
        double f = 1.0; for (int e = 0; e < k; ++e) f *= 0.7498942093324559;
        const float ang = (float)pos * (float)f; float c, s; sincos_acc(ang, c, s); R64[i] = (f32x2){c, s}; }
    for (int i = F.gw * 64 + F.lane; i < SEQ * 16; i += F.NGW * 64) { const int pos = i >> 4, k = i & 15;
        double f = 1.0; for (int e = 0; e < k; ++e) f *= 0.5623413251903491;
        const float ang = (float)pos * (float)f; float c, s; sincos_acc(ang, c, s); R32[i] = (f32x2){c, s}; }
}

__device__ __forceinline__ void norm0_phase(const Ctx& F, const float* x, const float* g, bf16* o, float* SS) {
    const GAS f32x4* gp = (const GAS f32x4*)g + F.lane;
    f32x4 gv[4];
#pragma unroll
    for (int j = 0; j < 4; ++j) gv[j] = gp[64 * j];
    for (int m = F.gw; m < M; m += F.NGW) {
        const GAS f32x4* xr = (const GAS f32x4*)(x + (size_t)m * DM) + F.lane;
        f32x4 v[4]; float s = 0.f;
#pragma unroll
        for (int j = 0; j < 4; ++j) { v[j] = xr[64 * j]; s += (v[j].x * v[j].x + v[j].y * v[j].y) + (v[j].z * v[j].z + v[j].w * v[j].w); }
        s = wave_sum(s);
        GAS unsigned long long* o8 = (GAS unsigned long long*)(o + (size_t)m * DM) + F.lane;
#pragma unroll
        for (int j = 0; j < 4; ++j) o8[64 * j] = (unsigned long long)pk2(v[j].x * gv[j].x, v[j].y * gv[j].y) | ((unsigned long long)pk2(v[j].z * gv[j].z, v[j].w * gv[j].w) << 32);
        if (F.lane < 16) SS[(size_t)m * 16 + F.lane] = (F.lane == 0) ? s : 0.f;
    }
}

__device__ __forceinline__ void post_phase(const Ctx& F, const float* g_fq, const float* g_fk, const float* g_dq, const float* g_dk, const float* b_f, bool dummy_out = false) {
    bf16* Z = (bf16*)(F.ws + WS_Z); const float* ZS = (const float*)(F.ws + WS_ZS);
    const f32x2* R64 = (const f32x2*)(F.ws + WS_ROPE64); const f32x2* R32 = (const f32x2*)(F.ws + WS_ROPE32);
    float* LF = (float*)(F.ws + WS_LF); unsigned* ISG = (unsigned*)(F.ws + WS_ISG);
    bf16* KD = (bf16*)(F.ws + WS_KD); bf16* VD = (bf16*)(F.ws + WS_VD); bf16* IQB = (bf16*)(F.ws + WS_IQB); bf16* IKB = (bf16*)(F.ws + WS_IKB);
    const int t0 = blockIdx.x * 512 + F.tid, NT = F.G * 512;
#pragma unroll 1
    for (int seg = 0; seg < 3; ++seg) {
        const int col = (seg == 0) ? Z_FQ : (seg == 1) ? Z_FK : Z_DQ; const float* gp = (seg == 0) ? g_fq : (seg == 1) ? g_fk : g_dq; const float osc = (seg == 1) ? 1.0f : C2;
        for (int t = t0; t < M * 8; t += NT) { const int m = t >> 3, h = t & 7; bf16* p = Z + (size_t)m * ZP + col + h * 64;
            v4u w[8];
#pragma unroll
            for (int i = 0; i < 8; ++i) w[i] = *(const GAS v4u*)(p + 8 * i);
            float f[64]; float ss = 0.f;
#pragma unroll
            for (int i = 0; i < 8; ++i) { float t8[8]; unpack8(w[i], t8);
#pragma unroll
                for (int j = 0; j < 8; ++j) { f[8 * i + j] = t8[j]; ss += t8[j] * t8[j]; } }
            const float rs = osc / sqrtf(ss * (1.f / 64) + NORM_EPS);
#pragma unroll
            for (int d = 0; d < 64; ++d) f[d] = f[d] * rs * gp[d];
            if (seg == 2) { const f32x2* cs = R64 + (m & (SEQ - 1)) * 32;
#pragma unroll
                for (int d = 0; d < 32; ++d) { const f32x2 tt = cs[d]; const float x1 = f[d], x2 = f[d + 32]; f[d] = x1 * tt.x - x2 * tt.y; f[d + 32] = x2 * tt.x + x1 * tt.y; } }
#pragma unroll
            for (int i = 0; i < 8; ++i) { float t8[8];
#pragma unroll
                for (int j = 0; j < 8; ++j) t8[j] = f[8 * i + j];
                *(GAS v4u*)((dummy_out ? (bf16*)(F.ws + WS_HDN + 16 * MiB) + (size_t)m * 512 + h * 64 : p) + 8 * i) = pack8(t8); }
        }
    }
    for (int t = t0; t < M * 8; t += NT) { const int m = t >> 3, h = t & 7; const float* sp = ZS + (size_t)m * ZSP + S_IQ + h * 32;
        f32x4 v[8];
#pragma unroll
        for (int i = 0; i < 8; ++i) v[i] = *(const GAS f32x4*)(sp + 4 * i);
        const float aw = fabsf(ZS[(size_t)m * ZSP + S_IW + h]);
        const f32x2* cs = R32 + (m & (SEQ - 1)) * 16; float f[32];
#pragma unroll
        for (int i = 0; i < 8; ++i) { f[4 * i] = v[i].x; f[4 * i + 1] = v[i].y; f[4 * i + 2] = v[i].z; f[4 * i + 3] = v[i].w; }
#pragma unroll
        for (int d = 0; d < 16; ++d) { const f32x2 tt = cs[d]; const float x1 = f[d], x2 = f[d + 16]; f[d] = (x1 * tt.x - x2 * tt.y) * aw; f[d + 16] = (x2 * tt.x + x1 * tt.y) * aw; }
        bf16* op = IQB + (size_t)m * 256 + h * 32;
#pragma unroll
        for (int i = 0; i < 4; ++i) { float t8[8];
#pragma unroll
            for (int j = 0; j < 8; ++j) t8[j] = f[8 * i + j];
            *(GAS v4u*)(op + 8 * i) = pack8(t8); }
    }
    for (int m = t0; m < M; m += NT) { const float* sr = ZS + (size_t)m * ZSP; const int pos = m & (SEQ - 1);
        { float f[64]; float ss = 0.f;
#pragma unroll
            for (int i = 0; i < 16; ++i) { const f32x4 v = *(const GAS f32x4*)(sr + S_DK + 4 * i); f[4 * i] = v.x; f[4 * i + 1] = v.y; f[4 * i + 2] = v.z; f[4 * i + 3] = v.w; ss += (v.x * v.x + v.y * v.y) + (v.z * v.z + v.w * v.w); }
            const float rs = 1.0f / sqrtf(ss * (1.f / 64) + NORM_EPS); const f32x2* cs = R64 + pos * 32;
#pragma unroll
            for (int d = 0; d < 64; ++d) f[d] = f[d] * rs * g_dk[d];
#pragma unroll
            for (int d = 0; d < 32; ++d) { const f32x2 tt = cs[d]; const float x1 = f[d], x2 = f[d + 32]; f[d] = x1 * tt.x - x2 * tt.y; f[d + 32] = x2 * tt.x + x1 * tt.y; }
#pragma unroll
            for (int i = 0; i < 8; ++i) { float t8[8];
#pragma unroll
                for (int j = 0; j < 8; ++j) t8[j] = f[8 * i + j];
                *(GAS v4u*)(KD + (size_t)m * 64 + 8 * i) = pack8(t8); } }
#pragma unroll
        for (int i = 0; i < 8; ++i) { const f32x4 a = *(const GAS f32x4*)(sr + S_DV + 8 * i), b = *(const GAS f32x4*)(sr + S_DV + 8 * i + 4); const float t8[8] = {a.x, a.y, a.z, a.w, b.x, b.y, b.z, b.w};
            *(GAS v4u*)(VD + (size_t)m * 64 + 8 * i) = pack8(t8); }
        { float f[32]; const f32x2* cs = R32 + pos * 16;
#pragma unroll
            for (int i = 0; i < 8; ++i) { const f32x4 v = *(const GAS f32x4*)(sr + S_IK + 4 * i); f[4 * i] = v.x; f[4 * i + 1] = v.y; f[4 * i + 2] = v.z; f[4 * i + 3] = v.w; }
#pragma unroll
            for (int d = 0; d < 16; ++d) { const f32x2 tt = cs[d]; const float x1 = f[d], x2 = f[d + 16]; f[d] = x1 * tt.x - x2 * tt.y; f[d + 16] = x2 * tt.x + x1 * tt.y; }
#pragma unroll
            for (int i = 0; i < 4; ++i) { float t8[8];
#pragma unroll
                for (int j = 0; j < 8; ++j) t8[j] = f[8 * i + j];
                *(GAS v4u*)(IKB + (size_t)m * 32 + 8 * i) = pack8(t8); } }
        { const f32x4 w0 = *(const GAS f32x4*)(sr + S_IW), w1 = *(const GAS f32x4*)(sr + S_IW + 4); const float iw[8] = {w0.x, w0.y, w0.z, w0.w, w1.x, w1.y, w1.z, w1.w}; unsigned sg = 0;
#pragma unroll
            for (int h = 0; h < 8; ++h) sg |= (iw[h] < 0.f ? 1u : 0u) << h;
            ISG[m] = sg;
            const f32x4 f0 = *(const GAS f32x4*)(sr + S_FF), f1 = *(const GAS f32x4*)(sr + S_FF + 4); const float ff[8] = {f0.x, f0.y, f0.z, f0.w, f1.x, f1.y, f1.z, f1.w}; float lf[8];
#pragma unroll
            for (int h = 0; h < 8; ++h) { const float xx = ff[h] + b_f[h]; lf[h] = (fminf(xx, 0.f) - __logf(1.0f + __expf(-fabsf(xx)))) * LOG2E; }
            *(GAS f32x4*)(LF + (size_t)m * 8) = (f32x4){lf[0], lf[1], lf[2], lf[3]}; *(GAS f32x4*)(LF + (size_t)m * 8 + 4) = (f32x4){lf[4], lf[5], lf[6], lf[7]}; }
    }
}

__device__ __forceinline__ float ret_l2g(int h) { return h == 0 ? -0.04580368961312479f : h == 1 ? -0.02272007650008353f : h == 2 ? -0.011315313227834146f : -0.005646563141142063f; }

__device__ __forceinline__ void scan_state_phase(const Ctx& F) {
    const float* LF = (const float*)(F.ws + WS_LF); float* CF = (float*)(F.ws + WS_CF);
    const bf16* Z = (const bf16*)(F.ws + WS_Z); float* RS = (float*)(F.ws + WS_HDN);
    if (F.gw < 32) {
        const int b = F.gw >> 3, h = F.gw & 7; const float* lp = LF + ((size_t)b * SEQ + F.lane * 64) * 8 + h; float s = 0.f;
        for (int i = 0; i < 64; ++i) s += lp[i * 8];
        float incl = s;
#pragma unroll
        for (int o = 1; o < 64; o <<= 1) { const float t = __builtin_bit_cast(float, __builtin_amdgcn_ds_bpermute(((F.lane - o) & 63) << 2, __builtin_bit_cast(int, incl))); if (F.lane >= o) incl += t; }
        float run = incl - s; float* cp = CF + (size_t)F.gw * SEQ + F.lane * 64;
        for (int i = 0; i < 64; ++i) { run += lp[i * 8]; cp[i] = run; }
    }
    for (int u = blockIdx.x; u < NB * 32 * 4; u += F.G) {
        const int h = u & 3, c = (u >> 2) & 31, b = u >> 7; const float l2g = ret_l2g(h);
        const int d = F.tid >> 3, e0 = (F.tid & 7) * 16; float acc[16];
#pragma unroll
        for (int i = 0; i < 16; ++i) acc[i] = 0.f;
        const bf16* base = Z + ((size_t)b * SEQ + c * 128) * ZP;
        for (int j = 0; j < 128; ++j) { const bf16* row = base + (size_t)j * ZP;
            const float kd = bf2f(row[Z_RK + h * 64 + d]) * exp2f((float)(127 - j) * l2g);
            const v4u w0 = *(const GAS v4u*)(row + Z_RV + h * 128 + e0), w1 = *(const GAS v4u*)(row + Z_RV + h * 128 + e0 + 8);
            float v0[8], v1[8]; unpack8(w0, v0); unpack8(w1, v1);
#pragma unroll
            for (int i = 0; i < 8; ++i) { acc[i] += kd * v0[i]; acc[8 + i] += kd * v1[i]; } }
        float* o = RS + (size_t)u * 8192 + d * 128 + e0;
#pragma unroll
        for (int i = 0; i < 4; ++i) *(GAS f32x4*)(o + 4 * i) = (f32x4){acc[4 * i], acc[4 * i + 1], acc[4 * i + 2], acc[4 * i + 3]};
    }
}

__device__ __forceinline__ void ret_out_naive(const Ctx& F, const float* gn) {
    bf16* Z = (bf16*)(F.ws + WS_Z); const float* RS = (const float*)(F.ws + WS_HDN);
    LAS float* S = (LAS float*)(F.lds);
    LAS bf16* Vt = (LAS bf16*)(F.lds + 32768);
    LAS float* Kt = (LAS float*)(F.lds + 65536);
    LAS float* aw = (LAS float*)(F.lds + 65536 + 33280) + F.wave * 128;
    LAS float* qw = (LAS float*)(F.lds + 65536 + 33280 + 4096) + F.wave * 64;
    for (int u = blockIdx.x; u < NB * 32 * 4; u += F.G) {
        const int h = u & 3, c = (u >> 2) & 31, b = u >> 7; const float l2g = ret_l2g(h); const float wch = exp2f(128.f * l2g);
        __syncthreads();
        { float s[16];
#pragma unroll
            for (int i = 0; i < 16; ++i) s[i] = 0.f;
            for (int cp = 0; cp < c; ++cp) { const float* L = RS + ((size_t)((b * 32 + cp) * 4 + h)) * 8192 + F.tid;
#pragma unroll
                for (int i = 0; i < 16; ++i) s[i] = wch * s[i] + L[i * 512]; }
#pragma unroll
            for (int i = 0; i < 16; ++i) S[F.tid + i * 512] = s[i]; }
        const bf16* base = Z + ((size_t)b * SEQ + c * 128) * ZP;
        for (int q = F.tid; q < 2048; q += 512) { const int r = q >> 4, ch = q & 15; *(LAS v4u*)(Vt + r * 128 + ch * 8) = *(const GAS v4u*)(base + (size_t)r * ZP + Z_RV + h * 128 + ch * 8); }
        for (int q = F.tid; q < 128 * 64; q += 512) { const int r = q >> 6, dd = q & 63; Kt[r * 65 + dd] = bf2f(base[(size_t)r * ZP + Z_RK + h * 64 + dd]); }
        __syncthreads();
        for (int i = F.wave; i < 128; i += NWAVES) {
            const size_t m = (size_t)b * SEQ + c * 128 + i; bf16* zr = Z + m * ZP;
            qw[F.lane] = bf2f(zr[Z_RQ + h * 64 + F.lane]);
            LDS_WAIT(); asm volatile("" ::: "memory");
#pragma unroll
            for (int jj = 0; jj < 2; ++jj) { const int j = F.lane + 64 * jj; float a = 0.f;
                if (j <= i) { float dot = 0.f; for (int dd = 0; dd < 64; ++dd) dot += qw[dd] * Kt[j * 65 + dd]; a = dot * exp2f((float)(i - j) * l2g); }
                aw[j] = a; }
            LDS_WAIT(); asm volatile("" ::: "memory");
            float o[2]; const float dq = exp2f((float)(i + 1) * l2g);
#pragma unroll
            for (int ee = 0; ee < 2; ++ee) { const int e = F.lane + 64 * ee; float acc = 0.f;
                for (int j = 0; j <= i; ++j) acc += aw[j] * bf2f(Vt[j * 128 + e]);
                float cr = 0.f; for (int dd = 0; dd < 64; ++dd) cr += qw[dd] * S[dd * 128 + e];
                o[ee] = acc + cr * dq; }
            const float ss = wave_sum(o[0] * o[0] + o[1] * o[1]); const float rstd = 1.0f / sqrtf(ss * (1.f / 128) + NORM_EPS);
#pragma unroll
            for (int ee = 0; ee < 2; ++ee) { const int e = F.lane + 64 * ee; const float rg = bf2f(zr[Z_RG + h * 128 + e]);
                zr[Z_RV + h * 128 + e] = (bf16)f2bf(o[ee] * rstd * gn[h * 128 + e] * rg * sigmoid_f(rg)); }
            LDS_WAIT(); asm volatile("" ::: "memory");
        }
    }
    __syncthreads();
}

__device__ __forceinline__ void fox_naive(const Ctx& F) {
    bf16* Z = (bf16*)(F.ws + WS_Z); const float* CF = (const float*)(F.ws + WS_CF);
    LAS float* sc = (LAS float*)(F.lds + F.wave * 16384);
    const int lane = F.lane;
    int it = 0;
    for (int r0 = 0; r0 < NB * 8 * SEQ; r0 += F.NGW, ++it) {
        const int r = r0 + ((it & 1) ? (F.NGW - 1 - F.gw) : F.gw);
        if (r >= NB * 8 * SEQ) continue;
        const int pos = r & (SEQ - 1), h = (r >> 12) & 7, b = r >> 15;
        const size_t m = (size_t)b * SEQ + pos;
        float qf[64];
        { const bf16* qp = Z + m * ZP + Z_FQ + h * 64;
#pragma unroll
            for (int i = 0; i < 8; ++i) { const v4u w = *(const GAS v4u*)(qp + 8 * i); float t[8]; unpack8(w, t);
#pragma unroll
                for (int j = 0; j < 8; ++j) qf[8 * i + j] = t[j]; } }
        const float* cf = CF + (size_t)(b * 8 + h) * SEQ;
        float mx = -INFINITY;
        for (int kk = lane; kk <= pos; kk += 64) { const bf16* kp = Z + ((size_t)b * SEQ + kk) * ZP + Z_FK + h * 64; float dot = 0.f;
#pragma unroll
            for (int i = 0; i < 8; ++i) { const v4u w = *(const GAS v4u*)(kp + 8 * i); float t[8]; unpack8(w, t);
#pragma unroll
                for (int j = 0; j < 8; ++j) dot += qf[8 * i + j] * t[j]; }
            const float s = dot - cf[kk]; sc[kk] = s; mx = fmaxf(mx, s); }
        mx = wave_max(mx);
        float sum = 0.f;
        for (int kk = lane; kk <= pos; kk += 64) { const float p = exp2f(sc[kk] - mx); sc[kk] = p; sum += p; }
        sum = wave_sum(sum);
        LDS_WAIT(); asm volatile("" ::: "memory");
        const bf16* vp = Z + (size_t)b * SEQ * ZP + Z_FV + h * 64 + lane;
        float o0 = 0.f, o1 = 0.f, o2 = 0.f, o3 = 0.f; int kk = 0;
        for (; kk + 3 <= pos; kk += 4) { o0 += sc[kk] * bf2f(vp[(size_t)kk * ZP]); o1 += sc[kk + 1] * bf2f(vp[(size_t)(kk + 1) * ZP]); o2 += sc[kk + 2] * bf2f(vp[(size_t)(kk + 2) * ZP]); o3 += sc[kk + 3] * bf2f(vp[(size_t)(kk + 3) * ZP]); }
        for (; kk <= pos; ++kk) o0 += sc[kk] * bf2f(vp[(size_t)kk * ZP]);
        Z[m * ZP + Z_FQ + h * 64 + lane] = (bf16)f2bf(((o0 + o1) + (o2 + o3)) / sum);
        LDS_WAIT(); asm volatile("" ::: "memory");
    }
}

__device__ __forceinline__ unsigned f2key(float s) { const unsigned u = __builtin_bit_cast(unsigned, s + 0.0f); return (u & 0x80000000u) ? ~u : (u | 0x80000000u); }
__device__ __forceinline__ void dsa_naive(const Ctx& F) {
    bf16* Z = (bf16*)(F.ws + WS_Z); const float* ZS = (const float*)(F.ws + WS_ZS);
    const unsigned* ISG = (const unsigned*)(F.ws + WS_ISG);
    const bf16* KD = (const bf16*)(F.ws + WS_KD); const bf16* VD = (const bf16*)(F.ws + WS_VD);
    LAS unsigned* kl = (LAS unsigned*)(F.lds + F.wave * 16384);
    LAS float* iqs = (LAS float*)(F.lds + XTRA_OFF + F.wave * 1536);
    const int lane = F.lane;
    int it = 0;
    for (int r0 = 0; r0 < M; r0 += F.NGW, ++it) {
        const int r = r0 + ((it & 1) ? (F.NGW - 1 - F.gw) : F.gw);
        if (r >= M) continue;
        const int pos = r & (SEQ - 1), b = r >> 12; const size_t m = (size_t)r;
        *(LAS f32x4*)(iqs + 4 * lane) = *(const GAS f32x4*)(ZS + m * ZSP + S_IQ + 4 * lane);
        const unsigned sg = ISG[m];
        LDS_WAIT(); asm volatile("" ::: "memory");
        for (int kk = lane; kk <= pos; kk += 64) { const float* ikp = ZS + ((size_t)b * SEQ + kk) * ZSP + S_IK; float ik[32];
#pragma unroll
            for (int i = 0; i < 8; ++i) { const f32x4 t = *(const GAS f32x4*)(ikp + 4 * i); ik[4 * i] = t.x; ik[4 * i + 1] = t.y; ik[4 * i + 2] = t.z; ik[4 * i + 3] = t.w; }
            float s = 0.f;
#pragma unroll 1
            for (int h = 0; h < 8; ++h) { float dot = 0.f;
#pragma unroll
                for (int dd = 0; dd < 32; ++dd) dot += iqs[h * 32 + dd] * ik[dd];
                dot = fmaxf(dot, 0.f); s += ((sg >> h) & 1u) ? -dot : dot; }
            kl[kk] = f2key(s); }
        LDS_WAIT(); asm volatile("" ::: "memory");
        unsigned key[64];
#pragma unroll
        for (int j = 0; j < 64; ++j) { const int kk = j * 64 + lane; key[j] = (kk <= pos) ? kl[kk] : 0u; }
        LDS_WAIT(); asm volatile("" ::: "memory");
        LAS unsigned* idx = kl; LAS float* pl = (LAS float*)(kl + 256); LAS bf16* qs = (LAS bf16*)(kl + 512);
        *(LAS v4u*)(qs + 8 * lane) = *(const GAS v4u*)(Z + m * ZP + Z_DQ + 8 * lane);
        unsigned T = 0u; int need = 0;
        if (pos + 1 > 256) {
            for (int bit = 31; bit >= 0; --bit) { const unsigned Tt = T | (1u << bit); int cnt = 0;
#pragma unroll
                for (int j = 0; j < 64; ++j) cnt += __builtin_popcountll(__ballot(key[j] >= Tt));
                if (cnt >= 256) T = Tt; }
            int ngt = 0;
#pragma unroll
            for (int j = 0; j < 64; ++j) ngt += __builtin_popcountll(__ballot(key[j] > T));
            need = 256 - ngt;
        }
        int nsel = 0, eqb = 0;
#pragma unroll
        for (int j = 0; j < 64; ++j) { const bool gt = key[j] > T, eq = (key[j] == T) && (T != 0u);
            const unsigned long long em = __ballot(eq); const int er = eqb + __builtin_amdgcn_mbcnt_hi((unsigned)(em >> 32), __builtin_amdgcn_mbcnt_lo((unsigned)em, 0u));
            const bool sel = gt || (eq && er < need); eqb += __builtin_popcountll(em);
            const unsigned long long sm = __ballot(sel); const int sp = nsel + __builtin_amdgcn_mbcnt_hi((unsigned)(sm >> 32), __builtin_amdgcn_mbcnt_lo((unsigned)sm, 0u));
            if (sel) idx[sp] = (unsigned)(j * 64 + lane); nsel += __builtin_popcountll(sm); }
        LDS_WAIT(); asm volatile("" ::: "memory");
        for (int h = 0; h < 8; ++h) {
            float sv[4]; float mx = -INFINITY;
#pragma unroll
            for (int i = 0; i < 4; ++i) { const int e = lane + 64 * i; sv[i] = -INFINITY;
                if (e < nsel) { const bf16* kp = KD + ((size_t)b * SEQ + idx[e]) * 64; float dot = 0.f;
#pragma unroll
                    for (int c = 0; c < 8; ++c) { const v4u w = *(const GAS v4u*)(kp + 8 * c); float t[8]; unpack8(w, t); const v4u qw = *(const LAS v4u*)(qs + h * 64 + 8 * c); float qq[8]; unpack8(qw, qq);
#pragma unroll
                        for (int j = 0; j < 8; ++j) dot += qq[j] * t[j]; }
                    sv[i] = dot; }
                mx = fmaxf(mx, sv[i]); }
            mx = wave_max(mx); float sum = 0.f;
#pragma unroll
            for (int i = 0; i < 4; ++i) { const int e = lane + 64 * i; const float p = (e < nsel) ? exp2f(sv[i] - mx) : 0.f; pl[e] = p; sum += p; }
            sum = wave_sum(sum);
            LDS_WAIT(); asm volatile("" ::: "memory");
            float o0 = 0.f, o1 = 0.f; int e = 0;
            for (; e + 1 < nsel; e += 2) { o0 += pl[e] * bf2f(VD[((size_t)b * SEQ + idx[e]) * 64 + lane]); o1 += pl[e + 1] * bf2f(VD[((size_t)b * SEQ + idx[e + 1]) * 64 + lane]); }
            if (e < nsel) o0 += pl[e] * bf2f(VD[((size_t)b * SEQ + idx[e]) * 64 + lane]);
            Z[m * ZP + Z_DQ + h * 64 + lane] = (bf16)f2bf((o0 + o1) / sum);
            LDS_WAIT(); asm volatile("" ::: "memory");
        }
    }
}
#ifndef PROBE_D
#define PROBE_D 0
#endif

typedef short s16x8 __attribute__((ext_vector_type(8)));
typedef short s16x4 __attribute__((ext_vector_type(4)));
typedef short v4i16_t __attribute__((ext_vector_type(4)));
__device__ __forceinline__ s16x4 tr16(const LAS unsigned char* p) { return __builtin_bit_cast(s16x4, __builtin_amdgcn_ds_read_tr16_b64_v4i16((LAS v4i16_t*)p)); }
__device__ __forceinline__ float key2f(unsigned k) { return __builtin_bit_cast(float, (k & 0x80000000u) ? (k & 0x7fffffffu) : ~k); }

template <int NR> __device__ __forceinline__ int dsa_count_ge(const unsigned (&key)[64], unsigned T) {
    int c = 0;
#pragma unroll
    for (int j = 0; j < NR; ++j) c += __builtin_popcountll(__ballot(key[j] >= T));
    return c;
}
#define DSA_COUNT_GE(T_, out_) do { if (nq == 1) out_ = dsa_count_ge<16>(key, (T_)); else if (nq == 2) out_ = dsa_count_ge<32>(key, (T_)); else if (nq == 3) out_ = dsa_count_ge<48>(key, (T_)); else out_ = dsa_count_ge<64>(key, (T_)); } while (0)
__device__ __forceinline__ void dsa_select(const unsigned (&key)[64], int nvalid, unsigned& T, int& need) {
    const int nq = __builtin_amdgcn_readfirstlane((nvalid + 1023) >> 10);
    T = 0u; need = 0;
    if (nvalid <= 256) return;
    unsigned kmax = 0u;
#pragma unroll
    for (int j = 0; j < 64; ++j) kmax = key[j] > kmax ? key[j] : kmax;
#pragma unroll
    for (int o_ = 0; o_ < 1; ++o_) { unsigned t; t = sxu<1>(kmax); kmax = t > kmax ? t : kmax; t = sxu<2>(kmax); kmax = t > kmax ? t : kmax; t = sxu<4>(kmax); kmax = t > kmax ? t : kmax; t = sxu<8>(kmax); kmax = t > kmax ? t : kmax; t = sxu<16>(kmax); kmax = t > kmax ? t : kmax;
        unsigned a_, b_; swap32(kmax, a_, b_); kmax = a_ > b_ ? a_ : b_; }
    unsigned lo = 1u, hi = kmax + 1u; int hic = 0;
    { const float vm = fabsf(key2f(kmax)) + 1.0f; unsigned l2 = f2key(-vm * 64.0f); int c; DSA_COUNT_GE(l2, c); if (c >= 256) lo = l2; }
    int iter = 0; bool exact = false;
    while (hi - lo > 1u) {
        unsigned mid;
        if (iter < 24 && lo > 1u) { const float mv = 0.5f * key2f(lo) + 0.5f * key2f(hi - 1u); mid = f2key(mv); }
        else mid = lo + ((hi - lo) >> 1);
        if (mid <= lo) mid = lo + 1u; if (mid >= hi) mid = hi - 1u;
        int c; DSA_COUNT_GE(mid, c);
        if (c == 256) { T = mid; exact = true; break; }
        if (c > 256) lo = mid; else { hi = mid; hic = c; }
        ++iter;
    }
    if (exact) need = 256; else { T = lo; need = 256 - hic; }
}

__device__ __forceinline__ void dsa_attend(const bf16* zq, bf16* zo, const bf16* KDb, const bf16* VDb, const LAS unsigned short* idx, int nsel, LAS unsigned char* vst, int lane) {
    const int g = lane >> 4, c = lane & 15;
    s16x8 qf[2];
#pragma unroll
    for (int ks = 0; ks < 2; ++ks) { qf[ks] = (s16x8){0, 0, 0, 0, 0, 0, 0, 0}; if (c < 8) qf[ks] = *(const GAS s16x8*)(zq + c * 64 + 32 * ks + 8 * g); }
    f32x4 acc[16];
    v4u vreg[16];
#pragma unroll
    for (int i = 0; i < 16; ++i) { const int pi = lane + 64 * i, r = pi >> 3, c16 = pi & 7; const int id = (r < nsel) ? (int)idx[r] : 0; vreg[i] = *(const GAS v4u*)(VDb + (size_t)id * 64 + c16 * 8); }
#pragma unroll
    for (int tb = 0; tb < 2; ++tb) {
        s16x8 kf[8][2];
#pragma unroll
        for (int tt = 0; tt < 8; ++tt) { const int e = 16 * (8 * tb + tt) + c; const int id = (e < nsel) ? (int)idx[e] : 0; const bf16* kp = KDb + (size_t)id * 64 + 8 * g;
            kf[tt][0] = *(const GAS s16x8*)kp; kf[tt][1] = *(const GAS s16x8*)(kp + 32); }
#pragma unroll
        for (int tt = 0; tt < 8; ++tt) { f32x4 a = (f32x4){0.f, 0.f, 0.f, 0.f};
            a = __builtin_amdgcn_mfma_f32_16x16x32_bf16(kf[tt][0], qf[0], a, 0, 0, 0); a = __builtin_amdgcn_mfma_f32_16x16x32_bf16(kf[tt][1], qf[1], a, 0, 0, 0); acc[8 * tb + tt] = a; }
    }
    float mx = -INFINITY;
#pragma unroll
    for (int t = 0; t < 16; ++t)
#pragma unroll
        for (int i = 0; i < 4; ++i) { const int e = 16 * t + 4 * g + i; if (e >= nsel) acc[t][i] = -INFINITY; mx = fmaxf(mx, acc[t][i]); }
    mx = fmaxf(mx, sx<16>(mx)); mx = half_max(mx);
    float sum = 0.f;
#pragma unroll
    for (int t = 0; t < 16; ++t)
#pragma unroll
        for (int i = 0; i < 4; ++i) { const float p = __builtin_amdgcn_exp2f(acc[t][i] - mx); acc[t][i] = p; sum += p; }
    sum += sx<16>(sum); sum = half_sum(sum);
    const float inv = 1.0f / sum;
    s16x8 pf[8];
#pragma unroll
    for (int s = 0; s < 8; ++s) { v4u w; w.x = pk2(acc[2 * s][0] * inv, acc[2 * s][1] * inv); w.y = pk2(acc[2 * s][2] * inv, acc[2 * s][3] * inv); w.z = pk2(acc[2 * s + 1][0] * inv, acc[2 * s + 1][1] * inv); w.w = pk2(acc[2 * s + 1][2] * inv, acc[2 * s + 1][3] * inv);
        pf[s] = __builtin_bit_cast(s16x8, w); }
    f32x4 o[4];
#pragma unroll
    for (int db = 0; db < 4; ++db) o[db] = (f32x4){0.f, 0.f, 0.f, 0.f};
    const int q = (lane >> 2) & 3, p = lane & 3, swz = 2 * (g & 1) + (q >> 1);
    const LAS unsigned char* rb = vst + (4 * g + q) * 128 + 8 * p;
#pragma unroll
    for (int hh = 0; hh < 2; ++hh) {
        asm volatile("s_waitcnt lgkmcnt(0)" ::: "memory");
#pragma unroll
        for (int i = 0; i < 16; ++i) { const int pi = lane + 64 * i, r = pi >> 3, c16 = pi & 7;
            *(LAS v4u*)(vst + r * 128 + ((((c16 >> 1) ^ ((r >> 1) & 3))) << 5) + ((c16 & 1) << 4)) = vreg[i]; }
        if (hh == 0) {
#pragma unroll
            for (int i = 0; i < 16; ++i) { const int pi = lane + 64 * i, r = pi >> 3, c16 = pi & 7, e = 128 + r; const int id = (e < nsel) ? (int)idx[e] : 0; vreg[i] = *(const GAS v4u*)(VDb + (size_t)id * 64 + c16 * 8); } }
        asm volatile("s_waitcnt lgkmcnt(0)" ::: "memory");
#pragma unroll
        for (int s4 = 0; s4 < 4; ++s4)
#pragma unroll
            for (int db = 0; db < 4; ++db) { const LAS unsigned char* a1 = rb + s4 * 4096 + ((db ^ swz) << 5);
                const s16x4 lo = tr16(a1), hi = tr16(a1 + 2048);
                const s16x8 vf = (s16x8){lo[0], lo[1], lo[2], lo[3], hi[0], hi[1], hi[2], hi[3]};
                o[db] = __builtin_amdgcn_mfma_f32_16x16x32_bf16(pf[4 * hh + s4], vf, o[db], 0, 0, 0); }
    }
    if (g < 2) {
#pragma unroll
        for (int db = 0; db < 4; ++db)
#pragma unroll
            for (int i = 0; i < 4; ++i) zo[(4 * g + i) * 64 + 16 * db + c] = (bf16)f2bf(o[db][i]);
    }
}

__device__ __forceinline__ void dsa_v2(const Ctx& F) {
    bf16* Z = (bf16*)(F.ws + WS_Z); const float* ZS = (const float*)(F.ws + WS_ZS);
    const unsigned* ISG = (const unsigned*)(F.ws + WS_ISG);
    const bf16* KD = (const bf16*)(F.ws + WS_KD); const bf16* VD = (const bf16*)(F.ws + WS_VD);
    LAS unsigned* kl = (LAS unsigned*)(F.lds + F.wave * 16384);
    LAS float* iqs = (LAS float*)(F.lds + XTRA_OFF + F.wave * 1536);
    LAS unsigned short* idx = (LAS unsigned short*)(F.lds + XTRA_OFF + F.wave * 1536 + 1024);
    const int lane = F.lane;
    int it = 0;
    for (int r0 = 0; r0 < M; r0 += F.NGW, ++it) {
        const int r = r0 + ((it & 1) ? (F.NGW - 1 - F.gw) : F.gw);
        if (r >= M) continue;
        const int pos = r & (SEQ - 1), b = r >> 12; const size_t m = (size_t)r;
        *(LAS f32x4*)(iqs + 4 * lane) = *(const GAS f32x4*)(ZS + m * ZSP + S_IQ + 4 * lane);
        const unsigned sg = ISG[m];
        LDS_WAIT(); asm volatile("" ::: "memory");
        for (int kk = lane; kk <= pos; kk += 64) { const float* ikp = ZS + ((size_t)b * SEQ + kk) * ZSP + S_IK; float ik[32];
#pragma unroll
            for (int i = 0; i < 8; ++i) { const f32x4 t = *(const GAS f32x4*)(ikp + 4 * i); ik[4 * i] = t.x; ik[4 * i + 1] = t.y; ik[4 * i + 2] = t.z; ik[4 * i + 3] = t.w; }
            float s = 0.f;
#pragma unroll 1
            for (int h = 0; h < 8; ++h) { float dot = 0.f;
#pragma unroll
                for (int dd = 0; dd < 32; ++dd) dot += iqs[h * 32 + dd] * ik[dd];
                dot = fmaxf(dot, 0.f); s += ((sg >> h) & 1u) ? -dot : dot; }
            kl[kk] = f2key(s); }
        LDS_WAIT(); asm volatile("" ::: "memory");
        unsigned key[64];
#pragma unroll
        for (int j = 0; j < 64; ++j) { const int kk = j * 64 + lane; key[j] = (kk <= pos) ? kl[kk] : 0u; }
        LDS_WAIT(); asm volatile("" ::: "memory");
        unsigned T; int need;
#ifdef DSA_OLDSEL
        T = 0u; need = 0;
        if (pos + 1 > 256) {
            for (int bit = 31; bit >= 0; --bit) { const unsigned Tt = T | (1u << bit); int cnt = 0;
#pragma unroll
                for (int j = 0; j < 64; ++j) cnt += __builtin_popcountll(__ballot(key[j] >= Tt));
                if (cnt >= 256) T = Tt; }
            int ngt = 0;
#pragma unroll
            for (int j = 0; j < 64; ++j) ngt += __builtin_popcountll(__ballot(key[j] > T));
            need = 256 - ngt;
        }
#else
        dsa_select(key, pos + 1, T, need);
#endif
        int nsel = 0, eqb = 0;
#pragma unroll
        for (int j = 0; j < 64; ++j) { const bool gt = key[j] > T, eq = (key[j] == T) && (T != 0u);
            const unsigned long long em = __ballot(eq); const int er = eqb + __builtin_amdgcn_mbcnt_hi((unsigned)(em >> 32), __builtin_amdgcn_mbcnt_lo((unsigned)em, 0u));
            const bool sel = gt || (eq && er < need); eqb += __builtin_popcountll(em);
            const unsigned long long sm = __ballot(sel); const int sp = nsel + __builtin_amdgcn_mbcnt_hi((unsigned)(sm >> 32), __builtin_amdgcn_mbcnt_lo((unsigned)sm, 0u));
            if (sel) idx[sp] = (unsigned short)(j * 64 + lane); nsel += __builtin_popcountll(sm); }
        LDS_WAIT(); asm volatile("" ::: "memory");
        dsa_attend(Z + m * ZP + Z_DQ, Z + m * ZP + Z_DQ, KD + (size_t)b * SEQ * 64, VD + (size_t)b * SEQ * 64, idx, nsel, (LAS unsigned char*)kl, lane);
        LDS_WAIT(); asm volatile("" ::: "memory");
    }
}

template <int NR> __device__ __forceinline__ int dsa_emit_n(const unsigned (&key)[64], unsigned T, int need, LAS unsigned short* idx, int lane) {
    int nsel = 0, eqb = 0;
#pragma unroll
    for (int j = 0; j < NR; ++j) { const bool gt = key[j] > T, eq = (key[j] == T) && (T != 0u);
        const unsigned long long em = __ballot(eq); const int er = eqb + __builtin_amdgcn_mbcnt_hi((unsigned)(em >> 32), __builtin_amdgcn_mbcnt_lo((unsigned)em, 0u));
        const bool sel = gt || (eq && er < need); eqb += __builtin_popcountll(em);
        const unsigned long long sm = __ballot(sel); const int sp = nsel + __builtin_amdgcn_mbcnt_hi((unsigned)(sm >> 32), __builtin_amdgcn_mbcnt_lo((unsigned)sm, 0u));
        if (sel) idx[sp] = (unsigned short)(j * 64 + lane); nsel += __builtin_popcountll(sm); }
    return nsel;
}
__device__ __forceinline__ int dsa_emit(const unsigned (&key)[64], int nvalid, unsigned T, int need, LAS unsigned short* idx, int lane) {
    const int nq = __builtin_amdgcn_readfirstlane((nvalid + 1023) >> 10);
    if (nq == 1) return dsa_emit_n<16>(key, T, need, idx, lane);
    if (nq == 2) return dsa_emit_n<32>(key, T, need, idx, lane);
    if (nq == 3) return dsa_emit_n<48>(key, T, need, idx, lane);
    return dsa_emit_n<64>(key, T, need, idx, lane);
}

template <int NR> __device__ __forceinline__ int dsa_lane_count(const unsigned (&key)[64], unsigned T) {
    int c = 0;
#pragma unroll
    for (int j = 0; j < NR; ++j) c += (key[j] >= T) ? 1 : 0;
    return c;
}
#define DSA_LCOUNT(T_, lc_) do { if (nq == 1) lc_ = dsa_lane_count<16>(key, (T_)); else if (nq == 2) lc_ = dsa_lane_count<32>(key, (T_)); else if (nq == 3) lc_ = dsa_lane_count<48>(key, (T_)); else lc_ = dsa_lane_count<64>(key, (T_)); } while (0)
template <int NR> __device__ __forceinline__ void dsa_write_ge(const unsigned (&key)[64], unsigned T, int off, LAS unsigned short* idx, int lane) {
    const int dummy = 256 + lane;
#pragma unroll
    for (int j = 0; j < NR; ++j) { const bool s = key[j] >= T; idx[s ? off : dummy] = (unsigned short)(j * 64 + lane); off += s ? 1 : 0; }
}
__device__ __forceinline__ int dsa_select2(const unsigned (&key)[64], int nvalid, LAS unsigned short* idx, int lane) {
    const int nq = __builtin_amdgcn_readfirstlane((nvalid + 1023) >> 10);
    unsigned T = 1u; int lc = 0; bool exact = true;
    if (nvalid > 256) {
        float s1 = 0.f, s2 = 0.f; unsigned kmax = 0u, kmin = 0xffffffffu;
#pragma unroll
        for (int j = 0; j < 64; ++j) { const unsigned k = key[j]; const bool ok = k != 0u; const float vv = ok ? key2f(k) : 0.f; s1 += vv; s2 += vv * vv; kmax = k > kmax ? k : kmax; kmin = (ok && k < kmin) ? k : kmin; }
        s1 = wave_sum(s1); s2 = wave_sum(s2);
        kmax = wave_umax(kmax); kmin = wave_umin(kmin);
        const float n = (float)nvalid, mean = s1 / n, sd = sqrtf(fmaxf(s2 / n - mean * mean, 1e-30f));
        const float pfrac = 256.0f / n, pt = fminf(pfrac, 1.0f - pfrac);
        const float tt = sqrtf(-2.0f * __logf(fmaxf(pt, 1e-6f)));
        float z = tt - (2.515517f + 0.802853f * tt + 0.010328f * tt * tt) / (1.0f + 1.432788f * tt + 0.189269f * tt * tt + 0.001308f * tt * tt * tt);
        if (pfrac > 0.5f) z = -z;
        const float dens = n * __expf(-0.5f * z * z) * 0.3989423f / sd;
        unsigned lo = kmin, hi = kmax + 1u; int clo = nvalid, chi = 0;
        exact = false; int same = 0, last = 0;
        for (int it = 0; hi - lo > 1u; ++it) {
            unsigned mid;
            if (it == 0) mid = f2key(mean + z * sd);
            else if (it == 1) { const float base = key2f(last > 0 ? lo : hi); const float c0 = (float)(last > 0 ? clo : chi); mid = f2key(base + 1.3f * (c0 - 256.0f) / dens); }
            else if (it < 24 && same < 2) { const float vlo = key2f(lo), vhi = key2f(hi - 1u); mid = f2key(vlo + (vhi - vlo) * (((float)(clo - 256) + 0.5f) / (float)(clo - chi))); }
            else if (it < 48) { mid = f2key(0.5f * key2f(lo) + 0.5f * key2f(hi - 1u)); same = 0; }
            else mid = lo + ((hi - lo) >> 1);
            if (!(mid > lo)) mid = lo + 1u; if (!(mid < hi)) mid = hi - 1u;
            DSA_LCOUNT(mid, lc); const int c = wave_isum(lc);
            if (c == 256) { T = mid; exact = true; break; }
            if (c > 256) { lo = mid; clo = c; same = (last > 0) ? same + 1 : 0; last = 1; } else { hi = mid; chi = c; same = (last < 0) ? same + 1 : 0; last = -1; }
        }
        if (!exact) {
            const int nsel = dsa_emit(key, nvalid, lo, 256 - chi, idx, lane);
            return nsel;
        }
    } else { DSA_LCOUNT(1u, lc); }
    int incl = lc;
#pragma unroll
    for (int o = 1; o < 64; o <<= 1) { const int t = __builtin_amdgcn_ds_bpermute(((lane - o) & 63) << 2, incl); if (lane >= o) incl += t; }
    const int total = __builtin_amdgcn_readlane(incl, 63);
    if (nq == 1) dsa_write_ge<16>(key, T, incl - lc, idx, lane); else if (nq == 2) dsa_write_ge<32>(key, T, incl - lc, idx, lane); else if (nq == 3) dsa_write_ge<48>(key, T, incl - lc, idx, lane); else dsa_write_ge<64>(key, T, incl - lc, idx, lane);
    return total;
}

constexpr int DSA_ROWF = 4100;
__device__ __forceinline__ void dsa_v3(const Ctx& F, int out_col = Z_DQ) {
    bf16* Z = (bf16*)(F.ws + WS_Z);
    const unsigned* ISG = (const unsigned*)(F.ws + WS_ISG);
    const bf16* KD = (const bf16*)(F.ws + WS_KD); const bf16* VD = (const bf16*)(F.ws + WS_VD);
    const bf16* IQB = (const bf16*)(F.ws + WS_IQB); const bf16* IKB = (const bf16*)(F.ws + WS_IKB);
    LAS unsigned* img = (LAS unsigned*)(F.lds);
    LAS unsigned short* idxw = (LAS unsigned short*)(F.lds + XTRA_OFF + F.wave * 1536);
    const int w = F.wave;
    const int v = (int)blockIdx.x;
    if (v < 256)
    for (int ui = 0; ui < 8; ++ui) {
        int lane_ = F.lane; asm volatile("" : "+v"(lane_)); const int lane = lane_, g = lane >> 4, c = lane & 15;
        const int b = v >> 6, k = v & 63; const int pb = 128 * (ui >> 1) + ((ui & 1) ? 127 - k : k);
        const int q0 = pb * 8, kend = q0 + 8, ntile = (kend + 15) >> 4;
        const size_t mb = (size_t)b * SEQ;
#if PROBE_D == 1
        for (int rp_ = 0; rp_ < 2; ++rp_)
#endif
        { s16x8 iqf[8]; float sgn[8];
          { const int qq = (q0 + c < SEQ) ? q0 + c : SEQ - 1; const bf16* qp = IQB + (mb + qq) * 256 + 8 * g; const unsigned sg = ISG[mb + qq];
#pragma unroll
            for (int h = 0; h < 8; ++h) { iqf[h] = *(const GAS s16x8*)(qp + h * 32); sgn[h] = ((sg >> h) & 1u) ? -1.0f : 1.0f; } }
          const bf16* ikp = IKB + (mb + c) * 32 + 8 * g;
          s16x8 cur[4], nxt[4];
#pragma unroll
          for (int i = 0; i < 4; ++i) { const int t = w + 8 * i; cur[i] = *(const GAS s16x8*)(ikp + (size_t)512 * (t < ntile ? t : 0)); }
          for (int t0 = w; t0 < ntile; t0 += 32) {
#pragma unroll
            for (int i = 0; i < 4; ++i) { const int t = t0 + 32 + 8 * i; nxt[i] = *(const GAS s16x8*)(ikp + (size_t)512 * (t < ntile ? t : 0)); }
#pragma unroll
            for (int i = 0; i < 4; ++i) { const int t = t0 + 8 * i;
              if (t < ntile) {
                f32x4 sc = (f32x4){0.f, 0.f, 0.f, 0.f};
#pragma unroll
                for (int h = 0; h < 8; ++h) { const f32x4 x = __builtin_amdgcn_mfma_f32_16x16x32_bf16(cur[i], iqf[h], (f32x4){0.f, 0.f, 0.f, 0.f}, 0, 0, 0);
#pragma unroll
                    for (int r = 0; r < 4; ++r) sc[r] += sgn[h] * fmaxf(x[r], 0.f); }
                v4u kk; kk.x = f2key(sc[0]); kk.y = f2key(sc[1]); kk.z = f2key(sc[2]); kk.w = f2key(sc[3]);
                const int kb = 16 * t + 4 * g, qa = q0 + c;
                if (kb + 0 > qa) kk.x = 0u; if (kb + 1 > qa) kk.y = 0u; if (kb + 2 > qa) kk.z = 0u; if (kb + 3 > qa) kk.w = 0u;
                if (c < 8) *(LAS v4u*)(img + c * DSA_ROWF + 16 * t + 4 * g) = kk; } }
#pragma unroll
            for (int i = 0; i < 4; ++i) cur[i] = nxt[i];
          } }
        __syncthreads();
        const int pos = q0 + w; unsigned key[64];
#pragma unroll
        for (int j = 0; j < 64; ++j) { const int kidx = 64 * j + lane; const unsigned a = img[w * DSA_ROWF + kidx]; key[j] = (kidx <= pos) ? a : 0u; }
        unsigned T; int need; int nsel;
        { nsel = dsa_select2(key, pos + 1, idxw, lane); (void)T; (void)need; }
        __syncthreads();
#if PROBE_D == 3
        { const size_t m = mb + pos; dsa_attend(Z + m * ZP + Z_DQ, Z + m * ZP + Z_RG, KD + mb * 64, VD + mb * 64, idxw, nsel, F.lds + w * 16384, lane); }
#endif
        { const size_t m = mb + pos; dsa_attend(Z + m * ZP + Z_DQ, Z + m * ZP + out_col, KD + mb * 64, VD + mb * 64, idxw, nsel, F.lds + w * 16384, lane); }
        __syncthreads();
    }
}

__device__ __forceinline__ void ret_rope_frag(const bf16* row, const f32x2* cs, float scale, int g, s16x8 (&f)[2]) {
    const u32x2 a0 = *(const GAS u32x2*)(row + 4 * g), a1 = *(const GAS u32x2*)(row + 16 + 4 * g), b0 = *(const GAS u32x2*)(row + 32 + 4 * g), b1 = *(const GAS u32x2*)(row + 48 + 4 * g);
    const float x1[8] = {bflo(a0.x), bfhi(a0.x), bflo(a0.y), bfhi(a0.y), bflo(a1.x), bfhi(a1.x), bflo(a1.y), bfhi(a1.y)};
    const float x2[8] = {bflo(b0.x), bfhi(b0.x), bflo(b0.y), bfhi(b0.y), bflo(b1.x), bfhi(b1.x), bflo(b1.y), bfhi(b1.y)};
    float o1[8], o2[8];
#pragma unroll
    for (int j = 0; j < 8; ++j) { const f32x2 t = cs[(j < 4 ? 4 * g + j : 16 + 4 * g + (j - 4))]; o1[j] = (x1[j] * t.x - x2[j] * t.y) * scale; o2[j] = (x2[j] * t.x + x1[j] * t.y) * scale; }
    f[0] = __builtin_bit_cast(s16x8, pack8(o1)); f[1] = __builtin_bit_cast(s16x8, pack8(o2));
}
__device__ __forceinline__ s16x8 ret_bfrag(const LAS unsigned char* img, int row0, int eb, int g, int q, int p) {
    const int r1 = row0 + 4 * g + q;
    const LAS unsigned char* a1 = img + r1 * 256 + ((eb ^ (r1 & 7)) << 5) + 8 * p;
    const LAS unsigned char* a2 = img + (r1 + 16) * 256 + ((eb ^ ((r1 + 16) & 7)) << 5) + 8 * p;
    const s16x4 lo = tr16(a1), hi = tr16(a2);
    return (s16x8){lo[0], lo[1], lo[2], lo[3], hi[0], hi[1], hi[2], hi[3]};
}

__device__ __forceinline__ void ret_state_mfma(const Ctx& F) {
    const bf16* Z = (const bf16*)(F.ws + WS_Z); float* RS = (float*)(F.ws + WS_HDN);
    const f32x2* R64 = (const f32x2*)(F.ws + WS_ROPE64);
    LAS unsigned char* Kimg = F.lds; LAS unsigned char* Vimg = F.lds + 16384;
    const int lane = F.lane, g = lane >> 4, c = lane & 15, q = (lane >> 2) & 3, p = lane & 3;
    for (int u = blockIdx.x; u < NB * 32 * 4; u += F.G) {
        const int h = u & 3, ch = (u >> 2) & 31, b = u >> 7; const float l2g = ret_l2g(h);
        const bf16* base = Z + ((size_t)b * SEQ + ch * 128) * ZP;
        __syncthreads();
        for (int t = F.tid; t < 2048; t += 512) { const int r = t >> 4, c16 = t & 15;
            *(LAS v4u*)(Vimg + r * 256 + (((c16 >> 1) ^ (r & 7)) << 5) + ((c16 & 1) << 4)) = *(const GAS v4u*)(base + (size_t)r * ZP + Z_RV + h * 128 + c16 * 8); }
        for (int t = F.tid; t < 1024; t += 512) { const int j = t >> 3, dg = t & 7; const bf16* row = base + (size_t)j * ZP + Z_RK + h * 64;
            const u32x2 a = *(const GAS u32x2*)(row + 4 * dg), bb = *(const GAS u32x2*)(row + 32 + 4 * dg);
            const float x1[4] = {bflo(a.x), bfhi(a.x), bflo(a.y), bfhi(a.y)}, x2[4] = {bflo(bb.x), bfhi(bb.x), bflo(bb.y), bfhi(bb.y)};
            const f32x2* cs = R64 + (ch * 128 + j) * 32 + 4 * dg; const float sc = exp2f((float)(127 - j) * l2g);
            float o1[4], o2[4];
#pragma unroll
            for (int e = 0; e < 4; ++e) { const f32x2 tt = cs[e]; o1[e] = (x1[e] * tt.x - x2[e] * tt.y) * sc; o2[e] = (x2[e] * tt.x + x1[e] * tt.y) * sc; }
            u32x2 w1, w2; w1.x = pk2(o1[0], o1[1]); w1.y = pk2(o1[2], o1[3]); w2.x = pk2(o2[0], o2[1]); w2.y = pk2(o2[2], o2[3]);
            const int sw = (j >> 1) & 3; const int d1 = 4 * dg, d2 = 32 + 4 * dg;
            *(LAS u32x2*)(Kimg + j * 128 + ((((2 * d1) >> 5) ^ sw) << 5) + ((2 * d1) & 31)) = w1;
            *(LAS u32x2*)(Kimg + j * 128 + ((((2 * d2) >> 5) ^ sw) << 5) + ((2 * d2) & 31)) = w2; }
        __syncthreads();
        f32x4 acc[4];
#pragma unroll
        for (int db = 0; db < 4; ++db) acc[db] = (f32x4){0.f, 0.f, 0.f, 0.f};
#pragma unroll
        for (int s = 0; s < 4; ++s) {
            const s16x8 vb = ret_bfrag(Vimg, 32 * s, F.wave, g, q, p);
            const int r1 = 32 * s + 4 * g + q, sw = (r1 >> 1) & 3;
#pragma unroll
            for (int db = 0; db < 4; ++db) { const LAS unsigned char* a1 = Kimg + r1 * 128 + ((db ^ sw) << 5) + 8 * p;
                const s16x4 lo = tr16(a1), hi = tr16(a1 + 2048);
                const s16x8 ka = (s16x8){lo[0], lo[1], lo[2], lo[3], hi[0], hi[1], hi[2], hi[3]};
                acc[db] = __builtin_amdgcn_mfma_f32_16x16x32_bf16(ka, vb, acc[db], 0, 0, 0); }
        }
        float* o = RS + (size_t)u * 8192 + 16 * F.wave + c;
#pragma unroll
        for (int db = 0; db < 4; ++db)
#pragma unroll
            for (int r = 0; r < 4; ++r) o[(16 * db + 4 * g + r) * 128] = acc[db][r];
    }
    __syncthreads();
}

__device__ __forceinline__ void ret_scan(const Ctx& F) {
    const float* RS = (const float*)(F.ws + WS_HDN); float* SC = (float*)(F.ws + WS_HDN + 16 * MiB);
    for (int t = blockIdx.x * 512 + F.tid; t < NB * 4 * 8192; t += F.G * 512) {
        const int el = t & 8191, h = (t >> 13) & 3, b = t >> 15; const float wch = exp2f(128.f * ret_l2g(h)); float s = 0.f;
        float L[32];
#pragma unroll
        for (int ch = 0; ch < 32; ++ch) L[ch] = RS[(size_t)(((b * 32 + ch) * 4 + h)) * 8192 + el];
#pragma unroll
        for (int ch = 0; ch < 32; ++ch) { SC[(size_t)(((b * 32 + ch) * 4 + h)) * 8192 + el] = s; s = wch * s + L[ch]; }
    }
}

__device__ __forceinline__ void ret_out_mfma(const Ctx& F, const float* gn, bool dummy_out = false) {
    bf16* Z = (bf16*)(F.ws + WS_Z); const float* SC = (const float*)(F.ws + WS_HDN + 16 * MiB);
    const f32x2* R64 = (const f32x2*)(F.ws + WS_ROPE64);
    LAS unsigned char* Vimg = F.lds; LAS unsigned char* Simg = F.lds + 32768;
    const int lane = F.lane, g = lane >> 4, c = lane & 15, q = (lane >> 2) & 3, p = lane & 3, w = F.wave;
    for (int u = blockIdx.x; u < NB * 32 * 4; u += F.G) {
        const int h = u & 3, ch = (u >> 2) & 31, b = u >> 7; const float l2g = ret_l2g(h); const float gam = exp2f(l2g);
        bf16* base = Z + ((size_t)b * SEQ + ch * 128) * ZP;
        __syncthreads();
        for (int t = F.tid; t < 2048; t += 512) { const int r = t >> 4, c16 = t & 15;
            *(LAS v4u*)(Vimg + r * 256 + (((c16 >> 1) ^ (r & 7)) << 5) + ((c16 & 1) << 4)) = *(const GAS v4u*)(base + (size_t)r * ZP + Z_RV + h * 128 + c16 * 8); }
        for (int t = F.tid; t < 1024; t += 512) { const int r = t >> 4, c16 = t & 15; const float* sp = SC + (size_t)u * 8192 + r * 128 + c16 * 8;
            const f32x4 s0 = *(const GAS f32x4*)sp, s1 = *(const GAS f32x4*)(sp + 4);
            v4u wv; wv.x = pk2(s0.x * gam, s0.y * gam); wv.y = pk2(s0.z * gam, s0.w * gam); wv.z = pk2(s1.x * gam, s1.y * gam); wv.w = pk2(s1.z * gam, s1.w * gam);
            *(LAS v4u*)(Simg + r * 256 + (((c16 >> 1) ^ (r & 7)) << 5) + ((c16 & 1) << 4)) = wv; }
        const int i = 16 * w + c; s16x8 qf[2];
        ret_rope_frag(base + (size_t)i * ZP + Z_RQ + h * 64, R64 + (ch * 128 + i) * 32, 0.125f * exp2f((float)i * l2g), g, qf);
        f32x4 acc[8];
#pragma unroll
        for (int t = 0; t < 8; ++t) { acc[t] = (f32x4){0.f, 0.f, 0.f, 0.f};
            if (t <= w) { const int j = 16 * t + c; s16x8 kf[2];
                ret_rope_frag(base + (size_t)j * ZP + Z_RK + h * 64, R64 + (ch * 128 + j) * 32, exp2f(-(float)j * l2g), g, kf);
                acc[t] = __builtin_amdgcn_mfma_f32_16x16x32_bf16(kf[0], qf[0], acc[t], 0, 0, 0); acc[t] = __builtin_amdgcn_mfma_f32_16x16x32_bf16(kf[1], qf[1], acc[t], 0, 0, 0);
                if (t == w) {
#pragma unroll
                    for (int r = 0; r < 4; ++r) if (4 * g + r > c) acc[t][r] = 0.f; } } }
        s16x8 pf[4];
#pragma unroll
        for (int s = 0; s < 4; ++s) { v4u wv; wv.x = pk2(acc[2 * s][0], acc[2 * s][1]); wv.y = pk2(acc[2 * s][2], acc[2 * s][3]); wv.z = pk2(acc[2 * s + 1][0], acc[2 * s + 1][1]); wv.w = pk2(acc[2 * s + 1][2], acc[2 * s + 1][3]);
            pf[s] = __builtin_bit_cast(s16x8, wv); }
        __syncthreads();
        f32x4 o[8];
#pragma unroll
        for (int eb = 0; eb < 8; ++eb) o[eb] = (f32x4){0.f, 0.f, 0.f, 0.f};
#pragma unroll
        for (int s = 0; s < 4; ++s) if (2 * s <= w) {
#pragma unroll
            for (int eb = 0; eb < 8; ++eb) o[eb] = __builtin_amdgcn_mfma_f32_16x16x32_bf16(pf[s], ret_bfrag(Vimg, 32 * s, eb, g, q, p), o[eb], 0, 0, 0); }
#pragma unroll
        for (int ks = 0; ks < 2; ++ks)
#pragma unroll
            for (int eb = 0; eb < 8; ++eb) o[eb] = __builtin_amdgcn_mfma_f32_16x16x32_bf16(qf[ks], ret_bfrag(Simg, 32 * ks, eb, g, q, p), o[eb], 0, 0, 0);
        float rs[4];
#pragma unroll
        for (int r = 0; r < 4; ++r) { float ss = 0.f;
#pragma unroll
            for (int eb = 0; eb < 8; ++eb) ss += o[eb][r] * o[eb][r];
            ss += sx<1>(ss); ss += sx<2>(ss); ss += sx<4>(ss); ss += sx<8>(ss);
            rs[r] = 1.0f / sqrtf(ss * (1.f / 128) + NORM_EPS); }
#pragma unroll
        for (int r = 0; r < 4; ++r) { bf16* zr = base + (size_t)(16 * w + 4 * g + r) * ZP; bf16* zw = dummy_out ? (bf16*)(F.ws + WS_ZS) + ((size_t)b * SEQ + ch * 128 + 16 * w + 4 * g + r) * 1024 - Z_RV : zr;
#pragma unroll
            for (int eb = 0; eb < 8; ++eb) { const int e = 16 * eb + c; const float rg = bf2f(zr[Z_RG + h * 128 + e]);
                zw[Z_RV + h * 128 + e] = (bf16)f2bf(o[eb][r] * rs[r] * gn[h * 128 + e] * rg * sigmoid_f(rg)); } }
    }
    __syncthreads();
}

__device__ __forceinline__ void fscan_phase(const Ctx& F) {
    const float* LF = (const float*)(F.ws + WS_LF); float* CF = (float*)(F.ws + WS_CF);
    if (F.gw < 32) {
        const int b = F.gw >> 3, h = F.gw & 7; const float* lp = LF + ((size_t)b * SEQ + F.lane * 64) * 8 + h; float s = 0.f;
        for (int i = 0; i < 64; ++i) s += lp[i * 8];
        float incl = s;
#pragma unroll
        for (int o = 1; o < 64; o <<= 1) { const float t = __builtin_bit_cast(float, __builtin_amdgcn_ds_bpermute(((F.lane - o) & 63) << 2, __builtin_bit_cast(int, incl))); if (F.lane >= o) incl += t; }
        float run = incl - s; float* cp = CF + (size_t)F.gw * SEQ + F.lane * 64;
        for (int i = 0; i < 64; ++i) { run += lp[i * 8]; cp[i] = run; }
    }
}
#include <hip/hip_bf16.h>
#include <cmath>
namespace attn_body {
using bf16=__hip_bfloat16;
using bf16x8=__attribute__((ext_vector_type(8)))short;
using s16x4=__attribute__((ext_vector_type(4)))short;
using f32x16=__attribute__((ext_vector_type(16)))float;
using u32x4=__attribute__((ext_vector_type(4)))unsigned;
constexpr int BATCH=4,NHEAD=8,SEQ=4096,D=64,DM=6656;
constexpr int NW=8,QBLK=32,QB=QBLK*NW,KVBLK=64,NQB=SEQ/QB;
constexpr int ATTN_PITCH=DM, ATTN_UNIT_ROWS=QB;
__device__ __forceinline__ int crow(int r,int hi){return (r&3)+8*(r>>2)+4*hi;}
#define SBAR() __builtin_amdgcn_sched_barrier(0)
__device__ __forceinline__ void cmask(f32x16&p0,f32x16&p1,int jb,int qrel,int hi){
  const float NEG=-INFINITY; int kb=64*jb+4*hi;
  #pragma unroll
  for(int r=0;r<16;++r){int kv=kb+(r&3)+8*(r>>2); if(kv>qrel)p0[r]=NEG; if(kv+32>qrel)p1[r]=NEG;}
}

constexpr int NSLOT=3, SLOTB=8192;
constexpr int LDS_K=0, LDS_V=NSLOT*SLOTB, LDS_WS=2*NSLOT*SLOTB, LDS_OST=LDS_WS+NW*64*4, LDS_NC=LDS_OST+NW*4096, LDS_BYTES=LDS_NC+SEQ*4;
constexpr float C2=0.125f*1.4426950408889634f;
__device__ __forceinline__ void glds16(const void*gsrc,unsigned lds_dst){unsigned keep;
  asm volatile("s_mov_b32 %0, m0\n\ts_mov_b32 m0, %2\n\ts_nop 0\n\tglobal_load_lds_dwordx4 %1, off\n\ts_mov_b32 m0, %0":"=&s"(keep):"v"(gsrc),"s"(lds_dst):"memory");}
__device__ __forceinline__ float max3f(float a,float b,float c){float r;asm("v_max3_f32 %0, %1, %2, %3":"=v"(r):"v"(a),"v"(b),"v"(c));return r;}
__device__ __forceinline__ float max2f(float a,float b){float r;asm("v_max_f32_e32 %0, %1, %2":"=v"(r):"v"(a),"v"(b));return r;}
__device__ __forceinline__ float fadd_s(float a,float b){float r;asm("v_add_f32_e32 %0, %1, %2":"=v"(r):"v"(a),"v"(b));return r;}
__device__ __forceinline__ float fsub_s(float a,float b){float r;asm("v_sub_f32_e32 %0, %1, %2":"=v"(r):"v"(a),"v"(b));return r;}
typedef float f32x4_t __attribute__((ext_vector_type(4))); typedef float f32x2_t __attribute__((ext_vector_type(2))); typedef __bf16 bf16x2_t __attribute__((ext_vector_type(2)));
__device__ __forceinline__ unsigned cvtpk_s(float lo,float hi){f32x2_t v={lo,hi};bf16x2_t b=__builtin_convertvector(v,bf16x2_t);return __builtin_bit_cast(unsigned,b);}
#define WAIT_BAR(N) asm volatile("s_waitcnt vmcnt(" #N ") lgkmcnt(0)\n\ts_barrier":::"memory")

__device__ __forceinline__ void qkt(f32x16&p0,f32x16&p1,const char*Kslot,const bf16x8*qr,const f32x16&negm,int r32,int hi){
  const char*kb=Kslot+hi*1024+r32*16;
  #pragma unroll
  for(int d0=0;d0<4;++d0){
    const bf16x8 b0=*reinterpret_cast<const bf16x8*>(kb+d0*2048);
    const bf16x8 b1=*reinterpret_cast<const bf16x8*>(kb+d0*2048+512);
    if(d0==0){p0=__builtin_amdgcn_mfma_f32_32x32x16_bf16(b0,qr[0],negm,0,0,0);p1=__builtin_amdgcn_mfma_f32_32x32x16_bf16(b1,qr[0],negm,0,0,0);}
    else{p0=__builtin_amdgcn_mfma_f32_32x32x16_bf16(b0,qr[d0],p0,0,0,0);p1=__builtin_amdgcn_mfma_f32_32x32x16_bf16(b1,qr[d0],p1,0,0,0);}}
}
typedef __attribute__((address_space(3))) const char* lds_cptr;
typedef short v4i16_t __attribute__((ext_vector_type(4)));
__device__ __forceinline__ void kload8(bf16x8*kf,lds_cptr kp){
  kf[0]=*(const __attribute__((address_space(3))) bf16x8*)(kp);      kf[1]=*(const __attribute__((address_space(3))) bf16x8*)(kp+512);
  kf[2]=*(const __attribute__((address_space(3))) bf16x8*)(kp+2048); kf[3]=*(const __attribute__((address_space(3))) bf16x8*)(kp+2560);
  kf[4]=*(const __attribute__((address_space(3))) bf16x8*)(kp+4096); kf[5]=*(const __attribute__((address_space(3))) bf16x8*)(kp+4608);
  kf[6]=*(const __attribute__((address_space(3))) bf16x8*)(kp+6144); kf[7]=*(const __attribute__((address_space(3))) bf16x8*)(kp+6656);
}
__device__ __forceinline__ void kload2(bf16x8*kf,lds_cptr kp,int j){ kf[2*j]=*(const __attribute__((address_space(3))) bf16x8*)(kp+j*2048); kf[2*j+1]=*(const __attribute__((address_space(3))) bf16x8*)(kp+j*2048+512); }
__device__ __forceinline__ s16x4 vtr(lds_cptr p){ return __builtin_bit_cast(s16x4,__builtin_amdgcn_ds_read_tr16_b64_v4i16((__attribute__((address_space(3))) v4i16_t*)p)); }
__device__ __forceinline__ float rowmax(const f32x16&p0,const f32x16&p1){
  float a=max3f(p0[0],p0[1],p1[0]),b=max3f(p0[2],p0[3],p1[1]);a=max3f(a,p1[2],p1[3]);
  #pragma unroll
  for(int r=4;r<16;r+=4){a=max3f(a,p0[r],p0[r+1]);b=max3f(b,p0[r+2],p0[r+3]);a=max3f(a,p1[r],p1[r+1]);b=max3f(b,p1[r+2],p1[r+3]);}
  const float m=max2f(a,b);
  auto rr=__builtin_amdgcn_permlane32_swap(__float_as_uint(m),__float_as_uint(m),false,false);
  return max2f(__uint_as_float(rr[0]),__uint_as_float(rr[1]));
}
__device__ __forceinline__ void pv(f32x16*o,int vb,bf16x8 pa0,bf16x8 pa1,bf16x8 pa2,bf16x8 pa3){
  #pragma unroll
  for(int d0=0;d0<2;++d0){s16x4 lo[4],hi[4];
    #pragma unroll
    for(int ks=0;ks<4;++ks){
      asm volatile("ds_read_b64_tr_b16 %0,%1 offset:%c2":"=&v"(lo[ks]):"v"(vb),"i"(d0*4096+ks*1024):"memory");
      asm volatile("ds_read_b64_tr_b16 %0,%1 offset:%c2":"=&v"(hi[ks]):"v"(vb),"i"(d0*4096+ks*1024+512):"memory");}
    asm volatile("s_waitcnt lgkmcnt(0)":::"memory");SBAR();
    #define PK(k) (bf16x8){lo[k][0],lo[k][1],lo[k][2],lo[k][3],hi[k][0],hi[k][1],hi[k][2],hi[k][3]}
    o[d0]=__builtin_amdgcn_mfma_f32_32x32x16_bf16(pa0,PK(0),o[d0],0,0,0);
    o[d0]=__builtin_amdgcn_mfma_f32_32x32x16_bf16(pa1,PK(1),o[d0],0,0,0);
    o[d0]=__builtin_amdgcn_mfma_f32_32x32x16_bf16(pa2,PK(2),o[d0],0,0,0);
    o[d0]=__builtin_amdgcn_mfma_f32_32x32x16_bf16(pa3,PK(3),o[d0],0,0,0);
    #undef PK
  }
}

#ifndef ATTN_STORE16
#define ATTN_STORE16(p,v) (*(u32x4*)(p)=(v))
#endif
template<int THRL> __device__ __forceinline__ void attn_unit(int b,int h,int qb,const bf16*Q,const bf16*__restrict__ K,const bf16*__restrict__ V,bf16*O,const float*CF,char*shm,int wave_id){
  int tid_=(wave_id<<6)|lane_id_v(); asm volatile("":"+v"(tid_));
  const int tid=tid_,lane=tid&63,r32=lane&31,hi=lane>>5; const int wid=__builtin_amdgcn_readfirstlane(tid>>6);
  const long rowbase=(long)b*SEQ; const int q0=qb*QB;
  const bf16*Qw=Q+(rowbase+q0+wid*QBLK)*DM+h*D;
  const bf16*Kh=K+rowbase*DM+h*D,*Vh=V+rowbase*DM+h*D;
  const unsigned lds0=(unsigned)(uintptr_t)shm;
  float*wsf=(float*)(shm+LDS_WS)+wid*64;
  const bf16*ksrc=Kh+(long)lane*DM+wid*8;
  const bf16*vsrc=Vh+(long)(16*(wid&3)+(lane>>2))*DM+(wid>>2)*32+(lane&3)*8;
  const unsigned kdst=lds0+LDS_K+wid*1024, vdst=lds0+LDS_V+wid*1024;
  #define DMA_K(t,slot) glds16(ksrc+(long)(t)*KVBLK*DM,(unsigned)__builtin_amdgcn_readfirstlane(kdst+(slot)))
  #define DMA_V(t,slot) glds16(vsrc+(long)(t)*KVBLK*DM,(unsigned)__builtin_amdgcn_readfirstlane(vdst+(slot)))
  const char*Kbase=shm+LDS_K; bf16x8 kf[8];
  const lds_cptr shm3=(lds_cptr)shm; const lds_cptr kp0=shm3+LDS_K+hi*1024+r32*16; const lds_cptr vp0=shm3+LDS_V+((lane>>4)&1)*32+(lane&3)*8+(4*hi+((lane&15)>>2))*64;
  const int NT=(q0+QB)/KVBLK;
  { const float*cfp=CF+(long)(b*NHEAD+h)*SEQ; float*ncw=(float*)(shm+LDS_NC);
    for(int i=tid;i<q0+QB;i+=NW*64)ncw[i]=-cfp[i]; }
  const lds_cptr ncp=(lds_cptr)shm+LDS_NC+hi*16;
  #define ADDC(P0,P1,t) do{ const lds_cptr np_=ncp+(t)*256; _Pragma("unroll") for(int g_=0;g_<4;++g_){ \
      const f32x4_t a_=*(const __attribute__((address_space(3))) f32x4_t*)(np_+g_*32), b_=*(const __attribute__((address_space(3))) f32x4_t*)(np_+g_*32+128); \
      P0[4*g_]+=a_[0];P0[4*g_+1]+=a_[1];P0[4*g_+2]+=a_[2];P0[4*g_+3]+=a_[3]; P1[4*g_]+=b_[0];P1[4*g_+1]+=b_[1];P1[4*g_+2]+=b_[2];P1[4*g_+3]+=b_[3]; } }while(0)
  DMA_K(0,0);DMA_V(0,0);DMA_K(1,SLOTB);
  bf16x8 qr[4];
  #pragma unroll
  for(int d0=0;d0<4;++d0)qr[d0]=*reinterpret_cast<const bf16x8*>(&Qw[(long)r32*DM+d0*16+hi*8]);
  float mhat=0.f,l_reg=0.f;f32x16 o[2];f32x16 negm; { float zz_; asm volatile("v_mov_b32 %0, 0":"=v"(zz_));
    _Pragma("unroll") for(int r=0;r<16;++r){o[0][r]=zz_;o[1][r]=zz_;negm[r]=zz_;} } asm volatile("":"+v"(negm));
  const int qrel=wid*QBLK+r32;
  #define CMASK(P0,P1,t) do{int jb_=(t)-(NT-4); if(jb_>=0)cmask(P0,P1,jb_,qrel,hi);}while(0)
  bool resc=false;
  #define START(P0,P1) do{ const float rm=rowmax(P0,P1); resc=false; \
    { const float dl=rm; mhat=fadd_s(mhat,dl); \
      _Pragma("unroll") for(int r=0;r<16;++r){P0[r]=fsub_s(P0[r],dl);P1[r]=fsub_s(P1[r],dl);} \
      _Pragma("unroll") for(int r=0;r<16;++r)negm[r]=-mhat; asm volatile("":"+v"(negm)); } \
    _Pragma("unroll") for(int r=0;r<16;++r)P0[r]=__builtin_amdgcn_exp2f(P0[r]); }while(0)
  #define RESC() do{ if(resc){ asm volatile("s_waitcnt lgkmcnt(0)":::"memory"); \
      _Pragma("unroll") for(int d_=0;d_<2;++d_) _Pragma("unroll") for(int r=0;r<16;++r)o[d_][r]*=wsf[crow(r,hi)]; } }while(0)
  f32x16 pA0,pA1,pB0,pB1;
  int sl_prev=0,sl_cur=0,sl_next=SLOTB;
  #define ROT() do{sl_prev=sl_cur;sl_cur=sl_next;sl_next=(sl_next==(NSLOT-1)*SLOTB)?0:sl_next+SLOTB;}while(0)
  DMA_K(2,2*SLOTB);
  WAIT_BAR(3);
  qkt(pA0,pA1,Kbase,qr,negm,r32,hi);asm volatile("s_nop 15\n\ts_nop 7":"+v"(pA0),"+v"(pA1));ADDC(pA0,pA1,0);CMASK(pA0,pA1,0);
  START(pA0,pA1);
  _Pragma("unroll") for(int r=0;r<16;++r)pA1[r]=__builtin_amdgcn_exp2f(pA1[r]);
  WAIT_BAR(0);
  DMA_K(3,0);DMA_V(1,SLOTB);
  ROT();
  kload8(kf,kp0+sl_cur);
  WAIT_BAR(2);
  s16x4 vlo[8],vhi[8]; u32x4 pw0,pw1,pw2,pw3;
  #define PKW(P,B) cvtpk_s(P[B],P[B+1])
  #define PAF(k) __builtin_bit_cast(bf16x8,pw##k)
  #define VFR(i) (bf16x8){vlo[i][0],vlo[i][1],vlo[i][2],vlo[i][3],vhi[i][0],vhi[i][1],vhi[i][2],vhi[i][3]}
  #define PIN(x) asm volatile("":"+v"(x))
  #define MX3(a,b,c) __builtin_fmaxf(__builtin_fmaxf((a),(b)),(c))
  #define GAPA(MF,A0,A1,A2,A3,W0,W1,PW) do{ MF; sacc+=A0; sacc+=A1; sacc+=A2; sacc+=A3; PIN(sacc); W0; W1; PIN(PW); SBAR(); }while(0)
  #define EX(v) __builtin_amdgcn_exp2f(v)
  #define GAPB(MF,X,B) do{ MF; X[B]=EX(X[B]); X[B+1]=EX(X[B+1]); X[B+2]=EX(X[B+2]); X[B+3]=EX(X[B+3]); PIN(X); SBAR(); }while(0)
  #define VRD(i) do{ vlo[i]=vtr(vp_+(((i)>>2)*4096+((i)&3)*1024)); vhi[i]=vtr(vp_+(((i)>>2)*4096+((i)&3)*1024+512)); }while(0)
  #define KRD(G,j) do{ if(G){ kload2(kf,kp0+sl_next,j); SBAR(); } }while(0)
  #define STEP(C0,C1,P0,P1,t,GK,GV,GL) do{ SBAR(); \
    const lds_cptr vp_=vp0+sl_prev; \
    VRD(0); SBAR(); float sacc=(P0[0]+P0[1]); \
    GAPA(C0=__builtin_amdgcn_mfma_f32_32x32x16_bf16(kf[0],qr[0],negm,0,0,0), P0[2],P0[3],P0[4],P0[5],     pw0[0]=PKW(P0,0), pw0[1]=PKW(P0,2), pw0); \
    VRD(4); SBAR(); GAPA(C1=__builtin_amdgcn_mfma_f32_32x32x16_bf16(kf[1],qr[0],negm,0,0,0), P0[6],P0[7],P0[8],P0[9],     pw0[2]=PKW(P0,4), pw0[3]=PKW(P0,6), pw0); \
    VRD(1); SBAR(); GAPA(C0=__builtin_amdgcn_mfma_f32_32x32x16_bf16(kf[2],qr[1],C0,0,0,0),   P0[10],P0[11],P0[12],P0[13], pw1[0]=PKW(P0,8), pw1[1]=PKW(P0,10), pw1); \
    VRD(5); SBAR(); GAPA(C1=__builtin_amdgcn_mfma_f32_32x32x16_bf16(kf[3],qr[1],C1,0,0,0),   P0[14],P0[15],P1[0],P1[1],   pw1[2]=PKW(P0,12),pw1[3]=PKW(P0,14), pw1); \
    VRD(2); SBAR(); GAPA(C0=__builtin_amdgcn_mfma_f32_32x32x16_bf16(kf[4],qr[2],C0,0,0,0),   P1[2],P1[3],P1[4],P1[5],     pw2[0]=PKW(P1,0), pw2[1]=PKW(P1,2), pw2); \
    VRD(6); SBAR(); GAPA(C1=__builtin_amdgcn_mfma_f32_32x32x16_bf16(kf[5],qr[2],C1,0,0,0),   P1[6],P1[7],P1[8],P1[9],     pw2[2]=PKW(P1,4), pw2[3]=PKW(P1,6), pw2); \
    VRD(3); SBAR(); GAPA(C0=__builtin_amdgcn_mfma_f32_32x32x16_bf16(kf[6],qr[3],C0,0,0,0),   P1[10],P1[11],P1[12],P1[13], pw3[0]=PKW(P1,8), pw3[1]=PKW(P1,10), pw3); \
    VRD(7); SBAR(); GAPA(C1=__builtin_amdgcn_mfma_f32_32x32x16_bf16(kf[7],qr[3],C1,0,0,0),   P1[14],P1[15],0.f,0.f,       pw3[2]=PKW(P1,12),pw3[3]=PKW(P1,14), pw3); \
    l_reg+=sacc; \
    if(GK){DMA_K((t)+3,sl_cur);} if(GV){DMA_V((t)+1,sl_next);} \
    ADDC(C0,C1,t); CMASK(C0,C1,t); \
    { float a=MX3(C0[0],C0[1],C1[0]),b=MX3(C0[2],C0[3],C1[1]); a=MX3(a,C1[2],C1[3]); \
      _Pragma("unroll") for(int r=4;r<16;r+=4){a=MX3(a,C0[r],C0[r+1]);b=MX3(b,C0[r+2],C0[r+3]);a=MX3(a,C1[r],C1[r+1]);b=MX3(b,C1[r+2],C1[r+3]);} \
      float rm=__builtin_fmaxf(a,b); { auto rr=__builtin_amdgcn_permlane32_swap(__float_as_uint(rm),__float_as_uint(rm),false,false); rm=__builtin_fmaxf(__uint_as_float(rr[0]),__uint_as_float(rr[1])); } \
      resc=false; \
      if(__builtin_expect(__any(rm>(float)THRL),0)){ const float dl=__builtin_fmaxf(rm,0.f); mhat+=dl; \
        _Pragma("unroll") for(int r=0;r<16;++r){C0[r]-=dl;C1[r]-=dl;} \
        _Pragma("unroll") for(int r=0;r<16;++r)negm[r]=-mhat; asm volatile("":"+v"(negm)); \
        const float f=__builtin_amdgcn_exp2f(-dl); l_reg*=f; if(hi==0)wsf[r32]=f; resc=true; } } \
    SBAR(); \
    GAPB(o[0]=__builtin_amdgcn_mfma_f32_32x32x16_bf16(PAF(0),VFR(0),o[0],0,0,0), C0,0); \
    GAPB(o[1]=__builtin_amdgcn_mfma_f32_32x32x16_bf16(PAF(0),VFR(4),o[1],0,0,0), C0,4); \
    KRD(GL,0); GAPB(o[0]=__builtin_amdgcn_mfma_f32_32x32x16_bf16(PAF(1),VFR(1),o[0],0,0,0), C0,8); \
    KRD(GL,1); GAPB(o[1]=__builtin_amdgcn_mfma_f32_32x32x16_bf16(PAF(1),VFR(5),o[1],0,0,0), C0,12); \
    KRD(GL,2); GAPB(o[0]=__builtin_amdgcn_mfma_f32_32x32x16_bf16(PAF(2),VFR(2),o[0],0,0,0), C1,0); \
    KRD(GL,3); GAPB(o[1]=__builtin_amdgcn_mfma_f32_32x32x16_bf16(PAF(2),VFR(6),o[1],0,0,0), C1,4); \
    GAPB(o[0]=__builtin_amdgcn_mfma_f32_32x32x16_bf16(PAF(3),VFR(3),o[0],0,0,0), C1,8); \
    GAPB(o[1]=__builtin_amdgcn_mfma_f32_32x32x16_bf16(PAF(3),VFR(7),o[1],0,0,0), C1,12); \
    }while(0)
  int t=1;
  #undef CMASK
  #define CMASK(P0,P1,t) do{}while(0)
  for(;t+5<NT;t+=2){
    STEP(pB0,pB1,pA0,pA1,t,true,true,true);     WAIT_BAR(2); RESC(); ROT();
    STEP(pA0,pA1,pB0,pB1,t+1,true,true,true);   WAIT_BAR(2); RESC(); ROT();
  }
  #undef CMASK
  #define CMASK(P0,P1,t) do{int jb_=(t)-(NT-4); if(jb_>=0)cmask(P0,P1,jb_,qrel,hi);}while(0)
  #define ENDW(tt) do{ if((tt)+3<NT){WAIT_BAR(2);} else if((tt)+2<NT){WAIT_BAR(1);} else {WAIT_BAR(0);} }while(0)
  for(;t+1<NT;t+=2){
    STEP(pB0,pB1,pA0,pA1,t,(t+3<NT),(t+1<NT),(t+1<NT));       ENDW(t);   RESC(); ROT();
    STEP(pA0,pA1,pB0,pB1,t+1,(t+4<NT),(t+2<NT),(t+2<NT));     ENDW(t+1); RESC(); ROT();
  }
  STEP(pB0,pB1,pA0,pA1,NT-1,false,false,false); RESC();
  { float sacc=pB0[0]+pB0[1]; _Pragma("unroll") for(int r=2;r<16;++r)sacc+=pB0[r]; _Pragma("unroll") for(int r=0;r<16;++r)sacc+=pB1[r]; l_reg+=sacc;
    pw0=(u32x4){PKW(pB0,0),PKW(pB0,2),PKW(pB0,4),PKW(pB0,6)};pw1=(u32x4){PKW(pB0,8),PKW(pB0,10),PKW(pB0,12),PKW(pB0,14)};pw2=(u32x4){PKW(pB1,0),PKW(pB1,2),PKW(pB1,4),PKW(pB1,6)};pw3=(u32x4){PKW(pB1,8),PKW(pB1,10),PKW(pB1,12),PKW(pB1,14)};
    int tl_=lane_id_v(); asm volatile("":"+v"(tl_)); const int ln_=tl_&63,hi_=ln_>>5; const int vb0e=(int)(lds0+LDS_V)+((ln_>>4)&1)*32+(ln_&3)*8+(4*hi_+((ln_&15)>>2))*64;
    SBAR(); pv(o,vb0e+sl_cur,PAF(0),PAF(1),PAF(2),PAF(3)); }
  #undef PKW
  #undef PAF
  #undef VFR
  #undef PIN
  #undef MX3
  #undef GAPA
  #undef GAPB
  #undef EX
  #undef VRD
  #undef KRD
  #undef STEP
  #undef ENDW
  {auto rr=__builtin_amdgcn_permlane32_swap(__float_as_uint(l_reg),__float_as_uint(l_reg),false,false);l_reg=__uint_as_float(rr[0])+__uint_as_float(rr[1]);}
  int te_=lane_id_v(); asm volatile("":"+v"(te_)); const int lane_e=te_&63,r32_e=lane_e&31,hi_e=lane_e>>5;
  if(hi_e==0)wsf[32+r32_e]=l_reg;asm volatile("s_waitcnt lgkmcnt(0)":::"memory");
  float rli[16];
  #pragma unroll
  for(int r=0;r<16;++r)rli[r]=__builtin_amdgcn_rcpf(wsf[32+crow(r,hi_e)]);
  bf16*Ow=O+(rowbase+q0+wid*QBLK)*DM+h*D;
  { bf16*stg=(bf16*)(shm+LDS_OST)+wid*2048;
    #pragma unroll
    for(int r=0;r<16;++r){const int orow=crow(r,hi_e);
      #pragma unroll
      for(int d0=0;d0<2;++d0)stg[orow*64+d0*32+r32_e]=__float2bfloat16(o[d0][r]*rli[r]);}
    asm volatile("s_waitcnt lgkmcnt(0)":::"memory");
    #pragma unroll
    for(int i=0;i<4;++i){const int row=i*8+(lane_e>>3),ch=lane_e&7; const u32x4 v=*(const u32x4*)(stg+row*64+ch*8); ATTN_STORE16(Ow+(long)row*DM+ch*8,v);} }
  asm volatile("s_waitcnt lgkmcnt(0)\n\ts_barrier":::"memory");
  #undef ADDC
  #undef DMA_K
  #undef DMA_V
  #undef CMASK
  #undef START
  #undef RESC
  #undef ROT
}
constexpr int ATTN_LDS_BYTES=LDS_BYTES;
struct AttnTensors { const bf16* Q; const bf16* K; const bf16* V; bf16* O; const float* CF; };
struct AttnUnit { int bh; int qb; };
struct StaticOrder {
  int vcu;
  __device__ __forceinline__ explicit StaticOrder(int grid,int block):vcu((block%8)*(grid/8)+block/8){}
  __device__ __forceinline__ bool next(int i,AttnUnit&u)const{ if(i>=2)return false; const int s=vcu&7; u.bh=vcu>>3; u.qb=(i==0)?s:15-s; return true; }
  __device__ __forceinline__ void a_ready(const AttnUnit&)const{}
  __device__ __forceinline__ void done(const AttnUnit&)const{}
};
template<class Sched,int THRL=8> __device__ __forceinline__ void attn_phase(char*lds,const AttnTensors&T,const Sched&S,int wave_id){
  AttnUnit u;
  for(int i=0;S.next(i,u);++i){ S.a_ready(u); attn_unit<THRL>(u.bh/NHEAD,u.bh%NHEAD,u.qb,T.Q,T.K,T.V,T.O,T.CF,lds,wave_id); S.done(u); }
}
#undef SBAR
#undef WAIT_BAR
}

struct Args { const float* in[16]; float* out; unsigned char* ws; };
__global__ void __launch_bounds__(NWAVES * 64, 2) hyb_fwd(Args args) {
    extern __shared__ __attribute__((aligned(16))) unsigned char lds[];
    Ctx F;
    F.lds = (LAS unsigned char*)lds;
    F.tid = threadIdx.x; F.lane = F.tid & 63; F.wave = __builtin_amdgcn_readfirstlane(F.tid >> 6);
    F.G = gridDim.x; F.gw = blockIdx.x * NWAVES + F.wave; F.NGW = F.G * NWAVES;
    F.out = args.out; F.ws = args.ws;
    volatile LAS unsigned* MISC = (volatile LAS unsigned*)(F.lds + MISC_OFF);
    for (int u = F.tid; u < (LDS_BYTES - LDSCTL_OFF) / 4; u += NWAVES * 64) ((LAS unsigned*)(F.lds + LDSCTL_OFF))[u] = 0u;
    __syncthreads();
    gu32* ctl = (gu32*)(F.ws + WS_CTL);
    XcdBarrier bar = xcd_barrier_post((unsigned*)(ctl + CW_BAR), MISC + 8); bar.w = F.wave;
#define FRESH(P) Ctx P = F; P.tid = (F.wave << 6) | lane_id_v(); asm volatile("" : "+v"(P.tid), "+s"(P.wave), "+s"(P.gw), "+s"(P.ws), "+s"(P.out)); P.lane = P.tid & 63
#define GRID_BAR() do { XcdBarrier b_ = bar; asm volatile("" : "+s"(b_.bar), "+s"(b_.x)); xcd_barrier(b_); } while (0)

    bf16* Wb = (bf16*)(F.ws + WS_W);
    bf16* Z = (bf16*)(F.ws + WS_Z); float* ZS = (float*)(F.ws + WS_ZS); bf16* HDN = (bf16*)(F.ws + WS_HDN);
    float* M32 = (float*)(F.ws + WS_HDN); bf16* HB = (bf16*)(F.ws + WS_Z);
    LAS unsigned char* ring = F.lds + RING_OFF; float* SSp = (float*)(F.ws + WS_SS);

    { FRESH(P); p0_prologue(P, args.in[2], args.in[9], args.in[10], args.in[11], args.in[12], args.in[14], args.in[15]); }
    { FRESH(P); norm0_phase(P, args.in[0], args.in[1], (bf16*)(P.ws + WS_HDN), (float*)(P.ws + WS_SS)); }
    GRID_BAR();

    #pragma unroll 1
    for (int layer = 0; layer < DEPTH; ++layer) {
        const float* xin = (layer == 0) ? args.in[0] : F.out;
        const bf16* L = Wb + (size_t)layer * LW_STRIDE;
        { pg8::Gemm g{HDN, L + LW_IN, M, NIN, DM, DM, DM}; pg8::StaticOrder S; S.init(M, NIN, F.G, (int)blockIdx.x);
          pg8::EpiZ E{Z, ZS, SSp};
          pg8::gemm_phase<pg8::EpiZ, pg8::StaticOrder, true, true>(ring, g, S, E, F.wave); }
        GRID_BAR();
#ifdef PROBE_PP
        { FRESH(P); post_phase(P, args.in[4] + layer * 64, args.in[5] + layer * 64, args.in[6] + layer * 64, args.in[7] + layer * 64, args.in[3] + layer * 8, true); }
#endif
        { FRESH(P); post_phase(P, args.in[4] + layer * 64, args.in[5] + layer * 64, args.in[6] + layer * 64, args.in[7] + layer * 64, args.in[3] + layer * 8); }
        { FRESH(P); ret_state_mfma(P); }
        GRID_BAR();
        { FRESH(P); fscan_phase(P); }
        { FRESH(P); ret_scan(P); }
        GRID_BAR();
#ifdef PROBE_RO
        { FRESH(P); ret_out_mfma(P, args.in[8] + layer * 512, true); }
#endif
        { FRESH(P); ret_out_mfma(P, args.in[8] + layer * 512); }
#ifdef PROBE_X3
        for (int rep_ = 0; rep_ < 2; ++rep_)
        { static_assert(attn_body::ATTN_LDS_BYTES <= RING_BYTES, "attention scratch fits the ring region");
          unsigned char* wsl = F.ws; asm volatile("" : "+s"(wsl));
          bf16* Zl = (bf16*)(wsl + WS_Z);
          const attn_body::AttnTensors AT{(const attn_body::bf16*)(Zl + Z_FQ), (const attn_body::bf16*)(Zl + Z_FK), (const attn_body::bf16*)(Zl + Z_FV), (attn_body::bf16*)(Zl + (rep_ == 0 ? Z_RQ : Z_FQ)), (const float*)(wsl + WS_CF)};
          const attn_body::StaticOrder S((int)F.G, (int)blockIdx.x);
          attn_body::attn_phase<attn_body::StaticOrder, 20>((char*)lds + RING_OFF, AT, S, F.wave); }
#ifdef PROBE_X4
        { FRESH(P); dsa_v3(P); }
#else
        for (int rep_ = 0; rep_ < 2; ++rep_) { FRESH(P); dsa_v3(P, rep_ == 0 ? Z_RG : Z_DQ); }
#endif
#else
        { static_assert(attn_body::ATTN_LDS_BYTES <= RING_BYTES, "attention scratch fits the ring region");
          unsigned char* wsl = F.ws; asm volatile("" : "+s"(wsl));
          bf16* Zl = (bf16*)(wsl + WS_Z);
          const attn_body::AttnTensors AT{(const attn_body::bf16*)(Zl + Z_FQ), (const attn_body::bf16*)(Zl + Z_FK), (const attn_body::bf16*)(Zl + Z_FV), (attn_body::bf16*)(Zl + Z_FQ), (const float*)(wsl + WS_CF)};
          const attn_body::StaticOrder S((int)F.G, (int)blockIdx.x);
          attn_body::attn_phase<attn_body::StaticOrder, 20>((char*)lds + RING_OFF, AT, S, F.wave); }
        { FRESH(P); dsa_v3(P); }
#endif
        GRID_BAR();
        { pg8::StaticOrder S; S.init(M, DM, F.G, (int)blockIdx.x);
          { pg8::Gemm g{Z + Z_FQ, L + LW_MIX, M, DM, 512, ZP, 512}; pg8::EpiGate<0> E{Z + Z_ZG, M32, Z + Z_MRG};
            pg8::gemm_phase<pg8::EpiGate<0>, pg8::StaticOrder, false, true>(ring, g, S, E, F.wave); }
          { pg8::Gemm g{Z + Z_DQ, L + LW_MIX + 512 * 1024, M, DM, 512, ZP, 512}; pg8::EpiGate<1> E{Z + Z_ZG, M32, Z + Z_MRG};
            pg8::gemm_phase<pg8::EpiGate<1>, pg8::StaticOrder, false, true>(ring, g, S, E, F.wave); }
          { pg8::Gemm g{Z + Z_RV, L + LW_MIX + 1024 * 1024, M, DM, 512, ZP, 512}; pg8::EpiGate<2> E{Z + Z_ZG, M32, Z + Z_MRG};
            pg8::gemm_phase<pg8::EpiGate<2>, pg8::StaticOrder, false, true>(ring, g, S, E, F.wave); } }
        GRID_BAR();
        { pg8::Gemm g{Z + Z_MRG, L + LW_O, M, DM, DM, ZP, DM}; pg8::StaticOrder S; S.init(M, DM, F.G, (int)blockIdx.x);
          pg8::EpiRes E{xin, F.out, args.in[13] + layer * DM, HDN, SSp};
          pg8::gemm_phase<pg8::EpiRes, pg8::StaticOrder, false, true>(ring, g, S, E, F.wave); }
        GRID_BAR();
        { pg8::Gemm g{HDN, L + LW_FI, M, FF2, DM, DM, DM}; pg8::StaticOrder S; S.init(M, FF2, F.G, (int)blockIdx.x);
          pg8::EpiSwi E{HB, FFH, SSp};
          pg8::gemm_phase<pg8::EpiSwi, pg8::StaticOrder, true, true>(ring, g, S, E, F.wave); }
        GRID_BAR();
        { pg8::Gemm g{HB, L + LW_FO, M, DM, FFH, FFH, FFH}; pg8::StaticOrder S; S.init(M, DM, F.G, (int)blockIdx.x);
          pg8::EpiRes E{F.out, F.out, args.in[1] + (layer + 1 < DEPTH ? layer + 1 : layer) * DM, HDN, SSp};
          pg8::gemm_phase<pg8::EpiRes, pg8::StaticOrder, false, true>(ring, g, S, E, F.wave); }
        GRID_BAR();
    }
    if (__hip_atomic_load((gu32*)((unsigned*)(ctl + CW_BAR) + XB_TMO), RLX_AGENT) != 0u) {
        const float q = __builtin_nanf("");
        for (int m = F.gw; m < M; m += F.NGW) { GAS f32x4* o = (GAS f32x4*)(F.out + (size_t)m * DM) + lane_id_v();
#pragma unroll
            for (int j = 0; j < 4; ++j) o[64 * j] = (f32x4){q, q, q, q}; }
    }
}

extern "C" void kernel_launch(void* const* d_in, const int* in_sizes, int n_in, void* d_out, int out_size, void* d_ws, size_t ws_size, hipStream_t stream) {
    static int grid = 0;
    if (grid == 0) {
        if (n_in != 16 || in_sizes[0] != M * DM || out_size != M * DM || ws_size < WS_END) { fprintf(stderr, "kernel_launch: unexpected shapes / workspace (n_in %d, in0 %d, out %d, ws %zu < %zu)\n", n_in, n_in > 0 ? in_sizes[0] : -1, out_size, ws_size, (size_t)WS_END); grid = -1; return; }
        int dev = 0, cus = 0, per_cu = 0;
        if (hipGetDevice(&dev) != hipSuccess || hipDeviceGetAttribute(&cus, hipDeviceAttributeMultiprocessorCount, dev) != hipSuccess) { grid = -1; return; }
        if (hipFuncSetAttribute((const void*)hyb_fwd, hipFuncAttributeMaxDynamicSharedMemorySize, LDS_BYTES) != hipSuccess) { fprintf(stderr, "kernel_launch: hipFuncSetAttribute failed\n"); grid = -1; return; }
        if (hipOccupancyMaxActiveBlocksPerMultiprocessor(&per_cu, (const void*)hyb_fwd, NWAVES * 64, LDS_BYTES) != hipSuccess || per_cu < 1) { fprintf(stderr, "kernel_launch: occupancy query reports %d blocks per CU\n", per_cu); }
        (void)hipGetLastError();
        grid = cus;
    }
    if (grid < 0) return;
    if (hipMemsetAsync((char*)d_ws + WS_CTL, 0, CTL_ZERO_BYTES, stream) != hipSuccess) return;
    Args a{};
    for (int i = 0; i < 16; ++i) a.in[i] = (const float*)d_in[i];
    a.out = (float*)d_out; a.ws = (unsigned char*)d_ws;
    hipLaunchKernelGGL(hyb_fwd, dim3(grid), dim3(NWAVES * 64), LDS_BYTES, stream, a);
}
```

```cpp
#include <hip/hip_runtime.h>
#include <cstdio>
#include <cstdint>
#include <cmath>
__device__ __forceinline__ int lane_id_v() { unsigned z; asm volatile("v_mov_b32 %0, 0" : "=v"(z)); return (int)__builtin_amdgcn_mbcnt_hi(~0u, __builtin_amdgcn_mbcnt_lo(~0u, z)); }
template <int MASK> __device__ __forceinline__ float sx(float v) { static_assert(MASK < 32, "swizzle xor mask"); return __builtin_bit_cast(float, __builtin_amdgcn_ds_swizzle(__builtin_bit_cast(int, v), 0x1F | (MASK << 10))); }
template <int MASK> __device__ __forceinline__ unsigned sxu(unsigned v) { return (unsigned)__builtin_amdgcn_ds_swizzle((int)v, 0x1F | (MASK << 10)); }
__device__ __forceinline__ void swap32(unsigned x, unsigned& lo_view, unsigned& hi_view) {
    unsigned a = x, b = x; asm volatile("" : "+v"(b));
    const auto rr = __builtin_amdgcn_permlane32_swap(a, b, false, false);
    lo_view = rr[0]; hi_view = rr[1];
}
template <int CTRL> __device__ __forceinline__ float dpp_f(float v) { return __builtin_bit_cast(float, __builtin_amdgcn_update_dpp(0, __builtin_bit_cast(int, v), CTRL, 0xF, 0xF, false)); }
template <int CTRL> __device__ __forceinline__ int dpp_i(int v) { return __builtin_amdgcn_update_dpp(0, v, CTRL, 0xF, 0xF, false); }
__device__ __forceinline__ float rl_f(float v, int l) { return __builtin_bit_cast(float, __builtin_amdgcn_readlane(__builtin_bit_cast(int, v), l)); }
__device__ __forceinline__ float wave_sum(float v) {
    v += dpp_f<0xB1>(v); v += dpp_f<0x4E>(v); v += dpp_f<0x141>(v); v += dpp_f<0x140>(v);
    return (rl_f(v, 0) + rl_f(v, 16)) + (rl_f(v, 32) + rl_f(v, 48));
}
__device__ __forceinline__ float wave_max(float v) {
    v = fmaxf(v, dpp_f<0xB1>(v)); v = fmaxf(v, dpp_f<0x4E>(v)); v = fmaxf(v, dpp_f<0x141>(v)); v = fmaxf(v, dpp_f<0x140>(v));
    return fmaxf(fmaxf(rl_f(v, 0), rl_f(v, 16)), fmaxf(rl_f(v, 32), rl_f(v, 48)));
}
__device__ __forceinline__ int wave_isum(int v) {
    v += dpp_i<0xB1>(v); v += dpp_i<0x4E>(v); v += dpp_i<0x141>(v); v += dpp_i<0x140>(v);
    return (__builtin_amdgcn_readlane(v, 0) + __builtin_amdgcn_readlane(v, 16)) + (__builtin_amdgcn_readlane(v, 32) + __builtin_amdgcn_readlane(v, 48));
}
__device__ __forceinline__ unsigned wave_umax(unsigned v) {
    unsigned t; t = (unsigned)dpp_i<0xB1>((int)v); v = t > v ? t : v; t = (unsigned)dpp_i<0x4E>((int)v); v = t > v ? t : v; t = (unsigned)dpp_i<0x141>((int)v); v = t > v ? t : v; t = (unsigned)dpp_i<0x140>((int)v); v = t > v ? t : v;
    const unsigned a = (unsigned)__builtin_amdgcn_readlane((int)v, 0), b = (unsigned)__builtin_amdgcn_readlane((int)v, 16), c = (unsigned)__builtin_amdgcn_readlane((int)v, 32), d = (unsigned)__builtin_amdgcn_readlane((int)v, 48);
    const unsigned ab = a > b ? a : b, cd = c > d ? c : d; return ab > cd ? ab : cd;
}
__device__ __forceinline__ unsigned wave_umin(unsigned v) { return ~wave_umax(~v); }
__device__ __forceinline__ float half_sum(float v) {
    unsigned a, b; swap32(__builtin_bit_cast(unsigned, v), a, b); return __builtin_bit_cast(float, a) + __builtin_bit_cast(float, b);
}
__device__ __forceinline__ float half_max(float v) {
    unsigned a, b; swap32(__builtin_bit_cast(unsigned, v), a, b); return fmaxf(__builtin_bit_cast(float, a), __builtin_bit_cast(float, b));
}
namespace pg8 {
#define PG8_LAS __attribute__((address_space(3)))
typedef unsigned short bf16_t;
typedef short bf16x8 __attribute__((ext_vector_type(8)));
typedef float f32x4 __attribute__((ext_vector_type(4)));
typedef unsigned u32x4 __attribute__((ext_vector_type(4)));
constexpr int BM = 256, BK = 64, HALF = 128, HTB = HALF * BK * 2  , STAGE_BYTES = 8 * HTB, NXCD = 8, WGM = 8;

__host__ __device__ __forceinline__ int lds_byte(int r, int c) { const int st = (r >> 4) * 2 + (c >> 5), rr = r & 15, cc = c & 31, ob = rr * 64 + cc * 2; return st * 1024 + (ob ^ (((ob >> 9) & 1) << 5)); }
__host__ __device__ __forceinline__ void stage_rc(int b, int& R, int& C) { const int st = b / 1024, sb = b % 1024, swz = sb ^ (((sb >> 9) & 1) << 5); R = (st >> 1) * 16 + swz / 64; C = (st & 1) * 32 + (swz % 64) / 2; }
__host__ __device__ __forceinline__ int perm32(int rho) { const int n = rho >> 4, i = rho & 15; return 8 * (i >> 2) + 4 * n + (i & 3); }

struct Unit { int pm, pn; };
struct Gemm { const bf16_t* A; const bf16_t* Bt; int M, N, K, lda, ldb; };

struct StaticOrder {
    int nM, nN, nwg, G, c;
    __host__ __device__ void init(int M, int N, int G_, int c_) { nM = M / BM; nN = N / BM; nwg = nM * nN; G = G_; c = c_; }
    __host__ __device__ bool next(int i, Unit& u) const {
        const long L = (long)i * G + c; if (L >= nwg) return false;
        int wgid = (int)L; { const int q = nwg / NXCD, r = nwg % NXCD, xcd = wgid % NXCD, off = wgid / NXCD; wgid = (xcd < r ? xcd * (q + 1) : r * (q + 1) + (xcd - r) * q) + off; }
        const int nig = WGM * nN, gid = wgid / nig, fm = gid * WGM, gsz = (nM - fm) < WGM ? (nM - fm) : WGM;
        u.pm = fm + ((wgid % nig) % gsz); u.pn = (wgid % nig) / gsz; return true;
    }
    __device__ __forceinline__ void a_ready(const Unit&) const {}
    __device__ __forceinline__ void done(const Unit&) const {}
};

__device__ __forceinline__ unsigned cvt_pk_bf16(float lo, float hi) { unsigned r; asm volatile("v_cvt_pk_bf16_f32 %0, %1, %2" : "=v"(r) : "v"(lo), "v"(hi)); return r; }
__device__ __forceinline__ float bflo(unsigned w) { return __builtin_bit_cast(float, w << 16); }
__device__ __forceinline__ float bfhi(unsigned w) { return __builtin_bit_cast(float, w & 0xffff0000u); }
__device__ __forceinline__ float sigmoidf_(float x) { return __builtin_amdgcn_rcpf(1.0f + __builtin_amdgcn_exp2f(-1.4426950408889634f * x)); }

constexpr int ZP = 6656;
constexpr int ZSP = 512;
constexpr int NZT = 26, GATE_T0 = 14;

__device__ __forceinline__ float row_rstd(const float* SS, int row) {
    const f32x4 a = *(const f32x4*)(SS + (size_t)row * 16), b = *(const f32x4*)(SS + (size_t)row * 16 + 4), c = *(const f32x4*)(SS + (size_t)row * 16 + 8), d = *(const f32x4*)(SS + (size_t)row * 16 + 12);
    const float s = ((a[0] + a[1]) + (a[2] + a[3])) + ((b[0] + b[1]) + (b[2] + b[3])) + ((c[0] + c[1]) + (c[2] + c[3])) + ((d[0] + d[1]) + (d[2] + d[3]));
    return 1.0f / __builtin_sqrtf(s * (1.0f / 1024.0f) + 1e-6f);
}
struct EpiZ {
    static constexpr bool PERM = true, AFTER_DRAIN = false;
    bf16_t* Z; float* ZS; const float* SS;
    __device__ __forceinline__ void operator()(const f32x4 (&acc)[2][2][4][2], const Unit& u, int wr, int wc, int fr, int fq) const {
        const int row0 = u.pm * BM + wr * 64 + fr;
        if (u.pn < NZT) {
            const int col0 = u.pn * BM + wc * 32 + 8 * fq;
#pragma unroll
            for (int ai = 0; ai < 2; ++ai)
#pragma unroll
                for (int m = 0; m < 4; ++m) { bf16_t* rowp = Z + (size_t)(row0 + ai * HALF + m * 16) * ZP + col0; const float rs = row_rstd(SS, row0 + ai * HALF + m * 16);
#pragma unroll
                    for (int bj = 0; bj < 2; ++bj) { f32x4 v0 = acc[ai][bj][m][0] * rs, v1 = acc[ai][bj][m][1] * rs;
                        if (u.pn >= GATE_T0) {
#pragma unroll
                            for (int i = 0; i < 4; ++i) { v0[i] = sigmoidf_(v0[i]); v1[i] = sigmoidf_(v1[i]); } }
                        u32x4 w; w.x = cvt_pk_bf16(v0[0], v0[1]); w.y = cvt_pk_bf16(v0[2], v0[3]); w.z = cvt_pk_bf16(v1[0], v1[1]); w.w = cvt_pk_bf16(v1[2], v1[3]);
                        *(u32x4*)(rowp + bj * HALF) = w; } }
        } else {
            const int col0 = (u.pn - NZT) * BM + wc * 32 + 8 * fq;
#pragma unroll
            for (int ai = 0; ai < 2; ++ai)
#pragma unroll
                for (int m = 0; m < 4; ++m) { float* rowp = ZS + (size_t)(row0 + ai * HALF + m * 16) * ZSP + col0; const float rs = row_rstd(SS, row0 + ai * HALF + m * 16);
#pragma unroll
                    for (int bj = 0; bj < 2; ++bj) { *(f32x4*)(rowp + bj * HALF) = acc[ai][bj][m][0] * rs; *(f32x4*)(rowp + bj * HALF + 4) = acc[ai][bj][m][1] * rs; } }
        }
    }
};

template <int P> struct EpiGate {
    static constexpr bool PERM = true, AFTER_DRAIN = false;
    const bf16_t* G;
    float* M32;
    bf16_t* OUT;
    __device__ __forceinline__ void operator()(const f32x4 (&acc)[2][2][4][2], const Unit& u, int wr, int wc, int fr, int fq) const {
        const int row0 = u.pm * BM + wr * 64 + fr, col0 = u.pn * BM + wc * 32 + 8 * fq;
#pragma unroll
        for (int ai = 0; ai < 2; ++ai)
#pragma unroll
            for (int m = 0; m < 4; ++m) { const size_t row = (size_t)(row0 + ai * HALF + m * 16);
#pragma unroll
                for (int bj = 0; bj < 2; ++bj) { const int col = col0 + bj * HALF;
                    const u32x4 gw = *(const u32x4*)(G + row * ZP + P * 1024 + col);
                    const f32x4 v0 = acc[ai][bj][m][0], v1 = acc[ai][bj][m][1];
                    f32x4 t0, t1;
                    t0[0] = bflo(gw.x) * v0[0]; t0[1] = bfhi(gw.x) * v0[1]; t0[2] = bflo(gw.y) * v0[2]; t0[3] = bfhi(gw.y) * v0[3];
                    t1[0] = bflo(gw.z) * v1[0]; t1[1] = bfhi(gw.z) * v1[1]; t1[2] = bflo(gw.w) * v1[2]; t1[3] = bfhi(gw.w) * v1[3];
                    float* mp = M32 + row * 1024 + col;
                    if (P == 0) { *(f32x4*)mp = t0; *(f32x4*)(mp + 4) = t1; }
                    else if (P == 1) { *(f32x4*)mp = *(const f32x4*)mp + t0; *(f32x4*)(mp + 4) = *(const f32x4*)(mp + 4) + t1; }
                    else { t0 = *(const f32x4*)mp + t0; t1 = *(const f32x4*)(mp + 4) + t1;
                        u32x4 w; w.x = cvt_pk_bf16(t0[0], t0[1]); w.y = cvt_pk_bf16(t0[2], t0[3]); w.z = cvt_pk_bf16(t1[0], t1[1]); w.w = cvt_pk_bf16(t1[2], t1[3]);
                        *(u32x4*)(OUT + row * ZP + col) = w; } } }
    }
};

struct EpiRes {
    static constexpr bool PERM = true, AFTER_DRAIN = false;
    const float* RES; float* OUT; const float* G; bf16_t* XG; float* SS;
    __device__ __forceinline__ void operator()(const f32x4 (&acc)[2][2][4][2], const Unit& u, int wr, int wc, int fr, int fq) const {
        const int row0 = u.pm * BM + wr * 64 + fr, col0 = u.pn * BM + wc * 32 + 8 * fq;
        f32x4 g[2][2];
#pragma unroll
        for (int bj = 0; bj < 2; ++bj) { g[bj][0] = *(const f32x4*)(G + col0 + bj * HALF); g[bj][1] = *(const f32x4*)(G + col0 + bj * HALF + 4); }
#pragma unroll
        for (int ai = 0; ai < 2; ++ai)
#pragma unroll
            for (int m = 0; m < 4; ++m) { const int row = row0 + ai * HALF + m * 16; const size_t off = (size_t)row * 1024 + col0; float ss = 0.f;
#pragma unroll
                for (int bj = 0; bj < 2; ++bj) { const float* rp = RES + off + bj * HALF; float* op = OUT + off + bj * HALF;
                    const f32x4 v0 = *(const f32x4*)rp + acc[ai][bj][m][0], v1 = *(const f32x4*)(rp + 4) + acc[ai][bj][m][1];
                    *(f32x4*)op = v0; *(f32x4*)(op + 4) = v1;
                    ss += ((v0[0] * v0[0] + v0[1] * v0[1]) + (v0[2] * v0[2] + v0[3] * v0[3])) + ((v1[0] * v1[0] + v1[1] * v1[1]) + (v1[2] * v1[2] + v1[3] * v1[3]));
                    const f32x4 x0 = v0 * g[bj][0], x1 = v1 * g[bj][1];
                    u32x4 w; w.x = cvt_pk_bf16(x0[0], x0[1]); w.y = cvt_pk_bf16(x0[2], x0[3]); w.z = cvt_pk_bf16(x1[0], x1[1]); w.w = cvt_pk_bf16(x1[2], x1[3]);
                    *(u32x4*)(XG + off + bj * HALF) = w; }
                ss += sx<16>(ss); { unsigned a, b; swap32(__builtin_bit_cast(unsigned, ss), a, b); ss = __builtin_bit_cast(float, a) + __builtin_bit_cast(float, b); }
                if (fq == 0) SS[(size_t)row * 16 + u.pn * 4 + wc] = ss; }
    }
};

struct EpiSwi {
    static constexpr bool PERM = true, AFTER_DRAIN = false;
    bf16_t* H; int ldh; const float* SS;
    __device__ __forceinline__ void operator()(const f32x4 (&acc)[2][2][4][2], const Unit& u, int wr, int wc, int fr, int fq) const {
        const int row0 = u.pm * BM + wr * 64 + fr, col0 = u.pn * HALF + wc * 32 + 8 * fq;
#pragma unroll
        for (int ai = 0; ai < 2; ++ai)
#pragma unroll
            for (int m = 0; m < 4; ++m) { bf16_t* hp = H + (size_t)(row0 + ai * HALF + m * 16) * ldh + col0; const float rs = row_rstd(SS, row0 + ai * HALF + m * 16);
                float o[8];
#pragma unroll
                for (int n = 0; n < 2; ++n)
#pragma unroll
                    for (int i = 0; i < 4; ++i) { const float g = acc[ai][0][m][n][i] * rs, up = acc[ai][1][m][n][i] * rs; o[4 * n + i] = g * sigmoidf_(g) * up; }
                u32x4 w; w.x = cvt_pk_bf16(o[0], o[1]); w.y = cvt_pk_bf16(o[2], o[3]); w.z = cvt_pk_bf16(o[4], o[5]); w.w = cvt_pk_bf16(o[6], o[7]);
                *(u32x4*)hp = w; }
    }
};

template <class Epi, class Sched, bool ALIGN_EPI = false, bool SP2 = false>
__device__ __forceinline__ void gemm_phase(PG8_LAS unsigned char* lds, Gemm g, const Sched& S0, const Epi& E, int wave_id) {
    int ovz, osz; asm volatile("v_mov_b32 %0, 0\n\ts_mov_b32 %1, 0" : "=v"(ovz), "=s"(osz));
    Sched S = S0; S.c += osz; g.lda += osz; g.ldb += osz;
    const int tid = ((wave_id << 6) | lane_id_v()) + ovz,
         wid = __builtin_amdgcn_readfirstlane(tid >> 6), lane = tid & 63, wr = wid >> 2, wc = wid & 3, fr = lane & 15, fq = lane >> 4;
    const int K = g.K, nt = K / BK;
    unsigned voffA[2], voffB[2];
#pragma unroll
    for (int i = 0; i < 2; ++i) { int R, C; stage_rc(tid * 16 + i * 8192, R, C); const int Rb = Epi::PERM ? ((R & ~31) + perm32(R & 31)) : R;
        voffA[i] = (unsigned)(R * g.lda + C) * 2u; voffB[i] = (unsigned)(Rb * g.ldb + C) * 2u; }
    const size_t kstep = (size_t)(BK * 2);
    const size_t hstepA = (size_t)HALF * g.lda * 2, hstepB = (size_t)HALF * g.ldb * 2;
    const size_t tstepA = 2 * hstepA, tstepB = 2 * hstepB;
    const unsigned ldsw = (unsigned)wid * 1024u;
    const int aoff = lds_byte(wr * 64 + fr, fq * 8), boff = lds_byte(wc * 32 + fr, fq * 8);
#define PG8_SA(b, h) (((b) * 2 + (h)) * HTB)
#define PG8_SB(b, h) ((4 + (b) * 2 + (h)) * HTB)
#define PG8_STAGE(bufoff, gbase, voff) do { _Pragma("unroll") for (int _i = 0; _i < 2; ++_i) \
        __builtin_amdgcn_global_load_lds((const unsigned*)((const char*)(gbase) + (voff)[_i]), (PG8_LAS unsigned*)(lds + (bufoff) + ldsw + _i * 8192), 16, 0, 0); } while (0)
#define PG8_LDA(dst, b, h) do { _Pragma("unroll") for (int m = 0; m < 4; ++m) _Pragma("unroll") for (int k = 0; k < 2; ++k) dst[m][k] = *(const PG8_LAS bf16x8*)(lds + PG8_SA(b, h) + aoff + m * 2048 + k * 1024); } while (0)
#define PG8_LDB(dst, b, h) do { _Pragma("unroll") for (int n = 0; n < 2; ++n) _Pragma("unroll") for (int k = 0; k < 2; ++k) dst[n][k] = *(const PG8_LAS bf16x8*)(lds + PG8_SB(b, h) + boff + n * 2048 + k * 1024); } while (0)
#define PG8_MMA(ai, bj, At, Bt) do { __builtin_amdgcn_s_setprio(1); _Pragma("unroll") for (int m = 0; m < 4; ++m) _Pragma("unroll") for (int n = 0; n < 2; ++n) _Pragma("unroll") for (int k = 0; k < 2; ++k) \
        acc[ai][bj][m][n] = __builtin_amdgcn_mfma_f32_16x16x32_bf16(Bt[n][k], At[m][k], acc[ai][bj][m][n], 0, 0, 0); __builtin_amdgcn_s_setprio(0); } while (0)
#define PG8_WAIT_V(n) asm volatile("s_waitcnt vmcnt(" #n ")" ::: "memory")
#define PG8_WAIT_L(n) asm volatile("s_waitcnt lgkmcnt(" #n ")" ::: "memory")
#define PG8_BAR __builtin_amdgcn_s_barrier()
#define PG8_SCHED __builtin_amdgcn_sched_barrier(0)
    Unit cur, nxt; int ui = 0;
    if (!S.next(0, cur)) return;
    f32x4 acc[2][2][4][2];
#pragma unroll
    for (int a = 0; a < 2; ++a)
#pragma unroll
        for (int b = 0; b < 2; ++b)
#pragma unroll
            for (int m = 0; m < 4; ++m)
#pragma unroll
                for (int n = 0; n < 2; ++n) acc[a][b][m][n] = (f32x4){0.f, 0.f, 0.f, 0.f};
    bf16x8 At[4][2], B0[2][2], B1[2][2];
    const char* cA = (const char*)g.A + (size_t)cur.pm * tstepA; const char* cB = (const char*)g.Bt + (size_t)cur.pn * tstepB;
    S.a_ready(cur);
    if constexpr (SP2) {
        PG8_STAGE(PG8_SB(0, 0), cB, voffB); PG8_STAGE(PG8_SB(0, 1), cB + hstepB, voffB); PG8_STAGE(PG8_SA(0, 0), cA, voffA); PG8_STAGE(PG8_SA(0, 1), cA + hstepA, voffA);
        if (wr == 1) PG8_BAR;
        PG8_WAIT_V(2); PG8_BAR;
        PG8_STAGE(PG8_SB(1, 0), cB + kstep, voffB); PG8_STAGE(PG8_SA(1, 0), cA + kstep, voffA); PG8_STAGE(PG8_SB(1, 1), cB + hstepB + kstep, voffB);
        PG8_WAIT_V(6); PG8_BAR;
    } else {
        PG8_STAGE(PG8_SB(0, 0), cB, voffB); PG8_STAGE(PG8_SA(0, 0), cA, voffA); PG8_STAGE(PG8_SB(0, 1), cB + hstepB, voffB); PG8_STAGE(PG8_SA(0, 1), cA + hstepA, voffA);
        if (wr == 1) PG8_BAR;
        PG8_WAIT_V(4); PG8_BAR;
        PG8_STAGE(PG8_SB(1, 0), cB + kstep, voffB); PG8_STAGE(PG8_SA(1, 0), cA + kstep, voffA); PG8_STAGE(PG8_SB(1, 1), cB + hstepB + kstep, voffB);
        PG8_WAIT_V(6); PG8_BAR;
    }
    for (;;) {
        const bool has_next = S.next(ui + 1, nxt);
        const char* nA = has_next ? (const char*)g.A + (size_t)nxt.pm * tstepA : cA; const char* nB = has_next ? (const char*)g.Bt + (size_t)nxt.pn * tstepB : cB;
        for (int t = 0; t < nt; t += 2) {
            const bool last = (t == nt - 2);
            const char* a1 = cA + (size_t)(t + 1) * kstep;
            const char* a2 = last ? nA : cA + (size_t)(t + 2) * kstep; const char* b2 = last ? nB : cB + (size_t)(t + 2) * kstep;
            const char* a3 = a2 + kstep; const char* b3 = b2 + kstep;
            if (last && has_next) S.a_ready(nxt);
            if constexpr (SP2) {
            PG8_LDB(B0, 0, 0); PG8_LDB(B1, 0, 1); PG8_SCHED; PG8_LDA(At, 0, 0); PG8_STAGE(PG8_SA(1, 1), a1 + hstepA, voffA);
            PG8_WAIT_V(8); PG8_WAIT_L(0); PG8_BAR; PG8_MMA(0, 0, At, B0); PG8_MMA(0, 1, At, B1); PG8_BAR; PG8_SCHED;
            PG8_LDA(At, 0, 1); PG8_STAGE(PG8_SB(0, 0), b2, voffB); PG8_STAGE(PG8_SB(0, 1), b2 + hstepB, voffB); PG8_STAGE(PG8_SA(0, 0), a2, voffA);
            PG8_WAIT_V(8); PG8_WAIT_L(0); PG8_BAR; PG8_MMA(1, 0, At, B0); PG8_MMA(1, 1, At, B1); PG8_BAR; PG8_SCHED;
            PG8_LDB(B0, 1, 0); PG8_LDB(B1, 1, 1); PG8_SCHED; PG8_LDA(At, 1, 0); PG8_STAGE(PG8_SA(0, 1), a2 + hstepA, voffA);
            PG8_WAIT_V(8); PG8_WAIT_L(0); PG8_BAR; PG8_MMA(0, 0, At, B0); PG8_MMA(0, 1, At, B1); PG8_BAR; PG8_SCHED;
            PG8_LDA(At, 1, 1); PG8_STAGE(PG8_SB(1, 0), b3, voffB); PG8_STAGE(PG8_SB(1, 1), b3 + hstepB, voffB); PG8_STAGE(PG8_SA(1, 0), a3, voffA);
            PG8_WAIT_V(8); PG8_WAIT_L(0); PG8_BAR; PG8_MMA(1, 0, At, B0); PG8_MMA(1, 1, At, B1); PG8_BAR; PG8_SCHED;
            } else {
            PG8_LDB(B0, 0, 0); PG8_SCHED; PG8_LDA(At, 0, 0); PG8_STAGE(PG8_SA(1, 1), a1 + hstepA, voffA);
            PG8_WAIT_L(8); PG8_BAR; PG8_WAIT_L(0); PG8_MMA(0, 0, At, B0); PG8_BAR; PG8_SCHED;
            PG8_LDB(B1, 0, 1); PG8_STAGE(PG8_SB(0, 0), b2, voffB);
            PG8_BAR; PG8_WAIT_L(0); PG8_MMA(0, 1, At, B1); PG8_BAR;
            PG8_LDA(At, 0, 1); PG8_STAGE(PG8_SA(0, 0), a2, voffA);
            PG8_BAR; PG8_WAIT_L(0); PG8_MMA(1, 0, At, B0); PG8_BAR; PG8_SCHED;
            PG8_STAGE(PG8_SB(0, 1), b2 + hstepB, voffB);
            PG8_WAIT_V(6); PG8_BAR; PG8_MMA(1, 1, At, B1); PG8_BAR;
            PG8_LDB(B0, 1, 0); PG8_SCHED; PG8_LDA(At, 1, 0); PG8_STAGE(PG8_SA(0, 1), a2 + hstepA, voffA);
            PG8_WAIT_L(8); PG8_BAR; PG8_WAIT_L(0); PG8_MMA(0, 0, At, B0); PG8_BAR; PG8_SCHED;
            PG8_LDB(B1, 1, 1); PG8_STAGE(PG8_SB(1, 0), b3, voffB);
            PG8_BAR; PG8_WAIT_L(0); PG8_MMA(0, 1, At, B1); PG8_BAR;
            PG8_LDA(At, 1, 1); PG8_STAGE(PG8_SA(1, 0), a3, voffA);
            PG8_BAR; PG8_WAIT_L(0); PG8_MMA(1, 0, At, B0); PG8_BAR; PG8_SCHED;
            PG8_STAGE(PG8_SB(1, 1), b3 + hstepB, voffB);
            PG8_WAIT_V(6); PG8_BAR; PG8_MMA(1, 1, At, B1); PG8_BAR;
            }
        }
        if constexpr (ALIGN_EPI) { if (wr == 0) PG8_BAR; }
        if constexpr (!Epi::AFTER_DRAIN) { E(acc, cur, wr, wc, fr, fq); S.done(cur); }
        if (!has_next) break;
#pragma unroll
        for (int a = 0; a < 2; ++a)
#pragma unroll
            for (int b = 0; b < 2; ++b)
#pragma unroll
                for (int m = 0; m < 4; ++m)
#pragma unroll
                    for (int n = 0; n < 2; ++n) acc[a][b][m][n] = (f32x4){0.f, 0.f, 0.f, 0.f};
        cur = nxt; cA = nA; cB = nB; ++ui;
        if constexpr (ALIGN_EPI) { if (wr == 1) PG8_BAR; }
    }
    PG8_WAIT_V(0);
    if constexpr (!ALIGN_EPI) { if (wr == 0) PG8_BAR; }
    PG8_BAR;
    if constexpr (Epi::AFTER_DRAIN) { E.fused(acc, cur, wr, wc, fr, fq, lds, wid, lane); S.done(cur); }
#undef PG8_SA
#undef PG8_SB
#undef PG8_STAGE
#undef PG8_LDA
#undef PG8_LDB
#undef PG8_MMA
#undef PG8_WAIT_V
#undef PG8_WAIT_L
#undef PG8_BAR
#undef PG8_SCHED
}
}

constexpr int NB = 4, SEQ = 4096, DM = 1024, DEPTH = 4, M = NB * SEQ;
constexpr int INC = 7088;
constexpr int NIN = 7168;
constexpr int FFH = 2816, FF2 = 5632;
constexpr int ZP = pg8::ZP, ZSP = pg8::ZSP;
constexpr int Z_FQ = 0, Z_FK = 512, Z_FV = 1024, Z_DQ = 1536, Z_RV = 2048, Z_RQ = 2560, Z_RK = 2816, Z_RG = 3072, Z_ZG = 3584, Z_MRG = 2560;
constexpr int S_IQ = 0, S_DK = 256, S_DV = 320, S_IK = 384, S_IW = 416, S_FF = 424;
constexpr float NORM_EPS = 1e-6f;
constexpr float LOG2E = 1.4426950408889634f;
constexpr float C2 = 0.125f * 1.4426950408889634f;

constexpr size_t MiB = 1u << 20;
constexpr size_t WS_CTL = 0, CTL_ZERO_BYTES = 1 * MiB;
constexpr size_t WS_ROPE64 = 1 * MiB;
constexpr size_t WS_ROPE32 = 2 * MiB;
constexpr size_t WS_LF = 2 * MiB + 512 * 1024;
constexpr size_t WS_CF = 3 * MiB;
constexpr size_t WS_ISG = 3 * MiB + 512 * 1024;
constexpr size_t WS_KD = 4 * MiB;
constexpr size_t WS_VD = 6 * MiB;
constexpr size_t WS_W = 8 * MiB;
constexpr size_t LW_IN = 0, LW_MIX = (size_t)NIN * 1024, LW_O = LW_MIX + 1536 * 1024, LW_FI = LW_O + 1024 * 1024, LW_FO = LW_FI + (size_t)FF2 * 1024, LW_STRIDE = LW_FO + (size_t)FFH * 1024;
constexpr size_t WS_Z = 150 * MiB;
constexpr size_t WS_HDN = 358 * MiB;
constexpr size_t WS_ZS = 390 * MiB;
constexpr size_t WS_IQB = 422 * MiB;
constexpr size_t WS_IKB = 430 * MiB;
constexpr size_t WS_SS = 431 * MiB;
constexpr size_t WS_END = 432 * MiB;
static_assert(WS_W + DEPTH * LW_STRIDE * 2 <= WS_Z && WS_Z + (size_t)M * ZP * 2 <= WS_HDN && WS_HDN + (size_t)M * 1024 * 2 == WS_ZS && WS_ZS + (size_t)M * ZSP * 4 == WS_IQB, "d_ws map");
constexpr int CW_BAR = 4096;

constexpr int RING_OFF = 0, RING_BYTES = 133120;
constexpr int LDSCTL_OFF = RING_BYTES, MISC_OFF = LDSCTL_OFF + 320;
constexpr int XTRA_OFF = RING_BYTES + 1024;
constexpr int LDS_BYTES = 147456;
constexpr int NWAVES = 8;
#define GAS __attribute__((address_space(1)))
#define LAS __attribute__((address_space(3)))
typedef unsigned short bf16;
typedef unsigned v4u __attribute__((ext_vector_type(4)));
typedef float f32x4 __attribute__((ext_vector_type(4)));
typedef short bf16x8 __attribute__((ext_vector_type(8)));
typedef GAS unsigned gu32;
typedef GAS unsigned long long gu64;
#define RLX_AGENT __ATOMIC_RELAXED, __HIP_MEMORY_SCOPE_AGENT
#define LDS_WAIT() asm volatile("s_waitcnt lgkmcnt(0)" ::: "memory")
#define VM_WAIT() asm volatile("s_waitcnt vmcnt(0)" ::: "memory")
__device__ __forceinline__ unsigned long long rt() { return __builtin_amdgcn_s_memrealtime(); }
__device__ __forceinline__ unsigned f2bf(float f) { unsigned u = __builtin_bit_cast(unsigned, f); return (u + 0x7fffu + ((u >> 16) & 1u)) >> 16; }
__device__ __forceinline__ unsigned pk2(float lo, float hi) { return f2bf(lo) | (f2bf(hi) << 16); }

#define XB_TMO      128
#define XB_XCNT(j)  (256  + 64 * (j))
#define XB_XSUB(j)  (1280 + 64 * (j))
#define XB_XGEN(j)  (2304 + 64 * (j))
#define XB_TOP      3328
#define XB_TOPGEN   3392
#define XCD_BAR_WORDS 3456
#define XB_SPIN_CAP (1u << 22)

__device__ __forceinline__ unsigned xb_ld(unsigned* p)              { return __hip_atomic_load(p, __ATOMIC_RELAXED, __HIP_MEMORY_SCOPE_AGENT); }
__device__ __forceinline__ unsigned xb_add(unsigned* p, unsigned v) { return __hip_atomic_fetch_add(p, v, __ATOMIC_RELAXED, __HIP_MEMORY_SCOPE_AGENT); }
__device__ __forceinline__ unsigned xb_xcc_id() { return (unsigned)__builtin_amdgcn_s_getreg((3 << 11) | 20) & 0xFu; }
#define XB_SPIN(cond, bar) do { unsigned _sp = 0; while (cond) { __builtin_amdgcn_s_sleep(1); \
    if ((++_sp & 255u) == 0u) { if (xb_ld(&(bar)[XB_TMO])) break; if (_sp > XB_SPIN_CAP) { atomicAdd(&(bar)[XB_TMO], 1u); break; } } } } while (0)

struct XcdBarrier {
    unsigned* bar; unsigned x; int w;
    volatile LAS unsigned* st;
};

__device__ __forceinline__ XcdBarrier xcd_barrier_post(unsigned* bar, volatile LAS unsigned* st) {
    XcdBarrier b; b.bar = bar; b.x = xb_xcc_id(); b.st = st; b.w = 0;
    if (threadIdx.x == 0) (void)xb_add(&bar[XB_XCNT(b.x)], 1u);
    return b;
}
__device__ __forceinline__ void xcd_barrier_complete(unsigned* bar, unsigned x, unsigned& nloc, unsigned& nx) {
    const unsigned G = gridDim.x * gridDim.y * gridDim.z;
    unsigned sum, cnt, mine, sp = 0u;
    for (;;) {
        sum = 0u; cnt = 0u; mine = 0u;
#pragma unroll
        for (unsigned j = 0; j < 16; ++j) { const unsigned c = xb_ld(&bar[XB_XCNT(j)]); sum += c; cnt += (c > 0u) ? 1u : 0u; mine = (j == x) ? c : mine; }
        if (sum == G) break;
        __builtin_amdgcn_s_sleep(1);
        if ((++sp & 255u) == 0u) { if (xb_ld(&bar[XB_TMO])) break; if (sp > XB_SPIN_CAP) { atomicAdd(&bar[XB_TMO], 1u); break; } }
    }
    nloc = mine > 0u ? mine : 1u; nx = cnt > 0u ? cnt : 1u;
}

__device__ __forceinline__ void xcd_barrier(const XcdBarrier& b) {
    asm volatile("s_waitcnt vmcnt(0)" ::: "memory");
    __syncthreads();
    if (b.w == 0 && lane_id_v() == 0) {
        unsigned* bar = b.bar;
        __builtin_amdgcn_s_waitcnt(0);
        unsigned nloc = b.st[0], nx = b.st[1];
        if (nloc == 0u) { xcd_barrier_complete(bar, b.x, nloc, nx); b.st[0] = nloc; b.st[1] = nx; }
        const unsigned old = xb_add(&bar[XB_XSUB(b.x)], 1u);
        const unsigned gen = old / nloc;
        if (old + 1u == (gen + 1u) * nloc) {
            __builtin_amdgcn_fence(__ATOMIC_RELEASE, "agent");
            asm volatile("s_waitcnt vmcnt(0)" ::: "memory");
            const unsigned og = xb_add(&bar[XB_TOP], 1u);
            const unsigned tg = og / nx;
            if (og + 1u == (tg + 1u) * nx) xb_add(&bar[XB_TOPGEN], 1u);
            else XB_SPIN(xb_ld(&bar[XB_TOPGEN]) == tg, bar);
            __builtin_amdgcn_fence(__ATOMIC_ACQUIRE, "agent");
            xb_add(&bar[XB_XGEN(b.x)], 1u);
            asm volatile("s_waitcnt vmcnt(0)" ::: "memory");
        } else {
            XB_SPIN(xb_ld(&bar[XB_XGEN(b.x)]) == gen, bar);
            __builtin_amdgcn_fence(__ATOMIC_ACQUIRE, "agent");
            asm volatile("s_waitcnt vmcnt(0)" ::: "memory");
        }
    }
    __syncthreads();
}

typedef float f32x2 __attribute__((ext_vector_type(2)));
typedef unsigned u32x2 __attribute__((ext_vector_type(2)));
__device__ __forceinline__ float bflo(unsigned w) { return __builtin_bit_cast(float, w << 16); }
__device__ __forceinline__ float bfhi(unsigned w) { return __builtin_bit_cast(float, w & 0xffff0000u); }
__device__ __forceinline__ float bf2f(bf16 v) { return __builtin_bit_cast(float, (unsigned)v << 16); }
__device__ __forceinline__ void unpack8(const v4u w, float (&f)[8]) { f[0] = bflo(w.x); f[1] = bfhi(w.x); f[2] = bflo(w.y); f[3] = bfhi(w.y); f[4] = bflo(w.z); f[5] = bfhi(w.z); f[6] = bflo(w.w); f[7] = bfhi(w.w); }
__device__ __forceinline__ v4u pack8(const float (&f)[8]) { v4u w; w.x = pk2(f[0], f[1]); w.y = pk2(f[2], f[3]); w.z = pk2(f[4], f[5]); w.w = pk2(f[6], f[7]); return w; }
__device__ __forceinline__ float xor32(float v, int lane) {
    return __builtin_bit_cast(float, __builtin_amdgcn_ds_bpermute((lane ^ 32) << 2, __builtin_bit_cast(int, v)));
}
__device__ __forceinline__ float sigmoid_f(float x) { return 1.0f / (1.0f + __expf(-x)); }

struct Ctx {
    LAS unsigned char* lds;
    int tid, lane, wave, G, gw, NGW;
    float* out; unsigned char* ws;
};

__device__ __forceinline__ void conv_item(const float* W, int N, int sc, int nv, int k0, bf16* WT, int ldw, int dr, LAS float* scr, int lane) {
    const int n_ = lane & 31;
#pragma unroll 8
    for (int i = 0; i < 32; ++i) { const int kk = 2 * i + (lane >> 5); scr[kk * 33 + n_] = (n_ < nv) ? W[(size_t)(k0 + kk) * N + sc + n_] : 0.f; }
    LDS_WAIT(); asm volatile("" ::: "memory");
    const int c = lane & 7;
#pragma unroll
    for (int j = 0; j < 4; ++j) { const int n = (lane >> 3) + 8 * j; const LAS float* s = scr + (8 * c) * 33 + n;
        v4u o; o.x = pk2(s[0 * 33], s[1 * 33]); o.y = pk2(s[2 * 33], s[3 * 33]); o.z = pk2(s[4 * 33], s[5 * 33]); o.w = pk2(s[6 * 33], s[7 * 33]);
        if (n < nv) *(GAS v4u*)(WT + (size_t)(dr + n) * ldw + k0 + 8 * c) = o; }
    LDS_WAIT(); asm volatile("" ::: "memory");
}
__device__ const int SEG_IN[15][3] = {
    {0, 0, 512}, {512, 512, 512}, {1024, 1024, 512}, {1536, 6656 + S_FF, 8}, {1544, Z_DQ, 512}, {2056, 6656 + S_DK, 64}, {2120, 6656 + S_DV, 64},
    {2184, 6656 + S_IQ, 256}, {2440, 6656 + S_IK, 32}, {2472, 6656 + S_IW, 8}, {2480, Z_RQ, 256}, {2736, Z_RK, 256}, {2992, Z_RV, 512}, {3504, Z_RG, 512}, {4016, Z_ZG, 3072}};
constexpr int IN_BLK = 223;
constexpr int IT_IN = 16 * IN_BLK, IT_MIX = 8 * 32, IT_O = 16 * 32, IT_FI = 16 * (FF2 / 32), IT_FO = (FFH / 64) * 32;
constexpr int IT_LAYER = IT_IN + 3 * IT_MIX + IT_O + IT_FI + IT_FO;

__device__ __forceinline__ void sincos_acc(float ang, float& c, float& s) {
    const double a = (double)ang;
    const double k = __builtin_rint(a * 0.6366197723675814);
    double y = a - k * 1.5707963267948966; y -= k * 6.123233995736766e-17;
    const double y2 = y * y;
    double sp = -7.647163731819816e-13; sp = sp * y2 + 1.6059043836821613e-10; sp = sp * y2 - 2.505210838544172e-08; sp = sp * y2 + 2.7557319223985893e-06; sp = sp * y2 - 1.984126984126984e-04; sp = sp * y2 + 8.333333333333333e-03; sp = sp * y2 - 1.6666666666666666e-01;
    const double sn = y + y * y2 * sp;
    double cp = 4.779477332387385e-14; cp = cp * y2 - 1.1470745597729725e-11; cp = cp * y2 + 2.08767569878681e-09; cp = cp * y2 - 2.755731922398589e-07; cp = cp * y2 + 2.48015873015873e-05; cp = cp * y2 - 1.388888888888889e-03; cp = cp * y2 + 4.1666666666666664e-02; cp = cp * y2 - 0.5;
    const double cs = 1.0 + y2 * cp;
    const int q = ((int)k) & 3;
    const double ss = (q & 1) ? cs : sn, cc = (q & 1) ? sn : cs;
    s = (float)((q & 2) ? -ss : ss);
    c = (float)(((q + 1) & 2) ? -cc : cc);
}

__device__ __forceinline__ void p0_prologue(const Ctx& F, const float* w_in, const float* w_fox, const float* w_dsa, const float* w_ret, const float* w_o, const float* w_fi, const float* w_fo) {
    LAS float* scr = (LAS float*)(F.lds + RING_OFF + F.wave * 16384);
    bf16* Wb = (bf16*)(F.ws + WS_W);
    for (int it = F.gw; it < DEPTH * IT_LAYER; it += F.NGW) {
        const int l = it / IT_LAYER; int r = it % IT_LAYER;
        bf16* L = Wb + (size_t)l * LW_STRIDE;
        if (r < IT_IN) {
            const int kb = r / IN_BLK; int blk = r % IN_BLK; int sc = 0, dr = 0, nv = 0;
            for (int s = 0; s < 15; ++s) { const int w = SEG_IN[s][2], nb = (w + 31) >> 5; if (blk < nb) { sc = SEG_IN[s][0] + 32 * blk; dr = SEG_IN[s][1] + 32 * blk; nv = (w - 32 * blk) < 32 ? (w - 32 * blk) : 32; break; } blk -= nb; }
            conv_item(w_in + (size_t)l * DM * INC, INC, sc, nv, 64 * kb, L + LW_IN, 1024, dr, scr, F.lane); continue; }
        r -= IT_IN;
        if (r < 3 * IT_MIX) { const int w = r / IT_MIX, q = r % IT_MIX, kb = q / 32, nb = q % 32;
            conv_item((w == 0 ? w_fox : w == 1 ? w_dsa : w_ret) + (size_t)l * 512 * DM, DM, 32 * nb, 32, 64 * kb, L + LW_MIX + (size_t)w * 512 * 1024, 512, 32 * nb, scr, F.lane); continue; }
        r -= 3 * IT_MIX;
        if (r < IT_O) { const int kb = r / 32, nb = r % 32;
            conv_item(w_o + (size_t)l * DM * DM, DM, 32 * nb, 32, 64 * kb, L + LW_O, 1024, 32 * nb, scr, F.lane); continue; }
        r -= IT_O;
        if (r < IT_FI) { const int kb = r / (FF2 / 32), nb = r % (FF2 / 32); const int n0 = 32 * nb;
            const int j = n0 < FFH ? n0 : n0 - FFH; const int dr = 256 * (j >> 7) + (j & 127) + (n0 < FFH ? 0 : 128);
            conv_item(w_fi + (size_t)l * DM * FF2, FF2, n0, 32, 64 * kb, L + LW_FI, 1024, dr, scr, F.lane); continue; }
        r -= IT_FI;
        { const int kb = r / 32, nb = r % 32;
            conv_item(w_fo + (size_t)l * FFH * DM, DM, 32 * nb, 32, 64 * kb, L + LW_FO, FFH, 32 * nb, scr, F.lane); }
    }
    for (int i = F.gw * 64 + F.lane; i < DEPTH * 80 * 128; i += F.NGW * 64) { const int l = i / (80 * 128), q = i % (80 * 128);
        *(GAS v4u*)(Wb + (size_t)l * LW_STRIDE + LW_IN + (size_t)INC * 1024 + (size_t)q * 8) = (v4u){0u, 0u, 0u, 0u}; }
    f32x2* R64 = (f32x2*)(F.ws + WS_ROPE64); f32x2* R32 = (f32x2*)(F.ws + WS_ROPE32);
    for (int i = F.gw * 64 + F.lane; i < SEQ * 32; i += F.NGW * 64) { const int pos = i >> 5, k = i & 31;
        double f = 1.0; for (int e = 0; e < k; ++e) f *= 0.7498942093324559;
        const float ang = (float)pos * (float)f; float c, s; sincos_acc(ang, c, s); R64[i] = (f32x2){c, s}; }
    for (int i = F.gw * 64 + F.lane; i < SEQ * 16; i += F.NGW * 64) { const int pos = i >> 4, k = i & 15;
        double f = 1.0; for (int e = 0; e < k; ++e) f *= 0.5623413251903491;
        const float ang = (float)pos * (float)f; float c, s; sincos_acc(ang, c, s); R32[i] = (f32x2){c, s}; }
}

__device__ __forceinline__ void norm0_phase(const Ctx& F, const float* x, const float* g, bf16* o, float* SS) {
    const GAS f32x4* gp = (const GAS f32x4*)g + F.lane;
    f32x4 gv[4];
#pragma unroll
    for (int j = 0; j < 4; ++j) gv[j] = gp[64 * j];
    for (int m = F.gw; m < M; m += F.NGW) {
        const GAS f32x4* xr = (const GAS f32x4*)(x + (size_t)m * DM) + F.lane;
        f32x4 v[4]; float s = 0.f;
#pragma unroll
        for (int j = 0; j < 4; ++j) { v[j] = xr[64 * j]; s += (v[j].x * v[j].x + v[j].y * v[j].y) + (v[j].z * v[j].z + v[j].w * v[j].w); }
        s = wave_sum(s);
        GAS unsigned long long* o8 = (GAS unsigned long long*)(o + (size_t)m * DM) + F.lane;
#pragma unroll
        for (int j = 0; j < 4; ++j) o8[64 * j] = (unsigned long long)pk2(v[j].x * gv[j].x, v[j].y * gv[j].y) | ((unsigned long long)pk2(v[j].z * gv[j].z, v[j].w * gv[j].w) << 32);
        if (F.lane < 16) SS[(size_t)m * 16 + F.lane] = (F.lane == 0) ? s : 0.f;
    }
}

__device__ __forceinline__ void post_phase(const Ctx& F, const float* g_fq, const float* g_fk, const float* g_dq, const float* g_dk, const float* b_f, bool dummy_out = false) {
    bf16* Z = (bf16*)(F.ws + WS_Z); const float* ZS = (const float*)(F.ws + WS_ZS);
    const f32x2* R64 = (const f32x2*)(F.ws + WS_ROPE64); const f32x2* R32 = (const f32x2*)(F.ws + WS_ROPE32);
    float* LF = (float*)(F.ws + WS_LF); unsigned* ISG = (unsigned*)(F.ws + WS_ISG);
    bf16* KD = (bf16*)(F.ws + WS_KD); bf16* VD = (bf16*)(F.ws + WS_VD); bf16* IQB = (bf16*)(F.ws + WS_IQB); bf16* IKB = (bf16*)(F.ws + WS_IKB);
    const int t0 = blockIdx.x * 512 + F.tid, NT = F.G * 512;
#pragma unroll 1
    for (int seg = 0; seg < 3; ++seg) {
        const int col = (seg == 0) ? Z_FQ : (seg == 1) ? Z_FK : Z_DQ; const float* gp = (seg == 0) ? g_fq : (seg == 1) ? g_fk : g_dq; const float osc = (seg == 1) ? 1.0f : C2;
        for (int t = t0; t < M * 8; t += NT) { const int m = t >> 3, h = t & 7; bf16* p = Z + (size_t)m * ZP + col + h * 64;
            v4u w[8];
#pragma unroll
            for (int i = 0; i < 8; ++i) w[i] = *(const GAS v4u*)(p + 8 * i);
            float f[64]; float ss = 0.f;
#pragma unroll
            for (int i = 0; i < 8; ++i) { float t8[8]; unpack8(w[i], t8);
#pragma unroll
                for (int j = 0; j < 8; ++j) { f[8 * i + j] = t8[j]; ss += t8[j] * t8[j]; } }
            const float rs = osc / sqrtf(ss * (1.f / 64) + NORM_EPS);
#pragma unroll
            for (int d = 0; d < 64; ++d) f[d] = f[d] * rs * gp[d];
            if (seg == 2) { const f32x2* cs = R64 + (m & (SEQ - 1)) * 32;
#pragma unroll
                for (int d = 0; d < 32; ++d) { const f32x2 tt = cs[d]; const float x1 = f[d], x2 = f[d + 32]; f[d] = x1 * tt.x - x2 * tt.y; f[d + 32] = x2 * tt.x + x1 * tt.y; } }
#pragma unroll
            for (int i = 0; i < 8; ++i) { float t8[8];
#pragma unroll
                for (int j = 0; j < 8; ++j) t8[j] = f[8 * i + j];
                *(GAS v4u*)((dummy_out ? (bf16*)(F.ws + WS_HDN + 16 * MiB) + (size_t)m * 512 + h * 64 : p) + 8 * i) = pack8(t8); }
        }
    }
    for (int t = t0; t < M * 8; t += NT) { const int m = t >> 3, h = t & 7; const float* sp = ZS + (size_t)m * ZSP + S_IQ + h * 32;
        f32x4 v[8];
#pragma unroll
        for (int i = 0; i < 8; ++i) v[i] = *(const GAS f32x4*)(sp + 4 * i);
        const float aw = fabsf(ZS[(size_t)m * ZSP + S_IW + h]);
        const f32x2* cs = R32 + (m & (SEQ - 1)) * 16; float f[32];
#pragma unroll
        for (int i = 0; i < 8; ++i) { f[4 * i] = v[i].x; f[4 * i + 1] = v[i].y; f[4 * i + 2] = v[i].z; f[4 * i + 3] = v[i].w; }
#pragma unroll
        for (int d = 0; d < 16; ++d) { const f32x2 tt = cs[d]; const float x1 = f[d], x2 = f[d + 16]; f[d] = (x1 * tt.x - x2 * tt.y) * aw; f[d + 16] = (x2 * tt.x + x1 * tt.y) * aw; }
        bf16* op = IQB + (size_t)m * 256 + h * 32;
#pragma unroll
        for (int i = 0; i < 4; ++i) { float t8[8];
#pragma unroll
            for (int j = 0; j < 8; ++j) t8[j] = f[8 * i + j];
            *(GAS v4u*)(op + 8 * i) = pack8(t8); }
    }
    for (int m = t0; m < M; m += NT) { const float* sr = ZS + (size_t)m * ZSP; const int pos = m & (SEQ - 1);
        { float f[64]; float ss = 0.f;
#pragma unroll
            for (int i = 0; i < 16; ++i) { const f32x4 v = *(const GAS f32x4*)(sr + S_DK + 4 * i); f[4 * i] = v.x; f[4 * i + 1] = v.y; f[4 * i + 2] = v.z; f[4 * i + 3] = v.w; ss += (v.x * v.x + v.y * v.y) + (v.z * v.z + v.w * v.w); }
            const float rs = 1.0f / sqrtf(ss * (1.f / 64) + NORM_EPS); const f32x2* cs = R64 + pos * 32;
#pragma unroll
            for (int d = 0; d < 64; ++d) f[d] = f[d] * rs * g_dk[d];
#pragma unroll
            for (int d = 0; d < 32; ++d) { const f32x2 tt = cs[d]; const float x1 = f[d], x2 = f[d + 32]; f[d] = x1 * tt.x - x2 * tt.y; f[d + 32] = x2 * tt.x + x1 * tt.y; }
#pragma unroll
            for (int i = 0; i < 8; ++i) { float t8[8];
#pragma unroll
                for (int j = 0; j < 8; ++j) t8[j] = f[8 * i + j];
                *(GAS v4u*)(KD + (size_t)m * 64 + 8 * i) = pack8(t8); } }
#pragma unroll
        for (int i = 0; i < 8; ++i) { const f32x4 a = *(const GAS f32x4*)(sr + S_DV + 8 * i), b = *(const GAS f32x4*)(sr + S_DV + 8 * i + 4); const float t8[8] = {a.x, a.y, a.z, a.w, b.x, b.y, b.z, b.w};
            *(GAS v4u*)(VD + (size_t)m * 64 + 8 * i) = pack8(t8); }
        { float f[32]; const f32x2* cs = R32 + pos * 16;
#pragma unroll
            for (int i = 0; i < 8; ++i) { const f32x4 v = *(const GAS f32x4*)(sr + S_IK + 4 * i); f[4 * i] = v.x; f[4 * i + 1] = v.y; f[4 * i + 2] = v.z; f[4 * i + 3] = v.w; }
#pragma unroll
            for (int d = 0; d < 16; ++d) { const f32x2 tt = cs[d]; const float x1 = f[d], x2 = f[d + 16]; f[d] = x1 * tt.x - x2 * tt.y; f[d + 16] = x2 * tt.x + x1 * tt.y; }
#pragma unroll
            for (int i = 0; i < 4; ++i) { float t8[8];
#pragma unroll
                for (int j = 0; j < 8; ++j) t8[j] = f[8 * i + j];
                *(GAS v4u*)(IKB + (size_t)m * 32 + 8 * i) = pack8(t8); } }
        { const f32x4 w0 = *(const GAS f32x4*)(sr + S_IW), w1 = *(const GAS f32x4*)(sr + S_IW + 4); const float iw[8] = {w0.x, w0.y, w0.z, w0.w, w1.x, w1.y, w1.z, w1.w}; unsigned sg = 0;
#pragma unroll
            for (int h = 0; h < 8; ++h) sg |= (iw[h] < 0.f ? 1u : 0u) << h;
            ISG[m] = sg;
            const f32x4 f0 = *(const GAS f32x4*)(sr + S_FF), f1 = *(const GAS f32x4*)(sr + S_FF + 4); const float ff[8] = {f0.x, f0.y, f0.z, f0.w, f1.x, f1.y, f1.z, f1.w}; float lf[8];
#pragma unroll
            for (int h = 0; h < 8; ++h) { const float xx = ff[h] + b_f[h]; lf[h] = (fminf(xx, 0.f) - __logf(1.0f + __expf(-fabsf(xx)))) * LOG2E; }
            *(GAS f32x4*)(LF + (size_t)m * 8) = (f32x4){lf[0], lf[1], lf[2], lf[3]}; *(GAS f32x4*)(LF + (size_t)m * 8 + 4) = (f32x4){lf[4], lf[5], lf[6], lf[7]}; }
    }
}

__device__ __forceinline__ float ret_l2g(int h) { return h == 0 ? -0.04580368961312479f : h == 1 ? -0.02272007650008353f : h == 2 ? -0.011315313227834146f : -0.005646563141142063f; }

__device__ __forceinline__ void scan_state_phase(const Ctx& F) {
    const float* LF = (const float*)(F.ws + WS_LF); float* CF = (float*)(F.ws + WS_CF);
    const bf16* Z = (const bf16*)(F.ws + WS_Z); float* RS = (float*)(F.ws + WS_HDN);
    if (F.gw < 32) {
        const int b = F.gw >> 3, h = F.gw & 7; const float* lp = LF + ((size_t)b * SEQ + F.lane * 64) * 8 + h; float s = 0.f;
        for (int i = 0; i < 64; ++i) s += lp[i * 8];
        float incl = s;
#pragma unroll
        for (int o = 1; o < 64; o <<= 1) { const float t = __builtin_bit_cast(float, __builtin_amdgcn_ds_bpermute(((F.lane - o) & 63) << 2, __builtin_bit_cast(int, incl))); if (F.lane >= o) incl += t; }
        float run = incl - s; float* cp = CF + (size_t)F.gw * SEQ + F.lane * 64;
        for (int i = 0; i < 64; ++i) { run += lp[i * 8]; cp[i] = run; }
    }
    for (int u = blockIdx.x; u < NB * 32 * 4; u += F.G) {
        const int h = u & 3, c = (u >> 2) & 31, b = u >> 7; const float l2g = ret_l2g(h);
        const int d = F.tid >> 3, e0 = (F.tid & 7) * 16; float acc[16];
#pragma unroll
        for (int i = 0; i < 16; ++i) acc[i] = 0.f;
        const bf16* base = Z + ((size_t)b * SEQ + c * 128) * ZP;
        for (int j = 0; j < 128; ++j) { const bf16* row = base + (size_t)j * ZP;
            const float kd = bf2f(row[Z_RK + h * 64 + d]) * exp2f((float)(127 - j) * l2g);
            const v4u w0 = *(const GAS v4u*)(row + Z_RV + h * 128 + e0), w1 = *(const GAS v4u*)(row + Z_RV + h * 128 + e0 + 8);
            float v0[8], v1[8]; unpack8(w0, v0); unpack8(w1, v1);
#pragma unroll
            for (int i = 0; i < 8; ++i) { acc[i] += kd * v0[i]; acc[8 + i] += kd * v1[i]; } }
        float* o = RS + (size_t)u * 8192 + d * 128 + e0;
#pragma unroll
        for (int i = 0; i < 4; ++i) *(GAS f32x4*)(o + 4 * i) = (f32x4){acc[4 * i], acc[4 * i + 1], acc[4 * i + 2], acc[4 * i + 3]};
    }
}

__device__ __forceinline__ void ret_out_naive(const Ctx& F, const float* gn) {
    bf16* Z = (bf16*)(F.ws + WS_Z); const float* RS = (const float*)(F.ws + WS_HDN);
    LAS float* S = (LAS float*)(F.lds);
    LAS bf16* Vt = (LAS bf16*)(F.lds + 32768);
    LAS float* Kt = (LAS float*)(F.lds + 65536);
    LAS float* aw = (LAS float*)(F.lds + 65536 + 33280) + F.wave * 128;
    LAS float* qw = (LAS float*)(F.lds + 65536 + 33280 + 4096) + F.wave * 64;
    for (int u = blockIdx.x; u < NB * 32 * 4; u += F.G) {
        const int h = u & 3, c = (u >> 2) & 31, b = u >> 7; const float l2g = ret_l2g(h); const float wch = exp2f(128.f * l2g);
        __syncthreads();
        { float s[16];
#pragma unroll
            for (int i = 0; i < 16; ++i) s[i] = 0.f;
            for (int cp = 0; cp < c; ++cp) { const float* L = RS + ((size_t)((b * 32 + cp) * 4 + h)) * 8192 + F.tid;
#pragma unroll
                for (int i = 0; i < 16; ++i) s[i] = wch * s[i] + L[i * 512]; }
#pragma unroll
            for (int i = 0; i < 16; ++i) S[F.tid + i * 512] = s[i]; }
        const bf16* base = Z + ((size_t)b * SEQ + c * 128) * ZP;
        for (int q = F.tid; q < 2048; q += 512) { const int r = q >> 4, ch = q & 15; *(LAS v4u*)(Vt + r * 128 + ch * 8) = *(const GAS v4u*)(base + (size_t)r * ZP + Z_RV + h * 128 + ch * 8); }
        for (int q = F.tid; q < 128 * 64; q += 512) { const int r = q >> 6, dd = q & 63; Kt[r * 65 + dd] = bf2f(base[(size_t)r * ZP + Z_RK + h * 64 + dd]); }
        __syncthreads();
        for (int i = F.wave; i < 128; i += NWAVES) {
            const size_t m = (size_t)b * SEQ + c * 128 + i; bf16* zr = Z + m * ZP;
            qw[F.lane] = bf2f(zr[Z_RQ + h * 64 + F.lane]);
            LDS_WAIT(); asm volatile("" ::: "memory");
#pragma unroll
            for (int jj = 0; jj < 2; ++jj) { const int j = F.lane + 64 * jj; float a = 0.f;
                if (j <= i) { float dot = 0.f; for (int dd = 0; dd < 64; ++dd) dot += qw[dd] * Kt[j * 65 + dd]; a = dot * exp2f((float)(i - j) * l2g); }
                aw[j] = a; }
            LDS_WAIT(); asm volatile("" ::: "memory");
            float o[2]; const float dq = exp2f((float)(i + 1) * l2g);
#pragma unroll
            for (int ee = 0; ee < 2; ++ee) { const int e = F.lane + 64 * ee; float acc = 0.f;
                for (int j = 0; j <= i; ++j) acc += aw[j] * bf2f(Vt[j * 128 + e]);
                float cr = 0.f; for (int dd = 0; dd < 64; ++dd) cr += qw[dd] * S[dd * 128 + e];
                o[ee] = acc + cr * dq; }
            const float ss = wave_sum(o[0] * o[0] + o[1] * o[1]); const float rstd = 1.0f / sqrtf(ss * (1.f / 128) + NORM_EPS);
#pragma unroll
            for (int ee = 0; ee < 2; ++ee) { const int e = F.lane + 64 * ee; const float rg = bf2f(zr[Z_RG + h * 128 + e]);
                zr[Z_RV + h * 128 + e] = (bf16)f2bf(o[ee] * rstd * gn[h * 128 + e] * rg * sigmoid_f(rg)); }
            LDS_WAIT(); asm volatile("" ::: "memory");
        }
    }
    __syncthreads();
}

__device__ __forceinline__ void fox_naive(const Ctx& F) {
    bf16* Z = (bf16*)(F.ws + WS_Z); const float* CF = (const float*)(F.ws + WS_CF);
    LAS float* sc = (LAS float*)(F.lds + F.wave * 16384);
    const int lane = F.lane;
    int it = 0;
    for (int r0 = 0; r0 < NB * 8 * SEQ; r0 += F.NGW, ++it) {
        const int r = r0 + ((it & 1) ? (F.NGW - 1 - F.gw) : F.gw);
        if (r >= NB * 8 * SEQ) continue;
        const int pos = r & (SEQ - 1), h = (r >> 12) & 7, b = r >> 15;
        const size_t m = (size_t)b * SEQ + pos;
        float qf[64];
        { const bf16* qp = Z + m * ZP + Z_FQ + h * 64;
#pragma unroll
            for (int i = 0; i < 8; ++i) { const v4u w = *(const GAS v4u*)(qp + 8 * i); float t[8]; unpack8(w, t);
#pragma unroll
                for (int j = 0; j < 8; ++j) qf[8 * i + j] = t[j]; } }
        const float* cf = CF + (size_t)(b * 8 + h) * SEQ;
        float mx = -INFINITY;
        for (int kk = lane; kk <= pos; kk += 64) { const bf16* kp = Z + ((size_t)b * SEQ + kk) * ZP + Z_FK + h * 64; float dot = 0.f;
#pragma unroll
            for (int i = 0; i < 8; ++i) { const v4u w = *(const GAS v4u*)(kp + 8 * i); float t[8]; unpack8(w, t);
#pragma unroll
                for (int j = 0; j < 8; ++j) dot += qf[8 * i + j] * t[j]; }
            const float s = dot - cf[kk]; sc[kk] = s; mx = fmaxf(mx, s); }
        mx = wave_max(mx);
        float sum = 0.f;
        for (int kk = lane; kk <= pos; kk += 64) { const float p = exp2f(sc[kk] - mx); sc[kk] = p; sum += p; }
        sum = wave_sum(sum);
        LDS_WAIT(); asm volatile("" ::: "memory");
        const bf16* vp = Z + (size_t)b * SEQ * ZP + Z_FV + h * 64 + lane;
        float o0 = 0.f, o1 = 0.f, o2 = 0.f, o3 = 0.f; int kk = 0;
        for (; kk + 3 <= pos; kk += 4) { o0 += sc[kk] * bf2f(vp[(size_t)kk * ZP]); o1 += sc[kk + 1] * bf2f(vp[(size_t)(kk + 1) * ZP]); o2 += sc[kk + 2] * bf2f(vp[(size_t)(kk + 2) * ZP]); o3 += sc[kk + 3] * bf2f(vp[(size_t)(kk + 3) * ZP]); }
        for (; kk <= pos; ++kk) o0 += sc[kk] * bf2f(vp[(size_t)kk * ZP]);
        Z[m * ZP + Z_FQ + h * 64 + lane] = (bf16)f2bf(((o0 + o1) + (o2 + o3)) / sum);
        LDS_WAIT(); asm volatile("" ::: "memory");
    }
}

__device__ __forceinline__ unsigned f2key(float s) { const unsigned u = __builtin_bit_cast(unsigned, s + 0.0f); return (u & 0x80000000u) ? ~u : (u | 0x80000000u); }
__device__ __forceinline__ void dsa_naive(const Ctx& F) {
    bf16* Z = (bf16*)(F.ws + WS_Z); const float* ZS = (const float*)(F.ws + WS_ZS);
    const unsigned* ISG = (const unsigned*)(F.ws + WS_ISG);
    const bf16* KD = (const bf16*)(F.ws + WS_KD); const bf16* VD = (const bf16*)(F.ws + WS_VD);
    LAS unsigned* kl = (LAS unsigned*)(F.lds + F.wave * 16384);
    LAS float* iqs = (LAS float*)(F.lds + XTRA_OFF + F.wave * 1536);
    const int lane = F.lane;
    int it = 0;
    for (int r0 = 0; r0 < M; r0 += F.NGW, ++it) {
        const int r = r0 + ((it & 1) ? (F.NGW - 1 - F.gw) : F.gw);
        if (r >= M) continue;
        const int pos = r & (SEQ - 1), b = r >> 12; const size_t m = (size_t)r;
        *(LAS f32x4*)(iqs + 4 * lane) = *(const GAS f32x4*)(ZS + m * ZSP + S_IQ + 4 * lane);
        const unsigned sg = ISG[m];
        LDS_WAIT(); asm volatile("" ::: "memory");
        for (int kk = lane; kk <= pos; kk += 64) { const float* ikp = ZS + ((size_t)b * SEQ + kk) * ZSP + S_IK; float ik[32];
#pragma unroll
            for (int i = 0; i < 8; ++i) { const f32x4 t = *(const GAS f32x4*)(ikp + 4 * i); ik[4 * i] = t.x; ik[4 * i + 1] = t.y; ik[4 * i + 2] = t.z; ik[4 * i + 3] = t.w; }
            float s = 0.f;
#pragma unroll 1
            for (int h = 0; h < 8; ++h) { float dot = 0.f;
#pragma unroll
                for (int dd = 0; dd < 32; ++dd) dot += iqs[h * 32 + dd] * ik[dd];
                dot = fmaxf(dot, 0.f); s += ((sg >> h) & 1u) ? -dot : dot; }
            kl[kk] = f2key(s); }
        LDS_WAIT(); asm volatile("" ::: "memory");
        unsigned key[64];
#pragma unroll
        for (int j = 0; j < 64; ++j) { const int kk = j * 64 + lane; key[j] = (kk <= pos) ? kl[kk] : 0u; }
        LDS_WAIT(); asm volatile("" ::: "memory");
        LAS unsigned* idx = kl; LAS float* pl = (LAS float*)(kl + 256); LAS bf16* qs = (LAS bf16*)(kl + 512);
        *(LAS v4u*)(qs + 8 * lane) = *(const GAS v4u*)(Z + m * ZP + Z_DQ + 8 * lane);
        unsigned T = 0u; int need = 0;
        if (pos + 1 > 256) {
            for (int bit = 31; bit >= 0; --bit) { const unsigned Tt = T | (1u << bit); int cnt = 0;
#pragma unroll
                for (int j = 0; j < 64; ++j) cnt += __builtin_popcountll(__ballot(key[j] >= Tt));
                if (cnt >= 256) T = Tt; }
            int ngt = 0;
#pragma unroll
            for (int j = 0; j < 64; ++j) ngt += __builtin_popcountll(__ballot(key[j] > T));
            need = 256 - ngt;
        }
        int nsel = 0, eqb = 0;
#pragma unroll
        for (int j = 0; j < 64; ++j) { const bool gt = key[j] > T, eq = (key[j] == T) && (T != 0u);
            const unsigned long long em = __ballot(eq); const int er = eqb + __builtin_amdgcn_mbcnt_hi((unsigned)(em >> 32), __builtin_amdgcn_mbcnt_lo((unsigned)em, 0u));
            const bool sel = gt || (eq && er < need); eqb += __builtin_popcountll(em);
            const unsigned long long sm = __ballot(sel); const int sp = nsel + __builtin_amdgcn_mbcnt_hi((unsigned)(sm >> 32), __builtin_amdgcn_mbcnt_lo((unsigned)sm, 0u));
            if (sel) idx[sp] = (unsigned)(j * 64 + lane); nsel += __builtin_popcountll(sm); }
        LDS_WAIT(); asm volatile("" ::: "memory");
        for (int h = 0; h < 8; ++h) {
            float sv[4]; float mx = -INFINITY;
#pragma unroll
            for (int i = 0; i < 4; ++i) { const int e = lane + 64 * i; sv[i] = -INFINITY;
                if (e < nsel) { const bf16* kp = KD + ((size_t)b * SEQ + idx[e]) * 64; float dot = 0.f;
#pragma unroll
                    for (int c = 0; c < 8; ++c) { const v4u w = *(const GAS v4u*)(kp + 8 * c); float t[8]; unpack8(w, t); const v4u qw = *(const LAS v4u*)(qs + h * 64 + 8 * c); float qq[8]; unpack8(qw, qq);
#pragma unroll
                        for (int j = 0; j < 8; ++j) dot += qq[j] * t[j]; }
                    sv[i] = dot; }
                mx = fmaxf(mx, sv[i]); }
            mx = wave_max(mx); float sum = 0.f;
#pragma unroll
            for (int i = 0; i < 4; ++i) { const int e = lane + 64 * i; const float p = (e < nsel) ? exp2f(sv[i] - mx) : 0.f; pl[e] = p; sum += p; }
            sum = wave_sum(sum);
            LDS_WAIT(); asm volatile("" ::: "memory");
            float o0 = 0.f, o1 = 0.f; int e = 0;
            for (; e + 1 < nsel; e += 2) { o0 += pl[e] * bf2f(VD[((size_t)b * SEQ + idx[e]) * 64 + lane]); o1 += pl[e + 1] * bf2f(VD[((size_t)b * SEQ + idx[e + 1]) * 64 + lane]); }
            if (e < nsel) o0 += pl[e] * bf2f(VD[((size_t)b * SEQ + idx[e]) * 64 + lane]);
            Z[m * ZP + Z_DQ + h * 64 + lane] = (bf16)f2bf((o0 + o1) / sum);
            LDS_WAIT(); asm volatile("" ::: "memory");
        }
    }
}
#ifndef PROBE_D
#define PROBE_D 0
#endif

typedef short s16x8 __attribute__((ext_vector_type(8)));
typedef short s16x4 __attribute__((ext_vector_type(4)));
typedef short v4i16_t __attribute__((ext_vector_type(4)));
__device__ __forceinline__ s16x4 tr16(const LAS unsigned char* p) { return __builtin_bit_cast(s16x4, __builtin_amdgcn_ds_read_tr16_b64_v4i16((LAS v4i16_t*)p)); }
__device__ __forceinline__ float key2f(unsigned k) { return __builtin_bit_cast(float, (k & 0x80000000u) ? (k & 0x7fffffffu) : ~k); }

template <int NR> __device__ __forceinline__ int dsa_count_ge(const unsigned (&key)[64], unsigned T) {
    int c = 0;
#pragma unroll
    for (int j = 0; j < NR; ++j) c += __builtin_popcountll(__ballot(key[j] >= T));
    return c;
}
#define DSA_COUNT_GE(T_, out_) do { if (nq == 1) out_ = dsa_count_ge<16>(key, (T_)); else if (nq == 2) out_ = dsa_count_ge<32>(key, (T_)); else if (nq == 3) out_ = dsa_count_ge<48>(key, (T_)); else out_ = dsa_count_ge<64>(key, (T_)); } while (0)
__device__ __forceinline__ void dsa_select(const unsigned (&key)[64], int nvalid, unsigned& T, int& need) {
    const int nq = __builtin_amdgcn_readfirstlane((nvalid + 1023) >> 10);
    T = 0u; need = 0;
    if (nvalid <= 256) return;
    unsigned kmax = 0u;
#pragma unroll
    for (int j = 0; j < 64; ++j) kmax = key[j] > kmax ? key[j] : kmax;
#pragma unroll
    for (int o_ = 0; o_ < 1; ++o_) { unsigned t; t = sxu<1>(kmax); kmax = t > kmax ? t : kmax; t = sxu<2>(kmax); kmax = t > kmax ? t : kmax; t = sxu<4>(kmax); kmax = t > kmax ? t : kmax; t = sxu<8>(kmax); kmax = t > kmax ? t : kmax; t = sxu<16>(kmax); kmax = t > kmax ? t : kmax;
        unsigned a_, b_; swap32(kmax, a_, b_); kmax = a_ > b_ ? a_ : b_; }
    unsigned lo = 1u, hi = kmax + 1u; int hic = 0;
    { const float vm = fabsf(key2f(kmax)) + 1.0f; unsigned l2 = f2key(-vm * 64.0f); int c; DSA_COUNT_GE(l2, c); if (c >= 256) lo = l2; }
    int iter = 0; bool exact = false;
    while (hi - lo > 1u) {
        unsigned mid;
        if (iter < 24 && lo > 1u) { const float mv = 0.5f * key2f(lo) + 0.5f * key2f(hi - 1u); mid = f2key(mv); }
        else mid = lo + ((hi - lo) >> 1);
        if (mid <= lo) mid = lo + 1u; if (mid >= hi) mid = hi - 1u;
        int c; DSA_COUNT_GE(mid, c);
        if (c == 256) { T = mid; exact = true; break; }
        if (c > 256) lo = mid; else { hi = mid; hic = c; }
        ++iter;
    }
    if (exact) need = 256; else { T = lo; need = 256 - hic; }
}

__device__ __forceinline__ void dsa_attend(const bf16* zq, bf16* zo, const bf16* KDb, const bf16* VDb, const LAS unsigned short* idx, int nsel, LAS unsigned char* vst, int lane) {
    const int g = lane >> 4, c = lane & 15;
    s16x8 qf[2];
#pragma unroll
    for (int ks = 0; ks < 2; ++ks) { qf[ks] = (s16x8){0, 0, 0, 0, 0, 0, 0, 0}; if (c < 8) qf[ks] = *(const GAS s16x8*)(zq + c * 64 + 32 * ks + 8 * g); }
    f32x4 acc[16];
    v4u vreg[16];
#pragma unroll
    for (int i = 0; i < 16; ++i) { const int pi = lane + 64 * i, r = pi >> 3, c16 = pi & 7; const int id = (r < nsel) ? (int)idx[r] : 0; vreg[i] = *(const GAS v4u*)(VDb + (size_t)id * 64 + c16 * 8); }
#pragma unroll
    for (int tb = 0; tb < 2; ++tb) {
        s16x8 kf[8][2];
#pragma unroll
        for (int tt = 0; tt < 8; ++tt) { const int e = 16 * (8 * tb + tt) + c; const int id = (e < nsel) ? (int)idx[e] : 0; const bf16* kp = KDb + (size_t)id * 64 + 8 * g;
            kf[tt][0] = *(const GAS s16x8*)kp; kf[tt][1] = *(const GAS s16x8*)(kp + 32); }
#pragma unroll
        for (int tt = 0; tt < 8; ++tt) { f32x4 a = (f32x4){0.f, 0.f, 0.f, 0.f};
            a = __builtin_amdgcn_mfma_f32_16x16x32_bf16(kf[tt][0], qf[0], a, 0, 0, 0); a = __builtin_amdgcn_mfma_f32_16x16x32_bf16(kf[tt][1], qf[1], a, 0, 0, 0); acc[8 * tb + tt] = a; }
    }
    float mx = -INFINITY;
#pragma unroll
    for (int t = 0; t < 16; ++t)
#pragma unroll
        for (int i = 0; i < 4; ++i) { const int e = 16 * t + 4 * g + i; if (e >= nsel) acc[t][i] = -INFINITY; mx = fmaxf(mx, acc[t][i]); }
    mx = fmaxf(mx, sx<16>(mx)); mx = half_max(mx);
    float sum = 0.f;
#pragma unroll
    for (int t = 0; t < 16; ++t)
#pragma unroll
        for (int i = 0; i < 4; ++i) { const float p = __builtin_amdgcn_exp2f(acc[t][i] - mx); acc[t][i] = p; sum += p; }
    sum += sx<16>(sum); sum = half_sum(sum);
    const float inv = 1.0f / sum;
    s16x8 pf[8];
#pragma unroll
    for (int s = 0; s < 8; ++s) { v4u w; w.x = pk2(acc[2 * s][0] * inv, acc[2 * s][1] * inv); w.y = pk2(acc[2 * s][2] * inv, acc[2 * s][3] * inv); w.z = pk2(acc[2 * s + 1][0] * inv, acc[2 * s + 1][1] * inv); w.w = pk2(acc[2 * s + 1][2] * inv, acc[2 * s + 1][3] * inv);
        pf[s] = __builtin_bit_cast(s16x8, w); }
    f32x4 o[4];
#pragma unroll
    for (int db = 0; db < 4; ++db) o[db] = (f32x4){0.f, 0.f, 0.f, 0.f};
    const int q = (lane >> 2) & 3, p = lane & 3, swz = 2 * (g & 1) + (q >> 1);
    const LAS unsigned char* rb = vst + (4 * g + q) * 128 + 8 * p;
#pragma unroll
    for (int hh = 0; hh < 2; ++hh) {
        asm volatile("s_waitcnt lgkmcnt(0)" ::: "memory");
#pragma unroll
        for (int i = 0; i < 16; ++i) { const int pi = lane + 64 * i, r = pi >> 3, c16 = pi & 7;
            *(LAS v4u*)(vst + r * 128 + ((((c16 >> 1) ^ ((r >> 1) & 3))) << 5) + ((c16 & 1) << 4)) = vreg[i]; }
        if (hh == 0) {
#pragma unroll
            for (int i = 0; i < 16; ++i) { const int pi = lane + 64 * i, r = pi >> 3, c16 = pi & 7, e = 128 + r; const int id = (e < nsel) ? (int)idx[e] : 0; vreg[i] = *(const GAS v4u*)(VDb + (size_t)id * 64 + c16 * 8); } }
        asm volatile("s_waitcnt lgkmcnt(0)" ::: "memory");
#pragma unroll
        for (int s4 = 0; s4 < 4; ++s4)
#pragma unroll
            for (int db = 0; db < 4; ++db) { const LAS unsigned char* a1 = rb + s4 * 4096 + ((db ^ swz) << 5);
                const s16x4 lo = tr16(a1), hi = tr16(a1 + 2048);
                const s16x8 vf = (s16x8){lo[0], lo[1], lo[2], lo[3], hi[0], hi[1], hi[2], hi[3]};
                o[db] = __builtin_amdgcn_mfma_f32_16x16x32_bf16(pf[4 * hh + s4], vf, o[db], 0, 0, 0); }
    }
    if (g < 2) {
#pragma unroll
        for (int db = 0; db < 4; ++db)
#pragma unroll
            for (int i = 0; i < 4; ++i) zo[(4 * g + i) * 64 + 16 * db + c] = (bf16)f2bf(o[db][i]);
    }
}

__device__ __forceinline__ void dsa_v2(const Ctx& F) {
    bf16* Z = (bf16*)(F.ws + WS_Z); const float* ZS = (const float*)(F.ws + WS_ZS);
    const unsigned* ISG = (const unsigned*)(F.ws + WS_ISG);
    const bf16* KD = (const bf16*)(F.ws + WS_KD); const bf16* VD = (const bf16*)(F.ws + WS_VD);
    LAS unsigned* kl = (LAS unsigned*)(F.lds + F.wave * 16384);
    LAS float* iqs = (LAS float*)(F.lds + XTRA_OFF + F.wave * 1536);
    LAS unsigned short* idx = (LAS unsigned short*)(F.lds + XTRA_OFF + F.wave * 1536 + 1024);
    const int lane = F.lane;
    int it = 0;
    for (int r0 = 0; r0 < M; r0 += F.NGW, ++it) {
        const int r = r0 + ((it & 1) ? (F.NGW - 1 - F.gw) : F.gw);
        if (r >= M) continue;
        const int pos = r & (SEQ - 1), b = r >> 12; const size_t m = (size_t)r;
        *(LAS f32x4*)(iqs + 4 * lane) = *(const GAS f32x4*)(ZS + m * ZSP + S_IQ + 4 * lane);
        const unsigned sg = ISG[m];
        LDS_WAIT(); asm volatile("" ::: "memory");
        for (int kk = lane; kk <= pos; kk += 64) { const float* ikp = ZS + ((size_t)b * SEQ + kk) * ZSP + S_IK; float ik[32];
#pragma unroll
            for (int i = 0; i < 8; ++i) { const f32x4 t = *(const GAS f32x4*)(ikp + 4 * i); ik[4 * i] = t.x; ik[4 * i + 1] = t.y; ik[4 * i + 2] = t.z; ik[4 * i + 3] = t.w; }
            float s = 0.f;
#pragma unroll 1
            for (int h = 0; h < 8; ++h) { float dot = 0.f;
#pragma unroll
                for (int dd = 0; dd < 32; ++dd) dot += iqs[h * 32 + dd] * ik[dd];
                dot = fmaxf(dot, 0.f); s += ((sg >> h) & 1u) ? -dot : dot; }
            kl[kk] = f2key(s); }
        LDS_WAIT(); asm volatile("" ::: "memory");
        unsigned key[64];
#pragma unroll
        for (int j = 0; j < 64; ++j) { const int kk = j * 64 + lane; key[j] = (kk <= pos) ? kl[kk] : 0u; }
        LDS_WAIT(); asm volatile("" ::: "memory");
        unsigned T; int need;
#ifdef DSA_OLDSEL
        T = 0u; need = 0;
        if (pos + 1 > 256) {
            for (int bit = 31; bit >= 0; --bit) { const unsigned Tt = T | (1u << bit); int cnt = 0;
#pragma unroll
                for (int j = 0; j < 64; ++j) cnt += __builtin_popcountll(__ballot(key[j] >= Tt));
                if (cnt >= 256) T = Tt; }
            int ngt = 0;
#pragma unroll
            for (int j = 0; j < 64; ++j) ngt += __builtin_popcountll(__ballot(key[j] > T));
            need = 256 - ngt;
        }
#else
        dsa_select(key, pos + 1, T, need);
#endif
        int nsel = 0, eqb = 0;
#pragma unroll
        for (int j = 0; j < 64; ++j) { const bool gt = key[j] > T, eq = (key[j] == T) && (T != 0u);
            const unsigned long long em = __ballot(eq); const int er = eqb + __builtin_amdgcn_mbcnt_hi((unsigned)(em >> 32), __builtin_amdgcn_mbcnt_lo((unsigned)em, 0u));
            const bool sel = gt || (eq && er < need); eqb += __builtin_popcountll(em);
            const unsigned long long sm = __ballot(sel); const int sp = nsel + __builtin_amdgcn_mbcnt_hi((unsigned)(sm >> 32), __builtin_amdgcn_mbcnt_lo((unsigned)sm, 0u));
            if (sel) idx[sp] = (unsigned short)(j * 64 + lane); nsel += __builtin_popcountll(sm); }
        LDS_WAIT(); asm volatile("" ::: "memory");
        dsa_attend(Z + m * ZP + Z_DQ, Z + m * ZP + Z_DQ, KD + (size_t)b * SEQ * 64, VD + (size_t)b * SEQ * 64, idx, nsel, (LAS unsigned char*)kl, lane);
        LDS_WAIT(); asm volatile("" ::: "memory");
    }
}

template <int NR> __device__ __forceinline__ int dsa_emit_n(const unsigned (&key)[64], unsigned T, int need, LAS unsigned short* idx, int lane) {
    int nsel = 0, eqb = 0;
#pragma unroll
    for (int j = 0; j < NR; ++j) { const bool gt = key[j] > T, eq = (key[j] == T) && (T != 0u);
        const unsigned long long em = __ballot(eq); const int er = eqb + __builtin_amdgcn_mbcnt_hi((unsigned)(em >> 32), __builtin_amdgcn_mbcnt_lo((unsigned)em, 0u));
        const bool sel = gt || (eq && er < need); eqb += __builtin_popcountll(em);
        const unsigned long long sm = __ballot(sel); const int sp = nsel + __builtin_amdgcn_mbcnt_hi((unsigned)(sm >> 32), __builtin_amdgcn_mbcnt_lo((unsigned)sm, 0u));
        if (sel) idx[sp] = (unsigned short)(j * 64 + lane); nsel += __builtin_popcountll(sm); }
    return nsel;
}
__device__ __forceinline__ int dsa_emit(const unsigned (&key)[64], int nvalid, unsigned T, int need, LAS unsigned short* idx, int lane) {
    const int nq = __builtin_amdgcn_readfirstlane((nvalid + 1023) >> 10);
    if (nq == 1) return dsa_emit_n<16>(key, T, need, idx, lane);
    if (nq == 2) return dsa_emit_n<32>(key, T, need, idx, lane);
    if (nq == 3) return dsa_emit_n<48>(key, T, need, idx, lane);
    return dsa_emit_n<64>(key, T, need, idx, lane);
}

template <int NR> __device__ __forceinline__ int dsa_lane_count(const unsigned (&key)[64], unsigned T) {
    int c = 0;
#pragma unroll
    for (int j = 0; j < NR; ++j) c += (key[j] >= T) ? 1 : 0;
    return c;
}
#define DSA_LCOUNT(T_, lc_) do { if (nq == 1) lc_ = dsa_lane_count<16>(key, (T_)); else if (nq == 2) lc_ = dsa_lane_count<32>(key, (T_)); else if (nq == 3) lc_ = dsa_lane_count<48>(key, (T_)); else lc_ = dsa_lane_count<64>(key, (T_)); } while (0)
template <int NR> __device__ __forceinline__ void dsa_write_ge(const unsigned (&key)[64], unsigned T, int off, LAS unsigned short* idx, int lane) {
    const int dummy = 256 + lane;
#pragma unroll
    for (int j = 0; j < NR; ++j) { const bool s = key[j] >= T; idx[s ? off : dummy] = (unsigned short)(j * 64 + lane); off += s ? 1 : 0; }
}
__device__ __forceinline__ int dsa_select2(const unsigned (&key)[64], int nvalid, LAS unsigned short* idx, int lane) {
    const int nq = __builtin_amdgcn_readfirstlane((nvalid + 1023) >> 10);
    unsigned T = 1u; int lc = 0; bool exact = true;
    if (nvalid > 256) {
        float s1 = 0.f, s2 = 0.f; unsigned kmax = 0u, kmin = 0xffffffffu;
#pragma unroll
        for (int j = 0; j < 64; ++j) { const unsigned k = key[j]; const bool ok = k != 0u; const float vv = ok ? key2f(k) : 0.f; s1 += vv; s2 += vv * vv; kmax = k > kmax ? k : kmax; kmin = (ok && k < kmin) ? k : kmin; }
        s1 = wave_sum(s1); s2 = wave_sum(s2);
        kmax = wave_umax(kmax); kmin = wave_umin(kmin);
        const float n = (float)nvalid, mean = s1 / n, sd = sqrtf(fmaxf(s2 / n - mean * mean, 1e-30f));
        const float pfrac = 256.0f / n, pt = fminf(pfrac, 1.0f - pfrac);
        const float tt = sqrtf(-2.0f * __logf(fmaxf(pt, 1e-6f)));
        float z = tt - (2.515517f + 0.802853f * tt + 0.010328f * tt * tt) / (1.0f + 1.432788f * tt + 0.189269f * tt * tt + 0.001308f * tt * tt * tt);
        if (pfrac > 0.5f) z = -z;
        const float dens = n * __expf(-0.5f * z * z) * 0.3989423f / sd;
        unsigned lo = kmin, hi = kmax + 1u; int clo = nvalid, chi = 0;
        exact = false; int same = 0, last = 0;
        for (int it = 0; hi - lo > 1u; ++it) {
            unsigned mid;
            if (it == 0) mid = f2key(mean + z * sd);
            else if (it == 1) { const float base = key2f(last > 0 ? lo : hi); const float c0 = (float)(last > 0 ? clo : chi); mid = f2key(base + 1.3f * (c0 - 256.0f) / dens); }
            else if (it < 24 && same < 2) { const float vlo = key2f(lo), vhi = key2f(hi - 1u); mid = f2key(vlo + (vhi - vlo) * (((float)(clo - 256) + 0.5f) / (float)(clo - chi))); }
            else if (it < 48) { mid = f2key(0.5f * key2f(lo) + 0.5f * key2f(hi - 1u)); same = 0; }
            else mid = lo + ((hi - lo) >> 1);
            if (!(mid > lo)) mid = lo + 1u; if (!(mid < hi)) mid = hi - 1u;
            DSA_LCOUNT(mid, lc); const int c = wave_isum(lc);
            if (c == 256) { T = mid; exact = true; break; }
            if (c > 256) { lo = mid; clo = c; same = (last > 0) ? same + 1 : 0; last = 1; } else { hi = mid; chi = c; same = (last < 0) ? same + 1 : 0; last = -1; }
        }
        if (!exact) {
            const int nsel = dsa_emit(key, nvalid, lo, 256 - chi, idx, lane);
            return nsel;
        }
    } else { DSA_LCOUNT(1u, lc); }
    int incl = lc;
#pragma unroll
    for (int o = 1; o < 64; o <<= 1) { const int t = __builtin_amdgcn_ds_bpermute(((lane - o) & 63) << 2, incl); if (lane >= o) incl += t; }
    const int total = __builtin_amdgcn_readlane(incl, 63);
    if (nq == 1) dsa_write_ge<16>(key, T, incl - lc, idx, lane); else if (nq == 2) dsa_write_ge<32>(key, T, incl - lc, idx, lane); else if (nq == 3) dsa_write_ge<48>(key, T, incl - lc, idx, lane); else dsa_write_ge<64>(key, T, incl - lc, idx, lane);
    return total;
}

constexpr int DSA_ROWF = 4100;
__device__ __forceinline__ void dsa_v3(const Ctx& F, int out_col = Z_DQ) {
    bf16* Z = (bf16*)(F.ws + WS_Z);
    const unsigned* ISG = (const unsigned*)(F.ws + WS_ISG);
    const bf16* KD = (const bf16*)(F.ws + WS_KD); const bf16* VD = (const bf16*)(F.ws + WS_VD);
    const bf16* IQB = (const bf16*)(F.ws + WS_IQB); const bf16* IKB = (const bf16*)(F.ws + WS_IKB);
    LAS unsigned* img = (LAS unsigned*)(F.lds);
    LAS unsigned short* idxw = (LAS unsigned short*)(F.lds + XTRA_OFF + F.wave * 1536);
    const int w = F.wave;
    const int v = (int)blockIdx.x;
    if (v < 256)
    for (int ui = 0; ui < 8; ++ui) {
        int lane_ = F.lane; asm volatile("" : "+v"(lane_)); const int lane = lane_, g = lane >> 4, c = lane & 15;
        const int b = v >> 6, k = v & 63; const int pb = 128 * (ui >> 1) + ((ui & 1) ? 127 - k : k);
        const int q0 = pb * 8, kend = q0 + 8, ntile = (kend + 15) >> 4;
        const size_t mb = (size_t)b * SEQ;
#if PROBE_D == 1
        for (int rp_ = 0; rp_ < 2; ++rp_)
#endif
        { s16x8 iqf[8]; float sgn[8];
          { const int qq = (q0 + c < SEQ) ? q0 + c : SEQ - 1; const bf16* qp = IQB + (mb + qq) * 256 + 8 * g; const unsigned sg = ISG[mb + qq];
#pragma unroll
            for (int h = 0; h < 8; ++h) { iqf[h] = *(const GAS s16x8*)(qp + h * 32); sgn[h] = ((sg >> h) & 1u) ? -1.0f : 1.0f; } }
          const bf16* ikp = IKB + (mb + c) * 32 + 8 * g;
          s16x8 cur[4], nxt[4];
#pragma unroll
          for (int i = 0; i < 4; ++i) { const int t = w + 8 * i; cur[i] = *(const GAS s16x8*)(ikp + (size_t)512 * (t < ntile ? t : 0)); }
          for (int t0 = w; t0 < ntile; t0 += 32) {
#pragma unroll
            for (int i = 0; i < 4; ++i) { const int t = t0 + 32 + 8 * i; nxt[i] = *(const GAS s16x8*)(ikp + (size_t)512 * (t < ntile ? t : 0)); }
#pragma unroll
            for (int i = 0; i < 4; ++i) { const int t = t0 + 8 * i;
              if (t < ntile) {
                f32x4 sc = (f32x4){0.f, 0.f, 0.f, 0.f};
#pragma unroll
                for (int h = 0; h < 8; ++h) { const f32x4 x = __builtin_amdgcn_mfma_f32_16x16x32_bf16(cur[i], iqf[h], (f32x4){0.f, 0.f, 0.f, 0.f}, 0, 0, 0);
#pragma unroll
                    for (int r = 0; r < 4; ++r) sc[r] += sgn[h] * fmaxf(x[r], 0.f); }
                v4u kk; kk.x = f2key(sc[0]); kk.y = f2key(sc[1]); kk.z = f2key(sc[2]); kk.w = f2key(sc[3]);
                const int kb = 16 * t + 4 * g, qa = q0 + c;
                if (kb + 0 > qa) kk.x = 0u; if (kb + 1 > qa) kk.y = 0u; if (kb + 2 > qa) kk.z = 0u; if (kb + 3 > qa) kk.w = 0u;
                if (c < 8) *(LAS v4u*)(img + c * DSA_ROWF + 16 * t + 4 * g) = kk; } }
#pragma unroll
            for (int i = 0; i < 4; ++i) cur[i] = nxt[i];
          } }
        __syncthreads();
        const int pos = q0 + w; unsigned key[64];
#pragma unroll
        for (int j = 0; j < 64; ++j) { const int kidx = 64 * j + lane; const unsigned a = img[w * DSA_ROWF + kidx]; key[j] = (kidx <= pos) ? a : 0u; }
        unsigned T; int need; int nsel;
        { nsel = dsa_select2(key, pos + 1, idxw, lane); (void)T; (void)need; }
        __syncthreads();
#if PROBE_D == 3
        { const size_t m = mb + pos; dsa_attend(Z + m * ZP + Z_DQ, Z + m * ZP + Z_RG, KD + mb * 64, VD + mb * 64, idxw, nsel, F.lds + w * 16384, lane); }
#endif
        { const size_t m = mb + pos; dsa_attend(Z + m * ZP + Z_DQ, Z + m * ZP + out_col, KD + mb * 64, VD + mb * 64, idxw, nsel, F.lds + w * 16384, lane); }
        __syncthreads();
    }
}

__device__ __forceinline__ void ret_rope_frag(const bf16* row, const f32x2* cs, float scale, int g, s16x8 (&f)[2]) {
    const u32x2 a0 = *(const GAS u32x2*)(row + 4 * g), a1 = *(const GAS u32x2*)(row + 16 + 4 * g), b0 = *(const GAS u32x2*)(row + 32 + 4 * g), b1 = *(const GAS u32x2*)(row + 48 + 4 * g);
    const float x1[8] = {bflo(a0.x), bfhi(a0.x), bflo(a0.y), bfhi(a0.y), bflo(a1.x), bfhi(a1.x), bflo(a1.y), bfhi(a1.y)};
    const float x2[8] = {bflo(b0.x), bfhi(b0.x), bflo(b0.y), bfhi(b0.y), bflo(b1.x), bfhi(b1.x), bflo(b1.y), bfhi(b1.y)};
    float o1[8], o2[8];
#pragma unroll
    for (int j = 0; j < 8; ++j) { const f32x2 t = cs[(j < 4 ? 4 * g + j : 16 + 4 * g + (j - 4))]; o1[j] = (x1[j] * t.x - x2[j] * t.y) * scale; o2[j] = (x2[j] * t.x + x1[j] * t.y) * scale; }
    f[0] = __builtin_bit_cast(s16x8, pack8(o1)); f[1] = __builtin_bit_cast(s16x8, pack8(o2));
}
__device__ __forceinline__ s16x8 ret_bfrag(const LAS unsigned char* img, int row0, int eb, int g, int q, int p) {
    const int r1 = row0 + 4 * g + q;
    const LAS unsigned char* a1 = img + r1 * 256 + ((eb ^ (r1 & 7)) << 5) + 8 * p;
    const LAS unsigned char* a2 = img + (r1 + 16) * 256 + ((eb ^ ((r1 + 16) & 7)) << 5) + 8 * p;
    const s16x4 lo = tr16(a1), hi = tr16(a2);
    return (s16x8){lo[0], lo[1], lo[2], lo[3], hi[0], hi[1], hi[2], hi[3]};
}

__device__ __forceinline__ void ret_state_mfma(const Ctx& F) {
    const bf16* Z = (const bf16*)(F.ws + WS_Z); float* RS = (float*)(F.ws + WS_HDN);
    const f32x2* R64 = (const f32x2*)(F.ws + WS_ROPE64);
    LAS unsigned char* Kimg = F.lds; LAS unsigned char* Vimg = F.lds + 16384;
    const int lane = F.lane, g = lane >> 4, c = lane & 15, q = (lane >> 2) & 3, p = lane & 3;
    for (int u = blockIdx.x; u < NB * 32 * 4; u += F.G) {
        const int h = u & 3, ch = (u >> 2) & 31, b = u >> 7; const float l2g = ret_l2g(h);
        const bf16* base = Z + ((size_t)b * SEQ + ch * 128) * ZP;
        __syncthreads();
        for (int t = F.tid; t < 2048; t += 512) { const int r = t >> 4, c16 = t & 15;
            *(LAS v4u*)(Vimg + r * 256 + (((c16 >> 1) ^ (r & 7)) << 5) + ((c16 & 1) << 4)) = *(const GAS v4u*)(base + (size_t)r * ZP + Z_RV + h * 128 + c16 * 8); }
        for (int t = F.tid; t < 1024; t += 512) { const int j = t >> 3, dg = t & 7; const bf16* row = base + (size_t)j * ZP + Z_RK + h * 64;
            const u32x2 a = *(const GAS u32x2*)(row + 4 * dg), bb = *(const GAS u32x2*)(row + 32 + 4 * dg);
            const float x1[4] = {bflo(a.x), bfhi(a.x), bflo(a.y), bfhi(a.y)}, x2[4] = {bflo(bb.x), bfhi(bb.x), bflo(bb.y), bfhi(bb.y)};
            const f32x2* cs = R64 + (ch * 128 + j) * 32 + 4 * dg; const float sc = exp2f((float)(127 - j) * l2g);
            float o1[4], o2[4];
#pragma unroll
            for (int e = 0; e < 4; ++e) { const f32x2 tt = cs[e]; o1[e] = (x1[e] * tt.x - x2[e] * tt.y) * sc; o2[e] = (x2[e] * tt.x + x1[e] * tt.y) * sc; }
            u32x2 w1, w2; w1.x = pk2(o1[0], o1[1]); w1.y = pk2(o1[2], o1[3]); w2.x = pk2(o2[0], o2[1]); w2.y = pk2(o2[2], o2[3]);
            const int sw = (j >> 1) & 3; const int d1 = 4 * dg, d2 = 32 + 4 * dg;
            *(LAS u32x2*)(Kimg + j * 128 + ((((2 * d1) >> 5) ^ sw) << 5) + ((2 * d1) & 31)) = w1;
            *(LAS u32x2*)(Kimg + j * 128 + ((((2 * d2) >> 5) ^ sw) << 5) + ((2 * d2) & 31)) = w2; }
        __syncthreads();
        f32x4 acc[4];
#pragma unroll
        for (int db = 0; db < 4; ++db) acc[db] = (f32x4){0.f, 0.f, 0.f, 0.f};
#pragma unroll
        for (int s = 0; s < 4; ++s) {
            const s16x8 vb = ret_bfrag(Vimg, 32 * s, F.wave, g, q, p);
            const int r1 = 32 * s + 4 * g + q, sw = (r1 >> 1) & 3;
#pragma unroll
            for (int db = 0; db < 4; ++db) { const LAS unsigned char* a1 = Kimg + r1 * 128 + ((db ^ sw) << 5) + 8 * p;
                const s16x4 lo = tr16(a1), hi = tr16(a1 + 2048);
                const s16x8 ka = (s16x8){lo[0], lo[1], lo[2], lo[3], hi[0], hi[1], hi[2], hi[3]};
                acc[db] = __builtin_amdgcn_mfma_f32_16x16x32_bf16(ka, vb, acc[db], 0, 0, 0); }
        }
        float* o = RS + (size_t)u * 8192 + 16 * F.wave + c;
#pragma unroll
        for (int db = 0; db < 4; ++db)
#pragma unroll
            for (int r = 0; r < 4; ++r) o[(16 * db + 4 * g + r) * 128] = acc[db][r];
    }
    __syncthreads();
}

__device__ __forceinline__ void ret_scan(const Ctx& F) {
    const float* RS = (const float*)(F.ws + WS_HDN); float* SC = (float*)(F.ws + WS_HDN + 16 * MiB);
    for (int t = blockIdx.x * 512 + F.tid; t < NB * 4 * 8192; t += F.G * 512) {
        const int el = t & 8191, h = (t >> 13) & 3, b = t >> 15; const float wch = exp2f(128.f * ret_l2g(h)); float s = 0.f;
        float L[32];
#pragma unroll
        for (int ch = 0; ch < 32; ++ch) L[ch] = RS[(size_t)(((b * 32 + ch) * 4 + h)) * 8192 + el];
#pragma unroll
        for (int ch = 0; ch < 32; ++ch) { SC[(size_t)(((b * 32 + ch) * 4 + h)) * 8192 + el] = s; s = wch * s + L[ch]; }
    }
}

__device__ __forceinline__ void ret_out_mfma(const Ctx& F, const float* gn, bool dummy_out = false) {
    bf16* Z = (bf16*)(F.ws + WS_Z); const float* SC = (const float*)(F.ws + WS_HDN + 16 * MiB);
    const f32x2* R64 = (const f32x2*)(F.ws + WS_ROPE64);
    LAS unsigned char* Vimg = F.lds; LAS unsigned char* Simg = F.lds + 32768;
    const int lane = F.lane, g = lane >> 4, c = lane & 15, q = (lane >> 2) & 3, p = lane & 3, w = F.wave;
    for (int u = blockIdx.x; u < NB * 32 * 4; u += F.G) {
        const int h = u & 3, ch = (u >> 2) & 31, b = u >> 7; const float l2g = ret_l2g(h); const float gam = exp2f(l2g);
        bf16* base = Z + ((size_t)b * SEQ + ch * 128) * ZP;
        __syncthreads();
        for (int t = F.tid; t < 2048; t += 512) { const int r = t >> 4, c16 = t & 15;
            *(LAS v4u*)(Vimg + r * 256 + (((c16 >> 1) ^ (r & 7)) << 5) + ((c16 & 1) << 4)) = *(const GAS v4u*)(base + (size_t)r * ZP + Z_RV + h * 128 + c16 * 8); }
        for (int t = F.tid; t < 1024; t += 512) { const int r = t >> 4, c16 = t & 15; const float* sp = SC + (size_t)u * 8192 + r * 128 + c16 * 8;
            const f32x4 s0 = *(const GAS f32x4*)sp, s1 = *(const GAS f32x4*)(sp + 4);
            v4u wv; wv.x = pk2(s0.x * gam, s0.y * gam); wv.y = pk2(s0.z * gam, s0.w * gam); wv.z = pk2(s1.x * gam, s1.y * gam); wv.w = pk2(s1.z * gam, s1.w * gam);
            *(LAS v4u*)(Simg + r * 256 + (((c16 >> 1) ^ (r & 7)) << 5) + ((c16 & 1) << 4)) = wv; }
        const int i = 16 * w + c; s16x8 qf[2];
        ret_rope_frag(base + (size_t)i * ZP + Z_RQ + h * 64, R64 + (ch * 128 + i) * 32, 0.125f * exp2f((float)i * l2g), g, qf);
        f32x4 acc[8];
#pragma unroll
        for (int t = 0; t < 8; ++t) { acc[t] = (f32x4){0.f, 0.f, 0.f, 0.f};
            if (t <= w) { const int j = 16 * t + c; s16x8 kf[2];
                ret_rope_frag(base + (size_t)j * ZP + Z_RK + h * 64, R64 + (ch * 128 + j) * 32, exp2f(-(float)j * l2g), g, kf);
                acc[t] = __builtin_amdgcn_mfma_f32_16x16x32_bf16(kf[0], qf[0], acc[t], 0, 0, 0); acc[t] = __builtin_amdgcn_mfma_f32_16x16x32_bf16(kf[1], qf[1], acc[t], 0, 0, 0);
                if (t == w) {
#pragma unroll
                    for (int r = 0; r < 4; ++r) if (4 * g + r > c) acc[t][r] = 0.f; } } }
        s16x8 pf[4];
#pragma unroll
        for (int s = 0; s < 4; ++s) { v4u wv; wv.x = pk2(acc[2 * s][0], acc[2 * s][1]); wv.y = pk2(acc[2 * s][2], acc[2 * s][3]); wv.z = pk2(acc[2 * s + 1][0], acc[2 * s + 1][1]); wv.w = pk2(acc[2 * s + 1][2], acc[2 * s + 1][3]);
            pf[s] = __builtin_bit_cast(s16x8, wv); }
        __syncthreads();
        f32x4 o[8];
#pragma unroll
        for (int eb = 0; eb < 8; ++eb) o[eb] = (f32x4){0.f, 0.f, 0.f, 0.f};
#pragma unroll
        for (int s = 0; s < 4; ++s) if (2 * s <= w) {
#pragma unroll
            for (int eb = 0; eb < 8; ++eb) o[eb] = __builtin_amdgcn_mfma_f32_16x16x32_bf16(pf[s], ret_bfrag(Vimg, 32 * s, eb, g, q, p), o[eb], 0, 0, 0); }
#pragma unroll
        for (int ks = 0; ks < 2; ++ks)
#pragma unroll
            for (int eb = 0; eb < 8; ++eb) o[eb] = __builtin_amdgcn_mfma_f32_16x16x32_bf16(qf[ks], ret_bfrag(Simg, 32 * ks, eb, g, q, p), o[eb], 0, 0, 0);
        float rs[4];
#pragma unroll
        for (int r = 0; r < 4; ++r) { float ss = 0.f;
#pragma unroll
            for (int eb = 0; eb < 8; ++eb) ss += o[eb][r] * o[eb][r];
            ss += sx<1>(ss); ss += sx<2>(ss); ss += sx<4>(ss); ss += sx<8>(ss);
            rs[r] = 1.0f / sqrtf(ss * (1.f / 128) + NORM_EPS); }
#pragma unroll
        for (int r = 0; r < 4; ++r) { bf16* zr = base + (size_t)(16 * w + 4 * g + r) * ZP; bf16* zw = dummy_out ? (bf16*)(F.ws + WS_ZS) + ((size_t)b * SEQ + ch * 128 + 16 * w + 4 * g + r) * 1024 - Z_RV : zr;
#pragma unroll
            for (int eb = 0; eb < 8; ++eb) { const int e = 16 * eb + c; const float rg = bf2f(zr[Z_RG + h * 128 + e]);
                zw[Z_RV + h * 128 + e] = (bf16)f2bf(o[eb][r] * rs[r] * gn[h * 128 + e] * rg * sigmoid_f(rg)); } }
    }
    __syncthreads();
}

__device__ __forceinline__ void fscan_phase(const Ctx& F) {
    const float* LF = (const float*)(F.ws + WS_LF); float* CF = (float*)(F.ws + WS_CF);
    if (F.gw < 32) {
        const int b = F.gw >> 3, h = F.gw & 7; const float* lp = LF + ((size_t)b * SEQ + F.lane * 64) * 8 + h; float s = 0.f;
        for (int i = 0; i < 64; ++i) s += lp[i * 8];
        float incl = s;
#pragma unroll
        for (int o = 1; o < 64; o <<= 1) { const float t = __builtin_bit_cast(float, __builtin_amdgcn_ds_bpermute(((F.lane - o) & 63) << 2, __builtin_bit_cast(int, incl))); if (F.lane >= o) incl += t; }
        float run = incl - s; float* cp = CF + (size_t)F.gw * SEQ + F.lane * 64;
        for (int i = 0; i < 64; ++i) { run += lp[i * 8]; cp[i] = run; }
    }
}
#include <hip/hip_bf16.h>
#include <cmath>
namespace attn_body {
using bf16=__hip_bfloat16;
using bf16x8=__attribute__((ext_vector_type(8)))short;
using s16x4=__attribute__((ext_vector_type(4)))short;
using f32x16=__attribute__((ext_vector_type(16)))float;
using u32x4=__attribute__((ext_vector_type(4)))unsigned;
constexpr int BATCH=4,NHEAD=8,SEQ=4096,D=64,DM=6656;
constexpr int NW=8,QBLK=32,QB=QBLK*NW,KVBLK=64,NQB=SEQ/QB;
constexpr int ATTN_PITCH=DM, ATTN_UNIT_ROWS=QB;
__device__ __forceinline__ int crow(int r,int hi){return (r&3)+8*(r>>2)+4*hi;}
#define SBAR() __builtin_amdgcn_sched_barrier(0)
__device__ __forceinline__ void cmask(f32x16&p0,f32x16&p1,int jb,int qrel,int hi){
  const float NEG=-INFINITY; int kb=64*jb+4*hi;
  #pragma unroll
  for(int r=0;r<16;++r){int kv=kb+(r&3)+8*(r>>2); if(kv>qrel)p0[r]=NEG; if(kv+32>qrel)p1[r]=NEG;}
}

constexpr int NSLOT=3, SLOTB=8192;
constexpr int LDS_K=0, LDS_V=NSLOT*SLOTB, LDS_WS=2*NSLOT*SLOTB, LDS_OST=LDS_WS+NW*64*4, LDS_NC=LDS_OST+NW*4096, LDS_BYTES=LDS_NC+SEQ*4;
constexpr float C2=0.125f*1.4426950408889634f;
__device__ __forceinline__ void glds16(const void*gsrc,unsigned lds_dst){unsigned keep;
  asm volatile("s_mov_b32 %0, m0\n\ts_mov_b32 m0, %2\n\ts_nop 0\n\tglobal_load_lds_dwordx4 %1, off\n\ts_mov_b32 m0, %0":"=&s"(keep):"v"(gsrc),"s"(lds_dst):"memory");}
__device__ __forceinline__ float max3f(float a,float b,float c){float r;asm("v_max3_f32 %0, %1, %2, %3":"=v"(r):"v"(a),"v"(b),"v"(c));return r;}
__device__ __forceinline__ float max2f(float a,float b){float r;asm("v_max_f32_e32 %0, %1, %2":"=v"(r):"v"(a),"v"(b));return r;}
__device__ __forceinline__ float fadd_s(float a,float b){float r;asm("v_add_f32_e32 %0, %1, %2":"=v"(r):"v"(a),"v"(b));return r;}
__device__ __forceinline__ float fsub_s(float a,float b){float r;asm("v_sub_f32_e32 %0, %1, %2":"=v"(r):"v"(a),"v"(b));return r;}
typedef float f32x4_t __attribute__((ext_vector_type(4))); typedef float f32x2_t __attribute__((ext_vector_type(2))); typedef __bf16 bf16x2_t __attribute__((ext_vector_type(2)));
__device__ __forceinline__ unsigned cvtpk_s(float lo,float hi){f32x2_t v={lo,hi};bf16x2_t b=__builtin_convertvector(v,bf16x2_t);return __builtin_bit_cast(unsigned,b);}
#define WAIT_BAR(N) asm volatile("s_waitcnt vmcnt(" #N ") lgkmcnt(0)\n\ts_barrier":::"memory")

__device__ __forceinline__ void qkt(f32x16&p0,f32x16&p1,const char*Kslot,const bf16x8*qr,const f32x16&negm,int r32,int hi){
  const char*kb=Kslot+hi*1024+r32*16;
  #pragma unroll
  for(int d0=0;d0<4;++d0){
    const bf16x8 b0=*reinterpret_cast<const bf16x8*>(kb+d0*2048);
    const bf16x8 b1=*reinterpret_cast<const bf16x8*>(kb+d0*2048+512);
    if(d0==0){p0=__builtin_amdgcn_mfma_f32_32x32x16_bf16(b0,qr[0],negm,0,0,0);p1=__builtin_amdgcn_mfma_f32_32x32x16_bf16(b1,qr[0],negm,0,0,0);}
    else{p0=__builtin_amdgcn_mfma_f32_32x32x16_bf16(b0,qr[d0],p0,0,0,0);p1=__builtin_amdgcn_mfma_f32_32x32x16_bf16(b1,qr[d0],p1,0,0,0);}}
}
typedef __attribute__((address_space(3))) const char* lds_cptr;
typedef short v4i16_t __attribute__((ext_vector_type(4)));
__device__ __forceinline__ void kload8(bf16x8*kf,lds_cptr kp){
  kf[0]=*(const __attribute__((address_space(3))) bf16x8*)(kp);      kf[1]=*(const __attribute__((address_space(3))) bf16x8*)(kp+512);
  kf[2]=*(const __attribute__((address_space(3))) bf16x8*)(kp+2048); kf[3]=*(const __attribute__((address_space(3))) bf16x8*)(kp+2560);
  kf[4]=*(const __attribute__((address_space(3))) bf16x8*)(kp+4096); kf[5]=*(const __attribute__((address_space(3))) bf16x8*)(kp+4608);
  kf[6]=*(const __attribute__((address_space(3))) bf16x8*)(kp+6144); kf[7]=*(const __attribute__((address_space(3))) bf16x8*)(kp+6656);
}
__device__ __forceinline__ void kload2(bf16x8*kf,lds_cptr kp,int j){ kf[2*j]=*(const __attribute__((address_space(3))) bf16x8*)(kp+j*2048); kf[2*j+1]=*(const __attribute__((address_space(3))) bf16x8*)(kp+j*2048+512); }
__device__ __forceinline__ s16x4 vtr(lds_cptr p){ return __builtin_bit_cast(s16x4,__builtin_amdgcn_ds_read_tr16_b64_v4i16((__attribute__((address_space(3))) v4i16_t*)p)); }
__device__ __forceinline__ float rowmax(const f32x16&p0,const f32x16&p1){
  float a=max3f(p0[0],p0[1],p1[0]),b=max3f(p0[2],p0[3],p1[1]);a=max3f(a,p1[2],p1[3]);
  #pragma unroll
  for(int r=4;r<16;r+=4){a=max3f(a,p0[r],p0[r+1]);b=max3f(b,p0[r+2],p0[r+3]);a=max3f(a,p1[r],p1[r+1]);b=max3f(b,p1[r+2],p1[r+3]);}
  const float m=max2f(a,b);
  auto rr=__builtin_amdgcn_permlane32_swap(__float_as_uint(m),__float_as_uint(m),false,false);
  return max2f(__uint_as_float(rr[0]),__uint_as_float(rr[1]));
}
__device__ __forceinline__ void pv(f32x16*o,int vb,bf16x8 pa0,bf16x8 pa1,bf16x8 pa2,bf16x8 pa3){
  #pragma unroll
  for(int d0=0;d0<2;++d0){s16x4 lo[4],hi[4];
    #pragma unroll
    for(int ks=0;ks<4;++ks){
      asm volatile("ds_read_b64_tr_b16 %0,%1 offset:%c2":"=&v"(lo[ks]):"v"(vb),"i"(d0*4096+ks*1024):"memory");
      asm volatile("ds_read_b64_tr_b16 %0,%1 offset:%c2":"=&v"(hi[ks]):"v"(vb),"i"(d0*4096+ks*1024+512):"memory");}
    asm volatile("s_waitcnt lgkmcnt(0)":::"memory");SBAR();
    #define PK(k) (bf16x8){lo[k][0],lo[k][1],lo[k][2],lo[k][3],hi[k][0],hi[k][1],hi[k][2],hi[k][3]}
    o[d0]=__builtin_amdgcn_mfma_f32_32x32x16_bf16(pa0,PK(0),o[d0],0,0,0);
    o[d0]=__builtin_amdgcn_mfma_f32_32x32x16_bf16(pa1,PK(1),o[d0],0,0,0);
    o[d0]=__builtin_amdgcn_mfma_f32_32x32x16_bf16(pa2,PK(2),o[d0],0,0,0);
    o[d0]=__builtin_amdgcn_mfma_f32_32x32x16_bf16(pa3,PK(3),o[d0],0,0,0);
    #undef PK
  }
}

#ifndef ATTN_STORE16
#define ATTN_STORE16(p,v) (*(u32x4*)(p)=(v))
#endif
template<int THRL> __device__ __forceinline__ void attn_unit(int b,int h,int qb,const bf16*Q,const bf16*__restrict__ K,const bf16*__restrict__ V,bf16*O,const float*CF,float dskip,char*shm,int wave_id){
  int tid_=(wave_id<<6)|lane_id_v(); asm volatile("":"+v"(tid_));
  const int tid=tid_,lane=tid&63,r32=lane&31,hi=lane>>5; const int wid=__builtin_amdgcn_readfirstlane(tid>>6);
  const long rowbase=(long)b*SEQ; const int q0=qb*QB;
  const bf16*Qw=Q+(rowbase+q0+wid*QBLK)*DM+h*D;
  const float*cfp0=CF+(long)(b*NHEAD+h)*SEQ; const int NT0=(q0+QB)/KVBLK;
  int ts; { const float cq=cfp0[q0]; const int il=(lane<NT0)?64*lane+63:q0; const bool keep=(lane<NT0)&&(cfp0[il]<cq+dskip);
    const unsigned long long km=__ballot(keep); int t0=(int)__builtin_ctzll(km|(1ull<<63)); t0&=~1; ts=__builtin_amdgcn_readfirstlane(t0<NT0-4?t0:NT0-4); }
  const bf16*Kh=K+(rowbase+(long)ts*KVBLK)*DM+h*D,*Vh=V+(rowbase+(long)ts*KVBLK)*DM+h*D;
  const unsigned lds0=(unsigned)(uintptr_t)shm;
  float*wsf=(float*)(shm+LDS_WS)+wid*64;
  const bf16*ksrc=Kh+(long)lane*DM+wid*8;
  const bf16*vsrc=Vh+(long)(16*(wid&3)+(lane>>2))*DM+(wid>>2)*32+(lane&3)*8;
  const unsigned kdst=lds0+LDS_K+wid*1024, vdst=lds0+LDS_V+wid*1024;
  #define DMA_K(t,slot) glds16(ksrc+(long)(t)*KVBLK*DM,(unsigned)__builtin_amdgcn_readfirstlane(kdst+(slot)))
  #define DMA_V(t,slot) glds16(vsrc+(long)(t)*KVBLK*DM,(unsigned)__builtin_amdgcn_readfirstlane(vdst+(slot)))
  const char*Kbase=shm+LDS_K; bf16x8 kf[8];
  const lds_cptr shm3=(lds_cptr)shm; const lds_cptr kp0=shm3+LDS_K+hi*1024+r32*16; const lds_cptr vp0=shm3+LDS_V+((lane>>4)&1)*32+(lane&3)*8+(4*hi+((lane&15)>>2))*64;
  const int NT=NT0-ts;
  { const float*cfp=CF+(long)(b*NHEAD+h)*SEQ; float*ncw=(float*)(shm+LDS_NC);
    for(int i=tid+ts*KVBLK;i<q0+QB;i+=NW*64)ncw[i-ts*KVBLK]=-cfp[i]; }
  const lds_cptr ncp=(lds_cptr)shm+LDS_NC+hi*16;
  #define ADDC(P0,P1,t) do{ const lds_cptr np_=ncp+(t)*256; _Pragma("unroll") for(int g_=0;g_<4;++g_){ \
      const f32x4_t a_=*(const __attribute__((address_space(3))) f32x4_t*)(np_+g_*32), b_=*(const __attribute__((address_space(3))) f32x4_t*)(np_+g_*32+128); \
      P0[4*g_]+=a_[0];P0[4*g_+1]+=a_[1];P0[4*g_+2]+=a_[2];P0[4*g_+3]+=a_[3]; P1[4*g_]+=b_[0];P1[4*g_+1]+=b_[1];P1[4*g_+2]+=b_[2];P1[4*g_+3]+=b_[3]; } }while(0)
  DMA_K(0,0);DMA_V(0,0);DMA_K(1,SLOTB);
  bf16x8 qr[4];
  #pragma unroll
  for(int d0=0;d0<4;++d0)qr[d0]=*reinterpret_cast<const bf16x8*>(&Qw[(long)r32*DM+d0*16+hi*8]);
  float mhat=0.f,l_reg=0.f;f32x16 o[2];f32x16 negm; { float zz_; asm volatile("v_mov_b32 %0, 0":"=v"(zz_));
    _Pragma("unroll") for(int r=0;r<16;++r){o[0][r]=zz_;o[1][r]=zz_;negm[r]=zz_;} } asm volatile("":"+v"(negm));
  const int qrel=wid*QBLK+r32;
  #define CMASK(P0,P1,t) do{int jb_=(t)-(NT-4); if(jb_>=0)cmask(P0,P1,jb_,qrel,hi);}while(0)
  bool resc=false;
  #define START(P0,P1) do{ const float rm=rowmax(P0,P1); resc=false; \
    { const float dl=rm; mhat=fadd_s(mhat,dl); \
      _Pragma("unroll") for(int r=0;r<16;++r){P0[r]=fsub_s(P0[r],dl);P1[r]=fsub_s(P1[r],dl);} \
      _Pragma("unroll") for(int r=0;r<16;++r)negm[r]=-mhat; asm volatile("":"+v"(negm)); } \
    _Pragma("unroll") for(int r=0;r<16;++r)P0[r]=__builtin_amdgcn_exp2f(P0[r]); }while(0)
  #define RESC() do{ if(resc){ asm volatile("s_waitcnt lgkmcnt(0)":::"memory"); \
      _Pragma("unroll") for(int d_=0;d_<2;++d_) _Pragma("unroll") for(int r=0;r<16;++r)o[d_][r]*=wsf[crow(r,hi)]; } }while(0)
  f32x16 pA0,pA1,pB0,pB1;
  int sl_prev=0,sl_cur=0,sl_next=SLOTB;
  #define ROT() do{sl_prev=sl_cur;sl_cur=sl_next;sl_next=(sl_next==(NSLOT-1)*SLOTB)?0:sl_next+SLOTB;}while(0)
  DMA_K(2,2*SLOTB);
  WAIT_BAR(3);
  qkt(pA0,pA1,Kbase,qr,negm,r32,hi);asm volatile("s_nop 15\n\ts_nop 7":"+v"(pA0),"+v"(pA1));ADDC(pA0,pA1,0);CMASK(pA0,pA1,0);
  START(pA0,pA1);
  _Pragma("unroll") for(int r=0;r<16;++r)pA1[r]=__builtin_amdgcn_exp2f(pA1[r]);
  WAIT_BAR(0);
  DMA_K(3,0);DMA_V(1,SLOTB);
  ROT();
  kload8(kf,kp0+sl_cur);
  WAIT_BAR(2);
  s16x4 vlo[8],vhi[8]; u32x4 pw0,pw1,pw2,pw3;
  #define PKW(P,B) cvtpk_s(P[B],P[B+1])
  #define PAF(k) __builtin_bit_cast(bf16x8,pw##k)
  #define VFR(i) (bf16x8){vlo[i][0],vlo[i][1],vlo[i][2],vlo[i][3],vhi[i][0],vhi[i][1],vhi[i][2],vhi[i][3]}
  #define PIN(x) asm volatile("":"+v"(x))
  #define MX3(a,b,c) __builtin_fmaxf(__builtin_fmaxf((a),(b)),(c))
  #define GAPA(MF,A0,A1,A2,A3,W0,W1,PW) do{ MF; sacc+=A0; sacc+=A1; sacc+=A2; sacc+=A3; PIN(sacc); W0; W1; PIN(PW); SBAR(); }while(0)
  #define EX(v) __builtin_amdgcn_exp2f(v)
  #define GAPB(MF,X,B) do{ MF; X[B]=EX(X[B]); X[B+1]=EX(X[B+1]); X[B+2]=EX(X[B+2]); X[B+3]=EX(X[B+3]); PIN(X); SBAR(); }while(0)
  #define VRD(i) do{ vlo[i]=vtr(vp_+(((i)>>2)*4096+((i)&3)*1024)); vhi[i]=vtr(vp_+(((i)>>2)*4096+((i)&3)*1024+512)); }while(0)
  #define KRD(G,j) do{ if(G){ kload2(kf,kp0+sl_next,j); SBAR(); } }while(0)
  #define STEP(C0,C1,P0,P1,t,GK,GV,GL) do{ SBAR(); \
    const lds_cptr vp_=vp0+sl_prev; \
    VRD(0); SBAR(); float sacc=(P0[0]+P0[1]); \
    GAPA(C0=__builtin_amdgcn_mfma_f32_32x32x16_bf16(kf[0],qr[0],negm,0,0,0), P0[2],P0[3],P0[4],P0[5],     pw0[0]=PKW(P0,0), pw0[1]=PKW(P0,2), pw0); \
    VRD(4); SBAR(); GAPA(C1=__builtin_amdgcn_mfma_f32_32x32x16_bf16(kf[1],qr[0],negm,0,0,0), P0[6],P0[7],P0[8],P0[9],     pw0[2]=PKW(P0,4), pw0[3]=PKW(P0,6), pw0); \
    VRD(1); SBAR(); GAPA(C0=__builtin_amdgcn_mfma_f32_32x32x16_bf16(kf[2],qr[1],C0,0,0,0),   P0[10],P0[11],P0[12],P0[13], pw1[0]=PKW(P0,8), pw1[1]=PKW(P0,10), pw1); \
    VRD(5); SBAR(); GAPA(C1=__builtin_amdgcn_mfma_f32_32x32x16_bf16(kf[3],qr[1],C1,0,0,0),   P0[14],P0[15],P1[0],P1[1],   pw1[2]=PKW(P0,12),pw1[3]=PKW(P0,14), pw1); \
    VRD(2); SBAR(); GAPA(C0=__builtin_amdgcn_mfma_f32_32x32x16_bf16(kf[4],qr[2],C0,0,0,0),   P1[2],P1[3],P1[4],P1[5],     pw2[0]=PKW(P1,0), pw2[1]=PKW(P1,2), pw2); \
    VRD(6); SBAR(); GAPA(C1=__builtin_amdgcn_mfma_f32_32x32x16_bf16(kf[5],qr[2],C1,0,0,0),   P1[6],P1[7],P1[8],P1[9],     pw2[2]=PKW(P1,4), pw2[3]=PKW(P1,6), pw2); \
    VRD(3); SBAR(); GAPA(C0=__builtin_amdgcn_mfma_f32_32x32x16_bf16(kf[6],qr[3],C0,0,0,0),   P1[10],P1[11],P1[12],P1[13], pw3[0]=PKW(P1,8), pw3[1]=PKW(P1,10), pw3); \
    VRD(7); SBAR(); GAPA(C1=__builtin_amdgcn_mfma_f32_32x32x16_bf16(kf[7],qr[3],C1,0,0,0),   P1[14],P1[15],0.f,0.f,       pw3[2]=PKW(P1,12),pw3[3]=PKW(P1,14), pw3); \
    l_reg+=sacc; \
    if(GK){DMA_K((t)+3,sl_cur);} if(GV){DMA_V((t)+1,sl_next);} \
    ADDC(C0,C1,t); CMASK(C0,C1,t); \
    { float a=MX3(C0[0],C0[1],C1[0]),b=MX3(C0[2],C0[3],C1[1]); a=MX3(a,C1[2],C1[3]); \
      _Pragma("unroll") for(int r=4;r<16;r+=4){a=MX3(a,C0[r],C0[r+1]);b=MX3(b,C0[r+2],C0[r+3]);a=MX3(a,C1[r],C1[r+1]);b=MX3(b,C1[r+2],C1[r+3]);} \
      float rm=__builtin_fmaxf(a,b); { auto rr=__builtin_amdgcn_permlane32_swap(__float_as_uint(rm),__float_as_uint(rm),false,false); rm=__builtin_fmaxf(__uint_as_float(rr[0]),__uint_as_float(rr[1])); } \
      resc=false; \
      if(__builtin_expect(__any(rm>(float)THRL),0)){ const float dl=__builtin_fmaxf(rm,0.f); mhat+=dl; \
        _Pragma("unroll") for(int r=0;r<16;++r){C0[r]-=dl;C1[r]-=dl;} \
        _Pragma("unroll") for(int r=0;r<16;++r)negm[r]=-mhat; asm volatile("":"+v"(negm)); \
        const float f=__builtin_amdgcn_exp2f(-dl); l_reg*=f; if(hi==0)wsf[r32]=f; resc=true; } } \
    SBAR(); \
    GAPB(o[0]=__builtin_amdgcn_mfma_f32_32x32x16_bf16(PAF(0),VFR(0),o[0],0,0,0), C0,0); \
    GAPB(o[1]=__builtin_amdgcn_mfma_f32_32x32x16_bf16(PAF(0),VFR(4),o[1],0,0,0), C0,4); \
    KRD(GL,0); GAPB(o[0]=__builtin_amdgcn_mfma_f32_32x32x16_bf16(PAF(1),VFR(1),o[0],0,0,0), C0,8); \
    KRD(GL,1); GAPB(o[1]=__builtin_amdgcn_mfma_f32_32x32x16_bf16(PAF(1),VFR(5),o[1],0,0,0), C0,12); \
    KRD(GL,2); GAPB(o[0]=__builtin_amdgcn_mfma_f32_32x32x16_bf16(PAF(2),VFR(2),o[0],0,0,0), C1,0); \
    KRD(GL,3); GAPB(o[1]=__builtin_amdgcn_mfma_f32_32x32x16_bf16(PAF(2),VFR(6),o[1],0,0,0), C1,4); \
    GAPB(o[0]=__builtin_amdgcn_mfma_f32_32x32x16_bf16(PAF(3),VFR(3),o[0],0,0,0), C1,8); \
    GAPB(o[1]=__builtin_amdgcn_mfma_f32_32x32x16_bf16(PAF(3),VFR(7),o[1],0,0,0), C1,12); \
    }while(0)
  int t=1;
  #undef CMASK
  #define CMASK(P0,P1,t) do{}while(0)
  for(;t+5<NT;t+=2){
    STEP(pB0,pB1,pA0,pA1,t,true,true,true);     WAIT_BAR(2); RESC(); ROT();
    STEP(pA0,pA1,pB0,pB1,t+1,true,true,true);   WAIT_BAR(2); RESC(); ROT();
  }
  #undef CMASK
  #define CMASK(P0,P1,t) do{int jb_=(t)-(NT-4); if(jb_>=0)cmask(P0,P1,jb_,qrel,hi);}while(0)
  #define ENDW(tt) do{ if((tt)+3<NT){WAIT_BAR(2);} else if((tt)+2<NT){WAIT_BAR(1);} else {WAIT_BAR(0);} }while(0)
  for(;t+1<NT;t+=2){
    STEP(pB0,pB1,pA0,pA1,t,(t+3<NT),(t+1<NT),(t+1<NT));       ENDW(t);   RESC(); ROT();
    STEP(pA0,pA1,pB0,pB1,t+1,(t+4<NT),(t+2<NT),(t+2<NT));     ENDW(t+1); RESC(); ROT();
  }
  STEP(pB0,pB1,pA0,pA1,NT-1,false,false,false); RESC();
  { float sacc=pB0[0]+pB0[1]; _Pragma("unroll") for(int r=2;r<16;++r)sacc+=pB0[r]; _Pragma("unroll") for(int r=0;r<16;++r)sacc+=pB1[r]; l_reg+=sacc;
    pw0=(u32x4){PKW(pB0,0),PKW(pB0,2),PKW(pB0,4),PKW(pB0,6)};pw1=(u32x4){PKW(pB0,8),PKW(pB0,10),PKW(pB0,12),PKW(pB0,14)};pw2=(u32x4){PKW(pB1,0),PKW(pB1,2),PKW(pB1,4),PKW(pB1,6)};pw3=(u32x4){PKW(pB1,8),PKW(pB1,10),PKW(pB1,12),PKW(pB1,14)};
    int tl_=lane_id_v(); asm volatile("":"+v"(tl_)); const int ln_=tl_&63,hi_=ln_>>5; const int vb0e=(int)(lds0+LDS_V)+((ln_>>4)&1)*32+(ln_&3)*8+(4*hi_+((ln_&15)>>2))*64;
    SBAR(); pv(o,vb0e+sl_cur,PAF(0),PAF(1),PAF(2),PAF(3)); }
  #undef PKW
  #undef PAF
  #undef VFR
  #undef PIN
  #undef MX3
  #undef GAPA
  #undef GAPB
  #undef EX
  #undef VRD
  #undef KRD
  #undef STEP
  #undef ENDW
  {auto rr=__builtin_amdgcn_permlane32_swap(__float_as_uint(l_reg),__float_as_uint(l_reg),false,false);l_reg=__uint_as_float(rr[0])+__uint_as_float(rr[1]);}
  int te_=lane_id_v(); asm volatile("":"+v"(te_)); const int lane_e=te_&63,r32_e=lane_e&31,hi_e=lane_e>>5;
  if(hi_e==0)wsf[32+r32_e]=l_reg;asm volatile("s_waitcnt lgkmcnt(0)":::"memory");
  float rli[16];
  #pragma unroll
  for(int r=0;r<16;++r)rli[r]=__builtin_amdgcn_rcpf(wsf[32+crow(r,hi_e)]);
  bf16*Ow=O+(rowbase+q0+wid*QBLK)*DM+h*D;
  { bf16*stg=(bf16*)(shm+LDS_OST)+wid*2048;
    #pragma unroll
    for(int r=0;r<16;++r){const int orow=crow(r,hi_e);
      #pragma unroll
      for(int d0=0;d0<2;++d0)stg[orow*64+d0*32+r32_e]=__float2bfloat16(o[d0][r]*rli[r]);}
    asm volatile("s_waitcnt lgkmcnt(0)":::"memory");
    #pragma unroll
    for(int i=0;i<4;++i){const int row=i*8+(lane_e>>3),ch=lane_e&7; const u32x4 v=*(const u32x4*)(stg+row*64+ch*8); ATTN_STORE16(Ow+(long)row*DM+ch*8,v);} }
  asm volatile("s_waitcnt lgkmcnt(0)\n\ts_barrier":::"memory");
  #undef ADDC
  #undef DMA_K
  #undef DMA_V
  #undef CMASK
  #undef START
  #undef RESC
  #undef ROT
}
constexpr int ATTN_LDS_BYTES=LDS_BYTES;
struct AttnTensors { const bf16* Q; const bf16* K; const bf16* V; bf16* O; const float* CF; float dskip; };
struct AttnUnit { int bh; int qb; };
struct StaticOrder {
  int vcu;
  __device__ __forceinline__ explicit StaticOrder(int grid,int block):vcu((block%8)*(grid/8)+block/8){}
  __device__ __forceinline__ bool next(int i,AttnUnit&u)const{ if(i>=2)return false; const int s=vcu&7; u.bh=vcu>>3; u.qb=(i==0)?s:15-s; return true; }
  __device__ __forceinline__ void a_ready(const AttnUnit&)const{}
  __device__ __forceinline__ void done(const AttnUnit&)const{}
};
template<class Sched,int THRL=8> __device__ __forceinline__ void attn_phase(char*lds,const AttnTensors&T,const Sched&S,int wave_id){
  AttnUnit u;
  for(int i=0;S.next(i,u);++i){ S.a_ready(u); attn_unit<THRL>(u.bh/NHEAD,u.bh%NHEAD,u.qb,T.Q,T.K,T.V,T.O,T.CF,T.dskip,lds,wave_id); S.done(u); }
}
#undef SBAR
#undef WAIT_BAR
}

struct Args { const float* in[16]; float* out; unsigned char* ws; };
__global__ void __launch_bounds__(NWAVES * 64, 2) hyb_fwd(Args args) {
    extern __shared__ __attribute__((aligned(16))) unsigned char lds[];
    Ctx F;
    F.lds = (LAS unsigned char*)lds;
    F.tid = threadIdx.x; F.lane = F.tid & 63; F.wave = __builtin_amdgcn_readfirstlane(F.tid >> 6);
    F.G = gridDim.x; F.gw = blockIdx.x * NWAVES + F.wave; F.NGW = F.G * NWAVES;
    F.out = args.out; F.ws = args.ws;
    volatile LAS unsigned* MISC = (volatile LAS unsigned*)(F.lds + MISC_OFF);
    for (int u = F.tid; u < (LDS_BYTES - LDSCTL_OFF) / 4; u += NWAVES * 64) ((LAS unsigned*)(F.lds + LDSCTL_OFF))[u] = 0u;
    __syncthreads();
    gu32* ctl = (gu32*)(F.ws + WS_CTL);
    XcdBarrier bar = xcd_barrier_post((unsigned*)(ctl + CW_BAR), MISC + 8); bar.w = F.wave;
#define FRESH(P) Ctx P = F; P.tid = (F.wave << 6) | lane_id_v(); asm volatile("" : "+v"(P.tid), "+s"(P.wave), "+s"(P.gw), "+s"(P.ws), "+s"(P.out)); P.lane = P.tid & 63
#define GRID_BAR() do { XcdBarrier b_ = bar; asm volatile("" : "+s"(b_.bar), "+s"(b_.x)); xcd_barrier(b_); } while (0)

    bf16* Wb = (bf16*)(F.ws + WS_W);
    bf16* Z = (bf16*)(F.ws + WS_Z); float* ZS = (float*)(F.ws + WS_ZS); bf16* HDN = (bf16*)(F.ws + WS_HDN);
    float* M32 = (float*)(F.ws + WS_HDN); bf16* HB = (bf16*)(F.ws + WS_Z);
    LAS unsigned char* ring = F.lds + RING_OFF; float* SSp = (float*)(F.ws + WS_SS);

    { FRESH(P); p0_prologue(P, args.in[2], args.in[9], args.in[10], args.in[11], args.in[12], args.in[14], args.in[15]); }
    { FRESH(P); norm0_phase(P, args.in[0], args.in[1], (bf16*)(P.ws + WS_HDN), (float*)(P.ws + WS_SS)); }
    GRID_BAR();

    #pragma unroll 1
    for (int layer = 0; layer < DEPTH; ++layer) {
        const float* xin = (layer == 0) ? args.in[0] : F.out;
        const bf16* L = Wb + (size_t)layer * LW_STRIDE;
        { pg8::Gemm g{HDN, L + LW_IN, M, NIN, DM, DM, DM}; pg8::StaticOrder S; S.init(M, NIN, F.G, (int)blockIdx.x);
          pg8::EpiZ E{Z, ZS, SSp};
          pg8::gemm_phase<pg8::EpiZ, pg8::StaticOrder, true, true>(ring, g, S, E, F.wave); }
        GRID_BAR();
#ifdef PROBE_PP
        { FRESH(P); post_phase(P, args.in[4] + layer * 64, args.in[5] + layer * 64, args.in[6] + layer * 64, args.in[7] + layer * 64, args.in[3] + layer * 8, true); }
#endif
        { FRESH(P); post_phase(P, args.in[4] + layer * 64, args.in[5] + layer * 64, args.in[6] + layer * 64, args.in[7] + layer * 64, args.in[3] + layer * 8); }
        { FRESH(P); ret_state_mfma(P); }
        GRID_BAR();
        { FRESH(P); fscan_phase(P); }
        { FRESH(P); ret_scan(P); }
        GRID_BAR();
#ifdef PROBE_RO
        { FRESH(P); ret_out_mfma(P, args.in[8] + layer * 512, true); }
#endif
        { FRESH(P); ret_out_mfma(P, args.in[8] + layer * 512); }
#ifdef PROBE_X3
        for (int rep_ = 0; rep_ < 2; ++rep_)
        { static_assert(attn_body::ATTN_LDS_BYTES <= RING_BYTES, "attention scratch fits the ring region");
          unsigned char* wsl = F.ws; asm volatile("" : "+s"(wsl));
          bf16* Zl = (bf16*)(wsl + WS_Z);
          const attn_body::AttnTensors AT{(const attn_body::bf16*)(Zl + Z_FQ), (const attn_body::bf16*)(Zl + Z_FK), (const attn_body::bf16*)(Zl + Z_FV), (attn_body::bf16*)(Zl + (rep_ == 0 ? Z_RQ : Z_FQ)), (const float*)(wsl + WS_CF)};
          const attn_body::StaticOrder S((int)F.G, (int)blockIdx.x);
          attn_body::attn_phase<attn_body::StaticOrder, 20>((char*)lds + RING_OFF, AT, S, F.wave); }
#ifdef PROBE_X4
        { FRESH(P); dsa_v3(P); }
#else
        for (int rep_ = 0; rep_ < 2; ++rep_) { FRESH(P); dsa_v3(P, rep_ == 0 ? Z_RG : Z_DQ); }
#endif
#else
        { static_assert(attn_body::ATTN_LDS_BYTES <= RING_BYTES, "attention scratch fits the ring region");
          unsigned char* wsl = F.ws; asm volatile("" : "+s"(wsl));
          bf16* Zl = (bf16*)(wsl + WS_Z);
          float dskip; { const int ln = lane_id_v(); const float gq = wave_max(fabsf(args.in[4][layer * 64 + ln])), gk = wave_max(fabsf(args.in[5][layer * 64 + ln])); dskip = 2.0f * (64.0f * C2 * gq * gk * 1.02f) + 48.0f; }
          const attn_body::AttnTensors AT{(const attn_body::bf16*)(Zl + Z_FQ), (const attn_body::bf16*)(Zl + Z_FK), (const attn_body::bf16*)(Zl + Z_FV), (attn_body::bf16*)(Zl + Z_FQ), (const float*)(wsl + WS_CF), dskip};
          const attn_body::StaticOrder S((int)F.G, (int)blockIdx.x);
          attn_body::attn_phase<attn_body::StaticOrder, 20>((char*)lds + RING_OFF, AT, S, F.wave); }
        { FRESH(P); dsa_v3(P); }
#endif
        GRID_BAR();
        { pg8::StaticOrder S; S.init(M, DM, F.G, (int)blockIdx.x);
          { pg8::Gemm g{Z + Z_FQ, L + LW_MIX, M, DM, 512, ZP, 512}; pg8::EpiGate<0> E{Z + Z_ZG, M32, Z + Z_MRG};
            pg8::gemm_phase<pg8::EpiGate<0>, pg8::StaticOrder, false, true>(ring, g, S, E, F.wave); }
          { pg8::Gemm g{Z + Z_DQ, L + LW_MIX + 512 * 1024, M, DM, 512, ZP, 512}; pg8::EpiGate<1> E{Z + Z_ZG, M32, Z + Z_MRG};
            pg8::gemm_phase<pg8::EpiGate<1>, pg8::StaticOrder, false, true>(ring, g, S, E, F.wave); }
          { pg8::Gemm g{Z + Z_RV, L + LW_MIX + 1024 * 1024, M, DM, 512, ZP, 512}; pg8::EpiGate<2> E{Z + Z_ZG, M32, Z + Z_MRG};
            pg8::gemm_phase<pg8::EpiGate<2>, pg8::StaticOrder, false, true>(ring, g, S, E, F.wave); } }
        GRID_BAR();
        { pg8::Gemm g{Z + Z_MRG, L + LW_O, M, DM, DM, ZP, DM}; pg8::StaticOrder S; S.init(M, DM, F.G, (int)blockIdx.x);
          pg8::EpiRes E{xin, F.out, args.in[13] + layer * DM, HDN, SSp};
          pg8::gemm_phase<pg8::EpiRes, pg8::StaticOrder, false, true>(ring, g, S, E, F.wave); }
        GRID_BAR();
        { pg8::Gemm g{HDN, L + LW_FI, M, FF2, DM, DM, DM}; pg8::StaticOrder S; S.init(M, FF2, F.G, (int)blockIdx.x);
          pg8::EpiSwi E{HB, FFH, SSp};
          pg8::gemm_phase<pg8::EpiSwi, pg8::StaticOrder, true, true>(ring, g, S, E, F.wave); }
        GRID_BAR();
        { pg8::Gemm g{HB, L + LW_FO, M, DM, FFH, FFH, FFH}; pg8::StaticOrder S; S.init(M, DM, F.G, (int)blockIdx.x);
          pg8::EpiRes E{F.out, F.out, args.in[1] + (layer + 1 < DEPTH ? layer + 1 : layer) * DM, HDN, SSp};
          pg8::gemm_phase<pg8::EpiRes, pg8::StaticOrder, false, true>(ring, g, S, E, F.wave); }
        GRID_BAR();
    }
    if (__hip_atomic_load((gu32*)((unsigned*)(ctl + CW_BAR) + XB_TMO), RLX_AGENT) != 0u) {
        const float q = __builtin_nanf("");
        for (int m = F.gw; m < M; m += F.NGW) { GAS f32x4* o = (GAS f32x4*)(F.out + (size_t)m * DM) + lane_id_v();
#pragma unroll
            for (int j = 0; j < 4; ++j) o[64 * j] = (f32x4){q, q, q, q}; }
    }
}

extern "C" void kernel_launch(void* const* d_in, const int* in_sizes, int n_in, void* d_out, int out_size, void* d_ws, size_t ws_size, hipStream_t stream) {
    static int grid = 0;
    if (grid == 0) {
        if (n_in != 16 || in_sizes[0] != M * DM || out_size != M * DM || ws_size < WS_END) { fprintf(stderr, "kernel_launch: unexpected shapes / workspace (n_in %d, in0 %d, out %d, ws %zu < %zu)\n", n_in, n_in > 0 ? in_sizes[0] : -1, out_size, ws_size, (size_t)WS_END); grid = -1; return; }
        int dev = 0, cus = 0, per_cu = 0;
        if (hipGetDevice(&dev) != hipSuccess || hipDeviceGetAttribute(&cus, hipDeviceAttributeMultiprocessorCount, dev) != hipSuccess) { grid = -1; return; }
        if (hipFuncSetAttribute((const void*)hyb_fwd, hipFuncAttributeMaxDynamicSharedMemorySize, LDS_BYTES) != hipSuccess) { fprintf(stderr, "kernel_launch: hipFuncSetAttribute failed\n"); grid = -1; return; }
        if (hipOccupancyMaxActiveBlocksPerMultiprocessor(&per_cu, (const void*)hyb_fwd, NWAVES * 64, LDS_BYTES) != hipSuccess || per_cu < 1) { fprintf(stderr, "kernel_launch: occupancy query reports %d blocks per CU\n", per_cu); }
        (void)hipGetLastError();
        grid = cus;
    }
    if (grid < 0) return;
    if (hipMemsetAsync((char*)d_ws + WS_CTL, 0, CTL_ZERO_BYTES, stream) != hipSuccess) return;
    Args a{};
    for (int i = 0; i < 16; ++i) a.in[i] = (const float*)d_in[i];
    a.out = (float*)d_out; a.ws = (unsigned char*)d_ws;
    hipLaunchKernelGGL(hyb_fwd, dim3(grid), dim3(NWAVES * 64), LDS_BYTES, stream, a);
}
```

```cpp
#include <hip/hip_runtime.h>
#include <cstdio>
#include <cstdint>
#include <cmath>
__device__ __forceinline__ int lane_id_v() { unsigned z; asm volatile("v_mov_b32 %0, 0" : "=v"(z)); return (int)__builtin_amdgcn_mbcnt_hi(~0u, __builtin_amdgcn_mbcnt_lo(~0u, z)); }
template <int MASK> __device__ __forceinline__ float sx(float v) { static_assert(MASK < 32, "swizzle xor mask"); return __builtin_bit_cast(float, __builtin_amdgcn_ds_swizzle(__builtin_bit_cast(int, v), 0x1F | (MASK << 10))); }
template <int MASK> __device__ __forceinline__ unsigned sxu(unsigned v) { return (unsigned)__builtin_amdgcn_ds_swizzle((int)v, 0x1F | (MASK << 10)); }
__device__ __forceinline__ void swap32(unsigned x, unsigned& lo_view, unsigned& hi_view) {
    unsigned a = x, b = x; asm volatile("" : "+v"(b));
    const auto rr = __builtin_amdgcn_permlane32_swap(a, b, false, false);
    lo_view = rr[0]; hi_view = rr[1];
}
template <int CTRL> __device__ __forceinline__ float dpp_f(float v) { return __builtin_bit_cast(float, __builtin_amdgcn_update_dpp(0, __builtin_bit_cast(int, v), CTRL, 0xF, 0xF, false)); }
template <int CTRL> __device__ __forceinline__ int dpp_i(int v) { return __builtin_amdgcn_update_dpp(0, v, CTRL, 0xF, 0xF, false); }
__device__ __forceinline__ float rl_f(float v, int l) { return __builtin_bit_cast(float, __builtin_amdgcn_readlane(__builtin_bit_cast(int, v), l)); }
__device__ __forceinline__ float wave_sum(float v) {
    v += dpp_f<0xB1>(v); v += dpp_f<0x4E>(v); v += dpp_f<0x141>(v); v += dpp_f<0x140>(v);
    return (rl_f(v, 0) + rl_f(v, 16)) + (rl_f(v, 32) + rl_f(v, 48));
}
__device__ __forceinline__ float wave_max(float v) {
    v = fmaxf(v, dpp_f<0xB1>(v)); v = fmaxf(v, dpp_f<0x4E>(v)); v = fmaxf(v, dpp_f<0x141>(v)); v = fmaxf(v, dpp_f<0x140>(v));
    return fmaxf(fmaxf(rl_f(v, 0), rl_f(v, 16)), fmaxf(rl_f(v, 32), rl_f(v, 48)));
}
__device__ __forceinline__ int wave_isum(int v) {
    v += dpp_i<0xB1>(v); v += dpp_i<0x4E>(v); v += dpp_i<0x141>(v); v += dpp_i<0x140>(v);
    return (__builtin_amdgcn_readlane(v, 0) + __builtin_amdgcn_readlane(v, 16)) + (__builtin_amdgcn_readlane(v, 32) + __builtin_amdgcn_readlane(v, 48));
}
__device__ __forceinline__ unsigned wave_umax(unsigned v) {
    unsigned t; t = (unsigned)dpp_i<0xB1>((int)v); v = t > v ? t : v; t = (unsigned)dpp_i<0x4E>((int)v); v = t > v ? t : v; t = (unsigned)dpp_i<0x141>((int)v); v = t > v ? t : v; t = (unsigned)dpp_i<0x140>((int)v); v = t > v ? t : v;
    const unsigned a = (unsigned)__builtin_amdgcn_readlane((int)v, 0), b = (unsigned)__builtin_amdgcn_readlane((int)v, 16), c = (unsigned)__builtin_amdgcn_readlane((int)v, 32), d = (unsigned)__builtin_amdgcn_readlane((int)v, 48);
    const unsigned ab = a > b ? a : b, cd = c > d ? c : d; return ab > cd ? ab : cd;
}
__device__ __forceinline__ unsigned wave_umin(unsigned v) { return ~wave_umax(~v); }
__device__ __forceinline__ float half_sum(float v) {
    unsigned a, b; swap32(__builtin_bit_cast(unsigned, v), a, b); return __builtin_bit_cast(float, a) + __builtin_bit_cast(float, b);
}
__device__ __forceinline__ float half_max(float v) {
    unsigned a, b; swap32(__builtin_bit_cast(unsigned, v), a, b); return fmaxf(__builtin_bit_cast(float, a), __builtin_bit_cast(float, b));
}
namespace pg8 {
#define PG8_LAS __attribute__((address_space(3)))
typedef unsigned short bf16_t;
typedef short bf16x8 __attribute__((ext_vector_type(8)));
typedef float f32x4 __attribute__((ext_vector_type(4)));
typedef unsigned u32x4 __attribute__((ext_vector_type(4)));
constexpr int BM = 256, BK = 64, HALF = 128, HTB = HALF * BK * 2  , STAGE_BYTES = 8 * HTB, NXCD = 8, WGM = 8;

__host__ __device__ __forceinline__ int lds_byte(int r, int c) { const int st = (r >> 4) * 2 + (c >> 5), rr = r & 15, cc = c & 31, ob = rr * 64 + cc * 2; return st * 1024 + (ob ^ (((ob >> 9) & 1) << 5)); }
__host__ __device__ __forceinline__ void stage_rc(int b, int& R, int& C) { const int st = b / 1024, sb = b % 1024, swz = sb ^ (((sb >> 9) & 1) << 5); R = (st >> 1) * 16 + swz / 64; C = (st & 1) * 32 + (swz % 64) / 2; }
__host__ __device__ __forceinline__ int perm32(int rho) { const int n = rho >> 4, i = rho & 15; return 8 * (i >> 2) + 4 * n + (i & 3); }

struct Unit { int pm, pn; };
struct Gemm { const bf16_t* A; const bf16_t* Bt; int M, N, K, lda, ldb; };

struct StaticOrder {
    int nM, nN, nwg, G, c;
    __host__ __device__ void init(int M, int N, int G_, int c_) { nM = M / BM; nN = N / BM; nwg = nM * nN; G = G_; c = c_; }
    __host__ __device__ bool next(int i, Unit& u) const {
        const long L = (long)i * G + c; if (L >= nwg) return false;
        int wgid = (int)L; { const int q = nwg / NXCD, r = nwg % NXCD, xcd = wgid % NXCD, off = wgid / NXCD; wgid = (xcd < r ? xcd * (q + 1) : r * (q + 1) + (xcd - r) * q) + off; }
        const int nig = WGM * nN, gid = wgid / nig, fm = gid * WGM, gsz = (nM - fm) < WGM ? (nM - fm) : WGM;
        u.pm = fm + ((wgid % nig) % gsz); u.pn = (wgid % nig) / gsz; return true;
    }
    __device__ __forceinline__ void a_ready(const Unit&) const {}
    __device__ __forceinline__ void done(const Unit&) const {}
};

__device__ __forceinline__ unsigned cvt_pk_bf16(float lo, float hi) { unsigned r; asm volatile("v_cvt_pk_bf16_f32 %0, %1, %2" : "=v"(r) : "v"(lo), "v"(hi)); return r; }
__device__ __forceinline__ float bflo(unsigned w) { return __builtin_bit_cast(float, w << 16); }
__device__ __forceinline__ float bfhi(unsigned w) { return __builtin_bit_cast(float, w & 0xffff0000u); }
__device__ __forceinline__ float sigmoidf_(float x) { return __builtin_amdgcn_rcpf(1.0f + __builtin_amdgcn_exp2f(-1.4426950408889634f * x)); }

constexpr int ZP = 6656;
constexpr int ZSP = 512;
constexpr int NZT = 26, GATE_T0 = 14;

__device__ __forceinline__ float row_rstd(const float* SS, int row) {
    const f32x4 a = *(const f32x4*)(SS + (size_t)row * 16), b = *(const f32x4*)(SS + (size_t)row * 16 + 4), c = *(const f32x4*)(SS + (size_t)row * 16 + 8), d = *(const f32x4*)(SS + (size_t)row * 16 + 12);
    const float s = ((a[0] + a[1]) + (a[2] + a[3])) + ((b[0] + b[1]) + (b[2] + b[3])) + ((c[0] + c[1]) + (c[2] + c[3])) + ((d[0] + d[1]) + (d[2] + d[3]));
    return 1.0f / __builtin_sqrtf(s * (1.0f / 1024.0f) + 1e-6f);
}
struct EpiZ {
    static constexpr bool PERM = true, AFTER_DRAIN = false;
    bf16_t* Z; float* ZS; const float* SS;
    __device__ __forceinline__ void operator()(const f32x4 (&acc)[2][2][4][2], const Unit& u, int wr, int wc, int fr, int fq) const {
        const int row0 = u.pm * BM + wr * 64 + fr;
        if (u.pn < NZT) {
            const int col0 = u.pn * BM + wc * 32 + 8 * fq;
#pragma unroll
            for (int ai = 0; ai < 2; ++ai)
#pragma unroll
                for (int m = 0; m < 4; ++m) { bf16_t* rowp = Z + (size_t)(row0 + ai * HALF + m * 16) * ZP + col0; const float rs = row_rstd(SS, row0 + ai * HALF + m * 16);
#pragma unroll
                    for (int bj = 0; bj < 2; ++bj) { f32x4 v0 = acc[ai][bj][m][0] * rs, v1 = acc[ai][bj][m][1] * rs;
                        if (u.pn >= GATE_T0) {
#pragma unroll
                            for (int i = 0; i < 4; ++i) { v0[i] = sigmoidf_(v0[i]); v1[i] = sigmoidf_(v1[i]); } }
                        u32x4 w; w.x = cvt_pk_bf16(v0[0], v0[1]); w.y = cvt_pk_bf16(v0[2], v0[3]); w.z = cvt_pk_bf16(v1[0], v1[1]); w.w = cvt_pk_bf16(v1[2], v1[3]);
                        *(u32x4*)(rowp + bj * HALF) = w; } }
        } else {
            const int col0 = (u.pn - NZT) * BM + wc * 32 + 8 * fq;
#pragma unroll
            for (int ai = 0; ai < 2; ++ai)
#pragma unroll
                for (int m = 0; m < 4; ++m) { float* rowp = ZS + (size_t)(row0 + ai * HALF + m * 16) * ZSP + col0; const float rs = row_rstd(SS, row0 + ai * HALF + m * 16);
#pragma unroll
                    for (int bj = 0; bj < 2; ++bj) { *(f32x4*)(rowp + bj * HALF) = acc[ai][bj][m][0] * rs; *(f32x4*)(rowp + bj * HALF + 4) = acc[ai][bj][m][1] * rs; } }
        }
    }
};

template <int P> struct EpiGate {
    static constexpr bool PERM = true, AFTER_DRAIN = false;
    const bf16_t* G;
    float* M32;
    bf16_t* OUT;
    __device__ __forceinline__ void operator()(const f32x4 (&acc)[2][2][4][2], const Unit& u, int wr, int wc, int fr, int fq) const {
        const int row0 = u.pm * BM + wr * 64 + fr, col0 = u.pn * BM + wc * 32 + 8 * fq;
#pragma unroll
        for (int ai = 0; ai < 2; ++ai)
#pragma unroll
            for (int m = 0; m < 4; ++m) { const size_t row = (size_t)(row0 + ai * HALF + m * 16);
#pragma unroll
                for (int bj = 0; bj < 2; ++bj) { const int col = col0 + bj * HALF;
                    const u32x4 gw = *(const u32x4*)(G + row * ZP + P * 1024 + col);
                    const f32x4 v0 = acc[ai][bj][m][0], v1 = acc[ai][bj][m][1];
                    f32x4 t0, t1;
                    t0[0] = bflo(gw.x) * v0[0]; t0[1] = bfhi(gw.x) * v0[1]; t0[2] = bflo(gw.y) * v0[2]; t0[3] = bfhi(gw.y) * v0[3];
                    t1[0] = bflo(gw.z) * v1[0]; t1[1] = bfhi(gw.z) * v1[1]; t1[2] = bflo(gw.w) * v1[2]; t1[3] = bfhi(gw.w) * v1[3];
                    float* mp = M32 + row * 1024 + col;
                    if (P == 0) { *(f32x4*)mp = t0; *(f32x4*)(mp + 4) = t1; }
                    else if (P == 1) { *(f32x4*)mp = *(const f32x4*)mp + t0; *(f32x4*)(mp + 4) = *(const f32x4*)(mp + 4) + t1; }
                    else { t0 = *(const f32x4*)mp + t0; t1 = *(const f32x4*)(mp + 4) + t1;
                        u32x4 w; w.x = cvt_pk_bf16(t0[0], t0[1]); w.y = cvt_pk_bf16(t0[2], t0[3]); w.z = cvt_pk_bf16(t1[0], t1[1]); w.w = cvt_pk_bf16(t1[2], t1[3]);
                        *(u32x4*)(OUT + row * ZP + col) = w; } } }
    }
};

struct EpiRes {
    static constexpr bool PERM = true, AFTER_DRAIN = false;
    const float* RES; float* OUT; const float* G; bf16_t* XG; float* SS;
    __device__ __forceinline__ void operator()(const f32x4 (&acc)[2][2][4][2], const Unit& u, int wr, int wc, int fr, int fq) const {
        const int row0 = u.pm * BM + wr * 64 + fr, col0 = u.pn * BM + wc * 32 + 8 * fq;
        f32x4 g[2][2];
#pragma unroll
        for (int bj = 0; bj < 2; ++bj) { g[bj][0] = *(const f32x4*)(G + col0 + bj * HALF); g[bj][1] = *(const f32x4*)(G + col0 + bj * HALF + 4); }
#pragma unroll
        for (int ai = 0; ai < 2; ++ai)
#pragma unroll
            for (int m = 0; m < 4; ++m) { const int row = row0 + ai * HALF + m * 16; const size_t off = (size_t)row * 1024 + col0; float ss = 0.f;
#pragma unroll
                for (int bj = 0; bj < 2; ++bj) { const float* rp = RES + off + bj * HALF; float* op = OUT + off + bj * HALF;
                    const f32x4 v0 = *(const f32x4*)rp + acc[ai][bj][m][0], v1 = *(const f32x4*)(rp + 4) + acc[ai][bj][m][1];
                    *(f32x4*)op = v0; *(f32x4*)(op + 4) = v1;
                    ss += ((v0[0] * v0[0] + v0[1] * v0[1]) + (v0[2] * v0[2] + v0[3] * v0[3])) + ((v1[0] * v1[0] + v1[1] * v1[1]) + (v1[2] * v1[2] + v1[3] * v1[3]));
                    const f32x4 x0 = v0 * g[bj][0], x1 = v1 * g[bj][1];
                    u32x4 w; w.x = cvt_pk_bf16(x0[0], x0[1]); w.y = cvt_pk_bf16(x0[2], x0[3]); w.z = cvt_pk_bf16(x1[0], x1[1]); w.w = cvt_pk_bf16(x1[2], x1[3]);
                    *(u32x4*)(XG + off + bj * HALF) = w; }
                ss += sx<16>(ss); { unsigned a, b; swap32(__builtin_bit_cast(unsigned, ss), a, b); ss = __builtin_bit_cast(float, a) + __builtin_bit_cast(float, b); }
                if (fq == 0) SS[(size_t)row * 16 + u.pn * 4 + wc] = ss; }
    }
};

struct EpiSwi {
    static constexpr bool PERM = true, AFTER_DRAIN = false;
    bf16_t* H; int ldh; const float* SS;
    __device__ __forceinline__ void operator()(const f32x4 (&acc)[2][2][4][2], const Unit& u, int wr, int wc, int fr, int fq) const {
        const int row0 = u.pm * BM + wr * 64 + fr, col0 = u.pn * HALF + wc * 32 + 8 * fq;
#pragma unroll
        for (int ai = 0; ai < 2; ++ai)
#pragma unroll
            for (int m = 0; m < 4; ++m) { bf16_t* hp = H + (size_t)(row0 + ai * HALF + m * 16) * ldh + col0; const float rs = row_rstd(SS, row0 + ai * HALF + m * 16);
                float o[8];
#pragma unroll
                for (int n = 0; n < 2; ++n)
#pragma unroll
                    for (int i = 0; i < 4; ++i) { const float g = acc[ai][0][m][n][i] * rs, up = acc[ai][1][m][n][i] * rs; o[4 * n + i] = g * sigmoidf_(g) * up; }
                u32x4 w; w.x = cvt_pk_bf16(o[0], o[1]); w.y = cvt_pk_bf16(o[2], o[3]); w.z = cvt_pk_bf16(o[4], o[5]); w.w = cvt_pk_bf16(o[6], o[7]);
                *(u32x4*)hp = w; }
    }
};

template <class Epi, class Sched, bool ALIGN_EPI = false, bool SP2 = false>
__device__ __forceinline__ void gemm_phase(PG8_LAS unsigned char* lds, Gemm g, const Sched& S0, const Epi& E, int wave_id) {
    int ovz, osz; asm volatile("v_mov_b32 %0, 0\n\ts_mov_b32 %1, 0" : "=v"(ovz), "=s"(osz));
    Sched S = S0; S.c += osz; g.lda += osz; g.ldb += osz;
    const int tid = ((wave_id << 6) | lane_id_v()) + ovz,
         wid = __builtin_amdgcn_readfirstlane(tid >> 6), lane = tid & 63, wr = wid >> 2, wc = wid & 3, fr = lane & 15, fq = lane >> 4;
    const int K = g.K, nt = K / BK;
    unsigned voffA[2], voffB[2];
#pragma unroll
    for (int i = 0; i < 2; ++i) { int R, C; stage_rc(tid * 16 + i * 8192, R, C); const int Rb = Epi::PERM ? ((R & ~31) + perm32(R & 31)) : R;
        voffA[i] = (unsigned)(R * g.lda + C) * 2u; voffB[i] = (unsigned)(Rb * g.ldb + C) * 2u; }
    const size_t kstep = (size_t)(BK * 2);
    const size_t hstepA = (size_t)HALF * g.lda * 2, hstepB = (size_t)HALF * g.ldb * 2;
    const size_t tstepA = 2 * hstepA, tstepB = 2 * hstepB;
    const unsigned ldsw = (unsigned)wid * 1024u;
    const int aoff = lds_byte(wr * 64 + fr, fq * 8), boff = lds_byte(wc * 32 + fr, fq * 8);
#define PG8_SA(b, h) (((b) * 2 + (h)) * HTB)
#define PG8_SB(b, h) ((4 + (b) * 2 + (h)) * HTB)
#define PG8_STAGE(bufoff, gbase, voff) do { _Pragma("unroll") for (int _i = 0; _i < 2; ++_i) \
        __builtin_amdgcn_global_load_lds((const unsigned*)((const char*)(gbase) + (voff)[_i]), (PG8_LAS unsigned*)(lds + (bufoff) + ldsw + _i * 8192), 16, 0, 0); } while (0)
#define PG8_LDA(dst, b, h) do { _Pragma("unroll") for (int m = 0; m < 4; ++m) _Pragma("unroll") for (int k = 0; k < 2; ++k) dst[m][k] = *(const PG8_LAS bf16x8*)(lds + PG8_SA(b, h) + aoff + m * 2048 + k * 1024); } while (0)
#define PG8_LDB(dst, b, h) do { _Pragma("unroll") for (int n = 0; n < 2; ++n) _Pragma("unroll") for (int k = 0; k < 2; ++k) dst[n][k] = *(const PG8_LAS bf16x8*)(lds + PG8_SB(b, h) + boff + n * 2048 + k * 1024); } while (0)
#define PG8_MMA(ai, bj, At, Bt) do { __builtin_amdgcn_s_setprio(1); _Pragma("unroll") for (int m = 0; m < 4; ++m) _Pragma("unroll") for (int n = 0; n < 2; ++n) _Pragma("unroll") for (int k = 0; k < 2; ++k) \
        acc[ai][bj][m][n] = __builtin_amdgcn_mfma_f32_16x16x32_bf16(Bt[n][k], At[m][k], acc[ai][bj][m][n], 0, 0, 0); __builtin_amdgcn_s_setprio(0); } while (0)
#define PG8_WAIT_V(n) asm volatile("s_waitcnt vmcnt(" #n ")" ::: "memory")
#define PG8_WAIT_L(n) asm volatile("s_waitcnt lgkmcnt(" #n ")" ::: "memory")
#define PG8_BAR __builtin_amdgcn_s_barrier()
#define PG8_SCHED __builtin_amdgcn_sched_barrier(0)
    Unit cur, nxt; int ui = 0;
    if (!S.next(0, cur)) return;
    f32x4 acc[2][2][4][2];
#pragma unroll
    for (int a = 0; a < 2; ++a)
#pragma unroll
        for (int b = 0; b < 2; ++b)
#pragma unroll
            for (int m = 0; m < 4; ++m)
#pragma unroll
                for (int n = 0; n < 2; ++n) acc[a][b][m][n] = (f32x4){0.f, 0.f, 0.f, 0.f};
    bf16x8 At[4][2], B0[2][2], B1[2][2];
    const char* cA = (const char*)g.A + (size_t)cur.pm * tstepA; const char* cB = (const char*)g.Bt + (size_t)cur.pn * tstepB;
    S.a_ready(cur);
    if constexpr (SP2) {
        PG8_STAGE(PG8_SB(0, 0), cB, voffB); PG8_STAGE(PG8_SB(0, 1), cB + hstepB, voffB); PG8_STAGE(PG8_SA(0, 0), cA, voffA); PG8_STAGE(PG8_SA(0, 1), cA + hstepA, voffA);
        if (wr == 1) PG8_BAR;
        PG8_WAIT_V(2); PG8_BAR;
        PG8_STAGE(PG8_SB(1, 0), cB + kstep, voffB); PG8_STAGE(PG8_SA(1, 0), cA + kstep, voffA); PG8_STAGE(PG8_SB(1, 1), cB + hstepB + kstep, voffB);
        PG8_WAIT_V(6); PG8_BAR;
    } else {
        PG8_STAGE(PG8_SB(0, 0), cB, voffB); PG8_STAGE(PG8_SA(0, 0), cA, voffA); PG8_STAGE(PG8_SB(0, 1), cB + hstepB, voffB); PG8_STAGE(PG8_SA(0, 1), cA + hstepA, voffA);
        if (wr == 1) PG8_BAR;
        PG8_WAIT_V(4); PG8_BAR;
        PG8_STAGE(PG8_SB(1, 0), cB + kstep, voffB); PG8_STAGE(PG8_SA(1, 0), cA + kstep, voffA); PG8_STAGE(PG8_SB(1, 1), cB + hstepB + kstep, voffB);
        PG8_WAIT_V(6); PG8_BAR;
    }
    for (;;) {
        const bool has_next = S.next(ui + 1, nxt);
        const char* nA = has_next ? (const char*)g.A + (size_t)nxt.pm * tstepA : cA; const char* nB = has_next ? (const char*)g.Bt + (size_t)nxt.pn * tstepB : cB;
        for (int t = 0; t < nt; t += 2) {
            const bool last = (t == nt - 2);
            const char* a1 = cA + (size_t)(t + 1) * kstep;
            const char* a2 = last ? nA : cA + (size_t)(t + 2) * kstep; const char* b2 = last ? nB : cB + (size_t)(t + 2) * kstep;
            const char* a3 = a2 + kstep; const char* b3 = b2 + kstep;
            if (last && has_next) S.a_ready(nxt);
            if constexpr (SP2) {
            PG8_LDB(B0, 0, 0); PG8_LDB(B1, 0, 1); PG8_SCHED; PG8_LDA(At, 0, 0); PG8_STAGE(PG8_SA(1, 1), a1 + hstepA, voffA);
            PG8_WAIT_V(8); PG8_WAIT_L(0); PG8_BAR; PG8_MMA(0, 0, At, B0); PG8_MMA(0, 1, At, B1); PG8_BAR; PG8_SCHED;
            PG8_LDA(At, 0, 1); PG8_STAGE(PG8_SB(0, 0), b2, voffB); PG8_STAGE(PG8_SB(0, 1), b2 + hstepB, voffB); PG8_STAGE(PG8_SA(0, 0), a2, voffA);
            PG8_WAIT_V(8); PG8_WAIT_L(0); PG8_BAR; PG8_MMA(1, 0, At, B0); PG8_MMA(1, 1, At, B1); PG8_BAR; PG8_SCHED;
            PG8_LDB(B0, 1, 0); PG8_LDB(B1, 1, 1); PG8_SCHED; PG8_LDA(At, 1, 0); PG8_STAGE(PG8_SA(0, 1), a2 + hstepA, voffA);
            PG8_WAIT_V(8); PG8_WAIT_L(0); PG8_BAR; PG8_MMA(0, 0, At, B0); PG8_MMA(0, 1, At, B1); PG8_BAR; PG8_SCHED;
            PG8_LDA(At, 1, 1); PG8_STAGE(PG8_SB(1, 0), b3, voffB); PG8_STAGE(PG8_SB(1, 1), b3 + hstepB, voffB); PG8_STAGE(PG8_SA(1, 0), a3, voffA);
            PG8_WAIT_V(8); PG8_WAIT_L(0); PG8_BAR; PG8_MMA(1, 0, At, B0); PG8_MMA(1, 1, At, B1); PG8_BAR; PG8_SCHED;
            } else {
            PG8_LDB(B0, 0, 0); PG8_SCHED; PG8_LDA(At, 0, 0); PG8_STAGE(PG8_SA(1, 1), a1 + hstepA, voffA);
            PG8_WAIT_L(8); PG8_BAR; PG8_WAIT_L(0); PG8_MMA(0, 0, At, B0); PG8_BAR; PG8_SCHED;
            PG8_LDB(B1, 0, 1); PG8_STAGE(PG8_SB(0, 0), b2, voffB);
            PG8_BAR; PG8_WAIT_L(0); PG8_MMA(0, 1, At, B1); PG8_BAR;
            PG8_LDA(At, 0, 1); PG8_STAGE(PG8_SA(0, 0), a2, voffA);
            PG8_BAR; PG8_WAIT_L(0); PG8_MMA(1, 0, At, B0); PG8_BAR; PG8_SCHED;
            PG8_STAGE(PG8_SB(0, 1), b2 + hstepB, voffB);
            PG8_WAIT_V(6); PG8_BAR; PG8_MMA(1, 1, At, B1); PG8_BAR;
            PG8_LDB(B0, 1, 0); PG8_SCHED; PG8_LDA(At, 1, 0); PG8_STAGE(PG8_SA(0, 1), a2 + hstepA, voffA);
            PG8_WAIT_L(8); PG8_BAR; PG8_WAIT_L(0); PG8_MMA(0, 0, At, B0); PG8_BAR; PG8_SCHED;
            PG8_LDB(B1, 1, 1); PG8_STAGE(PG8_SB(1, 0), b3, voffB);
            PG8_BAR; PG8_WAIT_L(0); PG8_MMA(0, 1, At, B1); PG8_BAR;
            PG8_LDA(At, 1, 1); PG8_STAGE(PG8_SA(1, 0), a3, voffA);
            PG8_BAR; PG8_WAIT_L(0); PG8_MMA(1, 0, At, B0); PG8_BAR; PG8_SCHED;
            PG8_STAGE(PG8_SB(1, 1), b3 + hstepB, voffB);
            PG8_WAIT_V(6); PG8_BAR; PG8_MMA(1, 1, At, B1); PG8_BAR;
            }
        }
        if constexpr (ALIGN_EPI) { if (wr == 0) PG8_BAR; }
        if constexpr (!Epi::AFTER_DRAIN) { E(acc, cur, wr, wc, fr, fq); S.done(cur); }
        if (!has_next) break;
#pragma unroll
        for (int a = 0; a < 2; ++a)
#pragma unroll
            for (int b = 0; b < 2; ++b)
#pragma unroll
                for (int m = 0; m < 4; ++m)
#pragma unroll
                    for (int n = 0; n < 2; ++n) acc[a][b][m][n] = (f32x4){0.f, 0.f, 0.f, 0.f};
        cur = nxt; cA = nA; cB = nB; ++ui;
        if constexpr (ALIGN_EPI) { if (wr == 1) PG8_BAR; }
    }
    PG8_WAIT_V(0);
    if constexpr (!ALIGN_EPI) { if (wr == 0) PG8_BAR; }
    PG8_BAR;
    if constexpr (Epi::AFTER_DRAIN) { E.fused(acc, cur, wr, wc, fr, fq, lds, wid, lane); S.done(cur); }
#undef PG8_SA
#undef PG8_SB
#undef PG8_STAGE
#undef PG8_LDA
#undef PG8_LDB
#undef PG8_MMA
#undef PG8_WAIT_V
#undef PG8_WAIT_L
#undef PG8_BAR
#undef PG8_SCHED
}
}

constexpr int NB = 4, SEQ = 4096, DM = 1024, DEPTH = 4, M = NB * SEQ;
constexpr int INC = 7088;
constexpr int NIN = 7168;
constexpr int FFH = 2816, FF2 = 5632;
constexpr int ZP = pg8::ZP, ZSP = pg8::ZSP;
constexpr int Z_FQ = 0, Z_FK = 512, Z_FV = 1024, Z_DQ = 1536, Z_RV = 2048, Z_RQ = 2560, Z_RK = 2816, Z_RG = 3072, Z_ZG = 3584, Z_MRG = 2560;
constexpr int S_IQ = 0, S_DK = 256, S_DV = 320, S_IK = 384, S_IW = 416, S_FF = 424;
constexpr float NORM_EPS = 1e-6f;
constexpr float LOG2E = 1.4426950408889634f;
constexpr float C2 = 0.125f * 1.4426950408889634f;

constexpr size_t MiB = 1u << 20;
constexpr size_t WS_CTL = 0, CTL_ZERO_BYTES = 1 * MiB;
constexpr size_t WS_ROPE64 = 1 * MiB;
constexpr size_t WS_ROPE32 = 2 * MiB;
constexpr size_t WS_LF = 2 * MiB + 512 * 1024;
constexpr size_t WS_CF = 3 * MiB;
constexpr size_t WS_ISG = 3 * MiB + 512 * 1024;
constexpr size_t WS_KD = 4 * MiB;
constexpr size_t WS_VD = 6 * MiB;
constexpr size_t WS_W = 8 * MiB;
constexpr size_t LW_IN = 0, LW_MIX = (size_t)NIN * 1024, LW_O = LW_MIX + 1536 * 1024, LW_FI = LW_O + 1024 * 1024, LW_FO = LW_FI + (size_t)FF2 * 1024, LW_STRIDE = LW_FO + (size_t)FFH * 1024;
constexpr size_t WS_Z = 150 * MiB;
constexpr size_t WS_HDN = 358 * MiB;
constexpr size_t WS_ZS = 390 * MiB;
constexpr size_t WS_IQB = 422 * MiB;
constexpr size_t WS_IKB = 430 * MiB;
constexpr size_t WS_SS = 431 * MiB;
constexpr size_t WS_END = 432 * MiB;
static_assert(WS_W + DEPTH * LW_STRIDE * 2 <= WS_Z && WS_Z + (size_t)M * ZP * 2 <= WS_HDN && WS_HDN + (size_t)M * 1024 * 2 == WS_ZS && WS_ZS + (size_t)M * ZSP * 4 == WS_IQB, "d_ws map");
constexpr int CW_BAR = 4096;

constexpr int RING_OFF = 0, RING_BYTES = 133120;
constexpr int LDSCTL_OFF = RING_BYTES, MISC_OFF = LDSCTL_OFF + 320;
constexpr int XTRA_OFF = RING_BYTES + 1024;
constexpr int LDS_BYTES = 147456;
constexpr int NWAVES = 8;
#define GAS __attribute__((address_space(1)))
#define LAS __attribute__((address_space(3)))
typedef unsigned short bf16;
typedef unsigned v4u __attribute__((ext_vector_type(4)));
typedef float f32x4 __attribute__((ext_vector_type(4)));
typedef short bf16x8 __attribute__((ext_vector_type(8)));
typedef GAS unsigned gu32;
typedef GAS unsigned long long gu64;
#define RLX_AGENT __ATOMIC_RELAXED, __HIP_MEMORY_SCOPE_AGENT
#define LDS_WAIT() asm volatile("s_waitcnt lgkmcnt(0)" ::: "memory")
#define VM_WAIT() asm volatile("s_waitcnt vmcnt(0)" ::: "memory")
__device__ __forceinline__ unsigned long long rt() { return __builtin_amdgcn_s_memrealtime(); }
__device__ __forceinline__ unsigned f2bf(float f) { unsigned u = __builtin_bit_cast(unsigned, f); return (u + 0x7fffu + ((u >> 16) & 1u)) >> 16; }
__device__ __forceinline__ unsigned pk2(float lo, float hi) { return f2bf(lo) | (f2bf(hi) << 16); }

#define XB_TMO      128
#define XB_XCNT(j)  (256  + 64 * (j))
#define XB_XSUB(j)  (1280 + 64 * (j))
#define XB_XGEN(j)  (2304 + 64 * (j))
#define XB_TOP      3328
#define XB_TOPGEN   3392
#define XCD_BAR_WORDS 3456
#define XB_SPIN_CAP (1u << 22)

__device__ __forceinline__ unsigned xb_ld(unsigned* p)              { return __hip_atomic_load(p, __ATOMIC_RELAXED, __HIP_MEMORY_SCOPE_AGENT); }
__device__ __forceinline__ unsigned xb_add(unsigned* p, unsigned v) { return __hip_atomic_fetch_add(p, v, __ATOMIC_RELAXED, __HIP_MEMORY_SCOPE_AGENT); }
__device__ __forceinline__ unsigned xb_xcc_id() { return (unsigned)__builtin_amdgcn_s_getreg((3 << 11) | 20) & 0xFu; }
#define XB_SPIN(cond, bar) do { unsigned _sp = 0; while (cond) { __builtin_amdgcn_s_sleep(1); \
    if ((++_sp & 255u) == 0u) { if (xb_ld(&(bar)[XB_TMO])) break; if (_sp > XB_SPIN_CAP) { atomicAdd(&(bar)[XB_TMO], 1u); break; } } } } while (0)

struct XcdBarrier {
    unsigned* bar; unsigned x; int w;
    volatile LAS unsigned* st;
};

__device__ __forceinline__ XcdBarrier xcd_barrier_post(unsigned* bar, volatile LAS unsigned* st) {
    XcdBarrier b; b.bar = bar; b.x = xb_xcc_id(); b.st = st; b.w = 0;
    if (threadIdx.x == 0) (void)xb_add(&bar[XB_XCNT(b.x)], 1u);
    return b;
}
__device__ __forceinline__ void xcd_barrier_complete(unsigned* bar, unsigned x, unsigned& nloc, unsigned& nx) {
    const unsigned G = gridDim.x * gridDim.y * gridDim.z;
    unsigned sum, cnt, mine, sp = 0u;
    for (;;) {
        sum = 0u; cnt = 0u; mine = 0u;
#pragma unroll
        for (unsigned j = 0; j < 16; ++j) { const unsigned c = xb_ld(&bar[XB_XCNT(j)]); sum += c; cnt += (c > 0u) ? 1u : 0u; mine = (j == x) ? c : mine; }
        if (sum == G) break;
        __builtin_amdgcn_s_sleep(1);
        if ((++sp & 255u) == 0u) { if (xb_ld(&bar[XB_TMO])) break; if (sp > XB_SPIN_CAP) { atomicAdd(&bar[XB_TMO], 1u); break; } }
    }
    nloc = mine > 0u ? mine : 1u; nx = cnt > 0u ? cnt : 1u;
}

__device__ __forceinline__ void xcd_barrier(const XcdBarrier& b) {
    asm volatile("s_waitcnt vmcnt(0)" ::: "memory");
    __syncthreads();
    if (b.w == 0 && lane_id_v() == 0) {
        unsigned* bar = b.bar;
        __builtin_amdgcn_s_waitcnt(0);
        unsigned nloc = b.st[0], nx = b.st[1];
        if (nloc == 0u) { xcd_barrier_complete(bar, b.x, nloc, nx); b.st[0] = nloc; b.st[1] = nx; }
        const unsigned old = xb_add(&bar[XB_XSUB(b.x)], 1u);
        const unsigned gen = old / nloc;
        if (old + 1u == (gen + 1u) * nloc) {
            __builtin_amdgcn_fence(__ATOMIC_RELEASE, "agent");
            asm volatile("s_waitcnt vmcnt(0)" ::: "memory");
            const unsigned og = xb_add(&bar[XB_TOP], 1u);
            const unsigned tg = og / nx;
            if (og + 1u == (tg + 1u) * nx) xb_add(&bar[XB_TOPGEN], 1u);
            else XB_SPIN(xb_ld(&bar[XB_TOPGEN]) == tg, bar);
            __builtin_amdgcn_fence(__ATOMIC_ACQUIRE, "agent");
            xb_add(&bar[XB_XGEN(b.x)], 1u);
            asm volatile("s_waitcnt vmcnt(0)" ::: "memory");
        } else {
            XB_SPIN(xb_ld(&bar[XB_XGEN(b.x)]) == gen, bar);
            __builtin_amdgcn_fence(__ATOMIC_ACQUIRE, "agent");
            asm volatile("s_waitcnt vmcnt(0)" ::: "memory");
        }
    }
    __syncthreads();
}

typedef float f32x2 __attribute__((ext_vector_type(2)));
typedef unsigned u32x2 __attribute__((ext_vector_type(2)));
__device__ __forceinline__ float bflo(unsigned w) { return __builtin_bit_cast(float, w << 16); }
__device__ __forceinline__ float bfhi(unsigned w) { return __builtin_bit_cast(float, w & 0xffff0000u); }
__device__ __forceinline__ float bf2f(bf16 v) { return __builtin_bit_cast(float, (unsigned)v << 16); }
__device__ __forceinline__ void unpack8(const v4u w, float (&f)[8]) { f[0] = bflo(w.x); f[1] = bfhi(w.x); f[2] = bflo(w.y); f[3] = bfhi(w.y); f[4] = bflo(w.z); f[5] = bfhi(w.z); f[6] = bflo(w.w); f[7] = bfhi(w.w); }
__device__ __forceinline__ v4u pack8(const float (&f)[8]) { v4u w; w.x = pk2(f[0], f[1]); w.y = pk2(f[2], f[3]); w.z = pk2(f[4], f[5]); w.w = pk2(f[6], f[7]); return w; }
__device__ __forceinline__ float xor32(float v, int lane) {
    return __builtin_bit_cast(float, __builtin_amdgcn_ds_bpermute((lane ^ 32) << 2, __builtin_bit_cast(int, v)));
}
__device__ __forceinline__ float sigmoid_f(float x) { return 1.0f / (1.0f + __expf(-x)); }

struct Ctx {
    LAS unsigned char* lds;
    int tid, lane, wave, G, gw, NGW;
    float* out; unsigned char* ws;
};

__device__ __forceinline__ void conv_item(const float* W, int N, int sc, int nv, int k0, bf16* WT, int ldw, int dr, LAS float* scr, int lane) {
    const int n_ = lane & 31;
#pragma unroll 8
    for (int i = 0; i < 32; ++i) { const int kk = 2 * i + (lane >> 5); scr[kk * 33 + n_] = (n_ < nv) ? W[(size_t)(k0 + kk) * N + sc + n_] : 0.f; }
    LDS_WAIT(); asm volatile("" ::: "memory");
    const int c = lane & 7;
#pragma unroll
    for (int j = 0; j < 4; ++j) { const int n = (lane >> 3) + 8 * j; const LAS float* s = scr + (8 * c) * 33 + n;
        v4u o; o.x = pk2(s[0 * 33], s[1 * 33]); o.y = pk2(s[2 * 33], s[3 * 33]); o.z = pk2(s[4 * 33], s[5 * 33]); o.w = pk2(s[6 * 33], s[7 * 33]);
        if (n < nv) *(GAS v4u*)(WT + (size_t)(dr + n) * ldw + k0 + 8 * c) = o; }
    LDS_WAIT(); asm volatile("" ::: "memory");
}
__device__ const int SEG_IN[15][3] = {
    {0, 0, 512}, {512, 512, 512}, {1024, 1024, 512}, {1536, 6656 + S_FF, 8}, {1544, Z_DQ, 512}, {2056, 6656 + S_DK, 64}, {2120, 6656 + S_DV, 64},
    {2184, 6656 + S_IQ, 256}, {2440, 6656 + S_IK, 32}, {2472, 6656 + S_IW, 8}, {2480, Z_RQ, 256}, {2736, Z_RK, 256}, {2992, Z_RV, 512}, {3504, Z_RG, 512}, {4016, Z_ZG, 3072}};
constexpr int IN_BLK = 223;
constexpr int IT_IN = 16 * IN_BLK, IT_MIX = 8 * 32, IT_O = 16 * 32, IT_FI = 16 * (FF2 / 32), IT_FO = (FFH / 64) * 32;
constexpr int IT_LAYER = IT_IN + 3 * IT_MIX + IT_O + IT_FI + IT_FO;

__device__ __forceinline__ void sincos_acc(float ang, float& c, float& s) {
    const double a = (double)ang;
    const double k = __builtin_rint(a * 0.6366197723675814);
    double y = a - k * 1.5707963267948966; y -= k * 6.123233995736766e-17;
    const double y2 = y * y;
    double sp = -7.647163731819816e-13; sp = sp * y2 + 1.6059043836821613e-10; sp = sp * y2 - 2.505210838544172e-08; sp = sp * y2 + 2.7557319223985893e-06; sp = sp * y2 - 1.984126984126984e-04; sp = sp * y2 + 8.333333333333333e-03; sp = sp * y2 - 1.6666666666666666e-01;
    const double sn = y + y * y2 * sp;
    double cp = 4.779477332387385e-14; cp = cp * y2 - 1.1470745597729725e-11; cp = cp * y2 + 2.08767569878681e-09; cp = cp * y2 - 2.755731922398589e-07; cp = cp * y2 + 2.48015873015873e-05; cp = cp * y2 - 1.388888888888889e-03; cp = cp * y2 + 4.1666666666666664e-02; cp = cp * y2 - 0.5;
    const double cs = 1.0 + y2 * cp;
    const int q = ((int)k) & 3;
    const double ss = (q & 1) ? cs : sn, cc = (q & 1) ? sn : cs;
    s = (float)((q & 2) ? -ss : ss);
    c = (float)(((q + 1) & 2) ? -cc : cc);
}

__device__ __forceinline__ void p0_prologue(const Ctx& F, const float* w_in, const float* w_fox, const float* w_dsa, const float* w_ret, const float* w_o, const float* w_fi, const float* w_fo) {
    LAS float* scr = (LAS float*)(F.lds + RING_OFF + F.wave * 16384);
    bf16* Wb = (bf16*)(F.ws + WS_W);
    for (int it = F.gw; it < DEPTH * IT_LAYER; it += F.NGW) {
        const int l = it / IT_LAYER; int r = it % IT_LAYER;
        bf16* L = Wb + (size_t)l * LW_STRIDE;
        if (r < IT_IN) {
            const int kb = r / IN_BLK; int blk = r % IN_BLK; int sc = 0, dr = 0, nv = 0;
            for (int s = 0; s < 15; ++s) { const int w = SEG_IN[s][2], nb = (w + 31) >> 5; if (blk < nb) { sc = SEG_IN[s][0] + 32 * blk; dr = SEG_IN[s][1] + 32 * blk; nv = (w - 32 * blk) < 32 ? (w - 32 * blk) : 32; break; } blk -= nb; }
            conv_item(w_in + (size_t)l * DM * INC, INC, sc, nv, 64 * kb, L + LW_IN, 1024, dr, scr, F.lane); continue; }
        r -= IT_IN;
        if (r < 3 * IT_MIX) { const int w = r / IT_MIX, q = r % IT_MIX, kb = q / 32, nb = q % 32;
            conv_item((w == 0 ? w_fox : w == 1 ? w_dsa : w_ret) + (size_t)l * 512 * DM, DM, 32 * nb, 32, 64 * kb, L + LW_MIX + (size_t)w * 512 * 1024, 512, 32 * nb, scr, F.lane); continue; }
        r -= 3 * IT_MIX;
        if (r < IT_O) { const int kb = r / 32, nb = r % 32;
            conv_item(w_o + (size_t)l * DM * DM, DM, 32 * nb, 32, 64 * kb, L + LW_O, 1024, 32 * nb, scr, F.lane); continue; }
        r -= IT_O;
        if (r < IT_FI) { const int kb = r / (FF2 / 32), nb = r % (FF2 / 32); const int n0 = 32 * nb;
            const int j = n0 < FFH ? n0 : n0 - FFH; const int dr = 256 * (j >> 7) + (j & 127) + (n0 < FFH ? 0 : 128);
            conv_item(w_fi + (size_t)l * DM * FF2, FF2, n0, 32, 64 * kb, L + LW_FI, 1024, dr, scr, F.lane); continue; }
        r -= IT_FI;
        { const int kb = r / 32, nb = r % 32;
            conv_item(w_fo + (size_t)l * FFH * DM, DM, 32 * nb, 32, 64 * kb, L + LW_FO, FFH, 32 * nb, scr, F.lane); }
    }
    for (int i = F.gw * 64 + F.lane; i < DEPTH * 80 * 128; i += F.NGW * 64) { const int l = i / (80 * 128), q = i % (80 * 128);
        *(GAS v4u*)(Wb + (size_t)l * LW_STRIDE + LW_IN + (size_t)INC * 1024 + (size_t)q * 8) = (v4u){0u, 0u, 0u, 0u}; }
    f32x2* R64 = (f32x2*)(F.ws + WS_ROPE64); f32x2* R32 = (f32x2*)(F.ws + WS_ROPE32);
    for (int i = F.gw * 64 + F.lane; i < SEQ * 32; i += F.NGW * 64) { const int pos = i >> 5, k = i & 31;
        double f = 1.0; for (int e = 0; e < k; ++e) f *= 0.7498942093324559;
        const float ang = (float)pos * (float)f; float c, s; sincos_acc(ang, c, s); R64[i] = (f32x2){c, s}; }
    for (int i = F.gw * 64 + F.lane; i < SEQ * 16; i += F.NGW * 64) { const int pos = i >> 4, k = i & 15;
        double f = 1.0; for (int e = 0; e < k; ++e) f *= 0.5623413251903491;
        const float ang = (float)pos * (float)f; float c, s; sincos_acc(ang, c, s); R32[i] = (f32x2){c, s}; }
}

__device__ __forceinline__ void norm0_phase(const Ctx& F, const float* x, const float* g, bf16* o, float* SS) {
    const GAS f32x4* gp = (const GAS f32x4*)g + F.lane;
    f32x4 gv[4];
#pragma unroll
    for (int j = 0; j < 4; ++j) gv[j] = gp[64 * j];
    for (int m = F.gw; m < M; m += F.NGW) {
        const GAS f32x4* xr = (const GAS f32x4*)(x + (size_t)m * DM) + F.lane;
        f32x4 v[4]; float s = 0.f;
#pragma unroll
        for (int j = 0; j < 4; ++j) { v[j] = xr[64 * j]; s += (v[j].x * v[j].x + v[j].y * v[j].y) + (v[j].z * v[j].z + v[j].w * v[j].w); }
        s = wave_sum(s);
        GAS unsigned long long* o8 = (GAS unsigned long long*)(o + (size_t)m * DM) + F.lane;
#pragma unroll
        for (int j = 0; j < 4; ++j) o8[64 * j] = (unsigned long long)pk2(v[j].x * gv[j].x, v[j].y * gv[j].y) | ((unsigned long long)pk2(v[j].z * gv[j].z, v[j].w * gv[j].w) << 32);
        if (F.lane < 16) SS[(size_t)m * 16 + F.lane] = (F.lane == 0) ? s : 0.f;
    }
}

__device__ __forceinline__ void post_phase(const Ctx& F, const float* g_fq, const float* g_fk, const float* g_dq, const float* g_dk, const float* b_f, bool dummy_out = false) {
    bf16* Z = (bf16*)(F.ws + WS_Z); const float* ZS = (const float*)(F.ws + WS_ZS);
    const f32x2* R64 = (const f32x2*)(F.ws + WS_ROPE64); const f32x2* R32 = (const f32x2*)(F.ws + WS_ROPE32);
    float* LF = (float*)(F.ws + WS_LF); unsigned* ISG = (unsigned*)(F.ws + WS_ISG);
    bf16* KD = (bf16*)(F.ws + WS_KD); bf16* VD = (bf16*)(F.ws + WS_VD); bf16* IQB = (bf16*)(F.ws + WS_IQB); bf16* IKB = (bf16*)(F.ws + WS_IKB);
    const int t0 = blockIdx.x * 512 + F.tid, NT = F.G * 512;
#pragma unroll 1
    for (int seg = 0; seg < 3; ++seg) {
        const int col = (seg == 0) ? Z_FQ : (seg == 1) ? Z_FK : Z_DQ; const float* gp = (seg == 0) ? g_fq : (seg == 1) ? g_fk : g_dq; const float osc = (seg == 1) ? 1.0f : C2;
        for (int t = t0; t < M * 8; t += NT) { const int m = t >> 3, h = t & 7; bf16* p = Z + (size_t)m * ZP + col + h * 64;
            v4u w[8];
#pragma unroll
            for (int i = 0; i < 8; ++i) w[i] = *(const GAS v4u*)(p + 8 * i);
            float f[64]; float ss = 0.f;
#pragma unroll
            for (int i = 0; i < 8; ++i) { float t8[8]; unpack8(w[i], t8);
#pragma unroll
                for (int j = 0; j < 8; ++j) { f[8 * i + j] = t8[j]; ss += t8[j] * t8[j]; } }
            const float rs = osc / sqrtf(ss * (1.f / 64) + NORM_EPS);
#pragma unroll
            for (int d = 0; d < 64; ++d) f[d] = f[d] * rs * gp[d];
            if (seg == 2) { const f32x2* cs = R64 + (m & (SEQ - 1)) * 32;
#pragma unroll
                for (int d = 0; d < 32; ++d) { const f32x2 tt = cs[d]; const float x1 = f[d], x2 = f[d + 32]; f[d] = x1 * tt.x - x2 * tt.y; f[d + 32] = x2 * tt.x + x1 * tt.y; } }
#pragma unroll
            for (int i = 0; i < 8; ++i) { float t8[8];
#pragma unroll
                for (int j = 0; j < 8; ++j) t8[j] = f[8 * i + j];
                *(GAS v4u*)((dummy_out ? (bf16*)(F.ws + WS_HDN + 16 * MiB) + (size_t)m * 512 + h * 64 : p) + 8 * i) = pack8(t8); }
        }
    }
    for (int t = t0; t < M * 8; t += NT) { const int m = t >> 3, h = t & 7; const float* sp = ZS + (size_t)m * ZSP + S_IQ + h * 32;
        f32x4 v[8];
#pragma unroll
        for (int i = 0; i < 8; ++i) v[i] = *(const GAS f32x4*)(sp + 4 * i);
        const float aw = fabsf(ZS[(size_t)m * ZSP + S_IW + h]);
        const f32x2* cs = R32 + (m & (SEQ - 1)) * 16; float f[32];
#pragma unroll
        for (int i = 0; i < 8; ++i) { f[4 * i] = v[i].x; f[4 * i + 1] = v[i].y; f[4 * i + 2] = v[i].z; f[4 * i + 3] = v[i].w; }
#pragma unroll
        for (int d = 0; d < 16; ++d) { const f32x2 tt = cs[d]; const float x1 = f[d], x2 = f[d + 16]; f[d] = (x1 * tt.x - x2 * tt.y) * aw; f[d + 16] = (x2 * tt.x + x1 * tt.y) * aw; }
        bf16* op = IQB + (size_t)m * 256 + h * 32;
#pragma unroll
        for (int i = 0; i < 4; ++i) { float t8[8];
#pragma unroll
            for (int j = 0; j < 8; ++j) t8[j] = f[8 * i + j];
            *(GAS v4u*)(op + 8 * i) = pack8(t8); }
    }
    for (int m = t0; m < M; m += NT) { const float* sr = ZS + (size_t)m * ZSP; const int pos = m & (SEQ - 1);
        { float f[64]; float ss = 0.f;
#pragma unroll
            for (int i = 0; i < 16; ++i) { const f32x4 v = *(const GAS f32x4*)(sr + S_DK + 4 * i); f[4 * i] = v.x; f[4 * i + 1] = v.y; f[4 * i + 2] = v.z; f[4 * i + 3] = v.w; ss += (v.x * v.x + v.y * v.y) + (v.z * v.z + v.w * v.w); }
            const float rs = 1.0f / sqrtf(ss * (1.f / 64) + NORM_EPS); const f32x2* cs = R64 + pos * 32;
#pragma unroll
            for (int d = 0; d < 64; ++d) f[d] = f[d] * rs * g_dk[d];
#pragma unroll
            for (int d = 0; d < 32; ++d) { const f32x2 tt = cs[d]; const float x1 = f[d], x2 = f[d + 32]; f[d] = x1 * tt.x - x2 * tt.y; f[d + 32] = x2 * tt.x + x1 * tt.y; }
#pragma unroll
            for (int i = 0; i < 8; ++i) { float t8[8];
#pragma unroll
                for (int j = 0; j < 8; ++j) t8[j] = f[8 * i + j];
                *(GAS v4u*)(KD + (size_t)m * 64 + 8 * i) = pack8(t8); } }
#pragma unroll
        for (int i = 0; i < 8; ++i) { const f32x4 a = *(const GAS f32x4*)(sr + S_DV + 8 * i), b = *(const GAS f32x4*)(sr + S_DV + 8 * i + 4); const float t8[8] = {a.x, a.y, a.z, a.w, b.x, b.y, b.z, b.w};
            *(GAS v4u*)(VD + (size_t)m * 64 + 8 * i) = pack8(t8); }
        { float f[32]; const f32x2* cs = R32 + pos * 16;
#pragma unroll
            for (int i = 0; i < 8; ++i) { const f32x4 v = *(const GAS f32x4*)(sr + S_IK + 4 * i); f[4 * i] = v.x; f[4 * i + 1] = v.y; f[4 * i + 2] = v.z; f[4 * i + 3] = v.w; }
#pragma unroll
            for (int d = 0; d < 16; ++d) { const f32x2 tt = cs[d]; const float x1 = f[d], x2 = f[d + 16]; f[d] = x1 * tt.x - x2 * tt.y; f[d + 16] = x2 * tt.x + x1 * tt.y; }
#pragma unroll
            for (int i = 0; i < 4; ++i) { float t8[8];
#pragma unroll
                for (int j = 0; j < 8; ++j) t8[j] = f[8 * i + j];
                *(GAS v4u*)(IKB + (size_t)m * 32 + 8 * i) = pack8(t8); } }
        { const f32x4 w0 = *(const GAS f32x4*)(sr + S_IW), w1 = *(const GAS f32x4*)(sr + S_IW + 4); const float iw[8] = {w0.x, w0.y, w0.z, w0.w, w1.x, w1.y, w1.z, w1.w}; unsigned sg = 0;
#pragma unroll
            for (int h = 0; h < 8; ++h) sg |= (iw[h] < 0.f ? 1u : 0u) << h;
            ISG[m] = sg;
            const f32x4 f0 = *(const GAS f32x4*)(sr + S_FF), f1 = *(const GAS f32x4*)(sr + S_FF + 4); const float ff[8] = {f0.x, f0.y, f0.z, f0.w, f1.x, f1.y, f1.z, f1.w}; float lf[8];
#pragma unroll
            for (int h = 0; h < 8; ++h) { const float xx = ff[h] + b_f[h]; lf[h] = (fminf(xx, 0.f) - __logf(1.0f + __expf(-fabsf(xx)))) * LOG2E; }
            *(GAS f32x4*)(LF + (size_t)m * 8) = (f32x4){lf[0], lf[1], lf[2], lf[3]}; *(GAS f32x4*)(LF + (size_t)m * 8 + 4) = (f32x4){lf[4], lf[5], lf[6], lf[7]}; }
    }
}

__device__ __forceinline__ float ret_l2g(int h) { return h == 0 ? -0.04580368961312479f : h == 1 ? -0.02272007650008353f : h == 2 ? -0.011315313227834146f : -0.005646563141142063f; }

__device__ __forceinline__ void scan_state_phase(const Ctx& F) {
    const float* LF = (const float*)(F.ws + WS_LF); float* CF = (float*)(F.ws + WS_CF);
    const bf16* Z = (const bf16*)(F.ws + WS_Z); float* RS = (float*)(F.ws + WS_HDN);
    if (F.gw < 32) {
        const int b = F.gw >> 3, h = F.gw & 7; const float* lp = LF + ((size_t)b * SEQ + F.lane * 64) * 8 + h; float s = 0.f;
        for (int i = 0; i < 64; ++i) s += lp[i * 8];
        float incl = s;
#pragma unroll
        for (int o = 1; o < 64; o <<= 1) { const float t = __builtin_bit_cast(float, __builtin_amdgcn_ds_bpermute(((F.lane - o) & 63) << 2, __builtin_bit_cast(int, incl))); if (F.lane >= o) incl += t; }
        float run = incl - s; float* cp = CF + (size_t)F.gw * SEQ + F.lane * 64;
        for (int i = 0; i < 64; ++i) { run += lp[i * 8]; cp[i] = run; }
    }
    for (int u = blockIdx.x; u < NB * 32 * 4; u += F.G) {
        const int h = u & 3, c = (u >> 2) & 31, b = u >> 7; const float l2g = ret_l2g(h);
        const int d = F.tid >> 3, e0 = (F.tid & 7) * 16; float acc[16];
#pragma unroll
        for (int i = 0; i < 16; ++i) acc[i] = 0.f;
        const bf16* base = Z + ((size_t)b * SEQ + c * 128) * ZP;
        for (int j = 0; j < 128; ++j) { const bf16* row = base + (size_t)j * ZP;
            const float kd = bf2f(row[Z_RK + h * 64 + d]) * exp2f((float)(127 - j) * l2g);
            const v4u w0 = *(const GAS v4u*)(row + Z_RV + h * 128 + e0), w1 = *(const GAS v4u*)(row + Z_RV + h * 128 + e0 + 8);
            float v0[8], v1[8]; unpack8(w0, v0); unpack8(w1, v1);
#pragma unroll
            for (int i = 0; i < 8; ++i) { acc[i] += kd * v0[i]; acc[8 + i] += kd * v1[i]; } }
        float* o = RS + (size_t)u * 8192 + d * 128 + e0;
#pragma unroll
        for (int i = 0; i < 4; ++i) *(GAS f32x4*)(o + 4 * i) = (f32x4){acc[4 * i], acc[4 * i + 1], acc[4 * i + 2], acc[4 * i + 3]};
    }
}

__device__ __forceinline__ void ret_out_naive(const Ctx& F, const float* gn) {
    bf16* Z = (bf16*)(F.ws + WS_Z); const float* RS = (const float*)(F.ws + WS_HDN);
    LAS float* S = (LAS float*)(F.lds);
    LAS bf16* Vt = (LAS bf16*)(F.lds + 32768);
    LAS float* Kt = (LAS float*)(F.lds + 65536);
    LAS float* aw = (LAS float*)(F.lds + 65536 + 33280) + F.wave * 128;
    LAS float* qw = (LAS float*)(F.lds + 65536 + 33280 + 4096) + F.wave * 64;
    for (int u = blockIdx.x; u < NB * 32 * 4; u += F.G) {
        const int h = u & 3, c = (u >> 2) & 31, b = u >> 7; const float l2g = ret_l2g(h); const float wch = exp2f(128.f * l2g);
        __syncthreads();
        { float s[16];
#pragma unroll
            for (int i = 0; i < 16; ++i) s[i] = 0.f;
            for (int cp = 0; cp < c; ++cp) { const float* L = RS + ((size_t)((b * 32 + cp) * 4 + h)) * 8192 + F.tid;
#pragma unroll
                for (int i = 0; i < 16; ++i) s[i] = wch * s[i] + L[i * 512]; }
#pragma unroll
            for (int i = 0; i < 16; ++i) S[F.tid + i * 512] = s[i]; }
        const bf16* base = Z + ((size_t)b * SEQ + c * 128) * ZP;
        for (int q = F.tid; q < 2048; q += 512) { const int r = q >> 4, ch = q & 15; *(LAS v4u*)(Vt + r * 128 + ch * 8) = *(const GAS v4u*)(base + (size_t)r * ZP + Z_RV + h * 128 + ch * 8); }
        for (int q = F.tid; q < 128 * 64; q += 512) { const int r = q >> 6, dd = q & 63; Kt[r * 65 + dd] = bf2f(base[(size_t)r * ZP + Z_RK + h * 64 + dd]); }
        __syncthreads();
        for (int i = F.wave; i < 128; i += NWAVES) {
            const size_t m = (size_t)b * SEQ + c * 128 + i; bf16* zr = Z + m * ZP;
            qw[F.lane] = bf2f(zr[Z_RQ + h * 64 + F.lane]);
            LDS_WAIT(); asm volatile("" ::: "memory");
#pragma unroll
            for (int jj = 0; jj < 2; ++jj) { const int j = F.lane + 64 * jj; float a = 0.f;
                if (j <= i) { float dot = 0.f; for (int dd = 0; dd < 64; ++dd) dot += qw[dd] * Kt[j * 65 + dd]; a = dot * exp2f((float)(i - j) * l2g); }
                aw[j] = a; }
            LDS_WAIT(); asm volatile("" ::: "memory");
            float o[2]; const float dq = exp2f((float)(i + 1) * l2g);
#pragma unroll
            for (int ee = 0; ee < 2; ++ee) { const int e = F.lane + 64 * ee; float acc = 0.f;
                for (int j = 0; j <= i; ++j) acc += aw[j] * bf2f(Vt[j * 128 + e]);
                float cr = 0.f; for (int dd = 0; dd < 64; ++dd) cr += qw[dd] * S[dd * 128 + e];
                o[ee] = acc + cr * dq; }
            const float ss = wave_sum(o[0] * o[0] + o[1] * o[1]); const float rstd = 1.0f / sqrtf(ss * (1.f / 128) + NORM_EPS);
#pragma unroll
            for (int ee = 0; ee < 2; ++ee) { const int e = F.lane + 64 * ee; const float rg = bf2f(zr[Z_RG + h * 128 + e]);
                zr[Z_RV + h * 128 + e] = (bf16)f2bf(o[ee] * rstd * gn[h * 128 + e] * rg * sigmoid_f(rg)); }
            LDS_WAIT(); asm volatile("" ::: "memory");
        }
    }
    __syncthreads();
}

__device__ __forceinline__ void fox_naive(const Ctx& F) {
    bf16* Z = (bf16*)(F.ws + WS_Z); const float* CF = (const float*)(F.ws + WS_CF);
    LAS float* sc = (LAS float*)(F.lds + F.wave * 16384);
    const int lane = F.lane;
    int it = 0;
    for (int r0 = 0; r0 < NB * 8 * SEQ; r0 += F.NGW, ++it) {
        const int r = r0 + ((it & 1) ? (F.NGW - 1 - F.gw) : F.gw);
        if (r >= NB * 8 * SEQ) continue;
        const int pos = r & (SEQ - 1), h = (r >> 12) & 7, b = r >> 15;
        const size_t m = (size_t)b * SEQ + pos;
        float qf[64];
        { const bf16* qp = Z + m * ZP + Z_FQ + h * 64;
#pragma unroll
            for (int i = 0; i < 8; ++i) { const v4u w = *(const GAS v4u*)(qp + 8 * i); float t[8]; unpack8(w, t);
#pragma unroll
                for (int j = 0; j < 8; ++j) qf[8 * i + j] = t[j]; } }
        const float* cf = CF + (size_t)(b * 8 + h) * SEQ;
        float mx = -INFINITY;
        for (int kk = lane; kk <= pos; kk += 64) { const bf16* kp = Z + ((size_t)b * SEQ + kk) * ZP + Z_FK + h * 64; float dot = 0.f;
#pragma unroll
            for (int i = 0; i < 8; ++i) { const v4u w = *(const GAS v4u*)(kp + 8 * i); float t[8]; unpack8(w, t);
#pragma unroll
                for (int j = 0; j < 8; ++j) dot += qf[8 * i + j] * t[j]; }
            const float s = dot - cf[kk]; sc[kk] = s; mx = fmaxf(mx, s); }
        mx = wave_max(mx);
        float sum = 0.f;
        for (int kk = lane; kk <= pos; kk += 64) { const float p = exp2f(sc[kk] - mx); sc[kk] = p; sum += p; }
        sum = wave_sum(sum);
        LDS_WAIT(); asm volatile("" ::: "memory");
        const bf16* vp = Z + (size_t)b * SEQ * ZP + Z_FV + h * 64 + lane;
        float o0 = 0.f, o1 = 0.f, o2 = 0.f, o3 = 0.f; int kk = 0;
        for (; kk + 3 <= pos; kk += 4) { o0 += sc[kk] * bf2f(vp[(size_t)kk * ZP]); o1 += sc[kk + 1] * bf2f(vp[(size_t)(kk + 1) * ZP]); o2 += sc[kk + 2] * bf2f(vp[(size_t)(kk + 2) * ZP]); o3 += sc[kk + 3] * bf2f(vp[(size_t)(kk + 3) * ZP]); }
        for (; kk <= pos; ++kk) o0 += sc[kk] * bf2f(vp[(size_t)kk * ZP]);
        Z[m * ZP + Z_FQ + h * 64 + lane] = (bf16)f2bf(((o0 + o1) + (o2 + o3)) / sum);
        LDS_WAIT(); asm volatile("" ::: "memory");
    }
}

__device__ __forceinline__ unsigned f2key(float s) { const unsigned u = __builtin_bit_cast(unsigned, s + 0.0f); return (u & 0x80000000u) ? ~u : (u | 0x80000000u); }
__device__ __forceinline__ void dsa_naive(const Ctx& F) {
    bf16* Z = (bf16*)(F.ws + WS_Z); const float* ZS = (const float*)(F.ws + WS_ZS);
    const unsigned* ISG = (const unsigned*)(F.ws + WS_ISG);
    const bf16* KD = (const bf16*)(F.ws + WS_KD); const bf16* VD = (const bf16*)(F.ws + WS_VD);
    LAS unsigned* kl = (LAS unsigned*)(F.lds + F.wave * 16384);
    LAS float* iqs = (LAS float*)(F.lds + XTRA_OFF + F.wave * 1536);
    const int lane = F.lane;
    int it = 0;
    for (int r0 = 0; r0 < M; r0 += F.NGW, ++it) {
        const int r = r0 + ((it & 1) ? (F.NGW - 1 - F.gw) : F.gw);
        if (r >= M) continue;
        const int pos = r & (SEQ - 1), b = r >> 12; const size_t m = (size_t)r;
        *(LAS f32x4*)(iqs + 4 * lane) = *(const GAS f32x4*)(ZS + m * ZSP + S_IQ + 4 * lane);
        const unsigned sg = ISG[m];
        LDS_WAIT(); asm volatile("" ::: "memory");
        for (int kk = lane; kk <= pos; kk += 64) { const float* ikp = ZS + ((size_t)b * SEQ + kk) * ZSP + S_IK; float ik[32];
#pragma unroll
            for (int i = 0; i < 8; ++i) { const f32x4 t = *(const GAS f32x4*)(ikp + 4 * i); ik[4 * i] = t.x; ik[4 * i + 1] = t.y; ik[4 * i + 2] = t.z; ik[4 * i + 3] = t.w; }
            float s = 0.f;
#pragma unroll 1
            for (int h = 0; h < 8; ++h) { float dot = 0.f;
#pragma unroll
                for (int dd = 0; dd < 32; ++dd) dot += iqs[h * 32 + dd] * ik[dd];
                dot = fmaxf(dot, 0.f); s += ((sg >> h) & 1u) ? -dot : dot; }
            kl[kk] = f2key(s); }
        LDS_WAIT(); asm volatile("" ::: "memory");
        unsigned key[64];
#pragma unroll
        for (int j = 0; j < 64; ++j) { const int kk = j * 64 + lane; key[j] = (kk <= pos) ? kl[kk] : 0u; }
        LDS_WAIT(); asm volatile("" ::: "memory");
        LAS unsigned* idx = kl; LAS float* pl = (LAS float*)(kl + 256); LAS bf16* qs = (LAS bf16*)(kl + 512);
        *(LAS v4u*)(qs + 8 * lane) = *(const GAS v4u*)(Z + m * ZP + Z_DQ + 8 * lane);
        unsigned T = 0u; int need = 0;
        if (pos + 1 > 256) {
            for (int bit = 31; bit >= 0; --bit) { const unsigned Tt = T | (1u << bit); int cnt = 0;
#pragma unroll
                for (int j = 0; j < 64; ++j) cnt += __builtin_popcountll(__ballot(key[j] >= Tt));
                if (cnt >= 256) T = Tt; }
            int ngt = 0;
#pragma unroll
            for (int j = 0; j < 64; ++j) ngt += __builtin_popcountll(__ballot(key[j] > T));
            need = 256 - ngt;
        }
        int nsel = 0, eqb = 0;
#pragma unroll
        for (int j = 0; j < 64; ++j) { const bool gt = key[j] > T, eq = (key[j] == T) && (T != 0u);
            const unsigned long long em = __ballot(eq); const int er = eqb + __builtin_amdgcn_mbcnt_hi((unsigned)(em >> 32), __builtin_amdgcn_mbcnt_lo((unsigned)em, 0u));
            const bool sel = gt || (eq && er < need); eqb += __builtin_popcountll(em);
            const unsigned long long sm = __ballot(sel); const int sp = nsel + __builtin_amdgcn_mbcnt_hi((unsigned)(sm >> 32), __builtin_amdgcn_mbcnt_lo((unsigned)sm, 0u));
            if (sel) idx[sp] = (unsigned)(j * 64 + lane); nsel += __builtin_popcountll(sm); }
        LDS_WAIT(); asm volatile("" ::: "memory");
        for (int h = 0; h < 8; ++h) {
            float sv[4]; float mx = -INFINITY;
#pragma unroll
            for (int i = 0; i < 4; ++i) { const int e = lane + 64 * i; sv[i] = -INFINITY;
                if (e < nsel) { const bf16* kp = KD + ((size_t)b * SEQ + idx[e]) * 64; float dot = 0.f;
#pragma unroll
                    for (int c = 0; c < 8; ++c) { const v4u w = *(const GAS v4u*)(kp + 8 * c); float t[8]; unpack8(w, t); const v4u qw = *(const LAS v4u*)(qs + h * 64 + 8 * c); float qq[8]; unpack8(qw, qq);
#pragma unroll
                        for (int j = 0; j < 8; ++j) dot += qq[j] * t[j]; }
                    sv[i] = dot; }
                mx = fmaxf(mx, sv[i]); }
            mx = wave_max(mx); float sum = 0.f;
#pragma unroll
            for (int i = 0; i < 4; ++i) { const int e = lane + 64 * i; const float p = (e < nsel) ? exp2f(sv[i] - mx) : 0.f; pl[e] = p; sum += p; }
            sum = wave_sum(sum);
            LDS_WAIT(); asm volatile("" ::: "memory");
            float o0 = 0.f, o1 = 0.f; int e = 0;
            for (; e + 1 < nsel; e += 2) { o0 += pl[e] * bf2f(VD[((size_t)b * SEQ + idx[e]) * 64 + lane]); o1 += pl[e + 1] * bf2f(VD[((size_t)b * SEQ + idx[e + 1]) * 64 + lane]); }
            if (e < nsel) o0 += pl[e] * bf2f(VD[((size_t)b * SEQ + idx[e]) * 64 + lane]);
            Z[m * ZP + Z_DQ + h * 64 + lane] = (bf16)f2bf((o0 + o1) / sum);
            LDS_WAIT(); asm volatile("" ::: "memory");
        }
    }
}
#ifndef PROBE_D
#define PROBE_D 0
#endif

typedef short s16x8 __attribute__((ext_vector_type(8)));
typedef short s16x4 __attribute__((ext_vector_type(4)));
typedef short v4i16_t __attribute__((ext_vector_type(4)));
__device__ __forceinline__ s16x4 tr16(const LAS unsigned char* p) { return __builtin_bit_cast(s16x4, __builtin_amdgcn_ds_read_tr16_b64_v4i16((LAS v4i16_t*)p)); }
__device__ __forceinline__ float key2f(unsigned k) { return __builtin_bit_cast(float, (k & 0x80000000u) ? (k & 0x7fffffffu) : ~k); }

template <int NR> __device__ __forceinline__ int dsa_count_ge(const unsigned (&key)[64], unsigned T) {
    int c = 0;
#pragma unroll
    for (int j = 0; j < NR; ++j) c += __builtin_popcountll(__ballot(key[j] >= T));
    return c;
}
#define DSA_COUNT_GE(T_, out_) do { if (nq == 1) out_ = dsa_count_ge<16>(key, (T_)); else if (nq == 2) out_ = dsa_count_ge<32>(key, (T_)); else if (nq == 3) out_ = dsa_count_ge<48>(key, (T_)); else out_ = dsa_count_ge<64>(key, (T_)); } while (0)
__device__ __forceinline__ void dsa_select(const unsigned (&key)[64], int nvalid, unsigned& T, int& need) {
    const int nq = __builtin_amdgcn_readfirstlane((nvalid + 1023) >> 10);
    T = 0u; need = 0;
    if (nvalid <= 256) return;
    unsigned kmax = 0u;
#pragma unroll
    for (int j = 0; j < 64; ++j) kmax = key[j] > kmax ? key[j] : kmax;
#pragma unroll
    for (int o_ = 0; o_ < 1; ++o_) { unsigned t; t = sxu<1>(kmax); kmax = t > kmax ? t : kmax; t = sxu<2>(kmax); kmax = t > kmax ? t : kmax; t = sxu<4>(kmax); kmax = t > kmax ? t : kmax; t = sxu<8>(kmax); kmax = t > kmax ? t : kmax; t = sxu<16>(kmax); kmax = t > kmax ? t : kmax;
        unsigned a_, b_; swap32(kmax, a_, b_); kmax = a_ > b_ ? a_ : b_; }
    unsigned lo = 1u, hi = kmax + 1u; int hic = 0;
    { const float vm = fabsf(key2f(kmax)) + 1.0f; unsigned l2 = f2key(-vm * 64.0f); int c; DSA_COUNT_GE(l2, c); if (c >= 256) lo = l2; }
    int iter = 0; bool exact = false;
    while (hi - lo > 1u) {
        unsigned mid;
        if (iter < 24 && lo > 1u) { const float mv = 0.5f * key2f(lo) + 0.5f * key2f(hi - 1u); mid = f2key(mv); }
        else mid = lo + ((hi - lo) >> 1);
        if (mid <= lo) mid = lo + 1u; if (mid >= hi) mid = hi - 1u;
        int c; DSA_COUNT_GE(mid, c);
        if (c == 256) { T = mid; exact = true; break; }
        if (c > 256) lo = mid; else { hi = mid; hic = c; }
        ++iter;
    }
    if (exact) need = 256; else { T = lo; need = 256 - hic; }
}

__device__ __forceinline__ void dsa_attend(const bf16* zq, bf16* zo, const bf16* KDb, const bf16* VDb, const LAS unsigned short* idx, int nsel, LAS unsigned char* vst, int lane) {
    const int g = lane >> 4, c = lane & 15;
    s16x8 qf[2];
#pragma unroll
    for (int ks = 0; ks < 2; ++ks) { qf[ks] = (s16x8){0, 0, 0, 0, 0, 0, 0, 0}; if (c < 8) qf[ks] = *(const GAS s16x8*)(zq + c * 64 + 32 * ks + 8 * g); }
    f32x4 acc[16];
    v4u vreg[16];
#pragma unroll
    for (int i = 0; i < 16; ++i) { const int pi = lane + 64 * i, r = pi >> 3, c16 = pi & 7; const int id = (r < nsel) ? (int)idx[r] : 0; vreg[i] = *(const GAS v4u*)(VDb + (size_t)id * 64 + c16 * 8); }
#pragma unroll
    for (int tb = 0; tb < 2; ++tb) {
        s16x8 kf[8][2];
#pragma unroll
        for (int tt = 0; tt < 8; ++tt) { const int e = 16 * (8 * tb + tt) + c; const int id = (e < nsel) ? (int)idx[e] : 0; const bf16* kp = KDb + (size_t)id * 64 + 8 * g;
            kf[tt][0] = *(const GAS s16x8*)kp; kf[tt][1] = *(const GAS s16x8*)(kp + 32); }
#pragma unroll
        for (int tt = 0; tt < 8; ++tt) { f32x4 a = (f32x4){0.f, 0.f, 0.f, 0.f};
            a = __builtin_amdgcn_mfma_f32_16x16x32_bf16(kf[tt][0], qf[0], a, 0, 0, 0); a = __builtin_amdgcn_mfma_f32_16x16x32_bf16(kf[tt][1], qf[1], a, 0, 0, 0); acc[8 * tb + tt] = a; }
    }
    float mx = -INFINITY;
#pragma unroll
    for (int t = 0; t < 16; ++t)
#pragma unroll
        for (int i = 0; i < 4; ++i) { const int e = 16 * t + 4 * g + i; if (nsel < 256 && e >= nsel) acc[t][i] = -INFINITY; mx = fmaxf(mx, acc[t][i]); }
    mx = fmaxf(mx, sx<16>(mx)); mx = half_max(mx);
    float sum = 0.f;
#pragma unroll
    for (int t = 0; t < 16; ++t)
#pragma unroll
        for (int i = 0; i < 4; ++i) { const float p = __builtin_amdgcn_exp2f(acc[t][i] - mx); acc[t][i] = p; sum += p; }
    sum += sx<16>(sum); sum = half_sum(sum);
    const float inv = 1.0f / sum;
    s16x8 pf[8];
#pragma unroll
    for (int s = 0; s < 8; ++s) { v4u w; w.x = pk2(acc[2 * s][0] * inv, acc[2 * s][1] * inv); w.y = pk2(acc[2 * s][2] * inv, acc[2 * s][3] * inv); w.z = pk2(acc[2 * s + 1][0] * inv, acc[2 * s + 1][1] * inv); w.w = pk2(acc[2 * s + 1][2] * inv, acc[2 * s + 1][3] * inv);
        pf[s] = __builtin_bit_cast(s16x8, w); }
    f32x4 o[4];
#pragma unroll
    for (int db = 0; db < 4; ++db) o[db] = (f32x4){0.f, 0.f, 0.f, 0.f};
    const int q = (lane >> 2) & 3, p = lane & 3, swz = 2 * (g & 1) + (q >> 1);
    const LAS unsigned char* rb = vst + (4 * g + q) * 128 + 8 * p;
#pragma unroll
    for (int hh = 0; hh < 2; ++hh) {
        asm volatile("s_waitcnt lgkmcnt(0)" ::: "memory");
#pragma unroll
        for (int i = 0; i < 16; ++i) { const int pi = lane + 64 * i, r = pi >> 3, c16 = pi & 7;
            *(LAS v4u*)(vst + r * 128 + ((((c16 >> 1) ^ ((r >> 1) & 3))) << 5) + ((c16 & 1) << 4)) = vreg[i]; }
        if (hh == 0) {
#pragma unroll
            for (int i = 0; i < 16; ++i) { const int pi = lane + 64 * i, r = pi >> 3, c16 = pi & 7, e = 128 + r; const int id = (e < nsel) ? (int)idx[e] : 0; vreg[i] = *(const GAS v4u*)(VDb + (size_t)id * 64 + c16 * 8); } }
        asm volatile("s_waitcnt lgkmcnt(0)" ::: "memory");
#pragma unroll
        for (int s4 = 0; s4 < 4; ++s4)
#pragma unroll
            for (int db = 0; db < 4; ++db) { const LAS unsigned char* a1 = rb + s4 * 4096 + ((db ^ swz) << 5);
                const s16x4 lo = tr16(a1), hi = tr16(a1 + 2048);
                const s16x8 vf = (s16x8){lo[0], lo[1], lo[2], lo[3], hi[0], hi[1], hi[2], hi[3]};
                o[db] = __builtin_amdgcn_mfma_f32_16x16x32_bf16(pf[4 * hh + s4], vf, o[db], 0, 0, 0); }
    }
    if (g < 2) {
#pragma unroll
        for (int db = 0; db < 4; ++db)
#pragma unroll
            for (int i = 0; i < 4; ++i) zo[(4 * g + i) * 64 + 16 * db + c] = (bf16)f2bf(o[db][i]);
    }
}

__device__ __forceinline__ void dsa_v2(const Ctx& F) {
    bf16* Z = (bf16*)(F.ws + WS_Z); const float* ZS = (const float*)(F.ws + WS_ZS);
    const unsigned* ISG = (const unsigned*)(F.ws + WS_ISG);
    const bf16* KD = (const bf16*)(F.ws + WS_KD); const bf16* VD = (const bf16*)(F.ws + WS_VD);
    LAS unsigned* kl = (LAS unsigned*)(F.lds + F.wave * 16384);
    LAS float* iqs = (LAS float*)(F.lds + XTRA_OFF + F.wave * 1536);
    LAS unsigned short* idx = (LAS unsigned short*)(F.lds + XTRA_OFF + F.wave * 1536 + 1024);
    const int lane = F.lane;
    int it = 0;
    for (int r0 = 0; r0 < M; r0 += F.NGW, ++it) {
        const int r = r0 + ((it & 1) ? (F.NGW - 1 - F.gw) : F.gw);
        if (r >= M) continue;
        const int pos = r & (SEQ - 1), b = r >> 12; const size_t m = (size_t)r;
        *(LAS f32x4*)(iqs + 4 * lane) = *(const GAS f32x4*)(ZS + m * ZSP + S_IQ + 4 * lane);
        const unsigned sg = ISG[m];
        LDS_WAIT(); asm volatile("" ::: "memory");
        for (int kk = lane; kk <= pos; kk += 64) { const float* ikp = ZS + ((size_t)b * SEQ + kk) * ZSP + S_IK; float ik[32];
#pragma unroll
            for (int i = 0; i < 8; ++i) { const f32x4 t = *(const GAS f32x4*)(ikp + 4 * i); ik[4 * i] = t.x; ik[4 * i + 1] = t.y; ik[4 * i + 2] = t.z; ik[4 * i + 3] = t.w; }
            float s = 0.f;
#pragma unroll 1
            for (int h = 0; h < 8; ++h) { float dot = 0.f;
#pragma unroll
                for (int dd = 0; dd < 32; ++dd) dot += iqs[h * 32 + dd] * ik[dd];
                dot = fmaxf(dot, 0.f); s += ((sg >> h) & 1u) ? -dot : dot; }
            kl[kk] = f2key(s); }
        LDS_WAIT(); asm volatile("" ::: "memory");
        unsigned key[64];
#pragma unroll
        for (int j = 0; j < 64; ++j) { const int kk = j * 64 + lane; key[j] = (kk <= pos) ? kl[kk] : 0u; }
        LDS_WAIT(); asm volatile("" ::: "memory");
        unsigned T; int need;
#ifdef DSA_OLDSEL
        T = 0u; need = 0;
        if (pos + 1 > 256) {
            for (int bit = 31; bit >= 0; --bit) { const unsigned Tt = T | (1u << bit); int cnt = 0;
#pragma unroll
                for (int j = 0; j < 64; ++j) cnt += __builtin_popcountll(__ballot(key[j] >= Tt));
                if (cnt >= 256) T = Tt; }
            int ngt = 0;
#pragma unroll
            for (int j = 0; j < 64; ++j) ngt += __builtin_popcountll(__ballot(key[j] > T));
            need = 256 - ngt;
        }
#else
        dsa_select(key, pos + 1, T, need);
#endif
        int nsel = 0, eqb = 0;
#pragma unroll
        for (int j = 0; j < 64; ++j) { const bool gt = key[j] > T, eq = (key[j] == T) && (T != 0u);
            const unsigned long long em = __ballot(eq); const int er = eqb + __builtin_amdgcn_mbcnt_hi((unsigned)(em >> 32), __builtin_amdgcn_mbcnt_lo((unsigned)em, 0u));
            const bool sel = gt || (eq && er < need); eqb += __builtin_popcountll(em);
            const unsigned long long sm = __ballot(sel); const int sp = nsel + __builtin_amdgcn_mbcnt_hi((unsigned)(sm >> 32), __builtin_amdgcn_mbcnt_lo((unsigned)sm, 0u));
            if (sel) idx[sp] = (unsigned short)(j * 64 + lane); nsel += __builtin_popcountll(sm); }
        LDS_WAIT(); asm volatile("" ::: "memory");
        dsa_attend(Z + m * ZP + Z_DQ, Z + m * ZP + Z_DQ, KD + (size_t)b * SEQ * 64, VD + (size_t)b * SEQ * 64, idx, nsel, (LAS unsigned char*)kl, lane);
        LDS_WAIT(); asm volatile("" ::: "memory");
    }
}

template <int NR> __device__ __forceinline__ int dsa_emit_n(const unsigned (&key)[64], unsigned T, int need, LAS unsigned short* idx, int lane) {
    int nsel = 0, eqb = 0;
#pragma unroll
    for (int j = 0; j < NR; ++j) { const bool gt = key[j] > T, eq = (key[j] == T) && (T != 0u);
        const unsigned long long em = __ballot(eq); const int er = eqb + __builtin_amdgcn_mbcnt_hi((unsigned)(em >> 32), __builtin_amdgcn_mbcnt_lo((unsigned)em, 0u));
        const bool sel = gt || (eq && er < need); eqb += __builtin_popcountll(em);
        const unsigned long long sm = __ballot(sel); const int sp = nsel + __builtin_amdgcn_mbcnt_hi((unsigned)(sm >> 32), __builtin_amdgcn_mbcnt_lo((unsigned)sm, 0u));
        if (sel) idx[sp] = (unsigned short)(j * 64 + lane); nsel += __builtin_popcountll(sm); }
    return nsel;
}
__device__ __forceinline__ int dsa_emit(const unsigned (&key)[64], int nvalid, unsigned T, int need, LAS unsigned short* idx, int lane) {
    const int nq = __builtin_amdgcn_readfirstlane((nvalid + 1023) >> 10);
    if (nq == 1) return dsa_emit_n<16>(key, T, need, idx, lane);
    if (nq == 2) return dsa_emit_n<32>(key, T, need, idx, lane);
    if (nq == 3) return dsa_emit_n<48>(key, T, need, idx, lane);
    return dsa_emit_n<64>(key, T, need, idx, lane);
}

#define DSA_CNT8(cnt_, k_, o_, T_) asm volatile( \
    "v_cmp_ge_u32_e64 s[60:61], %1, %9\n\tv_cmp_ge_u32_e64 s[62:63], %2, %9\n\tv_cmp_ge_u32_e64 s[64:65], %3, %9\n\tv_cmp_ge_u32_e64 s[66:67], %4, %9\n\t" \
    "v_cmp_ge_u32_e64 s[68:69], %5, %9\n\tv_cmp_ge_u32_e64 s[70:71], %6, %9\n\tv_cmp_ge_u32_e64 s[72:73], %7, %9\n\tv_cmp_ge_u32_e64 s[74:75], %8, %9\n\t" \
    "v_addc_co_u32_e64 %0, s[76:77], 0, %0, s[60:61]\n\tv_addc_co_u32_e64 %0, s[76:77], 0, %0, s[62:63]\n\tv_addc_co_u32_e64 %0, s[76:77], 0, %0, s[64:65]\n\tv_addc_co_u32_e64 %0, s[76:77], 0, %0, s[66:67]\n\t" \
    "v_addc_co_u32_e64 %0, s[76:77], 0, %0, s[68:69]\n\tv_addc_co_u32_e64 %0, s[76:77], 0, %0, s[70:71]\n\tv_addc_co_u32_e64 %0, s[76:77], 0, %0, s[72:73]\n\tv_addc_co_u32_e64 %0, s[76:77], 0, %0, s[74:75]" \
    : "+v"(cnt_) : "v"(k_[o_]), "v"(k_[o_ + 1]), "v"(k_[o_ + 2]), "v"(k_[o_ + 3]), "v"(k_[o_ + 4]), "v"(k_[o_ + 5]), "v"(k_[o_ + 6]), "v"(k_[o_ + 7]), "s"(T_) \
    : "s60", "s61", "s62", "s63", "s64", "s65", "s66", "s67", "s68", "s69", "s70", "s71", "s72", "s73", "s74", "s75", "s76", "s77")
template <int NR> __device__ __forceinline__ int dsa_lane_count(const unsigned (&key)[64], unsigned T) {
    int c = 0; const unsigned Ts = (unsigned)__builtin_amdgcn_readfirstlane((int)T);
#pragma unroll
    for (int j = 0; j < NR; j += 8) DSA_CNT8(c, key, j, Ts);
    return c;
}
#define DSA_LCOUNT(T_, lc_) do { if (nq == 1) lc_ = dsa_lane_count<16>(key, (T_)); else if (nq == 2) lc_ = dsa_lane_count<32>(key, (T_)); else if (nq == 3) lc_ = dsa_lane_count<48>(key, (T_)); else lc_ = dsa_lane_count<64>(key, (T_)); } while (0)
template <int NR> __device__ __forceinline__ void dsa_write_ge(const unsigned (&key)[64], unsigned T, int off, LAS unsigned short* idx, int lane) {
    const int dummy = 256 + lane;
#pragma unroll
    for (int j = 0; j < NR; ++j) { const bool s = key[j] >= T; idx[s ? off : dummy] = (unsigned short)(j * 64 + lane); off += s ? 1 : 0; }
}
__device__ __forceinline__ int dsa_select2(const unsigned (&key)[64], int nvalid, float s1, float s2, LAS unsigned short* idx, int lane) {
    const int nq = __builtin_amdgcn_readfirstlane((nvalid + 1023) >> 10);
    unsigned T = 1u; int lc = 0; bool exact = true;
    if (nvalid > 256) {
        const float n = (float)nvalid, mean = s1 / n, sd = sqrtf(fmaxf(s2 / n - mean * mean, 1e-30f));
        const float pfrac = 256.0f / n, pt = fminf(pfrac, 1.0f - pfrac);
        const float tt = sqrtf(-2.0f * __logf(fmaxf(pt, 1e-6f)));
        float zn = (0.010328f * tt + 0.802853f) * tt + 2.515517f; asm volatile("" : "+v"(zn));
        float zd = ((0.001308f * tt + 0.189269f) * tt + 1.432788f) * tt + 1.0f; asm volatile("" : "+v"(zd));
        float z = tt - zn / zd;
        if (pfrac > 0.5f) z = -z;
        const float dens = n * __expf(-0.5f * z * z) * 0.3989423f / sd;
        unsigned lo = 1u, hi = 0xffffffffu; int clo = nvalid, chi = 0;
        bool lop = false, hip = false; float lastv = mean + z * sd, lastc = 256.0f, grow = 1.3f;
        exact = false; int same = 0, last = 0;
        for (int it = 0; hi - lo > 1u; ++it) {
            unsigned mid;
            if (it == 0) mid = f2key(lastv);
            else if (!(lop && hip)) { lastv = lastv + grow * (lastc - 256.0f) / dens; grow *= 2.0f; mid = f2key(lastv); }
            else if (it < 24 && same < 2) { const float vlo = key2f(lo), vhi = key2f(hi - 1u); mid = f2key(vlo + (vhi - vlo) * (((float)(clo - 256) + 0.5f) / (float)(clo - chi))); }
            else if (it < 48) { mid = f2key(0.5f * key2f(lo) + 0.5f * key2f(hi - 1u)); same = 0; }
            else mid = lo + ((hi - lo) >> 1);
            if (!(mid > lo)) mid = lo + 1u; if (!(mid < hi)) mid = hi - 1u;
            DSA_LCOUNT(mid, lc); const int c = wave_isum(lc); lastc = (float)c; lastv = key2f(mid);
            if (c == 256) { T = mid; exact = true; break; }
            if (c > 256) { lo = mid; clo = c; lop = true; same = (last > 0) ? same + 1 : 0; last = 1; } else { hi = mid; chi = c; hip = true; same = (last < 0) ? same + 1 : 0; last = -1; }
        }
        if (!exact) {
            const int nsel = dsa_emit(key, nvalid, lo, 256 - chi, idx, lane);
            return nsel;
        }
    } else { DSA_LCOUNT(1u, lc); }
    int incl = lc;
#pragma unroll
    for (int o = 1; o < 64; o <<= 1) { const int t = __builtin_amdgcn_ds_bpermute(((lane - o) & 63) << 2, incl); if (lane >= o) incl += t; }
    const int total = __builtin_amdgcn_readlane(incl, 63);
    if (nq == 1) dsa_write_ge<16>(key, T, incl - lc, idx, lane); else if (nq == 2) dsa_write_ge<32>(key, T, incl - lc, idx, lane); else if (nq == 3) dsa_write_ge<48>(key, T, incl - lc, idx, lane); else dsa_write_ge<64>(key, T, incl - lc, idx, lane);
    return total;
}

constexpr int DSA_ROWF = 4100;
__device__ __forceinline__ void dsa_v3(const Ctx& F, int out_col = Z_DQ) {
    bf16* Z = (bf16*)(F.ws + WS_Z);
    const unsigned* ISG = (const unsigned*)(F.ws + WS_ISG);
    const bf16* KD = (const bf16*)(F.ws + WS_KD); const bf16* VD = (const bf16*)(F.ws + WS_VD);
    const bf16* IQB = (const bf16*)(F.ws + WS_IQB); const bf16* IKB = (const bf16*)(F.ws + WS_IKB);
    LAS unsigned* img = (LAS unsigned*)(F.lds);
    LAS unsigned short* idxw = (LAS unsigned short*)(F.lds + XTRA_OFF + F.wave * 1536);
    const int w = F.wave;
    const int v = (int)blockIdx.x;
    if (v < 256)
    for (int ui = 0; ui < 8; ++ui) {
        int lane_ = F.lane; asm volatile("" : "+v"(lane_)); const int lane = lane_, g = lane >> 4, c = lane & 15;
        const int b = v >> 6, k = v & 63; const int pb = 128 * (ui >> 1) + ((ui & 1) ? 127 - k : k);
        const int q0 = pb * 8, kend = q0 + 8, ntile = (kend + 15) >> 4;
        const size_t mb = (size_t)b * SEQ;
#if PROBE_D == 1
        for (int rp_ = 0; rp_ < 2; ++rp_)
#endif
        { s16x8 iqf[8]; float sgn[8]; s16x8 iqc;
          { const int qq = (q0 + c < SEQ) ? q0 + c : SEQ - 1; const bf16* qp = IQB + (mb + qq) * 256 + 8 * g; const unsigned sg = ISG[mb + qq];
            float cs[8];
#pragma unroll
            for (int e = 0; e < 8; ++e) cs[e] = 0.f;
#pragma unroll
            for (int h = 0; h < 8; ++h) { iqf[h] = *(const GAS s16x8*)(qp + h * 32); sgn[h] = ((sg >> h) & 1u) ? -1.0f : 1.0f;
                float t8[8]; unpack8(__builtin_bit_cast(v4u, iqf[h]), t8);
#pragma unroll
                for (int e = 0; e < 8; ++e) cs[e] += sgn[h] * t8[e]; }
            iqc = __builtin_bit_cast(s16x8, pack8(cs)); }
          const bf16* ikp = IKB + (mb + c) * 32 + 8 * g;
          float st1 = 0.f, st2 = 0.f;
          s16x8 cur[4], nxt[4];
#pragma unroll
          for (int i = 0; i < 4; ++i) { const int t = w + 8 * i; cur[i] = *(const GAS s16x8*)(ikp + (size_t)512 * (t < ntile ? t : 0)); }
          for (int t0 = w; t0 < ntile; t0 += 32) {
#pragma unroll
            for (int i = 0; i < 4; ++i) { const int t = t0 + 32 + 8 * i; nxt[i] = *(const GAS s16x8*)(ikp + (size_t)512 * (t < ntile ? t : 0)); }
#pragma unroll
            for (int i = 0; i < 4; ++i) { const int t = t0 + 8 * i;
              if (t < ntile) {
                f32x4 sc = __builtin_amdgcn_mfma_f32_16x16x32_bf16(cur[i], iqc, (f32x4){0.f, 0.f, 0.f, 0.f}, 0, 0, 0);
#pragma unroll
                for (int h = 0; h < 8; ++h) { const f32x4 x = __builtin_amdgcn_mfma_f32_16x16x32_bf16(cur[i], iqf[h], (f32x4){0.f, 0.f, 0.f, 0.f}, 0, 0, 0);
#pragma unroll
                    for (int r = 0; r < 4; ++r) sc[r] = __builtin_fmaf(sgn[h], __builtin_fabsf(x[r]), sc[r]); }
                v4u kk; kk.x = f2key(sc[0]); kk.y = f2key(sc[1]); kk.z = f2key(sc[2]); kk.w = f2key(sc[3]);
                if (16 * t + 15 <= q0) {
                    st1 += (sc[0] + sc[1]) + (sc[2] + sc[3]); st2 += (sc[0] * sc[0] + sc[1] * sc[1]) + (sc[2] * sc[2] + sc[3] * sc[3]);
                } else { const int kb = 16 * t + 4 * g, qa = q0 + c;
                    if (kb + 0 > qa) { kk.x = 0u; sc[0] = 0.f; } if (kb + 1 > qa) { kk.y = 0u; sc[1] = 0.f; } if (kb + 2 > qa) { kk.z = 0u; sc[2] = 0.f; } if (kb + 3 > qa) { kk.w = 0u; sc[3] = 0.f; }
                    st1 += (sc[0] + sc[1]) + (sc[2] + sc[3]); st2 += (sc[0] * sc[0] + sc[1] * sc[1]) + (sc[2] * sc[2] + sc[3] * sc[3]); }
                if (c < 8) *(LAS v4u*)(img + c * DSA_ROWF + 16 * t + 4 * g) = kk; } }
#pragma unroll
            for (int i = 0; i < 4; ++i) cur[i] = nxt[i];
          }
          st1 += sx<16>(st1); st2 += sx<16>(st2); st1 = half_sum(st1); st2 = half_sum(st2);
          if (g == 0 && c < 8) *(LAS f32x2*)(F.lds + XTRA_OFF + w * 1536 + 640 + c * 8) = (f32x2){st1, st2}; }
        __syncthreads();
        const int pos = q0 + w; unsigned key[64];
#pragma unroll
        for (int j = 0; j < 64; ++j) { const int kidx = 64 * j + lane; const unsigned a = img[w * DSA_ROWF + kidx]; key[j] = (kidx <= pos) ? a : 0u; }
        unsigned T; int need; int nsel;
        float rs1 = 0.f, rs2 = 0.f;
#pragma unroll
        for (int ww = 0; ww < 8; ++ww) { const f32x2 t = *(const LAS f32x2*)(F.lds + XTRA_OFF + ww * 1536 + 640 + w * 8); rs1 += t.x; rs2 += t.y; }
        { nsel = dsa_select2(key, pos + 1, rs1, rs2, idxw, lane); (void)T; (void)need; }
        __syncthreads();
#if PROBE_D == 3
        { const size_t m = mb + pos; dsa_attend(Z + m * ZP + Z_DQ, Z + m * ZP + Z_RG, KD + mb * 64, VD + mb * 64, idxw, nsel, F.lds + w * 16384, lane); }
#endif
        { const size_t m = mb + pos; dsa_attend(Z + m * ZP + Z_DQ, Z + m * ZP + out_col, KD + mb * 64, VD + mb * 64, idxw, nsel, F.lds + w * 16384, lane); }
        __syncthreads();
    }
}

__device__ __forceinline__ void ret_rope_frag(const bf16* row, const f32x2* cs, float scale, int g, s16x8 (&f)[2]) {
    const u32x2 a0 = *(const GAS u32x2*)(row + 4 * g), a1 = *(const GAS u32x2*)(row + 16 + 4 * g), b0 = *(const GAS u32x2*)(row + 32 + 4 * g), b1 = *(const GAS u32x2*)(row + 48 + 4 * g);
    const float x1[8] = {bflo(a0.x), bfhi(a0.x), bflo(a0.y), bfhi(a0.y), bflo(a1.x), bfhi(a1.x), bflo(a1.y), bfhi(a1.y)};
    const float x2[8] = {bflo(b0.x), bfhi(b0.x), bflo(b0.y), bfhi(b0.y), bflo(b1.x), bfhi(b1.x), bflo(b1.y), bfhi(b1.y)};
    float o1[8], o2[8];
#pragma unroll
    for (int j = 0; j < 8; ++j) { const f32x2 t = cs[(j < 4 ? 4 * g + j : 16 + 4 * g + (j - 4))]; o1[j] = (x1[j] * t.x - x2[j] * t.y) * scale; o2[j] = (x2[j] * t.x + x1[j] * t.y) * scale; }
    f[0] = __builtin_bit_cast(s16x8, pack8(o1)); f[1] = __builtin_bit_cast(s16x8, pack8(o2));
}
__device__ __forceinline__ s16x8 ret_bfrag(const LAS unsigned char* img, int row0, int eb, int g, int q, int p) {
    const int r1 = row0 + 4 * g + q;
    const LAS unsigned char* a1 = img + r1 * 256 + ((eb ^ (r1 & 7)) << 5) + 8 * p;
    const LAS unsigned char* a2 = img + (r1 + 16) * 256 + ((eb ^ ((r1 + 16) & 7)) << 5) + 8 * p;
    const s16x4 lo = tr16(a1), hi = tr16(a2);
    return (s16x8){lo[0], lo[1], lo[2], lo[3], hi[0], hi[1], hi[2], hi[3]};
}

__device__ __forceinline__ void ret_state_mfma(const Ctx& F) {
    const bf16* Z = (const bf16*)(F.ws + WS_Z); float* RS = (float*)(F.ws + WS_HDN);
    const f32x2* R64 = (const f32x2*)(F.ws + WS_ROPE64);
    LAS unsigned char* Kimg = F.lds; LAS unsigned char* Vimg = F.lds + 16384;
    const int lane = F.lane, g = lane >> 4, c = lane & 15, q = (lane >> 2) & 3, p = lane & 3;
    for (int u = blockIdx.x; u < NB * 32 * 4; u += F.G) {
        const int h = u & 3, ch = (u >> 2) & 31, b = u >> 7; const float l2g = ret_l2g(h);
        const bf16* base = Z + ((size_t)b * SEQ + ch * 128) * ZP;
        __syncthreads();
        for (int t = F.tid; t < 2048; t += 512) { const int r = t >> 4, c16 = t & 15;
            *(LAS v4u*)(Vimg + r * 256 + (((c16 >> 1) ^ (r & 7)) << 5) + ((c16 & 1) << 4)) = *(const GAS v4u*)(base + (size_t)r * ZP + Z_RV + h * 128 + c16 * 8); }
        for (int t = F.tid; t < 1024; t += 512) { const int j = t >> 3, dg = t & 7; const bf16* row = base + (size_t)j * ZP + Z_RK + h * 64;
            const u32x2 a = *(const GAS u32x2*)(row + 4 * dg), bb = *(const GAS u32x2*)(row + 32 + 4 * dg);
            const float x1[4] = {bflo(a.x), bfhi(a.x), bflo(a.y), bfhi(a.y)}, x2[4] = {bflo(bb.x), bfhi(bb.x), bflo(bb.y), bfhi(bb.y)};
            const f32x2* cs = R64 + (ch * 128 + j) * 32 + 4 * dg; const float sc = exp2f((float)(127 - j) * l2g);
            float o1[4], o2[4];
#pragma unroll
            for (int e = 0; e < 4; ++e) { const f32x2 tt = cs[e]; o1[e] = (x1[e] * tt.x - x2[e] * tt.y) * sc; o2[e] = (x2[e] * tt.x + x1[e] * tt.y) * sc; }
            u32x2 w1, w2; w1.x = pk2(o1[0], o1[1]); w1.y = pk2(o1[2], o1[3]); w2.x = pk2(o2[0], o2[1]); w2.y = pk2(o2[2], o2[3]);
            const int sw = (j >> 1) & 3; const int d1 = 4 * dg, d2 = 32 + 4 * dg;
            *(LAS u32x2*)(Kimg + j * 128 + ((((2 * d1) >> 5) ^ sw) << 5) + ((2 * d1) & 31)) = w1;
            *(LAS u32x2*)(Kimg + j * 128 + ((((2 * d2) >> 5) ^ sw) << 5) + ((2 * d2) & 31)) = w2; }
        __syncthreads();
        f32x4 acc[4];
#pragma unroll
        for (int db = 0; db < 4; ++db) acc[db] = (f32x4){0.f, 0.f, 0.f, 0.f};
#pragma unroll
        for (int s = 0; s < 4; ++s) {
            const s16x8 vb = ret_bfrag(Vimg, 32 * s, F.wave, g, q, p);
            const int r1 = 32 * s + 4 * g + q, sw = (r1 >> 1) & 3;
#pragma unroll
            for (int db = 0; db < 4; ++db) { const LAS unsigned char* a1 = Kimg + r1 * 128 + ((db ^ sw) << 5) + 8 * p;
                const s16x4 lo = tr16(a1), hi = tr16(a1 + 2048);
                const s16x8 ka = (s16x8){lo[0], lo[1], lo[2], lo[3], hi[0], hi[1], hi[2], hi[3]};
                acc[db] = __builtin_amdgcn_mfma_f32_16x16x32_bf16(ka, vb, acc[db], 0, 0, 0); }
        }
        float* o = RS + (size_t)u * 8192 + 16 * F.wave + c;
#pragma unroll
        for (int db = 0; db < 4; ++db)
#pragma unroll
            for (int r = 0; r < 4; ++r) o[(16 * db + 4 * g + r) * 128] = acc[db][r];
    }
    __syncthreads();
}

__device__ __forceinline__ void ret_scan(const Ctx& F) {
    const float* RS = (const float*)(F.ws + WS_HDN); float* SC = (float*)(F.ws + WS_HDN + 16 * MiB);
    for (int t = blockIdx.x * 512 + F.tid; t < NB * 4 * 8192; t += F.G * 512) {
        const int el = t & 8191, h = (t >> 13) & 3, b = t >> 15; const float wch = exp2f(128.f * ret_l2g(h)); float s = 0.f;
        float L[32];
#pragma unroll
        for (int ch = 0; ch < 32; ++ch) L[ch] = RS[(size_t)(((b * 32 + ch) * 4 + h)) * 8192 + el];
#pragma unroll
        for (int ch = 0; ch < 32; ++ch) { SC[(size_t)(((b * 32 + ch) * 4 + h)) * 8192 + el] = s; s = wch * s + L[ch]; }
    }
}

__device__ __forceinline__ void ret_out_mfma(const Ctx& F, const float* gn, bool dummy_out = false) {
    bf16* Z = (bf16*)(F.ws + WS_Z); const float* SC = (const float*)(F.ws + WS_HDN + 16 * MiB);
    const f32x2* R64 = (const f32x2*)(F.ws + WS_ROPE64);
    LAS unsigned char* Vimg = F.lds; LAS unsigned char* Simg = F.lds + 32768;
    const int lane = F.lane, g = lane >> 4, c = lane & 15, q = (lane >> 2) & 3, p = lane & 3, w = F.wave;
    for (int u = blockIdx.x; u < NB * 32 * 4; u += F.G) {
        const int h = u & 3, ch = (u >> 2) & 31, b = u >> 7; const float l2g = ret_l2g(h); const float gam = exp2f(l2g);
        bf16* base = Z + ((size_t)b * SEQ + ch * 128) * ZP;
        __syncthreads();
        for (int t = F.tid; t < 2048; t += 512) { const int r = t >> 4, c16 = t & 15;
            *(LAS v4u*)(Vimg + r * 256 + (((c16 >> 1) ^ (r & 7)) << 5) + ((c16 & 1) << 4)) = *(const GAS v4u*)(base + (size_t)r * ZP + Z_RV + h * 128 + c16 * 8); }
        for (int t = F.tid; t < 1024; t += 512) { const int r = t >> 4, c16 = t & 15; const float* sp = SC + (size_t)u * 8192 + r * 128 + c16 * 8;
            const f32x4 s0 = *(const GAS f32x4*)sp, s1 = *(const GAS f32x4*)(sp + 4);
            v4u wv; wv.x = pk2(s0.x * gam, s0.y * gam); wv.y = pk2(s0.z * gam, s0.w * gam); wv.z = pk2(s1.x * gam, s1.y * gam); wv.w = pk2(s1.z * gam, s1.w * gam);
            *(LAS v4u*)(Simg + r * 256 + (((c16 >> 1) ^ (r & 7)) << 5) + ((c16 & 1) << 4)) = wv; }
        const int i = 16 * w + c; s16x8 qf[2];
        ret_rope_frag(base + (size_t)i * ZP + Z_RQ + h * 64, R64 + (ch * 128 + i) * 32, 0.125f * exp2f((float)i * l2g), g, qf);
        f32x4 acc[8];
#pragma unroll
        for (int t = 0; t < 8; ++t) { acc[t] = (f32x4){0.f, 0.f, 0.f, 0.f};
            if (t <= w) { const int j = 16 * t + c; s16x8 kf[2];
                ret_rope_frag(base + (size_t)j * ZP + Z_RK + h * 64, R64 + (ch * 128 + j) * 32, exp2f(-(float)j * l2g), g, kf);
                acc[t] = __builtin_amdgcn_mfma_f32_16x16x32_bf16(kf[0], qf[0], acc[t], 0, 0, 0); acc[t] = __builtin_amdgcn_mfma_f32_16x16x32_bf16(kf[1], qf[1], acc[t], 0, 0, 0);
                if (t == w) {
#pragma unroll
                    for (int r = 0; r < 4; ++r) if (4 * g + r > c) acc[t][r] = 0.f; } } }
        s16x8 pf[4];
#pragma unroll
        for (int s = 0; s < 4; ++s) { v4u wv; wv.x = pk2(acc[2 * s][0], acc[2 * s][1]); wv.y = pk2(acc[2 * s][2], acc[2 * s][3]); wv.z = pk2(acc[2 * s + 1][0], acc[2 * s + 1][1]); wv.w = pk2(acc[2 * s + 1][2], acc[2 * s + 1][3]);
            pf[s] = __builtin_bit_cast(s16x8, wv); }
        __syncthreads();
        f32x4 o[8];
#pragma unroll
        for (int eb = 0; eb < 8; ++eb) o[eb] = (f32x4){0.f, 0.f, 0.f, 0.f};
#pragma unroll
        for (int s = 0; s < 4; ++s) if (2 * s <= w) {
#pragma unroll
            for (int eb = 0; eb < 8; ++eb) o[eb] = __builtin_amdgcn_mfma_f32_16x16x32_bf16(pf[s], ret_bfrag(Vimg, 32 * s, eb, g, q, p), o[eb], 0, 0, 0); }
#pragma unroll
        for (int ks = 0; ks < 2; ++ks)
#pragma unroll
            for (int eb = 0; eb < 8; ++eb) o[eb] = __builtin_amdgcn_mfma_f32_16x16x32_bf16(qf[ks], ret_bfrag(Simg, 32 * ks, eb, g, q, p), o[eb], 0, 0, 0);
        float rs[4];
#pragma unroll
        for (int r = 0; r < 4; ++r) { float ss = 0.f;
#pragma unroll
            for (int eb = 0; eb < 8; ++eb) ss += o[eb][r] * o[eb][r];
            ss += sx<1>(ss); ss += sx<2>(ss); ss += sx<4>(ss); ss += sx<8>(ss);
            rs[r] = 1.0f / sqrtf(ss * (1.f / 128) + NORM_EPS); }
#pragma unroll
        for (int r = 0; r < 4; ++r) { bf16* zr = base + (size_t)(16 * w + 4 * g + r) * ZP; bf16* zw = dummy_out ? (bf16*)(F.ws + WS_ZS) + ((size_t)b * SEQ + ch * 128 + 16 * w + 4 * g + r) * 1024 - Z_RV : zr;
#pragma unroll
            for (int eb = 0; eb < 8; ++eb) { const int e = 16 * eb + c; const float rg = bf2f(zr[Z_RG + h * 128 + e]);
                zw[Z_RV + h * 128 + e] = (bf16)f2bf(o[eb][r] * rs[r] * gn[h * 128 + e] * rg * sigmoid_f(rg)); } }
    }
    __syncthreads();
}

__device__ __forceinline__ void fscan_phase(const Ctx& F) {
    const float* LF = (const float*)(F.ws + WS_LF); float* CF = (float*)(F.ws + WS_CF);
    if (F.gw < 32) {
        const int b = F.gw >> 3, h = F.gw & 7; const float* lp = LF + ((size_t)b * SEQ + F.lane * 64) * 8 + h; float s = 0.f;
        for (int i = 0; i < 64; ++i) s += lp[i * 8];
        float incl = s;
#pragma unroll
        for (int o = 1; o < 64; o <<= 1) { const float t = __builtin_bit_cast(float, __builtin_amdgcn_ds_bpermute(((F.lane - o) & 63) << 2, __builtin_bit_cast(int, incl))); if (F.lane >= o) incl += t; }
        float run = incl - s; float* cp = CF + (size_t)F.gw * SEQ + F.lane * 64;
        for (int i = 0; i < 64; ++i) { run += lp[i * 8]; cp[i] = run; }
    }
}
#include <hip/hip_bf16.h>
#include <cmath>
namespace attn_body {
using bf16=__hip_bfloat16;
using bf16x8=__attribute__((ext_vector_type(8)))short;
using s16x4=__attribute__((ext_vector_type(4)))short;
using f32x16=__attribute__((ext_vector_type(16)))float;
using u32x4=__attribute__((ext_vector_type(4)))unsigned;
constexpr int BATCH=4,NHEAD=8,SEQ=4096,D=64,DM=6656;
constexpr int NW=8,QBLK=32,QB=QBLK*NW,KVBLK=64,NQB=SEQ/QB;
constexpr int ATTN_PITCH=DM, ATTN_UNIT_ROWS=QB;
__device__ __forceinline__ int crow(int r,int hi){return (r&3)+8*(r>>2)+4*hi;}
#define SBAR() __builtin_amdgcn_sched_barrier(0)
__device__ __forceinline__ void cmask(f32x16&p0,f32x16&p1,int jb,int qrel,int hi){
  const float NEG=-INFINITY; int kb=64*jb+4*hi;
  #pragma unroll
  for(int r=0;r<16;++r){int kv=kb+(r&3)+8*(r>>2); if(kv>qrel)p0[r]=NEG; if(kv+32>qrel)p1[r]=NEG;}
}

constexpr int NSLOT=3, SLOTB=8192;
constexpr int LDS_K=0, LDS_V=NSLOT*SLOTB, LDS_WS=2*NSLOT*SLOTB, LDS_OST=LDS_WS+NW*64*4, LDS_NC=LDS_OST+NW*4096, LDS_BYTES=LDS_NC+SEQ*4;
constexpr float C2=0.125f*1.4426950408889634f;
__device__ __forceinline__ void glds16(const void*gsrc,unsigned lds_dst){unsigned keep;
  asm volatile("s_mov_b32 %0, m0\n\ts_mov_b32 m0, %2\n\ts_nop 0\n\tglobal_load_lds_dwordx4 %1, off\n\ts_mov_b32 m0, %0":"=&s"(keep):"v"(gsrc),"s"(lds_dst):"memory");}
__device__ __forceinline__ float max3f(float a,float b,float c){float r;asm("v_max3_f32 %0, %1, %2, %3":"=v"(r):"v"(a),"v"(b),"v"(c));return r;}
__device__ __forceinline__ float max2f(float a,float b){float r;asm("v_max_f32_e32 %0, %1, %2":"=v"(r):"v"(a),"v"(b));return r;}
__device__ __forceinline__ float fadd_s(float a,float b){float r;asm("v_add_f32_e32 %0, %1, %2":"=v"(r):"v"(a),"v"(b));return r;}
__device__ __forceinline__ float fsub_s(float a,float b){float r;asm("v_sub_f32_e32 %0, %1, %2":"=v"(r):"v"(a),"v"(b));return r;}
typedef float f32x4_t __attribute__((ext_vector_type(4))); typedef float f32x2_t __attribute__((ext_vector_type(2))); typedef __bf16 bf16x2_t __attribute__((ext_vector_type(2)));
__device__ __forceinline__ unsigned cvtpk_s(float lo,float hi){f32x2_t v={lo,hi};bf16x2_t b=__builtin_convertvector(v,bf16x2_t);return __builtin_bit_cast(unsigned,b);}
#define WAIT_BAR(N) asm volatile("s_waitcnt vmcnt(" #N ") lgkmcnt(0)\n\ts_barrier":::"memory")

__device__ __forceinline__ void qkt(f32x16&p0,f32x16&p1,const char*Kslot,const bf16x8*qr,const f32x16&negm,int r32,int hi){
  const char*kb=Kslot+hi*1024+r32*16;
  #pragma unroll
  for(int d0=0;d0<4;++d0){
    const bf16x8 b0=*reinterpret_cast<const bf16x8*>(kb+d0*2048);
    const bf16x8 b1=*reinterpret_cast<const bf16x8*>(kb+d0*2048+512);
    if(d0==0){p0=__builtin_amdgcn_mfma_f32_32x32x16_bf16(b0,qr[0],negm,0,0,0);p1=__builtin_amdgcn_mfma_f32_32x32x16_bf16(b1,qr[0],negm,0,0,0);}
    else{p0=__builtin_amdgcn_mfma_f32_32x32x16_bf16(b0,qr[d0],p0,0,0,0);p1=__builtin_amdgcn_mfma_f32_32x32x16_bf16(b1,qr[d0],p1,0,0,0);}}
}
typedef __attribute__((address_space(3))) const char* lds_cptr;
typedef short v4i16_t __attribute__((ext_vector_type(4)));
__device__ __forceinline__ void kload8(bf16x8*kf,lds_cptr kp){
  kf[0]=*(const __attribute__((address_space(3))) bf16x8*)(kp);      kf[1]=*(const __attribute__((address_space(3))) bf16x8*)(kp+512);
  kf[2]=*(const __attribute__((address_space(3))) bf16x8*)(kp+2048); kf[3]=*(const __attribute__((address_space(3))) bf16x8*)(kp+2560);
  kf[4]=*(const __attribute__((address_space(3))) bf16x8*)(kp+4096); kf[5]=*(const __attribute__((address_space(3))) bf16x8*)(kp+4608);
  kf[6]=*(const __attribute__((address_space(3))) bf16x8*)(kp+6144); kf[7]=*(const __attribute__((address_space(3))) bf16x8*)(kp+6656);
}
__device__ __forceinline__ void kload2(bf16x8*kf,lds_cptr kp,int j){ kf[2*j]=*(const __attribute__((address_space(3))) bf16x8*)(kp+j*2048); kf[2*j+1]=*(const __attribute__((address_space(3))) bf16x8*)(kp+j*2048+512); }
__device__ __forceinline__ s16x4 vtr(lds_cptr p){ return __builtin_bit_cast(s16x4,__builtin_amdgcn_ds_read_tr16_b64_v4i16((__attribute__((address_space(3))) v4i16_t*)p)); }
__device__ __forceinline__ float rowmax(const f32x16&p0,const f32x16&p1){
  float a=max3f(p0[0],p0[1],p1[0]),b=max3f(p0[2],p0[3],p1[1]);a=max3f(a,p1[2],p1[3]);
  #pragma unroll
  for(int r=4;r<16;r+=4){a=max3f(a,p0[r],p0[r+1]);b=max3f(b,p0[r+2],p0[r+3]);a=max3f(a,p1[r],p1[r+1]);b=max3f(b,p1[r+2],p1[r+3]);}
  const float m=max2f(a,b);
  auto rr=__builtin_amdgcn_permlane32_swap(__float_as_uint(m),__float_as_uint(m),false,false);
  return max2f(__uint_as_float(rr[0]),__uint_as_float(rr[1]));
}
__device__ __forceinline__ void pv(f32x16*o,int vb,bf16x8 pa0,bf16x8 pa1,bf16x8 pa2,bf16x8 pa3){
  #pragma unroll
  for(int d0=0;d0<2;++d0){s16x4 lo[4],hi[4];
    #pragma unroll
    for(int ks=0;ks<4;++ks){
      asm volatile("ds_read_b64_tr_b16 %0,%1 offset:%c2":"=&v"(lo[ks]):"v"(vb),"i"(d0*4096+ks*1024):"memory");
      asm volatile("ds_read_b64_tr_b16 %0,%1 offset:%c2":"=&v"(hi[ks]):"v"(vb),"i"(d0*4096+ks*1024+512):"memory");}
    asm volatile("s_waitcnt lgkmcnt(0)":::"memory");SBAR();
    #define PK(k) (bf16x8){lo[k][0],lo[k][1],lo[k][2],lo[k][3],hi[k][0],hi[k][1],hi[k][2],hi[k][3]}
    o[d0]=__builtin_amdgcn_mfma_f32_32x32x16_bf16(pa0,PK(0),o[d0],0,0,0);
    o[d0]=__builtin_amdgcn_mfma_f32_32x32x16_bf16(pa1,PK(1),o[d0],0,0,0);
    o[d0]=__builtin_amdgcn_mfma_f32_32x32x16_bf16(pa2,PK(2),o[d0],0,0,0);
    o[d0]=__builtin_amdgcn_mfma_f32_32x32x16_bf16(pa3,PK(3),o[d0],0,0,0);
    #undef PK
  }
}

#ifndef ATTN_STORE16
#define ATTN_STORE16(p,v) (*(u32x4*)(p)=(v))
#endif
template<int THRL> __device__ __forceinline__ void attn_unit(int b,int h,int qb,const bf16*Q,const bf16*__restrict__ K,const bf16*__restrict__ V,bf16*O,const float*CF,float dskip,char*shm,int wave_id){
  int tid_=(wave_id<<6)|lane_id_v(); asm volatile("":"+v"(tid_));
  const int tid=tid_,lane=tid&63,r32=lane&31,hi=lane>>5; const int wid=__builtin_amdgcn_readfirstlane(tid>>6);
  const long rowbase=(long)b*SEQ; const int q0=qb*QB;
  const bf16*Qw=Q+(rowbase+q0+wid*QBLK)*DM+h*D;
  const float*cfp0=CF+(long)(b*NHEAD+h)*SEQ; const int NT0=(q0+QB)/KVBLK;
  int ts; { const float cq=cfp0[q0]; const int il=(lane<NT0)?64*lane+63:q0; const bool keep=(lane<NT0)&&(cfp0[il]<cq+dskip);
    const unsigned long long km=__ballot(keep); int t0=(int)__builtin_ctzll(km|(1ull<<63)); t0&=~1; ts=__builtin_amdgcn_readfirstlane(t0<NT0-4?t0:NT0-4); }
  const bf16*Kh=K+(rowbase+(long)ts*KVBLK)*DM+h*D,*Vh=V+(rowbase+(long)ts*KVBLK)*DM+h*D;
  const unsigned lds0=(unsigned)(uintptr_t)shm;
  float*wsf=(float*)(shm+LDS_WS)+wid*64;
  const bf16*ksrc=Kh+(long)lane*DM+wid*8;
  const bf16*vsrc=Vh+(long)(16*(wid&3)+(lane>>2))*DM+(wid>>2)*32+(lane&3)*8;
  const unsigned kdst=lds0+LDS_K+wid*1024, vdst=lds0+LDS_V+wid*1024;
  #define DMA_K(t,slot) glds16(ksrc+(long)(t)*KVBLK*DM,(unsigned)__builtin_amdgcn_readfirstlane(kdst+(slot)))
  #define DMA_V(t,slot) glds16(vsrc+(long)(t)*KVBLK*DM,(unsigned)__builtin_amdgcn_readfirstlane(vdst+(slot)))
  const char*Kbase=shm+LDS_K; bf16x8 kf[8];
  const lds_cptr shm3=(lds_cptr)shm; const lds_cptr kp0=shm3+LDS_K+hi*1024+r32*16; const lds_cptr vp0=shm3+LDS_V+((lane>>4)&1)*32+(lane&3)*8+(4*hi+((lane&15)>>2))*64;
  const int NT=NT0-ts;
  { const float*cfp=CF+(long)(b*NHEAD+h)*SEQ; float*ncw=(float*)(shm+LDS_NC);
    for(int i=tid+ts*KVBLK;i<q0+QB;i+=NW*64)ncw[i-ts*KVBLK]=-cfp[i]; }
  const lds_cptr ncp=(lds_cptr)shm+LDS_NC+hi*16;
  #define ADDC(P0,P1,t) do{ const lds_cptr np_=ncp+(t)*256; _Pragma("unroll") for(int g_=0;g_<4;++g_){ \
      const f32x4_t a_=*(const __attribute__((address_space(3))) f32x4_t*)(np_+g_*32), b_=*(const __attribute__((address_space(3))) f32x4_t*)(np_+g_*32+128); \
      P0[4*g_]+=a_[0];P0[4*g_+1]+=a_[1];P0[4*g_+2]+=a_[2];P0[4*g_+3]+=a_[3]; P1[4*g_]+=b_[0];P1[4*g_+1]+=b_[1];P1[4*g_+2]+=b_[2];P1[4*g_+3]+=b_[3]; } }while(0)
  DMA_K(0,0);DMA_V(0,0);DMA_K(1,SLOTB);
  bf16x8 qr[4];
  #pragma unroll
  for(int d0=0;d0<4;++d0)qr[d0]=*reinterpret_cast<const bf16x8*>(&Qw[(long)r32*DM+d0*16+hi*8]);
  float mhat=0.f,l_reg=0.f;f32x16 o[2];f32x16 negm; { float zz_; asm volatile("v_mov_b32 %0, 0":"=v"(zz_));
    _Pragma("unroll") for(int r=0;r<16;++r){o[0][r]=zz_;o[1][r]=zz_;negm[r]=zz_;} } asm volatile("":"+v"(negm));
  const int qrel=wid*QBLK+r32;
  #define CMASK(P0,P1,t) do{int jb_=(t)-(NT-4); if(jb_>=0)cmask(P0,P1,jb_,qrel,hi);}while(0)
  bool resc=false;
  #define START(P0,P1) do{ const float rm=rowmax(P0,P1); resc=false; \
    { const float dl=rm; mhat=fadd_s(mhat,dl); \
      _Pragma("unroll") for(int r=0;r<16;++r){P0[r]=fsub_s(P0[r],dl);P1[r]=fsub_s(P1[r],dl);} \
      _Pragma("unroll") for(int r=0;r<16;++r)negm[r]=-mhat; asm volatile("":"+v"(negm)); } \
    _Pragma("unroll") for(int r=0;r<16;++r)P0[r]=__builtin_amdgcn_exp2f(P0[r]); }while(0)
  #define RESC() do{ if(resc){ asm volatile("s_waitcnt lgkmcnt(0)":::"memory"); \
      _Pragma("unroll") for(int d_=0;d_<2;++d_) _Pragma("unroll") for(int r=0;r<16;++r)o[d_][r]*=wsf[crow(r,hi)]; } }while(0)
  f32x16 pA0,pA1,pB0,pB1;
  int sl_prev=0,sl_cur=0,sl_next=SLOTB;
  #define ROT() do{sl_prev=sl_cur;sl_cur=sl_next;sl_next=(sl_next==(NSLOT-1)*SLOTB)?0:sl_next+SLOTB;}while(0)
  DMA_K(2,2*SLOTB);
  WAIT_BAR(3);
  qkt(pA0,pA1,Kbase,qr,negm,r32,hi);asm volatile("s_nop 15\n\ts_nop 7":"+v"(pA0),"+v"(pA1));ADDC(pA0,pA1,0);CMASK(pA0,pA1,0);
  START(pA0,pA1);
  _Pragma("unroll") for(int r=0;r<16;++r)pA1[r]=__builtin_amdgcn_exp2f(pA1[r]);
  WAIT_BAR(0);
  DMA_K(3,0);DMA_V(1,SLOTB);
  ROT();
  kload8(kf,kp0+sl_cur);
  WAIT_BAR(2);
  s16x4 vlo[8],vhi[8]; u32x4 pw0,pw1,pw2,pw3;
  #define PKW(P,B) cvtpk_s(P[B],P[B+1])
  #define PAF(k) __builtin_bit_cast(bf16x8,pw##k)
  #define VFR(i) (bf16x8){vlo[i][0],vlo[i][1],vlo[i][2],vlo[i][3],vhi[i][0],vhi[i][1],vhi[i][2],vhi[i][3]}
  #define PIN(x) asm volatile("":"+v"(x))
  #define MX3(a,b,c) __builtin_fmaxf(__builtin_fmaxf((a),(b)),(c))
  #define GAPA(MF,A0,A1,A2,A3,W0,W1,PW) do{ MF; sacc+=A0; sacc+=A1; sacc+=A2; sacc+=A3; PIN(sacc); W0; W1; PIN(PW); SBAR(); }while(0)
  #define EX(v) __builtin_amdgcn_exp2f(v)
  #define GAPB(MF,X,B) do{ MF; X[B]=EX(X[B]); X[B+1]=EX(X[B+1]); X[B+2]=EX(X[B+2]); X[B+3]=EX(X[B+3]); PIN(X); SBAR(); }while(0)
  #define VRD(i) do{ vlo[i]=vtr(vp_+(((i)>>2)*4096+((i)&3)*1024)); vhi[i]=vtr(vp_+(((i)>>2)*4096+((i)&3)*1024+512)); }while(0)
  #define KRD(G,j) do{ if(G){ kload2(kf,kp0+sl_next,j); SBAR(); } }while(0)
  #define STEP(C0,C1,P0,P1,t,GK,GV,GL) do{ SBAR(); \
    const lds_cptr vp_=vp0+sl_prev; \
    VRD(0); SBAR(); float sacc=(P0[0]+P0[1]); \
    GAPA(C0=__builtin_amdgcn_mfma_f32_32x32x16_bf16(kf[0],qr[0],negm,0,0,0), P0[2],P0[3],P0[4],P0[5],     pw0[0]=PKW(P0,0), pw0[1]=PKW(P0,2), pw0); \
    VRD(4); SBAR(); GAPA(C1=__builtin_amdgcn_mfma_f32_32x32x16_bf16(kf[1],qr[0],negm,0,0,0), P0[6],P0[7],P0[8],P0[9],     pw0[2]=PKW(P0,4), pw0[3]=PKW(P0,6), pw0); \
    VRD(1); SBAR(); GAPA(C0=__builtin_amdgcn_mfma_f32_32x32x16_bf16(kf[2],qr[1],C0,0,0,0),   P0[10],P0[11],P0[12],P0[13], pw1[0]=PKW(P0,8), pw1[1]=PKW(P0,10), pw1); \
    VRD(5); SBAR(); GAPA(C1=__builtin_amdgcn_mfma_f32_32x32x16_bf16(kf[3],qr[1],C1,0,0,0),   P0[14],P0[15],P1[0],P1[1],   pw1[2]=PKW(P0,12),pw1[3]=PKW(P0,14), pw1); \
    VRD(2); SBAR(); GAPA(C0=__builtin_amdgcn_mfma_f32_32x32x16_bf16(kf[4],qr[2],C0,0,0,0),   P1[2],P1[3],P1[4],P1[5],     pw2[0]=PKW(P1,0), pw2[1]=PKW(P1,2), pw2); \
    VRD(6); SBAR(); GAPA(C1=__builtin_amdgcn_mfma_f32_32x32x16_bf16(kf[5],qr[2],C1,0,0,0),   P1[6],P1[7],P1[8],P1[9],     pw2[2]=PKW(P1,4), pw2[3]=PKW(P1,6), pw2); \
    VRD(3); SBAR(); GAPA(C0=__builtin_amdgcn_mfma_f32_32x32x16_bf16(kf[6],qr[3],C0,0,0,0),   P1[10],P1[11],P1[12],P1[13], pw3[0]=PKW(P1,8), pw3[1]=PKW(P1,10), pw3); \
    VRD(7); SBAR(); GAPA(C1=__builtin_amdgcn_mfma_f32_32x32x16_bf16(kf[7],qr[3],C1,0,0,0),   P1[14],P1[15],0.f,0.f,       pw3[2]=PKW(P1,12),pw3[3]=PKW(P1,14), pw3); \
    l_reg+=sacc; \
    if(GK){DMA_K((t)+3,sl_cur);} if(GV){DMA_V((t)+1,sl_next);} \
    ADDC(C0,C1,t); CMASK(C0,C1,t); \
    { float a=MX3(C0[0],C0[1],C1[0]),b=MX3(C0[2],C0[3],C1[1]); a=MX3(a,C1[2],C1[3]); \
      _Pragma("unroll") for(int r=4;r<16;r+=4){a=MX3(a,C0[r],C0[r+1]);b=MX3(b,C0[r+2],C0[r+3]);a=MX3(a,C1[r],C1[r+1]);b=MX3(b,C1[r+2],C1[r+3]);} \
      float rm=__builtin_fmaxf(a,b); { auto rr=__builtin_amdgcn_permlane32_swap(__float_as_uint(rm),__float_as_uint(rm),false,false); rm=__builtin_fmaxf(__uint_as_float(rr[0]),__uint_as_float(rr[1])); } \
      resc=false; \
      if(__builtin_expect(__any(rm>(float)THRL),0)){ const float dl=__builtin_fmaxf(rm,0.f); mhat+=dl; \
        _Pragma("unroll") for(int r=0;r<16;++r){C0[r]-=dl;C1[r]-=dl;} \
        _Pragma("unroll") for(int r=0;r<16;++r)negm[r]=-mhat; asm volatile("":"+v"(negm)); \
        const float f=__builtin_amdgcn_exp2f(-dl); l_reg*=f; if(hi==0)wsf[r32]=f; resc=true; } } \
    SBAR(); \
    GAPB(o[0]=__builtin_amdgcn_mfma_f32_32x32x16_bf16(PAF(0),VFR(0),o[0],0,0,0), C0,0); \
    GAPB(o[1]=__builtin_amdgcn_mfma_f32_32x32x16_bf16(PAF(0),VFR(4),o[1],0,0,0), C0,4); \
    KRD(GL,0); GAPB(o[0]=__builtin_amdgcn_mfma_f32_32x32x16_bf16(PAF(1),VFR(1),o[0],0,0,0), C0,8); \
    KRD(GL,1); GAPB(o[1]=__builtin_amdgcn_mfma_f32_32x32x16_bf16(PAF(1),VFR(5),o[1],0,0,0), C0,12); \
    KRD(GL,2); GAPB(o[0]=__builtin_amdgcn_mfma_f32_32x32x16_bf16(PAF(2),VFR(2),o[0],0,0,0), C1,0); \
    KRD(GL,3); GAPB(o[1]=__builtin_amdgcn_mfma_f32_32x32x16_bf16(PAF(2),VFR(6),o[1],0,0,0), C1,4); \
    GAPB(o[0]=__builtin_amdgcn_mfma_f32_32x32x16_bf16(PAF(3),VFR(3),o[0],0,0,0), C1,8); \
    GAPB(o[1]=__builtin_amdgcn_mfma_f32_32x32x16_bf16(PAF(3),VFR(7),o[1],0,0,0), C1,12); \
    }while(0)
  int t=1;
  #undef CMASK
  #define CMASK(P0,P1,t) do{}while(0)
  for(;t+5<NT;t+=2){
    STEP(pB0,pB1,pA0,pA1,t,true,true,true);     WAIT_BAR(2); RESC(); ROT();
    STEP(pA0,pA1,pB0,pB1,t+1,true,true,true);   WAIT_BAR(2); RESC(); ROT();
  }
  #undef CMASK
  #define CMASK(P0,P1,t) do{int jb_=(t)-(NT-4); if(jb_>=0)cmask(P0,P1,jb_,qrel,hi);}while(0)
  #define ENDW(tt) do{ if((tt)+3<NT){WAIT_BAR(2);} else if((tt)+2<NT){WAIT_BAR(1);} else {WAIT_BAR(0);} }while(0)
  for(;t+1<NT;t+=2){
    STEP(pB0,pB1,pA0,pA1,t,(t+3<NT),(t+1<NT),(t+1<NT));       ENDW(t);   RESC(); ROT();
    STEP(pA0,pA1,pB0,pB1,t+1,(t+4<NT),(t+2<NT),(t+2<NT));     ENDW(t+1); RESC(); ROT();
  }
  STEP(pB0,pB1,pA0,pA1,NT-1,false,false,false); RESC();
  { float sacc=pB0[0]+pB0[1]; _Pragma("unroll") for(int r=2;r<16;++r)sacc+=pB0[r]; _Pragma("unroll") for(int r=0;r<16;++r)sacc+=pB1[r]; l_reg+=sacc;
    pw0=(u32x4){PKW(pB0,0),PKW(pB0,2),PKW(pB0,4),PKW(pB0,6)};pw1=(u32x4){PKW(pB0,8),PKW(pB0,10),PKW(pB0,12),PKW(pB0,14)};pw2=(u32x4){PKW(pB1,0),PKW(pB1,2),PKW(pB1,4),PKW(pB1,6)};pw3=(u32x4){PKW(pB1,8),PKW(pB1,10),PKW(pB1,12),PKW(pB1,14)};
    int tl_=lane_id_v(); asm volatile("":"+v"(tl_)); const int ln_=tl_&63,hi_=ln_>>5; const int vb0e=(int)(lds0+LDS_V)+((ln_>>4)&1)*32+(ln_&3)*8+(4*hi_+((ln_&15)>>2))*64;
    SBAR(); pv(o,vb0e+sl_cur,PAF(0),PAF(1),PAF(2),PAF(3)); }
  #undef PKW
  #undef PAF
  #undef VFR
  #undef PIN
  #undef MX3
  #undef GAPA
  #undef GAPB
  #undef EX
  #undef VRD
  #undef KRD
  #undef STEP
  #undef ENDW
  {auto rr=__builtin_amdgcn_permlane32_swap(__float_as_uint(l_reg),__float_as_uint(l_reg),false,false);l_reg=__uint_as_float(rr[0])+__uint_as_float(rr[1]);}
  int te_=lane_id_v(); asm volatile("":"+v"(te_)); const int lane_e=te_&63,r32_e=lane_e&31,hi_e=lane_e>>5;
  if(hi_e==0)wsf[32+r32_e]=l_reg;asm volatile("s_waitcnt lgkmcnt(0)":::"memory");
  float rli[16];
  #pragma unroll
  for(int r=0;r<16;++r)rli[r]=__builtin_amdgcn_rcpf(wsf[32+crow(r,hi_e)]);
  bf16*Ow=O+(rowbase+q0+wid*QBLK)*DM+h*D;
  { bf16*stg=(bf16*)(shm+LDS_OST)+wid*2048;
    #pragma unroll
    for(int r=0;r<16;++r){const int orow=crow(r,hi_e);
      #pragma unroll
      for(int d0=0;d0<2;++d0)stg[orow*64+d0*32+r32_e]=__float2bfloat16(o[d0][r]*rli[r]);}
    asm volatile("s_waitcnt lgkmcnt(0)":::"memory");
    #pragma unroll
    for(int i=0;i<4;++i){const int row=i*8+(lane_e>>3),ch=lane_e&7; const u32x4 v=*(const u32x4*)(stg+row*64+ch*8); ATTN_STORE16(Ow+(long)row*DM+ch*8,v);} }
  asm volatile("s_waitcnt lgkmcnt(0)\n\ts_barrier":::"memory");
  #undef ADDC
  #undef DMA_K
  #undef DMA_V
  #undef CMASK
  #undef START
  #undef RESC
  #undef ROT
}
constexpr int ATTN_LDS_BYTES=LDS_BYTES;
struct AttnTensors { const bf16* Q; const bf16* K; const bf16* V; bf16* O; const float* CF; float dskip; };
struct AttnUnit { int bh; int qb; };
struct StaticOrder {
  int vcu;
  __device__ __forceinline__ explicit StaticOrder(int grid,int block):vcu((block%8)*(grid/8)+block/8){}
  __device__ __forceinline__ bool next(int i,AttnUnit&u)const{ if(i>=2)return false; const int s=vcu&7; u.bh=vcu>>3; u.qb=(i==0)?s:15-s; return true; }
  __device__ __forceinline__ void a_ready(const AttnUnit&)const{}
  __device__ __forceinline__ void done(const AttnUnit&)const{}
};
template<class Sched,int THRL=8> __device__ __forceinline__ void attn_phase(char*lds,const AttnTensors&T,const Sched&S,int wave_id){
  AttnUnit u;
  for(int i=0;S.next(i,u);++i){ S.a_ready(u); attn_unit<THRL>(u.bh/NHEAD,u.bh%NHEAD,u.qb,T.Q,T.K,T.V,T.O,T.CF,T.dskip,lds,wave_id); S.done(u); }
}
#undef SBAR
#undef WAIT_BAR
}

struct Args { const float* in[16]; float* out; unsigned char* ws; };
__global__ void __launch_bounds__(NWAVES * 64, 2) hyb_fwd(Args args) {
    extern __shared__ __attribute__((aligned(16))) unsigned char lds[];
    Ctx F;
    F.lds = (LAS unsigned char*)lds;
    F.tid = threadIdx.x; F.lane = F.tid & 63; F.wave = __builtin_amdgcn_readfirstlane(F.tid >> 6);
    F.G = gridDim.x; F.gw = blockIdx.x * NWAVES + F.wave; F.NGW = F.G * NWAVES;
    F.out = args.out; F.ws = args.ws;
    volatile LAS unsigned* MISC = (volatile LAS unsigned*)(F.lds + MISC_OFF);
    for (int u = F.tid; u < (LDS_BYTES - LDSCTL_OFF) / 4; u += NWAVES * 64) ((LAS unsigned*)(F.lds + LDSCTL_OFF))[u] = 0u;
    __syncthreads();
    gu32* ctl = (gu32*)(F.ws + WS_CTL);
    XcdBarrier bar = xcd_barrier_post((unsigned*)(ctl + CW_BAR), MISC + 8); bar.w = F.wave;
#define FRESH(P) Ctx P = F; P.tid = (F.wave << 6) | lane_id_v(); asm volatile("" : "+v"(P.tid), "+s"(P.wave), "+s"(P.gw), "+s"(P.ws), "+s"(P.out)); P.lane = P.tid & 63
#define GRID_BAR() do { XcdBarrier b_ = bar; asm volatile("" : "+s"(b_.bar), "+s"(b_.x)); xcd_barrier(b_); } while (0)

    bf16* Wb = (bf16*)(F.ws + WS_W);
    bf16* Z = (bf16*)(F.ws + WS_Z); float* ZS = (float*)(F.ws + WS_ZS); bf16* HDN = (bf16*)(F.ws + WS_HDN);
    float* M32 = (float*)(F.ws + WS_HDN); bf16* HB = (bf16*)(F.ws + WS_Z);
    LAS unsigned char* ring = F.lds + RING_OFF; float* SSp = (float*)(F.ws + WS_SS);

    { FRESH(P); p0_prologue(P, args.in[2], args.in[9], args.in[10], args.in[11], args.in[12], args.in[14], args.in[15]); }
    { FRESH(P); norm0_phase(P, args.in[0], args.in[1], (bf16*)(P.ws + WS_HDN), (float*)(P.ws + WS_SS)); }
    GRID_BAR();

    #pragma unroll 1
    for (int layer = 0; layer < DEPTH; ++layer) {
        const float* xin = (layer == 0) ? args.in[0] : F.out;
        const bf16* L = Wb + (size_t)layer * LW_STRIDE;
        { pg8::Gemm g{HDN, L + LW_IN, M, NIN, DM, DM, DM}; pg8::StaticOrder S; S.init(M, NIN, F.G, (int)blockIdx.x);
          pg8::EpiZ E{Z, ZS, SSp};
          pg8::gemm_phase<pg8::EpiZ, pg8::StaticOrder, true, true>(ring, g, S, E, F.wave); }
        GRID_BAR();
#ifdef PROBE_PP
        { FRESH(P); post_phase(P, args.in[4] + layer * 64, args.in[5] + layer * 64, args.in[6] + layer * 64, args.in[7] + layer * 64, args.in[3] + layer * 8, true); }
#endif
        { FRESH(P); post_phase(P, args.in[4] + layer * 64, args.in[5] + layer * 64, args.in[6] + layer * 64, args.in[7] + layer * 64, args.in[3] + layer * 8); }
        { FRESH(P); ret_state_mfma(P); }
        GRID_BAR();
        { FRESH(P); fscan_phase(P); }
        { FRESH(P); ret_scan(P); }
        GRID_BAR();
#ifdef PROBE_RO
        { FRESH(P); ret_out_mfma(P, args.in[8] + layer * 512, true); }
#endif
        { FRESH(P); ret_out_mfma(P, args.in[8] + layer * 512); }
#ifdef PROBE_X3
        for (int rep_ = 0; rep_ < 2; ++rep_)
        { static_assert(attn_body::ATTN_LDS_BYTES <= RING_BYTES, "attention scratch fits the ring region");
          unsigned char* wsl = F.ws; asm volatile("" : "+s"(wsl));
          bf16* Zl = (bf16*)(wsl + WS_Z);
          const attn_body::AttnTensors AT{(const attn_body::bf16*)(Zl + Z_FQ), (const attn_body::bf16*)(Zl + Z_FK), (const attn_body::bf16*)(Zl + Z_FV), (attn_body::bf16*)(Zl + (rep_ == 0 ? Z_RQ : Z_FQ)), (const float*)(wsl + WS_CF)};
          const attn_body::StaticOrder S((int)F.G, (int)blockIdx.x);
          attn_body::attn_phase<attn_body::StaticOrder, 20>((char*)lds + RING_OFF, AT, S, F.wave); }
#ifdef PROBE_X4
        { FRESH(P); dsa_v3(P); }
#else
        for (int rep_ = 0; rep_ < 2; ++rep_) { FRESH(P); dsa_v3(P, rep_ == 0 ? Z_RG : Z_DQ); }
#endif
#else
        { static_assert(attn_body::ATTN_LDS_BYTES <= RING_BYTES, "attention scratch fits the ring region");
          unsigned char* wsl = F.ws; asm volatile("" : "+s"(wsl));
          bf16* Zl = (bf16*)(wsl + WS_Z);
          float dskip; { const int ln = lane_id_v(); const float gq = wave_max(fabsf(args.in[4][layer * 64 + ln])), gk = wave_max(fabsf(args.in[5][layer * 64 + ln])); dskip = 2.0f * (64.0f * C2 * gq * gk * 1.02f) + 48.0f; }
          const attn_body::AttnTensors AT{(const attn_body::bf16*)(Zl + Z_FQ), (const attn_body::bf16*)(Zl + Z_FK), (const attn_body::bf16*)(Zl + Z_FV), (attn_body::bf16*)(Zl + Z_FQ), (const float*)(wsl + WS_CF), dskip};
          const attn_body::StaticOrder S((int)F.G, (int)blockIdx.x);
          attn_body::attn_phase<attn_body::StaticOrder, 20>((char*)lds + RING_OFF, AT, S, F.wave); }
        { FRESH(P); dsa_v3(P); }
#endif
        GRID_BAR();
        { pg8::StaticOrder S; S.init(M, DM, F.G, (int)blockIdx.x);
          { pg8::Gemm g{Z + Z_FQ, L + LW_MIX, M, DM, 512, ZP, 512}; pg8::EpiGate<0> E{Z + Z_ZG, M32, Z + Z_MRG};
            pg8::gemm_phase<pg8::EpiGate<0>, pg8::StaticOrder, false, true>(ring, g, S, E, F.wave); }
          { pg8::Gemm g{Z + Z_DQ, L + LW_MIX + 512 * 1024, M, DM, 512, ZP, 512}; pg8::EpiGate<1> E{Z + Z_ZG, M32, Z + Z_MRG};
            pg8::gemm_phase<pg8::EpiGate<1>, pg8::StaticOrder, false, true>(ring, g, S, E, F.wave); }
          { pg8::Gemm g{Z + Z_RV, L + LW_MIX + 1024 * 1024, M, DM, 512, ZP, 512}; pg8::EpiGate<2> E{Z + Z_ZG, M32, Z + Z_MRG};
            pg8::gemm_phase<pg8::EpiGate<2>, pg8::StaticOrder, false, true>(ring, g, S, E, F.wave); } }
        GRID_BAR();
        { pg8::Gemm g{Z + Z_MRG, L + LW_O, M, DM, DM, ZP, DM}; pg8::StaticOrder S; S.init(M, DM, F.G, (int)blockIdx.x);
          pg8::EpiRes E{xin, F.out, args.in[13] + layer * DM, HDN, SSp};
          pg8::gemm_phase<pg8::EpiRes, pg8::StaticOrder, false, true>(ring, g, S, E, F.wave); }
        GRID_BAR();
        { pg8::Gemm g{HDN, L + LW_FI, M, FF2, DM, DM, DM}; pg8::StaticOrder S; S.init(M, FF2, F.G, (int)blockIdx.x);
          pg8::EpiSwi E{HB, FFH, SSp};
          pg8::gemm_phase<pg8::EpiSwi, pg8::StaticOrder, true, true>(ring, g, S, E, F.wave); }
        GRID_BAR();
        { pg8::Gemm g{HB, L + LW_FO, M, DM, FFH, FFH, FFH}; pg8::StaticOrder S; S.init(M, DM, F.G, (int)blockIdx.x);
          pg8::EpiRes E{F.out, F.out, args.in[1] + (layer + 1 < DEPTH ? layer + 1 : layer) * DM, HDN, SSp};
          pg8::gemm_phase<pg8::EpiRes, pg8::StaticOrder, false, true>(ring, g, S, E, F.wave); }
        GRID_BAR();
    }
    if (__hip_atomic_load((gu32*)((unsigned*)(ctl + CW_BAR) + XB_TMO), RLX_AGENT) != 0u) {
        const float q = __builtin_nanf("");
        for (int m = F.gw; m < M; m += F.NGW) { GAS f32x4* o = (GAS f32x4*)(F.out + (size_t)m * DM) + lane_id_v();
#pragma unroll
            for (int j = 0; j < 4; ++j) o[64 * j] = (f32x4){q, q, q, q}; }
    }
}

extern "C" void kernel_launch(void* const* d_in, const int* in_sizes, int n_in, void* d_out, int out_size, void* d_ws, size_t ws_size, hipStream_t stream) {
    static int grid = 0;
    if (grid == 0) {
        if (n_in != 16 || in_sizes[0] != M * DM || out_size != M * DM || ws_size < WS_END) { fprintf(stderr, "kernel_launch: unexpected shapes / workspace (n_in %d, in0 %d, out %d, ws %zu < %zu)\n", n_in, n_in > 0 ? in_sizes[0] : -1, out_size, ws_size, (size_t)WS_END); grid = -1; return; }
        int dev = 0, cus = 0, per_cu = 0;
        if (hipGetDevice(&dev) != hipSuccess || hipDeviceGetAttribute(&cus, hipDeviceAttributeMultiprocessorCount, dev) != hipSuccess) { grid = -1; return; }
        if (hipFuncSetAttribute((const void*)hyb_fwd, hipFuncAttributeMaxDynamicSharedMemorySize, LDS_BYTES) != hipSuccess) { fprintf(stderr, "kernel_launch: hipFuncSetAttribute failed\n"); grid = -1; return; }
        if (hipOccupancyMaxActiveBlocksPerMultiprocessor(&per_cu, (const void*)hyb_fwd, NWAVES * 64, LDS_BYTES) != hipSuccess || per_cu < 1) { fprintf(stderr, "kernel_launch: occupancy query reports %d blocks per CU\n", per_cu); }
        (void)hipGetLastError();
        grid = cus;
    }
    if (grid < 0) return;
    if (hipMemsetAsync((char*)d_ws + WS_CTL, 0, CTL_ZERO_BYTES, stream) != hipSuccess) return;
    Args a{};
    for (int i = 0; i < 16; ++i) a.in[i] = (const float*)d_in[i];
    a.out = (float*)d_out; a.ws = (unsigned char*)d_ws;
    hipLaunchKernelGGL(hyb_fwd, dim3(grid), dim3(NWAVES * 64), LDS_BYTES, stream, a);
}
```

```cpp
#include <hip/hip_runtime.h>
#include <cstdio>
#include <cstdint>
#include <cmath>
__device__ __forceinline__ int lane_id_v() { unsigned z; asm volatile("v_mov_b32 %0, 0" : "=v"(z)); return (int)__builtin_amdgcn_mbcnt_hi(~0u, __builtin_amdgcn_mbcnt_lo(~0u, z)); }
template <int MASK> __device__ __forceinline__ float sx(float v) { static_assert(MASK < 32, "swizzle xor mask"); return __builtin_bit_cast(float, __builtin_amdgcn_ds_swizzle(__builtin_bit_cast(int, v), 0x1F | (MASK << 10))); }
template <int MASK> __device__ __forceinline__ unsigned sxu(unsigned v) { return (unsigned)__builtin_amdgcn_ds_swizzle((int)v, 0x1F | (MASK << 10)); }
__device__ __forceinline__ void swap32(unsigned x, unsigned& lo_view, unsigned& hi_view) {
    unsigned a = x, b = x; asm volatile("" : "+v"(b));
    const auto rr = __builtin_amdgcn_permlane32_swap(a, b, false, false);
    lo_view = rr[0]; hi_view = rr[1];
}
template <int CTRL> __device__ __forceinline__ float dpp_f(float v) { return __builtin_bit_cast(float, __builtin_amdgcn_update_dpp(0, __builtin_bit_cast(int, v), CTRL, 0xF, 0xF, false)); }
template <int CTRL> __device__ __forceinline__ int dpp_i(int v) { return __builtin_amdgcn_update_dpp(0, v, CTRL, 0xF, 0xF, false); }
__device__ __forceinline__ float rl_f(float v, int l) { return __builtin_bit_cast(float, __builtin_amdgcn_readlane(__builtin_bit_cast(int, v), l)); }
__device__ __forceinline__ float wave_sum(float v) {
    v += dpp_f<0xB1>(v); v += dpp_f<0x4E>(v); v += dpp_f<0x141>(v); v += dpp_f<0x140>(v);
    return (rl_f(v, 0) + rl_f(v, 16)) + (rl_f(v, 32) + rl_f(v, 48));
}
__device__ __forceinline__ float wave_max(float v) {
    v = fmaxf(v, dpp_f<0xB1>(v)); v = fmaxf(v, dpp_f<0x4E>(v)); v = fmaxf(v, dpp_f<0x141>(v)); v = fmaxf(v, dpp_f<0x140>(v));
    return fmaxf(fmaxf(rl_f(v, 0), rl_f(v, 16)), fmaxf(rl_f(v, 32), rl_f(v, 48)));
}
__device__ __forceinline__ int wave_isum(int v) {
    v += dpp_i<0xB1>(v); v += dpp_i<0x4E>(v); v += dpp_i<0x141>(v); v += dpp_i<0x140>(v);
    return (__builtin_amdgcn_readlane(v, 0) + __builtin_amdgcn_readlane(v, 16)) + (__builtin_amdgcn_readlane(v, 32) + __builtin_amdgcn_readlane(v, 48));
}
__device__ __forceinline__ unsigned wave_umax(unsigned v) {
    unsigned t; t = (unsigned)dpp_i<0xB1>((int)v); v = t > v ? t : v; t = (unsigned)dpp_i<0x4E>((int)v); v = t > v ? t : v; t = (unsigned)dpp_i<0x141>((int)v); v = t > v ? t : v; t = (unsigned)dpp_i<0x140>((int)v); v = t > v ? t : v;
    const unsigned a = (unsigned)__builtin_amdgcn_readlane((int)v, 0), b = (unsigned)__builtin_amdgcn_readlane((int)v, 16), c = (unsigned)__builtin_amdgcn_readlane((int)v, 32), d = (unsigned)__builtin_amdgcn_readlane((int)v, 48);
    const unsigned ab = a > b ? a : b, cd = c > d ? c : d; return ab > cd ? ab : cd;
}
__device__ __forceinline__ unsigned wave_umin(unsigned v) { return ~wave_umax(~v); }
__device__ __forceinline__ float half_sum(float v) {
    unsigned a, b; swap32(__builtin_bit_cast(unsigned, v), a, b); return __builtin_bit_cast(float, a) + __builtin_bit_cast(float, b);
}
__device__ __forceinline__ float half_max(float v) {
    unsigned a, b; swap32(__builtin_bit_cast(unsigned, v), a, b); return fmaxf(__builtin_bit_cast(float, a), __builtin_bit_cast(float, b));
}
namespace pg8 {
#define PG8_LAS __attribute__((address_space(3)))
typedef unsigned short bf16_t;
typedef short bf16x8 __attribute__((ext_vector_type(8)));
typedef float f32x4 __attribute__((ext_vector_type(4)));
typedef unsigned u32x4 __attribute__((ext_vector_type(4)));
constexpr int BM = 256, BK = 64, HALF = 128, HTB = HALF * BK * 2  , STAGE_BYTES = 8 * HTB, NXCD = 8, WGM = 8;

__host__ __device__ __forceinline__ int lds_byte(int r, int c) { const int st = (r >> 4) * 2 + (c >> 5), rr = r & 15, cc = c & 31, ob = rr * 64 + cc * 2; return st * 1024 + (ob ^ (((ob >> 9) & 1) << 5)); }
__host__ __device__ __forceinline__ void stage_rc(int b, int& R, int& C) { const int st = b / 1024, sb = b % 1024, swz = sb ^ (((sb >> 9) & 1) << 5); R = (st >> 1) * 16 + swz / 64; C = (st & 1) * 32 + (swz % 64) / 2; }
__host__ __device__ __forceinline__ int perm32(int rho) { const int n = rho >> 4, i = rho & 15; return 8 * (i >> 2) + 4 * n + (i & 3); }

struct Unit { int pm, pn; };
struct Gemm { const bf16_t* A; const bf16_t* Bt; int M, N, K, lda, ldb; };

struct StaticOrder {
    int nM, nN, nwg, G, c;
    __host__ __device__ void init(int M, int N, int G_, int c_) { nM = M / BM; nN = N / BM; nwg = nM * nN; G = G_; c = c_; }
    __host__ __device__ bool next(int i, Unit& u) const {
        const long L = (long)i * G + c; if (L >= nwg) return false;
        int wgid = (int)L; { const int q = nwg / NXCD, r = nwg % NXCD, xcd = wgid % NXCD, off = wgid / NXCD; wgid = (xcd < r ? xcd * (q + 1) : r * (q + 1) + (xcd - r) * q) + off; }
        const int nig = WGM * nN, gid = wgid / nig, fm = gid * WGM, gsz = (nM - fm) < WGM ? (nM - fm) : WGM;
        u.pm = fm + ((wgid % nig) % gsz); u.pn = (wgid % nig) / gsz; return true;
    }
    __device__ __forceinline__ void a_ready(const Unit&) const {}
    __device__ __forceinline__ void done(const Unit&) const {}
};

__device__ __forceinline__ unsigned cvt_pk_bf16(float lo, float hi) { unsigned r; asm volatile("v_cvt_pk_bf16_f32 %0, %1, %2" : "=v"(r) : "v"(lo), "v"(hi)); return r; }
__device__ __forceinline__ float bflo(unsigned w) { return __builtin_bit_cast(float, w << 16); }
__device__ __forceinline__ float bfhi(unsigned w) { return __builtin_bit_cast(float, w & 0xffff0000u); }
__device__ __forceinline__ float sigmoidf_(float x) { return __builtin_amdgcn_rcpf(1.0f + __builtin_amdgcn_exp2f(-1.4426950408889634f * x)); }

constexpr int ZP = 6656;
constexpr int ZSP = 512;
constexpr int NZT = 26, GATE_T0 = 14;

__device__ __forceinline__ float row_rstd(const float* SS, int row) {
    const f32x4 a = *(const f32x4*)(SS + (size_t)row * 16), b = *(const f32x4*)(SS + (size_t)row * 16 + 4), c = *(const f32x4*)(SS + (size_t)row * 16 + 8), d = *(const f32x4*)(SS + (size_t)row * 16 + 12);
    const float s = ((a[0] + a[1]) + (a[2] + a[3])) + ((b[0] + b[1]) + (b[2] + b[3])) + ((c[0] + c[1]) + (c[2] + c[3])) + ((d[0] + d[1]) + (d[2] + d[3]));
    return 1.0f / __builtin_sqrtf(s * (1.0f / 1024.0f) + 1e-6f);
}
struct EpiZ {
    static constexpr bool PERM = true, AFTER_DRAIN = false, MID = false;
    bf16_t* Z; float* ZS; const float* SS;
    __device__ __forceinline__ void operator()(const f32x4 (&acc)[2][2][4][2], const Unit& u, int wr, int wc, int fr, int fq) const {
        const int row0 = u.pm * BM + wr * 64 + fr;
        if (u.pn < NZT) {
            const int col0 = u.pn * BM + wc * 32 + 8 * fq;
#pragma unroll
            for (int ai = 0; ai < 2; ++ai)
#pragma unroll
                for (int m = 0; m < 4; ++m) { bf16_t* rowp = Z + (size_t)(row0 + ai * HALF + m * 16) * ZP + col0; const float rs = row_rstd(SS, row0 + ai * HALF + m * 16);
#pragma unroll
                    for (int bj = 0; bj < 2; ++bj) { f32x4 v0 = acc[ai][bj][m][0] * rs, v1 = acc[ai][bj][m][1] * rs;
                        if (u.pn >= GATE_T0) {
#pragma unroll
                            for (int i = 0; i < 4; ++i) { v0[i] = sigmoidf_(v0[i]); v1[i] = sigmoidf_(v1[i]); } }
                        u32x4 w; w.x = cvt_pk_bf16(v0[0], v0[1]); w.y = cvt_pk_bf16(v0[2], v0[3]); w.z = cvt_pk_bf16(v1[0], v1[1]); w.w = cvt_pk_bf16(v1[2], v1[3]);
                        *(u32x4*)(rowp + bj * HALF) = w; } }
        } else {
            const int col0 = (u.pn - NZT) * BM + wc * 32 + 8 * fq;
#pragma unroll
            for (int ai = 0; ai < 2; ++ai)
#pragma unroll
                for (int m = 0; m < 4; ++m) { float* rowp = ZS + (size_t)(row0 + ai * HALF + m * 16) * ZSP + col0; const float rs = row_rstd(SS, row0 + ai * HALF + m * 16);
#pragma unroll
                    for (int bj = 0; bj < 2; ++bj) { *(f32x4*)(rowp + bj * HALF) = acc[ai][bj][m][0] * rs; *(f32x4*)(rowp + bj * HALF + 4) = acc[ai][bj][m][1] * rs; } }
        }
    }
};

template <int P> struct EpiGate {
    static constexpr bool PERM = true, AFTER_DRAIN = false, MID = false;
    const bf16_t* G;
    float* M32;
    bf16_t* OUT;
    __device__ __forceinline__ void operator()(const f32x4 (&acc)[2][2][4][2], const Unit& u, int wr, int wc, int fr, int fq) const {
        const int row0 = u.pm * BM + wr * 64 + fr, col0 = u.pn * BM + wc * 32 + 8 * fq;
#pragma unroll
        for (int ai = 0; ai < 2; ++ai)
#pragma unroll
            for (int m = 0; m < 4; ++m) { const size_t row = (size_t)(row0 + ai * HALF + m * 16);
#pragma unroll
                for (int bj = 0; bj < 2; ++bj) { const int col = col0 + bj * HALF;
                    const u32x4 gw = *(const u32x4*)(G + row * ZP + P * 1024 + col);
                    const f32x4 v0 = acc[ai][bj][m][0], v1 = acc[ai][bj][m][1];
                    f32x4 t0, t1;
                    t0[0] = bflo(gw.x) * v0[0]; t0[1] = bfhi(gw.x) * v0[1]; t0[2] = bflo(gw.y) * v0[2]; t0[3] = bfhi(gw.y) * v0[3];
                    t1[0] = bflo(gw.z) * v1[0]; t1[1] = bfhi(gw.z) * v1[1]; t1[2] = bflo(gw.w) * v1[2]; t1[3] = bfhi(gw.w) * v1[3];
                    float* mp = M32 + row * 1024 + col;
                    if (P == 0) { *(f32x4*)mp = t0; *(f32x4*)(mp + 4) = t1; }
                    else if (P == 1) { *(f32x4*)mp = *(const f32x4*)mp + t0; *(f32x4*)(mp + 4) = *(const f32x4*)(mp + 4) + t1; }
                    else { t0 = *(const f32x4*)mp + t0; t1 = *(const f32x4*)(mp + 4) + t1;
                        u32x4 w; w.x = cvt_pk_bf16(t0[0], t0[1]); w.y = cvt_pk_bf16(t0[2], t0[3]); w.z = cvt_pk_bf16(t1[0], t1[1]); w.w = cvt_pk_bf16(t1[2], t1[3]);
                        *(u32x4*)(OUT + row * ZP + col) = w; } } }
    }
};

struct EpiGateF {
    static constexpr bool PERM = true, AFTER_DRAIN = false, MID = true;
    const bf16_t* G; bf16_t* OUT;
    __device__ __forceinline__ void mid(f32x4 (&acc)[2][2][4][2], const Unit& u, int wr, int wc, int fr_, int fq_, int s) const {
        int fr = fr_, fq = fq_; asm volatile("" : "+v"(fr), "+v"(fq));
        const int row0 = u.pm * BM + wr * 64 + fr, col0 = u.pn * BM + wc * 32 + 8 * fq;
#pragma unroll
        for (int ai = 0; ai < 2; ++ai)
#pragma unroll
            for (int m = 0; m < 4; ++m) { const size_t row = (size_t)(row0 + ai * HALF + m * 16);
#pragma unroll
                for (int bj = 0; bj < 2; ++bj) { const bf16_t* gp = G + row * ZP + s * 1024 + col0 + bj * HALF;
                    const u32x4 a = *(const u32x4*)gp, b = *(const u32x4*)(gp + 1024);
                    f32x4 r0, r1;
                    r0[0] = bflo(a.x) * __builtin_amdgcn_rcpf(bflo(b.x)); r0[1] = bfhi(a.x) * __builtin_amdgcn_rcpf(bfhi(b.x)); r0[2] = bflo(a.y) * __builtin_amdgcn_rcpf(bflo(b.y)); r0[3] = bfhi(a.y) * __builtin_amdgcn_rcpf(bfhi(b.y));
                    r1[0] = bflo(a.z) * __builtin_amdgcn_rcpf(bflo(b.z)); r1[1] = bfhi(a.z) * __builtin_amdgcn_rcpf(bfhi(b.z)); r1[2] = bflo(a.w) * __builtin_amdgcn_rcpf(bflo(b.w)); r1[3] = bfhi(a.w) * __builtin_amdgcn_rcpf(bfhi(b.w));
                    acc[ai][bj][m][0] = acc[ai][bj][m][0] * r0; acc[ai][bj][m][1] = acc[ai][bj][m][1] * r1; }
                __builtin_amdgcn_sched_barrier(0); }
    }
    __device__ __forceinline__ void operator()(const f32x4 (&acc)[2][2][4][2], const Unit& u, int wr, int wc, int fr, int fq) const {
        const int row0 = u.pm * BM + wr * 64 + fr, col0 = u.pn * BM + wc * 32 + 8 * fq;
#pragma unroll
        for (int ai = 0; ai < 2; ++ai)
#pragma unroll
            for (int m = 0; m < 4; ++m) { const size_t row = (size_t)(row0 + ai * HALF + m * 16);
#pragma unroll
                for (int bj = 0; bj < 2; ++bj) { const int col = col0 + bj * HALF;
                    const u32x4 gw = *(const u32x4*)(G + row * ZP + 2 * 1024 + col);
                    const f32x4 v0 = acc[ai][bj][m][0], v1 = acc[ai][bj][m][1];
                    u32x4 w; w.x = cvt_pk_bf16(bflo(gw.x) * v0[0], bfhi(gw.x) * v0[1]); w.y = cvt_pk_bf16(bflo(gw.y) * v0[2], bfhi(gw.y) * v0[3]);
                    w.z = cvt_pk_bf16(bflo(gw.z) * v1[0], bfhi(gw.z) * v1[1]); w.w = cvt_pk_bf16(bflo(gw.w) * v1[2], bfhi(gw.w) * v1[3]);
                    *(u32x4*)(OUT + row * ZP + col) = w; } }
    }
};

struct EpiRes {
    static constexpr bool PERM = true, AFTER_DRAIN = false, MID = false;
    const float* RES; float* OUT; const float* G; bf16_t* XG; float* SS;
    __device__ __forceinline__ void operator()(const f32x4 (&acc)[2][2][4][2], const Unit& u, int wr, int wc, int fr, int fq) const {
        const int row0 = u.pm * BM + wr * 64 + fr, col0 = u.pn * BM + wc * 32 + 8 * fq;
        f32x4 g[2][2];
#pragma unroll
        for (int bj = 0; bj < 2; ++bj) { g[bj][0] = *(const f32x4*)(G + col0 + bj * HALF); g[bj][1] = *(const f32x4*)(G + col0 + bj * HALF + 4); }
#pragma unroll
        for (int ai = 0; ai < 2; ++ai)
#pragma unroll
            for (int m = 0; m < 4; ++m) { const int row = row0 + ai * HALF + m * 16; const size_t off = (size_t)row * 1024 + col0; float ss = 0.f;
#pragma unroll
                for (int bj = 0; bj < 2; ++bj) { const float* rp = RES + off + bj * HALF; float* op = OUT + off + bj * HALF;
                    const f32x4 v0 = *(const f32x4*)rp + acc[ai][bj][m][0], v1 = *(const f32x4*)(rp + 4) + acc[ai][bj][m][1];
                    *(f32x4*)op = v0; *(f32x4*)(op + 4) = v1;
                    ss += ((v0[0] * v0[0] + v0[1] * v0[1]) + (v0[2] * v0[2] + v0[3] * v0[3])) + ((v1[0] * v1[0] + v1[1] * v1[1]) + (v1[2] * v1[2] + v1[3] * v1[3]));
                    const f32x4 x0 = v0 * g[bj][0], x1 = v1 * g[bj][1];
                    u32x4 w; w.x = cvt_pk_bf16(x0[0], x0[1]); w.y = cvt_pk_bf16(x0[2], x0[3]); w.z = cvt_pk_bf16(x1[0], x1[1]); w.w = cvt_pk_bf16(x1[2], x1[3]);
                    *(u32x4*)(XG + off + bj * HALF) = w; }
                ss += sx<16>(ss); { unsigned a, b; swap32(__builtin_bit_cast(unsigned, ss), a, b); ss = __builtin_bit_cast(float, a) + __builtin_bit_cast(float, b); }
                if (fq == 0) SS[(size_t)row * 16 + u.pn * 4 + wc] = ss; }
    }
};

struct EpiSwi {
    static constexpr bool PERM = true, AFTER_DRAIN = false, MID = false;
    bf16_t* H; int ldh; const float* SS;
    __device__ __forceinline__ void operator()(const f32x4 (&acc)[2][2][4][2], const Unit& u, int wr, int wc, int fr, int fq) const {
        const int row0 = u.pm * BM + wr * 64 + fr, col0 = u.pn * HALF + wc * 32 + 8 * fq;
#pragma unroll
        for (int ai = 0; ai < 2; ++ai)
#pragma unroll
            for (int m = 0; m < 4; ++m) { bf16_t* hp = H + (size_t)(row0 + ai * HALF + m * 16) * ldh + col0; const float rs = row_rstd(SS, row0 + ai * HALF + m * 16);
                float o[8];
#pragma unroll
                for (int n = 0; n < 2; ++n)
#pragma unroll
                    for (int i = 0; i < 4; ++i) { const float g = acc[ai][0][m][n][i] * rs, up = acc[ai][1][m][n][i] * rs; o[4 * n + i] = g * sigmoidf_(g) * up; }
                u32x4 w; w.x = cvt_pk_bf16(o[0], o[1]); w.y = cvt_pk_bf16(o[2], o[3]); w.z = cvt_pk_bf16(o[4], o[5]); w.w = cvt_pk_bf16(o[6], o[7]);
                *(u32x4*)hp = w; }
    }
};

template <class Epi, class Sched, bool ALIGN_EPI = false, bool SP2 = false>
__device__ __forceinline__ void gemm_phase(PG8_LAS unsigned char* lds, Gemm g, const Sched& S0, const Epi& E, int wave_id) {
    int ovz, osz; asm volatile("v_mov_b32 %0, 0\n\ts_mov_b32 %1, 0" : "=v"(ovz), "=s"(osz));
    Sched S = S0; S.c += osz; g.lda += osz; g.ldb += osz;
    const int tid = ((wave_id << 6) | lane_id_v()) + ovz,
         wid = __builtin_amdgcn_readfirstlane(tid >> 6), lane = tid & 63, wr = wid >> 2, wc = wid & 3, fr = lane & 15, fq = lane >> 4;
    const int K = g.K, nt = K / BK;
    unsigned voffA[2], voffB[2];
#pragma unroll
    for (int i = 0; i < 2; ++i) { int R, C; stage_rc(tid * 16 + i * 8192, R, C); const int Rb = Epi::PERM ? ((R & ~31) + perm32(R & 31)) : R;
        voffA[i] = (unsigned)(R * g.lda + C) * 2u; voffB[i] = (unsigned)(Rb * g.ldb + C) * 2u; }
    const size_t kstep = (size_t)(BK * 2);
    const size_t hstepA = (size_t)HALF * g.lda * 2, hstepB = (size_t)HALF * g.ldb * 2;
    const size_t tstepA = 2 * hstepA, tstepB = 2 * hstepB;
    const unsigned ldsw = (unsigned)wid * 1024u;
    const int aoff = lds_byte(wr * 64 + fr, fq * 8), boff = lds_byte(wc * 32 + fr, fq * 8);
#define PG8_SA(b, h) (((b) * 2 + (h)) * HTB)
#define PG8_SB(b, h) ((4 + (b) * 2 + (h)) * HTB)
#define PG8_STAGE(bufoff, gbase, voff) do { _Pragma("unroll") for (int _i = 0; _i < 2; ++_i) \
        __builtin_amdgcn_global_load_lds((const unsigned*)((const char*)(gbase) + (voff)[_i]), (PG8_LAS unsigned*)(lds + (bufoff) + ldsw + _i * 8192), 16, 0, 0); } while (0)
#define PG8_LDA(dst, b, h) do { _Pragma("unroll") for (int m = 0; m < 4; ++m) _Pragma("unroll") for (int k = 0; k < 2; ++k) dst[m][k] = *(const PG8_LAS bf16x8*)(lds + PG8_SA(b, h) + aoff + m * 2048 + k * 1024); } while (0)
#define PG8_LDB(dst, b, h) do { _Pragma("unroll") for (int n = 0; n < 2; ++n) _Pragma("unroll") for (int k = 0; k < 2; ++k) dst[n][k] = *(const PG8_LAS bf16x8*)(lds + PG8_SB(b, h) + boff + n * 2048 + k * 1024); } while (0)
#define PG8_MMA(ai, bj, At, Bt) do { __builtin_amdgcn_s_setprio(1); _Pragma("unroll") for (int m = 0; m < 4; ++m) _Pragma("unroll") for (int n = 0; n < 2; ++n) _Pragma("unroll") for (int k = 0; k < 2; ++k) \
        acc[ai][bj][m][n] = __builtin_amdgcn_mfma_f32_16x16x32_bf16(Bt[n][k], At[m][k], acc[ai][bj][m][n], 0, 0, 0); __builtin_amdgcn_s_setprio(0); } while (0)
#define PG8_WAIT_V(n) asm volatile("s_waitcnt vmcnt(" #n ")" ::: "memory")
#define PG8_WAIT_L(n) asm volatile("s_waitcnt lgkmcnt(" #n ")" ::: "memory")
#define PG8_BAR __builtin_amdgcn_s_barrier()
#define PG8_SCHED __builtin_amdgcn_sched_barrier(0)
    Unit cur, nxt; int ui = 0;
    if (!S.next(0, cur)) return;
    f32x4 acc[2][2][4][2];
#pragma unroll
    for (int a = 0; a < 2; ++a)
#pragma unroll
        for (int b = 0; b < 2; ++b)
#pragma unroll
            for (int m = 0; m < 4; ++m)
#pragma unroll
                for (int n = 0; n < 2; ++n) acc[a][b][m][n] = (f32x4){0.f, 0.f, 0.f, 0.f};
    bf16x8 At[4][2], B0[2][2], B1[2][2];
    const char* cA = (const char*)g.A + (size_t)cur.pm * tstepA; const char* cB = (const char*)g.Bt + (size_t)cur.pn * tstepB;
    S.a_ready(cur);
    if constexpr (SP2) {
        PG8_STAGE(PG8_SB(0, 0), cB, voffB); PG8_STAGE(PG8_SB(0, 1), cB + hstepB, voffB); PG8_STAGE(PG8_SA(0, 0), cA, voffA); PG8_STAGE(PG8_SA(0, 1), cA + hstepA, voffA);
        if (wr == 1) PG8_BAR;
        PG8_WAIT_V(2); PG8_BAR;
        PG8_STAGE(PG8_SB(1, 0), cB + kstep, voffB); PG8_STAGE(PG8_SA(1, 0), cA + kstep, voffA); PG8_STAGE(PG8_SB(1, 1), cB + hstepB + kstep, voffB);
        PG8_WAIT_V(6); PG8_BAR;
    } else {
        PG8_STAGE(PG8_SB(0, 0), cB, voffB); PG8_STAGE(PG8_SA(0, 0), cA, voffA); PG8_STAGE(PG8_SB(0, 1), cB + hstepB, voffB); PG8_STAGE(PG8_SA(0, 1), cA + hstepA, voffA);
        if (wr == 1) PG8_BAR;
        PG8_WAIT_V(4); PG8_BAR;
        PG8_STAGE(PG8_SB(1, 0), cB + kstep, voffB); PG8_STAGE(PG8_SA(1, 0), cA + kstep, voffA); PG8_STAGE(PG8_SB(1, 1), cB + hstepB + kstep, voffB);
        PG8_WAIT_V(6); PG8_BAR;
    }
    for (;;) {
        const bool has_next = S.next(ui + 1, nxt);
        const char* nA = has_next ? (const char*)g.A + (size_t)nxt.pm * tstepA : cA; const char* nB = has_next ? (const char*)g.Bt + (size_t)nxt.pn * tstepB : cB;
        for (int t = 0; t < nt; t += 2) {
            if constexpr (Epi::MID) { if (t == 8 || t == 16) E.mid(acc, cur, wr, wc, fr, fq, (t >> 3) - 1); }
            const bool last = (t == nt - 2);
            const char* a1 = cA + (size_t)(t + 1) * kstep;
            const char* a2 = last ? nA : cA + (size_t)(t + 2) * kstep; const char* b2 = last ? nB : cB + (size_t)(t + 2) * kstep;
            const char* a3 = a2 + kstep; const char* b3 = b2 + kstep;
            if (last && has_next) S.a_ready(nxt);
            if constexpr (SP2) {
            PG8_LDB(B0, 0, 0); PG8_LDB(B1, 0, 1); PG8_SCHED; PG8_LDA(At, 0, 0); PG8_STAGE(PG8_SA(1, 1), a1 + hstepA, voffA);
            PG8_WAIT_V(8); PG8_WAIT_L(0); PG8_BAR; PG8_MMA(0, 0, At, B0); PG8_MMA(0, 1, At, B1); PG8_BAR; PG8_SCHED;
            PG8_LDA(At, 0, 1); PG8_STAGE(PG8_SB(0, 0), b2, voffB); PG8_STAGE(PG8_SB(0, 1), b2 + hstepB, voffB); PG8_STAGE(PG8_SA(0, 0), a2, voffA);
            PG8_WAIT_V(8); PG8_WAIT_L(0); PG8_BAR; PG8_MMA(1, 0, At, B0); PG8_MMA(1, 1, At, B1); PG8_BAR; PG8_SCHED;
            PG8_LDB(B0, 1, 0); PG8_LDB(B1, 1, 1); PG8_SCHED; PG8_LDA(At, 1, 0); PG8_STAGE(PG8_SA(0, 1), a2 + hstepA, voffA);
            PG8_WAIT_V(8); PG8_WAIT_L(0); PG8_BAR; PG8_MMA(0, 0, At, B0); PG8_MMA(0, 1, At, B1); PG8_BAR; PG8_SCHED;
            PG8_LDA(At, 1, 1); PG8_STAGE(PG8_SB(1, 0), b3, voffB); PG8_STAGE(PG8_SB(1, 1), b3 + hstepB, voffB); PG8_STAGE(PG8_SA(1, 0), a3, voffA);
            PG8_WAIT_V(8); PG8_WAIT_L(0); PG8_BAR; PG8_MMA(1, 0, At, B0); PG8_MMA(1, 1, At, B1); PG8_BAR; PG8_SCHED;
            } else {
            PG8_LDB(B0, 0, 0); PG8_SCHED; PG8_LDA(At, 0, 0); PG8_STAGE(PG8_SA(1, 1), a1 + hstepA, voffA);
            PG8_WAIT_L(8); PG8_BAR; PG8_WAIT_L(0); PG8_MMA(0, 0, At, B0); PG8_BAR; PG8_SCHED;
            PG8_LDB(B1, 0, 1); PG8_STAGE(PG8_SB(0, 0), b2, voffB);
            PG8_BAR; PG8_WAIT_L(0); PG8_MMA(0, 1, At, B1); PG8_BAR;
            PG8_LDA(At, 0, 1); PG8_STAGE(PG8_SA(0, 0), a2, voffA);
            PG8_BAR; PG8_WAIT_L(0); PG8_MMA(1, 0, At, B0); PG8_BAR; PG8_SCHED;
            PG8_STAGE(PG8_SB(0, 1), b2 + hstepB, voffB);
            PG8_WAIT_V(6); PG8_BAR; PG8_MMA(1, 1, At, B1); PG8_BAR;
            PG8_LDB(B0, 1, 0); PG8_SCHED; PG8_LDA(At, 1, 0); PG8_STAGE(PG8_SA(0, 1), a2 + hstepA, voffA);
            PG8_WAIT_L(8); PG8_BAR; PG8_WAIT_L(0); PG8_MMA(0, 0, At, B0); PG8_BAR; PG8_SCHED;
            PG8_LDB(B1, 1, 1); PG8_STAGE(PG8_SB(1, 0), b3, voffB);
            PG8_BAR; PG8_WAIT_L(0); PG8_MMA(0, 1, At, B1); PG8_BAR;
            PG8_LDA(At, 1, 1); PG8_STAGE(PG8_SA(1, 0), a3, voffA);
            PG8_BAR; PG8_WAIT_L(0); PG8_MMA(1, 0, At, B0); PG8_BAR; PG8_SCHED;
            PG8_STAGE(PG8_SB(1, 1), b3 + hstepB, voffB);
            PG8_WAIT_V(6); PG8_BAR; PG8_MMA(1, 1, At, B1); PG8_BAR;
            }
        }
        if constexpr (ALIGN_EPI) { if (wr == 0) PG8_BAR; }
        if constexpr (!Epi::AFTER_DRAIN) { E(acc, cur, wr, wc, fr, fq); S.done(cur); }
        if (!has_next) break;
#pragma unroll
        for (int a = 0; a < 2; ++a)
#pragma unroll
            for (int b = 0; b < 2; ++b)
#pragma unroll
                for (int m = 0; m < 4; ++m)
#pragma unroll
                    for (int n = 0; n < 2; ++n) acc[a][b][m][n] = (f32x4){0.f, 0.f, 0.f, 0.f};
        cur = nxt; cA = nA; cB = nB; ++ui;
        if constexpr (ALIGN_EPI) { if (wr == 1) PG8_BAR; }
    }
    PG8_WAIT_V(0);
    if constexpr (!ALIGN_EPI) { if (wr == 0) PG8_BAR; }
    PG8_BAR;
    if constexpr (Epi::AFTER_DRAIN) { E.fused(acc, cur, wr, wc, fr, fq, lds, wid, lane); S.done(cur); }
#undef PG8_SA
#undef PG8_SB
#undef PG8_STAGE
#undef PG8_LDA
#undef PG8_LDB
#undef PG8_MMA
#undef PG8_WAIT_V
#undef PG8_WAIT_L
#undef PG8_BAR
#undef PG8_SCHED
}
}

constexpr int NB = 4, SEQ = 4096, DM = 1024, DEPTH = 4, M = NB * SEQ;
constexpr int INC = 7088;
constexpr int NIN = 7168;
constexpr int FFH = 2816, FF2 = 5632;
constexpr int ZP = pg8::ZP, ZSP = pg8::ZSP;
constexpr int Z_FQ = 0, Z_DQ = 512, Z_RV = 1024, Z_FK = 1536, Z_FV = 2048,
     Z_RQ = 2560, Z_RK = 2816, Z_RG = 3072, Z_ZG = 3584, Z_MRG = 2560;
constexpr int S_IQ = 0, S_DK = 256, S_DV = 320, S_IK = 384, S_IW = 416, S_FF = 424;
constexpr float NORM_EPS = 1e-6f;
constexpr float LOG2E = 1.4426950408889634f;
constexpr float C2 = 0.125f * 1.4426950408889634f;

constexpr size_t MiB = 1u << 20;
constexpr size_t WS_CTL = 0, CTL_ZERO_BYTES = 1 * MiB;
constexpr size_t WS_ROPE64 = 1 * MiB;
constexpr size_t WS_ROPE32 = 2 * MiB;
constexpr size_t WS_LF = 2 * MiB + 512 * 1024;
constexpr size_t WS_CF = 3 * MiB;
constexpr size_t WS_ISG = 3 * MiB + 512 * 1024;
constexpr size_t WS_KD = 4 * MiB;
constexpr size_t WS_VD = 6 * MiB;
constexpr size_t WS_W = 8 * MiB;
constexpr size_t LW_IN = 0, LW_MIX = (size_t)NIN * 1024, LW_O = LW_MIX + 1536 * 1024, LW_FI = LW_O + 1024 * 1024, LW_FO = LW_FI + (size_t)FF2 * 1024, LW_STRIDE = LW_FO + (size_t)FFH * 1024;
constexpr size_t WS_Z = 150 * MiB;
constexpr size_t WS_HDN = 358 * MiB;
constexpr size_t WS_ZS = 390 * MiB;
constexpr size_t WS_IQB = 422 * MiB;
constexpr size_t WS_IKB = 430 * MiB;
constexpr size_t WS_SS = 431 * MiB;
constexpr size_t WS_END = 432 * MiB;
static_assert(WS_W + DEPTH * LW_STRIDE * 2 <= WS_Z && WS_Z + (size_t)M * ZP * 2 <= WS_HDN && WS_HDN + (size_t)M * 1024 * 2 == WS_ZS && WS_ZS + (size_t)M * ZSP * 4 == WS_IQB, "d_ws map");
constexpr int CW_BAR = 4096;

constexpr int RING_OFF = 0, RING_BYTES = 133120;
constexpr int LDSCTL_OFF = RING_BYTES, MISC_OFF = LDSCTL_OFF + 320;
constexpr int XTRA_OFF = RING_BYTES + 1024;
constexpr int LDS_BYTES = 147456;
constexpr int NWAVES = 8;
#define GAS __attribute__((address_space(1)))
#define LAS __attribute__((address_space(3)))
typedef unsigned short bf16;
typedef unsigned v4u __attribute__((ext_vector_type(4)));
typedef float f32x4 __attribute__((ext_vector_type(4)));
typedef short bf16x8 __attribute__((ext_vector_type(8)));
typedef GAS unsigned gu32;
typedef GAS unsigned long long gu64;
#define RLX_AGENT __ATOMIC_RELAXED, __HIP_MEMORY_SCOPE_AGENT
#define LDS_WAIT() asm volatile("s_waitcnt lgkmcnt(0)" ::: "memory")
#define VM_WAIT() asm volatile("s_waitcnt vmcnt(0)" ::: "memory")
__device__ __forceinline__ unsigned long long rt() { return __builtin_amdgcn_s_memrealtime(); }
__device__ __forceinline__ unsigned f2bf(float f) { unsigned u = __builtin_bit_cast(unsigned, f); return (u + 0x7fffu + ((u >> 16) & 1u)) >> 16; }
__device__ __forceinline__ unsigned pk2(float lo, float hi) { return f2bf(lo) | (f2bf(hi) << 16); }

#define XB_TMO      128
#define XB_XCNT(j)  (256  + 64 * (j))
#define XB_XSUB(j)  (1280 + 64 * (j))
#define XB_XGEN(j)  (2304 + 64 * (j))
#define XB_TOP      3328
#define XB_TOPGEN   3392
#define XCD_BAR_WORDS 3456
#define XB_SPIN_CAP (1u << 22)

__device__ __forceinline__ unsigned xb_ld(unsigned* p)              { return __hip_atomic_load(p, __ATOMIC_RELAXED, __HIP_MEMORY_SCOPE_AGENT); }
__device__ __forceinline__ unsigned xb_add(unsigned* p, unsigned v) { return __hip_atomic_fetch_add(p, v, __ATOMIC_RELAXED, __HIP_MEMORY_SCOPE_AGENT); }
__device__ __forceinline__ unsigned xb_xcc_id() { return (unsigned)__builtin_amdgcn_s_getreg((3 << 11) | 20) & 0xFu; }
#define XB_SPIN(cond, bar) do { unsigned _sp = 0; while (cond) { __builtin_amdgcn_s_sleep(1); \
    if ((++_sp & 255u) == 0u) { if (xb_ld(&(bar)[XB_TMO])) break; if (_sp > XB_SPIN_CAP) { atomicAdd(&(bar)[XB_TMO], 1u); break; } } } } while (0)

struct XcdBarrier {
    unsigned* bar; unsigned x; int w;
    volatile LAS unsigned* st;
};

__device__ __forceinline__ XcdBarrier xcd_barrier_post(unsigned* bar, volatile LAS unsigned* st) {
    XcdBarrier b; b.bar = bar; b.x = xb_xcc_id(); b.st = st; b.w = 0;
    if (threadIdx.x == 0) (void)xb_add(&bar[XB_XCNT(b.x)], 1u);
    return b;
}
__device__ __forceinline__ void xcd_barrier_complete(unsigned* bar, unsigned x, unsigned& nloc, unsigned& nx) {
    const unsigned G = gridDim.x * gridDim.y * gridDim.z;
    unsigned sum, cnt, mine, sp = 0u;
    for (;;) {
        sum = 0u; cnt = 0u; mine = 0u;
#pragma unroll
        for (unsigned j = 0; j < 16; ++j) { const unsigned c = xb_ld(&bar[XB_XCNT(j)]); sum += c; cnt += (c > 0u) ? 1u : 0u; mine = (j == x) ? c : mine; }
        if (sum == G) break;
        __builtin_amdgcn_s_sleep(1);
        if ((++sp & 255u) == 0u) { if (xb_ld(&bar[XB_TMO])) break; if (sp > XB_SPIN_CAP) { atomicAdd(&bar[XB_TMO], 1u); break; } }
    }
    nloc = mine > 0u ? mine : 1u; nx = cnt > 0u ? cnt : 1u;
}

__device__ __forceinline__ void xcd_barrier(const XcdBarrier& b) {
    asm volatile("s_waitcnt vmcnt(0)" ::: "memory");
    __syncthreads();
    if (b.w == 0 && lane_id_v() == 0) {
        unsigned* bar = b.bar;
        __builtin_amdgcn_s_waitcnt(0);
        unsigned nloc = b.st[0], nx = b.st[1];
        if (nloc == 0u) { xcd_barrier_complete(bar, b.x, nloc, nx); b.st[0] = nloc; b.st[1] = nx; }
        const unsigned old = xb_add(&bar[XB_XSUB(b.x)], 1u);
        const unsigned gen = old / nloc;
        if (old + 1u == (gen + 1u) * nloc) {
            __builtin_amdgcn_fence(__ATOMIC_RELEASE, "agent");
            asm volatile("s_waitcnt vmcnt(0)" ::: "memory");
            const unsigned og = xb_add(&bar[XB_TOP], 1u);
            const unsigned tg = og / nx;
            if (og + 1u == (tg + 1u) * nx) xb_add(&bar[XB_TOPGEN], 1u);
            else XB_SPIN(xb_ld(&bar[XB_TOPGEN]) == tg, bar);
            __builtin_amdgcn_fence(__ATOMIC_ACQUIRE, "agent");
            xb_add(&bar[XB_XGEN(b.x)], 1u);
            asm volatile("s_waitcnt vmcnt(0)" ::: "memory");
        } else {
            XB_SPIN(xb_ld(&bar[XB_XGEN(b.x)]) == gen, bar);
            __builtin_amdgcn_fence(__ATOMIC_ACQUIRE, "agent");
            asm volatile("s_waitcnt vmcnt(0)" ::: "memory");
        }
    }
    __syncthreads();
}

typedef float f32x2 __attribute__((ext_vector_type(2)));
typedef unsigned u32x2 __attribute__((ext_vector_type(2)));
__device__ __forceinline__ float bflo(unsigned w) { return __builtin_bit_cast(float, w << 16); }
__device__ __forceinline__ float bfhi(unsigned w) { return __builtin_bit_cast(float, w & 0xffff0000u); }
__device__ __forceinline__ float bf2f(bf16 v) { return __builtin_bit_cast(float, (unsigned)v << 16); }
__device__ __forceinline__ void unpack8(const v4u w, float (&f)[8]) { f[0] = bflo(w.x); f[1] = bfhi(w.x); f[2] = bflo(w.y); f[3] = bfhi(w.y); f[4] = bflo(w.z); f[5] = bfhi(w.z); f[6] = bflo(w.w); f[7] = bfhi(w.w); }
__device__ __forceinline__ v4u pack8(const float (&f)[8]) { v4u w; w.x = pk2(f[0], f[1]); w.y = pk2(f[2], f[3]); w.z = pk2(f[4], f[5]); w.w = pk2(f[6], f[7]); return w; }
__device__ __forceinline__ float xor32(float v, int lane) {
    return __builtin_bit_cast(float, __builtin_amdgcn_ds_bpermute((lane ^ 32) << 2, __builtin_bit_cast(int, v)));
}
__device__ __forceinline__ float sigmoid_f(float x) { return 1.0f / (1.0f + __expf(-x)); }

struct Ctx {
    LAS unsigned char* lds;
    int tid, lane, wave, G, gw, NGW;
    float* out; unsigned char* ws;
};

__device__ __forceinline__ void conv_item(const float* W, int N, int sc, int nv, int k0, bf16* WT, int ldw, int dr, LAS float* scr, int lane) {
    const int n_ = lane & 31;
#pragma unroll 8
    for (int i = 0; i < 32; ++i) { const int kk = 2 * i + (lane >> 5); scr[kk * 33 + n_] = (n_ < nv) ? W[(size_t)(k0 + kk) * N + sc + n_] : 0.f; }
    LDS_WAIT(); asm volatile("" ::: "memory");
    const int c = lane & 7;
#pragma unroll
    for (int j = 0; j < 4; ++j) { const int n = (lane >> 3) + 8 * j; const LAS float* s = scr + (8 * c) * 33 + n;
        v4u o; o.x = pk2(s[0 * 33], s[1 * 33]); o.y = pk2(s[2 * 33], s[3 * 33]); o.z = pk2(s[4 * 33], s[5 * 33]); o.w = pk2(s[6 * 33], s[7 * 33]);
        if (n < nv) *(GAS v4u*)(WT + (size_t)(dr + n) * ldw + k0 + 8 * c) = o; }
    LDS_WAIT(); asm volatile("" ::: "memory");
}
__device__ const int SEG_IN[15][3] = {
    {0, Z_FQ, 512}, {512, Z_FK, 512}, {1024, Z_FV, 512}, {1536, 6656 + S_FF, 8}, {1544, Z_DQ, 512}, {2056, 6656 + S_DK, 64}, {2120, 6656 + S_DV, 64},
    {2184, 6656 + S_IQ, 256}, {2440, 6656 + S_IK, 32}, {2472, 6656 + S_IW, 8}, {2480, Z_RQ, 256}, {2736, Z_RK, 256}, {2992, Z_RV, 512}, {3504, Z_RG, 512}, {4016, Z_ZG, 3072}};
constexpr int IN_BLK = 223;
constexpr int IT_IN = 16 * IN_BLK, IT_MIX = 8 * 32, IT_O = 16 * 32, IT_FI = 16 * (FF2 / 32), IT_FO = (FFH / 64) * 32;
constexpr int IT_LAYER = IT_IN + 3 * IT_MIX + IT_O + IT_FI + IT_FO;

__device__ __forceinline__ void sincos_acc(float ang, float& c, float& s) {
    const double a = (double)ang;
    const double k = __builtin_rint(a * 0.6366197723675814);
    double y = a - k * 1.5707963267948966; y -= k * 6.123233995736766e-17;
    const double y2 = y * y;
    double sp = -7.647163731819816e-13; sp = sp * y2 + 1.6059043836821613e-10; sp = sp * y2 - 2.505210838544172e-08; sp = sp * y2 + 2.7557319223985893e-06; sp = sp * y2 - 1.984126984126984e-04; sp = sp * y2 + 8.333333333333333e-03; sp = sp * y2 - 1.6666666666666666e-01;
    const double sn = y + y * y2 * sp;
    double cp = 4.779477332387385e-14; cp = cp * y2 - 1.1470745597729725e-11; cp = cp * y2 + 2.08767569878681e-09; cp = cp * y2 - 2.755731922398589e-07; cp = cp * y2 + 2.48015873015873e-05; cp = cp * y2 - 1.388888888888889e-03; cp = cp * y2 + 4.1666666666666664e-02; cp = cp * y2 - 0.5;
    const double cs = 1.0 + y2 * cp;
    const int q = ((int)k) & 3;
    const double ss = (q & 1) ? cs : sn, cc = (q & 1) ? sn : cs;
    s = (float)((q & 2) ? -ss : ss);
    c = (float)(((q + 1) & 2) ? -cc : cc);
}

__device__ __forceinline__ void p0_prologue(const Ctx& F, const float* w_in, const float* w_fox, const float* w_dsa, const float* w_ret, const float* w_o, const float* w_fi, const float* w_fo) {
    LAS float* scr = (LAS float*)(F.lds + RING_OFF + F.wave * 16384);
    bf16* Wb = (bf16*)(F.ws + WS_W);
    for (int it = F.gw; it < DEPTH * IT_LAYER; it += F.NGW) {
        const int l = it / IT_LAYER; int r = it % IT_LAYER;
        bf16* L = Wb + (size_t)l * LW_STRIDE;
        if (r < IT_IN) {
            const int kb = r / IN_BLK; int blk = r % IN_BLK; int sc = 0, dr = 0, nv = 0;
            for (int s = 0; s < 15; ++s) { const int w = SEG_IN[s][2], nb = (w + 31) >> 5; if (blk < nb) { sc = SEG_IN[s][0] + 32 * blk; dr = SEG_IN[s][1] + 32 * blk; nv = (w - 32 * blk) < 32 ? (w - 32 * blk) : 32; break; } blk -= nb; }
            conv_item(w_in + (size_t)l * DM * INC, INC, sc, nv, 64 * kb, L + LW_IN, 1024, dr, scr, F.lane); continue; }
        r -= IT_IN;
        if (r < 3 * IT_MIX) { const int w = r / IT_MIX, q = r % IT_MIX, kb = q / 32, nb = q % 32;
            conv_item((w == 0 ? w_fox : w == 1 ? w_dsa : w_ret) + (size_t)l * 512 * DM, DM, 32 * nb, 32, 64 * kb, L + LW_MIX + (size_t)w * 512, 1536, 32 * nb, scr, F.lane); continue; }
        r -= 3 * IT_MIX;
        if (r < IT_O) { const int kb = r / 32, nb = r % 32;
            conv_item(w_o + (size_t)l * DM * DM, DM, 32 * nb, 32, 64 * kb, L + LW_O, 1024, 32 * nb, scr, F.lane); continue; }
        r -= IT_O;
        if (r < IT_FI) { const int kb = r / (FF2 / 32), nb = r % (FF2 / 32); const int n0 = 32 * nb;
            const int j = n0 < FFH ? n0 : n0 - FFH; const int dr = 256 * (j >> 7) + (j & 127) + (n0 < FFH ? 0 : 128);
            conv_item(w_fi + (size_t)l * DM * FF2, FF2, n0, 32, 64 * kb, L + LW_FI, 1024, dr, scr, F.lane); continue; }
        r -= IT_FI;
        { const int kb = r / 32, nb = r % 32;
            conv_item(w_fo + (size_t)l * FFH * DM, DM, 32 * nb, 32, 64 * kb, L + LW_FO, FFH, 32 * nb, scr, F.lane); }
    }
    for (int i = F.gw * 64 + F.lane; i < DEPTH * 80 * 128; i += F.NGW * 64) { const int l = i / (80 * 128), q = i % (80 * 128);
        *(GAS v4u*)(Wb + (size_t)l * LW_STRIDE + LW_IN + (size_t)INC * 1024 + (size_t)q * 8) = (v4u){0u, 0u, 0u, 0u}; }
    f32x2* R64 = (f32x2*)(F.ws + WS_ROPE64); f32x2* R32 = (f32x2*)(F.ws + WS_ROPE32);
    for (int i = F.gw * 64 + F.lane; i < SEQ * 32; i += F.NGW * 64) { const int pos = i >> 5, k = i & 31;
        double f = 1.0; for (int e = 0; e < k; ++e) f *= 0.7498942093324559;
        const float ang = (float)pos * (float)f; float c, s; sincos_acc(ang, c, s); R64[i] = (f32x2){c, s}; }
    for (int i = F.gw * 64 + F.lane; i < SEQ * 16; i += F.NGW * 64) { const int pos = i >> 4, k = i & 15;
        double f = 1.0; for (int e = 0; e < k; ++e) f *= 0.5623413251903491;
        const float ang = (float)pos * (float)f; float c, s; sincos_acc(ang, c, s); R32[i] = (f32x2){c, s}; }
}

__device__ __forceinline__ void norm0_phase(const Ctx& F, const float* x, const float* g, bf16* o, float* SS) {
    const GAS f32x4* gp = (const GAS f32x4*)g + F.lane;
    f32x4 gv[4];
#pragma unroll
    for (int j = 0; j < 4; ++j) gv[j] = gp[64 * j];
    for (int m = F.gw; m < M; m += F.NGW) {
        const GAS f32x4* xr = (const GAS f32x4*)(x + (size_t)m * DM) + F.lane;
        f32x4 v[4]; float s = 0.f;
#pragma unroll
        for (int j = 0; j < 4; ++j) { v[j] = xr[64 * j]; s += (v[j].x * v[j].x + v[j].y * v[j].y) + (v[j].z * v[j].z + v[j].w * v[j].w); }
        s = wave_sum(s);
        GAS unsigned long long* o8 = (GAS unsigned long long*)(o + (size_t)m * DM) + F.lane;
#pragma unroll
        for (int j = 0; j < 4; ++j) o8[64 * j] = (unsigned long long)pk2(v[j].x * gv[j].x, v[j].y * gv[j].y) | ((unsigned long long)pk2(v[j].z * gv[j].z, v[j].w * gv[j].w) << 32);
        if (F.lane < 16) SS[(size_t)m * 16 + F.lane] = (F.lane == 0) ? s : 0.f;
    }
}

__device__ __forceinline__ void post_phase(const Ctx& F, const float* g_fq, const float* g_fk, const float* g_dq, const float* g_dk, const float* b_f, bool dummy_out = false) {
    bf16* Z = (bf16*)(F.ws + WS_Z); const float* ZS = (const float*)(F.ws + WS_ZS);
    const f32x2* R64 = (const f32x2*)(F.ws + WS_ROPE64); const f32x2* R32 = (const f32x2*)(F.ws + WS_ROPE32);
    float* LF = (float*)(F.ws + WS_LF); unsigned* ISG = (unsigned*)(F.ws + WS_ISG);
    bf16* KD = (bf16*)(F.ws + WS_KD); bf16* VD = (bf16*)(F.ws + WS_VD); bf16* IQB = (bf16*)(F.ws + WS_IQB); bf16* IKB = (bf16*)(F.ws + WS_IKB);
    const int t0 = blockIdx.x * 512 + F.tid, NT = F.G * 512;
#pragma unroll 1
    for (int seg = 0; seg < 3; ++seg) {
        const int col = (seg == 0) ? Z_FQ : (seg == 1) ? Z_FK : Z_DQ; const float* gp = (seg == 0) ? g_fq : (seg == 1) ? g_fk : g_dq; const float osc = (seg == 1) ? 1.0f : C2;
        for (int t = t0; t < M * 8; t += NT) { const int m = t >> 3, h = t & 7; bf16* p = Z + (size_t)m * ZP + col + h * 64;
            v4u w[8];
#pragma unroll
            for (int i = 0; i < 8; ++i) w[i] = *(const GAS v4u*)(p + 8 * i);
            float f[64]; float ss = 0.f;
#pragma unroll
            for (int i = 0; i < 8; ++i) { float t8[8]; unpack8(w[i], t8);
#pragma unroll
                for (int j = 0; j < 8; ++j) { f[8 * i + j] = t8[j]; ss += t8[j] * t8[j]; } }
            const float rs = osc / sqrtf(ss * (1.f / 64) + NORM_EPS);
#pragma unroll
            for (int d = 0; d < 64; ++d) f[d] = f[d] * rs * gp[d];
            if (seg == 2) { const f32x2* cs = R64 + (m & (SEQ - 1)) * 32;
#pragma unroll
                for (int d = 0; d < 32; ++d) { const f32x2 tt = cs[d]; const float x1 = f[d], x2 = f[d + 32]; f[d] = x1 * tt.x - x2 * tt.y; f[d + 32] = x2 * tt.x + x1 * tt.y; } }
#pragma unroll
            for (int i = 0; i < 8; ++i) { float t8[8];
#pragma unroll
                for (int j = 0; j < 8; ++j) t8[j] = f[8 * i + j];
                *(GAS v4u*)((dummy_out ? (bf16*)(F.ws + WS_HDN + 16 * MiB) + (size_t)m * 512 + h * 64 : p) + 8 * i) = pack8(t8); }
        }
    }
    for (int t = t0; t < M * 8; t += NT) { const int m = t >> 3, h = t & 7; const float* sp = ZS + (size_t)m * ZSP + S_IQ + h * 32;
        f32x4 v[8];
#pragma unroll
        for (int i = 0; i < 8; ++i) v[i] = *(const GAS f32x4*)(sp + 4 * i);
        const float aw = fabsf(ZS[(size_t)m * ZSP + S_IW + h]);
        const f32x2* cs = R32 + (m & (SEQ - 1)) * 16; float f[32];
#pragma unroll
        for (int i = 0; i < 8; ++i) { f[4 * i] = v[i].x; f[4 * i + 1] = v[i].y; f[4 * i + 2] = v[i].z; f[4 * i + 3] = v[i].w; }
#pragma unroll
        for (int d = 0; d < 16; ++d) { const f32x2 tt = cs[d]; const float x1 = f[d], x2 = f[d + 16]; f[d] = (x1 * tt.x - x2 * tt.y) * aw; f[d + 16] = (x2 * tt.x + x1 * tt.y) * aw; }
        bf16* op = IQB + (size_t)m * 256 + h * 32;
#pragma unroll
        for (int i = 0; i < 4; ++i) { float t8[8];
#pragma unroll
            for (int j = 0; j < 8; ++j) t8[j] = f[8 * i + j];
            *(GAS v4u*)(op + 8 * i) = pack8(t8); }
    }
    for (int m = t0; m < M; m += NT) { const float* sr = ZS + (size_t)m * ZSP; const int pos = m & (SEQ - 1);
        { float f[64]; float ss = 0.f;
#pragma unroll
            for (int i = 0; i < 16; ++i) { const f32x4 v = *(const GAS f32x4*)(sr + S_DK + 4 * i); f[4 * i] = v.x; f[4 * i + 1] = v.y; f[4 * i + 2] = v.z; f[4 * i + 3] = v.w; ss += (v.x * v.x + v.y * v.y) + (v.z * v.z + v.w * v.w); }
            const float rs = 1.0f / sqrtf(ss * (1.f / 64) + NORM_EPS); const f32x2* cs = R64 + pos * 32;
#pragma unroll
            for (int d = 0; d < 64; ++d) f[d] = f[d] * rs * g_dk[d];
#pragma unroll
            for (int d = 0; d < 32; ++d) { const f32x2 tt = cs[d]; const float x1 = f[d], x2 = f[d + 32]; f[d] = x1 * tt.x - x2 * tt.y; f[d + 32] = x2 * tt.x + x1 * tt.y; }
#pragma unroll
            for (int i = 0; i < 8; ++i) { float t8[8];
#pragma unroll
                for (int j = 0; j < 8; ++j) t8[j] = f[8 * i + j];
                *(GAS v4u*)(KD + (size_t)m * 64 + 8 * i) = pack8(t8); } }
#pragma unroll
        for (int i = 0; i < 8; ++i) { const f32x4 a = *(const GAS f32x4*)(sr + S_DV + 8 * i), b = *(const GAS f32x4*)(sr + S_DV + 8 * i + 4); const float t8[8] = {a.x, a.y, a.z, a.w, b.x, b.y, b.z, b.w};
            *(GAS v4u*)(VD + (size_t)m * 64 + 8 * i) = pack8(t8); }
        { float f[32]; const f32x2* cs = R32 + pos * 16;
#pragma unroll
            for (int i = 0; i < 8; ++i) { const f32x4 v = *(const GAS f32x4*)(sr + S_IK + 4 * i); f[4 * i] = v.x; f[4 * i + 1] = v.y; f[4 * i + 2] = v.z; f[4 * i + 3] = v.w; }
#pragma unroll
            for (int d = 0; d < 16; ++d) { const f32x2 tt = cs[d]; const float x1 = f[d], x2 = f[d + 16]; f[d] = x1 * tt.x - x2 * tt.y; f[d + 16] = x2 * tt.x + x1 * tt.y; }
#pragma unroll
            for (int i = 0; i < 4; ++i) { float t8[8];
#pragma unroll
                for (int j = 0; j < 8; ++j) t8[j] = f[8 * i + j];
                *(GAS v4u*)(IKB + (size_t)m * 32 + 8 * i) = pack8(t8); } }
        { const f32x4 w0 = *(const GAS f32x4*)(sr + S_IW), w1 = *(const GAS f32x4*)(sr + S_IW + 4); const float iw[8] = {w0.x, w0.y, w0.z, w0.w, w1.x, w1.y, w1.z, w1.w}; unsigned sg = 0;
#pragma unroll
            for (int h = 0; h < 8; ++h) sg |= (iw[h] < 0.f ? 1u : 0u) << h;
            ISG[m] = sg;
            const f32x4 f0 = *(const GAS f32x4*)(sr + S_FF), f1 = *(const GAS f32x4*)(sr + S_FF + 4); const float ff[8] = {f0.x, f0.y, f0.z, f0.w, f1.x, f1.y, f1.z, f1.w}; float lf[8];
#pragma unroll
            for (int h = 0; h < 8; ++h) { const float xx = ff[h] + b_f[h]; lf[h] = (fminf(xx, 0.f) - __logf(1.0f + __expf(-fabsf(xx)))) * LOG2E; }
            *(GAS f32x4*)(LF + (size_t)m * 8) = (f32x4){lf[0], lf[1], lf[2], lf[3]}; *(GAS f32x4*)(LF + (size_t)m * 8 + 4) = (f32x4){lf[4], lf[5], lf[6], lf[7]}; }
    }
}

__device__ __forceinline__ float ret_l2g(int h) { return h == 0 ? -0.04580368961312479f : h == 1 ? -0.02272007650008353f : h == 2 ? -0.011315313227834146f : -0.005646563141142063f; }

__device__ __forceinline__ void scan_state_phase(const Ctx& F) {
    const float* LF = (const float*)(F.ws + WS_LF); float* CF = (float*)(F.ws + WS_CF);
    const bf16* Z = (const bf16*)(F.ws + WS_Z); float* RS = (float*)(F.ws + WS_HDN);
    if (F.gw < 32) {
        const int b = F.gw >> 3, h = F.gw & 7; const float* lp = LF + ((size_t)b * SEQ + F.lane * 64) * 8 + h; float s = 0.f;
        for (int i = 0; i < 64; ++i) s += lp[i * 8];
        float incl = s;
#pragma unroll
        for (int o = 1; o < 64; o <<= 1) { const float t = __builtin_bit_cast(float, __builtin_amdgcn_ds_bpermute(((F.lane - o) & 63) << 2, __builtin_bit_cast(int, incl))); if (F.lane >= o) incl += t; }
        float run = incl - s; float* cp = CF + (size_t)F.gw * SEQ + F.lane * 64;
        for (int i = 0; i < 64; ++i) { run += lp[i * 8]; cp[i] = run; }
    }
    for (int u = blockIdx.x; u < NB * 32 * 4; u += F.G) {
        const int h = u & 3, c = (u >> 2) & 31, b = u >> 7; const float l2g = ret_l2g(h);
        const int d = F.tid >> 3, e0 = (F.tid & 7) * 16; float acc[16];
#pragma unroll
        for (int i = 0; i < 16; ++i) acc[i] = 0.f;
        const bf16* base = Z + ((size_t)b * SEQ + c * 128) * ZP;
        for (int j = 0; j < 128; ++j) { const bf16* row = base + (size_t)j * ZP;
            const float kd = bf2f(row[Z_RK + h * 64 + d]) * exp2f((float)(127 - j) * l2g);
            const v4u w0 = *(const GAS v4u*)(row + Z_RV + h * 128 + e0), w1 = *(const GAS v4u*)(row + Z_RV + h * 128 + e0 + 8);
            float v0[8], v1[8]; unpack8(w0, v0); unpack8(w1, v1);
#pragma unroll
            for (int i = 0; i < 8; ++i) { acc[i] += kd * v0[i]; acc[8 + i] += kd * v1[i]; } }
        float* o = RS + (size_t)u * 8192 + d * 128 + e0;
#pragma unroll
        for (int i = 0; i < 4; ++i) *(GAS f32x4*)(o + 4 * i) = (f32x4){acc[4 * i], acc[4 * i + 1], acc[4 * i + 2], acc[4 * i + 3]};
    }
}

__device__ __forceinline__ void ret_out_naive(const Ctx& F, const float* gn) {
    bf16* Z = (bf16*)(F.ws + WS_Z); const float* RS = (const float*)(F.ws + WS_HDN);
    LAS float* S = (LAS float*)(F.lds);
    LAS bf16* Vt = (LAS bf16*)(F.lds + 32768);
    LAS float* Kt = (LAS float*)(F.lds + 65536);
    LAS float* aw = (LAS float*)(F.lds + 65536 + 33280) + F.wave * 128;
    LAS float* qw = (LAS float*)(F.lds + 65536 + 33280 + 4096) + F.wave * 64;
    for (int u = blockIdx.x; u < NB * 32 * 4; u += F.G) {
        const int h = u & 3, c = (u >> 2) & 31, b = u >> 7; const float l2g = ret_l2g(h); const float wch = exp2f(128.f * l2g);
        __syncthreads();
        { float s[16];
#pragma unroll
            for (int i = 0; i < 16; ++i) s[i] = 0.f;
            for (int cp = 0; cp < c; ++cp) { const float* L = RS + ((size_t)((b * 32 + cp) * 4 + h)) * 8192 + F.tid;
#pragma unroll
                for (int i = 0; i < 16; ++i) s[i] = wch * s[i] + L[i * 512]; }
#pragma unroll
            for (int i = 0; i < 16; ++i) S[F.tid + i * 512] = s[i]; }
        const bf16* base = Z + ((size_t)b * SEQ + c * 128) * ZP;
        for (int q = F.tid; q < 2048; q += 512) { const int r = q >> 4, ch = q & 15; *(LAS v4u*)(Vt + r * 128 + ch * 8) = *(const GAS v4u*)(base + (size_t)r * ZP + Z_RV + h * 128 + ch * 8); }
        for (int q = F.tid; q < 128 * 64; q += 512) { const int r = q >> 6, dd = q & 63; Kt[r * 65 + dd] = bf2f(base[(size_t)r * ZP + Z_RK + h * 64 + dd]); }
        __syncthreads();
        for (int i = F.wave; i < 128; i += NWAVES) {
            const size_t m = (size_t)b * SEQ + c * 128 + i; bf16* zr = Z + m * ZP;
            qw[F.lane] = bf2f(zr[Z_RQ + h * 64 + F.lane]);
            LDS_WAIT(); asm volatile("" ::: "memory");
#pragma unroll
            for (int jj = 0; jj < 2; ++jj) { const int j = F.lane + 64 * jj; float a = 0.f;
                if (j <= i) { float dot = 0.f; for (int dd = 0; dd < 64; ++dd) dot += qw[dd] * Kt[j * 65 + dd]; a = dot * exp2f((float)(i - j) * l2g); }
                aw[j] = a; }
            LDS_WAIT(); asm volatile("" ::: "memory");
            float o[2]; const float dq = exp2f((float)(i + 1) * l2g);
#pragma unroll
            for (int ee = 0; ee < 2; ++ee) { const int e = F.lane + 64 * ee; float acc = 0.f;
                for (int j = 0; j <= i; ++j) acc += aw[j] * bf2f(Vt[j * 128 + e]);
                float cr = 0.f; for (int dd = 0; dd < 64; ++dd) cr += qw[dd] * S[dd * 128 + e];
                o[ee] = acc + cr * dq; }
            const float ss = wave_sum(o[0] * o[0] + o[1] * o[1]); const float rstd = 1.0f / sqrtf(ss * (1.f / 128) + NORM_EPS);
#pragma unroll
            for (int ee = 0; ee < 2; ++ee) { const int e = F.lane + 64 * ee; const float rg = bf2f(zr[Z_RG + h * 128 + e]);
                zr[Z_RV + h * 128 + e] = (bf16)f2bf(o[ee] * rstd * gn[h * 128 + e] * rg * sigmoid_f(rg)); }
            LDS_WAIT(); asm volatile("" ::: "memory");
        }
    }
    __syncthreads();
}

__device__ __forceinline__ void fox_naive(const Ctx& F) {
    bf16* Z = (bf16*)(F.ws + WS_Z); const float* CF = (const float*)(F.ws + WS_CF);
    LAS float* sc = (LAS float*)(F.lds + F.wave * 16384);
    const int lane = F.lane;
    int it = 0;
    for (int r0 = 0; r0 < NB * 8 * SEQ; r0 += F.NGW, ++it) {
        const int r = r0 + ((it & 1) ? (F.NGW - 1 - F.gw) : F.gw);
        if (r >= NB * 8 * SEQ) continue;
        const int pos = r & (SEQ - 1), h = (r >> 12) & 7, b = r >> 15;
        const size_t m = (size_t)b * SEQ + pos;
        float qf[64];
        { const bf16* qp = Z + m * ZP + Z_FQ + h * 64;
#pragma unroll
            for (int i = 0; i < 8; ++i) { const v4u w = *(const GAS v4u*)(qp + 8 * i); float t[8]; unpack8(w, t);
#pragma unroll
                for (int j = 0; j < 8; ++j) qf[8 * i + j] = t[j]; } }
        const float* cf = CF + (size_t)(b * 8 + h) * SEQ;
        float mx = -INFINITY;
        for (int kk = lane; kk <= pos; kk += 64) { const bf16* kp = Z + ((size_t)b * SEQ + kk) * ZP + Z_FK + h * 64; float dot = 0.f;
#pragma unroll
            for (int i = 0; i < 8; ++i) { const v4u w = *(const GAS v4u*)(kp + 8 * i); float t[8]; unpack8(w, t);
#pragma unroll
                for (int j = 0; j < 8; ++j) dot += qf[8 * i + j] * t[j]; }
            const float s = dot - cf[kk]; sc[kk] = s; mx = fmaxf(mx, s); }
        mx = wave_max(mx);
        float sum = 0.f;
        for (int kk = lane; kk <= pos; kk += 64) { const float p = exp2f(sc[kk] - mx); sc[kk] = p; sum += p; }
        sum = wave_sum(sum);
        LDS_WAIT(); asm volatile("" ::: "memory");
        const bf16* vp = Z + (size_t)b * SEQ * ZP + Z_FV + h * 64 + lane;
        float o0 = 0.f, o1 = 0.f, o2 = 0.f, o3 = 0.f; int kk = 0;
        for (; kk + 3 <= pos; kk += 4) { o0 += sc[kk] * bf2f(vp[(size_t)kk * ZP]); o1 += sc[kk + 1] * bf2f(vp[(size_t)(kk + 1) * ZP]); o2 += sc[kk + 2] * bf2f(vp[(size_t)(kk + 2) * ZP]); o3 += sc[kk + 3] * bf2f(vp[(size_t)(kk + 3) * ZP]); }
        for (; kk <= pos; ++kk) o0 += sc[kk] * bf2f(vp[(size_t)kk * ZP]);
        Z[m * ZP + Z_FQ + h * 64 + lane] = (bf16)f2bf(((o0 + o1) + (o2 + o3)) / sum);
        LDS_WAIT(); asm volatile("" ::: "memory");
    }
}

__device__ __forceinline__ unsigned f2key(float s) { const unsigned u = __builtin_bit_cast(unsigned, s + 0.0f); return (u & 0x80000000u) ? ~u : (u | 0x80000000u); }
__device__ __forceinline__ void dsa_naive(const Ctx& F) {
    bf16* Z = (bf16*)(F.ws + WS_Z); const float* ZS = (const float*)(F.ws + WS_ZS);
    const unsigned* ISG = (const unsigned*)(F.ws + WS_ISG);
    const bf16* KD = (const bf16*)(F.ws + WS_KD); const bf16* VD = (const bf16*)(F.ws + WS_VD);
    LAS unsigned* kl = (LAS unsigned*)(F.lds + F.wave * 16384);
    LAS float* iqs = (LAS float*)(F.lds + XTRA_OFF + F.wave * 1536);
    const int lane = F.lane;
    int it = 0;
    for (int r0 = 0; r0 < M; r0 += F.NGW, ++it) {
        const int r = r0 + ((it & 1) ? (F.NGW - 1 - F.gw) : F.gw);
        if (r >= M) continue;
        const int pos = r & (SEQ - 1), b = r >> 12; const size_t m = (size_t)r;
        *(LAS f32x4*)(iqs + 4 * lane) = *(const GAS f32x4*)(ZS + m * ZSP + S_IQ + 4 * lane);
        const unsigned sg = ISG[m];
        LDS_WAIT(); asm volatile("" ::: "memory");
        for (int kk = lane; kk <= pos; kk += 64) { const float* ikp = ZS + ((size_t)b * SEQ + kk) * ZSP + S_IK; float ik[32];
#pragma unroll
            for (int i = 0; i < 8; ++i) { const f32x4 t = *(const GAS f32x4*)(ikp + 4 * i); ik[4 * i] = t.x; ik[4 * i + 1] = t.y; ik[4 * i + 2] = t.z; ik[4 * i + 3] = t.w; }
            float s = 0.f;
#pragma unroll 1
            for (int h = 0; h < 8; ++h) { float dot = 0.f;
#pragma unroll
                for (int dd = 0; dd < 32; ++dd) dot += iqs[h * 32 + dd] * ik[dd];
                dot = fmaxf(dot, 0.f); s += ((sg >> h) & 1u) ? -dot : dot; }
            kl[kk] = f2key(s); }
        LDS_WAIT(); asm volatile("" ::: "memory");
        unsigned key[64];
#pragma unroll
        for (int j = 0; j < 64; ++j) { const int kk = j * 64 + lane; key[j] = (kk <= pos) ? kl[kk] : 0u; }
        LDS_WAIT(); asm volatile("" ::: "memory");
        LAS unsigned* idx = kl; LAS float* pl = (LAS float*)(kl + 256); LAS bf16* qs = (LAS bf16*)(kl + 512);
        *(LAS v4u*)(qs + 8 * lane) = *(const GAS v4u*)(Z + m * ZP + Z_DQ + 8 * lane);
        unsigned T = 0u; int need = 0;
        if (pos + 1 > 256) {
            for (int bit = 31; bit >= 0; --bit) { const unsigned Tt = T | (1u << bit); int cnt = 0;
#pragma unroll
                for (int j = 0; j < 64; ++j) cnt += __builtin_popcountll(__ballot(key[j] >= Tt));
                if (cnt >= 256) T = Tt; }
            int ngt = 0;
#pragma unroll
            for (int j = 0; j < 64; ++j) ngt += __builtin_popcountll(__ballot(key[j] > T));
            need = 256 - ngt;
        }
        int nsel = 0, eqb = 0;
#pragma unroll
        for (int j = 0; j < 64; ++j) { const bool gt = key[j] > T, eq = (key[j] == T) && (T != 0u);
            const unsigned long long em = __ballot(eq); const int er = eqb + __builtin_amdgcn_mbcnt_hi((unsigned)(em >> 32), __builtin_amdgcn_mbcnt_lo((unsigned)em, 0u));
            const bool sel = gt || (eq && er < need); eqb += __builtin_popcountll(em);
            const unsigned long long sm = __ballot(sel); const int sp = nsel + __builtin_amdgcn_mbcnt_hi((unsigned)(sm >> 32), __builtin_amdgcn_mbcnt_lo((unsigned)sm, 0u));
            if (sel) idx[sp] = (unsigned)(j * 64 + lane); nsel += __builtin_popcountll(sm); }
        LDS_WAIT(); asm volatile("" ::: "memory");
        for (int h = 0; h < 8; ++h) {
            float sv[4]; float mx = -INFINITY;
#pragma unroll
            for (int i = 0; i < 4; ++i) { const int e = lane + 64 * i; sv[i] = -INFINITY;
                if (e < nsel) { const bf16* kp = KD + ((size_t)b * SEQ + idx[e]) * 64; float dot = 0.f;
#pragma unroll
                    for (int c = 0; c < 8; ++c) { const v4u w = *(const GAS v4u*)(kp + 8 * c); float t[8]; unpack8(w, t); const v4u qw = *(const LAS v4u*)(qs + h * 64 + 8 * c); float qq[8]; unpack8(qw, qq);
#pragma unroll
                        for (int j = 0; j < 8; ++j) dot += qq[j] * t[j]; }
                    sv[i] = dot; }
                mx = fmaxf(mx, sv[i]); }
            mx = wave_max(mx); float sum = 0.f;
#pragma unroll
            for (int i = 0; i < 4; ++i) { const int e = lane + 64 * i; const float p = (e < nsel) ? exp2f(sv[i] - mx) : 0.f; pl[e] = p; sum += p; }
            sum = wave_sum(sum);
            LDS_WAIT(); asm volatile("" ::: "memory");
            float o0 = 0.f, o1 = 0.f; int e = 0;
            for (; e + 1 < nsel; e += 2) { o0 += pl[e] * bf2f(VD[((size_t)b * SEQ + idx[e]) * 64 + lane]); o1 += pl[e + 1] * bf2f(VD[((size_t)b * SEQ + idx[e + 1]) * 64 + lane]); }
            if (e < nsel) o0 += pl[e] * bf2f(VD[((size_t)b * SEQ + idx[e]) * 64 + lane]);
            Z[m * ZP + Z_DQ + h * 64 + lane] = (bf16)f2bf((o0 + o1) / sum);
            LDS_WAIT(); asm volatile("" ::: "memory");
        }
    }
}
#ifndef PROBE_D
#define PROBE_D 0
#endif

typedef short s16x8 __attribute__((ext_vector_type(8)));
typedef short s16x4 __attribute__((ext_vector_type(4)));
typedef short v4i16_t __attribute__((ext_vector_type(4)));
__device__ __forceinline__ s16x4 tr16(const LAS unsigned char* p) { return __builtin_bit_cast(s16x4, __builtin_amdgcn_ds_read_tr16_b64_v4i16((LAS v4i16_t*)p)); }
__device__ __forceinline__ float key2f(unsigned k) { return __builtin_bit_cast(float, (k & 0x80000000u) ? (k & 0x7fffffffu) : ~k); }

template <int NR> __device__ __forceinline__ int dsa_count_ge(const unsigned (&key)[64], unsigned T) {
    int c = 0;
#pragma unroll
    for (int j = 0; j < NR; ++j) c += __builtin_popcountll(__ballot(key[j] >= T));
    return c;
}
#define DSA_COUNT_GE(T_, out_) do { if (nq == 1) out_ = dsa_count_ge<16>(key, (T_)); else if (nq == 2) out_ = dsa_count_ge<32>(key, (T_)); else if (nq == 3) out_ = dsa_count_ge<48>(key, (T_)); else out_ = dsa_count_ge<64>(key, (T_)); } while (0)
__device__ __forceinline__ void dsa_select(const unsigned (&key)[64], int nvalid, unsigned& T, int& need) {
    const int nq = __builtin_amdgcn_readfirstlane((nvalid + 1023) >> 10);
    T = 0u; need = 0;
    if (nvalid <= 256) return;
    unsigned kmax = 0u;
#pragma unroll
    for (int j = 0; j < 64; ++j) kmax = key[j] > kmax ? key[j] : kmax;
#pragma unroll
    for (int o_ = 0; o_ < 1; ++o_) { unsigned t; t = sxu<1>(kmax); kmax = t > kmax ? t : kmax; t = sxu<2>(kmax); kmax = t > kmax ? t : kmax; t = sxu<4>(kmax); kmax = t > kmax ? t : kmax; t = sxu<8>(kmax); kmax = t > kmax ? t : kmax; t = sxu<16>(kmax); kmax = t > kmax ? t : kmax;
        unsigned a_, b_; swap32(kmax, a_, b_); kmax = a_ > b_ ? a_ : b_; }
    unsigned lo = 1u, hi = kmax + 1u; int hic = 0;
    { const float vm = fabsf(key2f(kmax)) + 1.0f; unsigned l2 = f2key(-vm * 64.0f); int c; DSA_COUNT_GE(l2, c); if (c >= 256) lo = l2; }
    int iter = 0; bool exact = false;
    while (hi - lo > 1u) {
        unsigned mid;
        if (iter < 24 && lo > 1u) { const float mv = 0.5f * key2f(lo) + 0.5f * key2f(hi - 1u); mid = f2key(mv); }
        else mid = lo + ((hi - lo) >> 1);
        if (mid <= lo) mid = lo + 1u; if (mid >= hi) mid = hi - 1u;
        int c; DSA_COUNT_GE(mid, c);
        if (c == 256) { T = mid; exact = true; break; }
        if (c > 256) lo = mid; else { hi = mid; hic = c; }
        ++iter;
    }
    if (exact) need = 256; else { T = lo; need = 256 - hic; }
}

__device__ __forceinline__ void dsa_attend(const bf16* zq, bf16* zo, const bf16* KDb, const bf16* VDb, const LAS unsigned short* idx, int nsel, LAS unsigned char* vst, int lane) {
    const int g = lane >> 4, c = lane & 15;
    s16x8 qf[2];
#pragma unroll
    for (int ks = 0; ks < 2; ++ks) { qf[ks] = (s16x8){0, 0, 0, 0, 0, 0, 0, 0}; if (c < 8) qf[ks] = *(const GAS s16x8*)(zq + c * 64 + 32 * ks + 8 * g); }
    f32x4 acc[16];
    v4u vreg[16];
#pragma unroll
    for (int i = 0; i < 16; ++i) { const int pi = lane + 64 * i, r = pi >> 3, c16 = pi & 7; const int id = (r < nsel) ? (int)idx[r] : 0; vreg[i] = *(const GAS v4u*)(VDb + (size_t)id * 64 + c16 * 8); }
#pragma unroll
    for (int tb = 0; tb < 2; ++tb) {
        s16x8 kf[8][2];
#pragma unroll
        for (int tt = 0; tt < 8; ++tt) { const int e = 16 * (8 * tb + tt) + c; const int id = (e < nsel) ? (int)idx[e] : 0; const bf16* kp = KDb + (size_t)id * 64 + 8 * g;
            kf[tt][0] = *(const GAS s16x8*)kp; kf[tt][1] = *(const GAS s16x8*)(kp + 32); }
#pragma unroll
        for (int tt = 0; tt < 8; ++tt) { f32x4 a = (f32x4){0.f, 0.f, 0.f, 0.f};
            a = __builtin_amdgcn_mfma_f32_16x16x32_bf16(kf[tt][0], qf[0], a, 0, 0, 0); a = __builtin_amdgcn_mfma_f32_16x16x32_bf16(kf[tt][1], qf[1], a, 0, 0, 0); acc[8 * tb + tt] = a; }
    }
    float mx = -INFINITY;
#pragma unroll
    for (int t = 0; t < 16; ++t)
#pragma unroll
        for (int i = 0; i < 4; ++i) { const int e = 16 * t + 4 * g + i; if (nsel < 256 && e >= nsel) acc[t][i] = -INFINITY; mx = fmaxf(mx, acc[t][i]); }
    mx = fmaxf(mx, sx<16>(mx)); mx = half_max(mx);
    float sum = 0.f;
#pragma unroll
    for (int t = 0; t < 16; ++t)
#pragma unroll
        for (int i = 0; i < 4; ++i) { const float p = __builtin_amdgcn_exp2f(acc[t][i] - mx); acc[t][i] = p; sum += p; }
    sum += sx<16>(sum); sum = half_sum(sum);
    const float inv = 1.0f / sum;
    s16x8 pf[8];
#pragma unroll
    for (int s = 0; s < 8; ++s) { v4u w; w.x = pk2(acc[2 * s][0] * inv, acc[2 * s][1] * inv); w.y = pk2(acc[2 * s][2] * inv, acc[2 * s][3] * inv); w.z = pk2(acc[2 * s + 1][0] * inv, acc[2 * s + 1][1] * inv); w.w = pk2(acc[2 * s + 1][2] * inv, acc[2 * s + 1][3] * inv);
        pf[s] = __builtin_bit_cast(s16x8, w); }
    f32x4 o[4];
#pragma unroll
    for (int db = 0; db < 4; ++db) o[db] = (f32x4){0.f, 0.f, 0.f, 0.f};
    const int q = (lane >> 2) & 3, p = lane & 3, swz = 2 * (g & 1) + (q >> 1);
    const LAS unsigned char* rb = vst + (4 * g + q) * 128 + 8 * p;
#pragma unroll
    for (int hh = 0; hh < 2; ++hh) {
        asm volatile("s_waitcnt lgkmcnt(0)" ::: "memory");
#pragma unroll
        for (int i = 0; i < 16; ++i) { const int pi = lane + 64 * i, r = pi >> 3, c16 = pi & 7;
            *(LAS v4u*)(vst + r * 128 + ((((c16 >> 1) ^ ((r >> 1) & 3))) << 5) + ((c16 & 1) << 4)) = vreg[i]; }
        if (hh == 0) {
#pragma unroll
            for (int i = 0; i < 16; ++i) { const int pi = lane + 64 * i, r = pi >> 3, c16 = pi & 7, e = 128 + r; const int id = (e < nsel) ? (int)idx[e] : 0; vreg[i] = *(const GAS v4u*)(VDb + (size_t)id * 64 + c16 * 8); } }
        asm volatile("s_waitcnt lgkmcnt(0)" ::: "memory");
#pragma unroll
        for (int s4 = 0; s4 < 4; ++s4)
#pragma unroll
            for (int db = 0; db < 4; ++db) { const LAS unsigned char* a1 = rb + s4 * 4096 + ((db ^ swz) << 5);
                const s16x4 lo = tr16(a1), hi = tr16(a1 + 2048);
                const s16x8 vf = (s16x8){lo[0], lo[1], lo[2], lo[3], hi[0], hi[1], hi[2], hi[3]};
                o[db] = __builtin_amdgcn_mfma_f32_16x16x32_bf16(pf[4 * hh + s4], vf, o[db], 0, 0, 0); }
    }
    if (g < 2) {
#pragma unroll
        for (int db = 0; db < 4; ++db)
#pragma unroll
            for (int i = 0; i < 4; ++i) zo[(4 * g + i) * 64 + 16 * db + c] = (bf16)f2bf(o[db][i]);
    }
}

__device__ __forceinline__ void dsa_v2(const Ctx& F) {
    bf16* Z = (bf16*)(F.ws + WS_Z); const float* ZS = (const float*)(F.ws + WS_ZS);
    const unsigned* ISG = (const unsigned*)(F.ws + WS_ISG);
    const bf16* KD = (const bf16*)(F.ws + WS_KD); const bf16* VD = (const bf16*)(F.ws + WS_VD);
    LAS unsigned* kl = (LAS unsigned*)(F.lds + F.wave * 16384);
    LAS float* iqs = (LAS float*)(F.lds + XTRA_OFF + F.wave * 1536);
    LAS unsigned short* idx = (LAS unsigned short*)(F.lds + XTRA_OFF + F.wave * 1536 + 1024);
    const int lane = F.lane;
    int it = 0;
    for (int r0 = 0; r0 < M; r0 += F.NGW, ++it) {
        const int r = r0 + ((it & 1) ? (F.NGW - 1 - F.gw) : F.gw);
        if (r >= M) continue;
        const int pos = r & (SEQ - 1), b = r >> 12; const size_t m = (size_t)r;
        *(LAS f32x4*)(iqs + 4 * lane) = *(const GAS f32x4*)(ZS + m * ZSP + S_IQ + 4 * lane);
        const unsigned sg = ISG[m];
        LDS_WAIT(); asm volatile("" ::: "memory");
        for (int kk = lane; kk <= pos; kk += 64) { const float* ikp = ZS + ((size_t)b * SEQ + kk) * ZSP + S_IK; float ik[32];
#pragma unroll
            for (int i = 0; i < 8; ++i) { const f32x4 t = *(const GAS f32x4*)(ikp + 4 * i); ik[4 * i] = t.x; ik[4 * i + 1] = t.y; ik[4 * i + 2] = t.z; ik[4 * i + 3] = t.w; }
            float s = 0.f;
#pragma unroll 1
            for (int h = 0; h < 8; ++h) { float dot = 0.f;
#pragma unroll
                for (int dd = 0; dd < 32; ++dd) dot += iqs[h * 32 + dd] * ik[dd];
                dot = fmaxf(dot, 0.f); s += ((sg >> h) & 1u) ? -dot : dot; }
            kl[kk] = f2key(s); }
        LDS_WAIT(); asm volatile("" ::: "memory");
        unsigned key[64];
#pragma unroll
        for (int j = 0; j < 64; ++j) { const int kk = j * 64 + lane; key[j] = (kk <= pos) ? kl[kk] : 0u; }
        LDS_WAIT(); asm volatile("" ::: "memory");
        unsigned T; int need;
#ifdef DSA_OLDSEL
        T = 0u; need = 0;
        if (pos + 1 > 256) {
            for (int bit = 31; bit >= 0; --bit) { const unsigned Tt = T | (1u << bit); int cnt = 0;
#pragma unroll
                for (int j = 0; j < 64; ++j) cnt += __builtin_popcountll(__ballot(key[j] >= Tt));
                if (cnt >= 256) T = Tt; }
            int ngt = 0;
#pragma unroll
            for (int j = 0; j < 64; ++j) ngt += __builtin_popcountll(__ballot(key[j] > T));
            need = 256 - ngt;
        }
#else
        dsa_select(key, pos + 1, T, need);
#endif
        int nsel = 0, eqb = 0;
#pragma unroll
        for (int j = 0; j < 64; ++j) { const bool gt = key[j] > T, eq = (key[j] == T) && (T != 0u);
            const unsigned long long em = __ballot(eq); const int er = eqb + __builtin_amdgcn_mbcnt_hi((unsigned)(em >> 32), __builtin_amdgcn_mbcnt_lo((unsigned)em, 0u));
            const bool sel = gt || (eq && er < need); eqb += __builtin_popcountll(em);
            const unsigned long long sm = __ballot(sel); const int sp = nsel + __builtin_amdgcn_mbcnt_hi((unsigned)(sm >> 32), __builtin_amdgcn_mbcnt_lo((unsigned)sm, 0u));
            if (sel) idx[sp] = (unsigned short)(j * 64 + lane); nsel += __builtin_popcountll(sm); }
        LDS_WAIT(); asm volatile("" ::: "memory");
        dsa_attend(Z + m * ZP + Z_DQ, Z + m * ZP + Z_DQ, KD + (size_t)b * SEQ * 64, VD + (size_t)b * SEQ * 64, idx, nsel, (LAS unsigned char*)kl, lane);
        LDS_WAIT(); asm volatile("" ::: "memory");
    }
}

template <int NR> __device__ __forceinline__ int dsa_emit_n(const unsigned (&key)[64], unsigned T, int need, LAS unsigned short* idx, int lane) {
    int nsel = 0, eqb = 0;
#pragma unroll
    for (int j = 0; j < NR; ++j) { const bool gt = key[j] > T, eq = (key[j] == T) && (T != 0u);
        const unsigned long long em = __ballot(eq); const int er = eqb + __builtin_amdgcn_mbcnt_hi((unsigned)(em >> 32), __builtin_amdgcn_mbcnt_lo((unsigned)em, 0u));
        const bool sel = gt || (eq && er < need); eqb += __builtin_popcountll(em);
        const unsigned long long sm = __ballot(sel); const int sp = nsel + __builtin_amdgcn_mbcnt_hi((unsigned)(sm >> 32), __builtin_amdgcn_mbcnt_lo((unsigned)sm, 0u));
        if (sel) idx[sp] = (unsigned short)(j * 64 + lane); nsel += __builtin_popcountll(sm); }
    return nsel;
}
__device__ __forceinline__ int dsa_emit(const unsigned (&key)[64], int nvalid, unsigned T, int need, LAS unsigned short* idx, int lane) {
    const int nq = __builtin_amdgcn_readfirstlane((nvalid + 1023) >> 10);
    if (nq == 1) return dsa_emit_n<16>(key, T, need, idx, lane);
    if (nq == 2) return dsa_emit_n<32>(key, T, need, idx, lane);
    if (nq == 3) return dsa_emit_n<48>(key, T, need, idx, lane);
    return dsa_emit_n<64>(key, T, need, idx, lane);
}

#define DSA_CNT8(cnt_, k_, o_, T_) asm volatile( \
    "v_cmp_ge_u32_e64 s[60:61], %1, %9\n\tv_cmp_ge_u32_e64 s[62:63], %2, %9\n\tv_cmp_ge_u32_e64 s[64:65], %3, %9\n\tv_cmp_ge_u32_e64 s[66:67], %4, %9\n\t" \
    "v_cmp_ge_u32_e64 s[68:69], %5, %9\n\tv_cmp_ge_u32_e64 s[70:71], %6, %9\n\tv_cmp_ge_u32_e64 s[72:73], %7, %9\n\tv_cmp_ge_u32_e64 s[74:75], %8, %9\n\t" \
    "v_addc_co_u32_e64 %0, s[76:77], 0, %0, s[60:61]\n\tv_addc_co_u32_e64 %0, s[76:77], 0, %0, s[62:63]\n\tv_addc_co_u32_e64 %0, s[76:77], 0, %0, s[64:65]\n\tv_addc_co_u32_e64 %0, s[76:77], 0, %0, s[66:67]\n\t" \
    "v_addc_co_u32_e64 %0, s[76:77], 0, %0, s[68:69]\n\tv_addc_co_u32_e64 %0, s[76:77], 0, %0, s[70:71]\n\tv_addc_co_u32_e64 %0, s[76:77], 0, %0, s[72:73]\n\tv_addc_co_u32_e64 %0, s[76:77], 0, %0, s[74:75]" \
    : "+v"(cnt_) : "v"(k_[o_]), "v"(k_[o_ + 1]), "v"(k_[o_ + 2]), "v"(k_[o_ + 3]), "v"(k_[o_ + 4]), "v"(k_[o_ + 5]), "v"(k_[o_ + 6]), "v"(k_[o_ + 7]), "s"(T_) \
    : "s60", "s61", "s62", "s63", "s64", "s65", "s66", "s67", "s68", "s69", "s70", "s71", "s72", "s73", "s74", "s75", "s76", "s77")
template <int NR> __device__ __forceinline__ int dsa_lane_count(const unsigned (&key)[64], unsigned T) {
    int c = 0; const unsigned Ts = (unsigned)__builtin_amdgcn_readfirstlane((int)T);
#pragma unroll
    for (int j = 0; j < NR; j += 8) DSA_CNT8(c, key, j, Ts);
    return c;
}
#define DSA_LCOUNT(T_, lc_) do { if (nq == 1) lc_ = dsa_lane_count<16>(key, (T_)); else if (nq == 2) lc_ = dsa_lane_count<32>(key, (T_)); else if (nq == 3) lc_ = dsa_lane_count<48>(key, (T_)); else lc_ = dsa_lane_count<64>(key, (T_)); } while (0)
template <int NR> __device__ __forceinline__ void dsa_write_ge(const unsigned (&key)[64], unsigned T, int off, LAS unsigned short* idx, int lane) {
    const int dummy = 256 + lane;
#pragma unroll
    for (int j = 0; j < NR; ++j) { const bool s = key[j] >= T; idx[s ? off : dummy] = (unsigned short)(j * 64 + lane); off += s ? 1 : 0; }
}
__device__ __forceinline__ int dsa_select2(const unsigned (&key)[64], int nvalid, float s1, float s2, LAS unsigned short* idx, int lane) {
    const int nq = __builtin_amdgcn_readfirstlane((nvalid + 1023) >> 10);
    unsigned T = 1u; int lc = 0; bool exact = true;
    if (nvalid > 256) {
        const float n = (float)nvalid, mean = s1 / n, sd = sqrtf(fmaxf(s2 / n - mean * mean, 1e-30f));
        const float pfrac = 256.0f / n, pt = fminf(pfrac, 1.0f - pfrac);
        const float tt = sqrtf(-2.0f * __logf(fmaxf(pt, 1e-6f)));
        float zn = (0.010328f * tt + 0.802853f) * tt + 2.515517f; asm volatile("" : "+v"(zn));
        float zd = ((0.001308f * tt + 0.189269f) * tt + 1.432788f) * tt + 1.0f; asm volatile("" : "+v"(zd));
        float z = tt - zn / zd;
        if (pfrac > 0.5f) z = -z;
        const float dens = n * __expf(-0.5f * z * z) * 0.3989423f / sd;
        unsigned lo = 1u, hi = 0xffffffffu; int clo = nvalid, chi = 0;
        bool lop = false, hip = false; float lastv = mean + z * sd, lastc = 256.0f, grow = 1.3f;
        exact = false; int same = 0, last = 0;
        for (int it = 0; hi - lo > 1u; ++it) {
            unsigned mid;
            if (it == 0) mid = f2key(lastv);
            else if (!(lop && hip)) { lastv = lastv + grow * (lastc - 256.0f) / dens; grow *= 2.0f; mid = f2key(lastv); }
            else if (it < 24 && same < 2) { const float vlo = key2f(lo), vhi = key2f(hi - 1u); mid = f2key(vlo + (vhi - vlo) * (((float)(clo - 256) + 0.5f) / (float)(clo - chi))); }
            else if (it < 48) { mid = f2key(0.5f * key2f(lo) + 0.5f * key2f(hi - 1u)); same = 0; }
            else mid = lo + ((hi - lo) >> 1);
            if (!(mid > lo)) mid = lo + 1u; if (!(mid < hi)) mid = hi - 1u;
            DSA_LCOUNT(mid, lc); const int c = wave_isum(lc); lastc = (float)c; lastv = key2f(mid);
            if (c == 256) { T = mid; exact = true; break; }
            if (c > 256) { lo = mid; clo = c; lop = true; same = (last > 0) ? same + 1 : 0; last = 1; } else { hi = mid; chi = c; hip = true; same = (last < 0) ? same + 1 : 0; last = -1; }
        }
        if (!exact) {
            const int nsel = dsa_emit(key, nvalid, lo, 256 - chi, idx, lane);
            return nsel;
        }
    } else { DSA_LCOUNT(1u, lc); }
    int incl = lc;
#pragma unroll
    for (int o = 1; o < 64; o <<= 1) { const int t = __builtin_amdgcn_ds_bpermute(((lane - o) & 63) << 2, incl); if (lane >= o) incl += t; }
    const int total = __builtin_amdgcn_readlane(incl, 63);
    if (nq == 1) dsa_write_ge<16>(key, T, incl - lc, idx, lane); else if (nq == 2) dsa_write_ge<32>(key, T, incl - lc, idx, lane); else if (nq == 3) dsa_write_ge<48>(key, T, incl - lc, idx, lane); else dsa_write_ge<64>(key, T, incl - lc, idx, lane);
    return total;
}

constexpr int DSA_ROWF = 4100;
__device__ __forceinline__ void dsa_v3(const Ctx& F, int out_col = Z_DQ) {
    bf16* Z = (bf16*)(F.ws + WS_Z);
    const unsigned* ISG = (const unsigned*)(F.ws + WS_ISG);
    const bf16* KD = (const bf16*)(F.ws + WS_KD); const bf16* VD = (const bf16*)(F.ws + WS_VD);
    const bf16* IQB = (const bf16*)(F.ws + WS_IQB); const bf16* IKB = (const bf16*)(F.ws + WS_IKB);
    LAS unsigned* img = (LAS unsigned*)(F.lds);
    LAS unsigned short* idxw = (LAS unsigned short*)(F.lds + XTRA_OFF + F.wave * 1536);
    const int w = F.wave;
    const int v = (int)blockIdx.x;
    if (v < 256)
    for (int ui = 0; ui < 8; ++ui) {
        int lane_ = F.lane; asm volatile("" : "+v"(lane_)); const int lane = lane_, g = lane >> 4, c = lane & 15;
        const int b = v >> 6, k = v & 63; const int pb = 128 * (ui >> 1) + ((ui & 1) ? 127 - k : k);
        const int q0 = pb * 8, kend = q0 + 8, ntile = (kend + 15) >> 4;
        const size_t mb = (size_t)b * SEQ;
#if PROBE_D == 1
        for (int rp_ = 0; rp_ < 2; ++rp_)
#endif
        { s16x8 iqf[8]; float sgn[8]; s16x8 iqc;
          { const int qq = (q0 + c < SEQ) ? q0 + c : SEQ - 1; const bf16* qp = IQB + (mb + qq) * 256 + 8 * g; const unsigned sg = ISG[mb + qq];
            float cs[8];
#pragma unroll
            for (int e = 0; e < 8; ++e) cs[e] = 0.f;
#pragma unroll
            for (int h = 0; h < 8; ++h) { iqf[h] = *(const GAS s16x8*)(qp + h * 32); sgn[h] = ((sg >> h) & 1u) ? -1.0f : 1.0f;
                float t8[8]; unpack8(__builtin_bit_cast(v4u, iqf[h]), t8);
#pragma unroll
                for (int e = 0; e < 8; ++e) cs[e] += sgn[h] * t8[e]; }
            iqc = __builtin_bit_cast(s16x8, pack8(cs)); }
          const bf16* ikp = IKB + (mb + c) * 32 + 8 * g;
          float st1 = 0.f, st2 = 0.f;
          s16x8 cur[4], nxt[4];
#pragma unroll
          for (int i = 0; i < 4; ++i) { const int t = w + 8 * i; cur[i] = *(const GAS s16x8*)(ikp + (size_t)512 * (t < ntile ? t : 0)); }
          for (int t0 = w; t0 < ntile; t0 += 32) {
#pragma unroll
            for (int i = 0; i < 4; ++i) { const int t = t0 + 32 + 8 * i; nxt[i] = *(const GAS s16x8*)(ikp + (size_t)512 * (t < ntile ? t : 0)); }
#pragma unroll
            for (int i = 0; i < 4; ++i) { const int t = t0 + 8 * i;
              if (t < ntile) {
                f32x4 sc = __builtin_amdgcn_mfma_f32_16x16x32_bf16(cur[i], iqc, (f32x4){0.f, 0.f, 0.f, 0.f}, 0, 0, 0);
#pragma unroll
                for (int h = 0; h < 8; ++h) { const f32x4 x = __builtin_amdgcn_mfma_f32_16x16x32_bf16(cur[i], iqf[h], (f32x4){0.f, 0.f, 0.f, 0.f}, 0, 0, 0);
#pragma unroll
                    for (int r = 0; r < 4; ++r) sc[r] = __builtin_fmaf(sgn[h], __builtin_fabsf(x[r]), sc[r]); }
                v4u kk; kk.x = f2key(sc[0]); kk.y = f2key(sc[1]); kk.z = f2key(sc[2]); kk.w = f2key(sc[3]);
                if (16 * t + 15 <= q0) {
                    st1 += (sc[0] + sc[1]) + (sc[2] + sc[3]); st2 += (sc[0] * sc[0] + sc[1] * sc[1]) + (sc[2] * sc[2] + sc[3] * sc[3]);
                } else { const int kb = 16 * t + 4 * g, qa = q0 + c;
                    if (kb + 0 > qa) { kk.x = 0u; sc[0] = 0.f; } if (kb + 1 > qa) { kk.y = 0u; sc[1] = 0.f; } if (kb + 2 > qa) { kk.z = 0u; sc[2] = 0.f; } if (kb + 3 > qa) { kk.w = 0u; sc[3] = 0.f; }
                    st1 += (sc[0] + sc[1]) + (sc[2] + sc[3]); st2 += (sc[0] * sc[0] + sc[1] * sc[1]) + (sc[2] * sc[2] + sc[3] * sc[3]); }
                if (c < 8) *(LAS v4u*)(img + c * DSA_ROWF + 16 * t + 4 * g) = kk; } }
#pragma unroll
            for (int i = 0; i < 4; ++i) cur[i] = nxt[i];
          }
          st1 += sx<16>(st1); st2 += sx<16>(st2); st1 = half_sum(st1); st2 = half_sum(st2);
          if (g == 0 && c < 8) *(LAS f32x2*)(F.lds + XTRA_OFF + w * 1536 + 640 + c * 8) = (f32x2){st1, st2}; }
        __syncthreads();
        const int pos = q0 + w; unsigned key[64];
#pragma unroll
        for (int j = 0; j < 64; ++j) { const int kidx = 64 * j + lane; const unsigned a = img[w * DSA_ROWF + kidx]; key[j] = (kidx <= pos) ? a : 0u; }
        unsigned T; int need; int nsel;
        float rs1 = 0.f, rs2 = 0.f;
#pragma unroll
        for (int ww = 0; ww < 8; ++ww) { const f32x2 t = *(const LAS f32x2*)(F.lds + XTRA_OFF + ww * 1536 + 640 + w * 8); rs1 += t.x; rs2 += t.y; }
        { nsel = dsa_select2(key, pos + 1, rs1, rs2, idxw, lane); (void)T; (void)need; }
        __syncthreads();
#if PROBE_D == 3
        { const size_t m = mb + pos; dsa_attend(Z + m * ZP + Z_DQ, Z + m * ZP + Z_RG, KD + mb * 64, VD + mb * 64, idxw, nsel, F.lds + w * 16384, lane); }
#endif
        { const size_t m = mb + pos; dsa_attend(Z + m * ZP + Z_DQ, Z + m * ZP + out_col, KD + mb * 64, VD + mb * 64, idxw, nsel, F.lds + w * 16384, lane); }
        __syncthreads();
    }
}

__device__ __forceinline__ void ret_rope_frag(const bf16* row, const f32x2* cs, float scale, int g, s16x8 (&f)[2]) {
    const u32x2 a0 = *(const GAS u32x2*)(row + 4 * g), a1 = *(const GAS u32x2*)(row + 16 + 4 * g), b0 = *(const GAS u32x2*)(row + 32 + 4 * g), b1 = *(const GAS u32x2*)(row + 48 + 4 * g);
    const float x1[8] = {bflo(a0.x), bfhi(a0.x), bflo(a0.y), bfhi(a0.y), bflo(a1.x), bfhi(a1.x), bflo(a1.y), bfhi(a1.y)};
    const float x2[8] = {bflo(b0.x), bfhi(b0.x), bflo(b0.y), bfhi(b0.y), bflo(b1.x), bfhi(b1.x), bflo(b1.y), bfhi(b1.y)};
    float o1[8], o2[8];
#pragma unroll
    for (int j = 0; j < 8; ++j) { const f32x2 t = cs[(j < 4 ? 4 * g + j : 16 + 4 * g + (j - 4))]; o1[j] = (x1[j] * t.x - x2[j] * t.y) * scale; o2[j] = (x2[j] * t.x + x1[j] * t.y) * scale; }
    f[0] = __builtin_bit_cast(s16x8, pack8(o1)); f[1] = __builtin_bit_cast(s16x8, pack8(o2));
}
__device__ __forceinline__ s16x8 ret_bfrag(const LAS unsigned char* img, int row0, int eb, int g, int q, int p) {
    const int r1 = row0 + 4 * g + q;
    const LAS unsigned char* a1 = img + r1 * 256 + ((eb ^ (r1 & 7)) << 5) + 8 * p;
    const LAS unsigned char* a2 = img + (r1 + 16) * 256 + ((eb ^ ((r1 + 16) & 7)) << 5) + 8 * p;
    const s16x4 lo = tr16(a1), hi = tr16(a2);
    return (s16x8){lo[0], lo[1], lo[2], lo[3], hi[0], hi[1], hi[2], hi[3]};
}

__device__ __forceinline__ void ret_state_mfma(const Ctx& F) {
    const bf16* Z = (const bf16*)(F.ws + WS_Z); float* RS = (float*)(F.ws + WS_HDN);
    const f32x2* R64 = (const f32x2*)(F.ws + WS_ROPE64);
    LAS unsigned char* Kimg = F.lds; LAS unsigned char* Vimg = F.lds + 16384;
    const int lane = F.lane, g = lane >> 4, c = lane & 15, q = (lane >> 2) & 3, p = lane & 3;
    for (int u = blockIdx.x; u < NB * 32 * 4; u += F.G) {
        const int h = u & 3, ch = (u >> 2) & 31, b = u >> 7; const float l2g = ret_l2g(h);
        const bf16* base = Z + ((size_t)b * SEQ + ch * 128) * ZP;
        __syncthreads();
        for (int t = F.tid; t < 2048; t += 512) { const int r = t >> 4, c16 = t & 15;
            *(LAS v4u*)(Vimg + r * 256 + (((c16 >> 1) ^ (r & 7)) << 5) + ((c16 & 1) << 4)) = *(const GAS v4u*)(base + (size_t)r * ZP + Z_RV + h * 128 + c16 * 8); }
        for (int t = F.tid; t < 1024; t += 512) { const int j = t >> 3, dg = t & 7; const bf16* row = base + (size_t)j * ZP + Z_RK + h * 64;
            const u32x2 a = *(const GAS u32x2*)(row + 4 * dg), bb = *(const GAS u32x2*)(row + 32 + 4 * dg);
            const float x1[4] = {bflo(a.x), bfhi(a.x), bflo(a.y), bfhi(a.y)}, x2[4] = {bflo(bb.x), bfhi(bb.x), bflo(bb.y), bfhi(bb.y)};
            const f32x2* cs = R64 + (ch * 128 + j) * 32 + 4 * dg; const float sc = exp2f((float)(127 - j) * l2g);
            float o1[4], o2[4];
#pragma unroll
            for (int e = 0; e < 4; ++e) { const f32x2 tt = cs[e]; o1[e] = (x1[e] * tt.x - x2[e] * tt.y) * sc; o2[e] = (x2[e] * tt.x + x1[e] * tt.y) * sc; }
            u32x2 w1, w2; w1.x = pk2(o1[0], o1[1]); w1.y = pk2(o1[2], o1[3]); w2.x = pk2(o2[0], o2[1]); w2.y = pk2(o2[2], o2[3]);
            const int sw = (j >> 1) & 3; const int d1 = 4 * dg, d2 = 32 + 4 * dg;
            *(LAS u32x2*)(Kimg + j * 128 + ((((2 * d1) >> 5) ^ sw) << 5) + ((2 * d1) & 31)) = w1;
            *(LAS u32x2*)(Kimg + j * 128 + ((((2 * d2) >> 5) ^ sw) << 5) + ((2 * d2) & 31)) = w2; }
        __syncthreads();
        f32x4 acc[4];
#pragma unroll
        for (int db = 0; db < 4; ++db) acc[db] = (f32x4){0.f, 0.f, 0.f, 0.f};
#pragma unroll
        for (int s = 0; s < 4; ++s) {
            const s16x8 vb = ret_bfrag(Vimg, 32 * s, F.wave, g, q, p);
            const int r1 = 32 * s + 4 * g + q, sw = (r1 >> 1) & 3;
#pragma unroll
            for (int db = 0; db < 4; ++db) { const LAS unsigned char* a1 = Kimg + r1 * 128 + ((db ^ sw) << 5) + 8 * p;
                const s16x4 lo = tr16(a1), hi = tr16(a1 + 2048);
                const s16x8 ka = (s16x8){lo[0], lo[1], lo[2], lo[3], hi[0], hi[1], hi[2], hi[3]};
                acc[db] = __builtin_amdgcn_mfma_f32_16x16x32_bf16(ka, vb, acc[db], 0, 0, 0); }
        }
        float* o = RS + (size_t)u * 8192 + 16 * F.wave + c;
#pragma unroll
        for (int db = 0; db < 4; ++db)
#pragma unroll
            for (int r = 0; r < 4; ++r) o[(16 * db + 4 * g + r) * 128] = acc[db][r];
    }
    __syncthreads();
}

__device__ __forceinline__ void ret_scan(const Ctx& F) {
    const float* RS = (const float*)(F.ws + WS_HDN); float* SC = (float*)(F.ws + WS_HDN + 16 * MiB);
    for (int t = blockIdx.x * 512 + F.tid; t < NB * 4 * 8192; t += F.G * 512) {
        const int el = t & 8191, h = (t >> 13) & 3, b = t >> 15; const float wch = exp2f(128.f * ret_l2g(h)); float s = 0.f;
        float L[32];
#pragma unroll
        for (int ch = 0; ch < 32; ++ch) L[ch] = RS[(size_t)(((b * 32 + ch) * 4 + h)) * 8192 + el];
#pragma unroll
        for (int ch = 0; ch < 32; ++ch) { SC[(size_t)(((b * 32 + ch) * 4 + h)) * 8192 + el] = s; s = wch * s + L[ch]; }
    }
}

__device__ __forceinline__ void ret_out_mfma(const Ctx& F, const float* gn, bool dummy_out = false) {
    bf16* Z = (bf16*)(F.ws + WS_Z); const float* SC = (const float*)(F.ws + WS_HDN + 16 * MiB);
    const f32x2* R64 = (const f32x2*)(F.ws + WS_ROPE64);
    LAS unsigned char* Vimg = F.lds; LAS unsigned char* Simg = F.lds + 32768;
    const int lane = F.lane, g = lane >> 4, c = lane & 15, q = (lane >> 2) & 3, p = lane & 3, w = F.wave;
    for (int u = blockIdx.x; u < NB * 32 * 4; u += F.G) {
        const int h = u & 3, ch = (u >> 2) & 31, b = u >> 7; const float l2g = ret_l2g(h); const float gam = exp2f(l2g);
        bf16* base = Z + ((size_t)b * SEQ + ch * 128) * ZP;
        __syncthreads();
        for (int t = F.tid; t < 2048; t += 512) { const int r = t >> 4, c16 = t & 15;
            *(LAS v4u*)(Vimg + r * 256 + (((c16 >> 1) ^ (r & 7)) << 5) + ((c16 & 1) << 4)) = *(const GAS v4u*)(base + (size_t)r * ZP + Z_RV + h * 128 + c16 * 8); }
        for (int t = F.tid; t < 1024; t += 512) { const int r = t >> 4, c16 = t & 15; const float* sp = SC + (size_t)u * 8192 + r * 128 + c16 * 8;
            const f32x4 s0 = *(const GAS f32x4*)sp, s1 = *(const GAS f32x4*)(sp + 4);
            v4u wv; wv.x = pk2(s0.x * gam, s0.y * gam); wv.y = pk2(s0.z * gam, s0.w * gam); wv.z = pk2(s1.x * gam, s1.y * gam); wv.w = pk2(s1.z * gam, s1.w * gam);
            *(LAS v4u*)(Simg + r * 256 + (((c16 >> 1) ^ (r & 7)) << 5) + ((c16 & 1) << 4)) = wv; }
        const int i = 16 * w + c; s16x8 qf[2];
        ret_rope_frag(base + (size_t)i * ZP + Z_RQ + h * 64, R64 + (ch * 128 + i) * 32, 0.125f * exp2f((float)i * l2g), g, qf);
        f32x4 acc[8];
#pragma unroll
        for (int t = 0; t < 8; ++t) { acc[t] = (f32x4){0.f, 0.f, 0.f, 0.f};
            if (t <= w) { const int j = 16 * t + c; s16x8 kf[2];
                ret_rope_frag(base + (size_t)j * ZP + Z_RK + h * 64, R64 + (ch * 128 + j) * 32, exp2f(-(float)j * l2g), g, kf);
                acc[t] = __builtin_amdgcn_mfma_f32_16x16x32_bf16(kf[0], qf[0], acc[t], 0, 0, 0); acc[t] = __builtin_amdgcn_mfma_f32_16x16x32_bf16(kf[1], qf[1], acc[t], 0, 0, 0);
                if (t == w) {
#pragma unroll
                    for (int r = 0; r < 4; ++r) if (4 * g + r > c) acc[t][r] = 0.f; } } }
        s16x8 pf[4];
#pragma unroll
        for (int s = 0; s < 4; ++s) { v4u wv; wv.x = pk2(acc[2 * s][0], acc[2 * s][1]); wv.y = pk2(acc[2 * s][2], acc[2 * s][3]); wv.z = pk2(acc[2 * s + 1][0], acc[2 * s + 1][1]); wv.w = pk2(acc[2 * s + 1][2], acc[2 * s + 1][3]);
            pf[s] = __builtin_bit_cast(s16x8, wv); }
        __syncthreads();
        f32x4 o[8];
#pragma unroll
        for (int eb = 0; eb < 8; ++eb) o[eb] = (f32x4){0.f, 0.f, 0.f, 0.f};
#pragma unroll
        for (int s = 0; s < 4; ++s) if (2 * s <= w) {
#pragma unroll
            for (int eb = 0; eb < 8; ++eb) o[eb] = __builtin_amdgcn_mfma_f32_16x16x32_bf16(pf[s], ret_bfrag(Vimg, 32 * s, eb, g, q, p), o[eb], 0, 0, 0); }
#pragma unroll
        for (int ks = 0; ks < 2; ++ks)
#pragma unroll
            for (int eb = 0; eb < 8; ++eb) o[eb] = __builtin_amdgcn_mfma_f32_16x16x32_bf16(qf[ks], ret_bfrag(Simg, 32 * ks, eb, g, q, p), o[eb], 0, 0, 0);
        float rs[4];
#pragma unroll
        for (int r = 0; r < 4; ++r) { float ss = 0.f;
#pragma unroll
            for (int eb = 0; eb < 8; ++eb) ss += o[eb][r] * o[eb][r];
            ss += sx<1>(ss); ss += sx<2>(ss); ss += sx<4>(ss); ss += sx<8>(ss);
            rs[r] = 1.0f / sqrtf(ss * (1.f / 128) + NORM_EPS); }
#pragma unroll
        for (int r = 0; r < 4; ++r) { bf16* zr = base + (size_t)(16 * w + 4 * g + r) * ZP; bf16* zw = dummy_out ? (bf16*)(F.ws + WS_ZS) + ((size_t)b * SEQ + ch * 128 + 16 * w + 4 * g + r) * 1024 - Z_RV : zr;
#pragma unroll
            for (int eb = 0; eb < 8; ++eb) { const int e = 16 * eb + c; const float rg = bf2f(zr[Z_RG + h * 128 + e]);
                zw[Z_RV + h * 128 + e] = (bf16)f2bf(o[eb][r] * rs[r] * gn[h * 128 + e] * rg * sigmoid_f(rg)); } }
    }
    __syncthreads();
}

__device__ __forceinline__ void fscan_phase(const Ctx& F) {
    const float* LF = (const float*)(F.ws + WS_LF); float* CF = (float*)(F.ws + WS_CF);
    if (F.gw < 32) {
        const int b = F.gw >> 3, h = F.gw & 7; const float* lp = LF + ((size_t)b * SEQ + F.lane * 64) * 8 + h; float s = 0.f;
        for (int i = 0; i < 64; ++i) s += lp[i * 8];
        float incl = s;
#pragma unroll
        for (int o = 1; o < 64; o <<= 1) { const float t = __builtin_bit_cast(float, __builtin_amdgcn_ds_bpermute(((F.lane - o) & 63) << 2, __builtin_bit_cast(int, incl))); if (F.lane >= o) incl += t; }
        float run = incl - s; float* cp = CF + (size_t)F.gw * SEQ + F.lane * 64;
        for (int i = 0; i < 64; ++i) { run += lp[i * 8]; cp[i] = run; }
    }
}
#include <hip/hip_bf16.h>
#include <cmath>
namespace attn_body {
using bf16=__hip_bfloat16;
using bf16x8=__attribute__((ext_vector_type(8)))short;
using s16x4=__attribute__((ext_vector_type(4)))short;
using f32x16=__attribute__((ext_vector_type(16)))float;
using u32x4=__attribute__((ext_vector_type(4)))unsigned;
constexpr int BATCH=4,NHEAD=8,SEQ=4096,D=64,DM=6656;
constexpr int NW=8,QBLK=32,QB=QBLK*NW,KVBLK=64,NQB=SEQ/QB;
constexpr int ATTN_PITCH=DM, ATTN_UNIT_ROWS=QB;
__device__ __forceinline__ int crow(int r,int hi){return (r&3)+8*(r>>2)+4*hi;}
#define SBAR() __builtin_amdgcn_sched_barrier(0)
__device__ __forceinline__ void cmask(f32x16&p0,f32x16&p1,int jb,int qrel,int hi){
  const float NEG=-INFINITY; int kb=64*jb+4*hi;
  #pragma unroll
  for(int r=0;r<16;++r){int kv=kb+(r&3)+8*(r>>2); if(kv>qrel)p0[r]=NEG; if(kv+32>qrel)p1[r]=NEG;}
}

constexpr int NSLOT=3, SLOTB=8192;
constexpr int LDS_K=0, LDS_V=NSLOT*SLOTB, LDS_WS=2*NSLOT*SLOTB, LDS_OST=LDS_WS+NW*64*4, LDS_NC=LDS_OST+NW*4096, LDS_BYTES=LDS_NC+SEQ*4;
constexpr float C2=0.125f*1.4426950408889634f;
__device__ __forceinline__ void glds16(const void*gsrc,unsigned lds_dst){unsigned keep;
  asm volatile("s_mov_b32 %0, m0\n\ts_mov_b32 m0, %2\n\ts_nop 0\n\tglobal_load_lds_dwordx4 %1, off\n\ts_mov_b32 m0, %0":"=&s"(keep):"v"(gsrc),"s"(lds_dst):"memory");}
__device__ __forceinline__ float max3f(float a,float b,float c){float r;asm("v_max3_f32 %0, %1, %2, %3":"=v"(r):"v"(a),"v"(b),"v"(c));return r;}
__device__ __forceinline__ float max2f(float a,float b){float r;asm("v_max_f32_e32 %0, %1, %2":"=v"(r):"v"(a),"v"(b));return r;}
__device__ __forceinline__ float fadd_s(float a,float b){float r;asm("v_add_f32_e32 %0, %1, %2":"=v"(r):"v"(a),"v"(b));return r;}
__device__ __forceinline__ float fsub_s(float a,float b){float r;asm("v_sub_f32_e32 %0, %1, %2":"=v"(r):"v"(a),"v"(b));return r;}
typedef float f32x4_t __attribute__((ext_vector_type(4))); typedef float f32x2_t __attribute__((ext_vector_type(2))); typedef __bf16 bf16x2_t __attribute__((ext_vector_type(2)));
__device__ __forceinline__ unsigned cvtpk_s(float lo,float hi){f32x2_t v={lo,hi};bf16x2_t b=__builtin_convertvector(v,bf16x2_t);return __builtin_bit_cast(unsigned,b);}
#define WAIT_BAR(N) asm volatile("s_waitcnt vmcnt(" #N ") lgkmcnt(0)\n\ts_barrier":::"memory")

__device__ __forceinline__ void qkt(f32x16&p0,f32x16&p1,const char*Kslot,const bf16x8*qr,const f32x16&negm,int r32,int hi){
  const char*kb=Kslot+hi*1024+r32*16;
  #pragma unroll
  for(int d0=0;d0<4;++d0){
    const bf16x8 b0=*reinterpret_cast<const bf16x8*>(kb+d0*2048);
    const bf16x8 b1=*reinterpret_cast<const bf16x8*>(kb+d0*2048+512);
    if(d0==0){p0=__builtin_amdgcn_mfma_f32_32x32x16_bf16(b0,qr[0],negm,0,0,0);p1=__builtin_amdgcn_mfma_f32_32x32x16_bf16(b1,qr[0],negm,0,0,0);}
    else{p0=__builtin_amdgcn_mfma_f32_32x32x16_bf16(b0,qr[d0],p0,0,0,0);p1=__builtin_amdgcn_mfma_f32_32x32x16_bf16(b1,qr[d0],p1,0,0,0);}}
}
typedef __attribute__((address_space(3))) const char* lds_cptr;
typedef short v4i16_t __attribute__((ext_vector_type(4)));
__device__ __forceinline__ void kload8(bf16x8*kf,lds_cptr kp){
  kf[0]=*(const __attribute__((address_space(3))) bf16x8*)(kp);      kf[1]=*(const __attribute__((address_space(3))) bf16x8*)(kp+512);
  kf[2]=*(const __attribute__((address_space(3))) bf16x8*)(kp+2048); kf[3]=*(const __attribute__((address_space(3))) bf16x8*)(kp+2560);
  kf[4]=*(const __attribute__((address_space(3))) bf16x8*)(kp+4096); kf[5]=*(const __attribute__((address_space(3))) bf16x8*)(kp+4608);
  kf[6]=*(const __attribute__((address_space(3))) bf16x8*)(kp+6144); kf[7]=*(const __attribute__((address_space(3))) bf16x8*)(kp+6656);
}
__device__ __forceinline__ void kload2(bf16x8*kf,lds_cptr kp,int j){ kf[2*j]=*(const __attribute__((address_space(3))) bf16x8*)(kp+j*2048); kf[2*j+1]=*(const __attribute__((address_space(3))) bf16x8*)(kp+j*2048+512); }
__device__ __forceinline__ s16x4 vtr(lds_cptr p){ return __builtin_bit_cast(s16x4,__builtin_amdgcn_ds_read_tr16_b64_v4i16((__attribute__((address_space(3))) v4i16_t*)p)); }
__device__ __forceinline__ float rowmax(const f32x16&p0,const f32x16&p1){
  float a=max3f(p0[0],p0[1],p1[0]),b=max3f(p0[2],p0[3],p1[1]);a=max3f(a,p1[2],p1[3]);
  #pragma unroll
  for(int r=4;r<16;r+=4){a=max3f(a,p0[r],p0[r+1]);b=max3f(b,p0[r+2],p0[r+3]);a=max3f(a,p1[r],p1[r+1]);b=max3f(b,p1[r+2],p1[r+3]);}
  const float m=max2f(a,b);
  auto rr=__builtin_amdgcn_permlane32_swap(__float_as_uint(m),__float_as_uint(m),false,false);
  return max2f(__uint_as_float(rr[0]),__uint_as_float(rr[1]));
}
__device__ __forceinline__ void pv(f32x16*o,int vb,bf16x8 pa0,bf16x8 pa1,bf16x8 pa2,bf16x8 pa3){
  #pragma unroll
  for(int d0=0;d0<2;++d0){s16x4 lo[4],hi[4];
    #pragma unroll
    for(int ks=0;ks<4;++ks){
      asm volatile("ds_read_b64_tr_b16 %0,%1 offset:%c2":"=&v"(lo[ks]):"v"(vb),"i"(d0*4096+ks*1024):"memory");
      asm volatile("ds_read_b64_tr_b16 %0,%1 offset:%c2":"=&v"(hi[ks]):"v"(vb),"i"(d0*4096+ks*1024+512):"memory");}
    asm volatile("s_waitcnt lgkmcnt(0)":::"memory");SBAR();
    #define PK(k) (bf16x8){lo[k][0],lo[k][1],lo[k][2],lo[k][3],hi[k][0],hi[k][1],hi[k][2],hi[k][3]}
    o[d0]=__builtin_amdgcn_mfma_f32_32x32x16_bf16(pa0,PK(0),o[d0],0,0,0);
    o[d0]=__builtin_amdgcn_mfma_f32_32x32x16_bf16(pa1,PK(1),o[d0],0,0,0);
    o[d0]=__builtin_amdgcn_mfma_f32_32x32x16_bf16(pa2,PK(2),o[d0],0,0,0);
    o[d0]=__builtin_amdgcn_mfma_f32_32x32x16_bf16(pa3,PK(3),o[d0],0,0,0);
    #undef PK
  }
}

#ifndef ATTN_STORE16
#define ATTN_STORE16(p,v) (*(u32x4*)(p)=(v))
#endif
template<int THRL> __device__ __forceinline__ void attn_unit(int b,int h,int qb,const bf16*Q,const bf16*__restrict__ K,const bf16*__restrict__ V,bf16*O,const float*CF,float dskip,char*shm,int wave_id){
  int tid_=(wave_id<<6)|lane_id_v(); asm volatile("":"+v"(tid_));
  const int tid=tid_,lane=tid&63,r32=lane&31,hi=lane>>5; const int wid=__builtin_amdgcn_readfirstlane(tid>>6);
  const long rowbase=(long)b*SEQ; const int q0=qb*QB;
  const bf16*Qw=Q+(rowbase+q0+wid*QBLK)*DM+h*D;
  const float*cfp0=CF+(long)(b*NHEAD+h)*SEQ; const int NT0=(q0+QB)/KVBLK;
  int ts; { const float cq=cfp0[q0]; const int il=(lane<NT0)?64*lane+63:q0; const bool keep=(lane<NT0)&&(cfp0[il]<cq+dskip);
    const unsigned long long km=__ballot(keep); int t0=(int)__builtin_ctzll(km|(1ull<<63)); t0&=~1; ts=__builtin_amdgcn_readfirstlane(t0<NT0-4?t0:NT0-4); }
  const bf16*Kh=K+(rowbase+(long)ts*KVBLK)*DM+h*D,*Vh=V+(rowbase+(long)ts*KVBLK)*DM+h*D;
  const unsigned lds0=(unsigned)(uintptr_t)shm;
  float*wsf=(float*)(shm+LDS_WS)+wid*64;
  const bf16*ksrc=Kh+(long)lane*DM+wid*8;
  const bf16*vsrc=Vh+(long)(16*(wid&3)+(lane>>2))*DM+(wid>>2)*32+(lane&3)*8;
  const unsigned kdst=lds0+LDS_K+wid*1024, vdst=lds0+LDS_V+wid*1024;
  #define DMA_K(t,slot) glds16(ksrc+(long)(t)*KVBLK*DM,(unsigned)__builtin_amdgcn_readfirstlane(kdst+(slot)))
  #define DMA_V(t,slot) glds16(vsrc+(long)(t)*KVBLK*DM,(unsigned)__builtin_amdgcn_readfirstlane(vdst+(slot)))
  const char*Kbase=shm+LDS_K; bf16x8 kf[8];
  const lds_cptr shm3=(lds_cptr)shm; const lds_cptr kp0=shm3+LDS_K+hi*1024+r32*16; const lds_cptr vp0=shm3+LDS_V+((lane>>4)&1)*32+(lane&3)*8+(4*hi+((lane&15)>>2))*64;
  const int NT=NT0-ts;
  { const float*cfp=CF+(long)(b*NHEAD+h)*SEQ; float*ncw=(float*)(shm+LDS_NC);
    for(int i=tid+ts*KVBLK;i<q0+QB;i+=NW*64)ncw[i-ts*KVBLK]=-cfp[i]; }
  const lds_cptr ncp=(lds_cptr)shm+LDS_NC+hi*16;
  #define ADDC(P0,P1,t) do{ const lds_cptr np_=ncp+(t)*256; _Pragma("unroll") for(int g_=0;g_<4;++g_){ \
      const f32x4_t a_=*(const __attribute__((address_space(3))) f32x4_t*)(np_+g_*32), b_=*(const __attribute__((address_space(3))) f32x4_t*)(np_+g_*32+128); \
      P0[4*g_]+=a_[0];P0[4*g_+1]+=a_[1];P0[4*g_+2]+=a_[2];P0[4*g_+3]+=a_[3]; P1[4*g_]+=b_[0];P1[4*g_+1]+=b_[1];P1[4*g_+2]+=b_[2];P1[4*g_+3]+=b_[3]; } }while(0)
  DMA_K(0,0);DMA_V(0,0);DMA_K(1,SLOTB);
  bf16x8 qr[4];
  #pragma unroll
  for(int d0=0;d0<4;++d0)qr[d0]=*reinterpret_cast<const bf16x8*>(&Qw[(long)r32*DM+d0*16+hi*8]);
  float mhat=0.f,l_reg=0.f;f32x16 o[2];f32x16 negm; { float zz_; asm volatile("v_mov_b32 %0, 0":"=v"(zz_));
    _Pragma("unroll") for(int r=0;r<16;++r){o[0][r]=zz_;o[1][r]=zz_;negm[r]=zz_;} } asm volatile("":"+v"(negm));
  const int qrel=wid*QBLK+r32;
  #define CMASK(P0,P1,t) do{int jb_=(t)-(NT-4); if(jb_>=0)cmask(P0,P1,jb_,qrel,hi);}while(0)
  bool resc=false;
  #define START(P0,P1) do{ const float rm=rowmax(P0,P1); resc=false; \
    { const float dl=rm; mhat=fadd_s(mhat,dl); \
      _Pragma("unroll") for(int r=0;r<16;++r){P0[r]=fsub_s(P0[r],dl);P1[r]=fsub_s(P1[r],dl);} \
      _Pragma("unroll") for(int r=0;r<16;++r)negm[r]=-mhat; asm volatile("":"+v"(negm)); } \
    _Pragma("unroll") for(int r=0;r<16;++r)P0[r]=__builtin_amdgcn_exp2f(P0[r]); }while(0)
  #define RESC() do{ if(resc){ asm volatile("s_waitcnt lgkmcnt(0)":::"memory"); \
      _Pragma("unroll") for(int d_=0;d_<2;++d_) _Pragma("unroll") for(int r=0;r<16;++r)o[d_][r]*=wsf[crow(r,hi)]; } }while(0)
  f32x16 pA0,pA1,pB0,pB1;
  int sl_prev=0,sl_cur=0,sl_next=SLOTB;
  #define ROT() do{sl_prev=sl_cur;sl_cur=sl_next;sl_next=(sl_next==(NSLOT-1)*SLOTB)?0:sl_next+SLOTB;}while(0)
  DMA_K(2,2*SLOTB);
  WAIT_BAR(3);
  qkt(pA0,pA1,Kbase,qr,negm,r32,hi);asm volatile("s_nop 15\n\ts_nop 7":"+v"(pA0),"+v"(pA1));ADDC(pA0,pA1,0);CMASK(pA0,pA1,0);
  START(pA0,pA1);
  _Pragma("unroll") for(int r=0;r<16;++r)pA1[r]=__builtin_amdgcn_exp2f(pA1[r]);
  WAIT_BAR(0);
  DMA_K(3,0);DMA_V(1,SLOTB);
  ROT();
  kload8(kf,kp0+sl_cur);
  WAIT_BAR(2);
  s16x4 vlo[8],vhi[8]; u32x4 pw0,pw1,pw2,pw3;
  #define PKW(P,B) cvtpk_s(P[B],P[B+1])
  #define PAF(k) __builtin_bit_cast(bf16x8,pw##k)
  #define VFR(i) (bf16x8){vlo[i][0],vlo[i][1],vlo[i][2],vlo[i][3],vhi[i][0],vhi[i][1],vhi[i][2],vhi[i][3]}
  #define PIN(x) asm volatile("":"+v"(x))
  #define MX3(a,b,c) __builtin_fmaxf(__builtin_fmaxf((a),(b)),(c))
  #define GAPA(MF,A0,A1,A2,A3,W0,W1,PW) do{ MF; sacc+=A0; sacc+=A1; sacc+=A2; sacc+=A3; PIN(sacc); W0; W1; PIN(PW); SBAR(); }while(0)
  #define EX(v) __builtin_amdgcn_exp2f(v)
  #define GAPB(MF,X,B) do{ MF; X[B]=EX(X[B]); X[B+1]=EX(X[B+1]); X[B+2]=EX(X[B+2]); X[B+3]=EX(X[B+3]); PIN(X); SBAR(); }while(0)
  #define VRD(i) do{ vlo[i]=vtr(vp_+(((i)>>2)*4096+((i)&3)*1024)); vhi[i]=vtr(vp_+(((i)>>2)*4096+((i)&3)*1024+512)); }while(0)
  #define KRD(G,j) do{ if(G){ kload2(kf,kp0+sl_next,j); SBAR(); } }while(0)
  #define STEP(C0,C1,P0,P1,t,GK,GV,GL) do{ SBAR(); \
    const lds_cptr vp_=vp0+sl_prev; \
    VRD(0); SBAR(); float sacc=(P0[0]+P0[1]); \
    GAPA(C0=__builtin_amdgcn_mfma_f32_32x32x16_bf16(kf[0],qr[0],negm,0,0,0), P0[2],P0[3],P0[4],P0[5],     pw0[0]=PKW(P0,0), pw0[1]=PKW(P0,2), pw0); \
    VRD(4); SBAR(); GAPA(C1=__builtin_amdgcn_mfma_f32_32x32x16_bf16(kf[1],qr[0],negm,0,0,0), P0[6],P0[7],P0[8],P0[9],     pw0[2]=PKW(P0,4), pw0[3]=PKW(P0,6), pw0); \
    VRD(1); SBAR(); GAPA(C0=__builtin_amdgcn_mfma_f32_32x32x16_bf16(kf[2],qr[1],C0,0,0,0),   P0[10],P0[11],P0[12],P0[13], pw1[0]=PKW(P0,8), pw1[1]=PKW(P0,10), pw1); \
    VRD(5); SBAR(); GAPA(C1=__builtin_amdgcn_mfma_f32_32x32x16_bf16(kf[3],qr[1],C1,0,0,0),   P0[14],P0[15],P1[0],P1[1],   pw1[2]=PKW(P0,12),pw1[3]=PKW(P0,14), pw1); \
    VRD(2); SBAR(); GAPA(C0=__builtin_amdgcn_mfma_f32_32x32x16_bf16(kf[4],qr[2],C0,0,0,0),   P1[2],P1[3],P1[4],P1[5],     pw2[0]=PKW(P1,0), pw2[1]=PKW(P1,2), pw2); \
    VRD(6); SBAR(); GAPA(C1=__builtin_amdgcn_mfma_f32_32x32x16_bf16(kf[5],qr[2],C1,0,0,0),   P1[6],P1[7],P1[8],P1[9],     pw2[2]=PKW(P1,4), pw2[3]=PKW(P1,6), pw2); \
    VRD(3); SBAR(); GAPA(C0=__builtin_amdgcn_mfma_f32_32x32x16_bf16(kf[6],qr[3],C0,0,0,0),   P1[10],P1[11],P1[12],P1[13], pw3[0]=PKW(P1,8), pw3[1]=PKW(P1,10), pw3); \
    VRD(7); SBAR(); GAPA(C1=__builtin_amdgcn_mfma_f32_32x32x16_bf16(kf[7],qr[3],C1,0,0,0),   P1[14],P1[15],0.f,0.f,       pw3[2]=PKW(P1,12),pw3[3]=PKW(P1,14), pw3); \
    l_reg+=sacc; \
    if(GK){DMA_K((t)+3,sl_cur);} if(GV){DMA_V((t)+1,sl_next);} \
    ADDC(C0,C1,t); CMASK(C0,C1,t); \
    { float a=MX3(C0[0],C0[1],C1[0]),b=MX3(C0[2],C0[3],C1[1]); a=MX3(a,C1[2],C1[3]); \
      _Pragma("unroll") for(int r=4;r<16;r+=4){a=MX3(a,C0[r],C0[r+1]);b=MX3(b,C0[r+2],C0[r+3]);a=MX3(a,C1[r],C1[r+1]);b=MX3(b,C1[r+2],C1[r+3]);} \
      float rm=__builtin_fmaxf(a,b); { auto rr=__builtin_amdgcn_permlane32_swap(__float_as_uint(rm),__float_as_uint(rm),false,false); rm=__builtin_fmaxf(__uint_as_float(rr[0]),__uint_as_float(rr[1])); } \
      resc=false; \
      if(__builtin_expect(__any(rm>(float)THRL),0)){ const float dl=__builtin_fmaxf(rm,0.f); mhat+=dl; \
        _Pragma("unroll") for(int r=0;r<16;++r){C0[r]-=dl;C1[r]-=dl;} \
        _Pragma("unroll") for(int r=0;r<16;++r)negm[r]=-mhat; asm volatile("":"+v"(negm)); \
        const float f=__builtin_amdgcn_exp2f(-dl); l_reg*=f; if(hi==0)wsf[r32]=f; resc=true; } } \
    SBAR(); \
    GAPB(o[0]=__builtin_amdgcn_mfma_f32_32x32x16_bf16(PAF(0),VFR(0),o[0],0,0,0), C0,0); \
    GAPB(o[1]=__builtin_amdgcn_mfma_f32_32x32x16_bf16(PAF(0),VFR(4),o[1],0,0,0), C0,4); \
    KRD(GL,0); GAPB(o[0]=__builtin_amdgcn_mfma_f32_32x32x16_bf16(PAF(1),VFR(1),o[0],0,0,0), C0,8); \
    KRD(GL,1); GAPB(o[1]=__builtin_amdgcn_mfma_f32_32x32x16_bf16(PAF(1),VFR(5),o[1],0,0,0), C0,12); \
    KRD(GL,2); GAPB(o[0]=__builtin_amdgcn_mfma_f32_32x32x16_bf16(PAF(2),VFR(2),o[0],0,0,0), C1,0); \
    KRD(GL,3); GAPB(o[1]=__builtin_amdgcn_mfma_f32_32x32x16_bf16(PAF(2),VFR(6),o[1],0,0,0), C1,4); \
    GAPB(o[0]=__builtin_amdgcn_mfma_f32_32x32x16_bf16(PAF(3),VFR(3),o[0],0,0,0), C1,8); \
    GAPB(o[1]=__builtin_amdgcn_mfma_f32_32x32x16_bf16(PAF(3),VFR(7),o[1],0,0,0), C1,12); \
    }while(0)
  int t=1;
  #undef CMASK
  #define CMASK(P0,P1,t) do{}while(0)
  for(;t+5<NT;t+=2){
    STEP(pB0,pB1,pA0,pA1,t,true,true,true);     WAIT_BAR(2); RESC(); ROT();
    STEP(pA0,pA1,pB0,pB1,t+1,true,true,true);   WAIT_BAR(2); RESC(); ROT();
  }
  #undef CMASK
  #define CMASK(P0,P1,t) do{int jb_=(t)-(NT-4); if(jb_>=0)cmask(P0,P1,jb_,qrel,hi);}while(0)
  #define ENDW(tt) do{ if((tt)+3<NT){WAIT_BAR(2);} else if((tt)+2<NT){WAIT_BAR(1);} else {WAIT_BAR(0);} }while(0)
  for(;t+1<NT;t+=2){
    STEP(pB0,pB1,pA0,pA1,t,(t+3<NT),(t+1<NT),(t+1<NT));       ENDW(t);   RESC(); ROT();
    STEP(pA0,pA1,pB0,pB1,t+1,(t+4<NT),(t+2<NT),(t+2<NT));     ENDW(t+1); RESC(); ROT();
  }
  STEP(pB0,pB1,pA0,pA1,NT-1,false,false,false); RESC();
  { float sacc=pB0[0]+pB0[1]; _Pragma("unroll") for(int r=2;r<16;++r)sacc+=pB0[r]; _Pragma("unroll") for(int r=0;r<16;++r)sacc+=pB1[r]; l_reg+=sacc;
    pw0=(u32x4){PKW(pB0,0),PKW(pB0,2),PKW(pB0,4),PKW(pB0,6)};pw1=(u32x4){PKW(pB0,8),PKW(pB0,10),PKW(pB0,12),PKW(pB0,14)};pw2=(u32x4){PKW(pB1,0),PKW(pB1,2),PKW(pB1,4),PKW(pB1,6)};pw3=(u32x4){PKW(pB1,8),PKW(pB1,10),PKW(pB1,12),PKW(pB1,14)};
    int tl_=lane_id_v(); asm volatile("":"+v"(tl_)); const int ln_=tl_&63,hi_=ln_>>5; const int vb0e=(int)(lds0+LDS_V)+((ln_>>4)&1)*32+(ln_&3)*8+(4*hi_+((ln_&15)>>2))*64;
    SBAR(); pv(o,vb0e+sl_cur,PAF(0),PAF(1),PAF(2),PAF(3)); }
  #undef PKW
  #undef PAF
  #undef VFR
  #undef PIN
  #undef MX3
  #undef GAPA
  #undef GAPB
  #undef EX
  #undef VRD
  #undef KRD
  #undef STEP
  #undef ENDW
  {auto rr=__builtin_amdgcn_permlane32_swap(__float_as_uint(l_reg),__float_as_uint(l_reg),false,false);l_reg=__uint_as_float(rr[0])+__uint_as_float(rr[1]);}
  int te_=lane_id_v(); asm volatile("":"+v"(te_)); const int lane_e=te_&63,r32_e=lane_e&31,hi_e=lane_e>>5;
  if(hi_e==0)wsf[32+r32_e]=l_reg;asm volatile("s_waitcnt lgkmcnt(0)":::"memory");
  float rli[16];
  #pragma unroll
  for(int r=0;r<16;++r)rli[r]=__builtin_amdgcn_rcpf(wsf[32+crow(r,hi_e)]);
  bf16*Ow=O+(rowbase+q0+wid*QBLK)*DM+h*D;
  { bf16*stg=(bf16*)(shm+LDS_OST)+wid*2048;
    #pragma unroll
    for(int r=0;r<16;++r){const int orow=crow(r,hi_e);
      #pragma unroll
      for(int d0=0;d0<2;++d0)stg[orow*64+d0*32+r32_e]=__float2bfloat16(o[d0][r]*rli[r]);}
    asm volatile("s_waitcnt lgkmcnt(0)":::"memory");
    #pragma unroll
    for(int i=0;i<4;++i){const int row=i*8+(lane_e>>3),ch=lane_e&7; const u32x4 v=*(const u32x4*)(stg+row*64+ch*8); ATTN_STORE16(Ow+(long)row*DM+ch*8,v);} }
  asm volatile("s_waitcnt lgkmcnt(0)\n\ts_barrier":::"memory");
  #undef ADDC
  #undef DMA_K
  #undef DMA_V
  #undef CMASK
  #undef START
  #undef RESC
  #undef ROT
}
constexpr int ATTN_LDS_BYTES=LDS_BYTES;
struct AttnTensors { const bf16* Q; const bf16* K; const bf16* V; bf16* O; const float* CF; float dskip; };
struct AttnUnit { int bh; int qb; };
struct StaticOrder {
  int vcu;
  __device__ __forceinline__ explicit StaticOrder(int grid,int block):vcu((block%8)*(grid/8)+block/8){}
  __device__ __forceinline__ bool next(int i,AttnUnit&u)const{ if(i>=2)return false; const int s=vcu&7; u.bh=vcu>>3; u.qb=(i==0)?s:15-s; return true; }
  __device__ __forceinline__ void a_ready(const AttnUnit&)const{}
  __device__ __forceinline__ void done(const AttnUnit&)const{}
};
template<class Sched,int THRL=8> __device__ __forceinline__ void attn_phase(char*lds,const AttnTensors&T,const Sched&S,int wave_id){
  AttnUnit u;
  for(int i=0;S.next(i,u);++i){ S.a_ready(u); attn_unit<THRL>(u.bh/NHEAD,u.bh%NHEAD,u.qb,T.Q,T.K,T.V,T.O,T.CF,T.dskip,lds,wave_id); S.done(u); }
}
#undef SBAR
#undef WAIT_BAR
}

struct Args { const float* in[16]; float* out; unsigned char* ws; };
__global__ void __launch_bounds__(NWAVES * 64, 2) hyb_fwd(Args args) {
    extern __shared__ __attribute__((aligned(16))) unsigned char lds[];
    Ctx F;
    F.lds = (LAS unsigned char*)lds;
    F.tid = threadIdx.x; F.lane = F.tid & 63; F.wave = __builtin_amdgcn_readfirstlane(F.tid >> 6);
    F.G = gridDim.x; F.gw = blockIdx.x * NWAVES + F.wave; F.NGW = F.G * NWAVES;
    F.out = args.out; F.ws = args.ws;
    volatile LAS unsigned* MISC = (volatile LAS unsigned*)(F.lds + MISC_OFF);
    for (int u = F.tid; u < (LDS_BYTES - LDSCTL_OFF) / 4; u += NWAVES * 64) ((LAS unsigned*)(F.lds + LDSCTL_OFF))[u] = 0u;
    __syncthreads();
    gu32* ctl = (gu32*)(F.ws + WS_CTL);
    XcdBarrier bar = xcd_barrier_post((unsigned*)(ctl + CW_BAR), MISC + 8); bar.w = F.wave;
#define FRESH(P) Ctx P = F; P.tid = (F.wave << 6) | lane_id_v(); asm volatile("" : "+v"(P.tid), "+s"(P.wave), "+s"(P.gw), "+s"(P.ws), "+s"(P.out)); P.lane = P.tid & 63
#define GRID_BAR() do { XcdBarrier b_ = bar; asm volatile("" : "+s"(b_.bar), "+s"(b_.x)); xcd_barrier(b_); } while (0)

    bf16* Wb = (bf16*)(F.ws + WS_W);
    bf16* Z = (bf16*)(F.ws + WS_Z); float* ZS = (float*)(F.ws + WS_ZS); bf16* HDN = (bf16*)(F.ws + WS_HDN);
    float* M32 = (float*)(F.ws + WS_HDN); bf16* HB = (bf16*)(F.ws + WS_Z);
    LAS unsigned char* ring = F.lds + RING_OFF; float* SSp = (float*)(F.ws + WS_SS);

    { FRESH(P); p0_prologue(P, args.in[2], args.in[9], args.in[10], args.in[11], args.in[12], args.in[14], args.in[15]); }
    { FRESH(P); norm0_phase(P, args.in[0], args.in[1], (bf16*)(P.ws + WS_HDN), (float*)(P.ws + WS_SS)); }
    GRID_BAR();

    #pragma unroll 1
    for (int layer = 0; layer < DEPTH; ++layer) {
        const float* xin = (layer == 0) ? args.in[0] : F.out;
        const bf16* L = Wb + (size_t)layer * LW_STRIDE;
        { pg8::Gemm g{HDN, L + LW_IN, M, NIN, DM, DM, DM}; pg8::StaticOrder S; S.init(M, NIN, F.G, (int)blockIdx.x);
          pg8::EpiZ E{Z, ZS, SSp};
          pg8::gemm_phase<pg8::EpiZ, pg8::StaticOrder, true, true>(ring, g, S, E, F.wave); }
        GRID_BAR();
#ifdef PROBE_PP
        { FRESH(P); post_phase(P, args.in[4] + layer * 64, args.in[5] + layer * 64, args.in[6] + layer * 64, args.in[7] + layer * 64, args.in[3] + layer * 8, true); }
#endif
        { FRESH(P); post_phase(P, args.in[4] + layer * 64, args.in[5] + layer * 64, args.in[6] + layer * 64, args.in[7] + layer * 64, args.in[3] + layer * 8); }
        { FRESH(P); ret_state_mfma(P); }
        GRID_BAR();
        { FRESH(P); fscan_phase(P); }
        { FRESH(P); ret_scan(P); }
        GRID_BAR();
#ifdef PROBE_RO
        { FRESH(P); ret_out_mfma(P, args.in[8] + layer * 512, true); }
#endif
        { FRESH(P); ret_out_mfma(P, args.in[8] + layer * 512); }
#ifdef PROBE_X3
        for (int rep_ = 0; rep_ < 2; ++rep_)
        { static_assert(attn_body::ATTN_LDS_BYTES <= RING_BYTES, "attention scratch fits the ring region");
          unsigned char* wsl = F.ws; asm volatile("" : "+s"(wsl));
          bf16* Zl = (bf16*)(wsl + WS_Z);
          const attn_body::AttnTensors AT{(const attn_body::bf16*)(Zl + Z_FQ), (const attn_body::bf16*)(Zl + Z_FK), (const attn_body::bf16*)(Zl + Z_FV), (attn_body::bf16*)(Zl + (rep_ == 0 ? Z_RQ : Z_FQ)), (const float*)(wsl + WS_CF)};
          const attn_body::StaticOrder S((int)F.G, (int)blockIdx.x);
          attn_body::attn_phase<attn_body::StaticOrder, 20>((char*)lds + RING_OFF, AT, S, F.wave); }
#ifdef PROBE_X4
        { FRESH(P); dsa_v3(P); }
#else
        for (int rep_ = 0; rep_ < 2; ++rep_) { FRESH(P); dsa_v3(P, rep_ == 0 ? Z_RG : Z_DQ); }
#endif
#else
        { static_assert(attn_body::ATTN_LDS_BYTES <= RING_BYTES, "attention scratch fits the ring region");
          unsigned char* wsl = F.ws; asm volatile("" : "+s"(wsl));
          bf16* Zl = (bf16*)(wsl + WS_Z);
          float dskip; { const int ln = lane_id_v(); const float gq = wave_max(fabsf(args.in[4][layer * 64 + ln])), gk = wave_max(fabsf(args.in[5][layer * 64 + ln])); dskip = 2.0f * (64.0f * C2 * gq * gk * 1.02f) + 48.0f; }
          const attn_body::AttnTensors AT{(const attn_body::bf16*)(Zl + Z_FQ), (const attn_body::bf16*)(Zl + Z_FK), (const attn_body::bf16*)(Zl + Z_FV), (attn_body::bf16*)(Zl + Z_FQ), (const float*)(wsl + WS_CF), dskip};
          const attn_body::StaticOrder S((int)F.G, (int)blockIdx.x);
          attn_body::attn_phase<attn_body::StaticOrder, 20>((char*)lds + RING_OFF, AT, S, F.wave); }
        { FRESH(P); dsa_v3(P); }
#endif
        GRID_BAR();
        { pg8::Gemm g{Z + Z_FQ, L + LW_MIX, M, DM, 1536, ZP, 1536}; pg8::StaticOrder S; S.init(M, DM, F.G, (int)blockIdx.x);
          pg8::EpiGateF E{Z + Z_ZG, Z + Z_MRG};
          pg8::gemm_phase<pg8::EpiGateF, pg8::StaticOrder, false, true>(ring, g, S, E, F.wave); }
        GRID_BAR();
        { pg8::Gemm g{Z + Z_MRG, L + LW_O, M, DM, DM, ZP, DM}; pg8::StaticOrder S; S.init(M, DM, F.G, (int)blockIdx.x);
          pg8::EpiRes E{xin, F.out, args.in[13] + layer * DM, HDN, SSp};
          pg8::gemm_phase<pg8::EpiRes, pg8::StaticOrder, false, true>(ring, g, S, E, F.wave); }
        GRID_BAR();
        { pg8::Gemm g{HDN, L + LW_FI, M, FF2, DM, DM, DM}; pg8::StaticOrder S; S.init(M, FF2, F.G, (int)blockIdx.x);
          pg8::EpiSwi E{HB, FFH, SSp};
          pg8::gemm_phase<pg8::EpiSwi, pg8::StaticOrder, true, true>(ring, g, S, E, F.wave); }
        GRID_BAR();
        { pg8::Gemm g{HB, L + LW_FO, M, DM, FFH, FFH, FFH}; pg8::StaticOrder S; S.init(M, DM, F.G, (int)blockIdx.x);
          pg8::EpiRes E{F.out, F.out, args.in[1] + (layer + 1 < DEPTH ? layer + 1 : layer) * DM, HDN, SSp};
          pg8::gemm_phase<pg8::EpiRes, pg8::StaticOrder, false, true>(ring, g, S, E, F.wave); }
        GRID_BAR();
    }
    if (__hip_atomic_load((gu32*)((unsigned*)(ctl + CW_BAR) + XB_TMO), RLX_AGENT) != 0u) {
        const float q = __builtin_nanf("");
        for (int m = F.gw; m < M; m += F.NGW) { GAS f32x4* o = (GAS f32x4*)(F.out + (size_t)m * DM) + lane_id_v();
#pragma unroll
            for (int j = 0; j < 4; ++j) o[64 * j] = (f32x4){q, q, q, q}; }
    }
}

extern "C" void kernel_launch(void* const* d_in, const int* in_sizes, int n_in, void* d_out, int out_size, void* d_ws, size_t ws_size, hipStream_t stream) {
    static int grid = 0;
    if (grid == 0) {
        if (n_in != 16 || in_sizes[0] != M * DM || out_size != M * DM || ws_size < WS_END) { fprintf(stderr, "kernel_launch: unexpected shapes / workspace (n_in %d, in0 %d, out %d, ws %zu < %zu)\n", n_in, n_in > 0 ? in_sizes[0] : -1, out_size, ws_size, (size_t)WS_END); grid = -1; return; }
        int dev = 0, cus = 0, per_cu = 0;
        if (hipGetDevice(&dev) != hipSuccess || hipDeviceGetAttribute(&cus, hipDeviceAttributeMultiprocessorCount, dev) != hipSuccess) { grid = -1; return; }
        if (hipFuncSetAttribute((const void*)hyb_fwd, hipFuncAttributeMaxDynamicSharedMemorySize, LDS_BYTES) != hipSuccess) { fprintf(stderr, "kernel_launch: hipFuncSetAttribute failed\n"); grid = -1; return; }
        if (hipOccupancyMaxActiveBlocksPerMultiprocessor(&per_cu, (const void*)hyb_fwd, NWAVES * 64, LDS_BYTES) != hipSuccess || per_cu < 1) { fprintf(stderr, "kernel_launch: occupancy query reports %d blocks per CU\n", per_cu); }
        (void)hipGetLastError();
        grid = cus;
    }
    if (grid < 0) return;
    if (hipMemsetAsync((char*)d_ws + WS_CTL, 0, CTL_ZERO_BYTES, stream) != hipSuccess) return;
    Args a{};
    for (int i = 0; i < 16; ++i) a.in[i] = (const float*)d_in[i];
    a.out = (float*)d_out; a.ws = (unsigned char*)d_ws;
    hipLaunchKernelGGL(hyb_fwd, dim3(grid), dim3(NWAVES * 64), LDS_BYTES, stream, a);
}
```

```cpp
#include <hip/hip_runtime.h>
#include <cstdio>
#include <cstdint>
#include <cmath>
__device__ __forceinline__ int lane_id_v() { unsigned z; asm volatile("v_mov_b32 %0, 0" : "=v"(z)); return (int)__builtin_amdgcn_mbcnt_hi(~0u, __builtin_amdgcn_mbcnt_lo(~0u, z)); }
template <int MASK> __device__ __forceinline__ float sx(float v) { static_assert(MASK < 32, "swizzle xor mask"); return __builtin_bit_cast(float, __builtin_amdgcn_ds_swizzle(__builtin_bit_cast(int, v), 0x1F | (MASK << 10))); }
template <int MASK> __device__ __forceinline__ unsigned sxu(unsigned v) { return (unsigned)__builtin_amdgcn_ds_swizzle((int)v, 0x1F | (MASK << 10)); }
__device__ __forceinline__ void swap32(unsigned x, unsigned& lo_view, unsigned& hi_view) {
    unsigned a = x, b = x; asm volatile("" : "+v"(b));
    const auto rr = __builtin_amdgcn_permlane32_swap(a, b, false, false);
    lo_view = rr[0]; hi_view = rr[1];
}
template <int CTRL> __device__ __forceinline__ float dpp_f(float v) { return __builtin_bit_cast(float, __builtin_amdgcn_update_dpp(0, __builtin_bit_cast(int, v), CTRL, 0xF, 0xF, false)); }
template <int CTRL> __device__ __forceinline__ int dpp_i(int v) { return __builtin_amdgcn_update_dpp(0, v, CTRL, 0xF, 0xF, false); }
__device__ __forceinline__ float rl_f(float v, int l) { return __builtin_bit_cast(float, __builtin_amdgcn_readlane(__builtin_bit_cast(int, v), l)); }
__device__ __forceinline__ float wave_sum(float v) {
    v += dpp_f<0xB1>(v); v += dpp_f<0x4E>(v); v += dpp_f<0x141>(v); v += dpp_f<0x140>(v);
    return (rl_f(v, 0) + rl_f(v, 16)) + (rl_f(v, 32) + rl_f(v, 48));
}
__device__ __forceinline__ float wave_max(float v) {
    v = fmaxf(v, dpp_f<0xB1>(v)); v = fmaxf(v, dpp_f<0x4E>(v)); v = fmaxf(v, dpp_f<0x141>(v)); v = fmaxf(v, dpp_f<0x140>(v));
    return fmaxf(fmaxf(rl_f(v, 0), rl_f(v, 16)), fmaxf(rl_f(v, 32), rl_f(v, 48)));
}
__device__ __forceinline__ int wave_isum(int v) {
    v += dpp_i<0xB1>(v); v += dpp_i<0x4E>(v); v += dpp_i<0x141>(v); v += dpp_i<0x140>(v);
    return (__builtin_amdgcn_readlane(v, 0) + __builtin_amdgcn_readlane(v, 16)) + (__builtin_amdgcn_readlane(v, 32) + __builtin_amdgcn_readlane(v, 48));
}
__device__ __forceinline__ unsigned wave_umax(unsigned v) {
    unsigned t; t = (unsigned)dpp_i<0xB1>((int)v); v = t > v ? t : v; t = (unsigned)dpp_i<0x4E>((int)v); v = t > v ? t : v; t = (unsigned)dpp_i<0x141>((int)v); v = t > v ? t : v; t = (unsigned)dpp_i<0x140>((int)v); v = t > v ? t : v;
    const unsigned a = (unsigned)__builtin_amdgcn_readlane((int)v, 0), b = (unsigned)__builtin_amdgcn_readlane((int)v, 16), c = (unsigned)__builtin_amdgcn_readlane((int)v, 32), d = (unsigned)__builtin_amdgcn_readlane((int)v, 48);
    const unsigned ab = a > b ? a : b, cd = c > d ? c : d; return ab > cd ? ab : cd;
}
__device__ __forceinline__ unsigned wave_umin(unsigned v) { return ~wave_umax(~v); }
__device__ __forceinline__ float half_sum(float v) {
    unsigned a, b; swap32(__builtin_bit_cast(unsigned, v), a, b); return __builtin_bit_cast(float, a) + __builtin_bit_cast(float, b);
}
__device__ __forceinline__ float half_max(float v) {
    unsigned a, b; swap32(__builtin_bit_cast(unsigned, v), a, b); return fmaxf(__builtin_bit_cast(float, a), __builtin_bit_cast(float, b));
}
namespace pg8 {
#define PG8_LAS __attribute__((address_space(3)))
typedef unsigned short bf16_t;
typedef short bf16x8 __attribute__((ext_vector_type(8)));
typedef float f32x4 __attribute__((ext_vector_type(4)));
typedef unsigned u32x4 __attribute__((ext_vector_type(4)));
constexpr int BM = 256, BK = 64, HALF = 128, HTB = HALF * BK * 2  , STAGE_BYTES = 8 * HTB, NXCD = 8, WGM = 8;

__host__ __device__ __forceinline__ int lds_byte(int r, int c) { const int st = (r >> 4) * 2 + (c >> 5), rr = r & 15, cc = c & 31, ob = rr * 64 + cc * 2; return st * 1024 + (ob ^ (((ob >> 9) & 1) << 5)); }
__host__ __device__ __forceinline__ void stage_rc(int b, int& R, int& C) { const int st = b / 1024, sb = b % 1024, swz = sb ^ (((sb >> 9) & 1) << 5); R = (st >> 1) * 16 + swz / 64; C = (st & 1) * 32 + (swz % 64) / 2; }
__host__ __device__ __forceinline__ int perm32(int rho) { const int n = rho >> 4, i = rho & 15; return 8 * (i >> 2) + 4 * n + (i & 3); }

struct Unit { int pm, pn; };
struct Gemm { const bf16_t* A; const bf16_t* Bt; int M, N, K, lda, ldb; };

struct StaticOrder {
    int nM, nN, nwg, G, c;
    __host__ __device__ void init(int M, int N, int G_, int c_) { nM = M / BM; nN = N / BM; nwg = nM * nN; G = G_; c = c_; }
    __host__ __device__ bool next(int i, Unit& u) const {
        const long L = (long)i * G + c; if (L >= nwg) return false;
        int wgid = (int)L; { const int q = nwg / NXCD, r = nwg % NXCD, xcd = wgid % NXCD, off = wgid / NXCD; wgid = (xcd < r ? xcd * (q + 1) : r * (q + 1) + (xcd - r) * q) + off; }
        const int nig = WGM * nN, gid = wgid / nig, fm = gid * WGM, gsz = (nM - fm) < WGM ? (nM - fm) : WGM;
        u.pm = fm + ((wgid % nig) % gsz); u.pn = (wgid % nig) / gsz; return true;
    }
    __device__ __forceinline__ void a_ready(const Unit&) const {}
    __device__ __forceinline__ void done(const Unit&) const {}
};

__device__ __forceinline__ unsigned cvt_pk_bf16(float lo, float hi) { unsigned r; asm volatile("v_cvt_pk_bf16_f32 %0, %1, %2" : "=v"(r) : "v"(lo), "v"(hi)); return r; }
__device__ __forceinline__ float bflo(unsigned w) { return __builtin_bit_cast(float, w << 16); }
__device__ __forceinline__ float bfhi(unsigned w) { return __builtin_bit_cast(float, w & 0xffff0000u); }
__device__ __forceinline__ float sigmoidf_(float x) { return __builtin_amdgcn_rcpf(1.0f + __builtin_amdgcn_exp2f(-1.4426950408889634f * x)); }

constexpr int ZP = 6656;
constexpr int ZSP = 512;
constexpr int NZT = 26, GATE_T0 = 14;

__device__ __forceinline__ float row_rstd(const float* SS, int row) {
    const f32x4 a = *(const f32x4*)(SS + (size_t)row * 16), b = *(const f32x4*)(SS + (size_t)row * 16 + 4), c = *(const f32x4*)(SS + (size_t)row * 16 + 8), d = *(const f32x4*)(SS + (size_t)row * 16 + 12);
    const float s = ((a[0] + a[1]) + (a[2] + a[3])) + ((b[0] + b[1]) + (b[2] + b[3])) + ((c[0] + c[1]) + (c[2] + c[3])) + ((d[0] + d[1]) + (d[2] + d[3]));
    return 1.0f / __builtin_sqrtf(s * (1.0f / 1024.0f) + 1e-6f);
}
struct EpiZ {
    static constexpr bool PERM = true, AFTER_DRAIN = false, MID = false;
    bf16_t* Z; float* ZS; const float* SS;
    __device__ __forceinline__ void operator()(const f32x4 (&acc)[2][2][4][2], const Unit& u, int wr, int wc, int fr, int fq) const {
        const int row0 = u.pm * BM + wr * 64 + fr;
        if (u.pn < NZT) {
            const int col0 = u.pn * BM + wc * 32 + 8 * fq;
#pragma unroll
            for (int ai = 0; ai < 2; ++ai)
#pragma unroll
                for (int m = 0; m < 4; ++m) { bf16_t* rowp = Z + (size_t)(row0 + ai * HALF + m * 16) * ZP + col0; const float rs = row_rstd(SS, row0 + ai * HALF + m * 16);
#pragma unroll
                    for (int bj = 0; bj < 2; ++bj) { f32x4 v0 = acc[ai][bj][m][0] * rs, v1 = acc[ai][bj][m][1] * rs;
                        if (u.pn >= GATE_T0) {
#pragma unroll
                            for (int i = 0; i < 4; ++i) { v0[i] = sigmoidf_(v0[i]); v1[i] = sigmoidf_(v1[i]); } }
                        u32x4 w; w.x = cvt_pk_bf16(v0[0], v0[1]); w.y = cvt_pk_bf16(v0[2], v0[3]); w.z = cvt_pk_bf16(v1[0], v1[1]); w.w = cvt_pk_bf16(v1[2], v1[3]);
                        *(u32x4*)(rowp + bj * HALF) = w; } }
        } else {
            const int col0 = (u.pn - NZT) * BM + wc * 32 + 8 * fq;
#pragma unroll
            for (int ai = 0; ai < 2; ++ai)
#pragma unroll
                for (int m = 0; m < 4; ++m) { float* rowp = ZS + (size_t)(row0 + ai * HALF + m * 16) * ZSP + col0; const float rs = row_rstd(SS, row0 + ai * HALF + m * 16);
#pragma unroll
                    for (int bj = 0; bj < 2; ++bj) { *(f32x4*)(rowp + bj * HALF) = acc[ai][bj][m][0] * rs; *(f32x4*)(rowp + bj * HALF + 4) = acc[ai][bj][m][1] * rs; } }
        }
    }
};

template <int P> struct EpiGate {
    static constexpr bool PERM = true, AFTER_DRAIN = false, MID = false;
    const bf16_t* G;
    float* M32;
    bf16_t* OUT;
    __device__ __forceinline__ void operator()(const f32x4 (&acc)[2][2][4][2], const Unit& u, int wr, int wc, int fr, int fq) const {
        const int row0 = u.pm * BM + wr * 64 + fr, col0 = u.pn * BM + wc * 32 + 8 * fq;
#pragma unroll
        for (int ai = 0; ai < 2; ++ai)
#pragma unroll
            for (int m = 0; m < 4; ++m) { const size_t row = (size_t)(row0 + ai * HALF + m * 16);
#pragma unroll
                for (int bj = 0; bj < 2; ++bj) { const int col = col0 + bj * HALF;
                    const u32x4 gw = *(const u32x4*)(G + row * ZP + P * 1024 + col);
                    const f32x4 v0 = acc[ai][bj][m][0], v1 = acc[ai][bj][m][1];
                    f32x4 t0, t1;
                    t0[0] = bflo(gw.x) * v0[0]; t0[1] = bfhi(gw.x) * v0[1]; t0[2] = bflo(gw.y) * v0[2]; t0[3] = bfhi(gw.y) * v0[3];
                    t1[0] = bflo(gw.z) * v1[0]; t1[1] = bfhi(gw.z) * v1[1]; t1[2] = bflo(gw.w) * v1[2]; t1[3] = bfhi(gw.w) * v1[3];
                    float* mp = M32 + row * 1024 + col;
                    if (P == 0) { *(f32x4*)mp = t0; *(f32x4*)(mp + 4) = t1; }
                    else if (P == 1) { *(f32x4*)mp = *(const f32x4*)mp + t0; *(f32x4*)(mp + 4) = *(const f32x4*)(mp + 4) + t1; }
                    else { t0 = *(const f32x4*)mp + t0; t1 = *(const f32x4*)(mp + 4) + t1;
                        u32x4 w; w.x = cvt_pk_bf16(t0[0], t0[1]); w.y = cvt_pk_bf16(t0[2], t0[3]); w.z = cvt_pk_bf16(t1[0], t1[1]); w.w = cvt_pk_bf16(t1[2], t1[3]);
                        *(u32x4*)(OUT + row * ZP + col) = w; } } }
    }
};

struct EpiGateF {
    static constexpr bool PERM = true, AFTER_DRAIN = false, MID = true;
    const bf16_t* G; bf16_t* OUT;
    __device__ __forceinline__ void mid(f32x4 (&acc)[2][2][4][2], const Unit& u, int wr, int wc, int fr_, int fq_, int s) const {
        int fr = fr_, fq = fq_; asm volatile("" : "+v"(fr), "+v"(fq));
        const int row0 = u.pm * BM + wr * 64 + fr, col0 = u.pn * BM + wc * 32 + 8 * fq;
#pragma unroll
        for (int ai = 0; ai < 2; ++ai)
#pragma unroll
            for (int m = 0; m < 4; ++m) { const size_t row = (size_t)(row0 + ai * HALF + m * 16);
#pragma unroll
                for (int bj = 0; bj < 2; ++bj) { const bf16_t* gp = G + row * ZP + s * 1024 + col0 + bj * HALF;
                    const u32x4 a = *(const u32x4*)gp, b = *(const u32x4*)(gp + 1024);
                    f32x4 r0, r1;
                    r0[0] = bflo(a.x) * __builtin_amdgcn_rcpf(bflo(b.x)); r0[1] = bfhi(a.x) * __builtin_amdgcn_rcpf(bfhi(b.x)); r0[2] = bflo(a.y) * __builtin_amdgcn_rcpf(bflo(b.y)); r0[3] = bfhi(a.y) * __builtin_amdgcn_rcpf(bfhi(b.y));
                    r1[0] = bflo(a.z) * __builtin_amdgcn_rcpf(bflo(b.z)); r1[1] = bfhi(a.z) * __builtin_amdgcn_rcpf(bfhi(b.z)); r1[2] = bflo(a.w) * __builtin_amdgcn_rcpf(bflo(b.w)); r1[3] = bfhi(a.w) * __builtin_amdgcn_rcpf(bfhi(b.w));
                    acc[ai][bj][m][0] = acc[ai][bj][m][0] * r0; acc[ai][bj][m][1] = acc[ai][bj][m][1] * r1; }
                __builtin_amdgcn_sched_barrier(0); }
    }
    __device__ __forceinline__ void operator()(const f32x4 (&acc)[2][2][4][2], const Unit& u, int wr, int wc, int fr, int fq) const {
        const int row0 = u.pm * BM + wr * 64 + fr, col0 = u.pn * BM + wc * 32 + 8 * fq;
#pragma unroll
        for (int ai = 0; ai < 2; ++ai)
#pragma unroll
            for (int m = 0; m < 4; ++m) { const size_t row = (size_t)(row0 + ai * HALF + m * 16);
#pragma unroll
                for (int bj = 0; bj < 2; ++bj) { const int col = col0 + bj * HALF;
                    const u32x4 gw = *(const u32x4*)(G + row * ZP + 2 * 1024 + col);
                    const f32x4 v0 = acc[ai][bj][m][0], v1 = acc[ai][bj][m][1];
                    u32x4 w; w.x = cvt_pk_bf16(bflo(gw.x) * v0[0], bfhi(gw.x) * v0[1]); w.y = cvt_pk_bf16(bflo(gw.y) * v0[2], bfhi(gw.y) * v0[3]);
                    w.z = cvt_pk_bf16(bflo(gw.z) * v1[0], bfhi(gw.z) * v1[1]); w.w = cvt_pk_bf16(bflo(gw.w) * v1[2], bfhi(gw.w) * v1[3]);
                    *(u32x4*)(OUT + row * ZP + col) = w; } }
    }
};

struct EpiRes {
    static constexpr bool PERM = true, AFTER_DRAIN = false, MID = false;
    const float* RES; float* OUT; const float* G; bf16_t* XG; float* SS;
    __device__ __forceinline__ void operator()(const f32x4 (&acc)[2][2][4][2], const Unit& u, int wr, int wc, int fr, int fq) const {
        const int row0 = u.pm * BM + wr * 64 + fr, col0 = u.pn * BM + wc * 32 + 8 * fq;
        f32x4 g[2][2];
#pragma unroll
        for (int bj = 0; bj < 2; ++bj) { g[bj][0] = *(const f32x4*)(G + col0 + bj * HALF); g[bj][1] = *(const f32x4*)(G + col0 + bj * HALF + 4); }
#pragma unroll
        for (int ai = 0; ai < 2; ++ai)
#pragma unroll
            for (int m = 0; m < 4; ++m) { const int row = row0 + ai * HALF + m * 16; const size_t off = (size_t)row * 1024 + col0; float ss = 0.f;
#pragma unroll
                for (int bj = 0; bj < 2; ++bj) { const float* rp = RES + off + bj * HALF; float* op = OUT + off + bj * HALF;
                    const f32x4 v0 = *(const f32x4*)rp + acc[ai][bj][m][0], v1 = *(const f32x4*)(rp + 4) + acc[ai][bj][m][1];
                    *(f32x4*)op = v0; *(f32x4*)(op + 4) = v1;
                    ss += ((v0[0] * v0[0] + v0[1] * v0[1]) + (v0[2] * v0[2] + v0[3] * v0[3])) + ((v1[0] * v1[0] + v1[1] * v1[1]) + (v1[2] * v1[2] + v1[3] * v1[3]));
                    const f32x4 x0 = v0 * g[bj][0], x1 = v1 * g[bj][1];
                    u32x4 w; w.x = cvt_pk_bf16(x0[0], x0[1]); w.y = cvt_pk_bf16(x0[2], x0[3]); w.z = cvt_pk_bf16(x1[0], x1[1]); w.w = cvt_pk_bf16(x1[2], x1[3]);
                    *(u32x4*)(XG + off + bj * HALF) = w; }
                ss += sx<16>(ss); { unsigned a, b; swap32(__builtin_bit_cast(unsigned, ss), a, b); ss = __builtin_bit_cast(float, a) + __builtin_bit_cast(float, b); }
                if (fq == 0) SS[(size_t)row * 16 + u.pn * 4 + wc] = ss; }
    }
};

struct EpiSwi {
    static constexpr bool PERM = true, AFTER_DRAIN = false, MID = false;
    bf16_t* H; int ldh; const float* SS;
    __device__ __forceinline__ void operator()(const f32x4 (&acc)[2][2][4][2], const Unit& u, int wr, int wc, int fr, int fq) const {
        const int row0 = u.pm * BM + wr * 64 + fr, col0 = u.pn * HALF + wc * 32 + 8 * fq;
#pragma unroll
        for (int ai = 0; ai < 2; ++ai)
#pragma unroll
            for (int m = 0; m < 4; ++m) { bf16_t* hp = H + (size_t)(row0 + ai * HALF + m * 16) * ldh + col0; const float rs = row_rstd(SS, row0 + ai * HALF + m * 16);
                float o[8];
#pragma unroll
                for (int n = 0; n < 2; ++n)
#pragma unroll
                    for (int i = 0; i < 4; ++i) { const float g = acc[ai][0][m][n][i] * rs, up = acc[ai][1][m][n][i] * rs; o[4 * n + i] = g * sigmoidf_(g) * up; }
                u32x4 w; w.x = cvt_pk_bf16(o[0], o[1]); w.y = cvt_pk_bf16(o[2], o[3]); w.z = cvt_pk_bf16(o[4], o[5]); w.w = cvt_pk_bf16(o[6], o[7]);
                *(u32x4*)hp = w; }
    }
};

template <class Epi, class Sched, bool ALIGN_EPI = false, bool SP2 = false>
__device__ __forceinline__ void gemm_phase(PG8_LAS unsigned char* lds, Gemm g, const Sched& S0, const Epi& E, int wave_id) {
    int ovz, osz; asm volatile("v_mov_b32 %0, 0\n\ts_mov_b32 %1, 0" : "=v"(ovz), "=s"(osz));
    Sched S = S0; S.c += osz; g.lda += osz; g.ldb += osz;
    const int tid = ((wave_id << 6) | lane_id_v()) + ovz,
         wid = __builtin_amdgcn_readfirstlane(tid >> 6), lane = tid & 63, wr = wid >> 2, wc = wid & 3, fr = lane & 15, fq = lane >> 4;
    const int K = g.K, nt = K / BK;
    unsigned voffA[2], voffB[2];
#pragma unroll
    for (int i = 0; i < 2; ++i) { int R, C; stage_rc(tid * 16 + i * 8192, R, C); const int Rb = Epi::PERM ? ((R & ~31) + perm32(R & 31)) : R;
        voffA[i] = (unsigned)(R * g.lda + C) * 2u; voffB[i] = (unsigned)(Rb * g.ldb + C) * 2u; }
    const size_t kstep = (size_t)(BK * 2);
    const size_t hstepA = (size_t)HALF * g.lda * 2, hstepB = (size_t)HALF * g.ldb * 2;
    const size_t tstepA = 2 * hstepA, tstepB = 2 * hstepB;
    const unsigned ldsw = (unsigned)wid * 1024u;
    const int aoff = lds_byte(wr * 64 + fr, fq * 8), boff = lds_byte(wc * 32 + fr, fq * 8);
#define PG8_SA(b, h) (((b) * 2 + (h)) * HTB)
#define PG8_SB(b, h) ((4 + (b) * 2 + (h)) * HTB)
#define PG8_STAGE(bufoff, gbase, voff) do { _Pragma("unroll") for (int _i = 0; _i < 2; ++_i) \
        __builtin_amdgcn_global_load_lds((const unsigned*)((const char*)(gbase) + (voff)[_i]), (PG8_LAS unsigned*)(lds + (bufoff) + ldsw + _i * 8192), 16, 0, 0); } while (0)
#define PG8_LDA(dst, b, h) do { _Pragma("unroll") for (int m = 0; m < 4; ++m) _Pragma("unroll") for (int k = 0; k < 2; ++k) dst[m][k] = *(const PG8_LAS bf16x8*)(lds + PG8_SA(b, h) + aoff + m * 2048 + k * 1024); } while (0)
#define PG8_LDB(dst, b, h) do { _Pragma("unroll") for (int n = 0; n < 2; ++n) _Pragma("unroll") for (int k = 0; k < 2; ++k) dst[n][k] = *(const PG8_LAS bf16x8*)(lds + PG8_SB(b, h) + boff + n * 2048 + k * 1024); } while (0)
#define PG8_MMA(ai, bj, At, Bt) do { __builtin_amdgcn_s_setprio(1); _Pragma("unroll") for (int m = 0; m < 4; ++m) _Pragma("unroll") for (int n = 0; n < 2; ++n) _Pragma("unroll") for (int k = 0; k < 2; ++k) \
        acc[ai][bj][m][n] = __builtin_amdgcn_mfma_f32_16x16x32_bf16(Bt[n][k], At[m][k], acc[ai][bj][m][n], 0, 0, 0); __builtin_amdgcn_s_setprio(0); } while (0)
#define PG8_WAIT_V(n) asm volatile("s_waitcnt vmcnt(" #n ")" ::: "memory")
#define PG8_WAIT_L(n) asm volatile("s_waitcnt lgkmcnt(" #n ")" ::: "memory")
#define PG8_BAR __builtin_amdgcn_s_barrier()
#define PG8_SCHED __builtin_amdgcn_sched_barrier(0)
    Unit cur, nxt; int ui = 0;
    if (!S.next(0, cur)) return;
    f32x4 acc[2][2][4][2];
#pragma unroll
    for (int a = 0; a < 2; ++a)
#pragma unroll
        for (int b = 0; b < 2; ++b)
#pragma unroll
            for (int m = 0; m < 4; ++m)
#pragma unroll
                for (int n = 0; n < 2; ++n) acc[a][b][m][n] = (f32x4){0.f, 0.f, 0.f, 0.f};
    bf16x8 At[4][2], B0[2][2], B1[2][2];
    const char* cA = (const char*)g.A + (size_t)cur.pm * tstepA; const char* cB = (const char*)g.Bt + (size_t)cur.pn * tstepB;
    S.a_ready(cur);
    if constexpr (SP2) {
        PG8_STAGE(PG8_SB(0, 0), cB, voffB); PG8_STAGE(PG8_SB(0, 1), cB + hstepB, voffB); PG8_STAGE(PG8_SA(0, 0), cA, voffA); PG8_STAGE(PG8_SA(0, 1), cA + hstepA, voffA);
        if (wr == 1) PG8_BAR;
        PG8_WAIT_V(2); PG8_BAR;
        PG8_STAGE(PG8_SB(1, 0), cB + kstep, voffB); PG8_STAGE(PG8_SA(1, 0), cA + kstep, voffA); PG8_STAGE(PG8_SB(1, 1), cB + hstepB + kstep, voffB);
        PG8_WAIT_V(6); PG8_BAR;
    } else {
        PG8_STAGE(PG8_SB(0, 0), cB, voffB); PG8_STAGE(PG8_SA(0, 0), cA, voffA); PG8_STAGE(PG8_SB(0, 1), cB + hstepB, voffB); PG8_STAGE(PG8_SA(0, 1), cA + hstepA, voffA);
        if (wr == 1) PG8_BAR;
        PG8_WAIT_V(4); PG8_BAR;
        PG8_STAGE(PG8_SB(1, 0), cB + kstep, voffB); PG8_STAGE(PG8_SA(1, 0), cA + kstep, voffA); PG8_STAGE(PG8_SB(1, 1), cB + hstepB + kstep, voffB);
        PG8_WAIT_V(6); PG8_BAR;
    }
    for (;;) {
        const bool has_next = S.next(ui + 1, nxt);
        const char* nA = has_next ? (const char*)g.A + (size_t)nxt.pm * tstepA : cA; const char* nB = has_next ? (const char*)g.Bt + (size_t)nxt.pn * tstepB : cB;
        for (int t = 0; t < nt; t += 2) {
            if constexpr (Epi::MID) { if (t == 8 || t == 16) E.mid(acc, cur, wr, wc, fr, fq, (t >> 3) - 1); }
            const bool last = (t == nt - 2);
            const char* a1 = cA + (size_t)(t + 1) * kstep;
            const char* a2 = last ? nA : cA + (size_t)(t + 2) * kstep; const char* b2 = last ? nB : cB + (size_t)(t + 2) * kstep;
            const char* a3 = a2 + kstep; const char* b3 = b2 + kstep;
            if (last && has_next) S.a_ready(nxt);
            if constexpr (SP2) {
            PG8_LDB(B0, 0, 0); PG8_LDB(B1, 0, 1); PG8_SCHED; PG8_LDA(At, 0, 0); PG8_STAGE(PG8_SA(1, 1), a1 + hstepA, voffA);
            PG8_WAIT_V(8); PG8_WAIT_L(0); PG8_BAR; PG8_MMA(0, 0, At, B0); PG8_MMA(0, 1, At, B1); PG8_BAR; PG8_SCHED;
            PG8_LDA(At, 0, 1); PG8_STAGE(PG8_SB(0, 0), b2, voffB); PG8_STAGE(PG8_SB(0, 1), b2 + hstepB, voffB); PG8_STAGE(PG8_SA(0, 0), a2, voffA);
            PG8_WAIT_V(8); PG8_WAIT_L(0); PG8_BAR; PG8_MMA(1, 0, At, B0); PG8_MMA(1, 1, At, B1); PG8_BAR; PG8_SCHED;
            PG8_LDB(B0, 1, 0); PG8_LDB(B1, 1, 1); PG8_SCHED; PG8_LDA(At, 1, 0); PG8_STAGE(PG8_SA(0, 1), a2 + hstepA, voffA);
            PG8_WAIT_V(8); PG8_WAIT_L(0); PG8_BAR; PG8_MMA(0, 0, At, B0); PG8_MMA(0, 1, At, B1); PG8_BAR; PG8_SCHED;
            PG8_LDA(At, 1, 1); PG8_STAGE(PG8_SB(1, 0), b3, voffB); PG8_STAGE(PG8_SB(1, 1), b3 + hstepB, voffB); PG8_STAGE(PG8_SA(1, 0), a3, voffA);
            PG8_WAIT_V(8); PG8_WAIT_L(0); PG8_BAR; PG8_MMA(1, 0, At, B0); PG8_MMA(1, 1, At, B1); PG8_BAR; PG8_SCHED;
            } else {
            PG8_LDB(B0, 0, 0); PG8_SCHED; PG8_LDA(At, 0, 0); PG8_STAGE(PG8_SA(1, 1), a1 + hstepA, voffA);
            PG8_WAIT_L(8); PG8_BAR; PG8_WAIT_L(0); PG8_MMA(0, 0, At, B0); PG8_BAR; PG8_SCHED;
            PG8_LDB(B1, 0, 1); PG8_STAGE(PG8_SB(0, 0), b2, voffB);
            PG8_BAR; PG8_WAIT_L(0); PG8_MMA(0, 1, At, B1); PG8_BAR;
            PG8_LDA(At, 0, 1); PG8_STAGE(PG8_SA(0, 0), a2, voffA);
            PG8_BAR; PG8_WAIT_L(0); PG8_MMA(1, 0, At, B0); PG8_BAR; PG8_SCHED;
            PG8_STAGE(PG8_SB(0, 1), b2 + hstepB, voffB);
            PG8_WAIT_V(6); PG8_BAR; PG8_MMA(1, 1, At, B1); PG8_BAR;
            PG8_LDB(B0, 1, 0); PG8_SCHED; PG8_LDA(At, 1, 0); PG8_STAGE(PG8_SA(0, 1), a2 + hstepA, voffA);
            PG8_WAIT_L(8); PG8_BAR; PG8_WAIT_L(0); PG8_MMA(0, 0, At, B0); PG8_BAR; PG8_SCHED;
            PG8_LDB(B1, 1, 1); PG8_STAGE(PG8_SB(1, 0), b3, voffB);
            PG8_BAR; PG8_WAIT_L(0); PG8_MMA(0, 1, At, B1); PG8_BAR;
            PG8_LDA(At, 1, 1); PG8_STAGE(PG8_SA(1, 0), a3, voffA);
            PG8_BAR; PG8_WAIT_L(0); PG8_MMA(1, 0, At, B0); PG8_BAR; PG8_SCHED;
            PG8_STAGE(PG8_SB(1, 1), b3 + hstepB, voffB);
            PG8_WAIT_V(6); PG8_BAR; PG8_MMA(1, 1, At, B1); PG8_BAR;
            }
        }
        if constexpr (ALIGN_EPI) { if (wr == 0) PG8_BAR; }
        if constexpr (!Epi::AFTER_DRAIN) { E(acc, cur, wr, wc, fr, fq); S.done(cur); }
        if (!has_next) break;
#pragma unroll
        for (int a = 0; a < 2; ++a)
#pragma unroll
            for (int b = 0; b < 2; ++b)
#pragma unroll
                for (int m = 0; m < 4; ++m)
#pragma unroll
                    for (int n = 0; n < 2; ++n) acc[a][b][m][n] = (f32x4){0.f, 0.f, 0.f, 0.f};
        cur = nxt; cA = nA; cB = nB; ++ui;
        if constexpr (ALIGN_EPI) { if (wr == 1) PG8_BAR; }
    }
    PG8_WAIT_V(0);
    if constexpr (!ALIGN_EPI) { if (wr == 0) PG8_BAR; }
    PG8_BAR;
    if constexpr (Epi::AFTER_DRAIN) { E.fused(acc, cur, wr, wc, fr, fq, lds, wid, lane); S.done(cur); }
#undef PG8_SA
#undef PG8_SB
#undef PG8_STAGE
#undef PG8_LDA
#undef PG8_LDB
#undef PG8_MMA
#undef PG8_WAIT_V
#undef PG8_WAIT_L
#undef PG8_BAR
#undef PG8_SCHED
}
}

constexpr int NB = 4, SEQ = 4096, DM = 1024, DEPTH = 4, M = NB * SEQ;
constexpr int INC = 7088;
constexpr int NIN = 7168;
constexpr int FFH = 2816, FF2 = 5632;
constexpr int ZP = pg8::ZP, ZSP = pg8::ZSP;
constexpr int Z_FQ = 0, Z_DQ = 512, Z_RV = 1024, Z_FK = 1536, Z_FV = 2048,
     Z_RQ = 2560, Z_RK = 2816, Z_RG = 3072, Z_ZG = 3584, Z_MRG = 2560;
constexpr int S_IQ = 0, S_DK = 256, S_DV = 320, S_IK = 384, S_IW = 416, S_FF = 424;
constexpr float NORM_EPS = 1e-6f;
constexpr float LOG2E = 1.4426950408889634f;
constexpr float C2 = 0.125f * 1.4426950408889634f;

constexpr size_t MiB = 1u << 20;
constexpr size_t WS_CTL = 0, CTL_ZERO_BYTES = 1 * MiB;
constexpr size_t WS_ROPE64 = 1 * MiB;
constexpr size_t WS_ROPE32 = 2 * MiB;
constexpr size_t WS_LF = 2 * MiB + 512 * 1024;
constexpr size_t WS_CF = 3 * MiB;
constexpr size_t WS_ISG = 3 * MiB + 512 * 1024;
constexpr size_t WS_KD = 4 * MiB;
constexpr size_t WS_VD = 6 * MiB;
constexpr size_t WS_W = 8 * MiB;
constexpr size_t LW_IN = 0, LW_MIX = (size_t)NIN * 1024, LW_O = LW_MIX + 1536 * 1024, LW_FI = LW_O + 1024 * 1024, LW_FO = LW_FI + (size_t)FF2 * 1024, LW_STRIDE = LW_FO + (size_t)FFH * 1024;
constexpr size_t WS_Z = 150 * MiB;
constexpr size_t WS_HDN = 358 * MiB;
constexpr size_t WS_ZS = 390 * MiB;
constexpr size_t WS_IQB = 422 * MiB;
constexpr size_t WS_IKB = 430 * MiB;
constexpr size_t WS_SS = 431 * MiB;
constexpr size_t WS_END = 432 * MiB;
static_assert(WS_W + DEPTH * LW_STRIDE * 2 <= WS_Z && WS_Z + (size_t)M * ZP * 2 <= WS_HDN && WS_HDN + (size_t)M * 1024 * 2 == WS_ZS && WS_ZS + (size_t)M * ZSP * 4 == WS_IQB, "d_ws map");
constexpr int CW_BAR = 4096;

constexpr int RING_OFF = 0, RING_BYTES = 133120;
constexpr int LDSCTL_OFF = RING_BYTES, MISC_OFF = LDSCTL_OFF + 320;
constexpr int XTRA_OFF = RING_BYTES + 1024;
constexpr int LDS_BYTES = 147456;
constexpr int NWAVES = 8;
#define GAS __attribute__((address_space(1)))
#define LAS __attribute__((address_space(3)))
typedef unsigned short bf16;
typedef unsigned v4u __attribute__((ext_vector_type(4)));
typedef float f32x4 __attribute__((ext_vector_type(4)));
typedef short bf16x8 __attribute__((ext_vector_type(8)));
typedef GAS unsigned gu32;
typedef GAS unsigned long long gu64;
#define RLX_AGENT __ATOMIC_RELAXED, __HIP_MEMORY_SCOPE_AGENT
#define LDS_WAIT() asm volatile("s_waitcnt lgkmcnt(0)" ::: "memory")
#define VM_WAIT() asm volatile("s_waitcnt vmcnt(0)" ::: "memory")
__device__ __forceinline__ unsigned long long rt() { return __builtin_amdgcn_s_memrealtime(); }
__device__ __forceinline__ unsigned f2bf(float f) { unsigned u = __builtin_bit_cast(unsigned, f); return (u + 0x7fffu + ((u >> 16) & 1u)) >> 16; }
__device__ __forceinline__ unsigned pk2(float lo, float hi) { unsigned r; asm("v_cvt_pk_bf16_f32 %0, %1, %2" : "=v"(r) : "v"(lo), "v"(hi)); return r; }

#define XB_TMO      128
#define XB_XCNT(j)  (256  + 64 * (j))
#define XB_XSUB(j)  (1280 + 64 * (j))
#define XB_XGEN(j)  (2304 + 64 * (j))
#define XB_TOP      3328
#define XB_TOPGEN   3392
#define XCD_BAR_WORDS 3456
#define XB_SPIN_CAP (1u << 22)

__device__ __forceinline__ unsigned xb_ld(unsigned* p)              { return __hip_atomic_load(p, __ATOMIC_RELAXED, __HIP_MEMORY_SCOPE_AGENT); }
__device__ __forceinline__ unsigned xb_add(unsigned* p, unsigned v) { return __hip_atomic_fetch_add(p, v, __ATOMIC_RELAXED, __HIP_MEMORY_SCOPE_AGENT); }
__device__ __forceinline__ unsigned xb_xcc_id() { return (unsigned)__builtin_amdgcn_s_getreg((3 << 11) | 20) & 0xFu; }
#define XB_SPIN(cond, bar) do { unsigned _sp = 0; while (cond) { __builtin_amdgcn_s_sleep(1); \
    if ((++_sp & 255u) == 0u) { if (xb_ld(&(bar)[XB_TMO])) break; if (_sp > XB_SPIN_CAP) { atomicAdd(&(bar)[XB_TMO], 1u); break; } } } } while (0)

struct XcdBarrier {
    unsigned* bar; unsigned x; int w;
    volatile LAS unsigned* st;
};

__device__ __forceinline__ XcdBarrier xcd_barrier_post(unsigned* bar, volatile LAS unsigned* st) {
    XcdBarrier b; b.bar = bar; b.x = xb_xcc_id(); b.st = st; b.w = 0;
    if (threadIdx.x == 0) (void)xb_add(&bar[XB_XCNT(b.x)], 1u);
    return b;
}
__device__ __forceinline__ void xcd_barrier_complete(unsigned* bar, unsigned x, unsigned& nloc, unsigned& nx) {
    const unsigned G = gridDim.x * gridDim.y * gridDim.z;
    unsigned sum, cnt, mine, sp = 0u;
    for (;;) {
        sum = 0u; cnt = 0u; mine = 0u;
#pragma unroll
        for (unsigned j = 0; j < 16; ++j) { const unsigned c = xb_ld(&bar[XB_XCNT(j)]); sum += c; cnt += (c > 0u) ? 1u : 0u; mine = (j == x) ? c : mine; }
        if (sum == G) break;
        __builtin_amdgcn_s_sleep(1);
        if ((++sp & 255u) == 0u) { if (xb_ld(&bar[XB_TMO])) break; if (sp > XB_SPIN_CAP) { atomicAdd(&bar[XB_TMO], 1u); break; } }
    }
    nloc = mine > 0u ? mine : 1u; nx = cnt > 0u ? cnt : 1u;
}

__device__ __forceinline__ void xcd_barrier(const XcdBarrier& b) {
    asm volatile("s_waitcnt vmcnt(0)" ::: "memory");
    __syncthreads();
    if (b.w == 0 && lane_id_v() == 0) {
        unsigned* bar = b.bar;
        __builtin_amdgcn_s_waitcnt(0);
        unsigned nloc = b.st[0], nx = b.st[1];
        if (nloc == 0u) { xcd_barrier_complete(bar, b.x, nloc, nx); b.st[0] = nloc; b.st[1] = nx; }
        const unsigned old = xb_add(&bar[XB_XSUB(b.x)], 1u);
        const unsigned gen = old / nloc;
        if (old + 1u == (gen + 1u) * nloc) {
            __builtin_amdgcn_fence(__ATOMIC_RELEASE, "agent");
            asm volatile("s_waitcnt vmcnt(0)" ::: "memory");
            const unsigned og = xb_add(&bar[XB_TOP], 1u);
            const unsigned tg = og / nx;
            if (og + 1u == (tg + 1u) * nx) xb_add(&bar[XB_TOPGEN], 1u);
            else XB_SPIN(xb_ld(&bar[XB_TOPGEN]) == tg, bar);
            __builtin_amdgcn_fence(__ATOMIC_ACQUIRE, "agent");
            xb_add(&bar[XB_XGEN(b.x)], 1u);
            asm volatile("s_waitcnt vmcnt(0)" ::: "memory");
        } else {
            XB_SPIN(xb_ld(&bar[XB_XGEN(b.x)]) == gen, bar);
            __builtin_amdgcn_fence(__ATOMIC_ACQUIRE, "agent");
            asm volatile("s_waitcnt vmcnt(0)" ::: "memory");
        }
    }
    __syncthreads();
}

typedef float f32x2 __attribute__((ext_vector_type(2)));
typedef unsigned u32x2 __attribute__((ext_vector_type(2)));
__device__ __forceinline__ float bflo(unsigned w) { return __builtin_bit_cast(float, w << 16); }
__device__ __forceinline__ float bfhi(unsigned w) { return __builtin_bit_cast(float, w & 0xffff0000u); }
__device__ __forceinline__ float bf2f(bf16 v) { return __builtin_bit_cast(float, (unsigned)v << 16); }
__device__ __forceinline__ void unpack8(const v4u w, float (&f)[8]) { f[0] = bflo(w.x); f[1] = bfhi(w.x); f[2] = bflo(w.y); f[3] = bfhi(w.y); f[4] = bflo(w.z); f[5] = bfhi(w.z); f[6] = bflo(w.w); f[7] = bfhi(w.w); }
__device__ __forceinline__ v4u pack8(const float (&f)[8]) { v4u w; w.x = pk2(f[0], f[1]); w.y = pk2(f[2], f[3]); w.z = pk2(f[4], f[5]); w.w = pk2(f[6], f[7]); return w; }
__device__ __forceinline__ float xor32(float v, int lane) {
    return __builtin_bit_cast(float, __builtin_amdgcn_ds_bpermute((lane ^ 32) << 2, __builtin_bit_cast(int, v)));
}
__device__ __forceinline__ float sigmoid_f(float x) { return 1.0f / (1.0f + __expf(-x)); }

struct Ctx {
    LAS unsigned char* lds;
    int tid, lane, wave, G, gw, NGW;
    float* out; unsigned char* ws;
};

__device__ __forceinline__ void conv_item(const float* W, int N, int sc, int nv, int k0, bf16* WT, int ldw, int dr, LAS float* scr, int lane) {
    const int n_ = lane & 31;
#pragma unroll 8
    for (int i = 0; i < 32; ++i) { const int kk = 2 * i + (lane >> 5); scr[kk * 33 + n_] = (n_ < nv) ? W[(size_t)(k0 + kk) * N + sc + n_] : 0.f; }
    LDS_WAIT(); asm volatile("" ::: "memory");
    const int c = lane & 7;
#pragma unroll
    for (int j = 0; j < 4; ++j) { const int n = (lane >> 3) + 8 * j; const LAS float* s = scr + (8 * c) * 33 + n;
        v4u o; o.x = pk2(s[0 * 33], s[1 * 33]); o.y = pk2(s[2 * 33], s[3 * 33]); o.z = pk2(s[4 * 33], s[5 * 33]); o.w = pk2(s[6 * 33], s[7 * 33]);
        if (n < nv) *(GAS v4u*)(WT + (size_t)(dr + n) * ldw + k0 + 8 * c) = o; }
    LDS_WAIT(); asm volatile("" ::: "memory");
}
__device__ const int SEG_IN[15][3] = {
    {0, Z_FQ, 512}, {512, Z_FK, 512}, {1024, Z_FV, 512}, {1536, 6656 + S_FF, 8}, {1544, Z_DQ, 512}, {2056, 6656 + S_DK, 64}, {2120, 6656 + S_DV, 64},
    {2184, 6656 + S_IQ, 256}, {2440, 6656 + S_IK, 32}, {2472, 6656 + S_IW, 8}, {2480, Z_RQ, 256}, {2736, Z_RK, 256}, {2992, Z_RV, 512}, {3504, Z_RG, 512}, {4016, Z_ZG, 3072}};
constexpr int IN_BLK = 223;
constexpr int IT_IN = 16 * IN_BLK, IT_MIX = 8 * 32, IT_O = 16 * 32, IT_FI = 16 * (FF2 / 32), IT_FO = (FFH / 64) * 32;
constexpr int IT_LAYER = IT_IN + 3 * IT_MIX + IT_O + IT_FI + IT_FO;

__device__ __forceinline__ void sincos_acc(float ang, float& c, float& s) {
    const double a = (double)ang;
    const double k = __builtin_rint(a * 0.6366197723675814);
    double y = a - k * 1.5707963267948966; y -= k * 6.123233995736766e-17;
    const double y2 = y * y;
    double sp = -7.647163731819816e-13; sp = sp * y2 + 1.6059043836821613e-10; sp = sp * y2 - 2.505210838544172e-08; sp = sp * y2 + 2.7557319223985893e-06; sp = sp * y2 - 1.984126984126984e-04; sp = sp * y2 + 8.333333333333333e-03; sp = sp * y2 - 1.6666666666666666e-01;
    const double sn = y + y * y2 * sp;
    double cp = 4.779477332387385e-14; cp = cp * y2 - 1.1470745597729725e-11; cp = cp * y2 + 2.08767569878681e-09; cp = cp * y2 - 2.755731922398589e-07; cp = cp * y2 + 2.48015873015873e-05; cp = cp * y2 - 1.388888888888889e-03; cp = cp * y2 + 4.1666666666666664e-02; cp = cp * y2 - 0.5;
    const double cs = 1.0 + y2 * cp;
    const int q = ((int)k) & 3;
    const double ss = (q & 1) ? cs : sn, cc = (q & 1) ? sn : cs;
    s = (float)((q & 2) ? -ss : ss);
    c = (float)(((q + 1) & 2) ? -cc : cc);
}

__device__ __forceinline__ void p0_prologue(const Ctx& F, const float* w_in, const float* w_fox, const float* w_dsa, const float* w_ret, const float* w_o, const float* w_fi, const float* w_fo) {
    LAS float* scr = (LAS float*)(F.lds + RING_OFF + F.wave * 16384);
    bf16* Wb = (bf16*)(F.ws + WS_W);
    for (int it = F.gw; it < DEPTH * IT_LAYER; it += F.NGW) {
        const int l = it / IT_LAYER; int r = it % IT_LAYER;
        bf16* L = Wb + (size_t)l * LW_STRIDE;
        if (r < IT_IN) {
            const int kb = r / IN_BLK; int blk = r % IN_BLK; int sc = 0, dr = 0, nv = 0;
            for (int s = 0; s < 15; ++s) { const int w = SEG_IN[s][2], nb = (w + 31) >> 5; if (blk < nb) { sc = SEG_IN[s][0] + 32 * blk; dr = SEG_IN[s][1] + 32 * blk; nv = (w - 32 * blk) < 32 ? (w - 32 * blk) : 32; break; } blk -= nb; }
            conv_item(w_in + (size_t)l * DM * INC, INC, sc, nv, 64 * kb, L + LW_IN, 1024, dr, scr, F.lane); continue; }
        r -= IT_IN;
        if (r < 3 * IT_MIX) { const int w = r / IT_MIX, q = r % IT_MIX, kb = q / 32, nb = q % 32;
            conv_item((w == 0 ? w_fox : w == 1 ? w_dsa : w_ret) + (size_t)l * 512 * DM, DM, 32 * nb, 32, 64 * kb, L + LW_MIX + (size_t)w * 512, 1536, 32 * nb, scr, F.lane); continue; }
        r -= 3 * IT_MIX;
        if (r < IT_O) { const int kb = r / 32, nb = r % 32;
            conv_item(w_o + (size_t)l * DM * DM, DM, 32 * nb, 32, 64 * kb, L + LW_O, 1024, 32 * nb, scr, F.lane); continue; }
        r -= IT_O;
        if (r < IT_FI) { const int kb = r / (FF2 / 32), nb = r % (FF2 / 32); const int n0 = 32 * nb;
            const int j = n0 < FFH ? n0 : n0 - FFH; const int dr = 256 * (j >> 7) + (j & 127) + (n0 < FFH ? 0 : 128);
            conv_item(w_fi + (size_t)l * DM * FF2, FF2, n0, 32, 64 * kb, L + LW_FI, 1024, dr, scr, F.lane); continue; }
        r -= IT_FI;
        { const int kb = r / 32, nb = r % 32;
            conv_item(w_fo + (size_t)l * FFH * DM, DM, 32 * nb, 32, 64 * kb, L + LW_FO, FFH, 32 * nb, scr, F.lane); }
    }
    for (int i = F.gw * 64 + F.lane; i < DEPTH * 80 * 128; i += F.NGW * 64) { const int l = i / (80 * 128), q = i % (80 * 128);
        *(GAS v4u*)(Wb + (size_t)l * LW_STRIDE + LW_IN + (size_t)INC * 1024 + (size_t)q * 8) = (v4u){0u, 0u, 0u, 0u}; }
    f32x2* R64 = (f32x2*)(F.ws + WS_ROPE64); f32x2* R32 = (f32x2*)(F.ws + WS_ROPE32);
    for (int i = F.gw * 64 + F.lane; i < SEQ * 32; i += F.NGW * 64) { const int pos = i >> 5, k = i & 31;
        double f = 1.0; for (int e = 0; e < k; ++e) f *= 0.7498942093324559;
        const float ang = (float)pos * (float)f; float c, s; sincos_acc(ang, c, s); R64[i] = (f32x2){c, s}; }
    for (int i = F.gw * 64 + F.lane; i < SEQ * 16; i += F.NGW * 64) { const int pos = i >> 4, k = i & 15;
        double f = 1.0; for (int e = 0; e < k; ++e) f *= 0.5623413251903491;
        const float ang = (float)pos * (float)f; float c, s; sincos_acc(ang, c, s); R32[i] = (f32x2){c, s}; }
}

__device__ __forceinline__ void norm0_phase(const Ctx& F, const float* x, const float* g, bf16* o, float* SS) {
    const GAS f32x4* gp = (const GAS f32x4*)g + F.lane;
    f32x4 gv[4];
#pragma unroll
    for (int j = 0; j < 4; ++j) gv[j] = gp[64 * j];
    for (int m = F.gw; m < M; m += F.NGW) {
        const GAS f32x4* xr = (const GAS f32x4*)(x + (size_t)m * DM) + F.lane;
        f32x4 v[4]; float s = 0.f;
#pragma unroll
        for (int j = 0; j < 4; ++j) { v[j] = xr[64 * j]; s += (v[j].x * v[j].x + v[j].y * v[j].y) + (v[j].z * v[j].z + v[j].w * v[j].w); }
        s = wave_sum(s);
        GAS unsigned long long* o8 = (GAS unsigned long long*)(o + (size_t)m * DM) + F.lane;
#pragma unroll
        for (int j = 0; j < 4; ++j) o8[64 * j] = (unsigned long long)pk2(v[j].x * gv[j].x, v[j].y * gv[j].y) | ((unsigned long long)pk2(v[j].z * gv[j].z, v[j].w * gv[j].w) << 32);
        if (F.lane < 16) SS[(size_t)m * 16 + F.lane] = (F.lane == 0) ? s : 0.f;
    }
}

__device__ __forceinline__ void post_phase(const Ctx& F, const float* g_fq, const float* g_fk, const float* g_dq, const float* g_dk, const float* b_f, bool dummy_out = false) {
    bf16* Z = (bf16*)(F.ws + WS_Z); const float* ZS = (const float*)(F.ws + WS_ZS);
    const f32x2* R64 = (const f32x2*)(F.ws + WS_ROPE64); const f32x2* R32 = (const f32x2*)(F.ws + WS_ROPE32);
    float* LF = (float*)(F.ws + WS_LF); unsigned* ISG = (unsigned*)(F.ws + WS_ISG);
    bf16* KD = (bf16*)(F.ws + WS_KD); bf16* VD = (bf16*)(F.ws + WS_VD); bf16* IQB = (bf16*)(F.ws + WS_IQB); bf16* IKB = (bf16*)(F.ws + WS_IKB);
    const int t0 = blockIdx.x * 512 + F.tid, NT = F.G * 512;
#pragma unroll 1
    for (int seg = 0; seg < 3; ++seg) {
        const int col = (seg == 0) ? Z_FQ : (seg == 1) ? Z_FK : Z_DQ; const float* gp = (seg == 0) ? g_fq : (seg == 1) ? g_fk : g_dq; const float osc = (seg == 1) ? 1.0f : C2;
        for (int t = t0; t < M * 8; t += NT) { const int m = t >> 3, h = t & 7; bf16* p = Z + (size_t)m * ZP + col + h * 64;
            v4u w[8];
#pragma unroll
            for (int i = 0; i < 8; ++i) w[i] = *(const GAS v4u*)(p + 8 * i);
            float f[64]; float ss = 0.f;
#pragma unroll
            for (int i = 0; i < 8; ++i) { float t8[8]; unpack8(w[i], t8);
#pragma unroll
                for (int j = 0; j < 8; ++j) { f[8 * i + j] = t8[j]; ss += t8[j] * t8[j]; } }
            const float rs = osc / sqrtf(ss * (1.f / 64) + NORM_EPS);
#pragma unroll
            for (int d = 0; d < 64; ++d) f[d] = f[d] * rs * gp[d];
            if (seg == 2) { const f32x2* cs = R64 + (m & (SEQ - 1)) * 32;
#pragma unroll
                for (int d = 0; d < 32; ++d) { const f32x2 tt = cs[d]; const float x1 = f[d], x2 = f[d + 32]; f[d] = x1 * tt.x - x2 * tt.y; f[d + 32] = x2 * tt.x + x1 * tt.y; } }
#pragma unroll
            for (int i = 0; i < 8; ++i) { float t8[8];
#pragma unroll
                for (int j = 0; j < 8; ++j) t8[j] = f[8 * i + j];
                *(GAS v4u*)((dummy_out ? (bf16*)(F.ws + WS_HDN + 16 * MiB) + (size_t)m * 512 + h * 64 : p) + 8 * i) = pack8(t8); }
        }
    }
    for (int t = t0; t < M * 8; t += NT) { const int m = t >> 3, h = t & 7; const float* sp = ZS + (size_t)m * ZSP + S_IQ + h * 32;
        f32x4 v[8];
#pragma unroll
        for (int i = 0; i < 8; ++i) v[i] = *(const GAS f32x4*)(sp + 4 * i);
        const float aw = fabsf(ZS[(size_t)m * ZSP + S_IW + h]);
        const f32x2* cs = R32 + (m & (SEQ - 1)) * 16; float f[32];
#pragma unroll
        for (int i = 0; i < 8; ++i) { f[4 * i] = v[i].x; f[4 * i + 1] = v[i].y; f[4 * i + 2] = v[i].z; f[4 * i + 3] = v[i].w; }
#pragma unroll
        for (int d = 0; d < 16; ++d) { const f32x2 tt = cs[d]; const float x1 = f[d], x2 = f[d + 16]; f[d] = (x1 * tt.x - x2 * tt.y) * aw; f[d + 16] = (x2 * tt.x + x1 * tt.y) * aw; }
        bf16* op = IQB + (size_t)m * 256 + h * 32;
#pragma unroll
        for (int i = 0; i < 4; ++i) { float t8[8];
#pragma unroll
            for (int j = 0; j < 8; ++j) t8[j] = f[8 * i + j];
            *(GAS v4u*)(op + 8 * i) = pack8(t8); }
    }
    for (int m = t0; m < M; m += NT) { const float* sr = ZS + (size_t)m * ZSP; const int pos = m & (SEQ - 1);
        { float f[64]; float ss = 0.f;
#pragma unroll
            for (int i = 0; i < 16; ++i) { const f32x4 v = *(const GAS f32x4*)(sr + S_DK + 4 * i); f[4 * i] = v.x; f[4 * i + 1] = v.y; f[4 * i + 2] = v.z; f[4 * i + 3] = v.w; ss += (v.x * v.x + v.y * v.y) + (v.z * v.z + v.w * v.w); }
            const float rs = 1.0f / sqrtf(ss * (1.f / 64) + NORM_EPS); const f32x2* cs = R64 + pos * 32;
#pragma unroll
            for (int d = 0; d < 64; ++d) f[d] = f[d] * rs * g_dk[d];
#pragma unroll
            for (int d = 0; d < 32; ++d) { const f32x2 tt = cs[d]; const float x1 = f[d], x2 = f[d + 32]; f[d] = x1 * tt.x - x2 * tt.y; f[d + 32] = x2 * tt.x + x1 * tt.y; }
#pragma unroll
            for (int i = 0; i < 8; ++i) { float t8[8];
#pragma unroll
                for (int j = 0; j < 8; ++j) t8[j] = f[8 * i + j];
                *(GAS v4u*)(KD + (size_t)m * 64 + 8 * i) = pack8(t8); } }
#pragma unroll
        for (int i = 0; i < 8; ++i) { const f32x4 a = *(const GAS f32x4*)(sr + S_DV + 8 * i), b = *(const GAS f32x4*)(sr + S_DV + 8 * i + 4); const float t8[8] = {a.x, a.y, a.z, a.w, b.x, b.y, b.z, b.w};
            *(GAS v4u*)(VD + (size_t)m * 64 + 8 * i) = pack8(t8); }
        { float f[32]; const f32x2* cs = R32 + pos * 16;
#pragma unroll
            for (int i = 0; i < 8; ++i) { const f32x4 v = *(const GAS f32x4*)(sr + S_IK + 4 * i); f[4 * i] = v.x; f[4 * i + 1] = v.y; f[4 * i + 2] = v.z; f[4 * i + 3] = v.w; }
#pragma unroll
            for (int d = 0; d < 16; ++d) { const f32x2 tt = cs[d]; const float x1 = f[d], x2 = f[d + 16]; f[d] = x1 * tt.x - x2 * tt.y; f[d + 16] = x2 * tt.x + x1 * tt.y; }
#pragma unroll
            for (int i = 0; i < 4; ++i) { float t8[8];
#pragma unroll
                for (int j = 0; j < 8; ++j) t8[j] = f[8 * i + j];
                *(GAS v4u*)(IKB + (size_t)m * 32 + 8 * i) = pack8(t8); } }
        { const f32x4 w0 = *(const GAS f32x4*)(sr + S_IW), w1 = *(const GAS f32x4*)(sr + S_IW + 4); const float iw[8] = {w0.x, w0.y, w0.z, w0.w, w1.x, w1.y, w1.z, w1.w}; unsigned sg = 0;
#pragma unroll
            for (int h = 0; h < 8; ++h) sg |= (iw[h] < 0.f ? 1u : 0u) << h;
            ISG[m] = sg;
            const f32x4 f0 = *(const GAS f32x4*)(sr + S_FF), f1 = *(const GAS f32x4*)(sr + S_FF + 4); const float ff[8] = {f0.x, f0.y, f0.z, f0.w, f1.x, f1.y, f1.z, f1.w}; float lf[8];
#pragma unroll
            for (int h = 0; h < 8; ++h) { const float xx = ff[h] + b_f[h]; lf[h] = (fminf(xx, 0.f) - __logf(1.0f + __expf(-fabsf(xx)))) * LOG2E; }
            *(GAS f32x4*)(LF + (size_t)m * 8) = (f32x4){lf[0], lf[1], lf[2], lf[3]}; *(GAS f32x4*)(LF + (size_t)m * 8 + 4) = (f32x4){lf[4], lf[5], lf[6], lf[7]}; }
    }
}

__device__ __forceinline__ float ret_l2g(int h) { return h == 0 ? -0.04580368961312479f : h == 1 ? -0.02272007650008353f : h == 2 ? -0.011315313227834146f : -0.005646563141142063f; }

__device__ __forceinline__ void scan_state_phase(const Ctx& F) {
    const float* LF = (const float*)(F.ws + WS_LF); float* CF = (float*)(F.ws + WS_CF);
    const bf16* Z = (const bf16*)(F.ws + WS_Z); float* RS = (float*)(F.ws + WS_HDN);
    if (F.gw < 32) {
        const int b = F.gw >> 3, h = F.gw & 7; const float* lp = LF + ((size_t)b * SEQ + F.lane * 64) * 8 + h; float s = 0.f;
        for (int i = 0; i < 64; ++i) s += lp[i * 8];
        float incl = s;
#pragma unroll
        for (int o = 1; o < 64; o <<= 1) { const float t = __builtin_bit_cast(float, __builtin_amdgcn_ds_bpermute(((F.lane - o) & 63) << 2, __builtin_bit_cast(int, incl))); if (F.lane >= o) incl += t; }
        float run = incl - s; float* cp = CF + (size_t)F.gw * SEQ + F.lane * 64;
        for (int i = 0; i < 64; ++i) { run += lp[i * 8]; cp[i] = run; }
    }
    for (int u = blockIdx.x; u < NB * 32 * 4; u += F.G) {
        const int h = u & 3, c = (u >> 2) & 31, b = u >> 7; const float l2g = ret_l2g(h);
        const int d = F.tid >> 3, e0 = (F.tid & 7) * 16; float acc[16];
#pragma unroll
        for (int i = 0; i < 16; ++i) acc[i] = 0.f;
        const bf16* base = Z + ((size_t)b * SEQ + c * 128) * ZP;
        for (int j = 0; j < 128; ++j) { const bf16* row = base + (size_t)j * ZP;
            const float kd = bf2f(row[Z_RK + h * 64 + d]) * exp2f((float)(127 - j) * l2g);
            const v4u w0 = *(const GAS v4u*)(row + Z_RV + h * 128 + e0), w1 = *(const GAS v4u*)(row + Z_RV + h * 128 + e0 + 8);
            float v0[8], v1[8]; unpack8(w0, v0); unpack8(w1, v1);
#pragma unroll
            for (int i = 0; i < 8; ++i) { acc[i] += kd * v0[i]; acc[8 + i] += kd * v1[i]; } }
        float* o = RS + (size_t)u * 8192 + d * 128 + e0;
#pragma unroll
        for (int i = 0; i < 4; ++i) *(GAS f32x4*)(o + 4 * i) = (f32x4){acc[4 * i], acc[4 * i + 1], acc[4 * i + 2], acc[4 * i + 3]};
    }
}

__device__ __forceinline__ void ret_out_naive(const Ctx& F, const float* gn) {
    bf16* Z = (bf16*)(F.ws + WS_Z); const float* RS = (const float*)(F.ws + WS_HDN);
    LAS float* S = (LAS float*)(F.lds);
    LAS bf16* Vt = (LAS bf16*)(F.lds + 32768);
    LAS float* Kt = (LAS float*)(F.lds + 65536);
    LAS float* aw = (LAS float*)(F.lds + 65536 + 33280) + F.wave * 128;
    LAS float* qw = (LAS float*)(F.lds + 65536 + 33280 + 4096) + F.wave * 64;
    for (int u = blockIdx.x; u < NB * 32 * 4; u += F.G) {
        const int h = u & 3, c = (u >> 2) & 31, b = u >> 7; const float l2g = ret_l2g(h); const float wch = exp2f(128.f * l2g);
        __syncthreads();
        { float s[16];
#pragma unroll
            for (int i = 0; i < 16; ++i) s[i] = 0.f;
            for (int cp = 0; cp < c; ++cp) { const float* L = RS + ((size_t)((b * 32 + cp) * 4 + h)) * 8192 + F.tid;
#pragma unroll
                for (int i = 0; i < 16; ++i) s[i] = wch * s[i] + L[i * 512]; }
#pragma unroll
            for (int i = 0; i < 16; ++i) S[F.tid + i * 512] = s[i]; }
        const bf16* base = Z + ((size_t)b * SEQ + c * 128) * ZP;
        for (int q = F.tid; q < 2048; q += 512) { const int r = q >> 4, ch = q & 15; *(LAS v4u*)(Vt + r * 128 + ch * 8) = *(const GAS v4u*)(base + (size_t)r * ZP + Z_RV + h * 128 + ch * 8); }
        for (int q = F.tid; q < 128 * 64; q += 512) { const int r = q >> 6, dd = q & 63; Kt[r * 65 + dd] = bf2f(base[(size_t)r * ZP + Z_RK + h * 64 + dd]); }
        __syncthreads();
        for (int i = F.wave; i < 128; i += NWAVES) {
            const size_t m = (size_t)b * SEQ + c * 128 + i; bf16* zr = Z + m * ZP;
            qw[F.lane] = bf2f(zr[Z_RQ + h * 64 + F.lane]);
            LDS_WAIT(); asm volatile("" ::: "memory");
#pragma unroll
            for (int jj = 0; jj < 2; ++jj) { const int j = F.lane + 64 * jj; float a = 0.f;
                if (j <= i) { float dot = 0.f; for (int dd = 0; dd < 64; ++dd) dot += qw[dd] * Kt[j * 65 + dd]; a = dot * exp2f((float)(i - j) * l2g); }
                aw[j] = a; }
            LDS_WAIT(); asm volatile("" ::: "memory");
            float o[2]; const float dq = exp2f((float)(i + 1) * l2g);
#pragma unroll
            for (int ee = 0; ee < 2; ++ee) { const int e = F.lane + 64 * ee; float acc = 0.f;
                for (int j = 0; j <= i; ++j) acc += aw[j] * bf2f(Vt[j * 128 + e]);
                float cr = 0.f; for (int dd = 0; dd < 64; ++dd) cr += qw[dd] * S[dd * 128 + e];
                o[ee] = acc + cr * dq; }
            const float ss = wave_sum(o[0] * o[0] + o[1] * o[1]); const float rstd = 1.0f / sqrtf(ss * (1.f / 128) + NORM_EPS);
#pragma unroll
            for (int ee = 0; ee < 2; ++ee) { const int e = F.lane + 64 * ee; const float rg = bf2f(zr[Z_RG + h * 128 + e]);
                zr[Z_RV + h * 128 + e] = (bf16)f2bf(o[ee] * rstd * gn[h * 128 + e] * rg * sigmoid_f(rg)); }
            LDS_WAIT(); asm volatile("" ::: "memory");
        }
    }
    __syncthreads();
}

__device__ __forceinline__ void fox_naive(const Ctx& F) {
    bf16* Z = (bf16*)(F.ws + WS_Z); const float* CF = (const float*)(F.ws + WS_CF);
    LAS float* sc = (LAS float*)(F.lds + F.wave * 16384);
    const int lane = F.lane;
    int it = 0;
    for (int r0 = 0; r0 < NB * 8 * SEQ; r0 += F.NGW, ++it) {
        const int r = r0 + ((it & 1) ? (F.NGW - 1 - F.gw) : F.gw);
        if (r >= NB * 8 * SEQ) continue;
        const int pos = r & (SEQ - 1), h = (r >> 12) & 7, b = r >> 15;
        const size_t m = (size_t)b * SEQ + pos;
        float qf[64];
        { const bf16* qp = Z + m * ZP + Z_FQ + h * 64;
#pragma unroll
            for (int i = 0; i < 8; ++i) { const v4u w = *(const GAS v4u*)(qp + 8 * i); float t[8]; unpack8(w, t);
#pragma unroll
                for (int j = 0; j < 8; ++j) qf[8 * i + j] = t[j]; } }
        const float* cf = CF + (size_t)(b * 8 + h) * SEQ;
        float mx = -INFINITY;
        for (int kk = lane; kk <= pos; kk += 64) { const bf16* kp = Z + ((size_t)b * SEQ + kk) * ZP + Z_FK + h * 64; float dot = 0.f;
#pragma unroll
            for (int i = 0; i < 8; ++i) { const v4u w = *(const GAS v4u*)(kp + 8 * i); float t[8]; unpack8(w, t);
#pragma unroll
                for (int j = 0; j < 8; ++j) dot += qf[8 * i + j] * t[j]; }
            const float s = dot - cf[kk]; sc[kk] = s; mx = fmaxf(mx, s); }
        mx = wave_max(mx);
        float sum = 0.f;
        for (int kk = lane; kk <= pos; kk += 64) { const float p = exp2f(sc[kk] - mx); sc[kk] = p; sum += p; }
        sum = wave_sum(sum);
        LDS_WAIT(); asm volatile("" ::: "memory");
        const bf16* vp = Z + (size_t)b * SEQ * ZP + Z_FV + h * 64 + lane;
        float o0 = 0.f, o1 = 0.f, o2 = 0.f, o3 = 0.f; int kk = 0;
        for (; kk + 3 <= pos; kk += 4) { o0 += sc[kk] * bf2f(vp[(size_t)kk * ZP]); o1 += sc[kk + 1] * bf2f(vp[(size_t)(kk + 1) * ZP]); o2 += sc[kk + 2] * bf2f(vp[(size_t)(kk + 2) * ZP]); o3 += sc[kk + 3] * bf2f(vp[(size_t)(kk + 3) * ZP]); }
        for (; kk <= pos; ++kk) o0 += sc[kk] * bf2f(vp[(size_t)kk * ZP]);
        Z[m * ZP + Z_FQ + h * 64 + lane] = (bf16)f2bf(((o0 + o1) + (o2 + o3)) / sum);
        LDS_WAIT(); asm volatile("" ::: "memory");
    }
}

__device__ __forceinline__ unsigned f2key(float s) { const unsigned u = __builtin_bit_cast(unsigned, s + 0.0f); return (u & 0x80000000u) ? ~u : (u | 0x80000000u); }
__device__ __forceinline__ void dsa_naive(const Ctx& F) {
    bf16* Z = (bf16*)(F.ws + WS_Z); const float* ZS = (const float*)(F.ws + WS_ZS);
    const unsigned* ISG = (const unsigned*)(F.ws + WS_ISG);
    const bf16* KD = (const bf16*)(F.ws + WS_KD); const bf16* VD = (const bf16*)(F.ws + WS_VD);
    LAS unsigned* kl = (LAS unsigned*)(F.lds + F.wave * 16384);
    LAS float* iqs = (LAS float*)(F.lds + XTRA_OFF + F.wave * 1536);
    const int lane = F.lane;
    int it = 0;
    for (int r0 = 0; r0 < M; r0 += F.NGW, ++it) {
        const int r = r0 + ((it & 1) ? (F.NGW - 1 - F.gw) : F.gw);
        if (r >= M) continue;
        const int pos = r & (SEQ - 1), b = r >> 12; const size_t m = (size_t)r;
        *(LAS f32x4*)(iqs + 4 * lane) = *(const GAS f32x4*)(ZS + m * ZSP + S_IQ + 4 * lane);
        const unsigned sg = ISG[m];
        LDS_WAIT(); asm volatile("" ::: "memory");
        for (int kk = lane; kk <= pos; kk += 64) { const float* ikp = ZS + ((size_t)b * SEQ + kk) * ZSP + S_IK; float ik[32];
#pragma unroll
            for (int i = 0; i < 8; ++i) { const f32x4 t = *(const GAS f32x4*)(ikp + 4 * i); ik[4 * i] = t.x; ik[4 * i + 1] = t.y; ik[4 * i + 2] = t.z; ik[4 * i + 3] = t.w; }
            float s = 0.f;
#pragma unroll 1
            for (int h = 0; h < 8; ++h) { float dot = 0.f;
#pragma unroll
                for (int dd = 0; dd < 32; ++dd) dot += iqs[h * 32 + dd] * ik[dd];
                dot = fmaxf(dot, 0.f); s += ((sg >> h) & 1u) ? -dot : dot; }
            kl[kk] = f2key(s); }
        LDS_WAIT(); asm volatile("" ::: "memory");
        unsigned key[64];
#pragma unroll
        for (int j = 0; j < 64; ++j) { const int kk = j * 64 + lane; key[j] = (kk <= pos) ? kl[kk] : 0u; }
        LDS_WAIT(); asm volatile("" ::: "memory");
        LAS unsigned* idx = kl; LAS float* pl = (LAS float*)(kl + 256); LAS bf16* qs = (LAS bf16*)(kl + 512);
        *(LAS v4u*)(qs + 8 * lane) = *(const GAS v4u*)(Z + m * ZP + Z_DQ + 8 * lane);
        unsigned T = 0u; int need = 0;
        if (pos + 1 > 256) {
            for (int bit = 31; bit >= 0; --bit) { const unsigned Tt = T | (1u << bit); int cnt = 0;
#pragma unroll
                for (int j = 0; j < 64; ++j) cnt += __builtin_popcountll(__ballot(key[j] >= Tt));
                if (cnt >= 256) T = Tt; }
            int ngt = 0;
#pragma unroll
            for (int j = 0; j < 64; ++j) ngt += __builtin_popcountll(__ballot(key[j] > T));
            need = 256 - ngt;
        }
        int nsel = 0, eqb = 0;
#pragma unroll
        for (int j = 0; j < 64; ++j) { const bool gt = key[j] > T, eq = (key[j] == T) && (T != 0u);
            const unsigned long long em = __ballot(eq); const int er = eqb + __builtin_amdgcn_mbcnt_hi((unsigned)(em >> 32), __builtin_amdgcn_mbcnt_lo((unsigned)em, 0u));
            const bool sel = gt || (eq && er < need); eqb += __builtin_popcountll(em);
            const unsigned long long sm = __ballot(sel); const int sp = nsel + __builtin_amdgcn_mbcnt_hi((unsigned)(sm >> 32), __builtin_amdgcn_mbcnt_lo((unsigned)sm, 0u));
            if (sel) idx[sp] = (unsigned)(j * 64 + lane); nsel += __builtin_popcountll(sm); }
        LDS_WAIT(); asm volatile("" ::: "memory");
        for (int h = 0; h < 8; ++h) {
            float sv[4]; float mx = -INFINITY;
#pragma unroll
            for (int i = 0; i < 4; ++i) { const int e = lane + 64 * i; sv[i] = -INFINITY;
                if (e < nsel) { const bf16* kp = KD + ((size_t)b * SEQ + idx[e]) * 64; float dot = 0.f;
#pragma unroll
                    for (int c = 0; c < 8; ++c) { const v4u w = *(const GAS v4u*)(kp + 8 * c); float t[8]; unpack8(w, t); const v4u qw = *(const LAS v4u*)(qs + h * 64 + 8 * c); float qq[8]; unpack8(qw, qq);
#pragma unroll
                        for (int j = 0; j < 8; ++j) dot += qq[j] * t[j]; }
                    sv[i] = dot; }
                mx = fmaxf(mx, sv[i]); }
            mx = wave_max(mx); float sum = 0.f;
#pragma unroll
            for (int i = 0; i < 4; ++i) { const int e = lane + 64 * i; const float p = (e < nsel) ? exp2f(sv[i] - mx) : 0.f; pl[e] = p; sum += p; }
            sum = wave_sum(sum);
            LDS_WAIT(); asm volatile("" ::: "memory");
            float o0 = 0.f, o1 = 0.f; int e = 0;
            for (; e + 1 < nsel; e += 2) { o0 += pl[e] * bf2f(VD[((size_t)b * SEQ + idx[e]) * 64 + lane]); o1 += pl[e + 1] * bf2f(VD[((size_t)b * SEQ + idx[e + 1]) * 64 + lane]); }
            if (e < nsel) o0 += pl[e] * bf2f(VD[((size_t)b * SEQ + idx[e]) * 64 + lane]);
            Z[m * ZP + Z_DQ + h * 64 + lane] = (bf16)f2bf((o0 + o1) / sum);
            LDS_WAIT(); asm volatile("" ::: "memory");
        }
    }
}
#ifndef PROBE_D
#define PROBE_D 0
#endif

typedef short s16x8 __attribute__((ext_vector_type(8)));
typedef short s16x4 __attribute__((ext_vector_type(4)));
typedef short v4i16_t __attribute__((ext_vector_type(4)));
__device__ __forceinline__ s16x4 tr16(const LAS unsigned char* p) { return __builtin_bit_cast(s16x4, __builtin_amdgcn_ds_read_tr16_b64_v4i16((LAS v4i16_t*)p)); }
__device__ __forceinline__ float key2f(unsigned k) { return __builtin_bit_cast(float, (k & 0x80000000u) ? (k & 0x7fffffffu) : ~k); }

template <int NR> __device__ __forceinline__ int dsa_count_ge(const unsigned (&key)[64], unsigned T) {
    int c = 0;
#pragma unroll
    for (int j = 0; j < NR; ++j) c += __builtin_popcountll(__ballot(key[j] >= T));
    return c;
}
#define DSA_COUNT_GE(T_, out_) do { if (nq == 1) out_ = dsa_count_ge<16>(key, (T_)); else if (nq == 2) out_ = dsa_count_ge<32>(key, (T_)); else if (nq == 3) out_ = dsa_count_ge<48>(key, (T_)); else out_ = dsa_count_ge<64>(key, (T_)); } while (0)
__device__ __forceinline__ void dsa_select(const unsigned (&key)[64], int nvalid, unsigned& T, int& need) {
    const int nq = __builtin_amdgcn_readfirstlane((nvalid + 1023) >> 10);
    T = 0u; need = 0;
    if (nvalid <= 256) return;
    unsigned kmax = 0u;
#pragma unroll
    for (int j = 0; j < 64; ++j) kmax = key[j] > kmax ? key[j] : kmax;
#pragma unroll
    for (int o_ = 0; o_ < 1; ++o_) { unsigned t; t = sxu<1>(kmax); kmax = t > kmax ? t : kmax; t = sxu<2>(kmax); kmax = t > kmax ? t : kmax; t = sxu<4>(kmax); kmax = t > kmax ? t : kmax; t = sxu<8>(kmax); kmax = t > kmax ? t : kmax; t = sxu<16>(kmax); kmax = t > kmax ? t : kmax;
        unsigned a_, b_; swap32(kmax, a_, b_); kmax = a_ > b_ ? a_ : b_; }
    unsigned lo = 1u, hi = kmax + 1u; int hic = 0;
    { const float vm = fabsf(key2f(kmax)) + 1.0f; unsigned l2 = f2key(-vm * 64.0f); int c; DSA_COUNT_GE(l2, c); if (c >= 256) lo = l2; }
    int iter = 0; bool exact = false;
    while (hi - lo > 1u) {
        unsigned mid;
        if (iter < 24 && lo > 1u) { const float mv = 0.5f * key2f(lo) + 0.5f * key2f(hi - 1u); mid = f2key(mv); }
        else mid = lo + ((hi - lo) >> 1);
        if (mid <= lo) mid = lo + 1u; if (mid >= hi) mid = hi - 1u;
        int c; DSA_COUNT_GE(mid, c);
        if (c == 256) { T = mid; exact = true; break; }
        if (c > 256) lo = mid; else { hi = mid; hic = c; }
        ++iter;
    }
    if (exact) need = 256; else { T = lo; need = 256 - hic; }
}

__device__ __forceinline__ void dsa_attend(const bf16* zq, bf16* zo, const bf16* KDb, const bf16* VDb, const LAS unsigned short* idx, int nsel, LAS unsigned char* vst, int lane) {
    const int g = lane >> 4, c = lane & 15;
    s16x8 qf[2];
#pragma unroll
    for (int ks = 0; ks < 2; ++ks) { qf[ks] = (s16x8){0, 0, 0, 0, 0, 0, 0, 0}; if (c < 8) qf[ks] = *(const GAS s16x8*)(zq + c * 64 + 32 * ks + 8 * g); }
    f32x4 acc[16];
    v4u vreg[16];
#pragma unroll
    for (int i = 0; i < 16; ++i) { const int pi = lane + 64 * i, r = pi >> 3, c16 = pi & 7; const int id = (r < nsel) ? (int)idx[r] : 0; vreg[i] = *(const GAS v4u*)(VDb + (size_t)id * 64 + c16 * 8); }
#pragma unroll
    for (int tb = 0; tb < 2; ++tb) {
        s16x8 kf[8][2];
#pragma unroll
        for (int tt = 0; tt < 8; ++tt) { const int e = 16 * (8 * tb + tt) + c; const int id = (e < nsel) ? (int)idx[e] : 0; const bf16* kp = KDb + (size_t)id * 64 + 8 * g;
            kf[tt][0] = *(const GAS s16x8*)kp; kf[tt][1] = *(const GAS s16x8*)(kp + 32); }
#pragma unroll
        for (int tt = 0; tt < 8; ++tt) { f32x4 a = (f32x4){0.f, 0.f, 0.f, 0.f};
            a = __builtin_amdgcn_mfma_f32_16x16x32_bf16(kf[tt][0], qf[0], a, 0, 0, 0); a = __builtin_amdgcn_mfma_f32_16x16x32_bf16(kf[tt][1], qf[1], a, 0, 0, 0); acc[8 * tb + tt] = a; }
    }
    float mx = -INFINITY;
#pragma unroll
    for (int t = 0; t < 16; ++t)
#pragma unroll
        for (int i = 0; i < 4; ++i) { const int e = 16 * t + 4 * g + i; if (nsel < 256 && e >= nsel) acc[t][i] = -INFINITY; mx = fmaxf(mx, acc[t][i]); }
    mx = fmaxf(mx, sx<16>(mx)); mx = half_max(mx);
    float sum = 0.f;
#pragma unroll
    for (int t = 0; t < 16; ++t)
#pragma unroll
        for (int i = 0; i < 4; ++i) { const float p = __builtin_amdgcn_exp2f(acc[t][i] - mx); acc[t][i] = p; sum += p; }
    sum += sx<16>(sum); sum = half_sum(sum);
    const float inv = 1.0f / sum;
    s16x8 pf[8];
#pragma unroll
    for (int s = 0; s < 8; ++s) { v4u w; w.x = pk2(acc[2 * s][0] * inv, acc[2 * s][1] * inv); w.y = pk2(acc[2 * s][2] * inv, acc[2 * s][3] * inv); w.z = pk2(acc[2 * s + 1][0] * inv, acc[2 * s + 1][1] * inv); w.w = pk2(acc[2 * s + 1][2] * inv, acc[2 * s + 1][3] * inv);
        pf[s] = __builtin_bit_cast(s16x8, w); }
    f32x4 o[4];
#pragma unroll
    for (int db = 0; db < 4; ++db) o[db] = (f32x4){0.f, 0.f, 0.f, 0.f};
    const int q = (lane >> 2) & 3, p = lane & 3, swz = 2 * (g & 1) + (q >> 1);
    const LAS unsigned char* rb = vst + (4 * g + q) * 128 + 8 * p;
#pragma unroll
    for (int hh = 0; hh < 2; ++hh) {
        asm volatile("s_waitcnt lgkmcnt(0)" ::: "memory");
#pragma unroll
        for (int i = 0; i < 16; ++i) { const int pi = lane + 64 * i, r = pi >> 3, c16 = pi & 7;
            *(LAS v4u*)(vst + r * 128 + ((((c16 >> 1) ^ ((r >> 1) & 3))) << 5) + ((c16 & 1) << 4)) = vreg[i]; }
        if (hh == 0) {
#pragma unroll
            for (int i = 0; i < 16; ++i) { const int pi = lane + 64 * i, r = pi >> 3, c16 = pi & 7, e = 128 + r; const int id = (e < nsel) ? (int)idx[e] : 0; vreg[i] = *(const GAS v4u*)(VDb + (size_t)id * 64 + c16 * 8); } }
        asm volatile("s_waitcnt lgkmcnt(0)" ::: "memory");
#pragma unroll
        for (int s4 = 0; s4 < 4; ++s4)
#pragma unroll
            for (int db = 0; db < 4; ++db) { const LAS unsigned char* a1 = rb + s4 * 4096 + ((db ^ swz) << 5);
                const s16x4 lo = tr16(a1), hi = tr16(a1 + 2048);
                const s16x8 vf = (s16x8){lo[0], lo[1], lo[2], lo[3], hi[0], hi[1], hi[2], hi[3]};
                o[db] = __builtin_amdgcn_mfma_f32_16x16x32_bf16(pf[4 * hh + s4], vf, o[db], 0, 0, 0); }
    }
    if (g < 2) {
#pragma unroll
        for (int db = 0; db < 4; ++db)
#pragma unroll
            for (int i = 0; i < 4; ++i) zo[(4 * g + i) * 64 + 16 * db + c] = (bf16)f2bf(o[db][i]);
    }
}

__device__ __forceinline__ void dsa_v2(const Ctx& F) {
    bf16* Z = (bf16*)(F.ws + WS_Z); const float* ZS = (const float*)(F.ws + WS_ZS);
    const unsigned* ISG = (const unsigned*)(F.ws + WS_ISG);
    const bf16* KD = (const bf16*)(F.ws + WS_KD); const bf16* VD = (const bf16*)(F.ws + WS_VD);
    LAS unsigned* kl = (LAS unsigned*)(F.lds + F.wave * 16384);
    LAS float* iqs = (LAS float*)(F.lds + XTRA_OFF + F.wave * 1536);
    LAS unsigned short* idx = (LAS unsigned short*)(F.lds + XTRA_OFF + F.wave * 1536 + 1024);
    const int lane = F.lane;
    int it = 0;
    for (int r0 = 0; r0 < M; r0 += F.NGW, ++it) {
        const int r = r0 + ((it & 1) ? (F.NGW - 1 - F.gw) : F.gw);
        if (r >= M) continue;
        const int pos = r & (SEQ - 1), b = r >> 12; const size_t m = (size_t)r;
        *(LAS f32x4*)(iqs + 4 * lane) = *(const GAS f32x4*)(ZS + m * ZSP + S_IQ + 4 * lane);
        const unsigned sg = ISG[m];
        LDS_WAIT(); asm volatile("" ::: "memory");
        for (int kk = lane; kk <= pos; kk += 64) { const float* ikp = ZS + ((size_t)b * SEQ + kk) * ZSP + S_IK; float ik[32];
#pragma unroll
            for (int i = 0; i < 8; ++i) { const f32x4 t = *(const GAS f32x4*)(ikp + 4 * i); ik[4 * i] = t.x; ik[4 * i + 1] = t.y; ik[4 * i + 2] = t.z; ik[4 * i + 3] = t.w; }
            float s = 0.f;
#pragma unroll 1
            for (int h = 0; h < 8; ++h) { float dot = 0.f;
#pragma unroll
                for (int dd = 0; dd < 32; ++dd) dot += iqs[h * 32 + dd] * ik[dd];
                dot = fmaxf(dot, 0.f); s += ((sg >> h) & 1u) ? -dot : dot; }
            kl[kk] = f2key(s); }
        LDS_WAIT(); asm volatile("" ::: "memory");
        unsigned key[64];
#pragma unroll
        for (int j = 0; j < 64; ++j) { const int kk = j * 64 + lane; key[j] = (kk <= pos) ? kl[kk] : 0u; }
        LDS_WAIT(); asm volatile("" ::: "memory");
        unsigned T; int need;
#ifdef DSA_OLDSEL
        T = 0u; need = 0;
        if (pos + 1 > 256) {
            for (int bit = 31; bit >= 0; --bit) { const unsigned Tt = T | (1u << bit); int cnt = 0;
#pragma unroll
                for (int j = 0; j < 64; ++j) cnt += __builtin_popcountll(__ballot(key[j] >= Tt));
                if (cnt >= 256) T = Tt; }
            int ngt = 0;
#pragma unroll
            for (int j = 0; j < 64; ++j) ngt += __builtin_popcountll(__ballot(key[j] > T));
            need = 256 - ngt;
        }
#else
        dsa_select(key, pos + 1, T, need);
#endif
        int nsel = 0, eqb = 0;
#pragma unroll
        for (int j = 0; j < 64; ++j) { const bool gt = key[j] > T, eq = (key[j] == T) && (T != 0u);
            const unsigned long long em = __ballot(eq); const int er = eqb + __builtin_amdgcn_mbcnt_hi((unsigned)(em >> 32), __builtin_amdgcn_mbcnt_lo((unsigned)em, 0u));
            const bool sel = gt || (eq && er < need); eqb += __builtin_popcountll(em);
            const unsigned long long sm = __ballot(sel); const int sp = nsel + __builtin_amdgcn_mbcnt_hi((unsigned)(sm >> 32), __builtin_amdgcn_mbcnt_lo((unsigned)sm, 0u));
            if (sel) idx[sp] = (unsigned short)(j * 64 + lane); nsel += __builtin_popcountll(sm); }
        LDS_WAIT(); asm volatile("" ::: "memory");
        dsa_attend(Z + m * ZP + Z_DQ, Z + m * ZP + Z_DQ, KD + (size_t)b * SEQ * 64, VD + (size_t)b * SEQ * 64, idx, nsel, (LAS unsigned char*)kl, lane);
        LDS_WAIT(); asm volatile("" ::: "memory");
    }
}

template <int NR> __device__ __forceinline__ int dsa_emit_n(const unsigned (&key)[64], unsigned T, int need, LAS unsigned short* idx, int lane) {
    int nsel = 0, eqb = 0;
#pragma unroll
    for (int j = 0; j < NR; ++j) { const bool gt = key[j] > T, eq = (key[j] == T) && (T != 0u);
        const unsigned long long em = __ballot(eq); const int er = eqb + __builtin_amdgcn_mbcnt_hi((unsigned)(em >> 32), __builtin_amdgcn_mbcnt_lo((unsigned)em, 0u));
        const bool sel = gt || (eq && er < need); eqb += __builtin_popcountll(em);
        const unsigned long long sm = __ballot(sel); const int sp = nsel + __builtin_amdgcn_mbcnt_hi((unsigned)(sm >> 32), __builtin_amdgcn_mbcnt_lo((unsigned)sm, 0u));
        if (sel) idx[sp] = (unsigned short)(j * 64 + lane); nsel += __builtin_popcountll(sm); }
    return nsel;
}
__device__ __forceinline__ int dsa_emit(const unsigned (&key)[64], int nvalid, unsigned T, int need, LAS unsigned short* idx, int lane) {
    const int nq = __builtin_amdgcn_readfirstlane((nvalid + 1023) >> 10);
    if (nq == 1) return dsa_emit_n<16>(key, T, need, idx, lane);
    if (nq == 2) return dsa_emit_n<32>(key, T, need, idx, lane);
    if (nq == 3) return dsa_emit_n<48>(key, T, need, idx, lane);
    return dsa_emit_n<64>(key, T, need, idx, lane);
}

#define DSA_CNT8(cnt_, k_, o_, T_) asm volatile( \
    "v_cmp_ge_u32_e64 s[60:61], %1, %9\n\tv_cmp_ge_u32_e64 s[62:63], %2, %9\n\tv_cmp_ge_u32_e64 s[64:65], %3, %9\n\tv_cmp_ge_u32_e64 s[66:67], %4, %9\n\t" \
    "v_cmp_ge_u32_e64 s[68:69], %5, %9\n\tv_cmp_ge_u32_e64 s[70:71], %6, %9\n\tv_cmp_ge_u32_e64 s[72:73], %7, %9\n\tv_cmp_ge_u32_e64 s[74:75], %8, %9\n\t" \
    "v_addc_co_u32_e64 %0, s[76:77], 0, %0, s[60:61]\n\tv_addc_co_u32_e64 %0, s[76:77], 0, %0, s[62:63]\n\tv_addc_co_u32_e64 %0, s[76:77], 0, %0, s[64:65]\n\tv_addc_co_u32_e64 %0, s[76:77], 0, %0, s[66:67]\n\t" \
    "v_addc_co_u32_e64 %0, s[76:77], 0, %0, s[68:69]\n\tv_addc_co_u32_e64 %0, s[76:77], 0, %0, s[70:71]\n\tv_addc_co_u32_e64 %0, s[76:77], 0, %0, s[72:73]\n\tv_addc_co_u32_e64 %0, s[76:77], 0, %0, s[74:75]" \
    : "+v"(cnt_) : "v"(k_[o_]), "v"(k_[o_ + 1]), "v"(k_[o_ + 2]), "v"(k_[o_ + 3]), "v"(k_[o_ + 4]), "v"(k_[o_ + 5]), "v"(k_[o_ + 6]), "v"(k_[o_ + 7]), "s"(T_) \
    : "s60", "s61", "s62", "s63", "s64", "s65", "s66", "s67", "s68", "s69", "s70", "s71", "s72", "s73", "s74", "s75", "s76", "s77")
template <int NR> __device__ __forceinline__ int dsa_lane_count(const unsigned (&key)[64], unsigned T) {
    int c = 0; const unsigned Ts = (unsigned)__builtin_amdgcn_readfirstlane((int)T);
#pragma unroll
    for (int j = 0; j < NR; j += 8) DSA_CNT8(c, key, j, Ts);
    return c;
}
#define DSA_LCOUNT(T_, lc_) do { if (nq == 1) lc_ = dsa_lane_count<16>(key, (T_)); else if (nq == 2) lc_ = dsa_lane_count<32>(key, (T_)); else if (nq == 3) lc_ = dsa_lane_count<48>(key, (T_)); else lc_ = dsa_lane_count<64>(key, (T_)); } while (0)
template <int NR> __device__ __forceinline__ void dsa_write_ge(const unsigned (&key)[64], unsigned T, int off, LAS unsigned short* idx, int lane) {
    const int dummy = 256 + lane;
#pragma unroll
    for (int j = 0; j < NR; ++j) { const bool s = key[j] >= T; idx[s ? off : dummy] = (unsigned short)(j * 64 + lane); off += s ? 1 : 0; }
}
__device__ __forceinline__ int dsa_select2(const unsigned (&key)[64], int nvalid, float s1, float s2, LAS unsigned short* idx, int lane) {
    const int nq = __builtin_amdgcn_readfirstlane((nvalid + 1023) >> 10);
    unsigned T = 1u; int lc = 0; bool exact = true;
    if (nvalid > 256) {
        const float n = (float)nvalid, mean = s1 / n, sd = sqrtf(fmaxf(s2 / n - mean * mean, 1e-30f));
        const float pfrac = 256.0f / n, pt = fminf(pfrac, 1.0f - pfrac);
        const float tt = sqrtf(-2.0f * __logf(fmaxf(pt, 1e-6f)));
        float zn = (0.010328f * tt + 0.802853f) * tt + 2.515517f; asm volatile("" : "+v"(zn));
        float zd = ((0.001308f * tt + 0.189269f) * tt + 1.432788f) * tt + 1.0f; asm volatile("" : "+v"(zd));
        float z = tt - zn / zd;
        if (pfrac > 0.5f) z = -z;
        const float dens = n * __expf(-0.5f * z * z) * 0.3989423f / sd;
        unsigned lo = 1u, hi = 0xffffffffu; int clo = nvalid, chi = 0;
        bool lop = false, hip = false; float lastv = mean + z * sd, lastc = 256.0f, grow = 1.3f;
        exact = false; int same = 0, last = 0;
        for (int it = 0; hi - lo > 1u; ++it) {
            unsigned mid;
            if (it == 0) mid = f2key(lastv);
            else if (!(lop && hip)) { lastv = lastv + grow * (lastc - 256.0f) / dens; grow *= 2.0f; mid = f2key(lastv); }
            else if (it < 24 && same < 2) { const float vlo = key2f(lo), vhi = key2f(hi - 1u); mid = f2key(vlo + (vhi - vlo) * (((float)(clo - 256) + 0.5f) / (float)(clo - chi))); }
            else if (it < 48) { mid = f2key(0.5f * key2f(lo) + 0.5f * key2f(hi - 1u)); same = 0; }
            else mid = lo + ((hi - lo) >> 1);
            if (!(mid > lo)) mid = lo + 1u; if (!(mid < hi)) mid = hi - 1u;
            DSA_LCOUNT(mid, lc); const int c = wave_isum(lc); lastc = (float)c; lastv = key2f(mid);
            if (c == 256) { T = mid; exact = true; break; }
            if (c > 256) { lo = mid; clo = c; lop = true; same = (last > 0) ? same + 1 : 0; last = 1; } else { hi = mid; chi = c; hip = true; same = (last < 0) ? same + 1 : 0; last = -1; }
        }
        if (!exact) {
            const int nsel = dsa_emit(key, nvalid, lo, 256 - chi, idx, lane);
            return nsel;
        }
    } else { DSA_LCOUNT(1u, lc); }
    int incl = lc;
#pragma unroll
    for (int o = 1; o < 64; o <<= 1) { const int t = __builtin_amdgcn_ds_bpermute(((lane - o) & 63) << 2, incl); if (lane >= o) incl += t; }
    const int total = __builtin_amdgcn_readlane(incl, 63);
    if (nq == 1) dsa_write_ge<16>(key, T, incl - lc, idx, lane); else if (nq == 2) dsa_write_ge<32>(key, T, incl - lc, idx, lane); else if (nq == 3) dsa_write_ge<48>(key, T, incl - lc, idx, lane); else dsa_write_ge<64>(key, T, incl - lc, idx, lane);
    return total;
}

constexpr int DSA_ROWF = 4100;
__device__ __forceinline__ void dsa_v3(const Ctx& F, int out_col = Z_DQ) {
    bf16* Z = (bf16*)(F.ws + WS_Z);
    const unsigned* ISG = (const unsigned*)(F.ws + WS_ISG);
    const bf16* KD = (const bf16*)(F.ws + WS_KD); const bf16* VD = (const bf16*)(F.ws + WS_VD);
    const bf16* IQB = (const bf16*)(F.ws + WS_IQB); const bf16* IKB = (const bf16*)(F.ws + WS_IKB);
    LAS unsigned* img = (LAS unsigned*)(F.lds);
    LAS unsigned short* idxw = (LAS unsigned short*)(F.lds + XTRA_OFF + F.wave * 1536);
    const int w = F.wave;
    const int v = (int)blockIdx.x;
    if (v < 256)
    for (int ui = 0; ui < 8; ++ui) {
        int lane_ = F.lane; asm volatile("" : "+v"(lane_)); const int lane = lane_, g = lane >> 4, c = lane & 15;
        const int b = v >> 6, k = v & 63; const int pb = 128 * (ui >> 1) + ((ui & 1) ? 127 - k : k);
        const int q0 = pb * 8, kend = q0 + 8, ntile = (kend + 15) >> 4;
        const size_t mb = (size_t)b * SEQ;
#if PROBE_D == 1
        for (int rp_ = 0; rp_ < 2; ++rp_)
#endif
        { s16x8 iqf[4]; float sgn[4]; s16x8 iqc;
          { const int qi = c & 7, hs = c >> 3; const int qq = q0 + qi; const bf16* qp = IQB + (mb + qq) * 256 + 8 * g; const unsigned sg = ISG[mb + qq];
            float cs[8];
#pragma unroll
            for (int e = 0; e < 8; ++e) cs[e] = 0.f;
#pragma unroll
            for (int j = 0; j < 4; ++j) { const int h = 2 * j + hs; iqf[j] = *(const GAS s16x8*)(qp + h * 32); sgn[j] = ((sg >> h) & 1u) ? -1.0f : 1.0f;
                float t8[8]; unpack8(__builtin_bit_cast(v4u, iqf[j]), t8);
#pragma unroll
                for (int e = 0; e < 8; ++e) cs[e] += sgn[j] * t8[e]; }
            iqc = __builtin_bit_cast(s16x8, pack8(cs)); }
          const bf16* ikp = IKB + (mb + c) * 32 + 8 * g;
          float st1 = 0.f, st2 = 0.f;
          s16x8 cur[4], nxt[4];
#pragma unroll
          for (int i = 0; i < 4; ++i) { const int t = w + 8 * i; cur[i] = *(const GAS s16x8*)(ikp + (size_t)512 * (t < ntile ? t : 0)); }
          for (int t0 = w; t0 < ntile; t0 += 32) {
#pragma unroll
            for (int i = 0; i < 4; ++i) { const int t = t0 + 32 + 8 * i; nxt[i] = *(const GAS s16x8*)(ikp + (size_t)512 * (t < ntile ? t : 0)); }
#pragma unroll
            for (int i = 0; i < 4; ++i) { const int t = t0 + 8 * i;
              if (t < ntile) {
                f32x4 sc = __builtin_amdgcn_mfma_f32_16x16x32_bf16(cur[i], iqc, (f32x4){0.f, 0.f, 0.f, 0.f}, 0, 0, 0);
#pragma unroll
                for (int h = 0; h < 4; ++h) { const f32x4 x = __builtin_amdgcn_mfma_f32_16x16x32_bf16(cur[i], iqf[h], (f32x4){0.f, 0.f, 0.f, 0.f}, 0, 0, 0);
#pragma unroll
                    for (int r = 0; r < 4; ++r) sc[r] = __builtin_fmaf(sgn[h], __builtin_fabsf(x[r]), sc[r]); }
#pragma unroll
                for (int r = 0; r < 4; ++r) sc[r] += sx<8>(sc[r]);
                v4u kk; kk.x = f2key(sc[0]); kk.y = f2key(sc[1]); kk.z = f2key(sc[2]); kk.w = f2key(sc[3]);
                if (16 * t + 15 <= q0) {
                    st1 += (sc[0] + sc[1]) + (sc[2] + sc[3]); st2 += (sc[0] * sc[0] + sc[1] * sc[1]) + (sc[2] * sc[2] + sc[3] * sc[3]);
                } else { const int kb = 16 * t + 4 * g, qa = q0 + (c & 7);
                    if (kb + 0 > qa) { kk.x = 0u; sc[0] = 0.f; } if (kb + 1 > qa) { kk.y = 0u; sc[1] = 0.f; } if (kb + 2 > qa) { kk.z = 0u; sc[2] = 0.f; } if (kb + 3 > qa) { kk.w = 0u; sc[3] = 0.f; }
                    st1 += (sc[0] + sc[1]) + (sc[2] + sc[3]); st2 += (sc[0] * sc[0] + sc[1] * sc[1]) + (sc[2] * sc[2] + sc[3] * sc[3]); }
                if (c < 8) *(LAS v4u*)(img + c * DSA_ROWF + 16 * t + 4 * g) = kk; } }
#pragma unroll
            for (int i = 0; i < 4; ++i) cur[i] = nxt[i];
          }
          st1 += sx<16>(st1); st2 += sx<16>(st2); st1 = half_sum(st1); st2 = half_sum(st2);
          if (g == 0 && c < 8) *(LAS f32x2*)(F.lds + XTRA_OFF + w * 1536 + 640 + c * 8) = (f32x2){st1, st2}; }
        __syncthreads();
        const int pos = q0 + w; unsigned key[64];
#pragma unroll
        for (int j = 0; j < 64; ++j) { const int kidx = 64 * j + lane; const unsigned a = img[w * DSA_ROWF + kidx]; key[j] = (kidx <= pos) ? a : 0u; }
        unsigned T; int need; int nsel;
        float rs1 = 0.f, rs2 = 0.f;
#pragma unroll
        for (int ww = 0; ww < 8; ++ww) { const f32x2 t = *(const LAS f32x2*)(F.lds + XTRA_OFF + ww * 1536 + 640 + w * 8); rs1 += t.x; rs2 += t.y; }
        { nsel = dsa_select2(key, pos + 1, rs1, rs2, idxw, lane); (void)T; (void)need; }
        __syncthreads();
#if PROBE_D == 3
        { const size_t m = mb + pos; dsa_attend(Z + m * ZP + Z_DQ, Z + m * ZP + Z_RG, KD + mb * 64, VD + mb * 64, idxw, nsel, F.lds + w * 16384, lane); }
#endif
        { const size_t m = mb + pos; dsa_attend(Z + m * ZP + Z_DQ, Z + m * ZP + out_col, KD + mb * 64, VD + mb * 64, idxw, nsel, F.lds + w * 16384, lane); }
        __syncthreads();
    }
}

__device__ __forceinline__ void ret_rope_frag(const bf16* row, const f32x2* cs, float scale, int g, s16x8 (&f)[2]) {
    const u32x2 a0 = *(const GAS u32x2*)(row + 4 * g), a1 = *(const GAS u32x2*)(row + 16 + 4 * g), b0 = *(const GAS u32x2*)(row + 32 + 4 * g), b1 = *(const GAS u32x2*)(row + 48 + 4 * g);
    const float x1[8] = {bflo(a0.x), bfhi(a0.x), bflo(a0.y), bfhi(a0.y), bflo(a1.x), bfhi(a1.x), bflo(a1.y), bfhi(a1.y)};
    const float x2[8] = {bflo(b0.x), bfhi(b0.x), bflo(b0.y), bfhi(b0.y), bflo(b1.x), bfhi(b1.x), bflo(b1.y), bfhi(b1.y)};
    float o1[8], o2[8];
#pragma unroll
    for (int j = 0; j < 8; ++j) { const f32x2 t = cs[(j < 4 ? 4 * g + j : 16 + 4 * g + (j - 4))]; o1[j] = (x1[j] * t.x - x2[j] * t.y) * scale; o2[j] = (x2[j] * t.x + x1[j] * t.y) * scale; }
    f[0] = __builtin_bit_cast(s16x8, pack8(o1)); f[1] = __builtin_bit_cast(s16x8, pack8(o2));
}
__device__ __forceinline__ s16x8 ret_bfrag(const LAS unsigned char* img, int row0, int eb, int g, int q, int p) {
    const int r1 = row0 + 4 * g + q;
    const LAS unsigned char* a1 = img + r1 * 256 + ((eb ^ (r1 & 7)) << 5) + 8 * p;
    const LAS unsigned char* a2 = img + (r1 + 16) * 256 + ((eb ^ ((r1 + 16) & 7)) << 5) + 8 * p;
    const s16x4 lo = tr16(a1), hi = tr16(a2);
    return (s16x8){lo[0], lo[1], lo[2], lo[3], hi[0], hi[1], hi[2], hi[3]};
}

__device__ __forceinline__ void ret_state_mfma(const Ctx& F) {
    const bf16* Z = (const bf16*)(F.ws + WS_Z); float* RS = (float*)(F.ws + WS_HDN);
    const f32x2* R64 = (const f32x2*)(F.ws + WS_ROPE64);
    LAS unsigned char* Kimg = F.lds; LAS unsigned char* Vimg = F.lds + 16384;
    const int lane = F.lane, g = lane >> 4, c = lane & 15, q = (lane >> 2) & 3, p = lane & 3;
    for (int u = blockIdx.x; u < NB * 32 * 4; u += F.G) {
        const int h = u & 3, ch = (u >> 2) & 31, b = u >> 7; const float l2g = ret_l2g(h);
        const bf16* base = Z + ((size_t)b * SEQ + ch * 128) * ZP;
        __syncthreads();
        for (int t = F.tid; t < 2048; t += 512) { const int r = t >> 4, c16 = t & 15;
            *(LAS v4u*)(Vimg + r * 256 + (((c16 >> 1) ^ (r & 7)) << 5) + ((c16 & 1) << 4)) = *(const GAS v4u*)(base + (size_t)r * ZP + Z_RV + h * 128 + c16 * 8); }
        for (int t = F.tid; t < 1024; t += 512) { const int j = t >> 3, dg = t & 7; const bf16* row = base + (size_t)j * ZP + Z_RK + h * 64;
            const u32x2 a = *(const GAS u32x2*)(row + 4 * dg), bb = *(const GAS u32x2*)(row + 32 + 4 * dg);
            const float x1[4] = {bflo(a.x), bfhi(a.x), bflo(a.y), bfhi(a.y)}, x2[4] = {bflo(bb.x), bfhi(bb.x), bflo(bb.y), bfhi(bb.y)};
            const f32x2* cs = R64 + (ch * 128 + j) * 32 + 4 * dg; const float sc = exp2f((float)(127 - j) * l2g);
            float o1[4], o2[4];
#pragma unroll
            for (int e = 0; e < 4; ++e) { const f32x2 tt = cs[e]; o1[e] = (x1[e] * tt.x - x2[e] * tt.y) * sc; o2[e] = (x2[e] * tt.x + x1[e] * tt.y) * sc; }
            u32x2 w1, w2; w1.x = pk2(o1[0], o1[1]); w1.y = pk2(o1[2], o1[3]); w2.x = pk2(o2[0], o2[1]); w2.y = pk2(o2[2], o2[3]);
            const int sw = (j >> 1) & 3; const int d1 = 4 * dg, d2 = 32 + 4 * dg;
            *(LAS u32x2*)(Kimg + j * 128 + ((((2 * d1) >> 5) ^ sw) << 5) + ((2 * d1) & 31)) = w1;
            *(LAS u32x2*)(Kimg + j * 128 + ((((2 * d2) >> 5) ^ sw) << 5) + ((2 * d2) & 31)) = w2; }
        __syncthreads();
        f32x4 acc[4];
#pragma unroll
        for (int db = 0; db < 4; ++db) acc[db] = (f32x4){0.f, 0.f, 0.f, 0.f};
#pragma unroll
        for (int s = 0; s < 4; ++s) {
            const s16x8 vb = ret_bfrag(Vimg, 32 * s, F.wave, g, q, p);
            const int r1 = 32 * s + 4 * g + q, sw = (r1 >> 1) & 3;
#pragma unroll
            for (int db = 0; db < 4; ++db) { const LAS unsigned char* a1 = Kimg + r1 * 128 + ((db ^ sw) << 5) + 8 * p;
                const s16x4 lo = tr16(a1), hi = tr16(a1 + 2048);
                const s16x8 ka = (s16x8){lo[0], lo[1], lo[2], lo[3], hi[0], hi[1], hi[2], hi[3]};
                acc[db] = __builtin_amdgcn_mfma_f32_16x16x32_bf16(ka, vb, acc[db], 0, 0, 0); }
        }
        float* o = RS + (size_t)u * 8192 + 16 * F.wave + c;
#pragma unroll
        for (int db = 0; db < 4; ++db)
#pragma unroll
            for (int r = 0; r < 4; ++r) o[(16 * db + 4 * g + r) * 128] = acc[db][r];
    }
    __syncthreads();
}

__device__ __forceinline__ void ret_scan(const Ctx& F) {
    const float* RS = (const float*)(F.ws + WS_HDN); float* SC = (float*)(F.ws + WS_HDN + 16 * MiB);
    for (int t = blockIdx.x * 512 + F.tid; t < NB * 4 * 8192; t += F.G * 512) {
        const int el = t & 8191, h = (t >> 13) & 3, b = t >> 15; const float wch = exp2f(128.f * ret_l2g(h)); float s = 0.f;
        float L[32];
#pragma unroll
        for (int ch = 0; ch < 32; ++ch) L[ch] = RS[(size_t)(((b * 32 + ch) * 4 + h)) * 8192 + el];
#pragma unroll
        for (int ch = 0; ch < 32; ++ch) { SC[(size_t)(((b * 32 + ch) * 4 + h)) * 8192 + el] = s; s = wch * s + L[ch]; }
    }
}

__device__ __forceinline__ void ret_out_mfma(const Ctx& F, const float* gn, bool dummy_out = false) {
    bf16* Z = (bf16*)(F.ws + WS_Z); const float* SC = (const float*)(F.ws + WS_HDN + 16 * MiB);
    const f32x2* R64 = (const f32x2*)(F.ws + WS_ROPE64);
    LAS unsigned char* Vimg = F.lds; LAS unsigned char* Simg = F.lds + 32768;
    const int lane = F.lane, g = lane >> 4, c = lane & 15, q = (lane >> 2) & 3, p = lane & 3, w = F.wave;
    for (int u = blockIdx.x; u < NB * 32 * 4; u += F.G) {
        const int h = u & 3, ch = (u >> 2) & 31, b = u >> 7; const float l2g = ret_l2g(h); const float gam = exp2f(l2g);
        bf16* base = Z + ((size_t)b * SEQ + ch * 128) * ZP;
        __syncthreads();
        for (int t = F.tid; t < 2048; t += 512) { const int r = t >> 4, c16 = t & 15;
            *(LAS v4u*)(Vimg + r * 256 + (((c16 >> 1) ^ (r & 7)) << 5) + ((c16 & 1) << 4)) = *(const GAS v4u*)(base + (size_t)r * ZP + Z_RV + h * 128 + c16 * 8); }
        for (int t = F.tid; t < 1024; t += 512) { const int r = t >> 4, c16 = t & 15; const float* sp = SC + (size_t)u * 8192 + r * 128 + c16 * 8;
            const f32x4 s0 = *(const GAS f32x4*)sp, s1 = *(const GAS f32x4*)(sp + 4);
            v4u wv; wv.x = pk2(s0.x * gam, s0.y * gam); wv.y = pk2(s0.z * gam, s0.w * gam); wv.z = pk2(s1.x * gam, s1.y * gam); wv.w = pk2(s1.z * gam, s1.w * gam);
            *(LAS v4u*)(Simg + r * 256 + (((c16 >> 1) ^ (r & 7)) << 5) + ((c16 & 1) << 4)) = wv; }
        const int i = 16 * w + c; s16x8 qf[2];
        float sc8 = 0.125f; asm volatile("" : "+v"(sc8));
        ret_rope_frag(base + (size_t)i * ZP + Z_RQ + h * 64, R64 + (ch * 128 + i) * 32, sc8 * exp2f((float)i * l2g), g, qf);
        f32x4 acc[8];
#pragma unroll
        for (int t = 0; t < 8; ++t) { acc[t] = (f32x4){0.f, 0.f, 0.f, 0.f};
            if (t <= w) { const int j = 16 * t + c; s16x8 kf[2];
                ret_rope_frag(base + (size_t)j * ZP + Z_RK + h * 64, R64 + (ch * 128 + j) * 32, exp2f(-(float)j * l2g), g, kf);
                acc[t] = __builtin_amdgcn_mfma_f32_16x16x32_bf16(kf[0], qf[0], acc[t], 0, 0, 0); acc[t] = __builtin_amdgcn_mfma_f32_16x16x32_bf16(kf[1], qf[1], acc[t], 0, 0, 0);
                if (t == w) {
#pragma unroll
                    for (int r = 0; r < 4; ++r) if (4 * g + r > c) acc[t][r] = 0.f; } } }
        s16x8 pf[4];
#pragma unroll
        for (int s = 0; s < 4; ++s) { v4u wv; wv.x = pk2(acc[2 * s][0], acc[2 * s][1]); wv.y = pk2(acc[2 * s][2], acc[2 * s][3]); wv.z = pk2(acc[2 * s + 1][0], acc[2 * s + 1][1]); wv.w = pk2(acc[2 * s + 1][2], acc[2 * s + 1][3]);
            pf[s] = __builtin_bit_cast(s16x8, wv); }
        __syncthreads();
        f32x4 o[8];
#pragma unroll
        for (int eb = 0; eb < 8; ++eb) o[eb] = (f32x4){0.f, 0.f, 0.f, 0.f};
#pragma unroll
        for (int s = 0; s < 4; ++s) if (2 * s <= w) {
#pragma unroll
            for (int eb = 0; eb < 8; ++eb) o[eb] = __builtin_amdgcn_mfma_f32_16x16x32_bf16(pf[s], ret_bfrag(Vimg, 32 * s, eb, g, q, p), o[eb], 0, 0, 0); }
#pragma unroll
        for (int ks = 0; ks < 2; ++ks)
#pragma unroll
            for (int eb = 0; eb < 8; ++eb) o[eb] = __builtin_amdgcn_mfma_f32_16x16x32_bf16(qf[ks], ret_bfrag(Simg, 32 * ks, eb, g, q, p), o[eb], 0, 0, 0);
        float rs[4];
#pragma unroll
        for (int r = 0; r < 4; ++r) { float ss = 0.f;
#pragma unroll
            for (int eb = 0; eb < 8; ++eb) ss += o[eb][r] * o[eb][r];
            ss += sx<1>(ss); ss += sx<2>(ss); ss += sx<4>(ss); ss += sx<8>(ss);
            rs[r] = 1.0f / sqrtf(ss * (1.f / 128) + NORM_EPS); }
#pragma unroll
        for (int r = 0; r < 4; ++r) { bf16* zr = base + (size_t)(16 * w + 4 * g + r) * ZP; bf16* zw = dummy_out ? (bf16*)(F.ws + WS_ZS) + ((size_t)b * SEQ + ch * 128 + 16 * w + 4 * g + r) * 1024 - Z_RV : zr;
#pragma unroll
            for (int eb = 0; eb < 8; ++eb) { const int e = 16 * eb + c; const float rg = bf2f(zr[Z_RG + h * 128 + e]);
                zw[Z_RV + h * 128 + e] = (bf16)f2bf(o[eb][r] * rs[r] * gn[h * 128 + e] * rg * sigmoid_f(rg)); } }
    }
    __syncthreads();
}

__device__ __forceinline__ void fscan_phase(const Ctx& F) {
    const float* LF = (const float*)(F.ws + WS_LF); float* CF = (float*)(F.ws + WS_CF);
    if (F.gw < 32) {
        const int b = F.gw >> 3, h = F.gw & 7; const float* lp = LF + ((size_t)b * SEQ + F.lane * 64) * 8 + h; float s = 0.f;
        for (int i = 0; i < 64; ++i) s += lp[i * 8];
        float incl = s;
#pragma unroll
        for (int o = 1; o < 64; o <<= 1) { const float t = __builtin_bit_cast(float, __builtin_amdgcn_ds_bpermute(((F.lane - o) & 63) << 2, __builtin_bit_cast(int, incl))); if (F.lane >= o) incl += t; }
        float run = incl - s; float* cp = CF + (size_t)F.gw * SEQ + F.lane * 64;
        for (int i = 0; i < 64; ++i) { run += lp[i * 8]; cp[i] = run; }
    }
}
#include <hip/hip_bf16.h>
#include <cmath>
namespace attn_body {
using bf16=__hip_bfloat16;
using bf16x8=__attribute__((ext_vector_type(8)))short;
using s16x4=__attribute__((ext_vector_type(4)))short;
using f32x16=__attribute__((ext_vector_type(16)))float;
using u32x4=__attribute__((ext_vector_type(4)))unsigned;
constexpr int BATCH=4,NHEAD=8,SEQ=4096,D=64,DM=6656;
constexpr int NW=8,QBLK=32,QB=QBLK*NW,KVBLK=64,NQB=SEQ/QB;
constexpr int ATTN_PITCH=DM, ATTN_UNIT_ROWS=QB;
__device__ __forceinline__ int crow(int r,int hi){return (r&3)+8*(r>>2)+4*hi;}
#define SBAR() __builtin_amdgcn_sched_barrier(0)
__device__ __forceinline__ void cmask(f32x16&p0,f32x16&p1,int jb,int qrel,int hi){
  const float NEG=-INFINITY; int kb=64*jb+4*hi;
  #pragma unroll
  for(int r=0;r<16;++r){int kv=kb+(r&3)+8*(r>>2); if(kv>qrel)p0[r]=NEG; if(kv+32>qrel)p1[r]=NEG;}
}

constexpr int NSLOT=3, SLOTB=8192;
constexpr int LDS_K=0, LDS_V=NSLOT*SLOTB, LDS_WS=2*NSLOT*SLOTB, LDS_OST=LDS_WS+NW*64*4, LDS_NC=LDS_OST+NW*4096, LDS_BYTES=LDS_NC+SEQ*4;
constexpr float C2=0.125f*1.4426950408889634f;
__device__ __forceinline__ void glds16(const void*gsrc,unsigned lds_dst){unsigned keep;
  asm volatile("s_mov_b32 %0, m0\n\ts_mov_b32 m0, %2\n\ts_nop 0\n\tglobal_load_lds_dwordx4 %1, off\n\ts_mov_b32 m0, %0":"=&s"(keep):"v"(gsrc),"s"(lds_dst):"memory");}
__device__ __forceinline__ float max3f(float a,float b,float c){float r;asm("v_max3_f32 %0, %1, %2, %3":"=v"(r):"v"(a),"v"(b),"v"(c));return r;}
__device__ __forceinline__ float max2f(float a,float b){float r;asm("v_max_f32_e32 %0, %1, %2":"=v"(r):"v"(a),"v"(b));return r;}
__device__ __forceinline__ float fadd_s(float a,float b){float r;asm("v_add_f32_e32 %0, %1, %2":"=v"(r):"v"(a),"v"(b));return r;}
__device__ __forceinline__ float fsub_s(float a,float b){float r;asm("v_sub_f32_e32 %0, %1, %2":"=v"(r):"v"(a),"v"(b));return r;}
typedef float f32x4_t __attribute__((ext_vector_type(4))); typedef float f32x2_t __attribute__((ext_vector_type(2))); typedef __bf16 bf16x2_t __attribute__((ext_vector_type(2)));
__device__ __forceinline__ unsigned cvtpk_s(float lo,float hi){f32x2_t v={lo,hi};bf16x2_t b=__builtin_convertvector(v,bf16x2_t);return __builtin_bit_cast(unsigned,b);}
#define WAIT_BAR(N) asm volatile("s_waitcnt vmcnt(" #N ") lgkmcnt(0)\n\ts_barrier":::"memory")

__device__ __forceinline__ void qkt(f32x16&p0,f32x16&p1,const char*Kslot,const bf16x8*qr,const f32x16&negm,int r32,int hi){
  const char*kb=Kslot+hi*1024+r32*16;
  #pragma unroll
  for(int d0=0;d0<4;++d0){
    const bf16x8 b0=*reinterpret_cast<const bf16x8*>(kb+d0*2048);
    const bf16x8 b1=*reinterpret_cast<const bf16x8*>(kb+d0*2048+512);
    if(d0==0){p0=__builtin_amdgcn_mfma_f32_32x32x16_bf16(b0,qr[0],negm,0,0,0);p1=__builtin_amdgcn_mfma_f32_32x32x16_bf16(b1,qr[0],negm,0,0,0);}
    else{p0=__builtin_amdgcn_mfma_f32_32x32x16_bf16(b0,qr[d0],p0,0,0,0);p1=__builtin_amdgcn_mfma_f32_32x32x16_bf16(b1,qr[d0],p1,0,0,0);}}
}
typedef __attribute__((address_space(3))) const char* lds_cptr;
typedef short v4i16_t __attribute__((ext_vector_type(4)));
__device__ __forceinline__ void kload8(bf16x8*kf,lds_cptr kp){
  kf[0]=*(const __attribute__((address_space(3))) bf16x8*)(kp);      kf[1]=*(const __attribute__((address_space(3))) bf16x8*)(kp+512);
  kf[2]=*(const __attribute__((address_space(3))) bf16x8*)(kp+2048); kf[3]=*(const __attribute__((address_space(3))) bf16x8*)(kp+2560);
  kf[4]=*(const __attribute__((address_space(3))) bf16x8*)(kp+4096); kf[5]=*(const __attribute__((address_space(3))) bf16x8*)(kp+4608);
  kf[6]=*(const __attribute__((address_space(3))) bf16x8*)(kp+6144); kf[7]=*(const __attribute__((address_space(3))) bf16x8*)(kp+6656);
}
__device__ __forceinline__ void kload2(bf16x8*kf,lds_cptr kp,int j){ kf[2*j]=*(const __attribute__((address_space(3))) bf16x8*)(kp+j*2048); kf[2*j+1]=*(const __attribute__((address_space(3))) bf16x8*)(kp+j*2048+512); }
__device__ __forceinline__ s16x4 vtr(lds_cptr p){ return __builtin_bit_cast(s16x4,__builtin_amdgcn_ds_read_tr16_b64_v4i16((__attribute__((address_space(3))) v4i16_t*)p)); }
__device__ __forceinline__ float rowmax(const f32x16&p0,const f32x16&p1){
  float a=max3f(p0[0],p0[1],p1[0]),b=max3f(p0[2],p0[3],p1[1]);a=max3f(a,p1[2],p1[3]);
  #pragma unroll
  for(int r=4;r<16;r+=4){a=max3f(a,p0[r],p0[r+1]);b=max3f(b,p0[r+2],p0[r+3]);a=max3f(a,p1[r],p1[r+1]);b=max3f(b,p1[r+2],p1[r+3]);}
  const float m=max2f(a,b);
  auto rr=__builtin_amdgcn_permlane32_swap(__float_as_uint(m),__float_as_uint(m),false,false);
  return max2f(__uint_as_float(rr[0]),__uint_as_float(rr[1]));
}
__device__ __forceinline__ void pv(f32x16*o,int vb,bf16x8 pa0,bf16x8 pa1,bf16x8 pa2,bf16x8 pa3){
  #pragma unroll
  for(int d0=0;d0<2;++d0){s16x4 lo[4],hi[4];
    #pragma unroll
    for(int ks=0;ks<4;++ks){
      asm volatile("ds_read_b64_tr_b16 %0,%1 offset:%c2":"=&v"(lo[ks]):"v"(vb),"i"(d0*4096+ks*1024):"memory");
      asm volatile("ds_read_b64_tr_b16 %0,%1 offset:%c2":"=&v"(hi[ks]):"v"(vb),"i"(d0*4096+ks*1024+512):"memory");}
    asm volatile("s_waitcnt lgkmcnt(0)":::"memory");SBAR();
    #define PK(k) (bf16x8){lo[k][0],lo[k][1],lo[k][2],lo[k][3],hi[k][0],hi[k][1],hi[k][2],hi[k][3]}
    o[d0]=__builtin_amdgcn_mfma_f32_32x32x16_bf16(pa0,PK(0),o[d0],0,0,0);
    o[d0]=__builtin_amdgcn_mfma_f32_32x32x16_bf16(pa1,PK(1),o[d0],0,0,0);
    o[d0]=__builtin_amdgcn_mfma_f32_32x32x16_bf16(pa2,PK(2),o[d0],0,0,0);
    o[d0]=__builtin_amdgcn_mfma_f32_32x32x16_bf16(pa3,PK(3),o[d0],0,0,0);
    #undef PK
  }
}

#ifndef ATTN_STORE16
#define ATTN_STORE16(p,v) (*(u32x4*)(p)=(v))
#endif
template<int THRL> __device__ __forceinline__ void attn_unit(int b,int h,int qb,const bf16*Q,const bf16*__restrict__ K,const bf16*__restrict__ V,bf16*O,const float*CF,float dskip,char*shm,int wave_id){
  int tid_=(wave_id<<6)|lane_id_v(); asm volatile("":"+v"(tid_));
  const int tid=tid_,lane=tid&63,r32=lane&31,hi=lane>>5; const int wid=__builtin_amdgcn_readfirstlane(tid>>6);
  const long rowbase=(long)b*SEQ; const int q0=qb*QB;
  const bf16*Qw=Q+(rowbase+q0+wid*QBLK)*DM+h*D;
  const float*cfp0=CF+(long)(b*NHEAD+h)*SEQ; const int NT0=(q0+QB)/KVBLK;
  int ts; { const float cq=cfp0[q0]; const int il=(lane<NT0)?64*lane+63:q0; const bool keep=(lane<NT0)&&(cfp0[il]<cq+dskip);
    const unsigned long long km=__ballot(keep); int t0=(int)__builtin_ctzll(km|(1ull<<63)); t0&=~1; ts=__builtin_amdgcn_readfirstlane(t0<NT0-4?t0:NT0-4); }
  const bf16*Kh=K+(rowbase+(long)ts*KVBLK)*DM+h*D,*Vh=V+(rowbase+(long)ts*KVBLK)*DM+h*D;
  const unsigned lds0=(unsigned)(uintptr_t)shm;
  float*wsf=(float*)(shm+LDS_WS)+wid*64;
  const bf16*ksrc=Kh+(long)lane*DM+wid*8;
  const bf16*vsrc=Vh+(long)(16*(wid&3)+(lane>>2))*DM+(wid>>2)*32+(lane&3)*8;
  const unsigned kdst=lds0+LDS_K+wid*1024, vdst=lds0+LDS_V+wid*1024;
  #define DMA_K(t,slot) glds16(ksrc+(long)(t)*KVBLK*DM,(unsigned)__builtin_amdgcn_readfirstlane(kdst+(slot)))
  #define DMA_V(t,slot) glds16(vsrc+(long)(t)*KVBLK*DM,(unsigned)__builtin_amdgcn_readfirstlane(vdst+(slot)))
  const char*Kbase=shm+LDS_K; bf16x8 kf[8];
  const lds_cptr shm3=(lds_cptr)shm; const lds_cptr kp0=shm3+LDS_K+hi*1024+r32*16; const lds_cptr vp0=shm3+LDS_V+((lane>>4)&1)*32+(lane&3)*8+(4*hi+((lane&15)>>2))*64;
  const int NT=NT0-ts;
  { const float*cfp=CF+(long)(b*NHEAD+h)*SEQ; float*ncw=(float*)(shm+LDS_NC);
    for(int i=tid+ts*KVBLK;i<q0+QB;i+=NW*64)ncw[i-ts*KVBLK]=-cfp[i]; }
  const lds_cptr ncp=(lds_cptr)shm+LDS_NC+hi*16;
  #define ADDC(P0,P1,t) do{ const lds_cptr np_=ncp+(t)*256; _Pragma("unroll") for(int g_=0;g_<4;++g_){ \
      const f32x4_t a_=*(const __attribute__((address_space(3))) f32x4_t*)(np_+g_*32), b_=*(const __attribute__((address_space(3))) f32x4_t*)(np_+g_*32+128); \
      P0[4*g_]+=a_[0];P0[4*g_+1]+=a_[1];P0[4*g_+2]+=a_[2];P0[4*g_+3]+=a_[3]; P1[4*g_]+=b_[0];P1[4*g_+1]+=b_[1];P1[4*g_+2]+=b_[2];P1[4*g_+3]+=b_[3]; } }while(0)
  DMA_K(0,0);DMA_V(0,0);DMA_K(1,SLOTB);
  bf16x8 qr[4];
  #pragma unroll
  for(int d0=0;d0<4;++d0)qr[d0]=*reinterpret_cast<const bf16x8*>(&Qw[(long)r32*DM+d0*16+hi*8]);
  float mhat=0.f,l_reg=0.f;f32x16 o[2];f32x16 negm; { float zz_; asm volatile("v_mov_b32 %0, 0":"=v"(zz_));
    _Pragma("unroll") for(int r=0;r<16;++r){o[0][r]=zz_;o[1][r]=zz_;negm[r]=zz_;} } asm volatile("":"+v"(negm));
  const int qrel=wid*QBLK+r32;
  #define CMASK(P0,P1,t) do{int jb_=(t)-(NT-4); if(jb_>=0)cmask(P0,P1,jb_,qrel,hi);}while(0)
  bool resc=false;
  #define START(P0,P1) do{ const float rm=rowmax(P0,P1); resc=false; \
    { const float dl=rm; mhat=fadd_s(mhat,dl); \
      _Pragma("unroll") for(int r=0;r<16;++r){P0[r]=fsub_s(P0[r],dl);P1[r]=fsub_s(P1[r],dl);} \
      _Pragma("unroll") for(int r=0;r<16;++r)negm[r]=-mhat; asm volatile("":"+v"(negm)); } \
    _Pragma("unroll") for(int r=0;r<16;++r)P0[r]=__builtin_amdgcn_exp2f(P0[r]); }while(0)
  #define RESC() do{ if(resc){ asm volatile("s_waitcnt lgkmcnt(0)":::"memory"); \
      _Pragma("unroll") for(int d_=0;d_<2;++d_) _Pragma("unroll") for(int r=0;r<16;++r)o[d_][r]*=wsf[crow(r,hi)]; } }while(0)
  f32x16 pA0,pA1,pB0,pB1;
  int sl_prev=0,sl_cur=0,sl_next=SLOTB;
  #define ROT() do{sl_prev=sl_cur;sl_cur=sl_next;sl_next=(sl_next==(NSLOT-1)*SLOTB)?0:sl_next+SLOTB;}while(0)
  DMA_K(2,2*SLOTB);
  WAIT_BAR(3);
  qkt(pA0,pA1,Kbase,qr,negm,r32,hi);asm volatile("s_nop 15\n\ts_nop 7":"+v"(pA0),"+v"(pA1));ADDC(pA0,pA1,0);CMASK(pA0,pA1,0);
  START(pA0,pA1);
  _Pragma("unroll") for(int r=0;r<16;++r)pA1[r]=__builtin_amdgcn_exp2f(pA1[r]);
  WAIT_BAR(0);
  DMA_K(3,0);DMA_V(1,SLOTB);
  ROT();
  kload8(kf,kp0+sl_cur);
  WAIT_BAR(2);
  s16x4 vlo[8],vhi[8]; u32x4 pw0,pw1,pw2,pw3;
  #define PKW(P,B) cvtpk_s(P[B],P[B+1])
  #define PAF(k) __builtin_bit_cast(bf16x8,pw##k)
  #define VFR(i) (bf16x8){vlo[i][0],vlo[i][1],vlo[i][2],vlo[i][3],vhi[i][0],vhi[i][1],vhi[i][2],vhi[i][3]}
  #define PIN(x) asm volatile("":"+v"(x))
  #define MX3(a,b,c) __builtin_fmaxf(__builtin_fmaxf((a),(b)),(c))
  #define GAPA(MF,A0,A1,A2,A3,W0,W1,PW) do{ MF; sacc+=A0; sacc+=A1; sacc+=A2; sacc+=A3; PIN(sacc); W0; W1; PIN(PW); SBAR(); }while(0)
  #define EX(v) __builtin_amdgcn_exp2f(v)
  #define GAPB(MF,X,B) do{ MF; X[B]=EX(X[B]); X[B+1]=EX(X[B+1]); X[B+2]=EX(X[B+2]); X[B+3]=EX(X[B+3]); PIN(X); SBAR(); }while(0)
  #define VRD(i) do{ vlo[i]=vtr(vp_+(((i)>>2)*4096+((i)&3)*1024)); vhi[i]=vtr(vp_+(((i)>>2)*4096+((i)&3)*1024+512)); }while(0)
  #define KRD(G,j) do{ if(G){ kload2(kf,kp0+sl_next,j); SBAR(); } }while(0)
  #define STEP(C0,C1,P0,P1,t,GK,GV,GL) do{ SBAR(); \
    const lds_cptr vp_=vp0+sl_prev; \
    VRD(0); SBAR(); float sacc=(P0[0]+P0[1]); \
    GAPA(C0=__builtin_amdgcn_mfma_f32_32x32x16_bf16(kf[0],qr[0],negm,0,0,0), P0[2],P0[3],P0[4],P0[5],     pw0[0]=PKW(P0,0), pw0[1]=PKW(P0,2), pw0); \
    VRD(4); SBAR(); GAPA(C1=__builtin_amdgcn_mfma_f32_32x32x16_bf16(kf[1],qr[0],negm,0,0,0), P0[6],P0[7],P0[8],P0[9],     pw0[2]=PKW(P0,4), pw0[3]=PKW(P0,6), pw0); \
    VRD(1); SBAR(); GAPA(C0=__builtin_amdgcn_mfma_f32_32x32x16_bf16(kf[2],qr[1],C0,0,0,0),   P0[10],P0[11],P0[12],P0[13], pw1[0]=PKW(P0,8), pw1[1]=PKW(P0,10), pw1); \
    VRD(5); SBAR(); GAPA(C1=__builtin_amdgcn_mfma_f32_32x32x16_bf16(kf[3],qr[1],C1,0,0,0),   P0[14],P0[15],P1[0],P1[1],   pw1[2]=PKW(P0,12),pw1[3]=PKW(P0,14), pw1); \
    VRD(2); SBAR(); GAPA(C0=__builtin_amdgcn_mfma_f32_32x32x16_bf16(kf[4],qr[2],C0,0,0,0),   P1[2],P1[3],P1[4],P1[5],     pw2[0]=PKW(P1,0), pw2[1]=PKW(P1,2), pw2); \
    VRD(6); SBAR(); GAPA(C1=__builtin_amdgcn_mfma_f32_32x32x16_bf16(kf[5],qr[2],C1,0,0,0),   P1[6],P1[7],P1[8],P1[9],     pw2[2]=PKW(P1,4), pw2[3]=PKW(P1,6), pw2); \
    VRD(3); SBAR(); GAPA(C0=__builtin_amdgcn_mfma_f32_32x32x16_bf16(kf[6],qr[3],C0,0,0,0),   P1[10],P1[11],P1[12],P1[13], pw3[0]=PKW(P1,8), pw3[1]=PKW(P1,10), pw3); \
    VRD(7); SBAR(); GAPA(C1=__builtin_amdgcn_mfma_f32_32x32x16_bf16(kf[7],qr[3],C1,0,0,0),   P1[14],P1[15],0.f,0.f,       pw3[2]=PKW(P1,12),pw3[3]=PKW(P1,14), pw3); \
    l_reg+=sacc; \
    if(GK){DMA_K((t)+3,sl_cur);} if(GV){DMA_V((t)+1,sl_next);} \
    ADDC(C0,C1,t); CMASK(C0,C1,t); \
    { float a=MX3(C0[0],C0[1],C1[0]),b=MX3(C0[2],C0[3],C1[1]); a=MX3(a,C1[2],C1[3]); \
      _Pragma("unroll") for(int r=4;r<16;r+=4){a=MX3(a,C0[r],C0[r+1]);b=MX3(b,C0[r+2],C0[r+3]);a=MX3(a,C1[r],C1[r+1]);b=MX3(b,C1[r+2],C1[r+3]);} \
      float rm=__builtin_fmaxf(a,b); { auto rr=__builtin_amdgcn_permlane32_swap(__float_as_uint(rm),__float_as_uint(rm),false,false); rm=__builtin_fmaxf(__uint_as_float(rr[0]),__uint_as_float(rr[1])); } \
      resc=false; \
      if(__builtin_expect(__any(rm>(float)THRL),0)){ const float dl=__builtin_fmaxf(rm,0.f); mhat+=dl; \
        _Pragma("unroll") for(int r=0;r<16;++r){C0[r]-=dl;C1[r]-=dl;} \
        _Pragma("unroll") for(int r=0;r<16;++r)negm[r]=-mhat; asm volatile("":"+v"(negm)); \
        const float f=__builtin_amdgcn_exp2f(-dl); l_reg*=f; if(hi==0)wsf[r32]=f; resc=true; } } \
    SBAR(); \
    GAPB(o[0]=__builtin_amdgcn_mfma_f32_32x32x16_bf16(PAF(0),VFR(0),o[0],0,0,0), C0,0); \
    GAPB(o[1]=__builtin_amdgcn_mfma_f32_32x32x16_bf16(PAF(0),VFR(4),o[1],0,0,0), C0,4); \
    KRD(GL,0); GAPB(o[0]=__builtin_amdgcn_mfma_f32_32x32x16_bf16(PAF(1),VFR(1),o[0],0,0,0), C0,8); \
    KRD(GL,1); GAPB(o[1]=__builtin_amdgcn_mfma_f32_32x32x16_bf16(PAF(1),VFR(5),o[1],0,0,0), C0,12); \
    KRD(GL,2); GAPB(o[0]=__builtin_amdgcn_mfma_f32_32x32x16_bf16(PAF(2),VFR(2),o[0],0,0,0), C1,0); \
    KRD(GL,3); GAPB(o[1]=__builtin_amdgcn_mfma_f32_32x32x16_bf16(PAF(2),VFR(6),o[1],0,0,0), C1,4); \
    GAPB(o[0]=__builtin_amdgcn_mfma_f32_32x32x16_bf16(PAF(3),VFR(3),o[0],0,0,0), C1,8); \
    GAPB(o[1]=__builtin_amdgcn_mfma_f32_32x32x16_bf16(PAF(3),VFR(7),o[1],0,0,0), C1,12); \
    }while(0)
  int t=1;
  #undef CMASK
  #define CMASK(P0,P1,t) do{}while(0)
  for(;t+5<NT;t+=2){
    STEP(pB0,pB1,pA0,pA1,t,true,true,true);     WAIT_BAR(2); RESC(); ROT();
    STEP(pA0,pA1,pB0,pB1,t+1,true,true,true);   WAIT_BAR(2); RESC(); ROT();
  }
  #undef CMASK
  #define CMASK(P0,P1,t) do{int jb_=(t)-(NT-4); if(jb_>=0)cmask(P0,P1,jb_,qrel,hi);}while(0)
  #define ENDW(tt) do{ if((tt)+3<NT){WAIT_BAR(2);} else if((tt)+2<NT){WAIT_BAR(1);} else {WAIT_BAR(0);} }while(0)
  for(;t+1<NT;t+=2){
    STEP(pB0,pB1,pA0,pA1,t,(t+3<NT),(t+1<NT),(t+1<NT));       ENDW(t);   RESC(); ROT();
    STEP(pA0,pA1,pB0,pB1,t+1,(t+4<NT),(t+2<NT),(t+2<NT));     ENDW(t+1); RESC(); ROT();
  }
  STEP(pB0,pB1,pA0,pA1,NT-1,false,false,false); RESC();
  { float sacc=pB0[0]+pB0[1]; _Pragma("unroll") for(int r=2;r<16;++r)sacc+=pB0[r]; _Pragma("unroll") for(int r=0;r<16;++r)sacc+=pB1[r]; l_reg+=sacc;
    pw0=(u32x4){PKW(pB0,0),PKW(pB0,2),PKW(pB0,4),PKW(pB0,6)};pw1=(u32x4){PKW(pB0,8),PKW(pB0,10),PKW(pB0,12),PKW(pB0,14)};pw2=(u32x4){PKW(pB1,0),PKW(pB1,2),PKW(pB1,4),PKW(pB1,6)};pw3=(u32x4){PKW(pB1,8),PKW(pB1,10),PKW(pB1,12),PKW(pB1,14)};
    int tl_=lane_id_v(); asm volatile("":"+v"(tl_)); const int ln_=tl_&63,hi_=ln_>>5; const int vb0e=(int)(lds0+LDS_V)+((ln_>>4)&1)*32+(ln_&3)*8+(4*hi_+((ln_&15)>>2))*64;
    SBAR(); pv(o,vb0e+sl_cur,PAF(0),PAF(1),PAF(2),PAF(3)); }
  #undef PKW
  #undef PAF
  #undef VFR
  #undef PIN
  #undef MX3
  #undef GAPA
  #undef GAPB
  #undef EX
  #undef VRD
  #undef KRD
  #undef STEP
  #undef ENDW
  {auto rr=__builtin_amdgcn_permlane32_swap(__float_as_uint(l_reg),__float_as_uint(l_reg),false,false);l_reg=__uint_as_float(rr[0])+__uint_as_float(rr[1]);}
  int te_=lane_id_v(); asm volatile("":"+v"(te_)); const int lane_e=te_&63,r32_e=lane_e&31,hi_e=lane_e>>5;
  if(hi_e==0)wsf[32+r32_e]=l_reg;asm volatile("s_waitcnt lgkmcnt(0)":::"memory");
  float rli[16];
  #pragma unroll
  for(int r=0;r<16;++r)rli[r]=__builtin_amdgcn_rcpf(wsf[32+crow(r,hi_e)]);
  bf16*Ow=O+(rowbase+q0+wid*QBLK)*DM+h*D;
  { bf16*stg=(bf16*)(shm+LDS_OST)+wid*2048;
    #pragma unroll
    for(int r=0;r<16;++r){const int orow=crow(r,hi_e);
      #pragma unroll
      for(int d0=0;d0<2;++d0)stg[orow*64+d0*32+r32_e]=__float2bfloat16(o[d0][r]*rli[r]);}
    asm volatile("s_waitcnt lgkmcnt(0)":::"memory");
    #pragma unroll
    for(int i=0;i<4;++i){const int row=i*8+(lane_e>>3),ch=lane_e&7; const u32x4 v=*(const u32x4*)(stg+row*64+ch*8); ATTN_STORE16(Ow+(long)row*DM+ch*8,v);} }
  asm volatile("s_waitcnt lgkmcnt(0)\n\ts_barrier":::"memory");
  #undef ADDC
  #undef DMA_K
  #undef DMA_V
  #undef CMASK
  #undef START
  #undef RESC
  #undef ROT
}
constexpr int ATTN_LDS_BYTES=LDS_BYTES;
struct AttnTensors { const bf16* Q; const bf16* K; const bf16* V; bf16* O; const float* CF; float dskip; };
struct AttnUnit { int bh; int qb; };
struct StaticOrder {
  int vcu;
  __device__ __forceinline__ explicit StaticOrder(int grid,int block):vcu((block%8)*(grid/8)+block/8){}
  __device__ __forceinline__ bool next(int i,AttnUnit&u)const{ if(i>=2)return false; const int s=vcu&7; u.bh=vcu>>3; u.qb=(i==0)?s:15-s; return true; }
  __device__ __forceinline__ void a_ready(const AttnUnit&)const{}
  __device__ __forceinline__ void done(const AttnUnit&)const{}
};
template<class Sched,int THRL=8> __device__ __forceinline__ void attn_phase(char*lds,const AttnTensors&T,const Sched&S,int wave_id){
  AttnUnit u;
  for(int i=0;S.next(i,u);++i){ S.a_ready(u); attn_unit<THRL>(u.bh/NHEAD,u.bh%NHEAD,u.qb,T.Q,T.K,T.V,T.O,T.CF,T.dskip,lds,wave_id); S.done(u); }
}
#undef SBAR
#undef WAIT_BAR
}

struct Args { const float* in[16]; float* out; unsigned char* ws; };
__global__ void __launch_bounds__(NWAVES * 64, 2) hyb_fwd(Args args) {
    extern __shared__ __attribute__((aligned(16))) unsigned char lds[];
    Ctx F;
    F.lds = (LAS unsigned char*)lds;
    F.tid = threadIdx.x; F.lane = F.tid & 63; F.wave = __builtin_amdgcn_readfirstlane(F.tid >> 6);
    F.G = gridDim.x; F.gw = blockIdx.x * NWAVES + F.wave; F.NGW = F.G * NWAVES;
    F.out = args.out; F.ws = args.ws;
    volatile LAS unsigned* MISC = (volatile LAS unsigned*)(F.lds + MISC_OFF);
    for (int u = F.tid; u < (LDS_BYTES - LDSCTL_OFF) / 4; u += NWAVES * 64) ((LAS unsigned*)(F.lds + LDSCTL_OFF))[u] = 0u;
    __syncthreads();
    gu32* ctl = (gu32*)(F.ws + WS_CTL);
    XcdBarrier bar = xcd_barrier_post((unsigned*)(ctl + CW_BAR), MISC + 8); bar.w = F.wave;
#define FRESH(P) Ctx P = F; P.tid = (F.wave << 6) | lane_id_v(); asm volatile("" : "+v"(P.tid), "+s"(P.wave), "+s"(P.gw), "+s"(P.ws), "+s"(P.out)); P.lane = P.tid & 63
#define GRID_BAR() do { XcdBarrier b_ = bar; asm volatile("" : "+s"(b_.bar), "+s"(b_.x)); xcd_barrier(b_); } while (0)

    bf16* Wb = (bf16*)(F.ws + WS_W);
    bf16* Z = (bf16*)(F.ws + WS_Z); float* ZS = (float*)(F.ws + WS_ZS); bf16* HDN = (bf16*)(F.ws + WS_HDN);
    float* M32 = (float*)(F.ws + WS_HDN); bf16* HB = (bf16*)(F.ws + WS_Z);
    LAS unsigned char* ring = F.lds + RING_OFF; float* SSp = (float*)(F.ws + WS_SS);

    { FRESH(P); p0_prologue(P, args.in[2], args.in[9], args.in[10], args.in[11], args.in[12], args.in[14], args.in[15]); }
    { FRESH(P); norm0_phase(P, args.in[0], args.in[1], (bf16*)(P.ws + WS_HDN), (float*)(P.ws + WS_SS)); }
    GRID_BAR();

    #pragma unroll 1
    for (int layer = 0; layer < DEPTH; ++layer) {
        const float* xin = (layer == 0) ? args.in[0] : F.out;
        const bf16* L = Wb + (size_t)layer * LW_STRIDE;
        { pg8::Gemm g{HDN, L + LW_IN, M, NIN, DM, DM, DM}; pg8::StaticOrder S; S.init(M, NIN, F.G, (int)blockIdx.x);
          pg8::EpiZ E{Z, ZS, SSp};
          pg8::gemm_phase<pg8::EpiZ, pg8::StaticOrder, true, true>(ring, g, S, E, F.wave); }
        GRID_BAR();
#ifdef PROBE_PP
        { FRESH(P); post_phase(P, args.in[4] + layer * 64, args.in[5] + layer * 64, args.in[6] + layer * 64, args.in[7] + layer * 64, args.in[3] + layer * 8, true); }
#endif
        { FRESH(P); post_phase(P, args.in[4] + layer * 64, args.in[5] + layer * 64, args.in[6] + layer * 64, args.in[7] + layer * 64, args.in[3] + layer * 8); }
        { FRESH(P); ret_state_mfma(P); }
        GRID_BAR();
        { FRESH(P); fscan_phase(P); }
        { FRESH(P); ret_scan(P); }
        GRID_BAR();
#ifdef PROBE_RO
        { FRESH(P); ret_out_mfma(P, args.in[8] + layer * 512, true); }
#endif
        { FRESH(P); ret_out_mfma(P, args.in[8] + layer * 512); }
#ifdef PROBE_X3
        for (int rep_ = 0; rep_ < 2; ++rep_)
        { static_assert(attn_body::ATTN_LDS_BYTES <= RING_BYTES, "attention scratch fits the ring region");
          unsigned char* wsl = F.ws; asm volatile("" : "+s"(wsl));
          bf16* Zl = (bf16*)(wsl + WS_Z);
          const attn_body::AttnTensors AT{(const attn_body::bf16*)(Zl + Z_FQ), (const attn_body::bf16*)(Zl + Z_FK), (const attn_body::bf16*)(Zl + Z_FV), (attn_body::bf16*)(Zl + (rep_ == 0 ? Z_RQ : Z_FQ)), (const float*)(wsl + WS_CF)};
          const attn_body::StaticOrder S((int)F.G, (int)blockIdx.x);
          attn_body::attn_phase<attn_body::StaticOrder, 20>((char*)lds + RING_OFF, AT, S, F.wave); }
#ifdef PROBE_X4
        { FRESH(P); dsa_v3(P); }
#else
        for (int rep_ = 0; rep_ < 2; ++rep_) { FRESH(P); dsa_v3(P, rep_ == 0 ? Z_RG : Z_DQ); }
#endif
#else
        { static_assert(attn_body::ATTN_LDS_BYTES <= RING_BYTES, "attention scratch fits the ring region");
          unsigned char* wsl = F.ws; asm volatile("" : "+s"(wsl));
          bf16* Zl = (bf16*)(wsl + WS_Z);
          float dskip; { const int ln = lane_id_v(); const float gq = wave_max(fabsf(args.in[4][layer * 64 + ln])), gk = wave_max(fabsf(args.in[5][layer * 64 + ln])); dskip = 2.0f * (64.0f * C2 * gq * gk * 1.02f) + 48.0f; }
          const attn_body::AttnTensors AT{(const attn_body::bf16*)(Zl + Z_FQ), (const attn_body::bf16*)(Zl + Z_FK), (const attn_body::bf16*)(Zl + Z_FV), (attn_body::bf16*)(Zl + Z_FQ), (const float*)(wsl + WS_CF), dskip};
          const attn_body::StaticOrder S((int)F.G, (int)blockIdx.x);
          attn_body::attn_phase<attn_body::StaticOrder, 20>((char*)lds + RING_OFF, AT, S, F.wave); }
        { FRESH(P); dsa_v3(P); }
#endif
        GRID_BAR();
        { pg8::Gemm g{Z + Z_FQ, L + LW_MIX, M, DM, 1536, ZP, 1536}; pg8::StaticOrder S; S.init(M, DM, F.G, (int)blockIdx.x);
          pg8::EpiGateF E{Z + Z_ZG, Z + Z_MRG};
          pg8::gemm_phase<pg8::EpiGateF, pg8::StaticOrder, false, true>(ring, g, S, E, F.wave); }
        GRID_BAR();
        { pg8::Gemm g{Z + Z_MRG, L + LW_O, M, DM, DM, ZP, DM}; pg8::StaticOrder S; S.init(M, DM, F.G, (int)blockIdx.x);
          pg8::EpiRes E{xin, F.out, args.in[13] + layer * DM, HDN, SSp};
          pg8::gemm_phase<pg8::EpiRes, pg8::StaticOrder, false, true>(ring, g, S, E, F.wave); }
        GRID_BAR();
        { pg8::Gemm g{HDN, L + LW_FI, M, FF2, DM, DM, DM}; pg8::StaticOrder S; S.init(M, FF2, F.G, (int)blockIdx.x);
          pg8::EpiSwi E{HB, FFH, SSp};
          pg8::gemm_phase<pg8::EpiSwi, pg8::StaticOrder, true, true>(ring, g, S, E, F.wave); }
        GRID_BAR();
        { pg8::Gemm g{HB, L + LW_FO, M, DM, FFH, FFH, FFH}; pg8::StaticOrder S; S.init(M, DM, F.G, (int)blockIdx.x);
          pg8::EpiRes E{F.out, F.out, args.in[1] + (layer + 1 < DEPTH ? layer + 1 : layer) * DM, HDN, SSp};
          pg8::gemm_phase<pg8::EpiRes, pg8::StaticOrder, false, true>(ring, g, S, E, F.wave); }
        GRID_BAR();
    }
    if (__hip_atomic_load((gu32*)((unsigned*)(ctl + CW_BAR) + XB_TMO), RLX_AGENT) != 0u) {
        const float q = __builtin_nanf("");
        for (int m = F.gw; m < M; m += F.NGW) { GAS f32x4* o = (GAS f32x4*)(F.out + (size_t)m * DM) + lane_id_v();
#pragma unroll
            for (int j = 0; j < 4; ++j) o[64 * j] = (f32x4){q, q, q, q}; }
    }
}

extern "C" void kernel_launch(void* const* d_in, const int* in_sizes, int n_in, void* d_out, int out_size, void* d_ws, size_t ws_size, hipStream_t stream) {
    static int grid = 0;
    if (grid == 0) {
        if (n_in != 16 || in_sizes[0] != M * DM || out_size != M * DM || ws_size < WS_END) { fprintf(stderr, "kernel_launch: unexpected shapes / workspace (n_in %d, in0 %d, out %d, ws %zu < %zu)\n", n_in, n_in > 0 ? in_sizes[0] : -1, out_size, ws_size, (size_t)WS_END); grid = -1; return; }
        int dev = 0, cus = 0, per_cu = 0;
        if (hipGetDevice(&dev) != hipSuccess || hipDeviceGetAttribute(&cus, hipDeviceAttributeMultiprocessorCount, dev) != hipSuccess) { grid = -1; return; }
        if (hipFuncSetAttribute((const void*)hyb_fwd, hipFuncAttributeMaxDynamicSharedMemorySize, LDS_BYTES) != hipSuccess) { fprintf(stderr, "kernel_launch: hipFuncSetAttribute failed\n"); grid = -1; return; }
        if (hipOccupancyMaxActiveBlocksPerMultiprocessor(&per_cu, (const void*)hyb_fwd, NWAVES * 64, LDS_BYTES) != hipSuccess || per_cu < 1) { fprintf(stderr, "kernel_launch: occupancy query reports %d blocks per CU\n", per_cu); }
        (void)hipGetLastError();
        grid = cus;
    }
    if (grid < 0) return;
    if (hipMemsetAsync((char*)d_ws + WS_CTL, 0, CTL_ZERO_BYTES, stream) != hipSuccess) return;
    Args a{};
    for (int i = 0; i < 16; ++i) a.in[i] = (const float*)d_in[i];
    a.out = (float*)d_out; a.ws = (unsigned char*)d_ws;
    hipLaunchKernelGGL(hyb_fwd, dim3(grid), dim3(NWAVES * 64), LDS_BYTES, stream, a);
}
```

```cpp
#include <hip/hip_runtime.h>
#include <cstdio>
#include <cstdint>
#include <cmath>
__device__ __forceinline__ int lane_id_v() { unsigned z; asm volatile("v_mov_b32 %0, 0" : "=v"(z)); return (int)__builtin_amdgcn_mbcnt_hi(~0u, __builtin_amdgcn_mbcnt_lo(~0u, z)); }
template <int MASK> __device__ __forceinline__ float sx(float v) { static_assert(MASK < 32, "swizzle xor mask"); return __builtin_bit_cast(float, __builtin_amdgcn_ds_swizzle(__builtin_bit_cast(int, v), 0x1F | (MASK << 10))); }
template <int MASK> __device__ __forceinline__ unsigned sxu(unsigned v) { return (unsigned)__builtin_amdgcn_ds_swizzle((int)v, 0x1F | (MASK << 10)); }
__device__ __forceinline__ void swap32(unsigned x, unsigned& lo_view, unsigned& hi_view) {
    unsigned a = x, b = x; asm volatile("" : "+v"(b));
    const auto rr = __builtin_amdgcn_permlane32_swap(a, b, false, false);
    lo_view = rr[0]; hi_view = rr[1];
}
template <int CTRL> __device__ __forceinline__ float dpp_f(float v) { return __builtin_bit_cast(float, __builtin_amdgcn_update_dpp(0, __builtin_bit_cast(int, v), CTRL, 0xF, 0xF, false)); }
template <int CTRL> __device__ __forceinline__ int dpp_i(int v) { return __builtin_amdgcn_update_dpp(0, v, CTRL, 0xF, 0xF, false); }
__device__ __forceinline__ float rl_f(float v, int l) { return __builtin_bit_cast(float, __builtin_amdgcn_readlane(__builtin_bit_cast(int, v), l)); }
__device__ __forceinline__ float wave_sum(float v) {
    v += dpp_f<0xB1>(v); v += dpp_f<0x4E>(v); v += dpp_f<0x141>(v); v += dpp_f<0x140>(v);
    return (rl_f(v, 0) + rl_f(v, 16)) + (rl_f(v, 32) + rl_f(v, 48));
}
__device__ __forceinline__ float wave_max(float v) {
    v = fmaxf(v, dpp_f<0xB1>(v)); v = fmaxf(v, dpp_f<0x4E>(v)); v = fmaxf(v, dpp_f<0x141>(v)); v = fmaxf(v, dpp_f<0x140>(v));
    return fmaxf(fmaxf(rl_f(v, 0), rl_f(v, 16)), fmaxf(rl_f(v, 32), rl_f(v, 48)));
}
__device__ __forceinline__ int wave_isum(int v) {
    v += dpp_i<0xB1>(v); v += dpp_i<0x4E>(v); v += dpp_i<0x141>(v); v += dpp_i<0x140>(v);
    return (__builtin_amdgcn_readlane(v, 0) + __builtin_amdgcn_readlane(v, 16)) + (__builtin_amdgcn_readlane(v, 32) + __builtin_amdgcn_readlane(v, 48));
}
__device__ __forceinline__ unsigned wave_umax(unsigned v) {
    unsigned t; t = (unsigned)dpp_i<0xB1>((int)v); v = t > v ? t : v; t = (unsigned)dpp_i<0x4E>((int)v); v = t > v ? t : v; t = (unsigned)dpp_i<0x141>((int)v); v = t > v ? t : v; t = (unsigned)dpp_i<0x140>((int)v); v = t > v ? t : v;
    const unsigned a = (unsigned)__builtin_amdgcn_readlane((int)v, 0), b = (unsigned)__builtin_amdgcn_readlane((int)v, 16), c = (unsigned)__builtin_amdgcn_readlane((int)v, 32), d = (unsigned)__builtin_amdgcn_readlane((int)v, 48);
    const unsigned ab = a > b ? a : b, cd = c > d ? c : d; return ab > cd ? ab : cd;
}
__device__ __forceinline__ unsigned wave_umin(unsigned v) { return ~wave_umax(~v); }
__device__ __forceinline__ float half_sum(float v) {
    unsigned a, b; swap32(__builtin_bit_cast(unsigned, v), a, b); return __builtin_bit_cast(float, a) + __builtin_bit_cast(float, b);
}
__device__ __forceinline__ float half_max(float v) {
    unsigned a, b; swap32(__builtin_bit_cast(unsigned, v), a, b); return fmaxf(__builtin_bit_cast(float, a), __builtin_bit_cast(float, b));
}
namespace pg8 {
#define PG8_LAS __attribute__((address_space(3)))
typedef unsigned short bf16_t;
typedef short bf16x8 __attribute__((ext_vector_type(8)));
typedef float f32x4 __attribute__((ext_vector_type(4)));
typedef unsigned u32x4 __attribute__((ext_vector_type(4)));
constexpr int BM = 256, BK = 64, HALF = 128, HTB = HALF * BK * 2  , STAGE_BYTES = 8 * HTB, NXCD = 8, WGM = 8;

__host__ __device__ __forceinline__ int lds_byte(int r, int c) { const int st = (r >> 4) * 2 + (c >> 5), rr = r & 15, cc = c & 31, ob = rr * 64 + cc * 2; return st * 1024 + (ob ^ (((ob >> 9) & 1) << 5)); }
__host__ __device__ __forceinline__ void stage_rc(int b, int& R, int& C) { const int st = b / 1024, sb = b % 1024, swz = sb ^ (((sb >> 9) & 1) << 5); R = (st >> 1) * 16 + swz / 64; C = (st & 1) * 32 + (swz % 64) / 2; }
__host__ __device__ __forceinline__ int perm32(int rho) { const int n = rho >> 4, i = rho & 15; return 8 * (i >> 2) + 4 * n + (i & 3); }

struct Unit { int pm, pn; };
struct Gemm { const bf16_t* A; const bf16_t* Bt; int M, N, K, lda, ldb; };

struct StaticOrder {
    int nM, nN, nwg, G, c;
    __host__ __device__ void init(int M, int N, int G_, int c_) { nM = M / BM; nN = N / BM; nwg = nM * nN; G = G_; c = c_; }
    __host__ __device__ bool next(int i, Unit& u) const {
        const long L = (long)i * G + c; if (L >= nwg) return false;
        int wgid = (int)L; { const int q = nwg / NXCD, r = nwg % NXCD, xcd = wgid % NXCD, off = wgid / NXCD; wgid = (xcd < r ? xcd * (q + 1) : r * (q + 1) + (xcd - r) * q) + off; }
        const int nig = WGM * nN, gid = wgid / nig, fm = gid * WGM, gsz = (nM - fm) < WGM ? (nM - fm) : WGM;
        u.pm = fm + ((wgid % nig) % gsz); u.pn = (wgid % nig) / gsz; return true;
    }
    __device__ __forceinline__ void a_ready(const Unit&) const {}
    __device__ __forceinline__ void done(const Unit&) const {}
};

__device__ __forceinline__ unsigned cvt_pk_bf16(float lo, float hi) { unsigned r; asm volatile("v_cvt_pk_bf16_f32 %0, %1, %2" : "=v"(r) : "v"(lo), "v"(hi)); return r; }
__device__ __forceinline__ float bflo(unsigned w) { return __builtin_bit_cast(float, w << 16); }
__device__ __forceinline__ float bfhi(unsigned w) { return __builtin_bit_cast(float, w & 0xffff0000u); }
__device__ __forceinline__ float sigmoidf_(float x) { return __builtin_amdgcn_rcpf(1.0f + __builtin_amdgcn_exp2f(-1.4426950408889634f * x)); }

constexpr int ZP = 6656;
constexpr int ZSP = 512;
constexpr int NZT = 26, GATE_T0 = 14;

#define PRELOAD_RSTD(rsv, SS_, row0_) float rsv[2][4]; { f32x4 s_[2][4]; _Pragma("unroll") for (int ai_ = 0; ai_ < 2; ++ai_) _Pragma("unroll") for (int m_ = 0; m_ < 4; ++m_) s_[ai_][m_] = *(const f32x4*)((SS_) + (size_t)((row0_) + ai_ * HALF + m_ * 16) * 4); \
    _Pragma("unroll") for (int ai_ = 0; ai_ < 2; ++ai_) _Pragma("unroll") for (int m_ = 0; m_ < 4; ++m_) rsv[ai_][m_] = 1.0f / __builtin_sqrtf(((s_[ai_][m_][0] + s_[ai_][m_][1]) + (s_[ai_][m_][2] + s_[ai_][m_][3])) * (1.0f / 1024.0f) + 1e-6f); }
struct EpiZ {
    static constexpr bool PERM = true, AFTER_DRAIN = false, MID = false;
    bf16_t* Z; float* ZS; const float* SS; const float* GQ; const float* GK; const float* GD; const float* R64;
    __device__ __forceinline__ void operator()(const f32x4 (&acc)[2][2][4][2], const Unit& u, int wr, int wc, int fr, int fq) const {
        const int row0 = u.pm * BM + wr * 64 + fr;
        PRELOAD_RSTD(rsv, SS, row0);
        if (u.pn < 4 || u.pn == 6 || u.pn == 7) {
            const float osc = (u.pn < 4) ? 0.18033688011112042f : 1.0f; const bool rope = (u.pn == 2 || u.pn == 3);
            f32x4 g00, g01, g10, g11;
            if (u.pn < 2) { g00 = *(const f32x4*)(GQ + 8 * fq); g01 = *(const f32x4*)(GQ + 8 * fq + 4); g10 = *(const f32x4*)(GQ + 32 + 8 * fq); g11 = *(const f32x4*)(GQ + 32 + 8 * fq + 4); }
            else if (u.pn < 4) { g00 = *(const f32x4*)(GD + 8 * fq); g01 = *(const f32x4*)(GD + 8 * fq + 4); g10 = *(const f32x4*)(GD + 32 + 8 * fq); g11 = *(const f32x4*)(GD + 32 + 8 * fq + 4); }
            else { g00 = *(const f32x4*)(GK + 8 * fq); g01 = *(const f32x4*)(GK + 8 * fq + 4); g10 = *(const f32x4*)(GK + 32 + 8 * fq); g11 = *(const f32x4*)(GK + 32 + 8 * fq + 4); }
            const int colo = u.pn * BM + wc * 64 + 8 * fq;
#pragma unroll
            for (int ai = 0; ai < 2; ++ai)
#pragma unroll
                for (int m = 0; m < 4; ++m) { const int row = row0 + ai * HALF + m * 16; const float rs = rsv[ai][m];
                    f32x4 a0 = acc[ai][0][m][0] * rs, a1 = acc[ai][0][m][1] * rs, b0 = acc[ai][1][m][0] * rs, b1 = acc[ai][1][m][1] * rs;
                    float ss = ((a0[0] * a0[0] + a0[1] * a0[1]) + (a0[2] * a0[2] + a0[3] * a0[3])) + ((a1[0] * a1[0] + a1[1] * a1[1]) + (a1[2] * a1[2] + a1[3] * a1[3]))
                             + ((b0[0] * b0[0] + b0[1] * b0[1]) + (b0[2] * b0[2] + b0[3] * b0[3])) + ((b1[0] * b1[0] + b1[1] * b1[1]) + (b1[2] * b1[2] + b1[3] * b1[3]));
                    ss += sx<16>(ss); { unsigned x_, y_; swap32(__builtin_bit_cast(unsigned, ss), x_, y_); ss = __builtin_bit_cast(float, x_) + __builtin_bit_cast(float, y_); }
                    const float hr = osc / __builtin_sqrtf(ss * (1.0f / 64.0f) + 1e-6f);
                    a0 = a0 * g00 * hr; a1 = a1 * g01 * hr; b0 = b0 * g10 * hr; b1 = b1 * g11 * hr;
                    if (rope) { const float* cs = R64 + ((size_t)(row & 4095) * 32 + 8 * fq) * 2;
                        const f32x4 c0 = *(const f32x4*)cs, c1 = *(const f32x4*)(cs + 4), c2 = *(const f32x4*)(cs + 8), c3 = *(const f32x4*)(cs + 12);
                        f32x4 x0, x1, y0, y1;
                        x0[0] = a0[0] * c0[0] - b0[0] * c0[1]; y0[0] = b0[0] * c0[0] + a0[0] * c0[1]; x0[1] = a0[1] * c0[2] - b0[1] * c0[3]; y0[1] = b0[1] * c0[2] + a0[1] * c0[3];
                        x0[2] = a0[2] * c1[0] - b0[2] * c1[1]; y0[2] = b0[2] * c1[0] + a0[2] * c1[1]; x0[3] = a0[3] * c1[2] - b0[3] * c1[3]; y0[3] = b0[3] * c1[2] + a0[3] * c1[3];
                        x1[0] = a1[0] * c2[0] - b1[0] * c2[1]; y1[0] = b1[0] * c2[0] + a1[0] * c2[1]; x1[1] = a1[1] * c2[2] - b1[1] * c2[3]; y1[1] = b1[1] * c2[2] + a1[1] * c2[3];
                        x1[2] = a1[2] * c3[0] - b1[2] * c3[1]; y1[2] = b1[2] * c3[0] + a1[2] * c3[1]; x1[3] = a1[3] * c3[2] - b1[3] * c3[3]; y1[3] = b1[3] * c3[2] + a1[3] * c3[3];
                        a0 = x0; a1 = x1; b0 = y0; b1 = y1; }
                    bf16_t* rowp = Z + (size_t)row * ZP + colo;
                    u32x4 w; w.x = cvt_pk_bf16(a0[0], a0[1]); w.y = cvt_pk_bf16(a0[2], a0[3]); w.z = cvt_pk_bf16(a1[0], a1[1]); w.w = cvt_pk_bf16(a1[2], a1[3]); *(u32x4*)rowp = w;
                    w.x = cvt_pk_bf16(b0[0], b0[1]); w.y = cvt_pk_bf16(b0[2], b0[3]); w.z = cvt_pk_bf16(b1[0], b1[1]); w.w = cvt_pk_bf16(b1[2], b1[3]); *(u32x4*)(rowp + 32) = w;
                    __builtin_amdgcn_sched_barrier(0); }
        } else if (u.pn < NZT) {
            const int col0 = u.pn * BM + wc * 32 + 8 * fq;
#pragma unroll
            for (int ai = 0; ai < 2; ++ai)
#pragma unroll
                for (int m = 0; m < 4; ++m) { bf16_t* rowp = Z + (size_t)(row0 + ai * HALF + m * 16) * ZP + col0; const float rs = rsv[ai][m];
#pragma unroll
                    for (int bj = 0; bj < 2; ++bj) { f32x4 v0 = acc[ai][bj][m][0] * rs, v1 = acc[ai][bj][m][1] * rs;
                        if (u.pn >= GATE_T0) {
#pragma unroll
                            for (int i = 0; i < 4; ++i) { v0[i] = sigmoidf_(v0[i]); v1[i] = sigmoidf_(v1[i]); } }
                        u32x4 w; w.x = cvt_pk_bf16(v0[0], v0[1]); w.y = cvt_pk_bf16(v0[2], v0[3]); w.z = cvt_pk_bf16(v1[0], v1[1]); w.w = cvt_pk_bf16(v1[2], v1[3]);
                        *(u32x4*)(rowp + bj * HALF) = w; } }
        } else {
            const int col0 = (u.pn - NZT) * BM + wc * 32 + 8 * fq;
#pragma unroll
            for (int ai = 0; ai < 2; ++ai)
#pragma unroll
                for (int m = 0; m < 4; ++m) { float* rowp = ZS + (size_t)(row0 + ai * HALF + m * 16) * ZSP + col0; const float rs = rsv[ai][m];
#pragma unroll
                    for (int bj = 0; bj < 2; ++bj) { *(f32x4*)(rowp + bj * HALF) = acc[ai][bj][m][0] * rs; *(f32x4*)(rowp + bj * HALF + 4) = acc[ai][bj][m][1] * rs; } }
        }
    }
};

template <int P> struct EpiGate {
    static constexpr bool PERM = true, AFTER_DRAIN = false, MID = false;
    const bf16_t* G;
    float* M32;
    bf16_t* OUT;
    __device__ __forceinline__ void operator()(const f32x4 (&acc)[2][2][4][2], const Unit& u, int wr, int wc, int fr, int fq) const {
        const int row0 = u.pm * BM + wr * 64 + fr, col0 = u.pn * BM + wc * 32 + 8 * fq;
#pragma unroll
        for (int ai = 0; ai < 2; ++ai)
#pragma unroll
            for (int m = 0; m < 4; ++m) { const size_t row = (size_t)(row0 + ai * HALF + m * 16);
#pragma unroll
                for (int bj = 0; bj < 2; ++bj) { const int col = col0 + bj * HALF;
                    const u32x4 gw = *(const u32x4*)(G + row * ZP + P * 1024 + col);
                    const f32x4 v0 = acc[ai][bj][m][0], v1 = acc[ai][bj][m][1];
                    f32x4 t0, t1;
                    t0[0] = bflo(gw.x) * v0[0]; t0[1] = bfhi(gw.x) * v0[1]; t0[2] = bflo(gw.y) * v0[2]; t0[3] = bfhi(gw.y) * v0[3];
                    t1[0] = bflo(gw.z) * v1[0]; t1[1] = bfhi(gw.z) * v1[1]; t1[2] = bflo(gw.w) * v1[2]; t1[3] = bfhi(gw.w) * v1[3];
                    float* mp = M32 + row * 1024 + col;
                    if (P == 0) { *(f32x4*)mp = t0; *(f32x4*)(mp + 4) = t1; }
                    else if (P == 1) { *(f32x4*)mp = *(const f32x4*)mp + t0; *(f32x4*)(mp + 4) = *(const f32x4*)(mp + 4) + t1; }
                    else { t0 = *(const f32x4*)mp + t0; t1 = *(const f32x4*)(mp + 4) + t1;
                        u32x4 w; w.x = cvt_pk_bf16(t0[0], t0[1]); w.y = cvt_pk_bf16(t0[2], t0[3]); w.z = cvt_pk_bf16(t1[0], t1[1]); w.w = cvt_pk_bf16(t1[2], t1[3]);
                        *(u32x4*)(OUT + row * ZP + col) = w; } } }
    }
};

struct EpiGateF {
    static constexpr bool PERM = true, AFTER_DRAIN = false, MID = true;
    const bf16_t* G; bf16_t* OUT;
    __device__ __forceinline__ void mid(f32x4 (&acc)[2][2][4][2], const Unit& u, int wr, int wc, int fr_, int fq_, int s) const {
        int fr = fr_, fq = fq_; asm volatile("" : "+v"(fr), "+v"(fq));
        const int row0 = u.pm * BM + wr * 64 + fr, col0 = u.pn * BM + wc * 32 + 8 * fq;
#pragma unroll
        for (int ai = 0; ai < 2; ++ai) {
            u32x4 ga[4][2], gb[4][2];
#pragma unroll
            for (int m = 0; m < 4; ++m)
#pragma unroll
                for (int bj = 0; bj < 2; ++bj) { const bf16_t* gp = G + (size_t)(row0 + ai * HALF + m * 16) * ZP + s * 1024 + col0 + bj * HALF; ga[m][bj] = *(const u32x4*)gp; gb[m][bj] = *(const u32x4*)(gp + 1024); }
#pragma unroll
            for (int m = 0; m < 4; ++m)
#pragma unroll
                for (int bj = 0; bj < 2; ++bj) { const u32x4 a = ga[m][bj], b = gb[m][bj]; f32x4 r0, r1;
                    r0[0] = bflo(a.x) * __builtin_amdgcn_rcpf(bflo(b.x)); r0[1] = bfhi(a.x) * __builtin_amdgcn_rcpf(bfhi(b.x)); r0[2] = bflo(a.y) * __builtin_amdgcn_rcpf(bflo(b.y)); r0[3] = bfhi(a.y) * __builtin_amdgcn_rcpf(bfhi(b.y));
                    r1[0] = bflo(a.z) * __builtin_amdgcn_rcpf(bflo(b.z)); r1[1] = bfhi(a.z) * __builtin_amdgcn_rcpf(bfhi(b.z)); r1[2] = bflo(a.w) * __builtin_amdgcn_rcpf(bflo(b.w)); r1[3] = bfhi(a.w) * __builtin_amdgcn_rcpf(bfhi(b.w));
                    acc[ai][bj][m][0] = acc[ai][bj][m][0] * r0; acc[ai][bj][m][1] = acc[ai][bj][m][1] * r1; }
            __builtin_amdgcn_sched_barrier(0); }
    }
    __device__ __forceinline__ void operator()(const f32x4 (&acc)[2][2][4][2], const Unit& u, int wr, int wc, int fr, int fq) const {
        const int row0 = u.pm * BM + wr * 64 + fr, col0 = u.pn * BM + wc * 32 + 8 * fq;
#pragma unroll
        for (int ai = 0; ai < 2; ++ai)
#pragma unroll
            for (int m = 0; m < 4; ++m) { const size_t row = (size_t)(row0 + ai * HALF + m * 16);
#pragma unroll
                for (int bj = 0; bj < 2; ++bj) { const int col = col0 + bj * HALF;
                    const u32x4 gw = *(const u32x4*)(G + row * ZP + 2 * 1024 + col);
                    const f32x4 v0 = acc[ai][bj][m][0], v1 = acc[ai][bj][m][1];
                    u32x4 w; w.x = cvt_pk_bf16(bflo(gw.x) * v0[0], bfhi(gw.x) * v0[1]); w.y = cvt_pk_bf16(bflo(gw.y) * v0[2], bfhi(gw.y) * v0[3]);
                    w.z = cvt_pk_bf16(bflo(gw.z) * v1[0], bfhi(gw.z) * v1[1]); w.w = cvt_pk_bf16(bflo(gw.w) * v1[2], bfhi(gw.w) * v1[3]);
                    *(u32x4*)(OUT + row * ZP + col) = w; } }
    }
};

struct EpiRes {
    static constexpr bool PERM = true, AFTER_DRAIN = true, MID = false;
    const float* RES; float* OUT; const float* G; bf16_t* XG; float* SS;
    __device__ __forceinline__ void fused(const f32x4 (&acc)[2][2][4][2], const Unit& u, int wr, int wc, int fr, int fq, PG8_LAS unsigned char* lds, int wid, int lane) const {
        const int row0 = u.pm * BM + wr * 64 + fr, col0 = u.pn * BM + wc * 32 + 8 * fq;
        PG8_LAS float* P = (PG8_LAS float*)lds;
        f32x4 g[2][2];
#pragma unroll
        for (int bj = 0; bj < 2; ++bj) { g[bj][0] = *(const f32x4*)(G + col0 + bj * HALF); g[bj][1] = *(const f32x4*)(G + col0 + bj * HALF + 4); }
#pragma unroll
        for (int ai = 0; ai < 2; ++ai)
#pragma unroll
            for (int m = 0; m < 4; ++m) { const int row = row0 + ai * HALF + m * 16; const size_t off = (size_t)row * 1024 + col0; float ss = 0.f;
#pragma unroll
                for (int bj = 0; bj < 2; ++bj) { const float* rp = RES + off + bj * HALF; float* op = OUT + off + bj * HALF;
                    const f32x4 v0 = *(const f32x4*)rp + acc[ai][bj][m][0], v1 = *(const f32x4*)(rp + 4) + acc[ai][bj][m][1];
                    *(f32x4*)op = v0; *(f32x4*)(op + 4) = v1;
                    ss += ((v0[0] * v0[0] + v0[1] * v0[1]) + (v0[2] * v0[2] + v0[3] * v0[3])) + ((v1[0] * v1[0] + v1[1] * v1[1]) + (v1[2] * v1[2] + v1[3] * v1[3]));
                    const f32x4 x0 = v0 * g[bj][0], x1 = v1 * g[bj][1];
                    u32x4 w; w.x = cvt_pk_bf16(x0[0], x0[1]); w.y = cvt_pk_bf16(x0[2], x0[3]); w.z = cvt_pk_bf16(x1[0], x1[1]); w.w = cvt_pk_bf16(x1[2], x1[3]);
                    *(u32x4*)(XG + off + bj * HALF) = w; }
                ss += sx<16>(ss); { unsigned a, b; swap32(__builtin_bit_cast(unsigned, ss), a, b); ss = __builtin_bit_cast(float, a) + __builtin_bit_cast(float, b); }
                if (fq == 0) P[(ai * HALF + wr * 64 + m * 16 + fr) * 4 + wc] = ss; }
        asm volatile("s_waitcnt lgkmcnt(0)\n\ts_barrier" ::: "memory");
        const int t = wid * 64 + lane;
        if (t < 256) { const f32x4 p = *(const PG8_LAS f32x4*)(P + t * 4); SS[(size_t)(u.pm * BM + t) * 4 + u.pn] = (p[0] + p[1]) + (p[2] + p[3]); }
    }
};

struct EpiSwi {
    static constexpr bool PERM = true, AFTER_DRAIN = false, MID = false;
    bf16_t* H; int ldh; const float* SS;
    __device__ __forceinline__ void operator()(const f32x4 (&acc)[2][2][4][2], const Unit& u, int wr, int wc, int fr, int fq) const {
        const int row0 = u.pm * BM + wr * 64 + fr, col0 = u.pn * HALF + wc * 32 + 8 * fq;
        PRELOAD_RSTD(rsv, SS, row0);
#pragma unroll
        for (int ai = 0; ai < 2; ++ai)
#pragma unroll
            for (int m = 0; m < 4; ++m) { bf16_t* hp = H + (size_t)(row0 + ai * HALF + m * 16) * ldh + col0; const float rs = rsv[ai][m];
                float o[8];
#pragma unroll
                for (int n = 0; n < 2; ++n)
#pragma unroll
                    for (int i = 0; i < 4; ++i) { const float g = acc[ai][0][m][n][i] * rs, up = acc[ai][1][m][n][i] * rs; o[4 * n + i] = g * sigmoidf_(g) * up; }
                u32x4 w; w.x = cvt_pk_bf16(o[0], o[1]); w.y = cvt_pk_bf16(o[2], o[3]); w.z = cvt_pk_bf16(o[4], o[5]); w.w = cvt_pk_bf16(o[6], o[7]);
                *(u32x4*)hp = w; }
    }
};

template <class Epi, class Sched, bool ALIGN_EPI = false, bool SP2 = false>
__device__ __forceinline__ void gemm_phase(PG8_LAS unsigned char* lds, Gemm g, const Sched& S0, const Epi& E, int wave_id) {
    int ovz, osz; asm volatile("v_mov_b32 %0, 0\n\ts_mov_b32 %1, 0" : "=v"(ovz), "=s"(osz));
    Sched S = S0; S.c += osz; g.lda += osz; g.ldb += osz;
    const int tid = ((wave_id << 6) | lane_id_v()) + ovz,
         wid = __builtin_amdgcn_readfirstlane(tid >> 6), lane = tid & 63, wr = wid >> 2, wc = wid & 3, fr = lane & 15, fq = lane >> 4;
    const int K = g.K, nt = K / BK;
    unsigned voffA[2], voffB[2];
#pragma unroll
    for (int i = 0; i < 2; ++i) { int R, C; stage_rc(tid * 16 + i * 8192, R, C); const int Rb = Epi::PERM ? ((R & ~31) + perm32(R & 31)) : R;
        voffA[i] = (unsigned)(R * g.lda + C) * 2u; voffB[i] = (unsigned)(Rb * g.ldb + C) * 2u; }
    const size_t kstep = (size_t)(BK * 2);
    const size_t hstepA = (size_t)HALF * g.lda * 2, hstepB = (size_t)HALF * g.ldb * 2;
    const size_t tstepA = 2 * hstepA, tstepB = 2 * hstepB;
    const unsigned ldsw = (unsigned)wid * 1024u;
    const int aoff = lds_byte(wr * 64 + fr, fq * 8), boff = lds_byte(wc * 32 + fr, fq * 8);
#define PG8_SA(b, h) (((b) * 2 + (h)) * HTB)
#define PG8_SB(b, h) ((4 + (b) * 2 + (h)) * HTB)
#define PG8_STAGE(bufoff, gbase, voff) do { _Pragma("unroll") for (int _i = 0; _i < 2; ++_i) \
        __builtin_amdgcn_global_load_lds((const unsigned*)((const char*)(gbase) + (voff)[_i]), (PG8_LAS unsigned*)(lds + (bufoff) + ldsw + _i * 8192), 16, 0, 0); } while (0)
#define PG8_LDA(dst, b, h) do { _Pragma("unroll") for (int m = 0; m < 4; ++m) _Pragma("unroll") for (int k = 0; k < 2; ++k) dst[m][k] = *(const PG8_LAS bf16x8*)(lds + PG8_SA(b, h) + aoff + m * 2048 + k * 1024); } while (0)
#define PG8_LDB(dst, b, h) do { _Pragma("unroll") for (int n = 0; n < 2; ++n) _Pragma("unroll") for (int k = 0; k < 2; ++k) dst[n][k] = *(const PG8_LAS bf16x8*)(lds + PG8_SB(b, h) + boff + n * 2048 + k * 1024); } while (0)
#define PG8_MMA(ai, bj, At, Bt) do { __builtin_amdgcn_s_setprio(1); _Pragma("unroll") for (int m = 0; m < 4; ++m) _Pragma("unroll") for (int n = 0; n < 2; ++n) _Pragma("unroll") for (int k = 0; k < 2; ++k) \
        acc[ai][bj][m][n] = __builtin_amdgcn_mfma_f32_16x16x32_bf16(Bt[n][k], At[m][k], acc[ai][bj][m][n], 0, 0, 0); __builtin_amdgcn_s_setprio(0); } while (0)
#define PG8_WAIT_V(n) asm volatile("s_waitcnt vmcnt(" #n ")" ::: "memory")
#define PG8_WAIT_L(n) asm volatile("s_waitcnt lgkmcnt(" #n ")" ::: "memory")
#define PG8_BAR __builtin_amdgcn_s_barrier()
#define PG8_SCHED __builtin_amdgcn_sched_barrier(0)
    Unit cur, nxt; int ui = 0;
    if (!S.next(0, cur)) return;
    f32x4 acc[2][2][4][2];
#pragma unroll
    for (int a = 0; a < 2; ++a)
#pragma unroll
        for (int b = 0; b < 2; ++b)
#pragma unroll
            for (int m = 0; m < 4; ++m)
#pragma unroll
                for (int n = 0; n < 2; ++n) acc[a][b][m][n] = (f32x4){0.f, 0.f, 0.f, 0.f};
    bf16x8 At[4][2], B0[2][2], B1[2][2];
    const char* cA = (const char*)g.A + (size_t)cur.pm * tstepA; const char* cB = (const char*)g.Bt + (size_t)cur.pn * tstepB;
    S.a_ready(cur);
    if constexpr (SP2) {
        PG8_STAGE(PG8_SB(0, 0), cB, voffB); PG8_STAGE(PG8_SB(0, 1), cB + hstepB, voffB); PG8_STAGE(PG8_SA(0, 0), cA, voffA); PG8_STAGE(PG8_SA(0, 1), cA + hstepA, voffA);
        if (wr == 1) PG8_BAR;
        PG8_WAIT_V(2); PG8_BAR;
        PG8_STAGE(PG8_SB(1, 0), cB + kstep, voffB); PG8_STAGE(PG8_SA(1, 0), cA + kstep, voffA); PG8_STAGE(PG8_SB(1, 1), cB + hstepB + kstep, voffB);
        PG8_WAIT_V(6); PG8_BAR;
    } else {
        PG8_STAGE(PG8_SB(0, 0), cB, voffB); PG8_STAGE(PG8_SA(0, 0), cA, voffA); PG8_STAGE(PG8_SB(0, 1), cB + hstepB, voffB); PG8_STAGE(PG8_SA(0, 1), cA + hstepA, voffA);
        if (wr == 1) PG8_BAR;
        PG8_WAIT_V(4); PG8_BAR;
        PG8_STAGE(PG8_SB(1, 0), cB + kstep, voffB); PG8_STAGE(PG8_SA(1, 0), cA + kstep, voffA); PG8_STAGE(PG8_SB(1, 1), cB + hstepB + kstep, voffB);
        PG8_WAIT_V(6); PG8_BAR;
    }
    for (;;) {
        const bool has_next = S.next(ui + 1, nxt);
        const char* nA = has_next ? (const char*)g.A + (size_t)nxt.pm * tstepA : cA; const char* nB = has_next ? (const char*)g.Bt + (size_t)nxt.pn * tstepB : cB;
        for (int t = 0; t < nt; t += 2) {
            if constexpr (Epi::MID) { if (t == 8 || t == 16) E.mid(acc, cur, wr, wc, fr, fq, (t >> 3) - 1); }
            const bool last = (t == nt - 2);
            const char* a1 = cA + (size_t)(t + 1) * kstep;
            const char* a2 = last ? nA : cA + (size_t)(t + 2) * kstep; const char* b2 = last ? nB : cB + (size_t)(t + 2) * kstep;
            const char* a3 = a2 + kstep; const char* b3 = b2 + kstep;
            if (last && has_next) S.a_ready(nxt);
            if constexpr (SP2) {
            PG8_LDB(B0, 0, 0); PG8_LDB(B1, 0, 1); PG8_SCHED; PG8_LDA(At, 0, 0); PG8_STAGE(PG8_SA(1, 1), a1 + hstepA, voffA);
            PG8_WAIT_V(8); PG8_WAIT_L(0); PG8_BAR; PG8_MMA(0, 0, At, B0); PG8_MMA(0, 1, At, B1); PG8_BAR; PG8_SCHED;
            PG8_LDA(At, 0, 1); PG8_STAGE(PG8_SB(0, 0), b2, voffB); PG8_STAGE(PG8_SB(0, 1), b2 + hstepB, voffB); PG8_STAGE(PG8_SA(0, 0), a2, voffA);
            PG8_WAIT_V(8); PG8_WAIT_L(0); PG8_BAR; PG8_MMA(1, 0, At, B0); PG8_MMA(1, 1, At, B1); PG8_BAR; PG8_SCHED;
            PG8_LDB(B0, 1, 0); PG8_LDB(B1, 1, 1); PG8_SCHED; PG8_LDA(At, 1, 0); PG8_STAGE(PG8_SA(0, 1), a2 + hstepA, voffA);
            PG8_WAIT_V(8); PG8_WAIT_L(0); PG8_BAR; PG8_MMA(0, 0, At, B0); PG8_MMA(0, 1, At, B1); PG8_BAR; PG8_SCHED;
            PG8_LDA(At, 1, 1); PG8_STAGE(PG8_SB(1, 0), b3, voffB); PG8_STAGE(PG8_SB(1, 1), b3 + hstepB, voffB); PG8_STAGE(PG8_SA(1, 0), a3, voffA);
            PG8_WAIT_V(8); PG8_WAIT_L(0); PG8_BAR; PG8_MMA(1, 0, At, B0); PG8_MMA(1, 1, At, B1); PG8_BAR; PG8_SCHED;
            } else {
            PG8_LDB(B0, 0, 0); PG8_SCHED; PG8_LDA(At, 0, 0); PG8_STAGE(PG8_SA(1, 1), a1 + hstepA, voffA);
            PG8_WAIT_L(8); PG8_BAR; PG8_WAIT_L(0); PG8_MMA(0, 0, At, B0); PG8_BAR; PG8_SCHED;
            PG8_LDB(B1, 0, 1); PG8_STAGE(PG8_SB(0, 0), b2, voffB);
            PG8_BAR; PG8_WAIT_L(0); PG8_MMA(0, 1, At, B1); PG8_BAR;
            PG8_LDA(At, 0, 1); PG8_STAGE(PG8_SA(0, 0), a2, voffA);
            PG8_BAR; PG8_WAIT_L(0); PG8_MMA(1, 0, At, B0); PG8_BAR; PG8_SCHED;
            PG8_STAGE(PG8_SB(0, 1), b2 + hstepB, voffB);
            PG8_WAIT_V(6); PG8_BAR; PG8_MMA(1, 1, At, B1); PG8_BAR;
            PG8_LDB(B0, 1, 0); PG8_SCHED; PG8_LDA(At, 1, 0); PG8_STAGE(PG8_SA(0, 1), a2 + hstepA, voffA);
            PG8_WAIT_L(8); PG8_BAR; PG8_WAIT_L(0); PG8_MMA(0, 0, At, B0); PG8_BAR; PG8_SCHED;
            PG8_LDB(B1, 1, 1); PG8_STAGE(PG8_SB(1, 0), b3, voffB);
            PG8_BAR; PG8_WAIT_L(0); PG8_MMA(0, 1, At, B1); PG8_BAR;
            PG8_LDA(At, 1, 1); PG8_STAGE(PG8_SA(1, 0), a3, voffA);
            PG8_BAR; PG8_WAIT_L(0); PG8_MMA(1, 0, At, B0); PG8_BAR; PG8_SCHED;
            PG8_STAGE(PG8_SB(1, 1), b3 + hstepB, voffB);
            PG8_WAIT_V(6); PG8_BAR; PG8_MMA(1, 1, At, B1); PG8_BAR;
            }
        }
        if constexpr (ALIGN_EPI) { if (wr == 0) PG8_BAR; }
        if constexpr (!Epi::AFTER_DRAIN) { E(acc, cur, wr, wc, fr, fq); S.done(cur); }
        if (!has_next) break;
#pragma unroll
        for (int a = 0; a < 2; ++a)
#pragma unroll
            for (int b = 0; b < 2; ++b)
#pragma unroll
                for (int m = 0; m < 4; ++m)
#pragma unroll
                    for (int n = 0; n < 2; ++n) acc[a][b][m][n] = (f32x4){0.f, 0.f, 0.f, 0.f};
        cur = nxt; cA = nA; cB = nB; ++ui;
        if constexpr (ALIGN_EPI) { if (wr == 1) PG8_BAR; }
    }
    PG8_WAIT_V(0);
    if constexpr (!ALIGN_EPI) { if (wr == 0) PG8_BAR; }
    PG8_BAR;
    if constexpr (Epi::AFTER_DRAIN) { E.fused(acc, cur, wr, wc, fr, fq, lds, wid, lane); S.done(cur); }
#undef PG8_SA
#undef PG8_SB
#undef PG8_STAGE
#undef PG8_LDA
#undef PG8_LDB
#undef PG8_MMA
#undef PG8_WAIT_V
#undef PG8_WAIT_L
#undef PG8_BAR
#undef PG8_SCHED
}
}

constexpr int NB = 4, SEQ = 4096, DM = 1024, DEPTH = 4, M = NB * SEQ;
constexpr int INC = 7088;
constexpr int NIN = 7168;
constexpr int FFH = 2816, FF2 = 5632;
constexpr int ZP = pg8::ZP, ZSP = pg8::ZSP;
constexpr int Z_FQ = 0, Z_DQ = 512, Z_RV = 1024, Z_FK = 1536, Z_FV = 2048,
     Z_RQ = 2560, Z_RK = 2816, Z_RG = 3072, Z_ZG = 3584, Z_MRG = 2560;
constexpr int S_IQ = 0, S_DK = 256, S_DV = 320, S_IK = 384, S_IW = 416, S_FF = 424;
constexpr float NORM_EPS = 1e-6f;
constexpr float LOG2E = 1.4426950408889634f;
constexpr float C2 = 0.125f * 1.4426950408889634f;

constexpr size_t MiB = 1u << 20;
constexpr size_t WS_CTL = 0, CTL_ZERO_BYTES = 1 * MiB;
constexpr size_t WS_ROPE64 = 1 * MiB;
constexpr size_t WS_ROPE32 = 2 * MiB;
constexpr size_t WS_LF = 2 * MiB + 512 * 1024;
constexpr size_t WS_CF = 3 * MiB;
constexpr size_t WS_ISG = 3 * MiB + 512 * 1024;
constexpr size_t WS_KD = 4 * MiB;
constexpr size_t WS_VD = 6 * MiB;
constexpr size_t WS_W = 8 * MiB;
constexpr size_t LW_IN = 0, LW_MIX = (size_t)NIN * 1024, LW_O = LW_MIX + 1536 * 1024, LW_FI = LW_O + 1024 * 1024, LW_FO = LW_FI + (size_t)FF2 * 1024, LW_STRIDE = LW_FO + (size_t)FFH * 1024;
constexpr size_t WS_Z = 150 * MiB;
constexpr size_t WS_HDN = 358 * MiB;
constexpr size_t WS_ZS = 390 * MiB;
constexpr size_t WS_IQB = 422 * MiB;
constexpr size_t WS_IKB = 430 * MiB;
constexpr size_t WS_SS = 431 * MiB;
constexpr size_t WS_END = 432 * MiB;
static_assert(WS_W + DEPTH * LW_STRIDE * 2 <= WS_Z && WS_Z + (size_t)M * ZP * 2 <= WS_HDN && WS_HDN + (size_t)M * 1024 * 2 == WS_ZS && WS_ZS + (size_t)M * ZSP * 4 == WS_IQB, "d_ws map");
constexpr int CW_BAR = 4096;

constexpr int RING_OFF = 0, RING_BYTES = 133120;
constexpr int LDSCTL_OFF = RING_BYTES, MISC_OFF = LDSCTL_OFF + 320;
constexpr int XTRA_OFF = RING_BYTES + 1024;
constexpr int LDS_BYTES = 147456;
constexpr int NWAVES = 8;
#define GAS __attribute__((address_space(1)))
#define LAS __attribute__((address_space(3)))
typedef unsigned short bf16;
typedef unsigned v4u __attribute__((ext_vector_type(4)));
typedef float f32x4 __attribute__((ext_vector_type(4)));
typedef short bf16x8 __attribute__((ext_vector_type(8)));
typedef GAS unsigned gu32;
typedef GAS unsigned long long gu64;
#define RLX_AGENT __ATOMIC_RELAXED, __HIP_MEMORY_SCOPE_AGENT
#define LDS_WAIT() asm volatile("s_waitcnt lgkmcnt(0)" ::: "memory")
#define VM_WAIT() asm volatile("s_waitcnt vmcnt(0)" ::: "memory")
__device__ __forceinline__ unsigned long long rt() { return __builtin_amdgcn_s_memrealtime(); }
__device__ __forceinline__ unsigned f2bf(float f) { unsigned u = __builtin_bit_cast(unsigned, f); return (u + 0x7fffu + ((u >> 16) & 1u)) >> 16; }
__device__ __forceinline__ unsigned pk2(float lo, float hi) { unsigned r; asm("v_cvt_pk_bf16_f32 %0, %1, %2" : "=v"(r) : "v"(lo), "v"(hi)); return r; }

#define XB_TMO      128
#define XB_XCNT(j)  (256  + 64 * (j))
#define XB_XSUB(j)  (1280 + 64 * (j))
#define XB_XGEN(j)  (2304 + 64 * (j))
#define XB_TOP      3328
#define XB_TOPGEN   3392
#define XCD_BAR_WORDS 3456
#define XB_SPIN_CAP (1u << 22)

__device__ __forceinline__ unsigned xb_ld(unsigned* p)              { return __hip_atomic_load(p, __ATOMIC_RELAXED, __HIP_MEMORY_SCOPE_AGENT); }
__device__ __forceinline__ unsigned xb_add(unsigned* p, unsigned v) { return __hip_atomic_fetch_add(p, v, __ATOMIC_RELAXED, __HIP_MEMORY_SCOPE_AGENT); }
__device__ __forceinline__ unsigned xb_xcc_id() { return (unsigned)__builtin_amdgcn_s_getreg((3 << 11) | 20) & 0xFu; }
#define XB_SPIN(cond, bar) do { unsigned _sp = 0; while (cond) { __builtin_amdgcn_s_sleep(1); \
    if ((++_sp & 255u) == 0u) { if (xb_ld(&(bar)[XB_TMO])) break; if (_sp > XB_SPIN_CAP) { atomicAdd(&(bar)[XB_TMO], 1u); break; } } } } while (0)

struct XcdBarrier {
    unsigned* bar; unsigned x; int w;
    volatile LAS unsigned* st;
};

__device__ __forceinline__ XcdBarrier xcd_barrier_post(unsigned* bar, volatile LAS unsigned* st) {
    XcdBarrier b; b.bar = bar; b.x = xb_xcc_id(); b.st = st; b.w = 0;
    if (threadIdx.x == 0) (void)xb_add(&bar[XB_XCNT(b.x)], 1u);
    return b;
}
__device__ __forceinline__ void xcd_barrier_complete(unsigned* bar, unsigned x, unsigned& nloc, unsigned& nx) {
    const unsigned G = gridDim.x * gridDim.y * gridDim.z;
    unsigned sum, cnt, mine, sp = 0u;
    for (;;) {
        sum = 0u; cnt = 0u; mine = 0u;
#pragma unroll
        for (unsigned j = 0; j < 16; ++j) { const unsigned c = xb_ld(&bar[XB_XCNT(j)]); sum += c; cnt += (c > 0u) ? 1u : 0u; mine = (j == x) ? c : mine; }
        if (sum == G) break;
        __builtin_amdgcn_s_sleep(1);
        if ((++sp & 255u) == 0u) { if (xb_ld(&bar[XB_TMO])) break; if (sp > XB_SPIN_CAP) { atomicAdd(&bar[XB_TMO], 1u); break; } }
    }
    nloc = mine > 0u ? mine : 1u; nx = cnt > 0u ? cnt : 1u;
}

__device__ __forceinline__ void xcd_barrier(const XcdBarrier& b) {
    asm volatile("s_waitcnt vmcnt(0)" ::: "memory");
    __syncthreads();
    if (b.w == 0 && lane_id_v() == 0) {
        unsigned* bar = b.bar;
        __builtin_amdgcn_s_waitcnt(0);
        unsigned nloc = b.st[0], nx = b.st[1];
        if (nloc == 0u) { xcd_barrier_complete(bar, b.x, nloc, nx); b.st[0] = nloc; b.st[1] = nx; }
        const unsigned old = xb_add(&bar[XB_XSUB(b.x)], 1u);
        const unsigned gen = old / nloc;
        if (old + 1u == (gen + 1u) * nloc) {
            __builtin_amdgcn_fence(__ATOMIC_RELEASE, "agent");
            asm volatile("s_waitcnt vmcnt(0)" ::: "memory");
            const unsigned og = xb_add(&bar[XB_TOP], 1u);
            const unsigned tg = og / nx;
            if (og + 1u == (tg + 1u) * nx) xb_add(&bar[XB_TOPGEN], 1u);
            else XB_SPIN(xb_ld(&bar[XB_TOPGEN]) == tg, bar);
            __builtin_amdgcn_fence(__ATOMIC_ACQUIRE, "agent");
            xb_add(&bar[XB_XGEN(b.x)], 1u);
            asm volatile("s_waitcnt vmcnt(0)" ::: "memory");
        } else {
            XB_SPIN(xb_ld(&bar[XB_XGEN(b.x)]) == gen, bar);
            __builtin_amdgcn_fence(__ATOMIC_ACQUIRE, "agent");
            asm volatile("s_waitcnt vmcnt(0)" ::: "memory");
        }
    }
    __syncthreads();
}

typedef float f32x2 __attribute__((ext_vector_type(2)));
typedef unsigned u32x2 __attribute__((ext_vector_type(2)));
__device__ __forceinline__ float bflo(unsigned w) { return __builtin_bit_cast(float, w << 16); }
__device__ __forceinline__ float bfhi(unsigned w) { return __builtin_bit_cast(float, w & 0xffff0000u); }
__device__ __forceinline__ float bf2f(bf16 v) { return __builtin_bit_cast(float, (unsigned)v << 16); }
__device__ __forceinline__ void unpack8(const v4u w, float (&f)[8]) { f[0] = bflo(w.x); f[1] = bfhi(w.x); f[2] = bflo(w.y); f[3] = bfhi(w.y); f[4] = bflo(w.z); f[5] = bfhi(w.z); f[6] = bflo(w.w); f[7] = bfhi(w.w); }
__device__ __forceinline__ v4u pack8(const float (&f)[8]) { v4u w; w.x = pk2(f[0], f[1]); w.y = pk2(f[2], f[3]); w.z = pk2(f[4], f[5]); w.w = pk2(f[6], f[7]); return w; }
__device__ __forceinline__ float xor32(float v, int lane) {
    return __builtin_bit_cast(float, __builtin_amdgcn_ds_bpermute((lane ^ 32) << 2, __builtin_bit_cast(int, v)));
}
__device__ __forceinline__ float sigmoid_f(float x) { return 1.0f / (1.0f + __expf(-x)); }

struct Ctx {
    LAS unsigned char* lds;
    int tid, lane, wave, G, gw, NGW;
    float* out; unsigned char* ws;
};

__device__ __forceinline__ void conv_item(const float* W, int N, int sc, int nv, int k0, bf16* WT, int ldw, int dr, LAS float* scr, int lane) {
    const int n_ = lane & 31;
#pragma unroll 8
    for (int i = 0; i < 32; ++i) { const int kk = 2 * i + (lane >> 5); scr[kk * 33 + n_] = (n_ < nv) ? W[(size_t)(k0 + kk) * N + sc + n_] : 0.f; }
    LDS_WAIT(); asm volatile("" ::: "memory");
    const int c = lane & 7;
#pragma unroll
    for (int j = 0; j < 4; ++j) { const int n = (lane >> 3) + 8 * j; const LAS float* s = scr + (8 * c) * 33 + n;
        v4u o; o.x = pk2(s[0 * 33], s[1 * 33]); o.y = pk2(s[2 * 33], s[3 * 33]); o.z = pk2(s[4 * 33], s[5 * 33]); o.w = pk2(s[6 * 33], s[7 * 33]);
        if (n < nv) *(GAS v4u*)(WT + (size_t)(dr + n) * ldw + k0 + 8 * c) = o; }
    LDS_WAIT(); asm volatile("" ::: "memory");
}
__device__ const int SEG_IN[15][3] = {
    {0, Z_FQ, 512}, {512, Z_FK, 512}, {1024, Z_FV, 512}, {1536, 6656 + S_FF, 8}, {1544, Z_DQ, 512}, {2056, 6656 + S_DK, 64}, {2120, 6656 + S_DV, 64},
    {2184, 6656 + S_IQ, 256}, {2440, 6656 + S_IK, 32}, {2472, 6656 + S_IW, 8}, {2480, Z_RQ, 256}, {2736, Z_RK, 256}, {2992, Z_RV, 512}, {3504, Z_RG, 512}, {4016, Z_ZG, 3072}};
constexpr int IN_BLK = 223;
constexpr int IT_IN = 16 * IN_BLK, IT_MIX = 8 * 32, IT_O = 16 * 32, IT_FI = 16 * (FF2 / 32), IT_FO = (FFH / 64) * 32;
constexpr int IT_LAYER = IT_IN + 3 * IT_MIX + IT_O + IT_FI + IT_FO;

__device__ __forceinline__ void sincos_acc(float ang, float& c, float& s) {
    const double a = (double)ang;
    const double k = __builtin_rint(a * 0.6366197723675814);
    double y = a - k * 1.5707963267948966; y -= k * 6.123233995736766e-17;
    const double y2 = y * y;
    double sp = -7.647163731819816e-13; sp = sp * y2 + 1.6059043836821613e-10; sp = sp * y2 - 2.505210838544172e-08; sp = sp * y2 + 2.7557319223985893e-06; sp = sp * y2 - 1.984126984126984e-04; sp = sp * y2 + 8.333333333333333e-03; sp = sp * y2 - 1.6666666666666666e-01;
    const double sn = y + y * y2 * sp;
    double cp = 4.779477332387385e-14; cp = cp * y2 - 1.1470745597729725e-11; cp = cp * y2 + 2.08767569878681e-09; cp = cp * y2 - 2.755731922398589e-07; cp = cp * y2 + 2.48015873015873e-05; cp = cp * y2 - 1.388888888888889e-03; cp = cp * y2 + 4.1666666666666664e-02; cp = cp * y2 - 0.5;
    const double cs = 1.0 + y2 * cp;
    const int q = ((int)k) & 3;
    const double ss = (q & 1) ? cs : sn, cc = (q & 1) ? sn : cs;
    s = (float)((q & 2) ? -ss : ss);
    c = (float)(((q + 1) & 2) ? -cc : cc);
}

__device__ __forceinline__ void p0_prologue(const Ctx& F, const float* w_in, const float* w_fox, const float* w_dsa, const float* w_ret, const float* w_o, const float* w_fi, const float* w_fo) {
    LAS float* scr = (LAS float*)(F.lds + RING_OFF + F.wave * 16384);
    bf16* Wb = (bf16*)(F.ws + WS_W);
    for (int it = F.gw; it < DEPTH * IT_LAYER; it += F.NGW) {
        const int l = it / IT_LAYER; int r = it % IT_LAYER;
        bf16* L = Wb + (size_t)l * LW_STRIDE;
        if (r < IT_IN) {
            const int kb = r / IN_BLK; int blk = r % IN_BLK; int sc = 0, dr = 0, nv = 0;
            for (int s = 0; s < 15; ++s) { const int w = SEG_IN[s][2], nb = (w + 31) >> 5; if (blk < nb) { sc = SEG_IN[s][0] + 32 * blk; dr = SEG_IN[s][1] + 32 * blk; nv = (w - 32 * blk) < 32 ? (w - 32 * blk) : 32;
                if (s == 0 || s == 1 || s == 4) { const int hd = blk >> 1; dr = SEG_IN[s][1] + (hd >> 2) * 256 + 128 * (blk & 1) + 32 * (hd & 3); }
                break; } blk -= nb; }
            conv_item(w_in + (size_t)l * DM * INC, INC, sc, nv, 64 * kb, L + LW_IN, 1024, dr, scr, F.lane); continue; }
        r -= IT_IN;
        if (r < 3 * IT_MIX) { const int w = r / IT_MIX, q = r % IT_MIX, kb = q / 32, nb = q % 32;
            conv_item((w == 0 ? w_fox : w == 1 ? w_dsa : w_ret) + (size_t)l * 512 * DM, DM, 32 * nb, 32, 64 * kb, L + LW_MIX + (size_t)w * 512, 1536, 32 * nb, scr, F.lane); continue; }
        r -= 3 * IT_MIX;
        if (r < IT_O) { const int kb = r / 32, nb = r % 32;
            conv_item(w_o + (size_t)l * DM * DM, DM, 32 * nb, 32, 64 * kb, L + LW_O, 1024, 32 * nb, scr, F.lane); continue; }
        r -= IT_O;
        if (r < IT_FI) { const int kb = r / (FF2 / 32), nb = r % (FF2 / 32); const int n0 = 32 * nb;
            const int j = n0 < FFH ? n0 : n0 - FFH; const int dr = 256 * (j >> 7) + (j & 127) + (n0 < FFH ? 0 : 128);
            conv_item(w_fi + (size_t)l * DM * FF2, FF2, n0, 32, 64 * kb, L + LW_FI, 1024, dr, scr, F.lane); continue; }
        r -= IT_FI;
        { const int kb = r / 32, nb = r % 32;
            conv_item(w_fo + (size_t)l * FFH * DM, DM, 32 * nb, 32, 64 * kb, L + LW_FO, FFH, 32 * nb, scr, F.lane); }
    }
    for (int i = F.gw * 64 + F.lane; i < DEPTH * 80 * 128; i += F.NGW * 64) { const int l = i / (80 * 128), q = i % (80 * 128);
        *(GAS v4u*)(Wb + (size_t)l * LW_STRIDE + LW_IN + (size_t)INC * 1024 + (size_t)q * 8) = (v4u){0u, 0u, 0u, 0u}; }
    f32x2* R64 = (f32x2*)(F.ws + WS_ROPE64); f32x2* R32 = (f32x2*)(F.ws + WS_ROPE32);
    for (int i = F.gw * 64 + F.lane; i < SEQ * 32; i += F.NGW * 64) { const int pos = i >> 5, k = i & 31;
        double f = 1.0; for (int e = 0; e < k; ++e) f *= 0.7498942093324559;
        const float ang = (float)pos * (float)f; float c, s; sincos_acc(ang, c, s); R64[i] = (f32x2){c, s}; }
    for (int i = F.gw * 64 + F.lane; i < SEQ * 16; i += F.NGW * 64) { const int pos = i >> 4, k = i & 15;
        double f = 1.0; for (int e = 0; e < k; ++e) f *= 0.5623413251903491;
        const float ang = (float)pos * (float)f; float c, s; sincos_acc(ang, c, s); R32[i] = (f32x2){c, s}; }
}

__device__ __forceinline__ void norm0_phase(const Ctx& F, const float* x, const float* g, bf16* o, float* SS) {
    const GAS f32x4* gp = (const GAS f32x4*)g + F.lane;
    f32x4 gv[4];
#pragma unroll
    for (int j = 0; j < 4; ++j) gv[j] = gp[64 * j];
    for (int m = F.gw; m < M; m += F.NGW) {
        const GAS f32x4* xr = (const GAS f32x4*)(x + (size_t)m * DM) + F.lane;
        f32x4 v[4]; float s = 0.f;
#pragma unroll
        for (int j = 0; j < 4; ++j) { v[j] = xr[64 * j]; s += (v[j].x * v[j].x + v[j].y * v[j].y) + (v[j].z * v[j].z + v[j].w * v[j].w); }
        s = wave_sum(s);
        GAS unsigned long long* o8 = (GAS unsigned long long*)(o + (size_t)m * DM) + F.lane;
#pragma unroll
        for (int j = 0; j < 4; ++j) o8[64 * j] = (unsigned long long)pk2(v[j].x * gv[j].x, v[j].y * gv[j].y) | ((unsigned long long)pk2(v[j].z * gv[j].z, v[j].w * gv[j].w) << 32);
        if (F.lane < 4) SS[(size_t)m * 4 + F.lane] = (F.lane == 0) ? s : 0.f;
    }
}

__device__ __forceinline__ void post_phase(const Ctx& F, const float* g_fq, const float* g_fk, const float* g_dq, const float* g_dk, const float* b_f, bool dummy_out = false) {
    bf16* Z = (bf16*)(F.ws + WS_Z); const float* ZS = (const float*)(F.ws + WS_ZS);
    const f32x2* R64 = (const f32x2*)(F.ws + WS_ROPE64); const f32x2* R32 = (const f32x2*)(F.ws + WS_ROPE32);
    float* LF = (float*)(F.ws + WS_LF); unsigned* ISG = (unsigned*)(F.ws + WS_ISG);
    bf16* KD = (bf16*)(F.ws + WS_KD); bf16* VD = (bf16*)(F.ws + WS_VD); bf16* IQB = (bf16*)(F.ws + WS_IQB); bf16* IKB = (bf16*)(F.ws + WS_IKB);
    const int t0 = blockIdx.x * 512 + F.tid, NT = F.G * 512;
    for (int t = t0; t < M * 8; t += NT) { const int m = t >> 3, h = t & 7; const float* sp = ZS + (size_t)m * ZSP + S_IQ + h * 32;
        f32x4 v[8];
#pragma unroll
        for (int i = 0; i < 8; ++i) v[i] = *(const GAS f32x4*)(sp + 4 * i);
        const float aw = fabsf(ZS[(size_t)m * ZSP + S_IW + h]);
        const f32x2* cs = R32 + (m & (SEQ - 1)) * 16; float f[32];
#pragma unroll
        for (int i = 0; i < 8; ++i) { f[4 * i] = v[i].x; f[4 * i + 1] = v[i].y; f[4 * i + 2] = v[i].z; f[4 * i + 3] = v[i].w; }
#pragma unroll
        for (int d = 0; d < 16; ++d) { const f32x2 tt = cs[d]; const float x1 = f[d], x2 = f[d + 16]; f[d] = (x1 * tt.x - x2 * tt.y) * aw; f[d + 16] = (x2 * tt.x + x1 * tt.y) * aw; }
        bf16* op = IQB + (size_t)m * 256 + h * 32;
#pragma unroll
        for (int i = 0; i < 4; ++i) { float t8[8];
#pragma unroll
            for (int j = 0; j < 8; ++j) t8[j] = f[8 * i + j];
            *(GAS v4u*)(op + 8 * i) = pack8(t8); }
    }
    for (int m = t0; m < M; m += NT) { const float* sr = ZS + (size_t)m * ZSP; const int pos = m & (SEQ - 1);
        { float f[64]; float ss = 0.f;
#pragma unroll
            for (int i = 0; i < 16; ++i) { const f32x4 v = *(const GAS f32x4*)(sr + S_DK + 4 * i); f[4 * i] = v.x; f[4 * i + 1] = v.y; f[4 * i + 2] = v.z; f[4 * i + 3] = v.w; ss += (v.x * v.x + v.y * v.y) + (v.z * v.z + v.w * v.w); }
            const float rs = 1.0f / sqrtf(ss * (1.f / 64) + NORM_EPS); const f32x2* cs = R64 + pos * 32;
#pragma unroll
            for (int d = 0; d < 64; ++d) f[d] = f[d] * rs * g_dk[d];
#pragma unroll
            for (int d = 0; d < 32; ++d) { const f32x2 tt = cs[d]; const float x1 = f[d], x2 = f[d + 32]; f[d] = x1 * tt.x - x2 * tt.y; f[d + 32] = x2 * tt.x + x1 * tt.y; }
#pragma unroll
            for (int i = 0; i < 8; ++i) { float t8[8];
#pragma unroll
                for (int j = 0; j < 8; ++j) t8[j] = f[8 * i + j];
                *(GAS v4u*)(KD + (size_t)m * 64 + 8 * i) = pack8(t8); } }
#pragma unroll
        for (int i = 0; i < 8; ++i) { const f32x4 a = *(const GAS f32x4*)(sr + S_DV + 8 * i), b = *(const GAS f32x4*)(sr + S_DV + 8 * i + 4); const float t8[8] = {a.x, a.y, a.z, a.w, b.x, b.y, b.z, b.w};
            *(GAS v4u*)(VD + (size_t)m * 64 + 8 * i) = pack8(t8); }
        { float f[32]; const f32x2* cs = R32 + pos * 16;
#pragma unroll
            for (int i = 0; i < 8; ++i) { const f32x4 v = *(const GAS f32x4*)(sr + S_IK + 4 * i); f[4 * i] = v.x; f[4 * i + 1] = v.y; f[4 * i + 2] = v.z; f[4 * i + 3] = v.w; }
#pragma unroll
            for (int d = 0; d < 16; ++d) { const f32x2 tt = cs[d]; const float x1 = f[d], x2 = f[d + 16]; f[d] = x1 * tt.x - x2 * tt.y; f[d + 16] = x2 * tt.x + x1 * tt.y; }
#pragma unroll
            for (int i = 0; i < 4; ++i) { float t8[8];
#pragma unroll
                for (int j = 0; j < 8; ++j) t8[j] = f[8 * i + j];
                *(GAS v4u*)(IKB + (size_t)m * 32 + 8 * i) = pack8(t8); } }
        { const f32x4 w0 = *(const GAS f32x4*)(sr + S_IW), w1 = *(const GAS f32x4*)(sr + S_IW + 4); const float iw[8] = {w0.x, w0.y, w0.z, w0.w, w1.x, w1.y, w1.z, w1.w}; unsigned sg = 0;
#pragma unroll
            for (int h = 0; h < 8; ++h) sg |= (iw[h] < 0.f ? 1u : 0u) << h;
            ISG[m] = sg;
            const f32x4 f0 = *(const GAS f32x4*)(sr + S_FF), f1 = *(const GAS f32x4*)(sr + S_FF + 4); const float ff[8] = {f0.x, f0.y, f0.z, f0.w, f1.x, f1.y, f1.z, f1.w}; float lf[8];
#pragma unroll
            for (int h = 0; h < 8; ++h) { const float xx = ff[h] + b_f[h]; lf[h] = (fminf(xx, 0.f) - __logf(1.0f + __expf(-fabsf(xx)))) * LOG2E; }
            *(GAS f32x4*)(LF + (size_t)m * 8) = (f32x4){lf[0], lf[1], lf[2], lf[3]}; *(GAS f32x4*)(LF + (size_t)m * 8 + 4) = (f32x4){lf[4], lf[5], lf[6], lf[7]}; }
    }
}

__device__ __forceinline__ float ret_l2g(int h) { return h == 0 ? -0.04580368961312479f : h == 1 ? -0.02272007650008353f : h == 2 ? -0.011315313227834146f : -0.005646563141142063f; }

__device__ __forceinline__ void scan_state_phase(const Ctx& F) {
    const float* LF = (const float*)(F.ws + WS_LF); float* CF = (float*)(F.ws + WS_CF);
    const bf16* Z = (const bf16*)(F.ws + WS_Z); float* RS = (float*)(F.ws + WS_HDN);
    if (F.gw < 32) {
        const int b = F.gw >> 3, h = F.gw & 7; const float* lp = LF + ((size_t)b * SEQ + F.lane * 64) * 8 + h; float s = 0.f;
        for (int i = 0; i < 64; ++i) s += lp[i * 8];
        float incl = s;
#pragma unroll
        for (int o = 1; o < 64; o <<= 1) { const float t = __builtin_bit_cast(float, __builtin_amdgcn_ds_bpermute(((F.lane - o) & 63) << 2, __builtin_bit_cast(int, incl))); if (F.lane >= o) incl += t; }
        float run = incl - s; float* cp = CF + (size_t)F.gw * SEQ + F.lane * 64;
        for (int i = 0; i < 64; ++i) { run += lp[i * 8]; cp[i] = run; }
    }
    for (int u = blockIdx.x; u < NB * 32 * 4; u += F.G) {
        const int h = u & 3, c = (u >> 2) & 31, b = u >> 7; const float l2g = ret_l2g(h);
        const int d = F.tid >> 3, e0 = (F.tid & 7) * 16; float acc[16];
#pragma unroll
        for (int i = 0; i < 16; ++i) acc[i] = 0.f;
        const bf16* base = Z + ((size_t)b * SEQ + c * 128) * ZP;
        for (int j = 0; j < 128; ++j) { const bf16* row = base + (size_t)j * ZP;
            const float kd = bf2f(row[Z_RK + h * 64 + d]) * exp2f((float)(127 - j) * l2g);
            const v4u w0 = *(const GAS v4u*)(row + Z_RV + h * 128 + e0), w1 = *(const GAS v4u*)(row + Z_RV + h * 128 + e0 + 8);
            float v0[8], v1[8]; unpack8(w0, v0); unpack8(w1, v1);
#pragma unroll
            for (int i = 0; i < 8; ++i) { acc[i] += kd * v0[i]; acc[8 + i] += kd * v1[i]; } }
        float* o = RS + (size_t)u * 8192 + d * 128 + e0;
#pragma unroll
        for (int i = 0; i < 4; ++i) *(GAS f32x4*)(o + 4 * i) = (f32x4){acc[4 * i], acc[4 * i + 1], acc[4 * i + 2], acc[4 * i + 3]};
    }
}

__device__ __forceinline__ void ret_out_naive(const Ctx& F, const float* gn) {
    bf16* Z = (bf16*)(F.ws + WS_Z); const float* RS = (const float*)(F.ws + WS_HDN);
    LAS float* S = (LAS float*)(F.lds);
    LAS bf16* Vt = (LAS bf16*)(F.lds + 32768);
    LAS float* Kt = (LAS float*)(F.lds + 65536);
    LAS float* aw = (LAS float*)(F.lds + 65536 + 33280) + F.wave * 128;
    LAS float* qw = (LAS float*)(F.lds + 65536 + 33280 + 4096) + F.wave * 64;
    for (int u = blockIdx.x; u < NB * 32 * 4; u += F.G) {
        const int h = u & 3, c = (u >> 2) & 31, b = u >> 7; const float l2g = ret_l2g(h); const float wch = exp2f(128.f * l2g);
        __syncthreads();
        { float s[16];
#pragma unroll
            for (int i = 0; i < 16; ++i) s[i] = 0.f;
            for (int cp = 0; cp < c; ++cp) { const float* L = RS + ((size_t)((b * 32 + cp) * 4 + h)) * 8192 + F.tid;
#pragma unroll
                for (int i = 0; i < 16; ++i) s[i] = wch * s[i] + L[i * 512]; }
#pragma unroll
            for (int i = 0; i < 16; ++i) S[F.tid + i * 512] = s[i]; }
        const bf16* base = Z + ((size_t)b * SEQ + c * 128) * ZP;
        for (int q = F.tid; q < 2048; q += 512) { const int r = q >> 4, ch = q & 15; *(LAS v4u*)(Vt + r * 128 + ch * 8) = *(const GAS v4u*)(base + (size_t)r * ZP + Z_RV + h * 128 + ch * 8); }
        for (int q = F.tid; q < 128 * 64; q += 512) { const int r = q >> 6, dd = q & 63; Kt[r * 65 + dd] = bf2f(base[(size_t)r * ZP + Z_RK + h * 64 + dd]); }
        __syncthreads();
        for (int i = F.wave; i < 128; i += NWAVES) {
            const size_t m = (size_t)b * SEQ + c * 128 + i; bf16* zr = Z + m * ZP;
            qw[F.lane] = bf2f(zr[Z_RQ + h * 64 + F.lane]);
            LDS_WAIT(); asm volatile("" ::: "memory");
#pragma unroll
            for (int jj = 0; jj < 2; ++jj) { const int j = F.lane + 64 * jj; float a = 0.f;
                if (j <= i) { float dot = 0.f; for (int dd = 0; dd < 64; ++dd) dot += qw[dd] * Kt[j * 65 + dd]; a = dot * exp2f((float)(i - j) * l2g); }
                aw[j] = a; }
            LDS_WAIT(); asm volatile("" ::: "memory");
            float o[2]; const float dq = exp2f((float)(i + 1) * l2g);
#pragma unroll
            for (int ee = 0; ee < 2; ++ee) { const int e = F.lane + 64 * ee; float acc = 0.f;
                for (int j = 0; j <= i; ++j) acc += aw[j] * bf2f(Vt[j * 128 + e]);
                float cr = 0.f; for (int dd = 0; dd < 64; ++dd) cr += qw[dd] * S[dd * 128 + e];
                o[ee] = acc + cr * dq; }
            const float ss = wave_sum(o[0] * o[0] + o[1] * o[1]); const float rstd = 1.0f / sqrtf(ss * (1.f / 128) + NORM_EPS);
#pragma unroll
            for (int ee = 0; ee < 2; ++ee) { const int e = F.lane + 64 * ee; const float rg = bf2f(zr[Z_RG + h * 128 + e]);
                zr[Z_RV + h * 128 + e] = (bf16)f2bf(o[ee] * rstd * gn[h * 128 + e] * rg * sigmoid_f(rg)); }
            LDS_WAIT(); asm volatile("" ::: "memory");
        }
    }
    __syncthreads();
}

__device__ __forceinline__ void fox_naive(const Ctx& F) {
    bf16* Z = (bf16*)(F.ws + WS_Z); const float* CF = (const float*)(F.ws + WS_CF);
    LAS float* sc = (LAS float*)(F.lds + F.wave * 16384);
    const int lane = F.lane;
    int it = 0;
    for (int r0 = 0; r0 < NB * 8 * SEQ; r0 += F.NGW, ++it) {
        const int r = r0 + ((it & 1) ? (F.NGW - 1 - F.gw) : F.gw);
        if (r >= NB * 8 * SEQ) continue;
        const int pos = r & (SEQ - 1), h = (r >> 12) & 7, b = r >> 15;
        const size_t m = (size_t)b * SEQ + pos;
        float qf[64];
        { const bf16* qp = Z + m * ZP + Z_FQ + h * 64;
#pragma unroll
            for (int i = 0; i < 8; ++i) { const v4u w = *(const GAS v4u*)(qp + 8 * i); float t[8]; unpack8(w, t);
#pragma unroll
                for (int j = 0; j < 8; ++j) qf[8 * i + j] = t[j]; } }
        const float* cf = CF + (size_t)(b * 8 + h) * SEQ;
        float mx = -INFINITY;
        for (int kk = lane; kk <= pos; kk += 64) { const bf16* kp = Z + ((size_t)b * SEQ + kk) * ZP + Z_FK + h * 64; float dot = 0.f;
#pragma unroll
            for (int i = 0; i < 8; ++i) { const v4u w = *(const GAS v4u*)(kp + 8 * i); float t[8]; unpack8(w, t);
#pragma unroll
                for (int j = 0; j < 8; ++j) dot += qf[8 * i + j] * t[j]; }
            const float s = dot - cf[kk]; sc[kk] = s; mx = fmaxf(mx, s); }
        mx = wave_max(mx);
        float sum = 0.f;
        for (int kk = lane; kk <= pos; kk += 64) { const float p = exp2f(sc[kk] - mx); sc[kk] = p; sum += p; }
        sum = wave_sum(sum);
        LDS_WAIT(); asm volatile("" ::: "memory");
        const bf16* vp = Z + (size_t)b * SEQ * ZP + Z_FV + h * 64 + lane;
        float o0 = 0.f, o1 = 0.f, o2 = 0.f, o3 = 0.f; int kk = 0;
        for (; kk + 3 <= pos; kk += 4) { o0 += sc[kk] * bf2f(vp[(size_t)kk * ZP]); o1 += sc[kk + 1] * bf2f(vp[(size_t)(kk + 1) * ZP]); o2 += sc[kk + 2] * bf2f(vp[(size_t)(kk + 2) * ZP]); o3 += sc[kk + 3] * bf2f(vp[(size_t)(kk + 3) * ZP]); }
        for (; kk <= pos; ++kk) o0 += sc[kk] * bf2f(vp[(size_t)kk * ZP]);
        Z[m * ZP + Z_FQ + h * 64 + lane] = (bf16)f2bf(((o0 + o1) + (o2 + o3)) / sum);
        LDS_WAIT(); asm volatile("" ::: "memory");
    }
}

__device__ __forceinline__ unsigned f2key(float s) { const unsigned u = __builtin_bit_cast(unsigned, s + 0.0f); return (u & 0x80000000u) ? ~u : (u | 0x80000000u); }
__device__ __forceinline__ void dsa_naive(const Ctx& F) {
    bf16* Z = (bf16*)(F.ws + WS_Z); const float* ZS = (const float*)(F.ws + WS_ZS);
    const unsigned* ISG = (const unsigned*)(F.ws + WS_ISG);
    const bf16* KD = (const bf16*)(F.ws + WS_KD); const bf16* VD = (const bf16*)(F.ws + WS_VD);
    LAS unsigned* kl = (LAS unsigned*)(F.lds + F.wave * 16384);
    LAS float* iqs = (LAS float*)(F.lds + XTRA_OFF + F.wave * 1536);
    const int lane = F.lane;
    int it = 0;
    for (int r0 = 0; r0 < M; r0 += F.NGW, ++it) {
        const int r = r0 + ((it & 1) ? (F.NGW - 1 - F.gw) : F.gw);
        if (r >= M) continue;
        const int pos = r & (SEQ - 1), b = r >> 12; const size_t m = (size_t)r;
        *(LAS f32x4*)(iqs + 4 * lane) = *(const GAS f32x4*)(ZS + m * ZSP + S_IQ + 4 * lane);
        const unsigned sg = ISG[m];
        LDS_WAIT(); asm volatile("" ::: "memory");
        for (int kk = lane; kk <= pos; kk += 64) { const float* ikp = ZS + ((size_t)b * SEQ + kk) * ZSP + S_IK; float ik[32];
#pragma unroll
            for (int i = 0; i < 8; ++i) { const f32x4 t = *(const GAS f32x4*)(ikp + 4 * i); ik[4 * i] = t.x; ik[4 * i + 1] = t.y; ik[4 * i + 2] = t.z; ik[4 * i + 3] = t.w; }
            float s = 0.f;
#pragma unroll 1
            for (int h = 0; h < 8; ++h) { float dot = 0.f;
#pragma unroll
                for (int dd = 0; dd < 32; ++dd) dot += iqs[h * 32 + dd] * ik[dd];
                dot = fmaxf(dot, 0.f); s += ((sg >> h) & 1u) ? -dot : dot; }
            kl[kk] = f2key(s); }
        LDS_WAIT(); asm volatile("" ::: "memory");
        unsigned key[64];
#pragma unroll
        for (int j = 0; j < 64; ++j) { const int kk = j * 64 + lane; key[j] = (kk <= pos) ? kl[kk] : 0u; }
        LDS_WAIT(); asm volatile("" ::: "memory");
        LAS unsigned* idx = kl; LAS float* pl = (LAS float*)(kl + 256); LAS bf16* qs = (LAS bf16*)(kl + 512);
        *(LAS v4u*)(qs + 8 * lane) = *(const GAS v4u*)(Z + m * ZP + Z_DQ + 8 * lane);
        unsigned T = 0u; int need = 0;
        if (pos + 1 > 256) {
            for (int bit = 31; bit >= 0; --bit) { const unsigned Tt = T | (1u << bit); int cnt = 0;
#pragma unroll
                for (int j = 0; j < 64; ++j) cnt += __builtin_popcountll(__ballot(key[j] >= Tt));
                if (cnt >= 256) T = Tt; }
            int ngt = 0;
#pragma unroll
            for (int j = 0; j < 64; ++j) ngt += __builtin_popcountll(__ballot(key[j] > T));
            need = 256 - ngt;
        }
        int nsel = 0, eqb = 0;
#pragma unroll
        for (int j = 0; j < 64; ++j) { const bool gt = key[j] > T, eq = (key[j] == T) && (T != 0u);
            const unsigned long long em = __ballot(eq); const int er = eqb + __builtin_amdgcn_mbcnt_hi((unsigned)(em >> 32), __builtin_amdgcn_mbcnt_lo((unsigned)em, 0u));
            const bool sel = gt || (eq && er < need); eqb += __builtin_popcountll(em);
            const unsigned long long sm = __ballot(sel); const int sp = nsel + __builtin_amdgcn_mbcnt_hi((unsigned)(sm >> 32), __builtin_amdgcn_mbcnt_lo((unsigned)sm, 0u));
            if (sel) idx[sp] = (unsigned)(j * 64 + lane); nsel += __builtin_popcountll(sm); }
        LDS_WAIT(); asm volatile("" ::: "memory");
        for (int h = 0; h < 8; ++h) {
            float sv[4]; float mx = -INFINITY;
#pragma unroll
            for (int i = 0; i < 4; ++i) { const int e = lane + 64 * i; sv[i] = -INFINITY;
                if (e < nsel) { const bf16* kp = KD + ((size_t)b * SEQ + idx[e]) * 64; float dot = 0.f;
#pragma unroll
                    for (int c = 0; c < 8; ++c) { const v4u w = *(const GAS v4u*)(kp + 8 * c); float t[8]; unpack8(w, t); const v4u qw = *(const LAS v4u*)(qs + h * 64 + 8 * c); float qq[8]; unpack8(qw, qq);
#pragma unroll
                        for (int j = 0; j < 8; ++j) dot += qq[j] * t[j]; }
                    sv[i] = dot; }
                mx = fmaxf(mx, sv[i]); }
            mx = wave_max(mx); float sum = 0.f;
#pragma unroll
            for (int i = 0; i < 4; ++i) { const int e = lane + 64 * i; const float p = (e < nsel) ? exp2f(sv[i] - mx) : 0.f; pl[e] = p; sum += p; }
            sum = wave_sum(sum);
            LDS_WAIT(); asm volatile("" ::: "memory");
            float o0 = 0.f, o1 = 0.f; int e = 0;
            for (; e + 1 < nsel; e += 2) { o0 += pl[e] * bf2f(VD[((size_t)b * SEQ + idx[e]) * 64 + lane]); o1 += pl[e + 1] * bf2f(VD[((size_t)b * SEQ + idx[e + 1]) * 64 + lane]); }
            if (e < nsel) o0 += pl[e] * bf2f(VD[((size_t)b * SEQ + idx[e]) * 64 + lane]);
            Z[m * ZP + Z_DQ + h * 64 + lane] = (bf16)f2bf((o0 + o1) / sum);
            LDS_WAIT(); asm volatile("" ::: "memory");
        }
    }
}
#ifndef PROBE_D
#define PROBE_D 0
#endif

typedef short s16x8 __attribute__((ext_vector_type(8)));
typedef short s16x4 __attribute__((ext_vector_type(4)));
typedef short v4i16_t __attribute__((ext_vector_type(4)));
__device__ __forceinline__ s16x4 tr16(const LAS unsigned char* p) { return __builtin_bit_cast(s16x4, __builtin_amdgcn_ds_read_tr16_b64_v4i16((LAS v4i16_t*)p)); }
__device__ __forceinline__ float key2f(unsigned k) { return __builtin_bit_cast(float, (k & 0x80000000u) ? (k & 0x7fffffffu) : ~k); }

template <int NR> __device__ __forceinline__ int dsa_count_ge(const unsigned (&key)[64], unsigned T) {
    int c = 0;
#pragma unroll
    for (int j = 0; j < NR; ++j) c += __builtin_popcountll(__ballot(key[j] >= T));
    return c;
}
#define DSA_COUNT_GE(T_, out_) do { if (nq == 1) out_ = dsa_count_ge<16>(key, (T_)); else if (nq == 2) out_ = dsa_count_ge<32>(key, (T_)); else if (nq == 3) out_ = dsa_count_ge<48>(key, (T_)); else out_ = dsa_count_ge<64>(key, (T_)); } while (0)
__device__ __forceinline__ void dsa_select(const unsigned (&key)[64], int nvalid, unsigned& T, int& need) {
    const int nq = __builtin_amdgcn_readfirstlane((nvalid + 1023) >> 10);
    T = 0u; need = 0;
    if (nvalid <= 256) return;
    unsigned kmax = 0u;
#pragma unroll
    for (int j = 0; j < 64; ++j) kmax = key[j] > kmax ? key[j] : kmax;
#pragma unroll
    for (int o_ = 0; o_ < 1; ++o_) { unsigned t; t = sxu<1>(kmax); kmax = t > kmax ? t : kmax; t = sxu<2>(kmax); kmax = t > kmax ? t : kmax; t = sxu<4>(kmax); kmax = t > kmax ? t : kmax; t = sxu<8>(kmax); kmax = t > kmax ? t : kmax; t = sxu<16>(kmax); kmax = t > kmax ? t : kmax;
        unsigned a_, b_; swap32(kmax, a_, b_); kmax = a_ > b_ ? a_ : b_; }
    unsigned lo = 1u, hi = kmax + 1u; int hic = 0;
    { const float vm = fabsf(key2f(kmax)) + 1.0f; unsigned l2 = f2key(-vm * 64.0f); int c; DSA_COUNT_GE(l2, c); if (c >= 256) lo = l2; }
    int iter = 0; bool exact = false;
    while (hi - lo > 1u) {
        unsigned mid;
        if (iter < 24 && lo > 1u) { const float mv = 0.5f * key2f(lo) + 0.5f * key2f(hi - 1u); mid = f2key(mv); }
        else mid = lo + ((hi - lo) >> 1);
        if (mid <= lo) mid = lo + 1u; if (mid >= hi) mid = hi - 1u;
        int c; DSA_COUNT_GE(mid, c);
        if (c == 256) { T = mid; exact = true; break; }
        if (c > 256) lo = mid; else { hi = mid; hic = c; }
        ++iter;
    }
    if (exact) need = 256; else { T = lo; need = 256 - hic; }
}

__device__ __forceinline__ void dsa_attend(const bf16* zq, bf16* zo, const bf16* KDb, const bf16* VDb, const LAS unsigned short* idx, int nsel, LAS unsigned char* vst, int lane) {
    const int g = lane >> 4, c = lane & 15;
    s16x8 qf[2];
#pragma unroll
    for (int ks = 0; ks < 2; ++ks) { qf[ks] = (s16x8){0, 0, 0, 0, 0, 0, 0, 0}; if (c < 8) qf[ks] = *(const GAS s16x8*)(zq + c * 64 + 32 * ks + 8 * g); }
    f32x4 acc[16];
    v4u vreg[16];
#pragma unroll
    for (int i = 0; i < 16; ++i) { const int pi = lane + 64 * i, r = pi >> 3, c16 = pi & 7; const int id = (r < nsel) ? (int)idx[r] : 0; vreg[i] = *(const GAS v4u*)(VDb + (size_t)id * 64 + c16 * 8); }
#pragma unroll
    for (int tb = 0; tb < 2; ++tb) {
        s16x8 kf[8][2];
#pragma unroll
        for (int tt = 0; tt < 8; ++tt) { const int e = 16 * (8 * tb + tt) + c; const int id = (e < nsel) ? (int)idx[e] : 0; const bf16* kp = KDb + (size_t)id * 64 + 8 * g;
            kf[tt][0] = *(const GAS s16x8*)kp; kf[tt][1] = *(const GAS s16x8*)(kp + 32); }
#pragma unroll
        for (int tt = 0; tt < 8; ++tt) { f32x4 a = (f32x4){0.f, 0.f, 0.f, 0.f};
            a = __builtin_amdgcn_mfma_f32_16x16x32_bf16(kf[tt][0], qf[0], a, 0, 0, 0); a = __builtin_amdgcn_mfma_f32_16x16x32_bf16(kf[tt][1], qf[1], a, 0, 0, 0); acc[8 * tb + tt] = a; }
    }
    float mx = -INFINITY;
#pragma unroll
    for (int t = 0; t < 16; ++t)
#pragma unroll
        for (int i = 0; i < 4; ++i) { const int e = 16 * t + 4 * g + i; if (nsel < 256 && e >= nsel) acc[t][i] = -INFINITY; mx = fmaxf(mx, acc[t][i]); }
    mx = fmaxf(mx, sx<16>(mx)); mx = half_max(mx);
    float sum = 0.f;
#pragma unroll
    for (int t = 0; t < 16; ++t)
#pragma unroll
        for (int i = 0; i < 4; ++i) { const float p = __builtin_amdgcn_exp2f(acc[t][i] - mx); acc[t][i] = p; sum += p; }
    sum += sx<16>(sum); sum = half_sum(sum);
    const float inv = 1.0f / sum;
    s16x8 pf[8];
#pragma unroll
    for (int s = 0; s < 8; ++s) { v4u w; w.x = pk2(acc[2 * s][0] * inv, acc[2 * s][1] * inv); w.y = pk2(acc[2 * s][2] * inv, acc[2 * s][3] * inv); w.z = pk2(acc[2 * s + 1][0] * inv, acc[2 * s + 1][1] * inv); w.w = pk2(acc[2 * s + 1][2] * inv, acc[2 * s + 1][3] * inv);
        pf[s] = __builtin_bit_cast(s16x8, w); }
    f32x4 o[4];
#pragma unroll
    for (int db = 0; db < 4; ++db) o[db] = (f32x4){0.f, 0.f, 0.f, 0.f};
    const int q = (lane >> 2) & 3, p = lane & 3, swz = 2 * (g & 1) + (q >> 1);
    const LAS unsigned char* rb = vst + (4 * g + q) * 128 + 8 * p;
#pragma unroll
    for (int hh = 0; hh < 2; ++hh) {
        asm volatile("s_waitcnt lgkmcnt(0)" ::: "memory");
#pragma unroll
        for (int i = 0; i < 16; ++i) { const int pi = lane + 64 * i, r = pi >> 3, c16 = pi & 7;
            *(LAS v4u*)(vst + r * 128 + ((((c16 >> 1) ^ ((r >> 1) & 3))) << 5) + ((c16 & 1) << 4)) = vreg[i]; }
        if (hh == 0) {
#pragma unroll
            for (int i = 0; i < 16; ++i) { const int pi = lane + 64 * i, r = pi >> 3, c16 = pi & 7, e = 128 + r; const int id = (e < nsel) ? (int)idx[e] : 0; vreg[i] = *(const GAS v4u*)(VDb + (size_t)id * 64 + c16 * 8); } }
        asm volatile("s_waitcnt lgkmcnt(0)" ::: "memory");
#pragma unroll
        for (int s4 = 0; s4 < 4; ++s4)
#pragma unroll
            for (int db = 0; db < 4; ++db) { const LAS unsigned char* a1 = rb + s4 * 4096 + ((db ^ swz) << 5);
                const s16x4 lo = tr16(a1), hi = tr16(a1 + 2048);
                const s16x8 vf = (s16x8){lo[0], lo[1], lo[2], lo[3], hi[0], hi[1], hi[2], hi[3]};
                o[db] = __builtin_amdgcn_mfma_f32_16x16x32_bf16(pf[4 * hh + s4], vf, o[db], 0, 0, 0); }
    }
    if (g < 2) {
#pragma unroll
        for (int db = 0; db < 4; ++db)
#pragma unroll
            for (int i = 0; i < 4; ++i) zo[(4 * g + i) * 64 + 16 * db + c] = (bf16)f2bf(o[db][i]);
    }
}

__device__ __forceinline__ void dsa_v2(const Ctx& F) {
    bf16* Z = (bf16*)(F.ws + WS_Z); const float* ZS = (const float*)(F.ws + WS_ZS);
    const unsigned* ISG = (const unsigned*)(F.ws + WS_ISG);
    const bf16* KD = (const bf16*)(F.ws + WS_KD); const bf16* VD = (const bf16*)(F.ws + WS_VD);
    LAS unsigned* kl = (LAS unsigned*)(F.lds + F.wave * 16384);
    LAS float* iqs = (LAS float*)(F.lds + XTRA_OFF + F.wave * 1536);
    LAS unsigned short* idx = (LAS unsigned short*)(F.lds + XTRA_OFF + F.wave * 1536 + 1024);
    const int lane = F.lane;
    int it = 0;
    for (int r0 = 0; r0 < M; r0 += F.NGW, ++it) {
        const int r = r0 + ((it & 1) ? (F.NGW - 1 - F.gw) : F.gw);
        if (r >= M) continue;
        const int pos = r & (SEQ - 1), b = r >> 12; const size_t m = (size_t)r;
        *(LAS f32x4*)(iqs + 4 * lane) = *(const GAS f32x4*)(ZS + m * ZSP + S_IQ + 4 * lane);
        const unsigned sg = ISG[m];
        LDS_WAIT(); asm volatile("" ::: "memory");
        for (int kk = lane; kk <= pos; kk += 64) { const float* ikp = ZS + ((size_t)b * SEQ + kk) * ZSP + S_IK; float ik[32];
#pragma unroll
            for (int i = 0; i < 8; ++i) { const f32x4 t = *(const GAS f32x4*)(ikp + 4 * i); ik[4 * i] = t.x; ik[4 * i + 1] = t.y; ik[4 * i + 2] = t.z; ik[4 * i + 3] = t.w; }
            float s = 0.f;
#pragma unroll 1
            for (int h = 0; h < 8; ++h) { float dot = 0.f;
#pragma unroll
                for (int dd = 0; dd < 32; ++dd) dot += iqs[h * 32 + dd] * ik[dd];
                dot = fmaxf(dot, 0.f); s += ((sg >> h) & 1u) ? -dot : dot; }
            kl[kk] = f2key(s); }
        LDS_WAIT(); asm volatile("" ::: "memory");
        unsigned key[64];
#pragma unroll
        for (int j = 0; j < 64; ++j) { const int kk = j * 64 + lane; key[j] = (kk <= pos) ? kl[kk] : 0u; }
        LDS_WAIT(); asm volatile("" ::: "memory");
        unsigned T; int need;
#ifdef DSA_OLDSEL
        T = 0u; need = 0;
        if (pos + 1 > 256) {
            for (int bit = 31; bit >= 0; --bit) { const unsigned Tt = T | (1u << bit); int cnt = 0;
#pragma unroll
                for (int j = 0; j < 64; ++j) cnt += __builtin_popcountll(__ballot(key[j] >= Tt));
                if (cnt >= 256) T = Tt; }
            int ngt = 0;
#pragma unroll
            for (int j = 0; j < 64; ++j) ngt += __builtin_popcountll(__ballot(key[j] > T));
            need = 256 - ngt;
        }
#else
        dsa_select(key, pos + 1, T, need);
#endif
        int nsel = 0, eqb = 0;
#pragma unroll
        for (int j = 0; j < 64; ++j) { const bool gt = key[j] > T, eq = (key[j] == T) && (T != 0u);
            const unsigned long long em = __ballot(eq); const int er = eqb + __builtin_amdgcn_mbcnt_hi((unsigned)(em >> 32), __builtin_amdgcn_mbcnt_lo((unsigned)em, 0u));
            const bool sel = gt || (eq && er < need); eqb += __builtin_popcountll(em);
            const unsigned long long sm = __ballot(sel); const int sp = nsel + __builtin_amdgcn_mbcnt_hi((unsigned)(sm >> 32), __builtin_amdgcn_mbcnt_lo((unsigned)sm, 0u));
            if (sel) idx[sp] = (unsigned short)(j * 64 + lane); nsel += __builtin_popcountll(sm); }
        LDS_WAIT(); asm volatile("" ::: "memory");
        dsa_attend(Z + m * ZP + Z_DQ, Z + m * ZP + Z_DQ, KD + (size_t)b * SEQ * 64, VD + (size_t)b * SEQ * 64, idx, nsel, (LAS unsigned char*)kl, lane);
        LDS_WAIT(); asm volatile("" ::: "memory");
    }
}

template <int NR> __device__ __forceinline__ int dsa_emit_n(const unsigned (&key)[64], unsigned T, int need, LAS unsigned short* idx, int lane) {
    int nsel = 0, eqb = 0;
#pragma unroll
    for (int j = 0; j < NR; ++j) { const bool gt = key[j] > T, eq = (key[j] == T) && (T != 0u);
        const unsigned long long em = __ballot(eq); const int er = eqb + __builtin_amdgcn_mbcnt_hi((unsigned)(em >> 32), __builtin_amdgcn_mbcnt_lo((unsigned)em, 0u));
        const bool sel = gt || (eq && er < need); eqb += __builtin_popcountll(em);
        const unsigned long long sm = __ballot(sel); const int sp = nsel + __builtin_amdgcn_mbcnt_hi((unsigned)(sm >> 32), __builtin_amdgcn_mbcnt_lo((unsigned)sm, 0u));
        if (sel) idx[sp] = (unsigned short)(j * 64 + lane); nsel += __builtin_popcountll(sm); }
    return nsel;
}
__device__ __forceinline__ int dsa_emit(const unsigned (&key)[64], int nvalid, unsigned T, int need, LAS unsigned short* idx, int lane) {
    const int nq = __builtin_amdgcn_readfirstlane((nvalid + 1023) >> 10);
    if (nq == 1) return dsa_emit_n<16>(key, T, need, idx, lane);
    if (nq == 2) return dsa_emit_n<32>(key, T, need, idx, lane);
    if (nq == 3) return dsa_emit_n<48>(key, T, need, idx, lane);
    return dsa_emit_n<64>(key, T, need, idx, lane);
}

#define DSA_CNT8(cnt_, k_, o_, T_) asm volatile( \
    "v_cmp_ge_u32_e64 s[60:61], %1, %9\n\tv_cmp_ge_u32_e64 s[62:63], %2, %9\n\tv_cmp_ge_u32_e64 s[64:65], %3, %9\n\tv_cmp_ge_u32_e64 s[66:67], %4, %9\n\t" \
    "v_cmp_ge_u32_e64 s[68:69], %5, %9\n\tv_cmp_ge_u32_e64 s[70:71], %6, %9\n\tv_cmp_ge_u32_e64 s[72:73], %7, %9\n\tv_cmp_ge_u32_e64 s[74:75], %8, %9\n\t" \
    "v_addc_co_u32_e64 %0, s[76:77], 0, %0, s[60:61]\n\tv_addc_co_u32_e64 %0, s[76:77], 0, %0, s[62:63]\n\tv_addc_co_u32_e64 %0, s[76:77], 0, %0, s[64:65]\n\tv_addc_co_u32_e64 %0, s[76:77], 0, %0, s[66:67]\n\t" \
    "v_addc_co_u32_e64 %0, s[76:77], 0, %0, s[68:69]\n\tv_addc_co_u32_e64 %0, s[76:77], 0, %0, s[70:71]\n\tv_addc_co_u32_e64 %0, s[76:77], 0, %0, s[72:73]\n\tv_addc_co_u32_e64 %0, s[76:77], 0, %0, s[74:75]" \
    : "+v"(cnt_) : "v"(k_[o_]), "v"(k_[o_ + 1]), "v"(k_[o_ + 2]), "v"(k_[o_ + 3]), "v"(k_[o_ + 4]), "v"(k_[o_ + 5]), "v"(k_[o_ + 6]), "v"(k_[o_ + 7]), "s"(T_) \
    : "s60", "s61", "s62", "s63", "s64", "s65", "s66", "s67", "s68", "s69", "s70", "s71", "s72", "s73", "s74", "s75", "s76", "s77")
template <int NR> __device__ __forceinline__ int dsa_lane_count(const unsigned (&key)[64], unsigned T) {
    int c = 0; const unsigned Ts = (unsigned)__builtin_amdgcn_readfirstlane((int)T);
#pragma unroll
    for (int j = 0; j < NR; j += 8) DSA_CNT8(c, key, j, Ts);
    return c;
}
#define DSA_LCOUNT(T_, lc_) do { if (nq == 1) lc_ = dsa_lane_count<16>(key, (T_)); else if (nq == 2) lc_ = dsa_lane_count<32>(key, (T_)); else if (nq == 3) lc_ = dsa_lane_count<48>(key, (T_)); else lc_ = dsa_lane_count<64>(key, (T_)); } while (0)
template <int NR> __device__ __forceinline__ void dsa_write_ge(const unsigned (&key)[64], unsigned T, int off, LAS unsigned short* idx, int lane) {
    const int dummy = 256 + lane;
#pragma unroll
    for (int j = 0; j < NR; ++j) { const bool s = key[j] >= T; idx[s ? off : dummy] = (unsigned short)(j * 64 + lane); off += s ? 1 : 0; }
}
__device__ __forceinline__ int dsa_select2(const unsigned (&key)[64], int nvalid, float s1, float s2, LAS unsigned short* idx, int lane) {
    const int nq = __builtin_amdgcn_readfirstlane((nvalid + 1023) >> 10);
    unsigned T = 1u; int lc = 0; bool exact = true;
    if (nvalid > 256) {
        const float n = (float)nvalid, mean = s1 / n, sd = sqrtf(fmaxf(s2 / n - mean * mean, 1e-30f));
        const float pfrac = 256.0f / n, pt = fminf(pfrac, 1.0f - pfrac);
        const float tt = sqrtf(-2.0f * __logf(fmaxf(pt, 1e-6f)));
        float zn = (0.010328f * tt + 0.802853f) * tt + 2.515517f; asm volatile("" : "+v"(zn));
        float zd = ((0.001308f * tt + 0.189269f) * tt + 1.432788f) * tt + 1.0f; asm volatile("" : "+v"(zd));
        float z = tt - zn / zd;
        if (pfrac > 0.5f) z = -z;
        const float dens = n * __expf(-0.5f * z * z) * 0.3989423f / sd;
        unsigned lo = 1u, hi = 0xffffffffu; int clo = nvalid, chi = 0;
        bool lop = false, hip = false; float lastv = mean + z * sd, lastc = 256.0f, grow = 1.3f;
        exact = false; int same = 0, last = 0;
        for (int it = 0; hi - lo > 1u; ++it) {
            unsigned mid;
            if (it == 0) mid = f2key(lastv);
            else if (!(lop && hip)) { lastv = lastv + grow * (lastc - 256.0f) / dens; grow *= 2.0f; mid = f2key(lastv); }
            else if (it < 24 && same < 2) { const float vlo = key2f(lo), vhi = key2f(hi - 1u); mid = f2key(vlo + (vhi - vlo) * (((float)(clo - 256) + 0.5f) / (float)(clo - chi))); }
            else if (it < 48) { mid = f2key(0.5f * key2f(lo) + 0.5f * key2f(hi - 1u)); same = 0; }
            else mid = lo + ((hi - lo) >> 1);
            if (!(mid > lo)) mid = lo + 1u; if (!(mid < hi)) mid = hi - 1u;
            DSA_LCOUNT(mid, lc); const int c = wave_isum(lc); lastc = (float)c; lastv = key2f(mid);
            if (c == 256) { T = mid; exact = true; break; }
            if (c > 256) { lo = mid; clo = c; lop = true; same = (last > 0) ? same + 1 : 0; last = 1; } else { hi = mid; chi = c; hip = true; same = (last < 0) ? same + 1 : 0; last = -1; }
        }
        if (!exact) {
            const int nsel = dsa_emit(key, nvalid, lo, 256 - chi, idx, lane);
            return nsel;
        }
    } else { DSA_LCOUNT(1u, lc); }
    int incl = lc;
#pragma unroll
    for (int o = 1; o < 64; o <<= 1) { const int t = __builtin_amdgcn_ds_bpermute(((lane - o) & 63) << 2, incl); if (lane >= o) incl += t; }
    const int total = __builtin_amdgcn_readlane(incl, 63);
    if (nq == 1) dsa_write_ge<16>(key, T, incl - lc, idx, lane); else if (nq == 2) dsa_write_ge<32>(key, T, incl - lc, idx, lane); else if (nq == 3) dsa_write_ge<48>(key, T, incl - lc, idx, lane); else dsa_write_ge<64>(key, T, incl - lc, idx, lane);
    return total;
}

constexpr int DSA_ROWF = 4100;
__device__ __forceinline__ void dsa_v3(const Ctx& F, int out_col = Z_DQ) {
    bf16* Z = (bf16*)(F.ws + WS_Z);
    const unsigned* ISG = (const unsigned*)(F.ws + WS_ISG);
    const bf16* KD = (const bf16*)(F.ws + WS_KD); const bf16* VD = (const bf16*)(F.ws + WS_VD);
    const bf16* IQB = (const bf16*)(F.ws + WS_IQB); const bf16* IKB = (const bf16*)(F.ws + WS_IKB);
    LAS unsigned* img = (LAS unsigned*)(F.lds);
    LAS unsigned short* idxw = (LAS unsigned short*)(F.lds + XTRA_OFF + F.wave * 1536);
    const int w = F.wave;
    const int v = (int)blockIdx.x;
    if (v < 256)
    for (int ui = 0; ui < 8; ++ui) {
        int lane_ = F.lane; asm volatile("" : "+v"(lane_)); const int lane = lane_, g = lane >> 4, c = lane & 15;
        const int b = v >> 6, k = v & 63; const int pb = 128 * (ui >> 1) + ((ui & 1) ? 127 - k : k);
        const int q0 = pb * 8, kend = q0 + 8, ntile = (kend + 15) >> 4;
        const size_t mb = (size_t)b * SEQ;
#if PROBE_D == 1
        for (int rp_ = 0; rp_ < 2; ++rp_)
#endif
        { s16x8 iqf[4]; float sgn[4]; s16x8 iqc;
          { const int qi = c & 7, hs = c >> 3; const int qq = q0 + qi; const bf16* qp = IQB + (mb + qq) * 256 + 8 * g; const unsigned sg = ISG[mb + qq];
            float cs[8];
#pragma unroll
            for (int e = 0; e < 8; ++e) cs[e] = 0.f;
#pragma unroll
            for (int j = 0; j < 4; ++j) { const int h = 2 * j + hs; iqf[j] = *(const GAS s16x8*)(qp + h * 32); sgn[j] = ((sg >> h) & 1u) ? -1.0f : 1.0f;
                float t8[8]; unpack8(__builtin_bit_cast(v4u, iqf[j]), t8);
#pragma unroll
                for (int e = 0; e < 8; ++e) cs[e] += sgn[j] * t8[e]; }
            iqc = __builtin_bit_cast(s16x8, pack8(cs)); }
          const bf16* ikp = IKB + (mb + c) * 32 + 8 * g;
          float st1 = 0.f, st2 = 0.f;
          s16x8 cur[4], nxt[4];
#pragma unroll
          for (int i = 0; i < 4; ++i) { const int t = w + 8 * i; cur[i] = *(const GAS s16x8*)(ikp + (size_t)512 * (t < ntile ? t : 0)); }
          for (int t0 = w; t0 < ntile; t0 += 32) {
#pragma unroll
            for (int i = 0; i < 4; ++i) { const int t = t0 + 32 + 8 * i; nxt[i] = *(const GAS s16x8*)(ikp + (size_t)512 * (t < ntile ? t : 0)); }
#pragma unroll
            for (int i = 0; i < 4; ++i) { const int t = t0 + 8 * i;
              if (t < ntile) {
                f32x4 sc = __builtin_amdgcn_mfma_f32_16x16x32_bf16(cur[i], iqc, (f32x4){0.f, 0.f, 0.f, 0.f}, 0, 0, 0);
#pragma unroll
                for (int h = 0; h < 4; ++h) { const f32x4 x = __builtin_amdgcn_mfma_f32_16x16x32_bf16(cur[i], iqf[h], (f32x4){0.f, 0.f, 0.f, 0.f}, 0, 0, 0);
#pragma unroll
                    for (int r = 0; r < 4; ++r) sc[r] = __builtin_fmaf(sgn[h], __builtin_fabsf(x[r]), sc[r]); }
#pragma unroll
                for (int r = 0; r < 4; ++r) sc[r] += sx<8>(sc[r]);
                v4u kk; kk.x = f2key(sc[0]); kk.y = f2key(sc[1]); kk.z = f2key(sc[2]); kk.w = f2key(sc[3]);
                if (16 * t + 15 <= q0) {
                    st1 += (sc[0] + sc[1]) + (sc[2] + sc[3]); st2 += (sc[0] * sc[0] + sc[1] * sc[1]) + (sc[2] * sc[2] + sc[3] * sc[3]);
                } else { const int kb = 16 * t + 4 * g, qa = q0 + (c & 7);
                    if (kb + 0 > qa) { kk.x = 0u; sc[0] = 0.f; } if (kb + 1 > qa) { kk.y = 0u; sc[1] = 0.f; } if (kb + 2 > qa) { kk.z = 0u; sc[2] = 0.f; } if (kb + 3 > qa) { kk.w = 0u; sc[3] = 0.f; }
                    st1 += (sc[0] + sc[1]) + (sc[2] + sc[3]); st2 += (sc[0] * sc[0] + sc[1] * sc[1]) + (sc[2] * sc[2] + sc[3] * sc[3]); }
                if (c < 8) *(LAS v4u*)(img + c * DSA_ROWF + 16 * t + 4 * g) = kk; } }
#pragma unroll
            for (int i = 0; i < 4; ++i) cur[i] = nxt[i];
          }
          st1 += sx<16>(st1); st2 += sx<16>(st2); st1 = half_sum(st1); st2 = half_sum(st2);
          if (g == 0 && c < 8) *(LAS f32x2*)(F.lds + XTRA_OFF + w * 1536 + 640 + c * 8) = (f32x2){st1, st2}; }
        __syncthreads();
        const int pos = q0 + w; unsigned key[64];
#pragma unroll
        for (int j = 0; j < 64; ++j) { const int kidx = 64 * j + lane; const unsigned a = img[w * DSA_ROWF + kidx]; key[j] = (kidx <= pos) ? a : 0u; }
        unsigned T; int need; int nsel;
        float rs1 = 0.f, rs2 = 0.f;
#pragma unroll
        for (int ww = 0; ww < 8; ++ww) { const f32x2 t = *(const LAS f32x2*)(F.lds + XTRA_OFF + ww * 1536 + 640 + w * 8); rs1 += t.x; rs2 += t.y; }
        { nsel = dsa_select2(key, pos + 1, rs1, rs2, idxw, lane); (void)T; (void)need; }
        __syncthreads();
#if PROBE_D == 3
        { const size_t m = mb + pos; dsa_attend(Z + m * ZP + Z_DQ, Z + m * ZP + Z_RG, KD + mb * 64, VD + mb * 64, idxw, nsel, F.lds + w * 16384, lane); }
#endif
        { const size_t m = mb + pos; dsa_attend(Z + m * ZP + Z_DQ, Z + m * ZP + out_col, KD + mb * 64, VD + mb * 64, idxw, nsel, F.lds + w * 16384, lane); }
        __syncthreads();
    }
}

__device__ __forceinline__ void ret_rope_frag(const bf16* row, const f32x2* cs, float scale, int g, s16x8 (&f)[2]) {
    const u32x2 a0 = *(const GAS u32x2*)(row + 4 * g), a1 = *(const GAS u32x2*)(row + 16 + 4 * g), b0 = *(const GAS u32x2*)(row + 32 + 4 * g), b1 = *(const GAS u32x2*)(row + 48 + 4 * g);
    const float x1[8] = {bflo(a0.x), bfhi(a0.x), bflo(a0.y), bfhi(a0.y), bflo(a1.x), bfhi(a1.x), bflo(a1.y), bfhi(a1.y)};
    const float x2[8] = {bflo(b0.x), bfhi(b0.x), bflo(b0.y), bfhi(b0.y), bflo(b1.x), bfhi(b1.x), bflo(b1.y), bfhi(b1.y)};
    float o1[8], o2[8];
#pragma unroll
    for (int j = 0; j < 8; ++j) { const f32x2 t = cs[(j < 4 ? 4 * g + j : 16 + 4 * g + (j - 4))]; o1[j] = (x1[j] * t.x - x2[j] * t.y) * scale; o2[j] = (x2[j] * t.x + x1[j] * t.y) * scale; }
    f[0] = __builtin_bit_cast(s16x8, pack8(o1)); f[1] = __builtin_bit_cast(s16x8, pack8(o2));
}
__device__ __forceinline__ s16x8 ret_bfrag(const LAS unsigned char* img, int row0, int eb, int g, int q, int p) {
    const int r1 = row0 + 4 * g + q;
    const LAS unsigned char* a1 = img + r1 * 256 + ((eb ^ (r1 & 7)) << 5) + 8 * p;
    const LAS unsigned char* a2 = img + (r1 + 16) * 256 + ((eb ^ ((r1 + 16) & 7)) << 5) + 8 * p;
    const s16x4 lo = tr16(a1), hi = tr16(a2);
    return (s16x8){lo[0], lo[1], lo[2], lo[3], hi[0], hi[1], hi[2], hi[3]};
}

__device__ __forceinline__ void ret_state_mfma(const Ctx& F) {
    const bf16* Z = (const bf16*)(F.ws + WS_Z); float* RS = (float*)(F.ws + WS_HDN);
    const f32x2* R64 = (const f32x2*)(F.ws + WS_ROPE64);
    LAS unsigned char* Kimg = F.lds; LAS unsigned char* Vimg = F.lds + 16384;
    const int lane = F.lane, g = lane >> 4, c = lane & 15, q = (lane >> 2) & 3, p = lane & 3;
    for (int u = blockIdx.x; u < NB * 32 * 4; u += F.G) {
        const int h = u & 3, ch = (u >> 2) & 31, b = u >> 7; const float l2g = ret_l2g(h);
        const bf16* base = Z + ((size_t)b * SEQ + ch * 128) * ZP;
        __syncthreads();
        for (int t = F.tid; t < 2048; t += 512) { const int r = t >> 4, c16 = t & 15;
            *(LAS v4u*)(Vimg + r * 256 + (((c16 >> 1) ^ (r & 7)) << 5) + ((c16 & 1) << 4)) = *(const GAS v4u*)(base + (size_t)r * ZP + Z_RV + h * 128 + c16 * 8); }
        for (int t = F.tid; t < 1024; t += 512) { const int j = t >> 3, dg = t & 7; const bf16* row = base + (size_t)j * ZP + Z_RK + h * 64;
            const u32x2 a = *(const GAS u32x2*)(row + 4 * dg), bb = *(const GAS u32x2*)(row + 32 + 4 * dg);
            const float x1[4] = {bflo(a.x), bfhi(a.x), bflo(a.y), bfhi(a.y)}, x2[4] = {bflo(bb.x), bfhi(bb.x), bflo(bb.y), bfhi(bb.y)};
            const f32x2* cs = R64 + (ch * 128 + j) * 32 + 4 * dg; const float sc = exp2f((float)(127 - j) * l2g);
            float o1[4], o2[4];
#pragma unroll
            for (int e = 0; e < 4; ++e) { const f32x2 tt = cs[e]; o1[e] = (x1[e] * tt.x - x2[e] * tt.y) * sc; o2[e] = (x2[e] * tt.x + x1[e] * tt.y) * sc; }
            u32x2 w1, w2; w1.x = pk2(o1[0], o1[1]); w1.y = pk2(o1[2], o1[3]); w2.x = pk2(o2[0], o2[1]); w2.y = pk2(o2[2], o2[3]);
            const int sw = (j >> 1) & 3; const int d1 = 4 * dg, d2 = 32 + 4 * dg;
            *(LAS u32x2*)(Kimg + j * 128 + ((((2 * d1) >> 5) ^ sw) << 5) + ((2 * d1) & 31)) = w1;
            *(LAS u32x2*)(Kimg + j * 128 + ((((2 * d2) >> 5) ^ sw) << 5) + ((2 * d2) & 31)) = w2; }
        __syncthreads();
        f32x4 acc[4];
#pragma unroll
        for (int db = 0; db < 4; ++db) acc[db] = (f32x4){0.f, 0.f, 0.f, 0.f};
#pragma unroll
        for (int s = 0; s < 4; ++s) {
            const s16x8 vb = ret_bfrag(Vimg, 32 * s, F.wave, g, q, p);
            const int r1 = 32 * s + 4 * g + q, sw = (r1 >> 1) & 3;
#pragma unroll
            for (int db = 0; db < 4; ++db) { const LAS unsigned char* a1 = Kimg + r1 * 128 + ((db ^ sw) << 5) + 8 * p;
                const s16x4 lo = tr16(a1), hi = tr16(a1 + 2048);
                const s16x8 ka = (s16x8){lo[0], lo[1], lo[2], lo[3], hi[0], hi[1], hi[2], hi[3]};
                acc[db] = __builtin_amdgcn_mfma_f32_16x16x32_bf16(ka, vb, acc[db], 0, 0, 0); }
        }
        float* o = RS + (size_t)u * 8192 + 16 * F.wave + c;
#pragma unroll
        for (int db = 0; db < 4; ++db)
#pragma unroll
            for (int r = 0; r < 4; ++r) o[(16 * db + 4 * g + r) * 128] = acc[db][r];
    }
    __syncthreads();
}

__device__ __forceinline__ void ret_scan(const Ctx& F) {
    const float* RS = (const float*)(F.ws + WS_HDN); float* SC = (float*)(F.ws + WS_HDN + 16 * MiB);
    for (int t = blockIdx.x * 512 + F.tid; t < NB * 4 * 8192; t += F.G * 512) {
        const int el = t & 8191, h = (t >> 13) & 3, b = t >> 15; const float wch = exp2f(128.f * ret_l2g(h)); float s = 0.f;
        float L[32];
#pragma unroll
        for (int ch = 0; ch < 32; ++ch) L[ch] = RS[(size_t)(((b * 32 + ch) * 4 + h)) * 8192 + el];
#pragma unroll
        for (int ch = 0; ch < 32; ++ch) { SC[(size_t)(((b * 32 + ch) * 4 + h)) * 8192 + el] = s; s = wch * s + L[ch]; }
    }
}

__device__ __forceinline__ void ret_out_mfma(const Ctx& F, const float* gn, bool dummy_out = false) {
    bf16* Z = (bf16*)(F.ws + WS_Z); const float* SC = (const float*)(F.ws + WS_HDN + 16 * MiB);
    const f32x2* R64 = (const f32x2*)(F.ws + WS_ROPE64);
    LAS unsigned char* Vimg = F.lds; LAS unsigned char* Simg = F.lds + 32768;
    const int lane = F.lane, g = lane >> 4, c = lane & 15, q = (lane >> 2) & 3, p = lane & 3, w = F.wave;
    for (int u = blockIdx.x; u < NB * 32 * 4; u += F.G) {
        const int h = u & 3, ch = (u >> 2) & 31, b = u >> 7; const float l2g = ret_l2g(h); const float gam = exp2f(l2g);
        bf16* base = Z + ((size_t)b * SEQ + ch * 128) * ZP;
        __syncthreads();
        for (int t = F.tid; t < 2048; t += 512) { const int r = t >> 4, c16 = t & 15;
            *(LAS v4u*)(Vimg + r * 256 + (((c16 >> 1) ^ (r & 7)) << 5) + ((c16 & 1) << 4)) = *(const GAS v4u*)(base + (size_t)r * ZP + Z_RV + h * 128 + c16 * 8); }
        for (int t = F.tid; t < 1024; t += 512) { const int r = t >> 4, c16 = t & 15; const float* sp = SC + (size_t)u * 8192 + r * 128 + c16 * 8;
            const f32x4 s0 = *(const GAS f32x4*)sp, s1 = *(const GAS f32x4*)(sp + 4);
            v4u wv; wv.x = pk2(s0.x * gam, s0.y * gam); wv.y = pk2(s0.z * gam, s0.w * gam); wv.z = pk2(s1.x * gam, s1.y * gam); wv.w = pk2(s1.z * gam, s1.w * gam);
            *(LAS v4u*)(Simg + r * 256 + (((c16 >> 1) ^ (r & 7)) << 5) + ((c16 & 1) << 4)) = wv; }
        const int i = 16 * w + c; s16x8 qf[2];
        float sc8 = 0.125f; asm volatile("" : "+v"(sc8));
        ret_rope_frag(base + (size_t)i * ZP + Z_RQ + h * 64, R64 + (ch * 128 + i) * 32, sc8 * exp2f((float)i * l2g), g, qf);
        f32x4 acc[8];
#pragma unroll
        for (int t = 0; t < 8; ++t) { acc[t] = (f32x4){0.f, 0.f, 0.f, 0.f};
            if (t <= w) { const int j = 16 * t + c; s16x8 kf[2];
                ret_rope_frag(base + (size_t)j * ZP + Z_RK + h * 64, R64 + (ch * 128 + j) * 32, exp2f(-(float)j * l2g), g, kf);
                acc[t] = __builtin_amdgcn_mfma_f32_16x16x32_bf16(kf[0], qf[0], acc[t], 0, 0, 0); acc[t] = __builtin_amdgcn_mfma_f32_16x16x32_bf16(kf[1], qf[1], acc[t], 0, 0, 0);
                if (t == w) {
#pragma unroll
                    for (int r = 0; r < 4; ++r) if (4 * g + r > c) acc[t][r] = 0.f; } } }
        s16x8 pf[4];
#pragma unroll
        for (int s = 0; s < 4; ++s) { v4u wv; wv.x = pk2(acc[2 * s][0], acc[2 * s][1]); wv.y = pk2(acc[2 * s][2], acc[2 * s][3]); wv.z = pk2(acc[2 * s + 1][0], acc[2 * s + 1][1]); wv.w = pk2(acc[2 * s + 1][2], acc[2 * s + 1][3]);
            pf[s] = __builtin_bit_cast(s16x8, wv); }
        __syncthreads();
        f32x4 o[8];
#pragma unroll
        for (int eb = 0; eb < 8; ++eb) o[eb] = (f32x4){0.f, 0.f, 0.f, 0.f};
#pragma unroll
        for (int s = 0; s < 4; ++s) if (2 * s <= w) {
#pragma unroll
            for (int eb = 0; eb < 8; ++eb) o[eb] = __builtin_amdgcn_mfma_f32_16x16x32_bf16(pf[s], ret_bfrag(Vimg, 32 * s, eb, g, q, p), o[eb], 0, 0, 0); }
#pragma unroll
        for (int ks = 0; ks < 2; ++ks)
#pragma unroll
            for (int eb = 0; eb < 8; ++eb) o[eb] = __builtin_amdgcn_mfma_f32_16x16x32_bf16(qf[ks], ret_bfrag(Simg, 32 * ks, eb, g, q, p), o[eb], 0, 0, 0);
        float rs[4];
#pragma unroll
        for (int r = 0; r < 4; ++r) { float ss = 0.f;
#pragma unroll
            for (int eb = 0; eb < 8; ++eb) ss += o[eb][r] * o[eb][r];
            ss += sx<1>(ss); ss += sx<2>(ss); ss += sx<4>(ss); ss += sx<8>(ss);
            rs[r] = 1.0f / sqrtf(ss * (1.f / 128) + NORM_EPS); }
#pragma unroll
        for (int r = 0; r < 4; ++r) { bf16* zr = base + (size_t)(16 * w + 4 * g + r) * ZP; bf16* zw = dummy_out ? (bf16*)(F.ws + WS_ZS) + ((size_t)b * SEQ + ch * 128 + 16 * w + 4 * g + r) * 1024 - Z_RV : zr;
#pragma unroll
            for (int eb = 0; eb < 8; ++eb) { const int e = 16 * eb + c; const float rg = bf2f(zr[Z_RG + h * 128 + e]);
                zw[Z_RV + h * 128 + e] = (bf16)f2bf(o[eb][r] * rs[r] * gn[h * 128 + e] * rg * sigmoid_f(rg)); } }
    }
    __syncthreads();
}

__device__ __forceinline__ void fscan_phase(const Ctx& F) {
    const float* LF = (const float*)(F.ws + WS_LF); float* CF = (float*)(F.ws + WS_CF);
    if (F.gw < 32) {
        const int b = F.gw >> 3, h = F.gw & 7; const float* lp = LF + ((size_t)b * SEQ + F.lane * 64) * 8 + h; float s = 0.f;
        for (int i = 0; i < 64; ++i) s += lp[i * 8];
        float incl = s;
#pragma unroll
        for (int o = 1; o < 64; o <<= 1) { const float t = __builtin_bit_cast(float, __builtin_amdgcn_ds_bpermute(((F.lane - o) & 63) << 2, __builtin_bit_cast(int, incl))); if (F.lane >= o) incl += t; }
        float run = incl - s; float* cp = CF + (size_t)F.gw * SEQ + F.lane * 64;
        for (int i = 0; i < 64; ++i) { run += lp[i * 8]; cp[i] = run; }
    }
}
#include <hip/hip_bf16.h>
#include <cmath>
namespace attn_body {
using bf16=__hip_bfloat16;
using bf16x8=__attribute__((ext_vector_type(8)))short;
using s16x4=__attribute__((ext_vector_type(4)))short;
using f32x16=__attribute__((ext_vector_type(16)))float;
using u32x4=__attribute__((ext_vector_type(4)))unsigned;
constexpr int BATCH=4,NHEAD=8,SEQ=4096,D=64,DM=6656;
constexpr int NW=8,QBLK=32,QB=QBLK*NW,KVBLK=64,NQB=SEQ/QB;
constexpr int ATTN_PITCH=DM, ATTN_UNIT_ROWS=QB;
__device__ __forceinline__ int crow(int r,int hi){return (r&3)+8*(r>>2)+4*hi;}
#define SBAR() __builtin_amdgcn_sched_barrier(0)
__device__ __forceinline__ void cmask(f32x16&p0,f32x16&p1,int jb,int qrel,int hi){
  const float NEG=-INFINITY; int kb=64*jb+4*hi;
  #pragma unroll
  for(int r=0;r<16;++r){int kv=kb+(r&3)+8*(r>>2); if(kv>qrel)p0[r]=NEG; if(kv+32>qrel)p1[r]=NEG;}
}

constexpr int NSLOT=3, SLOTB=8192;
constexpr int LDS_K=0, LDS_V=NSLOT*SLOTB, LDS_WS=2*NSLOT*SLOTB, LDS_OST=LDS_WS+NW*64*4, LDS_NC=LDS_OST+NW*4096, LDS_BYTES=LDS_NC+SEQ*4;
constexpr float C2=0.125f*1.4426950408889634f;
__device__ __forceinline__ void glds16(const void*gsrc,unsigned lds_dst){unsigned keep;
  asm volatile("s_mov_b32 %0, m0\n\ts_mov_b32 m0, %2\n\ts_nop 0\n\tglobal_load_lds_dwordx4 %1, off\n\ts_mov_b32 m0, %0":"=&s"(keep):"v"(gsrc),"s"(lds_dst):"memory");}
__device__ __forceinline__ float max3f(float a,float b,float c){float r;asm("v_max3_f32 %0, %1, %2, %3":"=v"(r):"v"(a),"v"(b),"v"(c));return r;}
__device__ __forceinline__ float max2f(float a,float b){float r;asm("v_max_f32_e32 %0, %1, %2":"=v"(r):"v"(a),"v"(b));return r;}
__device__ __forceinline__ float fadd_s(float a,float b){float r;asm("v_add_f32_e32 %0, %1, %2":"=v"(r):"v"(a),"v"(b));return r;}
__device__ __forceinline__ float fsub_s(float a,float b){float r;asm("v_sub_f32_e32 %0, %1, %2":"=v"(r):"v"(a),"v"(b));return r;}
typedef float f32x4_t __attribute__((ext_vector_type(4))); typedef float f32x2_t __attribute__((ext_vector_type(2))); typedef __bf16 bf16x2_t __attribute__((ext_vector_type(2)));
__device__ __forceinline__ unsigned cvtpk_s(float lo,float hi){f32x2_t v={lo,hi};bf16x2_t b=__builtin_convertvector(v,bf16x2_t);return __builtin_bit_cast(unsigned,b);}
#define WAIT_BAR(N) asm volatile("s_waitcnt vmcnt(" #N ") lgkmcnt(0)\n\ts_barrier":::"memory")

__device__ __forceinline__ void qkt(f32x16&p0,f32x16&p1,const char*Kslot,const bf16x8*qr,const f32x16&negm,int r32,int hi){
  const char*kb=Kslot+hi*1024+r32*16;
  #pragma unroll
  for(int d0=0;d0<4;++d0){
    const bf16x8 b0=*reinterpret_cast<const bf16x8*>(kb+d0*2048);
    const bf16x8 b1=*reinterpret_cast<const bf16x8*>(kb+d0*2048+512);
    if(d0==0){p0=__builtin_amdgcn_mfma_f32_32x32x16_bf16(b0,qr[0],negm,0,0,0);p1=__builtin_amdgcn_mfma_f32_32x32x16_bf16(b1,qr[0],negm,0,0,0);}
    else{p0=__builtin_amdgcn_mfma_f32_32x32x16_bf16(b0,qr[d0],p0,0,0,0);p1=__builtin_amdgcn_mfma_f32_32x32x16_bf16(b1,qr[d0],p1,0,0,0);}}
}
typedef __attribute__((address_space(3))) const char* lds_cptr;
typedef short v4i16_t __attribute__((ext_vector_type(4)));
__device__ __forceinline__ void kload8(bf16x8*kf,lds_cptr kp){
  kf[0]=*(const __attribute__((address_space(3))) bf16x8*)(kp);      kf[1]=*(const __attribute__((address_space(3))) bf16x8*)(kp+512);
  kf[2]=*(const __attribute__((address_space(3))) bf16x8*)(kp+2048); kf[3]=*(const __attribute__((address_space(3))) bf16x8*)(kp+2560);
  kf[4]=*(const __attribute__((address_space(3))) bf16x8*)(kp+4096); kf[5]=*(const __attribute__((address_space(3))) bf16x8*)(kp+4608);
  kf[6]=*(const __attribute__((address_space(3))) bf16x8*)(kp+6144); kf[7]=*(const __attribute__((address_space(3))) bf16x8*)(kp+6656);
}
__device__ __forceinline__ void kload2(bf16x8*kf,lds_cptr kp,int j){ kf[2*j]=*(const __attribute__((address_space(3))) bf16x8*)(kp+j*2048); kf[2*j+1]=*(const __attribute__((address_space(3))) bf16x8*)(kp+j*2048+512); }
__device__ __forceinline__ s16x4 vtr(lds_cptr p){ return __builtin_bit_cast(s16x4,__builtin_amdgcn_ds_read_tr16_b64_v4i16((__attribute__((address_space(3))) v4i16_t*)p)); }
__device__ __forceinline__ float rowmax(const f32x16&p0,const f32x16&p1){
  float a=max3f(p0[0],p0[1],p1[0]),b=max3f(p0[2],p0[3],p1[1]);a=max3f(a,p1[2],p1[3]);
  #pragma unroll
  for(int r=4;r<16;r+=4){a=max3f(a,p0[r],p0[r+1]);b=max3f(b,p0[r+2],p0[r+3]);a=max3f(a,p1[r],p1[r+1]);b=max3f(b,p1[r+2],p1[r+3]);}
  const float m=max2f(a,b);
  auto rr=__builtin_amdgcn_permlane32_swap(__float_as_uint(m),__float_as_uint(m),false,false);
  return max2f(__uint_as_float(rr[0]),__uint_as_float(rr[1]));
}
__device__ __forceinline__ void pv(f32x16*o,int vb,bf16x8 pa0,bf16x8 pa1,bf16x8 pa2,bf16x8 pa3){
  #pragma unroll
  for(int d0=0;d0<2;++d0){s16x4 lo[4],hi[4];
    #pragma unroll
    for(int ks=0;ks<4;++ks){
      asm volatile("ds_read_b64_tr_b16 %0,%1 offset:%c2":"=&v"(lo[ks]):"v"(vb),"i"(d0*4096+ks*1024):"memory");
      asm volatile("ds_read_b64_tr_b16 %0,%1 offset:%c2":"=&v"(hi[ks]):"v"(vb),"i"(d0*4096+ks*1024+512):"memory");}
    asm volatile("s_waitcnt lgkmcnt(0)":::"memory");SBAR();
    #define PK(k) (bf16x8){lo[k][0],lo[k][1],lo[k][2],lo[k][3],hi[k][0],hi[k][1],hi[k][2],hi[k][3]}
    o[d0]=__builtin_amdgcn_mfma_f32_32x32x16_bf16(pa0,PK(0),o[d0],0,0,0);
    o[d0]=__builtin_amdgcn_mfma_f32_32x32x16_bf16(pa1,PK(1),o[d0],0,0,0);
    o[d0]=__builtin_amdgcn_mfma_f32_32x32x16_bf16(pa2,PK(2),o[d0],0,0,0);
    o[d0]=__builtin_amdgcn_mfma_f32_32x32x16_bf16(pa3,PK(3),o[d0],0,0,0);
    #undef PK
  }
}

#ifndef ATTN_STORE16
#define ATTN_STORE16(p,v) (*(u32x4*)(p)=(v))
#endif
template<int THRL> __device__ __forceinline__ void attn_unit(int b,int h,int qb,const bf16*Q,const bf16*__restrict__ K,const bf16*__restrict__ V,bf16*O,const float*CF,float dskip,char*shm,int wave_id){
  int tid_=(wave_id<<6)|lane_id_v(); asm volatile("":"+v"(tid_));
  const int tid=tid_,lane=tid&63,r32=lane&31,hi=lane>>5; const int wid=__builtin_amdgcn_readfirstlane(tid>>6);
  const long rowbase=(long)b*SEQ; const int q0=qb*QB;
  const bf16*Qw=Q+(rowbase+q0+wid*QBLK)*DM+h*D;
  const float*cfp0=CF+(long)(b*NHEAD+h)*SEQ; const int NT0=(q0+QB)/KVBLK;
  int ts; { const float cq=cfp0[q0]; const int il=(lane<NT0)?64*lane+63:q0; const bool keep=(lane<NT0)&&(cfp0[il]<cq+dskip);
    const unsigned long long km=__ballot(keep); int t0=(int)__builtin_ctzll(km|(1ull<<63)); t0&=~1; ts=__builtin_amdgcn_readfirstlane(t0<NT0-4?t0:NT0-4); }
  const bf16*Kh=K+(rowbase+(long)ts*KVBLK)*DM+h*D,*Vh=V+(rowbase+(long)ts*KVBLK)*DM+h*D;
  const unsigned lds0=(unsigned)(uintptr_t)shm;
  float*wsf=(float*)(shm+LDS_WS)+wid*64;
  const bf16*ksrc=Kh+(long)lane*DM+wid*8;
  const bf16*vsrc=Vh+(long)(16*(wid&3)+(lane>>2))*DM+(wid>>2)*32+(lane&3)*8;
  const unsigned kdst=lds0+LDS_K+wid*1024, vdst=lds0+LDS_V+wid*1024;
  #define DMA_K(t,slot) glds16(ksrc+(long)(t)*KVBLK*DM,(unsigned)__builtin_amdgcn_readfirstlane(kdst+(slot)))
  #define DMA_V(t,slot) glds16(vsrc+(long)(t)*KVBLK*DM,(unsigned)__builtin_amdgcn_readfirstlane(vdst+(slot)))
  const char*Kbase=shm+LDS_K; bf16x8 kf[8];
  const lds_cptr shm3=(lds_cptr)shm; const lds_cptr kp0=shm3+LDS_K+hi*1024+r32*16; const lds_cptr vp0=shm3+LDS_V+((lane>>4)&1)*32+(lane&3)*8+(4*hi+((lane&15)>>2))*64;
  const int NT=NT0-ts;
  { const float*cfp=CF+(long)(b*NHEAD+h)*SEQ; float*ncw=(float*)(shm+LDS_NC);
    for(int i=tid+ts*KVBLK;i<q0+QB;i+=NW*64)ncw[i-ts*KVBLK]=-cfp[i]; }
  const lds_cptr ncp=(lds_cptr)shm+LDS_NC+hi*16;
  #define ADDC(P0,P1,t) do{ const lds_cptr np_=ncp+(t)*256; _Pragma("unroll") for(int g_=0;g_<4;++g_){ \
      const f32x4_t a_=*(const __attribute__((address_space(3))) f32x4_t*)(np_+g_*32), b_=*(const __attribute__((address_space(3))) f32x4_t*)(np_+g_*32+128); \
      P0[4*g_]+=a_[0];P0[4*g_+1]+=a_[1];P0[4*g_+2]+=a_[2];P0[4*g_+3]+=a_[3]; P1[4*g_]+=b_[0];P1[4*g_+1]+=b_[1];P1[4*g_+2]+=b_[2];P1[4*g_+3]+=b_[3]; } }while(0)
  DMA_K(0,0);DMA_V(0,0);DMA_K(1,SLOTB);
  bf16x8 qr[4];
  #pragma unroll
  for(int d0=0;d0<4;++d0)qr[d0]=*reinterpret_cast<const bf16x8*>(&Qw[(long)r32*DM+d0*16+hi*8]);
  float mhat=0.f,l_reg=0.f;f32x16 o[2];f32x16 negm; { float zz_; asm volatile("v_mov_b32 %0, 0":"=v"(zz_));
    _Pragma("unroll") for(int r=0;r<16;++r){o[0][r]=zz_;o[1][r]=zz_;negm[r]=zz_;} } asm volatile("":"+v"(negm));
  const int qrel=wid*QBLK+r32;
  #define CMASK(P0,P1,t) do{int jb_=(t)-(NT-4); if(jb_>=0)cmask(P0,P1,jb_,qrel,hi);}while(0)
  bool resc=false;
  #define START(P0,P1) do{ const float rm=rowmax(P0,P1); resc=false; \
    { const float dl=rm; mhat=fadd_s(mhat,dl); \
      _Pragma("unroll") for(int r=0;r<16;++r){P0[r]=fsub_s(P0[r],dl);P1[r]=fsub_s(P1[r],dl);} \
      _Pragma("unroll") for(int r=0;r<16;++r)negm[r]=-mhat; asm volatile("":"+v"(negm)); } \
    _Pragma("unroll") for(int r=0;r<16;++r)P0[r]=__builtin_amdgcn_exp2f(P0[r]); }while(0)
  #define RESC() do{ if(resc){ asm volatile("s_waitcnt lgkmcnt(0)":::"memory"); \
      _Pragma("unroll") for(int d_=0;d_<2;++d_) _Pragma("unroll") for(int r=0;r<16;++r)o[d_][r]*=wsf[crow(r,hi)]; } }while(0)
  f32x16 pA0,pA1,pB0,pB1;
  int sl_prev=0,sl_cur=0,sl_next=SLOTB;
  #define ROT() do{sl_prev=sl_cur;sl_cur=sl_next;sl_next=(sl_next==(NSLOT-1)*SLOTB)?0:sl_next+SLOTB;}while(0)
  DMA_K(2,2*SLOTB);
  WAIT_BAR(3);
  qkt(pA0,pA1,Kbase,qr,negm,r32,hi);asm volatile("s_nop 15\n\ts_nop 7":"+v"(pA0),"+v"(pA1));ADDC(pA0,pA1,0);CMASK(pA0,pA1,0);
  START(pA0,pA1);
  _Pragma("unroll") for(int r=0;r<16;++r)pA1[r]=__builtin_amdgcn_exp2f(pA1[r]);
  WAIT_BAR(0);
  DMA_K(3,0);DMA_V(1,SLOTB);
  ROT();
  kload8(kf,kp0+sl_cur);
  WAIT_BAR(2);
  s16x4 vlo[8],vhi[8]; u32x4 pw0,pw1,pw2,pw3;
  #define PKW(P,B) cvtpk_s(P[B],P[B+1])
  #define PAF(k) __builtin_bit_cast(bf16x8,pw##k)
  #define VFR(i) (bf16x8){vlo[i][0],vlo[i][1],vlo[i][2],vlo[i][3],vhi[i][0],vhi[i][1],vhi[i][2],vhi[i][3]}
  #define PIN(x) asm volatile("":"+v"(x))
  #define MX3(a,b,c) __builtin_fmaxf(__builtin_fmaxf((a),(b)),(c))
  #define GAPA(MF,A0,A1,A2,A3,W0,W1,PW) do{ MF; sacc+=A0; sacc+=A1; sacc+=A2; sacc+=A3; PIN(sacc); W0; W1; PIN(PW); SBAR(); }while(0)
  #define EX(v) __builtin_amdgcn_exp2f(v)
  #define GAPB(MF,X,B) do{ MF; X[B]=EX(X[B]); X[B+1]=EX(X[B+1]); X[B+2]=EX(X[B+2]); X[B+3]=EX(X[B+3]); PIN(X); SBAR(); }while(0)
  #define VRD(i) do{ vlo[i]=vtr(vp_+(((i)>>2)*4096+((i)&3)*1024)); vhi[i]=vtr(vp_+(((i)>>2)*4096+((i)&3)*1024+512)); }while(0)
  #define KRD(G,j) do{ if(G){ kload2(kf,kp0+sl_next,j); SBAR(); } }while(0)
  #define STEP(C0,C1,P0,P1,t,GK,GV,GL) do{ SBAR(); \
    const lds_cptr vp_=vp0+sl_prev; \
    VRD(0); SBAR(); float sacc=(P0[0]+P0[1]); \
    GAPA(C0=__builtin_amdgcn_mfma_f32_32x32x16_bf16(kf[0],qr[0],negm,0,0,0), P0[2],P0[3],P0[4],P0[5],     pw0[0]=PKW(P0,0), pw0[1]=PKW(P0,2), pw0); \
    VRD(4); SBAR(); GAPA(C1=__builtin_amdgcn_mfma_f32_32x32x16_bf16(kf[1],qr[0],negm,0,0,0), P0[6],P0[7],P0[8],P0[9],     pw0[2]=PKW(P0,4), pw0[3]=PKW(P0,6), pw0); \
    VRD(1); SBAR(); GAPA(C0=__builtin_amdgcn_mfma_f32_32x32x16_bf16(kf[2],qr[1],C0,0,0,0),   P0[10],P0[11],P0[12],P0[13], pw1[0]=PKW(P0,8), pw1[1]=PKW(P0,10), pw1); \
    VRD(5); SBAR(); GAPA(C1=__builtin_amdgcn_mfma_f32_32x32x16_bf16(kf[3],qr[1],C1,0,0,0),   P0[14],P0[15],P1[0],P1[1],   pw1[2]=PKW(P0,12),pw1[3]=PKW(P0,14), pw1); \
    VRD(2); SBAR(); GAPA(C0=__builtin_amdgcn_mfma_f32_32x32x16_bf16(kf[4],qr[2],C0,0,0,0),   P1[2],P1[3],P1[4],P1[5],     pw2[0]=PKW(P1,0), pw2[1]=PKW(P1,2), pw2); \
    VRD(6); SBAR(); GAPA(C1=__builtin_amdgcn_mfma_f32_32x32x16_bf16(kf[5],qr[2],C1,0,0,0),   P1[6],P1[7],P1[8],P1[9],     pw2[2]=PKW(P1,4), pw2[3]=PKW(P1,6), pw2); \
    VRD(3); SBAR(); GAPA(C0=__builtin_amdgcn_mfma_f32_32x32x16_bf16(kf[6],qr[3],C0,0,0,0),   P1[10],P1[11],P1[12],P1[13], pw3[0]=PKW(P1,8), pw3[1]=PKW(P1,10), pw3); \
    VRD(7); SBAR(); GAPA(C1=__builtin_amdgcn_mfma_f32_32x32x16_bf16(kf[7],qr[3],C1,0,0,0),   P1[14],P1[15],0.f,0.f,       pw3[2]=PKW(P1,12),pw3[3]=PKW(P1,14), pw3); \
    l_reg+=sacc; \
    if(GK){DMA_K((t)+3,sl_cur);} if(GV){DMA_V((t)+1,sl_next);} \
    ADDC(C0,C1,t); CMASK(C0,C1,t); \
    { float a=MX3(C0[0],C0[1],C1[0]),b=MX3(C0[2],C0[3],C1[1]); a=MX3(a,C1[2],C1[3]); \
      _Pragma("unroll") for(int r=4;r<16;r+=4){a=MX3(a,C0[r],C0[r+1]);b=MX3(b,C0[r+2],C0[r+3]);a=MX3(a,C1[r],C1[r+1]);b=MX3(b,C1[r+2],C1[r+3]);} \
      float rm=__builtin_fmaxf(a,b); { auto rr=__builtin_amdgcn_permlane32_swap(__float_as_uint(rm),__float_as_uint(rm),false,false); rm=__builtin_fmaxf(__uint_as_float(rr[0]),__uint_as_float(rr[1])); } \
      resc=false; \
      if(__builtin_expect(__any(rm>(float)THRL),0)){ const float dl=__builtin_fmaxf(rm,0.f); mhat+=dl; \
        _Pragma("unroll") for(int r=0;r<16;++r){C0[r]-=dl;C1[r]-=dl;} \
        _Pragma("unroll") for(int r=0;r<16;++r)negm[r]=-mhat; asm volatile("":"+v"(negm)); \
        const float f=__builtin_amdgcn_exp2f(-dl); l_reg*=f; if(hi==0)wsf[r32]=f; resc=true; } } \
    SBAR(); \
    GAPB(o[0]=__builtin_amdgcn_mfma_f32_32x32x16_bf16(PAF(0),VFR(0),o[0],0,0,0), C0,0); \
    GAPB(o[1]=__builtin_amdgcn_mfma_f32_32x32x16_bf16(PAF(0),VFR(4),o[1],0,0,0), C0,4); \
    KRD(GL,0); GAPB(o[0]=__builtin_amdgcn_mfma_f32_32x32x16_bf16(PAF(1),VFR(1),o[0],0,0,0), C0,8); \
    KRD(GL,1); GAPB(o[1]=__builtin_amdgcn_mfma_f32_32x32x16_bf16(PAF(1),VFR(5),o[1],0,0,0), C0,12); \
    KRD(GL,2); GAPB(o[0]=__builtin_amdgcn_mfma_f32_32x32x16_bf16(PAF(2),VFR(2),o[0],0,0,0), C1,0); \
    KRD(GL,3); GAPB(o[1]=__builtin_amdgcn_mfma_f32_32x32x16_bf16(PAF(2),VFR(6),o[1],0,0,0), C1,4); \
    GAPB(o[0]=__builtin_amdgcn_mfma_f32_32x32x16_bf16(PAF(3),VFR(3),o[0],0,0,0), C1,8); \
    GAPB(o[1]=__builtin_amdgcn_mfma_f32_32x32x16_bf16(PAF(3),VFR(7),o[1],0,0,0), C1,12); \
    }while(0)
  int t=1;
  #undef CMASK
  #define CMASK(P0,P1,t) do{}while(0)
  for(;t+5<NT;t+=2){
    STEP(pB0,pB1,pA0,pA1,t,true,true,true);     WAIT_BAR(2); RESC(); ROT();
    STEP(pA0,pA1,pB0,pB1,t+1,true,true,true);   WAIT_BAR(2); RESC(); ROT();
  }
  #undef CMASK
  #define CMASK(P0,P1,t) do{int jb_=(t)-(NT-4); if(jb_>=0)cmask(P0,P1,jb_,qrel,hi);}while(0)
  #define ENDW(tt) do{ if((tt)+3<NT){WAIT_BAR(2);} else if((tt)+2<NT){WAIT_BAR(1);} else {WAIT_BAR(0);} }while(0)
  for(;t+1<NT;t+=2){
    STEP(pB0,pB1,pA0,pA1,t,(t+3<NT),(t+1<NT),(t+1<NT));       ENDW(t);   RESC(); ROT();
    STEP(pA0,pA1,pB0,pB1,t+1,(t+4<NT),(t+2<NT),(t+2<NT));     ENDW(t+1); RESC(); ROT();
  }
  STEP(pB0,pB1,pA0,pA1,NT-1,false,false,false); RESC();
  { float sacc=pB0[0]+pB0[1]; _Pragma("unroll") for(int r=2;r<16;++r)sacc+=pB0[r]; _Pragma("unroll") for(int r=0;r<16;++r)sacc+=pB1[r]; l_reg+=sacc;
    pw0=(u32x4){PKW(pB0,0),PKW(pB0,2),PKW(pB0,4),PKW(pB0,6)};pw1=(u32x4){PKW(pB0,8),PKW(pB0,10),PKW(pB0,12),PKW(pB0,14)};pw2=(u32x4){PKW(pB1,0),PKW(pB1,2),PKW(pB1,4),PKW(pB1,6)};pw3=(u32x4){PKW(pB1,8),PKW(pB1,10),PKW(pB1,12),PKW(pB1,14)};
    int tl_=lane_id_v(); asm volatile("":"+v"(tl_)); const int ln_=tl_&63,hi_=ln_>>5; const int vb0e=(int)(lds0+LDS_V)+((ln_>>4)&1)*32+(ln_&3)*8+(4*hi_+((ln_&15)>>2))*64;
    SBAR(); pv(o,vb0e+sl_cur,PAF(0),PAF(1),PAF(2),PAF(3)); }
  #undef PKW
  #undef PAF
  #undef VFR
  #undef PIN
  #undef MX3
  #undef GAPA
  #undef GAPB
  #undef EX
  #undef VRD
  #undef KRD
  #undef STEP
  #undef ENDW
  {auto rr=__builtin_amdgcn_permlane32_swap(__float_as_uint(l_reg),__float_as_uint(l_reg),false,false);l_reg=__uint_as_float(rr[0])+__uint_as_float(rr[1]);}
  int te_=lane_id_v(); asm volatile("":"+v"(te_)); const int lane_e=te_&63,r32_e=lane_e&31,hi_e=lane_e>>5;
  if(hi_e==0)wsf[32+r32_e]=l_reg;asm volatile("s_waitcnt lgkmcnt(0)":::"memory");
  float rli[16];
  #pragma unroll
  for(int r=0;r<16;++r)rli[r]=__builtin_amdgcn_rcpf(wsf[32+crow(r,hi_e)]);
  bf16*Ow=O+(rowbase+q0+wid*QBLK)*DM+h*D;
  { bf16*stg=(bf16*)(shm+LDS_OST)+wid*2048;
    #pragma unroll
    for(int r=0;r<16;++r){const int orow=crow(r,hi_e);
      #pragma unroll
      for(int d0=0;d0<2;++d0)stg[orow*64+d0*32+r32_e]=__float2bfloat16(o[d0][r]*rli[r]);}
    asm volatile("s_waitcnt lgkmcnt(0)":::"memory");
    #pragma unroll
    for(int i=0;i<4;++i){const int row=i*8+(lane_e>>3),ch=lane_e&7; const u32x4 v=*(const u32x4*)(stg+row*64+ch*8); ATTN_STORE16(Ow+(long)row*DM+ch*8,v);} }
  asm volatile("s_waitcnt lgkmcnt(0)\n\ts_barrier":::"memory");
  #undef ADDC
  #undef DMA_K
  #undef DMA_V
  #undef CMASK
  #undef START
  #undef RESC
  #undef ROT
}
constexpr int ATTN_LDS_BYTES=LDS_BYTES;
struct AttnTensors { const bf16* Q; const bf16* K; const bf16* V; bf16* O; const float* CF; float dskip; };
struct AttnUnit { int bh; int qb; };
struct StaticOrder {
  int vcu;
  __device__ __forceinline__ explicit StaticOrder(int grid,int block):vcu((block%8)*(grid/8)+block/8){}
  __device__ __forceinline__ bool next(int i,AttnUnit&u)const{ if(i>=2)return false; const int s=vcu&7; u.bh=vcu>>3; u.qb=(i==0)?s:15-s; return true; }
  __device__ __forceinline__ void a_ready(const AttnUnit&)const{}
  __device__ __forceinline__ void done(const AttnUnit&)const{}
};
template<class Sched,int THRL=8> __device__ __forceinline__ void attn_phase(char*lds,const AttnTensors&T,const Sched&S,int wave_id){
  AttnUnit u;
  for(int i=0;S.next(i,u);++i){ S.a_ready(u); attn_unit<THRL>(u.bh/NHEAD,u.bh%NHEAD,u.qb,T.Q,T.K,T.V,T.O,T.CF,T.dskip,lds,wave_id); S.done(u); }
}
#undef SBAR
#undef WAIT_BAR
}

struct Args { const float* in[16]; float* out; unsigned char* ws; };
__global__ void __launch_bounds__(NWAVES * 64, 2) hyb_fwd(Args args) {
    extern __shared__ __attribute__((aligned(16))) unsigned char lds[];
    Ctx F;
    F.lds = (LAS unsigned char*)lds;
    F.tid = threadIdx.x; F.lane = F.tid & 63; F.wave = __builtin_amdgcn_readfirstlane(F.tid >> 6);
    F.G = gridDim.x; F.gw = blockIdx.x * NWAVES + F.wave; F.NGW = F.G * NWAVES;
    F.out = args.out; F.ws = args.ws;
    volatile LAS unsigned* MISC = (volatile LAS unsigned*)(F.lds + MISC_OFF);
    for (int u = F.tid; u < (LDS_BYTES - LDSCTL_OFF) / 4; u += NWAVES * 64) ((LAS unsigned*)(F.lds + LDSCTL_OFF))[u] = 0u;
    __syncthreads();
    gu32* ctl = (gu32*)(F.ws + WS_CTL);
    XcdBarrier bar = xcd_barrier_post((unsigned*)(ctl + CW_BAR), MISC + 8); bar.w = F.wave;
#define FRESH(P) Ctx P = F; P.tid = (F.wave << 6) | lane_id_v(); asm volatile("" : "+v"(P.tid), "+s"(P.wave), "+s"(P.gw), "+s"(P.ws), "+s"(P.out)); P.lane = P.tid & 63
#define GRID_BAR() do { XcdBarrier b_ = bar; asm volatile("" : "+s"(b_.bar), "+s"(b_.x)); xcd_barrier(b_); } while (0)

    bf16* Wb = (bf16*)(F.ws + WS_W);
    bf16* Z = (bf16*)(F.ws + WS_Z); float* ZS = (float*)(F.ws + WS_ZS); bf16* HDN = (bf16*)(F.ws + WS_HDN);
    float* M32 = (float*)(F.ws + WS_HDN); bf16* HB = (bf16*)(F.ws + WS_Z);
    LAS unsigned char* ring = F.lds + RING_OFF; float* SSp = (float*)(F.ws + WS_SS);

    { FRESH(P); p0_prologue(P, args.in[2], args.in[9], args.in[10], args.in[11], args.in[12], args.in[14], args.in[15]); }
    { FRESH(P); norm0_phase(P, args.in[0], args.in[1], (bf16*)(P.ws + WS_HDN), (float*)(P.ws + WS_SS)); }
    GRID_BAR();

    #pragma unroll 1
    for (int layer = 0; layer < DEPTH; ++layer) {
        const float* xin = (layer == 0) ? args.in[0] : F.out;
        const bf16* L = Wb + (size_t)layer * LW_STRIDE;
        { pg8::Gemm g{HDN, L + LW_IN, M, NIN, DM, DM, DM}; pg8::StaticOrder S; S.init(M, NIN, F.G, (int)blockIdx.x);
          pg8::EpiZ E{Z, ZS, SSp, args.in[4] + layer * 64, args.in[5] + layer * 64, args.in[6] + layer * 64, (const float*)(F.ws + WS_ROPE64)};
          pg8::gemm_phase<pg8::EpiZ, pg8::StaticOrder, true, true>(ring, g, S, E, F.wave); }
        GRID_BAR();
#ifdef PROBE_PP
        { FRESH(P); post_phase(P, args.in[4] + layer * 64, args.in[5] + layer * 64, args.in[6] + layer * 64, args.in[7] + layer * 64, args.in[3] + layer * 8, true); }
#endif
        { FRESH(P); post_phase(P, args.in[4] + layer * 64, args.in[5] + layer * 64, args.in[6] + layer * 64, args.in[7] + layer * 64, args.in[3] + layer * 8); }
        { FRESH(P); ret_state_mfma(P); }
        GRID_BAR();
        { FRESH(P); fscan_phase(P); }
        { FRESH(P); ret_scan(P); }
        GRID_BAR();
#ifdef PROBE_RO
        { FRESH(P); ret_out_mfma(P, args.in[8] + layer * 512, true); }
#endif
        { FRESH(P); ret_out_mfma(P, args.in[8] + layer * 512); }
#ifdef PROBE_X3
        for (int rep_ = 0; rep_ < 2; ++rep_)
        { static_assert(attn_body::ATTN_LDS_BYTES <= RING_BYTES, "attention scratch fits the ring region");
          unsigned char* wsl = F.ws; asm volatile("" : "+s"(wsl));
          bf16* Zl = (bf16*)(wsl + WS_Z);
          const attn_body::AttnTensors AT{(const attn_body::bf16*)(Zl + Z_FQ), (const attn_body::bf16*)(Zl + Z_FK), (const attn_body::bf16*)(Zl + Z_FV), (attn_body::bf16*)(Zl + (rep_ == 0 ? Z_RQ : Z_FQ)), (const float*)(wsl + WS_CF)};
          const attn_body::StaticOrder S((int)F.G, (int)blockIdx.x);
          attn_body::attn_phase<attn_body::StaticOrder, 20>((char*)lds + RING_OFF, AT, S, F.wave); }
#ifdef PROBE_X4
        { FRESH(P); dsa_v3(P); }
#else
        for (int rep_ = 0; rep_ < 2; ++rep_) { FRESH(P); dsa_v3(P, rep_ == 0 ? Z_RG : Z_DQ); }
#endif
#else
        { static_assert(attn_body::ATTN_LDS_BYTES <= RING_BYTES, "attention scratch fits the ring region");
          unsigned char* wsl = F.ws; asm volatile("" : "+s"(wsl));
          bf16* Zl = (bf16*)(wsl + WS_Z);
          float dskip; { const int ln = lane_id_v(); const float gq = wave_max(fabsf(args.in[4][layer * 64 + ln])), gk = wave_max(fabsf(args.in[5][layer * 64 + ln])); dskip = 2.0f * (64.0f * C2 * gq * gk * 1.02f) + 48.0f; }
          const attn_body::AttnTensors AT{(const attn_body::bf16*)(Zl + Z_FQ), (const attn_body::bf16*)(Zl + Z_FK), (const attn_body::bf16*)(Zl + Z_FV), (attn_body::bf16*)(Zl + Z_FQ), (const float*)(wsl + WS_CF), dskip};
          const attn_body::StaticOrder S((int)F.G, (int)blockIdx.x);
          attn_body::attn_phase<attn_body::StaticOrder, 20>((char*)lds + RING_OFF, AT, S, F.wave); }
        { FRESH(P); dsa_v3(P); }
#endif
        GRID_BAR();
        { pg8::Gemm g{Z + Z_FQ, L + LW_MIX, M, DM, 1536, ZP, 1536}; pg8::StaticOrder S; S.init(M, DM, F.G, (int)blockIdx.x);
          pg8::EpiGateF E{Z + Z_ZG, Z + Z_MRG};
          pg8::gemm_phase<pg8::EpiGateF, pg8::StaticOrder, false, true>(ring, g, S, E, F.wave); }
        GRID_BAR();
        { pg8::Gemm g{Z + Z_MRG, L + LW_O, M, DM, DM, ZP, DM}; pg8::StaticOrder S; S.init(M, DM, F.G, (int)blockIdx.x);
          pg8::EpiRes E{xin, F.out, args.in[13] + layer * DM, HDN, SSp};
          pg8::gemm_phase<pg8::EpiRes, pg8::StaticOrder, false, true>(ring, g, S, E, F.wave); }
        GRID_BAR();
        { pg8::Gemm g{HDN, L + LW_FI, M, FF2, DM, DM, DM}; pg8::StaticOrder S; S.init(M, FF2, F.G, (int)blockIdx.x);
          pg8::EpiSwi E{HB, FFH, SSp};
          pg8::gemm_phase<pg8::EpiSwi, pg8::StaticOrder, true, true>(ring, g, S, E, F.wave); }
        GRID_BAR();
        { pg8::Gemm g{HB, L + LW_FO, M, DM, FFH, FFH, FFH}; pg8::StaticOrder S; S.init(M, DM, F.G, (int)blockIdx.x);
          pg8::EpiRes E{F.out, F.out, args.in[1] + (layer + 1 < DEPTH ? layer + 1 : layer) * DM, HDN, SSp};
          pg8::gemm_phase<pg8::EpiRes, pg8::StaticOrder, false, true>(ring, g, S, E, F.wave); }
        GRID_BAR();
    }
    if (__hip_atomic_load((gu32*)((unsigned*)(ctl + CW_BAR) + XB_TMO), RLX_AGENT) != 0u) {
        const float q = __builtin_nanf("");
        for (int m = F.gw; m < M; m += F.NGW) { GAS f32x4* o = (GAS f32x4*)(F.out + (size_t)m * DM) + lane_id_v();
#pragma unroll
            for (int j = 0; j < 4; ++j) o[64 * j] = (f32x4){q, q, q, q}; }
    }
}

extern "C" void kernel_launch(void* const* d_in, const int* in_sizes, int n_in, void* d_out, int out_size, void* d_ws, size_t ws_size, hipStream_t stream) {
    static int grid = 0;
    if (grid == 0) {
        if (n_in != 16 || in_sizes[0] != M * DM || out_size != M * DM || ws_size < WS_END) { fprintf(stderr, "kernel_launch: unexpected shapes / workspace (n_in %d, in0 %d, out %d, ws %zu < %zu)\n", n_in, n_in > 0 ? in_sizes[0] : -1, out_size, ws_size, (size_t)WS_END); grid = -1; return; }
        int dev = 0, cus = 0, per_cu = 0;
        if (hipGetDevice(&dev) != hipSuccess || hipDeviceGetAttribute(&cus, hipDeviceAttributeMultiprocessorCount, dev) != hipSuccess) { grid = -1; return; }
        if (hipFuncSetAttribute((const void*)hyb_fwd, hipFuncAttributeMaxDynamicSharedMemorySize, LDS_BYTES) != hipSuccess) { fprintf(stderr, "kernel_launch: hipFuncSetAttribute failed\n"); grid = -1; return; }
        if (hipOccupancyMaxActiveBlocksPerMultiprocessor(&per_cu, (const void*)hyb_fwd, NWAVES * 64, LDS_BYTES) != hipSuccess || per_cu < 1) { fprintf(stderr, "kernel_launch: occupancy query reports %d blocks per CU\n", per_cu); }
        (void)hipGetLastError();
        grid = cus;
    }
    if (grid < 0) return;
    if (hipMemsetAsync((char*)d_ws + WS_CTL, 0, CTL_ZERO_BYTES, stream) != hipSuccess) return;
    Args a{};
    for (int i = 0; i < 16; ++i) a.in[i] = (const float*)d_in[i];
    a.out = (float*)d_out; a.ws = (unsigned char*)d_ws;
    hipLaunchKernelGGL(hyb_fwd, dim3(grid), dim3(NWAVES * 64), LDS_BYTES, stream, a);
}
```

```cpp
#include <hip/hip_runtime.h>
#include <cstdio>
#include <cstdint>
#include <cmath>
__device__ __forceinline__ int lane_id_v() { unsigned z; asm volatile("v_mov_b32 %0, 0" : "=v"(z)); return (int)__builtin_amdgcn_mbcnt_hi(~0u, __builtin_amdgcn_mbcnt_lo(~0u, z)); }
template <int MASK> __device__ __forceinline__ float sx(float v) { static_assert(MASK < 32, "swizzle xor mask"); return __builtin_bit_cast(float, __builtin_amdgcn_ds_swizzle(__builtin_bit_cast(int, v), 0x1F | (MASK << 10))); }
template <int MASK> __device__ __forceinline__ unsigned sxu(unsigned v) { return (unsigned)__builtin_amdgcn_ds_swizzle((int)v, 0x1F | (MASK << 10)); }
__device__ __forceinline__ void swap32(unsigned x, unsigned& lo_view, unsigned& hi_view) {
    unsigned a = x, b = x; asm volatile("" : "+v"(b));
    const auto rr = __builtin_amdgcn_permlane32_swap(a, b, false, false);
    lo_view = rr[0]; hi_view = rr[1];
}
template <int CTRL> __device__ __forceinline__ float dpp_f(float v) { return __builtin_bit_cast(float, __builtin_amdgcn_update_dpp(0, __builtin_bit_cast(int, v), CTRL, 0xF, 0xF, false)); }
template <int CTRL> __device__ __forceinline__ int dpp_i(int v) { return __builtin_amdgcn_update_dpp(0, v, CTRL, 0xF, 0xF, false); }
__device__ __forceinline__ float rl_f(float v, int l) { return __builtin_bit_cast(float, __builtin_amdgcn_readlane(__builtin_bit_cast(int, v), l)); }
__device__ __forceinline__ float wave_sum(float v) {
    v += dpp_f<0xB1>(v); v += dpp_f<0x4E>(v); v += dpp_f<0x141>(v); v += dpp_f<0x140>(v);
    return (rl_f(v, 0) + rl_f(v, 16)) + (rl_f(v, 32) + rl_f(v, 48));
}
__device__ __forceinline__ float wave_max(float v) {
    v = fmaxf(v, dpp_f<0xB1>(v)); v = fmaxf(v, dpp_f<0x4E>(v)); v = fmaxf(v, dpp_f<0x141>(v)); v = fmaxf(v, dpp_f<0x140>(v));
    return fmaxf(fmaxf(rl_f(v, 0), rl_f(v, 16)), fmaxf(rl_f(v, 32), rl_f(v, 48)));
}
__device__ __forceinline__ int wave_isum(int v) {
    v += dpp_i<0xB1>(v); v += dpp_i<0x4E>(v); v += dpp_i<0x141>(v); v += dpp_i<0x140>(v);
    return (__builtin_amdgcn_readlane(v, 0) + __builtin_amdgcn_readlane(v, 16)) + (__builtin_amdgcn_readlane(v, 32) + __builtin_amdgcn_readlane(v, 48));
}
__device__ __forceinline__ unsigned wave_umax(unsigned v) {
    unsigned t; t = (unsigned)dpp_i<0xB1>((int)v); v = t > v ? t : v; t = (unsigned)dpp_i<0x4E>((int)v); v = t > v ? t : v; t = (unsigned)dpp_i<0x141>((int)v); v = t > v ? t : v; t = (unsigned)dpp_i<0x140>((int)v); v = t > v ? t : v;
    const unsigned a = (unsigned)__builtin_amdgcn_readlane((int)v, 0), b = (unsigned)__builtin_amdgcn_readlane((int)v, 16), c = (unsigned)__builtin_amdgcn_readlane((int)v, 32), d = (unsigned)__builtin_amdgcn_readlane((int)v, 48);
    const unsigned ab = a > b ? a : b, cd = c > d ? c : d; return ab > cd ? ab : cd;
}
__device__ __forceinline__ unsigned wave_umin(unsigned v) { return ~wave_umax(~v); }
__device__ __forceinline__ float half_sum(float v) {
    unsigned a, b; swap32(__builtin_bit_cast(unsigned, v), a, b); return __builtin_bit_cast(float, a) + __builtin_bit_cast(float, b);
}
__device__ __forceinline__ float half_max(float v) {
    unsigned a, b; swap32(__builtin_bit_cast(unsigned, v), a, b); return fmaxf(__builtin_bit_cast(float, a), __builtin_bit_cast(float, b));
}
namespace pg8 {
#define PG8_LAS __attribute__((address_space(3)))
typedef unsigned short bf16_t;
typedef short bf16x8 __attribute__((ext_vector_type(8)));
typedef float f32x4 __attribute__((ext_vector_type(4)));
typedef unsigned u32x4 __attribute__((ext_vector_type(4)));
constexpr int BM = 256, BK = 64, HALF = 128, HTB = HALF * BK * 2  , STAGE_BYTES = 8 * HTB, NXCD = 8, WGM = 8;

__host__ __device__ __forceinline__ int lds_byte(int r, int c) { const int st = (r >> 4) * 2 + (c >> 5), rr = r & 15, cc = c & 31, ob = rr * 64 + cc * 2; return st * 1024 + (ob ^ (((ob >> 9) & 1) << 5)); }
__host__ __device__ __forceinline__ void stage_rc(int b, int& R, int& C) { const int st = b / 1024, sb = b % 1024, swz = sb ^ (((sb >> 9) & 1) << 5); R = (st >> 1) * 16 + swz / 64; C = (st & 1) * 32 + (swz % 64) / 2; }
__host__ __device__ __forceinline__ int perm32(int rho) { const int n = rho >> 4, i = rho & 15; return 8 * (i >> 2) + 4 * n + (i & 3); }

struct Unit { int pm, pn; };
struct Gemm { const bf16_t* A; const bf16_t* Bt; int M, N, K, lda, ldb; };

struct StaticOrder {
    int nM, nN, nwg, G, c;
    __host__ __device__ void init(int M, int N, int G_, int c_) { nM = M / BM; nN = N / BM; nwg = nM * nN; G = G_; c = c_; }
    __host__ __device__ bool next(int i, Unit& u) const {
        const long L = (long)i * G + c; if (L >= nwg) return false;
        int wgid = (int)L; { const int q = nwg / NXCD, r = nwg % NXCD, xcd = wgid % NXCD, off = wgid / NXCD; wgid = (xcd < r ? xcd * (q + 1) : r * (q + 1) + (xcd - r) * q) + off; }
        const int nig = WGM * nN, gid = wgid / nig, fm = gid * WGM, gsz = (nM - fm) < WGM ? (nM - fm) : WGM;
        u.pm = fm + ((wgid % nig) % gsz); u.pn = (wgid % nig) / gsz; return true;
    }
    __device__ __forceinline__ void a_ready(const Unit&) const {}
    __device__ __forceinline__ void done(const Unit&) const {}
};

__device__ __forceinline__ unsigned cvt_pk_bf16(float lo, float hi) { unsigned r; asm volatile("v_cvt_pk_bf16_f32 %0, %1, %2" : "=v"(r) : "v"(lo), "v"(hi)); return r; }
__device__ __forceinline__ float bflo(unsigned w) { return __builtin_bit_cast(float, w << 16); }
__device__ __forceinline__ float bfhi(unsigned w) { return __builtin_bit_cast(float, w & 0xffff0000u); }
__device__ __forceinline__ float sigmoidf_(float x) { return __builtin_amdgcn_rcpf(1.0f + __builtin_amdgcn_exp2f(-1.4426950408889634f * x)); }

constexpr int ZP = 6656;
constexpr int ZSP = 512;
constexpr int NZT = 26, GATE_T0 = 14;

#define PRELOAD_RSTD(rsv, SS_, row0_) float rsv[2][4]; { f32x4 s_[2][4]; _Pragma("unroll") for (int ai_ = 0; ai_ < 2; ++ai_) _Pragma("unroll") for (int m_ = 0; m_ < 4; ++m_) s_[ai_][m_] = *(const f32x4*)((SS_) + (size_t)((row0_) + ai_ * HALF + m_ * 16) * 4); \
    _Pragma("unroll") for (int ai_ = 0; ai_ < 2; ++ai_) _Pragma("unroll") for (int m_ = 0; m_ < 4; ++m_) rsv[ai_][m_] = 1.0f / __builtin_sqrtf(((s_[ai_][m_][0] + s_[ai_][m_][1]) + (s_[ai_][m_][2] + s_[ai_][m_][3])) * (1.0f / 1024.0f) + 1e-6f); }
struct EpiZ {
    static constexpr bool PERM = true, AFTER_DRAIN = false, MID = false;
    bf16_t* Z; float* ZS; const float* SS; const float* GQ; const float* GK; const float* GD; const float* R64;
    __device__ __forceinline__ void operator()(const f32x4 (&acc)[2][2][4][2], const Unit& u, int wr, int wc, int fr, int fq) const {
        const int row0 = u.pm * BM + wr * 64 + fr;
        PRELOAD_RSTD(rsv, SS, row0);
        if (u.pn < 4 || u.pn == 6 || u.pn == 7) {
            const float osc = (u.pn < 4) ? 0.18033688011112042f : 1.0f; const bool rope = (u.pn == 2 || u.pn == 3);
            f32x4 g00, g01, g10, g11;
            if (u.pn < 2) { g00 = *(const f32x4*)(GQ + 8 * fq); g01 = *(const f32x4*)(GQ + 8 * fq + 4); g10 = *(const f32x4*)(GQ + 32 + 8 * fq); g11 = *(const f32x4*)(GQ + 32 + 8 * fq + 4); }
            else if (u.pn < 4) { g00 = *(const f32x4*)(GD + 8 * fq); g01 = *(const f32x4*)(GD + 8 * fq + 4); g10 = *(const f32x4*)(GD + 32 + 8 * fq); g11 = *(const f32x4*)(GD + 32 + 8 * fq + 4); }
            else { g00 = *(const f32x4*)(GK + 8 * fq); g01 = *(const f32x4*)(GK + 8 * fq + 4); g10 = *(const f32x4*)(GK + 32 + 8 * fq); g11 = *(const f32x4*)(GK + 32 + 8 * fq + 4); }
            const int colo = u.pn * BM + wc * 64 + 8 * fq;
#pragma unroll
            for (int ai = 0; ai < 2; ++ai)
#pragma unroll
                for (int m = 0; m < 4; ++m) { const int row = row0 + ai * HALF + m * 16; const float rs = rsv[ai][m];
                    f32x4 a0 = acc[ai][0][m][0] * rs, a1 = acc[ai][0][m][1] * rs, b0 = acc[ai][1][m][0] * rs, b1 = acc[ai][1][m][1] * rs;
                    float ss = ((a0[0] * a0[0] + a0[1] * a0[1]) + (a0[2] * a0[2] + a0[3] * a0[3])) + ((a1[0] * a1[0] + a1[1] * a1[1]) + (a1[2] * a1[2] + a1[3] * a1[3]))
                             + ((b0[0] * b0[0] + b0[1] * b0[1]) + (b0[2] * b0[2] + b0[3] * b0[3])) + ((b1[0] * b1[0] + b1[1] * b1[1]) + (b1[2] * b1[2] + b1[3] * b1[3]));
                    ss += sx<16>(ss); { unsigned x_, y_; swap32(__builtin_bit_cast(unsigned, ss), x_, y_); ss = __builtin_bit_cast(float, x_) + __builtin_bit_cast(float, y_); }
                    const float hr = osc / __builtin_sqrtf(ss * (1.0f / 64.0f) + 1e-6f);
                    a0 = a0 * g00 * hr; a1 = a1 * g01 * hr; b0 = b0 * g10 * hr; b1 = b1 * g11 * hr;
                    if (rope) { const float* cs = R64 + ((size_t)(row & 4095) * 32 + 8 * fq) * 2;
                        const f32x4 c0 = *(const f32x4*)cs, c1 = *(const f32x4*)(cs + 4), c2 = *(const f32x4*)(cs + 8), c3 = *(const f32x4*)(cs + 12);
                        f32x4 x0, x1, y0, y1;
                        x0[0] = a0[0] * c0[0] - b0[0] * c0[1]; y0[0] = b0[0] * c0[0] + a0[0] * c0[1]; x0[1] = a0[1] * c0[2] - b0[1] * c0[3]; y0[1] = b0[1] * c0[2] + a0[1] * c0[3];
                        x0[2] = a0[2] * c1[0] - b0[2] * c1[1]; y0[2] = b0[2] * c1[0] + a0[2] * c1[1]; x0[3] = a0[3] * c1[2] - b0[3] * c1[3]; y0[3] = b0[3] * c1[2] + a0[3] * c1[3];
                        x1[0] = a1[0] * c2[0] - b1[0] * c2[1]; y1[0] = b1[0] * c2[0] + a1[0] * c2[1]; x1[1] = a1[1] * c2[2] - b1[1] * c2[3]; y1[1] = b1[1] * c2[2] + a1[1] * c2[3];
                        x1[2] = a1[2] * c3[0] - b1[2] * c3[1]; y1[2] = b1[2] * c3[0] + a1[2] * c3[1]; x1[3] = a1[3] * c3[2] - b1[3] * c3[3]; y1[3] = b1[3] * c3[2] + a1[3] * c3[3];
                        a0 = x0; a1 = x1; b0 = y0; b1 = y1; }
                    bf16_t* rowp = Z + (size_t)row * ZP + colo;
                    u32x4 w; w.x = cvt_pk_bf16(a0[0], a0[1]); w.y = cvt_pk_bf16(a0[2], a0[3]); w.z = cvt_pk_bf16(a1[0], a1[1]); w.w = cvt_pk_bf16(a1[2], a1[3]); *(u32x4*)rowp = w;
                    w.x = cvt_pk_bf16(b0[0], b0[1]); w.y = cvt_pk_bf16(b0[2], b0[3]); w.z = cvt_pk_bf16(b1[0], b1[1]); w.w = cvt_pk_bf16(b1[2], b1[3]); *(u32x4*)(rowp + 32) = w;
                    __builtin_amdgcn_sched_barrier(0); }
        } else if (u.pn < NZT) {
            const int col0 = u.pn * BM + wc * 32 + 8 * fq;
#pragma unroll
            for (int ai = 0; ai < 2; ++ai)
#pragma unroll
                for (int m = 0; m < 4; ++m) { bf16_t* rowp = Z + (size_t)(row0 + ai * HALF + m * 16) * ZP + col0; const float rs = rsv[ai][m];
#pragma unroll
                    for (int bj = 0; bj < 2; ++bj) { f32x4 v0 = acc[ai][bj][m][0] * rs, v1 = acc[ai][bj][m][1] * rs;
                        if (u.pn >= GATE_T0) {
#pragma unroll
                            for (int i = 0; i < 4; ++i) { v0[i] = sigmoidf_(v0[i]); v1[i] = sigmoidf_(v1[i]); } }
                        u32x4 w; w.x = cvt_pk_bf16(v0[0], v0[1]); w.y = cvt_pk_bf16(v0[2], v0[3]); w.z = cvt_pk_bf16(v1[0], v1[1]); w.w = cvt_pk_bf16(v1[2], v1[3]);
                        *(u32x4*)(rowp + bj * HALF) = w; } }
        } else {
            const int col0 = (u.pn - NZT) * BM + wc * 32 + 8 * fq;
#pragma unroll
            for (int ai = 0; ai < 2; ++ai)
#pragma unroll
                for (int m = 0; m < 4; ++m) { float* rowp = ZS + (size_t)(row0 + ai * HALF + m * 16) * ZSP + col0; const float rs = rsv[ai][m];
#pragma unroll
                    for (int bj = 0; bj < 2; ++bj) { *(f32x4*)(rowp + bj * HALF) = acc[ai][bj][m][0] * rs; *(f32x4*)(rowp + bj * HALF + 4) = acc[ai][bj][m][1] * rs; } }
        }
    }
};

template <int P> struct EpiGate {
    static constexpr bool PERM = true, AFTER_DRAIN = false, MID = false;
    const bf16_t* G;
    float* M32;
    bf16_t* OUT;
    __device__ __forceinline__ void operator()(const f32x4 (&acc)[2][2][4][2], const Unit& u, int wr, int wc, int fr, int fq) const {
        const int row0 = u.pm * BM + wr * 64 + fr, col0 = u.pn * BM + wc * 32 + 8 * fq;
#pragma unroll
        for (int ai = 0; ai < 2; ++ai)
#pragma unroll
            for (int m = 0; m < 4; ++m) { const size_t row = (size_t)(row0 + ai * HALF + m * 16);
#pragma unroll
                for (int bj = 0; bj < 2; ++bj) { const int col = col0 + bj * HALF;
                    const u32x4 gw = *(const u32x4*)(G + row * ZP + P * 1024 + col);
                    const f32x4 v0 = acc[ai][bj][m][0], v1 = acc[ai][bj][m][1];
                    f32x4 t0, t1;
                    t0[0] = bflo(gw.x) * v0[0]; t0[1] = bfhi(gw.x) * v0[1]; t0[2] = bflo(gw.y) * v0[2]; t0[3] = bfhi(gw.y) * v0[3];
                    t1[0] = bflo(gw.z) * v1[0]; t1[1] = bfhi(gw.z) * v1[1]; t1[2] = bflo(gw.w) * v1[2]; t1[3] = bfhi(gw.w) * v1[3];
                    float* mp = M32 + row * 1024 + col;
                    if (P == 0) { *(f32x4*)mp = t0; *(f32x4*)(mp + 4) = t1; }
                    else if (P == 1) { *(f32x4*)mp = *(const f32x4*)mp + t0; *(f32x4*)(mp + 4) = *(const f32x4*)(mp + 4) + t1; }
                    else { t0 = *(const f32x4*)mp + t0; t1 = *(const f32x4*)(mp + 4) + t1;
                        u32x4 w; w.x = cvt_pk_bf16(t0[0], t0[1]); w.y = cvt_pk_bf16(t0[2], t0[3]); w.z = cvt_pk_bf16(t1[0], t1[1]); w.w = cvt_pk_bf16(t1[2], t1[3]);
                        *(u32x4*)(OUT + row * ZP + col) = w; } } }
    }
};

struct EpiGateF {
    static constexpr bool PERM = true, AFTER_DRAIN = false, MID = true;
    const bf16_t* G; bf16_t* OUT;
    __device__ __forceinline__ void mid(f32x4 (&acc)[2][2][4][2], const Unit& u, int wr, int wc, int fr_, int fq_, int s) const {
        int fr = fr_, fq = fq_; asm volatile("" : "+v"(fr), "+v"(fq));
        const int row0 = u.pm * BM + wr * 64 + fr, col0 = u.pn * BM + wc * 32 + 8 * fq;
#pragma unroll
        for (int ai = 0; ai < 2; ++ai) {
            u32x4 ga[4][2], gb[4][2];
#pragma unroll
            for (int m = 0; m < 4; ++m)
#pragma unroll
                for (int bj = 0; bj < 2; ++bj) { const bf16_t* gp = G + (size_t)(row0 + ai * HALF + m * 16) * ZP + s * 1024 + col0 + bj * HALF; ga[m][bj] = *(const u32x4*)gp; gb[m][bj] = *(const u32x4*)(gp + 1024); }
#pragma unroll
            for (int m = 0; m < 4; ++m)
#pragma unroll
                for (int bj = 0; bj < 2; ++bj) { const u32x4 a = ga[m][bj], b = gb[m][bj]; f32x4 r0, r1;
                    r0[0] = bflo(a.x) * __builtin_amdgcn_rcpf(__builtin_fmaxf(bflo(b.x), 1e-30f)); r0[1] = bfhi(a.x) * __builtin_amdgcn_rcpf(__builtin_fmaxf(bfhi(b.x), 1e-30f)); r0[2] = bflo(a.y) * __builtin_amdgcn_rcpf(__builtin_fmaxf(bflo(b.y), 1e-30f)); r0[3] = bfhi(a.y) * __builtin_amdgcn_rcpf(__builtin_fmaxf(bfhi(b.y), 1e-30f));
                    r1[0] = bflo(a.z) * __builtin_amdgcn_rcpf(__builtin_fmaxf(bflo(b.z), 1e-30f)); r1[1] = bfhi(a.z) * __builtin_amdgcn_rcpf(__builtin_fmaxf(bfhi(b.z), 1e-30f)); r1[2] = bflo(a.w) * __builtin_amdgcn_rcpf(__builtin_fmaxf(bflo(b.w), 1e-30f)); r1[3] = bfhi(a.w) * __builtin_amdgcn_rcpf(__builtin_fmaxf(bfhi(b.w), 1e-30f));
                    acc[ai][bj][m][0] = acc[ai][bj][m][0] * r0; acc[ai][bj][m][1] = acc[ai][bj][m][1] * r1; }
            __builtin_amdgcn_sched_barrier(0); }
    }
    __device__ __forceinline__ void operator()(const f32x4 (&acc)[2][2][4][2], const Unit& u, int wr, int wc, int fr, int fq) const {
        const int row0 = u.pm * BM + wr * 64 + fr, col0 = u.pn * BM + wc * 32 + 8 * fq;
#pragma unroll
        for (int ai = 0; ai < 2; ++ai)
#pragma unroll
            for (int m = 0; m < 4; ++m) { const size_t row = (size_t)(row0 + ai * HALF + m * 16);
#pragma unroll
                for (int bj = 0; bj < 2; ++bj) { const int col = col0 + bj * HALF;
                    const u32x4 gw = *(const u32x4*)(G + row * ZP + 2 * 1024 + col);
                    const f32x4 v0 = acc[ai][bj][m][0], v1 = acc[ai][bj][m][1];
                    u32x4 w; w.x = cvt_pk_bf16(bflo(gw.x) * v0[0], bfhi(gw.x) * v0[1]); w.y = cvt_pk_bf16(bflo(gw.y) * v0[2], bfhi(gw.y) * v0[3]);
                    w.z = cvt_pk_bf16(bflo(gw.z) * v1[0], bfhi(gw.z) * v1[1]); w.w = cvt_pk_bf16(bflo(gw.w) * v1[2], bfhi(gw.w) * v1[3]);
                    *(u32x4*)(OUT + row * ZP + col) = w; } }
    }
};

struct EpiRes {
    static constexpr bool PERM = true, AFTER_DRAIN = true, MID = false;
    const float* RES; float* OUT; const float* G; bf16_t* XG; float* SS;
    __device__ __forceinline__ void fused(const f32x4 (&acc)[2][2][4][2], const Unit& u, int wr, int wc, int fr, int fq, PG8_LAS unsigned char* lds, int wid, int lane) const {
        const int row0 = u.pm * BM + wr * 64 + fr, col0 = u.pn * BM + wc * 32 + 8 * fq;
        PG8_LAS float* P = (PG8_LAS float*)lds;
        f32x4 g[2][2];
#pragma unroll
        for (int bj = 0; bj < 2; ++bj) { g[bj][0] = *(const f32x4*)(G + col0 + bj * HALF); g[bj][1] = *(const f32x4*)(G + col0 + bj * HALF + 4); }
#pragma unroll
        for (int ai = 0; ai < 2; ++ai)
#pragma unroll
            for (int m = 0; m < 4; ++m) { const int row = row0 + ai * HALF + m * 16; const size_t off = (size_t)row * 1024 + col0; float ss = 0.f;
#pragma unroll
                for (int bj = 0; bj < 2; ++bj) { const float* rp = RES + off + bj * HALF; float* op = OUT + off + bj * HALF;
                    const f32x4 v0 = *(const f32x4*)rp + acc[ai][bj][m][0], v1 = *(const f32x4*)(rp + 4) + acc[ai][bj][m][1];
                    *(f32x4*)op = v0; *(f32x4*)(op + 4) = v1;
                    ss += ((v0[0] * v0[0] + v0[1] * v0[1]) + (v0[2] * v0[2] + v0[3] * v0[3])) + ((v1[0] * v1[0] + v1[1] * v1[1]) + (v1[2] * v1[2] + v1[3] * v1[3]));
                    const f32x4 x0 = v0 * g[bj][0], x1 = v1 * g[bj][1];
                    u32x4 w; w.x = cvt_pk_bf16(x0[0], x0[1]); w.y = cvt_pk_bf16(x0[2], x0[3]); w.z = cvt_pk_bf16(x1[0], x1[1]); w.w = cvt_pk_bf16(x1[2], x1[3]);
                    *(u32x4*)(XG + off + bj * HALF) = w; }
                ss += sx<16>(ss); { unsigned a, b; swap32(__builtin_bit_cast(unsigned, ss), a, b); ss = __builtin_bit_cast(float, a) + __builtin_bit_cast(float, b); }
                if (fq == 0) P[(ai * HALF + wr * 64 + m * 16 + fr) * 4 + wc] = ss; }
        asm volatile("s_waitcnt lgkmcnt(0)\n\ts_barrier" ::: "memory");
        const int t = wid * 64 + lane;
        if (t < 256) { const f32x4 p = *(const PG8_LAS f32x4*)(P + t * 4); SS[(size_t)(u.pm * BM + t) * 4 + u.pn] = (p[0] + p[1]) + (p[2] + p[3]); }
    }
};

struct EpiSwi {
    static constexpr bool PERM = true, AFTER_DRAIN = false, MID = false;
    bf16_t* H; int ldh; const float* SS;
    __device__ __forceinline__ void operator()(const f32x4 (&acc)[2][2][4][2], const Unit& u, int wr, int wc, int fr, int fq) const {
        const int row0 = u.pm * BM + wr * 64 + fr, col0 = u.pn * HALF + wc * 32 + 8 * fq;
        PRELOAD_RSTD(rsv, SS, row0);
#pragma unroll
        for (int ai = 0; ai < 2; ++ai)
#pragma unroll
            for (int m = 0; m < 4; ++m) { bf16_t* hp = H + (size_t)(row0 + ai * HALF + m * 16) * ldh + col0; const float rs = rsv[ai][m];
                float o[8];
#pragma unroll
                for (int n = 0; n < 2; ++n)
#pragma unroll
                    for (int i = 0; i < 4; ++i) { const float g = acc[ai][0][m][n][i] * rs, up = acc[ai][1][m][n][i] * rs; o[4 * n + i] = g * sigmoidf_(g) * up; }
                u32x4 w; w.x = cvt_pk_bf16(o[0], o[1]); w.y = cvt_pk_bf16(o[2], o[3]); w.z = cvt_pk_bf16(o[4], o[5]); w.w = cvt_pk_bf16(o[6], o[7]);
                *(u32x4*)hp = w; }
    }
};

template <class Epi, class Sched, bool ALIGN_EPI = false, bool SP2 = false>
__device__ __forceinline__ void gemm_phase(PG8_LAS unsigned char* lds, Gemm g, const Sched& S0, const Epi& E, int wave_id) {
    int ovz, osz; asm volatile("v_mov_b32 %0, 0\n\ts_mov_b32 %1, 0" : "=v"(ovz), "=s"(osz));
    Sched S = S0; S.c += osz; g.lda += osz; g.ldb += osz;
    const int tid = ((wave_id << 6) | lane_id_v()) + ovz,
         wid = __builtin_amdgcn_readfirstlane(tid >> 6), lane = tid & 63, wr = wid >> 2, wc = wid & 3, fr = lane & 15, fq = lane >> 4;
    const int K = g.K, nt = K / BK;
    unsigned voffA[2], voffB[2];
#pragma unroll
    for (int i = 0; i < 2; ++i) { int R, C; stage_rc(tid * 16 + i * 8192, R, C); const int Rb = Epi::PERM ? ((R & ~31) + perm32(R & 31)) : R;
        voffA[i] = (unsigned)(R * g.lda + C) * 2u; voffB[i] = (unsigned)(Rb * g.ldb + C) * 2u; }
    const size_t kstep = (size_t)(BK * 2);
    const size_t hstepA = (size_t)HALF * g.lda * 2, hstepB = (size_t)HALF * g.ldb * 2;
    const size_t tstepA = 2 * hstepA, tstepB = 2 * hstepB;
    const unsigned ldsw = (unsigned)wid * 1024u;
    const int aoff = lds_byte(wr * 64 + fr, fq * 8), boff = lds_byte(wc * 32 + fr, fq * 8);
#define PG8_SA(b, h) (((b) * 2 + (h)) * HTB)
#define PG8_SB(b, h) ((4 + (b) * 2 + (h)) * HTB)
#define PG8_STAGE(bufoff, gbase, voff) do { _Pragma("unroll") for (int _i = 0; _i < 2; ++_i) \
        __builtin_amdgcn_global_load_lds((const unsigned*)((const char*)(gbase) + (voff)[_i]), (PG8_LAS unsigned*)(lds + (bufoff) + ldsw + _i * 8192), 16, 0, 0); } while (0)
#define PG8_LDA(dst, b, h) do { _Pragma("unroll") for (int m = 0; m < 4; ++m) _Pragma("unroll") for (int k = 0; k < 2; ++k) dst[m][k] = *(const PG8_LAS bf16x8*)(lds + PG8_SA(b, h) + aoff + m * 2048 + k * 1024); } while (0)
#define PG8_LDB(dst, b, h) do { _Pragma("unroll") for (int n = 0; n < 2; ++n) _Pragma("unroll") for (int k = 0; k < 2; ++k) dst[n][k] = *(const PG8_LAS bf16x8*)(lds + PG8_SB(b, h) + boff + n * 2048 + k * 1024); } while (0)
#define PG8_MMA(ai, bj, At, Bt) do { __builtin_amdgcn_s_setprio(1); _Pragma("unroll") for (int m = 0; m < 4; ++m) _Pragma("unroll") for (int n = 0; n < 2; ++n) _Pragma("unroll") for (int k = 0; k < 2; ++k) \
        acc[ai][bj][m][n] = __builtin_amdgcn_mfma_f32_16x16x32_bf16(Bt[n][k], At[m][k], acc[ai][bj][m][n], 0, 0, 0); __builtin_amdgcn_s_setprio(0); } while (0)
#define PG8_WAIT_V(n) asm volatile("s_waitcnt vmcnt(" #n ")" ::: "memory")
#define PG8_WAIT_L(n) asm volatile("s_waitcnt lgkmcnt(" #n ")" ::: "memory")
#define PG8_BAR __builtin_amdgcn_s_barrier()
#define PG8_SCHED __builtin_amdgcn_sched_barrier(0)
    Unit cur, nxt; int ui = 0;
    if (!S.next(0, cur)) return;
    f32x4 acc[2][2][4][2];
#pragma unroll
    for (int a = 0; a < 2; ++a)
#pragma unroll
        for (int b = 0; b < 2; ++b)
#pragma unroll
            for (int m = 0; m < 4; ++m)
#pragma unroll
                for (int n = 0; n < 2; ++n) acc[a][b][m][n] = (f32x4){0.f, 0.f, 0.f, 0.f};
    bf16x8 At[4][2], B0[2][2], B1[2][2];
    const char* cA = (const char*)g.A + (size_t)cur.pm * tstepA; const char* cB = (const char*)g.Bt + (size_t)cur.pn * tstepB;
    S.a_ready(cur);
    if constexpr (SP2) {
        PG8_STAGE(PG8_SB(0, 0), cB, voffB); PG8_STAGE(PG8_SB(0, 1), cB + hstepB, voffB); PG8_STAGE(PG8_SA(0, 0), cA, voffA); PG8_STAGE(PG8_SA(0, 1), cA + hstepA, voffA);
        if (wr == 1) PG8_BAR;
        PG8_WAIT_V(2); PG8_BAR;
        PG8_STAGE(PG8_SB(1, 0), cB + kstep, voffB); PG8_STAGE(PG8_SA(1, 0), cA + kstep, voffA); PG8_STAGE(PG8_SB(1, 1), cB + hstepB + kstep, voffB);
        PG8_WAIT_V(6); PG8_BAR;
    } else {
        PG8_STAGE(PG8_SB(0, 0), cB, voffB); PG8_STAGE(PG8_SA(0, 0), cA, voffA); PG8_STAGE(PG8_SB(0, 1), cB + hstepB, voffB); PG8_STAGE(PG8_SA(0, 1), cA + hstepA, voffA);
        if (wr == 1) PG8_BAR;
        PG8_WAIT_V(4); PG8_BAR;
        PG8_STAGE(PG8_SB(1, 0), cB + kstep, voffB); PG8_STAGE(PG8_SA(1, 0), cA + kstep, voffA); PG8_STAGE(PG8_SB(1, 1), cB + hstepB + kstep, voffB);
        PG8_WAIT_V(6); PG8_BAR;
    }
    for (;;) {
        const bool has_next = S.next(ui + 1, nxt);
        const char* nA = has_next ? (const char*)g.A + (size_t)nxt.pm * tstepA : cA; const char* nB = has_next ? (const char*)g.Bt + (size_t)nxt.pn * tstepB : cB;
        for (int t = 0; t < nt; t += 2) {
            if constexpr (Epi::MID) { if (t == 8 || t == 16) E.mid(acc, cur, wr, wc, fr, fq, (t >> 3) - 1); }
            const bool last = (t == nt - 2);
            const char* a1 = cA + (size_t)(t + 1) * kstep;
            const char* a2 = last ? nA : cA + (size_t)(t + 2) * kstep; const char* b2 = last ? nB : cB + (size_t)(t + 2) * kstep;
            const char* a3 = a2 + kstep; const char* b3 = b2 + kstep;
            if (last && has_next) S.a_ready(nxt);
            if constexpr (SP2) {
            PG8_LDB(B0, 0, 0); PG8_LDB(B1, 0, 1); PG8_SCHED; PG8_LDA(At, 0, 0); PG8_STAGE(PG8_SA(1, 1), a1 + hstepA, voffA);
            PG8_WAIT_V(8); PG8_WAIT_L(0); PG8_BAR; PG8_MMA(0, 0, At, B0); PG8_MMA(0, 1, At, B1); PG8_BAR; PG8_SCHED;
            PG8_LDA(At, 0, 1); PG8_STAGE(PG8_SB(0, 0), b2, voffB); PG8_STAGE(PG8_SB(0, 1), b2 + hstepB, voffB); PG8_STAGE(PG8_SA(0, 0), a2, voffA);
            PG8_WAIT_V(8); PG8_WAIT_L(0); PG8_BAR; PG8_MMA(1, 0, At, B0); PG8_MMA(1, 1, At, B1); PG8_BAR; PG8_SCHED;
            PG8_LDB(B0, 1, 0); PG8_LDB(B1, 1, 1); PG8_SCHED; PG8_LDA(At, 1, 0); PG8_STAGE(PG8_SA(0, 1), a2 + hstepA, voffA);
            PG8_WAIT_V(8); PG8_WAIT_L(0); PG8_BAR; PG8_MMA(0, 0, At, B0); PG8_MMA(0, 1, At, B1); PG8_BAR; PG8_SCHED;
            PG8_LDA(At, 1, 1); PG8_STAGE(PG8_SB(1, 0), b3, voffB); PG8_STAGE(PG8_SB(1, 1), b3 + hstepB, voffB); PG8_STAGE(PG8_SA(1, 0), a3, voffA);
            PG8_WAIT_V(8); PG8_WAIT_L(0); PG8_BAR; PG8_MMA(1, 0, At, B0); PG8_MMA(1, 1, At, B1); PG8_BAR; PG8_SCHED;
            } else {
            PG8_LDB(B0, 0, 0); PG8_SCHED; PG8_LDA(At, 0, 0); PG8_STAGE(PG8_SA(1, 1), a1 + hstepA, voffA);
            PG8_WAIT_L(8); PG8_BAR; PG8_WAIT_L(0); PG8_MMA(0, 0, At, B0); PG8_BAR; PG8_SCHED;
            PG8_LDB(B1, 0, 1); PG8_STAGE(PG8_SB(0, 0), b2, voffB);
            PG8_BAR; PG8_WAIT_L(0); PG8_MMA(0, 1, At, B1); PG8_BAR;
            PG8_LDA(At, 0, 1); PG8_STAGE(PG8_SA(0, 0), a2, voffA);
            PG8_BAR; PG8_WAIT_L(0); PG8_MMA(1, 0, At, B0); PG8_BAR; PG8_SCHED;
            PG8_STAGE(PG8_SB(0, 1), b2 + hstepB, voffB);
            PG8_WAIT_V(6); PG8_BAR; PG8_MMA(1, 1, At, B1); PG8_BAR;
            PG8_LDB(B0, 1, 0); PG8_SCHED; PG8_LDA(At, 1, 0); PG8_STAGE(PG8_SA(0, 1), a2 + hstepA, voffA);
            PG8_WAIT_L(8); PG8_BAR; PG8_WAIT_L(0); PG8_MMA(0, 0, At, B0); PG8_BAR; PG8_SCHED;
            PG8_LDB(B1, 1, 1); PG8_STAGE(PG8_SB(1, 0), b3, voffB);
            PG8_BAR; PG8_WAIT_L(0); PG8_MMA(0, 1, At, B1); PG8_BAR;
            PG8_LDA(At, 1, 1); PG8_STAGE(PG8_SA(1, 0), a3, voffA);
            PG8_BAR; PG8_WAIT_L(0); PG8_MMA(1, 0, At, B0); PG8_BAR; PG8_SCHED;
            PG8_STAGE(PG8_SB(1, 1), b3 + hstepB, voffB);
            PG8_WAIT_V(6); PG8_BAR; PG8_MMA(1, 1, At, B1); PG8_BAR;
            }
        }
        if constexpr (ALIGN_EPI) { if (wr == 0) PG8_BAR; }
        if constexpr (!Epi::AFTER_DRAIN) { E(acc, cur, wr, wc, fr, fq); S.done(cur); }
        if (!has_next) break;
#pragma unroll
        for (int a = 0; a < 2; ++a)
#pragma unroll
            for (int b = 0; b < 2; ++b)
#pragma unroll
                for (int m = 0; m < 4; ++m)
#pragma unroll
                    for (int n = 0; n < 2; ++n) acc[a][b][m][n] = (f32x4){0.f, 0.f, 0.f, 0.f};
        cur = nxt; cA = nA; cB = nB; ++ui;
        if constexpr (ALIGN_EPI) { if (wr == 1) PG8_BAR; }
    }
    PG8_WAIT_V(0);
    if constexpr (!ALIGN_EPI) { if (wr == 0) PG8_BAR; }
    PG8_BAR;
    if constexpr (Epi::AFTER_DRAIN) { E.fused(acc, cur, wr, wc, fr, fq, lds, wid, lane); S.done(cur); }
#undef PG8_SA
#undef PG8_SB
#undef PG8_STAGE
#undef PG8_LDA
#undef PG8_LDB
#undef PG8_MMA
#undef PG8_WAIT_V
#undef PG8_WAIT_L
#undef PG8_BAR
#undef PG8_SCHED
}
}

constexpr int NB = 4, SEQ = 4096, DM = 1024, DEPTH = 4, M = NB * SEQ;
constexpr int INC = 7088;
constexpr int NIN = 7168;
constexpr int FFH = 2816, FF2 = 5632;
constexpr int ZP = pg8::ZP, ZSP = pg8::ZSP;
constexpr int Z_FQ = 0, Z_DQ = 512, Z_RV = 1024, Z_FK = 1536, Z_FV = 2048,
     Z_RQ = 2560, Z_RK = 2816, Z_RG = 3072, Z_ZG = 3584, Z_MRG = 2560;
constexpr int S_IQ = 0, S_DK = 256, S_DV = 320, S_IK = 384, S_IW = 416, S_FF = 424;
constexpr float NORM_EPS = 1e-6f;
constexpr float LOG2E = 1.4426950408889634f;
constexpr float C2 = 0.125f * 1.4426950408889634f;

constexpr size_t MiB = 1u << 20;
constexpr size_t WS_CTL = 0, CTL_ZERO_BYTES = 1 * MiB;
constexpr size_t WS_ROPE64 = 1 * MiB;
constexpr size_t WS_ROPE32 = 2 * MiB;
constexpr size_t WS_LF = 2 * MiB + 512 * 1024;
constexpr size_t WS_CF = 3 * MiB;
constexpr size_t WS_ISG = 3 * MiB + 512 * 1024;
constexpr size_t WS_KD = 4 * MiB;
constexpr size_t WS_VD = 6 * MiB;
constexpr size_t WS_W = 8 * MiB;
constexpr size_t LW_IN = 0, LW_MIX = (size_t)NIN * 1024, LW_O = LW_MIX + 1536 * 1024, LW_FI = LW_O + 1024 * 1024, LW_FO = LW_FI + (size_t)FF2 * 1024, LW_STRIDE = LW_FO + (size_t)FFH * 1024;
constexpr size_t WS_Z = 150 * MiB;
constexpr size_t WS_HDN = 358 * MiB;
constexpr size_t WS_ZS = 390 * MiB;
constexpr size_t WS_IQB = 422 * MiB;
constexpr size_t WS_IKB = 430 * MiB;
constexpr size_t WS_SS = 431 * MiB;
constexpr size_t WS_END = 432 * MiB;
static_assert(WS_W + DEPTH * LW_STRIDE * 2 <= WS_Z && WS_Z + (size_t)M * ZP * 2 <= WS_HDN && WS_HDN + (size_t)M * 1024 * 2 == WS_ZS && WS_ZS + (size_t)M * ZSP * 4 == WS_IQB, "d_ws map");
constexpr int CW_BAR = 4096;

constexpr int RING_OFF = 0, RING_BYTES = 133120;
constexpr int LDSCTL_OFF = RING_BYTES, MISC_OFF = LDSCTL_OFF + 320;
constexpr int XTRA_OFF = RING_BYTES + 1024;
constexpr int LDS_BYTES = 147456;
constexpr int NWAVES = 8;
#define GAS __attribute__((address_space(1)))
#define LAS __attribute__((address_space(3)))
typedef unsigned short bf16;
typedef unsigned v4u __attribute__((ext_vector_type(4)));
typedef float f32x4 __attribute__((ext_vector_type(4)));
typedef short bf16x8 __attribute__((ext_vector_type(8)));
typedef GAS unsigned gu32;
typedef GAS unsigned long long gu64;
#define RLX_AGENT __ATOMIC_RELAXED, __HIP_MEMORY_SCOPE_AGENT
#define LDS_WAIT() asm volatile("s_waitcnt lgkmcnt(0)" ::: "memory")
#define VM_WAIT() asm volatile("s_waitcnt vmcnt(0)" ::: "memory")
__device__ __forceinline__ unsigned long long rt() { return __builtin_amdgcn_s_memrealtime(); }
__device__ __forceinline__ unsigned f2bf(float f) { unsigned u = __builtin_bit_cast(unsigned, f); return (u + 0x7fffu + ((u >> 16) & 1u)) >> 16; }
__device__ __forceinline__ unsigned pk2(float lo, float hi) { unsigned r; asm("v_cvt_pk_bf16_f32 %0, %1, %2" : "=v"(r) : "v"(lo), "v"(hi)); return r; }

#define XB_TMO      128
#define XB_XCNT(j)  (256  + 64 * (j))
#define XB_XSUB(j)  (1280 + 64 * (j))
#define XB_XGEN(j)  (2304 + 64 * (j))
#define XB_TOP      3328
#define XB_TOPGEN   3392
#define XCD_BAR_WORDS 3456
#define XB_SPIN_CAP (1u << 22)

__device__ __forceinline__ unsigned xb_ld(unsigned* p)              { return __hip_atomic_load(p, __ATOMIC_RELAXED, __HIP_MEMORY_SCOPE_AGENT); }
__device__ __forceinline__ unsigned xb_add(unsigned* p, unsigned v) { return __hip_atomic_fetch_add(p, v, __ATOMIC_RELAXED, __HIP_MEMORY_SCOPE_AGENT); }
__device__ __forceinline__ unsigned xb_xcc_id() { return (unsigned)__builtin_amdgcn_s_getreg((3 << 11) | 20) & 0xFu; }
#define XB_SPIN(cond, bar) do { unsigned _sp = 0; while (cond) { __builtin_amdgcn_s_sleep(1); \
    if ((++_sp & 255u) == 0u) { if (xb_ld(&(bar)[XB_TMO])) break; if (_sp > XB_SPIN_CAP) { atomicAdd(&(bar)[XB_TMO], 1u); break; } } } } while (0)

struct XcdBarrier {
    unsigned* bar; unsigned x; int w;
    volatile LAS unsigned* st;
};

__device__ __forceinline__ XcdBarrier xcd_barrier_post(unsigned* bar, volatile LAS unsigned* st) {
    XcdBarrier b; b.bar = bar; b.x = xb_xcc_id(); b.st = st; b.w = 0;
    if (threadIdx.x == 0) (void)xb_add(&bar[XB_XCNT(b.x)], 1u);
    return b;
}
__device__ __forceinline__ void xcd_barrier_complete(unsigned* bar, unsigned x, unsigned& nloc, unsigned& nx) {
    const unsigned G = gridDim.x * gridDim.y * gridDim.z;
    unsigned sum, cnt, mine, sp = 0u;
    for (;;) {
        sum = 0u; cnt = 0u; mine = 0u;
#pragma unroll
        for (unsigned j = 0; j < 16; ++j) { const unsigned c = xb_ld(&bar[XB_XCNT(j)]); sum += c; cnt += (c > 0u) ? 1u : 0u; mine = (j == x) ? c : mine; }
        if (sum == G) break;
        __builtin_amdgcn_s_sleep(1);
        if ((++sp & 255u) == 0u) { if (xb_ld(&bar[XB_TMO])) break; if (sp > XB_SPIN_CAP) { atomicAdd(&bar[XB_TMO], 1u); break; } }
    }
    nloc = mine > 0u ? mine : 1u; nx = cnt > 0u ? cnt : 1u;
}

__device__ __forceinline__ void xcd_barrier(const XcdBarrier& b) {
    asm volatile("s_waitcnt vmcnt(0)" ::: "memory");
    __syncthreads();
    if (b.w == 0 && lane_id_v() == 0) {
        unsigned* bar = b.bar;
        __builtin_amdgcn_s_waitcnt(0);
        unsigned nloc = b.st[0], nx = b.st[1];
        if (nloc == 0u) { xcd_barrier_complete(bar, b.x, nloc, nx); b.st[0] = nloc; b.st[1] = nx; }
        const unsigned old = xb_add(&bar[XB_XSUB(b.x)], 1u);
        const unsigned gen = old / nloc;
        if (old + 1u == (gen + 1u) * nloc) {
            __builtin_amdgcn_fence(__ATOMIC_RELEASE, "agent");
            asm volatile("s_waitcnt vmcnt(0)" ::: "memory");
            const unsigned og = xb_add(&bar[XB_TOP], 1u);
            const unsigned tg = og / nx;
            if (og + 1u == (tg + 1u) * nx) xb_add(&bar[XB_TOPGEN], 1u);
            else XB_SPIN(xb_ld(&bar[XB_TOPGEN]) == tg, bar);
            __builtin_amdgcn_fence(__ATOMIC_ACQUIRE, "agent");
            xb_add(&bar[XB_XGEN(b.x)], 1u);
            asm volatile("s_waitcnt vmcnt(0)" ::: "memory");
        } else {
            XB_SPIN(xb_ld(&bar[XB_XGEN(b.x)]) == gen, bar);
            __builtin_amdgcn_fence(__ATOMIC_ACQUIRE, "agent");
            asm volatile("s_waitcnt vmcnt(0)" ::: "memory");
        }
    }
    __syncthreads();
}

typedef float f32x2 __attribute__((ext_vector_type(2)));
typedef unsigned u32x2 __attribute__((ext_vector_type(2)));
__device__ __forceinline__ float bflo(unsigned w) { return __builtin_bit_cast(float, w << 16); }
__device__ __forceinline__ float bfhi(unsigned w) { return __builtin_bit_cast(float, w & 0xffff0000u); }
__device__ __forceinline__ float bf2f(bf16 v) { return __builtin_bit_cast(float, (unsigned)v << 16); }
__device__ __forceinline__ void unpack8(const v4u w, float (&f)[8]) { f[0] = bflo(w.x); f[1] = bfhi(w.x); f[2] = bflo(w.y); f[3] = bfhi(w.y); f[4] = bflo(w.z); f[5] = bfhi(w.z); f[6] = bflo(w.w); f[7] = bfhi(w.w); }
__device__ __forceinline__ v4u pack8(const float (&f)[8]) { v4u w; w.x = pk2(f[0], f[1]); w.y = pk2(f[2], f[3]); w.z = pk2(f[4], f[5]); w.w = pk2(f[6], f[7]); return w; }
__device__ __forceinline__ float xor32(float v, int lane) {
    return __builtin_bit_cast(float, __builtin_amdgcn_ds_bpermute((lane ^ 32) << 2, __builtin_bit_cast(int, v)));
}
__device__ __forceinline__ float sigmoid_f(float x) { return 1.0f / (1.0f + __expf(-x)); }

struct Ctx {
    LAS unsigned char* lds;
    int tid, lane, wave, G, gw, NGW;
    float* out; unsigned char* ws;
};

__device__ __forceinline__ void conv_item(const float* W, int N, int sc, int nv, int k0, bf16* WT, int ldw, int dr, LAS float* scr, int lane) {
    const int n_ = lane & 31;
#pragma unroll 8
    for (int i = 0; i < 32; ++i) { const int kk = 2 * i + (lane >> 5); scr[kk * 33 + n_] = (n_ < nv) ? W[(size_t)(k0 + kk) * N + sc + n_] : 0.f; }
    LDS_WAIT(); asm volatile("" ::: "memory");
    const int c = lane & 7;
#pragma unroll
    for (int j = 0; j < 4; ++j) { const int n = (lane >> 3) + 8 * j; const LAS float* s = scr + (8 * c) * 33 + n;
        v4u o; o.x = pk2(s[0 * 33], s[1 * 33]); o.y = pk2(s[2 * 33], s[3 * 33]); o.z = pk2(s[4 * 33], s[5 * 33]); o.w = pk2(s[6 * 33], s[7 * 33]);
        if (n < nv) *(GAS v4u*)(WT + (size_t)(dr + n) * ldw + k0 + 8 * c) = o; }
    LDS_WAIT(); asm volatile("" ::: "memory");
}
__device__ const int SEG_IN[15][3] = {
    {0, Z_FQ, 512}, {512, Z_FK, 512}, {1024, Z_FV, 512}, {1536, 6656 + S_FF, 8}, {1544, Z_DQ, 512}, {2056, 6656 + S_DK, 64}, {2120, 6656 + S_DV, 64},
    {2184, 6656 + S_IQ, 256}, {2440, 6656 + S_IK, 32}, {2472, 6656 + S_IW, 8}, {2480, Z_RQ, 256}, {2736, Z_RK, 256}, {2992, Z_RV, 512}, {3504, Z_RG, 512}, {4016, Z_ZG, 3072}};
constexpr int IN_BLK = 223;
constexpr int IT_IN = 16 * IN_BLK, IT_MIX = 8 * 32, IT_O = 16 * 32, IT_FI = 16 * (FF2 / 32), IT_FO = (FFH / 64) * 32;
constexpr int IT_LAYER = IT_IN + 3 * IT_MIX + IT_O + IT_FI + IT_FO;

__device__ __forceinline__ void sincos_acc(float ang, float& c, float& s) {
    const double a = (double)ang;
    const double k = __builtin_rint(a * 0.6366197723675814);
    double y = a - k * 1.5707963267948966; y -= k * 6.123233995736766e-17;
    const double y2 = y * y;
    double sp = -7.647163731819816e-13; sp = sp * y2 + 1.6059043836821613e-10; sp = sp * y2 - 2.505210838544172e-08; sp = sp * y2 + 2.7557319223985893e-06; sp = sp * y2 - 1.984126984126984e-04; sp = sp * y2 + 8.333333333333333e-03; sp = sp * y2 - 1.6666666666666666e-01;
    const double sn = y + y * y2 * sp;
    double cp = 4.779477332387385e-14; cp = cp * y2 - 1.1470745597729725e-11; cp = cp * y2 + 2.08767569878681e-09; cp = cp * y2 - 2.755731922398589e-07; cp = cp * y2 + 2.48015873015873e-05; cp = cp * y2 - 1.388888888888889e-03; cp = cp * y2 + 4.1666666666666664e-02; cp = cp * y2 - 0.5;
    const double cs = 1.0 + y2 * cp;
    const int q = ((int)k) & 3;
    const double ss = (q & 1) ? cs : sn, cc = (q & 1) ? sn : cs;
    s = (float)((q & 2) ? -ss : ss);
    c = (float)(((q + 1) & 2) ? -cc : cc);
}

__device__ __forceinline__ void p0_prologue(const Ctx& F, const float* w_in, const float* w_fox, const float* w_dsa, const float* w_ret, const float* w_o, const float* w_fi, const float* w_fo) {
    LAS float* scr = (LAS float*)(F.lds + RING_OFF + F.wave * 16384);
    bf16* Wb = (bf16*)(F.ws + WS_W);
    for (int it = F.gw; it < DEPTH * IT_LAYER; it += F.NGW) {
        const int l = it / IT_LAYER; int r = it % IT_LAYER;
        bf16* L = Wb + (size_t)l * LW_STRIDE;
        if (r < IT_IN) {
            const int kb = r / IN_BLK; int blk = r % IN_BLK; int sc = 0, dr = 0, nv = 0;
            for (int s = 0; s < 15; ++s) { const int w = SEG_IN[s][2], nb = (w + 31) >> 5; if (blk < nb) { sc = SEG_IN[s][0] + 32 * blk; dr = SEG_IN[s][1] + 32 * blk; nv = (w - 32 * blk) < 32 ? (w - 32 * blk) : 32;
                if (s == 0 || s == 1 || s == 4) { const int hd = blk >> 1; dr = SEG_IN[s][1] + (hd >> 2) * 256 + 128 * (blk & 1) + 32 * (hd & 3); }
                break; } blk -= nb; }
            conv_item(w_in + (size_t)l * DM * INC, INC, sc, nv, 64 * kb, L + LW_IN, 1024, dr, scr, F.lane); continue; }
        r -= IT_IN;
        if (r < 3 * IT_MIX) { const int w = r / IT_MIX, q = r % IT_MIX, kb = q / 32, nb = q % 32;
            conv_item((w == 0 ? w_fox : w == 1 ? w_dsa : w_ret) + (size_t)l * 512 * DM, DM, 32 * nb, 32, 64 * kb, L + LW_MIX + (size_t)w * 512, 1536, 32 * nb, scr, F.lane); continue; }
        r -= 3 * IT_MIX;
        if (r < IT_O) { const int kb = r / 32, nb = r % 32;
            conv_item(w_o + (size_t)l * DM * DM, DM, 32 * nb, 32, 64 * kb, L + LW_O, 1024, 32 * nb, scr, F.lane); continue; }
        r -= IT_O;
        if (r < IT_FI) { const int kb = r / (FF2 / 32), nb = r % (FF2 / 32); const int n0 = 32 * nb;
            const int j = n0 < FFH ? n0 : n0 - FFH; const int dr = 256 * (j >> 7) + (j & 127) + (n0 < FFH ? 0 : 128);
            conv_item(w_fi + (size_t)l * DM * FF2, FF2, n0, 32, 64 * kb, L + LW_FI, 1024, dr, scr, F.lane); continue; }
        r -= IT_FI;
        { const int kb = r / 32, nb = r % 32;
            conv_item(w_fo + (size_t)l * FFH * DM, DM, 32 * nb, 32, 64 * kb, L + LW_FO, FFH, 32 * nb, scr, F.lane); }
    }
    for (int i = F.gw * 64 + F.lane; i < DEPTH * 80 * 128; i += F.NGW * 64) { const int l = i / (80 * 128), q = i % (80 * 128);
        *(GAS v4u*)(Wb + (size_t)l * LW_STRIDE + LW_IN + (size_t)INC * 1024 + (size_t)q * 8) = (v4u){0u, 0u, 0u, 0u}; }
    f32x2* R64 = (f32x2*)(F.ws + WS_ROPE64); f32x2* R32 = (f32x2*)(F.ws + WS_ROPE32);
    for (int i = F.gw * 64 + F.lane; i < SEQ * 32; i += F.NGW * 64) { const int pos = i >> 5, k = i & 31;
        double f = 1.0; for (int e = 0; e < k; ++e) f *= 0.7498942093324559;
        const float ang = (float)pos * (float)f; float c, s; sincos_acc(ang, c, s); R64[i] = (f32x2){c, s}; }
    for (int i = F.gw * 64 + F.lane; i < SEQ * 16; i += F.NGW * 64) { const int pos = i >> 4, k = i & 15;
        double f = 1.0; for (int e = 0; e < k; ++e) f *= 0.5623413251903491;
        const float ang = (float)pos * (float)f; float c, s; sincos_acc(ang, c, s); R32[i] = (f32x2){c, s}; }
}

__device__ __forceinline__ void norm0_phase(const Ctx& F, const float* x, const float* g, bf16* o, float* SS) {
    const GAS f32x4* gp = (const GAS f32x4*)g + F.lane;
    f32x4 gv[4];
#pragma unroll
    for (int j = 0; j < 4; ++j) gv[j] = gp[64 * j];
    for (int m = F.gw; m < M; m += F.NGW) {
        const GAS f32x4* xr = (const GAS f32x4*)(x + (size_t)m * DM) + F.lane;
        f32x4 v[4]; float s = 0.f;
#pragma unroll
        for (int j = 0; j < 4; ++j) { v[j] = xr[64 * j]; s += (v[j].x * v[j].x + v[j].y * v[j].y) + (v[j].z * v[j].z + v[j].w * v[j].w); }
        s = wave_sum(s);
        GAS unsigned long long* o8 = (GAS unsigned long long*)(o + (size_t)m * DM) + F.lane;
#pragma unroll
        for (int j = 0; j < 4; ++j) o8[64 * j] = (unsigned long long)pk2(v[j].x * gv[j].x, v[j].y * gv[j].y) | ((unsigned long long)pk2(v[j].z * gv[j].z, v[j].w * gv[j].w) << 32);
        if (F.lane < 4) SS[(size_t)m * 4 + F.lane] = (F.lane == 0) ? s : 0.f;
    }
}

__device__ __forceinline__ void post_phase(const Ctx& F, const float* g_fq, const float* g_fk, const float* g_dq, const float* g_dk, const float* b_f, bool dummy_out = false) {
    bf16* Z = (bf16*)(F.ws + WS_Z); const float* ZS = (const float*)(F.ws + WS_ZS);
    const f32x2* R64 = (const f32x2*)(F.ws + WS_ROPE64); const f32x2* R32 = (const f32x2*)(F.ws + WS_ROPE32);
    float* LF = (float*)(F.ws + WS_LF); unsigned* ISG = (unsigned*)(F.ws + WS_ISG);
    bf16* KD = (bf16*)(F.ws + WS_KD); bf16* VD = (bf16*)(F.ws + WS_VD); bf16* IQB = (bf16*)(F.ws + WS_IQB); bf16* IKB = (bf16*)(F.ws + WS_IKB);
    const int t0 = blockIdx.x * 512 + F.tid, NT = F.G * 512;
    for (int t = t0; t < M * 8; t += NT) { const int m = t >> 3, h = t & 7; const float* sp = ZS + (size_t)m * ZSP + S_IQ + h * 32;
        f32x4 v[8];
#pragma unroll
        for (int i = 0; i < 8; ++i) v[i] = *(const GAS f32x4*)(sp + 4 * i);
        const float aw = fabsf(ZS[(size_t)m * ZSP + S_IW + h]);
        const f32x2* cs = R32 + (m & (SEQ - 1)) * 16; float f[32];
#pragma unroll
        for (int i = 0; i < 8; ++i) { f[4 * i] = v[i].x; f[4 * i + 1] = v[i].y; f[4 * i + 2] = v[i].z; f[4 * i + 3] = v[i].w; }
#pragma unroll
        for (int d = 0; d < 16; ++d) { const f32x2 tt = cs[d]; const float x1 = f[d], x2 = f[d + 16]; f[d] = (x1 * tt.x - x2 * tt.y) * aw; f[d + 16] = (x2 * tt.x + x1 * tt.y) * aw; }
        bf16* op = IQB + (size_t)m * 256 + h * 32;
#pragma unroll
        for (int i = 0; i < 4; ++i) { float t8[8];
#pragma unroll
            for (int j = 0; j < 8; ++j) t8[j] = f[8 * i + j];
            *(GAS v4u*)(op + 8 * i) = pack8(t8); }
    }
    const int part = blockIdx.x & 3;
    for (int m = (blockIdx.x >> 2) * 512 + F.tid; m < M; m += (F.G >> 2) * 512) { const float* sr = ZS + (size_t)m * ZSP; const int pos = m & (SEQ - 1);
        if (part == 0) { float f[64]; float ss = 0.f;
#pragma unroll
            for (int i = 0; i < 16; ++i) { const f32x4 v = *(const GAS f32x4*)(sr + S_DK + 4 * i); f[4 * i] = v.x; f[4 * i + 1] = v.y; f[4 * i + 2] = v.z; f[4 * i + 3] = v.w; ss += (v.x * v.x + v.y * v.y) + (v.z * v.z + v.w * v.w); }
            const float rs = 1.0f / sqrtf(ss * (1.f / 64) + NORM_EPS); const f32x2* cs = R64 + pos * 32;
#pragma unroll
            for (int d = 0; d < 64; ++d) f[d] = f[d] * rs * g_dk[d];
#pragma unroll
            for (int d = 0; d < 32; ++d) { const f32x2 tt = cs[d]; const float x1 = f[d], x2 = f[d + 32]; f[d] = x1 * tt.x - x2 * tt.y; f[d + 32] = x2 * tt.x + x1 * tt.y; }
#pragma unroll
            for (int i = 0; i < 8; ++i) { float t8[8];
#pragma unroll
                for (int j = 0; j < 8; ++j) t8[j] = f[8 * i + j];
                *(GAS v4u*)(KD + (size_t)m * 64 + 8 * i) = pack8(t8); } }
        if (part == 1)
#pragma unroll
        for (int i = 0; i < 8; ++i) { const f32x4 a = *(const GAS f32x4*)(sr + S_DV + 8 * i), b = *(const GAS f32x4*)(sr + S_DV + 8 * i + 4); const float t8[8] = {a.x, a.y, a.z, a.w, b.x, b.y, b.z, b.w};
            *(GAS v4u*)(VD + (size_t)m * 64 + 8 * i) = pack8(t8); }
        if (part == 2) { float f[32]; const f32x2* cs = R32 + pos * 16;
#pragma unroll
            for (int i = 0; i < 8; ++i) { const f32x4 v = *(const GAS f32x4*)(sr + S_IK + 4 * i); f[4 * i] = v.x; f[4 * i + 1] = v.y; f[4 * i + 2] = v.z; f[4 * i + 3] = v.w; }
#pragma unroll
            for (int d = 0; d < 16; ++d) { const f32x2 tt = cs[d]; const float x1 = f[d], x2 = f[d + 16]; f[d] = x1 * tt.x - x2 * tt.y; f[d + 16] = x2 * tt.x + x1 * tt.y; }
#pragma unroll
            for (int i = 0; i < 4; ++i) { float t8[8];
#pragma unroll
                for (int j = 0; j < 8; ++j) t8[j] = f[8 * i + j];
                *(GAS v4u*)(IKB + (size_t)m * 32 + 8 * i) = pack8(t8); } }
        if (part == 3) { const f32x4 w0 = *(const GAS f32x4*)(sr + S_IW), w1 = *(const GAS f32x4*)(sr + S_IW + 4); const float iw[8] = {w0.x, w0.y, w0.z, w0.w, w1.x, w1.y, w1.z, w1.w}; unsigned sg = 0;
#pragma unroll
            for (int h = 0; h < 8; ++h) sg |= (iw[h] < 0.f ? 1u : 0u) << h;
            ISG[m] = sg;
            const f32x4 f0 = *(const GAS f32x4*)(sr + S_FF), f1 = *(const GAS f32x4*)(sr + S_FF + 4); const float ff[8] = {f0.x, f0.y, f0.z, f0.w, f1.x, f1.y, f1.z, f1.w}; float lf[8];
#pragma unroll
            for (int h = 0; h < 8; ++h) { const float xx = ff[h] + b_f[h]; lf[h] = (fminf(xx, 0.f) - __logf(1.0f + __expf(-fabsf(xx)))) * LOG2E; }
            *(GAS f32x4*)(LF + (size_t)m * 8) = (f32x4){lf[0], lf[1], lf[2], lf[3]}; *(GAS f32x4*)(LF + (size_t)m * 8 + 4) = (f32x4){lf[4], lf[5], lf[6], lf[7]}; }
    }
}

__device__ __forceinline__ float ret_l2g(int h) { return h == 0 ? -0.04580368961312479f : h == 1 ? -0.02272007650008353f : h == 2 ? -0.011315313227834146f : -0.005646563141142063f; }

__device__ __forceinline__ void scan_state_phase(const Ctx& F) {
    const float* LF = (const float*)(F.ws + WS_LF); float* CF = (float*)(F.ws + WS_CF);
    const bf16* Z = (const bf16*)(F.ws + WS_Z); float* RS = (float*)(F.ws + WS_HDN);
    if (F.gw < 32) {
        const int b = F.gw >> 3, h = F.gw & 7; const float* lp = LF + ((size_t)b * SEQ + F.lane * 64) * 8 + h; float s = 0.f;
        for (int i = 0; i < 64; ++i) s += lp[i * 8];
        float incl = s;
#pragma unroll
        for (int o = 1; o < 64; o <<= 1) { const float t = __builtin_bit_cast(float, __builtin_amdgcn_ds_bpermute(((F.lane - o) & 63) << 2, __builtin_bit_cast(int, incl))); if (F.lane >= o) incl += t; }
        float run = incl - s; float* cp = CF + (size_t)F.gw * SEQ + F.lane * 64;
        for (int i = 0; i < 64; ++i) { run += lp[i * 8]; cp[i] = run; }
    }
    for (int u = blockIdx.x; u < NB * 32 * 4; u += F.G) {
        const int h = u & 3, c = (u >> 2) & 31, b = u >> 7; const float l2g = ret_l2g(h);
        const int d = F.tid >> 3, e0 = (F.tid & 7) * 16; float acc[16];
#pragma unroll
        for (int i = 0; i < 16; ++i) acc[i] = 0.f;
        const bf16* base = Z + ((size_t)b * SEQ + c * 128) * ZP;
        for (int j = 0; j < 128; ++j) { const bf16* row = base + (size_t)j * ZP;
            const float kd = bf2f(row[Z_RK + h * 64 + d]) * exp2f((float)(127 - j) * l2g);
            const v4u w0 = *(const GAS v4u*)(row + Z_RV + h * 128 + e0), w1 = *(const GAS v4u*)(row + Z_RV + h * 128 + e0 + 8);
            float v0[8], v1[8]; unpack8(w0, v0); unpack8(w1, v1);
#pragma unroll
            for (int i = 0; i < 8; ++i) { acc[i] += kd * v0[i]; acc[8 + i] += kd * v1[i]; } }
        float* o = RS + (size_t)u * 8192 + d * 128 + e0;
#pragma unroll
        for (int i = 0; i < 4; ++i) *(GAS f32x4*)(o + 4 * i) = (f32x4){acc[4 * i], acc[4 * i + 1], acc[4 * i + 2], acc[4 * i + 3]};
    }
}

__device__ __forceinline__ void ret_out_naive(const Ctx& F, const float* gn) {
    bf16* Z = (bf16*)(F.ws + WS_Z); const float* RS = (const float*)(F.ws + WS_HDN);
    LAS float* S = (LAS float*)(F.lds);
    LAS bf16* Vt = (LAS bf16*)(F.lds + 32768);
    LAS float* Kt = (LAS float*)(F.lds + 65536);
    LAS float* aw = (LAS float*)(F.lds + 65536 + 33280) + F.wave * 128;
    LAS float* qw = (LAS float*)(F.lds + 65536 + 33280 + 4096) + F.wave * 64;
    for (int u = blockIdx.x; u < NB * 32 * 4; u += F.G) {
        const int h = u & 3, c = (u >> 2) & 31, b = u >> 7; const float l2g = ret_l2g(h); const float wch = exp2f(128.f * l2g);
        __syncthreads();
        { float s[16];
#pragma unroll
            for (int i = 0; i < 16; ++i) s[i] = 0.f;
            for (int cp = 0; cp < c; ++cp) { const float* L = RS + ((size_t)((b * 32 + cp) * 4 + h)) * 8192 + F.tid;
#pragma unroll
                for (int i = 0; i < 16; ++i) s[i] = wch * s[i] + L[i * 512]; }
#pragma unroll
            for (int i = 0; i < 16; ++i) S[F.tid + i * 512] = s[i]; }
        const bf16* base = Z + ((size_t)b * SEQ + c * 128) * ZP;
        for (int q = F.tid; q < 2048; q += 512) { const int r = q >> 4, ch = q & 15; *(LAS v4u*)(Vt + r * 128 + ch * 8) = *(const GAS v4u*)(base + (size_t)r * ZP + Z_RV + h * 128 + ch * 8); }
        for (int q = F.tid; q < 128 * 64; q += 512) { const int r = q >> 6, dd = q & 63; Kt[r * 65 + dd] = bf2f(base[(size_t)r * ZP + Z_RK + h * 64 + dd]); }
        __syncthreads();
        for (int i = F.wave; i < 128; i += NWAVES) {
            const size_t m = (size_t)b * SEQ + c * 128 + i; bf16* zr = Z + m * ZP;
            qw[F.lane] = bf2f(zr[Z_RQ + h * 64 + F.lane]);
            LDS_WAIT(); asm volatile("" ::: "memory");
#pragma unroll
            for (int jj = 0; jj < 2; ++jj) { const int j = F.lane + 64 * jj; float a = 0.f;
                if (j <= i) { float dot = 0.f; for (int dd = 0; dd < 64; ++dd) dot += qw[dd] * Kt[j * 65 + dd]; a = dot * exp2f((float)(i - j) * l2g); }
                aw[j] = a; }
            LDS_WAIT(); asm volatile("" ::: "memory");
            float o[2]; const float dq = exp2f((float)(i + 1) * l2g);
#pragma unroll
            for (int ee = 0; ee < 2; ++ee) { const int e = F.lane + 64 * ee; float acc = 0.f;
                for (int j = 0; j <= i; ++j) acc += aw[j] * bf2f(Vt[j * 128 + e]);
                float cr = 0.f; for (int dd = 0; dd < 64; ++dd) cr += qw[dd] * S[dd * 128 + e];
                o[ee] = acc + cr * dq; }
            const float ss = wave_sum(o[0] * o[0] + o[1] * o[1]); const float rstd = 1.0f / sqrtf(ss * (1.f / 128) + NORM_EPS);
#pragma unroll
            for (int ee = 0; ee < 2; ++ee) { const int e = F.lane + 64 * ee; const float rg = bf2f(zr[Z_RG + h * 128 + e]);
                zr[Z_RV + h * 128 + e] = (bf16)f2bf(o[ee] * rstd * gn[h * 128 + e] * rg * sigmoid_f(rg)); }
            LDS_WAIT(); asm volatile("" ::: "memory");
        }
    }
    __syncthreads();
}

__device__ __forceinline__ void fox_naive(const Ctx& F) {
    bf16* Z = (bf16*)(F.ws + WS_Z); const float* CF = (const float*)(F.ws + WS_CF);
    LAS float* sc = (LAS float*)(F.lds + F.wave * 16384);
    const int lane = F.lane;
    int it = 0;
    for (int r0 = 0; r0 < NB * 8 * SEQ; r0 += F.NGW, ++it) {
        const int r = r0 + ((it & 1) ? (F.NGW - 1 - F.gw) : F.gw);
        if (r >= NB * 8 * SEQ) continue;
        const int pos = r & (SEQ - 1), h = (r >> 12) & 7, b = r >> 15;
        const size_t m = (size_t)b * SEQ + pos;
        float qf[64];
        { const bf16* qp = Z + m * ZP + Z_FQ + h * 64;
#pragma unroll
            for (int i = 0; i < 8; ++i) { const v4u w = *(const GAS v4u*)(qp + 8 * i); float t[8]; unpack8(w, t);
#pragma unroll
                for (int j = 0; j < 8; ++j) qf[8 * i + j] = t[j]; } }
        const float* cf = CF + (size_t)(b * 8 + h) * SEQ;
        float mx = -INFINITY;
        for (int kk = lane; kk <= pos; kk += 64) { const bf16* kp = Z + ((size_t)b * SEQ + kk) * ZP + Z_FK + h * 64; float dot = 0.f;
#pragma unroll
            for (int i = 0; i < 8; ++i) { const v4u w = *(const GAS v4u*)(kp + 8 * i); float t[8]; unpack8(w, t);
#pragma unroll
                for (int j = 0; j < 8; ++j) dot += qf[8 * i + j] * t[j]; }
            const float s = dot - cf[kk]; sc[kk] = s; mx = fmaxf(mx, s); }
        mx = wave_max(mx);
        float sum = 0.f;
        for (int kk = lane; kk <= pos; kk += 64) { const float p = exp2f(sc[kk] - mx); sc[kk] = p; sum += p; }
        sum = wave_sum(sum);
        LDS_WAIT(); asm volatile("" ::: "memory");
        const bf16* vp = Z + (size_t)b * SEQ * ZP + Z_FV + h * 64 + lane;
        float o0 = 0.f, o1 = 0.f, o2 = 0.f, o3 = 0.f; int kk = 0;
        for (; kk + 3 <= pos; kk += 4) { o0 += sc[kk] * bf2f(vp[(size_t)kk * ZP]); o1 += sc[kk + 1] * bf2f(vp[(size_t)(kk + 1) * ZP]); o2 += sc[kk + 2] * bf2f(vp[(size_t)(kk + 2) * ZP]); o3 += sc[kk + 3] * bf2f(vp[(size_t)(kk + 3) * ZP]); }
        for (; kk <= pos; ++kk) o0 += sc[kk] * bf2f(vp[(size_t)kk * ZP]);
        Z[m * ZP + Z_FQ + h * 64 + lane] = (bf16)f2bf(((o0 + o1) + (o2 + o3)) / sum);
        LDS_WAIT(); asm volatile("" ::: "memory");
    }
}

__device__ __forceinline__ unsigned f2key(float s) { const unsigned u = __builtin_bit_cast(unsigned, s + 0.0f); return (u & 0x80000000u) ? ~u : (u | 0x80000000u); }
__device__ __forceinline__ void dsa_naive(const Ctx& F) {
    bf16* Z = (bf16*)(F.ws + WS_Z); const float* ZS = (const float*)(F.ws + WS_ZS);
    const unsigned* ISG = (const unsigned*)(F.ws + WS_ISG);
    const bf16* KD = (const bf16*)(F.ws + WS_KD); const bf16* VD = (const bf16*)(F.ws + WS_VD);
    LAS unsigned* kl = (LAS unsigned*)(F.lds + F.wave * 16384);
    LAS float* iqs = (LAS float*)(F.lds + XTRA_OFF + F.wave * 1536);
    const int lane = F.lane;
    int it = 0;
    for (int r0 = 0; r0 < M; r0 += F.NGW, ++it) {
        const int r = r0 + ((it & 1) ? (F.NGW - 1 - F.gw) : F.gw);
        if (r >= M) continue;
        const int pos = r & (SEQ - 1), b = r >> 12; const size_t m = (size_t)r;
        *(LAS f32x4*)(iqs + 4 * lane) = *(const GAS f32x4*)(ZS + m * ZSP + S_IQ + 4 * lane);
        const unsigned sg = ISG[m];
        LDS_WAIT(); asm volatile("" ::: "memory");
        for (int kk = lane; kk <= pos; kk += 64) { const float* ikp = ZS + ((size_t)b * SEQ + kk) * ZSP + S_IK; float ik[32];
#pragma unroll
            for (int i = 0; i < 8; ++i) { const f32x4 t = *(const GAS f32x4*)(ikp + 4 * i); ik[4 * i] = t.x; ik[4 * i + 1] = t.y; ik[4 * i + 2] = t.z; ik[4 * i + 3] = t.w; }
            float s = 0.f;
#pragma unroll 1
            for (int h = 0; h < 8; ++h) { float dot = 0.f;
#pragma unroll
                for (int dd = 0; dd < 32; ++dd) dot += iqs[h * 32 + dd] * ik[dd];
                dot = fmaxf(dot, 0.f); s += ((sg >> h) & 1u) ? -dot : dot; }
            kl[kk] = f2key(s); }
        LDS_WAIT(); asm volatile("" ::: "memory");
        unsigned key[64];
#pragma unroll
        for (int j = 0; j < 64; ++j) { const int kk = j * 64 + lane; key[j] = (kk <= pos) ? kl[kk] : 0u; }
        LDS_WAIT(); asm volatile("" ::: "memory");
        LAS unsigned* idx = kl; LAS float* pl = (LAS float*)(kl + 256); LAS bf16* qs = (LAS bf16*)(kl + 512);
        *(LAS v4u*)(qs + 8 * lane) = *(const GAS v4u*)(Z + m * ZP + Z_DQ + 8 * lane);
        unsigned T = 0u; int need = 0;
        if (pos + 1 > 256) {
            for (int bit = 31; bit >= 0; --bit) { const unsigned Tt = T | (1u << bit); int cnt = 0;
#pragma unroll
                for (int j = 0; j < 64; ++j) cnt += __builtin_popcountll(__ballot(key[j] >= Tt));
                if (cnt >= 256) T = Tt; }
            int ngt = 0;
#pragma unroll
            for (int j = 0; j < 64; ++j) ngt += __builtin_popcountll(__ballot(key[j] > T));
            need = 256 - ngt;
        }
        int nsel = 0, eqb = 0;
#pragma unroll
        for (int j = 0; j < 64; ++j) { const bool gt = key[j] > T, eq = (key[j] == T) && (T != 0u);
            const unsigned long long em = __ballot(eq); const int er = eqb + __builtin_amdgcn_mbcnt_hi((unsigned)(em >> 32), __builtin_amdgcn_mbcnt_lo((unsigned)em, 0u));
            const bool sel = gt || (eq && er < need); eqb += __builtin_popcountll(em);
            const unsigned long long sm = __ballot(sel); const int sp = nsel + __builtin_amdgcn_mbcnt_hi((unsigned)(sm >> 32), __builtin_amdgcn_mbcnt_lo((unsigned)sm, 0u));
            if (sel) idx[sp] = (unsigned)(j * 64 + lane); nsel += __builtin_popcountll(sm); }
        LDS_WAIT(); asm volatile("" ::: "memory");
        for (int h = 0; h < 8; ++h) {
            float sv[4]; float mx = -INFINITY;
#pragma unroll
            for (int i = 0; i < 4; ++i) { const int e = lane + 64 * i; sv[i] = -INFINITY;
                if (e < nsel) { const bf16* kp = KD + ((size_t)b * SEQ + idx[e]) * 64; float dot = 0.f;
#pragma unroll
                    for (int c = 0; c < 8; ++c) { const v4u w = *(const GAS v4u*)(kp + 8 * c); float t[8]; unpack8(w, t); const v4u qw = *(const LAS v4u*)(qs + h * 64 + 8 * c); float qq[8]; unpack8(qw, qq);
#pragma unroll
                        for (int j = 0; j < 8; ++j) dot += qq[j] * t[j]; }
                    sv[i] = dot; }
                mx = fmaxf(mx, sv[i]); }
            mx = wave_max(mx); float sum = 0.f;
#pragma unroll
            for (int i = 0; i < 4; ++i) { const int e = lane + 64 * i; const float p = (e < nsel) ? exp2f(sv[i] - mx) : 0.f; pl[e] = p; sum += p; }
            sum = wave_sum(sum);
            LDS_WAIT(); asm volatile("" ::: "memory");
            float o0 = 0.f, o1 = 0.f; int e = 0;
            for (; e + 1 < nsel; e += 2) { o0 += pl[e] * bf2f(VD[((size_t)b * SEQ + idx[e]) * 64 + lane]); o1 += pl[e + 1] * bf2f(VD[((size_t)b * SEQ + idx[e + 1]) * 64 + lane]); }
            if (e < nsel) o0 += pl[e] * bf2f(VD[((size_t)b * SEQ + idx[e]) * 64 + lane]);
            Z[m * ZP + Z_DQ + h * 64 + lane] = (bf16)f2bf((o0 + o1) / sum);
            LDS_WAIT(); asm volatile("" ::: "memory");
        }
    }
}
#ifndef PROBE_D
#define PROBE_D 0
#endif

typedef short s16x8 __attribute__((ext_vector_type(8)));
typedef short s16x4 __attribute__((ext_vector_type(4)));
typedef short v4i16_t __attribute__((ext_vector_type(4)));
__device__ __forceinline__ s16x4 tr16(const LAS unsigned char* p) { return __builtin_bit_cast(s16x4, __builtin_amdgcn_ds_read_tr16_b64_v4i16((LAS v4i16_t*)p)); }
__device__ __forceinline__ float key2f(unsigned k) { return __builtin_bit_cast(float, (k & 0x80000000u) ? (k & 0x7fffffffu) : ~k); }

template <int NR> __device__ __forceinline__ int dsa_count_ge(const unsigned (&key)[64], unsigned T) {
    int c = 0;
#pragma unroll
    for (int j = 0; j < NR; ++j) c += __builtin_popcountll(__ballot(key[j] >= T));
    return c;
}
#define DSA_COUNT_GE(T_, out_) do { if (nq == 1) out_ = dsa_count_ge<16>(key, (T_)); else if (nq == 2) out_ = dsa_count_ge<32>(key, (T_)); else if (nq == 3) out_ = dsa_count_ge<48>(key, (T_)); else out_ = dsa_count_ge<64>(key, (T_)); } while (0)
__device__ __forceinline__ void dsa_select(const unsigned (&key)[64], int nvalid, unsigned& T, int& need) {
    const int nq = __builtin_amdgcn_readfirstlane((nvalid + 1023) >> 10);
    T = 0u; need = 0;
    if (nvalid <= 256) return;
    unsigned kmax = 0u;
#pragma unroll
    for (int j = 0; j < 64; ++j) kmax = key[j] > kmax ? key[j] : kmax;
#pragma unroll
    for (int o_ = 0; o_ < 1; ++o_) { unsigned t; t = sxu<1>(kmax); kmax = t > kmax ? t : kmax; t = sxu<2>(kmax); kmax = t > kmax ? t : kmax; t = sxu<4>(kmax); kmax = t > kmax ? t : kmax; t = sxu<8>(kmax); kmax = t > kmax ? t : kmax; t = sxu<16>(kmax); kmax = t > kmax ? t : kmax;
        unsigned a_, b_; swap32(kmax, a_, b_); kmax = a_ > b_ ? a_ : b_; }
    unsigned lo = 1u, hi = kmax + 1u; int hic = 0;
    { const float vm = fabsf(key2f(kmax)) + 1.0f; unsigned l2 = f2key(-vm * 64.0f); int c; DSA_COUNT_GE(l2, c); if (c >= 256) lo = l2; }
    int iter = 0; bool exact = false;
    while (hi - lo > 1u) {
        unsigned mid;
        if (iter < 24 && lo > 1u) { const float mv = 0.5f * key2f(lo) + 0.5f * key2f(hi - 1u); mid = f2key(mv); }
        else mid = lo + ((hi - lo) >> 1);
        if (mid <= lo) mid = lo + 1u; if (mid >= hi) mid = hi - 1u;
        int c; DSA_COUNT_GE(mid, c);
        if (c == 256) { T = mid; exact = true; break; }
        if (c > 256) lo = mid; else { hi = mid; hic = c; }
        ++iter;
    }
    if (exact) need = 256; else { T = lo; need = 256 - hic; }
}

__device__ __forceinline__ void dsa_attend(const bf16* zq, bf16* zo, const bf16* KDb, const bf16* VDb, const LAS unsigned short* idx, int nsel, LAS unsigned char* vst, int lane) {
    const int g = lane >> 4, c = lane & 15;
    s16x8 qf[2];
#pragma unroll
    for (int ks = 0; ks < 2; ++ks) { qf[ks] = (s16x8){0, 0, 0, 0, 0, 0, 0, 0}; if (c < 8) qf[ks] = *(const GAS s16x8*)(zq + c * 64 + 32 * ks + 8 * g); }
    f32x4 acc[16];
    v4u vreg[16];
#pragma unroll
    for (int i = 0; i < 16; ++i) { const int pi = lane + 64 * i, r = pi >> 3, c16 = pi & 7; const int id = (r < nsel) ? (int)idx[r] : 0; vreg[i] = *(const GAS v4u*)(VDb + (size_t)id * 64 + c16 * 8); }
#pragma unroll
    for (int tb = 0; tb < 2; ++tb) {
        s16x8 kf[8][2];
#pragma unroll
        for (int tt = 0; tt < 8; ++tt) { const int e = 16 * (8 * tb + tt) + c; const int id = (e < nsel) ? (int)idx[e] : 0; const bf16* kp = KDb + (size_t)id * 64 + 8 * g;
            kf[tt][0] = *(const GAS s16x8*)kp; kf[tt][1] = *(const GAS s16x8*)(kp + 32); }
#pragma unroll
        for (int tt = 0; tt < 8; ++tt) { f32x4 a = (f32x4){0.f, 0.f, 0.f, 0.f};
            a = __builtin_amdgcn_mfma_f32_16x16x32_bf16(kf[tt][0], qf[0], a, 0, 0, 0); a = __builtin_amdgcn_mfma_f32_16x16x32_bf16(kf[tt][1], qf[1], a, 0, 0, 0); acc[8 * tb + tt] = a; }
    }
    float mx = -INFINITY;
#pragma unroll
    for (int t = 0; t < 16; ++t)
#pragma unroll
        for (int i = 0; i < 4; ++i) { const int e = 16 * t + 4 * g + i; if (nsel < 256 && e >= nsel) acc[t][i] = -INFINITY; mx = fmaxf(mx, acc[t][i]); }
    mx = fmaxf(mx, sx<16>(mx)); mx = half_max(mx);
    float sum = 0.f;
#pragma unroll
    for (int t = 0; t < 16; ++t)
#pragma unroll
        for (int i = 0; i < 4; ++i) { const float p = __builtin_amdgcn_exp2f(acc[t][i] - mx); acc[t][i] = p; sum += p; }
    sum += sx<16>(sum); sum = half_sum(sum);
    const float inv = 1.0f / sum;
    s16x8 pf[8];
#pragma unroll
    for (int s = 0; s < 8; ++s) { v4u w; w.x = pk2(acc[2 * s][0] * inv, acc[2 * s][1] * inv); w.y = pk2(acc[2 * s][2] * inv, acc[2 * s][3] * inv); w.z = pk2(acc[2 * s + 1][0] * inv, acc[2 * s + 1][1] * inv); w.w = pk2(acc[2 * s + 1][2] * inv, acc[2 * s + 1][3] * inv);
        pf[s] = __builtin_bit_cast(s16x8, w); }
    f32x4 o[4];
#pragma unroll
    for (int db = 0; db < 4; ++db) o[db] = (f32x4){0.f, 0.f, 0.f, 0.f};
    const int q = (lane >> 2) & 3, p = lane & 3, swz = 2 * (g & 1) + (q >> 1);
    const LAS unsigned char* rb = vst + (4 * g + q) * 128 + 8 * p;
#pragma unroll
    for (int hh = 0; hh < 2; ++hh) {
        asm volatile("s_waitcnt lgkmcnt(0)" ::: "memory");
#pragma unroll
        for (int i = 0; i < 16; ++i) { const int pi = lane + 64 * i, r = pi >> 3, c16 = pi & 7;
            *(LAS v4u*)(vst + r * 128 + ((((c16 >> 1) ^ ((r >> 1) & 3))) << 5) + ((c16 & 1) << 4)) = vreg[i]; }
        if (hh == 0) {
#pragma unroll
            for (int i = 0; i < 16; ++i) { const int pi = lane + 64 * i, r = pi >> 3, c16 = pi & 7, e = 128 + r; const int id = (e < nsel) ? (int)idx[e] : 0; vreg[i] = *(const GAS v4u*)(VDb + (size_t)id * 64 + c16 * 8); } }
        asm volatile("s_waitcnt lgkmcnt(0)" ::: "memory");
#pragma unroll
        for (int s4 = 0; s4 < 4; ++s4)
#pragma unroll
            for (int db = 0; db < 4; ++db) { const LAS unsigned char* a1 = rb + s4 * 4096 + ((db ^ swz) << 5);
                const s16x4 lo = tr16(a1), hi = tr16(a1 + 2048);
                const s16x8 vf = (s16x8){lo[0], lo[1], lo[2], lo[3], hi[0], hi[1], hi[2], hi[3]};
                o[db] = __builtin_amdgcn_mfma_f32_16x16x32_bf16(pf[4 * hh + s4], vf, o[db], 0, 0, 0); }
    }
    if (g < 2) {
#pragma unroll
        for (int db = 0; db < 4; ++db)
#pragma unroll
            for (int i = 0; i < 4; ++i) zo[(4 * g + i) * 64 + 16 * db + c] = (bf16)f2bf(o[db][i]);
    }
}

__device__ __forceinline__ void dsa_v2(const Ctx& F) {
    bf16* Z = (bf16*)(F.ws + WS_Z); const float* ZS = (const float*)(F.ws + WS_ZS);
    const unsigned* ISG = (const unsigned*)(F.ws + WS_ISG);
    const bf16* KD = (const bf16*)(F.ws + WS_KD); const bf16* VD = (const bf16*)(F.ws + WS_VD);
    LAS unsigned* kl = (LAS unsigned*)(F.lds + F.wave * 16384);
    LAS float* iqs = (LAS float*)(F.lds + XTRA_OFF + F.wave * 1536);
    LAS unsigned short* idx = (LAS unsigned short*)(F.lds + XTRA_OFF + F.wave * 1536 + 1024);
    const int lane = F.lane;
    int it = 0;
    for (int r0 = 0; r0 < M; r0 += F.NGW, ++it) {
        const int r = r0 + ((it & 1) ? (F.NGW - 1 - F.gw) : F.gw);
        if (r >= M) continue;
        const int pos = r & (SEQ - 1), b = r >> 12; const size_t m = (size_t)r;
        *(LAS f32x4*)(iqs + 4 * lane) = *(const GAS f32x4*)(ZS + m * ZSP + S_IQ + 4 * lane);
        const unsigned sg = ISG[m];
        LDS_WAIT(); asm volatile("" ::: "memory");
        for (int kk = lane; kk <= pos; kk += 64) { const float* ikp = ZS + ((size_t)b * SEQ + kk) * ZSP + S_IK; float ik[32];
#pragma unroll
            for (int i = 0; i < 8; ++i) { const f32x4 t = *(const GAS f32x4*)(ikp + 4 * i); ik[4 * i] = t.x; ik[4 * i + 1] = t.y; ik[4 * i + 2] = t.z; ik[4 * i + 3] = t.w; }
            float s = 0.f;
#pragma unroll 1
            for (int h = 0; h < 8; ++h) { float dot = 0.f;
#pragma unroll
                for (int dd = 0; dd < 32; ++dd) dot += iqs[h * 32 + dd] * ik[dd];
                dot = fmaxf(dot, 0.f); s += ((sg >> h) & 1u) ? -dot : dot; }
            kl[kk] = f2key(s); }
        LDS_WAIT(); asm volatile("" ::: "memory");
        unsigned key[64];
#pragma unroll
        for (int j = 0; j < 64; ++j) { const int kk = j * 64 + lane; key[j] = (kk <= pos) ? kl[kk] : 0u; }
        LDS_WAIT(); asm volatile("" ::: "memory");
        unsigned T; int need;
#ifdef DSA_OLDSEL
        T = 0u; need = 0;
        if (pos + 1 > 256) {
            for (int bit = 31; bit >= 0; --bit) { const unsigned Tt = T | (1u << bit); int cnt = 0;
#pragma unroll
                for (int j = 0; j < 64; ++j) cnt += __builtin_popcountll(__ballot(key[j] >= Tt));
                if (cnt >= 256) T = Tt; }
            int ngt = 0;
#pragma unroll
            for (int j = 0; j < 64; ++j) ngt += __builtin_popcountll(__ballot(key[j] > T));
            need = 256 - ngt;
        }
#else
        dsa_select(key, pos + 1, T, need);
#endif
        int nsel = 0, eqb = 0;
#pragma unroll
        for (int j = 0; j < 64; ++j) { const bool gt = key[j] > T, eq = (key[j] == T) && (T != 0u);
            const unsigned long long em = __ballot(eq); const int er = eqb + __builtin_amdgcn_mbcnt_hi((unsigned)(em >> 32), __builtin_amdgcn_mbcnt_lo((unsigned)em, 0u));
            const bool sel = gt || (eq && er < need); eqb += __builtin_popcountll(em);
            const unsigned long long sm = __ballot(sel); const int sp = nsel + __builtin_amdgcn_mbcnt_hi((unsigned)(sm >> 32), __builtin_amdgcn_mbcnt_lo((unsigned)sm, 0u));
            if (sel) idx[sp] = (unsigned short)(j * 64 + lane); nsel += __builtin_popcountll(sm); }
        LDS_WAIT(); asm volatile("" ::: "memory");
        dsa_attend(Z + m * ZP + Z_DQ, Z + m * ZP + Z_DQ, KD + (size_t)b * SEQ * 64, VD + (size_t)b * SEQ * 64, idx, nsel, (LAS unsigned char*)kl, lane);
        LDS_WAIT(); asm volatile("" ::: "memory");
    }
}

template <int NR> __device__ __forceinline__ int dsa_emit_n(const unsigned (&key)[64], unsigned T, int need, LAS unsigned short* idx, int lane) {
    int nsel = 0, eqb = 0;
#pragma unroll
    for (int j = 0; j < NR; ++j) { const bool gt = key[j] > T, eq = (key[j] == T) && (T != 0u);
        const unsigned long long em = __ballot(eq); const int er = eqb + __builtin_amdgcn_mbcnt_hi((unsigned)(em >> 32), __builtin_amdgcn_mbcnt_lo((unsigned)em, 0u));
        const bool sel = gt || (eq && er < need); eqb += __builtin_popcountll(em);
        const unsigned long long sm = __ballot(sel); const int sp = nsel + __builtin_amdgcn_mbcnt_hi((unsigned)(sm >> 32), __builtin_amdgcn_mbcnt_lo((unsigned)sm, 0u));
        if (sel) idx[sp] = (unsigned short)(j * 64 + lane); nsel += __builtin_popcountll(sm); }
    return nsel;
}
__device__ __forceinline__ int dsa_emit(const unsigned (&key)[64], int nvalid, unsigned T, int need, LAS unsigned short* idx, int lane) {
    const int nq = __builtin_amdgcn_readfirstlane((nvalid + 1023) >> 10);
    if (nq == 1) return dsa_emit_n<16>(key, T, need, idx, lane);
    if (nq == 2) return dsa_emit_n<32>(key, T, need, idx, lane);
    if (nq == 3) return dsa_emit_n<48>(key, T, need, idx, lane);
    return dsa_emit_n<64>(key, T, need, idx, lane);
}

#define DSA_CNT8(cnt_, k_, o_, T_) asm volatile( \
    "v_cmp_ge_u32_e64 s[60:61], %1, %9\n\tv_cmp_ge_u32_e64 s[62:63], %2, %9\n\tv_cmp_ge_u32_e64 s[64:65], %3, %9\n\tv_cmp_ge_u32_e64 s[66:67], %4, %9\n\t" \
    "v_cmp_ge_u32_e64 s[68:69], %5, %9\n\tv_cmp_ge_u32_e64 s[70:71], %6, %9\n\tv_cmp_ge_u32_e64 s[72:73], %7, %9\n\tv_cmp_ge_u32_e64 s[74:75], %8, %9\n\t" \
    "v_addc_co_u32_e64 %0, s[76:77], 0, %0, s[60:61]\n\tv_addc_co_u32_e64 %0, s[76:77], 0, %0, s[62:63]\n\tv_addc_co_u32_e64 %0, s[76:77], 0, %0, s[64:65]\n\tv_addc_co_u32_e64 %0, s[76:77], 0, %0, s[66:67]\n\t" \
    "v_addc_co_u32_e64 %0, s[76:77], 0, %0, s[68:69]\n\tv_addc_co_u32_e64 %0, s[76:77], 0, %0, s[70:71]\n\tv_addc_co_u32_e64 %0, s[76:77], 0, %0, s[72:73]\n\tv_addc_co_u32_e64 %0, s[76:77], 0, %0, s[74:75]" \
    : "+v"(cnt_) : "v"(k_[o_]), "v"(k_[o_ + 1]), "v"(k_[o_ + 2]), "v"(k_[o_ + 3]), "v"(k_[o_ + 4]), "v"(k_[o_ + 5]), "v"(k_[o_ + 6]), "v"(k_[o_ + 7]), "s"(T_) \
    : "s60", "s61", "s62", "s63", "s64", "s65", "s66", "s67", "s68", "s69", "s70", "s71", "s72", "s73", "s74", "s75", "s76", "s77")
template <int NR> __device__ __forceinline__ int dsa_lane_count(const unsigned (&key)[64], unsigned T) {
    int c = 0; const unsigned Ts = (unsigned)__builtin_amdgcn_readfirstlane((int)T);
#pragma unroll
    for (int j = 0; j < NR; j += 8) DSA_CNT8(c, key, j, Ts);
    return c;
}
#define DSA_LCOUNT(T_, lc_) do { if (nq == 1) lc_ = dsa_lane_count<16>(key, (T_)); else if (nq == 2) lc_ = dsa_lane_count<32>(key, (T_)); else if (nq == 3) lc_ = dsa_lane_count<48>(key, (T_)); else lc_ = dsa_lane_count<64>(key, (T_)); } while (0)
template <int NR> __device__ __forceinline__ void dsa_write_ge(const unsigned (&key)[64], unsigned T, int off, LAS unsigned short* idx, int lane) {
    const int dummy = 256 + lane;
#pragma unroll
    for (int j = 0; j < NR; ++j) { const bool s = key[j] >= T; idx[s ? off : dummy] = (unsigned short)(j * 64 + lane); off += s ? 1 : 0; }
}
__device__ __forceinline__ int dsa_select2(const unsigned (&key)[64], int nvalid, float s1, float s2, LAS unsigned short* idx, int lane) {
    const int nq = __builtin_amdgcn_readfirstlane((nvalid + 1023) >> 10);
    unsigned T = 1u; int lc = 0; bool exact = true;
    if (nvalid > 256) {
        const float n = (float)nvalid, mean = s1 / n, sd = sqrtf(fmaxf(s2 / n - mean * mean, 1e-30f));
        const float pfrac = 256.0f / n, pt = fminf(pfrac, 1.0f - pfrac);
        const float tt = sqrtf(-2.0f * __logf(fmaxf(pt, 1e-6f)));
        float zn = (0.010328f * tt + 0.802853f) * tt + 2.515517f; asm volatile("" : "+v"(zn));
        float zd = ((0.001308f * tt + 0.189269f) * tt + 1.432788f) * tt + 1.0f; asm volatile("" : "+v"(zd));
        float z = tt - zn / zd;
        if (pfrac > 0.5f) z = -z;
        const float dens = n * __expf(-0.5f * z * z) * 0.3989423f / sd;
        unsigned lo = 1u, hi = 0xffffffffu; int clo = nvalid, chi = 0;
        bool lop = false, hip = false; float lastv = mean + z * sd, lastc = 256.0f, grow = 1.3f;
        exact = false; int same = 0, last = 0;
        for (int it = 0; hi - lo > 1u; ++it) {
            unsigned mid;
            if (it == 0) mid = f2key(lastv);
            else if (!(lop && hip)) { lastv = lastv + grow * (lastc - 256.0f) / dens; grow *= 2.0f; mid = f2key(lastv); }
            else if (it < 24 && same < 2) { const float vlo = key2f(lo), vhi = key2f(hi - 1u); mid = f2key(vlo + (vhi - vlo) * (((float)(clo - 256) + 0.5f) / (float)(clo - chi))); }
            else if (it < 48) { mid = f2key(0.5f * key2f(lo) + 0.5f * key2f(hi - 1u)); same = 0; }
            else mid = lo + ((hi - lo) >> 1);
            if (!(mid > lo)) mid = lo + 1u; if (!(mid < hi)) mid = hi - 1u;
            DSA_LCOUNT(mid, lc); const int c = wave_isum(lc); lastc = (float)c; lastv = key2f(mid);
            if (c == 256) { T = mid; exact = true; break; }
            if (c > 256) { lo = mid; clo = c; lop = true; same = (last > 0) ? same + 1 : 0; last = 1; } else { hi = mid; chi = c; hip = true; same = (last < 0) ? same + 1 : 0; last = -1; }
        }
        if (!exact) {
            const int nsel = dsa_emit(key, nvalid, lo, 256 - chi, idx, lane);
            return nsel;
        }
    } else { DSA_LCOUNT(1u, lc); }
    int incl = lc;
#pragma unroll
    for (int o = 1; o < 64; o <<= 1) { const int t = __builtin_amdgcn_ds_bpermute(((lane - o) & 63) << 2, incl); if (lane >= o) incl += t; }
    const int total = __builtin_amdgcn_readlane(incl, 63);
    if (nq == 1) dsa_write_ge<16>(key, T, incl - lc, idx, lane); else if (nq == 2) dsa_write_ge<32>(key, T, incl - lc, idx, lane); else if (nq == 3) dsa_write_ge<48>(key, T, incl - lc, idx, lane); else dsa_write_ge<64>(key, T, incl - lc, idx, lane);
    return total;
}

constexpr int DSA_ROWF = 4100;
__device__ __forceinline__ void dsa_v3(const Ctx& F, int out_col = Z_DQ) {
    bf16* Z = (bf16*)(F.ws + WS_Z);
    const unsigned* ISG = (const unsigned*)(F.ws + WS_ISG);
    const bf16* KD = (const bf16*)(F.ws + WS_KD); const bf16* VD = (const bf16*)(F.ws + WS_VD);
    const bf16* IQB = (const bf16*)(F.ws + WS_IQB); const bf16* IKB = (const bf16*)(F.ws + WS_IKB);
    LAS unsigned* img = (LAS unsigned*)(F.lds);
    LAS unsigned short* idxw = (LAS unsigned short*)(F.lds + XTRA_OFF + F.wave * 1536);
    const int w = F.wave;
    const int v = (int)blockIdx.x;
    if (v < 256)
    for (int ui = 0; ui < 8; ++ui) {
        int lane_ = F.lane; asm volatile("" : "+v"(lane_)); const int lane = lane_, g = lane >> 4, c = lane & 15;
        const int b = v >> 6, k = v & 63; const int pb = 128 * (ui >> 1) + ((ui & 1) ? 127 - k : k);
        const int q0 = pb * 8, kend = q0 + 8, ntile = (kend + 15) >> 4;
        const size_t mb = (size_t)b * SEQ;
#if PROBE_D == 1
        for (int rp_ = 0; rp_ < 2; ++rp_)
#endif
        { s16x8 iqf[4]; float sgn[4]; s16x8 iqc;
          { const int qi = c & 7, hs = c >> 3; const int qq = q0 + qi; const bf16* qp = IQB + (mb + qq) * 256 + 8 * g; const unsigned sg = ISG[mb + qq];
            float cs[8];
#pragma unroll
            for (int e = 0; e < 8; ++e) cs[e] = 0.f;
#pragma unroll
            for (int j = 0; j < 4; ++j) { const int h = 2 * j + hs; iqf[j] = *(const GAS s16x8*)(qp + h * 32); sgn[j] = ((sg >> h) & 1u) ? -1.0f : 1.0f;
                float t8[8]; unpack8(__builtin_bit_cast(v4u, iqf[j]), t8);
#pragma unroll
                for (int e = 0; e < 8; ++e) cs[e] += sgn[j] * t8[e]; }
            iqc = __builtin_bit_cast(s16x8, pack8(cs)); }
          const bf16* ikp = IKB + (mb + c) * 32 + 8 * g;
          float st1 = 0.f, st2 = 0.f;
          s16x8 cur[4], nxt[4];
#pragma unroll
          for (int i = 0; i < 4; ++i) { const int t = w + 8 * i; cur[i] = *(const GAS s16x8*)(ikp + (size_t)512 * (t < ntile ? t : 0)); }
          for (int t0 = w; t0 < ntile; t0 += 32) {
#pragma unroll
            for (int i = 0; i < 4; ++i) { const int t = t0 + 32 + 8 * i; nxt[i] = *(const GAS s16x8*)(ikp + (size_t)512 * (t < ntile ? t : 0)); }
#pragma unroll
            for (int i = 0; i < 4; ++i) { const int t = t0 + 8 * i;
              if (t < ntile) {
                f32x4 sc = __builtin_amdgcn_mfma_f32_16x16x32_bf16(cur[i], iqc, (f32x4){0.f, 0.f, 0.f, 0.f}, 0, 0, 0);
#pragma unroll
                for (int h = 0; h < 4; ++h) { const f32x4 x = __builtin_amdgcn_mfma_f32_16x16x32_bf16(cur[i], iqf[h], (f32x4){0.f, 0.f, 0.f, 0.f}, 0, 0, 0);
#pragma unroll
                    for (int r = 0; r < 4; ++r) sc[r] = __builtin_fmaf(sgn[h], __builtin_fabsf(x[r]), sc[r]); }
#pragma unroll
                for (int r = 0; r < 4; ++r) sc[r] += sx<8>(sc[r]);
                v4u kk; kk.x = f2key(sc[0]); kk.y = f2key(sc[1]); kk.z = f2key(sc[2]); kk.w = f2key(sc[3]);
                if (16 * t + 15 <= q0) {
                    st1 += (sc[0] + sc[1]) + (sc[2] + sc[3]); st2 += (sc[0] * sc[0] + sc[1] * sc[1]) + (sc[2] * sc[2] + sc[3] * sc[3]);
                } else { const int kb = 16 * t + 4 * g, qa = q0 + (c & 7);
                    if (kb + 0 > qa) { kk.x = 0u; sc[0] = 0.f; } if (kb + 1 > qa) { kk.y = 0u; sc[1] = 0.f; } if (kb + 2 > qa) { kk.z = 0u; sc[2] = 0.f; } if (kb + 3 > qa) { kk.w = 0u; sc[3] = 0.f; }
                    st1 += (sc[0] + sc[1]) + (sc[2] + sc[3]); st2 += (sc[0] * sc[0] + sc[1] * sc[1]) + (sc[2] * sc[2] + sc[3] * sc[3]); }
                if (c < 8) *(LAS v4u*)(img + c * DSA_ROWF + 16 * t + 4 * g) = kk; } }
#pragma unroll
            for (int i = 0; i < 4; ++i) cur[i] = nxt[i];
          }
          st1 += sx<16>(st1); st2 += sx<16>(st2); st1 = half_sum(st1); st2 = half_sum(st2);
          if (g == 0 && c < 8) *(LAS f32x2*)(F.lds + XTRA_OFF + w * 1536 + 640 + c * 8) = (f32x2){st1, st2}; }
        __syncthreads();
        const int pos = q0 + w; unsigned key[64];
#pragma unroll
        for (int j = 0; j < 64; ++j) { const int kidx = 64 * j + lane; const unsigned a = img[w * DSA_ROWF + kidx]; key[j] = (kidx <= pos) ? a : 0u; }
        unsigned T; int need; int nsel;
        float rs1 = 0.f, rs2 = 0.f;
#pragma unroll
        for (int ww = 0; ww < 8; ++ww) { const f32x2 t = *(const LAS f32x2*)(F.lds + XTRA_OFF + ww * 1536 + 640 + w * 8); rs1 += t.x; rs2 += t.y; }
        { nsel = dsa_select2(key, pos + 1, rs1, rs2, idxw, lane); (void)T; (void)need; }
        __syncthreads();
#if PROBE_D == 3
        { const size_t m = mb + pos; dsa_attend(Z + m * ZP + Z_DQ, Z + m * ZP + Z_RG, KD + mb * 64, VD + mb * 64, idxw, nsel, F.lds + w * 16384, lane); }
#endif
        { const size_t m = mb + pos; dsa_attend(Z + m * ZP + Z_DQ, Z + m * ZP + out_col, KD + mb * 64, VD + mb * 64, idxw, nsel, F.lds + w * 16384, lane); }
        __syncthreads();
    }
}

__device__ __forceinline__ void ret_rope_frag(const bf16* row, const f32x2* cs, float scale, int g, s16x8 (&f)[2]) {
    const u32x2 a0 = *(const GAS u32x2*)(row + 4 * g), a1 = *(const GAS u32x2*)(row + 16 + 4 * g), b0 = *(const GAS u32x2*)(row + 32 + 4 * g), b1 = *(const GAS u32x2*)(row + 48 + 4 * g);
    const float x1[8] = {bflo(a0.x), bfhi(a0.x), bflo(a0.y), bfhi(a0.y), bflo(a1.x), bfhi(a1.x), bflo(a1.y), bfhi(a1.y)};
    const float x2[8] = {bflo(b0.x), bfhi(b0.x), bflo(b0.y), bfhi(b0.y), bflo(b1.x), bfhi(b1.x), bflo(b1.y), bfhi(b1.y)};
    float o1[8], o2[8];
#pragma unroll
    for (int j = 0; j < 8; ++j) { const f32x2 t = cs[(j < 4 ? 4 * g + j : 16 + 4 * g + (j - 4))]; o1[j] = (x1[j] * t.x - x2[j] * t.y) * scale; o2[j] = (x2[j] * t.x + x1[j] * t.y) * scale; }
    f[0] = __builtin_bit_cast(s16x8, pack8(o1)); f[1] = __builtin_bit_cast(s16x8, pack8(o2));
}
__device__ __forceinline__ s16x8 ret_bfrag(const LAS unsigned char* img, int row0, int eb, int g, int q, int p) {
    const int r1 = row0 + 4 * g + q;
    const LAS unsigned char* a1 = img + r1 * 256 + ((eb ^ (r1 & 7)) << 5) + 8 * p;
    const LAS unsigned char* a2 = img + (r1 + 16) * 256 + ((eb ^ ((r1 + 16) & 7)) << 5) + 8 * p;
    const s16x4 lo = tr16(a1), hi = tr16(a2);
    return (s16x8){lo[0], lo[1], lo[2], lo[3], hi[0], hi[1], hi[2], hi[3]};
}

__device__ __forceinline__ void ret_state_mfma(const Ctx& F) {
    const bf16* Z = (const bf16*)(F.ws + WS_Z); float* RS = (float*)(F.ws + WS_HDN);
    const f32x2* R64 = (const f32x2*)(F.ws + WS_ROPE64);
    LAS unsigned char* Kimg = F.lds; LAS unsigned char* Vimg = F.lds + 16384;
    const int lane = F.lane, g = lane >> 4, c = lane & 15, q = (lane >> 2) & 3, p = lane & 3;
    for (int u = blockIdx.x; u < NB * 32 * 4; u += F.G) {
        const int h = u & 3, ch = (u >> 2) & 31, b = u >> 7; const float l2g = ret_l2g(h);
        const bf16* base = Z + ((size_t)b * SEQ + ch * 128) * ZP;
        __syncthreads();
        for (int t = F.tid; t < 2048; t += 512) { const int r = t >> 4, c16 = t & 15;
            *(LAS v4u*)(Vimg + r * 256 + (((c16 >> 1) ^ (r & 7)) << 5) + ((c16 & 1) << 4)) = *(const GAS v4u*)(base + (size_t)r * ZP + Z_RV + h * 128 + c16 * 8); }
        for (int t = F.tid; t < 1024; t += 512) { const int j = t >> 3, dg = t & 7; const bf16* row = base + (size_t)j * ZP + Z_RK + h * 64;
            const u32x2 a = *(const GAS u32x2*)(row + 4 * dg), bb = *(const GAS u32x2*)(row + 32 + 4 * dg);
            const float x1[4] = {bflo(a.x), bfhi(a.x), bflo(a.y), bfhi(a.y)}, x2[4] = {bflo(bb.x), bfhi(bb.x), bflo(bb.y), bfhi(bb.y)};
            const f32x2* cs = R64 + (ch * 128 + j) * 32 + 4 * dg; const float sc = exp2f((float)(127 - j) * l2g);
            float o1[4], o2[4];
#pragma unroll
            for (int e = 0; e < 4; ++e) { const f32x2 tt = cs[e]; o1[e] = (x1[e] * tt.x - x2[e] * tt.y) * sc; o2[e] = (x2[e] * tt.x + x1[e] * tt.y) * sc; }
            u32x2 w1, w2; w1.x = pk2(o1[0], o1[1]); w1.y = pk2(o1[2], o1[3]); w2.x = pk2(o2[0], o2[1]); w2.y = pk2(o2[2], o2[3]);
            const int sw = (j >> 1) & 3; const int d1 = 4 * dg, d2 = 32 + 4 * dg;
            *(LAS u32x2*)(Kimg + j * 128 + ((((2 * d1) >> 5) ^ sw) << 5) + ((2 * d1) & 31)) = w1;
            *(LAS u32x2*)(Kimg + j * 128 + ((((2 * d2) >> 5) ^ sw) << 5) + ((2 * d2) & 31)) = w2; }
        __syncthreads();
        f32x4 acc[4];
#pragma unroll
        for (int db = 0; db < 4; ++db) acc[db] = (f32x4){0.f, 0.f, 0.f, 0.f};
#pragma unroll
        for (int s = 0; s < 4; ++s) {
            const s16x8 vb = ret_bfrag(Vimg, 32 * s, F.wave, g, q, p);
            const int r1 = 32 * s + 4 * g + q, sw = (r1 >> 1) & 3;
#pragma unroll
            for (int db = 0; db < 4; ++db) { const LAS unsigned char* a1 = Kimg + r1 * 128 + ((db ^ sw) << 5) + 8 * p;
                const s16x4 lo = tr16(a1), hi = tr16(a1 + 2048);
                const s16x8 ka = (s16x8){lo[0], lo[1], lo[2], lo[3], hi[0], hi[1], hi[2], hi[3]};
                acc[db] = __builtin_amdgcn_mfma_f32_16x16x32_bf16(ka, vb, acc[db], 0, 0, 0); }
        }
        float* o = RS + (size_t)u * 8192 + 16 * F.wave + c;
#pragma unroll
        for (int db = 0; db < 4; ++db)
#pragma unroll
            for (int r = 0; r < 4; ++r) o[(16 * db + 4 * g + r) * 128] = acc[db][r];
    }
    __syncthreads();
}

__device__ __forceinline__ void ret_scan(const Ctx& F) {
    const float* RS = (const float*)(F.ws + WS_HDN); float* SC = (float*)(F.ws + WS_HDN + 16 * MiB);
    for (int t = blockIdx.x * 512 + F.tid; t < NB * 4 * 8192; t += F.G * 512) {
        const int el = t & 8191, h = (t >> 13) & 3, b = t >> 15; const float wch = exp2f(128.f * ret_l2g(h)); float s = 0.f;
        float L[32];
#pragma unroll
        for (int ch = 0; ch < 32; ++ch) L[ch] = RS[(size_t)(((b * 32 + ch) * 4 + h)) * 8192 + el];
#pragma unroll
        for (int ch = 0; ch < 32; ++ch) { SC[(size_t)(((b * 32 + ch) * 4 + h)) * 8192 + el] = s; s = wch * s + L[ch]; }
    }
}

__device__ __forceinline__ void ret_out_mfma(const Ctx& F, const float* gn, bool dummy_out = false) {
    bf16* Z = (bf16*)(F.ws + WS_Z); const float* SC = (const float*)(F.ws + WS_HDN + 16 * MiB);
    const f32x2* R64 = (const f32x2*)(F.ws + WS_ROPE64);
    LAS unsigned char* Vimg = F.lds; LAS unsigned char* Simg = F.lds + 32768; LAS unsigned char* Kimg = F.lds + 49152;
    const int lane = F.lane, g = lane >> 4, c = lane & 15, q = (lane >> 2) & 3, p = lane & 3, w = F.wave;
    for (int u = blockIdx.x; u < NB * 32 * 4; u += F.G) {
        const int h = u & 3, ch = (u >> 2) & 31, b = u >> 7; const float l2g = ret_l2g(h); const float gam = exp2f(l2g);
        bf16* base = Z + ((size_t)b * SEQ + ch * 128) * ZP;
        __syncthreads();
        for (int t = F.tid; t < 2048; t += 512) { const int r = t >> 4, c16 = t & 15;
            *(LAS v4u*)(Vimg + r * 256 + (((c16 >> 1) ^ (r & 7)) << 5) + ((c16 & 1) << 4)) = *(const GAS v4u*)(base + (size_t)r * ZP + Z_RV + h * 128 + c16 * 8); }
        for (int t = F.tid; t < 1024; t += 512) { const int r = t >> 4, c16 = t & 15; const float* sp = SC + (size_t)u * 8192 + r * 128 + c16 * 8;
            const f32x4 s0 = *(const GAS f32x4*)sp, s1 = *(const GAS f32x4*)(sp + 4);
            v4u wv; wv.x = pk2(s0.x * gam, s0.y * gam); wv.y = pk2(s0.z * gam, s0.w * gam); wv.z = pk2(s1.x * gam, s1.y * gam); wv.w = pk2(s1.z * gam, s1.w * gam);
            *(LAS v4u*)(Simg + r * 256 + (((c16 >> 1) ^ (r & 7)) << 5) + ((c16 & 1) << 4)) = wv; }
        for (int t = F.tid; t < 1024; t += 512) { const int j = t >> 3, dg = t & 7; const bf16* row = base + (size_t)j * ZP + Z_RK + h * 64;
            const u32x2 a = *(const GAS u32x2*)(row + 4 * dg), bb = *(const GAS u32x2*)(row + 32 + 4 * dg);
            const float x1[4] = {bflo(a.x), bfhi(a.x), bflo(a.y), bfhi(a.y)}, x2[4] = {bflo(bb.x), bfhi(bb.x), bflo(bb.y), bfhi(bb.y)};
            const f32x2* cs = R64 + (ch * 128 + j) * 32 + 4 * dg; const float sc = exp2f(-(float)j * l2g);
            float o1[4], o2[4];
#pragma unroll
            for (int e = 0; e < 4; ++e) { const f32x2 tt = cs[e]; o1[e] = (x1[e] * tt.x - x2[e] * tt.y) * sc; o2[e] = (x2[e] * tt.x + x1[e] * tt.y) * sc; }
            u32x2 w1, w2; w1.x = pk2(o1[0], o1[1]); w1.y = pk2(o1[2], o1[3]); w2.x = pk2(o2[0], o2[1]); w2.y = pk2(o2[2], o2[3]);
            const int sw = (j >> 1) & 3; const int d1 = 4 * dg, d2 = 32 + 4 * dg;
            *(LAS u32x2*)(Kimg + j * 128 + ((((2 * d1) >> 5) ^ sw) << 5) + ((2 * d1) & 31)) = w1;
            *(LAS u32x2*)(Kimg + j * 128 + ((((2 * d2) >> 5) ^ sw) << 5) + ((2 * d2) & 31)) = w2; }
        const int i = 16 * w + c; s16x8 qf[2];
        float sc8 = 0.125f; asm volatile("" : "+v"(sc8));
        ret_rope_frag(base + (size_t)i * ZP + Z_RQ + h * 64, R64 + (ch * 128 + i) * 32, sc8 * exp2f((float)i * l2g), g, qf);
        __syncthreads();
        f32x4 acc[8];
#pragma unroll
        for (int t = 0; t < 8; ++t) { acc[t] = (f32x4){0.f, 0.f, 0.f, 0.f};
            if (t <= w) { const int j = 16 * t + c; const int sw = (j >> 1) & 3; const LAS unsigned char* kr = Kimg + j * 128;
                const u32x2 a0 = *(const LAS u32x2*)(kr + ((((8 * g) >> 5) ^ sw) << 5) + ((8 * g) & 31)), a1 = *(const LAS u32x2*)(kr + ((((32 + 8 * g) >> 5) ^ sw) << 5) + ((32 + 8 * g) & 31));
                const u32x2 b0 = *(const LAS u32x2*)(kr + ((((64 + 8 * g) >> 5) ^ sw) << 5) + ((64 + 8 * g) & 31)), b1 = *(const LAS u32x2*)(kr + ((((96 + 8 * g) >> 5) ^ sw) << 5) + ((96 + 8 * g) & 31));
                const s16x8 kf0 = __builtin_bit_cast(s16x8, (v4u){a0.x, a0.y, a1.x, a1.y}), kf1 = __builtin_bit_cast(s16x8, (v4u){b0.x, b0.y, b1.x, b1.y});
                acc[t] = __builtin_amdgcn_mfma_f32_16x16x32_bf16(kf0, qf[0], acc[t], 0, 0, 0); acc[t] = __builtin_amdgcn_mfma_f32_16x16x32_bf16(kf1, qf[1], acc[t], 0, 0, 0);
                if (t == w) {
#pragma unroll
                    for (int r = 0; r < 4; ++r) if (4 * g + r > c) acc[t][r] = 0.f; } } }
        s16x8 pf[4];
#pragma unroll
        for (int s = 0; s < 4; ++s) { v4u wv; wv.x = pk2(acc[2 * s][0], acc[2 * s][1]); wv.y = pk2(acc[2 * s][2], acc[2 * s][3]); wv.z = pk2(acc[2 * s + 1][0], acc[2 * s + 1][1]); wv.w = pk2(acc[2 * s + 1][2], acc[2 * s + 1][3]);
            pf[s] = __builtin_bit_cast(s16x8, wv); }
        f32x4 o[8];
#pragma unroll
        for (int eb = 0; eb < 8; ++eb) o[eb] = (f32x4){0.f, 0.f, 0.f, 0.f};
#pragma unroll
        for (int s = 0; s < 4; ++s) if (2 * s <= w) {
#pragma unroll
            for (int eb = 0; eb < 8; ++eb) o[eb] = __builtin_amdgcn_mfma_f32_16x16x32_bf16(pf[s], ret_bfrag(Vimg, 32 * s, eb, g, q, p), o[eb], 0, 0, 0); }
#pragma unroll
        for (int ks = 0; ks < 2; ++ks)
#pragma unroll
            for (int eb = 0; eb < 8; ++eb) o[eb] = __builtin_amdgcn_mfma_f32_16x16x32_bf16(qf[ks], ret_bfrag(Simg, 32 * ks, eb, g, q, p), o[eb], 0, 0, 0);
        float rs[4];
#pragma unroll
        for (int r = 0; r < 4; ++r) { float ss = 0.f;
#pragma unroll
            for (int eb = 0; eb < 8; ++eb) ss += o[eb][r] * o[eb][r];
            ss += sx<1>(ss); ss += sx<2>(ss); ss += sx<4>(ss); ss += sx<8>(ss);
            rs[r] = 1.0f / sqrtf(ss * (1.f / 128) + NORM_EPS); }
#pragma unroll
        for (int r = 0; r < 4; ++r) { bf16* zr = base + (size_t)(16 * w + 4 * g + r) * ZP; bf16* zw = dummy_out ? (bf16*)(F.ws + WS_ZS) + ((size_t)b * SEQ + ch * 128 + 16 * w + 4 * g + r) * 1024 - Z_RV : zr;
#pragma unroll
            for (int eb = 0; eb < 8; ++eb) { const int e = 16 * eb + c; const float rg = bf2f(zr[Z_RG + h * 128 + e]);
                zw[Z_RV + h * 128 + e] = (bf16)f2bf(o[eb][r] * rs[r] * gn[h * 128 + e] * rg * sigmoid_f(rg)); } }
    }
    __syncthreads();
}

__device__ __forceinline__ void fscan_phase(const Ctx& F) {
    const float* LF = (const float*)(F.ws + WS_LF); float* CF = (float*)(F.ws + WS_CF);
    LAS float* wsum = (LAS float*)(F.lds);
    const int seq = (int)blockIdx.x;
    if (seq < 32) {
        const int b = seq >> 3, h = seq & 7; const int p0 = F.tid * 8; const float* lp = LF + ((size_t)b * SEQ + p0) * 8 + h;
        float v[8]; float s = 0.f;
#pragma unroll
        for (int i = 0; i < 8; ++i) { v[i] = lp[i * 8]; }
#pragma unroll
        for (int i = 0; i < 8; ++i) { s += v[i]; v[i] = s; }
        float incl = s;
#pragma unroll
        for (int o = 1; o < 64; o <<= 1) { const float t = __builtin_bit_cast(float, __builtin_amdgcn_ds_bpermute(((F.lane - o) & 63) << 2, __builtin_bit_cast(int, incl))); if (F.lane >= o) incl += t; }
        if (F.lane == 63) wsum[F.wave] = incl;
        __syncthreads();
        float woff = 0.f;
#pragma unroll
        for (int ww = 0; ww < 8; ++ww) { const float t = wsum[ww]; if (ww < F.wave) woff += t; }
        const float base = woff + (incl - s);
        float* cp = CF + (size_t)seq * SEQ + p0;
        *(GAS f32x4*)cp = (f32x4){base + v[0], base + v[1], base + v[2], base + v[3]}; *(GAS f32x4*)(cp + 4) = (f32x4){base + v[4], base + v[5], base + v[6], base + v[7]};
    }
    __syncthreads();
}
#include <hip/hip_bf16.h>
#include <cmath>
namespace attn_body {
using bf16=__hip_bfloat16;
using bf16x8=__attribute__((ext_vector_type(8)))short;
using s16x4=__attribute__((ext_vector_type(4)))short;
using f32x16=__attribute__((ext_vector_type(16)))float;
using u32x4=__attribute__((ext_vector_type(4)))unsigned;
constexpr int BATCH=4,NHEAD=8,SEQ=4096,D=64,DM=6656;
constexpr int NW=8,QBLK=32,QB=QBLK*NW,KVBLK=64,NQB=SEQ/QB;
constexpr int ATTN_PITCH=DM, ATTN_UNIT_ROWS=QB;
__device__ __forceinline__ int crow(int r,int hi){return (r&3)+8*(r>>2)+4*hi;}
#define SBAR() __builtin_amdgcn_sched_barrier(0)
__device__ __forceinline__ void cmask(f32x16&p0,f32x16&p1,int jb,int qrel,int hi){
  const float NEG=-INFINITY; int kb=64*jb+4*hi;
  #pragma unroll
  for(int r=0;r<16;++r){int kv=kb+(r&3)+8*(r>>2); if(kv>qrel)p0[r]=NEG; if(kv+32>qrel)p1[r]=NEG;}
}

constexpr int NSLOT=3, SLOTB=8192;
constexpr int LDS_K=0, LDS_V=NSLOT*SLOTB, LDS_WS=2*NSLOT*SLOTB, LDS_OST=LDS_WS+NW*64*4, LDS_NC=LDS_OST+NW*4096, LDS_BYTES=LDS_NC+SEQ*4;
constexpr float C2=0.125f*1.4426950408889634f;
__device__ __forceinline__ void glds16(const void*gsrc,unsigned lds_dst){unsigned keep;
  asm volatile("s_mov_b32 %0, m0\n\ts_mov_b32 m0, %2\n\ts_nop 0\n\tglobal_load_lds_dwordx4 %1, off\n\ts_mov_b32 m0, %0":"=&s"(keep):"v"(gsrc),"s"(lds_dst):"memory");}
__device__ __forceinline__ float max3f(float a,float b,float c){float r;asm("v_max3_f32 %0, %1, %2, %3":"=v"(r):"v"(a),"v"(b),"v"(c));return r;}
__device__ __forceinline__ float max2f(float a,float b){float r;asm("v_max_f32_e32 %0, %1, %2":"=v"(r):"v"(a),"v"(b));return r;}
__device__ __forceinline__ float fadd_s(float a,float b){float r;asm("v_add_f32_e32 %0, %1, %2":"=v"(r):"v"(a),"v"(b));return r;}
__device__ __forceinline__ float fsub_s(float a,float b){float r;asm("v_sub_f32_e32 %0, %1, %2":"=v"(r):"v"(a),"v"(b));return r;}
typedef float f32x4_t __attribute__((ext_vector_type(4))); typedef float f32x2_t __attribute__((ext_vector_type(2))); typedef __bf16 bf16x2_t __attribute__((ext_vector_type(2)));
__device__ __forceinline__ unsigned cvtpk_s(float lo,float hi){f32x2_t v={lo,hi};bf16x2_t b=__builtin_convertvector(v,bf16x2_t);return __builtin_bit_cast(unsigned,b);}
#define WAIT_BAR(N) asm volatile("s_waitcnt vmcnt(" #N ") lgkmcnt(0)\n\ts_barrier":::"memory")

__device__ __forceinline__ void qkt(f32x16&p0,f32x16&p1,const char*Kslot,const bf16x8*qr,const f32x16&negm,int r32,int hi){
  const char*kb=Kslot+hi*1024+r32*16;
  #pragma unroll
  for(int d0=0;d0<4;++d0){
    const bf16x8 b0=*reinterpret_cast<const bf16x8*>(kb+d0*2048);
    const bf16x8 b1=*reinterpret_cast<const bf16x8*>(kb+d0*2048+512);
    if(d0==0){p0=__builtin_amdgcn_mfma_f32_32x32x16_bf16(b0,qr[0],negm,0,0,0);p1=__builtin_amdgcn_mfma_f32_32x32x16_bf16(b1,qr[0],negm,0,0,0);}
    else{p0=__builtin_amdgcn_mfma_f32_32x32x16_bf16(b0,qr[d0],p0,0,0,0);p1=__builtin_amdgcn_mfma_f32_32x32x16_bf16(b1,qr[d0],p1,0,0,0);}}
}
typedef __attribute__((address_space(3))) const char* lds_cptr;
typedef short v4i16_t __attribute__((ext_vector_type(4)));
__device__ __forceinline__ void kload8(bf16x8*kf,lds_cptr kp){
  kf[0]=*(const __attribute__((address_space(3))) bf16x8*)(kp);      kf[1]=*(const __attribute__((address_space(3))) bf16x8*)(kp+512);
  kf[2]=*(const __attribute__((address_space(3))) bf16x8*)(kp+2048); kf[3]=*(const __attribute__((address_space(3))) bf16x8*)(kp+2560);
  kf[4]=*(const __attribute__((address_space(3))) bf16x8*)(kp+4096); kf[5]=*(const __attribute__((address_space(3))) bf16x8*)(kp+4608);
  kf[6]=*(const __attribute__((address_space(3))) bf16x8*)(kp+6144); kf[7]=*(const __attribute__((address_space(3))) bf16x8*)(kp+6656);
}
__device__ __forceinline__ void kload2(bf16x8*kf,lds_cptr kp,int j){ kf[2*j]=*(const __attribute__((address_space(3))) bf16x8*)(kp+j*2048); kf[2*j+1]=*(const __attribute__((address_space(3))) bf16x8*)(kp+j*2048+512); }
__device__ __forceinline__ s16x4 vtr(lds_cptr p){ return __builtin_bit_cast(s16x4,__builtin_amdgcn_ds_read_tr16_b64_v4i16((__attribute__((address_space(3))) v4i16_t*)p)); }
__device__ __forceinline__ float rowmax(const f32x16&p0,const f32x16&p1){
  float a=max3f(p0[0],p0[1],p1[0]),b=max3f(p0[2],p0[3],p1[1]);a=max3f(a,p1[2],p1[3]);
  #pragma unroll
  for(int r=4;r<16;r+=4){a=max3f(a,p0[r],p0[r+1]);b=max3f(b,p0[r+2],p0[r+3]);a=max3f(a,p1[r],p1[r+1]);b=max3f(b,p1[r+2],p1[r+3]);}
  const float m=max2f(a,b);
  auto rr=__builtin_amdgcn_permlane32_swap(__float_as_uint(m),__float_as_uint(m),false,false);
  return max2f(__uint_as_float(rr[0]),__uint_as_float(rr[1]));
}
__device__ __forceinline__ void pv(f32x16*o,int vb,bf16x8 pa0,bf16x8 pa1,bf16x8 pa2,bf16x8 pa3){
  #pragma unroll
  for(int d0=0;d0<2;++d0){s16x4 lo[4],hi[4];
    #pragma unroll
    for(int ks=0;ks<4;++ks){
      asm volatile("ds_read_b64_tr_b16 %0,%1 offset:%c2":"=&v"(lo[ks]):"v"(vb),"i"(d0*4096+ks*1024):"memory");
      asm volatile("ds_read_b64_tr_b16 %0,%1 offset:%c2":"=&v"(hi[ks]):"v"(vb),"i"(d0*4096+ks*1024+512):"memory");}
    asm volatile("s_waitcnt lgkmcnt(0)":::"memory");SBAR();
    #define PK(k) (bf16x8){lo[k][0],lo[k][1],lo[k][2],lo[k][3],hi[k][0],hi[k][1],hi[k][2],hi[k][3]}
    o[d0]=__builtin_amdgcn_mfma_f32_32x32x16_bf16(pa0,PK(0),o[d0],0,0,0);
    o[d0]=__builtin_amdgcn_mfma_f32_32x32x16_bf16(pa1,PK(1),o[d0],0,0,0);
    o[d0]=__builtin_amdgcn_mfma_f32_32x32x16_bf16(pa2,PK(2),o[d0],0,0,0);
    o[d0]=__builtin_amdgcn_mfma_f32_32x32x16_bf16(pa3,PK(3),o[d0],0,0,0);
    #undef PK
  }
}

#ifndef ATTN_STORE16
#define ATTN_STORE16(p,v) (*(u32x4*)(p)=(v))
#endif
template<int THRL> __device__ __forceinline__ void attn_unit(int b,int h,int qb,const bf16*Q,const bf16*__restrict__ K,const bf16*__restrict__ V,bf16*O,const float*CF,float dskip,char*shm,int wave_id){
  int tid_=(wave_id<<6)|lane_id_v(); asm volatile("":"+v"(tid_));
  const int tid=tid_,lane=tid&63,r32=lane&31,hi=lane>>5; const int wid=__builtin_amdgcn_readfirstlane(tid>>6);
  const long rowbase=(long)b*SEQ; const int q0=qb*QB;
  const bf16*Qw=Q+(rowbase+q0+wid*QBLK)*DM+h*D;
  const float*cfp0=CF+(long)(b*NHEAD+h)*SEQ; const int NT0=(q0+QB)/KVBLK;
  int ts; { const float cq=cfp0[q0]; const int il=(lane<NT0)?64*lane+63:q0; const bool keep=(lane<NT0)&&(cfp0[il]<cq+dskip);
    const unsigned long long km=__ballot(keep); int t0=(int)__builtin_ctzll(km|(1ull<<63)); t0&=~1; ts=__builtin_amdgcn_readfirstlane(t0<NT0-4?t0:NT0-4); }
  const bf16*Kh=K+(rowbase+(long)ts*KVBLK)*DM+h*D,*Vh=V+(rowbase+(long)ts*KVBLK)*DM+h*D;
  const unsigned lds0=(unsigned)(uintptr_t)shm;
  float*wsf=(float*)(shm+LDS_WS)+wid*64;
  const bf16*ksrc=Kh+(long)lane*DM+wid*8;
  const bf16*vsrc=Vh+(long)(16*(wid&3)+(lane>>2))*DM+(wid>>2)*32+(lane&3)*8;
  const unsigned kdst=lds0+LDS_K+wid*1024, vdst=lds0+LDS_V+wid*1024;
  #define DMA_K(t,slot) glds16(ksrc+(long)(t)*KVBLK*DM,(unsigned)__builtin_amdgcn_readfirstlane(kdst+(slot)))
  #define DMA_V(t,slot) glds16(vsrc+(long)(t)*KVBLK*DM,(unsigned)__builtin_amdgcn_readfirstlane(vdst+(slot)))
  const char*Kbase=shm+LDS_K; bf16x8 kf[8];
  const lds_cptr shm3=(lds_cptr)shm; const lds_cptr kp0=shm3+LDS_K+hi*1024+r32*16; const lds_cptr vp0=shm3+LDS_V+((lane>>4)&1)*32+(lane&3)*8+(4*hi+((lane&15)>>2))*64;
  const int NT=NT0-ts;
  { const float*cfp=CF+(long)(b*NHEAD+h)*SEQ; float*ncw=(float*)(shm+LDS_NC);
    for(int i=tid+ts*KVBLK;i<q0+QB;i+=NW*64)ncw[i-ts*KVBLK]=-cfp[i]; }
  const lds_cptr ncp=(lds_cptr)shm+LDS_NC+hi*16;
  #define ADDC(P0,P1,t) do{ const lds_cptr np_=ncp+(t)*256; _Pragma("unroll") for(int g_=0;g_<4;++g_){ \
      const f32x4_t a_=*(const __attribute__((address_space(3))) f32x4_t*)(np_+g_*32), b_=*(const __attribute__((address_space(3))) f32x4_t*)(np_+g_*32+128); \
      P0[4*g_]+=a_[0];P0[4*g_+1]+=a_[1];P0[4*g_+2]+=a_[2];P0[4*g_+3]+=a_[3]; P1[4*g_]+=b_[0];P1[4*g_+1]+=b_[1];P1[4*g_+2]+=b_[2];P1[4*g_+3]+=b_[3]; } }while(0)
  DMA_K(0,0);DMA_V(0,0);DMA_K(1,SLOTB);
  bf16x8 qr[4];
  #pragma unroll
  for(int d0=0;d0<4;++d0)qr[d0]=*reinterpret_cast<const bf16x8*>(&Qw[(long)r32*DM+d0*16+hi*8]);
  float mhat=0.f,l_reg=0.f;f32x16 o[2];f32x16 negm; { float zz_; asm volatile("v_mov_b32 %0, 0":"=v"(zz_));
    _Pragma("unroll") for(int r=0;r<16;++r){o[0][r]=zz_;o[1][r]=zz_;negm[r]=zz_;} } asm volatile("":"+v"(negm));
  const int qrel=wid*QBLK+r32;
  #define CMASK(P0,P1,t) do{int jb_=(t)-(NT-4); if(jb_>=0)cmask(P0,P1,jb_,qrel,hi);}while(0)
  bool resc=false;
  #define START(P0,P1) do{ const float rm=rowmax(P0,P1); resc=false; \
    { const float dl=rm; mhat=fadd_s(mhat,dl); \
      _Pragma("unroll") for(int r=0;r<16;++r){P0[r]=fsub_s(P0[r],dl);P1[r]=fsub_s(P1[r],dl);} \
      _Pragma("unroll") for(int r=0;r<16;++r)negm[r]=-mhat; asm volatile("":"+v"(negm)); } \
    _Pragma("unroll") for(int r=0;r<16;++r)P0[r]=__builtin_amdgcn_exp2f(P0[r]); }while(0)
  #define RESC() do{ if(resc){ asm volatile("s_waitcnt lgkmcnt(0)":::"memory"); \
      _Pragma("unroll") for(int d_=0;d_<2;++d_) _Pragma("unroll") for(int r=0;r<16;++r)o[d_][r]*=wsf[crow(r,hi)]; } }while(0)
  f32x16 pA0,pA1,pB0,pB1;
  int sl_prev=0,sl_cur=0,sl_next=SLOTB;
  #define ROT() do{sl_prev=sl_cur;sl_cur=sl_next;sl_next=(sl_next==(NSLOT-1)*SLOTB)?0:sl_next+SLOTB;}while(0)
  DMA_K(2,2*SLOTB);
  WAIT_BAR(3);
  qkt(pA0,pA1,Kbase,qr,negm,r32,hi);asm volatile("s_nop 15\n\ts_nop 7":"+v"(pA0),"+v"(pA1));ADDC(pA0,pA1,0);CMASK(pA0,pA1,0);
  START(pA0,pA1);
  _Pragma("unroll") for(int r=0;r<16;++r)pA1[r]=__builtin_amdgcn_exp2f(pA1[r]);
  WAIT_BAR(0);
  DMA_K(3,0);DMA_V(1,SLOTB);
  ROT();
  kload8(kf,kp0+sl_cur);
  WAIT_BAR(2);
  s16x4 vlo[8],vhi[8]; u32x4 pw0,pw1,pw2,pw3;
  #define PKW(P,B) cvtpk_s(P[B],P[B+1])
  #define PAF(k) __builtin_bit_cast(bf16x8,pw##k)
  #define VFR(i) (bf16x8){vlo[i][0],vlo[i][1],vlo[i][2],vlo[i][3],vhi[i][0],vhi[i][1],vhi[i][2],vhi[i][3]}
  #define PIN(x) asm volatile("":"+v"(x))
  #define MX3(a,b,c) __builtin_fmaxf(__builtin_fmaxf((a),(b)),(c))
  #define GAPA(MF,A0,A1,A2,A3,W0,W1,PW) do{ MF; sacc+=A0; sacc+=A1; sacc+=A2; sacc+=A3; PIN(sacc); W0; W1; PIN(PW); SBAR(); }while(0)
  #define EX(v) __builtin_amdgcn_exp2f(v)
  #define GAPB(MF,X,B) do{ MF; X[B]=EX(X[B]); X[B+1]=EX(X[B+1]); X[B+2]=EX(X[B+2]); X[B+3]=EX(X[B+3]); PIN(X); SBAR(); }while(0)
  #define VRD(i) do{ vlo[i]=vtr(vp_+(((i)>>2)*4096+((i)&3)*1024)); vhi[i]=vtr(vp_+(((i)>>2)*4096+((i)&3)*1024+512)); }while(0)
  #define KRD(G,j) do{ if(G){ kload2(kf,kp0+sl_next,j); SBAR(); } }while(0)
  #define STEP(C0,C1,P0,P1,t,GK,GV,GL) do{ SBAR(); \
    const lds_cptr vp_=vp0+sl_prev; \
    VRD(0); SBAR(); float sacc=(P0[0]+P0[1]); \
    GAPA(C0=__builtin_amdgcn_mfma_f32_32x32x16_bf16(kf[0],qr[0],negm,0,0,0), P0[2],P0[3],P0[4],P0[5],     pw0[0]=PKW(P0,0), pw0[1]=PKW(P0,2), pw0); \
    VRD(4); SBAR(); GAPA(C1=__builtin_amdgcn_mfma_f32_32x32x16_bf16(kf[1],qr[0],negm,0,0,0), P0[6],P0[7],P0[8],P0[9],     pw0[2]=PKW(P0,4), pw0[3]=PKW(P0,6), pw0); \
    VRD(1); SBAR(); GAPA(C0=__builtin_amdgcn_mfma_f32_32x32x16_bf16(kf[2],qr[1],C0,0,0,0),   P0[10],P0[11],P0[12],P0[13], pw1[0]=PKW(P0,8), pw1[1]=PKW(P0,10), pw1); \
    VRD(5); SBAR(); GAPA(C1=__builtin_amdgcn_mfma_f32_32x32x16_bf16(kf[3],qr[1],C1,0,0,0),   P0[14],P0[15],P1[0],P1[1],   pw1[2]=PKW(P0,12),pw1[3]=PKW(P0,14), pw1); \
    VRD(2); SBAR(); GAPA(C0=__builtin_amdgcn_mfma_f32_32x32x16_bf16(kf[4],qr[2],C0,0,0,0),   P1[2],P1[3],P1[4],P1[5],     pw2[0]=PKW(P1,0), pw2[1]=PKW(P1,2), pw2); \
    VRD(6); SBAR(); GAPA(C1=__builtin_amdgcn_mfma_f32_32x32x16_bf16(kf[5],qr[2],C1,0,0,0),   P1[6],P1[7],P1[8],P1[9],     pw2[2]=PKW(P1,4), pw2[3]=PKW(P1,6), pw2); \
    VRD(3); SBAR(); GAPA(C0=__builtin_amdgcn_mfma_f32_32x32x16_bf16(kf[6],qr[3],C0,0,0,0),   P1[10],P1[11],P1[12],P1[13], pw3[0]=PKW(P1,8), pw3[1]=PKW(P1,10), pw3); \
    VRD(7); SBAR(); GAPA(C1=__builtin_amdgcn_mfma_f32_32x32x16_bf16(kf[7],qr[3],C1,0,0,0),   P1[14],P1[15],0.f,0.f,       pw3[2]=PKW(P1,12),pw3[3]=PKW(P1,14), pw3); \
    l_reg+=sacc; \
    if(GK){DMA_K((t)+3,sl_cur);} if(GV){DMA_V((t)+1,sl_next);} \
    ADDC(C0,C1,t); CMASK(C0,C1,t); \
    { float a=MX3(C0[0],C0[1],C1[0]),b=MX3(C0[2],C0[3],C1[1]); a=MX3(a,C1[2],C1[3]); \
      _Pragma("unroll") for(int r=4;r<16;r+=4){a=MX3(a,C0[r],C0[r+1]);b=MX3(b,C0[r+2],C0[r+3]);a=MX3(a,C1[r],C1[r+1]);b=MX3(b,C1[r+2],C1[r+3]);} \
      float rm=__builtin_fmaxf(a,b); { auto rr=__builtin_amdgcn_permlane32_swap(__float_as_uint(rm),__float_as_uint(rm),false,false); rm=__builtin_fmaxf(__uint_as_float(rr[0]),__uint_as_float(rr[1])); } \
      resc=false; \
      if(__builtin_expect(__any(rm>(float)THRL),0)){ const float dl=__builtin_fmaxf(rm,0.f); mhat+=dl; \
        _Pragma("unroll") for(int r=0;r<16;++r){C0[r]-=dl;C1[r]-=dl;} \
        _Pragma("unroll") for(int r=0;r<16;++r)negm[r]=-mhat; asm volatile("":"+v"(negm)); \
        const float f=__builtin_amdgcn_exp2f(-dl); l_reg*=f; if(hi==0)wsf[r32]=f; resc=true; } } \
    SBAR(); \
    GAPB(o[0]=__builtin_amdgcn_mfma_f32_32x32x16_bf16(PAF(0),VFR(0),o[0],0,0,0), C0,0); \
    GAPB(o[1]=__builtin_amdgcn_mfma_f32_32x32x16_bf16(PAF(0),VFR(4),o[1],0,0,0), C0,4); \
    KRD(GL,0); GAPB(o[0]=__builtin_amdgcn_mfma_f32_32x32x16_bf16(PAF(1),VFR(1),o[0],0,0,0), C0,8); \
    KRD(GL,1); GAPB(o[1]=__builtin_amdgcn_mfma_f32_32x32x16_bf16(PAF(1),VFR(5),o[1],0,0,0), C0,12); \
    KRD(GL,2); GAPB(o[0]=__builtin_amdgcn_mfma_f32_32x32x16_bf16(PAF(2),VFR(2),o[0],0,0,0), C1,0); \
    KRD(GL,3); GAPB(o[1]=__builtin_amdgcn_mfma_f32_32x32x16_bf16(PAF(2),VFR(6),o[1],0,0,0), C1,4); \
    GAPB(o[0]=__builtin_amdgcn_mfma_f32_32x32x16_bf16(PAF(3),VFR(3),o[0],0,0,0), C1,8); \
    GAPB(o[1]=__builtin_amdgcn_mfma_f32_32x32x16_bf16(PAF(3),VFR(7),o[1],0,0,0), C1,12); \
    }while(0)
  int t=1;
  #undef CMASK
  #define CMASK(P0,P1,t) do{}while(0)
  for(;t+5<NT;t+=2){
    STEP(pB0,pB1,pA0,pA1,t,true,true,true);     WAIT_BAR(2); RESC(); ROT();
    STEP(pA0,pA1,pB0,pB1,t+1,true,true,true);   WAIT_BAR(2); RESC(); ROT();
  }
  #undef CMASK
  #define CMASK(P0,P1,t) do{int jb_=(t)-(NT-4); if(jb_>=0)cmask(P0,P1,jb_,qrel,hi);}while(0)
  #define ENDW(tt) do{ if((tt)+3<NT){WAIT_BAR(2);} else if((tt)+2<NT){WAIT_BAR(1);} else {WAIT_BAR(0);} }while(0)
  for(;t+1<NT;t+=2){
    STEP(pB0,pB1,pA0,pA1,t,(t+3<NT),(t+1<NT),(t+1<NT));       ENDW(t);   RESC(); ROT();
    STEP(pA0,pA1,pB0,pB1,t+1,(t+4<NT),(t+2<NT),(t+2<NT));     ENDW(t+1); RESC(); ROT();
  }
  STEP(pB0,pB1,pA0,pA1,NT-1,false,false,false); RESC();
  { float sacc=pB0[0]+pB0[1]; _Pragma("unroll") for(int r=2;r<16;++r)sacc+=pB0[r]; _Pragma("unroll") for(int r=0;r<16;++r)sacc+=pB1[r]; l_reg+=sacc;
    pw0=(u32x4){PKW(pB0,0),PKW(pB0,2),PKW(pB0,4),PKW(pB0,6)};pw1=(u32x4){PKW(pB0,8),PKW(pB0,10),PKW(pB0,12),PKW(pB0,14)};pw2=(u32x4){PKW(pB1,0),PKW(pB1,2),PKW(pB1,4),PKW(pB1,6)};pw3=(u32x4){PKW(pB1,8),PKW(pB1,10),PKW(pB1,12),PKW(pB1,14)};
    int tl_=lane_id_v(); asm volatile("":"+v"(tl_)); const int ln_=tl_&63,hi_=ln_>>5; const int vb0e=(int)(lds0+LDS_V)+((ln_>>4)&1)*32+(ln_&3)*8+(4*hi_+((ln_&15)>>2))*64;
    SBAR(); pv(o,vb0e+sl_cur,PAF(0),PAF(1),PAF(2),PAF(3)); }
  #undef PKW
  #undef PAF
  #undef VFR
  #undef PIN
  #undef MX3
  #undef GAPA
  #undef GAPB
  #undef EX
  #undef VRD
  #undef KRD
  #undef STEP
  #undef ENDW
  {auto rr=__builtin_amdgcn_permlane32_swap(__float_as_uint(l_reg),__float_as_uint(l_reg),false,false);l_reg=__uint_as_float(rr[0])+__uint_as_float(rr[1]);}
  int te_=lane_id_v(); asm volatile("":"+v"(te_)); const int lane_e=te_&63,r32_e=lane_e&31,hi_e=lane_e>>5;
  if(hi_e==0)wsf[32+r32_e]=l_reg;asm volatile("s_waitcnt lgkmcnt(0)":::"memory");
  float rli[16];
  #pragma unroll
  for(int r=0;r<16;++r)rli[r]=__builtin_amdgcn_rcpf(wsf[32+crow(r,hi_e)]);
  bf16*Ow=O+(rowbase+q0+wid*QBLK)*DM+h*D;
  { bf16*stg=(bf16*)(shm+LDS_OST)+wid*2048;
    #pragma unroll
    for(int r=0;r<16;++r){const int orow=crow(r,hi_e);
      #pragma unroll
      for(int d0=0;d0<2;++d0)stg[orow*64+d0*32+r32_e]=__float2bfloat16(o[d0][r]*rli[r]);}
    asm volatile("s_waitcnt lgkmcnt(0)":::"memory");
    #pragma unroll
    for(int i=0;i<4;++i){const int row=i*8+(lane_e>>3),ch=lane_e&7; const u32x4 v=*(const u32x4*)(stg+row*64+ch*8); ATTN_STORE16(Ow+(long)row*DM+ch*8,v);} }
  asm volatile("s_waitcnt lgkmcnt(0)\n\ts_barrier":::"memory");
  #undef ADDC
  #undef DMA_K
  #undef DMA_V
  #undef CMASK
  #undef START
  #undef RESC
  #undef ROT
}
constexpr int ATTN_LDS_BYTES=LDS_BYTES;
struct AttnTensors { const bf16* Q; const bf16* K; const bf16* V; bf16* O; const float* CF; float dskip; };
struct AttnUnit { int bh; int qb; };
struct StaticOrder {
  int vcu;
  __device__ __forceinline__ explicit StaticOrder(int grid,int block):vcu((block%8)*(grid/8)+block/8){}
  __device__ __forceinline__ bool next(int i,AttnUnit&u)const{ if(i>=2)return false; const int s=vcu&7; u.bh=vcu>>3; u.qb=(i==0)?s:15-s; return true; }
  __device__ __forceinline__ void a_ready(const AttnUnit&)const{}
  __device__ __forceinline__ void done(const AttnUnit&)const{}
};
template<class Sched,int THRL=8> __device__ __forceinline__ void attn_phase(char*lds,const AttnTensors&T,const Sched&S,int wave_id){
  AttnUnit u;
  for(int i=0;S.next(i,u);++i){ S.a_ready(u); attn_unit<THRL>(u.bh/NHEAD,u.bh%NHEAD,u.qb,T.Q,T.K,T.V,T.O,T.CF,T.dskip,lds,wave_id); S.done(u); }
}
#undef SBAR
#undef WAIT_BAR
}

struct Args { const float* in[16]; float* out; unsigned char* ws; };
__global__ void __launch_bounds__(NWAVES * 64, 2) hyb_fwd(Args args) {
    extern __shared__ __attribute__((aligned(16))) unsigned char lds[];
    Ctx F;
    F.lds = (LAS unsigned char*)lds;
    F.tid = threadIdx.x; F.lane = F.tid & 63; F.wave = __builtin_amdgcn_readfirstlane(F.tid >> 6);
    F.G = gridDim.x; F.gw = blockIdx.x * NWAVES + F.wave; F.NGW = F.G * NWAVES;
    F.out = args.out; F.ws = args.ws;
    volatile LAS unsigned* MISC = (volatile LAS unsigned*)(F.lds + MISC_OFF);
    for (int u = F.tid; u < (LDS_BYTES - LDSCTL_OFF) / 4; u += NWAVES * 64) ((LAS unsigned*)(F.lds + LDSCTL_OFF))[u] = 0u;
    __syncthreads();
    gu32* ctl = (gu32*)(F.ws + WS_CTL);
    XcdBarrier bar = xcd_barrier_post((unsigned*)(ctl + CW_BAR), MISC + 8); bar.w = F.wave;
#define FRESH(P) Ctx P = F; P.tid = (F.wave << 6) | lane_id_v(); asm volatile("" : "+v"(P.tid), "+s"(P.wave), "+s"(P.gw), "+s"(P.ws), "+s"(P.out)); P.lane = P.tid & 63
#define GRID_BAR() do { XcdBarrier b_ = bar; asm volatile("" : "+s"(b_.bar), "+s"(b_.x)); xcd_barrier(b_); } while (0)

    bf16* Wb = (bf16*)(F.ws + WS_W);
    bf16* Z = (bf16*)(F.ws + WS_Z); float* ZS = (float*)(F.ws + WS_ZS); bf16* HDN = (bf16*)(F.ws + WS_HDN);
    float* M32 = (float*)(F.ws + WS_HDN); bf16* HB = (bf16*)(F.ws + WS_Z);
    LAS unsigned char* ring = F.lds + RING_OFF; float* SSp = (float*)(F.ws + WS_SS);

    { FRESH(P); p0_prologue(P, args.in[2], args.in[9], args.in[10], args.in[11], args.in[12], args.in[14], args.in[15]); }
    { FRESH(P); norm0_phase(P, args.in[0], args.in[1], (bf16*)(P.ws + WS_HDN), (float*)(P.ws + WS_SS)); }
    GRID_BAR();

    #pragma unroll 1
    for (int layer = 0; layer < DEPTH; ++layer) {
        const float* xin = (layer == 0) ? args.in[0] : F.out;
        const bf16* L = Wb + (size_t)layer * LW_STRIDE;
        { pg8::Gemm g{HDN, L + LW_IN, M, NIN, DM, DM, DM}; pg8::StaticOrder S; S.init(M, NIN, F.G, (int)blockIdx.x);
          pg8::EpiZ E{Z, ZS, SSp, args.in[4] + layer * 64, args.in[5] + layer * 64, args.in[6] + layer * 64, (const float*)(F.ws + WS_ROPE64)};
          pg8::gemm_phase<pg8::EpiZ, pg8::StaticOrder, true, true>(ring, g, S, E, F.wave); }
        GRID_BAR();
#ifdef PROBE_PP
        { FRESH(P); post_phase(P, args.in[4] + layer * 64, args.in[5] + layer * 64, args.in[6] + layer * 64, args.in[7] + layer * 64, args.in[3] + layer * 8, true); }
#endif
        { FRESH(P); post_phase(P, args.in[4] + layer * 64, args.in[5] + layer * 64, args.in[6] + layer * 64, args.in[7] + layer * 64, args.in[3] + layer * 8); }
        { FRESH(P); ret_state_mfma(P); }
        GRID_BAR();
        { FRESH(P); fscan_phase(P); }
        { FRESH(P); ret_scan(P); }
        GRID_BAR();
#ifdef PROBE_RO
        { FRESH(P); ret_out_mfma(P, args.in[8] + layer * 512, true); }
#endif
        { FRESH(P); ret_out_mfma(P, args.in[8] + layer * 512); }
#ifdef PROBE_X3
        for (int rep_ = 0; rep_ < 2; ++rep_)
        { static_assert(attn_body::ATTN_LDS_BYTES <= RING_BYTES, "attention scratch fits the ring region");
          unsigned char* wsl = F.ws; asm volatile("" : "+s"(wsl));
          bf16* Zl = (bf16*)(wsl + WS_Z);
          const attn_body::AttnTensors AT{(const attn_body::bf16*)(Zl + Z_FQ), (const attn_body::bf16*)(Zl + Z_FK), (const attn_body::bf16*)(Zl + Z_FV), (attn_body::bf16*)(Zl + (rep_ == 0 ? Z_RQ : Z_FQ)), (const float*)(wsl + WS_CF)};
          const attn_body::StaticOrder S((int)F.G, (int)blockIdx.x);
          attn_body::attn_phase<attn_body::StaticOrder, 20>((char*)lds + RING_OFF, AT, S, F.wave); }
#ifdef PROBE_X4
        { FRESH(P); dsa_v3(P); }
#else
        for (int rep_ = 0; rep_ < 2; ++rep_) { FRESH(P); dsa_v3(P, rep_ == 0 ? Z_RG : Z_DQ); }
#endif
#else
        { static_assert(attn_body::ATTN_LDS_BYTES <= RING_BYTES, "attention scratch fits the ring region");
          unsigned char* wsl = F.ws; asm volatile("" : "+s"(wsl));
          bf16* Zl = (bf16*)(wsl + WS_Z);
          float dskip; { const int ln = lane_id_v(); const float gq = wave_max(fabsf(args.in[4][layer * 64 + ln])), gk = wave_max(fabsf(args.in[5][layer * 64 + ln])); dskip = 2.0f * (64.0f * C2 * gq * gk * 1.02f) + 48.0f; }
          const attn_body::AttnTensors AT{(const attn_body::bf16*)(Zl + Z_FQ), (const attn_body::bf16*)(Zl + Z_FK), (const attn_body::bf16*)(Zl + Z_FV), (attn_body::bf16*)(Zl + Z_FQ), (const float*)(wsl + WS_CF), dskip};
          const attn_body::StaticOrder S((int)F.G, (int)blockIdx.x);
          attn_body::attn_phase<attn_body::StaticOrder, 20>((char*)lds + RING_OFF, AT, S, F.wave); }
        { FRESH(P); dsa_v3(P); }
#endif
        GRID_BAR();
        { pg8::Gemm g{Z + Z_FQ, L + LW_MIX, M, DM, 1536, ZP, 1536}; pg8::StaticOrder S; S.init(M, DM, F.G, (int)blockIdx.x);
          pg8::EpiGateF E{Z + Z_ZG, Z + Z_MRG};
          pg8::gemm_phase<pg8::EpiGateF, pg8::StaticOrder, false, true>(ring, g, S, E, F.wave); }
        GRID_BAR();
        { pg8::Gemm g{Z + Z_MRG, L + LW_O, M, DM, DM, ZP, DM}; pg8::StaticOrder S; S.init(M, DM, F.G, (int)blockIdx.x);
          pg8::EpiRes E{xin, F.out, args.in[13] + layer * DM, HDN, SSp};
          pg8::gemm_phase<pg8::EpiRes, pg8::StaticOrder, false, true>(ring, g, S, E, F.wave); }
        GRID_BAR();
        { pg8::Gemm g{HDN, L + LW_FI, M, FF2, DM, DM, DM}; pg8::StaticOrder S; S.init(M, FF2, F.G, (int)blockIdx.x);
          pg8::EpiSwi E{HB, FFH, SSp};
          pg8::gemm_phase<pg8::EpiSwi, pg8::StaticOrder, true, true>(ring, g, S, E, F.wave); }
        GRID_BAR();
        { pg8::Gemm g{HB, L + LW_FO, M, DM, FFH, FFH, FFH}; pg8::StaticOrder S; S.init(M, DM, F.G, (int)blockIdx.x);
          pg8::EpiRes E{F.out, F.out, args.in[1] + (layer + 1 < DEPTH ? layer + 1 : layer) * DM, HDN, SSp};
          pg8::gemm_phase<pg8::EpiRes, pg8::StaticOrder, false, true>(ring, g, S, E, F.wave); }
        GRID_BAR();
    }
    if (__hip_atomic_load((gu32*)((unsigned*)(ctl + CW_BAR) + XB_TMO), RLX_AGENT) != 0u) {
        const float q = __builtin_nanf("");
        for (int m = F.gw; m < M; m += F.NGW) { GAS f32x4* o = (GAS f32x4*)(F.out + (size_t)m * DM) + lane_id_v();
#pragma unroll
            for (int j = 0; j < 4; ++j) o[64 * j] = (f32x4){q, q, q, q}; }
    }
}

extern "C" void kernel_launch(void* const* d_in, const int* in_sizes, int n_in, void* d_out, int out_size, void* d_ws, size_t ws_size, hipStream_t stream) {
    static int grid = 0;
    if (grid == 0) {
        if (n_in != 16 || in_sizes[0] != M * DM || out_size != M * DM || ws_size < WS_END) { fprintf(stderr, "kernel_launch: unexpected shapes / workspace (n_in %d, in0 %d, out %d, ws %zu < %zu)\n", n_in, n_in > 0 ? in_sizes[0] : -1, out_size, ws_size, (size_t)WS_END); grid = -1; return; }
        int dev = 0, cus = 0, per_cu = 0;
        if (hipGetDevice(&dev) != hipSuccess || hipDeviceGetAttribute(&cus, hipDeviceAttributeMultiprocessorCount, dev) != hipSuccess) { grid = -1; return; }
        if (hipFuncSetAttribute((const void*)hyb_fwd, hipFuncAttributeMaxDynamicSharedMemorySize, LDS_BYTES) != hipSuccess) { fprintf(stderr, "kernel_launch: hipFuncSetAttribute failed\n"); grid = -1; return; }
        if (hipOccupancyMaxActiveBlocksPerMultiprocessor(&per_cu, (const void*)hyb_fwd, NWAVES * 64, LDS_BYTES) != hipSuccess || per_cu < 1) { fprintf(stderr, "kernel_launch: occupancy query reports %d blocks per CU\n", per_cu); }
        (void)hipGetLastError();
        grid = cus;
    }
    if (grid < 0) return;
    if (hipMemsetAsync((char*)d_ws + WS_CTL, 0, CTL_ZERO_BYTES, stream) != hipSuccess) return;
    Args a{};
    for (int i = 0; i < 16; ++i) a.in[i] = (const float*)d_in[i];
    a.out = (float*)d_out; a.ws = (unsigned char*)d_ws;
    hipLaunchKernelGGL(hyb_fwd, dim3(grid), dim3(NWAVES * 64), LDS_BYTES, stream, a);
}
```

```cpp
#include <hip/hip_runtime.h>
#include <cstdio>
#include <cstdint>
#include <cmath>
__device__ __forceinline__ int lane_id_v() { unsigned z; asm volatile("v_mov_b32 %0, 0" : "=v"(z)); return (int)__builtin_amdgcn_mbcnt_hi(~0u, __builtin_amdgcn_mbcnt_lo(~0u, z)); }
template <int MASK> __device__ __forceinline__ float sx(float v) { static_assert(MASK < 32, "swizzle xor mask"); return __builtin_bit_cast(float, __builtin_amdgcn_ds_swizzle(__builtin_bit_cast(int, v), 0x1F | (MASK << 10))); }
template <int MASK> __device__ __forceinline__ unsigned sxu(unsigned v) { return (unsigned)__builtin_amdgcn_ds_swizzle((int)v, 0x1F | (MASK << 10)); }
__device__ __forceinline__ void swap32(unsigned x, unsigned& lo_view, unsigned& hi_view) {
    unsigned a = x, b = x; asm volatile("" : "+v"(b));
    const auto rr = __builtin_amdgcn_permlane32_swap(a, b, false, false);
    lo_view = rr[0]; hi_view = rr[1];
}
template <int CTRL> __device__ __forceinline__ float dpp_f(float v) { return __builtin_bit_cast(float, __builtin_amdgcn_update_dpp(0, __builtin_bit_cast(int, v), CTRL, 0xF, 0xF, false)); }
template <int CTRL> __device__ __forceinline__ int dpp_i(int v) { return __builtin_amdgcn_update_dpp(0, v, CTRL, 0xF, 0xF, false); }
__device__ __forceinline__ float rl_f(float v, int l) { return __builtin_bit_cast(float, __builtin_amdgcn_readlane(__builtin_bit_cast(int, v), l)); }
__device__ __forceinline__ float wave_sum(float v) {
    v += dpp_f<0xB1>(v); v += dpp_f<0x4E>(v); v += dpp_f<0x141>(v); v += dpp_f<0x140>(v);
    return (rl_f(v, 0) + rl_f(v, 16)) + (rl_f(v, 32) + rl_f(v, 48));
}
__device__ __forceinline__ float wave_max(float v) {
    v = fmaxf(v, dpp_f<0xB1>(v)); v = fmaxf(v, dpp_f<0x4E>(v)); v = fmaxf(v, dpp_f<0x141>(v)); v = fmaxf(v, dpp_f<0x140>(v));
    return fmaxf(fmaxf(rl_f(v, 0), rl_f(v, 16)), fmaxf(rl_f(v, 32), rl_f(v, 48)));
}
__device__ __forceinline__ int wave_isum(int v) {
    v += dpp_i<0xB1>(v); v += dpp_i<0x4E>(v); v += dpp_i<0x141>(v); v += dpp_i<0x140>(v);
    return (__builtin_amdgcn_readlane(v, 0) + __builtin_amdgcn_readlane(v, 16)) + (__builtin_amdgcn_readlane(v, 32) + __builtin_amdgcn_readlane(v, 48));
}
__device__ __forceinline__ unsigned wave_umax(unsigned v) {
    unsigned t; t = (unsigned)dpp_i<0xB1>((int)v); v = t > v ? t : v; t = (unsigned)dpp_i<0x4E>((int)v); v = t > v ? t : v; t = (unsigned)dpp_i<0x141>((int)v); v = t > v ? t : v; t = (unsigned)dpp_i<0x140>((int)v); v = t > v ? t : v;
    const unsigned a = (unsigned)__builtin_amdgcn_readlane((int)v, 0), b = (unsigned)__builtin_amdgcn_readlane((int)v, 16), c = (unsigned)__builtin_amdgcn_readlane((int)v, 32), d = (unsigned)__builtin_amdgcn_readlane((int)v, 48);
    const unsigned ab = a > b ? a : b, cd = c > d ? c : d; return ab > cd ? ab : cd;
}
__device__ __forceinline__ unsigned wave_umin(unsigned v) { return ~wave_umax(~v); }
__device__ __forceinline__ float half_sum(float v) {
    unsigned a, b; swap32(__builtin_bit_cast(unsigned, v), a, b); return __builtin_bit_cast(float, a) + __builtin_bit_cast(float, b);
}
__device__ __forceinline__ float half_max(float v) {
    unsigned a, b; swap32(__builtin_bit_cast(unsigned, v), a, b); return fmaxf(__builtin_bit_cast(float, a), __builtin_bit_cast(float, b));
}
namespace pg8 {
#define PG8_LAS __attribute__((address_space(3)))
typedef unsigned short bf16_t;
typedef short bf16x8 __attribute__((ext_vector_type(8)));
typedef float f32x4 __attribute__((ext_vector_type(4)));
typedef unsigned u32x4 __attribute__((ext_vector_type(4)));
constexpr int BM = 256, BK = 64, HALF = 128, HTB = HALF * BK * 2  , STAGE_BYTES = 8 * HTB, NXCD = 8, WGM = 8;

__host__ __device__ __forceinline__ int lds_byte(int r, int c) { const int st = (r >> 4) * 2 + (c >> 5), rr = r & 15, cc = c & 31, ob = rr * 64 + cc * 2; return st * 1024 + (ob ^ (((ob >> 9) & 1) << 5)); }
__host__ __device__ __forceinline__ void stage_rc(int b, int& R, int& C) { const int st = b / 1024, sb = b % 1024, swz = sb ^ (((sb >> 9) & 1) << 5); R = (st >> 1) * 16 + swz / 64; C = (st & 1) * 32 + (swz % 64) / 2; }
__host__ __device__ __forceinline__ int perm32(int rho) { const int n = rho >> 4, i = rho & 15; return 8 * (i >> 2) + 4 * n + (i & 3); }

struct Unit { int pm, pn; };
struct Gemm { const bf16_t* A; const bf16_t* Bt; int M, N, K, lda, ldb; };

struct StaticOrder {
    int nM, nN, nwg, G, c;
    __host__ __device__ void init(int M, int N, int G_, int c_) { nM = M / BM; nN = N / BM; nwg = nM * nN; G = G_; c = c_; }
    __host__ __device__ bool next(int i, Unit& u) const {
        const long L = (long)i * G + c; if (L >= nwg) return false;
        int wgid = (int)L; { const int q = nwg / NXCD, r = nwg % NXCD, xcd = wgid % NXCD, off = wgid / NXCD; wgid = (xcd < r ? xcd * (q + 1) : r * (q + 1) + (xcd - r) * q) + off; }
        const int nig = WGM * nN, gid = wgid / nig, fm = gid * WGM, gsz = (nM - fm) < WGM ? (nM - fm) : WGM;
        u.pm = fm + ((wgid % nig) % gsz); u.pn = (wgid % nig) / gsz; return true;
    }
    __device__ __forceinline__ void a_ready(const Unit&) const {}
    __device__ __forceinline__ void done(const Unit&) const {}
};

__device__ __forceinline__ unsigned cvt_pk_bf16(float lo, float hi) { unsigned r; asm volatile("v_cvt_pk_bf16_f32 %0, %1, %2" : "=v"(r) : "v"(lo), "v"(hi)); return r; }
__device__ __forceinline__ float bflo(unsigned w) { return __builtin_bit_cast(float, w << 16); }
__device__ __forceinline__ float bfhi(unsigned w) { return __builtin_bit_cast(float, w & 0xffff0000u); }
__device__ __forceinline__ float sigmoidf_(float x) { return __builtin_amdgcn_rcpf(1.0f + __builtin_amdgcn_exp2f(-1.4426950408889634f * x)); }

constexpr int ZP = 6656;
constexpr int ZSP = 512;
constexpr int NZT = 26, GATE_T0 = 14;

#define PRELOAD_RSTD(rsv, SS_, row0_) float rsv[2][4]; { f32x4 s_[2][4]; _Pragma("unroll") for (int ai_ = 0; ai_ < 2; ++ai_) _Pragma("unroll") for (int m_ = 0; m_ < 4; ++m_) s_[ai_][m_] = *(const f32x4*)((SS_) + (size_t)((row0_) + ai_ * HALF + m_ * 16) * 4); \
    _Pragma("unroll") for (int ai_ = 0; ai_ < 2; ++ai_) _Pragma("unroll") for (int m_ = 0; m_ < 4; ++m_) rsv[ai_][m_] = 1.0f / __builtin_sqrtf(((s_[ai_][m_][0] + s_[ai_][m_][1]) + (s_[ai_][m_][2] + s_[ai_][m_][3])) * (1.0f / 1024.0f) + 1e-6f); }
struct EpiZ {
    static constexpr bool PERM = true, AFTER_DRAIN = false, MID = false;
    bf16_t* Z; float* ZS; const float* SS; const float* GQ; const float* GK; const float* GD; const float* R64;
    __device__ __forceinline__ void operator()(const f32x4 (&acc)[2][2][4][2], const Unit& u, int wr, int wc, int fr, int fq) const {
        const int row0 = u.pm * BM + wr * 64 + fr;
        PRELOAD_RSTD(rsv, SS, row0);
        if (u.pn < 4 || u.pn == 6 || u.pn == 7) {
            const float osc = (u.pn < 4) ? 0.18033688011112042f : 1.0f; const bool rope = (u.pn == 2 || u.pn == 3);
            f32x4 g00, g01, g10, g11;
            if (u.pn < 2) { g00 = *(const f32x4*)(GQ + 8 * fq); g01 = *(const f32x4*)(GQ + 8 * fq + 4); g10 = *(const f32x4*)(GQ + 32 + 8 * fq); g11 = *(const f32x4*)(GQ + 32 + 8 * fq + 4); }
            else if (u.pn < 4) { g00 = *(const f32x4*)(GD + 8 * fq); g01 = *(const f32x4*)(GD + 8 * fq + 4); g10 = *(const f32x4*)(GD + 32 + 8 * fq); g11 = *(const f32x4*)(GD + 32 + 8 * fq + 4); }
            else { g00 = *(const f32x4*)(GK + 8 * fq); g01 = *(const f32x4*)(GK + 8 * fq + 4); g10 = *(const f32x4*)(GK + 32 + 8 * fq); g11 = *(const f32x4*)(GK + 32 + 8 * fq + 4); }
            const int colo = u.pn * BM + wc * 64 + 8 * fq;
#pragma unroll
            for (int ai = 0; ai < 2; ++ai)
#pragma unroll
                for (int m = 0; m < 4; ++m) { const int row = row0 + ai * HALF + m * 16; const float rs = rsv[ai][m];
                    f32x4 a0 = acc[ai][0][m][0] * rs, a1 = acc[ai][0][m][1] * rs, b0 = acc[ai][1][m][0] * rs, b1 = acc[ai][1][m][1] * rs;
                    float ss = ((a0[0] * a0[0] + a0[1] * a0[1]) + (a0[2] * a0[2] + a0[3] * a0[3])) + ((a1[0] * a1[0] + a1[1] * a1[1]) + (a1[2] * a1[2] + a1[3] * a1[3]))
                             + ((b0[0] * b0[0] + b0[1] * b0[1]) + (b0[2] * b0[2] + b0[3] * b0[3])) + ((b1[0] * b1[0] + b1[1] * b1[1]) + (b1[2] * b1[2] + b1[3] * b1[3]));
                    ss += sx<16>(ss); { unsigned x_, y_; swap32(__builtin_bit_cast(unsigned, ss), x_, y_); ss = __builtin_bit_cast(float, x_) + __builtin_bit_cast(float, y_); }
                    const float hr = osc / __builtin_sqrtf(ss * (1.0f / 64.0f) + 1e-6f);
                    a0 = a0 * g00 * hr; a1 = a1 * g01 * hr; b0 = b0 * g10 * hr; b1 = b1 * g11 * hr;
                    if (rope) { const float* cs = R64 + ((size_t)(row & 4095) * 32 + 8 * fq) * 2;
                        const f32x4 c0 = *(const f32x4*)cs, c1 = *(const f32x4*)(cs + 4), c2 = *(const f32x4*)(cs + 8), c3 = *(const f32x4*)(cs + 12);
                        f32x4 x0, x1, y0, y1;
                        x0[0] = a0[0] * c0[0] - b0[0] * c0[1]; y0[0] = b0[0] * c0[0] + a0[0] * c0[1]; x0[1] = a0[1] * c0[2] - b0[1] * c0[3]; y0[1] = b0[1] * c0[2] + a0[1] * c0[3];
                        x0[2] = a0[2] * c1[0] - b0[2] * c1[1]; y0[2] = b0[2] * c1[0] + a0[2] * c1[1]; x0[3] = a0[3] * c1[2] - b0[3] * c1[3]; y0[3] = b0[3] * c1[2] + a0[3] * c1[3];
                        x1[0] = a1[0] * c2[0] - b1[0] * c2[1]; y1[0] = b1[0] * c2[0] + a1[0] * c2[1]; x1[1] = a1[1] * c2[2] - b1[1] * c2[3]; y1[1] = b1[1] * c2[2] + a1[1] * c2[3];
                        x1[2] = a1[2] * c3[0] - b1[2] * c3[1]; y1[2] = b1[2] * c3[0] + a1[2] * c3[1]; x1[3] = a1[3] * c3[2] - b1[3] * c3[3]; y1[3] = b1[3] * c3[2] + a1[3] * c3[3];
                        a0 = x0; a1 = x1; b0 = y0; b1 = y1; }
                    bf16_t* rowp = Z + (size_t)row * ZP + colo;
                    u32x4 w; w.x = cvt_pk_bf16(a0[0], a0[1]); w.y = cvt_pk_bf16(a0[2], a0[3]); w.z = cvt_pk_bf16(a1[0], a1[1]); w.w = cvt_pk_bf16(a1[2], a1[3]); *(u32x4*)rowp = w;
                    w.x = cvt_pk_bf16(b0[0], b0[1]); w.y = cvt_pk_bf16(b0[2], b0[3]); w.z = cvt_pk_bf16(b1[0], b1[1]); w.w = cvt_pk_bf16(b1[2], b1[3]); *(u32x4*)(rowp + 32) = w;
                    __builtin_amdgcn_sched_barrier(0); }
        } else if (u.pn < NZT) {
            const int col0 = u.pn * BM + wc * 32 + 8 * fq;
#pragma unroll
            for (int ai = 0; ai < 2; ++ai)
#pragma unroll
                for (int m = 0; m < 4; ++m) { bf16_t* rowp = Z + (size_t)(row0 + ai * HALF + m * 16) * ZP + col0; const float rs = rsv[ai][m];
#pragma unroll
                    for (int bj = 0; bj < 2; ++bj) { f32x4 v0 = acc[ai][bj][m][0] * rs, v1 = acc[ai][bj][m][1] * rs;
                        if (u.pn >= GATE_T0) {
#pragma unroll
                            for (int i = 0; i < 4; ++i) { v0[i] = sigmoidf_(v0[i]); v1[i] = sigmoidf_(v1[i]); } }
                        u32x4 w; w.x = cvt_pk_bf16(v0[0], v0[1]); w.y = cvt_pk_bf16(v0[2], v0[3]); w.z = cvt_pk_bf16(v1[0], v1[1]); w.w = cvt_pk_bf16(v1[2], v1[3]);
                        *(u32x4*)(rowp + bj * HALF) = w; } }
        } else {
            const int col0 = (u.pn - NZT) * BM + wc * 32 + 8 * fq;
#pragma unroll
            for (int ai = 0; ai < 2; ++ai)
#pragma unroll
                for (int m = 0; m < 4; ++m) { float* rowp = ZS + (size_t)(row0 + ai * HALF + m * 16) * ZSP + col0; const float rs = rsv[ai][m];
#pragma unroll
                    for (int bj = 0; bj < 2; ++bj) { *(f32x4*)(rowp + bj * HALF) = acc[ai][bj][m][0] * rs; *(f32x4*)(rowp + bj * HALF + 4) = acc[ai][bj][m][1] * rs; } }
        }
    }
};

template <int P> struct EpiGate {
    static constexpr bool PERM = true, AFTER_DRAIN = false, MID = false;
    const bf16_t* G;
    float* M32;
    bf16_t* OUT;
    __device__ __forceinline__ void operator()(const f32x4 (&acc)[2][2][4][2], const Unit& u, int wr, int wc, int fr, int fq) const {
        const int row0 = u.pm * BM + wr * 64 + fr, col0 = u.pn * BM + wc * 32 + 8 * fq;
#pragma unroll
        for (int ai = 0; ai < 2; ++ai)
#pragma unroll
            for (int m = 0; m < 4; ++m) { const size_t row = (size_t)(row0 + ai * HALF + m * 16);
#pragma unroll
                for (int bj = 0; bj < 2; ++bj) { const int col = col0 + bj * HALF;
                    const u32x4 gw = *(const u32x4*)(G + row * ZP + P * 1024 + col);
                    const f32x4 v0 = acc[ai][bj][m][0], v1 = acc[ai][bj][m][1];
                    f32x4 t0, t1;
                    t0[0] = bflo(gw.x) * v0[0]; t0[1] = bfhi(gw.x) * v0[1]; t0[2] = bflo(gw.y) * v0[2]; t0[3] = bfhi(gw.y) * v0[3];
                    t1[0] = bflo(gw.z) * v1[0]; t1[1] = bfhi(gw.z) * v1[1]; t1[2] = bflo(gw.w) * v1[2]; t1[3] = bfhi(gw.w) * v1[3];
                    float* mp = M32 + row * 1024 + col;
                    if (P == 0) { *(f32x4*)mp = t0; *(f32x4*)(mp + 4) = t1; }
                    else if (P == 1) { *(f32x4*)mp = *(const f32x4*)mp + t0; *(f32x4*)(mp + 4) = *(const f32x4*)(mp + 4) + t1; }
                    else { t0 = *(const f32x4*)mp + t0; t1 = *(const f32x4*)(mp + 4) + t1;
                        u32x4 w; w.x = cvt_pk_bf16(t0[0], t0[1]); w.y = cvt_pk_bf16(t0[2], t0[3]); w.z = cvt_pk_bf16(t1[0], t1[1]); w.w = cvt_pk_bf16(t1[2], t1[3]);
                        *(u32x4*)(OUT + row * ZP + col) = w; } } }
    }
};

struct EpiGateF {
    static constexpr bool PERM = true, AFTER_DRAIN = false, MID = true;
    const bf16_t* G; bf16_t* OUT;
    __device__ __forceinline__ void mid(f32x4 (&acc)[2][2][4][2], const Unit& u, int wr, int wc, int fr_, int fq_, int s) const {
        int fr = fr_, fq = fq_; asm volatile("" : "+v"(fr), "+v"(fq));
        const int row0 = u.pm * BM + wr * 64 + fr, col0 = u.pn * BM + wc * 32 + 8 * fq;
#pragma unroll
        for (int ai = 0; ai < 2; ++ai) {
            u32x4 ga[4][2], gb[4][2];
#pragma unroll
            for (int m = 0; m < 4; ++m)
#pragma unroll
                for (int bj = 0; bj < 2; ++bj) { const bf16_t* gp = G + (size_t)(row0 + ai * HALF + m * 16) * ZP + s * 1024 + col0 + bj * HALF; ga[m][bj] = *(const u32x4*)gp; gb[m][bj] = *(const u32x4*)(gp + 1024); }
#pragma unroll
            for (int m = 0; m < 4; ++m)
#pragma unroll
                for (int bj = 0; bj < 2; ++bj) { const u32x4 a = ga[m][bj], b = gb[m][bj]; f32x4 r0, r1;
                    r0[0] = bflo(a.x) * __builtin_amdgcn_rcpf(__builtin_fmaxf(bflo(b.x), 1e-30f)); r0[1] = bfhi(a.x) * __builtin_amdgcn_rcpf(__builtin_fmaxf(bfhi(b.x), 1e-30f)); r0[2] = bflo(a.y) * __builtin_amdgcn_rcpf(__builtin_fmaxf(bflo(b.y), 1e-30f)); r0[3] = bfhi(a.y) * __builtin_amdgcn_rcpf(__builtin_fmaxf(bfhi(b.y), 1e-30f));
                    r1[0] = bflo(a.z) * __builtin_amdgcn_rcpf(__builtin_fmaxf(bflo(b.z), 1e-30f)); r1[1] = bfhi(a.z) * __builtin_amdgcn_rcpf(__builtin_fmaxf(bfhi(b.z), 1e-30f)); r1[2] = bflo(a.w) * __builtin_amdgcn_rcpf(__builtin_fmaxf(bflo(b.w), 1e-30f)); r1[3] = bfhi(a.w) * __builtin_amdgcn_rcpf(__builtin_fmaxf(bfhi(b.w), 1e-30f));
                    acc[ai][bj][m][0] = acc[ai][bj][m][0] * r0; acc[ai][bj][m][1] = acc[ai][bj][m][1] * r1; }
            __builtin_amdgcn_sched_barrier(0); }
    }
    __device__ __forceinline__ void operator()(const f32x4 (&acc)[2][2][4][2], const Unit& u, int wr, int wc, int fr, int fq) const {
        const int row0 = u.pm * BM + wr * 64 + fr, col0 = u.pn * BM + wc * 32 + 8 * fq;
#pragma unroll
        for (int ai = 0; ai < 2; ++ai)
#pragma unroll
            for (int m = 0; m < 4; ++m) { const size_t row = (size_t)(row0 + ai * HALF + m * 16);
#pragma unroll
                for (int bj = 0; bj < 2; ++bj) { const int col = col0 + bj * HALF;
                    const u32x4 gw = *(const u32x4*)(G + row * ZP + 2 * 1024 + col);
                    const f32x4 v0 = acc[ai][bj][m][0], v1 = acc[ai][bj][m][1];
                    u32x4 w; w.x = cvt_pk_bf16(bflo(gw.x) * v0[0], bfhi(gw.x) * v0[1]); w.y = cvt_pk_bf16(bflo(gw.y) * v0[2], bfhi(gw.y) * v0[3]);
                    w.z = cvt_pk_bf16(bflo(gw.z) * v1[0], bfhi(gw.z) * v1[1]); w.w = cvt_pk_bf16(bflo(gw.w) * v1[2], bfhi(gw.w) * v1[3]);
                    *(u32x4*)(OUT + row * ZP + col) = w; } }
    }
};

struct EpiRes {
    static constexpr bool PERM = true, AFTER_DRAIN = true, MID = false;
    const float* RES; float* OUT; const float* G; bf16_t* XG; float* SS;
    __device__ __forceinline__ void fused(const f32x4 (&acc)[2][2][4][2], const Unit& u, int wr, int wc, int fr, int fq, PG8_LAS unsigned char* lds, int wid, int lane) const {
        const int row0 = u.pm * BM + wr * 64 + fr, col0 = u.pn * BM + wc * 32 + 8 * fq;
        PG8_LAS float* P = (PG8_LAS float*)lds;
        f32x4 g[2][2];
#pragma unroll
        for (int bj = 0; bj < 2; ++bj) { g[bj][0] = *(const f32x4*)(G + col0 + bj * HALF); g[bj][1] = *(const f32x4*)(G + col0 + bj * HALF + 4); }
#pragma unroll
        for (int ai = 0; ai < 2; ++ai)
#pragma unroll
            for (int m = 0; m < 4; ++m) { const int row = row0 + ai * HALF + m * 16; const size_t off = (size_t)row * 1024 + col0; float ss = 0.f;
#pragma unroll
                for (int bj = 0; bj < 2; ++bj) { const float* rp = RES + off + bj * HALF; float* op = OUT + off + bj * HALF;
                    const f32x4 v0 = *(const f32x4*)rp + acc[ai][bj][m][0], v1 = *(const f32x4*)(rp + 4) + acc[ai][bj][m][1];
                    *(f32x4*)op = v0; *(f32x4*)(op + 4) = v1;
                    ss += ((v0[0] * v0[0] + v0[1] * v0[1]) + (v0[2] * v0[2] + v0[3] * v0[3])) + ((v1[0] * v1[0] + v1[1] * v1[1]) + (v1[2] * v1[2] + v1[3] * v1[3]));
                    const f32x4 x0 = v0 * g[bj][0], x1 = v1 * g[bj][1];
                    u32x4 w; w.x = cvt_pk_bf16(x0[0], x0[1]); w.y = cvt_pk_bf16(x0[2], x0[3]); w.z = cvt_pk_bf16(x1[0], x1[1]); w.w = cvt_pk_bf16(x1[2], x1[3]);
                    *(u32x4*)(XG + off + bj * HALF) = w; }
                ss += sx<16>(ss); { unsigned a, b; swap32(__builtin_bit_cast(unsigned, ss), a, b); ss = __builtin_bit_cast(float, a) + __builtin_bit_cast(float, b); }
                if (fq == 0) P[(ai * HALF + wr * 64 + m * 16 + fr) * 4 + wc] = ss; }
        asm volatile("s_waitcnt lgkmcnt(0)\n\ts_barrier" ::: "memory");
        const int t = wid * 64 + lane;
        if (t < 256) { const f32x4 p = *(const PG8_LAS f32x4*)(P + t * 4); SS[(size_t)(u.pm * BM + t) * 4 + u.pn] = (p[0] + p[1]) + (p[2] + p[3]); }
    }
};

struct EpiSwi {
    static constexpr bool PERM = true, AFTER_DRAIN = false, MID = false;
    bf16_t* H; int ldh; const float* SS;
    __device__ __forceinline__ void operator()(const f32x4 (&acc)[2][2][4][2], const Unit& u, int wr, int wc, int fr, int fq) const {
        const int row0 = u.pm * BM + wr * 64 + fr, col0 = u.pn * HALF + wc * 32 + 8 * fq;
        PRELOAD_RSTD(rsv, SS, row0);
#pragma unroll
        for (int ai = 0; ai < 2; ++ai)
#pragma unroll
            for (int m = 0; m < 4; ++m) { bf16_t* hp = H + (size_t)(row0 + ai * HALF + m * 16) * ldh + col0; const float rs = rsv[ai][m];
                float o[8];
#pragma unroll
                for (int n = 0; n < 2; ++n)
#pragma unroll
                    for (int i = 0; i < 4; ++i) { const float g = acc[ai][0][m][n][i] * rs, up = acc[ai][1][m][n][i] * rs; o[4 * n + i] = g * sigmoidf_(g) * up; }
                u32x4 w; w.x = cvt_pk_bf16(o[0], o[1]); w.y = cvt_pk_bf16(o[2], o[3]); w.z = cvt_pk_bf16(o[4], o[5]); w.w = cvt_pk_bf16(o[6], o[7]);
                *(u32x4*)hp = w; }
    }
};

template <class Epi, class Sched, bool ALIGN_EPI = false, bool SP2 = false>
__device__ __forceinline__ void gemm_phase(PG8_LAS unsigned char* lds, Gemm g, const Sched& S0, const Epi& E, int wave_id) {
    int ovz, osz; asm volatile("v_mov_b32 %0, 0\n\ts_mov_b32 %1, 0" : "=v"(ovz), "=s"(osz));
    Sched S = S0; S.c += osz; g.lda += osz; g.ldb += osz;
    const int tid = ((wave_id << 6) | lane_id_v()) + ovz,
         wid = __builtin_amdgcn_readfirstlane(tid >> 6), lane = tid & 63, wr = wid >> 2, wc = wid & 3, fr = lane & 15, fq = lane >> 4;
    const int K = g.K, nt = K / BK;
    unsigned voffA[2], voffB[2];
#pragma unroll
    for (int i = 0; i < 2; ++i) { int R, C; stage_rc(tid * 16 + i * 8192, R, C); const int Rb = Epi::PERM ? ((R & ~31) + perm32(R & 31)) : R;
        voffA[i] = (unsigned)(R * g.lda + C) * 2u; voffB[i] = (unsigned)(Rb * g.ldb + C) * 2u; }
    const size_t kstep = (size_t)(BK * 2);
    const size_t hstepA = (size_t)HALF * g.lda * 2, hstepB = (size_t)HALF * g.ldb * 2;
    const size_t tstepA = 2 * hstepA, tstepB = 2 * hstepB;
    const unsigned ldsw = (unsigned)wid * 1024u;
    const int aoff = lds_byte(wr * 64 + fr, fq * 8), boff = lds_byte(wc * 32 + fr, fq * 8);
#define PG8_SA(b, h) (((b) * 2 + (h)) * HTB)
#define PG8_SB(b, h) ((4 + (b) * 2 + (h)) * HTB)
#define PG8_STAGE(bufoff, gbase, voff) do { _Pragma("unroll") for (int _i = 0; _i < 2; ++_i) \
        __builtin_amdgcn_global_load_lds((const unsigned*)((const char*)(gbase) + (voff)[_i]), (PG8_LAS unsigned*)(lds + (bufoff) + ldsw + _i * 8192), 16, 0, 0); } while (0)
#define PG8_LDA(dst, b, h) do { _Pragma("unroll") for (int m = 0; m < 4; ++m) _Pragma("unroll") for (int k = 0; k < 2; ++k) dst[m][k] = *(const PG8_LAS bf16x8*)(lds + PG8_SA(b, h) + aoff + m * 2048 + k * 1024); } while (0)
#define PG8_LDB(dst, b, h) do { _Pragma("unroll") for (int n = 0; n < 2; ++n) _Pragma("unroll") for (int k = 0; k < 2; ++k) dst[n][k] = *(const PG8_LAS bf16x8*)(lds + PG8_SB(b, h) + boff + n * 2048 + k * 1024); } while (0)
#define PG8_MMA(ai, bj, At, Bt) do { __builtin_amdgcn_s_setprio(1); _Pragma("unroll") for (int m = 0; m < 4; ++m) _Pragma("unroll") for (int n = 0; n < 2; ++n) _Pragma("unroll") for (int k = 0; k < 2; ++k) \
        acc[ai][bj][m][n] = __builtin_amdgcn_mfma_f32_16x16x32_bf16(Bt[n][k], At[m][k], acc[ai][bj][m][n], 0, 0, 0); __builtin_amdgcn_s_setprio(0); } while (0)
#define PG8_WAIT_V(n) asm volatile("s_waitcnt vmcnt(" #n ")" ::: "memory")
#define PG8_WAIT_L(n) asm volatile("s_waitcnt lgkmcnt(" #n ")" ::: "memory")
#define PG8_BAR __builtin_amdgcn_s_barrier()
#define PG8_SCHED __builtin_amdgcn_sched_barrier(0)
    Unit cur, nxt; int ui = 0;
    if (!S.next(0, cur)) return;
    f32x4 acc[2][2][4][2];
#pragma unroll
    for (int a = 0; a < 2; ++a)
#pragma unroll
        for (int b = 0; b < 2; ++b)
#pragma unroll
            for (int m = 0; m < 4; ++m)
#pragma unroll
                for (int n = 0; n < 2; ++n) acc[a][b][m][n] = (f32x4){0.f, 0.f, 0.f, 0.f};
    bf16x8 At[4][2], B0[2][2], B1[2][2];
    const char* cA = (const char*)g.A + (size_t)cur.pm * tstepA; const char* cB = (const char*)g.Bt + (size_t)cur.pn * tstepB;
    S.a_ready(cur);
    if constexpr (SP2) {
        PG8_STAGE(PG8_SB(0, 0), cB, voffB); PG8_STAGE(PG8_SB(0, 1), cB + hstepB, voffB); PG8_STAGE(PG8_SA(0, 0), cA, voffA); PG8_STAGE(PG8_SA(0, 1), cA + hstepA, voffA);
        if (wr == 1) PG8_BAR;
        PG8_WAIT_V(2); PG8_BAR;
        PG8_STAGE(PG8_SB(1, 0), cB + kstep, voffB); PG8_STAGE(PG8_SA(1, 0), cA + kstep, voffA); PG8_STAGE(PG8_SB(1, 1), cB + hstepB + kstep, voffB);
        PG8_WAIT_V(6); PG8_BAR;
    } else {
        PG8_STAGE(PG8_SB(0, 0), cB, voffB); PG8_STAGE(PG8_SA(0, 0), cA, voffA); PG8_STAGE(PG8_SB(0, 1), cB + hstepB, voffB); PG8_STAGE(PG8_SA(0, 1), cA + hstepA, voffA);
        if (wr == 1) PG8_BAR;
        PG8_WAIT_V(4); PG8_BAR;
        PG8_STAGE(PG8_SB(1, 0), cB + kstep, voffB); PG8_STAGE(PG8_SA(1, 0), cA + kstep, voffA); PG8_STAGE(PG8_SB(1, 1), cB + hstepB + kstep, voffB);
        PG8_WAIT_V(6); PG8_BAR;
    }
    for (;;) {
        const bool has_next = S.next(ui + 1, nxt);
        const char* nA = has_next ? (const char*)g.A + (size_t)nxt.pm * tstepA : cA; const char* nB = has_next ? (const char*)g.Bt + (size_t)nxt.pn * tstepB : cB;
        for (int t = 0; t < nt; t += 2) {
            if constexpr (Epi::MID) { if (t == 8 || t == 16) E.mid(acc, cur, wr, wc, fr, fq, (t >> 3) - 1); }
            const bool last = (t == nt - 2);
            const char* a1 = cA + (size_t)(t + 1) * kstep;
            const char* a2 = last ? nA : cA + (size_t)(t + 2) * kstep; const char* b2 = last ? nB : cB + (size_t)(t + 2) * kstep;
            const char* a3 = a2 + kstep; const char* b3 = b2 + kstep;
            if (last && has_next) S.a_ready(nxt);
            if constexpr (SP2) {
            PG8_LDB(B0, 0, 0); PG8_LDB(B1, 0, 1); PG8_SCHED; PG8_LDA(At, 0, 0); PG8_STAGE(PG8_SA(1, 1), a1 + hstepA, voffA);
            PG8_WAIT_V(8); PG8_WAIT_L(0); PG8_BAR; PG8_MMA(0, 0, At, B0); PG8_MMA(0, 1, At, B1); PG8_BAR; PG8_SCHED;
            PG8_LDA(At, 0, 1); PG8_STAGE(PG8_SB(0, 0), b2, voffB); PG8_STAGE(PG8_SB(0, 1), b2 + hstepB, voffB); PG8_STAGE(PG8_SA(0, 0), a2, voffA);
            PG8_WAIT_V(8); PG8_WAIT_L(0); PG8_BAR; PG8_MMA(1, 0, At, B0); PG8_MMA(1, 1, At, B1); PG8_BAR; PG8_SCHED;
            PG8_LDB(B0, 1, 0); PG8_LDB(B1, 1, 1); PG8_SCHED; PG8_LDA(At, 1, 0); PG8_STAGE(PG8_SA(0, 1), a2 + hstepA, voffA);
            PG8_WAIT_V(8); PG8_WAIT_L(0); PG8_BAR; PG8_MMA(0, 0, At, B0); PG8_MMA(0, 1, At, B1); PG8_BAR; PG8_SCHED;
            PG8_LDA(At, 1, 1); PG8_STAGE(PG8_SB(1, 0), b3, voffB); PG8_STAGE(PG8_SB(1, 1), b3 + hstepB, voffB); PG8_STAGE(PG8_SA(1, 0), a3, voffA);
            PG8_WAIT_V(8); PG8_WAIT_L(0); PG8_BAR; PG8_MMA(1, 0, At, B0); PG8_MMA(1, 1, At, B1); PG8_BAR; PG8_SCHED;
            } else {
            PG8_LDB(B0, 0, 0); PG8_SCHED; PG8_LDA(At, 0, 0); PG8_STAGE(PG8_SA(1, 1), a1 + hstepA, voffA);
            PG8_WAIT_L(8); PG8_BAR; PG8_WAIT_L(0); PG8_MMA(0, 0, At, B0); PG8_BAR; PG8_SCHED;
            PG8_LDB(B1, 0, 1); PG8_STAGE(PG8_SB(0, 0), b2, voffB);
            PG8_BAR; PG8_WAIT_L(0); PG8_MMA(0, 1, At, B1); PG8_BAR;
            PG8_LDA(At, 0, 1); PG8_STAGE(PG8_SA(0, 0), a2, voffA);
            PG8_BAR; PG8_WAIT_L(0); PG8_MMA(1, 0, At, B0); PG8_BAR; PG8_SCHED;
            PG8_STAGE(PG8_SB(0, 1), b2 + hstepB, voffB);
            PG8_WAIT_V(6); PG8_BAR; PG8_MMA(1, 1, At, B1); PG8_BAR;
            PG8_LDB(B0, 1, 0); PG8_SCHED; PG8_LDA(At, 1, 0); PG8_STAGE(PG8_SA(0, 1), a2 + hstepA, voffA);
            PG8_WAIT_L(8); PG8_BAR; PG8_WAIT_L(0); PG8_MMA(0, 0, At, B0); PG8_BAR; PG8_SCHED;
            PG8_LDB(B1, 1, 1); PG8_STAGE(PG8_SB(1, 0), b3, voffB);
            PG8_BAR; PG8_WAIT_L(0); PG8_MMA(0, 1, At, B1); PG8_BAR;
            PG8_LDA(At, 1, 1); PG8_STAGE(PG8_SA(1, 0), a3, voffA);
            PG8_BAR; PG8_WAIT_L(0); PG8_MMA(1, 0, At, B0); PG8_BAR; PG8_SCHED;
            PG8_STAGE(PG8_SB(1, 1), b3 + hstepB, voffB);
            PG8_WAIT_V(6); PG8_BAR; PG8_MMA(1, 1, At, B1); PG8_BAR;
            }
        }
        if constexpr (ALIGN_EPI) { if (wr == 0) PG8_BAR; }
        if constexpr (!Epi::AFTER_DRAIN) { E(acc, cur, wr, wc, fr, fq); S.done(cur); }
        if (!has_next) break;
#pragma unroll
        for (int a = 0; a < 2; ++a)
#pragma unroll
            for (int b = 0; b < 2; ++b)
#pragma unroll
                for (int m = 0; m < 4; ++m)
#pragma unroll
                    for (int n = 0; n < 2; ++n) acc[a][b][m][n] = (f32x4){0.f, 0.f, 0.f, 0.f};
        cur = nxt; cA = nA; cB = nB; ++ui;
        if constexpr (ALIGN_EPI) { if (wr == 1) PG8_BAR; }
    }
    PG8_WAIT_V(0);
    if constexpr (!ALIGN_EPI) { if (wr == 0) PG8_BAR; }
    PG8_BAR;
    if constexpr (Epi::AFTER_DRAIN) { E.fused(acc, cur, wr, wc, fr, fq, lds, wid, lane); S.done(cur); }
#undef PG8_SA
#undef PG8_SB
#undef PG8_STAGE
#undef PG8_LDA
#undef PG8_LDB
#undef PG8_MMA
#undef PG8_WAIT_V
#undef PG8_WAIT_L
#undef PG8_BAR
#undef PG8_SCHED
}
}

constexpr int NB = 4, SEQ = 4096, DM = 1024, DEPTH = 4, M = NB * SEQ;
constexpr int INC = 7088;
constexpr int NIN = 7168;
constexpr int FFH = 2816, FF2 = 5632;
constexpr int ZP = pg8::ZP, ZSP = pg8::ZSP;
constexpr int Z_FQ = 0, Z_DQ = 512, Z_RV = 1024, Z_FK = 1536, Z_FV = 2048,
     Z_RQ = 2560, Z_RK = 2816, Z_RG = 3072, Z_ZG = 3584, Z_MRG = 2560;
constexpr int S_IQ = 0, S_DK = 256, S_DV = 320, S_IK = 384, S_IW = 416, S_FF = 424;
constexpr float NORM_EPS = 1e-6f;
constexpr float LOG2E = 1.4426950408889634f;
constexpr float C2 = 0.125f * 1.4426950408889634f;

constexpr size_t MiB = 1u << 20;
constexpr size_t WS_CTL = 0, CTL_ZERO_BYTES = 1 * MiB;
constexpr size_t WS_ROPE64 = 1 * MiB;
constexpr size_t WS_ROPE32 = 2 * MiB;
constexpr size_t WS_LF = 2 * MiB + 512 * 1024;
constexpr size_t WS_CF = 3 * MiB;
constexpr size_t WS_ISG = 3 * MiB + 512 * 1024;
constexpr size_t WS_KD = 4 * MiB;
constexpr size_t WS_VD = 6 * MiB;
constexpr size_t WS_W = 8 * MiB;
constexpr size_t LW_IN = 0, LW_MIX = (size_t)NIN * 1024, LW_O = LW_MIX + 1536 * 1024, LW_FI = LW_O + 1024 * 1024, LW_FO = LW_FI + (size_t)FF2 * 1024, LW_STRIDE = LW_FO + (size_t)FFH * 1024;
constexpr size_t WS_Z = 150 * MiB;
constexpr size_t WS_HDN = 358 * MiB;
constexpr size_t WS_ZS = 390 * MiB;
constexpr size_t WS_IQB = 422 * MiB;
constexpr size_t WS_IKB = 430 * MiB;
constexpr size_t WS_SS = 431 * MiB;
constexpr size_t WS_END = 432 * MiB;
static_assert(WS_W + DEPTH * LW_STRIDE * 2 <= WS_Z && WS_Z + (size_t)M * ZP * 2 <= WS_HDN && WS_HDN + (size_t)M * 1024 * 2 == WS_ZS && WS_ZS + (size_t)M * ZSP * 4 == WS_IQB, "d_ws map");
constexpr int CW_BAR = 4096;

constexpr int RING_OFF = 0, RING_BYTES = 133120;
constexpr int LDSCTL_OFF = RING_BYTES, MISC_OFF = LDSCTL_OFF + 320;
constexpr int XTRA_OFF = RING_BYTES + 1024;
constexpr int LDS_BYTES = 147456;
constexpr int NWAVES = 8;
#define GAS __attribute__((address_space(1)))
#define LAS __attribute__((address_space(3)))
typedef unsigned short bf16;
typedef unsigned v4u __attribute__((ext_vector_type(4)));
typedef float f32x4 __attribute__((ext_vector_type(4)));
typedef short bf16x8 __attribute__((ext_vector_type(8)));
typedef GAS unsigned gu32;
typedef GAS unsigned long long gu64;
#define RLX_AGENT __ATOMIC_RELAXED, __HIP_MEMORY_SCOPE_AGENT
#define LDS_WAIT() asm volatile("s_waitcnt lgkmcnt(0)" ::: "memory")
#define VM_WAIT() asm volatile("s_waitcnt vmcnt(0)" ::: "memory")
__device__ __forceinline__ unsigned long long rt() { return __builtin_amdgcn_s_memrealtime(); }
__device__ __forceinline__ unsigned f2bf(float f) { unsigned u = __builtin_bit_cast(unsigned, f); return (u + 0x7fffu + ((u >> 16) & 1u)) >> 16; }
__device__ __forceinline__ unsigned pk2(float lo, float hi) { unsigned r; asm("v_cvt_pk_bf16_f32 %0, %1, %2" : "=v"(r) : "v"(lo), "v"(hi)); return r; }

#define XB_TMO      128
#define XB_XCNT(j)  (256  + 64 * (j))
#define XB_XSUB(j)  (1280 + 64 * (j))
#define XB_XGEN(j)  (2304 + 64 * (j))
#define XB_TOP      3328
#define XB_TOPGEN   3392
#define XCD_BAR_WORDS 3456
#define XB_SPIN_CAP (1u << 22)

__device__ __forceinline__ unsigned xb_ld(unsigned* p)              { return __hip_atomic_load(p, __ATOMIC_RELAXED, __HIP_MEMORY_SCOPE_AGENT); }
__device__ __forceinline__ unsigned xb_add(unsigned* p, unsigned v) { return __hip_atomic_fetch_add(p, v, __ATOMIC_RELAXED, __HIP_MEMORY_SCOPE_AGENT); }
__device__ __forceinline__ unsigned xb_xcc_id() { return (unsigned)__builtin_amdgcn_s_getreg((3 << 11) | 20) & 0xFu; }
#define XB_SPIN(cond, bar) do { unsigned _sp = 0; while (cond) { __builtin_amdgcn_s_sleep(1); \
    if ((++_sp & 255u) == 0u) { if (xb_ld(&(bar)[XB_TMO])) break; if (_sp > XB_SPIN_CAP) { atomicAdd(&(bar)[XB_TMO], 1u); break; } } } } while (0)

struct XcdBarrier {
    unsigned* bar; unsigned x; int w;
    volatile LAS unsigned* st;
};

__device__ __forceinline__ XcdBarrier xcd_barrier_post(unsigned* bar, volatile LAS unsigned* st) {
    XcdBarrier b; b.bar = bar; b.x = xb_xcc_id(); b.st = st; b.w = 0;
    if (threadIdx.x == 0) (void)xb_add(&bar[XB_XCNT(b.x)], 1u);
    return b;
}
__device__ __forceinline__ void xcd_barrier_complete(unsigned* bar, unsigned x, unsigned& nloc, unsigned& nx) {
    const unsigned G = gridDim.x * gridDim.y * gridDim.z;
    unsigned sum, cnt, mine, sp = 0u;
    for (;;) {
        sum = 0u; cnt = 0u; mine = 0u;
#pragma unroll
        for (unsigned j = 0; j < 16; ++j) { const unsigned c = xb_ld(&bar[XB_XCNT(j)]); sum += c; cnt += (c > 0u) ? 1u : 0u; mine = (j == x) ? c : mine; }
        if (sum == G) break;
        __builtin_amdgcn_s_sleep(1);
        if ((++sp & 255u) == 0u) { if (xb_ld(&bar[XB_TMO])) break; if (sp > XB_SPIN_CAP) { atomicAdd(&bar[XB_TMO], 1u); break; } }
    }
    nloc = mine > 0u ? mine : 1u; nx = cnt > 0u ? cnt : 1u;
}

__device__ __forceinline__ void xcd_barrier(const XcdBarrier& b) {
    asm volatile("s_waitcnt vmcnt(0)" ::: "memory");
    __syncthreads();
    if (b.w == 0 && lane_id_v() == 0) {
        unsigned* bar = b.bar;
        __builtin_amdgcn_s_waitcnt(0);
        unsigned nloc = b.st[0], nx = b.st[1];
        if (nloc == 0u) { xcd_barrier_complete(bar, b.x, nloc, nx); b.st[0] = nloc; b.st[1] = nx; }
        const unsigned old = xb_add(&bar[XB_XSUB(b.x)], 1u);
        const unsigned gen = old / nloc;
        if (old + 1u == (gen + 1u) * nloc) {
            __builtin_amdgcn_fence(__ATOMIC_RELEASE, "agent");
            asm volatile("s_waitcnt vmcnt(0)" ::: "memory");
            const unsigned og = xb_add(&bar[XB_TOP], 1u);
            const unsigned tg = og / nx;
            if (og + 1u == (tg + 1u) * nx) xb_add(&bar[XB_TOPGEN], 1u);
            else XB_SPIN(xb_ld(&bar[XB_TOPGEN]) == tg, bar);
            __builtin_amdgcn_fence(__ATOMIC_ACQUIRE, "agent");
            xb_add(&bar[XB_XGEN(b.x)], 1u);
            asm volatile("s_waitcnt vmcnt(0)" ::: "memory");
        } else {
            XB_SPIN(xb_ld(&bar[XB_XGEN(b.x)]) == gen, bar);
            __builtin_amdgcn_fence(__ATOMIC_ACQUIRE, "agent");
            asm volatile("s_waitcnt vmcnt(0)" ::: "memory");
        }
    }
    __syncthreads();
}

typedef float f32x2 __attribute__((ext_vector_type(2)));
typedef unsigned u32x2 __attribute__((ext_vector_type(2)));
__device__ __forceinline__ float bflo(unsigned w) { return __builtin_bit_cast(float, w << 16); }
__device__ __forceinline__ float bfhi(unsigned w) { return __builtin_bit_cast(float, w & 0xffff0000u); }
__device__ __forceinline__ float bf2f(bf16 v) { return __builtin_bit_cast(float, (unsigned)v << 16); }
__device__ __forceinline__ void unpack8(const v4u w, float (&f)[8]) { f[0] = bflo(w.x); f[1] = bfhi(w.x); f[2] = bflo(w.y); f[3] = bfhi(w.y); f[4] = bflo(w.z); f[5] = bfhi(w.z); f[6] = bflo(w.w); f[7] = bfhi(w.w); }
__device__ __forceinline__ v4u pack8(const float (&f)[8]) { v4u w; w.x = pk2(f[0], f[1]); w.y = pk2(f[2], f[3]); w.z = pk2(f[4], f[5]); w.w = pk2(f[6], f[7]); return w; }
__device__ __forceinline__ float xor32(float v, int lane) {
    return __builtin_bit_cast(float, __builtin_amdgcn_ds_bpermute((lane ^ 32) << 2, __builtin_bit_cast(int, v)));
}
__device__ __forceinline__ float sigmoid_f(float x) { return 1.0f / (1.0f + __expf(-x)); }

struct Ctx {
    LAS unsigned char* lds;
    int tid, lane, wave, G, gw, NGW;
    float* out; unsigned char* ws;
};

__device__ __forceinline__ void conv_item(const float* W, int N, int sc, int nv, int k0, bf16* WT, int ldw, int dr, LAS float* scr, int lane) {
    const int n_ = lane & 31;
    float wv[32];
#pragma unroll
    for (int i = 0; i < 32; ++i) { const int kk = 2 * i + (lane >> 5); wv[i] = (n_ < nv) ? W[(size_t)(k0 + kk) * N + sc + n_] : 0.f; }
#pragma unroll
    for (int i = 0; i < 32; ++i) { const int kk = 2 * i + (lane >> 5); scr[kk * 33 + n_] = wv[i]; }
    LDS_WAIT(); asm volatile("" ::: "memory");
    const int c = lane & 7;
#pragma unroll
    for (int j = 0; j < 4; ++j) { const int n = (lane >> 3) + 8 * j; const LAS float* s = scr + (8 * c) * 33 + n;
        v4u o; o.x = pk2(s[0 * 33], s[1 * 33]); o.y = pk2(s[2 * 33], s[3 * 33]); o.z = pk2(s[4 * 33], s[5 * 33]); o.w = pk2(s[6 * 33], s[7 * 33]);
        if (n < nv) *(GAS v4u*)(WT + (size_t)(dr + n) * ldw + k0 + 8 * c) = o; }
    LDS_WAIT(); asm volatile("" ::: "memory");
}
__device__ const int SEG_IN[15][3] = {
    {0, Z_FQ, 512}, {512, Z_FK, 512}, {1024, Z_FV, 512}, {1536, 6656 + S_FF, 8}, {1544, Z_DQ, 512}, {2056, 6656 + S_DK, 64}, {2120, 6656 + S_DV, 64},
    {2184, 6656 + S_IQ, 256}, {2440, 6656 + S_IK, 32}, {2472, 6656 + S_IW, 8}, {2480, Z_RQ, 256}, {2736, Z_RK, 256}, {2992, Z_RV, 512}, {3504, Z_RG, 512}, {4016, Z_ZG, 3072}};
constexpr int IN_BLK = 223;
constexpr int IT_IN = 16 * IN_BLK, IT_MIX = 8 * 32, IT_O = 16 * 32, IT_FI = 16 * (FF2 / 32), IT_FO = (FFH / 64) * 32;
constexpr int IT_LAYER = IT_IN + 3 * IT_MIX + IT_O + IT_FI + IT_FO;

__device__ __forceinline__ void sincos_acc(float ang, float& c, float& s) {
    const double a = (double)ang;
    const double k = __builtin_rint(a * 0.6366197723675814);
    double y = a - k * 1.5707963267948966; y -= k * 6.123233995736766e-17;
    const double y2 = y * y;
    double sp = -7.647163731819816e-13; sp = sp * y2 + 1.6059043836821613e-10; sp = sp * y2 - 2.505210838544172e-08; sp = sp * y2 + 2.7557319223985893e-06; sp = sp * y2 - 1.984126984126984e-04; sp = sp * y2 + 8.333333333333333e-03; sp = sp * y2 - 1.6666666666666666e-01;
    const double sn = y + y * y2 * sp;
    double cp = 4.779477332387385e-14; cp = cp * y2 - 1.1470745597729725e-11; cp = cp * y2 + 2.08767569878681e-09; cp = cp * y2 - 2.755731922398589e-07; cp = cp * y2 + 2.48015873015873e-05; cp = cp * y2 - 1.388888888888889e-03; cp = cp * y2 + 4.1666666666666664e-02; cp = cp * y2 - 0.5;
    const double cs = 1.0 + y2 * cp;
    const int q = ((int)k) & 3;
    const double ss = (q & 1) ? cs : sn, cc = (q & 1) ? sn : cs;
    s = (float)((q & 2) ? -ss : ss);
    c = (float)(((q + 1) & 2) ? -cc : cc);
}

__device__ __forceinline__ void p0_prologue(const Ctx& F, const float* w_in, const float* w_fox, const float* w_dsa, const float* w_ret, const float* w_o, const float* w_fi, const float* w_fo) {
    LAS float* scr = (LAS float*)(F.lds + RING_OFF + F.wave * 16384);
    bf16* Wb = (bf16*)(F.ws + WS_W);
    for (int it = F.gw; it < DEPTH * IT_LAYER; it += F.NGW) {
        const int l = it / IT_LAYER; int r = it % IT_LAYER;
        bf16* L = Wb + (size_t)l * LW_STRIDE;
        if (r < IT_IN) {
            const int kb = r / IN_BLK; int blk = r % IN_BLK; int sc = 0, dr = 0, nv = 0;
            for (int s = 0; s < 15; ++s) { const int w = SEG_IN[s][2], nb = (w + 31) >> 5; if (blk < nb) { sc = SEG_IN[s][0] + 32 * blk; dr = SEG_IN[s][1] + 32 * blk; nv = (w - 32 * blk) < 32 ? (w - 32 * blk) : 32;
                if (s == 0 || s == 1 || s == 4) { const int hd = blk >> 1; dr = SEG_IN[s][1] + (hd >> 2) * 256 + 128 * (blk & 1) + 32 * (hd & 3); }
                break; } blk -= nb; }
            conv_item(w_in + (size_t)l * DM * INC, INC, sc, nv, 64 * kb, L + LW_IN, 1024, dr, scr, F.lane); continue; }
        r -= IT_IN;
        if (r < 3 * IT_MIX) { const int w = r / IT_MIX, q = r % IT_MIX, kb = q / 32, nb = q % 32;
            conv_item((w == 0 ? w_fox : w == 1 ? w_dsa : w_ret) + (size_t)l * 512 * DM, DM, 32 * nb, 32, 64 * kb, L + LW_MIX + (size_t)w * 512, 1536, 32 * nb, scr, F.lane); continue; }
        r -= 3 * IT_MIX;
        if (r < IT_O) { const int kb = r / 32, nb = r % 32;
            conv_item(w_o + (size_t)l * DM * DM, DM, 32 * nb, 32, 64 * kb, L + LW_O, 1024, 32 * nb, scr, F.lane); continue; }
        r -= IT_O;
        if (r < IT_FI) { const int kb = r / (FF2 / 32), nb = r % (FF2 / 32); const int n0 = 32 * nb;
            const int j = n0 < FFH ? n0 : n0 - FFH; const int dr = 256 * (j >> 7) + (j & 127) + (n0 < FFH ? 0 : 128);
            conv_item(w_fi + (size_t)l * DM * FF2, FF2, n0, 32, 64 * kb, L + LW_FI, 1024, dr, scr, F.lane); continue; }
        r -= IT_FI;
        { const int kb = r / 32, nb = r % 32;
            conv_item(w_fo + (size_t)l * FFH * DM, DM, 32 * nb, 32, 64 * kb, L + LW_FO, FFH, 32 * nb, scr, F.lane); }
    }
    for (int i = F.gw * 64 + F.lane; i < DEPTH * 80 * 128; i += F.NGW * 64) { const int l = i / (80 * 128), q = i % (80 * 128);
        *(GAS v4u*)(Wb + (size_t)l * LW_STRIDE + LW_IN + (size_t)INC * 1024 + (size_t)q * 8) = (v4u){0u, 0u, 0u, 0u}; }
    f32x2* R64 = (f32x2*)(F.ws + WS_ROPE64); f32x2* R32 = (f32x2*)(F.ws + WS_ROPE32);
    for (int i = F.gw * 64 + F.lane; i < SEQ * 32; i += F.NGW * 64) { const int pos = i >> 5, k = i & 31;
        double f = 1.0; for (int e = 0; e < k; ++e) f *= 0.7498942093324559;
        const float ang = (float)pos * (float)f; float c, s; sincos_acc(ang, c, s); R64[i] = (f32x2){c, s}; }
    for (int i = F.gw * 64 + F.lane; i < SEQ * 16; i += F.NGW * 64) { const int pos = i >> 4, k = i & 15;
        double f = 1.0; for (int e = 0; e < k; ++e) f *= 0.5623413251903491;
        const float ang = (float)pos * (float)f; float c, s; sincos_acc(ang, c, s); R32[i] = (f32x2){c, s}; }
}

__device__ __forceinline__ void norm0_phase(const Ctx& F, const float* x, const float* g, bf16* o, float* SS) {
    const GAS f32x4* gp = (const GAS f32x4*)g + F.lane;
    f32x4 gv[4];
#pragma unroll
    for (int j = 0; j < 4; ++j) gv[j] = gp[64 * j];
    for (int m0 = F.gw; m0 < M; m0 += 4 * F.NGW) {
        f32x4 v[4][4];
#pragma unroll
        for (int r = 0; r < 4; ++r) { const int m = m0 + r * F.NGW; const GAS f32x4* xr = (const GAS f32x4*)(x + (size_t)(m < M ? m : m0) * DM) + F.lane;
#pragma unroll
            for (int j = 0; j < 4; ++j) v[r][j] = xr[64 * j]; }
#pragma unroll
        for (int r = 0; r < 4; ++r) { const int m = m0 + r * F.NGW; if (m < M) { float s = 0.f;
#pragma unroll
            for (int j = 0; j < 4; ++j) s += (v[r][j].x * v[r][j].x + v[r][j].y * v[r][j].y) + (v[r][j].z * v[r][j].z + v[r][j].w * v[r][j].w);
            s = wave_sum(s);
            GAS unsigned long long* o8 = (GAS unsigned long long*)(o + (size_t)m * DM) + F.lane;
#pragma unroll
            for (int j = 0; j < 4; ++j) o8[64 * j] = (unsigned long long)pk2(v[r][j].x * gv[j].x, v[r][j].y * gv[j].y) | ((unsigned long long)pk2(v[r][j].z * gv[j].z, v[r][j].w * gv[j].w) << 32);
            if (F.lane < 4) SS[(size_t)m * 4 + F.lane] = (F.lane == 0) ? s : 0.f; } }
    }
}

__device__ __forceinline__ void post_phase(const Ctx& F, const float* g_fq, const float* g_fk, const float* g_dq, const float* g_dk, const float* b_f, bool dummy_out = false) {
    bf16* Z = (bf16*)(F.ws + WS_Z); const float* ZS = (const float*)(F.ws + WS_ZS);
    const f32x2* R64 = (const f32x2*)(F.ws + WS_ROPE64); const f32x2* R32 = (const f32x2*)(F.ws + WS_ROPE32);
    float* LF = (float*)(F.ws + WS_LF); unsigned* ISG = (unsigned*)(F.ws + WS_ISG);
    bf16* KD = (bf16*)(F.ws + WS_KD); bf16* VD = (bf16*)(F.ws + WS_VD); bf16* IQB = (bf16*)(F.ws + WS_IQB); bf16* IKB = (bf16*)(F.ws + WS_IKB);
    const int t0 = blockIdx.x * 512 + F.tid, NT = F.G * 512;
    for (int t = t0; t < M * 8; t += NT) { const int m = t >> 3, h = t & 7; const float* sp = ZS + (size_t)m * ZSP + S_IQ + h * 32;
        f32x4 v[8];
#pragma unroll
        for (int i = 0; i < 8; ++i) v[i] = *(const GAS f32x4*)(sp + 4 * i);
        const float aw = fabsf(ZS[(size_t)m * ZSP + S_IW + h]);
        const f32x2* cs = R32 + (m & (SEQ - 1)) * 16; float f[32];
#pragma unroll
        for (int i = 0; i < 8; ++i) { f[4 * i] = v[i].x; f[4 * i + 1] = v[i].y; f[4 * i + 2] = v[i].z; f[4 * i + 3] = v[i].w; }
#pragma unroll
        for (int d = 0; d < 16; ++d) { const f32x2 tt = cs[d]; const float x1 = f[d], x2 = f[d + 16]; f[d] = (x1 * tt.x - x2 * tt.y) * aw; f[d + 16] = (x2 * tt.x + x1 * tt.y) * aw; }
        bf16* op = IQB + (size_t)m * 256 + h * 32;
#pragma unroll
        for (int i = 0; i < 4; ++i) { float t8[8];
#pragma unroll
            for (int j = 0; j < 8; ++j) t8[j] = f[8 * i + j];
            *(GAS v4u*)(op + 8 * i) = pack8(t8); }
    }
    const int part = blockIdx.x & 3;
    for (int m = (blockIdx.x >> 2) * 512 + F.tid; m < M; m += (F.G >> 2) * 512) { const float* sr = ZS + (size_t)m * ZSP; const int pos = m & (SEQ - 1);
        if (part == 0) { float f[64]; float ss = 0.f;
#pragma unroll
            for (int i = 0; i < 16; ++i) { const f32x4 v = *(const GAS f32x4*)(sr + S_DK + 4 * i); f[4 * i] = v.x; f[4 * i + 1] = v.y; f[4 * i + 2] = v.z; f[4 * i + 3] = v.w; ss += (v.x * v.x + v.y * v.y) + (v.z * v.z + v.w * v.w); }
            const float rs = 1.0f / sqrtf(ss * (1.f / 64) + NORM_EPS); const f32x2* cs = R64 + pos * 32;
#pragma unroll
            for (int d = 0; d < 64; ++d) f[d] = f[d] * rs * g_dk[d];
#pragma unroll
            for (int d = 0; d < 32; ++d) { const f32x2 tt = cs[d]; const float x1 = f[d], x2 = f[d + 32]; f[d] = x1 * tt.x - x2 * tt.y; f[d + 32] = x2 * tt.x + x1 * tt.y; }
#pragma unroll
            for (int i = 0; i < 8; ++i) { float t8[8];
#pragma unroll
                for (int j = 0; j < 8; ++j) t8[j] = f[8 * i + j];
                *(GAS v4u*)(KD + (size_t)m * 64 + 8 * i) = pack8(t8); } }
        if (part == 1)
#pragma unroll
        for (int i = 0; i < 8; ++i) { const f32x4 a = *(const GAS f32x4*)(sr + S_DV + 8 * i), b = *(const GAS f32x4*)(sr + S_DV + 8 * i + 4); const float t8[8] = {a.x, a.y, a.z, a.w, b.x, b.y, b.z, b.w};
            *(GAS v4u*)(VD + (size_t)m * 64 + 8 * i) = pack8(t8); }
        if (part == 2) { float f[32]; const f32x2* cs = R32 + pos * 16;
#pragma unroll
            for (int i = 0; i < 8; ++i) { const f32x4 v = *(const GAS f32x4*)(sr + S_IK + 4 * i); f[4 * i] = v.x; f[4 * i + 1] = v.y; f[4 * i + 2] = v.z; f[4 * i + 3] = v.w; }
#pragma unroll
            for (int d = 0; d < 16; ++d) { const f32x2 tt = cs[d]; const float x1 = f[d], x2 = f[d + 16]; f[d] = x1 * tt.x - x2 * tt.y; f[d + 16] = x2 * tt.x + x1 * tt.y; }
#pragma unroll
            for (int i = 0; i < 4; ++i) { float t8[8];
#pragma unroll
                for (int j = 0; j < 8; ++j) t8[j] = f[8 * i + j];
                *(GAS v4u*)(IKB + (size_t)m * 32 + 8 * i) = pack8(t8); } }
        if (part == 3) { const f32x4 w0 = *(const GAS f32x4*)(sr + S_IW), w1 = *(const GAS f32x4*)(sr + S_IW + 4); const float iw[8] = {w0.x, w0.y, w0.z, w0.w, w1.x, w1.y, w1.z, w1.w}; unsigned sg = 0;
#pragma unroll
            for (int h = 0; h < 8; ++h) sg |= (iw[h] < 0.f ? 1u : 0u) << h;
            ISG[m] = sg;
            const f32x4 f0 = *(const GAS f32x4*)(sr + S_FF), f1 = *(const GAS f32x4*)(sr + S_FF + 4); const float ff[8] = {f0.x, f0.y, f0.z, f0.w, f1.x, f1.y, f1.z, f1.w}; float lf[8];
#pragma unroll
            for (int h = 0; h < 8; ++h) { const float xx = ff[h] + b_f[h]; lf[h] = (fminf(xx, 0.f) - __logf(1.0f + __expf(-fabsf(xx)))) * LOG2E; }
            *(GAS f32x4*)(LF + (size_t)m * 8) = (f32x4){lf[0], lf[1], lf[2], lf[3]}; *(GAS f32x4*)(LF + (size_t)m * 8 + 4) = (f32x4){lf[4], lf[5], lf[6], lf[7]}; }
    }
}

__device__ __forceinline__ float ret_l2g(int h) { return h == 0 ? -0.04580368961312479f : h == 1 ? -0.02272007650008353f : h == 2 ? -0.011315313227834146f : -0.005646563141142063f; }

__device__ __forceinline__ void scan_state_phase(const Ctx& F) {
    const float* LF = (const float*)(F.ws + WS_LF); float* CF = (float*)(F.ws + WS_CF);
    const bf16* Z = (const bf16*)(F.ws + WS_Z); float* RS = (float*)(F.ws + WS_HDN);
    if (F.gw < 32) {
        const int b = F.gw >> 3, h = F.gw & 7; const float* lp = LF + ((size_t)b * SEQ + F.lane * 64) * 8 + h; float s = 0.f;
        for (int i = 0; i < 64; ++i) s += lp[i * 8];
        float incl = s;
#pragma unroll
        for (int o = 1; o < 64; o <<= 1) { const float t = __builtin_bit_cast(float, __builtin_amdgcn_ds_bpermute(((F.lane - o) & 63) << 2, __builtin_bit_cast(int, incl))); if (F.lane >= o) incl += t; }
        float run = incl - s; float* cp = CF + (size_t)F.gw * SEQ + F.lane * 64;
        for (int i = 0; i < 64; ++i) { run += lp[i * 8]; cp[i] = run; }
    }
    for (int u = blockIdx.x; u < NB * 32 * 4; u += F.G) {
        const int h = u & 3, c = (u >> 2) & 31, b = u >> 7; const float l2g = ret_l2g(h);
        const int d = F.tid >> 3, e0 = (F.tid & 7) * 16; float acc[16];
#pragma unroll
        for (int i = 0; i < 16; ++i) acc[i] = 0.f;
        const bf16* base = Z + ((size_t)b * SEQ + c * 128) * ZP;
        for (int j = 0; j < 128; ++j) { const bf16* row = base + (size_t)j * ZP;
            const float kd = bf2f(row[Z_RK + h * 64 + d]) * exp2f((float)(127 - j) * l2g);
            const v4u w0 = *(const GAS v4u*)(row + Z_RV + h * 128 + e0), w1 = *(const GAS v4u*)(row + Z_RV + h * 128 + e0 + 8);
            float v0[8], v1[8]; unpack8(w0, v0); unpack8(w1, v1);
#pragma unroll
            for (int i = 0; i < 8; ++i) { acc[i] += kd * v0[i]; acc[8 + i] += kd * v1[i]; } }
        float* o = RS + (size_t)u * 8192 + d * 128 + e0;
#pragma unroll
        for (int i = 0; i < 4; ++i) *(GAS f32x4*)(o + 4 * i) = (f32x4){acc[4 * i], acc[4 * i + 1], acc[4 * i + 2], acc[4 * i + 3]};
    }
}

__device__ __forceinline__ void ret_out_naive(const Ctx& F, const float* gn) {
    bf16* Z = (bf16*)(F.ws + WS_Z); const float* RS = (const float*)(F.ws + WS_HDN);
    LAS float* S = (LAS float*)(F.lds);
    LAS bf16* Vt = (LAS bf16*)(F.lds + 32768);
    LAS float* Kt = (LAS float*)(F.lds + 65536);
    LAS float* aw = (LAS float*)(F.lds + 65536 + 33280) + F.wave * 128;
    LAS float* qw = (LAS float*)(F.lds + 65536 + 33280 + 4096) + F.wave * 64;
    for (int u = blockIdx.x; u < NB * 32 * 4; u += F.G) {
        const int h = u & 3, c = (u >> 2) & 31, b = u >> 7; const float l2g = ret_l2g(h); const float wch = exp2f(128.f * l2g);
        __syncthreads();
        { float s[16];
#pragma unroll
            for (int i = 0; i < 16; ++i) s[i] = 0.f;
            for (int cp = 0; cp < c; ++cp) { const float* L = RS + ((size_t)((b * 32 + cp) * 4 + h)) * 8192 + F.tid;
#pragma unroll
                for (int i = 0; i < 16; ++i) s[i] = wch * s[i] + L[i * 512]; }
#pragma unroll
            for (int i = 0; i < 16; ++i) S[F.tid + i * 512] = s[i]; }
        const bf16* base = Z + ((size_t)b * SEQ + c * 128) * ZP;
        for (int q = F.tid; q < 2048; q += 512) { const int r = q >> 4, ch = q & 15; *(LAS v4u*)(Vt + r * 128 + ch * 8) = *(const GAS v4u*)(base + (size_t)r * ZP + Z_RV + h * 128 + ch * 8); }
        for (int q = F.tid; q < 128 * 64; q += 512) { const int r = q >> 6, dd = q & 63; Kt[r * 65 + dd] = bf2f(base[(size_t)r * ZP + Z_RK + h * 64 + dd]); }
        __syncthreads();
        for (int i = F.wave; i < 128; i += NWAVES) {
            const size_t m = (size_t)b * SEQ + c * 128 + i; bf16* zr = Z + m * ZP;
            qw[F.lane] = bf2f(zr[Z_RQ + h * 64 + F.lane]);
            LDS_WAIT(); asm volatile("" ::: "memory");
#pragma unroll
            for (int jj = 0; jj < 2; ++jj) { const int j = F.lane + 64 * jj; float a = 0.f;
                if (j <= i) { float dot = 0.f; for (int dd = 0; dd < 64; ++dd) dot += qw[dd] * Kt[j * 65 + dd]; a = dot * exp2f((float)(i - j) * l2g); }
                aw[j] = a; }
            LDS_WAIT(); asm volatile("" ::: "memory");
            float o[2]; const float dq = exp2f((float)(i + 1) * l2g);
#pragma unroll
            for (int ee = 0; ee < 2; ++ee) { const int e = F.lane + 64 * ee; float acc = 0.f;
                for (int j = 0; j <= i; ++j) acc += aw[j] * bf2f(Vt[j * 128 + e]);
                float cr = 0.f; for (int dd = 0; dd < 64; ++dd) cr += qw[dd] * S[dd * 128 + e];
                o[ee] = acc + cr * dq; }
            const float ss = wave_sum(o[0] * o[0] + o[1] * o[1]); const float rstd = 1.0f / sqrtf(ss * (1.f / 128) + NORM_EPS);
#pragma unroll
            for (int ee = 0; ee < 2; ++ee) { const int e = F.lane + 64 * ee; const float rg = bf2f(zr[Z_RG + h * 128 + e]);
                zr[Z_RV + h * 128 + e] = (bf16)f2bf(o[ee] * rstd * gn[h * 128 + e] * rg * sigmoid_f(rg)); }
            LDS_WAIT(); asm volatile("" ::: "memory");
        }
    }
    __syncthreads();
}

__device__ __forceinline__ void fox_naive(const Ctx& F) {
    bf16* Z = (bf16*)(F.ws + WS_Z); const float* CF = (const float*)(F.ws + WS_CF);
    LAS float* sc = (LAS float*)(F.lds + F.wave * 16384);
    const int lane = F.lane;
    int it = 0;
    for (int r0 = 0; r0 < NB * 8 * SEQ; r0 += F.NGW, ++it) {
        const int r = r0 + ((it & 1) ? (F.NGW - 1 - F.gw) : F.gw);
        if (r >= NB * 8 * SEQ) continue;
        const int pos = r & (SEQ - 1), h = (r >> 12) & 7, b = r >> 15;
        const size_t m = (size_t)b * SEQ + pos;
        float qf[64];
        { const bf16* qp = Z + m * ZP + Z_FQ + h * 64;
#pragma unroll
            for (int i = 0; i < 8; ++i) { const v4u w = *(const GAS v4u*)(qp + 8 * i); float t[8]; unpack8(w, t);
#pragma unroll
                for (int j = 0; j < 8; ++j) qf[8 * i + j] = t[j]; } }
        const float* cf = CF + (size_t)(b * 8 + h) * SEQ;
        float mx = -INFINITY;
        for (int kk = lane; kk <= pos; kk += 64) { const bf16* kp = Z + ((size_t)b * SEQ + kk) * ZP + Z_FK + h * 64; float dot = 0.f;
#pragma unroll
            for (int i = 0; i < 8; ++i) { const v4u w = *(const GAS v4u*)(kp + 8 * i); float t[8]; unpack8(w, t);
#pragma unroll
                for (int j = 0; j < 8; ++j) dot += qf[8 * i + j] * t[j]; }
            const float s = dot - cf[kk]; sc[kk] = s; mx = fmaxf(mx, s); }
        mx = wave_max(mx);
        float sum = 0.f;
        for (int kk = lane; kk <= pos; kk += 64) { const float p = exp2f(sc[kk] - mx); sc[kk] = p; sum += p; }
        sum = wave_sum(sum);
        LDS_WAIT(); asm volatile("" ::: "memory");
        const bf16* vp = Z + (size_t)b * SEQ * ZP + Z_FV + h * 64 + lane;
        float o0 = 0.f, o1 = 0.f, o2 = 0.f, o3 = 0.f; int kk = 0;
        for (; kk + 3 <= pos; kk += 4) { o0 += sc[kk] * bf2f(vp[(size_t)kk * ZP]); o1 += sc[kk + 1] * bf2f(vp[(size_t)(kk + 1) * ZP]); o2 += sc[kk + 2] * bf2f(vp[(size_t)(kk + 2) * ZP]); o3 += sc[kk + 3] * bf2f(vp[(size_t)(kk + 3) * ZP]); }
        for (; kk <= pos; ++kk) o0 += sc[kk] * bf2f(vp[(size_t)kk * ZP]);
        Z[m * ZP + Z_FQ + h * 64 + lane] = (bf16)f2bf(((o0 + o1) + (o2 + o3)) / sum);
        LDS_WAIT(); asm volatile("" ::: "memory");
    }
}

__device__ __forceinline__ unsigned f2key(float s) { const unsigned u = __builtin_bit_cast(unsigned, s + 0.0f); return (u & 0x80000000u) ? ~u : (u | 0x80000000u); }
__device__ __forceinline__ void dsa_naive(const Ctx& F) {
    bf16* Z = (bf16*)(F.ws + WS_Z); const float* ZS = (const float*)(F.ws + WS_ZS);
    const unsigned* ISG = (const unsigned*)(F.ws + WS_ISG);
    const bf16* KD = (const bf16*)(F.ws + WS_KD); const bf16* VD = (const bf16*)(F.ws + WS_VD);
    LAS unsigned* kl = (LAS unsigned*)(F.lds + F.wave * 16384);
    LAS float* iqs = (LAS float*)(F.lds + XTRA_OFF + F.wave * 1536);
    const int lane = F.lane;
    int it = 0;
    for (int r0 = 0; r0 < M; r0 += F.NGW, ++it) {
        const int r = r0 + ((it & 1) ? (F.NGW - 1 - F.gw) : F.gw);
        if (r >= M) continue;
        const int pos = r & (SEQ - 1), b = r >> 12; const size_t m = (size_t)r;
        *(LAS f32x4*)(iqs + 4 * lane) = *(const GAS f32x4*)(ZS + m * ZSP + S_IQ + 4 * lane);
        const unsigned sg = ISG[m];
        LDS_WAIT(); asm volatile("" ::: "memory");
        for (int kk = lane; kk <= pos; kk += 64) { const float* ikp = ZS + ((size_t)b * SEQ + kk) * ZSP + S_IK; float ik[32];
#pragma unroll
            for (int i = 0; i < 8; ++i) { const f32x4 t = *(const GAS f32x4*)(ikp + 4 * i); ik[4 * i] = t.x; ik[4 * i + 1] = t.y; ik[4 * i + 2] = t.z; ik[4 * i + 3] = t.w; }
            float s = 0.f;
#pragma unroll 1
            for (int h = 0; h < 8; ++h) { float dot = 0.f;
#pragma unroll
                for (int dd = 0; dd < 32; ++dd) dot += iqs[h * 32 + dd] * ik[dd];
                dot = fmaxf(dot, 0.f); s += ((sg >> h) & 1u) ? -dot : dot; }
            kl[kk] = f2key(s); }
        LDS_WAIT(); asm volatile("" ::: "memory");
        unsigned key[64];
#pragma unroll
        for (int j = 0; j < 64; ++j) { const int kk = j * 64 + lane; key[j] = (kk <= pos) ? kl[kk] : 0u; }
        LDS_WAIT(); asm volatile("" ::: "memory");
        LAS unsigned* idx = kl; LAS float* pl = (LAS float*)(kl + 256); LAS bf16* qs = (LAS bf16*)(kl + 512);
        *(LAS v4u*)(qs + 8 * lane) = *(const GAS v4u*)(Z + m * ZP + Z_DQ + 8 * lane);
        unsigned T = 0u; int need = 0;
        if (pos + 1 > 256) {
            for (int bit = 31; bit >= 0; --bit) { const unsigned Tt = T | (1u << bit); int cnt = 0;
#pragma unroll
                for (int j = 0; j < 64; ++j) cnt += __builtin_popcountll(__ballot(key[j] >= Tt));
                if (cnt >= 256) T = Tt; }
            int ngt = 0;
#pragma unroll
            for (int j = 0; j < 64; ++j) ngt += __builtin_popcountll(__ballot(key[j] > T));
            need = 256 - ngt;
        }
        int nsel = 0, eqb = 0;
#pragma unroll
        for (int j = 0; j < 64; ++j) { const bool gt = key[j] > T, eq = (key[j] == T) && (T != 0u);
            const unsigned long long em = __ballot(eq); const int er = eqb + __builtin_amdgcn_mbcnt_hi((unsigned)(em >> 32), __builtin_amdgcn_mbcnt_lo((unsigned)em, 0u));
            const bool sel = gt || (eq && er < need); eqb += __builtin_popcountll(em);
            const unsigned long long sm = __ballot(sel); const int sp = nsel + __builtin_amdgcn_mbcnt_hi((unsigned)(sm >> 32), __builtin_amdgcn_mbcnt_lo((unsigned)sm, 0u));
            if (sel) idx[sp] = (unsigned)(j * 64 + lane); nsel += __builtin_popcountll(sm); }
        LDS_WAIT(); asm volatile("" ::: "memory");
        for (int h = 0; h < 8; ++h) {
            float sv[4]; float mx = -INFINITY;
#pragma unroll
            for (int i = 0; i < 4; ++i) { const int e = lane + 64 * i; sv[i] = -INFINITY;
                if (e < nsel) { const bf16* kp = KD + ((size_t)b * SEQ + idx[e]) * 64; float dot = 0.f;
#pragma unroll
                    for (int c = 0; c < 8; ++c) { const v4u w = *(const GAS v4u*)(kp + 8 * c); float t[8]; unpack8(w, t); const v4u qw = *(const LAS v4u*)(qs + h * 64 + 8 * c); float qq[8]; unpack8(qw, qq);
#pragma unroll
                        for (int j = 0; j < 8; ++j) dot += qq[j] * t[j]; }
                    sv[i] = dot; }
                mx = fmaxf(mx, sv[i]); }
            mx = wave_max(mx); float sum = 0.f;
#pragma unroll
            for (int i = 0; i < 4; ++i) { const int e = lane + 64 * i; const float p = (e < nsel) ? exp2f(sv[i] - mx) : 0.f; pl[e] = p; sum += p; }
            sum = wave_sum(sum);
            LDS_WAIT(); asm volatile("" ::: "memory");
            float o0 = 0.f, o1 = 0.f; int e = 0;
            for (; e + 1 < nsel; e += 2) { o0 += pl[e] * bf2f(VD[((size_t)b * SEQ + idx[e]) * 64 + lane]); o1 += pl[e + 1] * bf2f(VD[((size_t)b * SEQ + idx[e + 1]) * 64 + lane]); }
            if (e < nsel) o0 += pl[e] * bf2f(VD[((size_t)b * SEQ + idx[e]) * 64 + lane]);
            Z[m * ZP + Z_DQ + h * 64 + lane] = (bf16)f2bf((o0 + o1) / sum);
            LDS_WAIT(); asm volatile("" ::: "memory");
        }
    }
}
#ifndef PROBE_D
#define PROBE_D 0
#endif

typedef short s16x8 __attribute__((ext_vector_type(8)));
typedef short s16x4 __attribute__((ext_vector_type(4)));
typedef short v4i16_t __attribute__((ext_vector_type(4)));
__device__ __forceinline__ s16x4 tr16(const LAS unsigned char* p) { return __builtin_bit_cast(s16x4, __builtin_amdgcn_ds_read_tr16_b64_v4i16((LAS v4i16_t*)p)); }
__device__ __forceinline__ float key2f(unsigned k) { return __builtin_bit_cast(float, (k & 0x80000000u) ? (k & 0x7fffffffu) : ~k); }

template <int NR> __device__ __forceinline__ int dsa_count_ge(const unsigned (&key)[64], unsigned T) {
    int c = 0;
#pragma unroll
    for (int j = 0; j < NR; ++j) c += __builtin_popcountll(__ballot(key[j] >= T));
    return c;
}
#define DSA_COUNT_GE(T_, out_) do { if (nq == 1) out_ = dsa_count_ge<16>(key, (T_)); else if (nq == 2) out_ = dsa_count_ge<32>(key, (T_)); else if (nq == 3) out_ = dsa_count_ge<48>(key, (T_)); else out_ = dsa_count_ge<64>(key, (T_)); } while (0)
__device__ __forceinline__ void dsa_select(const unsigned (&key)[64], int nvalid, unsigned& T, int& need) {
    const int nq = __builtin_amdgcn_readfirstlane((nvalid + 1023) >> 10);
    T = 0u; need = 0;
    if (nvalid <= 256) return;
    unsigned kmax = 0u;
#pragma unroll
    for (int j = 0; j < 64; ++j) kmax = key[j] > kmax ? key[j] : kmax;
#pragma unroll
    for (int o_ = 0; o_ < 1; ++o_) { unsigned t; t = sxu<1>(kmax); kmax = t > kmax ? t : kmax; t = sxu<2>(kmax); kmax = t > kmax ? t : kmax; t = sxu<4>(kmax); kmax = t > kmax ? t : kmax; t = sxu<8>(kmax); kmax = t > kmax ? t : kmax; t = sxu<16>(kmax); kmax = t > kmax ? t : kmax;
        unsigned a_, b_; swap32(kmax, a_, b_); kmax = a_ > b_ ? a_ : b_; }
    unsigned lo = 1u, hi = kmax + 1u; int hic = 0;
    { const float vm = fabsf(key2f(kmax)) + 1.0f; unsigned l2 = f2key(-vm * 64.0f); int c; DSA_COUNT_GE(l2, c); if (c >= 256) lo = l2; }
    int iter = 0; bool exact = false;
    while (hi - lo > 1u) {
        unsigned mid;
        if (iter < 24 && lo > 1u) { const float mv = 0.5f * key2f(lo) + 0.5f * key2f(hi - 1u); mid = f2key(mv); }
        else mid = lo + ((hi - lo) >> 1);
        if (mid <= lo) mid = lo + 1u; if (mid >= hi) mid = hi - 1u;
        int c; DSA_COUNT_GE(mid, c);
        if (c == 256) { T = mid; exact = true; break; }
        if (c > 256) lo = mid; else { hi = mid; hic = c; }
        ++iter;
    }
    if (exact) need = 256; else { T = lo; need = 256 - hic; }
}

template <bool SYNC_BEFORE_STAGE = false> __device__ __forceinline__ void dsa_attend(const bf16* zq, bf16* zo, const bf16* KDb, const bf16* VDb, const LAS unsigned short* idx, int nsel, LAS unsigned char* vst, int lane) {
    const int g = lane >> 4, c = lane & 15;
    s16x8 qf[2];
#pragma unroll
    for (int ks = 0; ks < 2; ++ks) { qf[ks] = (s16x8){0, 0, 0, 0, 0, 0, 0, 0}; if (c < 8) qf[ks] = *(const GAS s16x8*)(zq + c * 64 + 32 * ks + 8 * g); }
    f32x4 acc[16];
    v4u vreg[16];
#pragma unroll
    for (int i = 0; i < 16; ++i) { const int pi = lane + 64 * i, r = pi >> 3, c16 = pi & 7; const int id = (r < nsel) ? (int)idx[r] : 0; vreg[i] = *(const GAS v4u*)(VDb + (size_t)id * 64 + c16 * 8); }
#pragma unroll
    for (int tb = 0; tb < 2; ++tb) {
        s16x8 kf[8][2];
#pragma unroll
        for (int tt = 0; tt < 8; ++tt) { const int e = 16 * (8 * tb + tt) + c; const int id = (e < nsel) ? (int)idx[e] : 0; const bf16* kp = KDb + (size_t)id * 64 + 8 * g;
            kf[tt][0] = *(const GAS s16x8*)kp; kf[tt][1] = *(const GAS s16x8*)(kp + 32); }
#pragma unroll
        for (int tt = 0; tt < 8; ++tt) { f32x4 a = (f32x4){0.f, 0.f, 0.f, 0.f};
            a = __builtin_amdgcn_mfma_f32_16x16x32_bf16(kf[tt][0], qf[0], a, 0, 0, 0); a = __builtin_amdgcn_mfma_f32_16x16x32_bf16(kf[tt][1], qf[1], a, 0, 0, 0); acc[8 * tb + tt] = a; }
    }
    float mx = -INFINITY;
#pragma unroll
    for (int t = 0; t < 16; ++t)
#pragma unroll
        for (int i = 0; i < 4; ++i) { const int e = 16 * t + 4 * g + i; if (nsel < 256 && e >= nsel) acc[t][i] = -INFINITY; mx = fmaxf(mx, acc[t][i]); }
    mx = fmaxf(mx, sx<16>(mx)); mx = half_max(mx);
    float sum = 0.f;
#pragma unroll
    for (int t = 0; t < 16; ++t)
#pragma unroll
        for (int i = 0; i < 4; ++i) { const float p = __builtin_amdgcn_exp2f(acc[t][i] - mx); acc[t][i] = p; sum += p; }
    sum += sx<16>(sum); sum = half_sum(sum);
    const float inv = 1.0f / sum;
    s16x8 pf[8];
#pragma unroll
    for (int s = 0; s < 8; ++s) { v4u w; w.x = pk2(acc[2 * s][0] * inv, acc[2 * s][1] * inv); w.y = pk2(acc[2 * s][2] * inv, acc[2 * s][3] * inv); w.z = pk2(acc[2 * s + 1][0] * inv, acc[2 * s + 1][1] * inv); w.w = pk2(acc[2 * s + 1][2] * inv, acc[2 * s + 1][3] * inv);
        pf[s] = __builtin_bit_cast(s16x8, w); }
    f32x4 o[4];
#pragma unroll
    for (int db = 0; db < 4; ++db) o[db] = (f32x4){0.f, 0.f, 0.f, 0.f};
    const int q = (lane >> 2) & 3, p = lane & 3, swz = 2 * (g & 1) + (q >> 1);
    const LAS unsigned char* rb = vst + (4 * g + q) * 128 + 8 * p;
    if constexpr (SYNC_BEFORE_STAGE) __syncthreads();
#pragma unroll
    for (int hh = 0; hh < 2; ++hh) {
        asm volatile("s_waitcnt lgkmcnt(0)" ::: "memory");
#pragma unroll
        for (int i = 0; i < 16; ++i) { const int pi = lane + 64 * i, r = pi >> 3, c16 = pi & 7;
            *(LAS v4u*)(vst + r * 128 + ((((c16 >> 1) ^ ((r >> 1) & 3))) << 5) + ((c16 & 1) << 4)) = vreg[i]; }
        if (hh == 0) {
#pragma unroll
            for (int i = 0; i < 16; ++i) { const int pi = lane + 64 * i, r = pi >> 3, c16 = pi & 7, e = 128 + r; const int id = (e < nsel) ? (int)idx[e] : 0; vreg[i] = *(const GAS v4u*)(VDb + (size_t)id * 64 + c16 * 8); } }
        asm volatile("s_waitcnt lgkmcnt(0)" ::: "memory");
#pragma unroll
        for (int s4 = 0; s4 < 4; ++s4)
#pragma unroll
            for (int db = 0; db < 4; ++db) { const LAS unsigned char* a1 = rb + s4 * 4096 + ((db ^ swz) << 5);
                const s16x4 lo = tr16(a1), hi = tr16(a1 + 2048);
                const s16x8 vf = (s16x8){lo[0], lo[1], lo[2], lo[3], hi[0], hi[1], hi[2], hi[3]};
                o[db] = __builtin_amdgcn_mfma_f32_16x16x32_bf16(pf[4 * hh + s4], vf, o[db], 0, 0, 0); }
    }
    if (g < 2) {
#pragma unroll
        for (int db = 0; db < 4; ++db)
#pragma unroll
            for (int i = 0; i < 4; ++i) zo[(4 * g + i) * 64 + 16 * db + c] = (bf16)f2bf(o[db][i]);
    }
}

__device__ __forceinline__ void dsa_v2(const Ctx& F) {
    bf16* Z = (bf16*)(F.ws + WS_Z); const float* ZS = (const float*)(F.ws + WS_ZS);
    const unsigned* ISG = (const unsigned*)(F.ws + WS_ISG);
    const bf16* KD = (const bf16*)(F.ws + WS_KD); const bf16* VD = (const bf16*)(F.ws + WS_VD);
    LAS unsigned* kl = (LAS unsigned*)(F.lds + F.wave * 16384);
    LAS float* iqs = (LAS float*)(F.lds + XTRA_OFF + F.wave * 1536);
    LAS unsigned short* idx = (LAS unsigned short*)(F.lds + XTRA_OFF + F.wave * 1536 + 1024);
    const int lane = F.lane;
    int it = 0;
    for (int r0 = 0; r0 < M; r0 += F.NGW, ++it) {
        const int r = r0 + ((it & 1) ? (F.NGW - 1 - F.gw) : F.gw);
        if (r >= M) continue;
        const int pos = r & (SEQ - 1), b = r >> 12; const size_t m = (size_t)r;
        *(LAS f32x4*)(iqs + 4 * lane) = *(const GAS f32x4*)(ZS + m * ZSP + S_IQ + 4 * lane);
        const unsigned sg = ISG[m];
        LDS_WAIT(); asm volatile("" ::: "memory");
        for (int kk = lane; kk <= pos; kk += 64) { const float* ikp = ZS + ((size_t)b * SEQ + kk) * ZSP + S_IK; float ik[32];
#pragma unroll
            for (int i = 0; i < 8; ++i) { const f32x4 t = *(const GAS f32x4*)(ikp + 4 * i); ik[4 * i] = t.x; ik[4 * i + 1] = t.y; ik[4 * i + 2] = t.z; ik[4 * i + 3] = t.w; }
            float s = 0.f;
#pragma unroll 1
            for (int h = 0; h < 8; ++h) { float dot = 0.f;
#pragma unroll
                for (int dd = 0; dd < 32; ++dd) dot += iqs[h * 32 + dd] * ik[dd];
                dot = fmaxf(dot, 0.f); s += ((sg >> h) & 1u) ? -dot : dot; }
            kl[kk] = f2key(s); }
        LDS_WAIT(); asm volatile("" ::: "memory");
        unsigned key[64];
#pragma unroll
        for (int j = 0; j < 64; ++j) { const int kk = j * 64 + lane; key[j] = (kk <= pos) ? kl[kk] : 0u; }
        LDS_WAIT(); asm volatile("" ::: "memory");
        unsigned T; int need;
#ifdef DSA_OLDSEL
        T = 0u; need = 0;
        if (pos + 1 > 256) {
            for (int bit = 31; bit >= 0; --bit) { const unsigned Tt = T | (1u << bit); int cnt = 0;
#pragma unroll
                for (int j = 0; j < 64; ++j) cnt += __builtin_popcountll(__ballot(key[j] >= Tt));
                if (cnt >= 256) T = Tt; }
            int ngt = 0;
#pragma unroll
            for (int j = 0; j < 64; ++j) ngt += __builtin_popcountll(__ballot(key[j] > T));
            need = 256 - ngt;
        }
#else
        dsa_select(key, pos + 1, T, need);
#endif
        int nsel = 0, eqb = 0;
#pragma unroll
        for (int j = 0; j < 64; ++j) { const bool gt = key[j] > T, eq = (key[j] == T) && (T != 0u);
            const unsigned long long em = __ballot(eq); const int er = eqb + __builtin_amdgcn_mbcnt_hi((unsigned)(em >> 32), __builtin_amdgcn_mbcnt_lo((unsigned)em, 0u));
            const bool sel = gt || (eq && er < need); eqb += __builtin_popcountll(em);
            const unsigned long long sm = __ballot(sel); const int sp = nsel + __builtin_amdgcn_mbcnt_hi((unsigned)(sm >> 32), __builtin_amdgcn_mbcnt_lo((unsigned)sm, 0u));
            if (sel) idx[sp] = (unsigned short)(j * 64 + lane); nsel += __builtin_popcountll(sm); }
        LDS_WAIT(); asm volatile("" ::: "memory");
        dsa_attend(Z + m * ZP + Z_DQ, Z + m * ZP + Z_DQ, KD + (size_t)b * SEQ * 64, VD + (size_t)b * SEQ * 64, idx, nsel, (LAS unsigned char*)kl, lane);
        LDS_WAIT(); asm volatile("" ::: "memory");
    }
}

template <int NR> __device__ __forceinline__ int dsa_emit_n(const unsigned (&key)[64], unsigned T, int need, LAS unsigned short* idx, int lane) {
    int nsel = 0, eqb = 0;
#pragma unroll
    for (int j = 0; j < NR; ++j) { const bool gt = key[j] > T, eq = (key[j] == T) && (T != 0u);
        const unsigned long long em = __ballot(eq); const int er = eqb + __builtin_amdgcn_mbcnt_hi((unsigned)(em >> 32), __builtin_amdgcn_mbcnt_lo((unsigned)em, 0u));
        const bool sel = gt || (eq && er < need); eqb += __builtin_popcountll(em);
        const unsigned long long sm = __ballot(sel); const int sp = nsel + __builtin_amdgcn_mbcnt_hi((unsigned)(sm >> 32), __builtin_amdgcn_mbcnt_lo((unsigned)sm, 0u));
        if (sel) idx[sp] = (unsigned short)(j * 64 + lane); nsel += __builtin_popcountll(sm); }
    return nsel;
}
__device__ __forceinline__ int dsa_emit(const unsigned (&key)[64], int nvalid, unsigned T, int need, LAS unsigned short* idx, int lane) {
    const int nq = __builtin_amdgcn_readfirstlane((nvalid + 1023) >> 10);
    if (nq == 1) return dsa_emit_n<16>(key, T, need, idx, lane);
    if (nq == 2) return dsa_emit_n<32>(key, T, need, idx, lane);
    if (nq == 3) return dsa_emit_n<48>(key, T, need, idx, lane);
    return dsa_emit_n<64>(key, T, need, idx, lane);
}

#define DSA_CNT8(cnt_, k_, o_, T_) asm volatile( \
    "v_cmp_ge_u32_e64 s[60:61], %1, %9\n\tv_cmp_ge_u32_e64 s[62:63], %2, %9\n\tv_cmp_ge_u32_e64 s[64:65], %3, %9\n\tv_cmp_ge_u32_e64 s[66:67], %4, %9\n\t" \
    "v_cmp_ge_u32_e64 s[68:69], %5, %9\n\tv_cmp_ge_u32_e64 s[70:71], %6, %9\n\tv_cmp_ge_u32_e64 s[72:73], %7, %9\n\tv_cmp_ge_u32_e64 s[74:75], %8, %9\n\t" \
    "v_addc_co_u32_e64 %0, s[76:77], 0, %0, s[60:61]\n\tv_addc_co_u32_e64 %0, s[76:77], 0, %0, s[62:63]\n\tv_addc_co_u32_e64 %0, s[76:77], 0, %0, s[64:65]\n\tv_addc_co_u32_e64 %0, s[76:77], 0, %0, s[66:67]\n\t" \
    "v_addc_co_u32_e64 %0, s[76:77], 0, %0, s[68:69]\n\tv_addc_co_u32_e64 %0, s[76:77], 0, %0, s[70:71]\n\tv_addc_co_u32_e64 %0, s[76:77], 0, %0, s[72:73]\n\tv_addc_co_u32_e64 %0, s[76:77], 0, %0, s[74:75]" \
    : "+v"(cnt_) : "v"(k_[o_]), "v"(k_[o_ + 1]), "v"(k_[o_ + 2]), "v"(k_[o_ + 3]), "v"(k_[o_ + 4]), "v"(k_[o_ + 5]), "v"(k_[o_ + 6]), "v"(k_[o_ + 7]), "s"(T_) \
    : "s60", "s61", "s62", "s63", "s64", "s65", "s66", "s67", "s68", "s69", "s70", "s71", "s72", "s73", "s74", "s75", "s76", "s77")
template <int NR> __device__ __forceinline__ int dsa_lane_count(const unsigned (&key)[64], unsigned T) {
    int c = 0; const unsigned Ts = (unsigned)__builtin_amdgcn_readfirstlane((int)T);
#pragma unroll
    for (int j = 0; j < NR; j += 8) DSA_CNT8(c, key, j, Ts);
    return c;
}
#define DSA_LCOUNT(T_, lc_) do { if (nq == 1) lc_ = dsa_lane_count<16>(key, (T_)); else if (nq == 2) lc_ = dsa_lane_count<32>(key, (T_)); else if (nq == 3) lc_ = dsa_lane_count<48>(key, (T_)); else lc_ = dsa_lane_count<64>(key, (T_)); } while (0)
template <int NR> __device__ __forceinline__ void dsa_write_ge(const unsigned (&key)[64], unsigned T, int off, LAS unsigned short* idx, int lane) {
    const int dummy = 256 + lane;
#pragma unroll
    for (int j = 0; j < NR; ++j) { const bool s = key[j] >= T; idx[s ? off : dummy] = (unsigned short)(j * 64 + lane); off += s ? 1 : 0; }
}
__device__ __forceinline__ int dsa_select2(const unsigned (&key)[64], int nvalid, float s1, float s2, LAS unsigned short* idx, int lane) {
    const int nq = __builtin_amdgcn_readfirstlane((nvalid + 1023) >> 10);
    unsigned T = 1u; int lc = 0; bool exact = true;
    if (nvalid > 256) {
        const float n = (float)nvalid, mean = s1 / n, sd = sqrtf(fmaxf(s2 / n - mean * mean, 1e-30f));
        const float pfrac = 256.0f / n, pt = fminf(pfrac, 1.0f - pfrac);
        const float tt = sqrtf(-2.0f * __logf(fmaxf(pt, 1e-6f)));
        float zn = (0.010328f * tt + 0.802853f) * tt + 2.515517f; asm volatile("" : "+v"(zn));
        float zd = ((0.001308f * tt + 0.189269f) * tt + 1.432788f) * tt + 1.0f; asm volatile("" : "+v"(zd));
        float z = tt - zn / zd;
        if (pfrac > 0.5f) z = -z;
        const float dens = n * __expf(-0.5f * z * z) * 0.3989423f / sd;
        unsigned lo = 1u, hi = 0xffffffffu; int clo = nvalid, chi = 0;
        bool lop = false, hip = false; float lastv = mean + z * sd, lastc = 256.0f, grow = 1.3f;
        exact = false; int same = 0, last = 0;
        for (int it = 0; hi - lo > 1u; ++it) {
            unsigned mid;
            if (it == 0) mid = f2key(lastv);
            else if (!(lop && hip)) { lastv = lastv + grow * (lastc - 256.0f) / dens; grow *= 2.0f; mid = f2key(lastv); }
            else if (it < 24 && same < 2) { const float vlo = key2f(lo), vhi = key2f(hi - 1u); mid = f2key(vlo + (vhi - vlo) * (((float)(clo - 256) + 0.5f) / (float)(clo - chi))); }
            else if (it < 48) { mid = f2key(0.5f * key2f(lo) + 0.5f * key2f(hi - 1u)); same = 0; }
            else mid = lo + ((hi - lo) >> 1);
            if (!(mid > lo)) mid = lo + 1u; if (!(mid < hi)) mid = hi - 1u;
            DSA_LCOUNT(mid, lc); const int c = wave_isum(lc); lastc = (float)c; lastv = key2f(mid);
            if (c == 256) { T = mid; exact = true; break; }
            if (c > 256) { lo = mid; clo = c; lop = true; same = (last > 0) ? same + 1 : 0; last = 1; } else { hi = mid; chi = c; hip = true; same = (last < 0) ? same + 1 : 0; last = -1; }
        }
        if (!exact) {
            const int nsel = dsa_emit(key, nvalid, lo, 256 - chi, idx, lane);
            return nsel;
        }
    } else { DSA_LCOUNT(1u, lc); }
    int incl = lc;
#pragma unroll
    for (int o = 1; o < 64; o <<= 1) { const int t = __builtin_amdgcn_ds_bpermute(((lane - o) & 63) << 2, incl); if (lane >= o) incl += t; }
    const int total = __builtin_amdgcn_readlane(incl, 63);
    if (nq == 1) dsa_write_ge<16>(key, T, incl - lc, idx, lane); else if (nq == 2) dsa_write_ge<32>(key, T, incl - lc, idx, lane); else if (nq == 3) dsa_write_ge<48>(key, T, incl - lc, idx, lane); else dsa_write_ge<64>(key, T, incl - lc, idx, lane);
    return total;
}

constexpr int DSA_ROWF = 4100;
__device__ __forceinline__ void dsa_v3(const Ctx& F, int out_col = Z_DQ) {
    bf16* Z = (bf16*)(F.ws + WS_Z);
    const unsigned* ISG = (const unsigned*)(F.ws + WS_ISG);
    const bf16* KD = (const bf16*)(F.ws + WS_KD); const bf16* VD = (const bf16*)(F.ws + WS_VD);
    const bf16* IQB = (const bf16*)(F.ws + WS_IQB); const bf16* IKB = (const bf16*)(F.ws + WS_IKB);
    LAS unsigned* img = (LAS unsigned*)(F.lds);
    LAS unsigned short* idxw = (LAS unsigned short*)(F.lds + XTRA_OFF + F.wave * 1536);
    const int w = F.wave;
    const int v = (int)blockIdx.x;
    if (v < 256)
    for (int ui = 0; ui < 8; ++ui) {
        int lane_ = F.lane; asm volatile("" : "+v"(lane_)); const int lane = lane_, g = lane >> 4, c = lane & 15;
        const int b = v >> 6, k = v & 63; const int pb = 128 * (ui >> 1) + ((ui & 1) ? 127 - k : k);
        const int q0 = pb * 8, kend = q0 + 8, ntile = (kend + 15) >> 4;
        const size_t mb = (size_t)b * SEQ;
#if PROBE_D == 1
        for (int rp_ = 0; rp_ < 2; ++rp_)
#endif
        { s16x8 iqf[4]; float sgn[4]; s16x8 iqc;
          { const int qi = c & 7, hs = c >> 3; const int qq = q0 + qi; const bf16* qp = IQB + (mb + qq) * 256 + 8 * g; const unsigned sg = ISG[mb + qq];
            float cs[8];
#pragma unroll
            for (int e = 0; e < 8; ++e) cs[e] = 0.f;
#pragma unroll
            for (int j = 0; j < 4; ++j) { const int h = 2 * j + hs; iqf[j] = *(const GAS s16x8*)(qp + h * 32); sgn[j] = ((sg >> h) & 1u) ? -1.0f : 1.0f;
                float t8[8]; unpack8(__builtin_bit_cast(v4u, iqf[j]), t8);
#pragma unroll
                for (int e = 0; e < 8; ++e) cs[e] += sgn[j] * t8[e]; }
            iqc = __builtin_bit_cast(s16x8, pack8(cs)); }
          const bf16* ikp = IKB + (mb + c) * 32 + 8 * g;
          float st1 = 0.f, st2 = 0.f;
          s16x8 cur[4], nxt[4];
#pragma unroll
          for (int i = 0; i < 4; ++i) { const int t = w + 8 * i; cur[i] = *(const GAS s16x8*)(ikp + (size_t)512 * (t < ntile ? t : 0)); }
          for (int t0 = w; t0 < ntile; t0 += 32) {
#pragma unroll
            for (int i = 0; i < 4; ++i) { const int t = t0 + 32 + 8 * i; nxt[i] = *(const GAS s16x8*)(ikp + (size_t)512 * (t < ntile ? t : 0)); }
#pragma unroll
            for (int i = 0; i < 4; ++i) { const int t = t0 + 8 * i;
              if (t < ntile) {
                f32x4 sc = __builtin_amdgcn_mfma_f32_16x16x32_bf16(cur[i], iqc, (f32x4){0.f, 0.f, 0.f, 0.f}, 0, 0, 0);
#pragma unroll
                for (int h = 0; h < 4; ++h) { const f32x4 x = __builtin_amdgcn_mfma_f32_16x16x32_bf16(cur[i], iqf[h], (f32x4){0.f, 0.f, 0.f, 0.f}, 0, 0, 0);
#pragma unroll
                    for (int r = 0; r < 4; ++r) sc[r] = __builtin_fmaf(sgn[h], __builtin_fabsf(x[r]), sc[r]); }
#pragma unroll
                for (int r = 0; r < 4; ++r) sc[r] += sx<8>(sc[r]);
                v4u kk; kk.x = f2key(sc[0]); kk.y = f2key(sc[1]); kk.z = f2key(sc[2]); kk.w = f2key(sc[3]);
                if (16 * t + 15 <= q0) {
                    st1 += (sc[0] + sc[1]) + (sc[2] + sc[3]); st2 += (sc[0] * sc[0] + sc[1] * sc[1]) + (sc[2] * sc[2] + sc[3] * sc[3]);
                } else { const int kb = 16 * t + 4 * g, qa = q0 + (c & 7);
                    if (kb + 0 > qa) { kk.x = 0u; sc[0] = 0.f; } if (kb + 1 > qa) { kk.y = 0u; sc[1] = 0.f; } if (kb + 2 > qa) { kk.z = 0u; sc[2] = 0.f; } if (kb + 3 > qa) { kk.w = 0u; sc[3] = 0.f; }
                    st1 += (sc[0] + sc[1]) + (sc[2] + sc[3]); st2 += (sc[0] * sc[0] + sc[1] * sc[1]) + (sc[2] * sc[2] + sc[3] * sc[3]); }
                if (c < 8) *(LAS v4u*)(img + c * DSA_ROWF + 16 * t + 4 * g) = kk; } }
#pragma unroll
            for (int i = 0; i < 4; ++i) cur[i] = nxt[i];
          }
          st1 += sx<16>(st1); st2 += sx<16>(st2); st1 = half_sum(st1); st2 = half_sum(st2);
          if (g == 0 && c < 8) *(LAS f32x2*)(F.lds + XTRA_OFF + w * 1536 + 640 + c * 8) = (f32x2){st1, st2}; }
        __syncthreads();
        const int pos = q0 + w; unsigned key[64];
#pragma unroll
        for (int j = 0; j < 64; ++j) { const int kidx = 64 * j + lane; const unsigned a = img[w * DSA_ROWF + kidx]; key[j] = (kidx <= pos) ? a : 0u; }
        unsigned T; int need; int nsel;
        float rs1 = 0.f, rs2 = 0.f;
#pragma unroll
        for (int ww = 0; ww < 8; ++ww) { const f32x2 t = *(const LAS f32x2*)(F.lds + XTRA_OFF + ww * 1536 + 640 + w * 8); rs1 += t.x; rs2 += t.y; }
        { nsel = dsa_select2(key, pos + 1, rs1, rs2, idxw, lane); (void)T; (void)need; }
#if PROBE_D == 3
        { const size_t m = mb + pos; dsa_attend(Z + m * ZP + Z_DQ, Z + m * ZP + Z_RG, KD + mb * 64, VD + mb * 64, idxw, nsel, F.lds + w * 16384, lane); }
#endif
        { const size_t m = mb + pos; dsa_attend<true>(Z + m * ZP + Z_DQ, Z + m * ZP + out_col, KD + mb * 64, VD + mb * 64, idxw, nsel, F.lds + w * 16384, lane); }
        __syncthreads();
    }
}

__device__ __forceinline__ void ret_rope_frag(const bf16* row, const f32x2* cs, float scale, int g, s16x8 (&f)[2]) {
    const u32x2 a0 = *(const GAS u32x2*)(row + 4 * g), a1 = *(const GAS u32x2*)(row + 16 + 4 * g), b0 = *(const GAS u32x2*)(row + 32 + 4 * g), b1 = *(const GAS u32x2*)(row + 48 + 4 * g);
    const float x1[8] = {bflo(a0.x), bfhi(a0.x), bflo(a0.y), bfhi(a0.y), bflo(a1.x), bfhi(a1.x), bflo(a1.y), bfhi(a1.y)};
    const float x2[8] = {bflo(b0.x), bfhi(b0.x), bflo(b0.y), bfhi(b0.y), bflo(b1.x), bfhi(b1.x), bflo(b1.y), bfhi(b1.y)};
    float o1[8], o2[8];
#pragma unroll
    for (int j = 0; j < 8; ++j) { const f32x2 t = cs[(j < 4 ? 4 * g + j : 16 + 4 * g + (j - 4))]; o1[j] = (x1[j] * t.x - x2[j] * t.y) * scale; o2[j] = (x2[j] * t.x + x1[j] * t.y) * scale; }
    f[0] = __builtin_bit_cast(s16x8, pack8(o1)); f[1] = __builtin_bit_cast(s16x8, pack8(o2));
}
__device__ __forceinline__ s16x8 ret_bfrag(const LAS unsigned char* img, int row0, int eb, int g, int q, int p) {
    const int r1 = row0 + 4 * g + q;
    const LAS unsigned char* a1 = img + r1 * 256 + ((eb ^ (r1 & 7)) << 5) + 8 * p;
    const LAS unsigned char* a2 = img + (r1 + 16) * 256 + ((eb ^ ((r1 + 16) & 7)) << 5) + 8 * p;
    const s16x4 lo = tr16(a1), hi = tr16(a2);
    return (s16x8){lo[0], lo[1], lo[2], lo[3], hi[0], hi[1], hi[2], hi[3]};
}

__device__ __forceinline__ void ret_state_mfma(const Ctx& F) {
    const bf16* Z = (const bf16*)(F.ws + WS_Z); float* RS = (float*)(F.ws + WS_HDN);
    const f32x2* R64 = (const f32x2*)(F.ws + WS_ROPE64);
    LAS unsigned char* Kimg = F.lds; LAS unsigned char* Vimg = F.lds + 16384;
    const int lane = F.lane, g = lane >> 4, c = lane & 15, q = (lane >> 2) & 3, p = lane & 3;
    for (int u = blockIdx.x; u < NB * 32 * 4; u += F.G) {
        const int h = u & 3, ch = (u >> 2) & 31, b = u >> 7; const float l2g = ret_l2g(h);
        const bf16* base = Z + ((size_t)b * SEQ + ch * 128) * ZP;
        __syncthreads();
        for (int t = F.tid; t < 2048; t += 512) { const int r = t >> 4, c16 = t & 15;
            *(LAS v4u*)(Vimg + r * 256 + (((c16 >> 1) ^ (r & 7)) << 5) + ((c16 & 1) << 4)) = *(const GAS v4u*)(base + (size_t)r * ZP + Z_RV + h * 128 + c16 * 8); }
        for (int t = F.tid; t < 1024; t += 512) { const int j = t >> 3, dg = t & 7; const bf16* row = base + (size_t)j * ZP + Z_RK + h * 64;
            const u32x2 a = *(const GAS u32x2*)(row + 4 * dg), bb = *(const GAS u32x2*)(row + 32 + 4 * dg);
            const float x1[4] = {bflo(a.x), bfhi(a.x), bflo(a.y), bfhi(a.y)}, x2[4] = {bflo(bb.x), bfhi(bb.x), bflo(bb.y), bfhi(bb.y)};
            const f32x2* cs = R64 + (ch * 128 + j) * 32 + 4 * dg; const float sc = exp2f((float)(127 - j) * l2g);
            float o1[4], o2[4];
#pragma unroll
            for (int e = 0; e < 4; ++e) { const f32x2 tt = cs[e]; o1[e] = (x1[e] * tt.x - x2[e] * tt.y) * sc; o2[e] = (x2[e] * tt.x + x1[e] * tt.y) * sc; }
            u32x2 w1, w2; w1.x = pk2(o1[0], o1[1]); w1.y = pk2(o1[2], o1[3]); w2.x = pk2(o2[0], o2[1]); w2.y = pk2(o2[2], o2[3]);
            const int sw = (j >> 1) & 3; const int d1 = 4 * dg, d2 = 32 + 4 * dg;
            *(LAS u32x2*)(Kimg + j * 128 + ((((2 * d1) >> 5) ^ sw) << 5) + ((2 * d1) & 31)) = w1;
            *(LAS u32x2*)(Kimg + j * 128 + ((((2 * d2) >> 5) ^ sw) << 5) + ((2 * d2) & 31)) = w2; }
        __syncthreads();
        f32x4 acc[4];
#pragma unroll
        for (int db = 0; db < 4; ++db) acc[db] = (f32x4){0.f, 0.f, 0.f, 0.f};
#pragma unroll
        for (int s = 0; s < 4; ++s) {
            const s16x8 vb = ret_bfrag(Vimg, 32 * s, F.wave, g, q, p);
            const int r1 = 32 * s + 4 * g + q, sw = (r1 >> 1) & 3;
#pragma unroll
            for (int db = 0; db < 4; ++db) { const LAS unsigned char* a1 = Kimg + r1 * 128 + ((db ^ sw) << 5) + 8 * p;
                const s16x4 lo = tr16(a1), hi = tr16(a1 + 2048);
                const s16x8 ka = (s16x8){lo[0], lo[1], lo[2], lo[3], hi[0], hi[1], hi[2], hi[3]};
                acc[db] = __builtin_amdgcn_mfma_f32_16x16x32_bf16(ka, vb, acc[db], 0, 0, 0); }
        }
        float* o = RS + (size_t)u * 8192 + 16 * F.wave + c;
#pragma unroll
        for (int db = 0; db < 4; ++db)
#pragma unroll
            for (int r = 0; r < 4; ++r) o[(16 * db + 4 * g + r) * 128] = acc[db][r];
    }
    __syncthreads();
}

__device__ __forceinline__ void ret_scan(const Ctx& F) {
    const float* RS = (const float*)(F.ws + WS_HDN); float* SC = (float*)(F.ws + WS_HDN + 16 * MiB);
    for (int t = blockIdx.x * 512 + F.tid; t < NB * 4 * 8192; t += F.G * 512) {
        const int el = t & 8191, h = (t >> 13) & 3, b = t >> 15; const float wch = exp2f(128.f * ret_l2g(h)); float s = 0.f;
        float L[32];
#pragma unroll
        for (int ch = 0; ch < 32; ++ch) L[ch] = RS[(size_t)(((b * 32 + ch) * 4 + h)) * 8192 + el];
#pragma unroll
        for (int ch = 0; ch < 32; ++ch) { SC[(size_t)(((b * 32 + ch) * 4 + h)) * 8192 + el] = s; s = wch * s + L[ch]; }
    }
}

__device__ __forceinline__ void ret_out_mfma(const Ctx& F, const float* gn, bool dummy_out = false) {
    bf16* Z = (bf16*)(F.ws + WS_Z); const float* SC = (const float*)(F.ws + WS_HDN + 16 * MiB);
    const f32x2* R64 = (const f32x2*)(F.ws + WS_ROPE64);
    LAS unsigned char* Vimg = F.lds; LAS unsigned char* Simg = F.lds + 32768; LAS unsigned char* Kimg = F.lds + 49152;
    const int lane = F.lane, g = lane >> 4, c = lane & 15, q = (lane >> 2) & 3, p = lane & 3, w = F.wave;
    for (int u = blockIdx.x; u < NB * 32 * 4; u += F.G) {
        const int h = u & 3, ch = (u >> 2) & 31, b = u >> 7; const float l2g = ret_l2g(h); const float gam = exp2f(l2g);
        bf16* base = Z + ((size_t)b * SEQ + ch * 128) * ZP;
        __syncthreads();
        for (int t = F.tid; t < 2048; t += 512) { const int r = t >> 4, c16 = t & 15;
            *(LAS v4u*)(Vimg + r * 256 + (((c16 >> 1) ^ (r & 7)) << 5) + ((c16 & 1) << 4)) = *(const GAS v4u*)(base + (size_t)r * ZP + Z_RV + h * 128 + c16 * 8); }
        for (int t = F.tid; t < 1024; t += 512) { const int r = t >> 4, c16 = t & 15; const float* sp = SC + (size_t)u * 8192 + r * 128 + c16 * 8;
            const f32x4 s0 = *(const GAS f32x4*)sp, s1 = *(const GAS f32x4*)(sp + 4);
            v4u wv; wv.x = pk2(s0.x * gam, s0.y * gam); wv.y = pk2(s0.z * gam, s0.w * gam); wv.z = pk2(s1.x * gam, s1.y * gam); wv.w = pk2(s1.z * gam, s1.w * gam);
            *(LAS v4u*)(Simg + r * 256 + (((c16 >> 1) ^ (r & 7)) << 5) + ((c16 & 1) << 4)) = wv; }
        for (int t = F.tid; t < 1024; t += 512) { const int j = t >> 3, dg = t & 7; const bf16* row = base + (size_t)j * ZP + Z_RK + h * 64;
            const u32x2 a = *(const GAS u32x2*)(row + 4 * dg), bb = *(const GAS u32x2*)(row + 32 + 4 * dg);
            const float x1[4] = {bflo(a.x), bfhi(a.x), bflo(a.y), bfhi(a.y)}, x2[4] = {bflo(bb.x), bfhi(bb.x), bflo(bb.y), bfhi(bb.y)};
            const f32x2* cs = R64 + (ch * 128 + j) * 32 + 4 * dg; const float sc = exp2f(-(float)j * l2g);
            float o1[4], o2[4];
#pragma unroll
            for (int e = 0; e < 4; ++e) { const f32x2 tt = cs[e]; o1[e] = (x1[e] * tt.x - x2[e] * tt.y) * sc; o2[e] = (x2[e] * tt.x + x1[e] * tt.y) * sc; }
            u32x2 w1, w2; w1.x = pk2(o1[0], o1[1]); w1.y = pk2(o1[2], o1[3]); w2.x = pk2(o2[0], o2[1]); w2.y = pk2(o2[2], o2[3]);
            const int sw = (j >> 1) & 3; const int d1 = 4 * dg, d2 = 32 + 4 * dg;
            *(LAS u32x2*)(Kimg + j * 128 + ((((2 * d1) >> 5) ^ sw) << 5) + ((2 * d1) & 31)) = w1;
            *(LAS u32x2*)(Kimg + j * 128 + ((((2 * d2) >> 5) ^ sw) << 5) + ((2 * d2) & 31)) = w2; }
        const int i = 16 * w + c; s16x8 qf[2];
        float sc8 = 0.125f; asm volatile("" : "+v"(sc8));
        ret_rope_frag(base + (size_t)i * ZP + Z_RQ + h * 64, R64 + (ch * 128 + i) * 32, sc8 * exp2f((float)i * l2g), g, qf);
        __syncthreads();
        f32x4 acc[8];
#pragma unroll
        for (int t = 0; t < 8; ++t) { acc[t] = (f32x4){0.f, 0.f, 0.f, 0.f};
            if (t <= w) { const int j = 16 * t + c; const int sw = (j >> 1) & 3; const LAS unsigned char* kr = Kimg + j * 128;
                const u32x2 a0 = *(const LAS u32x2*)(kr + ((((8 * g) >> 5) ^ sw) << 5) + ((8 * g) & 31)), a1 = *(const LAS u32x2*)(kr + ((((32 + 8 * g) >> 5) ^ sw) << 5) + ((32 + 8 * g) & 31));
                const u32x2 b0 = *(const LAS u32x2*)(kr + ((((64 + 8 * g) >> 5) ^ sw) << 5) + ((64 + 8 * g) & 31)), b1 = *(const LAS u32x2*)(kr + ((((96 + 8 * g) >> 5) ^ sw) << 5) + ((96 + 8 * g) & 31));
                const s16x8 kf0 = __builtin_bit_cast(s16x8, (v4u){a0.x, a0.y, a1.x, a1.y}), kf1 = __builtin_bit_cast(s16x8, (v4u){b0.x, b0.y, b1.x, b1.y});
                acc[t] = __builtin_amdgcn_mfma_f32_16x16x32_bf16(kf0, qf[0], acc[t], 0, 0, 0); acc[t] = __builtin_amdgcn_mfma_f32_16x16x32_bf16(kf1, qf[1], acc[t], 0, 0, 0);
                if (t == w) {
#pragma unroll
                    for (int r = 0; r < 4; ++r) if (4 * g + r > c) acc[t][r] = 0.f; } } }
        s16x8 pf[4];
#pragma unroll
        for (int s = 0; s < 4; ++s) { v4u wv; wv.x = pk2(acc[2 * s][0], acc[2 * s][1]); wv.y = pk2(acc[2 * s][2], acc[2 * s][3]); wv.z = pk2(acc[2 * s + 1][0], acc[2 * s + 1][1]); wv.w = pk2(acc[2 * s + 1][2], acc[2 * s + 1][3]);
            pf[s] = __builtin_bit_cast(s16x8, wv); }
        f32x4 o[8];
#pragma unroll
        for (int eb = 0; eb < 8; ++eb) o[eb] = (f32x4){0.f, 0.f, 0.f, 0.f};
#pragma unroll
        for (int s = 0; s < 4; ++s) if (2 * s <= w) {
#pragma unroll
            for (int eb = 0; eb < 8; ++eb) o[eb] = __builtin_amdgcn_mfma_f32_16x16x32_bf16(pf[s], ret_bfrag(Vimg, 32 * s, eb, g, q, p), o[eb], 0, 0, 0); }
#pragma unroll
        for (int ks = 0; ks < 2; ++ks)
#pragma unroll
            for (int eb = 0; eb < 8; ++eb) o[eb] = __builtin_amdgcn_mfma_f32_16x16x32_bf16(qf[ks], ret_bfrag(Simg, 32 * ks, eb, g, q, p), o[eb], 0, 0, 0);
        float rs[4];
#pragma unroll
        for (int r = 0; r < 4; ++r) { float ss = 0.f;
#pragma unroll
            for (int eb = 0; eb < 8; ++eb) ss += o[eb][r] * o[eb][r];
            ss += sx<1>(ss); ss += sx<2>(ss); ss += sx<4>(ss); ss += sx<8>(ss);
            rs[r] = 1.0f / sqrtf(ss * (1.f / 128) + NORM_EPS); }
#pragma unroll
        for (int r = 0; r < 4; ++r) { bf16* zr = base + (size_t)(16 * w + 4 * g + r) * ZP; bf16* zw = dummy_out ? (bf16*)(F.ws + WS_ZS) + ((size_t)b * SEQ + ch * 128 + 16 * w + 4 * g + r) * 1024 - Z_RV : zr;
#pragma unroll
            for (int eb = 0; eb < 8; ++eb) { const int e = 16 * eb + c; const float rg = bf2f(zr[Z_RG + h * 128 + e]);
                zw[Z_RV + h * 128 + e] = (bf16)f2bf(o[eb][r] * rs[r] * gn[h * 128 + e] * rg * sigmoid_f(rg)); } }
    }
    __syncthreads();
}

__device__ __forceinline__ void fscan_phase(const Ctx& F) {
    const float* LF = (const float*)(F.ws + WS_LF); float* CF = (float*)(F.ws + WS_CF);
    LAS float* wsum = (LAS float*)(F.lds);
    const int seq = (int)blockIdx.x;
    if (seq < 32) {
        const int b = seq >> 3, h = seq & 7; const int p0 = F.tid * 8; const float* lp = LF + ((size_t)b * SEQ + p0) * 8 + h;
        float v[8]; float s = 0.f;
#pragma unroll
        for (int i = 0; i < 8; ++i) { v[i] = lp[i * 8]; }
#pragma unroll
        for (int i = 0; i < 8; ++i) { s += v[i]; v[i] = s; }
        float incl = s;
#pragma unroll
        for (int o = 1; o < 64; o <<= 1) { const float t = __builtin_bit_cast(float, __builtin_amdgcn_ds_bpermute(((F.lane - o) & 63) << 2, __builtin_bit_cast(int, incl))); if (F.lane >= o) incl += t; }
        if (F.lane == 63) wsum[F.wave] = incl;
        __syncthreads();
        float woff = 0.f;
#pragma unroll
        for (int ww = 0; ww < 8; ++ww) { const float t = wsum[ww]; if (ww < F.wave) woff += t; }
        const float base = woff + (incl - s);
        float* cp = CF + (size_t)seq * SEQ + p0;
        *(GAS f32x4*)cp = (f32x4){base + v[0], base + v[1], base + v[2], base + v[3]}; *(GAS f32x4*)(cp + 4) = (f32x4){base + v[4], base + v[5], base + v[6], base + v[7]};
    }
    __syncthreads();
}
#include <hip/hip_bf16.h>
#include <cmath>
namespace attn_body {
using bf16=__hip_bfloat16;
using bf16x8=__attribute__((ext_vector_type(8)))short;
using s16x4=__attribute__((ext_vector_type(4)))short;
using f32x16=__attribute__((ext_vector_type(16)))float;
using u32x4=__attribute__((ext_vector_type(4)))unsigned;
constexpr int BATCH=4,NHEAD=8,SEQ=4096,D=64,DM=6656;
constexpr int NW=8,QBLK=32,QB=QBLK*NW,KVBLK=64,NQB=SEQ/QB;
constexpr int ATTN_PITCH=DM, ATTN_UNIT_ROWS=QB;
__device__ __forceinline__ int crow(int r,int hi){return (r&3)+8*(r>>2)+4*hi;}
#define SBAR() __builtin_amdgcn_sched_barrier(0)
__device__ __forceinline__ void cmask(f32x16&p0,f32x16&p1,int jb,int qrel,int hi){
  const float NEG=-INFINITY; int kb=64*jb+4*hi;
  #pragma unroll
  for(int r=0;r<16;++r){int kv=kb+(r&3)+8*(r>>2); if(kv>qrel)p0[r]=NEG; if(kv+32>qrel)p1[r]=NEG;}
}

constexpr int NSLOT=3, SLOTB=8192;
constexpr int LDS_K=0, LDS_V=NSLOT*SLOTB, LDS_WS=2*NSLOT*SLOTB, LDS_OST=LDS_WS+NW*64*4, LDS_NC=LDS_OST+NW*4096, LDS_BYTES=LDS_NC+SEQ*4;
constexpr float C2=0.125f*1.4426950408889634f;
__device__ __forceinline__ void glds16(const void*gsrc,unsigned lds_dst){unsigned keep;
  asm volatile("s_mov_b32 %0, m0\n\ts_mov_b32 m0, %2\n\ts_nop 0\n\tglobal_load_lds_dwordx4 %1, off\n\ts_mov_b32 m0, %0":"=&s"(keep):"v"(gsrc),"s"(lds_dst):"memory");}
__device__ __forceinline__ float max3f(float a,float b,float c){float r;asm("v_max3_f32 %0, %1, %2, %3":"=v"(r):"v"(a),"v"(b),"v"(c));return r;}
__device__ __forceinline__ float max2f(float a,float b){float r;asm("v_max_f32_e32 %0, %1, %2":"=v"(r):"v"(a),"v"(b));return r;}
__device__ __forceinline__ float fadd_s(float a,float b){float r;asm("v_add_f32_e32 %0, %1, %2":"=v"(r):"v"(a),"v"(b));return r;}
__device__ __forceinline__ float fsub_s(float a,float b){float r;asm("v_sub_f32_e32 %0, %1, %2":"=v"(r):"v"(a),"v"(b));return r;}
typedef float f32x4_t __attribute__((ext_vector_type(4))); typedef float f32x2_t __attribute__((ext_vector_type(2))); typedef __bf16 bf16x2_t __attribute__((ext_vector_type(2)));
__device__ __forceinline__ unsigned cvtpk_s(float lo,float hi){f32x2_t v={lo,hi};bf16x2_t b=__builtin_convertvector(v,bf16x2_t);return __builtin_bit_cast(unsigned,b);}
#define WAIT_BAR(N) asm volatile("s_waitcnt vmcnt(" #N ") lgkmcnt(0)\n\ts_barrier":::"memory")

__device__ __forceinline__ void qkt(f32x16&p0,f32x16&p1,const char*Kslot,const bf16x8*qr,const f32x16&negm,int r32,int hi){
  const char*kb=Kslot+hi*1024+r32*16;
  #pragma unroll
  for(int d0=0;d0<4;++d0){
    const bf16x8 b0=*reinterpret_cast<const bf16x8*>(kb+d0*2048);
    const bf16x8 b1=*reinterpret_cast<const bf16x8*>(kb+d0*2048+512);
    if(d0==0){p0=__builtin_amdgcn_mfma_f32_32x32x16_bf16(b0,qr[0],negm,0,0,0);p1=__builtin_amdgcn_mfma_f32_32x32x16_bf16(b1,qr[0],negm,0,0,0);}
    else{p0=__builtin_amdgcn_mfma_f32_32x32x16_bf16(b0,qr[d0],p0,0,0,0);p1=__builtin_amdgcn_mfma_f32_32x32x16_bf16(b1,qr[d0],p1,0,0,0);}}
}
typedef __attribute__((address_space(3))) const char* lds_cptr;
typedef short v4i16_t __attribute__((ext_vector_type(4)));
__device__ __forceinline__ void kload8(bf16x8*kf,lds_cptr kp){
  kf[0]=*(const __attribute__((address_space(3))) bf16x8*)(kp);      kf[1]=*(const __attribute__((address_space(3))) bf16x8*)(kp+512);
  kf[2]=*(const __attribute__((address_space(3))) bf16x8*)(kp+2048); kf[3]=*(const __attribute__((address_space(3))) bf16x8*)(kp+2560);
  kf[4]=*(const __attribute__((address_space(3))) bf16x8*)(kp+4096); kf[5]=*(const __attribute__((address_space(3))) bf16x8*)(kp+4608);
  kf[6]=*(const __attribute__((address_space(3))) bf16x8*)(kp+6144); kf[7]=*(const __attribute__((address_space(3))) bf16x8*)(kp+6656);
}
__device__ __forceinline__ void kload2(bf16x8*kf,lds_cptr kp,int j){ kf[2*j]=*(const __attribute__((address_space(3))) bf16x8*)(kp+j*2048); kf[2*j+1]=*(const __attribute__((address_space(3))) bf16x8*)(kp+j*2048+512); }
__device__ __forceinline__ s16x4 vtr(lds_cptr p){ return __builtin_bit_cast(s16x4,__builtin_amdgcn_ds_read_tr16_b64_v4i16((__attribute__((address_space(3))) v4i16_t*)p)); }
__device__ __forceinline__ float rowmax(const f32x16&p0,const f32x16&p1){
  float a=max3f(p0[0],p0[1],p1[0]),b=max3f(p0[2],p0[3],p1[1]);a=max3f(a,p1[2],p1[3]);
  #pragma unroll
  for(int r=4;r<16;r+=4){a=max3f(a,p0[r],p0[r+1]);b=max3f(b,p0[r+2],p0[r+3]);a=max3f(a,p1[r],p1[r+1]);b=max3f(b,p1[r+2],p1[r+3]);}
  const float m=max2f(a,b);
  auto rr=__builtin_amdgcn_permlane32_swap(__float_as_uint(m),__float_as_uint(m),false,false);
  return max2f(__uint_as_float(rr[0]),__uint_as_float(rr[1]));
}
__device__ __forceinline__ void pv(f32x16*o,int vb,bf16x8 pa0,bf16x8 pa1,bf16x8 pa2,bf16x8 pa3){
  #pragma unroll
  for(int d0=0;d0<2;++d0){s16x4 lo[4],hi[4];
    #pragma unroll
    for(int ks=0;ks<4;++ks){
      asm volatile("ds_read_b64_tr_b16 %0,%1 offset:%c2":"=&v"(lo[ks]):"v"(vb),"i"(d0*4096+ks*1024):"memory");
      asm volatile("ds_read_b64_tr_b16 %0,%1 offset:%c2":"=&v"(hi[ks]):"v"(vb),"i"(d0*4096+ks*1024+512):"memory");}
    asm volatile("s_waitcnt lgkmcnt(0)":::"memory");SBAR();
    #define PK(k) (bf16x8){lo[k][0],lo[k][1],lo[k][2],lo[k][3],hi[k][0],hi[k][1],hi[k][2],hi[k][3]}
    o[d0]=__builtin_amdgcn_mfma_f32_32x32x16_bf16(pa0,PK(0),o[d0],0,0,0);
    o[d0]=__builtin_amdgcn_mfma_f32_32x32x16_bf16(pa1,PK(1),o[d0],0,0,0);
    o[d0]=__builtin_amdgcn_mfma_f32_32x32x16_bf16(pa2,PK(2),o[d0],0,0,0);
    o[d0]=__builtin_amdgcn_mfma_f32_32x32x16_bf16(pa3,PK(3),o[d0],0,0,0);
    #undef PK
  }
}

#ifndef ATTN_STORE16
#define ATTN_STORE16(p,v) (*(u32x4*)(p)=(v))
#endif
template<int THRL> __device__ __forceinline__ void attn_unit(int b,int h,int qb,const bf16*Q,const bf16*__restrict__ K,const bf16*__restrict__ V,bf16*O,const float*CF,float dskip,char*shm,int wave_id){
  int tid_=(wave_id<<6)|lane_id_v(); asm volatile("":"+v"(tid_));
  const int tid=tid_,lane=tid&63,r32=lane&31,hi=lane>>5; const int wid=__builtin_amdgcn_readfirstlane(tid>>6);
  const long rowbase=(long)b*SEQ; const int q0=qb*QB;
  const bf16*Qw=Q+(rowbase+q0+wid*QBLK)*DM+h*D;
  const float*cfp0=CF+(long)(b*NHEAD+h)*SEQ; const int NT0=(q0+QB)/KVBLK;
  int ts; { const float cq=cfp0[q0]; const int il=(lane<NT0)?64*lane+63:q0; const bool keep=(lane<NT0)&&(cfp0[il]<cq+dskip);
    const unsigned long long km=__ballot(keep); int t0=(int)__builtin_ctzll(km|(1ull<<63)); t0&=~1; ts=__builtin_amdgcn_readfirstlane(t0<NT0-4?t0:NT0-4); }
  const bf16*Kh=K+(rowbase+(long)ts*KVBLK)*DM+h*D,*Vh=V+(rowbase+(long)ts*KVBLK)*DM+h*D;
  const unsigned lds0=(unsigned)(uintptr_t)shm;
  float*wsf=(float*)(shm+LDS_WS)+wid*64;
  const bf16*ksrc=Kh+(long)lane*DM+wid*8;
  const bf16*vsrc=Vh+(long)(16*(wid&3)+(lane>>2))*DM+(wid>>2)*32+(lane&3)*8;
  const unsigned kdst=lds0+LDS_K+wid*1024, vdst=lds0+LDS_V+wid*1024;
  #define DMA_K(t,slot) glds16(ksrc+(long)(t)*KVBLK*DM,(unsigned)__builtin_amdgcn_readfirstlane(kdst+(slot)))
  #define DMA_V(t,slot) glds16(vsrc+(long)(t)*KVBLK*DM,(unsigned)__builtin_amdgcn_readfirstlane(vdst+(slot)))
  const char*Kbase=shm+LDS_K; bf16x8 kf[8];
  const lds_cptr shm3=(lds_cptr)shm; const lds_cptr kp0=shm3+LDS_K+hi*1024+r32*16; const lds_cptr vp0=shm3+LDS_V+((lane>>4)&1)*32+(lane&3)*8+(4*hi+((lane&15)>>2))*64;
  const int NT=NT0-ts;
  { const float*cfp=CF+(long)(b*NHEAD+h)*SEQ; float*ncw=(float*)(shm+LDS_NC);
    for(int i=tid+ts*KVBLK;i<q0+QB;i+=NW*64)ncw[i-ts*KVBLK]=-cfp[i]; }
  const lds_cptr ncp=(lds_cptr)shm+LDS_NC+hi*16;
  #define ADDC(P0,P1,t) do{ const lds_cptr np_=ncp+(t)*256; _Pragma("unroll") for(int g_=0;g_<4;++g_){ \
      const f32x4_t a_=*(const __attribute__((address_space(3))) f32x4_t*)(np_+g_*32), b_=*(const __attribute__((address_space(3))) f32x4_t*)(np_+g_*32+128); \
      P0[4*g_]+=a_[0];P0[4*g_+1]+=a_[1];P0[4*g_+2]+=a_[2];P0[4*g_+3]+=a_[3]; P1[4*g_]+=b_[0];P1[4*g_+1]+=b_[1];P1[4*g_+2]+=b_[2];P1[4*g_+3]+=b_[3]; } }while(0)
  DMA_K(0,0);DMA_V(0,0);DMA_K(1,SLOTB);
  bf16x8 qr[4];
  #pragma unroll
  for(int d0=0;d0<4;++d0)qr[d0]=*reinterpret_cast<const bf16x8*>(&Qw[(long)r32*DM+d0*16+hi*8]);
  float mhat=0.f,l_reg=0.f;f32x16 o[2];f32x16 negm; { float zz_; asm volatile("v_mov_b32 %0, 0":"=v"(zz_));
    _Pragma("unroll") for(int r=0;r<16;++r){o[0][r]=zz_;o[1][r]=zz_;negm[r]=zz_;} } asm volatile("":"+v"(negm));
  const int qrel=wid*QBLK+r32;
  #define CMASK(P0,P1,t) do{int jb_=(t)-(NT-4); if(jb_>=0)cmask(P0,P1,jb_,qrel,hi);}while(0)
  bool resc=false;
  #define START(P0,P1) do{ const float rm=rowmax(P0,P1); resc=false; \
    { const float dl=rm; mhat=fadd_s(mhat,dl); \
      _Pragma("unroll") for(int r=0;r<16;++r){P0[r]=fsub_s(P0[r],dl);P1[r]=fsub_s(P1[r],dl);} \
      _Pragma("unroll") for(int r=0;r<16;++r)negm[r]=-mhat; asm volatile("":"+v"(negm)); } \
    _Pragma("unroll") for(int r=0;r<16;++r)P0[r]=__builtin_amdgcn_exp2f(P0[r]); }while(0)
  #define RESC() do{ if(resc){ asm volatile("s_waitcnt lgkmcnt(0)":::"memory"); \
      _Pragma("unroll") for(int d_=0;d_<2;++d_) _Pragma("unroll") for(int r=0;r<16;++r)o[d_][r]*=wsf[crow(r,hi)]; } }while(0)
  f32x16 pA0,pA1,pB0,pB1;
  int sl_prev=0,sl_cur=0,sl_next=SLOTB;
  #define ROT() do{sl_prev=sl_cur;sl_cur=sl_next;sl_next=(sl_next==(NSLOT-1)*SLOTB)?0:sl_next+SLOTB;}while(0)
  DMA_K(2,2*SLOTB);
  WAIT_BAR(3);
  qkt(pA0,pA1,Kbase,qr,negm,r32,hi);asm volatile("s_nop 15\n\ts_nop 7":"+v"(pA0),"+v"(pA1));ADDC(pA0,pA1,0);CMASK(pA0,pA1,0);
  START(pA0,pA1);
  _Pragma("unroll") for(int r=0;r<16;++r)pA1[r]=__builtin_amdgcn_exp2f(pA1[r]);
  WAIT_BAR(0);
  DMA_K(3,0);DMA_V(1,SLOTB);
  ROT();
  kload8(kf,kp0+sl_cur);
  WAIT_BAR(2);
  s16x4 vlo[8],vhi[8]; u32x4 pw0,pw1,pw2,pw3;
  #define PKW(P,B) cvtpk_s(P[B],P[B+1])
  #define PAF(k) __builtin_bit_cast(bf16x8,pw##k)
  #define VFR(i) (bf16x8){vlo[i][0],vlo[i][1],vlo[i][2],vlo[i][3],vhi[i][0],vhi[i][1],vhi[i][2],vhi[i][3]}
  #define PIN(x) asm volatile("":"+v"(x))
  #define MX3(a,b,c) __builtin_fmaxf(__builtin_fmaxf((a),(b)),(c))
  #define GAPA(MF,A0,A1,A2,A3,W0,W1,PW) do{ MF; sacc+=A0; sacc+=A1; sacc+=A2; sacc+=A3; PIN(sacc); W0; W1; PIN(PW); SBAR(); }while(0)
  #define EX(v) __builtin_amdgcn_exp2f(v)
  #define GAPB(MF,X,B) do{ MF; X[B]=EX(X[B]); X[B+1]=EX(X[B+1]); X[B+2]=EX(X[B+2]); X[B+3]=EX(X[B+3]); PIN(X); SBAR(); }while(0)
  #define VRD(i) do{ vlo[i]=vtr(vp_+(((i)>>2)*4096+((i)&3)*1024)); vhi[i]=vtr(vp_+(((i)>>2)*4096+((i)&3)*1024+512)); }while(0)
  #define KRD(G,j) do{ if(G){ kload2(kf,kp0+sl_next,j); SBAR(); } }while(0)
  #define STEP(C0,C1,P0,P1,t,GK,GV,GL) do{ SBAR(); \
    const lds_cptr vp_=vp0+sl_prev; \
    VRD(0); SBAR(); float sacc=(P0[0]+P0[1]); \
    GAPA(C0=__builtin_amdgcn_mfma_f32_32x32x16_bf16(kf[0],qr[0],negm,0,0,0), P0[2],P0[3],P0[4],P0[5],     pw0[0]=PKW(P0,0), pw0[1]=PKW(P0,2), pw0); \
    VRD(4); SBAR(); GAPA(C1=__builtin_amdgcn_mfma_f32_32x32x16_bf16(kf[1],qr[0],negm,0,0,0), P0[6],P0[7],P0[8],P0[9],     pw0[2]=PKW(P0,4), pw0[3]=PKW(P0,6), pw0); \
    VRD(1); SBAR(); GAPA(C0=__builtin_amdgcn_mfma_f32_32x32x16_bf16(kf[2],qr[1],C0,0,0,0),   P0[10],P0[11],P0[12],P0[13], pw1[0]=PKW(P0,8), pw1[1]=PKW(P0,10), pw1); \
    VRD(5); SBAR(); GAPA(C1=__builtin_amdgcn_mfma_f32_32x32x16_bf16(kf[3],qr[1],C1,0,0,0),   P0[14],P0[15],P1[0],P1[1],   pw1[2]=PKW(P0,12),pw1[3]=PKW(P0,14), pw1); \
    VRD(2); SBAR(); GAPA(C0=__builtin_amdgcn_mfma_f32_32x32x16_bf16(kf[4],qr[2],C0,0,0,0),   P1[2],P1[3],P1[4],P1[5],     pw2[0]=PKW(P1,0), pw2[1]=PKW(P1,2), pw2); \
    VRD(6); SBAR(); GAPA(C1=__builtin_amdgcn_mfma_f32_32x32x16_bf16(kf[5],qr[2],C1,0,0,0),   P1[6],P1[7],P1[8],P1[9],     pw2[2]=PKW(P1,4), pw2[3]=PKW(P1,6), pw2); \
    VRD(3); SBAR(); GAPA(C0=__builtin_amdgcn_mfma_f32_32x32x16_bf16(kf[6],qr[3],C0,0,0,0),   P1[10],P1[11],P1[12],P1[13], pw3[0]=PKW(P1,8), pw3[1]=PKW(P1,10), pw3); \
    VRD(7); SBAR(); GAPA(C1=__builtin_amdgcn_mfma_f32_32x32x16_bf16(kf[7],qr[3],C1,0,0,0),   P1[14],P1[15],0.f,0.f,       pw3[2]=PKW(P1,12),pw3[3]=PKW(P1,14), pw3); \
    l_reg+=sacc; \
    if(GK){DMA_K((t)+3,sl_cur);} if(GV){DMA_V((t)+1,sl_next);} \
    ADDC(C0,C1,t); CMASK(C0,C1,t); \
    { float a=MX3(C0[0],C0[1],C1[0]),b=MX3(C0[2],C0[3],C1[1]); a=MX3(a,C1[2],C1[3]); \
      _Pragma("unroll") for(int r=4;r<16;r+=4){a=MX3(a,C0[r],C0[r+1]);b=MX3(b,C0[r+2],C0[r+3]);a=MX3(a,C1[r],C1[r+1]);b=MX3(b,C1[r+2],C1[r+3]);} \
      float rm=__builtin_fmaxf(a,b); { auto rr=__builtin_amdgcn_permlane32_swap(__float_as_uint(rm),__float_as_uint(rm),false,false); rm=__builtin_fmaxf(__uint_as_float(rr[0]),__uint_as_float(rr[1])); } \
      resc=false; \
      if(__builtin_expect(__any(rm>(float)THRL),0)){ const float dl=__builtin_fmaxf(rm,0.f); mhat+=dl; \
        _Pragma("unroll") for(int r=0;r<16;++r){C0[r]-=dl;C1[r]-=dl;} \
        _Pragma("unroll") for(int r=0;r<16;++r)negm[r]=-mhat; asm volatile("":"+v"(negm)); \
        const float f=__builtin_amdgcn_exp2f(-dl); l_reg*=f; if(hi==0)wsf[r32]=f; resc=true; } } \
    SBAR(); \
    GAPB(o[0]=__builtin_amdgcn_mfma_f32_32x32x16_bf16(PAF(0),VFR(0),o[0],0,0,0), C0,0); \
    GAPB(o[1]=__builtin_amdgcn_mfma_f32_32x32x16_bf16(PAF(0),VFR(4),o[1],0,0,0), C0,4); \
    KRD(GL,0); GAPB(o[0]=__builtin_amdgcn_mfma_f32_32x32x16_bf16(PAF(1),VFR(1),o[0],0,0,0), C0,8); \
    KRD(GL,1); GAPB(o[1]=__builtin_amdgcn_mfma_f32_32x32x16_bf16(PAF(1),VFR(5),o[1],0,0,0), C0,12); \
    KRD(GL,2); GAPB(o[0]=__builtin_amdgcn_mfma_f32_32x32x16_bf16(PAF(2),VFR(2),o[0],0,0,0), C1,0); \
    KRD(GL,3); GAPB(o[1]=__builtin_amdgcn_mfma_f32_32x32x16_bf16(PAF(2),VFR(6),o[1],0,0,0), C1,4); \
    GAPB(o[0]=__builtin_amdgcn_mfma_f32_32x32x16_bf16(PAF(3),VFR(3),o[0],0,0,0), C1,8); \
    GAPB(o[1]=__builtin_amdgcn_mfma_f32_32x32x16_bf16(PAF(3),VFR(7),o[1],0,0,0), C1,12); \
    }while(0)
  int t=1;
  #undef CMASK
  #define CMASK(P0,P1,t) do{}while(0)
  for(;t+5<NT;t+=2){
    STEP(pB0,pB1,pA0,pA1,t,true,true,true);     WAIT_BAR(2); RESC(); ROT();
    STEP(pA0,pA1,pB0,pB1,t+1,true,true,true);   WAIT_BAR(2); RESC(); ROT();
  }
  #undef CMASK
  #define CMASK(P0,P1,t) do{int jb_=(t)-(NT-4); if(jb_>=0)cmask(P0,P1,jb_,qrel,hi);}while(0)
  #define ENDW(tt) do{ if((tt)+3<NT){WAIT_BAR(2);} else if((tt)+2<NT){WAIT_BAR(1);} else {WAIT_BAR(0);} }while(0)
  for(;t+1<NT;t+=2){
    STEP(pB0,pB1,pA0,pA1,t,(t+3<NT),(t+1<NT),(t+1<NT));       ENDW(t);   RESC(); ROT();
    STEP(pA0,pA1,pB0,pB1,t+1,(t+4<NT),(t+2<NT),(t+2<NT));     ENDW(t+1); RESC(); ROT();
  }
  STEP(pB0,pB1,pA0,pA1,NT-1,false,false,false); RESC();
  { float sacc=pB0[0]+pB0[1]; _Pragma("unroll") for(int r=2;r<16;++r)sacc+=pB0[r]; _Pragma("unroll") for(int r=0;r<16;++r)sacc+=pB1[r]; l_reg+=sacc;
    pw0=(u32x4){PKW(pB0,0),PKW(pB0,2),PKW(pB0,4),PKW(pB0,6)};pw1=(u32x4){PKW(pB0,8),PKW(pB0,10),PKW(pB0,12),PKW(pB0,14)};pw2=(u32x4){PKW(pB1,0),PKW(pB1,2),PKW(pB1,4),PKW(pB1,6)};pw3=(u32x4){PKW(pB1,8),PKW(pB1,10),PKW(pB1,12),PKW(pB1,14)};
    int tl_=lane_id_v(); asm volatile("":"+v"(tl_)); const int ln_=tl_&63,hi_=ln_>>5; const int vb0e=(int)(lds0+LDS_V)+((ln_>>4)&1)*32+(ln_&3)*8+(4*hi_+((ln_&15)>>2))*64;
    SBAR(); pv(o,vb0e+sl_cur,PAF(0),PAF(1),PAF(2),PAF(3)); }
  #undef PKW
  #undef PAF
  #undef VFR
  #undef PIN
  #undef MX3
  #undef GAPA
  #undef GAPB
  #undef EX
  #undef VRD
  #undef KRD
  #undef STEP
  #undef ENDW
  {auto rr=__builtin_amdgcn_permlane32_swap(__float_as_uint(l_reg),__float_as_uint(l_reg),false,false);l_reg=__uint_as_float(rr[0])+__uint_as_float(rr[1]);}
  int te_=lane_id_v(); asm volatile("":"+v"(te_)); const int lane_e=te_&63,r32_e=lane_e&31,hi_e=lane_e>>5;
  if(hi_e==0)wsf[32+r32_e]=l_reg;asm volatile("s_waitcnt lgkmcnt(0)":::"memory");
  float rli[16];
  #pragma unroll
  for(int r=0;r<16;++r)rli[r]=__builtin_amdgcn_rcpf(wsf[32+crow(r,hi_e)]);
  bf16*Ow=O+(rowbase+q0+wid*QBLK)*DM+h*D;
  { bf16*stg=(bf16*)(shm+LDS_OST)+wid*2048;
    #pragma unroll
    for(int r=0;r<16;++r){const int orow=crow(r,hi_e);
      #pragma unroll
      for(int d0=0;d0<2;++d0)stg[orow*64+d0*32+r32_e]=__float2bfloat16(o[d0][r]*rli[r]);}
    asm volatile("s_waitcnt lgkmcnt(0)":::"memory");
    #pragma unroll
    for(int i=0;i<4;++i){const int row=i*8+(lane_e>>3),ch=lane_e&7; const u32x4 v=*(const u32x4*)(stg+row*64+ch*8); ATTN_STORE16(Ow+(long)row*DM+ch*8,v);} }
  asm volatile("s_waitcnt lgkmcnt(0)\n\ts_barrier":::"memory");
  #undef ADDC
  #undef DMA_K
  #undef DMA_V
  #undef CMASK
  #undef START
  #undef RESC
  #undef ROT
}
constexpr int ATTN_LDS_BYTES=LDS_BYTES;
struct AttnTensors { const bf16* Q; const bf16* K; const bf16* V; bf16* O; const float* CF; float dskip; };
struct AttnUnit { int bh; int qb; };
struct StaticOrder {
  int vcu;
  __device__ __forceinline__ explicit StaticOrder(int grid,int block):vcu((block%8)*(grid/8)+block/8){}
  __device__ __forceinline__ bool next(int i,AttnUnit&u)const{ if(i>=2)return false; const int s=vcu&7; u.bh=vcu>>3; u.qb=(i==0)?s:15-s; return true; }
  __device__ __forceinline__ void a_ready(const AttnUnit&)const{}
  __device__ __forceinline__ void done(const AttnUnit&)const{}
};
template<class Sched,int THRL=8> __device__ __forceinline__ void attn_phase(char*lds,const AttnTensors&T,const Sched&S,int wave_id){
  AttnUnit u;
  for(int i=0;S.next(i,u);++i){ S.a_ready(u); attn_unit<THRL>(u.bh/NHEAD,u.bh%NHEAD,u.qb,T.Q,T.K,T.V,T.O,T.CF,T.dskip,lds,wave_id); S.done(u); }
}
#undef SBAR
#undef WAIT_BAR
}

struct Args { const float* in[16]; float* out; unsigned char* ws; };
__global__ void __launch_bounds__(NWAVES * 64, 2) hyb_fwd(Args args) {
    extern __shared__ __attribute__((aligned(16))) unsigned char lds[];
    Ctx F;
    F.lds = (LAS unsigned char*)lds;
    F.tid = threadIdx.x; F.lane = F.tid & 63; F.wave = __builtin_amdgcn_readfirstlane(F.tid >> 6);
    F.G = gridDim.x; F.gw = blockIdx.x * NWAVES + F.wave; F.NGW = F.G * NWAVES;
    F.out = args.out; F.ws = args.ws;
    volatile LAS unsigned* MISC = (volatile LAS unsigned*)(F.lds + MISC_OFF);
    for (int u = F.tid; u < (LDS_BYTES - LDSCTL_OFF) / 4; u += NWAVES * 64) ((LAS unsigned*)(F.lds + LDSCTL_OFF))[u] = 0u;
    __syncthreads();
    gu32* ctl = (gu32*)(F.ws + WS_CTL);
    XcdBarrier bar = xcd_barrier_post((unsigned*)(ctl + CW_BAR), MISC + 8); bar.w = F.wave;
#define FRESH(P) Ctx P = F; P.tid = (F.wave << 6) | lane_id_v(); asm volatile("" : "+v"(P.tid), "+s"(P.wave), "+s"(P.gw), "+s"(P.ws), "+s"(P.out)); P.lane = P.tid & 63
#define GRID_BAR() do { XcdBarrier b_ = bar; asm volatile("" : "+s"(b_.bar), "+s"(b_.x)); xcd_barrier(b_); } while (0)

    bf16* Wb = (bf16*)(F.ws + WS_W);
    bf16* Z = (bf16*)(F.ws + WS_Z); float* ZS = (float*)(F.ws + WS_ZS); bf16* HDN = (bf16*)(F.ws + WS_HDN);
    float* M32 = (float*)(F.ws + WS_HDN); bf16* HB = (bf16*)(F.ws + WS_Z);
    LAS unsigned char* ring = F.lds + RING_OFF; float* SSp = (float*)(F.ws + WS_SS);

    { FRESH(P); p0_prologue(P, args.in[2], args.in[9], args.in[10], args.in[11], args.in[12], args.in[14], args.in[15]); }
    { FRESH(P); norm0_phase(P, args.in[0], args.in[1], (bf16*)(P.ws + WS_HDN), (float*)(P.ws + WS_SS)); }
    GRID_BAR();

    #pragma unroll 1
    for (int layer = 0; layer < DEPTH; ++layer) {
        const float* xin = (layer == 0) ? args.in[0] : F.out;
        const bf16* L = Wb + (size_t)layer * LW_STRIDE;
        { pg8::Gemm g{HDN, L + LW_IN, M, NIN, DM, DM, DM}; pg8::StaticOrder S; S.init(M, NIN, F.G, (int)blockIdx.x);
          pg8::EpiZ E{Z, ZS, SSp, args.in[4] + layer * 64, args.in[5] + layer * 64, args.in[6] + layer * 64, (const float*)(F.ws + WS_ROPE64)};
          pg8::gemm_phase<pg8::EpiZ, pg8::StaticOrder, true, true>(ring, g, S, E, F.wave); }
        GRID_BAR();
#ifdef PROBE_PP
        { FRESH(P); post_phase(P, args.in[4] + layer * 64, args.in[5] + layer * 64, args.in[6] + layer * 64, args.in[7] + layer * 64, args.in[3] + layer * 8, true); }
#endif
        { FRESH(P); post_phase(P, args.in[4] + layer * 64, args.in[5] + layer * 64, args.in[6] + layer * 64, args.in[7] + layer * 64, args.in[3] + layer * 8); }
        { FRESH(P); ret_state_mfma(P); }
        GRID_BAR();
        { FRESH(P); fscan_phase(P); }
        { FRESH(P); ret_scan(P); }
        GRID_BAR();
#ifdef PROBE_RO
        { FRESH(P); ret_out_mfma(P, args.in[8] + layer * 512, true); }
#endif
        { FRESH(P); ret_out_mfma(P, args.in[8] + layer * 512); }
#ifdef PROBE_X3
        for (int rep_ = 0; rep_ < 2; ++rep_)
        { static_assert(attn_body::ATTN_LDS_BYTES <= RING_BYTES, "attention scratch fits the ring region");
          unsigned char* wsl = F.ws; asm volatile("" : "+s"(wsl));
          bf16* Zl = (bf16*)(wsl + WS_Z);
          const attn_body::AttnTensors AT{(const attn_body::bf16*)(Zl + Z_FQ), (const attn_body::bf16*)(Zl + Z_FK), (const attn_body::bf16*)(Zl + Z_FV), (attn_body::bf16*)(Zl + (rep_ == 0 ? Z_RQ : Z_FQ)), (const float*)(wsl + WS_CF)};
          const attn_body::StaticOrder S((int)F.G, (int)blockIdx.x);
          attn_body::attn_phase<attn_body::StaticOrder, 20>((char*)lds + RING_OFF, AT, S, F.wave); }
#ifdef PROBE_X4
        { FRESH(P); dsa_v3(P); }
#else
        for (int rep_ = 0; rep_ < 2; ++rep_) { FRESH(P); dsa_v3(P, rep_ == 0 ? Z_RG : Z_DQ); }
#endif
#else
        { static_assert(attn_body::ATTN_LDS_BYTES <= RING_BYTES, "attention scratch fits the ring region");
          unsigned char* wsl = F.ws; asm volatile("" : "+s"(wsl));
          bf16* Zl = (bf16*)(wsl + WS_Z);
          float dskip; { const int ln = lane_id_v(); const float gq = wave_max(fabsf(args.in[4][layer * 64 + ln])), gk = wave_max(fabsf(args.in[5][layer * 64 + ln])); dskip = 2.0f * (64.0f * C2 * gq * gk * 1.02f) + 48.0f; }
          const attn_body::AttnTensors AT{(const attn_body::bf16*)(Zl + Z_FQ), (const attn_body::bf16*)(Zl + Z_FK), (const attn_body::bf16*)(Zl + Z_FV), (attn_body::bf16*)(Zl + Z_FQ), (const float*)(wsl + WS_CF), dskip};
          const attn_body::StaticOrder S((int)F.G, (int)blockIdx.x);
          attn_body::attn_phase<attn_body::StaticOrder, 20>((char*)lds + RING_OFF, AT, S, F.wave); }
        { FRESH(P); dsa_v3(P); }
#endif
        GRID_BAR();
        { pg8::Gemm g{Z + Z_FQ, L + LW_MIX, M, DM, 1536, ZP, 1536}; pg8::StaticOrder S; S.init(M, DM, F.G, (int)blockIdx.x);
          pg8::EpiGateF E{Z + Z_ZG, Z + Z_MRG};
          pg8::gemm_phase<pg8::EpiGateF, pg8::StaticOrder, false, true>(ring, g, S, E, F.wave); }
        GRID_BAR();
        { pg8::Gemm g{Z + Z_MRG, L + LW_O, M, DM, DM, ZP, DM}; pg8::StaticOrder S; S.init(M, DM, F.G, (int)blockIdx.x);
          pg8::EpiRes E{xin, F.out, args.in[13] + layer * DM, HDN, SSp};
          pg8::gemm_phase<pg8::EpiRes, pg8::StaticOrder, false, true>(ring, g, S, E, F.wave); }
        GRID_BAR();
        { pg8::Gemm g{HDN, L + LW_FI, M, FF2, DM, DM, DM}; pg8::StaticOrder S; S.init(M, FF2, F.G, (int)blockIdx.x);
          pg8::EpiSwi E{HB, FFH, SSp};
          pg8::gemm_phase<pg8::EpiSwi, pg8::StaticOrder, true, true>(ring, g, S, E, F.wave); }
        GRID_BAR();
        { pg8::Gemm g{HB, L + LW_FO, M, DM, FFH, FFH, FFH}; pg8::StaticOrder S; S.init(M, DM, F.G, (int)blockIdx.x);
          pg8::EpiRes E{F.out, F.out, args.in[1] + (layer + 1 < DEPTH ? layer + 1 : layer) * DM, HDN, SSp};
          pg8::gemm_phase<pg8::EpiRes, pg8::StaticOrder, false, true>(ring, g, S, E, F.wave); }
        GRID_BAR();
    }
    if (__hip_atomic_load((gu32*)((unsigned*)(ctl + CW_BAR) + XB_TMO), RLX_AGENT) != 0u) {
        const float q = __builtin_nanf("");
        for (int m = F.gw; m < M; m += F.NGW) { GAS f32x4* o = (GAS f32x4*)(F.out + (size_t)m * DM) + lane_id_v();
#pragma unroll
            for (int j = 0; j < 4; ++j) o[64 * j] = (f32x4){q, q, q, q}; }
    }
}

extern "C" void kernel_launch(void* const* d_in, const int* in_sizes, int n_in, void* d_out, int out_size, void* d_ws, size_t ws_size, hipStream_t stream) {
    static int grid = 0;
    if (grid == 0) {
        if (n_in != 16 || in_sizes[0] != M * DM || out_size != M * DM || ws_size < WS_END) { fprintf(stderr, "kernel_launch: unexpected shapes / workspace (n_in %d, in0 %d, out %d, ws %zu < %zu)\n", n_in, n_in > 0 ? in_sizes[0] : -1, out_size, ws_size, (size_t)WS_END); grid = -1; return; }
        int dev = 0, cus = 0, per_cu = 0;
        if (hipGetDevice(&dev) != hipSuccess || hipDeviceGetAttribute(&cus, hipDeviceAttributeMultiprocessorCount, dev) != hipSuccess) { grid = -1; return; }
        if (hipFuncSetAttribute((const void*)hyb_fwd, hipFuncAttributeMaxDynamicSharedMemorySize, LDS_BYTES) != hipSuccess) { fprintf(stderr, "kernel_launch: hipFuncSetAttribute failed\n"); grid = -1; return; }
        if (hipOccupancyMaxActiveBlocksPerMultiprocessor(&per_cu, (const void*)hyb_fwd, NWAVES * 64, LDS_BYTES) != hipSuccess || per_cu < 1) { fprintf(stderr, "kernel_launch: occupancy query reports %d blocks per CU\n", per_cu); }
        (void)hipGetLastError();
        grid = cus;
    }
    if (grid < 0) return;
    if (hipMemsetAsync((char*)d_ws + WS_CTL, 0, CTL_ZERO_BYTES, stream) != hipSuccess) return;
    Args a{};
    for (int i = 0; i < 16; ++i) a.in[i] = (const float*)d_in[i];
    a.out = (float*)d_out; a.ws = (unsigned char*)d_ws;
    hipLaunchKernelGGL(hyb_fwd, dim3(grid), dim3(NWAVES * 64), LDS_BYTES, stream, a);
}
```

```cpp
#include <hip/hip_runtime.h>
#include <cstdio>
#include <cstdint>
#include <cmath>
__device__ __forceinline__ int lane_id_v() { unsigned z; asm volatile("v_mov_b32 %0, 0" : "=v"(z)); return (int)__builtin_amdgcn_mbcnt_hi(~0u, __builtin_amdgcn_mbcnt_lo(~0u, z)); }
template <int MASK> __device__ __forceinline__ float sx(float v) { static_assert(MASK < 32, "swizzle xor mask"); return __builtin_bit_cast(float, __builtin_amdgcn_ds_swizzle(__builtin_bit_cast(int, v), 0x1F | (MASK << 10))); }
template <int MASK> __device__ __forceinline__ unsigned sxu(unsigned v) { return (unsigned)__builtin_amdgcn_ds_swizzle((int)v, 0x1F | (MASK << 10)); }
__device__ __forceinline__ void swap32(unsigned x, unsigned& lo_view, unsigned& hi_view) {
    unsigned a = x, b = x; asm volatile("" : "+v"(b));
    const auto rr = __builtin_amdgcn_permlane32_swap(a, b, false, false);
    lo_view = rr[0]; hi_view = rr[1];
}
template <int CTRL> __device__ __forceinline__ float dpp_f(float v) { return __builtin_bit_cast(float, __builtin_amdgcn_update_dpp(0, __builtin_bit_cast(int, v), CTRL, 0xF, 0xF, false)); }
template <int CTRL> __device__ __forceinline__ int dpp_i(int v) { return __builtin_amdgcn_update_dpp(0, v, CTRL, 0xF, 0xF, false); }
__device__ __forceinline__ float rl_f(float v, int l) { return __builtin_bit_cast(float, __builtin_amdgcn_readlane(__builtin_bit_cast(int, v), l)); }
__device__ __forceinline__ float wave_sum(float v) {
    v += dpp_f<0xB1>(v); v += dpp_f<0x4E>(v); v += dpp_f<0x141>(v); v += dpp_f<0x140>(v);
    return (rl_f(v, 0) + rl_f(v, 16)) + (rl_f(v, 32) + rl_f(v, 48));
}
__device__ __forceinline__ float wave_max(float v) {
    v = fmaxf(v, dpp_f<0xB1>(v)); v = fmaxf(v, dpp_f<0x4E>(v)); v = fmaxf(v, dpp_f<0x141>(v)); v = fmaxf(v, dpp_f<0x140>(v));
    return fmaxf(fmaxf(rl_f(v, 0), rl_f(v, 16)), fmaxf(rl_f(v, 32), rl_f(v, 48)));
}
__device__ __forceinline__ int wave_isum(int v) {
    v += dpp_i<0xB1>(v); v += dpp_i<0x4E>(v); v += dpp_i<0x141>(v); v += dpp_i<0x140>(v);
    return (__builtin_amdgcn_readlane(v, 0) + __builtin_amdgcn_readlane(v, 16)) + (__builtin_amdgcn_readlane(v, 32) + __builtin_amdgcn_readlane(v, 48));
}
__device__ __forceinline__ unsigned wave_umax(unsigned v) {
    unsigned t; t = (unsigned)dpp_i<0xB1>((int)v); v = t > v ? t : v; t = (unsigned)dpp_i<0x4E>((int)v); v = t > v ? t : v; t = (unsigned)dpp_i<0x141>((int)v); v = t > v ? t : v; t = (unsigned)dpp_i<0x140>((int)v); v = t > v ? t : v;
    const unsigned a = (unsigned)__builtin_amdgcn_readlane((int)v, 0), b = (unsigned)__builtin_amdgcn_readlane((int)v, 16), c = (unsigned)__builtin_amdgcn_readlane((int)v, 32), d = (unsigned)__builtin_amdgcn_readlane((int)v, 48);
    const unsigned ab = a > b ? a : b, cd = c > d ? c : d; return ab > cd ? ab : cd;
}
__device__ __forceinline__ unsigned wave_umin(unsigned v) { return ~wave_umax(~v); }
__device__ __forceinline__ float half_sum(float v) {
    unsigned a, b; swap32(__builtin_bit_cast(unsigned, v), a, b); return __builtin_bit_cast(float, a) + __builtin_bit_cast(float, b);
}
__device__ __forceinline__ float half_max(float v) {
    unsigned a, b; swap32(__builtin_bit_cast(unsigned, v), a, b); return fmaxf(__builtin_bit_cast(float, a), __builtin_bit_cast(float, b));
}
namespace pg8 {
#define PG8_LAS __attribute__((address_space(3)))
typedef unsigned short bf16_t;
typedef short bf16x8 __attribute__((ext_vector_type(8)));
typedef float f32x4 __attribute__((ext_vector_type(4)));
typedef unsigned u32x4 __attribute__((ext_vector_type(4)));
constexpr int BM = 256, BK = 64, HALF = 128, HTB = HALF * BK * 2  , STAGE_BYTES = 8 * HTB, NXCD = 8, WGM = 8;

__host__ __device__ __forceinline__ int lds_byte(int r, int c) { const int st = (r >> 4) * 2 + (c >> 5), rr = r & 15, cc = c & 31, ob = rr * 64 + cc * 2; return st * 1024 + (ob ^ (((ob >> 9) & 1) << 5)); }
__host__ __device__ __forceinline__ void stage_rc(int b, int& R, int& C) { const int st = b / 1024, sb = b % 1024, swz = sb ^ (((sb >> 9) & 1) << 5); R = (st >> 1) * 16 + swz / 64; C = (st & 1) * 32 + (swz % 64) / 2; }
__host__ __device__ __forceinline__ int perm32(int rho) { const int n = rho >> 4, i = rho & 15; return 8 * (i >> 2) + 4 * n + (i & 3); }

struct Unit { int pm, pn; };
struct Gemm { const bf16_t* A; const bf16_t* Bt; int M, N, K, lda, ldb; };

struct StaticOrder {
    int nM, nN, nwg, G, c;
    __host__ __device__ void init(int M, int N, int G_, int c_) { nM = M / BM; nN = N / BM; nwg = nM * nN; G = G_; c = c_; }
    __host__ __device__ bool next(int i, Unit& u) const {
        const long L = (long)i * G + c; if (L >= nwg) return false;
        int wgid = (int)L; { const int q = nwg / NXCD, r = nwg % NXCD, xcd = wgid % NXCD, off = wgid / NXCD; wgid = (xcd < r ? xcd * (q + 1) : r * (q + 1) + (xcd - r) * q) + off; }
        const int nig = WGM * nN, gid = wgid / nig, fm = gid * WGM, gsz = (nM - fm) < WGM ? (nM - fm) : WGM;
        u.pm = fm + ((wgid % nig) % gsz); u.pn = (wgid % nig) / gsz; return true;
    }
    __device__ __forceinline__ void a_ready(const Unit&) const {}
    __device__ __forceinline__ void done(const Unit&) const {}
};

__device__ __forceinline__ unsigned cvt_pk_bf16(float lo, float hi) { unsigned r; asm volatile("v_cvt_pk_bf16_f32 %0, %1, %2" : "=v"(r) : "v"(lo), "v"(hi)); return r; }
__device__ __forceinline__ float bflo(unsigned w) { return __builtin_bit_cast(float, w << 16); }
__device__ __forceinline__ float bfhi(unsigned w) { return __builtin_bit_cast(float, w & 0xffff0000u); }
__device__ __forceinline__ float sigmoidf_(float x) { return __builtin_amdgcn_rcpf(1.0f + __builtin_amdgcn_exp2f(-1.4426950408889634f * x)); }

constexpr int ZP = 6656;
constexpr int ZSP = 512;
constexpr int NZT = 26, GATE_T0 = 14;

#define PRELOAD_RSTD(rsv, SS_, row0_) float rsv[2][4]; { f32x4 s_[2][4]; _Pragma("unroll") for (int ai_ = 0; ai_ < 2; ++ai_) _Pragma("unroll") for (int m_ = 0; m_ < 4; ++m_) s_[ai_][m_] = *(const f32x4*)((SS_) + (size_t)((row0_) + ai_ * HALF + m_ * 16) * 4); \
    _Pragma("unroll") for (int ai_ = 0; ai_ < 2; ++ai_) _Pragma("unroll") for (int m_ = 0; m_ < 4; ++m_) rsv[ai_][m_] = 1.0f / __builtin_sqrtf(((s_[ai_][m_][0] + s_[ai_][m_][1]) + (s_[ai_][m_][2] + s_[ai_][m_][3])) * (1.0f / 1024.0f) + 1e-6f); }
struct EpiZ {
    static constexpr bool PERM = true, AFTER_DRAIN = false, MID = false;
    bf16_t* Z; float* ZS; const float* SS; const float* GQ; const float* GK; const float* GD; const float* R64;
    __device__ __forceinline__ void operator()(const f32x4 (&acc)[2][2][4][2], const Unit& u, int wr, int wc, int fr, int fq) const {
        const int row0 = u.pm * BM + wr * 64 + fr;
        PRELOAD_RSTD(rsv, SS, row0);
        if (u.pn < 4 || u.pn == 6 || u.pn == 7) {
            const float osc = (u.pn < 4) ? 0.18033688011112042f : 1.0f; const bool rope = (u.pn == 2 || u.pn == 3);
            f32x4 g00, g01, g10, g11;
            if (u.pn < 2) { g00 = *(const f32x4*)(GQ + 8 * fq); g01 = *(const f32x4*)(GQ + 8 * fq + 4); g10 = *(const f32x4*)(GQ + 32 + 8 * fq); g11 = *(const f32x4*)(GQ + 32 + 8 * fq + 4); }
            else if (u.pn < 4) { g00 = *(const f32x4*)(GD + 8 * fq); g01 = *(const f32x4*)(GD + 8 * fq + 4); g10 = *(const f32x4*)(GD + 32 + 8 * fq); g11 = *(const f32x4*)(GD + 32 + 8 * fq + 4); }
            else { g00 = *(const f32x4*)(GK + 8 * fq); g01 = *(const f32x4*)(GK + 8 * fq + 4); g10 = *(const f32x4*)(GK + 32 + 8 * fq); g11 = *(const f32x4*)(GK + 32 + 8 * fq + 4); }
            const int colo = u.pn * BM + wc * 64 + 8 * fq;
#pragma unroll
            for (int ai = 0; ai < 2; ++ai)
#pragma unroll
                for (int m = 0; m < 4; ++m) { const int row = row0 + ai * HALF + m * 16; const float rs = rsv[ai][m];
                    f32x4 a0 = acc[ai][0][m][0] * rs, a1 = acc[ai][0][m][1] * rs, b0 = acc[ai][1][m][0] * rs, b1 = acc[ai][1][m][1] * rs;
                    float ss = ((a0[0] * a0[0] + a0[1] * a0[1]) + (a0[2] * a0[2] + a0[3] * a0[3])) + ((a1[0] * a1[0] + a1[1] * a1[1]) + (a1[2] * a1[2] + a1[3] * a1[3]))
                             + ((b0[0] * b0[0] + b0[1] * b0[1]) + (b0[2] * b0[2] + b0[3] * b0[3])) + ((b1[0] * b1[0] + b1[1] * b1[1]) + (b1[2] * b1[2] + b1[3] * b1[3]));
                    ss += sx<16>(ss); { unsigned x_, y_; swap32(__builtin_bit_cast(unsigned, ss), x_, y_); ss = __builtin_bit_cast(float, x_) + __builtin_bit_cast(float, y_); }
                    const float hr = osc / __builtin_sqrtf(ss * (1.0f / 64.0f) + 1e-6f);
                    a0 = a0 * g00 * hr; a1 = a1 * g01 * hr; b0 = b0 * g10 * hr; b1 = b1 * g11 * hr;
                    if (rope) { const float* cs = R64 + ((size_t)(row & 4095) * 32 + 8 * fq) * 2;
                        const f32x4 c0 = *(const f32x4*)cs, c1 = *(const f32x4*)(cs + 4), c2 = *(const f32x4*)(cs + 8), c3 = *(const f32x4*)(cs + 12);
                        f32x4 x0, x1, y0, y1;
                        x0[0] = a0[0] * c0[0] - b0[0] * c0[1]; y0[0] = b0[0] * c0[0] + a0[0] * c0[1]; x0[1] = a0[1] * c0[2] - b0[1] * c0[3]; y0[1] = b0[1] * c0[2] + a0[1] * c0[3];
                        x0[2] = a0[2] * c1[0] - b0[2] * c1[1]; y0[2] = b0[2] * c1[0] + a0[2] * c1[1]; x0[3] = a0[3] * c1[2] - b0[3] * c1[3]; y0[3] = b0[3] * c1[2] + a0[3] * c1[3];
                        x1[0] = a1[0] * c2[0] - b1[0] * c2[1]; y1[0] = b1[0] * c2[0] + a1[0] * c2[1]; x1[1] = a1[1] * c2[2] - b1[1] * c2[3]; y1[1] = b1[1] * c2[2] + a1[1] * c2[3];
                        x1[2] = a1[2] * c3[0] - b1[2] * c3[1]; y1[2] = b1[2] * c3[0] + a1[2] * c3[1]; x1[3] = a1[3] * c3[2] - b1[3] * c3[3]; y1[3] = b1[3] * c3[2] + a1[3] * c3[3];
                        a0 = x0; a1 = x1; b0 = y0; b1 = y1; }
                    bf16_t* rowp = Z + (size_t)row * ZP + colo;
                    u32x4 w; w.x = cvt_pk_bf16(a0[0], a0[1]); w.y = cvt_pk_bf16(a0[2], a0[3]); w.z = cvt_pk_bf16(a1[0], a1[1]); w.w = cvt_pk_bf16(a1[2], a1[3]); *(u32x4*)rowp = w;
                    w.x = cvt_pk_bf16(b0[0], b0[1]); w.y = cvt_pk_bf16(b0[2], b0[3]); w.z = cvt_pk_bf16(b1[0], b1[1]); w.w = cvt_pk_bf16(b1[2], b1[3]); *(u32x4*)(rowp + 32) = w;
                    __builtin_amdgcn_sched_barrier(0); }
        } else if (u.pn < NZT) {
            const int col0 = u.pn * BM + wc * 32 + 8 * fq;
#pragma unroll
            for (int ai = 0; ai < 2; ++ai)
#pragma unroll
                for (int m = 0; m < 4; ++m) { bf16_t* rowp = Z + (size_t)(row0 + ai * HALF + m * 16) * ZP + col0; const float rs = rsv[ai][m];
#pragma unroll
                    for (int bj = 0; bj < 2; ++bj) { f32x4 v0 = acc[ai][bj][m][0] * rs, v1 = acc[ai][bj][m][1] * rs;
                        if (u.pn >= GATE_T0) {
#pragma unroll
                            for (int i = 0; i < 4; ++i) { v0[i] = sigmoidf_(v0[i]); v1[i] = sigmoidf_(v1[i]); } }
                        u32x4 w; w.x = cvt_pk_bf16(v0[0], v0[1]); w.y = cvt_pk_bf16(v0[2], v0[3]); w.z = cvt_pk_bf16(v1[0], v1[1]); w.w = cvt_pk_bf16(v1[2], v1[3]);
                        *(u32x4*)(rowp + bj * HALF) = w; } }
        } else {
            const int col0 = (u.pn - NZT) * BM + wc * 32 + 8 * fq;
#pragma unroll
            for (int ai = 0; ai < 2; ++ai)
#pragma unroll
                for (int m = 0; m < 4; ++m) { float* rowp = ZS + (size_t)(row0 + ai * HALF + m * 16) * ZSP + col0; const float rs = rsv[ai][m];
#pragma unroll
                    for (int bj = 0; bj < 2; ++bj) { *(f32x4*)(rowp + bj * HALF) = acc[ai][bj][m][0] * rs; *(f32x4*)(rowp + bj * HALF + 4) = acc[ai][bj][m][1] * rs; } }
        }
    }
};

template <int P> struct EpiGate {
    static constexpr bool PERM = true, AFTER_DRAIN = false, MID = false;
    const bf16_t* G;
    float* M32;
    bf16_t* OUT;
    __device__ __forceinline__ void operator()(const f32x4 (&acc)[2][2][4][2], const Unit& u, int wr, int wc, int fr, int fq) const {
        const int row0 = u.pm * BM + wr * 64 + fr, col0 = u.pn * BM + wc * 32 + 8 * fq;
#pragma unroll
        for (int ai = 0; ai < 2; ++ai)
#pragma unroll
            for (int m = 0; m < 4; ++m) { const size_t row = (size_t)(row0 + ai * HALF + m * 16);
#pragma unroll
                for (int bj = 0; bj < 2; ++bj) { const int col = col0 + bj * HALF;
                    const u32x4 gw = *(const u32x4*)(G + row * ZP + P * 1024 + col);
                    const f32x4 v0 = acc[ai][bj][m][0], v1 = acc[ai][bj][m][1];
                    f32x4 t0, t1;
                    t0[0] = bflo(gw.x) * v0[0]; t0[1] = bfhi(gw.x) * v0[1]; t0[2] = bflo(gw.y) * v0[2]; t0[3] = bfhi(gw.y) * v0[3];
                    t1[0] = bflo(gw.z) * v1[0]; t1[1] = bfhi(gw.z) * v1[1]; t1[2] = bflo(gw.w) * v1[2]; t1[3] = bfhi(gw.w) * v1[3];
                    float* mp = M32 + row * 1024 + col;
                    if (P == 0) { *(f32x4*)mp = t0; *(f32x4*)(mp + 4) = t1; }
                    else if (P == 1) { *(f32x4*)mp = *(const f32x4*)mp + t0; *(f32x4*)(mp + 4) = *(const f32x4*)(mp + 4) + t1; }
                    else { t0 = *(const f32x4*)mp + t0; t1 = *(const f32x4*)(mp + 4) + t1;
                        u32x4 w; w.x = cvt_pk_bf16(t0[0], t0[1]); w.y = cvt_pk_bf16(t0[2], t0[3]); w.z = cvt_pk_bf16(t1[0], t1[1]); w.w = cvt_pk_bf16(t1[2], t1[3]);
                        *(u32x4*)(OUT + row * ZP + col) = w; } } }
    }
};

struct EpiGateF {
    static constexpr bool PERM = true, AFTER_DRAIN = false, MID = true;
    const bf16_t* G; bf16_t* OUT;
    __device__ __forceinline__ void mid(f32x4 (&acc)[2][2][4][2], const Unit& u, int wr, int wc, int fr_, int fq_, int s) const {
        int fr = fr_, fq = fq_; asm volatile("" : "+v"(fr), "+v"(fq));
        const int row0 = u.pm * BM + wr * 64 + fr, col0 = u.pn * BM + wc * 32 + 8 * fq;
#pragma unroll
        for (int ai = 0; ai < 2; ++ai) {
            u32x4 ga[4][2], gb[4][2];
#pragma unroll
            for (int m = 0; m < 4; ++m)
#pragma unroll
                for (int bj = 0; bj < 2; ++bj) { const bf16_t* gp = G + (size_t)(row0 + ai * HALF + m * 16) * ZP + s * 1024 + col0 + bj * HALF; ga[m][bj] = *(const u32x4*)gp; gb[m][bj] = *(const u32x4*)(gp + 1024); }
#pragma unroll
            for (int m = 0; m < 4; ++m)
#pragma unroll
                for (int bj = 0; bj < 2; ++bj) { const u32x4 a = ga[m][bj], b = gb[m][bj]; f32x4 r0, r1;
                    r0[0] = bflo(a.x) * __builtin_amdgcn_rcpf(__builtin_fmaxf(bflo(b.x), 1e-30f)); r0[1] = bfhi(a.x) * __builtin_amdgcn_rcpf(__builtin_fmaxf(bfhi(b.x), 1e-30f)); r0[2] = bflo(a.y) * __builtin_amdgcn_rcpf(__builtin_fmaxf(bflo(b.y), 1e-30f)); r0[3] = bfhi(a.y) * __builtin_amdgcn_rcpf(__builtin_fmaxf(bfhi(b.y), 1e-30f));
                    r1[0] = bflo(a.z) * __builtin_amdgcn_rcpf(__builtin_fmaxf(bflo(b.z), 1e-30f)); r1[1] = bfhi(a.z) * __builtin_amdgcn_rcpf(__builtin_fmaxf(bfhi(b.z), 1e-30f)); r1[2] = bflo(a.w) * __builtin_amdgcn_rcpf(__builtin_fmaxf(bflo(b.w), 1e-30f)); r1[3] = bfhi(a.w) * __builtin_amdgcn_rcpf(__builtin_fmaxf(bfhi(b.w), 1e-30f));
                    acc[ai][bj][m][0] = acc[ai][bj][m][0] * r0; acc[ai][bj][m][1] = acc[ai][bj][m][1] * r1; }
            __builtin_amdgcn_sched_barrier(0); }
    }
    __device__ __forceinline__ void operator()(const f32x4 (&acc)[2][2][4][2], const Unit& u, int wr, int wc, int fr, int fq) const {
        const int row0 = u.pm * BM + wr * 64 + fr, col0 = u.pn * BM + wc * 32 + 8 * fq;
#pragma unroll
        for (int ai = 0; ai < 2; ++ai)
#pragma unroll
            for (int m = 0; m < 4; ++m) { const size_t row = (size_t)(row0 + ai * HALF + m * 16);
#pragma unroll
                for (int bj = 0; bj < 2; ++bj) { const int col = col0 + bj * HALF;
                    const u32x4 gw = *(const u32x4*)(G + row * ZP + 2 * 1024 + col);
                    const f32x4 v0 = acc[ai][bj][m][0], v1 = acc[ai][bj][m][1];
                    u32x4 w; w.x = cvt_pk_bf16(bflo(gw.x) * v0[0], bfhi(gw.x) * v0[1]); w.y = cvt_pk_bf16(bflo(gw.y) * v0[2], bfhi(gw.y) * v0[3]);
                    w.z = cvt_pk_bf16(bflo(gw.z) * v1[0], bfhi(gw.z) * v1[1]); w.w = cvt_pk_bf16(bflo(gw.w) * v1[2], bfhi(gw.w) * v1[3]);
                    *(u32x4*)(OUT + row * ZP + col) = w; } }
    }
};

struct EpiRes {
    static constexpr bool PERM = true, AFTER_DRAIN = true, MID = false;
    const bf16_t* RES; bf16_t* OUT; float* OUT32; float* SS;
    __device__ __forceinline__ void fused(const f32x4 (&acc)[2][2][4][2], const Unit& u, int wr, int wc, int fr, int fq, PG8_LAS unsigned char* lds, int wid, int lane) const {
        const int row0 = u.pm * BM + wr * 64 + fr, col0 = u.pn * BM + wc * 32 + 8 * fq;
        PG8_LAS float* P = (PG8_LAS float*)lds;
#pragma unroll
        for (int ai = 0; ai < 2; ++ai)
#pragma unroll
            for (int m = 0; m < 4; ++m) { const int row = row0 + ai * HALF + m * 16; const size_t off = (size_t)row * 1024 + col0; float ss = 0.f;
#pragma unroll
                for (int bj = 0; bj < 2; ++bj) { const u32x4 r = *(const u32x4*)(RES + off + bj * HALF);
                    f32x4 v0 = acc[ai][bj][m][0], v1 = acc[ai][bj][m][1];
                    v0[0] += bflo(r.x); v0[1] += bfhi(r.x); v0[2] += bflo(r.y); v0[3] += bfhi(r.y); v1[0] += bflo(r.z); v1[1] += bfhi(r.z); v1[2] += bflo(r.w); v1[3] += bfhi(r.w);
                    ss += ((v0[0] * v0[0] + v0[1] * v0[1]) + (v0[2] * v0[2] + v0[3] * v0[3])) + ((v1[0] * v1[0] + v1[1] * v1[1]) + (v1[2] * v1[2] + v1[3] * v1[3]));
                    if (OUT32) { float* op = OUT32 + off + bj * HALF; *(f32x4*)op = v0; *(f32x4*)(op + 4) = v1; }
                    else { u32x4 w; w.x = cvt_pk_bf16(v0[0], v0[1]); w.y = cvt_pk_bf16(v0[2], v0[3]); w.z = cvt_pk_bf16(v1[0], v1[1]); w.w = cvt_pk_bf16(v1[2], v1[3]); *(u32x4*)(OUT + off + bj * HALF) = w; } }
                ss += sx<16>(ss); { unsigned a, b; swap32(__builtin_bit_cast(unsigned, ss), a, b); ss = __builtin_bit_cast(float, a) + __builtin_bit_cast(float, b); }
                if (fq == 0) P[(ai * HALF + wr * 64 + m * 16 + fr) * 4 + wc] = ss; }
        asm volatile("s_waitcnt lgkmcnt(0)\n\ts_barrier" ::: "memory");
        const int t = wid * 64 + lane;
        if (t < 256) { const f32x4 p = *(const PG8_LAS f32x4*)(P + t * 4); SS[(size_t)(u.pm * BM + t) * 4 + u.pn] = (p[0] + p[1]) + (p[2] + p[3]); }
    }
};

struct EpiSwi {
    static constexpr bool PERM = true, AFTER_DRAIN = false, MID = false;
    bf16_t* H; int ldh; const float* SS;
    __device__ __forceinline__ void operator()(const f32x4 (&acc)[2][2][4][2], const Unit& u, int wr, int wc, int fr, int fq) const {
        const int row0 = u.pm * BM + wr * 64 + fr, col0 = u.pn * HALF + wc * 32 + 8 * fq;
        PRELOAD_RSTD(rsv, SS, row0);
#pragma unroll
        for (int ai = 0; ai < 2; ++ai)
#pragma unroll
            for (int m = 0; m < 4; ++m) { bf16_t* hp = H + (size_t)(row0 + ai * HALF + m * 16) * ldh + col0; const float rs = rsv[ai][m];
                float o[8];
#pragma unroll
                for (int n = 0; n < 2; ++n)
#pragma unroll
                    for (int i = 0; i < 4; ++i) { const float g = acc[ai][0][m][n][i] * rs, up = acc[ai][1][m][n][i] * rs; o[4 * n + i] = g * sigmoidf_(g) * up; }
                u32x4 w; w.x = cvt_pk_bf16(o[0], o[1]); w.y = cvt_pk_bf16(o[2], o[3]); w.z = cvt_pk_bf16(o[4], o[5]); w.w = cvt_pk_bf16(o[6], o[7]);
                *(u32x4*)hp = w; }
    }
};

template <class Epi, class Sched, bool ALIGN_EPI = false, bool SP2 = false>
__device__ __forceinline__ void gemm_phase(PG8_LAS unsigned char* lds, Gemm g, const Sched& S0, const Epi& E, int wave_id) {
    int ovz, osz; asm volatile("v_mov_b32 %0, 0\n\ts_mov_b32 %1, 0" : "=v"(ovz), "=s"(osz));
    Sched S = S0; S.c += osz; g.lda += osz; g.ldb += osz;
    const int tid = ((wave_id << 6) | lane_id_v()) + ovz,
         wid = __builtin_amdgcn_readfirstlane(tid >> 6), lane = tid & 63, wr = wid >> 2, wc = wid & 3, fr = lane & 15, fq = lane >> 4;
    const int K = g.K, nt = K / BK;
    unsigned voffA[2], voffB[2];
#pragma unroll
    for (int i = 0; i < 2; ++i) { int R, C; stage_rc(tid * 16 + i * 8192, R, C); const int Rb = Epi::PERM ? ((R & ~31) + perm32(R & 31)) : R;
        voffA[i] = (unsigned)(R * g.lda + C) * 2u; voffB[i] = (unsigned)(Rb * g.ldb + C) * 2u; }
    const size_t kstep = (size_t)(BK * 2);
    const size_t hstepA = (size_t)HALF * g.lda * 2, hstepB = (size_t)HALF * g.ldb * 2;
    const size_t tstepA = 2 * hstepA, tstepB = 2 * hstepB;
    const unsigned ldsw = (unsigned)wid * 1024u;
    const int aoff = lds_byte(wr * 64 + fr, fq * 8), boff = lds_byte(wc * 32 + fr, fq * 8);
#define PG8_SA(b, h) (((b) * 2 + (h)) * HTB)
#define PG8_SB(b, h) ((4 + (b) * 2 + (h)) * HTB)
#define PG8_STAGE(bufoff, gbase, voff) do { _Pragma("unroll") for (int _i = 0; _i < 2; ++_i) \
        __builtin_amdgcn_global_load_lds((const unsigned*)((const char*)(gbase) + (voff)[_i]), (PG8_LAS unsigned*)(lds + (bufoff) + ldsw + _i * 8192), 16, 0, 0); } while (0)
#define PG8_LDA(dst, b, h) do { _Pragma("unroll") for (int m = 0; m < 4; ++m) _Pragma("unroll") for (int k = 0; k < 2; ++k) dst[m][k] = *(const PG8_LAS bf16x8*)(lds + PG8_SA(b, h) + aoff + m * 2048 + k * 1024); } while (0)
#define PG8_LDB(dst, b, h) do { _Pragma("unroll") for (int n = 0; n < 2; ++n) _Pragma("unroll") for (int k = 0; k < 2; ++k) dst[n][k] = *(const PG8_LAS bf16x8*)(lds + PG8_SB(b, h) + boff + n * 2048 + k * 1024); } while (0)
#define PG8_MMA(ai, bj, At, Bt) do { __builtin_amdgcn_s_setprio(1); _Pragma("unroll") for (int m = 0; m < 4; ++m) _Pragma("unroll") for (int n = 0; n < 2; ++n) _Pragma("unroll") for (int k = 0; k < 2; ++k) \
        acc[ai][bj][m][n] = __builtin_amdgcn_mfma_f32_16x16x32_bf16(Bt[n][k], At[m][k], acc[ai][bj][m][n], 0, 0, 0); __builtin_amdgcn_s_setprio(0); } while (0)
#define PG8_WAIT_V(n) asm volatile("s_waitcnt vmcnt(" #n ")" ::: "memory")
#define PG8_WAIT_L(n) asm volatile("s_waitcnt lgkmcnt(" #n ")" ::: "memory")
#define PG8_BAR __builtin_amdgcn_s_barrier()
#define PG8_SCHED __builtin_amdgcn_sched_barrier(0)
    Unit cur, nxt; int ui = 0;
    if (!S.next(0, cur)) return;
    f32x4 acc[2][2][4][2];
#pragma unroll
    for (int a = 0; a < 2; ++a)
#pragma unroll
        for (int b = 0; b < 2; ++b)
#pragma unroll
            for (int m = 0; m < 4; ++m)
#pragma unroll
                for (int n = 0; n < 2; ++n) acc[a][b][m][n] = (f32x4){0.f, 0.f, 0.f, 0.f};
    bf16x8 At[4][2], B0[2][2], B1[2][2];
    const char* cA = (const char*)g.A + (size_t)cur.pm * tstepA; const char* cB = (const char*)g.Bt + (size_t)cur.pn * tstepB;
    S.a_ready(cur);
    if constexpr (SP2) {
        PG8_STAGE(PG8_SB(0, 0), cB, voffB); PG8_STAGE(PG8_SB(0, 1), cB + hstepB, voffB); PG8_STAGE(PG8_SA(0, 0), cA, voffA); PG8_STAGE(PG8_SA(0, 1), cA + hstepA, voffA);
        if (wr == 1) PG8_BAR;
        PG8_WAIT_V(2); PG8_BAR;
        PG8_STAGE(PG8_SB(1, 0), cB + kstep, voffB); PG8_STAGE(PG8_SA(1, 0), cA + kstep, voffA); PG8_STAGE(PG8_SB(1, 1), cB + hstepB + kstep, voffB);
        PG8_WAIT_V(6); PG8_BAR;
    } else {
        PG8_STAGE(PG8_SB(0, 0), cB, voffB); PG8_STAGE(PG8_SA(0, 0), cA, voffA); PG8_STAGE(PG8_SB(0, 1), cB + hstepB, voffB); PG8_STAGE(PG8_SA(0, 1), cA + hstepA, voffA);
        if (wr == 1) PG8_BAR;
        PG8_WAIT_V(4); PG8_BAR;
        PG8_STAGE(PG8_SB(1, 0), cB + kstep, voffB); PG8_STAGE(PG8_SA(1, 0), cA + kstep, voffA); PG8_STAGE(PG8_SB(1, 1), cB + hstepB + kstep, voffB);
        PG8_WAIT_V(6); PG8_BAR;
    }
    for (;;) {
        const bool has_next = S.next(ui + 1, nxt);
        const char* nA = has_next ? (const char*)g.A + (size_t)nxt.pm * tstepA : cA; const char* nB = has_next ? (const char*)g.Bt + (size_t)nxt.pn * tstepB : cB;
        for (int t = 0; t < nt; t += 2) {
            if constexpr (Epi::MID) { if (t == 8 || t == 16) E.mid(acc, cur, wr, wc, fr, fq, (t >> 3) - 1); }
            const bool last = (t == nt - 2);
            const char* a1 = cA + (size_t)(t + 1) * kstep;
            const char* a2 = last ? nA : cA + (size_t)(t + 2) * kstep; const char* b2 = last ? nB : cB + (size_t)(t + 2) * kstep;
            const char* a3 = a2 + kstep; const char* b3 = b2 + kstep;
            if (last && has_next) S.a_ready(nxt);
            if constexpr (SP2) {
            PG8_LDB(B0, 0, 0); PG8_LDB(B1, 0, 1); PG8_SCHED; PG8_LDA(At, 0, 0); PG8_STAGE(PG8_SA(1, 1), a1 + hstepA, voffA);
            PG8_WAIT_V(8); PG8_WAIT_L(0); PG8_BAR; PG8_MMA(0, 0, At, B0); PG8_MMA(0, 1, At, B1); PG8_BAR; PG8_SCHED;
            PG8_LDA(At, 0, 1); PG8_STAGE(PG8_SB(0, 0), b2, voffB); PG8_STAGE(PG8_SB(0, 1), b2 + hstepB, voffB); PG8_STAGE(PG8_SA(0, 0), a2, voffA);
            PG8_WAIT_V(8); PG8_WAIT_L(0); PG8_BAR; PG8_MMA(1, 0, At, B0); PG8_MMA(1, 1, At, B1); PG8_BAR; PG8_SCHED;
            PG8_LDB(B0, 1, 0); PG8_LDB(B1, 1, 1); PG8_SCHED; PG8_LDA(At, 1, 0); PG8_STAGE(PG8_SA(0, 1), a2 + hstepA, voffA);
            PG8_WAIT_V(8); PG8_WAIT_L(0); PG8_BAR; PG8_MMA(0, 0, At, B0); PG8_MMA(0, 1, At, B1); PG8_BAR; PG8_SCHED;
            PG8_LDA(At, 1, 1); PG8_STAGE(PG8_SB(1, 0), b3, voffB); PG8_STAGE(PG8_SB(1, 1), b3 + hstepB, voffB); PG8_STAGE(PG8_SA(1, 0), a3, voffA);
            PG8_WAIT_V(8); PG8_WAIT_L(0); PG8_BAR; PG8_MMA(1, 0, At, B0); PG8_MMA(1, 1, At, B1); PG8_BAR; PG8_SCHED;
            } else {
            PG8_LDB(B0, 0, 0); PG8_SCHED; PG8_LDA(At, 0, 0); PG8_STAGE(PG8_SA(1, 1), a1 + hstepA, voffA);
            PG8_WAIT_L(8); PG8_BAR; PG8_WAIT_L(0); PG8_MMA(0, 0, At, B0); PG8_BAR; PG8_SCHED;
            PG8_LDB(B1, 0, 1); PG8_STAGE(PG8_SB(0, 0), b2, voffB);
            PG8_BAR; PG8_WAIT_L(0); PG8_MMA(0, 1, At, B1); PG8_BAR;
            PG8_LDA(At, 0, 1); PG8_STAGE(PG8_SA(0, 0), a2, voffA);
            PG8_BAR; PG8_WAIT_L(0); PG8_MMA(1, 0, At, B0); PG8_BAR; PG8_SCHED;
            PG8_STAGE(PG8_SB(0, 1), b2 + hstepB, voffB);
            PG8_WAIT_V(6); PG8_BAR; PG8_MMA(1, 1, At, B1); PG8_BAR;
            PG8_LDB(B0, 1, 0); PG8_SCHED; PG8_LDA(At, 1, 0); PG8_STAGE(PG8_SA(0, 1), a2 + hstepA, voffA);
            PG8_WAIT_L(8); PG8_BAR; PG8_WAIT_L(0); PG8_MMA(0, 0, At, B0); PG8_BAR; PG8_SCHED;
            PG8_LDB(B1, 1, 1); PG8_STAGE(PG8_SB(1, 0), b3, voffB);
            PG8_BAR; PG8_WAIT_L(0); PG8_MMA(0, 1, At, B1); PG8_BAR;
            PG8_LDA(At, 1, 1); PG8_STAGE(PG8_SA(1, 0), a3, voffA);
            PG8_BAR; PG8_WAIT_L(0); PG8_MMA(1, 0, At, B0); PG8_BAR; PG8_SCHED;
            PG8_STAGE(PG8_SB(1, 1), b3 + hstepB, voffB);
            PG8_WAIT_V(6); PG8_BAR; PG8_MMA(1, 1, At, B1); PG8_BAR;
            }
        }
        if constexpr (ALIGN_EPI) { if (wr == 0) PG8_BAR; }
        if constexpr (!Epi::AFTER_DRAIN) { E(acc, cur, wr, wc, fr, fq); S.done(cur); }
        if (!has_next) break;
#pragma unroll
        for (int a = 0; a < 2; ++a)
#pragma unroll
            for (int b = 0; b < 2; ++b)
#pragma unroll
                for (int m = 0; m < 4; ++m)
#pragma unroll
                    for (int n = 0; n < 2; ++n) acc[a][b][m][n] = (f32x4){0.f, 0.f, 0.f, 0.f};
        cur = nxt; cA = nA; cB = nB; ++ui;
        if constexpr (ALIGN_EPI) { if (wr == 1) PG8_BAR; }
    }
    PG8_WAIT_V(0);
    if constexpr (!ALIGN_EPI) { if (wr == 0) PG8_BAR; }
    PG8_BAR;
    if constexpr (Epi::AFTER_DRAIN) { E.fused(acc, cur, wr, wc, fr, fq, lds, wid, lane); S.done(cur); }
#undef PG8_SA
#undef PG8_SB
#undef PG8_STAGE
#undef PG8_LDA
#undef PG8_LDB
#undef PG8_MMA
#undef PG8_WAIT_V
#undef PG8_WAIT_L
#undef PG8_BAR
#undef PG8_SCHED
}
}

constexpr int NB = 4, SEQ = 4096, DM = 1024, DEPTH = 4, M = NB * SEQ;
constexpr int INC = 7088;
constexpr int NIN = 7168;
constexpr int FFH = 2816, FF2 = 5632;
constexpr int ZP = pg8::ZP, ZSP = pg8::ZSP;
constexpr int Z_FQ = 0, Z_DQ = 512, Z_RV = 1024, Z_FK = 1536, Z_FV = 2048,
     Z_RQ = 2560, Z_RK = 2816, Z_RG = 3072, Z_ZG = 3584, Z_MRG = 2560;
constexpr int S_IQ = 0, S_DK = 256, S_DV = 320, S_IK = 384, S_IW = 416, S_FF = 424;
constexpr float NORM_EPS = 1e-6f;
constexpr float LOG2E = 1.4426950408889634f;
constexpr float C2 = 0.125f * 1.4426950408889634f;

constexpr size_t MiB = 1u << 20;
constexpr size_t WS_CTL = 0, CTL_ZERO_BYTES = 1 * MiB;
constexpr size_t WS_ROPE64 = 1 * MiB;
constexpr size_t WS_ROPE32 = 2 * MiB;
constexpr size_t WS_LF = 2 * MiB + 512 * 1024;
constexpr size_t WS_CF = 3 * MiB;
constexpr size_t WS_ISG = 3 * MiB + 512 * 1024;
constexpr size_t WS_KD = 4 * MiB;
constexpr size_t WS_VD = 6 * MiB;
constexpr size_t WS_W = 8 * MiB;
constexpr size_t LW_IN = 0, LW_MIX = (size_t)NIN * 1024, LW_O = LW_MIX + 1536 * 1024, LW_FI = LW_O + 1024 * 1024, LW_FO = LW_FI + (size_t)FF2 * 1024, LW_STRIDE = LW_FO + (size_t)FFH * 1024;
constexpr size_t WS_Z = 150 * MiB;
constexpr size_t WS_HDN = 358 * MiB;
constexpr size_t WS_ZS = 390 * MiB;
constexpr size_t WS_IQB = 422 * MiB;
constexpr size_t WS_IKB = 430 * MiB;
constexpr size_t WS_SS = 431 * MiB;
constexpr size_t WS_END = 432 * MiB;
static_assert(WS_W + DEPTH * LW_STRIDE * 2 <= WS_Z && WS_Z + (size_t)M * ZP * 2 <= WS_HDN && WS_HDN + (size_t)M * 1024 * 2 == WS_ZS && WS_ZS + (size_t)M * ZSP * 4 == WS_IQB, "d_ws map");
constexpr int CW_BAR = 4096;

constexpr int RING_OFF = 0, RING_BYTES = 133120;
constexpr int LDSCTL_OFF = RING_BYTES, MISC_OFF = LDSCTL_OFF + 320;
constexpr int XTRA_OFF = RING_BYTES + 1024;
constexpr int LDS_BYTES = 147456;
constexpr int NWAVES = 8;
#define GAS __attribute__((address_space(1)))
#define LAS __attribute__((address_space(3)))
typedef unsigned short bf16;
typedef unsigned v4u __attribute__((ext_vector_type(4)));
typedef float f32x4 __attribute__((ext_vector_type(4)));
typedef short bf16x8 __attribute__((ext_vector_type(8)));
typedef GAS unsigned gu32;
typedef GAS unsigned long long gu64;
#define RLX_AGENT __ATOMIC_RELAXED, __HIP_MEMORY_SCOPE_AGENT
#define LDS_WAIT() asm volatile("s_waitcnt lgkmcnt(0)" ::: "memory")
#define VM_WAIT() asm volatile("s_waitcnt vmcnt(0)" ::: "memory")
__device__ __forceinline__ unsigned long long rt() { return __builtin_amdgcn_s_memrealtime(); }
__device__ __forceinline__ unsigned f2bf(float f) { unsigned u = __builtin_bit_cast(unsigned, f); return (u + 0x7fffu + ((u >> 16) & 1u)) >> 16; }
__device__ __forceinline__ unsigned pk2(float lo, float hi) { unsigned r; asm("v_cvt_pk_bf16_f32 %0, %1, %2" : "=v"(r) : "v"(lo), "v"(hi)); return r; }

#define XB_TMO      128
#define XB_XCNT(j)  (256  + 64 * (j))
#define XB_XSUB(j)  (1280 + 64 * (j))
#define XB_XGEN(j)  (2304 + 64 * (j))
#define XB_TOP      3328
#define XB_TOPGEN   3392
#define XCD_BAR_WORDS 3456
#define XB_SPIN_CAP (1u << 22)

__device__ __forceinline__ unsigned xb_ld(unsigned* p)              { return __hip_atomic_load(p, __ATOMIC_RELAXED, __HIP_MEMORY_SCOPE_AGENT); }
__device__ __forceinline__ unsigned xb_add(unsigned* p, unsigned v) { return __hip_atomic_fetch_add(p, v, __ATOMIC_RELAXED, __HIP_MEMORY_SCOPE_AGENT); }
__device__ __forceinline__ unsigned xb_xcc_id() { return (unsigned)__builtin_amdgcn_s_getreg((3 << 11) | 20) & 0xFu; }
#define XB_SPIN(cond, bar) do { unsigned _sp = 0; while (cond) { __builtin_amdgcn_s_sleep(1); \
    if ((++_sp & 255u) == 0u) { if (xb_ld(&(bar)[XB_TMO])) break; if (_sp > XB_SPIN_CAP) { atomicAdd(&(bar)[XB_TMO], 1u); break; } } } } while (0)

struct XcdBarrier {
    unsigned* bar; unsigned x; int w;
    volatile LAS unsigned* st;
};

__device__ __forceinline__ XcdBarrier xcd_barrier_post(unsigned* bar, volatile LAS unsigned* st) {
    XcdBarrier b; b.bar = bar; b.x = xb_xcc_id(); b.st = st; b.w = 0;
    if (threadIdx.x == 0) (void)xb_add(&bar[XB_XCNT(b.x)], 1u);
    return b;
}
__device__ __forceinline__ void xcd_barrier_complete(unsigned* bar, unsigned x, unsigned& nloc, unsigned& nx) {
    const unsigned G = gridDim.x * gridDim.y * gridDim.z;
    unsigned sum, cnt, mine, sp = 0u;
    for (;;) {
        sum = 0u; cnt = 0u; mine = 0u;
#pragma unroll
        for (unsigned j = 0; j < 16; ++j) { const unsigned c = xb_ld(&bar[XB_XCNT(j)]); sum += c; cnt += (c > 0u) ? 1u : 0u; mine = (j == x) ? c : mine; }
        if (sum == G) break;
        __builtin_amdgcn_s_sleep(1);
        if ((++sp & 255u) == 0u) { if (xb_ld(&bar[XB_TMO])) break; if (sp > XB_SPIN_CAP) { atomicAdd(&bar[XB_TMO], 1u); break; } }
    }
    nloc = mine > 0u ? mine : 1u; nx = cnt > 0u ? cnt : 1u;
}

__device__ __forceinline__ void xcd_barrier(const XcdBarrier& b) {
    asm volatile("s_waitcnt vmcnt(0)" ::: "memory");
    __syncthreads();
    if (b.w == 0 && lane_id_v() == 0) {
        unsigned* bar = b.bar;
        __builtin_amdgcn_s_waitcnt(0);
        unsigned nloc = b.st[0], nx = b.st[1];
        if (nloc == 0u) { xcd_barrier_complete(bar, b.x, nloc, nx); b.st[0] = nloc; b.st[1] = nx; }
        const unsigned old = xb_add(&bar[XB_XSUB(b.x)], 1u);
        const unsigned gen = old / nloc;
        if (old + 1u == (gen + 1u) * nloc) {
            __builtin_amdgcn_fence(__ATOMIC_RELEASE, "agent");
            asm volatile("s_waitcnt vmcnt(0)" ::: "memory");
            const unsigned og = xb_add(&bar[XB_TOP], 1u);
            const unsigned tg = og / nx;
            if (og + 1u == (tg + 1u) * nx) xb_add(&bar[XB_TOPGEN], 1u);
            else XB_SPIN(xb_ld(&bar[XB_TOPGEN]) == tg, bar);
            __builtin_amdgcn_fence(__ATOMIC_ACQUIRE, "agent");
            xb_add(&bar[XB_XGEN(b.x)], 1u);
            asm volatile("s_waitcnt vmcnt(0)" ::: "memory");
        } else {
            XB_SPIN(xb_ld(&bar[XB_XGEN(b.x)]) == gen, bar);
            __builtin_amdgcn_fence(__ATOMIC_ACQUIRE, "agent");
            asm volatile("s_waitcnt vmcnt(0)" ::: "memory");
        }
    }
    __syncthreads();
}

typedef float f32x2 __attribute__((ext_vector_type(2)));
typedef unsigned u32x2 __attribute__((ext_vector_type(2)));
__device__ __forceinline__ float bflo(unsigned w) { return __builtin_bit_cast(float, w << 16); }
__device__ __forceinline__ float bfhi(unsigned w) { return __builtin_bit_cast(float, w & 0xffff0000u); }
__device__ __forceinline__ float bf2f(bf16 v) { return __builtin_bit_cast(float, (unsigned)v << 16); }
__device__ __forceinline__ void unpack8(const v4u w, float (&f)[8]) { f[0] = bflo(w.x); f[1] = bfhi(w.x); f[2] = bflo(w.y); f[3] = bfhi(w.y); f[4] = bflo(w.z); f[5] = bfhi(w.z); f[6] = bflo(w.w); f[7] = bfhi(w.w); }
__device__ __forceinline__ v4u pack8(const float (&f)[8]) { v4u w; w.x = pk2(f[0], f[1]); w.y = pk2(f[2], f[3]); w.z = pk2(f[4], f[5]); w.w = pk2(f[6], f[7]); return w; }
__device__ __forceinline__ float xor32(float v, int lane) {
    return __builtin_bit_cast(float, __builtin_amdgcn_ds_bpermute((lane ^ 32) << 2, __builtin_bit_cast(int, v)));
}
__device__ __forceinline__ float sigmoid_f(float x) { return 1.0f / (1.0f + __expf(-x)); }

struct Ctx {
    LAS unsigned char* lds;
    int tid, lane, wave, G, gw, NGW;
    float* out; unsigned char* ws;
};

__device__ __forceinline__ void conv_item(const float* W, int N, int sc, int nv, int k0, bf16* WT, int ldw, int dr, LAS float* scr, int lane, const float* gk = nullptr) {
    const int n_ = lane & 31;
    float wv[32];
#pragma unroll
    for (int i = 0; i < 32; ++i) { const int kk = 2 * i + (lane >> 5); wv[i] = (n_ < nv) ? W[(size_t)(k0 + kk) * N + sc + n_] : 0.f; }
#pragma unroll
    for (int i = 0; i < 32; ++i) { const int kk = 2 * i + (lane >> 5); scr[kk * 33 + n_] = gk ? wv[i] * gk[k0 + kk] : wv[i]; }
    LDS_WAIT(); asm volatile("" ::: "memory");
    const int c = lane & 7;
#pragma unroll
    for (int j = 0; j < 4; ++j) { const int n = (lane >> 3) + 8 * j; const LAS float* s = scr + (8 * c) * 33 + n;
        v4u o; o.x = pk2(s[0 * 33], s[1 * 33]); o.y = pk2(s[2 * 33], s[3 * 33]); o.z = pk2(s[4 * 33], s[5 * 33]); o.w = pk2(s[6 * 33], s[7 * 33]);
        if (n < nv) *(GAS v4u*)(WT + (size_t)(dr + n) * ldw + k0 + 8 * c) = o; }
    LDS_WAIT(); asm volatile("" ::: "memory");
}
__device__ const int SEG_IN[15][3] = {
    {0, Z_FQ, 512}, {512, Z_FK, 512}, {1024, Z_FV, 512}, {1536, 6656 + S_FF, 8}, {1544, Z_DQ, 512}, {2056, 6656 + S_DK, 64}, {2120, 6656 + S_DV, 64},
    {2184, 6656 + S_IQ, 256}, {2440, 6656 + S_IK, 32}, {2472, 6656 + S_IW, 8}, {2480, Z_RQ, 256}, {2736, Z_RK, 256}, {2992, Z_RV, 512}, {3504, Z_RG, 512}, {4016, Z_ZG, 3072}};
constexpr int IN_BLK = 223;
constexpr int IT_IN = 16 * IN_BLK, IT_MIX = 8 * 32, IT_O = 16 * 32, IT_FI = 16 * (FF2 / 32), IT_FO = (FFH / 64) * 32;
constexpr int IT_LAYER = IT_IN + 3 * IT_MIX + IT_O + IT_FI + IT_FO;

__device__ __forceinline__ void sincos_acc(float ang, float& c, float& s) {
    const double a = (double)ang;
    const double k = __builtin_rint(a * 0.6366197723675814);
    double y = a - k * 1.5707963267948966; y -= k * 6.123233995736766e-17;
    const double y2 = y * y;
    double sp = -7.647163731819816e-13; sp = sp * y2 + 1.6059043836821613e-10; sp = sp * y2 - 2.505210838544172e-08; sp = sp * y2 + 2.7557319223985893e-06; sp = sp * y2 - 1.984126984126984e-04; sp = sp * y2 + 8.333333333333333e-03; sp = sp * y2 - 1.6666666666666666e-01;
    const double sn = y + y * y2 * sp;
    double cp = 4.779477332387385e-14; cp = cp * y2 - 1.1470745597729725e-11; cp = cp * y2 + 2.08767569878681e-09; cp = cp * y2 - 2.755731922398589e-07; cp = cp * y2 + 2.48015873015873e-05; cp = cp * y2 - 1.388888888888889e-03; cp = cp * y2 + 4.1666666666666664e-02; cp = cp * y2 - 0.5;
    const double cs = 1.0 + y2 * cp;
    const int q = ((int)k) & 3;
    const double ss = (q & 1) ? cs : sn, cc = (q & 1) ? sn : cs;
    s = (float)((q & 2) ? -ss : ss);
    c = (float)(((q + 1) & 2) ? -cc : cc);
}

__device__ __forceinline__ void p0_prologue(const Ctx& F, const float* w_in, const float* w_fox, const float* w_dsa, const float* w_ret, const float* w_o, const float* w_fi, const float* w_fo, const float* ln1g, const float* ln2g) {
    LAS float* scr = (LAS float*)(F.lds + RING_OFF + F.wave * 16384);
    bf16* Wb = (bf16*)(F.ws + WS_W);
    for (int it = F.gw; it < DEPTH * IT_LAYER; it += F.NGW) {
        const int l = it / IT_LAYER; int r = it % IT_LAYER;
        bf16* L = Wb + (size_t)l * LW_STRIDE;
        if (r < IT_IN) {
            const int kb = r / IN_BLK; int blk = r % IN_BLK; int sc = 0, dr = 0, nv = 0;
            for (int s = 0; s < 15; ++s) { const int w = SEG_IN[s][2], nb = (w + 31) >> 5; if (blk < nb) { sc = SEG_IN[s][0] + 32 * blk; dr = SEG_IN[s][1] + 32 * blk; nv = (w - 32 * blk) < 32 ? (w - 32 * blk) : 32;
                if (s == 0 || s == 1 || s == 4) { const int hd = blk >> 1; dr = SEG_IN[s][1] + (hd >> 2) * 256 + 128 * (blk & 1) + 32 * (hd & 3); }
                break; } blk -= nb; }
            conv_item(w_in + (size_t)l * DM * INC, INC, sc, nv, 64 * kb, L + LW_IN, 1024, dr, scr, F.lane, ln1g + l * DM); continue; }
        r -= IT_IN;
        if (r < 3 * IT_MIX) { const int w = r / IT_MIX, q = r % IT_MIX, kb = q / 32, nb = q % 32;
            conv_item((w == 0 ? w_fox : w == 1 ? w_dsa : w_ret) + (size_t)l * 512 * DM, DM, 32 * nb, 32, 64 * kb, L + LW_MIX + (size_t)w * 512, 1536, 32 * nb, scr, F.lane); continue; }
        r -= 3 * IT_MIX;
        if (r < IT_O) { const int kb = r / 32, nb = r % 32;
            conv_item(w_o + (size_t)l * DM * DM, DM, 32 * nb, 32, 64 * kb, L + LW_O, 1024, 32 * nb, scr, F.lane); continue; }
        r -= IT_O;
        if (r < IT_FI) { const int kb = r / (FF2 / 32), nb = r % (FF2 / 32); const int n0 = 32 * nb;
            const int j = n0 < FFH ? n0 : n0 - FFH; const int dr = 256 * (j >> 7) + (j & 127) + (n0 < FFH ? 0 : 128);
            conv_item(w_fi + (size_t)l * DM * FF2, FF2, n0, 32, 64 * kb, L + LW_FI, 1024, dr, scr, F.lane, ln2g + l * DM); continue; }
        r -= IT_FI;
        { const int kb = r / 32, nb = r % 32;
            conv_item(w_fo + (size_t)l * FFH * DM, DM, 32 * nb, 32, 64 * kb, L + LW_FO, FFH, 32 * nb, scr, F.lane); }
    }
    for (int i = F.gw * 64 + F.lane; i < DEPTH * 80 * 128; i += F.NGW * 64) { const int l = i / (80 * 128), q = i % (80 * 128);
        *(GAS v4u*)(Wb + (size_t)l * LW_STRIDE + LW_IN + (size_t)INC * 1024 + (size_t)q * 8) = (v4u){0u, 0u, 0u, 0u}; }
    f32x2* R64 = (f32x2*)(F.ws + WS_ROPE64); f32x2* R32 = (f32x2*)(F.ws + WS_ROPE32);
    for (int i = F.gw * 64 + F.lane; i < SEQ * 32; i += F.NGW * 64) { const int pos = i >> 5, k = i & 31;
        double f = 1.0; for (int e = 0; e < k; ++e) f *= 0.7498942093324559;
        const float ang = (float)pos * (float)f; float c, s; sincos_acc(ang, c, s); R64[i] = (f32x2){c, s}; }
    for (int i = F.gw * 64 + F.lane; i < SEQ * 16; i += F.NGW * 64) { const int pos = i >> 4, k = i & 15;
        double f = 1.0; for (int e = 0; e < k; ++e) f *= 0.5623413251903491;
        const float ang = (float)pos * (float)f; float c, s; sincos_acc(ang, c, s); R32[i] = (f32x2){c, s}; }
}

__device__ __forceinline__ void norm0_phase(const Ctx& F, const float* x, bf16* o, float* SS) {
    for (int m0 = F.gw; m0 < M; m0 += 4 * F.NGW) {
        f32x4 v[4][4];
#pragma unroll
        for (int r = 0; r < 4; ++r) { const int m = m0 + r * F.NGW; const GAS f32x4* xr = (const GAS f32x4*)(x + (size_t)(m < M ? m : m0) * DM) + F.lane;
#pragma unroll
            for (int j = 0; j < 4; ++j) v[r][j] = xr[64 * j]; }
#pragma unroll
        for (int r = 0; r < 4; ++r) { const int m = m0 + r * F.NGW; if (m < M) { float s = 0.f;
#pragma unroll
            for (int j = 0; j < 4; ++j) s += (v[r][j].x * v[r][j].x + v[r][j].y * v[r][j].y) + (v[r][j].z * v[r][j].z + v[r][j].w * v[r][j].w);
            s = wave_sum(s);
            GAS unsigned long long* o8 = (GAS unsigned long long*)(o + (size_t)m * DM) + F.lane;
#pragma unroll
            for (int j = 0; j < 4; ++j) o8[64 * j] = (unsigned long long)pk2(v[r][j].x, v[r][j].y) | ((unsigned long long)pk2(v[r][j].z, v[r][j].w) << 32);
            if (F.lane < 4) SS[(size_t)m * 4 + F.lane] = (F.lane == 0) ? s : 0.f; } }
    }
}

__device__ __forceinline__ void post_phase(const Ctx& F, const float* g_fq, const float* g_fk, const float* g_dq, const float* g_dk, const float* b_f, bool dummy_out = false) {
    bf16* Z = (bf16*)(F.ws + WS_Z); const float* ZS = (const float*)(F.ws + WS_ZS);
    const f32x2* R64 = (const f32x2*)(F.ws + WS_ROPE64); const f32x2* R32 = (const f32x2*)(F.ws + WS_ROPE32);
    float* LF = (float*)(F.ws + WS_LF); unsigned* ISG = (unsigned*)(F.ws + WS_ISG);
    bf16* KD = (bf16*)(F.ws + WS_KD); bf16* VD = (bf16*)(F.ws + WS_VD); bf16* IQB = (bf16*)(F.ws + WS_IQB); bf16* IKB = (bf16*)(F.ws + WS_IKB);
    const int t0 = blockIdx.x * 512 + F.tid, NT = F.G * 512;
    for (int t = t0; t < M * 8; t += NT) { const int m = t >> 3, h = t & 7; const float* sp = ZS + (size_t)m * ZSP + S_IQ + h * 32;
        f32x4 v[8];
#pragma unroll
        for (int i = 0; i < 8; ++i) v[i] = *(const GAS f32x4*)(sp + 4 * i);
        const float aw = fabsf(ZS[(size_t)m * ZSP + S_IW + h]);
        const f32x2* cs = R32 + (m & (SEQ - 1)) * 16; float f[32];
#pragma unroll
        for (int i = 0; i < 8; ++i) { f[4 * i] = v[i].x; f[4 * i + 1] = v[i].y; f[4 * i + 2] = v[i].z; f[4 * i + 3] = v[i].w; }
#pragma unroll
        for (int d = 0; d < 16; ++d) { const f32x2 tt = cs[d]; const float x1 = f[d], x2 = f[d + 16]; f[d] = (x1 * tt.x - x2 * tt.y) * aw; f[d + 16] = (x2 * tt.x + x1 * tt.y) * aw; }
        bf16* op = IQB + (size_t)m * 256 + h * 32;
#pragma unroll
        for (int i = 0; i < 4; ++i) { float t8[8];
#pragma unroll
            for (int j = 0; j < 8; ++j) t8[j] = f[8 * i + j];
            *(GAS v4u*)(op + 8 * i) = pack8(t8); }
    }
    const int part = blockIdx.x & 3;
    for (int m = (blockIdx.x >> 2) * 512 + F.tid; m < M; m += (F.G >> 2) * 512) { const float* sr = ZS + (size_t)m * ZSP; const int pos = m & (SEQ - 1);
        if (part == 0) { float f[64]; float ss = 0.f;
#pragma unroll
            for (int i = 0; i < 16; ++i) { const f32x4 v = *(const GAS f32x4*)(sr + S_DK + 4 * i); f[4 * i] = v.x; f[4 * i + 1] = v.y; f[4 * i + 2] = v.z; f[4 * i + 3] = v.w; ss += (v.x * v.x + v.y * v.y) + (v.z * v.z + v.w * v.w); }
            const float rs = 1.0f / sqrtf(ss * (1.f / 64) + NORM_EPS); const f32x2* cs = R64 + pos * 32;
#pragma unroll
            for (int d = 0; d < 64; ++d) f[d] = f[d] * rs * g_dk[d];
#pragma unroll
            for (int d = 0; d < 32; ++d) { const f32x2 tt = cs[d]; const float x1 = f[d], x2 = f[d + 32]; f[d] = x1 * tt.x - x2 * tt.y; f[d + 32] = x2 * tt.x + x1 * tt.y; }
#pragma unroll
            for (int i = 0; i < 8; ++i) { float t8[8];
#pragma unroll
                for (int j = 0; j < 8; ++j) t8[j] = f[8 * i + j];
                *(GAS v4u*)(KD + (size_t)m * 64 + 8 * i) = pack8(t8); } }
        if (part == 1)
#pragma unroll
        for (int i = 0; i < 8; ++i) { const f32x4 a = *(const GAS f32x4*)(sr + S_DV + 8 * i), b = *(const GAS f32x4*)(sr + S_DV + 8 * i + 4); const float t8[8] = {a.x, a.y, a.z, a.w, b.x, b.y, b.z, b.w};
            *(GAS v4u*)(VD + (size_t)m * 64 + 8 * i) = pack8(t8); }
        if (part == 2) { float f[32]; const f32x2* cs = R32 + pos * 16;
#pragma unroll
            for (int i = 0; i < 8; ++i) { const f32x4 v = *(const GAS f32x4*)(sr + S_IK + 4 * i); f[4 * i] = v.x; f[4 * i + 1] = v.y; f[4 * i + 2] = v.z; f[4 * i + 3] = v.w; }
#pragma unroll
            for (int d = 0; d < 16; ++d) { const f32x2 tt = cs[d]; const float x1 = f[d], x2 = f[d + 16]; f[d] = x1 * tt.x - x2 * tt.y; f[d + 16] = x2 * tt.x + x1 * tt.y; }
#pragma unroll
            for (int i = 0; i < 4; ++i) { float t8[8];
#pragma unroll
                for (int j = 0; j < 8; ++j) t8[j] = f[8 * i + j];
                *(GAS v4u*)(IKB + (size_t)m * 32 + 8 * i) = pack8(t8); } }
        if (part == 3) { const f32x4 w0 = *(const GAS f32x4*)(sr + S_IW), w1 = *(const GAS f32x4*)(sr + S_IW + 4); const float iw[8] = {w0.x, w0.y, w0.z, w0.w, w1.x, w1.y, w1.z, w1.w}; unsigned sg = 0;
#pragma unroll
            for (int h = 0; h < 8; ++h) sg |= (iw[h] < 0.f ? 1u : 0u) << h;
            ISG[m] = sg;
            const f32x4 f0 = *(const GAS f32x4*)(sr + S_FF), f1 = *(const GAS f32x4*)(sr + S_FF + 4); const float ff[8] = {f0.x, f0.y, f0.z, f0.w, f1.x, f1.y, f1.z, f1.w}; float lf[8];
#pragma unroll
            for (int h = 0; h < 8; ++h) { const float xx = ff[h] + b_f[h]; lf[h] = (fminf(xx, 0.f) - __logf(1.0f + __expf(-fabsf(xx)))) * LOG2E; }
            *(GAS f32x4*)(LF + (size_t)m * 8) = (f32x4){lf[0], lf[1], lf[2], lf[3]}; *(GAS f32x4*)(LF + (size_t)m * 8 + 4) = (f32x4){lf[4], lf[5], lf[6], lf[7]}; }
    }
}

__device__ __forceinline__ float ret_l2g(int h) { return h == 0 ? -0.04580368961312479f : h == 1 ? -0.02272007650008353f : h == 2 ? -0.011315313227834146f : -0.005646563141142063f; }

__device__ __forceinline__ void scan_state_phase(const Ctx& F) {
    const float* LF = (const float*)(F.ws + WS_LF); float* CF = (float*)(F.ws + WS_CF);
    const bf16* Z = (const bf16*)(F.ws + WS_Z); float* RS = (float*)(F.ws + WS_HDN);
    if (F.gw < 32) {
        const int b = F.gw >> 3, h = F.gw & 7; const float* lp = LF + ((size_t)b * SEQ + F.lane * 64) * 8 + h; float s = 0.f;
        for (int i = 0; i < 64; ++i) s += lp[i * 8];
        float incl = s;
#pragma unroll
        for (int o = 1; o < 64; o <<= 1) { const float t = __builtin_bit_cast(float, __builtin_amdgcn_ds_bpermute(((F.lane - o) & 63) << 2, __builtin_bit_cast(int, incl))); if (F.lane >= o) incl += t; }
        float run = incl - s; float* cp = CF + (size_t)F.gw * SEQ + F.lane * 64;
        for (int i = 0; i < 64; ++i) { run += lp[i * 8]; cp[i] = run; }
    }
    for (int u = blockIdx.x; u < NB * 32 * 4; u += F.G) {
        const int h = u & 3, c = (u >> 2) & 31, b = u >> 7; const float l2g = ret_l2g(h);
        const int d = F.tid >> 3, e0 = (F.tid & 7) * 16; float acc[16];
#pragma unroll
        for (int i = 0; i < 16; ++i) acc[i] = 0.f;
        const bf16* base = Z + ((size_t)b * SEQ + c * 128) * ZP;
        for (int j = 0; j < 128; ++j) { const bf16* row = base + (size_t)j * ZP;
            const float kd = bf2f(row[Z_RK + h * 64 + d]) * exp2f((float)(127 - j) * l2g);
            const v4u w0 = *(const GAS v4u*)(row + Z_RV + h * 128 + e0), w1 = *(const GAS v4u*)(row + Z_RV + h * 128 + e0 + 8);
            float v0[8], v1[8]; unpack8(w0, v0); unpack8(w1, v1);
#pragma unroll
            for (int i = 0; i < 8; ++i) { acc[i] += kd * v0[i]; acc[8 + i] += kd * v1[i]; } }
        float* o = RS + (size_t)u * 8192 + d * 128 + e0;
#pragma unroll
        for (int i = 0; i < 4; ++i) *(GAS f32x4*)(o + 4 * i) = (f32x4){acc[4 * i], acc[4 * i + 1], acc[4 * i + 2], acc[4 * i + 3]};
    }
}

__device__ __forceinline__ void ret_out_naive(const Ctx& F, const float* gn) {
    bf16* Z = (bf16*)(F.ws + WS_Z); const float* RS = (const float*)(F.ws + WS_HDN);
    LAS float* S = (LAS float*)(F.lds);
    LAS bf16* Vt = (LAS bf16*)(F.lds + 32768);
    LAS float* Kt = (LAS float*)(F.lds + 65536);
    LAS float* aw = (LAS float*)(F.lds + 65536 + 33280) + F.wave * 128;
    LAS float* qw = (LAS float*)(F.lds + 65536 + 33280 + 4096) + F.wave * 64;
    for (int u = blockIdx.x; u < NB * 32 * 4; u += F.G) {
        const int h = u & 3, c = (u >> 2) & 31, b = u >> 7; const float l2g = ret_l2g(h); const float wch = exp2f(128.f * l2g);
        __syncthreads();
        { float s[16];
#pragma unroll
            for (int i = 0; i < 16; ++i) s[i] = 0.f;
            for (int cp = 0; cp < c; ++cp) { const float* L = RS + ((size_t)((b * 32 + cp) * 4 + h)) * 8192 + F.tid;
#pragma unroll
                for (int i = 0; i < 16; ++i) s[i] = wch * s[i] + L[i * 512]; }
#pragma unroll
            for (int i = 0; i < 16; ++i) S[F.tid + i * 512] = s[i]; }
        const bf16* base = Z + ((size_t)b * SEQ + c * 128) * ZP;
        for (int q = F.tid; q < 2048; q += 512) { const int r = q >> 4, ch = q & 15; *(LAS v4u*)(Vt + r * 128 + ch * 8) = *(const GAS v4u*)(base + (size_t)r * ZP + Z_RV + h * 128 + ch * 8); }
        for (int q = F.tid; q < 128 * 64; q += 512) { const int r = q >> 6, dd = q & 63; Kt[r * 65 + dd] = bf2f(base[(size_t)r * ZP + Z_RK + h * 64 + dd]); }
        __syncthreads();
        for (int i = F.wave; i < 128; i += NWAVES) {
            const size_t m = (size_t)b * SEQ + c * 128 + i; bf16* zr = Z + m * ZP;
            qw[F.lane] = bf2f(zr[Z_RQ + h * 64 + F.lane]);
            LDS_WAIT(); asm volatile("" ::: "memory");
#pragma unroll
            for (int jj = 0; jj < 2; ++jj) { const int j = F.lane + 64 * jj; float a = 0.f;
                if (j <= i) { float dot = 0.f; for (int dd = 0; dd < 64; ++dd) dot += qw[dd] * Kt[j * 65 + dd]; a = dot * exp2f((float)(i - j) * l2g); }
                aw[j] = a; }
            LDS_WAIT(); asm volatile("" ::: "memory");
            float o[2]; const float dq = exp2f((float)(i + 1) * l2g);
#pragma unroll
            for (int ee = 0; ee < 2; ++ee) { const int e = F.lane + 64 * ee; float acc = 0.f;
                for (int j = 0; j <= i; ++j) acc += aw[j] * bf2f(Vt[j * 128 + e]);
                float cr = 0.f; for (int dd = 0; dd < 64; ++dd) cr += qw[dd] * S[dd * 128 + e];
                o[ee] = acc + cr * dq; }
            const float ss = wave_sum(o[0] * o[0] + o[1] * o[1]); const float rstd = 1.0f / sqrtf(ss * (1.f / 128) + NORM_EPS);
#pragma unroll
            for (int ee = 0; ee < 2; ++ee) { const int e = F.lane + 64 * ee; const float rg = bf2f(zr[Z_RG + h * 128 + e]);
                zr[Z_RV + h * 128 + e] = (bf16)f2bf(o[ee] * rstd * gn[h * 128 + e] * rg * sigmoid_f(rg)); }
            LDS_WAIT(); asm volatile("" ::: "memory");
        }
    }
    __syncthreads();
}

__device__ __forceinline__ void fox_naive(const Ctx& F) {
    bf16* Z = (bf16*)(F.ws + WS_Z); const float* CF = (const float*)(F.ws + WS_CF);
    LAS float* sc = (LAS float*)(F.lds + F.wave * 16384);
    const int lane = F.lane;
    int it = 0;
    for (int r0 = 0; r0 < NB * 8 * SEQ; r0 += F.NGW, ++it) {
        const int r = r0 + ((it & 1) ? (F.NGW - 1 - F.gw) : F.gw);
        if (r >= NB * 8 * SEQ) continue;
        const int pos = r & (SEQ - 1), h = (r >> 12) & 7, b = r >> 15;
        const size_t m = (size_t)b * SEQ + pos;
        float qf[64];
        { const bf16* qp = Z + m * ZP + Z_FQ + h * 64;
#pragma unroll
            for (int i = 0; i < 8; ++i) { const v4u w = *(const GAS v4u*)(qp + 8 * i); float t[8]; unpack8(w, t);
#pragma unroll
                for (int j = 0; j < 8; ++j) qf[8 * i + j] = t[j]; } }
        const float* cf = CF + (size_t)(b * 8 + h) * SEQ;
        float mx = -INFINITY;
        for (int kk = lane; kk <= pos; kk += 64) { const bf16* kp = Z + ((size_t)b * SEQ + kk) * ZP + Z_FK + h * 64; float dot = 0.f;
#pragma unroll
            for (int i = 0; i < 8; ++i) { const v4u w = *(const GAS v4u*)(kp + 8 * i); float t[8]; unpack8(w, t);
#pragma unroll
                for (int j = 0; j < 8; ++j) dot += qf[8 * i + j] * t[j]; }
            const float s = dot - cf[kk]; sc[kk] = s; mx = fmaxf(mx, s); }
        mx = wave_max(mx);
        float sum = 0.f;
        for (int kk = lane; kk <= pos; kk += 64) { const float p = exp2f(sc[kk] - mx); sc[kk] = p; sum += p; }
        sum = wave_sum(sum);
        LDS_WAIT(); asm volatile("" ::: "memory");
        const bf16* vp = Z + (size_t)b * SEQ * ZP + Z_FV + h * 64 + lane;
        float o0 = 0.f, o1 = 0.f, o2 = 0.f, o3 = 0.f; int kk = 0;
        for (; kk + 3 <= pos; kk += 4) { o0 += sc[kk] * bf2f(vp[(size_t)kk * ZP]); o1 += sc[kk + 1] * bf2f(vp[(size_t)(kk + 1) * ZP]); o2 += sc[kk + 2] * bf2f(vp[(size_t)(kk + 2) * ZP]); o3 += sc[kk + 3] * bf2f(vp[(size_t)(kk + 3) * ZP]); }
        for (; kk <= pos; ++kk) o0 += sc[kk] * bf2f(vp[(size_t)kk * ZP]);
        Z[m * ZP + Z_FQ + h * 64 + lane] = (bf16)f2bf(((o0 + o1) + (o2 + o3)) / sum);
        LDS_WAIT(); asm volatile("" ::: "memory");
    }
}

__device__ __forceinline__ unsigned f2key(float s) { const unsigned u = __builtin_bit_cast(unsigned, s + 0.0f); return (u & 0x80000000u) ? ~u : (u | 0x80000000u); }
__device__ __forceinline__ void dsa_naive(const Ctx& F) {
    bf16* Z = (bf16*)(F.ws + WS_Z); const float* ZS = (const float*)(F.ws + WS_ZS);
    const unsigned* ISG = (const unsigned*)(F.ws + WS_ISG);
    const bf16* KD = (const bf16*)(F.ws + WS_KD); const bf16* VD = (const bf16*)(F.ws + WS_VD);
    LAS unsigned* kl = (LAS unsigned*)(F.lds + F.wave * 16384);
    LAS float* iqs = (LAS float*)(F.lds + XTRA_OFF + F.wave * 1536);
    const int lane = F.lane;
    int it = 0;
    for (int r0 = 0; r0 < M; r0 += F.NGW, ++it) {
        const int r = r0 + ((it & 1) ? (F.NGW - 1 - F.gw) : F.gw);
        if (r >= M) continue;
        const int pos = r & (SEQ - 1), b = r >> 12; const size_t m = (size_t)r;
        *(LAS f32x4*)(iqs + 4 * lane) = *(const GAS f32x4*)(ZS + m * ZSP + S_IQ + 4 * lane);
        const unsigned sg = ISG[m];
        LDS_WAIT(); asm volatile("" ::: "memory");
        for (int kk = lane; kk <= pos; kk += 64) { const float* ikp = ZS + ((size_t)b * SEQ + kk) * ZSP + S_IK; float ik[32];
#pragma unroll
            for (int i = 0; i < 8; ++i) { const f32x4 t = *(const GAS f32x4*)(ikp + 4 * i); ik[4 * i] = t.x; ik[4 * i + 1] = t.y; ik[4 * i + 2] = t.z; ik[4 * i + 3] = t.w; }
            float s = 0.f;
#pragma unroll 1
            for (int h = 0; h < 8; ++h) { float dot = 0.f;
#pragma unroll
                for (int dd = 0; dd < 32; ++dd) dot += iqs[h * 32 + dd] * ik[dd];
                dot = fmaxf(dot, 0.f); s += ((sg >> h) & 1u) ? -dot : dot; }
            kl[kk] = f2key(s); }
        LDS_WAIT(); asm volatile("" ::: "memory");
        unsigned key[64];
#pragma unroll
        for (int j = 0; j < 64; ++j) { const int kk = j * 64 + lane; key[j] = (kk <= pos) ? kl[kk] : 0u; }
        LDS_WAIT(); asm volatile("" ::: "memory");
        LAS unsigned* idx = kl; LAS float* pl = (LAS float*)(kl + 256); LAS bf16* qs = (LAS bf16*)(kl + 512);
        *(LAS v4u*)(qs + 8 * lane) = *(const GAS v4u*)(Z + m * ZP + Z_DQ + 8 * lane);
        unsigned T = 0u; int need = 0;
        if (pos + 1 > 256) {
            for (int bit = 31; bit >= 0; --bit) { const unsigned Tt = T | (1u << bit); int cnt = 0;
#pragma unroll
                for (int j = 0; j < 64; ++j) cnt += __builtin_popcountll(__ballot(key[j] >= Tt));
                if (cnt >= 256) T = Tt; }
            int ngt = 0;
#pragma unroll
            for (int j = 0; j < 64; ++j) ngt += __builtin_popcountll(__ballot(key[j] > T));
            need = 256 - ngt;
        }
        int nsel = 0, eqb = 0;
#pragma unroll
        for (int j = 0; j < 64; ++j) { const bool gt = key[j] > T, eq = (key[j] == T) && (T != 0u);
            const unsigned long long em = __ballot(eq); const int er = eqb + __builtin_amdgcn_mbcnt_hi((unsigned)(em >> 32), __builtin_amdgcn_mbcnt_lo((unsigned)em, 0u));
            const bool sel = gt || (eq && er < need); eqb += __builtin_popcountll(em);
            const unsigned long long sm = __ballot(sel); const int sp = nsel + __builtin_amdgcn_mbcnt_hi((unsigned)(sm >> 32), __builtin_amdgcn_mbcnt_lo((unsigned)sm, 0u));
            if (sel) idx[sp] = (unsigned)(j * 64 + lane); nsel += __builtin_popcountll(sm); }
        LDS_WAIT(); asm volatile("" ::: "memory");
        for (int h = 0; h < 8; ++h) {
            float sv[4]; float mx = -INFINITY;
#pragma unroll
            for (int i = 0; i < 4; ++i) { const int e = lane + 64 * i; sv[i] = -INFINITY;
                if (e < nsel) { const bf16* kp = KD + ((size_t)b * SEQ + idx[e]) * 64; float dot = 0.f;
#pragma unroll
                    for (int c = 0; c < 8; ++c) { const v4u w = *(const GAS v4u*)(kp + 8 * c); float t[8]; unpack8(w, t); const v4u qw = *(const LAS v4u*)(qs + h * 64 + 8 * c); float qq[8]; unpack8(qw, qq);
#pragma unroll
                        for (int j = 0; j < 8; ++j) dot += qq[j] * t[j]; }
                    sv[i] = dot; }
                mx = fmaxf(mx, sv[i]); }
            mx = wave_max(mx); float sum = 0.f;
#pragma unroll
            for (int i = 0; i < 4; ++i) { const int e = lane + 64 * i; const float p = (e < nsel) ? exp2f(sv[i] - mx) : 0.f; pl[e] = p; sum += p; }
            sum = wave_sum(sum);
            LDS_WAIT(); asm volatile("" ::: "memory");
            float o0 = 0.f, o1 = 0.f; int e = 0;
            for (; e + 1 < nsel; e += 2) { o0 += pl[e] * bf2f(VD[((size_t)b * SEQ + idx[e]) * 64 + lane]); o1 += pl[e + 1] * bf2f(VD[((size_t)b * SEQ + idx[e + 1]) * 64 + lane]); }
            if (e < nsel) o0 += pl[e] * bf2f(VD[((size_t)b * SEQ + idx[e]) * 64 + lane]);
            Z[m * ZP + Z_DQ + h * 64 + lane] = (bf16)f2bf((o0 + o1) / sum);
            LDS_WAIT(); asm volatile("" ::: "memory");
        }
    }
}
#ifndef PROBE_D
#define PROBE_D 0
#endif

typedef short s16x8 __attribute__((ext_vector_type(8)));
typedef short s16x4 __attribute__((ext_vector_type(4)));
typedef short v4i16_t __attribute__((ext_vector_type(4)));
__device__ __forceinline__ s16x4 tr16(const LAS unsigned char* p) { return __builtin_bit_cast(s16x4, __builtin_amdgcn_ds_read_tr16_b64_v4i16((LAS v4i16_t*)p)); }
__device__ __forceinline__ float key2f(unsigned k) { return __builtin_bit_cast(float, (k & 0x80000000u) ? (k & 0x7fffffffu) : ~k); }

template <int NR> __device__ __forceinline__ int dsa_count_ge(const unsigned (&key)[64], unsigned T) {
    int c = 0;
#pragma unroll
    for (int j = 0; j < NR; ++j) c += __builtin_popcountll(__ballot(key[j] >= T));
    return c;
}
#define DSA_COUNT_GE(T_, out_) do { if (nq == 1) out_ = dsa_count_ge<16>(key, (T_)); else if (nq == 2) out_ = dsa_count_ge<32>(key, (T_)); else if (nq == 3) out_ = dsa_count_ge<48>(key, (T_)); else out_ = dsa_count_ge<64>(key, (T_)); } while (0)
__device__ __forceinline__ void dsa_select(const unsigned (&key)[64], int nvalid, unsigned& T, int& need) {
    const int nq = __builtin_amdgcn_readfirstlane((nvalid + 1023) >> 10);
    T = 0u; need = 0;
    if (nvalid <= 256) return;
    unsigned kmax = 0u;
#pragma unroll
    for (int j = 0; j < 64; ++j) kmax = key[j] > kmax ? key[j] : kmax;
#pragma unroll
    for (int o_ = 0; o_ < 1; ++o_) { unsigned t; t = sxu<1>(kmax); kmax = t > kmax ? t : kmax; t = sxu<2>(kmax); kmax = t > kmax ? t : kmax; t = sxu<4>(kmax); kmax = t > kmax ? t : kmax; t = sxu<8>(kmax); kmax = t > kmax ? t : kmax; t = sxu<16>(kmax); kmax = t > kmax ? t : kmax;
        unsigned a_, b_; swap32(kmax, a_, b_); kmax = a_ > b_ ? a_ : b_; }
    unsigned lo = 1u, hi = kmax + 1u; int hic = 0;
    { const float vm = fabsf(key2f(kmax)) + 1.0f; unsigned l2 = f2key(-vm * 64.0f); int c; DSA_COUNT_GE(l2, c); if (c >= 256) lo = l2; }
    int iter = 0; bool exact = false;
    while (hi - lo > 1u) {
        unsigned mid;
        if (iter < 24 && lo > 1u) { const float mv = 0.5f * key2f(lo) + 0.5f * key2f(hi - 1u); mid = f2key(mv); }
        else mid = lo + ((hi - lo) >> 1);
        if (mid <= lo) mid = lo + 1u; if (mid >= hi) mid = hi - 1u;
        int c; DSA_COUNT_GE(mid, c);
        if (c == 256) { T = mid; exact = true; break; }
        if (c > 256) lo = mid; else { hi = mid; hic = c; }
        ++iter;
    }
    if (exact) need = 256; else { T = lo; need = 256 - hic; }
}

template <bool SYNC_BEFORE_STAGE = false> __device__ __forceinline__ void dsa_attend(const bf16* zq, bf16* zo, const bf16* KDb, const bf16* VDb, const LAS unsigned short* idx, int nsel, LAS unsigned char* vst, int lane) {
    const int g = lane >> 4, c = lane & 15;
    s16x8 qf[2];
#pragma unroll
    for (int ks = 0; ks < 2; ++ks) { qf[ks] = (s16x8){0, 0, 0, 0, 0, 0, 0, 0}; if (c < 8) qf[ks] = *(const GAS s16x8*)(zq + c * 64 + 32 * ks + 8 * g); }
    f32x4 acc[16];
    v4u vreg[16];
#pragma unroll
    for (int i = 0; i < 16; ++i) { const int pi = lane + 64 * i, r = pi >> 3, c16 = pi & 7; const int id = (r < nsel) ? (int)idx[r] : 0; vreg[i] = *(const GAS v4u*)(VDb + (size_t)id * 64 + c16 * 8); }
#pragma unroll
    for (int tb = 0; tb < 2; ++tb) {
        s16x8 kf[8][2];
#pragma unroll
        for (int tt = 0; tt < 8; ++tt) { const int e = 16 * (8 * tb + tt) + c; const int id = (e < nsel) ? (int)idx[e] : 0; const bf16* kp = KDb + (size_t)id * 64 + 8 * g;
            kf[tt][0] = *(const GAS s16x8*)kp; kf[tt][1] = *(const GAS s16x8*)(kp + 32); }
#pragma unroll
        for (int tt = 0; tt < 8; ++tt) { f32x4 a = (f32x4){0.f, 0.f, 0.f, 0.f};
            a = __builtin_amdgcn_mfma_f32_16x16x32_bf16(kf[tt][0], qf[0], a, 0, 0, 0); a = __builtin_amdgcn_mfma_f32_16x16x32_bf16(kf[tt][1], qf[1], a, 0, 0, 0); acc[8 * tb + tt] = a; }
    }
    float mx = -INFINITY;
#pragma unroll
    for (int t = 0; t < 16; ++t)
#pragma unroll
        for (int i = 0; i < 4; ++i) { const int e = 16 * t + 4 * g + i; if (nsel < 256 && e >= nsel) acc[t][i] = -INFINITY; mx = fmaxf(mx, acc[t][i]); }
    mx = fmaxf(mx, sx<16>(mx)); mx = half_max(mx);
    float sum = 0.f;
#pragma unroll
    for (int t = 0; t < 16; ++t)
#pragma unroll
        for (int i = 0; i < 4; ++i) { const float p = __builtin_amdgcn_exp2f(acc[t][i] - mx); acc[t][i] = p; sum += p; }
    sum += sx<16>(sum); sum = half_sum(sum);
    const float inv = 1.0f / sum;
    s16x8 pf[8];
#pragma unroll
    for (int s = 0; s < 8; ++s) { v4u w; w.x = pk2(acc[2 * s][0] * inv, acc[2 * s][1] * inv); w.y = pk2(acc[2 * s][2] * inv, acc[2 * s][3] * inv); w.z = pk2(acc[2 * s + 1][0] * inv, acc[2 * s + 1][1] * inv); w.w = pk2(acc[2 * s + 1][2] * inv, acc[2 * s + 1][3] * inv);
        pf[s] = __builtin_bit_cast(s16x8, w); }
    f32x4 o[4];
#pragma unroll
    for (int db = 0; db < 4; ++db) o[db] = (f32x4){0.f, 0.f, 0.f, 0.f};
    const int q = (lane >> 2) & 3, p = lane & 3, swz = 2 * (g & 1) + (q >> 1);
    const LAS unsigned char* rb = vst + (4 * g + q) * 128 + 8 * p;
    if constexpr (SYNC_BEFORE_STAGE) __syncthreads();
#pragma unroll
    for (int hh = 0; hh < 2; ++hh) {
        asm volatile("s_waitcnt lgkmcnt(0)" ::: "memory");
#pragma unroll
        for (int i = 0; i < 16; ++i) { const int pi = lane + 64 * i, r = pi >> 3, c16 = pi & 7;
            *(LAS v4u*)(vst + r * 128 + ((((c16 >> 1) ^ ((r >> 1) & 3))) << 5) + ((c16 & 1) << 4)) = vreg[i]; }
        if (hh == 0) {
#pragma unroll
            for (int i = 0; i < 16; ++i) { const int pi = lane + 64 * i, r = pi >> 3, c16 = pi & 7, e = 128 + r; const int id = (e < nsel) ? (int)idx[e] : 0; vreg[i] = *(const GAS v4u*)(VDb + (size_t)id * 64 + c16 * 8); } }
        asm volatile("s_waitcnt lgkmcnt(0)" ::: "memory");
#pragma unroll
        for (int s4 = 0; s4 < 4; ++s4)
#pragma unroll
            for (int db = 0; db < 4; ++db) { const LAS unsigned char* a1 = rb + s4 * 4096 + ((db ^ swz) << 5);
                const s16x4 lo = tr16(a1), hi = tr16(a1 + 2048);
                const s16x8 vf = (s16x8){lo[0], lo[1], lo[2], lo[3], hi[0], hi[1], hi[2], hi[3]};
                o[db] = __builtin_amdgcn_mfma_f32_16x16x32_bf16(pf[4 * hh + s4], vf, o[db], 0, 0, 0); }
    }
    if (g < 2) {
#pragma unroll
        for (int db = 0; db < 4; ++db)
#pragma unroll
            for (int i = 0; i < 4; ++i) zo[(4 * g + i) * 64 + 16 * db + c] = (bf16)f2bf(o[db][i]);
    }
}

__device__ __forceinline__ void dsa_v2(const Ctx& F) {
    bf16* Z = (bf16*)(F.ws + WS_Z); const float* ZS = (const float*)(F.ws + WS_ZS);
    const unsigned* ISG = (const unsigned*)(F.ws + WS_ISG);
    const bf16* KD = (const bf16*)(F.ws + WS_KD); const bf16* VD = (const bf16*)(F.ws + WS_VD);
    LAS unsigned* kl = (LAS unsigned*)(F.lds + F.wave * 16384);
    LAS float* iqs = (LAS float*)(F.lds + XTRA_OFF + F.wave * 1536);
    LAS unsigned short* idx = (LAS unsigned short*)(F.lds + XTRA_OFF + F.wave * 1536 + 1024);
    const int lane = F.lane;
    int it = 0;
    for (int r0 = 0; r0 < M; r0 += F.NGW, ++it) {
        const int r = r0 + ((it & 1) ? (F.NGW - 1 - F.gw) : F.gw);
        if (r >= M) continue;
        const int pos = r & (SEQ - 1), b = r >> 12; const size_t m = (size_t)r;
        *(LAS f32x4*)(iqs + 4 * lane) = *(const GAS f32x4*)(ZS + m * ZSP + S_IQ + 4 * lane);
        const unsigned sg = ISG[m];
        LDS_WAIT(); asm volatile("" ::: "memory");
        for (int kk = lane; kk <= pos; kk += 64) { const float* ikp = ZS + ((size_t)b * SEQ + kk) * ZSP + S_IK; float ik[32];
#pragma unroll
            for (int i = 0; i < 8; ++i) { const f32x4 t = *(const GAS f32x4*)(ikp + 4 * i); ik[4 * i] = t.x; ik[4 * i + 1] = t.y; ik[4 * i + 2] = t.z; ik[4 * i + 3] = t.w; }
            float s = 0.f;
#pragma unroll 1
            for (int h = 0; h < 8; ++h) { float dot = 0.f;
#pragma unroll
                for (int dd = 0; dd < 32; ++dd) dot += iqs[h * 32 + dd] * ik[dd];
                dot = fmaxf(dot, 0.f); s += ((sg >> h) & 1u) ? -dot : dot; }
            kl[kk] = f2key(s); }
        LDS_WAIT(); asm volatile("" ::: "memory");
        unsigned key[64];
#pragma unroll
        for (int j = 0; j < 64; ++j) { const int kk = j * 64 + lane; key[j] = (kk <= pos) ? kl[kk] : 0u; }
        LDS_WAIT(); asm volatile("" ::: "memory");
        unsigned T; int need;
#ifdef DSA_OLDSEL
        T = 0u; need = 0;
        if (pos + 1 > 256) {
            for (int bit = 31; bit >= 0; --bit) { const unsigned Tt = T | (1u << bit); int cnt = 0;
#pragma unroll
                for (int j = 0; j < 64; ++j) cnt += __builtin_popcountll(__ballot(key[j] >= Tt));
                if (cnt >= 256) T = Tt; }
            int ngt = 0;
#pragma unroll
            for (int j = 0; j < 64; ++j) ngt += __builtin_popcountll(__ballot(key[j] > T));
            need = 256 - ngt;
        }
#else
        dsa_select(key, pos + 1, T, need);
#endif
        int nsel = 0, eqb = 0;
#pragma unroll
        for (int j = 0; j < 64; ++j) { const bool gt = key[j] > T, eq = (key[j] == T) && (T != 0u);
            const unsigned long long em = __ballot(eq); const int er = eqb + __builtin_amdgcn_mbcnt_hi((unsigned)(em >> 32), __builtin_amdgcn_mbcnt_lo((unsigned)em, 0u));
            const bool sel = gt || (eq && er < need); eqb += __builtin_popcountll(em);
            const unsigned long long sm = __ballot(sel); const int sp = nsel + __builtin_amdgcn_mbcnt_hi((unsigned)(sm >> 32), __builtin_amdgcn_mbcnt_lo((unsigned)sm, 0u));
            if (sel) idx[sp] = (unsigned short)(j * 64 + lane); nsel += __builtin_popcountll(sm); }
        LDS_WAIT(); asm volatile("" ::: "memory");
        dsa_attend(Z + m * ZP + Z_DQ, Z + m * ZP + Z_DQ, KD + (size_t)b * SEQ * 64, VD + (size_t)b * SEQ * 64, idx, nsel, (LAS unsigned char*)kl, lane);
        LDS_WAIT(); asm volatile("" ::: "memory");
    }
}

template <int NR> __device__ __forceinline__ int dsa_emit_n(const unsigned (&key)[64], unsigned T, int need, LAS unsigned short* idx, int lane) {
    int nsel = 0, eqb = 0;
#pragma unroll
    for (int j = 0; j < NR; ++j) { const bool gt = key[j] > T, eq = (key[j] == T) && (T != 0u);
        const unsigned long long em = __ballot(eq); const int er = eqb + __builtin_amdgcn_mbcnt_hi((unsigned)(em >> 32), __builtin_amdgcn_mbcnt_lo((unsigned)em, 0u));
        const bool sel = gt || (eq && er < need); eqb += __builtin_popcountll(em);
        const unsigned long long sm = __ballot(sel); const int sp = nsel + __builtin_amdgcn_mbcnt_hi((unsigned)(sm >> 32), __builtin_amdgcn_mbcnt_lo((unsigned)sm, 0u));
        if (sel) idx[sp] = (unsigned short)(j * 64 + lane); nsel += __builtin_popcountll(sm); }
    return nsel;
}
__device__ __forceinline__ int dsa_emit(const unsigned (&key)[64], int nvalid, unsigned T, int need, LAS unsigned short* idx, int lane) {
    const int nq = __builtin_amdgcn_readfirstlane((nvalid + 1023) >> 10);
    if (nq == 1) return dsa_emit_n<16>(key, T, need, idx, lane);
    if (nq == 2) return dsa_emit_n<32>(key, T, need, idx, lane);
    if (nq == 3) return dsa_emit_n<48>(key, T, need, idx, lane);
    return dsa_emit_n<64>(key, T, need, idx, lane);
}

#define DSA_CNT8(cnt_, k_, o_, T_) asm volatile( \
    "v_cmp_ge_u32_e64 s[60:61], %1, %9\n\tv_cmp_ge_u32_e64 s[62:63], %2, %9\n\tv_cmp_ge_u32_e64 s[64:65], %3, %9\n\tv_cmp_ge_u32_e64 s[66:67], %4, %9\n\t" \
    "v_cmp_ge_u32_e64 s[68:69], %5, %9\n\tv_cmp_ge_u32_e64 s[70:71], %6, %9\n\tv_cmp_ge_u32_e64 s[72:73], %7, %9\n\tv_cmp_ge_u32_e64 s[74:75], %8, %9\n\t" \
    "v_addc_co_u32_e64 %0, s[76:77], 0, %0, s[60:61]\n\tv_addc_co_u32_e64 %0, s[76:77], 0, %0, s[62:63]\n\tv_addc_co_u32_e64 %0, s[76:77], 0, %0, s[64:65]\n\tv_addc_co_u32_e64 %0, s[76:77], 0, %0, s[66:67]\n\t" \
    "v_addc_co_u32_e64 %0, s[76:77], 0, %0, s[68:69]\n\tv_addc_co_u32_e64 %0, s[76:77], 0, %0, s[70:71]\n\tv_addc_co_u32_e64 %0, s[76:77], 0, %0, s[72:73]\n\tv_addc_co_u32_e64 %0, s[76:77], 0, %0, s[74:75]" \
    : "+v"(cnt_) : "v"(k_[o_]), "v"(k_[o_ + 1]), "v"(k_[o_ + 2]), "v"(k_[o_ + 3]), "v"(k_[o_ + 4]), "v"(k_[o_ + 5]), "v"(k_[o_ + 6]), "v"(k_[o_ + 7]), "s"(T_) \
    : "s60", "s61", "s62", "s63", "s64", "s65", "s66", "s67", "s68", "s69", "s70", "s71", "s72", "s73", "s74", "s75", "s76", "s77")
template <int NR> __device__ __forceinline__ int dsa_lane_count(const unsigned (&key)[64], unsigned T) {
    int c = 0; const unsigned Ts = (unsigned)__builtin_amdgcn_readfirstlane((int)T);
#pragma unroll
    for (int j = 0; j < NR; j += 8) DSA_CNT8(c, key, j, Ts);
    return c;
}
#define DSA_LCOUNT(T_, lc_) do { if (nq == 1) lc_ = dsa_lane_count<16>(key, (T_)); else if (nq == 2) lc_ = dsa_lane_count<32>(key, (T_)); else if (nq == 3) lc_ = dsa_lane_count<48>(key, (T_)); else lc_ = dsa_lane_count<64>(key, (T_)); } while (0)
template <int NR> __device__ __forceinline__ void dsa_write_ge(const unsigned (&key)[64], unsigned T, int off, LAS unsigned short* idx, int lane) {
    const int dummy = 256 + lane;
#pragma unroll
    for (int j = 0; j < NR; ++j) { const bool s = key[j] >= T; idx[s ? off : dummy] = (unsigned short)(j * 64 + lane); off += s ? 1 : 0; }
}
__device__ __forceinline__ int dsa_select2(const unsigned (&key)[64], int nvalid, float s1, float s2, LAS unsigned short* idx, int lane) {
    const int nq = __builtin_amdgcn_readfirstlane((nvalid + 1023) >> 10);
    unsigned T = 1u; int lc = 0; bool exact = true;
    if (nvalid > 256) {
        const float n = (float)nvalid, mean = s1 / n, sd = sqrtf(fmaxf(s2 / n - mean * mean, 1e-30f));
        const float pfrac = 256.0f / n, pt = fminf(pfrac, 1.0f - pfrac);
        const float tt = sqrtf(-2.0f * __logf(fmaxf(pt, 1e-6f)));
        float zn = (0.010328f * tt + 0.802853f) * tt + 2.515517f; asm volatile("" : "+v"(zn));
        float zd = ((0.001308f * tt + 0.189269f) * tt + 1.432788f) * tt + 1.0f; asm volatile("" : "+v"(zd));
        float z = tt - zn / zd;
        if (pfrac > 0.5f) z = -z;
        const float dens = n * __expf(-0.5f * z * z) * 0.3989423f / sd;
        unsigned lo = 1u, hi = 0xffffffffu; int clo = nvalid, chi = 0;
        bool lop = false, hip = false; float lastv = mean + z * sd, lastc = 256.0f, grow = 1.3f;
        exact = false; int same = 0, last = 0;
        for (int it = 0; hi - lo > 1u; ++it) {
            unsigned mid;
            if (it == 0) mid = f2key(lastv);
            else if (!(lop && hip)) { lastv = lastv + grow * (lastc - 256.0f) / dens; grow *= 2.0f; mid = f2key(lastv); }
            else if (it < 24 && same < 2) { const float vlo = key2f(lo), vhi = key2f(hi - 1u); mid = f2key(vlo + (vhi - vlo) * (((float)(clo - 256) + 0.5f) / (float)(clo - chi))); }
            else if (it < 48) { mid = f2key(0.5f * key2f(lo) + 0.5f * key2f(hi - 1u)); same = 0; }
            else mid = lo + ((hi - lo) >> 1);
            if (!(mid > lo)) mid = lo + 1u; if (!(mid < hi)) mid = hi - 1u;
            DSA_LCOUNT(mid, lc); const int c = wave_isum(lc); lastc = (float)c; lastv = key2f(mid);
            if (c == 256) { T = mid; exact = true; break; }
            if (c > 256) { lo = mid; clo = c; lop = true; same = (last > 0) ? same + 1 : 0; last = 1; } else { hi = mid; chi = c; hip = true; same = (last < 0) ? same + 1 : 0; last = -1; }
        }
        if (!exact) {
            const int nsel = dsa_emit(key, nvalid, lo, 256 - chi, idx, lane);
            return nsel;
        }
    } else { DSA_LCOUNT(1u, lc); }
    int incl = lc;
#pragma unroll
    for (int o = 1; o < 64; o <<= 1) { const int t = __builtin_amdgcn_ds_bpermute(((lane - o) & 63) << 2, incl); if (lane >= o) incl += t; }
    const int total = __builtin_amdgcn_readlane(incl, 63);
    if (nq == 1) dsa_write_ge<16>(key, T, incl - lc, idx, lane); else if (nq == 2) dsa_write_ge<32>(key, T, incl - lc, idx, lane); else if (nq == 3) dsa_write_ge<48>(key, T, incl - lc, idx, lane); else dsa_write_ge<64>(key, T, incl - lc, idx, lane);
    return total;
}

constexpr int DSA_ROWF = 4100;
__device__ __forceinline__ void dsa_v3(const Ctx& F, int out_col = Z_DQ) {
    bf16* Z = (bf16*)(F.ws + WS_Z);
    const unsigned* ISG = (const unsigned*)(F.ws + WS_ISG);
    const bf16* KD = (const bf16*)(F.ws + WS_KD); const bf16* VD = (const bf16*)(F.ws + WS_VD);
    const bf16* IQB = (const bf16*)(F.ws + WS_IQB); const bf16* IKB = (const bf16*)(F.ws + WS_IKB);
    LAS unsigned* img = (LAS unsigned*)(F.lds);
    LAS unsigned short* idxw = (LAS unsigned short*)(F.lds + XTRA_OFF + F.wave * 1536);
    const int w = F.wave;
    const int v = (int)blockIdx.x;
    if (v < 256)
    for (int ui = 0; ui < 8; ++ui) {
        int lane_ = F.lane; asm volatile("" : "+v"(lane_)); const int lane = lane_, g = lane >> 4, c = lane & 15;
        const int b = v >> 6, k = v & 63; const int pb = 128 * (ui >> 1) + ((ui & 1) ? 127 - k : k);
        const int q0 = pb * 8, kend = q0 + 8, ntile = (kend + 15) >> 4;
        const size_t mb = (size_t)b * SEQ;
#if PROBE_D == 1
        for (int rp_ = 0; rp_ < 2; ++rp_)
#endif
        { s16x8 iqf[4]; float sgn[4]; s16x8 iqc;
          { const int qi = c & 7, hs = c >> 3; const int qq = q0 + qi; const bf16* qp = IQB + (mb + qq) * 256 + 8 * g; const unsigned sg = ISG[mb + qq];
            float cs[8];
#pragma unroll
            for (int e = 0; e < 8; ++e) cs[e] = 0.f;
#pragma unroll
            for (int j = 0; j < 4; ++j) { const int h = 2 * j + hs; iqf[j] = *(const GAS s16x8*)(qp + h * 32); sgn[j] = ((sg >> h) & 1u) ? -1.0f : 1.0f;
                float t8[8]; unpack8(__builtin_bit_cast(v4u, iqf[j]), t8);
#pragma unroll
                for (int e = 0; e < 8; ++e) cs[e] += sgn[j] * t8[e]; }
            iqc = __builtin_bit_cast(s16x8, pack8(cs)); }
          const bf16* ikp = IKB + (mb + c) * 32 + 8 * g;
          float st1 = 0.f, st2 = 0.f;
          s16x8 cur[4], nxt[4];
#pragma unroll
          for (int i = 0; i < 4; ++i) { const int t = w + 8 * i; cur[i] = *(const GAS s16x8*)(ikp + (size_t)512 * (t < ntile ? t : 0)); }
          for (int t0 = w; t0 < ntile; t0 += 32) {
#pragma unroll
            for (int i = 0; i < 4; ++i) { const int t = t0 + 32 + 8 * i; nxt[i] = *(const GAS s16x8*)(ikp + (size_t)512 * (t < ntile ? t : 0)); }
#pragma unroll
            for (int i = 0; i < 4; ++i) { const int t = t0 + 8 * i;
              if (t < ntile) {
                f32x4 sc = __builtin_amdgcn_mfma_f32_16x16x32_bf16(cur[i], iqc, (f32x4){0.f, 0.f, 0.f, 0.f}, 0, 0, 0);
#pragma unroll
                for (int h = 0; h < 4; ++h) { const f32x4 x = __builtin_amdgcn_mfma_f32_16x16x32_bf16(cur[i], iqf[h], (f32x4){0.f, 0.f, 0.f, 0.f}, 0, 0, 0);
#pragma unroll
                    for (int r = 0; r < 4; ++r) sc[r] = __builtin_fmaf(sgn[h], __builtin_fabsf(x[r]), sc[r]); }
#pragma unroll
                for (int r = 0; r < 4; ++r) sc[r] += sx<8>(sc[r]);
                v4u kk; kk.x = f2key(sc[0]); kk.y = f2key(sc[1]); kk.z = f2key(sc[2]); kk.w = f2key(sc[3]);
                if (16 * t + 15 <= q0) {
                    st1 += (sc[0] + sc[1]) + (sc[2] + sc[3]); st2 += (sc[0] * sc[0] + sc[1] * sc[1]) + (sc[2] * sc[2] + sc[3] * sc[3]);
                } else { const int kb = 16 * t + 4 * g, qa = q0 + (c & 7);
                    if (kb + 0 > qa) { kk.x = 0u; sc[0] = 0.f; } if (kb + 1 > qa) { kk.y = 0u; sc[1] = 0.f; } if (kb + 2 > qa) { kk.z = 0u; sc[2] = 0.f; } if (kb + 3 > qa) { kk.w = 0u; sc[3] = 0.f; }
                    st1 += (sc[0] + sc[1]) + (sc[2] + sc[3]); st2 += (sc[0] * sc[0] + sc[1] * sc[1]) + (sc[2] * sc[2] + sc[3] * sc[3]); }
                if (c < 8) *(LAS v4u*)(img + c * DSA_ROWF + 16 * t + 4 * g) = kk; } }
#pragma unroll
            for (int i = 0; i < 4; ++i) cur[i] = nxt[i];
          }
          st1 += sx<16>(st1); st2 += sx<16>(st2); st1 = half_sum(st1); st2 = half_sum(st2);
          if (g == 0 && c < 8) *(LAS f32x2*)(F.lds + XTRA_OFF + w * 1536 + 640 + c * 8) = (f32x2){st1, st2}; }
        __syncthreads();
        const int pos = q0 + w; unsigned key[64];
#pragma unroll
        for (int j = 0; j < 64; ++j) { const int kidx = 64 * j + lane; const unsigned a = img[w * DSA_ROWF + kidx]; key[j] = (kidx <= pos) ? a : 0u; }
        unsigned T; int need; int nsel;
        float rs1 = 0.f, rs2 = 0.f;
#pragma unroll
        for (int ww = 0; ww < 8; ++ww) { const f32x2 t = *(const LAS f32x2*)(F.lds + XTRA_OFF + ww * 1536 + 640 + w * 8); rs1 += t.x; rs2 += t.y; }
        { nsel = dsa_select2(key, pos + 1, rs1, rs2, idxw, lane); (void)T; (void)need; }
#if PROBE_D == 3
        { const size_t m = mb + pos; dsa_attend(Z + m * ZP + Z_DQ, Z + m * ZP + Z_RG, KD + mb * 64, VD + mb * 64, idxw, nsel, F.lds + w * 16384, lane); }
#endif
        { const size_t m = mb + pos; dsa_attend<true>(Z + m * ZP + Z_DQ, Z + m * ZP + out_col, KD + mb * 64, VD + mb * 64, idxw, nsel, F.lds + w * 16384, lane); }
        __syncthreads();
    }
}

__device__ __forceinline__ void ret_rope_frag(const bf16* row, const f32x2* cs, float scale, int g, s16x8 (&f)[2]) {
    const u32x2 a0 = *(const GAS u32x2*)(row + 4 * g), a1 = *(const GAS u32x2*)(row + 16 + 4 * g), b0 = *(const GAS u32x2*)(row + 32 + 4 * g), b1 = *(const GAS u32x2*)(row + 48 + 4 * g);
    const float x1[8] = {bflo(a0.x), bfhi(a0.x), bflo(a0.y), bfhi(a0.y), bflo(a1.x), bfhi(a1.x), bflo(a1.y), bfhi(a1.y)};
    const float x2[8] = {bflo(b0.x), bfhi(b0.x), bflo(b0.y), bfhi(b0.y), bflo(b1.x), bfhi(b1.x), bflo(b1.y), bfhi(b1.y)};
    float o1[8], o2[8];
#pragma unroll
    for (int j = 0; j < 8; ++j) { const f32x2 t = cs[(j < 4 ? 4 * g + j : 16 + 4 * g + (j - 4))]; o1[j] = (x1[j] * t.x - x2[j] * t.y) * scale; o2[j] = (x2[j] * t.x + x1[j] * t.y) * scale; }
    f[0] = __builtin_bit_cast(s16x8, pack8(o1)); f[1] = __builtin_bit_cast(s16x8, pack8(o2));
}
__device__ __forceinline__ s16x8 ret_bfrag(const LAS unsigned char* img, int row0, int eb, int g, int q, int p) {
    const int r1 = row0 + 4 * g + q;
    const LAS unsigned char* a1 = img + r1 * 256 + ((eb ^ (r1 & 7)) << 5) + 8 * p;
    const LAS unsigned char* a2 = img + (r1 + 16) * 256 + ((eb ^ ((r1 + 16) & 7)) << 5) + 8 * p;
    const s16x4 lo = tr16(a1), hi = tr16(a2);
    return (s16x8){lo[0], lo[1], lo[2], lo[3], hi[0], hi[1], hi[2], hi[3]};
}

__device__ __forceinline__ void ret_state_mfma(const Ctx& F) {
    const bf16* Z = (const bf16*)(F.ws + WS_Z); float* RS = (float*)(F.ws + WS_HDN);
    const f32x2* R64 = (const f32x2*)(F.ws + WS_ROPE64);
    LAS unsigned char* Kimg = F.lds; LAS unsigned char* Vimg = F.lds + 16384;
    const int lane = F.lane, g = lane >> 4, c = lane & 15, q = (lane >> 2) & 3, p = lane & 3;
    for (int u = blockIdx.x; u < NB * 32 * 4; u += F.G) {
        const int h = u & 3, ch = (u >> 2) & 31, b = u >> 7; const float l2g = ret_l2g(h);
        const bf16* base = Z + ((size_t)b * SEQ + ch * 128) * ZP;
        __syncthreads();
        for (int t = F.tid; t < 2048; t += 512) { const int r = t >> 4, c16 = t & 15;
            *(LAS v4u*)(Vimg + r * 256 + (((c16 >> 1) ^ (r & 7)) << 5) + ((c16 & 1) << 4)) = *(const GAS v4u*)(base + (size_t)r * ZP + Z_RV + h * 128 + c16 * 8); }
        for (int t = F.tid; t < 1024; t += 512) { const int j = t >> 3, dg = t & 7; const bf16* row = base + (size_t)j * ZP + Z_RK + h * 64;
            const u32x2 a = *(const GAS u32x2*)(row + 4 * dg), bb = *(const GAS u32x2*)(row + 32 + 4 * dg);
            const float x1[4] = {bflo(a.x), bfhi(a.x), bflo(a.y), bfhi(a.y)}, x2[4] = {bflo(bb.x), bfhi(bb.x), bflo(bb.y), bfhi(bb.y)};
            const f32x2* cs = R64 + (ch * 128 + j) * 32 + 4 * dg; const float sc = exp2f((float)(127 - j) * l2g);
            float o1[4], o2[4];
#pragma unroll
            for (int e = 0; e < 4; ++e) { const f32x2 tt = cs[e]; o1[e] = (x1[e] * tt.x - x2[e] * tt.y) * sc; o2[e] = (x2[e] * tt.x + x1[e] * tt.y) * sc; }
            u32x2 w1, w2; w1.x = pk2(o1[0], o1[1]); w1.y = pk2(o1[2], o1[3]); w2.x = pk2(o2[0], o2[1]); w2.y = pk2(o2[2], o2[3]);
            const int sw = (j >> 1) & 3; const int d1 = 4 * dg, d2 = 32 + 4 * dg;
            *(LAS u32x2*)(Kimg + j * 128 + ((((2 * d1) >> 5) ^ sw) << 5) + ((2 * d1) & 31)) = w1;
            *(LAS u32x2*)(Kimg + j * 128 + ((((2 * d2) >> 5) ^ sw) << 5) + ((2 * d2) & 31)) = w2; }
        __syncthreads();
        f32x4 acc[4];
#pragma unroll
        for (int db = 0; db < 4; ++db) acc[db] = (f32x4){0.f, 0.f, 0.f, 0.f};
#pragma unroll
        for (int s = 0; s < 4; ++s) {
            const s16x8 vb = ret_bfrag(Vimg, 32 * s, F.wave, g, q, p);
            const int r1 = 32 * s + 4 * g + q, sw = (r1 >> 1) & 3;
#pragma unroll
            for (int db = 0; db < 4; ++db) { const LAS unsigned char* a1 = Kimg + r1 * 128 + ((db ^ sw) << 5) + 8 * p;
                const s16x4 lo = tr16(a1), hi = tr16(a1 + 2048);
                const s16x8 ka = (s16x8){lo[0], lo[1], lo[2], lo[3], hi[0], hi[1], hi[2], hi[3]};
                acc[db] = __builtin_amdgcn_mfma_f32_16x16x32_bf16(ka, vb, acc[db], 0, 0, 0); }
        }
        float* o = RS + (size_t)u * 8192 + 16 * F.wave + c;
#pragma unroll
        for (int db = 0; db < 4; ++db)
#pragma unroll
            for (int r = 0; r < 4; ++r) o[(16 * db + 4 * g + r) * 128] = acc[db][r];
    }
    __syncthreads();
}

__device__ __forceinline__ void ret_scan(const Ctx& F) {
    const float* RS = (const float*)(F.ws + WS_HDN); float* SC = (float*)(F.ws + WS_HDN + 16 * MiB);
    for (int t = blockIdx.x * 512 + F.tid; t < NB * 4 * 8192; t += F.G * 512) {
        const int el = t & 8191, h = (t >> 13) & 3, b = t >> 15; const float wch = exp2f(128.f * ret_l2g(h)); float s = 0.f;
        float L[32];
#pragma unroll
        for (int ch = 0; ch < 32; ++ch) L[ch] = RS[(size_t)(((b * 32 + ch) * 4 + h)) * 8192 + el];
#pragma unroll
        for (int ch = 0; ch < 32; ++ch) { SC[(size_t)(((b * 32 + ch) * 4 + h)) * 8192 + el] = s; s = wch * s + L[ch]; }
    }
}

__device__ __forceinline__ void ret_out_mfma(const Ctx& F, const float* gn, bool dummy_out = false) {
    bf16* Z = (bf16*)(F.ws + WS_Z); const float* SC = (const float*)(F.ws + WS_HDN + 16 * MiB);
    const f32x2* R64 = (const f32x2*)(F.ws + WS_ROPE64);
    LAS unsigned char* Vimg = F.lds; LAS unsigned char* Simg = F.lds + 32768; LAS unsigned char* Kimg = F.lds + 49152;
    const int lane = F.lane, g = lane >> 4, c = lane & 15, q = (lane >> 2) & 3, p = lane & 3, w = F.wave;
    for (int u = blockIdx.x; u < NB * 32 * 4; u += F.G) {
        const int h = u & 3, ch = (u >> 2) & 31, b = u >> 7; const float l2g = ret_l2g(h); const float gam = exp2f(l2g);
        bf16* base = Z + ((size_t)b * SEQ + ch * 128) * ZP;
        __syncthreads();
        for (int t = F.tid; t < 2048; t += 512) { const int r = t >> 4, c16 = t & 15;
            *(LAS v4u*)(Vimg + r * 256 + (((c16 >> 1) ^ (r & 7)) << 5) + ((c16 & 1) << 4)) = *(const GAS v4u*)(base + (size_t)r * ZP + Z_RV + h * 128 + c16 * 8); }
        for (int t = F.tid; t < 1024; t += 512) { const int r = t >> 4, c16 = t & 15; const float* sp = SC + (size_t)u * 8192 + r * 128 + c16 * 8;
            const f32x4 s0 = *(const GAS f32x4*)sp, s1 = *(const GAS f32x4*)(sp + 4);
            v4u wv; wv.x = pk2(s0.x * gam, s0.y * gam); wv.y = pk2(s0.z * gam, s0.w * gam); wv.z = pk2(s1.x * gam, s1.y * gam); wv.w = pk2(s1.z * gam, s1.w * gam);
            *(LAS v4u*)(Simg + r * 256 + (((c16 >> 1) ^ (r & 7)) << 5) + ((c16 & 1) << 4)) = wv; }
        for (int t = F.tid; t < 1024; t += 512) { const int j = t >> 3, dg = t & 7; const bf16* row = base + (size_t)j * ZP + Z_RK + h * 64;
            const u32x2 a = *(const GAS u32x2*)(row + 4 * dg), bb = *(const GAS u32x2*)(row + 32 + 4 * dg);
            const float x1[4] = {bflo(a.x), bfhi(a.x), bflo(a.y), bfhi(a.y)}, x2[4] = {bflo(bb.x), bfhi(bb.x), bflo(bb.y), bfhi(bb.y)};
            const f32x2* cs = R64 + (ch * 128 + j) * 32 + 4 * dg; const float sc = exp2f(-(float)j * l2g);
            float o1[4], o2[4];
#pragma unroll
            for (int e = 0; e < 4; ++e) { const f32x2 tt = cs[e]; o1[e] = (x1[e] * tt.x - x2[e] * tt.y) * sc; o2[e] = (x2[e] * tt.x + x1[e] * tt.y) * sc; }
            u32x2 w1, w2; w1.x = pk2(o1[0], o1[1]); w1.y = pk2(o1[2], o1[3]); w2.x = pk2(o2[0], o2[1]); w2.y = pk2(o2[2], o2[3]);
            const int sw = (j >> 1) & 3; const int d1 = 4 * dg, d2 = 32 + 4 * dg;
            *(LAS u32x2*)(Kimg + j * 128 + ((((2 * d1) >> 5) ^ sw) << 5) + ((2 * d1) & 31)) = w1;
            *(LAS u32x2*)(Kimg + j * 128 + ((((2 * d2) >> 5) ^ sw) << 5) + ((2 * d2) & 31)) = w2; }
        const int i = 16 * w + c; s16x8 qf[2];
        float sc8 = 0.125f; asm volatile("" : "+v"(sc8));
        ret_rope_frag(base + (size_t)i * ZP + Z_RQ + h * 64, R64 + (ch * 128 + i) * 32, sc8 * exp2f((float)i * l2g), g, qf);
        __syncthreads();
        f32x4 acc[8];
#pragma unroll
        for (int t = 0; t < 8; ++t) { acc[t] = (f32x4){0.f, 0.f, 0.f, 0.f};
            if (t <= w) { const int j = 16 * t + c; const int sw = (j >> 1) & 3; const LAS unsigned char* kr = Kimg + j * 128;
                const u32x2 a0 = *(const LAS u32x2*)(kr + ((((8 * g) >> 5) ^ sw) << 5) + ((8 * g) & 31)), a1 = *(const LAS u32x2*)(kr + ((((32 + 8 * g) >> 5) ^ sw) << 5) + ((32 + 8 * g) & 31));
                const u32x2 b0 = *(const LAS u32x2*)(kr + ((((64 + 8 * g) >> 5) ^ sw) << 5) + ((64 + 8 * g) & 31)), b1 = *(const LAS u32x2*)(kr + ((((96 + 8 * g) >> 5) ^ sw) << 5) + ((96 + 8 * g) & 31));
                const s16x8 kf0 = __builtin_bit_cast(s16x8, (v4u){a0.x, a0.y, a1.x, a1.y}), kf1 = __builtin_bit_cast(s16x8, (v4u){b0.x, b0.y, b1.x, b1.y});
                acc[t] = __builtin_amdgcn_mfma_f32_16x16x32_bf16(kf0, qf[0], acc[t], 0, 0, 0); acc[t] = __builtin_amdgcn_mfma_f32_16x16x32_bf16(kf1, qf[1], acc[t], 0, 0, 0);
                if (t == w) {
#pragma unroll
                    for (int r = 0; r < 4; ++r) if (4 * g + r > c) acc[t][r] = 0.f; } } }
        s16x8 pf[4];
#pragma unroll
        for (int s = 0; s < 4; ++s) { v4u wv; wv.x = pk2(acc[2 * s][0], acc[2 * s][1]); wv.y = pk2(acc[2 * s][2], acc[2 * s][3]); wv.z = pk2(acc[2 * s + 1][0], acc[2 * s + 1][1]); wv.w = pk2(acc[2 * s + 1][2], acc[2 * s + 1][3]);
            pf[s] = __builtin_bit_cast(s16x8, wv); }
        f32x4 o[8];
#pragma unroll
        for (int eb = 0; eb < 8; ++eb) o[eb] = (f32x4){0.f, 0.f, 0.f, 0.f};
#pragma unroll
        for (int s = 0; s < 4; ++s) if (2 * s <= w) {
#pragma unroll
            for (int eb = 0; eb < 8; ++eb) o[eb] = __builtin_amdgcn_mfma_f32_16x16x32_bf16(pf[s], ret_bfrag(Vimg, 32 * s, eb, g, q, p), o[eb], 0, 0, 0); }
#pragma unroll
        for (int ks = 0; ks < 2; ++ks)
#pragma unroll
            for (int eb = 0; eb < 8; ++eb) o[eb] = __builtin_amdgcn_mfma_f32_16x16x32_bf16(qf[ks], ret_bfrag(Simg, 32 * ks, eb, g, q, p), o[eb], 0, 0, 0);
        float rs[4];
#pragma unroll
        for (int r = 0; r < 4; ++r) { float ss = 0.f;
#pragma unroll
            for (int eb = 0; eb < 8; ++eb) ss += o[eb][r] * o[eb][r];
            ss += sx<1>(ss); ss += sx<2>(ss); ss += sx<4>(ss); ss += sx<8>(ss);
            rs[r] = 1.0f / sqrtf(ss * (1.f / 128) + NORM_EPS); }
#pragma unroll
        for (int r = 0; r < 4; ++r) { bf16* zr = base + (size_t)(16 * w + 4 * g + r) * ZP; bf16* zw = dummy_out ? (bf16*)(F.ws + WS_ZS) + ((size_t)b * SEQ + ch * 128 + 16 * w + 4 * g + r) * 1024 - Z_RV : zr;
#pragma unroll
            for (int eb = 0; eb < 8; ++eb) { const int e = 16 * eb + c; const float rg = bf2f(zr[Z_RG + h * 128 + e]);
                zw[Z_RV + h * 128 + e] = (bf16)f2bf(o[eb][r] * rs[r] * gn[h * 128 + e] * rg * sigmoid_f(rg)); } }
    }
    __syncthreads();
}

__device__ __forceinline__ void fscan_phase(const Ctx& F) {
    const float* LF = (const float*)(F.ws + WS_LF); float* CF = (float*)(F.ws + WS_CF);
    LAS float* wsum = (LAS float*)(F.lds);
    const int seq = (int)blockIdx.x;
    if (seq < 32) {
        const int b = seq >> 3, h = seq & 7; const int p0 = F.tid * 8; const float* lp = LF + ((size_t)b * SEQ + p0) * 8 + h;
        float v[8]; float s = 0.f;
#pragma unroll
        for (int i = 0; i < 8; ++i) { v[i] = lp[i * 8]; }
#pragma unroll
        for (int i = 0; i < 8; ++i) { s += v[i]; v[i] = s; }
        float incl = s;
#pragma unroll
        for (int o = 1; o < 64; o <<= 1) { const float t = __builtin_bit_cast(float, __builtin_amdgcn_ds_bpermute(((F.lane - o) & 63) << 2, __builtin_bit_cast(int, incl))); if (F.lane >= o) incl += t; }
        if (F.lane == 63) wsum[F.wave] = incl;
        __syncthreads();
        float woff = 0.f;
#pragma unroll
        for (int ww = 0; ww < 8; ++ww) { const float t = wsum[ww]; if (ww < F.wave) woff += t; }
        const float base = woff + (incl - s);
        float* cp = CF + (size_t)seq * SEQ + p0;
        *(GAS f32x4*)cp = (f32x4){base + v[0], base + v[1], base + v[2], base + v[3]}; *(GAS f32x4*)(cp + 4) = (f32x4){base + v[4], base + v[5], base + v[6], base + v[7]};
    }
    __syncthreads();
}
#include <hip/hip_bf16.h>
#include <cmath>
namespace attn_body {
using bf16=__hip_bfloat16;
using bf16x8=__attribute__((ext_vector_type(8)))short;
using s16x4=__attribute__((ext_vector_type(4)))short;
using f32x16=__attribute__((ext_vector_type(16)))float;
using u32x4=__attribute__((ext_vector_type(4)))unsigned;
constexpr int BATCH=4,NHEAD=8,SEQ=4096,D=64,DM=6656;
constexpr int NW=8,QBLK=32,QB=QBLK*NW,KVBLK=64,NQB=SEQ/QB;
constexpr int ATTN_PITCH=DM, ATTN_UNIT_ROWS=QB;
__device__ __forceinline__ int crow(int r,int hi){return (r&3)+8*(r>>2)+4*hi;}
#define SBAR() __builtin_amdgcn_sched_barrier(0)
__device__ __forceinline__ void cmask(f32x16&p0,f32x16&p1,int jb,int qrel,int hi){
  const float NEG=-INFINITY; int kb=64*jb+4*hi;
  #pragma unroll
  for(int r=0;r<16;++r){int kv=kb+(r&3)+8*(r>>2); if(kv>qrel)p0[r]=NEG; if(kv+32>qrel)p1[r]=NEG;}
}

constexpr int NSLOT=3, SLOTB=8192;
constexpr int LDS_K=0, LDS_V=NSLOT*SLOTB, LDS_WS=2*NSLOT*SLOTB, LDS_OST=LDS_WS+NW*64*4, LDS_NC=LDS_OST+NW*4096, LDS_BYTES=LDS_NC+SEQ*4;
constexpr float C2=0.125f*1.4426950408889634f;
__device__ __forceinline__ void glds16(const void*gsrc,unsigned lds_dst){unsigned keep;
  asm volatile("s_mov_b32 %0, m0\n\ts_mov_b32 m0, %2\n\ts_nop 0\n\tglobal_load_lds_dwordx4 %1, off\n\ts_mov_b32 m0, %0":"=&s"(keep):"v"(gsrc),"s"(lds_dst):"memory");}
__device__ __forceinline__ float max3f(float a,float b,float c){float r;asm("v_max3_f32 %0, %1, %2, %3":"=v"(r):"v"(a),"v"(b),"v"(c));return r;}
__device__ __forceinline__ float max2f(float a,float b){float r;asm("v_max_f32_e32 %0, %1, %2":"=v"(r):"v"(a),"v"(b));return r;}
__device__ __forceinline__ float fadd_s(float a,float b){float r;asm("v_add_f32_e32 %0, %1, %2":"=v"(r):"v"(a),"v"(b));return r;}
__device__ __forceinline__ float fsub_s(float a,float b){float r;asm("v_sub_f32_e32 %0, %1, %2":"=v"(r):"v"(a),"v"(b));return r;}
typedef float f32x4_t __attribute__((ext_vector_type(4))); typedef float f32x2_t __attribute__((ext_vector_type(2))); typedef __bf16 bf16x2_t __attribute__((ext_vector_type(2)));
__device__ __forceinline__ unsigned cvtpk_s(float lo,float hi){f32x2_t v={lo,hi};bf16x2_t b=__builtin_convertvector(v,bf16x2_t);return __builtin_bit_cast(unsigned,b);}
#define WAIT_BAR(N) asm volatile("s_waitcnt vmcnt(" #N ") lgkmcnt(0)\n\ts_barrier":::"memory")

__device__ __forceinline__ void qkt(f32x16&p0,f32x16&p1,const char*Kslot,const bf16x8*qr,const f32x16&negm,int r32,int hi){
  const char*kb=Kslot+hi*1024+r32*16;
  #pragma unroll
  for(int d0=0;d0<4;++d0){
    const bf16x8 b0=*reinterpret_cast<const bf16x8*>(kb+d0*2048);
    const bf16x8 b1=*reinterpret_cast<const bf16x8*>(kb+d0*2048+512);
    if(d0==0){p0=__builtin_amdgcn_mfma_f32_32x32x16_bf16(b0,qr[0],negm,0,0,0);p1=__builtin_amdgcn_mfma_f32_32x32x16_bf16(b1,qr[0],negm,0,0,0);}
    else{p0=__builtin_amdgcn_mfma_f32_32x32x16_bf16(b0,qr[d0],p0,0,0,0);p1=__builtin_amdgcn_mfma_f32_32x32x16_bf16(b1,qr[d0],p1,0,0,0);}}
}
typedef __attribute__((address_space(3))) const char* lds_cptr;
typedef short v4i16_t __attribute__((ext_vector_type(4)));
__device__ __forceinline__ void kload8(bf16x8*kf,lds_cptr kp){
  kf[0]=*(const __attribute__((address_space(3))) bf16x8*)(kp);      kf[1]=*(const __attribute__((address_space(3))) bf16x8*)(kp+512);
  kf[2]=*(const __attribute__((address_space(3))) bf16x8*)(kp+2048); kf[3]=*(const __attribute__((address_space(3))) bf16x8*)(kp+2560);
  kf[4]=*(const __attribute__((address_space(3))) bf16x8*)(kp+4096); kf[5]=*(const __attribute__((address_space(3))) bf16x8*)(kp+4608);
  kf[6]=*(const __attribute__((address_space(3))) bf16x8*)(kp+6144); kf[7]=*(const __attribute__((address_space(3))) bf16x8*)(kp+6656);
}
__device__ __forceinline__ void kload2(bf16x8*kf,lds_cptr kp,int j){ kf[2*j]=*(const __attribute__((address_space(3))) bf16x8*)(kp+j*2048); kf[2*j+1]=*(const __attribute__((address_space(3))) bf16x8*)(kp+j*2048+512); }
__device__ __forceinline__ s16x4 vtr(lds_cptr p){ return __builtin_bit_cast(s16x4,__builtin_amdgcn_ds_read_tr16_b64_v4i16((__attribute__((address_space(3))) v4i16_t*)p)); }
__device__ __forceinline__ float rowmax(const f32x16&p0,const f32x16&p1){
  float a=max3f(p0[0],p0[1],p1[0]),b=max3f(p0[2],p0[3],p1[1]);a=max3f(a,p1[2],p1[3]);
  #pragma unroll
  for(int r=4;r<16;r+=4){a=max3f(a,p0[r],p0[r+1]);b=max3f(b,p0[r+2],p0[r+3]);a=max3f(a,p1[r],p1[r+1]);b=max3f(b,p1[r+2],p1[r+3]);}
  const float m=max2f(a,b);
  auto rr=__builtin_amdgcn_permlane32_swap(__float_as_uint(m),__float_as_uint(m),false,false);
  return max2f(__uint_as_float(rr[0]),__uint_as_float(rr[1]));
}
__device__ __forceinline__ void pv(f32x16*o,int vb,bf16x8 pa0,bf16x8 pa1,bf16x8 pa2,bf16x8 pa3){
  #pragma unroll
  for(int d0=0;d0<2;++d0){s16x4 lo[4],hi[4];
    #pragma unroll
    for(int ks=0;ks<4;++ks){
      asm volatile("ds_read_b64_tr_b16 %0,%1 offset:%c2":"=&v"(lo[ks]):"v"(vb),"i"(d0*4096+ks*1024):"memory");
      asm volatile("ds_read_b64_tr_b16 %0,%1 offset:%c2":"=&v"(hi[ks]):"v"(vb),"i"(d0*4096+ks*1024+512):"memory");}
    asm volatile("s_waitcnt lgkmcnt(0)":::"memory");SBAR();
    #define PK(k) (bf16x8){lo[k][0],lo[k][1],lo[k][2],lo[k][3],hi[k][0],hi[k][1],hi[k][2],hi[k][3]}
    o[d0]=__builtin_amdgcn_mfma_f32_32x32x16_bf16(pa0,PK(0),o[d0],0,0,0);
    o[d0]=__builtin_amdgcn_mfma_f32_32x32x16_bf16(pa1,PK(1),o[d0],0,0,0);
    o[d0]=__builtin_amdgcn_mfma_f32_32x32x16_bf16(pa2,PK(2),o[d0],0,0,0);
    o[d0]=__builtin_amdgcn_mfma_f32_32x32x16_bf16(pa3,PK(3),o[d0],0,0,0);
    #undef PK
  }
}

#ifndef ATTN_STORE16
#define ATTN_STORE16(p,v) (*(u32x4*)(p)=(v))
#endif
template<int THRL> __device__ __forceinline__ void attn_unit(int b,int h,int qb,const bf16*Q,const bf16*__restrict__ K,const bf16*__restrict__ V,bf16*O,const float*CF,float dskip,char*shm,int wave_id){
  int tid_=(wave_id<<6)|lane_id_v(); asm volatile("":"+v"(tid_));
  const int tid=tid_,lane=tid&63,r32=lane&31,hi=lane>>5; const int wid=__builtin_amdgcn_readfirstlane(tid>>6);
  const long rowbase=(long)b*SEQ; const int q0=qb*QB;
  const bf16*Qw=Q+(rowbase+q0+wid*QBLK)*DM+h*D;
  const float*cfp0=CF+(long)(b*NHEAD+h)*SEQ; const int NT0=(q0+QB)/KVBLK;
  int ts; { const float cq=cfp0[q0]; const int il=(lane<NT0)?64*lane+63:q0; const bool keep=(lane<NT0)&&(cfp0[il]<cq+dskip);
    const unsigned long long km=__ballot(keep); int t0=(int)__builtin_ctzll(km|(1ull<<63)); t0&=~1; ts=__builtin_amdgcn_readfirstlane(t0<NT0-4?t0:NT0-4); }
  const bf16*Kh=K+(rowbase+(long)ts*KVBLK)*DM+h*D,*Vh=V+(rowbase+(long)ts*KVBLK)*DM+h*D;
  const unsigned lds0=(unsigned)(uintptr_t)shm;
  float*wsf=(float*)(shm+LDS_WS)+wid*64;
  const bf16*ksrc=Kh+(long)lane*DM+wid*8;
  const bf16*vsrc=Vh+(long)(16*(wid&3)+(lane>>2))*DM+(wid>>2)*32+(lane&3)*8;
  const unsigned kdst=lds0+LDS_K+wid*1024, vdst=lds0+LDS_V+wid*1024;
  #define DMA_K(t,slot) glds16(ksrc+(long)(t)*KVBLK*DM,(unsigned)__builtin_amdgcn_readfirstlane(kdst+(slot)))
  #define DMA_V(t,slot) glds16(vsrc+(long)(t)*KVBLK*DM,(unsigned)__builtin_amdgcn_readfirstlane(vdst+(slot)))
  const char*Kbase=shm+LDS_K; bf16x8 kf[8];
  const lds_cptr shm3=(lds_cptr)shm; const lds_cptr kp0=shm3+LDS_K+hi*1024+r32*16; const lds_cptr vp0=shm3+LDS_V+((lane>>4)&1)*32+(lane&3)*8+(4*hi+((lane&15)>>2))*64;
  const int NT=NT0-ts;
  { const float*cfp=CF+(long)(b*NHEAD+h)*SEQ; float*ncw=(float*)(shm+LDS_NC);
    for(int i=tid+ts*KVBLK;i<q0+QB;i+=NW*64)ncw[i-ts*KVBLK]=-cfp[i]; }
  const lds_cptr ncp=(lds_cptr)shm+LDS_NC+hi*16;
  #define ADDC(P0,P1,t) do{ const lds_cptr np_=ncp+(t)*256; _Pragma("unroll") for(int g_=0;g_<4;++g_){ \
      const f32x4_t a_=*(const __attribute__((address_space(3))) f32x4_t*)(np_+g_*32), b_=*(const __attribute__((address_space(3))) f32x4_t*)(np_+g_*32+128); \
      P0[4*g_]+=a_[0];P0[4*g_+1]+=a_[1];P0[4*g_+2]+=a_[2];P0[4*g_+3]+=a_[3]; P1[4*g_]+=b_[0];P1[4*g_+1]+=b_[1];P1[4*g_+2]+=b_[2];P1[4*g_+3]+=b_[3]; } }while(0)
  DMA_K(0,0);DMA_V(0,0);DMA_K(1,SLOTB);
  bf16x8 qr[4];
  #pragma unroll
  for(int d0=0;d0<4;++d0)qr[d0]=*reinterpret_cast<const bf16x8*>(&Qw[(long)r32*DM+d0*16+hi*8]);
  float mhat=0.f,l_reg=0.f;f32x16 o[2];f32x16 negm; { float zz_; asm volatile("v_mov_b32 %0, 0":"=v"(zz_));
    _Pragma("unroll") for(int r=0;r<16;++r){o[0][r]=zz_;o[1][r]=zz_;negm[r]=zz_;} } asm volatile("":"+v"(negm));
  const int qrel=wid*QBLK+r32;
  #define CMASK(P0,P1,t) do{int jb_=(t)-(NT-4); if(jb_>=0)cmask(P0,P1,jb_,qrel,hi);}while(0)
  bool resc=false;
  #define START(P0,P1) do{ const float rm=rowmax(P0,P1); resc=false; \
    { const float dl=rm; mhat=fadd_s(mhat,dl); \
      _Pragma("unroll") for(int r=0;r<16;++r){P0[r]=fsub_s(P0[r],dl);P1[r]=fsub_s(P1[r],dl);} \
      _Pragma("unroll") for(int r=0;r<16;++r)negm[r]=-mhat; asm volatile("":"+v"(negm)); } \
    _Pragma("unroll") for(int r=0;r<16;++r)P0[r]=__builtin_amdgcn_exp2f(P0[r]); }while(0)
  #define RESC() do{ if(resc){ asm volatile("s_waitcnt lgkmcnt(0)":::"memory"); \
      _Pragma("unroll") for(int d_=0;d_<2;++d_) _Pragma("unroll") for(int r=0;r<16;++r)o[d_][r]*=wsf[crow(r,hi)]; } }while(0)
  f32x16 pA0,pA1,pB0,pB1;
  int sl_prev=0,sl_cur=0,sl_next=SLOTB;
  #define ROT() do{sl_prev=sl_cur;sl_cur=sl_next;sl_next=(sl_next==(NSLOT-1)*SLOTB)?0:sl_next+SLOTB;}while(0)
  DMA_K(2,2*SLOTB);
  WAIT_BAR(3);
  qkt(pA0,pA1,Kbase,qr,negm,r32,hi);asm volatile("s_nop 15\n\ts_nop 7":"+v"(pA0),"+v"(pA1));ADDC(pA0,pA1,0);CMASK(pA0,pA1,0);
  START(pA0,pA1);
  _Pragma("unroll") for(int r=0;r<16;++r)pA1[r]=__builtin_amdgcn_exp2f(pA1[r]);
  WAIT_BAR(0);
  DMA_K(3,0);DMA_V(1,SLOTB);
  ROT();
  kload8(kf,kp0+sl_cur);
  WAIT_BAR(2);
  s16x4 vlo[8],vhi[8]; u32x4 pw0,pw1,pw2,pw3;
  #define PKW(P,B) cvtpk_s(P[B],P[B+1])
  #define PAF(k) __builtin_bit_cast(bf16x8,pw##k)
  #define VFR(i) (bf16x8){vlo[i][0],vlo[i][1],vlo[i][2],vlo[i][3],vhi[i][0],vhi[i][1],vhi[i][2],vhi[i][3]}
  #define PIN(x) asm volatile("":"+v"(x))
  #define MX3(a,b,c) __builtin_fmaxf(__builtin_fmaxf((a),(b)),(c))
  #define GAPA(MF,A0,A1,A2,A3,W0,W1,PW) do{ MF; sacc+=A0; sacc+=A1; sacc+=A2; sacc+=A3; PIN(sacc); W0; W1; PIN(PW); SBAR(); }while(0)
  #define EX(v) __builtin_amdgcn_exp2f(v)
  #define GAPB(MF,X,B) do{ MF; X[B]=EX(X[B]); X[B+1]=EX(X[B+1]); X[B+2]=EX(X[B+2]); X[B+3]=EX(X[B+3]); PIN(X); SBAR(); }while(0)
  #define VRD(i) do{ vlo[i]=vtr(vp_+(((i)>>2)*4096+((i)&3)*1024)); vhi[i]=vtr(vp_+(((i)>>2)*4096+((i)&3)*1024+512)); }while(0)
  #define KRD(G,j) do{ if(G){ kload2(kf,kp0+sl_next,j); SBAR(); } }while(0)
  #define STEP(C0,C1,P0,P1,t,GK,GV,GL) do{ SBAR(); \
    const lds_cptr vp_=vp0+sl_prev; \
    VRD(0); SBAR(); float sacc=(P0[0]+P0[1]); \
    GAPA(C0=__builtin_amdgcn_mfma_f32_32x32x16_bf16(kf[0],qr[0],negm,0,0,0), P0[2],P0[3],P0[4],P0[5],     pw0[0]=PKW(P0,0), pw0[1]=PKW(P0,2), pw0); \
    VRD(4); SBAR(); GAPA(C1=__builtin_amdgcn_mfma_f32_32x32x16_bf16(kf[1],qr[0],negm,0,0,0), P0[6],P0[7],P0[8],P0[9],     pw0[2]=PKW(P0,4), pw0[3]=PKW(P0,6), pw0); \
    VRD(1); SBAR(); GAPA(C0=__builtin_amdgcn_mfma_f32_32x32x16_bf16(kf[2],qr[1],C0,0,0,0),   P0[10],P0[11],P0[12],P0[13], pw1[0]=PKW(P0,8), pw1[1]=PKW(P0,10), pw1); \
    VRD(5); SBAR(); GAPA(C1=__builtin_amdgcn_mfma_f32_32x32x16_bf16(kf[3],qr[1],C1,0,0,0),   P0[14],P0[15],P1[0],P1[1],   pw1[2]=PKW(P0,12),pw1[3]=PKW(P0,14), pw1); \
    VRD(2); SBAR(); GAPA(C0=__builtin_amdgcn_mfma_f32_32x32x16_bf16(kf[4],qr[2],C0,0,0,0),   P1[2],P1[3],P1[4],P1[5],     pw2[0]=PKW(P1,0), pw2[1]=PKW(P1,2), pw2); \
    VRD(6); SBAR(); GAPA(C1=__builtin_amdgcn_mfma_f32_32x32x16_bf16(kf[5],qr[2],C1,0,0,0),   P1[6],P1[7],P1[8],P1[9],     pw2[2]=PKW(P1,4), pw2[3]=PKW(P1,6), pw2); \
    VRD(3); SBAR(); GAPA(C0=__builtin_amdgcn_mfma_f32_32x32x16_bf16(kf[6],qr[3],C0,0,0,0),   P1[10],P1[11],P1[12],P1[13], pw3[0]=PKW(P1,8), pw3[1]=PKW(P1,10), pw3); \
    VRD(7); SBAR(); GAPA(C1=__builtin_amdgcn_mfma_f32_32x32x16_bf16(kf[7],qr[3],C1,0,0,0),   P1[14],P1[15],0.f,0.f,       pw3[2]=PKW(P1,12),pw3[3]=PKW(P1,14), pw3); \
    l_reg+=sacc; \
    if(GK){DMA_K((t)+3,sl_cur);} if(GV){DMA_V((t)+1,sl_next);} \
    ADDC(C0,C1,t); CMASK(C0,C1,t); \
    { float a=MX3(C0[0],C0[1],C1[0]),b=MX3(C0[2],C0[3],C1[1]); a=MX3(a,C1[2],C1[3]); \
      _Pragma("unroll") for(int r=4;r<16;r+=4){a=MX3(a,C0[r],C0[r+1]);b=MX3(b,C0[r+2],C0[r+3]);a=MX3(a,C1[r],C1[r+1]);b=MX3(b,C1[r+2],C1[r+3]);} \
      float rm=__builtin_fmaxf(a,b); { auto rr=__builtin_amdgcn_permlane32_swap(__float_as_uint(rm),__float_as_uint(rm),false,false); rm=__builtin_fmaxf(__uint_as_float(rr[0]),__uint_as_float(rr[1])); } \
      resc=false; \
      if(__builtin_expect(__any(rm>(float)THRL),0)){ const float dl=__builtin_fmaxf(rm,0.f); mhat+=dl; \
        _Pragma("unroll") for(int r=0;r<16;++r){C0[r]-=dl;C1[r]-=dl;} \
        _Pragma("unroll") for(int r=0;r<16;++r)negm[r]=-mhat; asm volatile("":"+v"(negm)); \
        const float f=__builtin_amdgcn_exp2f(-dl); l_reg*=f; if(hi==0)wsf[r32]=f; resc=true; } } \
    SBAR(); \
    GAPB(o[0]=__builtin_amdgcn_mfma_f32_32x32x16_bf16(PAF(0),VFR(0),o[0],0,0,0), C0,0); \
    GAPB(o[1]=__builtin_amdgcn_mfma_f32_32x32x16_bf16(PAF(0),VFR(4),o[1],0,0,0), C0,4); \
    KRD(GL,0); GAPB(o[0]=__builtin_amdgcn_mfma_f32_32x32x16_bf16(PAF(1),VFR(1),o[0],0,0,0), C0,8); \
    KRD(GL,1); GAPB(o[1]=__builtin_amdgcn_mfma_f32_32x32x16_bf16(PAF(1),VFR(5),o[1],0,0,0), C0,12); \
    KRD(GL,2); GAPB(o[0]=__builtin_amdgcn_mfma_f32_32x32x16_bf16(PAF(2),VFR(2),o[0],0,0,0), C1,0); \
    KRD(GL,3); GAPB(o[1]=__builtin_amdgcn_mfma_f32_32x32x16_bf16(PAF(2),VFR(6),o[1],0,0,0), C1,4); \
    GAPB(o[0]=__builtin_amdgcn_mfma_f32_32x32x16_bf16(PAF(3),VFR(3),o[0],0,0,0), C1,8); \
    GAPB(o[1]=__builtin_amdgcn_mfma_f32_32x32x16_bf16(PAF(3),VFR(7),o[1],0,0,0), C1,12); \
    }while(0)
  int t=1;
  #undef CMASK
  #define CMASK(P0,P1,t) do{}while(0)
  for(;t+5<NT;t+=2){
    STEP(pB0,pB1,pA0,pA1,t,true,true,true);     WAIT_BAR(2); RESC(); ROT();
    STEP(pA0,pA1,pB0,pB1,t+1,true,true,true);   WAIT_BAR(2); RESC(); ROT();
  }
  #undef CMASK
  #define CMASK(P0,P1,t) do{int jb_=(t)-(NT-4); if(jb_>=0)cmask(P0,P1,jb_,qrel,hi);}while(0)
  #define ENDW(tt) do{ if((tt)+3<NT){WAIT_BAR(2);} else if((tt)+2<NT){WAIT_BAR(1);} else {WAIT_BAR(0);} }while(0)
  for(;t+1<NT;t+=2){
    STEP(pB0,pB1,pA0,pA1,t,(t+3<NT),(t+1<NT),(t+1<NT));       ENDW(t);   RESC(); ROT();
    STEP(pA0,pA1,pB0,pB1,t+1,(t+4<NT),(t+2<NT),(t+2<NT));     ENDW(t+1); RESC(); ROT();
  }
  STEP(pB0,pB1,pA0,pA1,NT-1,false,false,false); RESC();
  { float sacc=pB0[0]+pB0[1]; _Pragma("unroll") for(int r=2;r<16;++r)sacc+=pB0[r]; _Pragma("unroll") for(int r=0;r<16;++r)sacc+=pB1[r]; l_reg+=sacc;
    pw0=(u32x4){PKW(pB0,0),PKW(pB0,2),PKW(pB0,4),PKW(pB0,6)};pw1=(u32x4){PKW(pB0,8),PKW(pB0,10),PKW(pB0,12),PKW(pB0,14)};pw2=(u32x4){PKW(pB1,0),PKW(pB1,2),PKW(pB1,4),PKW(pB1,6)};pw3=(u32x4){PKW(pB1,8),PKW(pB1,10),PKW(pB1,12),PKW(pB1,14)};
    int tl_=lane_id_v(); asm volatile("":"+v"(tl_)); const int ln_=tl_&63,hi_=ln_>>5; const int vb0e=(int)(lds0+LDS_V)+((ln_>>4)&1)*32+(ln_&3)*8+(4*hi_+((ln_&15)>>2))*64;
    SBAR(); pv(o,vb0e+sl_cur,PAF(0),PAF(1),PAF(2),PAF(3)); }
  #undef PKW
  #undef PAF
  #undef VFR
  #undef PIN
  #undef MX3
  #undef GAPA
  #undef GAPB
  #undef EX
  #undef VRD
  #undef KRD
  #undef STEP
  #undef ENDW
  {auto rr=__builtin_amdgcn_permlane32_swap(__float_as_uint(l_reg),__float_as_uint(l_reg),false,false);l_reg=__uint_as_float(rr[0])+__uint_as_float(rr[1]);}
  int te_=lane_id_v(); asm volatile("":"+v"(te_)); const int lane_e=te_&63,r32_e=lane_e&31,hi_e=lane_e>>5;
  if(hi_e==0)wsf[32+r32_e]=l_reg;asm volatile("s_waitcnt lgkmcnt(0)":::"memory");
  float rli[16];
  #pragma unroll
  for(int r=0;r<16;++r)rli[r]=__builtin_amdgcn_rcpf(wsf[32+crow(r,hi_e)]);
  bf16*Ow=O+(rowbase+q0+wid*QBLK)*DM+h*D;
  { bf16*stg=(bf16*)(shm+LDS_OST)+wid*2048;
    #pragma unroll
    for(int r=0;r<16;++r){const int orow=crow(r,hi_e);
      #pragma unroll
      for(int d0=0;d0<2;++d0)stg[orow*64+d0*32+r32_e]=__float2bfloat16(o[d0][r]*rli[r]);}
    asm volatile("s_waitcnt lgkmcnt(0)":::"memory");
    #pragma unroll
    for(int i=0;i<4;++i){const int row=i*8+(lane_e>>3),ch=lane_e&7; const u32x4 v=*(const u32x4*)(stg+row*64+ch*8); ATTN_STORE16(Ow+(long)row*DM+ch*8,v);} }
  asm volatile("s_waitcnt lgkmcnt(0)\n\ts_barrier":::"memory");
  #undef ADDC
  #undef DMA_K
  #undef DMA_V
  #undef CMASK
  #undef START
  #undef RESC
  #undef ROT
}
constexpr int ATTN_LDS_BYTES=LDS_BYTES;
struct AttnTensors { const bf16* Q; const bf16* K; const bf16* V; bf16* O; const float* CF; float dskip; };
struct AttnUnit { int bh; int qb; };
struct StaticOrder {
  int vcu;
  __device__ __forceinline__ explicit StaticOrder(int grid,int block):vcu((block%8)*(grid/8)+block/8){}
  __device__ __forceinline__ bool next(int i,AttnUnit&u)const{ if(i>=2)return false; const int s=vcu&7; u.bh=vcu>>3; u.qb=(i==0)?s:15-s; return true; }
  __device__ __forceinline__ void a_ready(const AttnUnit&)const{}
  __device__ __forceinline__ void done(const AttnUnit&)const{}
};
template<class Sched,int THRL=8> __device__ __forceinline__ void attn_phase(char*lds,const AttnTensors&T,const Sched&S,int wave_id){
  AttnUnit u;
  for(int i=0;S.next(i,u);++i){ S.a_ready(u); attn_unit<THRL>(u.bh/NHEAD,u.bh%NHEAD,u.qb,T.Q,T.K,T.V,T.O,T.CF,T.dskip,lds,wave_id); S.done(u); }
}
#undef SBAR
#undef WAIT_BAR
}

struct Args { const float* in[16]; float* out; unsigned char* ws; };
__global__ void __launch_bounds__(NWAVES * 64, 2) hyb_fwd(Args args) {
    extern __shared__ __attribute__((aligned(16))) unsigned char lds[];
    Ctx F;
    F.lds = (LAS unsigned char*)lds;
    F.tid = threadIdx.x; F.lane = F.tid & 63; F.wave = __builtin_amdgcn_readfirstlane(F.tid >> 6);
    F.G = gridDim.x; F.gw = blockIdx.x * NWAVES + F.wave; F.NGW = F.G * NWAVES;
    F.out = args.out; F.ws = args.ws;
    volatile LAS unsigned* MISC = (volatile LAS unsigned*)(F.lds + MISC_OFF);
    for (int u = F.tid; u < (LDS_BYTES - LDSCTL_OFF) / 4; u += NWAVES * 64) ((LAS unsigned*)(F.lds + LDSCTL_OFF))[u] = 0u;
    __syncthreads();
    gu32* ctl = (gu32*)(F.ws + WS_CTL);
    XcdBarrier bar = xcd_barrier_post((unsigned*)(ctl + CW_BAR), MISC + 8); bar.w = F.wave;
#define FRESH(P) Ctx P = F; P.tid = (F.wave << 6) | lane_id_v(); asm volatile("" : "+v"(P.tid), "+s"(P.wave), "+s"(P.gw), "+s"(P.ws), "+s"(P.out)); P.lane = P.tid & 63
#define GRID_BAR() do { XcdBarrier b_ = bar; asm volatile("" : "+s"(b_.bar), "+s"(b_.x)); xcd_barrier(b_); } while (0)

    bf16* Wb = (bf16*)(F.ws + WS_W);
    bf16* Z = (bf16*)(F.ws + WS_Z); float* ZS = (float*)(F.ws + WS_ZS); bf16* HDN = (bf16*)(F.ws + WS_HDN);
    float* M32 = (float*)(F.ws + WS_HDN); bf16* HB = (bf16*)(F.ws + WS_Z);
    LAS unsigned char* ring = F.lds + RING_OFF; float* SSp = (float*)(F.ws + WS_SS); bf16* XA = (bf16*)F.out;

    { FRESH(P); p0_prologue(P, args.in[2], args.in[9], args.in[10], args.in[11], args.in[12], args.in[14], args.in[15], args.in[1], args.in[13]); }
    { FRESH(P); norm0_phase(P, args.in[0], (bf16*)P.out, (float*)(P.ws + WS_SS)); }
    GRID_BAR();

    #pragma unroll 1
    for (int layer = 0; layer < DEPTH; ++layer) {
        const bf16* L = Wb + (size_t)layer * LW_STRIDE;
        { pg8::Gemm g{XA, L + LW_IN, M, NIN, DM, DM, DM}; pg8::StaticOrder S; S.init(M, NIN, F.G, (int)blockIdx.x);
          pg8::EpiZ E{Z, ZS, SSp, args.in[4] + layer * 64, args.in[5] + layer * 64, args.in[6] + layer * 64, (const float*)(F.ws + WS_ROPE64)};
          pg8::gemm_phase<pg8::EpiZ, pg8::StaticOrder, true, true>(ring, g, S, E, F.wave); }
        GRID_BAR();
#ifdef PROBE_PP
        { FRESH(P); post_phase(P, args.in[4] + layer * 64, args.in[5] + layer * 64, args.in[6] + layer * 64, args.in[7] + layer * 64, args.in[3] + layer * 8, true); }
#endif
        { FRESH(P); post_phase(P, args.in[4] + layer * 64, args.in[5] + layer * 64, args.in[6] + layer * 64, args.in[7] + layer * 64, args.in[3] + layer * 8); }
        { FRESH(P); ret_state_mfma(P); }
        GRID_BAR();
        { FRESH(P); fscan_phase(P); }
        { FRESH(P); ret_scan(P); }
        GRID_BAR();
#ifdef PROBE_RO
        { FRESH(P); ret_out_mfma(P, args.in[8] + layer * 512, true); }
#endif
        { FRESH(P); ret_out_mfma(P, args.in[8] + layer * 512); }
#ifdef PROBE_X3
        for (int rep_ = 0; rep_ < 2; ++rep_)
        { static_assert(attn_body::ATTN_LDS_BYTES <= RING_BYTES, "attention scratch fits the ring region");
          unsigned char* wsl = F.ws; asm volatile("" : "+s"(wsl));
          bf16* Zl = (bf16*)(wsl + WS_Z);
          const attn_body::AttnTensors AT{(const attn_body::bf16*)(Zl + Z_FQ), (const attn_body::bf16*)(Zl + Z_FK), (const attn_body::bf16*)(Zl + Z_FV), (attn_body::bf16*)(Zl + (rep_ == 0 ? Z_RQ : Z_FQ)), (const float*)(wsl + WS_CF)};
          const attn_body::StaticOrder S((int)F.G, (int)blockIdx.x);
          attn_body::attn_phase<attn_body::StaticOrder, 20>((char*)lds + RING_OFF, AT, S, F.wave); }
#ifdef PROBE_X4
        { FRESH(P); dsa_v3(P); }
#else
        for (int rep_ = 0; rep_ < 2; ++rep_) { FRESH(P); dsa_v3(P, rep_ == 0 ? Z_RG : Z_DQ); }
#endif
#else
        { static_assert(attn_body::ATTN_LDS_BYTES <= RING_BYTES, "attention scratch fits the ring region");
          unsigned char* wsl = F.ws; asm volatile("" : "+s"(wsl));
          bf16* Zl = (bf16*)(wsl + WS_Z);
          float dskip; { const int ln = lane_id_v(); const float gq = wave_max(fabsf(args.in[4][layer * 64 + ln])), gk = wave_max(fabsf(args.in[5][layer * 64 + ln])); dskip = 2.0f * (64.0f * C2 * gq * gk * 1.02f) + 48.0f; }
          const attn_body::AttnTensors AT{(const attn_body::bf16*)(Zl + Z_FQ), (const attn_body::bf16*)(Zl + Z_FK), (const attn_body::bf16*)(Zl + Z_FV), (attn_body::bf16*)(Zl + Z_FQ), (const float*)(wsl + WS_CF), dskip};
          const attn_body::StaticOrder S((int)F.G, (int)blockIdx.x);
          attn_body::attn_phase<attn_body::StaticOrder, 20>((char*)lds + RING_OFF, AT, S, F.wave); }
        { FRESH(P); dsa_v3(P); }
#endif
        GRID_BAR();
        { pg8::Gemm g{Z + Z_FQ, L + LW_MIX, M, DM, 1536, ZP, 1536}; pg8::StaticOrder S; S.init(M, DM, F.G, (int)blockIdx.x);
          pg8::EpiGateF E{Z + Z_ZG, Z + Z_MRG};
          pg8::gemm_phase<pg8::EpiGateF, pg8::StaticOrder, false, true>(ring, g, S, E, F.wave); }
        GRID_BAR();
        { pg8::Gemm g{Z + Z_MRG, L + LW_O, M, DM, DM, ZP, DM}; pg8::StaticOrder S; S.init(M, DM, F.G, (int)blockIdx.x);
          pg8::EpiRes E{XA, HDN, nullptr, SSp};
          pg8::gemm_phase<pg8::EpiRes, pg8::StaticOrder, false, true>(ring, g, S, E, F.wave); }
        GRID_BAR();
        { pg8::Gemm g{HDN, L + LW_FI, M, FF2, DM, DM, DM}; pg8::StaticOrder S; S.init(M, FF2, F.G, (int)blockIdx.x);
          pg8::EpiSwi E{HB, FFH, SSp};
          pg8::gemm_phase<pg8::EpiSwi, pg8::StaticOrder, true, true>(ring, g, S, E, F.wave); }
        GRID_BAR();
        { pg8::Gemm g{HB, L + LW_FO, M, DM, FFH, FFH, FFH}; pg8::StaticOrder S; S.init(M, DM, F.G, (int)blockIdx.x);
          pg8::EpiRes E{HDN, XA, (layer + 1 < DEPTH) ? nullptr : F.out, SSp};
          pg8::gemm_phase<pg8::EpiRes, pg8::StaticOrder, false, true>(ring, g, S, E, F.wave); }
        GRID_BAR();
    }
    if (__hip_atomic_load((gu32*)((unsigned*)(ctl + CW_BAR) + XB_TMO), RLX_AGENT) != 0u) {
        const float q = __builtin_nanf("");
        for (int m = F.gw; m < M; m += F.NGW) { GAS f32x4* o = (GAS f32x4*)(F.out + (size_t)m * DM) + lane_id_v();
#pragma unroll
            for (int j = 0; j < 4; ++j) o[64 * j] = (f32x4){q, q, q, q}; }
    }
}

extern "C" void kernel_launch(void* const* d_in, const int* in_sizes, int n_in, void* d_out, int out_size, void* d_ws, size_t ws_size, hipStream_t stream) {
    static int grid = 0;
    if (grid == 0) {
        if (n_in != 16 || in_sizes[0] != M * DM || out_size != M * DM || ws_size < WS_END) { fprintf(stderr, "kernel_launch: unexpected shapes / workspace (n_in %d, in0 %d, out %d, ws %zu < %zu)\n", n_in, n_in > 0 ? in_sizes[0] : -1, out_size, ws_size, (size_t)WS_END); grid = -1; return; }
        int dev = 0, cus = 0, per_cu = 0;
        if (hipGetDevice(&dev) != hipSuccess || hipDeviceGetAttribute(&cus, hipDeviceAttributeMultiprocessorCount, dev) != hipSuccess) { grid = -1; return; }
        if (hipFuncSetAttribute((const void*)hyb_fwd, hipFuncAttributeMaxDynamicSharedMemorySize, LDS_BYTES) != hipSuccess) { fprintf(stderr, "kernel_launch: hipFuncSetAttribute failed\n"); grid = -1; return; }
        if (hipOccupancyMaxActiveBlocksPerMultiprocessor(&per_cu, (const void*)hyb_fwd, NWAVES * 64, LDS_BYTES) != hipSuccess || per_cu < 1) { fprintf(stderr, "kernel_launch: occupancy query reports %d blocks per CU\n", per_cu); }
        (void)hipGetLastError();
        grid = cus;
    }
    if (grid < 0) return;
    if (hipMemsetAsync((char*)d_ws + WS_CTL, 0, CTL_ZERO_BYTES, stream) != hipSuccess) return;
    Args a{};
    for (int i = 0; i < 16; ++i) a.in[i] = (const float*)d_in[i];
    a.out = (float*)d_out; a.ws = (unsigned char*)d_ws;
    hipLaunchKernelGGL(hyb_fwd, dim3(grid), dim3(NWAVES * 64), LDS_BYTES, stream, a);
}
```

```cpp
#include <hip/hip_runtime.h>
#include <cstdio>
#include <cstdint>
#include <cmath>
__device__ __forceinline__ int lane_id_v() { unsigned z; asm volatile("v_mov_b32 %0, 0" : "=v"(z)); return (int)__builtin_amdgcn_mbcnt_hi(~0u, __builtin_amdgcn_mbcnt_lo(~0u, z)); }
template <int MASK> __device__ __forceinline__ float sx(float v) { static_assert(MASK < 32, "swizzle xor mask"); return __builtin_bit_cast(float, __builtin_amdgcn_ds_swizzle(__builtin_bit_cast(int, v), 0x1F | (MASK << 10))); }
template <int MASK> __device__ __forceinline__ unsigned sxu(unsigned v) { return (unsigned)__builtin_amdgcn_ds_swizzle((int)v, 0x1F | (MASK << 10)); }
__device__ __forceinline__ void swap32(unsigned x, unsigned& lo_view, unsigned& hi_view) {
    unsigned a = x, b = x; asm volatile("" : "+v"(b));
    const auto rr = __builtin_amdgcn_permlane32_swap(a, b, false, false);
    lo_view = rr[0]; hi_view = rr[1];
}
template <int CTRL> __device__ __forceinline__ float dpp_f(float v) { return __builtin_bit_cast(float, __builtin_amdgcn_update_dpp(0, __builtin_bit_cast(int, v), CTRL, 0xF, 0xF, false)); }
template <int CTRL> __device__ __forceinline__ int dpp_i(int v) { return __builtin_amdgcn_update_dpp(0, v, CTRL, 0xF, 0xF, false); }
__device__ __forceinline__ float rl_f(float v, int l) { return __builtin_bit_cast(float, __builtin_amdgcn_readlane(__builtin_bit_cast(int, v), l)); }
__device__ __forceinline__ float wave_sum(float v) {
    v += dpp_f<0xB1>(v); v += dpp_f<0x4E>(v); v += dpp_f<0x141>(v); v += dpp_f<0x140>(v);
    return (rl_f(v, 0) + rl_f(v, 16)) + (rl_f(v, 32) + rl_f(v, 48));
}
__device__ __forceinline__ float wave_max(float v) {
    v = fmaxf(v, dpp_f<0xB1>(v)); v = fmaxf(v, dpp_f<0x4E>(v)); v = fmaxf(v, dpp_f<0x141>(v)); v = fmaxf(v, dpp_f<0x140>(v));
    return fmaxf(fmaxf(rl_f(v, 0), rl_f(v, 16)), fmaxf(rl_f(v, 32), rl_f(v, 48)));
}
__device__ __forceinline__ int wave_isum(int v) {
    v += dpp_i<0xB1>(v); v += dpp_i<0x4E>(v); v += dpp_i<0x141>(v); v += dpp_i<0x140>(v);
    return (__builtin_amdgcn_readlane(v, 0) + __builtin_amdgcn_readlane(v, 16)) + (__builtin_amdgcn_readlane(v, 32) + __builtin_amdgcn_readlane(v, 48));
}
__device__ __forceinline__ unsigned wave_umax(unsigned v) {
    unsigned t; t = (unsigned)dpp_i<0xB1>((int)v); v = t > v ? t : v; t = (unsigned)dpp_i<0x4E>((int)v); v = t > v ? t : v; t = (unsigned)dpp_i<0x141>((int)v); v = t > v ? t : v; t = (unsigned)dpp_i<0x140>((int)v); v = t > v ? t : v;
    const unsigned a = (unsigned)__builtin_amdgcn_readlane((int)v, 0), b = (unsigned)__builtin_amdgcn_readlane((int)v, 16), c = (unsigned)__builtin_amdgcn_readlane((int)v, 32), d = (unsigned)__builtin_amdgcn_readlane((int)v, 48);
    const unsigned ab = a > b ? a : b, cd = c > d ? c : d; return ab > cd ? ab : cd;
}
__device__ __forceinline__ unsigned wave_umin(unsigned v) { return ~wave_umax(~v); }
__device__ __forceinline__ float half_sum(float v) {
    unsigned a, b; swap32(__builtin_bit_cast(unsigned, v), a, b); return __builtin_bit_cast(float, a) + __builtin_bit_cast(float, b);
}
__device__ __forceinline__ float half_max(float v) {
    unsigned a, b; swap32(__builtin_bit_cast(unsigned, v), a, b); return fmaxf(__builtin_bit_cast(float, a), __builtin_bit_cast(float, b));
}
namespace pg8 {
#define PG8_LAS __attribute__((address_space(3)))
typedef unsigned short bf16_t;
typedef short bf16x8 __attribute__((ext_vector_type(8)));
typedef float f32x4 __attribute__((ext_vector_type(4)));
typedef unsigned u32x4 __attribute__((ext_vector_type(4)));
constexpr int BM = 256, BK = 64, HALF = 128, HTB = HALF * BK * 2  , STAGE_BYTES = 8 * HTB, NXCD = 8, WGM = 8;

__host__ __device__ __forceinline__ int lds_byte(int r, int c) { const int st = (r >> 4) * 2 + (c >> 5), rr = r & 15, cc = c & 31, ob = rr * 64 + cc * 2; return st * 1024 + (ob ^ (((ob >> 9) & 1) << 5)); }
__host__ __device__ __forceinline__ void stage_rc(int b, int& R, int& C) { const int st = b / 1024, sb = b % 1024, swz = sb ^ (((sb >> 9) & 1) << 5); R = (st >> 1) * 16 + swz / 64; C = (st & 1) * 32 + (swz % 64) / 2; }
__host__ __device__ __forceinline__ int perm32(int rho) { const int n = rho >> 4, i = rho & 15; return 8 * (i >> 2) + 4 * n + (i & 3); }

struct Unit { int pm, pn; };
struct Gemm { const bf16_t* A; const bf16_t* Bt; int M, N, K, lda, ldb; };

struct StaticOrder {
    int nM, nN, nwg, G, c;
    __host__ __device__ void init(int M, int N, int G_, int c_) { nM = M / BM; nN = N / BM; nwg = nM * nN; G = G_; c = c_; }
    __host__ __device__ bool next(int i, Unit& u) const {
        const long L = (long)i * G + c; if (L >= nwg) return false;
        int wgid = (int)L; { const int q = nwg / NXCD, r = nwg % NXCD, xcd = wgid % NXCD, off = wgid / NXCD; wgid = (xcd < r ? xcd * (q + 1) : r * (q + 1) + (xcd - r) * q) + off; }
        const int nig = WGM * nN, gid = wgid / nig, fm = gid * WGM, gsz = (nM - fm) < WGM ? (nM - fm) : WGM;
        u.pm = fm + ((wgid % nig) % gsz); u.pn = (wgid % nig) / gsz; return true;
    }
    __device__ __forceinline__ void a_ready(const Unit&) const {}
    __device__ __forceinline__ void done(const Unit&) const {}
};

__device__ __forceinline__ unsigned cvt_pk_bf16(float lo, float hi) { unsigned r; asm volatile("v_cvt_pk_bf16_f32 %0, %1, %2" : "=v"(r) : "v"(lo), "v"(hi)); return r; }
__device__ __forceinline__ float bflo(unsigned w) { return __builtin_bit_cast(float, w << 16); }
__device__ __forceinline__ float bfhi(unsigned w) { return __builtin_bit_cast(float, w & 0xffff0000u); }
__device__ __forceinline__ float sigmoidf_(float x) { return __builtin_amdgcn_rcpf(1.0f + __builtin_amdgcn_exp2f(-1.4426950408889634f * x)); }

constexpr int ZP = 6656;
constexpr int ZSP = 512;
constexpr int NZT = 26, GATE_T0 = 14, Z_GATE = 3584;
typedef unsigned u32x2 __attribute__((ext_vector_type(2)));

#define PRELOAD_RSTD(rsv, SS_, row0_) float rsv[2][4]; { f32x4 s_[2][4]; _Pragma("unroll") for (int ai_ = 0; ai_ < 2; ++ai_) _Pragma("unroll") for (int m_ = 0; m_ < 4; ++m_) s_[ai_][m_] = *(const f32x4*)((SS_) + (size_t)((row0_) + ai_ * HALF + m_ * 16) * 4); \
    _Pragma("unroll") for (int ai_ = 0; ai_ < 2; ++ai_) _Pragma("unroll") for (int m_ = 0; m_ < 4; ++m_) rsv[ai_][m_] = 1.0f / __builtin_sqrtf(((s_[ai_][m_][0] + s_[ai_][m_][1]) + (s_[ai_][m_][2] + s_[ai_][m_][3])) * (1.0f / 1024.0f) + 1e-6f); }
struct EpiZ {
    static constexpr bool PERM = true, AFTER_DRAIN = false, MID = false;
    bf16_t* Z; float* ZS; const float* SS; const float* GQ; const float* GK; const float* GD; const float* R64;
    __device__ __forceinline__ void operator()(const f32x4 (&acc)[2][2][4][2], const Unit& u, int wr, int wc, int fr, int fq) const {
        const int row0 = u.pm * BM + wr * 64 + fr;
        PRELOAD_RSTD(rsv, SS, row0);
        if (u.pn < 4 || u.pn == 6 || u.pn == 7) {
            const float osc = (u.pn < 4) ? 0.18033688011112042f : 1.0f; const bool rope = (u.pn == 2 || u.pn == 3);
            f32x4 g00, g01, g10, g11;
            if (u.pn < 2) { g00 = *(const f32x4*)(GQ + 8 * fq); g01 = *(const f32x4*)(GQ + 8 * fq + 4); g10 = *(const f32x4*)(GQ + 32 + 8 * fq); g11 = *(const f32x4*)(GQ + 32 + 8 * fq + 4); }
            else if (u.pn < 4) { g00 = *(const f32x4*)(GD + 8 * fq); g01 = *(const f32x4*)(GD + 8 * fq + 4); g10 = *(const f32x4*)(GD + 32 + 8 * fq); g11 = *(const f32x4*)(GD + 32 + 8 * fq + 4); }
            else { g00 = *(const f32x4*)(GK + 8 * fq); g01 = *(const f32x4*)(GK + 8 * fq + 4); g10 = *(const f32x4*)(GK + 32 + 8 * fq); g11 = *(const f32x4*)(GK + 32 + 8 * fq + 4); }
            const int colo = u.pn * BM + wc * 64 + 8 * fq;
#pragma unroll
            for (int ai = 0; ai < 2; ++ai)
#pragma unroll
                for (int m = 0; m < 4; ++m) { const int row = row0 + ai * HALF + m * 16; const float rs = rsv[ai][m];
                    f32x4 a0 = acc[ai][0][m][0] * rs, a1 = acc[ai][0][m][1] * rs, b0 = acc[ai][1][m][0] * rs, b1 = acc[ai][1][m][1] * rs;
                    float ss = ((a0[0] * a0[0] + a0[1] * a0[1]) + (a0[2] * a0[2] + a0[3] * a0[3])) + ((a1[0] * a1[0] + a1[1] * a1[1]) + (a1[2] * a1[2] + a1[3] * a1[3]))
                             + ((b0[0] * b0[0] + b0[1] * b0[1]) + (b0[2] * b0[2] + b0[3] * b0[3])) + ((b1[0] * b1[0] + b1[1] * b1[1]) + (b1[2] * b1[2] + b1[3] * b1[3]));
                    ss += sx<16>(ss); { unsigned x_, y_; swap32(__builtin_bit_cast(unsigned, ss), x_, y_); ss = __builtin_bit_cast(float, x_) + __builtin_bit_cast(float, y_); }
                    const float hr = osc / __builtin_sqrtf(ss * (1.0f / 64.0f) + 1e-6f);
                    a0 = a0 * g00 * hr; a1 = a1 * g01 * hr; b0 = b0 * g10 * hr; b1 = b1 * g11 * hr;
                    if (rope) { const float* cs = R64 + ((size_t)(row & 4095) * 32 + 8 * fq) * 2;
                        const f32x4 c0 = *(const f32x4*)cs, c1 = *(const f32x4*)(cs + 4), c2 = *(const f32x4*)(cs + 8), c3 = *(const f32x4*)(cs + 12);
                        f32x4 x0, x1, y0, y1;
                        x0[0] = a0[0] * c0[0] - b0[0] * c0[1]; y0[0] = b0[0] * c0[0] + a0[0] * c0[1]; x0[1] = a0[1] * c0[2] - b0[1] * c0[3]; y0[1] = b0[1] * c0[2] + a0[1] * c0[3];
                        x0[2] = a0[2] * c1[0] - b0[2] * c1[1]; y0[2] = b0[2] * c1[0] + a0[2] * c1[1]; x0[3] = a0[3] * c1[2] - b0[3] * c1[3]; y0[3] = b0[3] * c1[2] + a0[3] * c1[3];
                        x1[0] = a1[0] * c2[0] - b1[0] * c2[1]; y1[0] = b1[0] * c2[0] + a1[0] * c2[1]; x1[1] = a1[1] * c2[2] - b1[1] * c2[3]; y1[1] = b1[1] * c2[2] + a1[1] * c2[3];
                        x1[2] = a1[2] * c3[0] - b1[2] * c3[1]; y1[2] = b1[2] * c3[0] + a1[2] * c3[1]; x1[3] = a1[3] * c3[2] - b1[3] * c3[3]; y1[3] = b1[3] * c3[2] + a1[3] * c3[3];
                        a0 = x0; a1 = x1; b0 = y0; b1 = y1; }
                    bf16_t* rowp = Z + (size_t)row * ZP + colo;
                    u32x4 w; w.x = cvt_pk_bf16(a0[0], a0[1]); w.y = cvt_pk_bf16(a0[2], a0[3]); w.z = cvt_pk_bf16(a1[0], a1[1]); w.w = cvt_pk_bf16(a1[2], a1[3]); *(u32x4*)rowp = w;
                    w.x = cvt_pk_bf16(b0[0], b0[1]); w.y = cvt_pk_bf16(b0[2], b0[3]); w.z = cvt_pk_bf16(b1[0], b1[1]); w.w = cvt_pk_bf16(b1[2], b1[3]); *(u32x4*)(rowp + 32) = w;
                    __builtin_amdgcn_sched_barrier(0); }
        } else if (u.pn >= GATE_T0 && u.pn < NZT) {
            unsigned char* gb = (unsigned char*)(Z + Z_GATE) + (u.pn - GATE_T0) * 256 + wc * 32 + 8 * fq;
#pragma unroll
            for (int ai = 0; ai < 2; ++ai)
#pragma unroll
                for (int m = 0; m < 4; ++m) { const float rs = rsv[ai][m]; unsigned char* rowp = gb + (size_t)(row0 + ai * HALF + m * 16) * (ZP * 2);
#pragma unroll
                    for (int bj = 0; bj < 2; ++bj) { const f32x4 v0 = acc[ai][bj][m][0] * rs, v1 = acc[ai][bj][m][1] * rs; u32x2 w = {0u, 0u};
#pragma unroll
                        for (int i = 0; i < 4; ++i) { w.x = __builtin_amdgcn_cvt_pk_u8_f32(__builtin_fmaxf(255.0f * sigmoidf_(v0[i]), 1.0f), i, w.x); w.y = __builtin_amdgcn_cvt_pk_u8_f32(__builtin_fmaxf(255.0f * sigmoidf_(v1[i]), 1.0f), i, w.y); }
                        *(u32x2*)(rowp + bj * HALF) = w; } }
        } else if (u.pn < NZT) {
            const int col0 = u.pn * BM + wc * 32 + 8 * fq;
#pragma unroll
            for (int ai = 0; ai < 2; ++ai)
#pragma unroll
                for (int m = 0; m < 4; ++m) { bf16_t* rowp = Z + (size_t)(row0 + ai * HALF + m * 16) * ZP + col0; const float rs = rsv[ai][m];
#pragma unroll
                    for (int bj = 0; bj < 2; ++bj) { const f32x4 v0 = acc[ai][bj][m][0] * rs, v1 = acc[ai][bj][m][1] * rs;
                        u32x4 w; w.x = cvt_pk_bf16(v0[0], v0[1]); w.y = cvt_pk_bf16(v0[2], v0[3]); w.z = cvt_pk_bf16(v1[0], v1[1]); w.w = cvt_pk_bf16(v1[2], v1[3]);
                        *(u32x4*)(rowp + bj * HALF) = w; } }
        } else {
            const int col0 = (u.pn - NZT) * BM + wc * 32 + 8 * fq;
#pragma unroll
            for (int ai = 0; ai < 2; ++ai)
#pragma unroll
                for (int m = 0; m < 4; ++m) { float* rowp = ZS + (size_t)(row0 + ai * HALF + m * 16) * ZSP + col0; const float rs = rsv[ai][m];
#pragma unroll
                    for (int bj = 0; bj < 2; ++bj) { *(f32x4*)(rowp + bj * HALF) = acc[ai][bj][m][0] * rs; *(f32x4*)(rowp + bj * HALF + 4) = acc[ai][bj][m][1] * rs; } }
        }
    }
};

template <int P> struct EpiGate {
    static constexpr bool PERM = true, AFTER_DRAIN = false, MID = false;
    const bf16_t* G;
    float* M32;
    bf16_t* OUT;
    __device__ __forceinline__ void operator()(const f32x4 (&acc)[2][2][4][2], const Unit& u, int wr, int wc, int fr, int fq) const {
        const int row0 = u.pm * BM + wr * 64 + fr, col0 = u.pn * BM + wc * 32 + 8 * fq;
#pragma unroll
        for (int ai = 0; ai < 2; ++ai)
#pragma unroll
            for (int m = 0; m < 4; ++m) { const size_t row = (size_t)(row0 + ai * HALF + m * 16);
#pragma unroll
                for (int bj = 0; bj < 2; ++bj) { const int col = col0 + bj * HALF;
                    const u32x4 gw = *(const u32x4*)(G + row * ZP + P * 1024 + col);
                    const f32x4 v0 = acc[ai][bj][m][0], v1 = acc[ai][bj][m][1];
                    f32x4 t0, t1;
                    t0[0] = bflo(gw.x) * v0[0]; t0[1] = bfhi(gw.x) * v0[1]; t0[2] = bflo(gw.y) * v0[2]; t0[3] = bfhi(gw.y) * v0[3];
                    t1[0] = bflo(gw.z) * v1[0]; t1[1] = bfhi(gw.z) * v1[1]; t1[2] = bflo(gw.w) * v1[2]; t1[3] = bfhi(gw.w) * v1[3];
                    float* mp = M32 + row * 1024 + col;
                    if (P == 0) { *(f32x4*)mp = t0; *(f32x4*)(mp + 4) = t1; }
                    else if (P == 1) { *(f32x4*)mp = *(const f32x4*)mp + t0; *(f32x4*)(mp + 4) = *(const f32x4*)(mp + 4) + t1; }
                    else { t0 = *(const f32x4*)mp + t0; t1 = *(const f32x4*)(mp + 4) + t1;
                        u32x4 w; w.x = cvt_pk_bf16(t0[0], t0[1]); w.y = cvt_pk_bf16(t0[2], t0[3]); w.z = cvt_pk_bf16(t1[0], t1[1]); w.w = cvt_pk_bf16(t1[2], t1[3]);
                        *(u32x4*)(OUT + row * ZP + col) = w; } } }
    }
};

struct EpiGateF {
    static constexpr bool PERM = true, AFTER_DRAIN = false, MID = true;
    const unsigned char* G; bf16_t* OUT;
    __device__ __forceinline__ void mid(f32x4 (&acc)[2][2][4][2], const Unit& u, int wr, int wc, int fr_, int fq_, int s) const {
        int fr = fr_, fq = fq_; asm volatile("" : "+v"(fr), "+v"(fq));
        const int row0 = u.pm * BM + wr * 64 + fr, col0 = u.pn * BM + wc * 32 + 8 * fq;
        u32x2 ga[2][4][2], gb[2][4][2];
#pragma unroll
        for (int ai = 0; ai < 2; ++ai)
#pragma unroll
            for (int m = 0; m < 4; ++m)
#pragma unroll
                for (int bj = 0; bj < 2; ++bj) { const unsigned char* gp = G + (size_t)(row0 + ai * HALF + m * 16) * (ZP * 2) + s * 1024 + col0 + bj * HALF; ga[ai][m][bj] = *(const u32x2*)gp; gb[ai][m][bj] = *(const u32x2*)(gp + 1024); }
#pragma unroll
        for (int ai = 0; ai < 2; ++ai)
#pragma unroll
            for (int m = 0; m < 4; ++m)
#pragma unroll
                for (int bj = 0; bj < 2; ++bj) { const u32x2 a = ga[ai][m][bj], b = gb[ai][m][bj]; f32x4 r0, r1;
                    r0[0] = (float)(a.x & 255u) * __builtin_amdgcn_rcpf((float)(b.x & 255u)); r0[1] = (float)((a.x >> 8) & 255u) * __builtin_amdgcn_rcpf((float)((b.x >> 8) & 255u));
                    r0[2] = (float)((a.x >> 16) & 255u) * __builtin_amdgcn_rcpf((float)((b.x >> 16) & 255u)); r0[3] = (float)(a.x >> 24) * __builtin_amdgcn_rcpf((float)(b.x >> 24));
                    r1[0] = (float)(a.y & 255u) * __builtin_amdgcn_rcpf((float)(b.y & 255u)); r1[1] = (float)((a.y >> 8) & 255u) * __builtin_amdgcn_rcpf((float)((b.y >> 8) & 255u));
                    r1[2] = (float)((a.y >> 16) & 255u) * __builtin_amdgcn_rcpf((float)((b.y >> 16) & 255u)); r1[3] = (float)(a.y >> 24) * __builtin_amdgcn_rcpf((float)(b.y >> 24));
                    acc[ai][bj][m][0] = acc[ai][bj][m][0] * r0; acc[ai][bj][m][1] = acc[ai][bj][m][1] * r1; }
    }
    __device__ __forceinline__ void operator()(const f32x4 (&acc)[2][2][4][2], const Unit& u, int wr, int wc, int fr, int fq) const {
        const int row0 = u.pm * BM + wr * 64 + fr, col0 = u.pn * BM + wc * 32 + 8 * fq; const float k255 = 1.0f / 255.0f;
#pragma unroll
        for (int ai = 0; ai < 2; ++ai)
#pragma unroll
            for (int m = 0; m < 4; ++m) { const size_t row = (size_t)(row0 + ai * HALF + m * 16);
#pragma unroll
                for (int bj = 0; bj < 2; ++bj) { const int col = col0 + bj * HALF;
                    const u32x2 gw = *(const u32x2*)(G + row * (ZP * 2) + 2 * 1024 + col);
                    const f32x4 v0 = acc[ai][bj][m][0] * k255, v1 = acc[ai][bj][m][1] * k255;
                    u32x4 w; w.x = cvt_pk_bf16((float)(gw.x & 255u) * v0[0], (float)((gw.x >> 8) & 255u) * v0[1]); w.y = cvt_pk_bf16((float)((gw.x >> 16) & 255u) * v0[2], (float)(gw.x >> 24) * v0[3]);
                    w.z = cvt_pk_bf16((float)(gw.y & 255u) * v1[0], (float)((gw.y >> 8) & 255u) * v1[1]); w.w = cvt_pk_bf16((float)((gw.y >> 16) & 255u) * v1[2], (float)(gw.y >> 24) * v1[3]);
                    *(u32x4*)(OUT + row * ZP + col) = w; } }
    }
};

struct EpiRes {
    static constexpr bool PERM = true, AFTER_DRAIN = true, MID = false;
    const bf16_t* RES; bf16_t* OUT; float* OUT32; float* SS;
    __device__ __forceinline__ void fused(const f32x4 (&acc)[2][2][4][2], const Unit& u, int wr, int wc, int fr, int fq, PG8_LAS unsigned char* lds, int wid, int lane) const {
        const int row0 = u.pm * BM + wr * 64 + fr, col0 = u.pn * BM + wc * 32 + 8 * fq;
        PG8_LAS float* P = (PG8_LAS float*)lds;
#pragma unroll
        for (int ai = 0; ai < 2; ++ai)
#pragma unroll
            for (int m = 0; m < 4; ++m) { const int row = row0 + ai * HALF + m * 16; const size_t off = (size_t)row * 1024 + col0; float ss = 0.f;
#pragma unroll
                for (int bj = 0; bj < 2; ++bj) { const u32x4 r = *(const u32x4*)(RES + off + bj * HALF);
                    f32x4 v0 = acc[ai][bj][m][0], v1 = acc[ai][bj][m][1];
                    v0[0] += bflo(r.x); v0[1] += bfhi(r.x); v0[2] += bflo(r.y); v0[3] += bfhi(r.y); v1[0] += bflo(r.z); v1[1] += bfhi(r.z); v1[2] += bflo(r.w); v1[3] += bfhi(r.w);
                    ss += ((v0[0] * v0[0] + v0[1] * v0[1]) + (v0[2] * v0[2] + v0[3] * v0[3])) + ((v1[0] * v1[0] + v1[1] * v1[1]) + (v1[2] * v1[2] + v1[3] * v1[3]));
                    if (OUT32) { float* op = OUT32 + off + bj * HALF; *(f32x4*)op = v0; *(f32x4*)(op + 4) = v1; }
                    else { u32x4 w; w.x = cvt_pk_bf16(v0[0], v0[1]); w.y = cvt_pk_bf16(v0[2], v0[3]); w.z = cvt_pk_bf16(v1[0], v1[1]); w.w = cvt_pk_bf16(v1[2], v1[3]); *(u32x4*)(OUT + off + bj * HALF) = w; } }
                ss += sx<16>(ss); { unsigned a, b; swap32(__builtin_bit_cast(unsigned, ss), a, b); ss = __builtin_bit_cast(float, a) + __builtin_bit_cast(float, b); }
                if (fq == 0) P[(ai * HALF + wr * 64 + m * 16 + fr) * 4 + wc] = ss; }
        asm volatile("s_waitcnt lgkmcnt(0)\n\ts_barrier" ::: "memory");
        const int t = wid * 64 + lane;
        if (t < 256) { const f32x4 p = *(const PG8_LAS f32x4*)(P + t * 4); SS[(size_t)(u.pm * BM + t) * 4 + u.pn] = (p[0] + p[1]) + (p[2] + p[3]); }
    }
};

struct EpiSwi {
    static constexpr bool PERM = true, AFTER_DRAIN = false, MID = false;
    bf16_t* H; int ldh; const float* SS;
    __device__ __forceinline__ void operator()(const f32x4 (&acc)[2][2][4][2], const Unit& u, int wr, int wc, int fr, int fq) const {
        const int row0 = u.pm * BM + wr * 64 + fr, col0 = u.pn * HALF + wc * 32 + 8 * fq;
        PRELOAD_RSTD(rsv, SS, row0);
#pragma unroll
        for (int ai = 0; ai < 2; ++ai)
#pragma unroll
            for (int m = 0; m < 4; ++m) { bf16_t* hp = H + (size_t)(row0 + ai * HALF + m * 16) * ldh + col0; const float rs = rsv[ai][m];
                float o[8];
#pragma unroll
                for (int n = 0; n < 2; ++n)
#pragma unroll
                    for (int i = 0; i < 4; ++i) { const float g = acc[ai][0][m][n][i] * rs, up = acc[ai][1][m][n][i] * rs; o[4 * n + i] = g * sigmoidf_(g) * up; }
                u32x4 w; w.x = cvt_pk_bf16(o[0], o[1]); w.y = cvt_pk_bf16(o[2], o[3]); w.z = cvt_pk_bf16(o[4], o[5]); w.w = cvt_pk_bf16(o[6], o[7]);
                *(u32x4*)hp = w; }
    }
};

template <class Epi, class Sched, bool ALIGN_EPI = false, bool SP2 = false>
__device__ __forceinline__ void gemm_phase(PG8_LAS unsigned char* lds, Gemm g, const Sched& S0, const Epi& E, int wave_id) {
    int ovz, osz; asm volatile("v_mov_b32 %0, 0\n\ts_mov_b32 %1, 0" : "=v"(ovz), "=s"(osz));
    Sched S = S0; S.c += osz; g.lda += osz; g.ldb += osz;
    const int tid = ((wave_id << 6) | lane_id_v()) + ovz,
         wid = __builtin_amdgcn_readfirstlane(tid >> 6), lane = tid & 63, wr = wid >> 2, wc = wid & 3, fr = lane & 15, fq = lane >> 4;
    const int K = g.K, nt = K / BK;
    unsigned voffA[2], voffB[2];
#pragma unroll
    for (int i = 0; i < 2; ++i) { int R, C; stage_rc(tid * 16 + i * 8192, R, C); const int Rb = Epi::PERM ? ((R & ~31) + perm32(R & 31)) : R;
        voffA[i] = (unsigned)(R * g.lda + C) * 2u; voffB[i] = (unsigned)(Rb * g.ldb + C) * 2u; }
    const size_t kstep = (size_t)(BK * 2);
    const size_t hstepA = (size_t)HALF * g.lda * 2, hstepB = (size_t)HALF * g.ldb * 2;
    const size_t tstepA = 2 * hstepA, tstepB = 2 * hstepB;
    const unsigned ldsw = (unsigned)wid * 1024u;
    const int aoff = lds_byte(wr * 64 + fr, fq * 8), boff = lds_byte(wc * 32 + fr, fq * 8);
#define PG8_SA(b, h) (((b) * 2 + (h)) * HTB)
#define PG8_SB(b, h) ((4 + (b) * 2 + (h)) * HTB)
#define PG8_STAGE(bufoff, gbase, voff) do { _Pragma("unroll") for (int _i = 0; _i < 2; ++_i) \
        __builtin_amdgcn_global_load_lds((const unsigned*)((const char*)(gbase) + (voff)[_i]), (PG8_LAS unsigned*)(lds + (bufoff) + ldsw + _i * 8192), 16, 0, 0); } while (0)
#define PG8_LDA(dst, b, h) do { _Pragma("unroll") for (int m = 0; m < 4; ++m) _Pragma("unroll") for (int k = 0; k < 2; ++k) dst[m][k] = *(const PG8_LAS bf16x8*)(lds + PG8_SA(b, h) + aoff + m * 2048 + k * 1024); } while (0)
#define PG8_LDB(dst, b, h) do { _Pragma("unroll") for (int n = 0; n < 2; ++n) _Pragma("unroll") for (int k = 0; k < 2; ++k) dst[n][k] = *(const PG8_LAS bf16x8*)(lds + PG8_SB(b, h) + boff + n * 2048 + k * 1024); } while (0)
#define PG8_MMA(ai, bj, At, Bt) do { __builtin_amdgcn_s_setprio(1); _Pragma("unroll") for (int m = 0; m < 4; ++m) _Pragma("unroll") for (int n = 0; n < 2; ++n) _Pragma("unroll") for (int k = 0; k < 2; ++k) \
        acc[ai][bj][m][n] = __builtin_amdgcn_mfma_f32_16x16x32_bf16(Bt[n][k], At[m][k], acc[ai][bj][m][n], 0, 0, 0); __builtin_amdgcn_s_setprio(0); } while (0)
#define PG8_WAIT_V(n) asm volatile("s_waitcnt vmcnt(" #n ")" ::: "memory")
#define PG8_WAIT_L(n) asm volatile("s_waitcnt lgkmcnt(" #n ")" ::: "memory")
#define PG8_BAR __builtin_amdgcn_s_barrier()
#define PG8_SCHED __builtin_amdgcn_sched_barrier(0)
    Unit cur, nxt; int ui = 0;
    if (!S.next(0, cur)) return;
    f32x4 acc[2][2][4][2];
#pragma unroll
    for (int a = 0; a < 2; ++a)
#pragma unroll
        for (int b = 0; b < 2; ++b)
#pragma unroll
            for (int m = 0; m < 4; ++m)
#pragma unroll
                for (int n = 0; n < 2; ++n) acc[a][b][m][n] = (f32x4){0.f, 0.f, 0.f, 0.f};
    bf16x8 At[4][2], B0[2][2], B1[2][2];
    const char* cA = (const char*)g.A + (size_t)cur.pm * tstepA; const char* cB = (const char*)g.Bt + (size_t)cur.pn * tstepB;
    S.a_ready(cur);
    if constexpr (SP2) {
        PG8_STAGE(PG8_SB(0, 0), cB, voffB); PG8_STAGE(PG8_SB(0, 1), cB + hstepB, voffB); PG8_STAGE(PG8_SA(0, 0), cA, voffA); PG8_STAGE(PG8_SA(0, 1), cA + hstepA, voffA);
        if (wr == 1) PG8_BAR;
        PG8_WAIT_V(2); PG8_BAR;
        PG8_STAGE(PG8_SB(1, 0), cB + kstep, voffB); PG8_STAGE(PG8_SA(1, 0), cA + kstep, voffA); PG8_STAGE(PG8_SB(1, 1), cB + hstepB + kstep, voffB);
        PG8_WAIT_V(6); PG8_BAR;
    } else {
        PG8_STAGE(PG8_SB(0, 0), cB, voffB); PG8_STAGE(PG8_SA(0, 0), cA, voffA); PG8_STAGE(PG8_SB(0, 1), cB + hstepB, voffB); PG8_STAGE(PG8_SA(0, 1), cA + hstepA, voffA);
        if (wr == 1) PG8_BAR;
        PG8_WAIT_V(4); PG8_BAR;
        PG8_STAGE(PG8_SB(1, 0), cB + kstep, voffB); PG8_STAGE(PG8_SA(1, 0), cA + kstep, voffA); PG8_STAGE(PG8_SB(1, 1), cB + hstepB + kstep, voffB);
        PG8_WAIT_V(6); PG8_BAR;
    }
    for (;;) {
        const bool has_next = S.next(ui + 1, nxt);
        const char* nA = has_next ? (const char*)g.A + (size_t)nxt.pm * tstepA : cA; const char* nB = has_next ? (const char*)g.Bt + (size_t)nxt.pn * tstepB : cB;
        for (int t = 0; t < nt; t += 2) {
            if constexpr (Epi::MID) { if (t == 8 || t == 16) E.mid(acc, cur, wr, wc, fr, fq, (t >> 3) - 1); }
            const bool last = (t == nt - 2);
            const char* a1 = cA + (size_t)(t + 1) * kstep;
            const char* a2 = last ? nA : cA + (size_t)(t + 2) * kstep; const char* b2 = last ? nB : cB + (size_t)(t + 2) * kstep;
            const char* a3 = a2 + kstep; const char* b3 = b2 + kstep;
            if (last && has_next) S.a_ready(nxt);
            if constexpr (SP2) {
            PG8_LDB(B0, 0, 0); PG8_LDB(B1, 0, 1); PG8_SCHED; PG8_LDA(At, 0, 0); PG8_STAGE(PG8_SA(1, 1), a1 + hstepA, voffA);
            PG8_WAIT_V(8); PG8_WAIT_L(0); PG8_BAR; PG8_MMA(0, 0, At, B0); PG8_MMA(0, 1, At, B1); PG8_BAR; PG8_SCHED;
            PG8_LDA(At, 0, 1); PG8_STAGE(PG8_SB(0, 0), b2, voffB); PG8_STAGE(PG8_SB(0, 1), b2 + hstepB, voffB); PG8_STAGE(PG8_SA(0, 0), a2, voffA);
            PG8_WAIT_V(8); PG8_WAIT_L(0); PG8_BAR; PG8_MMA(1, 0, At, B0); PG8_MMA(1, 1, At, B1); PG8_BAR; PG8_SCHED;
            PG8_LDB(B0, 1, 0); PG8_LDB(B1, 1, 1); PG8_SCHED; PG8_LDA(At, 1, 0); PG8_STAGE(PG8_SA(0, 1), a2 + hstepA, voffA);
            PG8_WAIT_V(8); PG8_WAIT_L(0); PG8_BAR; PG8_MMA(0, 0, At, B0); PG8_MMA(0, 1, At, B1); PG8_BAR; PG8_SCHED;
            PG8_LDA(At, 1, 1); PG8_STAGE(PG8_SB(1, 0), b3, voffB); PG8_STAGE(PG8_SB(1, 1), b3 + hstepB, voffB); PG8_STAGE(PG8_SA(1, 0), a3, voffA);
            PG8_WAIT_V(8); PG8_WAIT_L(0); PG8_BAR; PG8_MMA(1, 0, At, B0); PG8_MMA(1, 1, At, B1); PG8_BAR; PG8_SCHED;
            } else {
            PG8_LDB(B0, 0, 0); PG8_SCHED; PG8_LDA(At, 0, 0); PG8_STAGE(PG8_SA(1, 1), a1 + hstepA, voffA);
            PG8_WAIT_L(8); PG8_BAR; PG8_WAIT_L(0); PG8_MMA(0, 0, At, B0); PG8_BAR; PG8_SCHED;
            PG8_LDB(B1, 0, 1); PG8_STAGE(PG8_SB(0, 0), b2, voffB);
            PG8_BAR; PG8_WAIT_L(0); PG8_MMA(0, 1, At, B1); PG8_BAR;
            PG8_LDA(At, 0, 1); PG8_STAGE(PG8_SA(0, 0), a2, voffA);
            PG8_BAR; PG8_WAIT_L(0); PG8_MMA(1, 0, At, B0); PG8_BAR; PG8_SCHED;
            PG8_STAGE(PG8_SB(0, 1), b2 + hstepB, voffB);
            PG8_WAIT_V(6); PG8_BAR; PG8_MMA(1, 1, At, B1); PG8_BAR;
            PG8_LDB(B0, 1, 0); PG8_SCHED; PG8_LDA(At, 1, 0); PG8_STAGE(PG8_SA(0, 1), a2 + hstepA, voffA);
            PG8_WAIT_L(8); PG8_BAR; PG8_WAIT_L(0); PG8_MMA(0, 0, At, B0); PG8_BAR; PG8_SCHED;
            PG8_LDB(B1, 1, 1); PG8_STAGE(PG8_SB(1, 0), b3, voffB);
            PG8_BAR; PG8_WAIT_L(0); PG8_MMA(0, 1, At, B1); PG8_BAR;
            PG8_LDA(At, 1, 1); PG8_STAGE(PG8_SA(1, 0), a3, voffA);
            PG8_BAR; PG8_WAIT_L(0); PG8_MMA(1, 0, At, B0); PG8_BAR; PG8_SCHED;
            PG8_STAGE(PG8_SB(1, 1), b3 + hstepB, voffB);
            PG8_WAIT_V(6); PG8_BAR; PG8_MMA(1, 1, At, B1); PG8_BAR;
            }
        }
        if constexpr (ALIGN_EPI) { if (wr == 0) PG8_BAR; }
        if constexpr (!Epi::AFTER_DRAIN) { E(acc, cur, wr, wc, fr, fq); S.done(cur); }
        if (!has_next) break;
#pragma unroll
        for (int a = 0; a < 2; ++a)
#pragma unroll
            for (int b = 0; b < 2; ++b)
#pragma unroll
                for (int m = 0; m < 4; ++m)
#pragma unroll
                    for (int n = 0; n < 2; ++n) acc[a][b][m][n] = (f32x4){0.f, 0.f, 0.f, 0.f};
        cur = nxt; cA = nA; cB = nB; ++ui;
        if constexpr (ALIGN_EPI) { if (wr == 1) PG8_BAR; }
    }
    PG8_WAIT_V(0);
    if constexpr (!ALIGN_EPI) { if (wr == 0) PG8_BAR; }
    PG8_BAR;
    if constexpr (Epi::AFTER_DRAIN) { E.fused(acc, cur, wr, wc, fr, fq, lds, wid, lane); S.done(cur); }
#undef PG8_SA
#undef PG8_SB
#undef PG8_STAGE
#undef PG8_LDA
#undef PG8_LDB
#undef PG8_MMA
#undef PG8_WAIT_V
#undef PG8_WAIT_L
#undef PG8_BAR
#undef PG8_SCHED
}
}

constexpr int NB = 4, SEQ = 4096, DM = 1024, DEPTH = 4, M = NB * SEQ;
constexpr int INC = 7088;
constexpr int NIN = 7168;
constexpr int FFH = 2816, FF2 = 5632;
constexpr int ZP = pg8::ZP, ZSP = pg8::ZSP;
constexpr int Z_FQ = 0, Z_DQ = 512, Z_RV = 1024, Z_FK = 1536, Z_FV = 2048,
     Z_RQ = 2560, Z_RK = 2816, Z_RG = 3072, Z_ZG = 3584, Z_MRG = 2560;
constexpr int S_IQ = 0, S_DK = 256, S_DV = 320, S_IK = 384, S_IW = 416, S_FF = 424;
constexpr float NORM_EPS = 1e-6f;
constexpr float LOG2E = 1.4426950408889634f;
constexpr float C2 = 0.125f * 1.4426950408889634f;

constexpr size_t MiB = 1u << 20;
constexpr size_t WS_CTL = 0, CTL_ZERO_BYTES = 1 * MiB;
constexpr size_t WS_ROPE64 = 1 * MiB;
constexpr size_t WS_ROPE32 = 2 * MiB;
constexpr size_t WS_LF = 2 * MiB + 512 * 1024;
constexpr size_t WS_CF = 3 * MiB;
constexpr size_t WS_ISG = 3 * MiB + 512 * 1024;
constexpr size_t WS_KD = 4 * MiB;
constexpr size_t WS_VD = 6 * MiB;
constexpr size_t WS_W = 8 * MiB;
constexpr size_t LW_IN = 0, LW_MIX = (size_t)NIN * 1024, LW_O = LW_MIX + 1536 * 1024, LW_FI = LW_O + 1024 * 1024, LW_FO = LW_FI + (size_t)FF2 * 1024, LW_STRIDE = LW_FO + (size_t)FFH * 1024;
constexpr size_t WS_Z = 150 * MiB;
constexpr size_t WS_HDN = 358 * MiB;
constexpr size_t WS_ZS = 390 * MiB;
constexpr size_t WS_IQB = 422 * MiB;
constexpr size_t WS_IKB = 430 * MiB;
constexpr size_t WS_SS = 431 * MiB;
constexpr size_t WS_END = 432 * MiB;
static_assert(WS_W + DEPTH * LW_STRIDE * 2 <= WS_Z && WS_Z + (size_t)M * ZP * 2 <= WS_HDN && WS_HDN + (size_t)M * 1024 * 2 == WS_ZS && WS_ZS + (size_t)M * ZSP * 4 == WS_IQB, "d_ws map");
constexpr int CW_BAR = 4096;

constexpr int RING_OFF = 0, RING_BYTES = 133120;
constexpr int LDSCTL_OFF = RING_BYTES, MISC_OFF = LDSCTL_OFF + 320;
constexpr int XTRA_OFF = RING_BYTES + 1024;
constexpr int LDS_BYTES = 147456;
constexpr int NWAVES = 8;
#define GAS __attribute__((address_space(1)))
#define LAS __attribute__((address_space(3)))
typedef unsigned short bf16;
typedef unsigned v4u __attribute__((ext_vector_type(4)));
typedef float f32x4 __attribute__((ext_vector_type(4)));
typedef short bf16x8 __attribute__((ext_vector_type(8)));
typedef GAS unsigned gu32;
typedef GAS unsigned long long gu64;
#define RLX_AGENT __ATOMIC_RELAXED, __HIP_MEMORY_SCOPE_AGENT
#define LDS_WAIT() asm volatile("s_waitcnt lgkmcnt(0)" ::: "memory")
#define VM_WAIT() asm volatile("s_waitcnt vmcnt(0)" ::: "memory")
__device__ __forceinline__ unsigned long long rt() { return __builtin_amdgcn_s_memrealtime(); }
__device__ __forceinline__ unsigned f2bf(float f) { unsigned u = __builtin_bit_cast(unsigned, f); return (u + 0x7fffu + ((u >> 16) & 1u)) >> 16; }
__device__ __forceinline__ unsigned pk2(float lo, float hi) { unsigned r; asm("v_cvt_pk_bf16_f32 %0, %1, %2" : "=v"(r) : "v"(lo), "v"(hi)); return r; }

#define XB_TMO      128
#define XB_XCNT(j)  (256  + 64 * (j))
#define XB_XSUB(j)  (1280 + 64 * (j))
#define XB_XGEN(j)  (2304 + 64 * (j))
#define XB_TOP      3328
#define XB_TOPGEN   3392
#define XCD_BAR_WORDS 3456
#define XB_SPIN_CAP (1u << 22)

__device__ __forceinline__ unsigned xb_ld(unsigned* p)              { return __hip_atomic_load(p, __ATOMIC_RELAXED, __HIP_MEMORY_SCOPE_AGENT); }
__device__ __forceinline__ unsigned xb_add(unsigned* p, unsigned v) { return __hip_atomic_fetch_add(p, v, __ATOMIC_RELAXED, __HIP_MEMORY_SCOPE_AGENT); }
__device__ __forceinline__ unsigned xb_xcc_id() { return (unsigned)__builtin_amdgcn_s_getreg((3 << 11) | 20) & 0xFu; }
#define XB_SPIN(cond, bar) do { unsigned _sp = 0; while (cond) { __builtin_amdgcn_s_sleep(1); \
    if ((++_sp & 255u) == 0u) { if (xb_ld(&(bar)[XB_TMO])) break; if (_sp > XB_SPIN_CAP) { atomicAdd(&(bar)[XB_TMO], 1u); break; } } } } while (0)

struct XcdBarrier {
    unsigned* bar; unsigned x; int w;
    volatile LAS unsigned* st;
};

__device__ __forceinline__ XcdBarrier xcd_barrier_post(unsigned* bar, volatile LAS unsigned* st) {
    XcdBarrier b; b.bar = bar; b.x = xb_xcc_id(); b.st = st; b.w = 0;
    if (threadIdx.x == 0) (void)xb_add(&bar[XB_XCNT(b.x)], 1u);
    return b;
}
__device__ __forceinline__ void xcd_barrier_complete(unsigned* bar, unsigned x, unsigned& nloc, unsigned& nx) {
    const unsigned G = gridDim.x * gridDim.y * gridDim.z;
    unsigned sum, cnt, mine, sp = 0u;
    for (;;) {
        sum = 0u; cnt = 0u; mine = 0u;
#pragma unroll
        for (unsigned j = 0; j < 16; ++j) { const unsigned c = xb_ld(&bar[XB_XCNT(j)]); sum += c; cnt += (c > 0u) ? 1u : 0u; mine = (j == x) ? c : mine; }
        if (sum == G) break;
        __builtin_amdgcn_s_sleep(1);
        if ((++sp & 255u) == 0u) { if (xb_ld(&bar[XB_TMO])) break; if (sp > XB_SPIN_CAP) { atomicAdd(&bar[XB_TMO], 1u); break; } }
    }
    nloc = mine > 0u ? mine : 1u; nx = cnt > 0u ? cnt : 1u;
}

__device__ __forceinline__ void xcd_barrier(const XcdBarrier& b) {
    asm volatile("s_waitcnt vmcnt(0)" ::: "memory");
    __syncthreads();
    if (b.w == 0 && lane_id_v() == 0) {
        unsigned* bar = b.bar;
        __builtin_amdgcn_s_waitcnt(0);
        unsigned nloc = b.st[0], nx = b.st[1];
        if (nloc == 0u) { xcd_barrier_complete(bar, b.x, nloc, nx); b.st[0] = nloc; b.st[1] = nx; }
        const unsigned old = xb_add(&bar[XB_XSUB(b.x)], 1u);
        const unsigned gen = old / nloc;
        if (old + 1u == (gen + 1u) * nloc) {
            __builtin_amdgcn_fence(__ATOMIC_RELEASE, "agent");
            asm volatile("s_waitcnt vmcnt(0)" ::: "memory");
            const unsigned og = xb_add(&bar[XB_TOP], 1u);
            const unsigned tg = og / nx;
            if (og + 1u == (tg + 1u) * nx) xb_add(&bar[XB_TOPGEN], 1u);
            else XB_SPIN(xb_ld(&bar[XB_TOPGEN]) == tg, bar);
            __builtin_amdgcn_fence(__ATOMIC_ACQUIRE, "agent");
            xb_add(&bar[XB_XGEN(b.x)], 1u);
            asm volatile("s_waitcnt vmcnt(0)" ::: "memory");
        } else {
            XB_SPIN(xb_ld(&bar[XB_XGEN(b.x)]) == gen, bar);
            __builtin_amdgcn_fence(__ATOMIC_ACQUIRE, "agent");
            asm volatile("s_waitcnt vmcnt(0)" ::: "memory");
        }
    }
    __syncthreads();
}

typedef float f32x2 __attribute__((ext_vector_type(2)));
typedef unsigned u32x2 __attribute__((ext_vector_type(2)));
__device__ __forceinline__ float bflo(unsigned w) { return __builtin_bit_cast(float, w << 16); }
__device__ __forceinline__ float bfhi(unsigned w) { return __builtin_bit_cast(float, w & 0xffff0000u); }
__device__ __forceinline__ float bf2f(bf16 v) { return __builtin_bit_cast(float, (unsigned)v << 16); }
__device__ __forceinline__ void unpack8(const v4u w, float (&f)[8]) { f[0] = bflo(w.x); f[1] = bfhi(w.x); f[2] = bflo(w.y); f[3] = bfhi(w.y); f[4] = bflo(w.z); f[5] = bfhi(w.z); f[6] = bflo(w.w); f[7] = bfhi(w.w); }
__device__ __forceinline__ v4u pack8(const float (&f)[8]) { v4u w; w.x = pk2(f[0], f[1]); w.y = pk2(f[2], f[3]); w.z = pk2(f[4], f[5]); w.w = pk2(f[6], f[7]); return w; }
__device__ __forceinline__ float xor32(float v, int lane) {
    return __builtin_bit_cast(float, __builtin_amdgcn_ds_bpermute((lane ^ 32) << 2, __builtin_bit_cast(int, v)));
}
__device__ __forceinline__ float sigmoid_f(float x) { return 1.0f / (1.0f + __expf(-x)); }

struct Ctx {
    LAS unsigned char* lds;
    int tid, lane, wave, G, gw, NGW;
    float* out; unsigned char* ws;
};

__device__ __forceinline__ void conv_item(const float* W, int N, int sc, int nv, int k0, bf16* WT, int ldw, int dr, LAS float* scr, int lane, const float* gk = nullptr) {
    const int n_ = lane & 31;
    float wv[32];
#pragma unroll
    for (int i = 0; i < 32; ++i) { const int kk = 2 * i + (lane >> 5); wv[i] = (n_ < nv) ? W[(size_t)(k0 + kk) * N + sc + n_] : 0.f; }
#pragma unroll
    for (int i = 0; i < 32; ++i) { const int kk = 2 * i + (lane >> 5); scr[kk * 33 + n_] = gk ? wv[i] * gk[k0 + kk] : wv[i]; }
    LDS_WAIT(); asm volatile("" ::: "memory");
    const int c = lane & 7;
#pragma unroll
    for (int j = 0; j < 4; ++j) { const int n = (lane >> 3) + 8 * j; const LAS float* s = scr + (8 * c) * 33 + n;
        v4u o; o.x = pk2(s[0 * 33], s[1 * 33]); o.y = pk2(s[2 * 33], s[3 * 33]); o.z = pk2(s[4 * 33], s[5 * 33]); o.w = pk2(s[6 * 33], s[7 * 33]);
        if (n < nv) *(GAS v4u*)(WT + (size_t)(dr + n) * ldw + k0 + 8 * c) = o; }
    LDS_WAIT(); asm volatile("" ::: "memory");
}
__device__ const int SEG_IN[15][3] = {
    {0, Z_FQ, 512}, {512, Z_FK, 512}, {1024, Z_FV, 512}, {1536, 6656 + S_FF, 8}, {1544, Z_DQ, 512}, {2056, 6656 + S_DK, 64}, {2120, 6656 + S_DV, 64},
    {2184, 6656 + S_IQ, 256}, {2440, 6656 + S_IK, 32}, {2472, 6656 + S_IW, 8}, {2480, Z_RQ, 256}, {2736, Z_RK, 256}, {2992, Z_RV, 512}, {3504, Z_RG, 512}, {4016, Z_ZG, 3072}};
constexpr int IN_BLK = 223;
constexpr int IT_IN = 16 * IN_BLK, IT_MIX = 8 * 32, IT_O = 16 * 32, IT_FI = 16 * (FF2 / 32), IT_FO = (FFH / 64) * 32;
constexpr int IT_LAYER = IT_IN + 3 * IT_MIX + IT_O + IT_FI + IT_FO;

__device__ __forceinline__ void sincos_acc(float ang, float& c, float& s) {
    const double a = (double)ang;
    const double k = __builtin_rint(a * 0.6366197723675814);
    double y = a - k * 1.5707963267948966; y -= k * 6.123233995736766e-17;
    const double y2 = y * y;
    double sp = -7.647163731819816e-13; sp = sp * y2 + 1.6059043836821613e-10; sp = sp * y2 - 2.505210838544172e-08; sp = sp * y2 + 2.7557319223985893e-06; sp = sp * y2 - 1.984126984126984e-04; sp = sp * y2 + 8.333333333333333e-03; sp = sp * y2 - 1.6666666666666666e-01;
    const double sn = y + y * y2 * sp;
    double cp = 4.779477332387385e-14; cp = cp * y2 - 1.1470745597729725e-11; cp = cp * y2 + 2.08767569878681e-09; cp = cp * y2 - 2.755731922398589e-07; cp = cp * y2 + 2.48015873015873e-05; cp = cp * y2 - 1.388888888888889e-03; cp = cp * y2 + 4.1666666666666664e-02; cp = cp * y2 - 0.5;
    const double cs = 1.0 + y2 * cp;
    const int q = ((int)k) & 3;
    const double ss = (q & 1) ? cs : sn, cc = (q & 1) ? sn : cs;
    s = (float)((q & 2) ? -ss : ss);
    c = (float)(((q + 1) & 2) ? -cc : cc);
}

__device__ __forceinline__ void p0_prologue(const Ctx& F, const float* w_in, const float* w_fox, const float* w_dsa, const float* w_ret, const float* w_o, const float* w_fi, const float* w_fo, const float* ln1g, const float* ln2g) {
    LAS float* scr = (LAS float*)(F.lds + RING_OFF + F.wave * 16384);
    bf16* Wb = (bf16*)(F.ws + WS_W);
    for (int it = F.gw; it < DEPTH * IT_LAYER; it += F.NGW) {
        const int l = it / IT_LAYER; int r = it % IT_LAYER;
        bf16* L = Wb + (size_t)l * LW_STRIDE;
        if (r < IT_IN) {
            const int kb = r / IN_BLK; int blk = r % IN_BLK; int sc = 0, dr = 0, nv = 0;
            for (int s = 0; s < 15; ++s) { const int w = SEG_IN[s][2], nb = (w + 31) >> 5; if (blk < nb) { sc = SEG_IN[s][0] + 32 * blk; dr = SEG_IN[s][1] + 32 * blk; nv = (w - 32 * blk) < 32 ? (w - 32 * blk) : 32;
                if (s == 0 || s == 1 || s == 4) { const int hd = blk >> 1; dr = SEG_IN[s][1] + (hd >> 2) * 256 + 128 * (blk & 1) + 32 * (hd & 3); }
                break; } blk -= nb; }
            conv_item(w_in + (size_t)l * DM * INC, INC, sc, nv, 64 * kb, L + LW_IN, 1024, dr, scr, F.lane, ln1g + l * DM); continue; }
        r -= IT_IN;
        if (r < 3 * IT_MIX) { const int w = r / IT_MIX, q = r % IT_MIX, kb = q / 32, nb = q % 32;
            conv_item((w == 0 ? w_fox : w == 1 ? w_dsa : w_ret) + (size_t)l * 512 * DM, DM, 32 * nb, 32, 64 * kb, L + LW_MIX + (size_t)w * 512, 1536, 32 * nb, scr, F.lane); continue; }
        r -= 3 * IT_MIX;
        if (r < IT_O) { const int kb = r / 32, nb = r % 32;
            conv_item(w_o + (size_t)l * DM * DM, DM, 32 * nb, 32, 64 * kb, L + LW_O, 1024, 32 * nb, scr, F.lane); continue; }
        r -= IT_O;
        if (r < IT_FI) { const int kb = r / (FF2 / 32), nb = r % (FF2 / 32); const int n0 = 32 * nb;
            const int j = n0 < FFH ? n0 : n0 - FFH; const int dr = 256 * (j >> 7) + (j & 127) + (n0 < FFH ? 0 : 128);
            conv_item(w_fi + (size_t)l * DM * FF2, FF2, n0, 32, 64 * kb, L + LW_FI, 1024, dr, scr, F.lane, ln2g + l * DM); continue; }
        r -= IT_FI;
        { const int kb = r / 32, nb = r % 32;
            conv_item(w_fo + (size_t)l * FFH * DM, DM, 32 * nb, 32, 64 * kb, L + LW_FO, FFH, 32 * nb, scr, F.lane); }
    }
    for (int i = F.gw * 64 + F.lane; i < DEPTH * 80 * 128; i += F.NGW * 64) { const int l = i / (80 * 128), q = i % (80 * 128);
        *(GAS v4u*)(Wb + (size_t)l * LW_STRIDE + LW_IN + (size_t)INC * 1024 + (size_t)q * 8) = (v4u){0u, 0u, 0u, 0u}; }
    f32x2* R64 = (f32x2*)(F.ws + WS_ROPE64); f32x2* R32 = (f32x2*)(F.ws + WS_ROPE32);
    for (int i = F.gw * 64 + F.lane; i < SEQ * 32; i += F.NGW * 64) { const int pos = i >> 5, k = i & 31;
        double f = 1.0; for (int e = 0; e < k; ++e) f *= 0.7498942093324559;
        const float ang = (float)pos * (float)f; float c, s; sincos_acc(ang, c, s); R64[i] = (f32x2){c, s}; }
    for (int i = F.gw * 64 + F.lane; i < SEQ * 16; i += F.NGW * 64) { const int pos = i >> 4, k = i & 15;
        double f = 1.0; for (int e = 0; e < k; ++e) f *= 0.5623413251903491;
        const float ang = (float)pos * (float)f; float c, s; sincos_acc(ang, c, s); R32[i] = (f32x2){c, s}; }
}

__device__ __forceinline__ void norm0_phase(const Ctx& F, const float* x, bf16* o, float* SS) {
    for (int m0 = F.gw; m0 < M; m0 += 4 * F.NGW) {
        f32x4 v[4][4];
#pragma unroll
        for (int r = 0; r < 4; ++r) { const int m = m0 + r * F.NGW; const GAS f32x4* xr = (const GAS f32x4*)(x + (size_t)(m < M ? m : m0) * DM) + F.lane;
#pragma unroll
            for (int j = 0; j < 4; ++j) v[r][j] = xr[64 * j]; }
#pragma unroll
        for (int r = 0; r < 4; ++r) { const int m = m0 + r * F.NGW; if (m < M) { float s = 0.f;
#pragma unroll
            for (int j = 0; j < 4; ++j) s += (v[r][j].x * v[r][j].x + v[r][j].y * v[r][j].y) + (v[r][j].z * v[r][j].z + v[r][j].w * v[r][j].w);
            s = wave_sum(s);
            GAS unsigned long long* o8 = (GAS unsigned long long*)(o + (size_t)m * DM) + F.lane;
#pragma unroll
            for (int j = 0; j < 4; ++j) o8[64 * j] = (unsigned long long)pk2(v[r][j].x, v[r][j].y) | ((unsigned long long)pk2(v[r][j].z, v[r][j].w) << 32);
            if (F.lane < 4) SS[(size_t)m * 4 + F.lane] = (F.lane == 0) ? s : 0.f; } }
    }
}

__device__ __forceinline__ void post_phase(const Ctx& F, const float* g_fq, const float* g_fk, const float* g_dq, const float* g_dk, const float* b_f, bool dummy_out = false) {
    bf16* Z = (bf16*)(F.ws + WS_Z); const float* ZS = (const float*)(F.ws + WS_ZS);
    const f32x2* R64 = (const f32x2*)(F.ws + WS_ROPE64); const f32x2* R32 = (const f32x2*)(F.ws + WS_ROPE32);
    float* LF = (float*)(F.ws + WS_LF); unsigned* ISG = (unsigned*)(F.ws + WS_ISG);
    bf16* KD = (bf16*)(F.ws + WS_KD); bf16* VD = (bf16*)(F.ws + WS_VD); bf16* IQB = (bf16*)(F.ws + WS_IQB); bf16* IKB = (bf16*)(F.ws + WS_IKB);
    const int t0 = blockIdx.x * 512 + F.tid, NT = F.G * 512;
    for (int t = t0; t < M * 8; t += NT) { const int m = t >> 3, h = t & 7; const float* sp = ZS + (size_t)m * ZSP + S_IQ + h * 32;
        f32x4 v[8];
#pragma unroll
        for (int i = 0; i < 8; ++i) v[i] = *(const GAS f32x4*)(sp + 4 * i);
        const float aw = fabsf(ZS[(size_t)m * ZSP + S_IW + h]);
        const f32x2* cs = R32 + (m & (SEQ - 1)) * 16; float f[32];
#pragma unroll
        for (int i = 0; i < 8; ++i) { f[4 * i] = v[i].x; f[4 * i + 1] = v[i].y; f[4 * i + 2] = v[i].z; f[4 * i + 3] = v[i].w; }
#pragma unroll
        for (int d = 0; d < 16; ++d) { const f32x2 tt = cs[d]; const float x1 = f[d], x2 = f[d + 16]; f[d] = (x1 * tt.x - x2 * tt.y) * aw; f[d + 16] = (x2 * tt.x + x1 * tt.y) * aw; }
        bf16* op = IQB + (size_t)m * 256 + h * 32;
#pragma unroll
        for (int i = 0; i < 4; ++i) { float t8[8];
#pragma unroll
            for (int j = 0; j < 8; ++j) t8[j] = f[8 * i + j];
            *(GAS v4u*)(op + 8 * i) = pack8(t8); }
    }
    const int part = blockIdx.x & 3;
    for (int m = (blockIdx.x >> 2) * 512 + F.tid; m < M; m += (F.G >> 2) * 512) { const float* sr = ZS + (size_t)m * ZSP; const int pos = m & (SEQ - 1);
        if (part == 0) { float f[64]; float ss = 0.f;
#pragma unroll
            for (int i = 0; i < 16; ++i) { const f32x4 v = *(const GAS f32x4*)(sr + S_DK + 4 * i); f[4 * i] = v.x; f[4 * i + 1] = v.y; f[4 * i + 2] = v.z; f[4 * i + 3] = v.w; ss += (v.x * v.x + v.y * v.y) + (v.z * v.z + v.w * v.w); }
            const float rs = 1.0f / sqrtf(ss * (1.f / 64) + NORM_EPS); const f32x2* cs = R64 + pos * 32;
#pragma unroll
            for (int d = 0; d < 64; ++d) f[d] = f[d] * rs * g_dk[d];
#pragma unroll
            for (int d = 0; d < 32; ++d) { const f32x2 tt = cs[d]; const float x1 = f[d], x2 = f[d + 32]; f[d] = x1 * tt.x - x2 * tt.y; f[d + 32] = x2 * tt.x + x1 * tt.y; }
#pragma unroll
            for (int i = 0; i < 8; ++i) { float t8[8];
#pragma unroll
                for (int j = 0; j < 8; ++j) t8[j] = f[8 * i + j];
                *(GAS v4u*)(KD + (size_t)m * 64 + 8 * i) = pack8(t8); } }
        if (part == 1)
#pragma unroll
        for (int i = 0; i < 8; ++i) { const f32x4 a = *(const GAS f32x4*)(sr + S_DV + 8 * i), b = *(const GAS f32x4*)(sr + S_DV + 8 * i + 4); const float t8[8] = {a.x, a.y, a.z, a.w, b.x, b.y, b.z, b.w};
            *(GAS v4u*)(VD + (size_t)m * 64 + 8 * i) = pack8(t8); }
        if (part == 2) { float f[32]; const f32x2* cs = R32 + pos * 16;
#pragma unroll
            for (int i = 0; i < 8; ++i) { const f32x4 v = *(const GAS f32x4*)(sr + S_IK + 4 * i); f[4 * i] = v.x; f[4 * i + 1] = v.y; f[4 * i + 2] = v.z; f[4 * i + 3] = v.w; }
#pragma unroll
            for (int d = 0; d < 16; ++d) { const f32x2 tt = cs[d]; const float x1 = f[d], x2 = f[d + 16]; f[d] = x1 * tt.x - x2 * tt.y; f[d + 16] = x2 * tt.x + x1 * tt.y; }
#pragma unroll
            for (int i = 0; i < 4; ++i) { float t8[8];
#pragma unroll
                for (int j = 0; j < 8; ++j) t8[j] = f[8 * i + j];
                *(GAS v4u*)(IKB + (size_t)m * 32 + 8 * i) = pack8(t8); } }
        if (part == 3) { const f32x4 w0 = *(const GAS f32x4*)(sr + S_IW), w1 = *(const GAS f32x4*)(sr + S_IW + 4); const float iw[8] = {w0.x, w0.y, w0.z, w0.w, w1.x, w1.y, w1.z, w1.w}; unsigned sg = 0;
#pragma unroll
            for (int h = 0; h < 8; ++h) sg |= (iw[h] < 0.f ? 1u : 0u) << h;
            ISG[m] = sg;
            const f32x4 f0 = *(const GAS f32x4*)(sr + S_FF), f1 = *(const GAS f32x4*)(sr + S_FF + 4); const float ff[8] = {f0.x, f0.y, f0.z, f0.w, f1.x, f1.y, f1.z, f1.w}; float lf[8];
#pragma unroll
            for (int h = 0; h < 8; ++h) { const float xx = ff[h] + b_f[h]; lf[h] = (fminf(xx, 0.f) - __logf(1.0f + __expf(-fabsf(xx)))) * LOG2E; }
            *(GAS f32x4*)(LF + (size_t)m * 8) = (f32x4){lf[0], lf[1], lf[2], lf[3]}; *(GAS f32x4*)(LF + (size_t)m * 8 + 4) = (f32x4){lf[4], lf[5], lf[6], lf[7]}; }
    }
}

__device__ __forceinline__ float ret_l2g(int h) { return h == 0 ? -0.04580368961312479f : h == 1 ? -0.02272007650008353f : h == 2 ? -0.011315313227834146f : -0.005646563141142063f; }

__device__ __forceinline__ void scan_state_phase(const Ctx& F) {
    const float* LF = (const float*)(F.ws + WS_LF); float* CF = (float*)(F.ws + WS_CF);
    const bf16* Z = (const bf16*)(F.ws + WS_Z); float* RS = (float*)(F.ws + WS_HDN);
    if (F.gw < 32) {
        const int b = F.gw >> 3, h = F.gw & 7; const float* lp = LF + ((size_t)b * SEQ + F.lane * 64) * 8 + h; float s = 0.f;
        for (int i = 0; i < 64; ++i) s += lp[i * 8];
        float incl = s;
#pragma unroll
        for (int o = 1; o < 64; o <<= 1) { const float t = __builtin_bit_cast(float, __builtin_amdgcn_ds_bpermute(((F.lane - o) & 63) << 2, __builtin_bit_cast(int, incl))); if (F.lane >= o) incl += t; }
        float run = incl - s; float* cp = CF + (size_t)F.gw * SEQ + F.lane * 64;
        for (int i = 0; i < 64; ++i) { run += lp[i * 8]; cp[i] = run; }
    }
    for (int u = blockIdx.x; u < NB * 32 * 4; u += F.G) {
        const int h = u & 3, c = (u >> 2) & 31, b = u >> 7; const float l2g = ret_l2g(h);
        const int d = F.tid >> 3, e0 = (F.tid & 7) * 16; float acc[16];
#pragma unroll
        for (int i = 0; i < 16; ++i) acc[i] = 0.f;
        const bf16* base = Z + ((size_t)b * SEQ + c * 128) * ZP;
        for (int j = 0; j < 128; ++j) { const bf16* row = base + (size_t)j * ZP;
            const float kd = bf2f(row[Z_RK + h * 64 + d]) * exp2f((float)(127 - j) * l2g);
            const v4u w0 = *(const GAS v4u*)(row + Z_RV + h * 128 + e0), w1 = *(const GAS v4u*)(row + Z_RV + h * 128 + e0 + 8);
            float v0[8], v1[8]; unpack8(w0, v0); unpack8(w1, v1);
#pragma unroll
            for (int i = 0; i < 8; ++i) { acc[i] += kd * v0[i]; acc[8 + i] += kd * v1[i]; } }
        float* o = RS + (size_t)u * 8192 + d * 128 + e0;
#pragma unroll
        for (int i = 0; i < 4; ++i) *(GAS f32x4*)(o + 4 * i) = (f32x4){acc[4 * i], acc[4 * i + 1], acc[4 * i + 2], acc[4 * i + 3]};
    }
}

__device__ __forceinline__ void ret_out_naive(const Ctx& F, const float* gn) {
    bf16* Z = (bf16*)(F.ws + WS_Z); const float* RS = (const float*)(F.ws + WS_HDN);
    LAS float* S = (LAS float*)(F.lds);
    LAS bf16* Vt = (LAS bf16*)(F.lds + 32768);
    LAS float* Kt = (LAS float*)(F.lds + 65536);
    LAS float* aw = (LAS float*)(F.lds + 65536 + 33280) + F.wave * 128;
    LAS float* qw = (LAS float*)(F.lds + 65536 + 33280 + 4096) + F.wave * 64;
    for (int u = blockIdx.x; u < NB * 32 * 4; u += F.G) {
        const int h = u & 3, c = (u >> 2) & 31, b = u >> 7; const float l2g = ret_l2g(h); const float wch = exp2f(128.f * l2g);
        __syncthreads();
        { float s[16];
#pragma unroll
            for (int i = 0; i < 16; ++i) s[i] = 0.f;
            for (int cp = 0; cp < c; ++cp) { const float* L = RS + ((size_t)((b * 32 + cp) * 4 + h)) * 8192 + F.tid;
#pragma unroll
                for (int i = 0; i < 16; ++i) s[i] = wch * s[i] + L[i * 512]; }
#pragma unroll
            for (int i = 0; i < 16; ++i) S[F.tid + i * 512] = s[i]; }
        const bf16* base = Z + ((size_t)b * SEQ + c * 128) * ZP;
        for (int q = F.tid; q < 2048; q += 512) { const int r = q >> 4, ch = q & 15; *(LAS v4u*)(Vt + r * 128 + ch * 8) = *(const GAS v4u*)(base + (size_t)r * ZP + Z_RV + h * 128 + ch * 8); }
        for (int q = F.tid; q < 128 * 64; q += 512) { const int r = q >> 6, dd = q & 63; Kt[r * 65 + dd] = bf2f(base[(size_t)r * ZP + Z_RK + h * 64 + dd]); }
        __syncthreads();
        for (int i = F.wave; i < 128; i += NWAVES) {
            const size_t m = (size_t)b * SEQ + c * 128 + i; bf16* zr = Z + m * ZP;
            qw[F.lane] = bf2f(zr[Z_RQ + h * 64 + F.lane]);
            LDS_WAIT(); asm volatile("" ::: "memory");
#pragma unroll
            for (int jj = 0; jj < 2; ++jj) { const int j = F.lane + 64 * jj; float a = 0.f;
                if (j <= i) { float dot = 0.f; for (int dd = 0; dd < 64; ++dd) dot += qw[dd] * Kt[j * 65 + dd]; a = dot * exp2f((float)(i - j) * l2g); }
                aw[j] = a; }
            LDS_WAIT(); asm volatile("" ::: "memory");
            float o[2]; const float dq = exp2f((float)(i + 1) * l2g);
#pragma unroll
            for (int ee = 0; ee < 2; ++ee) { const int e = F.lane + 64 * ee; float acc = 0.f;
                for (int j = 0; j <= i; ++j) acc += aw[j] * bf2f(Vt[j * 128 + e]);
                float cr = 0.f; for (int dd = 0; dd < 64; ++dd) cr += qw[dd] * S[dd * 128 + e];
                o[ee] = acc + cr * dq; }
            const float ss = wave_sum(o[0] * o[0] + o[1] * o[1]); const float rstd = 1.0f / sqrtf(ss * (1.f / 128) + NORM_EPS);
#pragma unroll
            for (int ee = 0; ee < 2; ++ee) { const int e = F.lane + 64 * ee; const float rg = bf2f(zr[Z_RG + h * 128 + e]);
                zr[Z_RV + h * 128 + e] = (bf16)f2bf(o[ee] * rstd * gn[h * 128 + e] * rg * sigmoid_f(rg)); }
            LDS_WAIT(); asm volatile("" ::: "memory");
        }
    }
    __syncthreads();
}

__device__ __forceinline__ void fox_naive(const Ctx& F) {
    bf16* Z = (bf16*)(F.ws + WS_Z); const float* CF = (const float*)(F.ws + WS_CF);
    LAS float* sc = (LAS float*)(F.lds + F.wave * 16384);
    const int lane = F.lane;
    int it = 0;
    for (int r0 = 0; r0 < NB * 8 * SEQ; r0 += F.NGW, ++it) {
        const int r = r0 + ((it & 1) ? (F.NGW - 1 - F.gw) : F.gw);
        if (r >= NB * 8 * SEQ) continue;
        const int pos = r & (SEQ - 1), h = (r >> 12) & 7, b = r >> 15;
        const size_t m = (size_t)b * SEQ + pos;
        float qf[64];
        { const bf16* qp = Z + m * ZP + Z_FQ + h * 64;
#pragma unroll
            for (int i = 0; i < 8; ++i) { const v4u w = *(const GAS v4u*)(qp + 8 * i); float t[8]; unpack8(w, t);
#pragma unroll
                for (int j = 0; j < 8; ++j) qf[8 * i + j] = t[j]; } }
        const float* cf = CF + (size_t)(b * 8 + h) * SEQ;
        float mx = -INFINITY;
        for (int kk = lane; kk <= pos; kk += 64) { const bf16* kp = Z + ((size_t)b * SEQ + kk) * ZP + Z_FK + h * 64; float dot = 0.f;
#pragma unroll
            for (int i = 0; i < 8; ++i) { const v4u w = *(const GAS v4u*)(kp + 8 * i); float t[8]; unpack8(w, t);
#pragma unroll
                for (int j = 0; j < 8; ++j) dot += qf[8 * i + j] * t[j]; }
            const float s = dot - cf[kk]; sc[kk] = s; mx = fmaxf(mx, s); }
        mx = wave_max(mx);
        float sum = 0.f;
        for (int kk = lane; kk <= pos; kk += 64) { const float p = exp2f(sc[kk] - mx); sc[kk] = p; sum += p; }
        sum = wave_sum(sum);
        LDS_WAIT(); asm volatile("" ::: "memory");
        const bf16* vp = Z + (size_t)b * SEQ * ZP + Z_FV + h * 64 + lane;
        float o0 = 0.f, o1 = 0.f, o2 = 0.f, o3 = 0.f; int kk = 0;
        for (; kk + 3 <= pos; kk += 4) { o0 += sc[kk] * bf2f(vp[(size_t)kk * ZP]); o1 += sc[kk + 1] * bf2f(vp[(size_t)(kk + 1) * ZP]); o2 += sc[kk + 2] * bf2f(vp[(size_t)(kk + 2) * ZP]); o3 += sc[kk + 3] * bf2f(vp[(size_t)(kk + 3) * ZP]); }
        for (; kk <= pos; ++kk) o0 += sc[kk] * bf2f(vp[(size_t)kk * ZP]);
        Z[m * ZP + Z_FQ + h * 64 + lane] = (bf16)f2bf(((o0 + o1) + (o2 + o3)) / sum);
        LDS_WAIT(); asm volatile("" ::: "memory");
    }
}

__device__ __forceinline__ unsigned f2key(float s) { const unsigned u = __builtin_bit_cast(unsigned, s + 0.0f); return (u & 0x80000000u) ? ~u : (u | 0x80000000u); }
__device__ __forceinline__ void dsa_naive(const Ctx& F) {
    bf16* Z = (bf16*)(F.ws + WS_Z); const float* ZS = (const float*)(F.ws + WS_ZS);
    const unsigned* ISG = (const unsigned*)(F.ws + WS_ISG);
    const bf16* KD = (const bf16*)(F.ws + WS_KD); const bf16* VD = (const bf16*)(F.ws + WS_VD);
    LAS unsigned* kl = (LAS unsigned*)(F.lds + F.wave * 16384);
    LAS float* iqs = (LAS float*)(F.lds + XTRA_OFF + F.wave * 1536);
    const int lane = F.lane;
    int it = 0;
    for (int r0 = 0; r0 < M; r0 += F.NGW, ++it) {
        const int r = r0 + ((it & 1) ? (F.NGW - 1 - F.gw) : F.gw);
        if (r >= M) continue;
        const int pos = r & (SEQ - 1), b = r >> 12; const size_t m = (size_t)r;
        *(LAS f32x4*)(iqs + 4 * lane) = *(const GAS f32x4*)(ZS + m * ZSP + S_IQ + 4 * lane);
        const unsigned sg = ISG[m];
        LDS_WAIT(); asm volatile("" ::: "memory");
        for (int kk = lane; kk <= pos; kk += 64) { const float* ikp = ZS + ((size_t)b * SEQ + kk) * ZSP + S_IK; float ik[32];
#pragma unroll
            for (int i = 0; i < 8; ++i) { const f32x4 t = *(const GAS f32x4*)(ikp + 4 * i); ik[4 * i] = t.x; ik[4 * i + 1] = t.y; ik[4 * i + 2] = t.z; ik[4 * i + 3] = t.w; }
            float s = 0.f;
#pragma unroll 1
            for (int h = 0; h < 8; ++h) { float dot = 0.f;
#pragma unroll
                for (int dd = 0; dd < 32; ++dd) dot += iqs[h * 32 + dd] * ik[dd];
                dot = fmaxf(dot, 0.f); s += ((sg >> h) & 1u) ? -dot : dot; }
            kl[kk] = f2key(s); }
        LDS_WAIT(); asm volatile("" ::: "memory");
        unsigned key[64];
#pragma unroll
        for (int j = 0; j < 64; ++j) { const int kk = j * 64 + lane; key[j] = (kk <= pos) ? kl[kk] : 0u; }
        LDS_WAIT(); asm volatile("" ::: "memory");
        LAS unsigned* idx = kl; LAS float* pl = (LAS float*)(kl + 256); LAS bf16* qs = (LAS bf16*)(kl + 512);
        *(LAS v4u*)(qs + 8 * lane) = *(const GAS v4u*)(Z + m * ZP + Z_DQ + 8 * lane);
        unsigned T = 0u; int need = 0;
        if (pos + 1 > 256) {
            for (int bit = 31; bit >= 0; --bit) { const unsigned Tt = T | (1u << bit); int cnt = 0;
#pragma unroll
                for (int j = 0; j < 64; ++j) cnt += __builtin_popcountll(__ballot(key[j] >= Tt));
                if (cnt >= 256) T = Tt; }
            int ngt = 0;
#pragma unroll
            for (int j = 0; j < 64; ++j) ngt += __builtin_popcountll(__ballot(key[j] > T));
            need = 256 - ngt;
        }
        int nsel = 0, eqb = 0;
#pragma unroll
        for (int j = 0; j < 64; ++j) { const bool gt = key[j] > T, eq = (key[j] == T) && (T != 0u);
            const unsigned long long em = __ballot(eq); const int er = eqb + __builtin_amdgcn_mbcnt_hi((unsigned)(em >> 32), __builtin_amdgcn_mbcnt_lo((unsigned)em, 0u));
            const bool sel = gt || (eq && er < need); eqb += __builtin_popcountll(em);
            const unsigned long long sm = __ballot(sel); const int sp = nsel + __builtin_amdgcn_mbcnt_hi((unsigned)(sm >> 32), __builtin_amdgcn_mbcnt_lo((unsigned)sm, 0u));
            if (sel) idx[sp] = (unsigned)(j * 64 + lane); nsel += __builtin_popcountll(sm); }
        LDS_WAIT(); asm volatile("" ::: "memory");
        for (int h = 0; h < 8; ++h) {
            float sv[4]; float mx = -INFINITY;
#pragma unroll
            for (int i = 0; i < 4; ++i) { const int e = lane + 64 * i; sv[i] = -INFINITY;
                if (e < nsel) { const bf16* kp = KD + ((size_t)b * SEQ + idx[e]) * 64; float dot = 0.f;
#pragma unroll
                    for (int c = 0; c < 8; ++c) { const v4u w = *(const GAS v4u*)(kp + 8 * c); float t[8]; unpack8(w, t); const v4u qw = *(const LAS v4u*)(qs + h * 64 + 8 * c); float qq[8]; unpack8(qw, qq);
#pragma unroll
                        for (int j = 0; j < 8; ++j) dot += qq[j] * t[j]; }
                    sv[i] = dot; }
                mx = fmaxf(mx, sv[i]); }
            mx = wave_max(mx); float sum = 0.f;
#pragma unroll
            for (int i = 0; i < 4; ++i) { const int e = lane + 64 * i; const float p = (e < nsel) ? exp2f(sv[i] - mx) : 0.f; pl[e] = p; sum += p; }
            sum = wave_sum(sum);
            LDS_WAIT(); asm volatile("" ::: "memory");
            float o0 = 0.f, o1 = 0.f; int e = 0;
            for (; e + 1 < nsel; e += 2) { o0 += pl[e] * bf2f(VD[((size_t)b * SEQ + idx[e]) * 64 + lane]); o1 += pl[e + 1] * bf2f(VD[((size_t)b * SEQ + idx[e + 1]) * 64 + lane]); }
            if (e < nsel) o0 += pl[e] * bf2f(VD[((size_t)b * SEQ + idx[e]) * 64 + lane]);
            Z[m * ZP + Z_DQ + h * 64 + lane] = (bf16)f2bf((o0 + o1) / sum);
            LDS_WAIT(); asm volatile("" ::: "memory");
        }
    }
}
#ifndef PROBE_D
#define PROBE_D 0
#endif

typedef short s16x8 __attribute__((ext_vector_type(8)));
typedef short s16x4 __attribute__((ext_vector_type(4)));
typedef short v4i16_t __attribute__((ext_vector_type(4)));
__device__ __forceinline__ s16x4 tr16(const LAS unsigned char* p) { return __builtin_bit_cast(s16x4, __builtin_amdgcn_ds_read_tr16_b64_v4i16((LAS v4i16_t*)p)); }
__device__ __forceinline__ float key2f(unsigned k) { return __builtin_bit_cast(float, (k & 0x80000000u) ? (k & 0x7fffffffu) : ~k); }

template <int NR> __device__ __forceinline__ int dsa_count_ge(const unsigned (&key)[64], unsigned T) {
    int c = 0;
#pragma unroll
    for (int j = 0; j < NR; ++j) c += __builtin_popcountll(__ballot(key[j] >= T));
    return c;
}
#define DSA_COUNT_GE(T_, out_) do { if (nq == 1) out_ = dsa_count_ge<16>(key, (T_)); else if (nq == 2) out_ = dsa_count_ge<32>(key, (T_)); else if (nq == 3) out_ = dsa_count_ge<48>(key, (T_)); else out_ = dsa_count_ge<64>(key, (T_)); } while (0)
__device__ __forceinline__ void dsa_select(const unsigned (&key)[64], int nvalid, unsigned& T, int& need) {
    const int nq = __builtin_amdgcn_readfirstlane((nvalid + 1023) >> 10);
    T = 0u; need = 0;
    if (nvalid <= 256) return;
    unsigned kmax = 0u;
#pragma unroll
    for (int j = 0; j < 64; ++j) kmax = key[j] > kmax ? key[j] : kmax;
#pragma unroll
    for (int o_ = 0; o_ < 1; ++o_) { unsigned t; t = sxu<1>(kmax); kmax = t > kmax ? t : kmax; t = sxu<2>(kmax); kmax = t > kmax ? t : kmax; t = sxu<4>(kmax); kmax = t > kmax ? t : kmax; t = sxu<8>(kmax); kmax = t > kmax ? t : kmax; t = sxu<16>(kmax); kmax = t > kmax ? t : kmax;
        unsigned a_, b_; swap32(kmax, a_, b_); kmax = a_ > b_ ? a_ : b_; }
    unsigned lo = 1u, hi = kmax + 1u; int hic = 0;
    { const float vm = fabsf(key2f(kmax)) + 1.0f; unsigned l2 = f2key(-vm * 64.0f); int c; DSA_COUNT_GE(l2, c); if (c >= 256) lo = l2; }
    int iter = 0; bool exact = false;
    while (hi - lo > 1u) {
        unsigned mid;
        if (iter < 24 && lo > 1u) { const float mv = 0.5f * key2f(lo) + 0.5f * key2f(hi - 1u); mid = f2key(mv); }
        else mid = lo + ((hi - lo) >> 1);
        if (mid <= lo) mid = lo + 1u; if (mid >= hi) mid = hi - 1u;
        int c; DSA_COUNT_GE(mid, c);
        if (c == 256) { T = mid; exact = true; break; }
        if (c > 256) lo = mid; else { hi = mid; hic = c; }
        ++iter;
    }
    if (exact) need = 256; else { T = lo; need = 256 - hic; }
}

template <bool SYNC_BEFORE_STAGE = false> __device__ __forceinline__ void dsa_attend(const bf16* zq, bf16* zo, const bf16* KDb, const bf16* VDb, const LAS unsigned short* idx, int nsel, LAS unsigned char* vst, int lane) {
    const int g = lane >> 4, c = lane & 15;
    s16x8 qf[2];
#pragma unroll
    for (int ks = 0; ks < 2; ++ks) { qf[ks] = (s16x8){0, 0, 0, 0, 0, 0, 0, 0}; if (c < 8) qf[ks] = *(const GAS s16x8*)(zq + c * 64 + 32 * ks + 8 * g); }
    f32x4 acc[16];
    v4u vreg[16];
#pragma unroll
    for (int i = 0; i < 16; ++i) { const int pi = lane + 64 * i, r = pi >> 3, c16 = pi & 7; const int id = (r < nsel) ? (int)idx[r] : 0; vreg[i] = *(const GAS v4u*)(VDb + (size_t)id * 64 + c16 * 8); }
#pragma unroll
    for (int tb = 0; tb < 2; ++tb) {
        s16x8 kf[8][2];
#pragma unroll
        for (int tt = 0; tt < 8; ++tt) { const int e = 16 * (8 * tb + tt) + c; const int id = (e < nsel) ? (int)idx[e] : 0; const bf16* kp = KDb + (size_t)id * 64 + 8 * g;
            kf[tt][0] = *(const GAS s16x8*)kp; kf[tt][1] = *(const GAS s16x8*)(kp + 32); }
#pragma unroll
        for (int tt = 0; tt < 8; ++tt) { f32x4 a = (f32x4){0.f, 0.f, 0.f, 0.f};
            a = __builtin_amdgcn_mfma_f32_16x16x32_bf16(kf[tt][0], qf[0], a, 0, 0, 0); a = __builtin_amdgcn_mfma_f32_16x16x32_bf16(kf[tt][1], qf[1], a, 0, 0, 0); acc[8 * tb + tt] = a; }
    }
    float mx = -INFINITY;
#pragma unroll
    for (int t = 0; t < 16; ++t)
#pragma unroll
        for (int i = 0; i < 4; ++i) { const int e = 16 * t + 4 * g + i; if (nsel < 256 && e >= nsel) acc[t][i] = -INFINITY; mx = fmaxf(mx, acc[t][i]); }
    mx = fmaxf(mx, sx<16>(mx)); mx = half_max(mx);
    float sum = 0.f;
#pragma unroll
    for (int t = 0; t < 16; ++t)
#pragma unroll
        for (int i = 0; i < 4; ++i) { const float p = __builtin_amdgcn_exp2f(acc[t][i] - mx); acc[t][i] = p; sum += p; }
    sum += sx<16>(sum); sum = half_sum(sum);
    const float inv = 1.0f / sum;
    s16x8 pf[8];
#pragma unroll
    for (int s = 0; s < 8; ++s) { v4u w; w.x = pk2(acc[2 * s][0] * inv, acc[2 * s][1] * inv); w.y = pk2(acc[2 * s][2] * inv, acc[2 * s][3] * inv); w.z = pk2(acc[2 * s + 1][0] * inv, acc[2 * s + 1][1] * inv); w.w = pk2(acc[2 * s + 1][2] * inv, acc[2 * s + 1][3] * inv);
        pf[s] = __builtin_bit_cast(s16x8, w); }
    f32x4 o[4];
#pragma unroll
    for (int db = 0; db < 4; ++db) o[db] = (f32x4){0.f, 0.f, 0.f, 0.f};
    const int q = (lane >> 2) & 3, p = lane & 3, swz = 2 * (g & 1) + (q >> 1);
    const LAS unsigned char* rb = vst + (4 * g + q) * 128 + 8 * p;
    if constexpr (SYNC_BEFORE_STAGE) __syncthreads();
#pragma unroll
    for (int hh = 0; hh < 2; ++hh) {
        asm volatile("s_waitcnt lgkmcnt(0)" ::: "memory");
#pragma unroll
        for (int i = 0; i < 16; ++i) { const int pi = lane + 64 * i, r = pi >> 3, c16 = pi & 7;
            *(LAS v4u*)(vst + r * 128 + ((((c16 >> 1) ^ ((r >> 1) & 3))) << 5) + ((c16 & 1) << 4)) = vreg[i]; }
        if (hh == 0) {
#pragma unroll
            for (int i = 0; i < 16; ++i) { const int pi = lane + 64 * i, r = pi >> 3, c16 = pi & 7, e = 128 + r; const int id = (e < nsel) ? (int)idx[e] : 0; vreg[i] = *(const GAS v4u*)(VDb + (size_t)id * 64 + c16 * 8); } }
        asm volatile("s_waitcnt lgkmcnt(0)" ::: "memory");
#pragma unroll
        for (int s4 = 0; s4 < 4; ++s4)
#pragma unroll
            for (int db = 0; db < 4; ++db) { const LAS unsigned char* a1 = rb + s4 * 4096 + ((db ^ swz) << 5);
                const s16x4 lo = tr16(a1), hi = tr16(a1 + 2048);
                const s16x8 vf = (s16x8){lo[0], lo[1], lo[2], lo[3], hi[0], hi[1], hi[2], hi[3]};
                o[db] = __builtin_amdgcn_mfma_f32_16x16x32_bf16(pf[4 * hh + s4], vf, o[db], 0, 0, 0); }
    }
    if (g < 2) {
#pragma unroll
        for (int db = 0; db < 4; ++db)
#pragma unroll
            for (int i = 0; i < 4; ++i) zo[(4 * g + i) * 64 + 16 * db + c] = (bf16)f2bf(o[db][i]);
    }
}

__device__ __forceinline__ void dsa_v2(const Ctx& F) {
    bf16* Z = (bf16*)(F.ws + WS_Z); const float* ZS = (const float*)(F.ws + WS_ZS);
    const unsigned* ISG = (const unsigned*)(F.ws + WS_ISG);
    const bf16* KD = (const bf16*)(F.ws + WS_KD); const bf16* VD = (const bf16*)(F.ws + WS_VD);
    LAS unsigned* kl = (LAS unsigned*)(F.lds + F.wave * 16384);
    LAS float* iqs = (LAS float*)(F.lds + XTRA_OFF + F.wave * 1536);
    LAS unsigned short* idx = (LAS unsigned short*)(F.lds + XTRA_OFF + F.wave * 1536 + 1024);
    const int lane = F.lane;
    int it = 0;
    for (int r0 = 0; r0 < M; r0 += F.NGW, ++it) {
        const int r = r0 + ((it & 1) ? (F.NGW - 1 - F.gw) : F.gw);
        if (r >= M) continue;
        const int pos = r & (SEQ - 1), b = r >> 12; const size_t m = (size_t)r;
        *(LAS f32x4*)(iqs + 4 * lane) = *(const GAS f32x4*)(ZS + m * ZSP + S_IQ + 4 * lane);
        const unsigned sg = ISG[m];
        LDS_WAIT(); asm volatile("" ::: "memory");
        for (int kk = lane; kk <= pos; kk += 64) { const float* ikp = ZS + ((size_t)b * SEQ + kk) * ZSP + S_IK; float ik[32];
#pragma unroll
            for (int i = 0; i < 8; ++i) { const f32x4 t = *(const GAS f32x4*)(ikp + 4 * i); ik[4 * i] = t.x; ik[4 * i + 1] = t.y; ik[4 * i + 2] = t.z; ik[4 * i + 3] = t.w; }
            float s = 0.f;
#pragma unroll 1
            for (int h = 0; h < 8; ++h) { float dot = 0.f;
#pragma unroll
                for (int dd = 0; dd < 32; ++dd) dot += iqs[h * 32 + dd] * ik[dd];
                dot = fmaxf(dot, 0.f); s += ((sg >> h) & 1u) ? -dot : dot; }
            kl[kk] = f2key(s); }
        LDS_WAIT(); asm volatile("" ::: "memory");
        unsigned key[64];
#pragma unroll
        for (int j = 0; j < 64; ++j) { const int kk = j * 64 + lane; key[j] = (kk <= pos) ? kl[kk] : 0u; }
        LDS_WAIT(); asm volatile("" ::: "memory");
        unsigned T; int need;
#ifdef DSA_OLDSEL
        T = 0u; need = 0;
        if (pos + 1 > 256) {
            for (int bit = 31; bit >= 0; --bit) { const unsigned Tt = T | (1u << bit); int cnt = 0;
#pragma unroll
                for (int j = 0; j < 64; ++j) cnt += __builtin_popcountll(__ballot(key[j] >= Tt));
                if (cnt >= 256) T = Tt; }
            int ngt = 0;
#pragma unroll
            for (int j = 0; j < 64; ++j) ngt += __builtin_popcountll(__ballot(key[j] > T));
            need = 256 - ngt;
        }
#else
        dsa_select(key, pos + 1, T, need);
#endif
        int nsel = 0, eqb = 0;
#pragma unroll
        for (int j = 0; j < 64; ++j) { const bool gt = key[j] > T, eq = (key[j] == T) && (T != 0u);
            const unsigned long long em = __ballot(eq); const int er = eqb + __builtin_amdgcn_mbcnt_hi((unsigned)(em >> 32), __builtin_amdgcn_mbcnt_lo((unsigned)em, 0u));
            const bool sel = gt || (eq && er < need); eqb += __builtin_popcountll(em);
            const unsigned long long sm = __ballot(sel); const int sp = nsel + __builtin_amdgcn_mbcnt_hi((unsigned)(sm >> 32), __builtin_amdgcn_mbcnt_lo((unsigned)sm, 0u));
            if (sel) idx[sp] = (unsigned short)(j * 64 + lane); nsel += __builtin_popcountll(sm); }
        LDS_WAIT(); asm volatile("" ::: "memory");
        dsa_attend(Z + m * ZP + Z_DQ, Z + m * ZP + Z_DQ, KD + (size_t)b * SEQ * 64, VD + (size_t)b * SEQ * 64, idx, nsel, (LAS unsigned char*)kl, lane);
        LDS_WAIT(); asm volatile("" ::: "memory");
    }
}

template <int NR> __device__ __forceinline__ int dsa_emit_n(const unsigned (&key)[64], unsigned T, int need, LAS unsigned short* idx, int lane) {
    int nsel = 0, eqb = 0;
#pragma unroll
    for (int j = 0; j < NR; ++j) { const bool gt = key[j] > T, eq = (key[j] == T) && (T != 0u);
        const unsigned long long em = __ballot(eq); const int er = eqb + __builtin_amdgcn_mbcnt_hi((unsigned)(em >> 32), __builtin_amdgcn_mbcnt_lo((unsigned)em, 0u));
        const bool sel = gt || (eq && er < need); eqb += __builtin_popcountll(em);
        const unsigned long long sm = __ballot(sel); const int sp = nsel + __builtin_amdgcn_mbcnt_hi((unsigned)(sm >> 32), __builtin_amdgcn_mbcnt_lo((unsigned)sm, 0u));
        if (sel) idx[sp] = (unsigned short)(j * 64 + lane); nsel += __builtin_popcountll(sm); }
    return nsel;
}
__device__ __forceinline__ int dsa_emit(const unsigned (&key)[64], int nvalid, unsigned T, int need, LAS unsigned short* idx, int lane) {
    const int nq = __builtin_amdgcn_readfirstlane((nvalid + 1023) >> 10);
    if (nq == 1) return dsa_emit_n<16>(key, T, need, idx, lane);
    if (nq == 2) return dsa_emit_n<32>(key, T, need, idx, lane);
    if (nq == 3) return dsa_emit_n<48>(key, T, need, idx, lane);
    return dsa_emit_n<64>(key, T, need, idx, lane);
}

#define DSA_CNT8(cnt_, k_, o_, T_) asm volatile( \
    "v_cmp_ge_u32_e64 s[60:61], %1, %9\n\tv_cmp_ge_u32_e64 s[62:63], %2, %9\n\tv_cmp_ge_u32_e64 s[64:65], %3, %9\n\tv_cmp_ge_u32_e64 s[66:67], %4, %9\n\t" \
    "v_cmp_ge_u32_e64 s[68:69], %5, %9\n\tv_cmp_ge_u32_e64 s[70:71], %6, %9\n\tv_cmp_ge_u32_e64 s[72:73], %7, %9\n\tv_cmp_ge_u32_e64 s[74:75], %8, %9\n\t" \
    "v_addc_co_u32_e64 %0, s[76:77], 0, %0, s[60:61]\n\tv_addc_co_u32_e64 %0, s[76:77], 0, %0, s[62:63]\n\tv_addc_co_u32_e64 %0, s[76:77], 0, %0, s[64:65]\n\tv_addc_co_u32_e64 %0, s[76:77], 0, %0, s[66:67]\n\t" \
    "v_addc_co_u32_e64 %0, s[76:77], 0, %0, s[68:69]\n\tv_addc_co_u32_e64 %0, s[76:77], 0, %0, s[70:71]\n\tv_addc_co_u32_e64 %0, s[76:77], 0, %0, s[72:73]\n\tv_addc_co_u32_e64 %0, s[76:77], 0, %0, s[74:75]" \
    : "+v"(cnt_) : "v"(k_[o_]), "v"(k_[o_ + 1]), "v"(k_[o_ + 2]), "v"(k_[o_ + 3]), "v"(k_[o_ + 4]), "v"(k_[o_ + 5]), "v"(k_[o_ + 6]), "v"(k_[o_ + 7]), "s"(T_) \
    : "s60", "s61", "s62", "s63", "s64", "s65", "s66", "s67", "s68", "s69", "s70", "s71", "s72", "s73", "s74", "s75", "s76", "s77")
template <int NR> __device__ __forceinline__ int dsa_lane_count(const unsigned (&key)[64], unsigned T) {
    int c = 0; const unsigned Ts = (unsigned)__builtin_amdgcn_readfirstlane((int)T);
#pragma unroll
    for (int j = 0; j < NR; j += 8) DSA_CNT8(c, key, j, Ts);
    return c;
}
#define DSA_LCOUNT(T_, lc_) do { if (nq == 1) lc_ = dsa_lane_count<16>(key, (T_)); else if (nq == 2) lc_ = dsa_lane_count<32>(key, (T_)); else if (nq == 3) lc_ = dsa_lane_count<48>(key, (T_)); else lc_ = dsa_lane_count<64>(key, (T_)); } while (0)
template <int NR> __device__ __forceinline__ void dsa_write_ge(const unsigned (&key)[64], unsigned T, int off, LAS unsigned short* idx, int lane) {
    const int dummy = 256 + lane;
#pragma unroll
    for (int j = 0; j < NR; ++j) { const bool s = key[j] >= T; idx[s ? off : dummy] = (unsigned short)(j * 64 + lane); off += s ? 1 : 0; }
}
__device__ __forceinline__ int dsa_select2(const unsigned (&key)[64], int nvalid, float s1, float s2, LAS unsigned short* idx, int lane) {
    const int nq = __builtin_amdgcn_readfirstlane((nvalid + 1023) >> 10);
    unsigned T = 1u; int lc = 0; bool exact = true;
    if (nvalid > 256) {
        const float n = (float)nvalid, mean = s1 / n, sd = sqrtf(fmaxf(s2 / n - mean * mean, 1e-30f));
        const float pfrac = 256.0f / n, pt = fminf(pfrac, 1.0f - pfrac);
        const float tt = sqrtf(-2.0f * __logf(fmaxf(pt, 1e-6f)));
        float zn = (0.010328f * tt + 0.802853f) * tt + 2.515517f; asm volatile("" : "+v"(zn));
        float zd = ((0.001308f * tt + 0.189269f) * tt + 1.432788f) * tt + 1.0f; asm volatile("" : "+v"(zd));
        float z = tt - zn / zd;
        if (pfrac > 0.5f) z = -z;
        const float dens = n * __expf(-0.5f * z * z) * 0.3989423f / sd;
        unsigned lo = 1u, hi = 0xffffffffu; int clo = nvalid, chi = 0;
        bool lop = false, hip = false; float lastv = mean + z * sd, lastc = 256.0f, grow = 1.3f;
        exact = false; int same = 0, last = 0;
        for (int it = 0; hi - lo > 1u; ++it) {
            unsigned mid;
            if (it == 0) mid = f2key(lastv);
            else if (!(lop && hip)) { lastv = lastv + grow * (lastc - 256.0f) / dens; grow *= 2.0f; mid = f2key(lastv); }
            else if (it < 24 && same < 2) { const float vlo = key2f(lo), vhi = key2f(hi - 1u); mid = f2key(vlo + (vhi - vlo) * (((float)(clo - 256) + 0.5f) / (float)(clo - chi))); }
            else if (it < 48) { mid = f2key(0.5f * key2f(lo) + 0.5f * key2f(hi - 1u)); same = 0; }
            else mid = lo + ((hi - lo) >> 1);
            if (!(mid > lo)) mid = lo + 1u; if (!(mid < hi)) mid = hi - 1u;
            DSA_LCOUNT(mid, lc); const int c = wave_isum(lc); lastc = (float)c; lastv = key2f(mid);
            if (c == 256) { T = mid; exact = true; break; }
            if (c > 256) { lo = mid; clo = c; lop = true; same = (last > 0) ? same + 1 : 0; last = 1; } else { hi = mid; chi = c; hip = true; same = (last < 0) ? same + 1 : 0; last = -1; }
        }
        if (!exact) {
            const int nsel = dsa_emit(key, nvalid, lo, 256 - chi, idx, lane);
            return nsel;
        }
    } else { DSA_LCOUNT(1u, lc); }
    int incl = lc;
#pragma unroll
    for (int o = 1; o < 64; o <<= 1) { const int t = __builtin_amdgcn_ds_bpermute(((lane - o) & 63) << 2, incl); if (lane >= o) incl += t; }
    const int total = __builtin_amdgcn_readlane(incl, 63);
    if (nq == 1) dsa_write_ge<16>(key, T, incl - lc, idx, lane); else if (nq == 2) dsa_write_ge<32>(key, T, incl - lc, idx, lane); else if (nq == 3) dsa_write_ge<48>(key, T, incl - lc, idx, lane); else dsa_write_ge<64>(key, T, incl - lc, idx, lane);
    return total;
}

constexpr int DSA_ROWF = 4100;
__device__ __forceinline__ void dsa_v3(const Ctx& F, int out_col = Z_DQ) {
    bf16* Z = (bf16*)(F.ws + WS_Z);
    const unsigned* ISG = (const unsigned*)(F.ws + WS_ISG);
    const bf16* KD = (const bf16*)(F.ws + WS_KD); const bf16* VD = (const bf16*)(F.ws + WS_VD);
    const bf16* IQB = (const bf16*)(F.ws + WS_IQB); const bf16* IKB = (const bf16*)(F.ws + WS_IKB);
    LAS unsigned* img = (LAS unsigned*)(F.lds);
    LAS unsigned short* idxw = (LAS unsigned short*)(F.lds + XTRA_OFF + F.wave * 1536);
    const int w = F.wave;
    const int v = (int)blockIdx.x;
    if (v < 256)
    for (int ui = 0; ui < 8; ++ui) {
        int lane_ = F.lane; asm volatile("" : "+v"(lane_)); const int lane = lane_, g = lane >> 4, c = lane & 15;
        const int b = v >> 6, k = v & 63; const int pb = 128 * (ui >> 1) + ((ui & 1) ? 127 - k : k);
        const int q0 = pb * 8, kend = q0 + 8, ntile = (kend + 15) >> 4;
        const size_t mb = (size_t)b * SEQ;
#if PROBE_D == 1
        for (int rp_ = 0; rp_ < 2; ++rp_)
#endif
        { s16x8 iqf[4]; float sgn[4]; s16x8 iqc;
          { const int qi = c & 7, hs = c >> 3; const int qq = q0 + qi; const bf16* qp = IQB + (mb + qq) * 256 + 8 * g; const unsigned sg = ISG[mb + qq];
            float cs[8];
#pragma unroll
            for (int e = 0; e < 8; ++e) cs[e] = 0.f;
#pragma unroll
            for (int j = 0; j < 4; ++j) { const int h = 2 * j + hs; iqf[j] = *(const GAS s16x8*)(qp + h * 32); sgn[j] = ((sg >> h) & 1u) ? -1.0f : 1.0f;
                float t8[8]; unpack8(__builtin_bit_cast(v4u, iqf[j]), t8);
#pragma unroll
                for (int e = 0; e < 8; ++e) cs[e] += sgn[j] * t8[e]; }
            iqc = __builtin_bit_cast(s16x8, pack8(cs)); }
          const bf16* ikp = IKB + (mb + c) * 32 + 8 * g;
          float st1 = 0.f, st2 = 0.f;
          s16x8 cur[4], nxt[4];
#pragma unroll
          for (int i = 0; i < 4; ++i) { const int t = w + 8 * i; cur[i] = *(const GAS s16x8*)(ikp + (size_t)512 * (t < ntile ? t : 0)); }
          for (int t0 = w; t0 < ntile; t0 += 32) {
#pragma unroll
            for (int i = 0; i < 4; ++i) { const int t = t0 + 32 + 8 * i; nxt[i] = *(const GAS s16x8*)(ikp + (size_t)512 * (t < ntile ? t : 0)); }
#pragma unroll
            for (int i = 0; i < 4; ++i) { const int t = t0 + 8 * i;
              if (t < ntile) {
                f32x4 sc = __builtin_amdgcn_mfma_f32_16x16x32_bf16(cur[i], iqc, (f32x4){0.f, 0.f, 0.f, 0.f}, 0, 0, 0);
#pragma unroll
                for (int h = 0; h < 4; ++h) { const f32x4 x = __builtin_amdgcn_mfma_f32_16x16x32_bf16(cur[i], iqf[h], (f32x4){0.f, 0.f, 0.f, 0.f}, 0, 0, 0);
#pragma unroll
                    for (int r = 0; r < 4; ++r) sc[r] = __builtin_fmaf(sgn[h], __builtin_fabsf(x[r]), sc[r]); }
#pragma unroll
                for (int r = 0; r < 4; ++r) sc[r] += sx<8>(sc[r]);
                v4u kk; kk.x = f2key(sc[0]); kk.y = f2key(sc[1]); kk.z = f2key(sc[2]); kk.w = f2key(sc[3]);
                if (16 * t + 15 <= q0) {
                    st1 += (sc[0] + sc[1]) + (sc[2] + sc[3]); st2 += (sc[0] * sc[0] + sc[1] * sc[1]) + (sc[2] * sc[2] + sc[3] * sc[3]);
                } else { const int kb = 16 * t + 4 * g, qa = q0 + (c & 7);
                    if (kb + 0 > qa) { kk.x = 0u; sc[0] = 0.f; } if (kb + 1 > qa) { kk.y = 0u; sc[1] = 0.f; } if (kb + 2 > qa) { kk.z = 0u; sc[2] = 0.f; } if (kb + 3 > qa) { kk.w = 0u; sc[3] = 0.f; }
                    st1 += (sc[0] + sc[1]) + (sc[2] + sc[3]); st2 += (sc[0] * sc[0] + sc[1] * sc[1]) + (sc[2] * sc[2] + sc[3] * sc[3]); }
                if (c < 8) *(LAS v4u*)(img + c * DSA_ROWF + 16 * t + 4 * g) = kk; } }
#pragma unroll
            for (int i = 0; i < 4; ++i) cur[i] = nxt[i];
          }
          st1 += sx<16>(st1); st2 += sx<16>(st2); st1 = half_sum(st1); st2 = half_sum(st2);
          if (g == 0 && c < 8) *(LAS f32x2*)(F.lds + XTRA_OFF + w * 1536 + 640 + c * 8) = (f32x2){st1, st2}; }
        __syncthreads();
        const int pos = q0 + w; unsigned key[64];
#pragma unroll
        for (int j = 0; j < 64; ++j) { const int kidx = 64 * j + lane; const unsigned a = img[w * DSA_ROWF + kidx]; key[j] = (kidx <= pos) ? a : 0u; }
        unsigned T; int need; int nsel;
        float rs1 = 0.f, rs2 = 0.f;
#pragma unroll
        for (int ww = 0; ww < 8; ++ww) { const f32x2 t = *(const LAS f32x2*)(F.lds + XTRA_OFF + ww * 1536 + 640 + w * 8); rs1 += t.x; rs2 += t.y; }
        { nsel = dsa_select2(key, pos + 1, rs1, rs2, idxw, lane); (void)T; (void)need; }
#if PROBE_D == 3
        { const size_t m = mb + pos; dsa_attend(Z + m * ZP + Z_DQ, Z + m * ZP + Z_RG, KD + mb * 64, VD + mb * 64, idxw, nsel, F.lds + w * 16384, lane); }
#endif
        { const size_t m = mb + pos; dsa_attend<true>(Z + m * ZP + Z_DQ, Z + m * ZP + out_col, KD + mb * 64, VD + mb * 64, idxw, nsel, F.lds + w * 16384, lane); }
        __syncthreads();
    }
}

__device__ __forceinline__ void ret_rope_frag(const bf16* row, const f32x2* cs, float scale, int g, s16x8 (&f)[2]) {
    const u32x2 a0 = *(const GAS u32x2*)(row + 4 * g), a1 = *(const GAS u32x2*)(row + 16 + 4 * g), b0 = *(const GAS u32x2*)(row + 32 + 4 * g), b1 = *(const GAS u32x2*)(row + 48 + 4 * g);
    const float x1[8] = {bflo(a0.x), bfhi(a0.x), bflo(a0.y), bfhi(a0.y), bflo(a1.x), bfhi(a1.x), bflo(a1.y), bfhi(a1.y)};
    const float x2[8] = {bflo(b0.x), bfhi(b0.x), bflo(b0.y), bfhi(b0.y), bflo(b1.x), bfhi(b1.x), bflo(b1.y), bfhi(b1.y)};
    float o1[8], o2[8];
#pragma unroll
    for (int j = 0; j < 8; ++j) { const f32x2 t = cs[(j < 4 ? 4 * g + j : 16 + 4 * g + (j - 4))]; o1[j] = (x1[j] * t.x - x2[j] * t.y) * scale; o2[j] = (x2[j] * t.x + x1[j] * t.y) * scale; }
    f[0] = __builtin_bit_cast(s16x8, pack8(o1)); f[1] = __builtin_bit_cast(s16x8, pack8(o2));
}
__device__ __forceinline__ s16x8 ret_bfrag(const LAS unsigned char* img, int row0, int eb, int g, int q, int p) {
    const int r1 = row0 + 4 * g + q;
    const LAS unsigned char* a1 = img + r1 * 256 + ((eb ^ (r1 & 7)) << 5) + 8 * p;
    const LAS unsigned char* a2 = img + (r1 + 16) * 256 + ((eb ^ ((r1 + 16) & 7)) << 5) + 8 * p;
    const s16x4 lo = tr16(a1), hi = tr16(a2);
    return (s16x8){lo[0], lo[1], lo[2], lo[3], hi[0], hi[1], hi[2], hi[3]};
}

__device__ __forceinline__ void ret_state_mfma(const Ctx& F) {
    const bf16* Z = (const bf16*)(F.ws + WS_Z); float* RS = (float*)(F.ws + WS_HDN);
    const f32x2* R64 = (const f32x2*)(F.ws + WS_ROPE64);
    LAS unsigned char* Kimg = F.lds; LAS unsigned char* Vimg = F.lds + 16384;
    const int lane = F.lane, g = lane >> 4, c = lane & 15, q = (lane >> 2) & 3, p = lane & 3;
    for (int u = blockIdx.x; u < NB * 32 * 4; u += F.G) {
        const int h = u & 3, ch = (u >> 2) & 31, b = u >> 7; const float l2g = ret_l2g(h);
        const bf16* base = Z + ((size_t)b * SEQ + ch * 128) * ZP;
        __syncthreads();
        for (int t = F.tid; t < 2048; t += 512) { const int r = t >> 4, c16 = t & 15;
            *(LAS v4u*)(Vimg + r * 256 + (((c16 >> 1) ^ (r & 7)) << 5) + ((c16 & 1) << 4)) = *(const GAS v4u*)(base + (size_t)r * ZP + Z_RV + h * 128 + c16 * 8); }
        for (int t = F.tid; t < 1024; t += 512) { const int j = t >> 3, dg = t & 7; const bf16* row = base + (size_t)j * ZP + Z_RK + h * 64;
            const u32x2 a = *(const GAS u32x2*)(row + 4 * dg), bb = *(const GAS u32x2*)(row + 32 + 4 * dg);
            const float x1[4] = {bflo(a.x), bfhi(a.x), bflo(a.y), bfhi(a.y)}, x2[4] = {bflo(bb.x), bfhi(bb.x), bflo(bb.y), bfhi(bb.y)};
            const f32x2* cs = R64 + (ch * 128 + j) * 32 + 4 * dg; const float sc = exp2f((float)(127 - j) * l2g);
            float o1[4], o2[4];
#pragma unroll
            for (int e = 0; e < 4; ++e) { const f32x2 tt = cs[e]; o1[e] = (x1[e] * tt.x - x2[e] * tt.y) * sc; o2[e] = (x2[e] * tt.x + x1[e] * tt.y) * sc; }
            u32x2 w1, w2; w1.x = pk2(o1[0], o1[1]); w1.y = pk2(o1[2], o1[3]); w2.x = pk2(o2[0], o2[1]); w2.y = pk2(o2[2], o2[3]);
            const int sw = (j >> 1) & 3; const int d1 = 4 * dg, d2 = 32 + 4 * dg;
            *(LAS u32x2*)(Kimg + j * 128 + ((((2 * d1) >> 5) ^ sw) << 5) + ((2 * d1) & 31)) = w1;
            *(LAS u32x2*)(Kimg + j * 128 + ((((2 * d2) >> 5) ^ sw) << 5) + ((2 * d2) & 31)) = w2; }
        __syncthreads();
        f32x4 acc[4];
#pragma unroll
        for (int db = 0; db < 4; ++db) acc[db] = (f32x4){0.f, 0.f, 0.f, 0.f};
#pragma unroll
        for (int s = 0; s < 4; ++s) {
            const s16x8 vb = ret_bfrag(Vimg, 32 * s, F.wave, g, q, p);
            const int r1 = 32 * s + 4 * g + q, sw = (r1 >> 1) & 3;
#pragma unroll
            for (int db = 0; db < 4; ++db) { const LAS unsigned char* a1 = Kimg + r1 * 128 + ((db ^ sw) << 5) + 8 * p;
                const s16x4 lo = tr16(a1), hi = tr16(a1 + 2048);
                const s16x8 ka = (s16x8){lo[0], lo[1], lo[2], lo[3], hi[0], hi[1], hi[2], hi[3]};
                acc[db] = __builtin_amdgcn_mfma_f32_16x16x32_bf16(ka, vb, acc[db], 0, 0, 0); }
        }
        float* o = RS + (size_t)u * 8192 + 16 * F.wave + c;
#pragma unroll
        for (int db = 0; db < 4; ++db)
#pragma unroll
            for (int r = 0; r < 4; ++r) o[(16 * db + 4 * g + r) * 128] = acc[db][r];
    }
    __syncthreads();
}

__device__ __forceinline__ void ret_scan(const Ctx& F) {
    const float* RS = (const float*)(F.ws + WS_HDN); float* SC = (float*)(F.ws + WS_HDN + 16 * MiB);
    for (int t = blockIdx.x * 512 + F.tid; t < NB * 4 * 8192; t += F.G * 512) {
        const int el = t & 8191, h = (t >> 13) & 3, b = t >> 15; const float wch = exp2f(128.f * ret_l2g(h)); float s = 0.f;
        float L[32];
#pragma unroll
        for (int ch = 0; ch < 32; ++ch) L[ch] = RS[(size_t)(((b * 32 + ch) * 4 + h)) * 8192 + el];
#pragma unroll
        for (int ch = 0; ch < 32; ++ch) { SC[(size_t)(((b * 32 + ch) * 4 + h)) * 8192 + el] = s; s = wch * s + L[ch]; }
    }
}

__device__ __forceinline__ void ret_out_mfma(const Ctx& F, const float* gn, bool dummy_out = false) {
    bf16* Z = (bf16*)(F.ws + WS_Z); const float* SC = (const float*)(F.ws + WS_HDN + 16 * MiB);
    const f32x2* R64 = (const f32x2*)(F.ws + WS_ROPE64);
    LAS unsigned char* Vimg = F.lds; LAS unsigned char* Simg = F.lds + 32768; LAS unsigned char* Kimg = F.lds + 49152;
    const int lane = F.lane, g = lane >> 4, c = lane & 15, q = (lane >> 2) & 3, p = lane & 3, w = F.wave;
    for (int u = blockIdx.x; u < NB * 32 * 4; u += F.G) {
        const int h = u & 3, ch = (u >> 2) & 31, b = u >> 7; const float l2g = ret_l2g(h); const float gam = exp2f(l2g);
        bf16* base = Z + ((size_t)b * SEQ + ch * 128) * ZP;
        __syncthreads();
        for (int t = F.tid; t < 2048; t += 512) { const int r = t >> 4, c16 = t & 15;
            *(LAS v4u*)(Vimg + r * 256 + (((c16 >> 1) ^ (r & 7)) << 5) + ((c16 & 1) << 4)) = *(const GAS v4u*)(base + (size_t)r * ZP + Z_RV + h * 128 + c16 * 8); }
        for (int t = F.tid; t < 1024; t += 512) { const int r = t >> 4, c16 = t & 15; const float* sp = SC + (size_t)u * 8192 + r * 128 + c16 * 8;
            const f32x4 s0 = *(const GAS f32x4*)sp, s1 = *(const GAS f32x4*)(sp + 4);
            v4u wv; wv.x = pk2(s0.x * gam, s0.y * gam); wv.y = pk2(s0.z * gam, s0.w * gam); wv.z = pk2(s1.x * gam, s1.y * gam); wv.w = pk2(s1.z * gam, s1.w * gam);
            *(LAS v4u*)(Simg + r * 256 + (((c16 >> 1) ^ (r & 7)) << 5) + ((c16 & 1) << 4)) = wv; }
        for (int t = F.tid; t < 1024; t += 512) { const int j = t >> 3, dg = t & 7; const bf16* row = base + (size_t)j * ZP + Z_RK + h * 64;
            const u32x2 a = *(const GAS u32x2*)(row + 4 * dg), bb = *(const GAS u32x2*)(row + 32 + 4 * dg);
            const float x1[4] = {bflo(a.x), bfhi(a.x), bflo(a.y), bfhi(a.y)}, x2[4] = {bflo(bb.x), bfhi(bb.x), bflo(bb.y), bfhi(bb.y)};
            const f32x2* cs = R64 + (ch * 128 + j) * 32 + 4 * dg; const float sc = exp2f(-(float)j * l2g);
            float o1[4], o2[4];
#pragma unroll
            for (int e = 0; e < 4; ++e) { const f32x2 tt = cs[e]; o1[e] = (x1[e] * tt.x - x2[e] * tt.y) * sc; o2[e] = (x2[e] * tt.x + x1[e] * tt.y) * sc; }
            u32x2 w1, w2; w1.x = pk2(o1[0], o1[1]); w1.y = pk2(o1[2], o1[3]); w2.x = pk2(o2[0], o2[1]); w2.y = pk2(o2[2], o2[3]);
            const int sw = (j >> 1) & 3; const int d1 = 4 * dg, d2 = 32 + 4 * dg;
            *(LAS u32x2*)(Kimg + j * 128 + ((((2 * d1) >> 5) ^ sw) << 5) + ((2 * d1) & 31)) = w1;
            *(LAS u32x2*)(Kimg + j * 128 + ((((2 * d2) >> 5) ^ sw) << 5) + ((2 * d2) & 31)) = w2; }
        const int i = 16 * w + c; s16x8 qf[2];
        float sc8 = 0.125f; asm volatile("" : "+v"(sc8));
        ret_rope_frag(base + (size_t)i * ZP + Z_RQ + h * 64, R64 + (ch * 128 + i) * 32, sc8 * exp2f((float)i * l2g), g, qf);
        __syncthreads();
        f32x4 acc[8];
#pragma unroll
        for (int t = 0; t < 8; ++t) { acc[t] = (f32x4){0.f, 0.f, 0.f, 0.f};
            if (t <= w) { const int j = 16 * t + c; const int sw = (j >> 1) & 3; const LAS unsigned char* kr = Kimg + j * 128;
                const u32x2 a0 = *(const LAS u32x2*)(kr + ((((8 * g) >> 5) ^ sw) << 5) + ((8 * g) & 31)), a1 = *(const LAS u32x2*)(kr + ((((32 + 8 * g) >> 5) ^ sw) << 5) + ((32 + 8 * g) & 31));
                const u32x2 b0 = *(const LAS u32x2*)(kr + ((((64 + 8 * g) >> 5) ^ sw) << 5) + ((64 + 8 * g) & 31)), b1 = *(const LAS u32x2*)(kr + ((((96 + 8 * g) >> 5) ^ sw) << 5) + ((96 + 8 * g) & 31));
                const s16x8 kf0 = __builtin_bit_cast(s16x8, (v4u){a0.x, a0.y, a1.x, a1.y}), kf1 = __builtin_bit_cast(s16x8, (v4u){b0.x, b0.y, b1.x, b1.y});
                acc[t] = __builtin_amdgcn_mfma_f32_16x16x32_bf16(kf0, qf[0], acc[t], 0, 0, 0); acc[t] = __builtin_amdgcn_mfma_f32_16x16x32_bf16(kf1, qf[1], acc[t], 0, 0, 0);
                if (t == w) {
#pragma unroll
                    for (int r = 0; r < 4; ++r) if (4 * g + r > c) acc[t][r] = 0.f; } } }
        s16x8 pf[4];
#pragma unroll
        for (int s = 0; s < 4; ++s) { v4u wv; wv.x = pk2(acc[2 * s][0], acc[2 * s][1]); wv.y = pk2(acc[2 * s][2], acc[2 * s][3]); wv.z = pk2(acc[2 * s + 1][0], acc[2 * s + 1][1]); wv.w = pk2(acc[2 * s + 1][2], acc[2 * s + 1][3]);
            pf[s] = __builtin_bit_cast(s16x8, wv); }
        f32x4 o[8];
#pragma unroll
        for (int eb = 0; eb < 8; ++eb) o[eb] = (f32x4){0.f, 0.f, 0.f, 0.f};
#pragma unroll
        for (int s = 0; s < 4; ++s) if (2 * s <= w) {
#pragma unroll
            for (int eb = 0; eb < 8; ++eb) o[eb] = __builtin_amdgcn_mfma_f32_16x16x32_bf16(pf[s], ret_bfrag(Vimg, 32 * s, eb, g, q, p), o[eb], 0, 0, 0); }
#pragma unroll
        for (int ks = 0; ks < 2; ++ks)
#pragma unroll
            for (int eb = 0; eb < 8; ++eb) o[eb] = __builtin_amdgcn_mfma_f32_16x16x32_bf16(qf[ks], ret_bfrag(Simg, 32 * ks, eb, g, q, p), o[eb], 0, 0, 0);
        float rs[4];
#pragma unroll
        for (int r = 0; r < 4; ++r) { float ss = 0.f;
#pragma unroll
            for (int eb = 0; eb < 8; ++eb) ss += o[eb][r] * o[eb][r];
            ss += sx<1>(ss); ss += sx<2>(ss); ss += sx<4>(ss); ss += sx<8>(ss);
            rs[r] = 1.0f / sqrtf(ss * (1.f / 128) + NORM_EPS); }
#pragma unroll
        for (int r = 0; r < 4; ++r) { bf16* zr = base + (size_t)(16 * w + 4 * g + r) * ZP; bf16* zw = dummy_out ? (bf16*)(F.ws + WS_ZS) + ((size_t)b * SEQ + ch * 128 + 16 * w + 4 * g + r) * 1024 - Z_RV : zr;
#pragma unroll
            for (int eb = 0; eb < 8; ++eb) { const int e = 16 * eb + c; const float rg = bf2f(zr[Z_RG + h * 128 + e]);
                zw[Z_RV + h * 128 + e] = (bf16)f2bf(o[eb][r] * rs[r] * gn[h * 128 + e] * rg * sigmoid_f(rg)); } }
    }
    __syncthreads();
}

__device__ __forceinline__ void fscan_phase(const Ctx& F) {
    const float* LF = (const float*)(F.ws + WS_LF); float* CF = (float*)(F.ws + WS_CF);
    LAS float* wsum = (LAS float*)(F.lds);
    const int seq = (int)blockIdx.x;
    if (seq < 32) {
        const int b = seq >> 3, h = seq & 7; const int p0 = F.tid * 8; const float* lp = LF + ((size_t)b * SEQ + p0) * 8 + h;
        float v[8]; float s = 0.f;
#pragma unroll
        for (int i = 0; i < 8; ++i) { v[i] = lp[i * 8]; }
#pragma unroll
        for (int i = 0; i < 8; ++i) { s += v[i]; v[i] = s; }
        float incl = s;
#pragma unroll
        for (int o = 1; o < 64; o <<= 1) { const float t = __builtin_bit_cast(float, __builtin_amdgcn_ds_bpermute(((F.lane - o) & 63) << 2, __builtin_bit_cast(int, incl))); if (F.lane >= o) incl += t; }
        if (F.lane == 63) wsum[F.wave] = incl;
        __syncthreads();
        float woff = 0.f;
#pragma unroll
        for (int ww = 0; ww < 8; ++ww) { const float t = wsum[ww]; if (ww < F.wave) woff += t; }
        const float base = woff + (incl - s);
        float* cp = CF + (size_t)seq * SEQ + p0;
        *(GAS f32x4*)cp = (f32x4){base + v[0], base + v[1], base + v[2], base + v[3]}; *(GAS f32x4*)(cp + 4) = (f32x4){base + v[4], base + v[5], base + v[6], base + v[7]};
    }
    __syncthreads();
}
#include <hip/hip_bf16.h>
#include <cmath>
namespace attn_body {
using bf16=__hip_bfloat16;
using bf16x8=__attribute__((ext_vector_type(8)))short;
using s16x4=__attribute__((ext_vector_type(4)))short;
using f32x16=__attribute__((ext_vector_type(16)))float;
using u32x4=__attribute__((ext_vector_type(4)))unsigned;
constexpr int BATCH=4,NHEAD=8,SEQ=4096,D=64,DM=6656;
constexpr int NW=8,QBLK=32,QB=QBLK*NW,KVBLK=64,NQB=SEQ/QB;
constexpr int ATTN_PITCH=DM, ATTN_UNIT_ROWS=QB;
__device__ __forceinline__ int crow(int r,int hi){return (r&3)+8*(r>>2)+4*hi;}
#define SBAR() __builtin_amdgcn_sched_barrier(0)
__device__ __forceinline__ void cmask(f32x16&p0,f32x16&p1,int jb,int qrel,int hi){
  const float NEG=-INFINITY; int kb=64*jb+4*hi;
  #pragma unroll
  for(int r=0;r<16;++r){int kv=kb+(r&3)+8*(r>>2); if(kv>qrel)p0[r]=NEG; if(kv+32>qrel)p1[r]=NEG;}
}

constexpr int NSLOT=3, SLOTB=8192;
constexpr int LDS_K=0, LDS_V=NSLOT*SLOTB, LDS_WS=2*NSLOT*SLOTB, LDS_OST=LDS_WS+NW*64*4, LDS_NC=LDS_OST+NW*4096, LDS_BYTES=LDS_NC+SEQ*4;
constexpr float C2=0.125f*1.4426950408889634f;
__device__ __forceinline__ void glds16(const void*gsrc,unsigned lds_dst){unsigned keep;
  asm volatile("s_mov_b32 %0, m0\n\ts_mov_b32 m0, %2\n\ts_nop 0\n\tglobal_load_lds_dwordx4 %1, off\n\ts_mov_b32 m0, %0":"=&s"(keep):"v"(gsrc),"s"(lds_dst):"memory");}
__device__ __forceinline__ float max3f(float a,float b,float c){float r;asm("v_max3_f32 %0, %1, %2, %3":"=v"(r):"v"(a),"v"(b),"v"(c));return r;}
__device__ __forceinline__ float max2f(float a,float b){float r;asm("v_max_f32_e32 %0, %1, %2":"=v"(r):"v"(a),"v"(b));return r;}
__device__ __forceinline__ float fadd_s(float a,float b){float r;asm("v_add_f32_e32 %0, %1, %2":"=v"(r):"v"(a),"v"(b));return r;}
__device__ __forceinline__ float fsub_s(float a,float b){float r;asm("v_sub_f32_e32 %0, %1, %2":"=v"(r):"v"(a),"v"(b));return r;}
typedef float f32x4_t __attribute__((ext_vector_type(4))); typedef float f32x2_t __attribute__((ext_vector_type(2))); typedef __bf16 bf16x2_t __attribute__((ext_vector_type(2)));
__device__ __forceinline__ unsigned cvtpk_s(float lo,float hi){f32x2_t v={lo,hi};bf16x2_t b=__builtin_convertvector(v,bf16x2_t);return __builtin_bit_cast(unsigned,b);}
#define WAIT_BAR(N) asm volatile("s_waitcnt vmcnt(" #N ") lgkmcnt(0)\n\ts_barrier":::"memory")

__device__ __forceinline__ void qkt(f32x16&p0,f32x16&p1,const char*Kslot,const bf16x8*qr,const f32x16&negm,int r32,int hi){
  const char*kb=Kslot+hi*1024+r32*16;
  #pragma unroll
  for(int d0=0;d0<4;++d0){
    const bf16x8 b0=*reinterpret_cast<const bf16x8*>(kb+d0*2048);
    const bf16x8 b1=*reinterpret_cast<const bf16x8*>(kb+d0*2048+512);
    if(d0==0){p0=__builtin_amdgcn_mfma_f32_32x32x16_bf16(b0,qr[0],negm,0,0,0);p1=__builtin_amdgcn_mfma_f32_32x32x16_bf16(b1,qr[0],negm,0,0,0);}
    else{p0=__builtin_amdgcn_mfma_f32_32x32x16_bf16(b0,qr[d0],p0,0,0,0);p1=__builtin_amdgcn_mfma_f32_32x32x16_bf16(b1,qr[d0],p1,0,0,0);}}
}
typedef __attribute__((address_space(3))) const char* lds_cptr;
typedef short v4i16_t __attribute__((ext_vector_type(4)));
__device__ __forceinline__ void kload8(bf16x8*kf,lds_cptr kp){
  kf[0]=*(const __attribute__((address_space(3))) bf16x8*)(kp);      kf[1]=*(const __attribute__((address_space(3))) bf16x8*)(kp+512);
  kf[2]=*(const __attribute__((address_space(3))) bf16x8*)(kp+2048); kf[3]=*(const __attribute__((address_space(3))) bf16x8*)(kp+2560);
  kf[4]=*(const __attribute__((address_space(3))) bf16x8*)(kp+4096); kf[5]=*(const __attribute__((address_space(3))) bf16x8*)(kp+4608);
  kf[6]=*(const __attribute__((address_space(3))) bf16x8*)(kp+6144); kf[7]=*(const __attribute__((address_space(3))) bf16x8*)(kp+6656);
}
__device__ __forceinline__ void kload2(bf16x8*kf,lds_cptr kp,int j){ kf[2*j]=*(const __attribute__((address_space(3))) bf16x8*)(kp+j*2048); kf[2*j+1]=*(const __attribute__((address_space(3))) bf16x8*)(kp+j*2048+512); }
__device__ __forceinline__ s16x4 vtr(lds_cptr p){ return __builtin_bit_cast(s16x4,__builtin_amdgcn_ds_read_tr16_b64_v4i16((__attribute__((address_space(3))) v4i16_t*)p)); }
__device__ __forceinline__ float rowmax(const f32x16&p0,const f32x16&p1){
  float a=max3f(p0[0],p0[1],p1[0]),b=max3f(p0[2],p0[3],p1[1]);a=max3f(a,p1[2],p1[3]);
  #pragma unroll
  for(int r=4;r<16;r+=4){a=max3f(a,p0[r],p0[r+1]);b=max3f(b,p0[r+2],p0[r+3]);a=max3f(a,p1[r],p1[r+1]);b=max3f(b,p1[r+2],p1[r+3]);}
  const float m=max2f(a,b);
  auto rr=__builtin_amdgcn_permlane32_swap(__float_as_uint(m),__float_as_uint(m),false,false);
  return max2f(__uint_as_float(rr[0]),__uint_as_float(rr[1]));
}
__device__ __forceinline__ void pv(f32x16*o,int vb,bf16x8 pa0,bf16x8 pa1,bf16x8 pa2,bf16x8 pa3){
  #pragma unroll
  for(int d0=0;d0<2;++d0){s16x4 lo[4],hi[4];
    #pragma unroll
    for(int ks=0;ks<4;++ks){
      asm volatile("ds_read_b64_tr_b16 %0,%1 offset:%c2":"=&v"(lo[ks]):"v"(vb),"i"(d0*4096+ks*1024):"memory");
      asm volatile("ds_read_b64_tr_b16 %0,%1 offset:%c2":"=&v"(hi[ks]):"v"(vb),"i"(d0*4096+ks*1024+512):"memory");}
    asm volatile("s_waitcnt lgkmcnt(0)":::"memory");SBAR();
    #define PK(k) (bf16x8){lo[k][0],lo[k][1],lo[k][2],lo[k][3],hi[k][0],hi[k][1],hi[k][2],hi[k][3]}
    o[d0]=__builtin_amdgcn_mfma_f32_32x32x16_bf16(pa0,PK(0),o[d0],0,0,0);
    o[d0]=__builtin_amdgcn_mfma_f32_32x32x16_bf16(pa1,PK(1),o[d0],0,0,0);
    o[d0]=__builtin_amdgcn_mfma_f32_32x32x16_bf16(pa2,PK(2),o[d0],0,0,0);
    o[d0]=__builtin_amdgcn_mfma_f32_32x32x16_bf16(pa3,PK(3),o[d0],0,0,0);
    #undef PK
  }
}

#ifndef ATTN_STORE16
#define ATTN_STORE16(p,v) (*(u32x4*)(p)=(v))
#endif
template<int THRL> __device__ __forceinline__ void attn_unit(int b,int h,int qb,const bf16*Q,const bf16*__restrict__ K,const bf16*__restrict__ V,bf16*O,const float*CF,float dskip,char*shm,int wave_id){
  int tid_=(wave_id<<6)|lane_id_v(); asm volatile("":"+v"(tid_));
  const int tid=tid_,lane=tid&63,r32=lane&31,hi=lane>>5; const int wid=__builtin_amdgcn_readfirstlane(tid>>6);
  const long rowbase=(long)b*SEQ; const int q0=qb*QB;
  const bf16*Qw=Q+(rowbase+q0+wid*QBLK)*DM+h*D;
  const float*cfp0=CF+(long)(b*NHEAD+h)*SEQ; const int NT0=(q0+QB)/KVBLK;
  int ts; { const float cq=cfp0[q0]; const int il=(lane<NT0)?64*lane+63:q0; const bool keep=(lane<NT0)&&(cfp0[il]<cq+dskip);
    const unsigned long long km=__ballot(keep); int t0=(int)__builtin_ctzll(km|(1ull<<63)); t0&=~1; ts=__builtin_amdgcn_readfirstlane(t0<NT0-4?t0:NT0-4); }
  const bf16*Kh=K+(rowbase+(long)ts*KVBLK)*DM+h*D,*Vh=V+(rowbase+(long)ts*KVBLK)*DM+h*D;
  const unsigned lds0=(unsigned)(uintptr_t)shm;
  float*wsf=(float*)(shm+LDS_WS)+wid*64;
  const bf16*ksrc=Kh+(long)lane*DM+wid*8;
  const bf16*vsrc=Vh+(long)(16*(wid&3)+(lane>>2))*DM+(wid>>2)*32+(lane&3)*8;
  const unsigned kdst=lds0+LDS_K+wid*1024, vdst=lds0+LDS_V+wid*1024;
  #define DMA_K(t,slot) glds16(ksrc+(long)(t)*KVBLK*DM,(unsigned)__builtin_amdgcn_readfirstlane(kdst+(slot)))
  #define DMA_V(t,slot) glds16(vsrc+(long)(t)*KVBLK*DM,(unsigned)__builtin_amdgcn_readfirstlane(vdst+(slot)))
  const char*Kbase=shm+LDS_K; bf16x8 kf[8];
  const lds_cptr shm3=(lds_cptr)shm; const lds_cptr kp0=shm3+LDS_K+hi*1024+r32*16; const lds_cptr vp0=shm3+LDS_V+((lane>>4)&1)*32+(lane&3)*8+(4*hi+((lane&15)>>2))*64;
  const int NT=NT0-ts;
  { const float*cfp=CF+(long)(b*NHEAD+h)*SEQ; float*ncw=(float*)(shm+LDS_NC);
    for(int i=tid+ts*KVBLK;i<q0+QB;i+=NW*64)ncw[i-ts*KVBLK]=-cfp[i]; }
  const lds_cptr ncp=(lds_cptr)shm+LDS_NC+hi*16;
  #define ADDC(P0,P1,t) do{ const lds_cptr np_=ncp+(t)*256; _Pragma("unroll") for(int g_=0;g_<4;++g_){ \
      const f32x4_t a_=*(const __attribute__((address_space(3))) f32x4_t*)(np_+g_*32), b_=*(const __attribute__((address_space(3))) f32x4_t*)(np_+g_*32+128); \
      P0[4*g_]+=a_[0];P0[4*g_+1]+=a_[1];P0[4*g_+2]+=a_[2];P0[4*g_+3]+=a_[3]; P1[4*g_]+=b_[0];P1[4*g_+1]+=b_[1];P1[4*g_+2]+=b_[2];P1[4*g_+3]+=b_[3]; } }while(0)
  DMA_K(0,0);DMA_V(0,0);DMA_K(1,SLOTB);
  bf16x8 qr[4];
  #pragma unroll
  for(int d0=0;d0<4;++d0)qr[d0]=*reinterpret_cast<const bf16x8*>(&Qw[(long)r32*DM+d0*16+hi*8]);
  float mhat=0.f,l_reg=0.f;f32x16 o[2];f32x16 negm; { float zz_; asm volatile("v_mov_b32 %0, 0":"=v"(zz_));
    _Pragma("unroll") for(int r=0;r<16;++r){o[0][r]=zz_;o[1][r]=zz_;negm[r]=zz_;} } asm volatile("":"+v"(negm));
  const int qrel=wid*QBLK+r32;
  #define CMASK(P0,P1,t) do{int jb_=(t)-(NT-4); if(jb_>=0)cmask(P0,P1,jb_,qrel,hi);}while(0)
  bool resc=false;
  #define START(P0,P1) do{ const float rm=rowmax(P0,P1); resc=false; \
    { const float dl=rm; mhat=fadd_s(mhat,dl); \
      _Pragma("unroll") for(int r=0;r<16;++r){P0[r]=fsub_s(P0[r],dl);P1[r]=fsub_s(P1[r],dl);} \
      _Pragma("unroll") for(int r=0;r<16;++r)negm[r]=-mhat; asm volatile("":"+v"(negm)); } \
    _Pragma("unroll") for(int r=0;r<16;++r)P0[r]=__builtin_amdgcn_exp2f(P0[r]); }while(0)
  #define RESC() do{ if(resc){ asm volatile("s_waitcnt lgkmcnt(0)":::"memory"); \
      _Pragma("unroll") for(int d_=0;d_<2;++d_) _Pragma("unroll") for(int r=0;r<16;++r)o[d_][r]*=wsf[crow(r,hi)]; } }while(0)
  f32x16 pA0,pA1,pB0,pB1;
  int sl_prev=0,sl_cur=0,sl_next=SLOTB;
  #define ROT() do{sl_prev=sl_cur;sl_cur=sl_next;sl_next=(sl_next==(NSLOT-1)*SLOTB)?0:sl_next+SLOTB;}while(0)
  DMA_K(2,2*SLOTB);
  WAIT_BAR(3);
  qkt(pA0,pA1,Kbase,qr,negm,r32,hi);asm volatile("s_nop 15\n\ts_nop 7":"+v"(pA0),"+v"(pA1));ADDC(pA0,pA1,0);CMASK(pA0,pA1,0);
  START(pA0,pA1);
  _Pragma("unroll") for(int r=0;r<16;++r)pA1[r]=__builtin_amdgcn_exp2f(pA1[r]);
  WAIT_BAR(0);
  DMA_K(3,0);DMA_V(1,SLOTB);
  ROT();
  kload8(kf,kp0+sl_cur);
  WAIT_BAR(2);
  s16x4 vlo[8],vhi[8]; u32x4 pw0,pw1,pw2,pw3;
  #define PKW(P,B) cvtpk_s(P[B],P[B+1])
  #define PAF(k) __builtin_bit_cast(bf16x8,pw##k)
  #define VFR(i) (bf16x8){vlo[i][0],vlo[i][1],vlo[i][2],vlo[i][3],vhi[i][0],vhi[i][1],vhi[i][2],vhi[i][3]}
  #define PIN(x) asm volatile("":"+v"(x))
  #define MX3(a,b,c) __builtin_fmaxf(__builtin_fmaxf((a),(b)),(c))
  #define GAPA(MF,A0,A1,A2,A3,W0,W1,PW) do{ MF; sacc+=A0; sacc+=A1; sacc+=A2; sacc+=A3; PIN(sacc); W0; W1; PIN(PW); SBAR(); }while(0)
  #define EX(v) __builtin_amdgcn_exp2f(v)
  #define GAPB(MF,X,B) do{ MF; X[B]=EX(X[B]); X[B+1]=EX(X[B+1]); X[B+2]=EX(X[B+2]); X[B+3]=EX(X[B+3]); PIN(X); SBAR(); }while(0)
  #define VRD(i) do{ vlo[i]=vtr(vp_+(((i)>>2)*4096+((i)&3)*1024)); vhi[i]=vtr(vp_+(((i)>>2)*4096+((i)&3)*1024+512)); }while(0)
  #define KRD(G,j) do{ if(G){ kload2(kf,kp0+sl_next,j); SBAR(); } }while(0)
  #define STEP(C0,C1,P0,P1,t,GK,GV,GL) do{ SBAR(); \
    const lds_cptr vp_=vp0+sl_prev; \
    VRD(0); SBAR(); float sacc=(P0[0]+P0[1]); \
    GAPA(C0=__builtin_amdgcn_mfma_f32_32x32x16_bf16(kf[0],qr[0],negm,0,0,0), P0[2],P0[3],P0[4],P0[5],     pw0[0]=PKW(P0,0), pw0[1]=PKW(P0,2), pw0); \
    VRD(4); SBAR(); GAPA(C1=__builtin_amdgcn_mfma_f32_32x32x16_bf16(kf[1],qr[0],negm,0,0,0), P0[6],P0[7],P0[8],P0[9],     pw0[2]=PKW(P0,4), pw0[3]=PKW(P0,6), pw0); \
    VRD(1); SBAR(); GAPA(C0=__builtin_amdgcn_mfma_f32_32x32x16_bf16(kf[2],qr[1],C0,0,0,0),   P0[10],P0[11],P0[12],P0[13], pw1[0]=PKW(P0,8), pw1[1]=PKW(P0,10), pw1); \
    VRD(5); SBAR(); GAPA(C1=__builtin_amdgcn_mfma_f32_32x32x16_bf16(kf[3],qr[1],C1,0,0,0),   P0[14],P0[15],P1[0],P1[1],   pw1[2]=PKW(P0,12),pw1[3]=PKW(P0,14), pw1); \
    VRD(2); SBAR(); GAPA(C0=__builtin_amdgcn_mfma_f32_32x32x16_bf16(kf[4],qr[2],C0,0,0,0),   P1[2],P1[3],P1[4],P1[5],     pw2[0]=PKW(P1,0), pw2[1]=PKW(P1,2), pw2); \
    VRD(6); SBAR(); GAPA(C1=__builtin_amdgcn_mfma_f32_32x32x16_bf16(kf[5],qr[2],C1,0,0,0),   P1[6],P1[7],P1[8],P1[9],     pw2[2]=PKW(P1,4), pw2[3]=PKW(P1,6), pw2); \
    VRD(3); SBAR(); GAPA(C0=__builtin_amdgcn_mfma_f32_32x32x16_bf16(kf[6],qr[3],C0,0,0,0),   P1[10],P1[11],P1[12],P1[13], pw3[0]=PKW(P1,8), pw3[1]=PKW(P1,10), pw3); \
    VRD(7); SBAR(); GAPA(C1=__builtin_amdgcn_mfma_f32_32x32x16_bf16(kf[7],qr[3],C1,0,0,0),   P1[14],P1[15],0.f,0.f,       pw3[2]=PKW(P1,12),pw3[3]=PKW(P1,14), pw3); \
    l_reg+=sacc; \
    if(GK){DMA_K((t)+3,sl_cur);} if(GV){DMA_V((t)+1,sl_next);} \
    ADDC(C0,C1,t); CMASK(C0,C1,t); \
    { float a=MX3(C0[0],C0[1],C1[0]),b=MX3(C0[2],C0[3],C1[1]); a=MX3(a,C1[2],C1[3]); \
      _Pragma("unroll") for(int r=4;r<16;r+=4){a=MX3(a,C0[r],C0[r+1]);b=MX3(b,C0[r+2],C0[r+3]);a=MX3(a,C1[r],C1[r+1]);b=MX3(b,C1[r+2],C1[r+3]);} \
      float rm=__builtin_fmaxf(a,b); { auto rr=__builtin_amdgcn_permlane32_swap(__float_as_uint(rm),__float_as_uint(rm),false,false); rm=__builtin_fmaxf(__uint_as_float(rr[0]),__uint_as_float(rr[1])); } \
      resc=false; \
      if(__builtin_expect(__any(rm>(float)THRL),0)){ const float dl=__builtin_fmaxf(rm,0.f); mhat+=dl; \
        _Pragma("unroll") for(int r=0;r<16;++r){C0[r]-=dl;C1[r]-=dl;} \
        _Pragma("unroll") for(int r=0;r<16;++r)negm[r]=-mhat; asm volatile("":"+v"(negm)); \
        const float f=__builtin_amdgcn_exp2f(-dl); l_reg*=f; if(hi==0)wsf[r32]=f; resc=true; } } \
    SBAR(); \
    GAPB(o[0]=__builtin_amdgcn_mfma_f32_32x32x16_bf16(PAF(0),VFR(0),o[0],0,0,0), C0,0); \
    GAPB(o[1]=__builtin_amdgcn_mfma_f32_32x32x16_bf16(PAF(0),VFR(4),o[1],0,0,0), C0,4); \
    KRD(GL,0); GAPB(o[0]=__builtin_amdgcn_mfma_f32_32x32x16_bf16(PAF(1),VFR(1),o[0],0,0,0), C0,8); \
    KRD(GL,1); GAPB(o[1]=__builtin_amdgcn_mfma_f32_32x32x16_bf16(PAF(1),VFR(5),o[1],0,0,0), C0,12); \
    KRD(GL,2); GAPB(o[0]=__builtin_amdgcn_mfma_f32_32x32x16_bf16(PAF(2),VFR(2),o[0],0,0,0), C1,0); \
    KRD(GL,3); GAPB(o[1]=__builtin_amdgcn_mfma_f32_32x32x16_bf16(PAF(2),VFR(6),o[1],0,0,0), C1,4); \
    GAPB(o[0]=__builtin_amdgcn_mfma_f32_32x32x16_bf16(PAF(3),VFR(3),o[0],0,0,0), C1,8); \
    GAPB(o[1]=__builtin_amdgcn_mfma_f32_32x32x16_bf16(PAF(3),VFR(7),o[1],0,0,0), C1,12); \
    }while(0)
  int t=1;
  #undef CMASK
  #define CMASK(P0,P1,t) do{}while(0)
  for(;t+5<NT;t+=2){
    STEP(pB0,pB1,pA0,pA1,t,true,true,true);     WAIT_BAR(2); RESC(); ROT();
    STEP(pA0,pA1,pB0,pB1,t+1,true,true,true);   WAIT_BAR(2); RESC(); ROT();
  }
  #undef CMASK
  #define CMASK(P0,P1,t) do{int jb_=(t)-(NT-4); if(jb_>=0)cmask(P0,P1,jb_,qrel,hi);}while(0)
  #define ENDW(tt) do{ if((tt)+3<NT){WAIT_BAR(2);} else if((tt)+2<NT){WAIT_BAR(1);} else {WAIT_BAR(0);} }while(0)
  for(;t+1<NT;t+=2){
    STEP(pB0,pB1,pA0,pA1,t,(t+3<NT),(t+1<NT),(t+1<NT));       ENDW(t);   RESC(); ROT();
    STEP(pA0,pA1,pB0,pB1,t+1,(t+4<NT),(t+2<NT),(t+2<NT));     ENDW(t+1); RESC(); ROT();
  }
  STEP(pB0,pB1,pA0,pA1,NT-1,false,false,false); RESC();
  { float sacc=pB0[0]+pB0[1]; _Pragma("unroll") for(int r=2;r<16;++r)sacc+=pB0[r]; _Pragma("unroll") for(int r=0;r<16;++r)sacc+=pB1[r]; l_reg+=sacc;
    pw0=(u32x4){PKW(pB0,0),PKW(pB0,2),PKW(pB0,4),PKW(pB0,6)};pw1=(u32x4){PKW(pB0,8),PKW(pB0,10),PKW(pB0,12),PKW(pB0,14)};pw2=(u32x4){PKW(pB1,0),PKW(pB1,2),PKW(pB1,4),PKW(pB1,6)};pw3=(u32x4){PKW(pB1,8),PKW(pB1,10),PKW(pB1,12),PKW(pB1,14)};
    int tl_=lane_id_v(); asm volatile("":"+v"(tl_)); const int ln_=tl_&63,hi_=ln_>>5; const int vb0e=(int)(lds0+LDS_V)+((ln_>>4)&1)*32+(ln_&3)*8+(4*hi_+((ln_&15)>>2))*64;
    SBAR(); pv(o,vb0e+sl_cur,PAF(0),PAF(1),PAF(2),PAF(3)); }
  #undef PKW
  #undef PAF
  #undef VFR
  #undef PIN
  #undef MX3
  #undef GAPA
  #undef GAPB
  #undef EX
  #undef VRD
  #undef KRD
  #undef STEP
  #undef ENDW
  {auto rr=__builtin_amdgcn_permlane32_swap(__float_as_uint(l_reg),__float_as_uint(l_reg),false,false);l_reg=__uint_as_float(rr[0])+__uint_as_float(rr[1]);}
  int te_=lane_id_v(); asm volatile("":"+v"(te_)); const int lane_e=te_&63,r32_e=lane_e&31,hi_e=lane_e>>5;
  if(hi_e==0)wsf[32+r32_e]=l_reg;asm volatile("s_waitcnt lgkmcnt(0)":::"memory");
  float rli[16];
  #pragma unroll
  for(int r=0;r<16;++r)rli[r]=__builtin_amdgcn_rcpf(wsf[32+crow(r,hi_e)]);
  bf16*Ow=O+(rowbase+q0+wid*QBLK)*DM+h*D;
  { bf16*stg=(bf16*)(shm+LDS_OST)+wid*2048;
    #pragma unroll
    for(int r=0;r<16;++r){const int orow=crow(r,hi_e);
      #pragma unroll
      for(int d0=0;d0<2;++d0)stg[orow*64+d0*32+r32_e]=__float2bfloat16(o[d0][r]*rli[r]);}
    asm volatile("s_waitcnt lgkmcnt(0)":::"memory");
    #pragma unroll
    for(int i=0;i<4;++i){const int row=i*8+(lane_e>>3),ch=lane_e&7; const u32x4 v=*(const u32x4*)(stg+row*64+ch*8); ATTN_STORE16(Ow+(long)row*DM+ch*8,v);} }
  asm volatile("s_waitcnt lgkmcnt(0)\n\ts_barrier":::"memory");
  #undef ADDC
  #undef DMA_K
  #undef DMA_V
  #undef CMASK
  #undef START
  #undef RESC
  #undef ROT
}
constexpr int ATTN_LDS_BYTES=LDS_BYTES;
struct AttnTensors { const bf16* Q; const bf16* K; const bf16* V; bf16* O; const float* CF; float dskip; };
struct AttnUnit { int bh; int qb; };
struct StaticOrder {
  int vcu;
  __device__ __forceinline__ explicit StaticOrder(int grid,int block):vcu((block%8)*(grid/8)+block/8){}
  __device__ __forceinline__ bool next(int i,AttnUnit&u)const{ if(i>=2)return false; const int s=vcu&7; u.bh=vcu>>3; u.qb=(i==0)?s:15-s; return true; }
  __device__ __forceinline__ void a_ready(const AttnUnit&)const{}
  __device__ __forceinline__ void done(const AttnUnit&)const{}
};
template<class Sched,int THRL=8> __device__ __forceinline__ void attn_phase(char*lds,const AttnTensors&T,const Sched&S,int wave_id){
  AttnUnit u;
  for(int i=0;S.next(i,u);++i){ S.a_ready(u); attn_unit<THRL>(u.bh/NHEAD,u.bh%NHEAD,u.qb,T.Q,T.K,T.V,T.O,T.CF,T.dskip,lds,wave_id); S.done(u); }
}
#undef SBAR
#undef WAIT_BAR
}

struct Args { const float* in[16]; float* out; unsigned char* ws; };
__global__ void __launch_bounds__(NWAVES * 64, 2) hyb_fwd(Args args) {
    extern __shared__ __attribute__((aligned(16))) unsigned char lds[];
    Ctx F;
    F.lds = (LAS unsigned char*)lds;
    F.tid = threadIdx.x; F.lane = F.tid & 63; F.wave = __builtin_amdgcn_readfirstlane(F.tid >> 6);
    F.G = gridDim.x; F.gw = blockIdx.x * NWAVES + F.wave; F.NGW = F.G * NWAVES;
    F.out = args.out; F.ws = args.ws;
    volatile LAS unsigned* MISC = (volatile LAS unsigned*)(F.lds + MISC_OFF);
    for (int u = F.tid; u < (LDS_BYTES - LDSCTL_OFF) / 4; u += NWAVES * 64) ((LAS unsigned*)(F.lds + LDSCTL_OFF))[u] = 0u;
    __syncthreads();
    gu32* ctl = (gu32*)(F.ws + WS_CTL);
    XcdBarrier bar = xcd_barrier_post((unsigned*)(ctl + CW_BAR), MISC + 8); bar.w = F.wave;
#define FRESH(P) Ctx P = F; P.tid = (F.wave << 6) | lane_id_v(); asm volatile("" : "+v"(P.tid), "+s"(P.wave), "+s"(P.gw), "+s"(P.ws), "+s"(P.out)); P.lane = P.tid & 63
#define GRID_BAR() do { XcdBarrier b_ = bar; asm volatile("" : "+s"(b_.bar), "+s"(b_.x)); xcd_barrier(b_); } while (0)

    bf16* Wb = (bf16*)(F.ws + WS_W);
    bf16* Z = (bf16*)(F.ws + WS_Z); float* ZS = (float*)(F.ws + WS_ZS); bf16* HDN = (bf16*)(F.ws + WS_HDN);
    float* M32 = (float*)(F.ws + WS_HDN); bf16* HB = (bf16*)(F.ws + WS_Z);
    LAS unsigned char* ring = F.lds + RING_OFF; float* SSp = (float*)(F.ws + WS_SS); bf16* XA = (bf16*)F.out;

    { FRESH(P); p0_prologue(P, args.in[2], args.in[9], args.in[10], args.in[11], args.in[12], args.in[14], args.in[15], args.in[1], args.in[13]); }
    { FRESH(P); norm0_phase(P, args.in[0], (bf16*)P.out, (float*)(P.ws + WS_SS)); }
    GRID_BAR();

    #pragma unroll 1
    for (int layer = 0; layer < DEPTH; ++layer) {
        const bf16* L = Wb + (size_t)layer * LW_STRIDE;
        { pg8::Gemm g{XA, L + LW_IN, M, NIN, DM, DM, DM}; pg8::StaticOrder S; S.init(M, NIN, F.G, (int)blockIdx.x);
          pg8::EpiZ E{Z, ZS, SSp, args.in[4] + layer * 64, args.in[5] + layer * 64, args.in[6] + layer * 64, (const float*)(F.ws + WS_ROPE64)};
          pg8::gemm_phase<pg8::EpiZ, pg8::StaticOrder, true, true>(ring, g, S, E, F.wave); }
        GRID_BAR();
#ifdef PROBE_PP
        { FRESH(P); post_phase(P, args.in[4] + layer * 64, args.in[5] + layer * 64, args.in[6] + layer * 64, args.in[7] + layer * 64, args.in[3] + layer * 8, true); }
#endif
        { FRESH(P); post_phase(P, args.in[4] + layer * 64, args.in[5] + layer * 64, args.in[6] + layer * 64, args.in[7] + layer * 64, args.in[3] + layer * 8); }
        { FRESH(P); ret_state_mfma(P); }
        GRID_BAR();
        { FRESH(P); fscan_phase(P); }
        { FRESH(P); ret_scan(P); }
        GRID_BAR();
#ifdef PROBE_RO
        { FRESH(P); ret_out_mfma(P, args.in[8] + layer * 512, true); }
#endif
        { FRESH(P); ret_out_mfma(P, args.in[8] + layer * 512); }
#ifdef PROBE_X3
        for (int rep_ = 0; rep_ < 2; ++rep_)
        { static_assert(attn_body::ATTN_LDS_BYTES <= RING_BYTES, "attention scratch fits the ring region");
          unsigned char* wsl = F.ws; asm volatile("" : "+s"(wsl));
          bf16* Zl = (bf16*)(wsl + WS_Z);
          const attn_body::AttnTensors AT{(const attn_body::bf16*)(Zl + Z_FQ), (const attn_body::bf16*)(Zl + Z_FK), (const attn_body::bf16*)(Zl + Z_FV), (attn_body::bf16*)(Zl + (rep_ == 0 ? Z_RQ : Z_FQ)), (const float*)(wsl + WS_CF)};
          const attn_body::StaticOrder S((int)F.G, (int)blockIdx.x);
          attn_body::attn_phase<attn_body::StaticOrder, 20>((char*)lds + RING_OFF, AT, S, F.wave); }
#ifdef PROBE_X4
        { FRESH(P); dsa_v3(P); }
#else
        for (int rep_ = 0; rep_ < 2; ++rep_) { FRESH(P); dsa_v3(P, rep_ == 0 ? Z_RG : Z_DQ); }
#endif
#else
        { static_assert(attn_body::ATTN_LDS_BYTES <= RING_BYTES, "attention scratch fits the ring region");
          unsigned char* wsl = F.ws; asm volatile("" : "+s"(wsl));
          bf16* Zl = (bf16*)(wsl + WS_Z);
          float dskip; { const int ln = lane_id_v(); const float gq = wave_max(fabsf(args.in[4][layer * 64 + ln])), gk = wave_max(fabsf(args.in[5][layer * 64 + ln])); dskip = 2.0f * (64.0f * C2 * gq * gk * 1.02f) + 48.0f; }
          const attn_body::AttnTensors AT{(const attn_body::bf16*)(Zl + Z_FQ), (const attn_body::bf16*)(Zl + Z_FK), (const attn_body::bf16*)(Zl + Z_FV), (attn_body::bf16*)(Zl + Z_FQ), (const float*)(wsl + WS_CF), dskip};
          const attn_body::StaticOrder S((int)F.G, (int)blockIdx.x);
          attn_body::attn_phase<attn_body::StaticOrder, 20>((char*)lds + RING_OFF, AT, S, F.wave); }
        { FRESH(P); dsa_v3(P); }
#endif
        GRID_BAR();
        { pg8::Gemm g{Z + Z_FQ, L + LW_MIX, M, DM, 1536, ZP, 1536}; pg8::StaticOrder S; S.init(M, DM, F.G, (int)blockIdx.x);
          pg8::EpiGateF E{(const unsigned char*)(Z + Z_ZG), Z + Z_MRG};
          pg8::gemm_phase<pg8::EpiGateF, pg8::StaticOrder, false, true>(ring, g, S, E, F.wave); }
        GRID_BAR();
        { pg8::Gemm g{Z + Z_MRG, L + LW_O, M, DM, DM, ZP, DM}; pg8::StaticOrder S; S.init(M, DM, F.G, (int)blockIdx.x);
          pg8::EpiRes E{XA, HDN, nullptr, SSp};
          pg8::gemm_phase<pg8::EpiRes, pg8::StaticOrder, false, true>(ring, g, S, E, F.wave); }
        GRID_BAR();
        { pg8::Gemm g{HDN, L + LW_FI, M, FF2, DM, DM, DM}; pg8::StaticOrder S; S.init(M, FF2, F.G, (int)blockIdx.x);
          pg8::EpiSwi E{HB, FFH, SSp};
          pg8::gemm_phase<pg8::EpiSwi, pg8::StaticOrder, true, true>(ring, g, S, E, F.wave); }
        GRID_BAR();
        { pg8::Gemm g{HB, L + LW_FO, M, DM, FFH, FFH, FFH}; pg8::StaticOrder S; S.init(M, DM, F.G, (int)blockIdx.x);
          pg8::EpiRes E{HDN, XA, (layer + 1 < DEPTH) ? nullptr : F.out, SSp};
          pg8::gemm_phase<pg8::EpiRes, pg8::StaticOrder, false, true>(ring, g, S, E, F.wave); }
        GRID_BAR();
    }
    if (__hip_atomic_load((gu32*)((unsigned*)(ctl + CW_BAR) + XB_TMO), RLX_AGENT) != 0u) {
        const float q = __builtin_nanf("");
        for (int m = F.gw; m < M; m += F.NGW) { GAS f32x4* o = (GAS f32x4*)(F.out + (size_t)m * DM) + lane_id_v();
#pragma unroll
            for (int j = 0; j < 4; ++j) o[64 * j] = (f32x4){q, q, q, q}; }
    }
}

extern "C" void kernel_launch(void* const* d_in, const int* in_sizes, int n_in, void* d_out, int out_size, void* d_ws, size_t ws_size, hipStream_t stream) {
    static int grid = 0;
    if (grid == 0) {
        if (n_in != 16 || in_sizes[0] != M * DM || out_size != M * DM || ws_size < WS_END) { fprintf(stderr, "kernel_launch: unexpected shapes / workspace (n_in %d, in0 %d, out %d, ws %zu < %zu)\n", n_in, n_in > 0 ? in_sizes[0] : -1, out_size, ws_size, (size_t)WS_END); grid = -1; return; }
        int dev = 0, cus = 0, per_cu = 0;
        if (hipGetDevice(&dev) != hipSuccess || hipDeviceGetAttribute(&cus, hipDeviceAttributeMultiprocessorCount, dev) != hipSuccess) { grid = -1; return; }
        if (hipFuncSetAttribute((const void*)hyb_fwd, hipFuncAttributeMaxDynamicSharedMemorySize, LDS_BYTES) != hipSuccess) { fprintf(stderr, "kernel_launch: hipFuncSetAttribute failed\n"); grid = -1; return; }
        if (hipOccupancyMaxActiveBlocksPerMultiprocessor(&per_cu, (const void*)hyb_fwd, NWAVES * 64, LDS_BYTES) != hipSuccess || per_cu < 1) { fprintf(stderr, "kernel_launch: occupancy query reports %d blocks per CU\n", per_cu); }
        (void)hipGetLastError();
        grid = cus;
    }
    if (grid < 0) return;
    if (hipMemsetAsync((char*)d_ws + WS_CTL, 0, CTL_ZERO_BYTES, stream) != hipSuccess) return;
    Args a{};
    for (int i = 0; i < 16; ++i) a.in[i] = (const float*)d_in[i];
    a.out = (float*)d_out; a.ws = (unsigned char*)d_ws;
    hipLaunchKernelGGL(hyb_fwd, dim3(grid), dim3(NWAVES * 64), LDS_BYTES, stream, a);
}
```

```cpp
#include <hip/hip_runtime.h>
#include <cstdio>
#include <cstdint>
#include <cmath>
__device__ __forceinline__ int lane_id_v() { unsigned z; asm volatile("v_mov_b32 %0, 0" : "=v"(z)); return (int)__builtin_amdgcn_mbcnt_hi(~0u, __builtin_amdgcn_mbcnt_lo(~0u, z)); }
template <int MASK> __device__ __forceinline__ float sx(float v) { static_assert(MASK < 32, "swizzle xor mask"); return __builtin_bit_cast(float, __builtin_amdgcn_ds_swizzle(__builtin_bit_cast(int, v), 0x1F | (MASK << 10))); }
template <int MASK> __device__ __forceinline__ unsigned sxu(unsigned v) { return (unsigned)__builtin_amdgcn_ds_swizzle((int)v, 0x1F | (MASK << 10)); }
__device__ __forceinline__ void swap32(unsigned x, unsigned& lo_view, unsigned& hi_view) {
    unsigned a = x, b = x; asm volatile("" : "+v"(b));
    const auto rr = __builtin_amdgcn_permlane32_swap(a, b, false, false);
    lo_view = rr[0]; hi_view = rr[1];
}
template <int CTRL> __device__ __forceinline__ float dpp_f(float v) { return __builtin_bit_cast(float, __builtin_amdgcn_update_dpp(0, __builtin_bit_cast(int, v), CTRL, 0xF, 0xF, false)); }
template <int CTRL> __device__ __forceinline__ int dpp_i(int v) { return __builtin_amdgcn_update_dpp(0, v, CTRL, 0xF, 0xF, false); }
__device__ __forceinline__ float rl_f(float v, int l) { return __builtin_bit_cast(float, __builtin_amdgcn_readlane(__builtin_bit_cast(int, v), l)); }
__device__ __forceinline__ float wave_sum(float v) {
    v += dpp_f<0xB1>(v); v += dpp_f<0x4E>(v); v += dpp_f<0x141>(v); v += dpp_f<0x140>(v);
    return (rl_f(v, 0) + rl_f(v, 16)) + (rl_f(v, 32) + rl_f(v, 48));
}
__device__ __forceinline__ float wave_max(float v) {
    v = fmaxf(v, dpp_f<0xB1>(v)); v = fmaxf(v, dpp_f<0x4E>(v)); v = fmaxf(v, dpp_f<0x141>(v)); v = fmaxf(v, dpp_f<0x140>(v));
    return fmaxf(fmaxf(rl_f(v, 0), rl_f(v, 16)), fmaxf(rl_f(v, 32), rl_f(v, 48)));
}
__device__ __forceinline__ int wave_isum(int v) {
    v += dpp_i<0xB1>(v); v += dpp_i<0x4E>(v); v += dpp_i<0x141>(v); v += dpp_i<0x140>(v);
    return (__builtin_amdgcn_readlane(v, 0) + __builtin_amdgcn_readlane(v, 16)) + (__builtin_amdgcn_readlane(v, 32) + __builtin_amdgcn_readlane(v, 48));
}
__device__ __forceinline__ unsigned wave_umax(unsigned v) {
    unsigned t; t = (unsigned)dpp_i<0xB1>((int)v); v = t > v ? t : v; t = (unsigned)dpp_i<0x4E>((int)v); v = t > v ? t : v; t = (unsigned)dpp_i<0x141>((int)v); v = t > v ? t : v; t = (unsigned)dpp_i<0x140>((int)v); v = t > v ? t : v;
    const unsigned a = (unsigned)__builtin_amdgcn_readlane((int)v, 0), b = (unsigned)__builtin_amdgcn_readlane((int)v, 16), c = (unsigned)__builtin_amdgcn_readlane((int)v, 32), d = (unsigned)__builtin_amdgcn_readlane((int)v, 48);
    const unsigned ab = a > b ? a : b, cd = c > d ? c : d; return ab > cd ? ab : cd;
}
__device__ __forceinline__ unsigned wave_umin(unsigned v) { return ~wave_umax(~v); }
__device__ __forceinline__ float half_sum(float v) {
    unsigned a, b; swap32(__builtin_bit_cast(unsigned, v), a, b); return __builtin_bit_cast(float, a) + __builtin_bit_cast(float, b);
}
__device__ __forceinline__ float half_max(float v) {
    unsigned a, b; swap32(__builtin_bit_cast(unsigned, v), a, b); return fmaxf(__builtin_bit_cast(float, a), __builtin_bit_cast(float, b));
}
namespace pg8 {
#define PG8_LAS __attribute__((address_space(3)))
typedef unsigned short bf16_t;
typedef PG8_LAS float PG8_LAS_F;
typedef short bf16x8 __attribute__((ext_vector_type(8)));
typedef float f32x4 __attribute__((ext_vector_type(4)));
typedef unsigned u32x4 __attribute__((ext_vector_type(4)));
constexpr int BM = 256, BK = 64, HALF = 128, HTB = HALF * BK * 2  , STAGE_BYTES = 8 * HTB, NXCD = 8, WGM = 8;

__host__ __device__ __forceinline__ int lds_byte(int r, int c) { const int st = (r >> 4) * 2 + (c >> 5), rr = r & 15, cc = c & 31, ob = rr * 64 + cc * 2; return st * 1024 + (ob ^ (((ob >> 9) & 1) << 5)); }
__host__ __device__ __forceinline__ void stage_rc(int b, int& R, int& C) { const int st = b / 1024, sb = b % 1024, swz = sb ^ (((sb >> 9) & 1) << 5); R = (st >> 1) * 16 + swz / 64; C = (st & 1) * 32 + (swz % 64) / 2; }
__host__ __device__ __forceinline__ int perm32(int rho) { const int n = rho >> 4, i = rho & 15; return 8 * (i >> 2) + 4 * n + (i & 3); }

struct Unit { int pm, pn; };
struct Gemm { const bf16_t* A; const bf16_t* Bt; int M, N, K, lda, ldb, tsA; };

struct StaticOrder {
    int nM, nN, nwg, G, c;
    __host__ __device__ void init(int M, int N, int G_, int c_) { nM = M / BM; nN = N / BM; nwg = nM * nN; G = G_; c = c_; }
    __host__ __device__ bool next(int i, Unit& u) const {
        const long L = (long)i * G + c; if (L >= nwg) return false;
        int wgid = (int)L; { const int q = nwg / NXCD, r = nwg % NXCD, xcd = wgid % NXCD, off = wgid / NXCD; wgid = (xcd < r ? xcd * (q + 1) : r * (q + 1) + (xcd - r) * q) + off; }
        const int nig = WGM * nN, gid = wgid / nig, fm = gid * WGM, gsz = (nM - fm) < WGM ? (nM - fm) : WGM;
        u.pm = fm + ((wgid % nig) % gsz); u.pn = (wgid % nig) / gsz; return true;
    }
    __device__ __forceinline__ void a_ready(const Unit&) const {}
    __device__ __forceinline__ void done(const Unit&) const {}
};

__device__ __forceinline__ unsigned cvt_pk_bf16(float lo, float hi) { unsigned r; asm volatile("v_cvt_pk_bf16_f32 %0, %1, %2" : "=v"(r) : "v"(lo), "v"(hi)); return r; }
__device__ __forceinline__ float bflo(unsigned w) { return __builtin_bit_cast(float, w << 16); }
__device__ __forceinline__ float bfhi(unsigned w) { return __builtin_bit_cast(float, w & 0xffff0000u); }
__device__ __forceinline__ float sigmoidf_(float x) { return __builtin_amdgcn_rcpf(1.0f + __builtin_amdgcn_exp2f(-1.4426950408889634f * x)); }

constexpr int ZP = 6656;
constexpr int ZSP = 512;
constexpr int NZT = 26, GATE_T0 = 14, Z_GATE = 3584;
typedef unsigned u32x2 __attribute__((ext_vector_type(2)));

#define PRELOAD_RSTD(rsv, RT_, pmt_, SS_, u_, row0_, wr_, fr_) float rsv[2][4]; \
    if ((u_).pm == (pmt_)) { _Pragma("unroll") for (int ai_ = 0; ai_ < 2; ++ai_) _Pragma("unroll") for (int m_ = 0; m_ < 4; ++m_) rsv[ai_][m_] = (RT_)[(wr_) * 64 + (fr_) + ai_ * HALF + m_ * 16]; } \
    else { f32x4 s_[2][4]; _Pragma("unroll") for (int ai_ = 0; ai_ < 2; ++ai_) _Pragma("unroll") for (int m_ = 0; m_ < 4; ++m_) s_[ai_][m_] = *(const f32x4*)((SS_) + (size_t)((row0_) + ai_ * HALF + m_ * 16) * 4); \
    _Pragma("unroll") for (int ai_ = 0; ai_ < 2; ++ai_) _Pragma("unroll") for (int m_ = 0; m_ < 4; ++m_) rsv[ai_][m_] = 1.0f / __builtin_sqrtf(((s_[ai_][m_][0] + s_[ai_][m_][1]) + (s_[ai_][m_][2] + s_[ai_][m_][3])) * (1.0f / 1024.0f) + 1e-6f); }
__device__ __forceinline__ int rstd_table(PG8_LAS float* RT, const float* SS, const StaticOrder& S, int wave_id) {
    Unit u0; if (!S.next(0, u0)) return -1;
    const int t = (wave_id << 6) | lane_id_v();
    if (t < 256) { const f32x4 s = *(const f32x4*)(SS + (size_t)(u0.pm * BM + t) * 4); RT[t] = 1.0f / __builtin_sqrtf(((s[0] + s[1]) + (s[2] + s[3])) * (1.0f / 1024.0f) + 1e-6f); }
    __syncthreads();
    return u0.pm;
}
struct EpiZ {
    static constexpr bool PERM = true, AFTER_DRAIN = false, MID = false;
    bf16_t* Z; float* ZS; const float* SS; const float* GQ; const float* GK; const float* GD; const float* R64; const PG8_LAS float* RT; int pmt;
    __device__ __forceinline__ void operator()(const f32x4 (&acc)[2][2][4][2], const Unit& u, int wr, int wc, int fr, int fq) const {
        const int row0 = u.pm * BM + wr * 64 + fr;
        PRELOAD_RSTD(rsv, RT, pmt, SS, u, row0, wr, fr);
        if (u.pn < 4 || u.pn == 6 || u.pn == 7) {
            const float osc = (u.pn < 4) ? 0.18033688011112042f : 1.0f; const bool rope = (u.pn == 2 || u.pn == 3);
            f32x4 g00, g01, g10, g11;
            if (u.pn < 2) { g00 = *(const f32x4*)(GQ + 8 * fq); g01 = *(const f32x4*)(GQ + 8 * fq + 4); g10 = *(const f32x4*)(GQ + 32 + 8 * fq); g11 = *(const f32x4*)(GQ + 32 + 8 * fq + 4); }
            else if (u.pn < 4) { g00 = *(const f32x4*)(GD + 8 * fq); g01 = *(const f32x4*)(GD + 8 * fq + 4); g10 = *(const f32x4*)(GD + 32 + 8 * fq); g11 = *(const f32x4*)(GD + 32 + 8 * fq + 4); }
            else { g00 = *(const f32x4*)(GK + 8 * fq); g01 = *(const f32x4*)(GK + 8 * fq + 4); g10 = *(const f32x4*)(GK + 32 + 8 * fq); g11 = *(const f32x4*)(GK + 32 + 8 * fq + 4); }
            const int colo = u.pn * BM + wc * 64 + 8 * fq;
#pragma unroll
            for (int ai = 0; ai < 2; ++ai)
#pragma unroll
                for (int m = 0; m < 4; ++m) { const int row = row0 + ai * HALF + m * 16; const float rs = rsv[ai][m];
                    f32x4 a0 = acc[ai][0][m][0] * rs, a1 = acc[ai][0][m][1] * rs, b0 = acc[ai][1][m][0] * rs, b1 = acc[ai][1][m][1] * rs;
                    float ss = ((a0[0] * a0[0] + a0[1] * a0[1]) + (a0[2] * a0[2] + a0[3] * a0[3])) + ((a1[0] * a1[0] + a1[1] * a1[1]) + (a1[2] * a1[2] + a1[3] * a1[3]))
                             + ((b0[0] * b0[0] + b0[1] * b0[1]) + (b0[2] * b0[2] + b0[3] * b0[3])) + ((b1[0] * b1[0] + b1[1] * b1[1]) + (b1[2] * b1[2] + b1[3] * b1[3]));
                    ss += sx<16>(ss); { unsigned x_, y_; swap32(__builtin_bit_cast(unsigned, ss), x_, y_); ss = __builtin_bit_cast(float, x_) + __builtin_bit_cast(float, y_); }
                    const float hr = osc / __builtin_sqrtf(ss * (1.0f / 64.0f) + 1e-6f);
                    a0 = a0 * g00 * hr; a1 = a1 * g01 * hr; b0 = b0 * g10 * hr; b1 = b1 * g11 * hr;
                    if (rope) { const float* cs = R64 + ((size_t)(row & 4095) * 32 + 8 * fq) * 2;
                        const f32x4 c0 = *(const f32x4*)cs, c1 = *(const f32x4*)(cs + 4), c2 = *(const f32x4*)(cs + 8), c3 = *(const f32x4*)(cs + 12);
                        f32x4 x0, x1, y0, y1;
                        x0[0] = a0[0] * c0[0] - b0[0] * c0[1]; y0[0] = b0[0] * c0[0] + a0[0] * c0[1]; x0[1] = a0[1] * c0[2] - b0[1] * c0[3]; y0[1] = b0[1] * c0[2] + a0[1] * c0[3];
                        x0[2] = a0[2] * c1[0] - b0[2] * c1[1]; y0[2] = b0[2] * c1[0] + a0[2] * c1[1]; x0[3] = a0[3] * c1[2] - b0[3] * c1[3]; y0[3] = b0[3] * c1[2] + a0[3] * c1[3];
                        x1[0] = a1[0] * c2[0] - b1[0] * c2[1]; y1[0] = b1[0] * c2[0] + a1[0] * c2[1]; x1[1] = a1[1] * c2[2] - b1[1] * c2[3]; y1[1] = b1[1] * c2[2] + a1[1] * c2[3];
                        x1[2] = a1[2] * c3[0] - b1[2] * c3[1]; y1[2] = b1[2] * c3[0] + a1[2] * c3[1]; x1[3] = a1[3] * c3[2] - b1[3] * c3[3]; y1[3] = b1[3] * c3[2] + a1[3] * c3[3];
                        a0 = x0; a1 = x1; b0 = y0; b1 = y1; }
                    bf16_t* rowp = Z + (size_t)row * ZP + colo;
                    u32x4 w; w.x = cvt_pk_bf16(a0[0], a0[1]); w.y = cvt_pk_bf16(a0[2], a0[3]); w.z = cvt_pk_bf16(a1[0], a1[1]); w.w = cvt_pk_bf16(a1[2], a1[3]); *(u32x4*)rowp = w;
                    w.x = cvt_pk_bf16(b0[0], b0[1]); w.y = cvt_pk_bf16(b0[2], b0[3]); w.z = cvt_pk_bf16(b1[0], b1[1]); w.w = cvt_pk_bf16(b1[2], b1[3]); *(u32x4*)(rowp + 32) = w;
                    __builtin_amdgcn_sched_barrier(0); }
        } else if (u.pn >= GATE_T0 && u.pn < NZT) {
            unsigned char* gb = (unsigned char*)(Z + Z_GATE) + (u.pn - GATE_T0) * 256 + wc * 32 + 8 * fq;
#pragma unroll
            for (int ai = 0; ai < 2; ++ai)
#pragma unroll
                for (int m = 0; m < 4; ++m) { const float rs = rsv[ai][m]; unsigned char* rowp = gb + (size_t)(row0 + ai * HALF + m * 16) * (ZP * 2);
#pragma unroll
                    for (int bj = 0; bj < 2; ++bj) { const f32x4 v0 = acc[ai][bj][m][0] * rs, v1 = acc[ai][bj][m][1] * rs; u32x2 w = {0u, 0u};
#pragma unroll
                        for (int i = 0; i < 4; ++i) { w.x = __builtin_amdgcn_cvt_pk_u8_f32(__builtin_fmaxf(255.0f * sigmoidf_(v0[i]), 1.0f), i, w.x); w.y = __builtin_amdgcn_cvt_pk_u8_f32(__builtin_fmaxf(255.0f * sigmoidf_(v1[i]), 1.0f), i, w.y); }
                        *(u32x2*)(rowp + bj * HALF) = w; } }
        } else if (u.pn < NZT) {
            const int col0 = u.pn * BM + wc * 32 + 8 * fq;
#pragma unroll
            for (int ai = 0; ai < 2; ++ai)
#pragma unroll
                for (int m = 0; m < 4; ++m) { bf16_t* rowp = Z + (size_t)(row0 + ai * HALF + m * 16) * ZP + col0; const float rs = rsv[ai][m];
#pragma unroll
                    for (int bj = 0; bj < 2; ++bj) { const f32x4 v0 = acc[ai][bj][m][0] * rs, v1 = acc[ai][bj][m][1] * rs;
                        u32x4 w; w.x = cvt_pk_bf16(v0[0], v0[1]); w.y = cvt_pk_bf16(v0[2], v0[3]); w.z = cvt_pk_bf16(v1[0], v1[1]); w.w = cvt_pk_bf16(v1[2], v1[3]);
                        *(u32x4*)(rowp + bj * HALF) = w; } }
        } else {
            const int col0 = (u.pn - NZT) * BM + wc * 32 + 8 * fq;
#pragma unroll
            for (int ai = 0; ai < 2; ++ai)
#pragma unroll
                for (int m = 0; m < 4; ++m) { float* rowp = ZS + (size_t)(row0 + ai * HALF + m * 16) * ZSP + col0; const float rs = rsv[ai][m];
#pragma unroll
                    for (int bj = 0; bj < 2; ++bj) { *(f32x4*)(rowp + bj * HALF) = acc[ai][bj][m][0] * rs; *(f32x4*)(rowp + bj * HALF + 4) = acc[ai][bj][m][1] * rs; } }
        }
    }
};

template <int P> struct EpiGate {
    static constexpr bool PERM = true, AFTER_DRAIN = false, MID = false;
    const bf16_t* G;
    float* M32;
    bf16_t* OUT;
    __device__ __forceinline__ void operator()(const f32x4 (&acc)[2][2][4][2], const Unit& u, int wr, int wc, int fr, int fq) const {
        const int row0 = u.pm * BM + wr * 64 + fr, col0 = u.pn * BM + wc * 32 + 8 * fq;
#pragma unroll
        for (int ai = 0; ai < 2; ++ai)
#pragma unroll
            for (int m = 0; m < 4; ++m) { const size_t row = (size_t)(row0 + ai * HALF + m * 16);
#pragma unroll
                for (int bj = 0; bj < 2; ++bj) { const int col = col0 + bj * HALF;
                    const u32x4 gw = *(const u32x4*)(G + row * ZP + P * 1024 + col);
                    const f32x4 v0 = acc[ai][bj][m][0], v1 = acc[ai][bj][m][1];
                    f32x4 t0, t1;
                    t0[0] = bflo(gw.x) * v0[0]; t0[1] = bfhi(gw.x) * v0[1]; t0[2] = bflo(gw.y) * v0[2]; t0[3] = bfhi(gw.y) * v0[3];
                    t1[0] = bflo(gw.z) * v1[0]; t1[1] = bfhi(gw.z) * v1[1]; t1[2] = bflo(gw.w) * v1[2]; t1[3] = bfhi(gw.w) * v1[3];
                    float* mp = M32 + row * 1024 + col;
                    if (P == 0) { *(f32x4*)mp = t0; *(f32x4*)(mp + 4) = t1; }
                    else if (P == 1) { *(f32x4*)mp = *(const f32x4*)mp + t0; *(f32x4*)(mp + 4) = *(const f32x4*)(mp + 4) + t1; }
                    else { t0 = *(const f32x4*)mp + t0; t1 = *(const f32x4*)(mp + 4) + t1;
                        u32x4 w; w.x = cvt_pk_bf16(t0[0], t0[1]); w.y = cvt_pk_bf16(t0[2], t0[3]); w.z = cvt_pk_bf16(t1[0], t1[1]); w.w = cvt_pk_bf16(t1[2], t1[3]);
                        *(u32x4*)(OUT + row * ZP + col) = w; } } }
    }
};

struct EpiGateF {
    static constexpr bool PERM = true, AFTER_DRAIN = false, MID = true;
    const unsigned char* G; bf16_t* OUT;
    __device__ __forceinline__ void mid(f32x4 (&acc)[2][2][4][2], const Unit& u, int wr, int wc, int fr_, int fq_, int s) const {
        int fr = fr_, fq = fq_; asm volatile("" : "+v"(fr), "+v"(fq));
        const int row0 = u.pm * BM + wr * 64 + fr, col0 = u.pn * BM + wc * 32 + 8 * fq;
        u32x2 ga[2][4][2], gb[2][4][2];
#pragma unroll
        for (int ai = 0; ai < 2; ++ai)
#pragma unroll
            for (int m = 0; m < 4; ++m)
#pragma unroll
                for (int bj = 0; bj < 2; ++bj) { const unsigned char* gp = G + (size_t)(row0 + ai * HALF + m * 16) * (ZP * 2) + s * 1024 + col0 + bj * HALF; ga[ai][m][bj] = *(const u32x2*)gp; gb[ai][m][bj] = *(const u32x2*)(gp + 1024); }
#pragma unroll
        for (int ai = 0; ai < 2; ++ai)
#pragma unroll
            for (int m = 0; m < 4; ++m)
#pragma unroll
                for (int bj = 0; bj < 2; ++bj) { const u32x2 a = ga[ai][m][bj], b = gb[ai][m][bj]; f32x4 r0, r1;
                    r0[0] = (float)(a.x & 255u) * __builtin_amdgcn_rcpf((float)(b.x & 255u)); r0[1] = (float)((a.x >> 8) & 255u) * __builtin_amdgcn_rcpf((float)((b.x >> 8) & 255u));
                    r0[2] = (float)((a.x >> 16) & 255u) * __builtin_amdgcn_rcpf((float)((b.x >> 16) & 255u)); r0[3] = (float)(a.x >> 24) * __builtin_amdgcn_rcpf((float)(b.x >> 24));
                    r1[0] = (float)(a.y & 255u) * __builtin_amdgcn_rcpf((float)(b.y & 255u)); r1[1] = (float)((a.y >> 8) & 255u) * __builtin_amdgcn_rcpf((float)((b.y >> 8) & 255u));
                    r1[2] = (float)((a.y >> 16) & 255u) * __builtin_amdgcn_rcpf((float)((b.y >> 16) & 255u)); r1[3] = (float)(a.y >> 24) * __builtin_amdgcn_rcpf((float)(b.y >> 24));
                    acc[ai][bj][m][0] = acc[ai][bj][m][0] * r0; acc[ai][bj][m][1] = acc[ai][bj][m][1] * r1; }
    }
    __device__ __forceinline__ void operator()(const f32x4 (&acc)[2][2][4][2], const Unit& u, int wr, int wc, int fr, int fq) const {
        const int row0 = u.pm * BM + wr * 64 + fr, col0 = u.pn * BM + wc * 32 + 8 * fq; const float k255 = 1.0f / 255.0f;
#pragma unroll
        for (int ai = 0; ai < 2; ++ai)
#pragma unroll
            for (int m = 0; m < 4; ++m) { const size_t row = (size_t)(row0 + ai * HALF + m * 16);
#pragma unroll
                for (int bj = 0; bj < 2; ++bj) { const int col = col0 + bj * HALF;
                    const u32x2 gw = *(const u32x2*)(G + row * (ZP * 2) + 2 * 1024 + col);
                    const f32x4 v0 = acc[ai][bj][m][0] * k255, v1 = acc[ai][bj][m][1] * k255;
                    u32x4 w; w.x = cvt_pk_bf16((float)(gw.x & 255u) * v0[0], (float)((gw.x >> 8) & 255u) * v0[1]); w.y = cvt_pk_bf16((float)((gw.x >> 16) & 255u) * v0[2], (float)(gw.x >> 24) * v0[3]);
                    w.z = cvt_pk_bf16((float)(gw.y & 255u) * v1[0], (float)((gw.y >> 8) & 255u) * v1[1]); w.w = cvt_pk_bf16((float)((gw.y >> 16) & 255u) * v1[2], (float)(gw.y >> 24) * v1[3]);
                    *(u32x4*)(OUT + row * ZP + col) = w; } }
    }
};

struct EpiRes {
    static constexpr bool PERM = true, AFTER_DRAIN = true, MID = false;
    const bf16_t* RES; bf16_t* OUT; float* OUT32; float* SS;
    __device__ __forceinline__ void fused(const f32x4 (&acc)[2][2][4][2], const Unit& u, int wr, int wc, int fr, int fq, PG8_LAS unsigned char* lds, int wid, int lane) const {
        const int row0 = u.pm * BM + wr * 64 + fr, col0 = u.pn * BM + wc * 32 + 8 * fq;
        PG8_LAS float* P = (PG8_LAS float*)lds;
#pragma unroll
        for (int ai = 0; ai < 2; ++ai)
#pragma unroll
            for (int m = 0; m < 4; ++m) { const int row = row0 + ai * HALF + m * 16; const size_t off = (size_t)row * 1024 + col0; float ss = 0.f;
#pragma unroll
                for (int bj = 0; bj < 2; ++bj) { const u32x4 r = *(const u32x4*)(RES + off + bj * HALF);
                    f32x4 v0 = acc[ai][bj][m][0], v1 = acc[ai][bj][m][1];
                    v0[0] += bflo(r.x); v0[1] += bfhi(r.x); v0[2] += bflo(r.y); v0[3] += bfhi(r.y); v1[0] += bflo(r.z); v1[1] += bfhi(r.z); v1[2] += bflo(r.w); v1[3] += bfhi(r.w);
                    ss += ((v0[0] * v0[0] + v0[1] * v0[1]) + (v0[2] * v0[2] + v0[3] * v0[3])) + ((v1[0] * v1[0] + v1[1] * v1[1]) + (v1[2] * v1[2] + v1[3] * v1[3]));
                    if (OUT32) { float* op = OUT32 + off + bj * HALF; *(f32x4*)op = v0; *(f32x4*)(op + 4) = v1; }
                    else { u32x4 w; w.x = cvt_pk_bf16(v0[0], v0[1]); w.y = cvt_pk_bf16(v0[2], v0[3]); w.z = cvt_pk_bf16(v1[0], v1[1]); w.w = cvt_pk_bf16(v1[2], v1[3]); *(u32x4*)(OUT + off + bj * HALF) = w; } }
                ss += sx<16>(ss); { unsigned a, b; swap32(__builtin_bit_cast(unsigned, ss), a, b); ss = __builtin_bit_cast(float, a) + __builtin_bit_cast(float, b); }
                if (fq == 0) P[(ai * HALF + wr * 64 + m * 16 + fr) * 4 + wc] = ss; }
        asm volatile("s_waitcnt lgkmcnt(0)\n\ts_barrier" ::: "memory");
        const int t = wid * 64 + lane;
        if (t < 256) { const f32x4 p = *(const PG8_LAS f32x4*)(P + t * 4); SS[(size_t)(u.pm * BM + t) * 4 + u.pn] = (p[0] + p[1]) + (p[2] + p[3]); }
    }
};

struct EpiSwi {
    static constexpr bool PERM = true, AFTER_DRAIN = false, MID = false;
    bf16_t* H; int ldh; int tsH; const float* SS; const PG8_LAS float* RT; int pmt;
    __device__ __forceinline__ void operator()(const f32x4 (&acc)[2][2][4][2], const Unit& u, int wr, int wc, int fr, int fq) const {
        const int row0 = u.pm * BM + wr * 64 + fr, col0 = u.pn * HALF + wc * 32 + 8 * fq;
        PRELOAD_RSTD(rsv, RT, pmt, SS, u, row0, wr, fr);
#pragma unroll
        for (int ai = 0; ai < 2; ++ai)
#pragma unroll
            for (int m = 0; m < 4; ++m) { bf16_t* hp = H + (size_t)u.pm * tsH + (size_t)(wr * 64 + fr + ai * HALF + m * 16) * ldh + col0; const float rs = rsv[ai][m];
                float o[8];
#pragma unroll
                for (int n = 0; n < 2; ++n)
#pragma unroll
                    for (int i = 0; i < 4; ++i) { const float g = acc[ai][0][m][n][i] * rs, up = acc[ai][1][m][n][i] * rs; o[4 * n + i] = g * sigmoidf_(g) * up; }
                u32x4 w; w.x = cvt_pk_bf16(o[0], o[1]); w.y = cvt_pk_bf16(o[2], o[3]); w.z = cvt_pk_bf16(o[4], o[5]); w.w = cvt_pk_bf16(o[6], o[7]);
                *(u32x4*)hp = w; }
    }
};

template <class Epi, class Sched, bool ALIGN_EPI = false, bool SP2 = false>
__device__ __forceinline__ void gemm_phase(PG8_LAS unsigned char* lds, Gemm g, const Sched& S0, const Epi& E, int wave_id) {
    int ovz, osz; asm volatile("v_mov_b32 %0, 0\n\ts_mov_b32 %1, 0" : "=v"(ovz), "=s"(osz));
    Sched S = S0; S.c += osz; g.lda += osz; g.ldb += osz; g.tsA += osz;
    const int tid = ((wave_id << 6) | lane_id_v()) + ovz,
         wid = __builtin_amdgcn_readfirstlane(tid >> 6), lane = tid & 63, wr = wid >> 2, wc = wid & 3, fr = lane & 15, fq = lane >> 4;
    const int K = g.K, nt = K / BK;
    unsigned voffA[2], voffB[2];
#pragma unroll
    for (int i = 0; i < 2; ++i) { int R, C; stage_rc(tid * 16 + i * 8192, R, C); const int Rb = Epi::PERM ? ((R & ~31) + perm32(R & 31)) : R;
        voffA[i] = (unsigned)(R * g.lda + C) * 2u; voffB[i] = (unsigned)(Rb * g.ldb + C) * 2u; }
    const size_t kstep = (size_t)(BK * 2);
    const size_t hstepA = (size_t)HALF * g.lda * 2, hstepB = (size_t)HALF * g.ldb * 2;
    const size_t tstepA = (size_t)g.tsA * 2, tstepB = 2 * hstepB;
    const unsigned ldsw = (unsigned)wid * 1024u;
    const int aoff = lds_byte(wr * 64 + fr, fq * 8), boff = lds_byte(wc * 32 + fr, fq * 8);
#define PG8_SA(b, h) (((b) * 2 + (h)) * HTB)
#define PG8_SB(b, h) ((4 + (b) * 2 + (h)) * HTB)
#define PG8_STAGE(bufoff, gbase, voff) do { _Pragma("unroll") for (int _i = 0; _i < 2; ++_i) \
        __builtin_amdgcn_global_load_lds((const unsigned*)((const char*)(gbase) + (voff)[_i]), (PG8_LAS unsigned*)(lds + (bufoff) + ldsw + _i * 8192), 16, 0, 0); } while (0)
#define PG8_LDA(dst, b, h) do { _Pragma("unroll") for (int m = 0; m < 4; ++m) _Pragma("unroll") for (int k = 0; k < 2; ++k) dst[m][k] = *(const PG8_LAS bf16x8*)(lds + PG8_SA(b, h) + aoff + m * 2048 + k * 1024); } while (0)
#define PG8_LDB(dst, b, h) do { _Pragma("unroll") for (int n = 0; n < 2; ++n) _Pragma("unroll") for (int k = 0; k < 2; ++k) dst[n][k] = *(const PG8_LAS bf16x8*)(lds + PG8_SB(b, h) + boff + n * 2048 + k * 1024); } while (0)
#define PG8_MMA(ai, bj, At, Bt) do { __builtin_amdgcn_s_setprio(1); _Pragma("unroll") for (int m = 0; m < 4; ++m) _Pragma("unroll") for (int n = 0; n < 2; ++n) _Pragma("unroll") for (int k = 0; k < 2; ++k) \
        acc[ai][bj][m][n] = __builtin_amdgcn_mfma_f32_16x16x32_bf16(Bt[n][k], At[m][k], acc[ai][bj][m][n], 0, 0, 0); __builtin_amdgcn_s_setprio(0); } while (0)
#define PG8_WAIT_V(n) asm volatile("s_waitcnt vmcnt(" #n ")" ::: "memory")
#define PG8_WAIT_L(n) asm volatile("s_waitcnt lgkmcnt(" #n ")" ::: "memory")
#define PG8_BAR __builtin_amdgcn_s_barrier()
#define PG8_SCHED __builtin_amdgcn_sched_barrier(0)
    Unit cur, nxt; int ui = 0;
    if (!S.next(0, cur)) return;
    f32x4 acc[2][2][4][2];
#pragma unroll
    for (int a = 0; a < 2; ++a)
#pragma unroll
        for (int b = 0; b < 2; ++b)
#pragma unroll
            for (int m = 0; m < 4; ++m)
#pragma unroll
                for (int n = 0; n < 2; ++n) acc[a][b][m][n] = (f32x4){0.f, 0.f, 0.f, 0.f};
    bf16x8 At[4][2], B0[2][2], B1[2][2];
    const char* cA = (const char*)g.A + (size_t)cur.pm * tstepA; const char* cB = (const char*)g.Bt + (size_t)cur.pn * tstepB;
    S.a_ready(cur);
    if constexpr (SP2) {
        PG8_STAGE(PG8_SB(0, 0), cB, voffB); PG8_STAGE(PG8_SB(0, 1), cB + hstepB, voffB); PG8_STAGE(PG8_SA(0, 0), cA, voffA); PG8_STAGE(PG8_SA(0, 1), cA + hstepA, voffA);
        if (wr == 1) PG8_BAR;
        PG8_WAIT_V(2); PG8_BAR;
        PG8_STAGE(PG8_SB(1, 0), cB + kstep, voffB); PG8_STAGE(PG8_SA(1, 0), cA + kstep, voffA); PG8_STAGE(PG8_SB(1, 1), cB + hstepB + kstep, voffB);
        PG8_WAIT_V(6); PG8_BAR;
    } else {
        PG8_STAGE(PG8_SB(0, 0), cB, voffB); PG8_STAGE(PG8_SA(0, 0), cA, voffA); PG8_STAGE(PG8_SB(0, 1), cB + hstepB, voffB); PG8_STAGE(PG8_SA(0, 1), cA + hstepA, voffA);
        if (wr == 1) PG8_BAR;
        PG8_WAIT_V(4); PG8_BAR;
        PG8_STAGE(PG8_SB(1, 0), cB + kstep, voffB); PG8_STAGE(PG8_SA(1, 0), cA + kstep, voffA); PG8_STAGE(PG8_SB(1, 1), cB + hstepB + kstep, voffB);
        PG8_WAIT_V(6); PG8_BAR;
    }
    for (;;) {
        const bool has_next = S.next(ui + 1, nxt);
        const char* nA = has_next ? (const char*)g.A + (size_t)nxt.pm * tstepA : cA; const char* nB = has_next ? (const char*)g.Bt + (size_t)nxt.pn * tstepB : cB;
        for (int t = 0; t < nt; t += 2) {
            if constexpr (Epi::MID) { if (t == 8 || t == 16) E.mid(acc, cur, wr, wc, fr, fq, (t >> 3) - 1); }
            const bool last = (t == nt - 2);
            const char* a1 = cA + (size_t)(t + 1) * kstep;
            const char* a2 = last ? nA : cA + (size_t)(t + 2) * kstep; const char* b2 = last ? nB : cB + (size_t)(t + 2) * kstep;
            const char* a3 = a2 + kstep; const char* b3 = b2 + kstep;
            if (last && has_next) S.a_ready(nxt);
            if constexpr (SP2) {
            PG8_LDB(B0, 0, 0); PG8_LDB(B1, 0, 1); PG8_SCHED; PG8_LDA(At, 0, 0); PG8_STAGE(PG8_SA(1, 1), a1 + hstepA, voffA);
            PG8_WAIT_V(8); PG8_WAIT_L(0); PG8_BAR; PG8_MMA(0, 0, At, B0); PG8_MMA(0, 1, At, B1); PG8_BAR; PG8_SCHED;
            PG8_LDA(At, 0, 1); PG8_STAGE(PG8_SB(0, 0), b2, voffB); PG8_STAGE(PG8_SB(0, 1), b2 + hstepB, voffB); PG8_STAGE(PG8_SA(0, 0), a2, voffA);
            PG8_WAIT_V(8); PG8_WAIT_L(0); PG8_BAR; PG8_MMA(1, 0, At, B0); PG8_MMA(1, 1, At, B1); PG8_BAR; PG8_SCHED;
            PG8_LDB(B0, 1, 0); PG8_LDB(B1, 1, 1); PG8_SCHED; PG8_LDA(At, 1, 0); PG8_STAGE(PG8_SA(0, 1), a2 + hstepA, voffA);
            PG8_WAIT_V(8); PG8_WAIT_L(0); PG8_BAR; PG8_MMA(0, 0, At, B0); PG8_MMA(0, 1, At, B1); PG8_BAR; PG8_SCHED;
            PG8_LDA(At, 1, 1); PG8_STAGE(PG8_SB(1, 0), b3, voffB); PG8_STAGE(PG8_SB(1, 1), b3 + hstepB, voffB); PG8_STAGE(PG8_SA(1, 0), a3, voffA);
            PG8_WAIT_V(8); PG8_WAIT_L(0); PG8_BAR; PG8_MMA(1, 0, At, B0); PG8_MMA(1, 1, At, B1); PG8_BAR; PG8_SCHED;
            } else {
            PG8_LDB(B0, 0, 0); PG8_SCHED; PG8_LDA(At, 0, 0); PG8_STAGE(PG8_SA(1, 1), a1 + hstepA, voffA);
            PG8_WAIT_L(8); PG8_BAR; PG8_WAIT_L(0); PG8_MMA(0, 0, At, B0); PG8_BAR; PG8_SCHED;
            PG8_LDB(B1, 0, 1); PG8_STAGE(PG8_SB(0, 0), b2, voffB);
            PG8_BAR; PG8_WAIT_L(0); PG8_MMA(0, 1, At, B1); PG8_BAR;
            PG8_LDA(At, 0, 1); PG8_STAGE(PG8_SA(0, 0), a2, voffA);
            PG8_BAR; PG8_WAIT_L(0); PG8_MMA(1, 0, At, B0); PG8_BAR; PG8_SCHED;
            PG8_STAGE(PG8_SB(0, 1), b2 + hstepB, voffB);
            PG8_WAIT_V(6); PG8_BAR; PG8_MMA(1, 1, At, B1); PG8_BAR;
            PG8_LDB(B0, 1, 0); PG8_SCHED; PG8_LDA(At, 1, 0); PG8_STAGE(PG8_SA(0, 1), a2 + hstepA, voffA);
            PG8_WAIT_L(8); PG8_BAR; PG8_WAIT_L(0); PG8_MMA(0, 0, At, B0); PG8_BAR; PG8_SCHED;
            PG8_LDB(B1, 1, 1); PG8_STAGE(PG8_SB(1, 0), b3, voffB);
            PG8_BAR; PG8_WAIT_L(0); PG8_MMA(0, 1, At, B1); PG8_BAR;
            PG8_LDA(At, 1, 1); PG8_STAGE(PG8_SA(1, 0), a3, voffA);
            PG8_BAR; PG8_WAIT_L(0); PG8_MMA(1, 0, At, B0); PG8_BAR; PG8_SCHED;
            PG8_STAGE(PG8_SB(1, 1), b3 + hstepB, voffB);
            PG8_WAIT_V(6); PG8_BAR; PG8_MMA(1, 1, At, B1); PG8_BAR;
            }
        }
        if constexpr (ALIGN_EPI) { if (wr == 0) PG8_BAR; }
        if constexpr (!Epi::AFTER_DRAIN) { E(acc, cur, wr, wc, fr, fq); S.done(cur); }
        if (!has_next) break;
#pragma unroll
        for (int a = 0; a < 2; ++a)
#pragma unroll
            for (int b = 0; b < 2; ++b)
#pragma unroll
                for (int m = 0; m < 4; ++m)
#pragma unroll
                    for (int n = 0; n < 2; ++n) acc[a][b][m][n] = (f32x4){0.f, 0.f, 0.f, 0.f};
        cur = nxt; cA = nA; cB = nB; ++ui;
        if constexpr (ALIGN_EPI) { if (wr == 1) PG8_BAR; }
    }
    PG8_WAIT_V(0);
    if constexpr (!ALIGN_EPI) { if (wr == 0) PG8_BAR; }
    PG8_BAR;
    if constexpr (Epi::AFTER_DRAIN) { E.fused(acc, cur, wr, wc, fr, fq, lds, wid, lane); S.done(cur); }
#undef PG8_SA
#undef PG8_SB
#undef PG8_STAGE
#undef PG8_LDA
#undef PG8_LDB
#undef PG8_MMA
#undef PG8_WAIT_V
#undef PG8_WAIT_L
#undef PG8_BAR
#undef PG8_SCHED
}
}

constexpr int NB = 4, SEQ = 4096, DM = 1024, DEPTH = 4, M = NB * SEQ;
constexpr int INC = 7088;
constexpr int NIN = 7168;
constexpr int FFH = 2816, FF2 = 5632;
constexpr int ZP = pg8::ZP, ZSP = pg8::ZSP;
constexpr int Z_FQ = 0, Z_DQ = 512, Z_RV = 1024, Z_FK = 1536, Z_FV = 2048,
     Z_RQ = 2560, Z_RK = 2816, Z_RG = 3072, Z_ZG = 3584, Z_MRG = 2560;
constexpr int S_IQ = 0, S_DK = 256, S_DV = 320, S_IK = 384, S_IW = 416, S_FF = 424;
constexpr float NORM_EPS = 1e-6f;
constexpr float LOG2E = 1.4426950408889634f;
constexpr float C2 = 0.125f * 1.4426950408889634f;

constexpr size_t MiB = 1u << 20;
constexpr size_t WS_CTL = 0, CTL_ZERO_BYTES = 1 * MiB;
constexpr size_t WS_ROPE64 = 1 * MiB;
constexpr size_t WS_ROPE32 = 2 * MiB;
constexpr size_t WS_LF = 2 * MiB + 512 * 1024;
constexpr size_t WS_CF = 3 * MiB;
constexpr size_t WS_ISG = 3 * MiB + 512 * 1024;
constexpr size_t WS_KD = 4 * MiB;
constexpr size_t WS_VD = 6 * MiB;
constexpr size_t WS_W = 8 * MiB;
constexpr size_t LW_IN = 0, LW_MIX = (size_t)NIN * 1024, LW_O = LW_MIX + 1536 * 1024, LW_FI = LW_O + 1024 * 1024, LW_FO = LW_FI + (size_t)FF2 * 1024, LW_STRIDE = LW_FO + (size_t)FFH * 1024;
constexpr size_t WS_Z = 150 * MiB;
constexpr size_t WS_HDN = 358 * MiB;
constexpr size_t WS_ZS = 390 * MiB;
constexpr size_t WS_IQB = 422 * MiB;
constexpr size_t WS_IKB = 430 * MiB;
constexpr size_t WS_SS = 431 * MiB;
constexpr size_t WS_END = 432 * MiB;
static_assert(WS_W + DEPTH * LW_STRIDE * 2 <= WS_Z && WS_Z + (size_t)M * ZP * 2 <= WS_HDN && WS_HDN + (size_t)M * 1024 * 2 == WS_ZS && WS_ZS + (size_t)M * ZSP * 4 == WS_IQB, "d_ws map");
constexpr int CW_BAR = 4096;

constexpr int RING_OFF = 0, RING_BYTES = 133120;
constexpr int LDSCTL_OFF = RING_BYTES, MISC_OFF = LDSCTL_OFF + 320;
constexpr int XTRA_OFF = RING_BYTES + 1024;
constexpr int LDS_BYTES = 147456;
constexpr int NWAVES = 8;
#define GAS __attribute__((address_space(1)))
#define LAS __attribute__((address_space(3)))
typedef unsigned short bf16;
typedef unsigned v4u __attribute__((ext_vector_type(4)));
typedef float f32x4 __attribute__((ext_vector_type(4)));
typedef short bf16x8 __attribute__((ext_vector_type(8)));
typedef GAS unsigned gu32;
typedef GAS unsigned long long gu64;
#define RLX_AGENT __ATOMIC_RELAXED, __HIP_MEMORY_SCOPE_AGENT
#define LDS_WAIT() asm volatile("s_waitcnt lgkmcnt(0)" ::: "memory")
#define VM_WAIT() asm volatile("s_waitcnt vmcnt(0)" ::: "memory")
__device__ __forceinline__ unsigned long long rt() { return __builtin_amdgcn_s_memrealtime(); }
__device__ __forceinline__ unsigned f2bf(float f) { unsigned u = __builtin_bit_cast(unsigned, f); return (u + 0x7fffu + ((u >> 16) & 1u)) >> 16; }
__device__ __forceinline__ unsigned pk2(float lo, float hi) { unsigned r; asm("v_cvt_pk_bf16_f32 %0, %1, %2" : "=v"(r) : "v"(lo), "v"(hi)); return r; }

#define XB_TMO      128
#define XB_XCNT(j)  (256  + 64 * (j))
#define XB_XSUB(j)  (1280 + 64 * (j))
#define XB_XGEN(j)  (2304 + 64 * (j))
#define XB_TOP      3328
#define XB_TOPGEN   3392
#define XCD_BAR_WORDS 3456
#define XB_LSUB(j)  (3456 + 64 * (j))
#define XB_LGEN(j)  (4480 + 64 * (j))
#define XB_SPIN_CAP (1u << 22)

__device__ __forceinline__ unsigned xb_ld(unsigned* p)              { return __hip_atomic_load(p, __ATOMIC_RELAXED, __HIP_MEMORY_SCOPE_AGENT); }
__device__ __forceinline__ unsigned xb_add(unsigned* p, unsigned v) { return __hip_atomic_fetch_add(p, v, __ATOMIC_RELAXED, __HIP_MEMORY_SCOPE_AGENT); }
__device__ __forceinline__ unsigned xb_xcc_id() { return (unsigned)__builtin_amdgcn_s_getreg((3 << 11) | 20) & 0xFu; }
#define XB_SPIN(cond, bar) do { unsigned _sp = 0; while (cond) { __builtin_amdgcn_s_sleep(1); \
    if ((++_sp & 255u) == 0u) { if (xb_ld(&(bar)[XB_TMO])) break; if (_sp > XB_SPIN_CAP) { atomicAdd(&(bar)[XB_TMO], 1u); break; } } } } while (0)

struct XcdBarrier {
    unsigned* bar; unsigned x; int w;
    volatile LAS unsigned* st;
};

__device__ __forceinline__ XcdBarrier xcd_barrier_post(unsigned* bar, volatile LAS unsigned* st) {
    XcdBarrier b; b.bar = bar; b.x = xb_xcc_id(); b.st = st; b.w = 0;
    if (threadIdx.x == 0) st[2] = xb_add(&bar[XB_XCNT(b.x)], 1u);
    return b;
}
__device__ __forceinline__ void xcd_barrier_complete(unsigned* bar, unsigned x, unsigned& nloc, unsigned& nx) {
    const unsigned G = gridDim.x * gridDim.y * gridDim.z;
    unsigned sum, cnt, mine, sp = 0u;
    for (;;) {
        sum = 0u; cnt = 0u; mine = 0u;
#pragma unroll
        for (unsigned j = 0; j < 16; ++j) { const unsigned c = xb_ld(&bar[XB_XCNT(j)]); sum += c; cnt += (c > 0u) ? 1u : 0u; mine = (j == x) ? c : mine; }
        if (sum == G) break;
        __builtin_amdgcn_s_sleep(1);
        if ((++sp & 255u) == 0u) { if (xb_ld(&bar[XB_TMO])) break; if (sp > XB_SPIN_CAP) { atomicAdd(&bar[XB_TMO], 1u); break; } }
    }
    nloc = mine > 0u ? mine : 1u; nx = cnt > 0u ? cnt : 1u;
}

__device__ __forceinline__ void xcd_barrier(const XcdBarrier& b) {
    asm volatile("s_waitcnt vmcnt(0)" ::: "memory");
    __syncthreads();
    if (b.w == 0 && lane_id_v() == 0) {
        unsigned* bar = b.bar;
        __builtin_amdgcn_s_waitcnt(0);
        unsigned nloc = b.st[0], nx = b.st[1];
        if (nloc == 0u) { xcd_barrier_complete(bar, b.x, nloc, nx); b.st[0] = nloc; b.st[1] = nx; }
        const unsigned old = xb_add(&bar[XB_XSUB(b.x)], 1u);
        const unsigned gen = old / nloc;
        if (old + 1u == (gen + 1u) * nloc) {
            __builtin_amdgcn_fence(__ATOMIC_RELEASE, "agent");
            asm volatile("s_waitcnt vmcnt(0)" ::: "memory");
            const unsigned og = xb_add(&bar[XB_TOP], 1u);
            const unsigned tg = og / nx;
            if (og + 1u == (tg + 1u) * nx) xb_add(&bar[XB_TOPGEN], 1u);
            else XB_SPIN(xb_ld(&bar[XB_TOPGEN]) == tg, bar);
            __builtin_amdgcn_fence(__ATOMIC_ACQUIRE, "agent");
            xb_add(&bar[XB_XGEN(b.x)], 1u);
            asm volatile("s_waitcnt vmcnt(0)" ::: "memory");
        } else {
            XB_SPIN(xb_ld(&bar[XB_XGEN(b.x)]) == gen, bar);
            __builtin_amdgcn_fence(__ATOMIC_ACQUIRE, "agent");
            asm volatile("s_waitcnt vmcnt(0)" ::: "memory");
        }
    }
    __syncthreads();
}

__device__ __forceinline__ void xcd_local_barrier(const XcdBarrier& b) {
    asm volatile("s_waitcnt vmcnt(0)" ::: "memory");
    __syncthreads();
    if (b.w == 0 && lane_id_v() == 0) {
        unsigned* bar = b.bar;
        __builtin_amdgcn_s_waitcnt(0);
        const unsigned nloc = b.st[0];
        const unsigned old = xb_add(&bar[XB_LSUB(b.x)], 1u);
        const unsigned gen = old / nloc;
        if (old + 1u == (gen + 1u) * nloc) xb_add(&bar[XB_LGEN(b.x)], 1u);
        else XB_SPIN(xb_ld(&bar[XB_LGEN(b.x)]) == gen, bar);
        __builtin_amdgcn_fence(__ATOMIC_ACQUIRE, "agent");
        asm volatile("s_waitcnt vmcnt(0)" ::: "memory");
    }
    __syncthreads();
}

typedef float f32x2 __attribute__((ext_vector_type(2)));
typedef unsigned u32x2 __attribute__((ext_vector_type(2)));
__device__ __forceinline__ float bflo(unsigned w) { return __builtin_bit_cast(float, w << 16); }
__device__ __forceinline__ float bfhi(unsigned w) { return __builtin_bit_cast(float, w & 0xffff0000u); }
__device__ __forceinline__ float bf2f(bf16 v) { return __builtin_bit_cast(float, (unsigned)v << 16); }
__device__ __forceinline__ void unpack8(const v4u w, float (&f)[8]) { f[0] = bflo(w.x); f[1] = bfhi(w.x); f[2] = bflo(w.y); f[3] = bfhi(w.y); f[4] = bflo(w.z); f[5] = bfhi(w.z); f[6] = bflo(w.w); f[7] = bfhi(w.w); }
__device__ __forceinline__ v4u pack8(const float (&f)[8]) { v4u w; w.x = pk2(f[0], f[1]); w.y = pk2(f[2], f[3]); w.z = pk2(f[4], f[5]); w.w = pk2(f[6], f[7]); return w; }
__device__ __forceinline__ float xor32(float v, int lane) {
    return __builtin_bit_cast(float, __builtin_amdgcn_ds_bpermute((lane ^ 32) << 2, __builtin_bit_cast(int, v)));
}
__device__ __forceinline__ float sigmoid_f(float x) { return 1.0f / (1.0f + __expf(-x)); }

struct Ctx {
    LAS unsigned char* lds;
    int tid, lane, wave, G, gw, NGW;
    float* out; unsigned char* ws;
};

__device__ __forceinline__ void conv_item(const float* W, int N, int sc, int nv, int k0, bf16* WT, int ldw, int dr, LAS float* scr, int lane, const float* gk = nullptr) {
    const int n_ = lane & 31;
    float wv[32];
#pragma unroll
    for (int i = 0; i < 32; ++i) { const int kk = 2 * i + (lane >> 5); wv[i] = (n_ < nv) ? W[(size_t)(k0 + kk) * N + sc + n_] : 0.f; }
#pragma unroll
    for (int i = 0; i < 32; ++i) { const int kk = 2 * i + (lane >> 5); scr[kk * 33 + n_] = gk ? wv[i] * gk[k0 + kk] : wv[i]; }
    LDS_WAIT(); asm volatile("" ::: "memory");
    const int c = lane & 7;
#pragma unroll
    for (int j = 0; j < 4; ++j) { const int n = (lane >> 3) + 8 * j; const LAS float* s = scr + (8 * c) * 33 + n;
        v4u o; o.x = pk2(s[0 * 33], s[1 * 33]); o.y = pk2(s[2 * 33], s[3 * 33]); o.z = pk2(s[4 * 33], s[5 * 33]); o.w = pk2(s[6 * 33], s[7 * 33]);
        if (n < nv) *(GAS v4u*)(WT + (size_t)(dr + n) * ldw + k0 + 8 * c) = o; }
    LDS_WAIT(); asm volatile("" ::: "memory");
}
__device__ const int SEG_IN[15][3] = {
    {0, Z_FQ, 512}, {512, Z_FK, 512}, {1024, Z_FV, 512}, {1536, 6656 + S_FF, 8}, {1544, Z_DQ, 512}, {2056, 6656 + S_DK, 64}, {2120, 6656 + S_DV, 64},
    {2184, 6656 + S_IQ, 256}, {2440, 6656 + S_IK, 32}, {2472, 6656 + S_IW, 8}, {2480, Z_RQ, 256}, {2736, Z_RK, 256}, {2992, Z_RV, 512}, {3504, Z_RG, 512}, {4016, Z_ZG, 3072}};
constexpr int IN_BLK = 223;
constexpr int IT_IN = 16 * IN_BLK, IT_MIX = 8 * 32, IT_O = 16 * 32, IT_FI = 16 * (FF2 / 32), IT_FO = (FFH / 64) * 32;
constexpr int IT_LAYER = IT_IN + 3 * IT_MIX + IT_O + IT_FI + IT_FO;

__device__ __forceinline__ void sincos_acc(float ang, float& c, float& s) {
    const double a = (double)ang;
    const double k = __builtin_rint(a * 0.6366197723675814);
    double y = a - k * 1.5707963267948966; y -= k * 6.123233995736766e-17;
    const double y2 = y * y;
    double sp = -7.647163731819816e-13; sp = sp * y2 + 1.6059043836821613e-10; sp = sp * y2 - 2.505210838544172e-08; sp = sp * y2 + 2.7557319223985893e-06; sp = sp * y2 - 1.984126984126984e-04; sp = sp * y2 + 8.333333333333333e-03; sp = sp * y2 - 1.6666666666666666e-01;
    const double sn = y + y * y2 * sp;
    double cp = 4.779477332387385e-14; cp = cp * y2 - 1.1470745597729725e-11; cp = cp * y2 + 2.08767569878681e-09; cp = cp * y2 - 2.755731922398589e-07; cp = cp * y2 + 2.48015873015873e-05; cp = cp * y2 - 1.388888888888889e-03; cp = cp * y2 + 4.1666666666666664e-02; cp = cp * y2 - 0.5;
    const double cs = 1.0 + y2 * cp;
    const int q = ((int)k) & 3;
    const double ss = (q & 1) ? cs : sn, cc = (q & 1) ? sn : cs;
    s = (float)((q & 2) ? -ss : ss);
    c = (float)(((q + 1) & 2) ? -cc : cc);
}

__device__ __forceinline__ void p0_prologue(const Ctx& F, const float* w_in, const float* w_fox, const float* w_dsa, const float* w_ret, const float* w_o, const float* w_fi, const float* w_fo, const float* ln1g, const float* ln2g) {
    LAS float* scr = (LAS float*)(F.lds + RING_OFF + F.wave * 16384);
    bf16* Wb = (bf16*)(F.ws + WS_W);
    for (int it = F.gw; it < DEPTH * IT_LAYER; it += F.NGW) {
        const int l = it / IT_LAYER; int r = it % IT_LAYER;
        bf16* L = Wb + (size_t)l * LW_STRIDE;
        if (r < IT_IN) {
            const int kb = r / IN_BLK; int blk = r % IN_BLK; int sc = 0, dr = 0, nv = 0;
            for (int s = 0; s < 15; ++s) { const int w = SEG_IN[s][2], nb = (w + 31) >> 5; if (blk < nb) { sc = SEG_IN[s][0] + 32 * blk; dr = SEG_IN[s][1] + 32 * blk; nv = (w - 32 * blk) < 32 ? (w - 32 * blk) : 32;
                if (s == 0 || s == 1 || s == 4) { const int hd = blk >> 1; dr = SEG_IN[s][1] + (hd >> 2) * 256 + 128 * (blk & 1) + 32 * (hd & 3); }
                break; } blk -= nb; }
            conv_item(w_in + (size_t)l * DM * INC, INC, sc, nv, 64 * kb, L + LW_IN, 1024, dr, scr, F.lane, ln1g + l * DM); continue; }
        r -= IT_IN;
        if (r < 3 * IT_MIX) { const int w = r / IT_MIX, q = r % IT_MIX, kb = q / 32, nb = q % 32;
            conv_item((w == 0 ? w_fox : w == 1 ? w_dsa : w_ret) + (size_t)l * 512 * DM, DM, 32 * nb, 32, 64 * kb, L + LW_MIX + (size_t)w * 512, 1536, 32 * nb, scr, F.lane); continue; }
        r -= 3 * IT_MIX;
        if (r < IT_O) { const int kb = r / 32, nb = r % 32;
            conv_item(w_o + (size_t)l * DM * DM, DM, 32 * nb, 32, 64 * kb, L + LW_O, 1024, 32 * nb, scr, F.lane); continue; }
        r -= IT_O;
        if (r < IT_FI) { const int kb = r / (FF2 / 32), nb = r % (FF2 / 32); const int n0 = 32 * nb;
            const int j = n0 < FFH ? n0 : n0 - FFH; const int dr = 256 * (j >> 7) + (j & 127) + (n0 < FFH ? 0 : 128);
            conv_item(w_fi + (size_t)l * DM * FF2, FF2, n0, 32, 64 * kb, L + LW_FI, 1024, dr, scr, F.lane, ln2g + l * DM); continue; }
        r -= IT_FI;
        { const int kb = r / 32, nb = r % 32;
            conv_item(w_fo + (size_t)l * FFH * DM, DM, 32 * nb, 32, 64 * kb, L + LW_FO, FFH, 32 * nb, scr, F.lane); }
    }
    for (int i = F.gw * 64 + F.lane; i < DEPTH * 80 * 128; i += F.NGW * 64) { const int l = i / (80 * 128), q = i % (80 * 128);
        *(GAS v4u*)(Wb + (size_t)l * LW_STRIDE + LW_IN + (size_t)INC * 1024 + (size_t)q * 8) = (v4u){0u, 0u, 0u, 0u}; }
    f32x2* R64 = (f32x2*)(F.ws + WS_ROPE64); f32x2* R32 = (f32x2*)(F.ws + WS_ROPE32);
    for (int i = F.gw * 64 + F.lane; i < SEQ * 32; i += F.NGW * 64) { const int pos = i >> 5, k = i & 31;
        double f = 1.0; for (int e = 0; e < k; ++e) f *= 0.7498942093324559;
        const float ang = (float)pos * (float)f; float c, s; sincos_acc(ang, c, s); R64[i] = (f32x2){c, s}; }
    for (int i = F.gw * 64 + F.lane; i < SEQ * 16; i += F.NGW * 64) { const int pos = i >> 4, k = i & 15;
        double f = 1.0; for (int e = 0; e < k; ++e) f *= 0.5623413251903491;
        const float ang = (float)pos * (float)f; float c, s; sincos_acc(ang, c, s); R32[i] = (f32x2){c, s}; }
}

__device__ __forceinline__ void norm0_phase(const Ctx& F, const float* x, bf16* o, float* SS) {
    for (int m0 = F.gw; m0 < M; m0 += 4 * F.NGW) {
        f32x4 v[4][4];
#pragma unroll
        for (int r = 0; r < 4; ++r) { const int m = m0 + r * F.NGW; const GAS f32x4* xr = (const GAS f32x4*)(x + (size_t)(m < M ? m : m0) * DM) + F.lane;
#pragma unroll
            for (int j = 0; j < 4; ++j) v[r][j] = xr[64 * j]; }
#pragma unroll
        for (int r = 0; r < 4; ++r) { const int m = m0 + r * F.NGW; if (m < M) { float s = 0.f;
#pragma unroll
            for (int j = 0; j < 4; ++j) s += (v[r][j].x * v[r][j].x + v[r][j].y * v[r][j].y) + (v[r][j].z * v[r][j].z + v[r][j].w * v[r][j].w);
            s = wave_sum(s);
            GAS unsigned long long* o8 = (GAS unsigned long long*)(o + (size_t)m * DM) + F.lane;
#pragma unroll
            for (int j = 0; j < 4; ++j) o8[64 * j] = (unsigned long long)pk2(v[r][j].x, v[r][j].y) | ((unsigned long long)pk2(v[r][j].z, v[r][j].w) << 32);
            if (F.lane < 4) SS[(size_t)m * 4 + F.lane] = (F.lane == 0) ? s : 0.f; } }
    }
}

__device__ __forceinline__ void post_phase(const Ctx& F, const float* g_fq, const float* g_fk, const float* g_dq, const float* g_dk, const float* b_f, bool dummy_out = false) {
    bf16* Z = (bf16*)(F.ws + WS_Z); const float* ZS = (const float*)(F.ws + WS_ZS);
    const f32x2* R64 = (const f32x2*)(F.ws + WS_ROPE64); const f32x2* R32 = (const f32x2*)(F.ws + WS_ROPE32);
    float* LF = (float*)(F.ws + WS_LF); unsigned* ISG = (unsigned*)(F.ws + WS_ISG);
    bf16* KD = (bf16*)(F.ws + WS_KD); bf16* VD = (bf16*)(F.ws + WS_VD); bf16* IQB = (bf16*)(F.ws + WS_IQB); bf16* IKB = (bf16*)(F.ws + WS_IKB);
    const int t0 = blockIdx.x * 512 + F.tid, NT = F.G * 512;
    for (int t = t0; t < M * 8; t += NT) { const int m = t >> 3, h = t & 7; const float* sp = ZS + (size_t)m * ZSP + S_IQ + h * 32;
        f32x4 v[8];
#pragma unroll
        for (int i = 0; i < 8; ++i) v[i] = *(const GAS f32x4*)(sp + 4 * i);
        const float aw = fabsf(ZS[(size_t)m * ZSP + S_IW + h]);
        const f32x2* cs = R32 + (m & (SEQ - 1)) * 16; float f[32];
#pragma unroll
        for (int i = 0; i < 8; ++i) { f[4 * i] = v[i].x; f[4 * i + 1] = v[i].y; f[4 * i + 2] = v[i].z; f[4 * i + 3] = v[i].w; }
#pragma unroll
        for (int d = 0; d < 16; ++d) { const f32x2 tt = cs[d]; const float x1 = f[d], x2 = f[d + 16]; f[d] = (x1 * tt.x - x2 * tt.y) * aw; f[d + 16] = (x2 * tt.x + x1 * tt.y) * aw; }
        bf16* op = IQB + (size_t)m * 256 + h * 32;
#pragma unroll
        for (int i = 0; i < 4; ++i) { float t8[8];
#pragma unroll
            for (int j = 0; j < 8; ++j) t8[j] = f[8 * i + j];
            *(GAS v4u*)(op + 8 * i) = pack8(t8); }
    }
    const int part = blockIdx.x & 3;
    for (int m = (blockIdx.x >> 2) * 512 + F.tid; m < M; m += (F.G >> 2) * 512) { const float* sr = ZS + (size_t)m * ZSP; const int pos = m & (SEQ - 1);
        if (part == 0) { float f[64]; float ss = 0.f;
#pragma unroll
            for (int i = 0; i < 16; ++i) { const f32x4 v = *(const GAS f32x4*)(sr + S_DK + 4 * i); f[4 * i] = v.x; f[4 * i + 1] = v.y; f[4 * i + 2] = v.z; f[4 * i + 3] = v.w; ss += (v.x * v.x + v.y * v.y) + (v.z * v.z + v.w * v.w); }
            const float rs = 1.0f / sqrtf(ss * (1.f / 64) + NORM_EPS); const f32x2* cs = R64 + pos * 32;
#pragma unroll
            for (int d = 0; d < 64; ++d) f[d] = f[d] * rs * g_dk[d];
#pragma unroll
            for (int d = 0; d < 32; ++d) { const f32x2 tt = cs[d]; const float x1 = f[d], x2 = f[d + 32]; f[d] = x1 * tt.x - x2 * tt.y; f[d + 32] = x2 * tt.x + x1 * tt.y; }
#pragma unroll
            for (int i = 0; i < 8; ++i) { float t8[8];
#pragma unroll
                for (int j = 0; j < 8; ++j) t8[j] = f[8 * i + j];
                *(GAS v4u*)(KD + (size_t)m * 64 + 8 * i) = pack8(t8); } }
        if (part == 1)
#pragma unroll
        for (int i = 0; i < 8; ++i) { const f32x4 a = *(const GAS f32x4*)(sr + S_DV + 8 * i), b = *(const GAS f32x4*)(sr + S_DV + 8 * i + 4); const float t8[8] = {a.x, a.y, a.z, a.w, b.x, b.y, b.z, b.w};
            *(GAS v4u*)(VD + (size_t)m * 64 + 8 * i) = pack8(t8); }
        if (part == 2) { float f[32]; const f32x2* cs = R32 + pos * 16;
#pragma unroll
            for (int i = 0; i < 8; ++i) { const f32x4 v = *(const GAS f32x4*)(sr + S_IK + 4 * i); f[4 * i] = v.x; f[4 * i + 1] = v.y; f[4 * i + 2] = v.z; f[4 * i + 3] = v.w; }
#pragma unroll
            for (int d = 0; d < 16; ++d) { const f32x2 tt = cs[d]; const float x1 = f[d], x2 = f[d + 16]; f[d] = x1 * tt.x - x2 * tt.y; f[d + 16] = x2 * tt.x + x1 * tt.y; }
#pragma unroll
            for (int i = 0; i < 4; ++i) { float t8[8];
#pragma unroll
                for (int j = 0; j < 8; ++j) t8[j] = f[8 * i + j];
                *(GAS v4u*)(IKB + (size_t)m * 32 + 8 * i) = pack8(t8); } }
        if (part == 3) { const f32x4 w0 = *(const GAS f32x4*)(sr + S_IW), w1 = *(const GAS f32x4*)(sr + S_IW + 4); const float iw[8] = {w0.x, w0.y, w0.z, w0.w, w1.x, w1.y, w1.z, w1.w}; unsigned sg = 0;
#pragma unroll
            for (int h = 0; h < 8; ++h) sg |= (iw[h] < 0.f ? 1u : 0u) << h;
            ISG[m] = sg;
            const f32x4 f0 = *(const GAS f32x4*)(sr + S_FF), f1 = *(const GAS f32x4*)(sr + S_FF + 4); const float ff[8] = {f0.x, f0.y, f0.z, f0.w, f1.x, f1.y, f1.z, f1.w}; float lf[8];
#pragma unroll
            for (int h = 0; h < 8; ++h) { const float xx = ff[h] + b_f[h]; lf[h] = (fminf(xx, 0.f) - __logf(1.0f + __expf(-fabsf(xx)))) * LOG2E; }
            *(GAS f32x4*)(LF + (size_t)m * 8) = (f32x4){lf[0], lf[1], lf[2], lf[3]}; *(GAS f32x4*)(LF + (size_t)m * 8 + 4) = (f32x4){lf[4], lf[5], lf[6], lf[7]}; }
    }
}

__device__ __forceinline__ float ret_l2g(int h) { return h == 0 ? -0.04580368961312479f : h == 1 ? -0.02272007650008353f : h == 2 ? -0.011315313227834146f : -0.005646563141142063f; }

__device__ __forceinline__ void scan_state_phase(const Ctx& F) {
    const float* LF = (const float*)(F.ws + WS_LF); float* CF = (float*)(F.ws + WS_CF);
    const bf16* Z = (const bf16*)(F.ws + WS_Z); float* RS = (float*)(F.ws + WS_HDN);
    if (F.gw < 32) {
        const int b = F.gw >> 3, h = F.gw & 7; const float* lp = LF + ((size_t)b * SEQ + F.lane * 64) * 8 + h; float s = 0.f;
        for (int i = 0; i < 64; ++i) s += lp[i * 8];
        float incl = s;
#pragma unroll
        for (int o = 1; o < 64; o <<= 1) { const float t = __builtin_bit_cast(float, __builtin_amdgcn_ds_bpermute(((F.lane - o) & 63) << 2, __builtin_bit_cast(int, incl))); if (F.lane >= o) incl += t; }
        float run = incl - s; float* cp = CF + (size_t)F.gw * SEQ + F.lane * 64;
        for (int i = 0; i < 64; ++i) { run += lp[i * 8]; cp[i] = run; }
    }
    for (int u = blockIdx.x; u < NB * 32 * 4; u += F.G) {
        const int h = u & 3, c = (u >> 2) & 31, b = u >> 7; const float l2g = ret_l2g(h);
        const int d = F.tid >> 3, e0 = (F.tid & 7) * 16; float acc[16];
#pragma unroll
        for (int i = 0; i < 16; ++i) acc[i] = 0.f;
        const bf16* base = Z + ((size_t)b * SEQ + c * 128) * ZP;
        for (int j = 0; j < 128; ++j) { const bf16* row = base + (size_t)j * ZP;
            const float kd = bf2f(row[Z_RK + h * 64 + d]) * exp2f((float)(127 - j) * l2g);
            const v4u w0 = *(const GAS v4u*)(row + Z_RV + h * 128 + e0), w1 = *(const GAS v4u*)(row + Z_RV + h * 128 + e0 + 8);
            float v0[8], v1[8]; unpack8(w0, v0); unpack8(w1, v1);
#pragma unroll
            for (int i = 0; i < 8; ++i) { acc[i] += kd * v0[i]; acc[8 + i] += kd * v1[i]; } }
        float* o = RS + (size_t)u * 8192 + d * 128 + e0;
#pragma unroll
        for (int i = 0; i < 4; ++i) *(GAS f32x4*)(o + 4 * i) = (f32x4){acc[4 * i], acc[4 * i + 1], acc[4 * i + 2], acc[4 * i + 3]};
    }
}

__device__ __forceinline__ void ret_out_naive(const Ctx& F, const float* gn) {
    bf16* Z = (bf16*)(F.ws + WS_Z); const float* RS = (const float*)(F.ws + WS_HDN);
    LAS float* S = (LAS float*)(F.lds);
    LAS bf16* Vt = (LAS bf16*)(F.lds + 32768);
    LAS float* Kt = (LAS float*)(F.lds + 65536);
    LAS float* aw = (LAS float*)(F.lds + 65536 + 33280) + F.wave * 128;
    LAS float* qw = (LAS float*)(F.lds + 65536 + 33280 + 4096) + F.wave * 64;
    for (int u = blockIdx.x; u < NB * 32 * 4; u += F.G) {
        const int h = u & 3, c = (u >> 2) & 31, b = u >> 7; const float l2g = ret_l2g(h); const float wch = exp2f(128.f * l2g);
        __syncthreads();
        { float s[16];
#pragma unroll
            for (int i = 0; i < 16; ++i) s[i] = 0.f;
            for (int cp = 0; cp < c; ++cp) { const float* L = RS + ((size_t)((b * 32 + cp) * 4 + h)) * 8192 + F.tid;
#pragma unroll
                for (int i = 0; i < 16; ++i) s[i] = wch * s[i] + L[i * 512]; }
#pragma unroll
            for (int i = 0; i < 16; ++i) S[F.tid + i * 512] = s[i]; }
        const bf16* base = Z + ((size_t)b * SEQ + c * 128) * ZP;
        for (int q = F.tid; q < 2048; q += 512) { const int r = q >> 4, ch = q & 15; *(LAS v4u*)(Vt + r * 128 + ch * 8) = *(const GAS v4u*)(base + (size_t)r * ZP + Z_RV + h * 128 + ch * 8); }
        for (int q = F.tid; q < 128 * 64; q += 512) { const int r = q >> 6, dd = q & 63; Kt[r * 65 + dd] = bf2f(base[(size_t)r * ZP + Z_RK + h * 64 + dd]); }
        __syncthreads();
        for (int i = F.wave; i < 128; i += NWAVES) {
            const size_t m = (size_t)b * SEQ + c * 128 + i; bf16* zr = Z + m * ZP;
            qw[F.lane] = bf2f(zr[Z_RQ + h * 64 + F.lane]);
            LDS_WAIT(); asm volatile("" ::: "memory");
#pragma unroll
            for (int jj = 0; jj < 2; ++jj) { const int j = F.lane + 64 * jj; float a = 0.f;
                if (j <= i) { float dot = 0.f; for (int dd = 0; dd < 64; ++dd) dot += qw[dd] * Kt[j * 65 + dd]; a = dot * exp2f((float)(i - j) * l2g); }
                aw[j] = a; }
            LDS_WAIT(); asm volatile("" ::: "memory");
            float o[2]; const float dq = exp2f((float)(i + 1) * l2g);
#pragma unroll
            for (int ee = 0; ee < 2; ++ee) { const int e = F.lane + 64 * ee; float acc = 0.f;
                for (int j = 0; j <= i; ++j) acc += aw[j] * bf2f(Vt[j * 128 + e]);
                float cr = 0.f; for (int dd = 0; dd < 64; ++dd) cr += qw[dd] * S[dd * 128 + e];
                o[ee] = acc + cr * dq; }
            const float ss = wave_sum(o[0] * o[0] + o[1] * o[1]); const float rstd = 1.0f / sqrtf(ss * (1.f / 128) + NORM_EPS);
#pragma unroll
            for (int ee = 0; ee < 2; ++ee) { const int e = F.lane + 64 * ee; const float rg = bf2f(zr[Z_RG + h * 128 + e]);
                zr[Z_RV + h * 128 + e] = (bf16)f2bf(o[ee] * rstd * gn[h * 128 + e] * rg * sigmoid_f(rg)); }
            LDS_WAIT(); asm volatile("" ::: "memory");
        }
    }
    __syncthreads();
}

__device__ __forceinline__ void fox_naive(const Ctx& F) {
    bf16* Z = (bf16*)(F.ws + WS_Z); const float* CF = (const float*)(F.ws + WS_CF);
    LAS float* sc = (LAS float*)(F.lds + F.wave * 16384);
    const int lane = F.lane;
    int it = 0;
    for (int r0 = 0; r0 < NB * 8 * SEQ; r0 += F.NGW, ++it) {
        const int r = r0 + ((it & 1) ? (F.NGW - 1 - F.gw) : F.gw);
        if (r >= NB * 8 * SEQ) continue;
        const int pos = r & (SEQ - 1), h = (r >> 12) & 7, b = r >> 15;
        const size_t m = (size_t)b * SEQ + pos;
        float qf[64];
        { const bf16* qp = Z + m * ZP + Z_FQ + h * 64;
#pragma unroll
            for (int i = 0; i < 8; ++i) { const v4u w = *(const GAS v4u*)(qp + 8 * i); float t[8]; unpack8(w, t);
#pragma unroll
                for (int j = 0; j < 8; ++j) qf[8 * i + j] = t[j]; } }
        const float* cf = CF + (size_t)(b * 8 + h) * SEQ;
        float mx = -INFINITY;
        for (int kk = lane; kk <= pos; kk += 64) { const bf16* kp = Z + ((size_t)b * SEQ + kk) * ZP + Z_FK + h * 64; float dot = 0.f;
#pragma unroll
            for (int i = 0; i < 8; ++i) { const v4u w = *(const GAS v4u*)(kp + 8 * i); float t[8]; unpack8(w, t);
#pragma unroll
                for (int j = 0; j < 8; ++j) dot += qf[8 * i + j] * t[j]; }
            const float s = dot - cf[kk]; sc[kk] = s; mx = fmaxf(mx, s); }
        mx = wave_max(mx);
        float sum = 0.f;
        for (int kk = lane; kk <= pos; kk += 64) { const float p = exp2f(sc[kk] - mx); sc[kk] = p; sum += p; }
        sum = wave_sum(sum);
        LDS_WAIT(); asm volatile("" ::: "memory");
        const bf16* vp = Z + (size_t)b * SEQ * ZP + Z_FV + h * 64 + lane;
        float o0 = 0.f, o1 = 0.f, o2 = 0.f, o3 = 0.f; int kk = 0;
        for (; kk + 3 <= pos; kk += 4) { o0 += sc[kk] * bf2f(vp[(size_t)kk * ZP]); o1 += sc[kk + 1] * bf2f(vp[(size_t)(kk + 1) * ZP]); o2 += sc[kk + 2] * bf2f(vp[(size_t)(kk + 2) * ZP]); o3 += sc[kk + 3] * bf2f(vp[(size_t)(kk + 3) * ZP]); }
        for (; kk <= pos; ++kk) o0 += sc[kk] * bf2f(vp[(size_t)kk * ZP]);
        Z[m * ZP + Z_FQ + h * 64 + lane] = (bf16)f2bf(((o0 + o1) + (o2 + o3)) / sum);
        LDS_WAIT(); asm volatile("" ::: "memory");
    }
}

__device__ __forceinline__ unsigned f2key(float s) { const unsigned u = __builtin_bit_cast(unsigned, s + 0.0f); return (u & 0x80000000u) ? ~u : (u | 0x80000000u); }
__device__ __forceinline__ void dsa_naive(const Ctx& F) {
    bf16* Z = (bf16*)(F.ws + WS_Z); const float* ZS = (const float*)(F.ws + WS_ZS);
    const unsigned* ISG = (const unsigned*)(F.ws + WS_ISG);
    const bf16* KD = (const bf16*)(F.ws + WS_KD); const bf16* VD = (const bf16*)(F.ws + WS_VD);
    LAS unsigned* kl = (LAS unsigned*)(F.lds + F.wave * 16384);
    LAS float* iqs = (LAS float*)(F.lds + XTRA_OFF + F.wave * 1536);
    const int lane = F.lane;
    int it = 0;
    for (int r0 = 0; r0 < M; r0 += F.NGW, ++it) {
        const int r = r0 + ((it & 1) ? (F.NGW - 1 - F.gw) : F.gw);
        if (r >= M) continue;
        const int pos = r & (SEQ - 1), b = r >> 12; const size_t m = (size_t)r;
        *(LAS f32x4*)(iqs + 4 * lane) = *(const GAS f32x4*)(ZS + m * ZSP + S_IQ + 4 * lane);
        const unsigned sg = ISG[m];
        LDS_WAIT(); asm volatile("" ::: "memory");
        for (int kk = lane; kk <= pos; kk += 64) { const float* ikp = ZS + ((size_t)b * SEQ + kk) * ZSP + S_IK; float ik[32];
#pragma unroll
            for (int i = 0; i < 8; ++i) { const f32x4 t = *(const GAS f32x4*)(ikp + 4 * i); ik[4 * i] = t.x; ik[4 * i + 1] = t.y; ik[4 * i + 2] = t.z; ik[4 * i + 3] = t.w; }
            float s = 0.f;
#pragma unroll 1
            for (int h = 0; h < 8; ++h) { float dot = 0.f;
#pragma unroll
                for (int dd = 0; dd < 32; ++dd) dot += iqs[h * 32 + dd] * ik[dd];
                dot = fmaxf(dot, 0.f); s += ((sg >> h) & 1u) ? -dot : dot; }
            kl[kk] = f2key(s); }
        LDS_WAIT(); asm volatile("" ::: "memory");
        unsigned key[64];
#pragma unroll
        for (int j = 0; j < 64; ++j) { const int kk = j * 64 + lane; key[j] = (kk <= pos) ? kl[kk] : 0u; }
        LDS_WAIT(); asm volatile("" ::: "memory");
        LAS unsigned* idx = kl; LAS float* pl = (LAS float*)(kl + 256); LAS bf16* qs = (LAS bf16*)(kl + 512);
        *(LAS v4u*)(qs + 8 * lane) = *(const GAS v4u*)(Z + m * ZP + Z_DQ + 8 * lane);
        unsigned T = 0u; int need = 0;
        if (pos + 1 > 256) {
            for (int bit = 31; bit >= 0; --bit) { const unsigned Tt = T | (1u << bit); int cnt = 0;
#pragma unroll
                for (int j = 0; j < 64; ++j) cnt += __builtin_popcountll(__ballot(key[j] >= Tt));
                if (cnt >= 256) T = Tt; }
            int ngt = 0;
#pragma unroll
            for (int j = 0; j < 64; ++j) ngt += __builtin_popcountll(__ballot(key[j] > T));
            need = 256 - ngt;
        }
        int nsel = 0, eqb = 0;
#pragma unroll
        for (int j = 0; j < 64; ++j) { const bool gt = key[j] > T, eq = (key[j] == T) && (T != 0u);
            const unsigned long long em = __ballot(eq); const int er = eqb + __builtin_amdgcn_mbcnt_hi((unsigned)(em >> 32), __builtin_amdgcn_mbcnt_lo((unsigned)em, 0u));
            const bool sel = gt || (eq && er < need); eqb += __builtin_popcountll(em);
            const unsigned long long sm = __ballot(sel); const int sp = nsel + __builtin_amdgcn_mbcnt_hi((unsigned)(sm >> 32), __builtin_amdgcn_mbcnt_lo((unsigned)sm, 0u));
            if (sel) idx[sp] = (unsigned)(j * 64 + lane); nsel += __builtin_popcountll(sm); }
        LDS_WAIT(); asm volatile("" ::: "memory");
        for (int h = 0; h < 8; ++h) {
            float sv[4]; float mx = -INFINITY;
#pragma unroll
            for (int i = 0; i < 4; ++i) { const int e = lane + 64 * i; sv[i] = -INFINITY;
                if (e < nsel) { const bf16* kp = KD + ((size_t)b * SEQ + idx[e]) * 64; float dot = 0.f;
#pragma unroll
                    for (int c = 0; c < 8; ++c) { const v4u w = *(const GAS v4u*)(kp + 8 * c); float t[8]; unpack8(w, t); const v4u qw = *(const LAS v4u*)(qs + h * 64 + 8 * c); float qq[8]; unpack8(qw, qq);
#pragma unroll
                        for (int j = 0; j < 8; ++j) dot += qq[j] * t[j]; }
                    sv[i] = dot; }
                mx = fmaxf(mx, sv[i]); }
            mx = wave_max(mx); float sum = 0.f;
#pragma unroll
            for (int i = 0; i < 4; ++i) { const int e = lane + 64 * i; const float p = (e < nsel) ? exp2f(sv[i] - mx) : 0.f; pl[e] = p; sum += p; }
            sum = wave_sum(sum);
            LDS_WAIT(); asm volatile("" ::: "memory");
            float o0 = 0.f, o1 = 0.f; int e = 0;
            for (; e + 1 < nsel; e += 2) { o0 += pl[e] * bf2f(VD[((size_t)b * SEQ + idx[e]) * 64 + lane]); o1 += pl[e + 1] * bf2f(VD[((size_t)b * SEQ + idx[e + 1]) * 64 + lane]); }
            if (e < nsel) o0 += pl[e] * bf2f(VD[((size_t)b * SEQ + idx[e]) * 64 + lane]);
            Z[m * ZP + Z_DQ + h * 64 + lane] = (bf16)f2bf((o0 + o1) / sum);
            LDS_WAIT(); asm volatile("" ::: "memory");
        }
    }
}
#ifndef PROBE_D
#define PROBE_D 0
#endif

typedef short s16x8 __attribute__((ext_vector_type(8)));
typedef short s16x4 __attribute__((ext_vector_type(4)));
typedef short v4i16_t __attribute__((ext_vector_type(4)));
__device__ __forceinline__ s16x4 tr16(const LAS unsigned char* p) { return __builtin_bit_cast(s16x4, __builtin_amdgcn_ds_read_tr16_b64_v4i16((LAS v4i16_t*)p)); }
__device__ __forceinline__ float key2f(unsigned k) { return __builtin_bit_cast(float, (k & 0x80000000u) ? (k & 0x7fffffffu) : ~k); }

template <int NR> __device__ __forceinline__ int dsa_count_ge(const unsigned (&key)[64], unsigned T) {
    int c = 0;
#pragma unroll
    for (int j = 0; j < NR; ++j) c += __builtin_popcountll(__ballot(key[j] >= T));
    return c;
}
#define DSA_COUNT_GE(T_, out_) do { if (nq == 1) out_ = dsa_count_ge<16>(key, (T_)); else if (nq == 2) out_ = dsa_count_ge<32>(key, (T_)); else if (nq == 3) out_ = dsa_count_ge<48>(key, (T_)); else out_ = dsa_count_ge<64>(key, (T_)); } while (0)
__device__ __forceinline__ void dsa_select(const unsigned (&key)[64], int nvalid, unsigned& T, int& need) {
    const int nq = __builtin_amdgcn_readfirstlane((nvalid + 1023) >> 10);
    T = 0u; need = 0;
    if (nvalid <= 256) return;
    unsigned kmax = 0u;
#pragma unroll
    for (int j = 0; j < 64; ++j) kmax = key[j] > kmax ? key[j] : kmax;
#pragma unroll
    for (int o_ = 0; o_ < 1; ++o_) { unsigned t; t = sxu<1>(kmax); kmax = t > kmax ? t : kmax; t = sxu<2>(kmax); kmax = t > kmax ? t : kmax; t = sxu<4>(kmax); kmax = t > kmax ? t : kmax; t = sxu<8>(kmax); kmax = t > kmax ? t : kmax; t = sxu<16>(kmax); kmax = t > kmax ? t : kmax;
        unsigned a_, b_; swap32(kmax, a_, b_); kmax = a_ > b_ ? a_ : b_; }
    unsigned lo = 1u, hi = kmax + 1u; int hic = 0;
    { const float vm = fabsf(key2f(kmax)) + 1.0f; unsigned l2 = f2key(-vm * 64.0f); int c; DSA_COUNT_GE(l2, c); if (c >= 256) lo = l2; }
    int iter = 0; bool exact = false;
    while (hi - lo > 1u) {
        unsigned mid;
        if (iter < 24 && lo > 1u) { const float mv = 0.5f * key2f(lo) + 0.5f * key2f(hi - 1u); mid = f2key(mv); }
        else mid = lo + ((hi - lo) >> 1);
        if (mid <= lo) mid = lo + 1u; if (mid >= hi) mid = hi - 1u;
        int c; DSA_COUNT_GE(mid, c);
        if (c == 256) { T = mid; exact = true; break; }
        if (c > 256) lo = mid; else { hi = mid; hic = c; }
        ++iter;
    }
    if (exact) need = 256; else { T = lo; need = 256 - hic; }
}

template <bool SYNC_BEFORE_STAGE = false> __device__ __forceinline__ void dsa_attend(const bf16* zq, bf16* zo, const bf16* KDb, const bf16* VDb, const LAS unsigned short* idx, int nsel, LAS unsigned char* vst, int lane) {
    const int g = lane >> 4, c = lane & 15;
    s16x8 qf[2];
#pragma unroll
    for (int ks = 0; ks < 2; ++ks) { qf[ks] = (s16x8){0, 0, 0, 0, 0, 0, 0, 0}; if (c < 8) qf[ks] = *(const GAS s16x8*)(zq + c * 64 + 32 * ks + 8 * g); }
    f32x4 acc[16];
    v4u vreg[16];
#pragma unroll
    for (int i = 0; i < 16; ++i) { const int pi = lane + 64 * i, r = pi >> 3, c16 = pi & 7; const int id = (r < nsel) ? (int)idx[r] : 0; vreg[i] = *(const GAS v4u*)(VDb + (size_t)id * 64 + c16 * 8); }
#pragma unroll
    for (int tb = 0; tb < 2; ++tb) {
        s16x8 kf[8][2];
#pragma unroll
        for (int tt = 0; tt < 8; ++tt) { const int e = 16 * (8 * tb + tt) + c; const int id = (e < nsel) ? (int)idx[e] : 0; const bf16* kp = KDb + (size_t)id * 64 + 8 * g;
            kf[tt][0] = *(const GAS s16x8*)kp; kf[tt][1] = *(const GAS s16x8*)(kp + 32); }
#pragma unroll
        for (int tt = 0; tt < 8; ++tt) { f32x4 a = (f32x4){0.f, 0.f, 0.f, 0.f};
            a = __builtin_amdgcn_mfma_f32_16x16x32_bf16(kf[tt][0], qf[0], a, 0, 0, 0); a = __builtin_amdgcn_mfma_f32_16x16x32_bf16(kf[tt][1], qf[1], a, 0, 0, 0); acc[8 * tb + tt] = a; }
    }
    float mx = -INFINITY;
#pragma unroll
    for (int t = 0; t < 16; ++t)
#pragma unroll
        for (int i = 0; i < 4; ++i) { const int e = 16 * t + 4 * g + i; if (nsel < 256 && e >= nsel) acc[t][i] = -INFINITY; mx = fmaxf(mx, acc[t][i]); }
    mx = fmaxf(mx, sx<16>(mx)); mx = half_max(mx);
    float sum = 0.f;
#pragma unroll
    for (int t = 0; t < 16; ++t)
#pragma unroll
        for (int i = 0; i < 4; ++i) { const float p = __builtin_amdgcn_exp2f(acc[t][i] - mx); acc[t][i] = p; sum += p; }
    sum += sx<16>(sum); sum = half_sum(sum);
    const float inv = 1.0f / sum;
    s16x8 pf[8];
#pragma unroll
    for (int s = 0; s < 8; ++s) { v4u w; w.x = pk2(acc[2 * s][0] * inv, acc[2 * s][1] * inv); w.y = pk2(acc[2 * s][2] * inv, acc[2 * s][3] * inv); w.z = pk2(acc[2 * s + 1][0] * inv, acc[2 * s + 1][1] * inv); w.w = pk2(acc[2 * s + 1][2] * inv, acc[2 * s + 1][3] * inv);
        pf[s] = __builtin_bit_cast(s16x8, w); }
    f32x4 o[4];
#pragma unroll
    for (int db = 0; db < 4; ++db) o[db] = (f32x4){0.f, 0.f, 0.f, 0.f};
    const int q = (lane >> 2) & 3, p = lane & 3, swz = 2 * (g & 1) + (q >> 1);
    const LAS unsigned char* rb = vst + (4 * g + q) * 128 + 8 * p;
    if constexpr (SYNC_BEFORE_STAGE) __syncthreads();
#pragma unroll
    for (int hh = 0; hh < 2; ++hh) {
        asm volatile("s_waitcnt lgkmcnt(0)" ::: "memory");
#pragma unroll
        for (int i = 0; i < 16; ++i) { const int pi = lane + 64 * i, r = pi >> 3, c16 = pi & 7;
            *(LAS v4u*)(vst + r * 128 + ((((c16 >> 1) ^ ((r >> 1) & 3))) << 5) + ((c16 & 1) << 4)) = vreg[i]; }
        if (hh == 0) {
#pragma unroll
            for (int i = 0; i < 16; ++i) { const int pi = lane + 64 * i, r = pi >> 3, c16 = pi & 7, e = 128 + r; const int id = (e < nsel) ? (int)idx[e] : 0; vreg[i] = *(const GAS v4u*)(VDb + (size_t)id * 64 + c16 * 8); } }
        asm volatile("s_waitcnt lgkmcnt(0)" ::: "memory");
#pragma unroll
        for (int s4 = 0; s4 < 4; ++s4)
#pragma unroll
            for (int db = 0; db < 4; ++db) { const LAS unsigned char* a1 = rb + s4 * 4096 + ((db ^ swz) << 5);
                const s16x4 lo = tr16(a1), hi = tr16(a1 + 2048);
                const s16x8 vf = (s16x8){lo[0], lo[1], lo[2], lo[3], hi[0], hi[1], hi[2], hi[3]};
                o[db] = __builtin_amdgcn_mfma_f32_16x16x32_bf16(pf[4 * hh + s4], vf, o[db], 0, 0, 0); }
    }
    if (g < 2) {
#pragma unroll
        for (int db = 0; db < 4; ++db)
#pragma unroll
            for (int i = 0; i < 4; ++i) zo[(4 * g + i) * 64 + 16 * db + c] = (bf16)f2bf(o[db][i]);
    }
}

__device__ __forceinline__ void dsa_v2(const Ctx& F) {
    bf16* Z = (bf16*)(F.ws + WS_Z); const float* ZS = (const float*)(F.ws + WS_ZS);
    const unsigned* ISG = (const unsigned*)(F.ws + WS_ISG);
    const bf16* KD = (const bf16*)(F.ws + WS_KD); const bf16* VD = (const bf16*)(F.ws + WS_VD);
    LAS unsigned* kl = (LAS unsigned*)(F.lds + F.wave * 16384);
    LAS float* iqs = (LAS float*)(F.lds + XTRA_OFF + F.wave * 1536);
    LAS unsigned short* idx = (LAS unsigned short*)(F.lds + XTRA_OFF + F.wave * 1536 + 1024);
    const int lane = F.lane;
    int it = 0;
    for (int r0 = 0; r0 < M; r0 += F.NGW, ++it) {
        const int r = r0 + ((it & 1) ? (F.NGW - 1 - F.gw) : F.gw);
        if (r >= M) continue;
        const int pos = r & (SEQ - 1), b = r >> 12; const size_t m = (size_t)r;
        *(LAS f32x4*)(iqs + 4 * lane) = *(const GAS f32x4*)(ZS + m * ZSP + S_IQ + 4 * lane);
        const unsigned sg = ISG[m];
        LDS_WAIT(); asm volatile("" ::: "memory");
        for (int kk = lane; kk <= pos; kk += 64) { const float* ikp = ZS + ((size_t)b * SEQ + kk) * ZSP + S_IK; float ik[32];
#pragma unroll
            for (int i = 0; i < 8; ++i) { const f32x4 t = *(const GAS f32x4*)(ikp + 4 * i); ik[4 * i] = t.x; ik[4 * i + 1] = t.y; ik[4 * i + 2] = t.z; ik[4 * i + 3] = t.w; }
            float s = 0.f;
#pragma unroll 1
            for (int h = 0; h < 8; ++h) { float dot = 0.f;
#pragma unroll
                for (int dd = 0; dd < 32; ++dd) dot += iqs[h * 32 + dd] * ik[dd];
                dot = fmaxf(dot, 0.f); s += ((sg >> h) & 1u) ? -dot : dot; }
            kl[kk] = f2key(s); }
        LDS_WAIT(); asm volatile("" ::: "memory");
        unsigned key[64];
#pragma unroll
        for (int j = 0; j < 64; ++j) { const int kk = j * 64 + lane; key[j] = (kk <= pos) ? kl[kk] : 0u; }
        LDS_WAIT(); asm volatile("" ::: "memory");
        unsigned T; int need;
#ifdef DSA_OLDSEL
        T = 0u; need = 0;
        if (pos + 1 > 256) {
            for (int bit = 31; bit >= 0; --bit) { const unsigned Tt = T | (1u << bit); int cnt = 0;
#pragma unroll
                for (int j = 0; j < 64; ++j) cnt += __builtin_popcountll(__ballot(key[j] >= Tt));
                if (cnt >= 256) T = Tt; }
            int ngt = 0;
#pragma unroll
            for (int j = 0; j < 64; ++j) ngt += __builtin_popcountll(__ballot(key[j] > T));
            need = 256 - ngt;
        }
#else
        dsa_select(key, pos + 1, T, need);
#endif
        int nsel = 0, eqb = 0;
#pragma unroll
        for (int j = 0; j < 64; ++j) { const bool gt = key[j] > T, eq = (key[j] == T) && (T != 0u);
            const unsigned long long em = __ballot(eq); const int er = eqb + __builtin_amdgcn_mbcnt_hi((unsigned)(em >> 32), __builtin_amdgcn_mbcnt_lo((unsigned)em, 0u));
            const bool sel = gt || (eq && er < need); eqb += __builtin_popcountll(em);
            const unsigned long long sm = __ballot(sel); const int sp = nsel + __builtin_amdgcn_mbcnt_hi((unsigned)(sm >> 32), __builtin_amdgcn_mbcnt_lo((unsigned)sm, 0u));
            if (sel) idx[sp] = (unsigned short)(j * 64 + lane); nsel += __builtin_popcountll(sm); }
        LDS_WAIT(); asm volatile("" ::: "memory");
        dsa_attend(Z + m * ZP + Z_DQ, Z + m * ZP + Z_DQ, KD + (size_t)b * SEQ * 64, VD + (size_t)b * SEQ * 64, idx, nsel, (LAS unsigned char*)kl, lane);
        LDS_WAIT(); asm volatile("" ::: "memory");
    }
}

template <int NR> __device__ __forceinline__ int dsa_emit_n(const unsigned (&key)[64], unsigned T, int need, LAS unsigned short* idx, int lane) {
    int nsel = 0, eqb = 0;
#pragma unroll
    for (int j = 0; j < NR; ++j) { const bool gt = key[j] > T, eq = (key[j] == T) && (T != 0u);
        const unsigned long long em = __ballot(eq); const int er = eqb + __builtin_amdgcn_mbcnt_hi((unsigned)(em >> 32), __builtin_amdgcn_mbcnt_lo((unsigned)em, 0u));
        const bool sel = gt || (eq && er < need); eqb += __builtin_popcountll(em);
        const unsigned long long sm = __ballot(sel); const int sp = nsel + __builtin_amdgcn_mbcnt_hi((unsigned)(sm >> 32), __builtin_amdgcn_mbcnt_lo((unsigned)sm, 0u));
        if (sel) idx[sp] = (unsigned short)(j * 64 + lane); nsel += __builtin_popcountll(sm); }
    return nsel;
}
__device__ __forceinline__ int dsa_emit(const unsigned (&key)[64], int nvalid, unsigned T, int need, LAS unsigned short* idx, int lane) {
    const int nq = __builtin_amdgcn_readfirstlane((nvalid + 1023) >> 10);
    if (nq == 1) return dsa_emit_n<16>(key, T, need, idx, lane);
    if (nq == 2) return dsa_emit_n<32>(key, T, need, idx, lane);
    if (nq == 3) return dsa_emit_n<48>(key, T, need, idx, lane);
    return dsa_emit_n<64>(key, T, need, idx, lane);
}

#define DSA_CNT8(cnt_, k_, o_, T_) asm volatile( \
    "v_cmp_ge_u32_e64 s[60:61], %1, %9\n\tv_cmp_ge_u32_e64 s[62:63], %2, %9\n\tv_cmp_ge_u32_e64 s[64:65], %3, %9\n\tv_cmp_ge_u32_e64 s[66:67], %4, %9\n\t" \
    "v_cmp_ge_u32_e64 s[68:69], %5, %9\n\tv_cmp_ge_u32_e64 s[70:71], %6, %9\n\tv_cmp_ge_u32_e64 s[72:73], %7, %9\n\tv_cmp_ge_u32_e64 s[74:75], %8, %9\n\t" \
    "v_addc_co_u32_e64 %0, s[76:77], 0, %0, s[60:61]\n\tv_addc_co_u32_e64 %0, s[76:77], 0, %0, s[62:63]\n\tv_addc_co_u32_e64 %0, s[76:77], 0, %0, s[64:65]\n\tv_addc_co_u32_e64 %0, s[76:77], 0, %0, s[66:67]\n\t" \
    "v_addc_co_u32_e64 %0, s[76:77], 0, %0, s[68:69]\n\tv_addc_co_u32_e64 %0, s[76:77], 0, %0, s[70:71]\n\tv_addc_co_u32_e64 %0, s[76:77], 0, %0, s[72:73]\n\tv_addc_co_u32_e64 %0, s[76:77], 0, %0, s[74:75]" \
    : "+v"(cnt_) : "v"(k_[o_]), "v"(k_[o_ + 1]), "v"(k_[o_ + 2]), "v"(k_[o_ + 3]), "v"(k_[o_ + 4]), "v"(k_[o_ + 5]), "v"(k_[o_ + 6]), "v"(k_[o_ + 7]), "s"(T_) \
    : "s60", "s61", "s62", "s63", "s64", "s65", "s66", "s67", "s68", "s69", "s70", "s71", "s72", "s73", "s74", "s75", "s76", "s77")
template <int NR> __device__ __forceinline__ int dsa_lane_count(const unsigned (&key)[64], unsigned T) {
    int c = 0; const unsigned Ts = (unsigned)__builtin_amdgcn_readfirstlane((int)T);
#pragma unroll
    for (int j = 0; j < NR; j += 8) DSA_CNT8(c, key, j, Ts);
    return c;
}
#define DSA_LCOUNT(T_, lc_) do { if (nq == 1) lc_ = dsa_lane_count<16>(key, (T_)); else if (nq == 2) lc_ = dsa_lane_count<32>(key, (T_)); else if (nq == 3) lc_ = dsa_lane_count<48>(key, (T_)); else lc_ = dsa_lane_count<64>(key, (T_)); } while (0)
template <int NR> __device__ __forceinline__ void dsa_write_ge(const unsigned (&key)[64], unsigned T, int off, LAS unsigned short* idx, int lane) {
    const int dummy = 256 + lane;
#pragma unroll
    for (int j = 0; j < NR; ++j) { const bool s = key[j] >= T; idx[s ? off : dummy] = (unsigned short)(j * 64 + lane); off += s ? 1 : 0; }
}
__device__ __forceinline__ int dsa_select2(const unsigned (&key)[64], int nvalid, float s1, float s2, LAS unsigned short* idx, int lane) {
    const int nq = __builtin_amdgcn_readfirstlane((nvalid + 1023) >> 10);
    unsigned T = 1u; int lc = 0; bool exact = true;
    if (nvalid > 256) {
        const float n = (float)nvalid, mean = s1 / n, sd = sqrtf(fmaxf(s2 / n - mean * mean, 1e-30f));
        const float pfrac = 256.0f / n, pt = fminf(pfrac, 1.0f - pfrac);
        const float tt = sqrtf(-2.0f * __logf(fmaxf(pt, 1e-6f)));
        float zn = (0.010328f * tt + 0.802853f) * tt + 2.515517f; asm volatile("" : "+v"(zn));
        float zd = ((0.001308f * tt + 0.189269f) * tt + 1.432788f) * tt + 1.0f; asm volatile("" : "+v"(zd));
        float z = tt - zn / zd;
        if (pfrac > 0.5f) z = -z;
        const float dens = n * __expf(-0.5f * z * z) * 0.3989423f / sd;
        unsigned lo = 1u, hi = 0xffffffffu; int clo = nvalid, chi = 0;
        bool lop = false, hip = false; float lastv = mean + z * sd, lastc = 256.0f, grow = 1.3f;
        exact = false; int same = 0, last = 0;
        for (int it = 0; hi - lo > 1u; ++it) {
            unsigned mid;
            if (it == 0) mid = f2key(lastv);
            else if (!(lop && hip)) { lastv = lastv + grow * (lastc - 256.0f) / dens; grow *= 2.0f; mid = f2key(lastv); }
            else if (it < 24 && same < 2) { const float vlo = key2f(lo), vhi = key2f(hi - 1u); mid = f2key(vlo + (vhi - vlo) * (((float)(clo - 256) + 0.5f) / (float)(clo - chi))); }
            else if (it < 48) { mid = f2key(0.5f * key2f(lo) + 0.5f * key2f(hi - 1u)); same = 0; }
            else mid = lo + ((hi - lo) >> 1);
            if (!(mid > lo)) mid = lo + 1u; if (!(mid < hi)) mid = hi - 1u;
            DSA_LCOUNT(mid, lc); const int c = wave_isum(lc); lastc = (float)c; lastv = key2f(mid);
            if (c == 256) { T = mid; exact = true; break; }
            if (c > 256) { lo = mid; clo = c; lop = true; same = (last > 0) ? same + 1 : 0; last = 1; } else { hi = mid; chi = c; hip = true; same = (last < 0) ? same + 1 : 0; last = -1; }
        }
        if (!exact) {
            const int nsel = dsa_emit(key, nvalid, lo, 256 - chi, idx, lane);
            return nsel;
        }
    } else { DSA_LCOUNT(1u, lc); }
    int incl = lc;
#pragma unroll
    for (int o = 1; o < 64; o <<= 1) { const int t = __builtin_amdgcn_ds_bpermute(((lane - o) & 63) << 2, incl); if (lane >= o) incl += t; }
    const int total = __builtin_amdgcn_readlane(incl, 63);
    if (nq == 1) dsa_write_ge<16>(key, T, incl - lc, idx, lane); else if (nq == 2) dsa_write_ge<32>(key, T, incl - lc, idx, lane); else if (nq == 3) dsa_write_ge<48>(key, T, incl - lc, idx, lane); else dsa_write_ge<64>(key, T, incl - lc, idx, lane);
    return total;
}

constexpr int DSA_ROWF = 4100;
__device__ __forceinline__ void dsa_v3(const Ctx& F, int out_col = Z_DQ) {
    bf16* Z = (bf16*)(F.ws + WS_Z);
    const unsigned* ISG = (const unsigned*)(F.ws + WS_ISG);
    const bf16* KD = (const bf16*)(F.ws + WS_KD); const bf16* VD = (const bf16*)(F.ws + WS_VD);
    const bf16* IQB = (const bf16*)(F.ws + WS_IQB); const bf16* IKB = (const bf16*)(F.ws + WS_IKB);
    LAS unsigned* img = (LAS unsigned*)(F.lds);
    LAS unsigned short* idxw = (LAS unsigned short*)(F.lds + XTRA_OFF + F.wave * 1536);
    const int w = F.wave;
    const int v = (int)blockIdx.x;
    if (v < 256)
    for (int ui = 0; ui < 8; ++ui) {
        int lane_ = F.lane; asm volatile("" : "+v"(lane_)); const int lane = lane_, g = lane >> 4, c = lane & 15;
        const int b = (v & 7) >> 1, k = ((v >> 3) << 1) | (v & 1); const int pb = 128 * (ui >> 1) + ((ui & 1) ? 127 - k : k);
        const int q0 = pb * 8, kend = q0 + 8, ntile = (kend + 15) >> 4;
        const size_t mb = (size_t)b * SEQ;
#if PROBE_D == 1
        for (int rp_ = 0; rp_ < 2; ++rp_)
#endif
        { s16x8 iqf[4]; float sgn[4]; s16x8 iqc;
          { const int qi = c & 7, hs = c >> 3; const int qq = q0 + qi; const bf16* qp = IQB + (mb + qq) * 256 + 8 * g; const unsigned sg = ISG[mb + qq];
            float cs[8];
#pragma unroll
            for (int e = 0; e < 8; ++e) cs[e] = 0.f;
#pragma unroll
            for (int j = 0; j < 4; ++j) { const int h = 2 * j + hs; iqf[j] = *(const GAS s16x8*)(qp + h * 32); sgn[j] = ((sg >> h) & 1u) ? -1.0f : 1.0f;
                float t8[8]; unpack8(__builtin_bit_cast(v4u, iqf[j]), t8);
#pragma unroll
                for (int e = 0; e < 8; ++e) cs[e] += sgn[j] * t8[e]; }
            iqc = __builtin_bit_cast(s16x8, pack8(cs)); }
          const bf16* ikp = IKB + (mb + c) * 32 + 8 * g;
          float st1 = 0.f, st2 = 0.f;
          s16x8 cur[4], nxt[4];
#pragma unroll
          for (int i = 0; i < 4; ++i) { const int t = w + 8 * i; cur[i] = *(const GAS s16x8*)(ikp + (size_t)512 * (t < ntile ? t : 0)); }
          for (int t0 = w; t0 < ntile; t0 += 32) {
#pragma unroll
            for (int i = 0; i < 4; ++i) { const int t = t0 + 32 + 8 * i; nxt[i] = *(const GAS s16x8*)(ikp + (size_t)512 * (t < ntile ? t : 0)); }
#pragma unroll
            for (int i = 0; i < 4; ++i) { const int t = t0 + 8 * i;
              if (t < ntile) {
                f32x4 sc = __builtin_amdgcn_mfma_f32_16x16x32_bf16(cur[i], iqc, (f32x4){0.f, 0.f, 0.f, 0.f}, 0, 0, 0);
#pragma unroll
                for (int h = 0; h < 4; ++h) { const f32x4 x = __builtin_amdgcn_mfma_f32_16x16x32_bf16(cur[i], iqf[h], (f32x4){0.f, 0.f, 0.f, 0.f}, 0, 0, 0);
#pragma unroll
                    for (int r = 0; r < 4; ++r) sc[r] = __builtin_fmaf(sgn[h], __builtin_fabsf(x[r]), sc[r]); }
#pragma unroll
                for (int r = 0; r < 4; ++r) sc[r] += sx<8>(sc[r]);
                v4u kk; kk.x = f2key(sc[0]); kk.y = f2key(sc[1]); kk.z = f2key(sc[2]); kk.w = f2key(sc[3]);
                if (16 * t + 15 <= q0) {
                    st1 += (sc[0] + sc[1]) + (sc[2] + sc[3]); st2 += (sc[0] * sc[0] + sc[1] * sc[1]) + (sc[2] * sc[2] + sc[3] * sc[3]);
                } else { const int kb = 16 * t + 4 * g, qa = q0 + (c & 7);
                    if (kb + 0 > qa) { kk.x = 0u; sc[0] = 0.f; } if (kb + 1 > qa) { kk.y = 0u; sc[1] = 0.f; } if (kb + 2 > qa) { kk.z = 0u; sc[2] = 0.f; } if (kb + 3 > qa) { kk.w = 0u; sc[3] = 0.f; }
                    st1 += (sc[0] + sc[1]) + (sc[2] + sc[3]); st2 += (sc[0] * sc[0] + sc[1] * sc[1]) + (sc[2] * sc[2] + sc[3] * sc[3]); }
                if (c < 8) *(LAS v4u*)(img + c * DSA_ROWF + 16 * t + 4 * g) = kk; } }
#pragma unroll
            for (int i = 0; i < 4; ++i) cur[i] = nxt[i];
          }
          st1 += sx<16>(st1); st2 += sx<16>(st2); st1 = half_sum(st1); st2 = half_sum(st2);
          if (g == 0 && c < 8) *(LAS f32x2*)(F.lds + XTRA_OFF + w * 1536 + 640 + c * 8) = (f32x2){st1, st2}; }
        __syncthreads();
        const int pos = q0 + w; unsigned key[64];
#pragma unroll
        for (int j = 0; j < 64; ++j) { const int kidx = 64 * j + lane; const unsigned a = img[w * DSA_ROWF + kidx]; key[j] = (kidx <= pos) ? a : 0u; }
        unsigned T; int need; int nsel;
        float rs1 = 0.f, rs2 = 0.f;
#pragma unroll
        for (int ww = 0; ww < 8; ++ww) { const f32x2 t = *(const LAS f32x2*)(F.lds + XTRA_OFF + ww * 1536 + 640 + w * 8); rs1 += t.x; rs2 += t.y; }
        { nsel = dsa_select2(key, pos + 1, rs1, rs2, idxw, lane); (void)T; (void)need; }
#if PROBE_D == 3
        { const size_t m = mb + pos; dsa_attend(Z + m * ZP + Z_DQ, Z + m * ZP + Z_RG, KD + mb * 64, VD + mb * 64, idxw, nsel, F.lds + w * 16384, lane); }
#endif
        { const size_t m = mb + pos; dsa_attend<true>(Z + m * ZP + Z_DQ, Z + m * ZP + out_col, KD + mb * 64, VD + mb * 64, idxw, nsel, F.lds + w * 16384, lane); }
        __syncthreads();
    }
}

__device__ __forceinline__ void ret_rope_frag(const bf16* row, const f32x2* cs, float scale, int g, s16x8 (&f)[2]) {
    const u32x2 a0 = *(const GAS u32x2*)(row + 4 * g), a1 = *(const GAS u32x2*)(row + 16 + 4 * g), b0 = *(const GAS u32x2*)(row + 32 + 4 * g), b1 = *(const GAS u32x2*)(row + 48 + 4 * g);
    const float x1[8] = {bflo(a0.x), bfhi(a0.x), bflo(a0.y), bfhi(a0.y), bflo(a1.x), bfhi(a1.x), bflo(a1.y), bfhi(a1.y)};
    const float x2[8] = {bflo(b0.x), bfhi(b0.x), bflo(b0.y), bfhi(b0.y), bflo(b1.x), bfhi(b1.x), bflo(b1.y), bfhi(b1.y)};
    float o1[8], o2[8];
#pragma unroll
    for (int j = 0; j < 8; ++j) { const f32x2 t = cs[(j < 4 ? 4 * g + j : 16 + 4 * g + (j - 4))]; o1[j] = (x1[j] * t.x - x2[j] * t.y) * scale; o2[j] = (x2[j] * t.x + x1[j] * t.y) * scale; }
    f[0] = __builtin_bit_cast(s16x8, pack8(o1)); f[1] = __builtin_bit_cast(s16x8, pack8(o2));
}
__device__ __forceinline__ s16x8 ret_bfrag(const LAS unsigned char* img, int row0, int eb, int g, int q, int p) {
    const int r1 = row0 + 4 * g + q;
    const LAS unsigned char* a1 = img + r1 * 256 + ((eb ^ (r1 & 7)) << 5) + 8 * p;
    const LAS unsigned char* a2 = img + (r1 + 16) * 256 + ((eb ^ ((r1 + 16) & 7)) << 5) + 8 * p;
    const s16x4 lo = tr16(a1), hi = tr16(a2);
    return (s16x8){lo[0], lo[1], lo[2], lo[3], hi[0], hi[1], hi[2], hi[3]};
}

__device__ __forceinline__ void ret_state_mfma(const Ctx& F) {
    const bf16* Z = (const bf16*)(F.ws + WS_Z); float* RS = (float*)(F.ws + WS_HDN);
    const f32x2* R64 = (const f32x2*)(F.ws + WS_ROPE64);
    LAS unsigned char* Kimg = F.lds; LAS unsigned char* Vimg = F.lds + 16384;
    const int lane = F.lane, g = lane >> 4, c = lane & 15, q = (lane >> 2) & 3, p = lane & 3;
    for (int u = blockIdx.x; u < NB * 32 * 4; u += F.G) {
        const int h = u & 3, ch = (u >> 2) & 31, b = u >> 7; const float l2g = ret_l2g(h);
        const bf16* base = Z + ((size_t)b * SEQ + ch * 128) * ZP;
        __syncthreads();
        for (int t = F.tid; t < 2048; t += 512) { const int r = t >> 4, c16 = t & 15;
            *(LAS v4u*)(Vimg + r * 256 + (((c16 >> 1) ^ (r & 7)) << 5) + ((c16 & 1) << 4)) = *(const GAS v4u*)(base + (size_t)r * ZP + Z_RV + h * 128 + c16 * 8); }
        for (int t = F.tid; t < 1024; t += 512) { const int j = t >> 3, dg = t & 7; const bf16* row = base + (size_t)j * ZP + Z_RK + h * 64;
            const u32x2 a = *(const GAS u32x2*)(row + 4 * dg), bb = *(const GAS u32x2*)(row + 32 + 4 * dg);
            const float x1[4] = {bflo(a.x), bfhi(a.x), bflo(a.y), bfhi(a.y)}, x2[4] = {bflo(bb.x), bfhi(bb.x), bflo(bb.y), bfhi(bb.y)};
            const f32x2* cs = R64 + (ch * 128 + j) * 32 + 4 * dg; const float sc = exp2f((float)(127 - j) * l2g);
            float o1[4], o2[4];
#pragma unroll
            for (int e = 0; e < 4; ++e) { const f32x2 tt = cs[e]; o1[e] = (x1[e] * tt.x - x2[e] * tt.y) * sc; o2[e] = (x2[e] * tt.x + x1[e] * tt.y) * sc; }
            u32x2 w1, w2; w1.x = pk2(o1[0], o1[1]); w1.y = pk2(o1[2], o1[3]); w2.x = pk2(o2[0], o2[1]); w2.y = pk2(o2[2], o2[3]);
            const int sw = (j >> 1) & 3; const int d1 = 4 * dg, d2 = 32 + 4 * dg;
            *(LAS u32x2*)(Kimg + j * 128 + ((((2 * d1) >> 5) ^ sw) << 5) + ((2 * d1) & 31)) = w1;
            *(LAS u32x2*)(Kimg + j * 128 + ((((2 * d2) >> 5) ^ sw) << 5) + ((2 * d2) & 31)) = w2; }
        __syncthreads();
        f32x4 acc[4];
#pragma unroll
        for (int db = 0; db < 4; ++db) acc[db] = (f32x4){0.f, 0.f, 0.f, 0.f};
#pragma unroll
        for (int s = 0; s < 4; ++s) {
            const s16x8 vb = ret_bfrag(Vimg, 32 * s, F.wave, g, q, p);
            const int r1 = 32 * s + 4 * g + q, sw = (r1 >> 1) & 3;
#pragma unroll
            for (int db = 0; db < 4; ++db) { const LAS unsigned char* a1 = Kimg + r1 * 128 + ((db ^ sw) << 5) + 8 * p;
                const s16x4 lo = tr16(a1), hi = tr16(a1 + 2048);
                const s16x8 ka = (s16x8){lo[0], lo[1], lo[2], lo[3], hi[0], hi[1], hi[2], hi[3]};
                acc[db] = __builtin_amdgcn_mfma_f32_16x16x32_bf16(ka, vb, acc[db], 0, 0, 0); }
        }
        float* o = RS + (size_t)u * 8192 + 16 * F.wave + c;
#pragma unroll
        for (int db = 0; db < 4; ++db)
#pragma unroll
            for (int r = 0; r < 4; ++r) o[(16 * db + 4 * g + r) * 128] = acc[db][r];
    }
    __syncthreads();
}

__device__ __forceinline__ void ret_scan(const Ctx& F) {
    const float* RS = (const float*)(F.ws + WS_HDN); float* SC = (float*)(F.ws + WS_HDN + 16 * MiB);
    for (int t = blockIdx.x * 512 + F.tid; t < NB * 4 * 8192; t += F.G * 512) {
        const int el = t & 8191, h = (t >> 13) & 3, b = t >> 15; const float wch = exp2f(128.f * ret_l2g(h)); float s = 0.f;
        float L[32];
#pragma unroll
        for (int ch = 0; ch < 32; ++ch) L[ch] = RS[(size_t)(((b * 32 + ch) * 4 + h)) * 8192 + el];
#pragma unroll
        for (int ch = 0; ch < 32; ++ch) { SC[(size_t)(((b * 32 + ch) * 4 + h)) * 8192 + el] = s; s = wch * s + L[ch]; }
    }
}

__device__ __forceinline__ void ret_out_mfma(const Ctx& F, const float* gn, bool dummy_out = false) {
    bf16* Z = (bf16*)(F.ws + WS_Z); const float* SC = (const float*)(F.ws + WS_HDN + 16 * MiB);
    const f32x2* R64 = (const f32x2*)(F.ws + WS_ROPE64);
    LAS unsigned char* Vimg = F.lds; LAS unsigned char* Simg = F.lds + 32768; LAS unsigned char* Kimg = F.lds + 49152;
    const int lane = F.lane, g = lane >> 4, c = lane & 15, q = (lane >> 2) & 3, p = lane & 3, w = F.wave;
    for (int u = blockIdx.x; u < NB * 32 * 4; u += F.G) {
        const int h = u & 3, ch = (u >> 2) & 31, b = u >> 7; const float l2g = ret_l2g(h); const float gam = exp2f(l2g);
        bf16* base = Z + ((size_t)b * SEQ + ch * 128) * ZP;
        __syncthreads();
        for (int t = F.tid; t < 2048; t += 512) { const int r = t >> 4, c16 = t & 15;
            *(LAS v4u*)(Vimg + r * 256 + (((c16 >> 1) ^ (r & 7)) << 5) + ((c16 & 1) << 4)) = *(const GAS v4u*)(base + (size_t)r * ZP + Z_RV + h * 128 + c16 * 8); }
        for (int t = F.tid; t < 1024; t += 512) { const int r = t >> 4, c16 = t & 15; const float* sp = SC + (size_t)u * 8192 + r * 128 + c16 * 8;
            const f32x4 s0 = *(const GAS f32x4*)sp, s1 = *(const GAS f32x4*)(sp + 4);
            v4u wv; wv.x = pk2(s0.x * gam, s0.y * gam); wv.y = pk2(s0.z * gam, s0.w * gam); wv.z = pk2(s1.x * gam, s1.y * gam); wv.w = pk2(s1.z * gam, s1.w * gam);
            *(LAS v4u*)(Simg + r * 256 + (((c16 >> 1) ^ (r & 7)) << 5) + ((c16 & 1) << 4)) = wv; }
        for (int t = F.tid; t < 1024; t += 512) { const int j = t >> 3, dg = t & 7; const bf16* row = base + (size_t)j * ZP + Z_RK + h * 64;
            const u32x2 a = *(const GAS u32x2*)(row + 4 * dg), bb = *(const GAS u32x2*)(row + 32 + 4 * dg);
            const float x1[4] = {bflo(a.x), bfhi(a.x), bflo(a.y), bfhi(a.y)}, x2[4] = {bflo(bb.x), bfhi(bb.x), bflo(bb.y), bfhi(bb.y)};
            const f32x2* cs = R64 + (ch * 128 + j) * 32 + 4 * dg; const float sc = exp2f(-(float)j * l2g);
            float o1[4], o2[4];
#pragma unroll
            for (int e = 0; e < 4; ++e) { const f32x2 tt = cs[e]; o1[e] = (x1[e] * tt.x - x2[e] * tt.y) * sc; o2[e] = (x2[e] * tt.x + x1[e] * tt.y) * sc; }
            u32x2 w1, w2; w1.x = pk2(o1[0], o1[1]); w1.y = pk2(o1[2], o1[3]); w2.x = pk2(o2[0], o2[1]); w2.y = pk2(o2[2], o2[3]);
            const int sw = (j >> 1) & 3; const int d1 = 4 * dg, d2 = 32 + 4 * dg;
            *(LAS u32x2*)(Kimg + j * 128 + ((((2 * d1) >> 5) ^ sw) << 5) + ((2 * d1) & 31)) = w1;
            *(LAS u32x2*)(Kimg + j * 128 + ((((2 * d2) >> 5) ^ sw) << 5) + ((2 * d2) & 31)) = w2; }
        const int i = 16 * w + c; s16x8 qf[2];
        float sc8 = 0.125f; asm volatile("" : "+v"(sc8));
        ret_rope_frag(base + (size_t)i * ZP + Z_RQ + h * 64, R64 + (ch * 128 + i) * 32, sc8 * exp2f((float)i * l2g), g, qf);
        __syncthreads();
        f32x4 acc[8];
#pragma unroll
        for (int t = 0; t < 8; ++t) { acc[t] = (f32x4){0.f, 0.f, 0.f, 0.f};
            if (t <= w) { const int j = 16 * t + c; const int sw = (j >> 1) & 3; const LAS unsigned char* kr = Kimg + j * 128;
                const u32x2 a0 = *(const LAS u32x2*)(kr + ((((8 * g) >> 5) ^ sw) << 5) + ((8 * g) & 31)), a1 = *(const LAS u32x2*)(kr + ((((32 + 8 * g) >> 5) ^ sw) << 5) + ((32 + 8 * g) & 31));
                const u32x2 b0 = *(const LAS u32x2*)(kr + ((((64 + 8 * g) >> 5) ^ sw) << 5) + ((64 + 8 * g) & 31)), b1 = *(const LAS u32x2*)(kr + ((((96 + 8 * g) >> 5) ^ sw) << 5) + ((96 + 8 * g) & 31));
                const s16x8 kf0 = __builtin_bit_cast(s16x8, (v4u){a0.x, a0.y, a1.x, a1.y}), kf1 = __builtin_bit_cast(s16x8, (v4u){b0.x, b0.y, b1.x, b1.y});
                acc[t] = __builtin_amdgcn_mfma_f32_16x16x32_bf16(kf0, qf[0], acc[t], 0, 0, 0); acc[t] = __builtin_amdgcn_mfma_f32_16x16x32_bf16(kf1, qf[1], acc[t], 0, 0, 0);
                if (t == w) {
#pragma unroll
                    for (int r = 0; r < 4; ++r) if (4 * g + r > c) acc[t][r] = 0.f; } } }
        s16x8 pf[4];
#pragma unroll
        for (int s = 0; s < 4; ++s) { v4u wv; wv.x = pk2(acc[2 * s][0], acc[2 * s][1]); wv.y = pk2(acc[2 * s][2], acc[2 * s][3]); wv.z = pk2(acc[2 * s + 1][0], acc[2 * s + 1][1]); wv.w = pk2(acc[2 * s + 1][2], acc[2 * s + 1][3]);
            pf[s] = __builtin_bit_cast(s16x8, wv); }
        f32x4 o[8];
#pragma unroll
        for (int eb = 0; eb < 8; ++eb) o[eb] = (f32x4){0.f, 0.f, 0.f, 0.f};
#pragma unroll
        for (int s = 0; s < 4; ++s) if (2 * s <= w) {
#pragma unroll
            for (int eb = 0; eb < 8; ++eb) o[eb] = __builtin_amdgcn_mfma_f32_16x16x32_bf16(pf[s], ret_bfrag(Vimg, 32 * s, eb, g, q, p), o[eb], 0, 0, 0); }
#pragma unroll
        for (int ks = 0; ks < 2; ++ks)
#pragma unroll
            for (int eb = 0; eb < 8; ++eb) o[eb] = __builtin_amdgcn_mfma_f32_16x16x32_bf16(qf[ks], ret_bfrag(Simg, 32 * ks, eb, g, q, p), o[eb], 0, 0, 0);
        float rs[4];
#pragma unroll
        for (int r = 0; r < 4; ++r) { float ss = 0.f;
#pragma unroll
            for (int eb = 0; eb < 8; ++eb) ss += o[eb][r] * o[eb][r];
            ss += sx<1>(ss); ss += sx<2>(ss); ss += sx<4>(ss); ss += sx<8>(ss);
            rs[r] = 1.0f / sqrtf(ss * (1.f / 128) + NORM_EPS); }
#pragma unroll
        for (int r = 0; r < 4; ++r) { bf16* zr = base + (size_t)(16 * w + 4 * g + r) * ZP; bf16* zw = dummy_out ? (bf16*)(F.ws + WS_ZS) + ((size_t)b * SEQ + ch * 128 + 16 * w + 4 * g + r) * 1024 - Z_RV : zr;
#pragma unroll
            for (int eb = 0; eb < 8; ++eb) { const int e = 16 * eb + c; const float rg = bf2f(zr[Z_RG + h * 128 + e]);
                zw[Z_RV + h * 128 + e] = (bf16)f2bf(o[eb][r] * rs[r] * gn[h * 128 + e] * rg * sigmoid_f(rg)); } }
    }
    __syncthreads();
}

__device__ __forceinline__ void fscan_phase(const Ctx& F) {
    const float* LF = (const float*)(F.ws + WS_LF); float* CF = (float*)(F.ws + WS_CF);
    LAS float* wsum = (LAS float*)(F.lds);
    const int seq = (int)blockIdx.x;
    if (seq < 32) {
        const int b = seq >> 3, h = seq & 7; const int p0 = F.tid * 8; const float* lp = LF + ((size_t)b * SEQ + p0) * 8 + h;
        float v[8]; float s = 0.f;
#pragma unroll
        for (int i = 0; i < 8; ++i) { v[i] = lp[i * 8]; }
#pragma unroll
        for (int i = 0; i < 8; ++i) { s += v[i]; v[i] = s; }
        float incl = s;
#pragma unroll
        for (int o = 1; o < 64; o <<= 1) { const float t = __builtin_bit_cast(float, __builtin_amdgcn_ds_bpermute(((F.lane - o) & 63) << 2, __builtin_bit_cast(int, incl))); if (F.lane >= o) incl += t; }
        if (F.lane == 63) wsum[F.wave] = incl;
        __syncthreads();
        float woff = 0.f;
#pragma unroll
        for (int ww = 0; ww < 8; ++ww) { const float t = wsum[ww]; if (ww < F.wave) woff += t; }
        const float base = woff + (incl - s);
        float* cp = CF + (size_t)seq * SEQ + p0;
        *(GAS f32x4*)cp = (f32x4){base + v[0], base + v[1], base + v[2], base + v[3]}; *(GAS f32x4*)(cp + 4) = (f32x4){base + v[4], base + v[5], base + v[6], base + v[7]};
    }
    __syncthreads();
}
#include <hip/hip_bf16.h>
#include <cmath>
namespace attn_body {
using bf16=__hip_bfloat16;
using bf16x8=__attribute__((ext_vector_type(8)))short;
using s16x4=__attribute__((ext_vector_type(4)))short;
using f32x16=__attribute__((ext_vector_type(16)))float;
using u32x4=__attribute__((ext_vector_type(4)))unsigned;
constexpr int BATCH=4,NHEAD=8,SEQ=4096,D=64,DM=6656;
constexpr int NW=8,QBLK=32,QB=QBLK*NW,KVBLK=64,NQB=SEQ/QB;
constexpr int ATTN_PITCH=DM, ATTN_UNIT_ROWS=QB;
__device__ __forceinline__ int crow(int r,int hi){return (r&3)+8*(r>>2)+4*hi;}
#define SBAR() __builtin_amdgcn_sched_barrier(0)
__device__ __forceinline__ void cmask(f32x16&p0,f32x16&p1,int jb,int qrel,int hi){
  const float NEG=-INFINITY; int kb=64*jb+4*hi;
  #pragma unroll
  for(int r=0;r<16;++r){int kv=kb+(r&3)+8*(r>>2); if(kv>qrel)p0[r]=NEG; if(kv+32>qrel)p1[r]=NEG;}
}

constexpr int NSLOT=3, SLOTB=8192;
constexpr int LDS_K=0, LDS_V=NSLOT*SLOTB, LDS_WS=2*NSLOT*SLOTB, LDS_OST=LDS_WS+NW*64*4, LDS_NC=LDS_OST+NW*4096, LDS_BYTES=LDS_NC+SEQ*4;
constexpr float C2=0.125f*1.4426950408889634f;
__device__ __forceinline__ void glds16(const void*gsrc,unsigned lds_dst){unsigned keep;
  asm volatile("s_mov_b32 %0, m0\n\ts_mov_b32 m0, %2\n\ts_nop 0\n\tglobal_load_lds_dwordx4 %1, off\n\ts_mov_b32 m0, %0":"=&s"(keep):"v"(gsrc),"s"(lds_dst):"memory");}
__device__ __forceinline__ float max3f(float a,float b,float c){float r;asm("v_max3_f32 %0, %1, %2, %3":"=v"(r):"v"(a),"v"(b),"v"(c));return r;}
__device__ __forceinline__ float max2f(float a,float b){float r;asm("v_max_f32_e32 %0, %1, %2":"=v"(r):"v"(a),"v"(b));return r;}
__device__ __forceinline__ float fadd_s(float a,float b){float r;asm("v_add_f32_e32 %0, %1, %2":"=v"(r):"v"(a),"v"(b));return r;}
__device__ __forceinline__ float fsub_s(float a,float b){float r;asm("v_sub_f32_e32 %0, %1, %2":"=v"(r):"v"(a),"v"(b));return r;}
typedef float f32x4_t __attribute__((ext_vector_type(4))); typedef float f32x2_t __attribute__((ext_vector_type(2))); typedef __bf16 bf16x2_t __attribute__((ext_vector_type(2)));
__device__ __forceinline__ unsigned cvtpk_s(float lo,float hi){f32x2_t v={lo,hi};bf16x2_t b=__builtin_convertvector(v,bf16x2_t);return __builtin_bit_cast(unsigned,b);}
#define WAIT_BAR(N) asm volatile("s_waitcnt vmcnt(" #N ") lgkmcnt(0)\n\ts_barrier":::"memory")

__device__ __forceinline__ void qkt(f32x16&p0,f32x16&p1,const char*Kslot,const bf16x8*qr,const f32x16&negm,int r32,int hi){
  const char*kb=Kslot+hi*1024+r32*16;
  #pragma unroll
  for(int d0=0;d0<4;++d0){
    const bf16x8 b0=*reinterpret_cast<const bf16x8*>(kb+d0*2048);
    const bf16x8 b1=*reinterpret_cast<const bf16x8*>(kb+d0*2048+512);
    if(d0==0){p0=__builtin_amdgcn_mfma_f32_32x32x16_bf16(b0,qr[0],negm,0,0,0);p1=__builtin_amdgcn_mfma_f32_32x32x16_bf16(b1,qr[0],negm,0,0,0);}
    else{p0=__builtin_amdgcn_mfma_f32_32x32x16_bf16(b0,qr[d0],p0,0,0,0);p1=__builtin_amdgcn_mfma_f32_32x32x16_bf16(b1,qr[d0],p1,0,0,0);}}
}
typedef __attribute__((address_space(3))) const char* lds_cptr;
typedef short v4i16_t __attribute__((ext_vector_type(4)));
__device__ __forceinline__ void kload8(bf16x8*kf,lds_cptr kp){
  kf[0]=*(const __attribute__((address_space(3))) bf16x8*)(kp);      kf[1]=*(const __attribute__((address_space(3))) bf16x8*)(kp+512);
  kf[2]=*(const __attribute__((address_space(3))) bf16x8*)(kp+2048); kf[3]=*(const __attribute__((address_space(3))) bf16x8*)(kp+2560);
  kf[4]=*(const __attribute__((address_space(3))) bf16x8*)(kp+4096); kf[5]=*(const __attribute__((address_space(3))) bf16x8*)(kp+4608);
  kf[6]=*(const __attribute__((address_space(3))) bf16x8*)(kp+6144); kf[7]=*(const __attribute__((address_space(3))) bf16x8*)(kp+6656);
}
__device__ __forceinline__ void kload2(bf16x8*kf,lds_cptr kp,int j){ kf[2*j]=*(const __attribute__((address_space(3))) bf16x8*)(kp+j*2048); kf[2*j+1]=*(const __attribute__((address_space(3))) bf16x8*)(kp+j*2048+512); }
__device__ __forceinline__ s16x4 vtr(lds_cptr p){ return __builtin_bit_cast(s16x4,__builtin_amdgcn_ds_read_tr16_b64_v4i16((__attribute__((address_space(3))) v4i16_t*)p)); }
__device__ __forceinline__ float rowmax(const f32x16&p0,const f32x16&p1){
  float a=max3f(p0[0],p0[1],p1[0]),b=max3f(p0[2],p0[3],p1[1]);a=max3f(a,p1[2],p1[3]);
  #pragma unroll
  for(int r=4;r<16;r+=4){a=max3f(a,p0[r],p0[r+1]);b=max3f(b,p0[r+2],p0[r+3]);a=max3f(a,p1[r],p1[r+1]);b=max3f(b,p1[r+2],p1[r+3]);}
  const float m=max2f(a,b);
  auto rr=__builtin_amdgcn_permlane32_swap(__float_as_uint(m),__float_as_uint(m),false,false);
  return max2f(__uint_as_float(rr[0]),__uint_as_float(rr[1]));
}
__device__ __forceinline__ void pv(f32x16*o,int vb,bf16x8 pa0,bf16x8 pa1,bf16x8 pa2,bf16x8 pa3){
  #pragma unroll
  for(int d0=0;d0<2;++d0){s16x4 lo[4],hi[4];
    #pragma unroll
    for(int ks=0;ks<4;++ks){
      asm volatile("ds_read_b64_tr_b16 %0,%1 offset:%c2":"=&v"(lo[ks]):"v"(vb),"i"(d0*4096+ks*1024):"memory");
      asm volatile("ds_read_b64_tr_b16 %0,%1 offset:%c2":"=&v"(hi[ks]):"v"(vb),"i"(d0*4096+ks*1024+512):"memory");}
    asm volatile("s_waitcnt lgkmcnt(0)":::"memory");SBAR();
    #define PK(k) (bf16x8){lo[k][0],lo[k][1],lo[k][2],lo[k][3],hi[k][0],hi[k][1],hi[k][2],hi[k][3]}
    o[d0]=__builtin_amdgcn_mfma_f32_32x32x16_bf16(pa0,PK(0),o[d0],0,0,0);
    o[d0]=__builtin_amdgcn_mfma_f32_32x32x16_bf16(pa1,PK(1),o[d0],0,0,0);
    o[d0]=__builtin_amdgcn_mfma_f32_32x32x16_bf16(pa2,PK(2),o[d0],0,0,0);
    o[d0]=__builtin_amdgcn_mfma_f32_32x32x16_bf16(pa3,PK(3),o[d0],0,0,0);
    #undef PK
  }
}

#ifndef ATTN_STORE16
#define ATTN_STORE16(p,v) (*(u32x4*)(p)=(v))
#endif
template<int THRL> __device__ __forceinline__ void attn_unit(int b,int h,int qb,const bf16*Q,const bf16*__restrict__ K,const bf16*__restrict__ V,bf16*O,const float*CF,float dskip,char*shm,int wave_id){
  int tid_=(wave_id<<6)|lane_id_v(); asm volatile("":"+v"(tid_));
  const int tid=tid_,lane=tid&63,r32=lane&31,hi=lane>>5; const int wid=__builtin_amdgcn_readfirstlane(tid>>6);
  const long rowbase=(long)b*SEQ; const int q0=qb*QB;
  const bf16*Qw=Q+(rowbase+q0+wid*QBLK)*DM+h*D;
  const float*cfp0=CF+(long)(b*NHEAD+h)*SEQ; const int NT0=(q0+QB)/KVBLK;
  int ts; { const float cq=cfp0[q0]; const int il=(lane<NT0)?64*lane+63:q0; const bool keep=(lane<NT0)&&(cfp0[il]<cq+dskip);
    const unsigned long long km=__ballot(keep); int t0=(int)__builtin_ctzll(km|(1ull<<63)); t0&=~1; ts=__builtin_amdgcn_readfirstlane(t0<NT0-4?t0:NT0-4); }
  const bf16*Kh=K+(rowbase+(long)ts*KVBLK)*DM+h*D,*Vh=V+(rowbase+(long)ts*KVBLK)*DM+h*D;
  const unsigned lds0=(unsigned)(uintptr_t)shm;
  float*wsf=(float*)(shm+LDS_WS)+wid*64;
  const bf16*ksrc=Kh+(long)lane*DM+wid*8;
  const bf16*vsrc=Vh+(long)(16*(wid&3)+(lane>>2))*DM+(wid>>2)*32+(lane&3)*8;
  const unsigned kdst=lds0+LDS_K+wid*1024, vdst=lds0+LDS_V+wid*1024;
  #define DMA_K(t,slot) glds16(ksrc+(long)(t)*KVBLK*DM,(unsigned)__builtin_amdgcn_readfirstlane(kdst+(slot)))
  #define DMA_V(t,slot) glds16(vsrc+(long)(t)*KVBLK*DM,(unsigned)__builtin_amdgcn_readfirstlane(vdst+(slot)))
  const char*Kbase=shm+LDS_K; bf16x8 kf[8];
  const lds_cptr shm3=(lds_cptr)shm; const lds_cptr kp0=shm3+LDS_K+hi*1024+r32*16; const lds_cptr vp0=shm3+LDS_V+((lane>>4)&1)*32+(lane&3)*8+(4*hi+((lane&15)>>2))*64;
  const int NT=NT0-ts;
  { const float*cfp=CF+(long)(b*NHEAD+h)*SEQ; float*ncw=(float*)(shm+LDS_NC);
    for(int i=tid+ts*KVBLK;i<q0+QB;i+=NW*64)ncw[i-ts*KVBLK]=-cfp[i]; }
  const lds_cptr ncp=(lds_cptr)shm+LDS_NC+hi*16;
  #define ADDC(P0,P1,t) do{ const lds_cptr np_=ncp+(t)*256; _Pragma("unroll") for(int g_=0;g_<4;++g_){ \
      const f32x4_t a_=*(const __attribute__((address_space(3))) f32x4_t*)(np_+g_*32), b_=*(const __attribute__((address_space(3))) f32x4_t*)(np_+g_*32+128); \
      P0[4*g_]+=a_[0];P0[4*g_+1]+=a_[1];P0[4*g_+2]+=a_[2];P0[4*g_+3]+=a_[3]; P1[4*g_]+=b_[0];P1[4*g_+1]+=b_[1];P1[4*g_+2]+=b_[2];P1[4*g_+3]+=b_[3]; } }while(0)
  DMA_K(0,0);DMA_V(0,0);DMA_K(1,SLOTB);
  bf16x8 qr[4];
  #pragma unroll
  for(int d0=0;d0<4;++d0)qr[d0]=*reinterpret_cast<const bf16x8*>(&Qw[(long)r32*DM+d0*16+hi*8]);
  float mhat=0.f,l_reg=0.f;f32x16 o[2];f32x16 negm; { float zz_; asm volatile("v_mov_b32 %0, 0":"=v"(zz_));
    _Pragma("unroll") for(int r=0;r<16;++r){o[0][r]=zz_;o[1][r]=zz_;negm[r]=zz_;} } asm volatile("":"+v"(negm));
  const int qrel=wid*QBLK+r32;
  #define CMASK(P0,P1,t) do{int jb_=(t)-(NT-4); if(jb_>=0)cmask(P0,P1,jb_,qrel,hi);}while(0)
  bool resc=false;
  #define START(P0,P1) do{ const float rm=rowmax(P0,P1); resc=false; \
    { const float dl=rm; mhat=fadd_s(mhat,dl); \
      _Pragma("unroll") for(int r=0;r<16;++r){P0[r]=fsub_s(P0[r],dl);P1[r]=fsub_s(P1[r],dl);} \
      _Pragma("unroll") for(int r=0;r<16;++r)negm[r]=-mhat; asm volatile("":"+v"(negm)); } \
    _Pragma("unroll") for(int r=0;r<16;++r)P0[r]=__builtin_amdgcn_exp2f(P0[r]); }while(0)
  #define RESC() do{ if(resc){ asm volatile("s_waitcnt lgkmcnt(0)":::"memory"); \
      _Pragma("unroll") for(int d_=0;d_<2;++d_) _Pragma("unroll") for(int r=0;r<16;++r)o[d_][r]*=wsf[crow(r,hi)]; } }while(0)
  f32x16 pA0,pA1,pB0,pB1;
  int sl_prev=0,sl_cur=0,sl_next=SLOTB;
  #define ROT() do{sl_prev=sl_cur;sl_cur=sl_next;sl_next=(sl_next==(NSLOT-1)*SLOTB)?0:sl_next+SLOTB;}while(0)
  DMA_K(2,2*SLOTB);
  WAIT_BAR(3);
  qkt(pA0,pA1,Kbase,qr,negm,r32,hi);asm volatile("s_nop 15\n\ts_nop 7":"+v"(pA0),"+v"(pA1));ADDC(pA0,pA1,0);CMASK(pA0,pA1,0);
  START(pA0,pA1);
  _Pragma("unroll") for(int r=0;r<16;++r)pA1[r]=__builtin_amdgcn_exp2f(pA1[r]);
  WAIT_BAR(0);
  DMA_K(3,0);DMA_V(1,SLOTB);
  ROT();
  kload8(kf,kp0+sl_cur);
  WAIT_BAR(2);
  s16x4 vlo[8],vhi[8]; u32x4 pw0,pw1,pw2,pw3;
  #define PKW(P,B) cvtpk_s(P[B],P[B+1])
  #define PAF(k) __builtin_bit_cast(bf16x8,pw##k)
  #define VFR(i) (bf16x8){vlo[i][0],vlo[i][1],vlo[i][2],vlo[i][3],vhi[i][0],vhi[i][1],vhi[i][2],vhi[i][3]}
  #define PIN(x) asm volatile("":"+v"(x))
  #define MX3(a,b,c) __builtin_fmaxf(__builtin_fmaxf((a),(b)),(c))
  #define GAPA(MF,A0,A1,A2,A3,W0,W1,PW) do{ MF; sacc+=A0; sacc+=A1; sacc+=A2; sacc+=A3; PIN(sacc); W0; W1; PIN(PW); SBAR(); }while(0)
  #define EX(v) __builtin_amdgcn_exp2f(v)
  #define GAPB(MF,X,B) do{ MF; X[B]=EX(X[B]); X[B+1]=EX(X[B+1]); X[B+2]=EX(X[B+2]); X[B+3]=EX(X[B+3]); PIN(X); SBAR(); }while(0)
  #define VRD(i) do{ vlo[i]=vtr(vp_+(((i)>>2)*4096+((i)&3)*1024)); vhi[i]=vtr(vp_+(((i)>>2)*4096+((i)&3)*1024+512)); }while(0)
  #define KRD(G,j) do{ if(G){ kload2(kf,kp0+sl_next,j); SBAR(); } }while(0)
  #define STEP(C0,C1,P0,P1,t,GK,GV,GL) do{ SBAR(); \
    const lds_cptr vp_=vp0+sl_prev; \
    VRD(0); SBAR(); float sacc=(P0[0]+P0[1]); \
    GAPA(C0=__builtin_amdgcn_mfma_f32_32x32x16_bf16(kf[0],qr[0],negm,0,0,0), P0[2],P0[3],P0[4],P0[5],     pw0[0]=PKW(P0,0), pw0[1]=PKW(P0,2), pw0); \
    VRD(4); SBAR(); GAPA(C1=__builtin_amdgcn_mfma_f32_32x32x16_bf16(kf[1],qr[0],negm,0,0,0), P0[6],P0[7],P0[8],P0[9],     pw0[2]=PKW(P0,4), pw0[3]=PKW(P0,6), pw0); \
    VRD(1); SBAR(); GAPA(C0=__builtin_amdgcn_mfma_f32_32x32x16_bf16(kf[2],qr[1],C0,0,0,0),   P0[10],P0[11],P0[12],P0[13], pw1[0]=PKW(P0,8), pw1[1]=PKW(P0,10), pw1); \
    VRD(5); SBAR(); GAPA(C1=__builtin_amdgcn_mfma_f32_32x32x16_bf16(kf[3],qr[1],C1,0,0,0),   P0[14],P0[15],P1[0],P1[1],   pw1[2]=PKW(P0,12),pw1[3]=PKW(P0,14), pw1); \
    VRD(2); SBAR(); GAPA(C0=__builtin_amdgcn_mfma_f32_32x32x16_bf16(kf[4],qr[2],C0,0,0,0),   P1[2],P1[3],P1[4],P1[5],     pw2[0]=PKW(P1,0), pw2[1]=PKW(P1,2), pw2); \
    VRD(6); SBAR(); GAPA(C1=__builtin_amdgcn_mfma_f32_32x32x16_bf16(kf[5],qr[2],C1,0,0,0),   P1[6],P1[7],P1[8],P1[9],     pw2[2]=PKW(P1,4), pw2[3]=PKW(P1,6), pw2); \
    VRD(3); SBAR(); GAPA(C0=__builtin_amdgcn_mfma_f32_32x32x16_bf16(kf[6],qr[3],C0,0,0,0),   P1[10],P1[11],P1[12],P1[13], pw3[0]=PKW(P1,8), pw3[1]=PKW(P1,10), pw3); \
    VRD(7); SBAR(); GAPA(C1=__builtin_amdgcn_mfma_f32_32x32x16_bf16(kf[7],qr[3],C1,0,0,0),   P1[14],P1[15],0.f,0.f,       pw3[2]=PKW(P1,12),pw3[3]=PKW(P1,14), pw3); \
    l_reg+=sacc; \
    if(GK){DMA_K((t)+3,sl_cur);} if(GV){DMA_V((t)+1,sl_next);} \
    ADDC(C0,C1,t); CMASK(C0,C1,t); \
    { float a=MX3(C0[0],C0[1],C1[0]),b=MX3(C0[2],C0[3],C1[1]); a=MX3(a,C1[2],C1[3]); \
      _Pragma("unroll") for(int r=4;r<16;r+=4){a=MX3(a,C0[r],C0[r+1]);b=MX3(b,C0[r+2],C0[r+3]);a=MX3(a,C1[r],C1[r+1]);b=MX3(b,C1[r+2],C1[r+3]);} \
      float rm=__builtin_fmaxf(a,b); { auto rr=__builtin_amdgcn_permlane32_swap(__float_as_uint(rm),__float_as_uint(rm),false,false); rm=__builtin_fmaxf(__uint_as_float(rr[0]),__uint_as_float(rr[1])); } \
      resc=false; \
      if(__builtin_expect(__any(rm>(float)THRL),0)){ const float dl=__builtin_fmaxf(rm,0.f); mhat+=dl; \
        _Pragma("unroll") for(int r=0;r<16;++r){C0[r]-=dl;C1[r]-=dl;} \
        _Pragma("unroll") for(int r=0;r<16;++r)negm[r]=-mhat; asm volatile("":"+v"(negm)); \
        const float f=__builtin_amdgcn_exp2f(-dl); l_reg*=f; if(hi==0)wsf[r32]=f; resc=true; } } \
    SBAR(); \
    GAPB(o[0]=__builtin_amdgcn_mfma_f32_32x32x16_bf16(PAF(0),VFR(0),o[0],0,0,0), C0,0); \
    GAPB(o[1]=__builtin_amdgcn_mfma_f32_32x32x16_bf16(PAF(0),VFR(4),o[1],0,0,0), C0,4); \
    KRD(GL,0); GAPB(o[0]=__builtin_amdgcn_mfma_f32_32x32x16_bf16(PAF(1),VFR(1),o[0],0,0,0), C0,8); \
    KRD(GL,1); GAPB(o[1]=__builtin_amdgcn_mfma_f32_32x32x16_bf16(PAF(1),VFR(5),o[1],0,0,0), C0,12); \
    KRD(GL,2); GAPB(o[0]=__builtin_amdgcn_mfma_f32_32x32x16_bf16(PAF(2),VFR(2),o[0],0,0,0), C1,0); \
    KRD(GL,3); GAPB(o[1]=__builtin_amdgcn_mfma_f32_32x32x16_bf16(PAF(2),VFR(6),o[1],0,0,0), C1,4); \
    GAPB(o[0]=__builtin_amdgcn_mfma_f32_32x32x16_bf16(PAF(3),VFR(3),o[0],0,0,0), C1,8); \
    GAPB(o[1]=__builtin_amdgcn_mfma_f32_32x32x16_bf16(PAF(3),VFR(7),o[1],0,0,0), C1,12); \
    }while(0)
  int t=1;
  #undef CMASK
  #define CMASK(P0,P1,t) do{}while(0)
  for(;t+5<NT;t+=2){
    STEP(pB0,pB1,pA0,pA1,t,true,true,true);     WAIT_BAR(2); RESC(); ROT();
    STEP(pA0,pA1,pB0,pB1,t+1,true,true,true);   WAIT_BAR(2); RESC(); ROT();
  }
  #undef CMASK
  #define CMASK(P0,P1,t) do{int jb_=(t)-(NT-4); if(jb_>=0)cmask(P0,P1,jb_,qrel,hi);}while(0)
  #define ENDW(tt) do{ if((tt)+3<NT){WAIT_BAR(2);} else if((tt)+2<NT){WAIT_BAR(1);} else {WAIT_BAR(0);} }while(0)
  for(;t+1<NT;t+=2){
    STEP(pB0,pB1,pA0,pA1,t,(t+3<NT),(t+1<NT),(t+1<NT));       ENDW(t);   RESC(); ROT();
    STEP(pA0,pA1,pB0,pB1,t+1,(t+4<NT),(t+2<NT),(t+2<NT));     ENDW(t+1); RESC(); ROT();
  }
  STEP(pB0,pB1,pA0,pA1,NT-1,false,false,false); RESC();
  { float sacc=pB0[0]+pB0[1]; _Pragma("unroll") for(int r=2;r<16;++r)sacc+=pB0[r]; _Pragma("unroll") for(int r=0;r<16;++r)sacc+=pB1[r]; l_reg+=sacc;
    pw0=(u32x4){PKW(pB0,0),PKW(pB0,2),PKW(pB0,4),PKW(pB0,6)};pw1=(u32x4){PKW(pB0,8),PKW(pB0,10),PKW(pB0,12),PKW(pB0,14)};pw2=(u32x4){PKW(pB1,0),PKW(pB1,2),PKW(pB1,4),PKW(pB1,6)};pw3=(u32x4){PKW(pB1,8),PKW(pB1,10),PKW(pB1,12),PKW(pB1,14)};
    int tl_=lane_id_v(); asm volatile("":"+v"(tl_)); const int ln_=tl_&63,hi_=ln_>>5; const int vb0e=(int)(lds0+LDS_V)+((ln_>>4)&1)*32+(ln_&3)*8+(4*hi_+((ln_&15)>>2))*64;
    SBAR(); pv(o,vb0e+sl_cur,PAF(0),PAF(1),PAF(2),PAF(3)); }
  #undef PKW
  #undef PAF
  #undef VFR
  #undef PIN
  #undef MX3
  #undef GAPA
  #undef GAPB
  #undef EX
  #undef VRD
  #undef KRD
  #undef STEP
  #undef ENDW
  {auto rr=__builtin_amdgcn_permlane32_swap(__float_as_uint(l_reg),__float_as_uint(l_reg),false,false);l_reg=__uint_as_float(rr[0])+__uint_as_float(rr[1]);}
  int te_=lane_id_v(); asm volatile("":"+v"(te_)); const int lane_e=te_&63,r32_e=lane_e&31,hi_e=lane_e>>5;
  if(hi_e==0)wsf[32+r32_e]=l_reg;asm volatile("s_waitcnt lgkmcnt(0)":::"memory");
  float rli[16];
  #pragma unroll
  for(int r=0;r<16;++r)rli[r]=__builtin_amdgcn_rcpf(wsf[32+crow(r,hi_e)]);
  bf16*Ow=O+(rowbase+q0+wid*QBLK)*DM+h*D;
  { bf16*stg=(bf16*)(shm+LDS_OST)+wid*2048;
    #pragma unroll
    for(int r=0;r<16;++r){const int orow=crow(r,hi_e);
      #pragma unroll
      for(int d0=0;d0<2;++d0)stg[orow*64+d0*32+r32_e]=__float2bfloat16(o[d0][r]*rli[r]);}
    asm volatile("s_waitcnt lgkmcnt(0)":::"memory");
    #pragma unroll
    for(int i=0;i<4;++i){const int row=i*8+(lane_e>>3),ch=lane_e&7; const u32x4 v=*(const u32x4*)(stg+row*64+ch*8); ATTN_STORE16(Ow+(long)row*DM+ch*8,v);} }
  asm volatile("s_waitcnt lgkmcnt(0)\n\ts_barrier":::"memory");
  #undef ADDC
  #undef DMA_K
  #undef DMA_V
  #undef CMASK
  #undef START
  #undef RESC
  #undef ROT
}
constexpr int ATTN_LDS_BYTES=LDS_BYTES;
struct AttnTensors { const bf16* Q; const bf16* K; const bf16* V; bf16* O; const float* CF; float dskip; };
struct AttnUnit { int bh; int qb; };
struct StaticOrder {
  int vcu;
  __device__ __forceinline__ explicit StaticOrder(int grid,int block):vcu((block%8)*(grid/8)+block/8){}
  __device__ __forceinline__ bool next(int i,AttnUnit&u)const{ if(i>=2)return false; const int s=vcu&7; u.bh=vcu>>3; u.qb=(i==0)?s:15-s; return true; }
  __device__ __forceinline__ void a_ready(const AttnUnit&)const{}
  __device__ __forceinline__ void done(const AttnUnit&)const{}
};
template<class Sched,int THRL=8> __device__ __forceinline__ void attn_phase(char*lds,const AttnTensors&T,const Sched&S,int wave_id){
  AttnUnit u;
  for(int i=0;S.next(i,u);++i){ S.a_ready(u); attn_unit<THRL>(u.bh/NHEAD,u.bh%NHEAD,u.qb,T.Q,T.K,T.V,T.O,T.CF,T.dskip,lds,wave_id); S.done(u); }
}
#undef SBAR
#undef WAIT_BAR
}

struct Args { const float* in[16]; float* out; unsigned char* ws; };
__global__ void __launch_bounds__(NWAVES * 64, 2) hyb_fwd(Args args) {
    extern __shared__ __attribute__((aligned(16))) unsigned char lds[];
    Ctx F;
    F.lds = (LAS unsigned char*)lds;
    F.tid = threadIdx.x; F.lane = F.tid & 63; F.wave = __builtin_amdgcn_readfirstlane(F.tid >> 6);
    F.G = gridDim.x; F.gw = blockIdx.x * NWAVES + F.wave; F.NGW = F.G * NWAVES;
    F.out = args.out; F.ws = args.ws;
    volatile LAS unsigned* MISC = (volatile LAS unsigned*)(F.lds + MISC_OFF);
    for (int u = F.tid; u < (LDS_BYTES - LDSCTL_OFF) / 4; u += NWAVES * 64) ((LAS unsigned*)(F.lds + LDSCTL_OFF))[u] = 0u;
    __syncthreads();
    gu32* ctl = (gu32*)(F.ws + WS_CTL);
    XcdBarrier bar = xcd_barrier_post((unsigned*)(ctl + CW_BAR), MISC + 8); bar.w = F.wave;
#define FRESH(P) Ctx P = F; P.tid = (F.wave << 6) | lane_id_v(); asm volatile("" : "+v"(P.tid), "+s"(P.wave), "+s"(P.gw), "+s"(P.ws), "+s"(P.out)); P.lane = P.tid & 63
#define GRID_BAR() do { XcdBarrier b_ = bar; asm volatile("" : "+s"(b_.bar), "+s"(b_.x)); xcd_barrier(b_); } while (0)

    bf16* Wb = (bf16*)(F.ws + WS_W);
    bf16* Z = (bf16*)(F.ws + WS_Z); float* ZS = (float*)(F.ws + WS_ZS); bf16* HDN = (bf16*)(F.ws + WS_HDN);
    float* M32 = (float*)(F.ws + WS_HDN); bf16* HB = (bf16*)(F.ws + WS_Z);
    LAS unsigned char* ring = F.lds + RING_OFF; float* SSp = (float*)(F.ws + WS_SS); bf16* XA = (bf16*)F.out;

    { FRESH(P); p0_prologue(P, args.in[2], args.in[9], args.in[10], args.in[11], args.in[12], args.in[14], args.in[15], args.in[1], args.in[13]); }
    { FRESH(P); norm0_phase(P, args.in[0], (bf16*)P.out, (float*)(P.ws + WS_SS)); }
    GRID_BAR();
    if (F.wave == 0 && lane_id_v() == 0) { unsigned ok = (F.G == 256) ? 1u : 0u;
        for (unsigned j = 0; j < 16; ++j) { const unsigned c = xb_ld((unsigned*)(ctl + CW_BAR) + XB_XCNT(j)); if (c != (j < 8 ? 32u : 0u)) ok = 0u; }
        MISC[11] = ok; }
    __syncthreads();
    const int seam_loc = __builtin_amdgcn_readfirstlane((int)MISC[11]);
    const int cidx_ = __builtin_amdgcn_readfirstlane(seam_loc ? (int)(8u * MISC[10] + bar.x) : (int)blockIdx.x);
#define CIDX() cidx_
#define SEAM_BAR() do { XcdBarrier b_ = bar; asm volatile("" : "+s"(b_.bar), "+s"(b_.x)); if (seam_loc) xcd_local_barrier(b_); else xcd_barrier(b_); } while (0)

    #pragma unroll 1
    for (int layer = 0; layer < DEPTH; ++layer) {
        const bf16* L = Wb + (size_t)layer * LW_STRIDE;
        { pg8::Gemm g{XA, L + LW_IN, M, NIN, DM, DM, DM, 256 * DM}; pg8::StaticOrder S; S.init(M, NIN, F.G, CIDX());
          const pg8::PG8_LAS_F* RT = (const pg8::PG8_LAS_F*)(F.lds + XTRA_OFF); const int pmt = pg8::rstd_table((pg8::PG8_LAS_F*)(F.lds + XTRA_OFF), SSp, S, F.wave);
          pg8::EpiZ E{Z, ZS, SSp, args.in[4] + layer * 64, args.in[5] + layer * 64, args.in[6] + layer * 64, (const float*)(F.ws + WS_ROPE64), RT, pmt};
          pg8::gemm_phase<pg8::EpiZ, pg8::StaticOrder, true, true>(ring, g, S, E, F.wave); }
        GRID_BAR();
#ifdef PROBE_PP
        { FRESH(P); post_phase(P, args.in[4] + layer * 64, args.in[5] + layer * 64, args.in[6] + layer * 64, args.in[7] + layer * 64, args.in[3] + layer * 8, true); }
#endif
        { FRESH(P); post_phase(P, args.in[4] + layer * 64, args.in[5] + layer * 64, args.in[6] + layer * 64, args.in[7] + layer * 64, args.in[3] + layer * 8); }
        { FRESH(P); ret_state_mfma(P); }
        GRID_BAR();
        { FRESH(P); fscan_phase(P); }
        { FRESH(P); ret_scan(P); }
        GRID_BAR();
#ifdef PROBE_RO
        { FRESH(P); ret_out_mfma(P, args.in[8] + layer * 512, true); }
#endif
        { FRESH(P); ret_out_mfma(P, args.in[8] + layer * 512); }
#ifdef PROBE_X3
        for (int rep_ = 0; rep_ < 2; ++rep_)
        { static_assert(attn_body::ATTN_LDS_BYTES <= RING_BYTES, "attention scratch fits the ring region");
          unsigned char* wsl = F.ws; asm volatile("" : "+s"(wsl));
          bf16* Zl = (bf16*)(wsl + WS_Z);
          const attn_body::AttnTensors AT{(const attn_body::bf16*)(Zl + Z_FQ), (const attn_body::bf16*)(Zl + Z_FK), (const attn_body::bf16*)(Zl + Z_FV), (attn_body::bf16*)(Zl + (rep_ == 0 ? Z_RQ : Z_FQ)), (const float*)(wsl + WS_CF)};
          const attn_body::StaticOrder S((int)F.G, (int)blockIdx.x);
          attn_body::attn_phase<attn_body::StaticOrder, 20>((char*)lds + RING_OFF, AT, S, F.wave); }
#ifdef PROBE_X4
        { FRESH(P); dsa_v3(P); }
#else
        for (int rep_ = 0; rep_ < 2; ++rep_) { FRESH(P); dsa_v3(P, rep_ == 0 ? Z_RG : Z_DQ); }
#endif
#else
        { static_assert(attn_body::ATTN_LDS_BYTES <= RING_BYTES, "attention scratch fits the ring region");
          unsigned char* wsl = F.ws; asm volatile("" : "+s"(wsl));
          bf16* Zl = (bf16*)(wsl + WS_Z);
          float dskip; { const int ln = lane_id_v(); const float gq = wave_max(fabsf(args.in[4][layer * 64 + ln])), gk = wave_max(fabsf(args.in[5][layer * 64 + ln])); dskip = 2.0f * (64.0f * C2 * gq * gk * 1.02f) + 48.0f; }
          const attn_body::AttnTensors AT{(const attn_body::bf16*)(Zl + Z_FQ), (const attn_body::bf16*)(Zl + Z_FK), (const attn_body::bf16*)(Zl + Z_FV), (attn_body::bf16*)(Zl + Z_FQ), (const float*)(wsl + WS_CF), dskip};
          const attn_body::StaticOrder S((int)F.G, (int)blockIdx.x);
          attn_body::attn_phase<attn_body::StaticOrder, 20>((char*)lds + RING_OFF, AT, S, F.wave); }
        { FRESH(P); dsa_v3(P); }
#endif
        GRID_BAR();
        { pg8::Gemm g{Z + Z_FQ, L + LW_MIX, M, DM, 1536, ZP, 1536, 256 * ZP}; pg8::StaticOrder S; S.init(M, DM, F.G, CIDX());
          pg8::EpiGateF E{(const unsigned char*)(Z + Z_ZG), Z + Z_MRG};
          pg8::gemm_phase<pg8::EpiGateF, pg8::StaticOrder, false, true>(ring, g, S, E, F.wave); }
        SEAM_BAR();
        { pg8::Gemm g{Z + Z_MRG, L + LW_O, M, DM, DM, ZP, DM, 256 * ZP}; pg8::StaticOrder S; S.init(M, DM, F.G, CIDX());
          pg8::EpiRes E{XA, HDN, nullptr, SSp};
          pg8::gemm_phase<pg8::EpiRes, pg8::StaticOrder, false, true>(ring, g, S, E, F.wave); }
        SEAM_BAR();
        { pg8::Gemm g{HDN, L + LW_FI, M, FF2, DM, DM, DM, 256 * DM}; pg8::StaticOrder S; S.init(M, FF2, F.G, CIDX());
          const pg8::PG8_LAS_F* RT = (const pg8::PG8_LAS_F*)(F.lds + XTRA_OFF); const int pmt = pg8::rstd_table((pg8::PG8_LAS_F*)(F.lds + XTRA_OFF), SSp, S, F.wave);
          pg8::EpiSwi E{HB, FFH, 256 * ZP, SSp, RT, pmt};
          pg8::gemm_phase<pg8::EpiSwi, pg8::StaticOrder, true, true>(ring, g, S, E, F.wave); }
        SEAM_BAR();
        { pg8::Gemm g{HB, L + LW_FO, M, DM, FFH, FFH, FFH, 256 * ZP}; pg8::StaticOrder S; S.init(M, DM, F.G, CIDX());
          pg8::EpiRes E{HDN, XA, (layer + 1 < DEPTH) ? nullptr : F.out, SSp};
          pg8::gemm_phase<pg8::EpiRes, pg8::StaticOrder, false, true>(ring, g, S, E, F.wave); }
        if (layer + 1 < DEPTH) SEAM_BAR(); else GRID_BAR();
    }
    if (__hip_atomic_load((gu32*)((unsigned*)(ctl + CW_BAR) + XB_TMO), RLX_AGENT) != 0u) {
        const float q = __builtin_nanf("");
        for (int m = F.gw; m < M; m += F.NGW) { GAS f32x4* o = (GAS f32x4*)(F.out + (size_t)m * DM) + lane_id_v();
#pragma unroll
            for (int j = 0; j < 4; ++j) o[64 * j] = (f32x4){q, q, q, q}; }
    }
}

extern "C" void kernel_launch(void* const* d_in, const int* in_sizes, int n_in, void* d_out, int out_size, void* d_ws, size_t ws_size, hipStream_t stream) {
    static int grid = 0;
    if (grid == 0) {
        if (n_in != 16 || in_sizes[0] != M * DM || out_size != M * DM || ws_size < WS_END) { fprintf(stderr, "kernel_launch: unexpected shapes / workspace (n_in %d, in0 %d, out %d, ws %zu < %zu)\n", n_in, n_in > 0 ? in_sizes[0] : -1, out_size, ws_size, (size_t)WS_END); grid = -1; return; }
        int dev = 0, cus = 0, per_cu = 0;
        if (hipGetDevice(&dev) != hipSuccess || hipDeviceGetAttribute(&cus, hipDeviceAttributeMultiprocessorCount, dev) != hipSuccess) { grid = -1; return; }
        if (hipFuncSetAttribute((const void*)hyb_fwd, hipFuncAttributeMaxDynamicSharedMemorySize, LDS_BYTES) != hipSuccess) { fprintf(stderr, "kernel_launch: hipFuncSetAttribute failed\n"); grid = -1; return; }
        if (hipOccupancyMaxActiveBlocksPerMultiprocessor(&per_cu, (const void*)hyb_fwd, NWAVES * 64, LDS_BYTES) != hipSuccess || per_cu < 1) { fprintf(stderr, "kernel_launch: occupancy query reports %d blocks per CU\n", per_cu); }
        (void)hipGetLastError();
        grid = cus;
    }
    if (grid < 0) return;
    if (hipMemsetAsync((char*)d_ws + WS_CTL, 0, CTL_ZERO_BYTES, stream) != hipSuccess) return;
    Args a{};
    for (int i = 0; i < 16; ++i) a.in[i] = (const float*)d_in[i];
    a.out = (float*)d_out; a.ws = (unsigned char*)d_ws;
    hipLaunchKernelGGL(hyb_fwd, dim3(grid), dim3(NWAVES * 64), LDS_BYTES, stream, a);
}
```

```cpp
#include <hip/hip_runtime.h>
#include <cstdio>
#include <cstdint>
#include <cmath>
__device__ __forceinline__ int lane_id_v() { unsigned z; asm volatile("v_mov_b32 %0, 0" : "=v"(z)); return (int)__builtin_amdgcn_mbcnt_hi(~0u, __builtin_amdgcn_mbcnt_lo(~0u, z)); }
template <int MASK> __device__ __forceinline__ float sx(float v) { static_assert(MASK < 32, "swizzle xor mask"); return __builtin_bit_cast(float, __builtin_amdgcn_ds_swizzle(__builtin_bit_cast(int, v), 0x1F | (MASK << 10))); }
template <int MASK> __device__ __forceinline__ unsigned sxu(unsigned v) { return (unsigned)__builtin_amdgcn_ds_swizzle((int)v, 0x1F | (MASK << 10)); }
__device__ __forceinline__ void swap32(unsigned x, unsigned& lo_view, unsigned& hi_view) {
    unsigned a = x, b = x; asm volatile("" : "+v"(b));
    const auto rr = __builtin_amdgcn_permlane32_swap(a, b, false, false);
    lo_view = rr[0]; hi_view = rr[1];
}
template <int CTRL> __device__ __forceinline__ float dpp_f(float v) { return __builtin_bit_cast(float, __builtin_amdgcn_update_dpp(0, __builtin_bit_cast(int, v), CTRL, 0xF, 0xF, false)); }
template <int CTRL> __device__ __forceinline__ int dpp_i(int v) { return __builtin_amdgcn_update_dpp(0, v, CTRL, 0xF, 0xF, false); }
__device__ __forceinline__ float rl_f(float v, int l) { return __builtin_bit_cast(float, __builtin_amdgcn_readlane(__builtin_bit_cast(int, v), l)); }
__device__ __forceinline__ float wave_sum(float v) {
    v += dpp_f<0xB1>(v); v += dpp_f<0x4E>(v); v += dpp_f<0x141>(v); v += dpp_f<0x140>(v);
    return (rl_f(v, 0) + rl_f(v, 16)) + (rl_f(v, 32) + rl_f(v, 48));
}
__device__ __forceinline__ float wave_max(float v) {
    v = fmaxf(v, dpp_f<0xB1>(v)); v = fmaxf(v, dpp_f<0x4E>(v)); v = fmaxf(v, dpp_f<0x141>(v)); v = fmaxf(v, dpp_f<0x140>(v));
    return fmaxf(fmaxf(rl_f(v, 0), rl_f(v, 16)), fmaxf(rl_f(v, 32), rl_f(v, 48)));
}
__device__ __forceinline__ int wave_isum(int v) {
    v += dpp_i<0xB1>(v); v += dpp_i<0x4E>(v); v += dpp_i<0x141>(v); v += dpp_i<0x140>(v);
    return (__builtin_amdgcn_readlane(v, 0) + __builtin_amdgcn_readlane(v, 16)) + (__builtin_amdgcn_readlane(v, 32) + __builtin_amdgcn_readlane(v, 48));
}
__device__ __forceinline__ unsigned wave_umax(unsigned v) {
    unsigned t; t = (unsigned)dpp_i<0xB1>((int)v); v = t > v ? t : v; t = (unsigned)dpp_i<0x4E>((int)v); v = t > v ? t : v; t = (unsigned)dpp_i<0x141>((int)v); v = t > v ? t : v; t = (unsigned)dpp_i<0x140>((int)v); v = t > v ? t : v;
    const unsigned a = (unsigned)__builtin_amdgcn_readlane((int)v, 0), b = (unsigned)__builtin_amdgcn_readlane((int)v, 16), c = (unsigned)__builtin_amdgcn_readlane((int)v, 32), d = (unsigned)__builtin_amdgcn_readlane((int)v, 48);
    const unsigned ab = a > b ? a : b, cd = c > d ? c : d; return ab > cd ? ab : cd;
}
__device__ __forceinline__ unsigned wave_umin(unsigned v) { return ~wave_umax(~v); }
__device__ __forceinline__ float half_sum(float v) {
    unsigned a, b; swap32(__builtin_bit_cast(unsigned, v), a, b); return __builtin_bit_cast(float, a) + __builtin_bit_cast(float, b);
}
__device__ __forceinline__ float half_max(float v) {
    unsigned a, b; swap32(__builtin_bit_cast(unsigned, v), a, b); return fmaxf(__builtin_bit_cast(float, a), __builtin_bit_cast(float, b));
}
namespace pg8 {
#define PG8_LAS __attribute__((address_space(3)))
typedef unsigned short bf16_t;
typedef PG8_LAS float PG8_LAS_F;
typedef short bf16x8 __attribute__((ext_vector_type(8)));
typedef float f32x4 __attribute__((ext_vector_type(4)));
typedef unsigned u32x4 __attribute__((ext_vector_type(4)));
constexpr int BM = 256, BK = 64, HALF = 128, HTB = HALF * BK * 2  , STAGE_BYTES = 8 * HTB, NXCD = 8, WGM = 8;

__host__ __device__ __forceinline__ int lds_byte(int r, int c) { const int st = (r >> 4) * 2 + (c >> 5), rr = r & 15, cc = c & 31, ob = rr * 64 + cc * 2; return st * 1024 + (ob ^ (((ob >> 9) & 1) << 5)); }
__host__ __device__ __forceinline__ void stage_rc(int b, int& R, int& C) { const int st = b / 1024, sb = b % 1024, swz = sb ^ (((sb >> 9) & 1) << 5); R = (st >> 1) * 16 + swz / 64; C = (st & 1) * 32 + (swz % 64) / 2; }
__host__ __device__ __forceinline__ int perm32(int rho) { const int n = rho >> 4, i = rho & 15; return 8 * (i >> 2) + 4 * n + (i & 3); }

struct Unit { int pm, pn; };
struct Gemm { const bf16_t* A; const bf16_t* Bt; int M, N, K, lda, ldb, tsA; };

struct StaticOrder {
    int nM, nN, nwg, G, c;
    __host__ __device__ void init(int M, int N, int G_, int c_) { nM = M / BM; nN = N / BM; nwg = nM * nN; G = G_; c = c_; }
    __host__ __device__ bool next(int i, Unit& u) const {
        const long L = (long)i * G + c; if (L >= nwg) return false;
        int wgid = (int)L; { const int q = nwg / NXCD, r = nwg % NXCD, xcd = wgid % NXCD, off = wgid / NXCD; wgid = (xcd < r ? xcd * (q + 1) : r * (q + 1) + (xcd - r) * q) + off; }
        const int nig = WGM * nN, gid = wgid / nig, fm = gid * WGM, gsz = (nM - fm) < WGM ? (nM - fm) : WGM;
        u.pm = fm + ((wgid % nig) % gsz); u.pn = (wgid % nig) / gsz; return true;
    }
    __device__ __forceinline__ void a_ready(const Unit&) const {}
    __device__ __forceinline__ void done(const Unit&) const {}
};

__device__ __forceinline__ unsigned cvt_pk_bf16(float lo, float hi) { unsigned r; asm volatile("v_cvt_pk_bf16_f32 %0, %1, %2" : "=v"(r) : "v"(lo), "v"(hi)); return r; }
__device__ __forceinline__ float bflo(unsigned w) { return __builtin_bit_cast(float, w << 16); }
__device__ __forceinline__ float bfhi(unsigned w) { return __builtin_bit_cast(float, w & 0xffff0000u); }
__device__ __forceinline__ float sigmoidf_(float x) { return __builtin_amdgcn_rcpf(1.0f + __builtin_amdgcn_exp2f(-1.4426950408889634f * x)); }

constexpr int ZP = 6656;
constexpr int ZSP = 512;
constexpr int NZT = 26, GATE_T0 = 14, Z_GATE = 3584;
typedef unsigned u32x2 __attribute__((ext_vector_type(2)));

#define PRELOAD_RSTD(rsv, RT_, pmt_, SS_, u_, row0_, wr_, fr_) float rsv[2][4]; \
    if ((u_).pm == (pmt_)) { _Pragma("unroll") for (int ai_ = 0; ai_ < 2; ++ai_) _Pragma("unroll") for (int m_ = 0; m_ < 4; ++m_) rsv[ai_][m_] = (RT_)[(wr_) * 64 + (fr_) + ai_ * HALF + m_ * 16]; } \
    else { f32x4 s_[2][4]; _Pragma("unroll") for (int ai_ = 0; ai_ < 2; ++ai_) _Pragma("unroll") for (int m_ = 0; m_ < 4; ++m_) s_[ai_][m_] = *(const f32x4*)((SS_) + (size_t)((row0_) + ai_ * HALF + m_ * 16) * 4); \
    _Pragma("unroll") for (int ai_ = 0; ai_ < 2; ++ai_) _Pragma("unroll") for (int m_ = 0; m_ < 4; ++m_) rsv[ai_][m_] = 1.0f / __builtin_sqrtf(((s_[ai_][m_][0] + s_[ai_][m_][1]) + (s_[ai_][m_][2] + s_[ai_][m_][3])) * (1.0f / 1024.0f) + 1e-6f); }
__device__ __forceinline__ int rstd_table(PG8_LAS float* RT, const float* SS, const StaticOrder& S, int wave_id) {
    Unit u0; if (!S.next(0, u0)) return -1;
    const int t = (wave_id << 6) | lane_id_v();
    if (t < 256) { const f32x4 s = *(const f32x4*)(SS + (size_t)(u0.pm * BM + t) * 4); RT[t] = 1.0f / __builtin_sqrtf(((s[0] + s[1]) + (s[2] + s[3])) * (1.0f / 1024.0f) + 1e-6f); }
    __syncthreads();
    return u0.pm;
}
struct EpiZ {
    static constexpr bool PERM = true, AFTER_DRAIN = false, MID = false;
    bf16_t* Z; float* ZS; const float* SS; const float* GQ; const float* GK; const float* GD; const float* R64; const PG8_LAS float* RT; int pmt;
    __device__ __forceinline__ void operator()(const f32x4 (&acc)[2][2][4][2], const Unit& u, int wr, int wc, int fr, int fq) const {
        const int row0 = u.pm * BM + wr * 64 + fr;
        PRELOAD_RSTD(rsv, RT, pmt, SS, u, row0, wr, fr);
        if (u.pn < 4 || u.pn == 6 || u.pn == 7) {
            const float osc = (u.pn < 4) ? 0.18033688011112042f : 1.0f; const bool rope = (u.pn == 2 || u.pn == 3);
            f32x4 g00, g01, g10, g11;
            if (u.pn < 2) { g00 = *(const f32x4*)(GQ + 8 * fq); g01 = *(const f32x4*)(GQ + 8 * fq + 4); g10 = *(const f32x4*)(GQ + 32 + 8 * fq); g11 = *(const f32x4*)(GQ + 32 + 8 * fq + 4); }
            else if (u.pn < 4) { g00 = *(const f32x4*)(GD + 8 * fq); g01 = *(const f32x4*)(GD + 8 * fq + 4); g10 = *(const f32x4*)(GD + 32 + 8 * fq); g11 = *(const f32x4*)(GD + 32 + 8 * fq + 4); }
            else { g00 = *(const f32x4*)(GK + 8 * fq); g01 = *(const f32x4*)(GK + 8 * fq + 4); g10 = *(const f32x4*)(GK + 32 + 8 * fq); g11 = *(const f32x4*)(GK + 32 + 8 * fq + 4); }
            const int colo = u.pn * BM + wc * 64 + 8 * fq;
#pragma unroll
            for (int ai = 0; ai < 2; ++ai)
#pragma unroll
                for (int m = 0; m < 4; ++m) { const int row = row0 + ai * HALF + m * 16; const float rs = rsv[ai][m];
                    f32x4 a0 = acc[ai][0][m][0] * rs, a1 = acc[ai][0][m][1] * rs, b0 = acc[ai][1][m][0] * rs, b1 = acc[ai][1][m][1] * rs;
                    float ss = ((a0[0] * a0[0] + a0[1] * a0[1]) + (a0[2] * a0[2] + a0[3] * a0[3])) + ((a1[0] * a1[0] + a1[1] * a1[1]) + (a1[2] * a1[2] + a1[3] * a1[3]))
                             + ((b0[0] * b0[0] + b0[1] * b0[1]) + (b0[2] * b0[2] + b0[3] * b0[3])) + ((b1[0] * b1[0] + b1[1] * b1[1]) + (b1[2] * b1[2] + b1[3] * b1[3]));
                    ss += sx<16>(ss); { unsigned x_, y_; swap32(__builtin_bit_cast(unsigned, ss), x_, y_); ss = __builtin_bit_cast(float, x_) + __builtin_bit_cast(float, y_); }
                    const float hr = osc / __builtin_sqrtf(ss * (1.0f / 64.0f) + 1e-6f);
                    a0 = a0 * g00 * hr; a1 = a1 * g01 * hr; b0 = b0 * g10 * hr; b1 = b1 * g11 * hr;
                    if (rope) { const float* cs = R64 + ((size_t)(row & 4095) * 32 + 8 * fq) * 2;
                        const f32x4 c0 = *(const f32x4*)cs, c1 = *(const f32x4*)(cs + 4), c2 = *(const f32x4*)(cs + 8), c3 = *(const f32x4*)(cs + 12);
                        f32x4 x0, x1, y0, y1;
                        x0[0] = a0[0] * c0[0] - b0[0] * c0[1]; y0[0] = b0[0] * c0[0] + a0[0] * c0[1]; x0[1] = a0[1] * c0[2] - b0[1] * c0[3]; y0[1] = b0[1] * c0[2] + a0[1] * c0[3];
                        x0[2] = a0[2] * c1[0] - b0[2] * c1[1]; y0[2] = b0[2] * c1[0] + a0[2] * c1[1]; x0[3] = a0[3] * c1[2] - b0[3] * c1[3]; y0[3] = b0[3] * c1[2] + a0[3] * c1[3];
                        x1[0] = a1[0] * c2[0] - b1[0] * c2[1]; y1[0] = b1[0] * c2[0] + a1[0] * c2[1]; x1[1] = a1[1] * c2[2] - b1[1] * c2[3]; y1[1] = b1[1] * c2[2] + a1[1] * c2[3];
                        x1[2] = a1[2] * c3[0] - b1[2] * c3[1]; y1[2] = b1[2] * c3[0] + a1[2] * c3[1]; x1[3] = a1[3] * c3[2] - b1[3] * c3[3]; y1[3] = b1[3] * c3[2] + a1[3] * c3[3];
                        a0 = x0; a1 = x1; b0 = y0; b1 = y1; }
                    bf16_t* rowp = Z + (size_t)row * ZP + colo;
                    u32x4 w; w.x = cvt_pk_bf16(a0[0], a0[1]); w.y = cvt_pk_bf16(a0[2], a0[3]); w.z = cvt_pk_bf16(a1[0], a1[1]); w.w = cvt_pk_bf16(a1[2], a1[3]); *(u32x4*)rowp = w;
                    w.x = cvt_pk_bf16(b0[0], b0[1]); w.y = cvt_pk_bf16(b0[2], b0[3]); w.z = cvt_pk_bf16(b1[0], b1[1]); w.w = cvt_pk_bf16(b1[2], b1[3]); *(u32x4*)(rowp + 32) = w;
                    __builtin_amdgcn_sched_barrier(0); }
        } else if (u.pn >= GATE_T0 && u.pn < NZT) {
            unsigned char* gb = (unsigned char*)(Z + Z_GATE) + (u.pn - GATE_T0) * 256 + wc * 32 + 8 * fq;
#pragma unroll
            for (int ai = 0; ai < 2; ++ai)
#pragma unroll
                for (int m = 0; m < 4; ++m) { const float rs = rsv[ai][m]; unsigned char* rowp = gb + (size_t)(row0 + ai * HALF + m * 16) * (ZP * 2);
#pragma unroll
                    for (int bj = 0; bj < 2; ++bj) { const f32x4 v0 = acc[ai][bj][m][0] * rs, v1 = acc[ai][bj][m][1] * rs; u32x2 w = {0u, 0u};
#pragma unroll
                        for (int i = 0; i < 4; ++i) { w.x = __builtin_amdgcn_cvt_pk_u8_f32(__builtin_fmaxf(255.0f * sigmoidf_(v0[i]), 1.0f), i, w.x); w.y = __builtin_amdgcn_cvt_pk_u8_f32(__builtin_fmaxf(255.0f * sigmoidf_(v1[i]), 1.0f), i, w.y); }
                        *(u32x2*)(rowp + bj * HALF) = w; } }
        } else if (u.pn < NZT) {
            const int col0 = u.pn * BM + wc * 32 + 8 * fq;
#pragma unroll
            for (int ai = 0; ai < 2; ++ai)
#pragma unroll
                for (int m = 0; m < 4; ++m) { bf16_t* rowp = Z + (size_t)(row0 + ai * HALF + m * 16) * ZP + col0; const float rs = rsv[ai][m];
#pragma unroll
                    for (int bj = 0; bj < 2; ++bj) { const f32x4 v0 = acc[ai][bj][m][0] * rs, v1 = acc[ai][bj][m][1] * rs;
                        u32x4 w; w.x = cvt_pk_bf16(v0[0], v0[1]); w.y = cvt_pk_bf16(v0[2], v0[3]); w.z = cvt_pk_bf16(v1[0], v1[1]); w.w = cvt_pk_bf16(v1[2], v1[3]);
                        *(u32x4*)(rowp + bj * HALF) = w; } }
        } else {
            const int col0 = (u.pn - NZT) * BM + wc * 32 + 8 * fq;
#pragma unroll
            for (int ai = 0; ai < 2; ++ai)
#pragma unroll
                for (int m = 0; m < 4; ++m) { float* rowp = ZS + (size_t)(row0 + ai * HALF + m * 16) * ZSP + col0; const float rs = rsv[ai][m];
#pragma unroll
                    for (int bj = 0; bj < 2; ++bj) { *(f32x4*)(rowp + bj * HALF) = acc[ai][bj][m][0] * rs; *(f32x4*)(rowp + bj * HALF + 4) = acc[ai][bj][m][1] * rs; } }
        }
    }
};

template <int P> struct EpiGate {
    static constexpr bool PERM = true, AFTER_DRAIN = false, MID = false;
    const bf16_t* G;
    float* M32;
    bf16_t* OUT;
    __device__ __forceinline__ void operator()(const f32x4 (&acc)[2][2][4][2], const Unit& u, int wr, int wc, int fr, int fq) const {
        const int row0 = u.pm * BM + wr * 64 + fr, col0 = u.pn * BM + wc * 32 + 8 * fq;
#pragma unroll
        for (int ai = 0; ai < 2; ++ai)
#pragma unroll
            for (int m = 0; m < 4; ++m) { const size_t row = (size_t)(row0 + ai * HALF + m * 16);
#pragma unroll
                for (int bj = 0; bj < 2; ++bj) { const int col = col0 + bj * HALF;
                    const u32x4 gw = *(const u32x4*)(G + row * ZP + P * 1024 + col);
                    const f32x4 v0 = acc[ai][bj][m][0], v1 = acc[ai][bj][m][1];
                    f32x4 t0, t1;
                    t0[0] = bflo(gw.x) * v0[0]; t0[1] = bfhi(gw.x) * v0[1]; t0[2] = bflo(gw.y) * v0[2]; t0[3] = bfhi(gw.y) * v0[3];
                    t1[0] = bflo(gw.z) * v1[0]; t1[1] = bfhi(gw.z) * v1[1]; t1[2] = bflo(gw.w) * v1[2]; t1[3] = bfhi(gw.w) * v1[3];
                    float* mp = M32 + row * 1024 + col;
                    if (P == 0) { *(f32x4*)mp = t0; *(f32x4*)(mp + 4) = t1; }
                    else if (P == 1) { *(f32x4*)mp = *(const f32x4*)mp + t0; *(f32x4*)(mp + 4) = *(const f32x4*)(mp + 4) + t1; }
                    else { t0 = *(const f32x4*)mp + t0; t1 = *(const f32x4*)(mp + 4) + t1;
                        u32x4 w; w.x = cvt_pk_bf16(t0[0], t0[1]); w.y = cvt_pk_bf16(t0[2], t0[3]); w.z = cvt_pk_bf16(t1[0], t1[1]); w.w = cvt_pk_bf16(t1[2], t1[3]);
                        *(u32x4*)(OUT + row * ZP + col) = w; } } }
    }
};

struct EpiGateF {
    static constexpr bool PERM = true, AFTER_DRAIN = false, MID = true;
    const unsigned char* G; bf16_t* OUT;
    __device__ __forceinline__ void mid(f32x4 (&acc)[2][2][4][2], const Unit& u, int wr, int wc, int fr_, int fq_, int s) const {
        int fr = fr_, fq = fq_; asm volatile("" : "+v"(fr), "+v"(fq));
        const int row0 = u.pm * BM + wr * 64 + fr, col0 = u.pn * BM + wc * 32 + 8 * fq;
        u32x2 ga[2][4][2], gb[2][4][2];
#pragma unroll
        for (int ai = 0; ai < 2; ++ai)
#pragma unroll
            for (int m = 0; m < 4; ++m)
#pragma unroll
                for (int bj = 0; bj < 2; ++bj) { const unsigned char* gp = G + (size_t)(row0 + ai * HALF + m * 16) * (ZP * 2) + s * 1024 + col0 + bj * HALF; ga[ai][m][bj] = *(const u32x2*)gp; gb[ai][m][bj] = *(const u32x2*)(gp + 1024); }
#pragma unroll
        for (int ai = 0; ai < 2; ++ai)
#pragma unroll
            for (int m = 0; m < 4; ++m)
#pragma unroll
                for (int bj = 0; bj < 2; ++bj) { const u32x2 a = ga[ai][m][bj], b = gb[ai][m][bj]; f32x4 r0, r1;
                    r0[0] = (float)(a.x & 255u) * __builtin_amdgcn_rcpf((float)(b.x & 255u)); r0[1] = (float)((a.x >> 8) & 255u) * __builtin_amdgcn_rcpf((float)((b.x >> 8) & 255u));
                    r0[2] = (float)((a.x >> 16) & 255u) * __builtin_amdgcn_rcpf((float)((b.x >> 16) & 255u)); r0[3] = (float)(a.x >> 24) * __builtin_amdgcn_rcpf((float)(b.x >> 24));
                    r1[0] = (float)(a.y & 255u) * __builtin_amdgcn_rcpf((float)(b.y & 255u)); r1[1] = (float)((a.y >> 8) & 255u) * __builtin_amdgcn_rcpf((float)((b.y >> 8) & 255u));
                    r1[2] = (float)((a.y >> 16) & 255u) * __builtin_amdgcn_rcpf((float)((b.y >> 16) & 255u)); r1[3] = (float)(a.y >> 24) * __builtin_amdgcn_rcpf((float)(b.y >> 24));
                    acc[ai][bj][m][0] = acc[ai][bj][m][0] * r0; acc[ai][bj][m][1] = acc[ai][bj][m][1] * r1; }
    }
    __device__ __forceinline__ void operator()(const f32x4 (&acc)[2][2][4][2], const Unit& u, int wr, int wc, int fr, int fq) const {
        const int row0 = u.pm * BM + wr * 64 + fr, col0 = u.pn * BM + wc * 32 + 8 * fq; const float k255 = 1.0f / 255.0f;
#pragma unroll
        for (int ai = 0; ai < 2; ++ai)
#pragma unroll
            for (int m = 0; m < 4; ++m) { const size_t row = (size_t)(row0 + ai * HALF + m * 16);
#pragma unroll
                for (int bj = 0; bj < 2; ++bj) { const int col = col0 + bj * HALF;
                    const u32x2 gw = *(const u32x2*)(G + row * (ZP * 2) + 2 * 1024 + col);
                    const f32x4 v0 = acc[ai][bj][m][0] * k255, v1 = acc[ai][bj][m][1] * k255;
                    u32x4 w; w.x = cvt_pk_bf16((float)(gw.x & 255u) * v0[0], (float)((gw.x >> 8) & 255u) * v0[1]); w.y = cvt_pk_bf16((float)((gw.x >> 16) & 255u) * v0[2], (float)(gw.x >> 24) * v0[3]);
                    w.z = cvt_pk_bf16((float)(gw.y & 255u) * v1[0], (float)((gw.y >> 8) & 255u) * v1[1]); w.w = cvt_pk_bf16((float)((gw.y >> 16) & 255u) * v1[2], (float)(gw.y >> 24) * v1[3]);
                    *(u32x4*)(OUT + row * ZP + col) = w; } }
    }
};

struct EpiRes {
    static constexpr bool PERM = true, AFTER_DRAIN = true, MID = false;
    const bf16_t* RES; bf16_t* OUT; float* OUT32; float* SS;
    __device__ __forceinline__ void fused(const f32x4 (&acc)[2][2][4][2], const Unit& u, int wr, int wc, int fr, int fq, PG8_LAS unsigned char* lds, int wid, int lane) const {
        const int row0 = u.pm * BM + wr * 64 + fr, col0 = u.pn * BM + wc * 32 + 8 * fq;
        PG8_LAS float* P = (PG8_LAS float*)lds;
#pragma unroll
        for (int ai = 0; ai < 2; ++ai)
#pragma unroll
            for (int m = 0; m < 4; ++m) { const int row = row0 + ai * HALF + m * 16; const size_t off = (size_t)row * 1024 + col0; float ss = 0.f;
#pragma unroll
                for (int bj = 0; bj < 2; ++bj) { const u32x4 r = *(const u32x4*)(RES + off + bj * HALF);
                    f32x4 v0 = acc[ai][bj][m][0], v1 = acc[ai][bj][m][1];
                    v0[0] += bflo(r.x); v0[1] += bfhi(r.x); v0[2] += bflo(r.y); v0[3] += bfhi(r.y); v1[0] += bflo(r.z); v1[1] += bfhi(r.z); v1[2] += bflo(r.w); v1[3] += bfhi(r.w);
                    ss += ((v0[0] * v0[0] + v0[1] * v0[1]) + (v0[2] * v0[2] + v0[3] * v0[3])) + ((v1[0] * v1[0] + v1[1] * v1[1]) + (v1[2] * v1[2] + v1[3] * v1[3]));
                    if (OUT32) { float* op = OUT32 + off + bj * HALF; *(f32x4*)op = v0; *(f32x4*)(op + 4) = v1; }
                    else { u32x4 w; w.x = cvt_pk_bf16(v0[0], v0[1]); w.y = cvt_pk_bf16(v0[2], v0[3]); w.z = cvt_pk_bf16(v1[0], v1[1]); w.w = cvt_pk_bf16(v1[2], v1[3]); *(u32x4*)(OUT + off + bj * HALF) = w; } }
                ss += sx<16>(ss); { unsigned a, b; swap32(__builtin_bit_cast(unsigned, ss), a, b); ss = __builtin_bit_cast(float, a) + __builtin_bit_cast(float, b); }
                if (fq == 0) P[(ai * HALF + wr * 64 + m * 16 + fr) * 4 + wc] = ss; }
        asm volatile("s_waitcnt lgkmcnt(0)\n\ts_barrier" ::: "memory");
        const int t = wid * 64 + lane;
        if (t < 256) { const f32x4 p = *(const PG8_LAS f32x4*)(P + t * 4); SS[(size_t)(u.pm * BM + t) * 4 + u.pn] = (p[0] + p[1]) + (p[2] + p[3]); }
    }
};

struct EpiSwi {
    static constexpr bool PERM = true, AFTER_DRAIN = false, MID = false;
    bf16_t* H; int ldh; int tsH; const float* SS; const PG8_LAS float* RT; int pmt;
    __device__ __forceinline__ void operator()(const f32x4 (&acc)[2][2][4][2], const Unit& u, int wr, int wc, int fr, int fq) const {
        const int row0 = u.pm * BM + wr * 64 + fr, col0 = u.pn * HALF + wc * 32 + 8 * fq;
        PRELOAD_RSTD(rsv, RT, pmt, SS, u, row0, wr, fr);
#pragma unroll
        for (int ai = 0; ai < 2; ++ai)
#pragma unroll
            for (int m = 0; m < 4; ++m) { bf16_t* hp = H + (size_t)u.pm * tsH + (size_t)(wr * 64 + fr + ai * HALF + m * 16) * ldh + col0; const float rs = rsv[ai][m];
                float o[8];
#pragma unroll
                for (int n = 0; n < 2; ++n)
#pragma unroll
                    for (int i = 0; i < 4; ++i) { const float g = acc[ai][0][m][n][i] * rs, up = acc[ai][1][m][n][i] * rs; o[4 * n + i] = g * sigmoidf_(g) * up; }
                u32x4 w; w.x = cvt_pk_bf16(o[0], o[1]); w.y = cvt_pk_bf16(o[2], o[3]); w.z = cvt_pk_bf16(o[4], o[5]); w.w = cvt_pk_bf16(o[6], o[7]);
                *(u32x4*)hp = w; }
    }
};

template <class Epi, class Sched, bool ALIGN_EPI = false, bool SP2 = false>
__device__ __forceinline__ void gemm_phase(PG8_LAS unsigned char* lds, Gemm g, const Sched& S0, const Epi& E, int wave_id) {
    int ovz, osz; asm volatile("v_mov_b32 %0, 0\n\ts_mov_b32 %1, 0" : "=v"(ovz), "=s"(osz));
    Sched S = S0; S.c += osz; g.lda += osz; g.ldb += osz; g.tsA += osz;
    const int tid = ((wave_id << 6) | lane_id_v()) + ovz,
         wid = __builtin_amdgcn_readfirstlane(tid >> 6), lane = tid & 63, wr = wid >> 2, wc = wid & 3, fr = lane & 15, fq = lane >> 4;
    const int K = g.K, nt = K / BK;
    unsigned voffA[2], voffB[2];
#pragma unroll
    for (int i = 0; i < 2; ++i) { int R, C; stage_rc(tid * 16 + i * 8192, R, C); const int Rb = Epi::PERM ? ((R & ~31) + perm32(R & 31)) : R;
        voffA[i] = (unsigned)(R * g.lda + C) * 2u; voffB[i] = (unsigned)(Rb * g.ldb + C) * 2u; }
    const size_t kstep = (size_t)(BK * 2);
    const size_t hstepA = (size_t)HALF * g.lda * 2, hstepB = (size_t)HALF * g.ldb * 2;
    const size_t tstepA = (size_t)g.tsA * 2, tstepB = 2 * hstepB;
    const unsigned ldsw = (unsigned)wid * 1024u;
    const int aoff = lds_byte(wr * 64 + fr, fq * 8), boff = lds_byte(wc * 32 + fr, fq * 8);
#define PG8_SA(b, h) (((b) * 2 + (h)) * HTB)
#define PG8_SB(b, h) ((4 + (b) * 2 + (h)) * HTB)
#define PG8_STAGE(bufoff, gbase, voff) do { _Pragma("unroll") for (int _i = 0; _i < 2; ++_i) \
        __builtin_amdgcn_global_load_lds((const unsigned*)((const char*)(gbase) + (voff)[_i]), (PG8_LAS unsigned*)(lds + (bufoff) + ldsw + _i * 8192), 16, 0, 0); } while (0)
#define PG8_LDA(dst, b, h) do { _Pragma("unroll") for (int m = 0; m < 4; ++m) _Pragma("unroll") for (int k = 0; k < 2; ++k) dst[m][k] = *(const PG8_LAS bf16x8*)(lds + PG8_SA(b, h) + aoff + m * 2048 + k * 1024); } while (0)
#define PG8_LDB(dst, b, h) do { _Pragma("unroll") for (int n = 0; n < 2; ++n) _Pragma("unroll") for (int k = 0; k < 2; ++k) dst[n][k] = *(const PG8_LAS bf16x8*)(lds + PG8_SB(b, h) + boff + n * 2048 + k * 1024); } while (0)
#define PG8_MMA(ai, bj, At, Bt) do { __builtin_amdgcn_s_setprio(1); _Pragma("unroll") for (int m = 0; m < 4; ++m) _Pragma("unroll") for (int n = 0; n < 2; ++n) _Pragma("unroll") for (int k = 0; k < 2; ++k) \
        acc[ai][bj][m][n] = __builtin_amdgcn_mfma_f32_16x16x32_bf16(Bt[n][k], At[m][k], acc[ai][bj][m][n], 0, 0, 0); __builtin_amdgcn_s_setprio(0); } while (0)
#define PG8_WAIT_V(n) asm volatile("s_waitcnt vmcnt(" #n ")" ::: "memory")
#define PG8_WAIT_L(n) asm volatile("s_waitcnt lgkmcnt(" #n ")" ::: "memory")
#define PG8_BAR __builtin_amdgcn_s_barrier()
#define PG8_SCHED __builtin_amdgcn_sched_barrier(0)
    Unit cur, nxt; int ui = 0;
    if (!S.next(0, cur)) return;
    f32x4 acc[2][2][4][2];
#pragma unroll
    for (int a = 0; a < 2; ++a)
#pragma unroll
        for (int b = 0; b < 2; ++b)
#pragma unroll
            for (int m = 0; m < 4; ++m)
#pragma unroll
                for (int n = 0; n < 2; ++n) acc[a][b][m][n] = (f32x4){0.f, 0.f, 0.f, 0.f};
    bf16x8 At[4][2], B0[2][2], B1[2][2];
    const char* cA = (const char*)g.A + (size_t)cur.pm * tstepA; const char* cB = (const char*)g.Bt + (size_t)cur.pn * tstepB;
    S.a_ready(cur);
    if constexpr (SP2) {
        PG8_STAGE(PG8_SB(0, 0), cB, voffB); PG8_STAGE(PG8_SB(0, 1), cB + hstepB, voffB); PG8_STAGE(PG8_SA(0, 0), cA, voffA); PG8_STAGE(PG8_SA(0, 1), cA + hstepA, voffA);
        if (wr == 1) PG8_BAR;
        PG8_WAIT_V(2); PG8_BAR;
        PG8_STAGE(PG8_SB(1, 0), cB + kstep, voffB); PG8_STAGE(PG8_SA(1, 0), cA + kstep, voffA); PG8_STAGE(PG8_SB(1, 1), cB + hstepB + kstep, voffB);
        PG8_WAIT_V(6); PG8_BAR;
    } else {
        PG8_STAGE(PG8_SB(0, 0), cB, voffB); PG8_STAGE(PG8_SA(0, 0), cA, voffA); PG8_STAGE(PG8_SB(0, 1), cB + hstepB, voffB); PG8_STAGE(PG8_SA(0, 1), cA + hstepA, voffA);
        if (wr == 1) PG8_BAR;
        PG8_WAIT_V(4); PG8_BAR;
        PG8_STAGE(PG8_SB(1, 0), cB + kstep, voffB); PG8_STAGE(PG8_SA(1, 0), cA + kstep, voffA); PG8_STAGE(PG8_SB(1, 1), cB + hstepB + kstep, voffB);
        PG8_WAIT_V(6); PG8_BAR;
    }
    for (;;) {
        const bool has_next = S.next(ui + 1, nxt);
        const char* nA = has_next ? (const char*)g.A + (size_t)nxt.pm * tstepA : cA; const char* nB = has_next ? (const char*)g.Bt + (size_t)nxt.pn * tstepB : cB;
        for (int t = 0; t < nt; t += 2) {
            if constexpr (Epi::MID) { if (t == 8 || t == 16) E.mid(acc, cur, wr, wc, fr, fq, (t >> 3) - 1); }
            const bool last = (t == nt - 2);
            const char* a1 = cA + (size_t)(t + 1) * kstep;
            const char* a2 = last ? nA : cA + (size_t)(t + 2) * kstep; const char* b2 = last ? nB : cB + (size_t)(t + 2) * kstep;
            const char* a3 = a2 + kstep; const char* b3 = b2 + kstep;
            if (last && has_next) S.a_ready(nxt);
            if constexpr (SP2) {
            PG8_LDB(B0, 0, 0); PG8_LDB(B1, 0, 1); PG8_SCHED; PG8_LDA(At, 0, 0); PG8_STAGE(PG8_SA(1, 1), a1 + hstepA, voffA);
            PG8_WAIT_V(8); PG8_WAIT_L(0); PG8_BAR; PG8_MMA(0, 0, At, B0); PG8_MMA(0, 1, At, B1); PG8_BAR; PG8_SCHED;
            PG8_LDA(At, 0, 1); PG8_STAGE(PG8_SB(0, 0), b2, voffB); PG8_STAGE(PG8_SB(0, 1), b2 + hstepB, voffB); PG8_STAGE(PG8_SA(0, 0), a2, voffA);
            PG8_WAIT_V(8); PG8_WAIT_L(0); PG8_BAR; PG8_MMA(1, 0, At, B0); PG8_MMA(1, 1, At, B1); PG8_BAR; PG8_SCHED;
            PG8_LDB(B0, 1, 0); PG8_LDB(B1, 1, 1); PG8_SCHED; PG8_LDA(At, 1, 0); PG8_STAGE(PG8_SA(0, 1), a2 + hstepA, voffA);
            PG8_WAIT_V(8); PG8_WAIT_L(0); PG8_BAR; PG8_MMA(0, 0, At, B0); PG8_MMA(0, 1, At, B1); PG8_BAR; PG8_SCHED;
            PG8_LDA(At, 1, 1); PG8_STAGE(PG8_SB(1, 0), b3, voffB); PG8_STAGE(PG8_SB(1, 1), b3 + hstepB, voffB); PG8_STAGE(PG8_SA(1, 0), a3, voffA);
            PG8_WAIT_V(8); PG8_WAIT_L(0); PG8_BAR; PG8_MMA(1, 0, At, B0); PG8_MMA(1, 1, At, B1); PG8_BAR; PG8_SCHED;
            } else {
            PG8_LDB(B0, 0, 0); PG8_SCHED; PG8_LDA(At, 0, 0); PG8_STAGE(PG8_SA(1, 1), a1 + hstepA, voffA);
            PG8_WAIT_L(8); PG8_BAR; PG8_WAIT_L(0); PG8_MMA(0, 0, At, B0); PG8_BAR; PG8_SCHED;
            PG8_LDB(B1, 0, 1); PG8_STAGE(PG8_SB(0, 0), b2, voffB);
            PG8_BAR; PG8_WAIT_L(0); PG8_MMA(0, 1, At, B1); PG8_BAR;
            PG8_LDA(At, 0, 1); PG8_STAGE(PG8_SA(0, 0), a2, voffA);
            PG8_BAR; PG8_WAIT_L(0); PG8_MMA(1, 0, At, B0); PG8_BAR; PG8_SCHED;
            PG8_STAGE(PG8_SB(0, 1), b2 + hstepB, voffB);
            PG8_WAIT_V(6); PG8_BAR; PG8_MMA(1, 1, At, B1); PG8_BAR;
            PG8_LDB(B0, 1, 0); PG8_SCHED; PG8_LDA(At, 1, 0); PG8_STAGE(PG8_SA(0, 1), a2 + hstepA, voffA);
            PG8_WAIT_L(8); PG8_BAR; PG8_WAIT_L(0); PG8_MMA(0, 0, At, B0); PG8_BAR; PG8_SCHED;
            PG8_LDB(B1, 1, 1); PG8_STAGE(PG8_SB(1, 0), b3, voffB);
            PG8_BAR; PG8_WAIT_L(0); PG8_MMA(0, 1, At, B1); PG8_BAR;
            PG8_LDA(At, 1, 1); PG8_STAGE(PG8_SA(1, 0), a3, voffA);
            PG8_BAR; PG8_WAIT_L(0); PG8_MMA(1, 0, At, B0); PG8_BAR; PG8_SCHED;
            PG8_STAGE(PG8_SB(1, 1), b3 + hstepB, voffB);
            PG8_WAIT_V(6); PG8_BAR; PG8_MMA(1, 1, At, B1); PG8_BAR;
            }
        }
        if constexpr (ALIGN_EPI) { if (wr == 0) PG8_BAR; }
        if constexpr (!Epi::AFTER_DRAIN) { E(acc, cur, wr, wc, fr, fq); S.done(cur); }
        if (!has_next) break;
#pragma unroll
        for (int a = 0; a < 2; ++a)
#pragma unroll
            for (int b = 0; b < 2; ++b)
#pragma unroll
                for (int m = 0; m < 4; ++m)
#pragma unroll
                    for (int n = 0; n < 2; ++n) acc[a][b][m][n] = (f32x4){0.f, 0.f, 0.f, 0.f};
        cur = nxt; cA = nA; cB = nB; ++ui;
        if constexpr (ALIGN_EPI) { if (wr == 1) PG8_BAR; }
    }
    PG8_WAIT_V(0);
    if constexpr (!ALIGN_EPI) { if (wr == 0) PG8_BAR; }
    PG8_BAR;
    if constexpr (Epi::AFTER_DRAIN) { E.fused(acc, cur, wr, wc, fr, fq, lds, wid, lane); S.done(cur); }
#undef PG8_SA
#undef PG8_SB
#undef PG8_STAGE
#undef PG8_LDA
#undef PG8_LDB
#undef PG8_MMA
#undef PG8_WAIT_V
#undef PG8_WAIT_L
#undef PG8_BAR
#undef PG8_SCHED
}
}

constexpr int NB = 4, SEQ = 4096, DM = 1024, DEPTH = 4, M = NB * SEQ;
constexpr int INC = 7088;
constexpr int NIN = 7168;
constexpr int FFH = 2816, FF2 = 5632;
constexpr int ZP = pg8::ZP, ZSP = pg8::ZSP;
constexpr int Z_FQ = 0, Z_DQ = 512, Z_RV = 1024, Z_FK = 1536, Z_FV = 2048,
     Z_RQ = 2560, Z_RK = 2816, Z_RG = 3072, Z_ZG = 3584, Z_MRG = 2560;
constexpr int S_IQ = 0, S_DK = 256, S_DV = 320, S_IK = 384, S_IW = 416, S_FF = 424;
constexpr float NORM_EPS = 1e-6f;
constexpr float LOG2E = 1.4426950408889634f;
constexpr float C2 = 0.125f * 1.4426950408889634f;

constexpr size_t MiB = 1u << 20;
constexpr size_t WS_CTL = 0, CTL_ZERO_BYTES = 1 * MiB;
constexpr size_t WS_ROPE64 = 1 * MiB;
constexpr size_t WS_ROPE32 = 2 * MiB;
constexpr size_t WS_LF = 2 * MiB + 512 * 1024;
constexpr size_t WS_CF = 3 * MiB;
constexpr size_t WS_ISG = 3 * MiB + 512 * 1024;
constexpr size_t WS_KD = 4 * MiB;
constexpr size_t WS_VD = 6 * MiB;
constexpr size_t WS_W = 8 * MiB;
constexpr size_t LW_IN = 0, LW_MIX = (size_t)NIN * 1024, LW_O = LW_MIX + 1536 * 1024, LW_FI = LW_O + 1024 * 1024, LW_FO = LW_FI + (size_t)FF2 * 1024, LW_STRIDE = LW_FO + (size_t)FFH * 1024;
constexpr size_t WS_Z = 150 * MiB;
constexpr size_t WS_HDN = 358 * MiB;
constexpr size_t WS_ZS = 390 * MiB;
constexpr size_t WS_IQB = 422 * MiB;
constexpr size_t WS_IKB = 430 * MiB;
constexpr size_t WS_SS = 431 * MiB;
constexpr size_t WS_END = 432 * MiB;
static_assert(WS_W + DEPTH * LW_STRIDE * 2 <= WS_Z && WS_Z + (size_t)M * ZP * 2 <= WS_HDN && WS_HDN + (size_t)M * 1024 * 2 == WS_ZS && WS_ZS + (size_t)M * ZSP * 4 == WS_IQB, "d_ws map");
constexpr int CW_BAR = 4096;

constexpr int RING_OFF = 0, RING_BYTES = 133120;
constexpr int LDSCTL_OFF = RING_BYTES, MISC_OFF = LDSCTL_OFF + 320;
constexpr int XTRA_OFF = RING_BYTES + 1024;
constexpr int LDS_BYTES = 147456;
constexpr int NWAVES = 8;
#define GAS __attribute__((address_space(1)))
#define LAS __attribute__((address_space(3)))
typedef unsigned short bf16;
typedef unsigned v4u __attribute__((ext_vector_type(4)));
typedef float f32x4 __attribute__((ext_vector_type(4)));
typedef short bf16x8 __attribute__((ext_vector_type(8)));
typedef GAS unsigned gu32;
typedef GAS unsigned long long gu64;
#define RLX_AGENT __ATOMIC_RELAXED, __HIP_MEMORY_SCOPE_AGENT
#define LDS_WAIT() asm volatile("s_waitcnt lgkmcnt(0)" ::: "memory")
#define VM_WAIT() asm volatile("s_waitcnt vmcnt(0)" ::: "memory")
__device__ __forceinline__ unsigned long long rt() { return __builtin_amdgcn_s_memrealtime(); }
__device__ __forceinline__ unsigned f2bf(float f) { unsigned u = __builtin_bit_cast(unsigned, f); return (u + 0x7fffu + ((u >> 16) & 1u)) >> 16; }
__device__ __forceinline__ unsigned pk2(float lo, float hi) { unsigned r; asm("v_cvt_pk_bf16_f32 %0, %1, %2" : "=v"(r) : "v"(lo), "v"(hi)); return r; }

#define XB_TMO      128
#define XB_XCNT(j)  (256  + 64 * (j))
#define XB_XSUB(j)  (1280 + 64 * (j))
#define XB_XGEN(j)  (2304 + 64 * (j))
#define XB_TOP      3328
#define XB_TOPGEN   3392
#define XCD_BAR_WORDS 3456
#define XB_LSUB(j)  (3456 + 64 * (j))
#define XB_LGEN(j)  (4480 + 64 * (j))
#define XB_SPIN_CAP (1u << 22)

__device__ __forceinline__ unsigned xb_ld(unsigned* p)              { return __hip_atomic_load(p, __ATOMIC_RELAXED, __HIP_MEMORY_SCOPE_AGENT); }
__device__ __forceinline__ unsigned xb_add(unsigned* p, unsigned v) { return __hip_atomic_fetch_add(p, v, __ATOMIC_RELAXED, __HIP_MEMORY_SCOPE_AGENT); }
__device__ __forceinline__ unsigned xb_xcc_id() { return (unsigned)__builtin_amdgcn_s_getreg((3 << 11) | 20) & 0xFu; }
#define XB_SPIN(cond, bar) do { unsigned _sp = 0; while (cond) { __builtin_amdgcn_s_sleep(1); \
    if ((++_sp & 255u) == 0u) { if (xb_ld(&(bar)[XB_TMO])) break; if (_sp > XB_SPIN_CAP) { atomicAdd(&(bar)[XB_TMO], 1u); break; } } } } while (0)

struct XcdBarrier {
    unsigned* bar; unsigned x; int w;
    volatile LAS unsigned* st;
};

__device__ __forceinline__ XcdBarrier xcd_barrier_post(unsigned* bar, volatile LAS unsigned* st) {
    XcdBarrier b; b.bar = bar; b.x = xb_xcc_id(); b.st = st; b.w = 0;
    if (threadIdx.x == 0) st[2] = xb_add(&bar[XB_XCNT(b.x)], 1u);
    return b;
}
__device__ __forceinline__ void xcd_barrier_complete(unsigned* bar, unsigned x, unsigned& nloc, unsigned& nx) {
    const unsigned G = gridDim.x * gridDim.y * gridDim.z;
    unsigned sum, cnt, mine, sp = 0u;
    for (;;) {
        sum = 0u; cnt = 0u; mine = 0u;
#pragma unroll
        for (unsigned j = 0; j < 16; ++j) { const unsigned c = xb_ld(&bar[XB_XCNT(j)]); sum += c; cnt += (c > 0u) ? 1u : 0u; mine = (j == x) ? c : mine; }
        if (sum == G) break;
        __builtin_amdgcn_s_sleep(1);
        if ((++sp & 255u) == 0u) { if (xb_ld(&bar[XB_TMO])) break; if (sp > XB_SPIN_CAP) { atomicAdd(&bar[XB_TMO], 1u); break; } }
    }
    nloc = mine > 0u ? mine : 1u; nx = cnt > 0u ? cnt : 1u;
}

__device__ __forceinline__ void xcd_barrier(const XcdBarrier& b) {
    asm volatile("s_waitcnt vmcnt(0)" ::: "memory");
    __syncthreads();
    if (b.w == 0 && lane_id_v() == 0) {
        unsigned* bar = b.bar;
        __builtin_amdgcn_s_waitcnt(0);
        unsigned nloc = b.st[0], nx = b.st[1];
        if (nloc == 0u) { xcd_barrier_complete(bar, b.x, nloc, nx); b.st[0] = nloc; b.st[1] = nx; }
        const unsigned old = xb_add(&bar[XB_XSUB(b.x)], 1u);
        const unsigned gen = old / nloc;
        if (old + 1u == (gen + 1u) * nloc) {
            __builtin_amdgcn_fence(__ATOMIC_RELEASE, "agent");
            asm volatile("s_waitcnt vmcnt(0)" ::: "memory");
            const unsigned og = xb_add(&bar[XB_TOP], 1u);
            const unsigned tg = og / nx;
            if (og + 1u == (tg + 1u) * nx) xb_add(&bar[XB_TOPGEN], 1u);
            else XB_SPIN(xb_ld(&bar[XB_TOPGEN]) == tg, bar);
            __builtin_amdgcn_fence(__ATOMIC_ACQUIRE, "agent");
            xb_add(&bar[XB_XGEN(b.x)], 1u);
            asm volatile("s_waitcnt vmcnt(0)" ::: "memory");
        } else {
            XB_SPIN(xb_ld(&bar[XB_XGEN(b.x)]) == gen, bar);
            __builtin_amdgcn_fence(__ATOMIC_ACQUIRE, "agent");
            asm volatile("s_waitcnt vmcnt(0)" ::: "memory");
        }
    }
    __syncthreads();
}

__device__ __forceinline__ void xcd_local_barrier(const XcdBarrier& b) {
    asm volatile("s_waitcnt vmcnt(0)" ::: "memory");
    __syncthreads();
    if (b.w == 0 && lane_id_v() == 0) {
        unsigned* bar = b.bar;
        __builtin_amdgcn_s_waitcnt(0);
        const unsigned nloc = b.st[0];
        const unsigned old = xb_add(&bar[XB_LSUB(b.x)], 1u);
        const unsigned gen = old / nloc;
        if (old + 1u == (gen + 1u) * nloc) xb_add(&bar[XB_LGEN(b.x)], 1u);
        else XB_SPIN(xb_ld(&bar[XB_LGEN(b.x)]) == gen, bar);
        __builtin_amdgcn_fence(__ATOMIC_ACQUIRE, "agent");
        asm volatile("s_waitcnt vmcnt(0)" ::: "memory");
    }
    __syncthreads();
}

typedef float f32x2 __attribute__((ext_vector_type(2)));
typedef unsigned u32x2 __attribute__((ext_vector_type(2)));
__device__ __forceinline__ float bflo(unsigned w) { return __builtin_bit_cast(float, w << 16); }
__device__ __forceinline__ float bfhi(unsigned w) { return __builtin_bit_cast(float, w & 0xffff0000u); }
__device__ __forceinline__ float bf2f(bf16 v) { return __builtin_bit_cast(float, (unsigned)v << 16); }
__device__ __forceinline__ void unpack8(const v4u w, float (&f)[8]) { f[0] = bflo(w.x); f[1] = bfhi(w.x); f[2] = bflo(w.y); f[3] = bfhi(w.y); f[4] = bflo(w.z); f[5] = bfhi(w.z); f[6] = bflo(w.w); f[7] = bfhi(w.w); }
__device__ __forceinline__ v4u pack8(const float (&f)[8]) { v4u w; w.x = pk2(f[0], f[1]); w.y = pk2(f[2], f[3]); w.z = pk2(f[4], f[5]); w.w = pk2(f[6], f[7]); return w; }
__device__ __forceinline__ float xor32(float v, int lane) {
    return __builtin_bit_cast(float, __builtin_amdgcn_ds_bpermute((lane ^ 32) << 2, __builtin_bit_cast(int, v)));
}
__device__ __forceinline__ float sigmoid_f(float x) { return 1.0f / (1.0f + __expf(-x)); }

struct Ctx {
    LAS unsigned char* lds;
    int tid, lane, wave, G, gw, NGW;
    float* out; unsigned char* ws;
};

__device__ __forceinline__ void conv_item(const float* W, int N, int sc, int nv, int k0, bf16* WT, int ldw, int dr, LAS float* scr, int lane, const float* gk = nullptr) {
    const int n_ = lane & 31;
    float wv[32];
#pragma unroll
    for (int i = 0; i < 32; ++i) { const int kk = 2 * i + (lane >> 5); wv[i] = (n_ < nv) ? W[(size_t)(k0 + kk) * N + sc + n_] : 0.f; }
#pragma unroll
    for (int i = 0; i < 32; ++i) { const int kk = 2 * i + (lane >> 5); scr[kk * 33 + n_] = gk ? wv[i] * gk[k0 + kk] : wv[i]; }
    LDS_WAIT(); asm volatile("" ::: "memory");
    const int c = lane & 7;
#pragma unroll
    for (int j = 0; j < 4; ++j) { const int n = (lane >> 3) + 8 * j; const LAS float* s = scr + (8 * c) * 33 + n;
        v4u o; o.x = pk2(s[0 * 33], s[1 * 33]); o.y = pk2(s[2 * 33], s[3 * 33]); o.z = pk2(s[4 * 33], s[5 * 33]); o.w = pk2(s[6 * 33], s[7 * 33]);
        if (n < nv) *(GAS v4u*)(WT + (size_t)(dr + n) * ldw + k0 + 8 * c) = o; }
    LDS_WAIT(); asm volatile("" ::: "memory");
}
__device__ const int SEG_IN[15][3] = {
    {0, Z_FQ, 512}, {512, Z_FK, 512}, {1024, Z_FV, 512}, {1536, 6656 + S_FF, 8}, {1544, Z_DQ, 512}, {2056, 6656 + S_DK, 64}, {2120, 6656 + S_DV, 64},
    {2184, 6656 + S_IQ, 256}, {2440, 6656 + S_IK, 32}, {2472, 6656 + S_IW, 8}, {2480, Z_RQ, 256}, {2736, Z_RK, 256}, {2992, Z_RV, 512}, {3504, Z_RG, 512}, {4016, Z_ZG, 3072}};
constexpr int IN_BLK = 223;
constexpr int IT_IN = 16 * IN_BLK, IT_MIX = 8 * 32, IT_O = 16 * 32, IT_FI = 16 * (FF2 / 32), IT_FO = (FFH / 64) * 32;
constexpr int IT_LAYER = IT_IN + 3 * IT_MIX + IT_O + IT_FI + IT_FO;

__device__ __forceinline__ void sincos_acc(float ang, float& c, float& s) {
    const double a = (double)ang;
    const double k = __builtin_rint(a * 0.6366197723675814);
    double y = a - k * 1.5707963267948966; y -= k * 6.123233995736766e-17;
    const double y2 = y * y;
    double sp = -7.647163731819816e-13; sp = sp * y2 + 1.6059043836821613e-10; sp = sp * y2 - 2.505210838544172e-08; sp = sp * y2 + 2.7557319223985893e-06; sp = sp * y2 - 1.984126984126984e-04; sp = sp * y2 + 8.333333333333333e-03; sp = sp * y2 - 1.6666666666666666e-01;
    const double sn = y + y * y2 * sp;
    double cp = 4.779477332387385e-14; cp = cp * y2 - 1.1470745597729725e-11; cp = cp * y2 + 2.08767569878681e-09; cp = cp * y2 - 2.755731922398589e-07; cp = cp * y2 + 2.48015873015873e-05; cp = cp * y2 - 1.388888888888889e-03; cp = cp * y2 + 4.1666666666666664e-02; cp = cp * y2 - 0.5;
    const double cs = 1.0 + y2 * cp;
    const int q = ((int)k) & 3;
    const double ss = (q & 1) ? cs : sn, cc = (q & 1) ? sn : cs;
    s = (float)((q & 2) ? -ss : ss);
    c = (float)(((q + 1) & 2) ? -cc : cc);
}

__device__ __forceinline__ void p0_prologue(const Ctx& F, const float* w_in, const float* w_fox, const float* w_dsa, const float* w_ret, const float* w_o, const float* w_fi, const float* w_fo, const float* ln1g, const float* ln2g) {
    LAS float* scr = (LAS float*)(F.lds + RING_OFF + F.wave * 16384);
    bf16* Wb = (bf16*)(F.ws + WS_W);
    for (int it = F.gw; it < DEPTH * IT_LAYER; it += F.NGW) {
        const int l = it / IT_LAYER; int r = it % IT_LAYER;
        bf16* L = Wb + (size_t)l * LW_STRIDE;
        if (r < IT_IN) {
            const int kb = r / IN_BLK; int blk = r % IN_BLK; int sc = 0, dr = 0, nv = 0;
            for (int s = 0; s < 15; ++s) { const int w = SEG_IN[s][2], nb = (w + 31) >> 5; if (blk < nb) { sc = SEG_IN[s][0] + 32 * blk; dr = SEG_IN[s][1] + 32 * blk; nv = (w - 32 * blk) < 32 ? (w - 32 * blk) : 32;
                if (s == 0 || s == 1 || s == 4) { const int hd = blk >> 1; dr = SEG_IN[s][1] + (hd >> 2) * 256 + 128 * (blk & 1) + 32 * (hd & 3); }
                break; } blk -= nb; }
            conv_item(w_in + (size_t)l * DM * INC, INC, sc, nv, 64 * kb, L + LW_IN, 1024, dr, scr, F.lane, ln1g + l * DM); continue; }
        r -= IT_IN;
        if (r < 3 * IT_MIX) { const int w = r / IT_MIX, q = r % IT_MIX, kb = q / 32, nb = q % 32;
            conv_item((w == 0 ? w_fox : w == 1 ? w_dsa : w_ret) + (size_t)l * 512 * DM, DM, 32 * nb, 32, 64 * kb, L + LW_MIX + (size_t)w * 512, 1536, 32 * nb, scr, F.lane); continue; }
        r -= 3 * IT_MIX;
        if (r < IT_O) { const int kb = r / 32, nb = r % 32;
            conv_item(w_o + (size_t)l * DM * DM, DM, 32 * nb, 32, 64 * kb, L + LW_O, 1024, 32 * nb, scr, F.lane); continue; }
        r -= IT_O;
        if (r < IT_FI) { const int kb = r / (FF2 / 32), nb = r % (FF2 / 32); const int n0 = 32 * nb;
            const int j = n0 < FFH ? n0 : n0 - FFH; const int dr = 256 * (j >> 7) + (j & 127) + (n0 < FFH ? 0 : 128);
            conv_item(w_fi + (size_t)l * DM * FF2, FF2, n0, 32, 64 * kb, L + LW_FI, 1024, dr, scr, F.lane, ln2g + l * DM); continue; }
        r -= IT_FI;
        { const int kb = r / 32, nb = r % 32;
            conv_item(w_fo + (size_t)l * FFH * DM, DM, 32 * nb, 32, 64 * kb, L + LW_FO, FFH, 32 * nb, scr, F.lane); }
    }
    for (int i = F.gw * 64 + F.lane; i < DEPTH * 80 * 128; i += F.NGW * 64) { const int l = i / (80 * 128), q = i % (80 * 128);
        *(GAS v4u*)(Wb + (size_t)l * LW_STRIDE + LW_IN + (size_t)INC * 1024 + (size_t)q * 8) = (v4u){0u, 0u, 0u, 0u}; }
    f32x2* R64 = (f32x2*)(F.ws + WS_ROPE64); f32x2* R32 = (f32x2*)(F.ws + WS_ROPE32);
    for (int i = F.gw * 64 + F.lane; i < SEQ * 32; i += F.NGW * 64) { const int pos = i >> 5, k = i & 31;
        double f = 1.0; for (int e = 0; e < k; ++e) f *= 0.7498942093324559;
        const float ang = (float)pos * (float)f; float c, s; sincos_acc(ang, c, s); R64[i] = (f32x2){c, s}; }
    for (int i = F.gw * 64 + F.lane; i < SEQ * 16; i += F.NGW * 64) { const int pos = i >> 4, k = i & 15;
        double f = 1.0; for (int e = 0; e < k; ++e) f *= 0.5623413251903491;
        const float ang = (float)pos * (float)f; float c, s; sincos_acc(ang, c, s); R32[i] = (f32x2){c, s}; }
}

__device__ __forceinline__ void norm0_phase(const Ctx& F, const float* x, bf16* o, float* SS) {
    for (int m0 = F.gw; m0 < M; m0 += 4 * F.NGW) {
        f32x4 v[4][4];
#pragma unroll
        for (int r = 0; r < 4; ++r) { const int m = m0 + r * F.NGW; const GAS f32x4* xr = (const GAS f32x4*)(x + (size_t)(m < M ? m : m0) * DM) + F.lane;
#pragma unroll
            for (int j = 0; j < 4; ++j) v[r][j] = xr[64 * j]; }
#pragma unroll
        for (int r = 0; r < 4; ++r) { const int m = m0 + r * F.NGW; if (m < M) { float s = 0.f;
#pragma unroll
            for (int j = 0; j < 4; ++j) s += (v[r][j].x * v[r][j].x + v[r][j].y * v[r][j].y) + (v[r][j].z * v[r][j].z + v[r][j].w * v[r][j].w);
            s = wave_sum(s);
            GAS unsigned long long* o8 = (GAS unsigned long long*)(o + (size_t)m * DM) + F.lane;
#pragma unroll
            for (int j = 0; j < 4; ++j) o8[64 * j] = (unsigned long long)pk2(v[r][j].x, v[r][j].y) | ((unsigned long long)pk2(v[r][j].z, v[r][j].w) << 32);
            if (F.lane < 4) SS[(size_t)m * 4 + F.lane] = (F.lane == 0) ? s : 0.f; } }
    }
}

__device__ __forceinline__ void post_phase(const Ctx& F, const float* g_fq, const float* g_fk, const float* g_dq, const float* g_dk, const float* b_f, bool dummy_out = false) {
    bf16* Z = (bf16*)(F.ws + WS_Z); const float* ZS = (const float*)(F.ws + WS_ZS);
    const f32x2* R64 = (const f32x2*)(F.ws + WS_ROPE64); const f32x2* R32 = (const f32x2*)(F.ws + WS_ROPE32);
    float* LF = (float*)(F.ws + WS_LF); unsigned* ISG = (unsigned*)(F.ws + WS_ISG);
    bf16* KD = (bf16*)(F.ws + WS_KD); bf16* VD = (bf16*)(F.ws + WS_VD); bf16* IQB = (bf16*)(F.ws + WS_IQB); bf16* IKB = (bf16*)(F.ws + WS_IKB);
    const int t0 = blockIdx.x * 512 + F.tid, NT = F.G * 512;
    for (int t = t0; t < M * 8; t += NT) { const int m = t >> 3, h = t & 7; const float* sp = ZS + (size_t)m * ZSP + S_IQ + h * 32;
        f32x4 v[8];
#pragma unroll
        for (int i = 0; i < 8; ++i) v[i] = *(const GAS f32x4*)(sp + 4 * i);
        const float aw = fabsf(ZS[(size_t)m * ZSP + S_IW + h]);
        const f32x2* cs = R32 + (m & (SEQ - 1)) * 16; float f[32];
#pragma unroll
        for (int i = 0; i < 8; ++i) { f[4 * i] = v[i].x; f[4 * i + 1] = v[i].y; f[4 * i + 2] = v[i].z; f[4 * i + 3] = v[i].w; }
#pragma unroll
        for (int d = 0; d < 16; ++d) { const f32x2 tt = cs[d]; const float x1 = f[d], x2 = f[d + 16]; f[d] = (x1 * tt.x - x2 * tt.y) * aw; f[d + 16] = (x2 * tt.x + x1 * tt.y) * aw; }
        bf16* op = IQB + (size_t)m * 256 + h * 32;
#pragma unroll
        for (int i = 0; i < 4; ++i) { float t8[8];
#pragma unroll
            for (int j = 0; j < 8; ++j) t8[j] = f[8 * i + j];
            *(GAS v4u*)(op + 8 * i) = pack8(t8); }
    }
    const int part = blockIdx.x & 3;
    for (int m = (blockIdx.x >> 2) * 512 + F.tid; m < M; m += (F.G >> 2) * 512) { const float* sr = ZS + (size_t)m * ZSP; const int pos = m & (SEQ - 1);
        if (part == 0) { float f[64]; float ss = 0.f;
#pragma unroll
            for (int i = 0; i < 16; ++i) { const f32x4 v = *(const GAS f32x4*)(sr + S_DK + 4 * i); f[4 * i] = v.x; f[4 * i + 1] = v.y; f[4 * i + 2] = v.z; f[4 * i + 3] = v.w; ss += (v.x * v.x + v.y * v.y) + (v.z * v.z + v.w * v.w); }
            const float rs = 1.0f / sqrtf(ss * (1.f / 64) + NORM_EPS); const f32x2* cs = R64 + pos * 32;
#pragma unroll
            for (int d = 0; d < 64; ++d) f[d] = f[d] * rs * g_dk[d];
#pragma unroll
            for (int d = 0; d < 32; ++d) { const f32x2 tt = cs[d]; const float x1 = f[d], x2 = f[d + 32]; f[d] = x1 * tt.x - x2 * tt.y; f[d + 32] = x2 * tt.x + x1 * tt.y; }
#pragma unroll
            for (int i = 0; i < 8; ++i) { float t8[8];
#pragma unroll
                for (int j = 0; j < 8; ++j) t8[j] = f[8 * i + j];
                *(GAS v4u*)(KD + (size_t)m * 64 + 8 * i) = pack8(t8); } }
        if (part == 1)
#pragma unroll
        for (int i = 0; i < 8; ++i) { const f32x4 a = *(const GAS f32x4*)(sr + S_DV + 8 * i), b = *(const GAS f32x4*)(sr + S_DV + 8 * i + 4); const float t8[8] = {a.x, a.y, a.z, a.w, b.x, b.y, b.z, b.w};
            *(GAS v4u*)(VD + (size_t)m * 64 + 8 * i) = pack8(t8); }
        if (part == 2) { float f[32]; const f32x2* cs = R32 + pos * 16;
#pragma unroll
            for (int i = 0; i < 8; ++i) { const f32x4 v = *(const GAS f32x4*)(sr + S_IK + 4 * i); f[4 * i] = v.x; f[4 * i + 1] = v.y; f[4 * i + 2] = v.z; f[4 * i + 3] = v.w; }
#pragma unroll
            for (int d = 0; d < 16; ++d) { const f32x2 tt = cs[d]; const float x1 = f[d], x2 = f[d + 16]; f[d] = x1 * tt.x - x2 * tt.y; f[d + 16] = x2 * tt.x + x1 * tt.y; }
#pragma unroll
            for (int i = 0; i < 4; ++i) { float t8[8];
#pragma unroll
                for (int j = 0; j < 8; ++j) t8[j] = f[8 * i + j];
                *(GAS v4u*)(IKB + (size_t)m * 32 + 8 * i) = pack8(t8); } }
        if (part == 3) { const f32x4 w0 = *(const GAS f32x4*)(sr + S_IW), w1 = *(const GAS f32x4*)(sr + S_IW + 4); const float iw[8] = {w0.x, w0.y, w0.z, w0.w, w1.x, w1.y, w1.z, w1.w}; unsigned sg = 0;
#pragma unroll
            for (int h = 0; h < 8; ++h) sg |= (iw[h] < 0.f ? 1u : 0u) << h;
            ISG[m] = sg;
            const f32x4 f0 = *(const GAS f32x4*)(sr + S_FF), f1 = *(const GAS f32x4*)(sr + S_FF + 4); const float ff[8] = {f0.x, f0.y, f0.z, f0.w, f1.x, f1.y, f1.z, f1.w}; float lf[8];
#pragma unroll
            for (int h = 0; h < 8; ++h) { const float xx = ff[h] + b_f[h]; lf[h] = (fminf(xx, 0.f) - __logf(1.0f + __expf(-fabsf(xx)))) * LOG2E; }
            *(GAS f32x4*)(LF + (size_t)m * 8) = (f32x4){lf[0], lf[1], lf[2], lf[3]}; *(GAS f32x4*)(LF + (size_t)m * 8 + 4) = (f32x4){lf[4], lf[5], lf[6], lf[7]}; }
    }
}

__device__ __forceinline__ float ret_l2g(int h) { return h == 0 ? -0.04580368961312479f : h == 1 ? -0.02272007650008353f : h == 2 ? -0.011315313227834146f : -0.005646563141142063f; }

__device__ __forceinline__ void scan_state_phase(const Ctx& F) {
    const float* LF = (const float*)(F.ws + WS_LF); float* CF = (float*)(F.ws + WS_CF);
    const bf16* Z = (const bf16*)(F.ws + WS_Z); float* RS = (float*)(F.ws + WS_HDN);
    if (F.gw < 32) {
        const int b = F.gw >> 3, h = F.gw & 7; const float* lp = LF + ((size_t)b * SEQ + F.lane * 64) * 8 + h; float s = 0.f;
        for (int i = 0; i < 64; ++i) s += lp[i * 8];
        float incl = s;
#pragma unroll
        for (int o = 1; o < 64; o <<= 1) { const float t = __builtin_bit_cast(float, __builtin_amdgcn_ds_bpermute(((F.lane - o) & 63) << 2, __builtin_bit_cast(int, incl))); if (F.lane >= o) incl += t; }
        float run = incl - s; float* cp = CF + (size_t)F.gw * SEQ + F.lane * 64;
        for (int i = 0; i < 64; ++i) { run += lp[i * 8]; cp[i] = run; }
    }
    for (int u = blockIdx.x; u < NB * 32 * 4; u += F.G) {
        const int h = u & 3, c = (u >> 2) & 31, b = u >> 7; const float l2g = ret_l2g(h);
        const int d = F.tid >> 3, e0 = (F.tid & 7) * 16; float acc[16];
#pragma unroll
        for (int i = 0; i < 16; ++i) acc[i] = 0.f;
        const bf16* base = Z + ((size_t)b * SEQ + c * 128) * ZP;
        for (int j = 0; j < 128; ++j) { const bf16* row = base + (size_t)j * ZP;
            const float kd = bf2f(row[Z_RK + h * 64 + d]) * exp2f((float)(127 - j) * l2g);
            const v4u w0 = *(const GAS v4u*)(row + Z_RV + h * 128 + e0), w1 = *(const GAS v4u*)(row + Z_RV + h * 128 + e0 + 8);
            float v0[8], v1[8]; unpack8(w0, v0); unpack8(w1, v1);
#pragma unroll
            for (int i = 0; i < 8; ++i) { acc[i] += kd * v0[i]; acc[8 + i] += kd * v1[i]; } }
        float* o = RS + (size_t)u * 8192 + d * 128 + e0;
#pragma unroll
        for (int i = 0; i < 4; ++i) *(GAS f32x4*)(o + 4 * i) = (f32x4){acc[4 * i], acc[4 * i + 1], acc[4 * i + 2], acc[4 * i + 3]};
    }
}

__device__ __forceinline__ void ret_out_naive(const Ctx& F, const float* gn) {
    bf16* Z = (bf16*)(F.ws + WS_Z); const float* RS = (const float*)(F.ws + WS_HDN);
    LAS float* S = (LAS float*)(F.lds);
    LAS bf16* Vt = (LAS bf16*)(F.lds + 32768);
    LAS float* Kt = (LAS float*)(F.lds + 65536);
    LAS float* aw = (LAS float*)(F.lds + 65536 + 33280) + F.wave * 128;
    LAS float* qw = (LAS float*)(F.lds + 65536 + 33280 + 4096) + F.wave * 64;
    for (int u = blockIdx.x; u < NB * 32 * 4; u += F.G) {
        const int h = u & 3, c = (u >> 2) & 31, b = u >> 7; const float l2g = ret_l2g(h); const float wch = exp2f(128.f * l2g);
        __syncthreads();
        { float s[16];
#pragma unroll
            for (int i = 0; i < 16; ++i) s[i] = 0.f;
            for (int cp = 0; cp < c; ++cp) { const float* L = RS + ((size_t)((b * 32 + cp) * 4 + h)) * 8192 + F.tid;
#pragma unroll
                for (int i = 0; i < 16; ++i) s[i] = wch * s[i] + L[i * 512]; }
#pragma unroll
            for (int i = 0; i < 16; ++i) S[F.tid + i * 512] = s[i]; }
        const bf16* base = Z + ((size_t)b * SEQ + c * 128) * ZP;
        for (int q = F.tid; q < 2048; q += 512) { const int r = q >> 4, ch = q & 15; *(LAS v4u*)(Vt + r * 128 + ch * 8) = *(const GAS v4u*)(base + (size_t)r * ZP + Z_RV + h * 128 + ch * 8); }
        for (int q = F.tid; q < 128 * 64; q += 512) { const int r = q >> 6, dd = q & 63; Kt[r * 65 + dd] = bf2f(base[(size_t)r * ZP + Z_RK + h * 64 + dd]); }
        __syncthreads();
        for (int i = F.wave; i < 128; i += NWAVES) {
            const size_t m = (size_t)b * SEQ + c * 128 + i; bf16* zr = Z + m * ZP;
            qw[F.lane] = bf2f(zr[Z_RQ + h * 64 + F.lane]);
            LDS_WAIT(); asm volatile("" ::: "memory");
#pragma unroll
            for (int jj = 0; jj < 2; ++jj) { const int j = F.lane + 64 * jj; float a = 0.f;
                if (j <= i) { float dot = 0.f; for (int dd = 0; dd < 64; ++dd) dot += qw[dd] * Kt[j * 65 + dd]; a = dot * exp2f((float)(i - j) * l2g); }
                aw[j] = a; }
            LDS_WAIT(); asm volatile("" ::: "memory");
            float o[2]; const float dq = exp2f((float)(i + 1) * l2g);
#pragma unroll
            for (int ee = 0; ee < 2; ++ee) { const int e = F.lane + 64 * ee; float acc = 0.f;
                for (int j = 0; j <= i; ++j) acc += aw[j] * bf2f(Vt[j * 128 + e]);
                float cr = 0.f; for (int dd = 0; dd < 64; ++dd) cr += qw[dd] * S[dd * 128 + e];
                o[ee] = acc + cr * dq; }
            const float ss = wave_sum(o[0] * o[0] + o[1] * o[1]); const float rstd = 1.0f / sqrtf(ss * (1.f / 128) + NORM_EPS);
#pragma unroll
            for (int ee = 0; ee < 2; ++ee) { const int e = F.lane + 64 * ee; const float rg = bf2f(zr[Z_RG + h * 128 + e]);
                zr[Z_RV + h * 128 + e] = (bf16)f2bf(o[ee] * rstd * gn[h * 128 + e] * rg * sigmoid_f(rg)); }
            LDS_WAIT(); asm volatile("" ::: "memory");
        }
    }
    __syncthreads();
}

__device__ __forceinline__ void fox_naive(const Ctx& F) {
    bf16* Z = (bf16*)(F.ws + WS_Z); const float* CF = (const float*)(F.ws + WS_CF);
    LAS float* sc = (LAS float*)(F.lds + F.wave * 16384);
    const int lane = F.lane;
    int it = 0;
    for (int r0 = 0; r0 < NB * 8 * SEQ; r0 += F.NGW, ++it) {
        const int r = r0 + ((it & 1) ? (F.NGW - 1 - F.gw) : F.gw);
        if (r >= NB * 8 * SEQ) continue;
        const int pos = r & (SEQ - 1), h = (r >> 12) & 7, b = r >> 15;
        const size_t m = (size_t)b * SEQ + pos;
        float qf[64];
        { const bf16* qp = Z + m * ZP + Z_FQ + h * 64;
#pragma unroll
            for (int i = 0; i < 8; ++i) { const v4u w = *(const GAS v4u*)(qp + 8 * i); float t[8]; unpack8(w, t);
#pragma unroll
                for (int j = 0; j < 8; ++j) qf[8 * i + j] = t[j]; } }
        const float* cf = CF + (size_t)(b * 8 + h) * SEQ;
        float mx = -INFINITY;
        for (int kk = lane; kk <= pos; kk += 64) { const bf16* kp = Z + ((size_t)b * SEQ + kk) * ZP + Z_FK + h * 64; float dot = 0.f;
#pragma unroll
            for (int i = 0; i < 8; ++i) { const v4u w = *(const GAS v4u*)(kp + 8 * i); float t[8]; unpack8(w, t);
#pragma unroll
                for (int j = 0; j < 8; ++j) dot += qf[8 * i + j] * t[j]; }
            const float s = dot - cf[kk]; sc[kk] = s; mx = fmaxf(mx, s); }
        mx = wave_max(mx);
        float sum = 0.f;
        for (int kk = lane; kk <= pos; kk += 64) { const float p = exp2f(sc[kk] - mx); sc[kk] = p; sum += p; }
        sum = wave_sum(sum);
        LDS_WAIT(); asm volatile("" ::: "memory");
        const bf16* vp = Z + (size_t)b * SEQ * ZP + Z_FV + h * 64 + lane;
        float o0 = 0.f, o1 = 0.f, o2 = 0.f, o3 = 0.f; int kk = 0;
        for (; kk + 3 <= pos; kk += 4) { o0 += sc[kk] * bf2f(vp[(size_t)kk * ZP]); o1 += sc[kk + 1] * bf2f(vp[(size_t)(kk + 1) * ZP]); o2 += sc[kk + 2] * bf2f(vp[(size_t)(kk + 2) * ZP]); o3 += sc[kk + 3] * bf2f(vp[(size_t)(kk + 3) * ZP]); }
        for (; kk <= pos; ++kk) o0 += sc[kk] * bf2f(vp[(size_t)kk * ZP]);
        Z[m * ZP + Z_FQ + h * 64 + lane] = (bf16)f2bf(((o0 + o1) + (o2 + o3)) / sum);
        LDS_WAIT(); asm volatile("" ::: "memory");
    }
}

__device__ __forceinline__ unsigned f2key(float s) { const unsigned u = __builtin_bit_cast(unsigned, s + 0.0f); return (u & 0x80000000u) ? ~u : (u | 0x80000000u); }
__device__ __forceinline__ void dsa_naive(const Ctx& F) {
    bf16* Z = (bf16*)(F.ws + WS_Z); const float* ZS = (const float*)(F.ws + WS_ZS);
    const unsigned* ISG = (const unsigned*)(F.ws + WS_ISG);
    const bf16* KD = (const bf16*)(F.ws + WS_KD); const bf16* VD = (const bf16*)(F.ws + WS_VD);
    LAS unsigned* kl = (LAS unsigned*)(F.lds + F.wave * 16384);
    LAS float* iqs = (LAS float*)(F.lds + XTRA_OFF + F.wave * 1536);
    const int lane = F.lane;
    int it = 0;
    for (int r0 = 0; r0 < M; r0 += F.NGW, ++it) {
        const int r = r0 + ((it & 1) ? (F.NGW - 1 - F.gw) : F.gw);
        if (r >= M) continue;
        const int pos = r & (SEQ - 1), b = r >> 12; const size_t m = (size_t)r;
        *(LAS f32x4*)(iqs + 4 * lane) = *(const GAS f32x4*)(ZS + m * ZSP + S_IQ + 4 * lane);
        const unsigned sg = ISG[m];
        LDS_WAIT(); asm volatile("" ::: "memory");
        for (int kk = lane; kk <= pos; kk += 64) { const float* ikp = ZS + ((size_t)b * SEQ + kk) * ZSP + S_IK; float ik[32];
#pragma unroll
            for (int i = 0; i < 8; ++i) { const f32x4 t = *(const GAS f32x4*)(ikp + 4 * i); ik[4 * i] = t.x; ik[4 * i + 1] = t.y; ik[4 * i + 2] = t.z; ik[4 * i + 3] = t.w; }
            float s = 0.f;
#pragma unroll 1
            for (int h = 0; h < 8; ++h) { float dot = 0.f;
#pragma unroll
                for (int dd = 0; dd < 32; ++dd) dot += iqs[h * 32 + dd] * ik[dd];
                dot = fmaxf(dot, 0.f); s += ((sg >> h) & 1u) ? -dot : dot; }
            kl[kk] = f2key(s); }
        LDS_WAIT(); asm volatile("" ::: "memory");
        unsigned key[64];
#pragma unroll
        for (int j = 0; j < 64; ++j) { const int kk = j * 64 + lane; key[j] = (kk <= pos) ? kl[kk] : 0u; }
        LDS_WAIT(); asm volatile("" ::: "memory");
        LAS unsigned* idx = kl; LAS float* pl = (LAS float*)(kl + 256); LAS bf16* qs = (LAS bf16*)(kl + 512);
        *(LAS v4u*)(qs + 8 * lane) = *(const GAS v4u*)(Z + m * ZP + Z_DQ + 8 * lane);
        unsigned T = 0u; int need = 0;
        if (pos + 1 > 256) {
            for (int bit = 31; bit >= 0; --bit) { const unsigned Tt = T | (1u << bit); int cnt = 0;
#pragma unroll
                for (int j = 0; j < 64; ++j) cnt += __builtin_popcountll(__ballot(key[j] >= Tt));
                if (cnt >= 256) T = Tt; }
            int ngt = 0;
#pragma unroll
            for (int j = 0; j < 64; ++j) ngt += __builtin_popcountll(__ballot(key[j] > T));
            need = 256 - ngt;
        }
        int nsel = 0, eqb = 0;
#pragma unroll
        for (int j = 0; j < 64; ++j) { const bool gt = key[j] > T, eq = (key[j] == T) && (T != 0u);
            const unsigned long long em = __ballot(eq); const int er = eqb + __builtin_amdgcn_mbcnt_hi((unsigned)(em >> 32), __builtin_amdgcn_mbcnt_lo((unsigned)em, 0u));
            const bool sel = gt || (eq && er < need); eqb += __builtin_popcountll(em);
            const unsigned long long sm = __ballot(sel); const int sp = nsel + __builtin_amdgcn_mbcnt_hi((unsigned)(sm >> 32), __builtin_amdgcn_mbcnt_lo((unsigned)sm, 0u));
            if (sel) idx[sp] = (unsigned)(j * 64 + lane); nsel += __builtin_popcountll(sm); }
        LDS_WAIT(); asm volatile("" ::: "memory");
        for (int h = 0; h < 8; ++h) {
            float sv[4]; float mx = -INFINITY;
#pragma unroll
            for (int i = 0; i < 4; ++i) { const int e = lane + 64 * i; sv[i] = -INFINITY;
                if (e < nsel) { const bf16* kp = KD + ((size_t)b * SEQ + idx[e]) * 64; float dot = 0.f;
#pragma unroll
                    for (int c = 0; c < 8; ++c) { const v4u w = *(const GAS v4u*)(kp + 8 * c); float t[8]; unpack8(w, t); const v4u qw = *(const LAS v4u*)(qs + h * 64 + 8 * c); float qq[8]; unpack8(qw, qq);
#pragma unroll
                        for (int j = 0; j < 8; ++j) dot += qq[j] * t[j]; }
                    sv[i] = dot; }
                mx = fmaxf(mx, sv[i]); }
            mx = wave_max(mx); float sum = 0.f;
#pragma unroll
            for (int i = 0; i < 4; ++i) { const int e = lane + 64 * i; const float p = (e < nsel) ? exp2f(sv[i] - mx) : 0.f; pl[e] = p; sum += p; }
            sum = wave_sum(sum);
            LDS_WAIT(); asm volatile("" ::: "memory");
            float o0 = 0.f, o1 = 0.f; int e = 0;
            for (; e + 1 < nsel; e += 2) { o0 += pl[e] * bf2f(VD[((size_t)b * SEQ + idx[e]) * 64 + lane]); o1 += pl[e + 1] * bf2f(VD[((size_t)b * SEQ + idx[e + 1]) * 64 + lane]); }
            if (e < nsel) o0 += pl[e] * bf2f(VD[((size_t)b * SEQ + idx[e]) * 64 + lane]);
            Z[m * ZP + Z_DQ + h * 64 + lane] = (bf16)f2bf((o0 + o1) / sum);
            LDS_WAIT(); asm volatile("" ::: "memory");
        }
    }
}
#ifndef PROBE_D
#define PROBE_D 0
#endif

typedef short s16x8 __attribute__((ext_vector_type(8)));
typedef short s16x4 __attribute__((ext_vector_type(4)));
typedef short v4i16_t __attribute__((ext_vector_type(4)));
__device__ __forceinline__ s16x4 tr16(const LAS unsigned char* p) { return __builtin_bit_cast(s16x4, __builtin_amdgcn_ds_read_tr16_b64_v4i16((LAS v4i16_t*)p)); }
__device__ __forceinline__ float key2f(unsigned k) { return __builtin_bit_cast(float, (k & 0x80000000u) ? (k & 0x7fffffffu) : ~k); }

template <int NR> __device__ __forceinline__ int dsa_count_ge(const unsigned (&key)[64], unsigned T) {
    int c = 0;
#pragma unroll
    for (int j = 0; j < NR; ++j) c += __builtin_popcountll(__ballot(key[j] >= T));
    return c;
}
#define DSA_COUNT_GE(T_, out_) do { if (nq == 1) out_ = dsa_count_ge<16>(key, (T_)); else if (nq == 2) out_ = dsa_count_ge<32>(key, (T_)); else if (nq == 3) out_ = dsa_count_ge<48>(key, (T_)); else out_ = dsa_count_ge<64>(key, (T_)); } while (0)
__device__ __forceinline__ void dsa_select(const unsigned (&key)[64], int nvalid, unsigned& T, int& need) {
    const int nq = __builtin_amdgcn_readfirstlane((nvalid + 1023) >> 10);
    T = 0u; need = 0;
    if (nvalid <= 256) return;
    unsigned kmax = 0u;
#pragma unroll
    for (int j = 0; j < 64; ++j) kmax = key[j] > kmax ? key[j] : kmax;
#pragma unroll
    for (int o_ = 0; o_ < 1; ++o_) { unsigned t; t = sxu<1>(kmax); kmax = t > kmax ? t : kmax; t = sxu<2>(kmax); kmax = t > kmax ? t : kmax; t = sxu<4>(kmax); kmax = t > kmax ? t : kmax; t = sxu<8>(kmax); kmax = t > kmax ? t : kmax; t = sxu<16>(kmax); kmax = t > kmax ? t : kmax;
        unsigned a_, b_; swap32(kmax, a_, b_); kmax = a_ > b_ ? a_ : b_; }
    unsigned lo = 1u, hi = kmax + 1u; int hic = 0;
    { const float vm = fabsf(key2f(kmax)) + 1.0f; unsigned l2 = f2key(-vm * 64.0f); int c; DSA_COUNT_GE(l2, c); if (c >= 256) lo = l2; }
    int iter = 0; bool exact = false;
    while (hi - lo > 1u) {
        unsigned mid;
        if (iter < 24 && lo > 1u) { const float mv = 0.5f * key2f(lo) + 0.5f * key2f(hi - 1u); mid = f2key(mv); }
        else mid = lo + ((hi - lo) >> 1);
        if (mid <= lo) mid = lo + 1u; if (mid >= hi) mid = hi - 1u;
        int c; DSA_COUNT_GE(mid, c);
        if (c == 256) { T = mid; exact = true; break; }
        if (c > 256) lo = mid; else { hi = mid; hic = c; }
        ++iter;
    }
    if (exact) need = 256; else { T = lo; need = 256 - hic; }
}

template <bool SYNC_BEFORE_STAGE = false> __device__ __forceinline__ void dsa_attend(const bf16* zq, bf16* zo, const bf16* KDb, const bf16* VDb, const LAS unsigned short* idx, int nsel, LAS unsigned char* vst, int lane) {
    const int g = lane >> 4, c = lane & 15;
    s16x8 qf[2];
#pragma unroll
    for (int ks = 0; ks < 2; ++ks) { qf[ks] = (s16x8){0, 0, 0, 0, 0, 0, 0, 0}; if (c < 8) qf[ks] = *(const GAS s16x8*)(zq + c * 64 + 32 * ks + 8 * g); }
    f32x4 acc[16];
    v4u vreg[16];
#pragma unroll
    for (int i = 0; i < 16; ++i) { const int pi = lane + 64 * i, r = pi >> 3, c16 = pi & 7; const int id = (r < nsel) ? (int)idx[r] : 0; vreg[i] = *(const GAS v4u*)(VDb + (size_t)id * 64 + c16 * 8); }
#pragma unroll
    for (int tb = 0; tb < 2; ++tb) {
        s16x8 kf[8][2];
#pragma unroll
        for (int tt = 0; tt < 8; ++tt) { const int e = 16 * (8 * tb + tt) + c; const int id = (e < nsel) ? (int)idx[e] : 0; const bf16* kp = KDb + (size_t)id * 64 + 8 * g;
            kf[tt][0] = *(const GAS s16x8*)kp; kf[tt][1] = *(const GAS s16x8*)(kp + 32); }
#pragma unroll
        for (int tt = 0; tt < 8; ++tt) { f32x4 a = (f32x4){0.f, 0.f, 0.f, 0.f};
            a = __builtin_amdgcn_mfma_f32_16x16x32_bf16(kf[tt][0], qf[0], a, 0, 0, 0); a = __builtin_amdgcn_mfma_f32_16x16x32_bf16(kf[tt][1], qf[1], a, 0, 0, 0); acc[8 * tb + tt] = a; }
    }
    float mx = -INFINITY;
#pragma unroll
    for (int t = 0; t < 16; ++t)
#pragma unroll
        for (int i = 0; i < 4; ++i) { const int e = 16 * t + 4 * g + i; if (nsel < 256 && e >= nsel) acc[t][i] = -INFINITY; mx = fmaxf(mx, acc[t][i]); }
    mx = fmaxf(mx, sx<16>(mx)); mx = half_max(mx);
    float sum = 0.f;
#pragma unroll
    for (int t = 0; t < 16; ++t)
#pragma unroll
        for (int i = 0; i < 4; ++i) { const float p = __builtin_amdgcn_exp2f(acc[t][i] - mx); acc[t][i] = p; sum += p; }
    sum += sx<16>(sum); sum = half_sum(sum);
    const float inv = 1.0f / sum;
    s16x8 pf[8];
#pragma unroll
    for (int s = 0; s < 8; ++s) { v4u w; w.x = pk2(acc[2 * s][0] * inv, acc[2 * s][1] * inv); w.y = pk2(acc[2 * s][2] * inv, acc[2 * s][3] * inv); w.z = pk2(acc[2 * s + 1][0] * inv, acc[2 * s + 1][1] * inv); w.w = pk2(acc[2 * s + 1][2] * inv, acc[2 * s + 1][3] * inv);
        pf[s] = __builtin_bit_cast(s16x8, w); }
    f32x4 o[4];
#pragma unroll
    for (int db = 0; db < 4; ++db) o[db] = (f32x4){0.f, 0.f, 0.f, 0.f};
    const int q = (lane >> 2) & 3, p = lane & 3, swz = 2 * (g & 1) + (q >> 1);
    const LAS unsigned char* rb = vst + (4 * g + q) * 128 + 8 * p;
    if constexpr (SYNC_BEFORE_STAGE) __syncthreads();
#pragma unroll
    for (int hh = 0; hh < 2; ++hh) {
        asm volatile("s_waitcnt lgkmcnt(0)" ::: "memory");
#pragma unroll
        for (int i = 0; i < 16; ++i) { const int pi = lane + 64 * i, r = pi >> 3, c16 = pi & 7;
            *(LAS v4u*)(vst + r * 128 + ((((c16 >> 1) ^ ((r >> 1) & 3))) << 5) + ((c16 & 1) << 4)) = vreg[i]; }
        if (hh == 0) {
#pragma unroll
            for (int i = 0; i < 16; ++i) { const int pi = lane + 64 * i, r = pi >> 3, c16 = pi & 7, e = 128 + r; const int id = (e < nsel) ? (int)idx[e] : 0; vreg[i] = *(const GAS v4u*)(VDb + (size_t)id * 64 + c16 * 8); } }
        asm volatile("s_waitcnt lgkmcnt(0)" ::: "memory");
#pragma unroll
        for (int s4 = 0; s4 < 4; ++s4)
#pragma unroll
            for (int db = 0; db < 4; ++db) { const LAS unsigned char* a1 = rb + s4 * 4096 + ((db ^ swz) << 5);
                const s16x4 lo = tr16(a1), hi = tr16(a1 + 2048);
                const s16x8 vf = (s16x8){lo[0], lo[1], lo[2], lo[3], hi[0], hi[1], hi[2], hi[3]};
                o[db] = __builtin_amdgcn_mfma_f32_16x16x32_bf16(pf[4 * hh + s4], vf, o[db], 0, 0, 0); }
    }
    if (g < 2) {
#pragma unroll
        for (int db = 0; db < 4; ++db)
#pragma unroll
            for (int i = 0; i < 4; ++i) zo[(4 * g + i) * 64 + 16 * db + c] = (bf16)f2bf(o[db][i]);
    }
}

__device__ __forceinline__ void dsa_v2(const Ctx& F) {
    bf16* Z = (bf16*)(F.ws + WS_Z); const float* ZS = (const float*)(F.ws + WS_ZS);
    const unsigned* ISG = (const unsigned*)(F.ws + WS_ISG);
    const bf16* KD = (const bf16*)(F.ws + WS_KD); const bf16* VD = (const bf16*)(F.ws + WS_VD);
    LAS unsigned* kl = (LAS unsigned*)(F.lds + F.wave * 16384);
    LAS float* iqs = (LAS float*)(F.lds + XTRA_OFF + F.wave * 1536);
    LAS unsigned short* idx = (LAS unsigned short*)(F.lds + XTRA_OFF + F.wave * 1536 + 1024);
    const int lane = F.lane;
    int it = 0;
    for (int r0 = 0; r0 < M; r0 += F.NGW, ++it) {
        const int r = r0 + ((it & 1) ? (F.NGW - 1 - F.gw) : F.gw);
        if (r >= M) continue;
        const int pos = r & (SEQ - 1), b = r >> 12; const size_t m = (size_t)r;
        *(LAS f32x4*)(iqs + 4 * lane) = *(const GAS f32x4*)(ZS + m * ZSP + S_IQ + 4 * lane);
        const unsigned sg = ISG[m];
        LDS_WAIT(); asm volatile("" ::: "memory");
        for (int kk = lane; kk <= pos; kk += 64) { const float* ikp = ZS + ((size_t)b * SEQ + kk) * ZSP + S_IK; float ik[32];
#pragma unroll
            for (int i = 0; i < 8; ++i) { const f32x4 t = *(const GAS f32x4*)(ikp + 4 * i); ik[4 * i] = t.x; ik[4 * i + 1] = t.y; ik[4 * i + 2] = t.z; ik[4 * i + 3] = t.w; }
            float s = 0.f;
#pragma unroll 1
            for (int h = 0; h < 8; ++h) { float dot = 0.f;
#pragma unroll
                for (int dd = 0; dd < 32; ++dd) dot += iqs[h * 32 + dd] * ik[dd];
                dot = fmaxf(dot, 0.f); s += ((sg >> h) & 1u) ? -dot : dot; }
            kl[kk] = f2key(s); }
        LDS_WAIT(); asm volatile("" ::: "memory");
        unsigned key[64];
#pragma unroll
        for (int j = 0; j < 64; ++j) { const int kk = j * 64 + lane; key[j] = (kk <= pos) ? kl[kk] : 0u; }
        LDS_WAIT(); asm volatile("" ::: "memory");
        unsigned T; int need;
#ifdef DSA_OLDSEL
        T = 0u; need = 0;
        if (pos + 1 > 256) {
            for (int bit = 31; bit >= 0; --bit) { const unsigned Tt = T | (1u << bit); int cnt = 0;
#pragma unroll
                for (int j = 0; j < 64; ++j) cnt += __builtin_popcountll(__ballot(key[j] >= Tt));
                if (cnt >= 256) T = Tt; }
            int ngt = 0;
#pragma unroll
            for (int j = 0; j < 64; ++j) ngt += __builtin_popcountll(__ballot(key[j] > T));
            need = 256 - ngt;
        }
#else
        dsa_select(key, pos + 1, T, need);
#endif
        int nsel = 0, eqb = 0;
#pragma unroll
        for (int j = 0; j < 64; ++j) { const bool gt = key[j] > T, eq = (key[j] == T) && (T != 0u);
            const unsigned long long em = __ballot(eq); const int er = eqb + __builtin_amdgcn_mbcnt_hi((unsigned)(em >> 32), __builtin_amdgcn_mbcnt_lo((unsigned)em, 0u));
            const bool sel = gt || (eq && er < need); eqb += __builtin_popcountll(em);
            const unsigned long long sm = __ballot(sel); const int sp = nsel + __builtin_amdgcn_mbcnt_hi((unsigned)(sm >> 32), __builtin_amdgcn_mbcnt_lo((unsigned)sm, 0u));
            if (sel) idx[sp] = (unsigned short)(j * 64 + lane); nsel += __builtin_popcountll(sm); }
        LDS_WAIT(); asm volatile("" ::: "memory");
        dsa_attend(Z + m * ZP + Z_DQ, Z + m * ZP + Z_DQ, KD + (size_t)b * SEQ * 64, VD + (size_t)b * SEQ * 64, idx, nsel, (LAS unsigned char*)kl, lane);
        LDS_WAIT(); asm volatile("" ::: "memory");
    }
}

template <int NR> __device__ __forceinline__ int dsa_emit_n(const unsigned (&key)[64], unsigned T, int need, LAS unsigned short* idx, int lane) {
    int nsel = 0, eqb = 0;
#pragma unroll
    for (int j = 0; j < NR; ++j) { const bool gt = key[j] > T, eq = (key[j] == T) && (T != 0u);
        const unsigned long long em = __ballot(eq); const int er = eqb + __builtin_amdgcn_mbcnt_hi((unsigned)(em >> 32), __builtin_amdgcn_mbcnt_lo((unsigned)em, 0u));
        const bool sel = gt || (eq && er < need); eqb += __builtin_popcountll(em);
        const unsigned long long sm = __ballot(sel); const int sp = nsel + __builtin_amdgcn_mbcnt_hi((unsigned)(sm >> 32), __builtin_amdgcn_mbcnt_lo((unsigned)sm, 0u));
        if (sel) idx[sp] = (unsigned short)(j * 64 + lane); nsel += __builtin_popcountll(sm); }
    return nsel;
}
__device__ __forceinline__ int dsa_emit(const unsigned (&key)[64], int nvalid, unsigned T, int need, LAS unsigned short* idx, int lane) {
    const int nq = __builtin_amdgcn_readfirstlane((nvalid + 1023) >> 10);
    if (nq == 1) return dsa_emit_n<16>(key, T, need, idx, lane);
    if (nq == 2) return dsa_emit_n<32>(key, T, need, idx, lane);
    if (nq == 3) return dsa_emit_n<48>(key, T, need, idx, lane);
    return dsa_emit_n<64>(key, T, need, idx, lane);
}

#define DSA_CNT8(cnt_, k_, o_, T_) asm volatile( \
    "v_cmp_ge_u32_e64 s[60:61], %1, %9\n\tv_cmp_ge_u32_e64 s[62:63], %2, %9\n\tv_cmp_ge_u32_e64 s[64:65], %3, %9\n\tv_cmp_ge_u32_e64 s[66:67], %4, %9\n\t" \
    "v_cmp_ge_u32_e64 s[68:69], %5, %9\n\tv_cmp_ge_u32_e64 s[70:71], %6, %9\n\tv_cmp_ge_u32_e64 s[72:73], %7, %9\n\tv_cmp_ge_u32_e64 s[74:75], %8, %9\n\t" \
    "v_addc_co_u32_e64 %0, s[76:77], 0, %0, s[60:61]\n\tv_addc_co_u32_e64 %0, s[76:77], 0, %0, s[62:63]\n\tv_addc_co_u32_e64 %0, s[76:77], 0, %0, s[64:65]\n\tv_addc_co_u32_e64 %0, s[76:77], 0, %0, s[66:67]\n\t" \
    "v_addc_co_u32_e64 %0, s[76:77], 0, %0, s[68:69]\n\tv_addc_co_u32_e64 %0, s[76:77], 0, %0, s[70:71]\n\tv_addc_co_u32_e64 %0, s[76:77], 0, %0, s[72:73]\n\tv_addc_co_u32_e64 %0, s[76:77], 0, %0, s[74:75]" \
    : "+v"(cnt_) : "v"(k_[o_]), "v"(k_[o_ + 1]), "v"(k_[o_ + 2]), "v"(k_[o_ + 3]), "v"(k_[o_ + 4]), "v"(k_[o_ + 5]), "v"(k_[o_ + 6]), "v"(k_[o_ + 7]), "s"(T_) \
    : "s60", "s61", "s62", "s63", "s64", "s65", "s66", "s67", "s68", "s69", "s70", "s71", "s72", "s73", "s74", "s75", "s76", "s77")
template <int NR> __device__ __forceinline__ int dsa_lane_count(const unsigned (&key)[64], unsigned T) {
    int c = 0; const unsigned Ts = (unsigned)__builtin_amdgcn_readfirstlane((int)T);
#pragma unroll
    for (int j = 0; j < NR; j += 8) DSA_CNT8(c, key, j, Ts);
    return c;
}
#define DSA_LCOUNT(T_, lc_) do { if (nq == 1) lc_ = dsa_lane_count<16>(key, (T_)); else if (nq == 2) lc_ = dsa_lane_count<32>(key, (T_)); else if (nq == 3) lc_ = dsa_lane_count<48>(key, (T_)); else lc_ = dsa_lane_count<64>(key, (T_)); } while (0)
template <int NR> __device__ __forceinline__ void dsa_write_ge(const unsigned (&key)[64], unsigned T, int off, LAS unsigned short* idx, int lane) {
    const int dummy = 256 + lane;
#pragma unroll
    for (int j = 0; j < NR; ++j) { const bool s = key[j] >= T; idx[s ? off : dummy] = (unsigned short)(j * 64 + lane); off += s ? 1 : 0; }
}
__device__ __forceinline__ int dsa_select2(const unsigned (&key)[64], int nvalid, float s1, float s2, LAS unsigned short* idx, int lane) {
    const int nq = __builtin_amdgcn_readfirstlane((nvalid + 1023) >> 10);
    unsigned T = 1u; int lc = 0; bool exact = true;
    if (nvalid > 256) {
        const float n = (float)nvalid, mean = s1 / n, sd = sqrtf(fmaxf(s2 / n - mean * mean, 1e-30f));
        const float pfrac = 256.0f / n, pt = fminf(pfrac, 1.0f - pfrac);
        const float tt = sqrtf(-2.0f * __logf(fmaxf(pt, 1e-6f)));
        float zn = (0.010328f * tt + 0.802853f) * tt + 2.515517f; asm volatile("" : "+v"(zn));
        float zd = ((0.001308f * tt + 0.189269f) * tt + 1.432788f) * tt + 1.0f; asm volatile("" : "+v"(zd));
        float z = tt - zn / zd;
        if (pfrac > 0.5f) z = -z;
        const float dens = n * __expf(-0.5f * z * z) * 0.3989423f / sd;
        unsigned lo = 1u, hi = 0xffffffffu; int clo = nvalid, chi = 0;
        bool lop = false, hip = false; float lastv = mean + z * sd, lastc = 256.0f, grow = 1.3f;
        exact = false; int same = 0, last = 0;
        for (int it = 0; hi - lo > 1u; ++it) {
            unsigned mid;
            if (it == 0) mid = f2key(lastv);
            else if (!(lop && hip)) { lastv = lastv + grow * (lastc - 256.0f) / dens; grow *= 2.0f; mid = f2key(lastv); }
            else if (it < 24 && same < 2) { const float vlo = key2f(lo), vhi = key2f(hi - 1u); mid = f2key(vlo + (vhi - vlo) * (((float)(clo - 256) + 0.5f) / (float)(clo - chi))); }
            else if (it < 48) { mid = f2key(0.5f * key2f(lo) + 0.5f * key2f(hi - 1u)); same = 0; }
            else mid = lo + ((hi - lo) >> 1);
            if (!(mid > lo)) mid = lo + 1u; if (!(mid < hi)) mid = hi - 1u;
            DSA_LCOUNT(mid, lc); const int c = wave_isum(lc); lastc = (float)c; lastv = key2f(mid);
            if (c == 256) { T = mid; exact = true; break; }
            if (c > 256) { lo = mid; clo = c; lop = true; same = (last > 0) ? same + 1 : 0; last = 1; } else { hi = mid; chi = c; hip = true; same = (last < 0) ? same + 1 : 0; last = -1; }
        }
        if (!exact) {
            const int nsel = dsa_emit(key, nvalid, lo, 256 - chi, idx, lane);
            return nsel;
        }
    } else { DSA_LCOUNT(1u, lc); }
    int incl = lc;
#pragma unroll
    for (int o = 1; o < 64; o <<= 1) { const int t = __builtin_amdgcn_ds_bpermute(((lane - o) & 63) << 2, incl); if (lane >= o) incl += t; }
    const int total = __builtin_amdgcn_readlane(incl, 63);
    if (nq == 1) dsa_write_ge<16>(key, T, incl - lc, idx, lane); else if (nq == 2) dsa_write_ge<32>(key, T, incl - lc, idx, lane); else if (nq == 3) dsa_write_ge<48>(key, T, incl - lc, idx, lane); else dsa_write_ge<64>(key, T, incl - lc, idx, lane);
    return total;
}

__device__ __forceinline__ void fmac_(float& a, float x, float y) { asm("v_fmac_f32 %0, %1, %2" : "+v"(a) : "v"(x), "v"(y)); }
__device__ __forceinline__ unsigned f2key3(float s) { const unsigned u = __builtin_bit_cast(unsigned, s + 0.0f); return u ^ ((unsigned)((int)u >> 31) | 0x80000000u); }
constexpr int DSA_ROWF = 4100;
__device__ __forceinline__ void dsa_v3(const Ctx& F, int out_col = Z_DQ) {
    LAS unsigned* img = (LAS unsigned*)(F.lds);
    const int v = (int)blockIdx.x;
    if (v < 256)
    for (int ui = 0; ui < 8; ++ui) {
        unsigned char* wsl = F.ws; asm volatile("" : "+s"(wsl));
        bf16* Z = (bf16*)(wsl + WS_Z); const unsigned* ISG = (const unsigned*)(wsl + WS_ISG);
        const bf16* KD = (const bf16*)(wsl + WS_KD); const bf16* VD = (const bf16*)(wsl + WS_VD);
        const bf16* IQB = (const bf16*)(wsl + WS_IQB); const bf16* IKB = (const bf16*)(wsl + WS_IKB);
        int w_ = F.wave; asm volatile("" : "+s"(w_)); const int w = w_;
        LAS unsigned short* idxw = (LAS unsigned short*)(F.lds + XTRA_OFF + w * 1536);
        const int lane = lane_id_v(), g = lane >> 4, c = lane & 15;
        const int b = (v & 7) >> 1, k = ((v >> 3) << 1) | (v & 1); const int pb = 128 * (ui >> 1) + ((ui & 1) ? 127 - k : k);
        const int q0 = pb * 8, kend = q0 + 8, ntile = (kend + 15) >> 4;
        const size_t mb = (size_t)b * SEQ;
#if PROBE_D == 1
        for (int rp_ = 0; rp_ < 2; ++rp_)
#endif
        { s16x8 iqf[4]; float sgn[4]; s16x8 iqc;
          { const int qi = c & 7, hs = c >> 3; const int qq = q0 + qi; const bf16* qp = IQB + (mb + qq) * 256 + 8 * g; const unsigned sg = ISG[mb + qq];
            float cs[8];
#pragma unroll
            for (int e = 0; e < 8; ++e) cs[e] = 0.f;
#pragma unroll
            for (int j = 0; j < 4; ++j) { const int h = 2 * j + hs; iqf[j] = *(const GAS s16x8*)(qp + h * 32); sgn[j] = ((sg >> h) & 1u) ? -1.0f : 1.0f;
                float t8[8]; unpack8(__builtin_bit_cast(v4u, iqf[j]), t8);
#pragma unroll
                for (int e = 0; e < 8; ++e) cs[e] += sgn[j] * t8[e]; }
            iqc = __builtin_bit_cast(s16x8, pack8(cs)); }
          const bf16* ikp = IKB + (mb + c) * 32 + 8 * g;
          float st1 = 0.f, st2 = 0.f;
#pragma unroll 1
          for (int tg = 0; tg < 2; ++tg) { if (w + 128 * tg < ntile) {
          s16x8 kt[16];
#pragma unroll
          for (int i4 = 0; i4 < 4; ++i4) { if (w + 128 * tg + 32 * i4 < ntile) {
#pragma unroll
              for (int i = 4 * i4; i < 4 * i4 + 4; ++i) { const int t = w + 128 * tg + 8 * i; kt[i] = *(const GAS s16x8*)(ikp + (size_t)512 * (t < ntile ? t : 0)); } }
            else {
#pragma unroll
              for (int i = 4 * i4; i < 4 * i4 + 4; ++i) kt[i] = (s16x8){0, 0, 0, 0, 0, 0, 0, 0}; } }
#pragma unroll
          for (int i = 0; i < 16; ++i) { const int t = w + 128 * tg + 8 * i;
              if (t < ntile) {
                f32x4 xs[4]; f32x4 sc = __builtin_amdgcn_mfma_f32_16x16x32_bf16(kt[i], iqc, (f32x4){0.f, 0.f, 0.f, 0.f}, 0, 0, 0);
#pragma unroll
                for (int h = 0; h < 4; ++h) xs[h] = __builtin_amdgcn_mfma_f32_16x16x32_bf16(kt[i], iqf[h], (f32x4){0.f, 0.f, 0.f, 0.f}, 0, 0, 0);
                __builtin_amdgcn_sched_barrier(0);
#pragma unroll
                for (int h = 0; h < 4; ++h)
#pragma unroll
                    for (int r = 0; r < 4; ++r) { sc[r] = __builtin_fmaf(sgn[h], __builtin_fabsf(xs[h][r]), sc[r]); asm("" : "+v"(sc[r])); }
#pragma unroll
                for (int r = 0; r < 4; ++r) sc[r] += sx<8>(sc[r]);
                v4u kk; kk.x = f2key3(sc[0]); kk.y = f2key3(sc[1]); kk.z = f2key3(sc[2]); kk.w = f2key3(sc[3]);
                if (16 * t + 15 <= q0) {
                    st1 += (sc[0] + sc[1]) + (sc[2] + sc[3]); fmac_(st2, sc[0], sc[0]); fmac_(st2, sc[1], sc[1]); fmac_(st2, sc[2], sc[2]); fmac_(st2, sc[3], sc[3]);
                } else { const int kb = 16 * t + 4 * g, qa = q0 + (c & 7);
                    if (kb + 0 > qa) { kk.x = 0u; sc[0] = 0.f; } if (kb + 1 > qa) { kk.y = 0u; sc[1] = 0.f; } if (kb + 2 > qa) { kk.z = 0u; sc[2] = 0.f; } if (kb + 3 > qa) { kk.w = 0u; sc[3] = 0.f; }
                    st1 += (sc[0] + sc[1]) + (sc[2] + sc[3]); fmac_(st2, sc[0], sc[0]); fmac_(st2, sc[1], sc[1]); fmac_(st2, sc[2], sc[2]); fmac_(st2, sc[3], sc[3]); }
                if (c < 8) *(LAS v4u*)(img + c * DSA_ROWF + 16 * t + 4 * g) = kk; }
              __builtin_amdgcn_sched_barrier(0); } } }
          st1 += sx<16>(st1); st2 += sx<16>(st2); st1 = half_sum(st1); st2 = half_sum(st2);
          if (g == 0 && c < 8) *(LAS f32x2*)(F.lds + XTRA_OFF + w * 1536 + 640 + c * 8) = (f32x2){st1, st2}; }
        __syncthreads();
        const int pos = q0 + w; unsigned key[64];
#pragma unroll
        for (int j = 0; j < 64; ++j) { const int kidx = 64 * j + lane; const unsigned a = img[w * DSA_ROWF + kidx]; key[j] = (kidx <= pos) ? a : 0u; }
        unsigned T; int need; int nsel;
        float rs1 = 0.f, rs2 = 0.f;
#pragma unroll
        for (int ww = 0; ww < 8; ++ww) { const f32x2 t = *(const LAS f32x2*)(F.lds + XTRA_OFF + ww * 1536 + 640 + w * 8); rs1 += t.x; rs2 += t.y; }
        { nsel = dsa_select2(key, pos + 1, rs1, rs2, idxw, lane); (void)T; (void)need; }
#if PROBE_D == 3
        { const size_t m = mb + pos; dsa_attend(Z + m * ZP + Z_DQ, Z + m * ZP + Z_RG, KD + mb * 64, VD + mb * 64, idxw, nsel, F.lds + w * 16384, lane); }
#endif
        { const size_t m = mb + pos; dsa_attend<true>(Z + m * ZP + Z_DQ, Z + m * ZP + out_col, KD + mb * 64, VD + mb * 64, idxw, nsel, F.lds + w * 16384, lane); }
        __syncthreads();
    }
}

__device__ __forceinline__ void ret_rope_frag(const bf16* row, const f32x2* cs, float scale, int g, s16x8 (&f)[2]) {
    const u32x2 a0 = *(const GAS u32x2*)(row + 4 * g), a1 = *(const GAS u32x2*)(row + 16 + 4 * g), b0 = *(const GAS u32x2*)(row + 32 + 4 * g), b1 = *(const GAS u32x2*)(row + 48 + 4 * g);
    const float x1[8] = {bflo(a0.x), bfhi(a0.x), bflo(a0.y), bfhi(a0.y), bflo(a1.x), bfhi(a1.x), bflo(a1.y), bfhi(a1.y)};
    const float x2[8] = {bflo(b0.x), bfhi(b0.x), bflo(b0.y), bfhi(b0.y), bflo(b1.x), bfhi(b1.x), bflo(b1.y), bfhi(b1.y)};
    float o1[8], o2[8];
#pragma unroll
    for (int j = 0; j < 8; ++j) { const f32x2 t = cs[(j < 4 ? 4 * g + j : 16 + 4 * g + (j - 4))]; o1[j] = (x1[j] * t.x - x2[j] * t.y) * scale; o2[j] = (x2[j] * t.x + x1[j] * t.y) * scale; }
    f[0] = __builtin_bit_cast(s16x8, pack8(o1)); f[1] = __builtin_bit_cast(s16x8, pack8(o2));
}
__device__ __forceinline__ s16x8 ret_bfrag(const LAS unsigned char* img, int row0, int eb, int g, int q, int p) {
    const int r1 = row0 + 4 * g + q;
    const LAS unsigned char* a1 = img + r1 * 256 + ((eb ^ (r1 & 7)) << 5) + 8 * p;
    const LAS unsigned char* a2 = img + (r1 + 16) * 256 + ((eb ^ ((r1 + 16) & 7)) << 5) + 8 * p;
    const s16x4 lo = tr16(a1), hi = tr16(a2);
    return (s16x8){lo[0], lo[1], lo[2], lo[3], hi[0], hi[1], hi[2], hi[3]};
}

__device__ __forceinline__ void ret_state_mfma(const Ctx& F) {
    const bf16* Z = (const bf16*)(F.ws + WS_Z); float* RS = (float*)(F.ws + WS_HDN);
    const f32x2* R64 = (const f32x2*)(F.ws + WS_ROPE64);
    LAS unsigned char* Kimg = F.lds; LAS unsigned char* Vimg = F.lds + 16384;
    const int lane = F.lane, g = lane >> 4, c = lane & 15, q = (lane >> 2) & 3, p = lane & 3;
    for (int u = blockIdx.x; u < NB * 32 * 4; u += F.G) {
        const int h = u & 3, ch = (u >> 2) & 31, b = u >> 7; const float l2g = ret_l2g(h);
        const bf16* base = Z + ((size_t)b * SEQ + ch * 128) * ZP;
        __syncthreads();
        for (int t = F.tid; t < 2048; t += 512) { const int r = t >> 4, c16 = t & 15;
            *(LAS v4u*)(Vimg + r * 256 + (((c16 >> 1) ^ (r & 7)) << 5) + ((c16 & 1) << 4)) = *(const GAS v4u*)(base + (size_t)r * ZP + Z_RV + h * 128 + c16 * 8); }
        for (int t = F.tid; t < 1024; t += 512) { const int j = t >> 3, dg = t & 7; const bf16* row = base + (size_t)j * ZP + Z_RK + h * 64;
            const u32x2 a = *(const GAS u32x2*)(row + 4 * dg), bb = *(const GAS u32x2*)(row + 32 + 4 * dg);
            const float x1[4] = {bflo(a.x), bfhi(a.x), bflo(a.y), bfhi(a.y)}, x2[4] = {bflo(bb.x), bfhi(bb.x), bflo(bb.y), bfhi(bb.y)};
            const f32x2* cs = R64 + (ch * 128 + j) * 32 + 4 * dg; const float sc = exp2f((float)(127 - j) * l2g);
            float o1[4], o2[4];
#pragma unroll
            for (int e = 0; e < 4; ++e) { const f32x2 tt = cs[e]; o1[e] = (x1[e] * tt.x - x2[e] * tt.y) * sc; o2[e] = (x2[e] * tt.x + x1[e] * tt.y) * sc; }
            u32x2 w1, w2; w1.x = pk2(o1[0], o1[1]); w1.y = pk2(o1[2], o1[3]); w2.x = pk2(o2[0], o2[1]); w2.y = pk2(o2[2], o2[3]);
            const int sw = (j >> 1) & 3; const int d1 = 4 * dg, d2 = 32 + 4 * dg;
            *(LAS u32x2*)(Kimg + j * 128 + ((((2 * d1) >> 5) ^ sw) << 5) + ((2 * d1) & 31)) = w1;
            *(LAS u32x2*)(Kimg + j * 128 + ((((2 * d2) >> 5) ^ sw) << 5) + ((2 * d2) & 31)) = w2; }
        __syncthreads();
        f32x4 acc[4];
#pragma unroll
        for (int db = 0; db < 4; ++db) acc[db] = (f32x4){0.f, 0.f, 0.f, 0.f};
#pragma unroll
        for (int s = 0; s < 4; ++s) {
            const s16x8 vb = ret_bfrag(Vimg, 32 * s, F.wave, g, q, p);
            const int r1 = 32 * s + 4 * g + q, sw = (r1 >> 1) & 3;
#pragma unroll
            for (int db = 0; db < 4; ++db) { const LAS unsigned char* a1 = Kimg + r1 * 128 + ((db ^ sw) << 5) + 8 * p;
                const s16x4 lo = tr16(a1), hi = tr16(a1 + 2048);
                const s16x8 ka = (s16x8){lo[0], lo[1], lo[2], lo[3], hi[0], hi[1], hi[2], hi[3]};
                acc[db] = __builtin_amdgcn_mfma_f32_16x16x32_bf16(ka, vb, acc[db], 0, 0, 0); }
        }
        float* o = RS + (size_t)u * 8192 + 16 * F.wave + c;
#pragma unroll
        for (int db = 0; db < 4; ++db)
#pragma unroll
            for (int r = 0; r < 4; ++r) o[(16 * db + 4 * g + r) * 128] = acc[db][r];
    }
    __syncthreads();
}

__device__ __forceinline__ void ret_scan(const Ctx& F) {
    const float* RS = (const float*)(F.ws + WS_HDN); float* SC = (float*)(F.ws + WS_HDN + 16 * MiB);
    for (int t = blockIdx.x * 512 + F.tid; t < NB * 4 * 8192; t += F.G * 512) {
        const int el = t & 8191, h = (t >> 13) & 3, b = t >> 15; const float wch = exp2f(128.f * ret_l2g(h)); float s = 0.f;
        float L[32];
#pragma unroll
        for (int ch = 0; ch < 32; ++ch) L[ch] = RS[(size_t)(((b * 32 + ch) * 4 + h)) * 8192 + el];
#pragma unroll
        for (int ch = 0; ch < 32; ++ch) { SC[(size_t)(((b * 32 + ch) * 4 + h)) * 8192 + el] = s; s = wch * s + L[ch]; }
    }
}

__device__ __forceinline__ void ret_out_mfma(const Ctx& F, const float* gn, bool dummy_out = false) {
    bf16* Z = (bf16*)(F.ws + WS_Z); const float* SC = (const float*)(F.ws + WS_HDN + 16 * MiB);
    const f32x2* R64 = (const f32x2*)(F.ws + WS_ROPE64);
    LAS unsigned char* Vimg = F.lds; LAS unsigned char* Simg = F.lds + 32768; LAS unsigned char* Kimg = F.lds + 49152;
    const int lane = F.lane, g = lane >> 4, c = lane & 15, q = (lane >> 2) & 3, p = lane & 3, w = F.wave;
    for (int u = blockIdx.x; u < NB * 32 * 4; u += F.G) {
        const int h = u & 3, ch = (u >> 2) & 31, b = u >> 7; const float l2g = ret_l2g(h); const float gam = exp2f(l2g);
        bf16* base = Z + ((size_t)b * SEQ + ch * 128) * ZP;
        __syncthreads();
        for (int t = F.tid; t < 2048; t += 512) { const int r = t >> 4, c16 = t & 15;
            *(LAS v4u*)(Vimg + r * 256 + (((c16 >> 1) ^ (r & 7)) << 5) + ((c16 & 1) << 4)) = *(const GAS v4u*)(base + (size_t)r * ZP + Z_RV + h * 128 + c16 * 8); }
        for (int t = F.tid; t < 1024; t += 512) { const int r = t >> 4, c16 = t & 15; const float* sp = SC + (size_t)u * 8192 + r * 128 + c16 * 8;
            const f32x4 s0 = *(const GAS f32x4*)sp, s1 = *(const GAS f32x4*)(sp + 4);
            v4u wv; wv.x = pk2(s0.x * gam, s0.y * gam); wv.y = pk2(s0.z * gam, s0.w * gam); wv.z = pk2(s1.x * gam, s1.y * gam); wv.w = pk2(s1.z * gam, s1.w * gam);
            *(LAS v4u*)(Simg + r * 256 + (((c16 >> 1) ^ (r & 7)) << 5) + ((c16 & 1) << 4)) = wv; }
        for (int t = F.tid; t < 1024; t += 512) { const int j = t >> 3, dg = t & 7; const bf16* row = base + (size_t)j * ZP + Z_RK + h * 64;
            const u32x2 a = *(const GAS u32x2*)(row + 4 * dg), bb = *(const GAS u32x2*)(row + 32 + 4 * dg);
            const float x1[4] = {bflo(a.x), bfhi(a.x), bflo(a.y), bfhi(a.y)}, x2[4] = {bflo(bb.x), bfhi(bb.x), bflo(bb.y), bfhi(bb.y)};
            const f32x2* cs = R64 + (ch * 128 + j) * 32 + 4 * dg; const float sc = exp2f(-(float)j * l2g);
            float o1[4], o2[4];
#pragma unroll
            for (int e = 0; e < 4; ++e) { const f32x2 tt = cs[e]; o1[e] = (x1[e] * tt.x - x2[e] * tt.y) * sc; o2[e] = (x2[e] * tt.x + x1[e] * tt.y) * sc; }
            u32x2 w1, w2; w1.x = pk2(o1[0], o1[1]); w1.y = pk2(o1[2], o1[3]); w2.x = pk2(o2[0], o2[1]); w2.y = pk2(o2[2], o2[3]);
            const int sw = (j >> 1) & 3; const int d1 = 4 * dg, d2 = 32 + 4 * dg;
            *(LAS u32x2*)(Kimg + j * 128 + ((((2 * d1) >> 5) ^ sw) << 5) + ((2 * d1) & 31)) = w1;
            *(LAS u32x2*)(Kimg + j * 128 + ((((2 * d2) >> 5) ^ sw) << 5) + ((2 * d2) & 31)) = w2; }
        const int i = 16 * w + c; s16x8 qf[2];
        float sc8 = 0.125f; asm volatile("" : "+v"(sc8));
        ret_rope_frag(base + (size_t)i * ZP + Z_RQ + h * 64, R64 + (ch * 128 + i) * 32, sc8 * exp2f((float)i * l2g), g, qf);
        __syncthreads();
        f32x4 acc[8];
#pragma unroll
        for (int t = 0; t < 8; ++t) { acc[t] = (f32x4){0.f, 0.f, 0.f, 0.f};
            if (t <= w) { const int j = 16 * t + c; const int sw = (j >> 1) & 3; const LAS unsigned char* kr = Kimg + j * 128;
                const u32x2 a0 = *(const LAS u32x2*)(kr + ((((8 * g) >> 5) ^ sw) << 5) + ((8 * g) & 31)), a1 = *(const LAS u32x2*)(kr + ((((32 + 8 * g) >> 5) ^ sw) << 5) + ((32 + 8 * g) & 31));
                const u32x2 b0 = *(const LAS u32x2*)(kr + ((((64 + 8 * g) >> 5) ^ sw) << 5) + ((64 + 8 * g) & 31)), b1 = *(const LAS u32x2*)(kr + ((((96 + 8 * g) >> 5) ^ sw) << 5) + ((96 + 8 * g) & 31));
                const s16x8 kf0 = __builtin_bit_cast(s16x8, (v4u){a0.x, a0.y, a1.x, a1.y}), kf1 = __builtin_bit_cast(s16x8, (v4u){b0.x, b0.y, b1.x, b1.y});
                acc[t] = __builtin_amdgcn_mfma_f32_16x16x32_bf16(kf0, qf[0], acc[t], 0, 0, 0); acc[t] = __builtin_amdgcn_mfma_f32_16x16x32_bf16(kf1, qf[1], acc[t], 0, 0, 0);
                if (t == w) {
#pragma unroll
                    for (int r = 0; r < 4; ++r) if (4 * g + r > c) acc[t][r] = 0.f; } } }
        s16x8 pf[4];
#pragma unroll
        for (int s = 0; s < 4; ++s) { v4u wv; wv.x = pk2(acc[2 * s][0], acc[2 * s][1]); wv.y = pk2(acc[2 * s][2], acc[2 * s][3]); wv.z = pk2(acc[2 * s + 1][0], acc[2 * s + 1][1]); wv.w = pk2(acc[2 * s + 1][2], acc[2 * s + 1][3]);
            pf[s] = __builtin_bit_cast(s16x8, wv); }
        f32x4 o[8];
#pragma unroll
        for (int eb = 0; eb < 8; ++eb) o[eb] = (f32x4){0.f, 0.f, 0.f, 0.f};
#pragma unroll
        for (int s = 0; s < 4; ++s) if (2 * s <= w) {
#pragma unroll
            for (int eb = 0; eb < 8; ++eb) o[eb] = __builtin_amdgcn_mfma_f32_16x16x32_bf16(pf[s], ret_bfrag(Vimg, 32 * s, eb, g, q, p), o[eb], 0, 0, 0); }
#pragma unroll
        for (int ks = 0; ks < 2; ++ks)
#pragma unroll
            for (int eb = 0; eb < 8; ++eb) o[eb] = __builtin_amdgcn_mfma_f32_16x16x32_bf16(qf[ks], ret_bfrag(Simg, 32 * ks, eb, g, q, p), o[eb], 0, 0, 0);
        float rs[4];
#pragma unroll
        for (int r = 0; r < 4; ++r) { float ss = 0.f;
#pragma unroll
            for (int eb = 0; eb < 8; ++eb) ss += o[eb][r] * o[eb][r];
            ss += sx<1>(ss); ss += sx<2>(ss); ss += sx<4>(ss); ss += sx<8>(ss);
            rs[r] = 1.0f / sqrtf(ss * (1.f / 128) + NORM_EPS); }
#pragma unroll
        for (int r = 0; r < 4; ++r) { bf16* zr = base + (size_t)(16 * w + 4 * g + r) * ZP; bf16* zw = dummy_out ? (bf16*)(F.ws + WS_ZS) + ((size_t)b * SEQ + ch * 128 + 16 * w + 4 * g + r) * 1024 - Z_RV : zr;
#pragma unroll
            for (int eb = 0; eb < 8; ++eb) { const int e = 16 * eb + c; const float rg = bf2f(zr[Z_RG + h * 128 + e]);
                zw[Z_RV + h * 128 + e] = (bf16)f2bf(o[eb][r] * rs[r] * gn[h * 128 + e] * rg * sigmoid_f(rg)); } }
    }
    __syncthreads();
}

__device__ __forceinline__ void fscan_phase(const Ctx& F) {
    const float* LF = (const float*)(F.ws + WS_LF); float* CF = (float*)(F.ws + WS_CF);
    LAS float* wsum = (LAS float*)(F.lds);
    const int seq = (int)blockIdx.x;
    if (seq < 32) {
        const int b = seq >> 3, h = seq & 7; const int p0 = F.tid * 8; const float* lp = LF + ((size_t)b * SEQ + p0) * 8 + h;
        float v[8]; float s = 0.f;
#pragma unroll
        for (int i = 0; i < 8; ++i) { v[i] = lp[i * 8]; }
#pragma unroll
        for (int i = 0; i < 8; ++i) { s += v[i]; v[i] = s; }
        float incl = s;
#pragma unroll
        for (int o = 1; o < 64; o <<= 1) { const float t = __builtin_bit_cast(float, __builtin_amdgcn_ds_bpermute(((F.lane - o) & 63) << 2, __builtin_bit_cast(int, incl))); if (F.lane >= o) incl += t; }
        if (F.lane == 63) wsum[F.wave] = incl;
        __syncthreads();
        float woff = 0.f;
#pragma unroll
        for (int ww = 0; ww < 8; ++ww) { const float t = wsum[ww]; if (ww < F.wave) woff += t; }
        const float base = woff + (incl - s);
        float* cp = CF + (size_t)seq * SEQ + p0;
        *(GAS f32x4*)cp = (f32x4){base + v[0], base + v[1], base + v[2], base + v[3]}; *(GAS f32x4*)(cp + 4) = (f32x4){base + v[4], base + v[5], base + v[6], base + v[7]};
    }
    __syncthreads();
}
#include <hip/hip_bf16.h>
#include <cmath>
namespace attn_body {
using bf16=__hip_bfloat16;
using bf16x8=__attribute__((ext_vector_type(8)))short;
using s16x4=__attribute__((ext_vector_type(4)))short;
using f32x16=__attribute__((ext_vector_type(16)))float;
using u32x4=__attribute__((ext_vector_type(4)))unsigned;
constexpr int BATCH=4,NHEAD=8,SEQ=4096,D=64,DM=6656;
constexpr int NW=8,QBLK=32,QB=QBLK*NW,KVBLK=64,NQB=SEQ/QB;
constexpr int ATTN_PITCH=DM, ATTN_UNIT_ROWS=QB;
__device__ __forceinline__ int crow(int r,int hi){return (r&3)+8*(r>>2)+4*hi;}
#define SBAR() __builtin_amdgcn_sched_barrier(0)
__device__ __forceinline__ void cmask(f32x16&p0,f32x16&p1,int jb,int qrel,int hi){
  const float NEG=-INFINITY; int kb=64*jb+4*hi;
  #pragma unroll
  for(int r=0;r<16;++r){int kv=kb+(r&3)+8*(r>>2); if(kv>qrel)p0[r]=NEG; if(kv+32>qrel)p1[r]=NEG;}
}

constexpr int NSLOT=3, SLOTB=8192;
constexpr int LDS_K=0, LDS_V=NSLOT*SLOTB, LDS_WS=2*NSLOT*SLOTB, LDS_OST=LDS_WS+NW*64*4, LDS_NC=LDS_OST+NW*4096, LDS_BYTES=LDS_NC+SEQ*4;
constexpr float C2=0.125f*1.4426950408889634f;
__device__ __forceinline__ void glds16(const void*gsrc,unsigned lds_dst){unsigned keep;
  asm volatile("s_mov_b32 %0, m0\n\ts_mov_b32 m0, %2\n\ts_nop 0\n\tglobal_load_lds_dwordx4 %1, off\n\ts_mov_b32 m0, %0":"=&s"(keep):"v"(gsrc),"s"(lds_dst):"memory");}
__device__ __forceinline__ float max3f(float a,float b,float c){float r;asm("v_max3_f32 %0, %1, %2, %3":"=v"(r):"v"(a),"v"(b),"v"(c));return r;}
__device__ __forceinline__ float max2f(float a,float b){float r;asm("v_max_f32_e32 %0, %1, %2":"=v"(r):"v"(a),"v"(b));return r;}
__device__ __forceinline__ float fadd_s(float a,float b){float r;asm("v_add_f32_e32 %0, %1, %2":"=v"(r):"v"(a),"v"(b));return r;}
__device__ __forceinline__ float fsub_s(float a,float b){float r;asm("v_sub_f32_e32 %0, %1, %2":"=v"(r):"v"(a),"v"(b));return r;}
typedef float f32x4_t __attribute__((ext_vector_type(4))); typedef float f32x2_t __attribute__((ext_vector_type(2))); typedef __bf16 bf16x2_t __attribute__((ext_vector_type(2)));
__device__ __forceinline__ unsigned cvtpk_s(float lo,float hi){f32x2_t v={lo,hi};bf16x2_t b=__builtin_convertvector(v,bf16x2_t);return __builtin_bit_cast(unsigned,b);}
#define WAIT_BAR(N) asm volatile("s_waitcnt vmcnt(" #N ") lgkmcnt(0)\n\ts_barrier":::"memory")

__device__ __forceinline__ void qkt(f32x16&p0,f32x16&p1,const char*Kslot,const bf16x8*qr,const f32x16&negm,int r32,int hi){
  const char*kb=Kslot+hi*1024+r32*16;
  #pragma unroll
  for(int d0=0;d0<4;++d0){
    const bf16x8 b0=*reinterpret_cast<const bf16x8*>(kb+d0*2048);
    const bf16x8 b1=*reinterpret_cast<const bf16x8*>(kb+d0*2048+512);
    if(d0==0){p0=__builtin_amdgcn_mfma_f32_32x32x16_bf16(b0,qr[0],negm,0,0,0);p1=__builtin_amdgcn_mfma_f32_32x32x16_bf16(b1,qr[0],negm,0,0,0);}
    else{p0=__builtin_amdgcn_mfma_f32_32x32x16_bf16(b0,qr[d0],p0,0,0,0);p1=__builtin_amdgcn_mfma_f32_32x32x16_bf16(b1,qr[d0],p1,0,0,0);}}
}
typedef __attribute__((address_space(3))) const char* lds_cptr;
typedef short v4i16_t __attribute__((ext_vector_type(4)));
__device__ __forceinline__ void kload8(bf16x8*kf,lds_cptr kp){
  kf[0]=*(const __attribute__((address_space(3))) bf16x8*)(kp);      kf[1]=*(const __attribute__((address_space(3))) bf16x8*)(kp+512);
  kf[2]=*(const __attribute__((address_space(3))) bf16x8*)(kp+2048); kf[3]=*(const __attribute__((address_space(3))) bf16x8*)(kp+2560);
  kf[4]=*(const __attribute__((address_space(3))) bf16x8*)(kp+4096); kf[5]=*(const __attribute__((address_space(3))) bf16x8*)(kp+4608);
  kf[6]=*(const __attribute__((address_space(3))) bf16x8*)(kp+6144); kf[7]=*(const __attribute__((address_space(3))) bf16x8*)(kp+6656);
}
__device__ __forceinline__ void kload2(bf16x8*kf,lds_cptr kp,int j){ kf[2*j]=*(const __attribute__((address_space(3))) bf16x8*)(kp+j*2048); kf[2*j+1]=*(const __attribute__((address_space(3))) bf16x8*)(kp+j*2048+512); }
__device__ __forceinline__ s16x4 vtr(lds_cptr p){ return __builtin_bit_cast(s16x4,__builtin_amdgcn_ds_read_tr16_b64_v4i16((__attribute__((address_space(3))) v4i16_t*)p)); }
__device__ __forceinline__ float rowmax(const f32x16&p0,const f32x16&p1){
  float a=max3f(p0[0],p0[1],p1[0]),b=max3f(p0[2],p0[3],p1[1]);a=max3f(a,p1[2],p1[3]);
  #pragma unroll
  for(int r=4;r<16;r+=4){a=max3f(a,p0[r],p0[r+1]);b=max3f(b,p0[r+2],p0[r+3]);a=max3f(a,p1[r],p1[r+1]);b=max3f(b,p1[r+2],p1[r+3]);}
  const float m=max2f(a,b);
  auto rr=__builtin_amdgcn_permlane32_swap(__float_as_uint(m),__float_as_uint(m),false,false);
  return max2f(__uint_as_float(rr[0]),__uint_as_float(rr[1]));
}
__device__ __forceinline__ void pv(f32x16*o,int vb,bf16x8 pa0,bf16x8 pa1,bf16x8 pa2,bf16x8 pa3){
  #pragma unroll
  for(int d0=0;d0<2;++d0){s16x4 lo[4],hi[4];
    #pragma unroll
    for(int ks=0;ks<4;++ks){
      asm volatile("ds_read_b64_tr_b16 %0,%1 offset:%c2":"=&v"(lo[ks]):"v"(vb),"i"(d0*4096+ks*1024):"memory");
      asm volatile("ds_read_b64_tr_b16 %0,%1 offset:%c2":"=&v"(hi[ks]):"v"(vb),"i"(d0*4096+ks*1024+512):"memory");}
    asm volatile("s_waitcnt lgkmcnt(0)":::"memory");SBAR();
    #define PK(k) (bf16x8){lo[k][0],lo[k][1],lo[k][2],lo[k][3],hi[k][0],hi[k][1],hi[k][2],hi[k][3]}
    o[d0]=__builtin_amdgcn_mfma_f32_32x32x16_bf16(pa0,PK(0),o[d0],0,0,0);
    o[d0]=__builtin_amdgcn_mfma_f32_32x32x16_bf16(pa1,PK(1),o[d0],0,0,0);
    o[d0]=__builtin_amdgcn_mfma_f32_32x32x16_bf16(pa2,PK(2),o[d0],0,0,0);
    o[d0]=__builtin_amdgcn_mfma_f32_32x32x16_bf16(pa3,PK(3),o[d0],0,0,0);
    #undef PK
  }
}

#ifndef ATTN_STORE16
#define ATTN_STORE16(p,v) (*(u32x4*)(p)=(v))
#endif
template<int THRL> __device__ __forceinline__ void attn_unit(int b,int h,int qb,const bf16*Q,const bf16*__restrict__ K,const bf16*__restrict__ V,bf16*O,const float*CF,float dskip,char*shm,int wave_id){
  int tid_=(wave_id<<6)|lane_id_v(); asm volatile("":"+v"(tid_));
  const int tid=tid_,lane=tid&63,r32=lane&31,hi=lane>>5; const int wid=__builtin_amdgcn_readfirstlane(tid>>6);
  const long rowbase=(long)b*SEQ; const int q0=qb*QB;
  const bf16*Qw=Q+(rowbase+q0+wid*QBLK)*DM+h*D;
  const float*cfp0=CF+(long)(b*NHEAD+h)*SEQ; const int NT0=(q0+QB)/KVBLK;
  int ts; { const float cq=cfp0[q0]; const int il=(lane<NT0)?64*lane+63:q0; const bool keep=(lane<NT0)&&(cfp0[il]<cq+dskip);
    const unsigned long long km=__ballot(keep); int t0=(int)__builtin_ctzll(km|(1ull<<63)); t0&=~1; ts=__builtin_amdgcn_readfirstlane(t0<NT0-4?t0:NT0-4); }
  const bf16*Kh=K+(rowbase+(long)ts*KVBLK)*DM+h*D,*Vh=V+(rowbase+(long)ts*KVBLK)*DM+h*D;
  const unsigned lds0=(unsigned)(uintptr_t)shm;
  float*wsf=(float*)(shm+LDS_WS)+wid*64;
  const bf16*ksrc=Kh+(long)lane*DM+wid*8;
  const bf16*vsrc=Vh+(long)(16*(wid&3)+(lane>>2))*DM+(wid>>2)*32+(lane&3)*8;
  const unsigned kdst=lds0+LDS_K+wid*1024, vdst=lds0+LDS_V+wid*1024;
  #define DMA_K(t,slot) glds16(ksrc+(long)(t)*KVBLK*DM,(unsigned)__builtin_amdgcn_readfirstlane(kdst+(slot)))
  #define DMA_V(t,slot) glds16(vsrc+(long)(t)*KVBLK*DM,(unsigned)__builtin_amdgcn_readfirstlane(vdst+(slot)))
  const char*Kbase=shm+LDS_K; bf16x8 kf[8];
  const lds_cptr shm3=(lds_cptr)shm; const lds_cptr kp0=shm3+LDS_K+hi*1024+r32*16; const lds_cptr vp0=shm3+LDS_V+((lane>>4)&1)*32+(lane&3)*8+(4*hi+((lane&15)>>2))*64;
  const int NT=NT0-ts;
  { const float*cfp=CF+(long)(b*NHEAD+h)*SEQ; float*ncw=(float*)(shm+LDS_NC);
    for(int i=tid+ts*KVBLK;i<q0+QB;i+=NW*64)ncw[i-ts*KVBLK]=-cfp[i]; }
  const lds_cptr ncp=(lds_cptr)shm+LDS_NC+hi*16;
  #define ADDC(P0,P1,t) do{ const lds_cptr np_=ncp+(t)*256; _Pragma("unroll") for(int g_=0;g_<4;++g_){ \
      const f32x4_t a_=*(const __attribute__((address_space(3))) f32x4_t*)(np_+g_*32), b_=*(const __attribute__((address_space(3))) f32x4_t*)(np_+g_*32+128); \
      P0[4*g_]+=a_[0];P0[4*g_+1]+=a_[1];P0[4*g_+2]+=a_[2];P0[4*g_+3]+=a_[3]; P1[4*g_]+=b_[0];P1[4*g_+1]+=b_[1];P1[4*g_+2]+=b_[2];P1[4*g_+3]+=b_[3]; } }while(0)
  DMA_K(0,0);DMA_V(0,0);DMA_K(1,SLOTB);
  bf16x8 qr[4];
  #pragma unroll
  for(int d0=0;d0<4;++d0)qr[d0]=*reinterpret_cast<const bf16x8*>(&Qw[(long)r32*DM+d0*16+hi*8]);
  float mhat=0.f,l_reg=0.f;f32x16 o[2];f32x16 negm; { float zz_; asm volatile("v_mov_b32 %0, 0":"=v"(zz_));
    _Pragma("unroll") for(int r=0;r<16;++r){o[0][r]=zz_;o[1][r]=zz_;negm[r]=zz_;} } asm volatile("":"+v"(negm));
  const int qrel=wid*QBLK+r32;
  #define CMASK(P0,P1,t) do{int jb_=(t)-(NT-4); if(jb_>=0)cmask(P0,P1,jb_,qrel,hi);}while(0)
  bool resc=false;
  #define START(P0,P1) do{ const float rm=rowmax(P0,P1); resc=false; \
    { const float dl=rm; mhat=fadd_s(mhat,dl); \
      _Pragma("unroll") for(int r=0;r<16;++r){P0[r]=fsub_s(P0[r],dl);P1[r]=fsub_s(P1[r],dl);} \
      _Pragma("unroll") for(int r=0;r<16;++r)negm[r]=-mhat; asm volatile("":"+v"(negm)); } \
    _Pragma("unroll") for(int r=0;r<16;++r)P0[r]=__builtin_amdgcn_exp2f(P0[r]); }while(0)
  #define RESC() do{ if(resc){ asm volatile("s_waitcnt lgkmcnt(0)":::"memory"); \
      _Pragma("unroll") for(int d_=0;d_<2;++d_) _Pragma("unroll") for(int r=0;r<16;++r)o[d_][r]*=wsf[crow(r,hi)]; } }while(0)
  f32x16 pA0,pA1,pB0,pB1;
  int sl_prev=0,sl_cur=0,sl_next=SLOTB;
  #define ROT() do{sl_prev=sl_cur;sl_cur=sl_next;sl_next=(sl_next==(NSLOT-1)*SLOTB)?0:sl_next+SLOTB;}while(0)
  DMA_K(2,2*SLOTB);
  WAIT_BAR(3);
  qkt(pA0,pA1,Kbase,qr,negm,r32,hi);asm volatile("s_nop 15\n\ts_nop 7":"+v"(pA0),"+v"(pA1));ADDC(pA0,pA1,0);CMASK(pA0,pA1,0);
  START(pA0,pA1);
  _Pragma("unroll") for(int r=0;r<16;++r)pA1[r]=__builtin_amdgcn_exp2f(pA1[r]);
  WAIT_BAR(0);
  DMA_K(3,0);DMA_V(1,SLOTB);
  ROT();
  kload8(kf,kp0+sl_cur);
  WAIT_BAR(2);
  s16x4 vlo[8],vhi[8]; u32x4 pw0,pw1,pw2,pw3;
  #define PKW(P,B) cvtpk_s(P[B],P[B+1])
  #define PAF(k) __builtin_bit_cast(bf16x8,pw##k)
  #define VFR(i) (bf16x8){vlo[i][0],vlo[i][1],vlo[i][2],vlo[i][3],vhi[i][0],vhi[i][1],vhi[i][2],vhi[i][3]}
  #define PIN(x) asm volatile("":"+v"(x))
  #define MX3(a,b,c) __builtin_fmaxf(__builtin_fmaxf((a),(b)),(c))
  #define GAPA(MF,A0,A1,A2,A3,W0,W1,PW) do{ MF; sacc+=A0; sacc+=A1; sacc+=A2; sacc+=A3; PIN(sacc); W0; W1; PIN(PW); SBAR(); }while(0)
  #define EX(v) __builtin_amdgcn_exp2f(v)
  #define GAPB(MF,X,B) do{ MF; X[B]=EX(X[B]); X[B+1]=EX(X[B+1]); X[B+2]=EX(X[B+2]); X[B+3]=EX(X[B+3]); PIN(X); SBAR(); }while(0)
  #define VRD(i) do{ vlo[i]=vtr(vp_+(((i)>>2)*4096+((i)&3)*1024)); vhi[i]=vtr(vp_+(((i)>>2)*4096+((i)&3)*1024+512)); }while(0)
  #define KRD(G,j) do{ if(G){ kload2(kf,kp0+sl_next,j); SBAR(); } }while(0)
  #define STEP(C0,C1,P0,P1,t,GK,GV,GL) do{ SBAR(); \
    const lds_cptr vp_=vp0+sl_prev; \
    VRD(0); SBAR(); float sacc=(P0[0]+P0[1]); \
    GAPA(C0=__builtin_amdgcn_mfma_f32_32x32x16_bf16(kf[0],qr[0],negm,0,0,0), P0[2],P0[3],P0[4],P0[5],     pw0[0]=PKW(P0,0), pw0[1]=PKW(P0,2), pw0); \
    VRD(4); SBAR(); GAPA(C1=__builtin_amdgcn_mfma_f32_32x32x16_bf16(kf[1],qr[0],negm,0,0,0), P0[6],P0[7],P0[8],P0[9],     pw0[2]=PKW(P0,4), pw0[3]=PKW(P0,6), pw0); \
    VRD(1); SBAR(); GAPA(C0=__builtin_amdgcn_mfma_f32_32x32x16_bf16(kf[2],qr[1],C0,0,0,0),   P0[10],P0[11],P0[12],P0[13], pw1[0]=PKW(P0,8), pw1[1]=PKW(P0,10), pw1); \
    VRD(5); SBAR(); GAPA(C1=__builtin_amdgcn_mfma_f32_32x32x16_bf16(kf[3],qr[1],C1,0,0,0),   P0[14],P0[15],P1[0],P1[1],   pw1[2]=PKW(P0,12),pw1[3]=PKW(P0,14), pw1); \
    VRD(2); SBAR(); GAPA(C0=__builtin_amdgcn_mfma_f32_32x32x16_bf16(kf[4],qr[2],C0,0,0,0),   P1[2],P1[3],P1[4],P1[5],     pw2[0]=PKW(P1,0), pw2[1]=PKW(P1,2), pw2); \
    VRD(6); SBAR(); GAPA(C1=__builtin_amdgcn_mfma_f32_32x32x16_bf16(kf[5],qr[2],C1,0,0,0),   P1[6],P1[7],P1[8],P1[9],     pw2[2]=PKW(P1,4), pw2[3]=PKW(P1,6), pw2); \
    VRD(3); SBAR(); GAPA(C0=__builtin_amdgcn_mfma_f32_32x32x16_bf16(kf[6],qr[3],C0,0,0,0),   P1[10],P1[11],P1[12],P1[13], pw3[0]=PKW(P1,8), pw3[1]=PKW(P1,10), pw3); \
    VRD(7); SBAR(); GAPA(C1=__builtin_amdgcn_mfma_f32_32x32x16_bf16(kf[7],qr[3],C1,0,0,0),   P1[14],P1[15],0.f,0.f,       pw3[2]=PKW(P1,12),pw3[3]=PKW(P1,14), pw3); \
    l_reg+=sacc; \
    if(GK){DMA_K((t)+3,sl_cur);} if(GV){DMA_V((t)+1,sl_next);} \
    ADDC(C0,C1,t); CMASK(C0,C1,t); \
    { float a=MX3(C0[0],C0[1],C1[0]),b=MX3(C0[2],C0[3],C1[1]); a=MX3(a,C1[2],C1[3]); \
      _Pragma("unroll") for(int r=4;r<16;r+=4){a=MX3(a,C0[r],C0[r+1]);b=MX3(b,C0[r+2],C0[r+3]);a=MX3(a,C1[r],C1[r+1]);b=MX3(b,C1[r+2],C1[r+3]);} \
      float rm=__builtin_fmaxf(a,b); { auto rr=__builtin_amdgcn_permlane32_swap(__float_as_uint(rm),__float_as_uint(rm),false,false); rm=__builtin_fmaxf(__uint_as_float(rr[0]),__uint_as_float(rr[1])); } \
      resc=false; \
      if(__builtin_expect(__any(rm>(float)THRL),0)){ const float dl=__builtin_fmaxf(rm,0.f); mhat+=dl; \
        _Pragma("unroll") for(int r=0;r<16;++r){C0[r]-=dl;C1[r]-=dl;} \
        _Pragma("unroll") for(int r=0;r<16;++r)negm[r]=-mhat; asm volatile("":"+v"(negm)); \
        const float f=__builtin_amdgcn_exp2f(-dl); l_reg*=f; if(hi==0)wsf[r32]=f; resc=true; } } \
    SBAR(); \
    GAPB(o[0]=__builtin_amdgcn_mfma_f32_32x32x16_bf16(PAF(0),VFR(0),o[0],0,0,0), C0,0); \
    GAPB(o[1]=__builtin_amdgcn_mfma_f32_32x32x16_bf16(PAF(0),VFR(4),o[1],0,0,0), C0,4); \
    KRD(GL,0); GAPB(o[0]=__builtin_amdgcn_mfma_f32_32x32x16_bf16(PAF(1),VFR(1),o[0],0,0,0), C0,8); \
    KRD(GL,1); GAPB(o[1]=__builtin_amdgcn_mfma_f32_32x32x16_bf16(PAF(1),VFR(5),o[1],0,0,0), C0,12); \
    KRD(GL,2); GAPB(o[0]=__builtin_amdgcn_mfma_f32_32x32x16_bf16(PAF(2),VFR(2),o[0],0,0,0), C1,0); \
    KRD(GL,3); GAPB(o[1]=__builtin_amdgcn_mfma_f32_32x32x16_bf16(PAF(2),VFR(6),o[1],0,0,0), C1,4); \
    GAPB(o[0]=__builtin_amdgcn_mfma_f32_32x32x16_bf16(PAF(3),VFR(3),o[0],0,0,0), C1,8); \
    GAPB(o[1]=__builtin_amdgcn_mfma_f32_32x32x16_bf16(PAF(3),VFR(7),o[1],0,0,0), C1,12); \
    }while(0)
  int t=1;
  #undef CMASK
  #define CMASK(P0,P1,t) do{}while(0)
  for(;t+5<NT;t+=2){
    STEP(pB0,pB1,pA0,pA1,t,true,true,true);     WAIT_BAR(2); RESC(); ROT();
    STEP(pA0,pA1,pB0,pB1,t+1,true,true,true);   WAIT_BAR(2); RESC(); ROT();
  }
  #undef CMASK
  #define CMASK(P0,P1,t) do{int jb_=(t)-(NT-4); if(jb_>=0)cmask(P0,P1,jb_,qrel,hi);}while(0)
  #define ENDW(tt) do{ if((tt)+3<NT){WAIT_BAR(2);} else if((tt)+2<NT){WAIT_BAR(1);} else {WAIT_BAR(0);} }while(0)
  for(;t+1<NT;t+=2){
    STEP(pB0,pB1,pA0,pA1,t,(t+3<NT),(t+1<NT),(t+1<NT));       ENDW(t);   RESC(); ROT();
    STEP(pA0,pA1,pB0,pB1,t+1,(t+4<NT),(t+2<NT),(t+2<NT));     ENDW(t+1); RESC(); ROT();
  }
  STEP(pB0,pB1,pA0,pA1,NT-1,false,false,false); RESC();
  { float sacc=pB0[0]+pB0[1]; _Pragma("unroll") for(int r=2;r<16;++r)sacc+=pB0[r]; _Pragma("unroll") for(int r=0;r<16;++r)sacc+=pB1[r]; l_reg+=sacc;
    pw0=(u32x4){PKW(pB0,0),PKW(pB0,2),PKW(pB0,4),PKW(pB0,6)};pw1=(u32x4){PKW(pB0,8),PKW(pB0,10),PKW(pB0,12),PKW(pB0,14)};pw2=(u32x4){PKW(pB1,0),PKW(pB1,2),PKW(pB1,4),PKW(pB1,6)};pw3=(u32x4){PKW(pB1,8),PKW(pB1,10),PKW(pB1,12),PKW(pB1,14)};
    int tl_=lane_id_v(); asm volatile("":"+v"(tl_)); const int ln_=tl_&63,hi_=ln_>>5; const int vb0e=(int)(lds0+LDS_V)+((ln_>>4)&1)*32+(ln_&3)*8+(4*hi_+((ln_&15)>>2))*64;
    SBAR(); pv(o,vb0e+sl_cur,PAF(0),PAF(1),PAF(2),PAF(3)); }
  #undef PKW
  #undef PAF
  #undef VFR
  #undef PIN
  #undef MX3
  #undef GAPA
  #undef GAPB
  #undef EX
  #undef VRD
  #undef KRD
  #undef STEP
  #undef ENDW
  {auto rr=__builtin_amdgcn_permlane32_swap(__float_as_uint(l_reg),__float_as_uint(l_reg),false,false);l_reg=__uint_as_float(rr[0])+__uint_as_float(rr[1]);}
  int te_=lane_id_v(); asm volatile("":"+v"(te_)); const int lane_e=te_&63,r32_e=lane_e&31,hi_e=lane_e>>5;
  if(hi_e==0)wsf[32+r32_e]=l_reg;asm volatile("s_waitcnt lgkmcnt(0)":::"memory");
  float rli[16];
  #pragma unroll
  for(int r=0;r<16;++r)rli[r]=__builtin_amdgcn_rcpf(wsf[32+crow(r,hi_e)]);
  bf16*Ow=O+(rowbase+q0+wid*QBLK)*DM+h*D;
  { bf16*stg=(bf16*)(shm+LDS_OST)+wid*2048;
    #pragma unroll
    for(int r=0;r<16;++r){const int orow=crow(r,hi_e);
      #pragma unroll
      for(int d0=0;d0<2;++d0)stg[orow*64+d0*32+r32_e]=__float2bfloat16(o[d0][r]*rli[r]);}
    asm volatile("s_waitcnt lgkmcnt(0)":::"memory");
    #pragma unroll
    for(int i=0;i<4;++i){const int row=i*8+(lane_e>>3),ch=lane_e&7; const u32x4 v=*(const u32x4*)(stg+row*64+ch*8); ATTN_STORE16(Ow+(long)row*DM+ch*8,v);} }
  asm volatile("s_waitcnt lgkmcnt(0)\n\ts_barrier":::"memory");
  #undef ADDC
  #undef DMA_K
  #undef DMA_V
  #undef CMASK
  #undef START
  #undef RESC
  #undef ROT
}
constexpr int ATTN_LDS_BYTES=LDS_BYTES;
struct AttnTensors { const bf16* Q; const bf16* K; const bf16* V; bf16* O; const float* CF; float dskip; };
struct AttnUnit { int bh; int qb; };
struct StaticOrder {
  int vcu;
  __device__ __forceinline__ explicit StaticOrder(int grid,int block):vcu((block%8)*(grid/8)+block/8){}
  __device__ __forceinline__ bool next(int i,AttnUnit&u)const{ if(i>=2)return false; const int s=vcu&7; u.bh=vcu>>3; u.qb=(i==0)?s:15-s; return true; }
  __device__ __forceinline__ void a_ready(const AttnUnit&)const{}
  __device__ __forceinline__ void done(const AttnUnit&)const{}
};
template<class Sched,int THRL=8> __device__ __forceinline__ void attn_phase(char*lds,const AttnTensors&T,const Sched&S,int wave_id){
  AttnUnit u;
  for(int i=0;S.next(i,u);++i){ S.a_ready(u); attn_unit<THRL>(u.bh/NHEAD,u.bh%NHEAD,u.qb,T.Q,T.K,T.V,T.O,T.CF,T.dskip,lds,wave_id); S.done(u); }
}
#undef SBAR
#undef WAIT_BAR
}

struct Args { const float* in[16]; float* out; unsigned char* ws; };
__global__ void __launch_bounds__(NWAVES * 64, 2) hyb_fwd(Args args) {
    extern __shared__ __attribute__((aligned(16))) unsigned char lds[];
    Ctx F;
    F.lds = (LAS unsigned char*)lds;
    F.tid = threadIdx.x; F.lane = F.tid & 63; F.wave = __builtin_amdgcn_readfirstlane(F.tid >> 6);
    F.G = gridDim.x; F.gw = blockIdx.x * NWAVES + F.wave; F.NGW = F.G * NWAVES;
    F.out = args.out; F.ws = args.ws;
    volatile LAS unsigned* MISC = (volatile LAS unsigned*)(F.lds + MISC_OFF);
    for (int u = F.tid; u < (LDS_BYTES - LDSCTL_OFF) / 4; u += NWAVES * 64) ((LAS unsigned*)(F.lds + LDSCTL_OFF))[u] = 0u;
    __syncthreads();
    gu32* ctl = (gu32*)(F.ws + WS_CTL);
    XcdBarrier bar = xcd_barrier_post((unsigned*)(ctl + CW_BAR), MISC + 8); bar.w = F.wave;
#define FRESH(P) Ctx P = F; P.tid = (F.wave << 6) | lane_id_v(); asm volatile("" : "+v"(P.tid), "+s"(P.wave), "+s"(P.gw), "+s"(P.ws), "+s"(P.out)); P.lane = P.tid & 63
#define GRID_BAR() do { XcdBarrier b_ = bar; asm volatile("" : "+s"(b_.bar), "+s"(b_.x)); xcd_barrier(b_); } while (0)

    bf16* Wb = (bf16*)(F.ws + WS_W);
    bf16* Z = (bf16*)(F.ws + WS_Z); float* ZS = (float*)(F.ws + WS_ZS); bf16* HDN = (bf16*)(F.ws + WS_HDN);
    float* M32 = (float*)(F.ws + WS_HDN); bf16* HB = (bf16*)(F.ws + WS_Z);
    LAS unsigned char* ring = F.lds + RING_OFF; float* SSp = (float*)(F.ws + WS_SS); bf16* XA = (bf16*)F.out;

    { FRESH(P); p0_prologue(P, args.in[2], args.in[9], args.in[10], args.in[11], args.in[12], args.in[14], args.in[15], args.in[1], args.in[13]); }
    { FRESH(P); norm0_phase(P, args.in[0], (bf16*)P.out, (float*)(P.ws + WS_SS)); }
    GRID_BAR();
    if (F.wave == 0 && lane_id_v() == 0) { unsigned ok = (F.G == 256) ? 1u : 0u;
        for (unsigned j = 0; j < 16; ++j) { const unsigned c = xb_ld((unsigned*)(ctl + CW_BAR) + XB_XCNT(j)); if (c != (j < 8 ? 32u : 0u)) ok = 0u; }
        MISC[11] = ok; }
    __syncthreads();
    const int seam_loc = __builtin_amdgcn_readfirstlane((int)MISC[11]);
    const int cidx_ = __builtin_amdgcn_readfirstlane(seam_loc ? (int)(8u * MISC[10] + bar.x) : (int)blockIdx.x);
#define CIDX() cidx_
#define SEAM_BAR() do { XcdBarrier b_ = bar; asm volatile("" : "+s"(b_.bar), "+s"(b_.x)); if (seam_loc) xcd_local_barrier(b_); else xcd_barrier(b_); } while (0)

    #pragma unroll 1
    for (int layer = 0; layer < DEPTH; ++layer) {
        const bf16* L = Wb + (size_t)layer * LW_STRIDE;
        { pg8::Gemm g{XA, L + LW_IN, M, NIN, DM, DM, DM, 256 * DM}; pg8::StaticOrder S; S.init(M, NIN, F.G, CIDX());
          const pg8::PG8_LAS_F* RT = (const pg8::PG8_LAS_F*)(F.lds + XTRA_OFF); const int pmt = pg8::rstd_table((pg8::PG8_LAS_F*)(F.lds + XTRA_OFF), SSp, S, F.wave);
          pg8::EpiZ E{Z, ZS, SSp, args.in[4] + layer * 64, args.in[5] + layer * 64, args.in[6] + layer * 64, (const float*)(F.ws + WS_ROPE64), RT, pmt};
          pg8::gemm_phase<pg8::EpiZ, pg8::StaticOrder, true, true>(ring, g, S, E, F.wave); }
        GRID_BAR();
#ifdef PROBE_PP
        { FRESH(P); post_phase(P, args.in[4] + layer * 64, args.in[5] + layer * 64, args.in[6] + layer * 64, args.in[7] + layer * 64, args.in[3] + layer * 8, true); }
#endif
        { FRESH(P); post_phase(P, args.in[4] + layer * 64, args.in[5] + layer * 64, args.in[6] + layer * 64, args.in[7] + layer * 64, args.in[3] + layer * 8); }
        { FRESH(P); ret_state_mfma(P); }
        GRID_BAR();
        { FRESH(P); fscan_phase(P); }
        { FRESH(P); ret_scan(P); }
        GRID_BAR();
#ifdef PROBE_RO
        { FRESH(P); ret_out_mfma(P, args.in[8] + layer * 512, true); }
#endif
        { FRESH(P); ret_out_mfma(P, args.in[8] + layer * 512); }
#ifdef PROBE_X3
        for (int rep_ = 0; rep_ < 2; ++rep_)
        { static_assert(attn_body::ATTN_LDS_BYTES <= RING_BYTES, "attention scratch fits the ring region");
          unsigned char* wsl = F.ws; asm volatile("" : "+s"(wsl));
          bf16* Zl = (bf16*)(wsl + WS_Z);
          const attn_body::AttnTensors AT{(const attn_body::bf16*)(Zl + Z_FQ), (const attn_body::bf16*)(Zl + Z_FK), (const attn_body::bf16*)(Zl + Z_FV), (attn_body::bf16*)(Zl + (rep_ == 0 ? Z_RQ : Z_FQ)), (const float*)(wsl + WS_CF)};
          const attn_body::StaticOrder S((int)F.G, (int)blockIdx.x);
          attn_body::attn_phase<attn_body::StaticOrder, 20>((char*)lds + RING_OFF, AT, S, F.wave); }
#ifdef PROBE_X4
        { FRESH(P); dsa_v3(P); }
#else
        for (int rep_ = 0; rep_ < 2; ++rep_) { FRESH(P); dsa_v3(P, rep_ == 0 ? Z_RG : Z_DQ); }
#endif
#else
        { static_assert(attn_body::ATTN_LDS_BYTES <= RING_BYTES, "attention scratch fits the ring region");
          unsigned char* wsl = F.ws; asm volatile("" : "+s"(wsl));
          bf16* Zl = (bf16*)(wsl + WS_Z);
          float dskip; { const int ln = lane_id_v(); const float gq = wave_max(fabsf(args.in[4][layer * 64 + ln])), gk = wave_max(fabsf(args.in[5][layer * 64 + ln])); dskip = 2.0f * (64.0f * C2 * gq * gk * 1.02f) + 36.0f; }
          const attn_body::AttnTensors AT{(const attn_body::bf16*)(Zl + Z_FQ), (const attn_body::bf16*)(Zl + Z_FK), (const attn_body::bf16*)(Zl + Z_FV), (attn_body::bf16*)(Zl + Z_FQ), (const float*)(wsl + WS_CF), dskip};
          const attn_body::StaticOrder S((int)F.G, (int)blockIdx.x);
          attn_body::attn_phase<attn_body::StaticOrder, 20>((char*)lds + RING_OFF, AT, S, F.wave); }
        { FRESH(P); dsa_v3(P); }
#endif
        GRID_BAR();
        { pg8::Gemm g{Z + Z_FQ, L + LW_MIX, M, DM, 1536, ZP, 1536, 256 * ZP}; pg8::StaticOrder S; S.init(M, DM, F.G, CIDX());
          pg8::EpiGateF E{(const unsigned char*)(Z + Z_ZG), Z + Z_MRG};
          pg8::gemm_phase<pg8::EpiGateF, pg8::StaticOrder, false, true>(ring, g, S, E, F.wave); }
        SEAM_BAR();
        { pg8::Gemm g{Z + Z_MRG, L + LW_O, M, DM, DM, ZP, DM, 256 * ZP}; pg8::StaticOrder S; S.init(M, DM, F.G, CIDX());
          pg8::EpiRes E{XA, HDN, nullptr, SSp};
          pg8::gemm_phase<pg8::EpiRes, pg8::StaticOrder, false, true>(ring, g, S, E, F.wave); }
        SEAM_BAR();
        { pg8::Gemm g{HDN, L + LW_FI, M, FF2, DM, DM, DM, 256 * DM}; pg8::StaticOrder S; S.init(M, FF2, F.G, CIDX());
          const pg8::PG8_LAS_F* RT = (const pg8::PG8_LAS_F*)(F.lds + XTRA_OFF); const int pmt = pg8::rstd_table((pg8::PG8_LAS_F*)(F.lds + XTRA_OFF), SSp, S, F.wave);
          pg8::EpiSwi E{HB, FFH, 256 * ZP, SSp, RT, pmt};
          pg8::gemm_phase<pg8::EpiSwi, pg8::StaticOrder, true, true>(ring, g, S, E, F.wave); }
        SEAM_BAR();
        { pg8::Gemm g{HB, L + LW_FO, M, DM, FFH, FFH, FFH, 256 * ZP}; pg8::StaticOrder S; S.init(M, DM, F.G, CIDX());
          pg8::EpiRes E{HDN, XA, (layer + 1 < DEPTH) ? nullptr : F.out, SSp};
          pg8::gemm_phase<pg8::EpiRes, pg8::StaticOrder, false, true>(ring, g, S, E, F.wave); }
        if (layer + 1 < DEPTH) SEAM_BAR(); else GRID_BAR();
    }
    if (__hip_atomic_load((gu32*)((unsigned*)(ctl + CW_BAR) + XB_TMO), RLX_AGENT) != 0u) {
        const float q = __builtin_nanf("");
        for (int m = F.gw; m < M; m += F.NGW) { GAS f32x4* o = (GAS f32x4*)(F.out + (size_t)m * DM) + lane_id_v();
#pragma unroll
            for (int j = 0; j < 4; ++j) o[64 * j] = (f32x4){q, q, q, q}; }
    }
}

extern "C" void kernel_launch(void* const* d_in, const int* in_sizes, int n_in, void* d_out, int out_size, void* d_ws, size_t ws_size, hipStream_t stream) {
    static int grid = 0;
    if (grid == 0) {
        if (n_in != 16 || in_sizes[0] != M * DM || out_size != M * DM || ws_size < WS_END) { fprintf(stderr, "kernel_launch: unexpected shapes / workspace (n_in %d, in0 %d, out %d, ws %zu < %zu)\n", n_in, n_in > 0 ? in_sizes[0] : -1, out_size, ws_size, (size_t)WS_END); grid = -1; return; }
        int dev = 0, cus = 0, per_cu = 0;
        if (hipGetDevice(&dev) != hipSuccess || hipDeviceGetAttribute(&cus, hipDeviceAttributeMultiprocessorCount, dev) != hipSuccess) { grid = -1; return; }
        if (hipFuncSetAttribute((const void*)hyb_fwd, hipFuncAttributeMaxDynamicSharedMemorySize, LDS_BYTES) != hipSuccess) { fprintf(stderr, "kernel_launch: hipFuncSetAttribute failed\n"); grid = -1; return; }
        if (hipOccupancyMaxActiveBlocksPerMultiprocessor(&per_cu, (const void*)hyb_fwd, NWAVES * 64, LDS_BYTES) != hipSuccess || per_cu < 1) { fprintf(stderr, "kernel_launch: occupancy query reports %d blocks per CU\n", per_cu); }
        (void)hipGetLastError();
        grid = cus;
    }
    if (grid < 0) return;
    if (hipMemsetAsync((char*)d_ws + WS_CTL, 0, CTL_ZERO_BYTES, stream) != hipSuccess) return;
    Args a{};
    for (int i = 0; i < 16; ++i) a.in[i] = (const float*)d_in[i];
    a.out = (float*)d_out; a.ws = (unsigned char*)d_ws;
    hipLaunchKernelGGL(hyb_fwd, dim3(grid), dim3(NWAVES * 64), LDS_BYTES, stream, a);
}
```

```cpp
#include <hip/hip_runtime.h>
#include <cstdio>
#include <cstdint>
#include <cmath>
__device__ __forceinline__ int lane_id_v() { unsigned z; asm volatile("v_mov_b32 %0, 0" : "=v"(z)); return (int)__builtin_amdgcn_mbcnt_hi(~0u, __builtin_amdgcn_mbcnt_lo(~0u, z)); }
template <int MASK> __device__ __forceinline__ float sx(float v) { static_assert(MASK < 32, "swizzle xor mask"); return __builtin_bit_cast(float, __builtin_amdgcn_ds_swizzle(__builtin_bit_cast(int, v), 0x1F | (MASK << 10))); }
template <int MASK> __device__ __forceinline__ unsigned sxu(unsigned v) { return (unsigned)__builtin_amdgcn_ds_swizzle((int)v, 0x1F | (MASK << 10)); }
__device__ __forceinline__ void swap32(unsigned x, unsigned& lo_view, unsigned& hi_view) {
    unsigned a = x, b = x; asm volatile("" : "+v"(b));
    const auto rr = __builtin_amdgcn_permlane32_swap(a, b, false, false);
    lo_view = rr[0]; hi_view = rr[1];
}
template <int CTRL> __device__ __forceinline__ float dpp_f(float v) { return __builtin_bit_cast(float, __builtin_amdgcn_update_dpp(0, __builtin_bit_cast(int, v), CTRL, 0xF, 0xF, false)); }
template <int CTRL> __device__ __forceinline__ int dpp_i(int v) { return __builtin_amdgcn_update_dpp(0, v, CTRL, 0xF, 0xF, false); }
__device__ __forceinline__ float rl_f(float v, int l) { return __builtin_bit_cast(float, __builtin_amdgcn_readlane(__builtin_bit_cast(int, v), l)); }
__device__ __forceinline__ float wave_sum(float v) {
    v += dpp_f<0xB1>(v); v += dpp_f<0x4E>(v); v += dpp_f<0x141>(v); v += dpp_f<0x140>(v);
    return (rl_f(v, 0) + rl_f(v, 16)) + (rl_f(v, 32) + rl_f(v, 48));
}
__device__ __forceinline__ float wave_max(float v) {
    v = fmaxf(v, dpp_f<0xB1>(v)); v = fmaxf(v, dpp_f<0x4E>(v)); v = fmaxf(v, dpp_f<0x141>(v)); v = fmaxf(v, dpp_f<0x140>(v));
    return fmaxf(fmaxf(rl_f(v, 0), rl_f(v, 16)), fmaxf(rl_f(v, 32), rl_f(v, 48)));
}
__device__ __forceinline__ int wave_isum(int v) {
    v += dpp_i<0xB1>(v); v += dpp_i<0x4E>(v); v += dpp_i<0x141>(v); v += dpp_i<0x140>(v);
    return (__builtin_amdgcn_readlane(v, 0) + __builtin_amdgcn_readlane(v, 16)) + (__builtin_amdgcn_readlane(v, 32) + __builtin_amdgcn_readlane(v, 48));
}
__device__ __forceinline__ unsigned wave_umax(unsigned v) {
    unsigned t; t = (unsigned)dpp_i<0xB1>((int)v); v = t > v ? t : v; t = (unsigned)dpp_i<0x4E>((int)v); v = t > v ? t : v; t = (unsigned)dpp_i<0x141>((int)v); v = t > v ? t : v; t = (unsigned)dpp_i<0x140>((int)v); v = t > v ? t : v;
    const unsigned a = (unsigned)__builtin_amdgcn_readlane((int)v, 0), b = (unsigned)__builtin_amdgcn_readlane((int)v, 16), c = (unsigned)__builtin_amdgcn_readlane((int)v, 32), d = (unsigned)__builtin_amdgcn_readlane((int)v, 48);
    const unsigned ab = a > b ? a : b, cd = c > d ? c : d; return ab > cd ? ab : cd;
}
__device__ __forceinline__ unsigned wave_umin(unsigned v) { return ~wave_umax(~v); }
__device__ __forceinline__ float half_sum(float v) {
    unsigned a, b; swap32(__builtin_bit_cast(unsigned, v), a, b); return __builtin_bit_cast(float, a) + __builtin_bit_cast(float, b);
}
__device__ __forceinline__ float half_max(float v) {
    unsigned a, b; swap32(__builtin_bit_cast(unsigned, v), a, b); return fmaxf(__builtin_bit_cast(float, a), __builtin_bit_cast(float, b));
}
namespace pg8 {
#define PG8_LAS __attribute__((address_space(3)))
typedef unsigned short bf16_t;
typedef PG8_LAS float PG8_LAS_F;
typedef short bf16x8 __attribute__((ext_vector_type(8)));
typedef float f32x4 __attribute__((ext_vector_type(4)));
typedef unsigned u32x4 __attribute__((ext_vector_type(4)));
constexpr int BM = 256, BK = 64, HALF = 128, HTB = HALF * BK * 2  , STAGE_BYTES = 8 * HTB, NXCD = 8, WGM = 8;

__host__ __device__ __forceinline__ int lds_byte(int r, int c) { const int st = (r >> 4) * 2 + (c >> 5), rr = r & 15, cc = c & 31, ob = rr * 64 + cc * 2; return st * 1024 + (ob ^ (((ob >> 9) & 1) << 5)); }
__host__ __device__ __forceinline__ void stage_rc(int b, int& R, int& C) { const int st = b / 1024, sb = b % 1024, swz = sb ^ (((sb >> 9) & 1) << 5); R = (st >> 1) * 16 + swz / 64; C = (st & 1) * 32 + (swz % 64) / 2; }
__host__ __device__ __forceinline__ int perm32(int rho) { const int n = rho >> 4, i = rho & 15; return 8 * (i >> 2) + 4 * n + (i & 3); }

struct Unit { int pm, pn; };
struct Gemm { const bf16_t* A; const bf16_t* Bt; int M, N, K, lda, ldb, tsA; };

struct StaticOrder {
    int nM, nN, nwg, G, c;
    __host__ __device__ void init(int M, int N, int G_, int c_) { nM = M / BM; nN = N / BM; nwg = nM * nN; G = G_; c = c_; }
    __host__ __device__ bool next(int i, Unit& u) const {
        const long L = (long)i * G + c; if (L >= nwg) return false;
        int wgid = (int)L; { const int q = nwg / NXCD, r = nwg % NXCD, xcd = wgid % NXCD, off = wgid / NXCD; wgid = (xcd < r ? xcd * (q + 1) : r * (q + 1) + (xcd - r) * q) + off; }
        const int nig = WGM * nN, gid = wgid / nig, fm = gid * WGM, gsz = (nM - fm) < WGM ? (nM - fm) : WGM;
        u.pm = fm + ((wgid % nig) % gsz); u.pn = (wgid % nig) / gsz; return true;
    }
    __device__ __forceinline__ void a_ready(const Unit&) const {}
    __device__ __forceinline__ void done(const Unit&) const {}
};

__device__ __forceinline__ unsigned cvt_pk_bf16(float lo, float hi) { unsigned r; asm volatile("v_cvt_pk_bf16_f32 %0, %1, %2" : "=v"(r) : "v"(lo), "v"(hi)); return r; }
__device__ __forceinline__ float bflo(unsigned w) { return __builtin_bit_cast(float, w << 16); }
__device__ __forceinline__ float bfhi(unsigned w) { return __builtin_bit_cast(float, w & 0xffff0000u); }
__device__ __forceinline__ float sigmoidf_(float x) { return __builtin_amdgcn_rcpf(1.0f + __builtin_amdgcn_exp2f(-1.4426950408889634f * x)); }

constexpr int ZP = 6656;
constexpr int ZSP = 512;
constexpr int NZT = 26, GATE_T0 = 14, Z_GATE = 3584;
typedef unsigned u32x2 __attribute__((ext_vector_type(2)));

#define PRELOAD_RSTD(rsv, RT_, pmt_, SS_, u_, row0_, wr_, fr_) float rsv[2][4]; \
    if ((u_).pm == (pmt_)) { _Pragma("unroll") for (int ai_ = 0; ai_ < 2; ++ai_) _Pragma("unroll") for (int m_ = 0; m_ < 4; ++m_) rsv[ai_][m_] = (RT_)[(wr_) * 64 + (fr_) + ai_ * HALF + m_ * 16]; } \
    else { f32x4 s_[2][4]; _Pragma("unroll") for (int ai_ = 0; ai_ < 2; ++ai_) _Pragma("unroll") for (int m_ = 0; m_ < 4; ++m_) s_[ai_][m_] = *(const f32x4*)((SS_) + (size_t)((row0_) + ai_ * HALF + m_ * 16) * 4); \
    _Pragma("unroll") for (int ai_ = 0; ai_ < 2; ++ai_) _Pragma("unroll") for (int m_ = 0; m_ < 4; ++m_) rsv[ai_][m_] = 1.0f / __builtin_sqrtf(((s_[ai_][m_][0] + s_[ai_][m_][1]) + (s_[ai_][m_][2] + s_[ai_][m_][3])) * (1.0f / 1024.0f) + 1e-6f); }
__device__ __forceinline__ int rstd_table(PG8_LAS float* RT, const float* SS, const StaticOrder& S, int wave_id) {
    Unit u0; if (!S.next(0, u0)) return -1;
    const int t = (wave_id << 6) | lane_id_v();
    if (t < 256) { const f32x4 s = *(const f32x4*)(SS + (size_t)(u0.pm * BM + t) * 4); RT[t] = 1.0f / __builtin_sqrtf(((s[0] + s[1]) + (s[2] + s[3])) * (1.0f / 1024.0f) + 1e-6f); }
    __syncthreads();
    return u0.pm;
}
struct EpiZ {
    static constexpr bool PERM = true, AFTER_DRAIN = false, MID = false;
    bf16_t* Z; float* ZS; const float* SS; const float* GQ; const float* GK; const float* GD; const float* R64; const PG8_LAS float* RT; int pmt;
    __device__ __forceinline__ void operator()(const f32x4 (&acc)[2][2][4][2], const Unit& u, int wr, int wc, int fr, int fq) const {
        const int row0 = u.pm * BM + wr * 64 + fr;
        PRELOAD_RSTD(rsv, RT, pmt, SS, u, row0, wr, fr);
        if (u.pn < 4 || u.pn == 6 || u.pn == 7) {
            const float osc = (u.pn < 4) ? 0.18033688011112042f : 1.0f; const bool rope = (u.pn == 2 || u.pn == 3);
            f32x4 g00, g01, g10, g11;
            if (u.pn < 2) { g00 = *(const f32x4*)(GQ + 8 * fq); g01 = *(const f32x4*)(GQ + 8 * fq + 4); g10 = *(const f32x4*)(GQ + 32 + 8 * fq); g11 = *(const f32x4*)(GQ + 32 + 8 * fq + 4); }
            else if (u.pn < 4) { g00 = *(const f32x4*)(GD + 8 * fq); g01 = *(const f32x4*)(GD + 8 * fq + 4); g10 = *(const f32x4*)(GD + 32 + 8 * fq); g11 = *(const f32x4*)(GD + 32 + 8 * fq + 4); }
            else { g00 = *(const f32x4*)(GK + 8 * fq); g01 = *(const f32x4*)(GK + 8 * fq + 4); g10 = *(const f32x4*)(GK + 32 + 8 * fq); g11 = *(const f32x4*)(GK + 32 + 8 * fq + 4); }
            const int colo = u.pn * BM + wc * 64 + 8 * fq;
#pragma unroll
            for (int ai = 0; ai < 2; ++ai)
#pragma unroll
                for (int m = 0; m < 4; ++m) { const int row = row0 + ai * HALF + m * 16; const float rs = rsv[ai][m];
                    f32x4 a0 = acc[ai][0][m][0] * rs, a1 = acc[ai][0][m][1] * rs, b0 = acc[ai][1][m][0] * rs, b1 = acc[ai][1][m][1] * rs;
                    float ss = ((a0[0] * a0[0] + a0[1] * a0[1]) + (a0[2] * a0[2] + a0[3] * a0[3])) + ((a1[0] * a1[0] + a1[1] * a1[1]) + (a1[2] * a1[2] + a1[3] * a1[3]))
                             + ((b0[0] * b0[0] + b0[1] * b0[1]) + (b0[2] * b0[2] + b0[3] * b0[3])) + ((b1[0] * b1[0] + b1[1] * b1[1]) + (b1[2] * b1[2] + b1[3] * b1[3]));
                    ss += sx<16>(ss); { unsigned x_, y_; swap32(__builtin_bit_cast(unsigned, ss), x_, y_); ss = __builtin_bit_cast(float, x_) + __builtin_bit_cast(float, y_); }
                    const float hr = osc / __builtin_sqrtf(ss * (1.0f / 64.0f) + 1e-6f);
                    a0 = a0 * g00 * hr; a1 = a1 * g01 * hr; b0 = b0 * g10 * hr; b1 = b1 * g11 * hr;
                    if (rope) { const float* cs = R64 + ((size_t)(row & 4095) * 32 + 8 * fq) * 2;
                        const f32x4 c0 = *(const f32x4*)cs, c1 = *(const f32x4*)(cs + 4), c2 = *(const f32x4*)(cs + 8), c3 = *(const f32x4*)(cs + 12);
                        f32x4 x0, x1, y0, y1;
                        x0[0] = a0[0] * c0[0] - b0[0] * c0[1]; y0[0] = b0[0] * c0[0] + a0[0] * c0[1]; x0[1] = a0[1] * c0[2] - b0[1] * c0[3]; y0[1] = b0[1] * c0[2] + a0[1] * c0[3];
                        x0[2] = a0[2] * c1[0] - b0[2] * c1[1]; y0[2] = b0[2] * c1[0] + a0[2] * c1[1]; x0[3] = a0[3] * c1[2] - b0[3] * c1[3]; y0[3] = b0[3] * c1[2] + a0[3] * c1[3];
                        x1[0] = a1[0] * c2[0] - b1[0] * c2[1]; y1[0] = b1[0] * c2[0] + a1[0] * c2[1]; x1[1] = a1[1] * c2[2] - b1[1] * c2[3]; y1[1] = b1[1] * c2[2] + a1[1] * c2[3];
                        x1[2] = a1[2] * c3[0] - b1[2] * c3[1]; y1[2] = b1[2] * c3[0] + a1[2] * c3[1]; x1[3] = a1[3] * c3[2] - b1[3] * c3[3]; y1[3] = b1[3] * c3[2] + a1[3] * c3[3];
                        a0 = x0; a1 = x1; b0 = y0; b1 = y1; }
                    bf16_t* rowp = Z + (size_t)row * ZP + colo;
                    u32x4 w; w.x = cvt_pk_bf16(a0[0], a0[1]); w.y = cvt_pk_bf16(a0[2], a0[3]); w.z = cvt_pk_bf16(a1[0], a1[1]); w.w = cvt_pk_bf16(a1[2], a1[3]); *(u32x4*)rowp = w;
                    w.x = cvt_pk_bf16(b0[0], b0[1]); w.y = cvt_pk_bf16(b0[2], b0[3]); w.z = cvt_pk_bf16(b1[0], b1[1]); w.w = cvt_pk_bf16(b1[2], b1[3]); *(u32x4*)(rowp + 32) = w;
                    __builtin_amdgcn_sched_barrier(0); }
        } else if (u.pn >= GATE_T0 && u.pn < NZT) {
            unsigned char* gb = (unsigned char*)(Z + Z_GATE) + (u.pn - GATE_T0) * 256 + wc * 32 + 8 * fq;
#pragma unroll
            for (int ai = 0; ai < 2; ++ai)
#pragma unroll
                for (int m = 0; m < 4; ++m) { const float rs = rsv[ai][m]; unsigned char* rowp = gb + (size_t)(row0 + ai * HALF + m * 16) * (ZP * 2);
#pragma unroll
                    for (int bj = 0; bj < 2; ++bj) { const f32x4 v0 = acc[ai][bj][m][0] * rs, v1 = acc[ai][bj][m][1] * rs; u32x2 w = {0u, 0u};
#pragma unroll
                        for (int i = 0; i < 4; ++i) { w.x = __builtin_amdgcn_cvt_pk_u8_f32(__builtin_fmaxf(255.0f * sigmoidf_(v0[i]), 1.0f), i, w.x); w.y = __builtin_amdgcn_cvt_pk_u8_f32(__builtin_fmaxf(255.0f * sigmoidf_(v1[i]), 1.0f), i, w.y); }
                        *(u32x2*)(rowp + bj * HALF) = w; } }
        } else if (u.pn < NZT) {
            const int col0 = u.pn * BM + wc * 32 + 8 * fq;
#pragma unroll
            for (int ai = 0; ai < 2; ++ai)
#pragma unroll
                for (int m = 0; m < 4; ++m) { bf16_t* rowp = Z + (size_t)(row0 + ai * HALF + m * 16) * ZP + col0; const float rs = rsv[ai][m];
#pragma unroll
                    for (int bj = 0; bj < 2; ++bj) { const f32x4 v0 = acc[ai][bj][m][0] * rs, v1 = acc[ai][bj][m][1] * rs;
                        u32x4 w; w.x = cvt_pk_bf16(v0[0], v0[1]); w.y = cvt_pk_bf16(v0[2], v0[3]); w.z = cvt_pk_bf16(v1[0], v1[1]); w.w = cvt_pk_bf16(v1[2], v1[3]);
                        *(u32x4*)(rowp + bj * HALF) = w; } }
        } else {
            const int col0 = (u.pn - NZT) * BM + wc * 32 + 8 * fq;
#pragma unroll
            for (int ai = 0; ai < 2; ++ai)
#pragma unroll
                for (int m = 0; m < 4; ++m) { float* rowp = ZS + (size_t)(row0 + ai * HALF + m * 16) * ZSP + col0; const float rs = rsv[ai][m];
#pragma unroll
                    for (int bj = 0; bj < 2; ++bj) { *(f32x4*)(rowp + bj * HALF) = acc[ai][bj][m][0] * rs; *(f32x4*)(rowp + bj * HALF + 4) = acc[ai][bj][m][1] * rs; } }
        }
    }
};

template <int P> struct EpiGate {
    static constexpr bool PERM = true, AFTER_DRAIN = false, MID = false;
    const bf16_t* G;
    float* M32;
    bf16_t* OUT;
    __device__ __forceinline__ void operator()(const f32x4 (&acc)[2][2][4][2], const Unit& u, int wr, int wc, int fr, int fq) const {
        const int row0 = u.pm * BM + wr * 64 + fr, col0 = u.pn * BM + wc * 32 + 8 * fq;
#pragma unroll
        for (int ai = 0; ai < 2; ++ai)
#pragma unroll
            for (int m = 0; m < 4; ++m) { const size_t row = (size_t)(row0 + ai * HALF + m * 16);
#pragma unroll
                for (int bj = 0; bj < 2; ++bj) { const int col = col0 + bj * HALF;
                    const u32x4 gw = *(const u32x4*)(G + row * ZP + P * 1024 + col);
                    const f32x4 v0 = acc[ai][bj][m][0], v1 = acc[ai][bj][m][1];
                    f32x4 t0, t1;
                    t0[0] = bflo(gw.x) * v0[0]; t0[1] = bfhi(gw.x) * v0[1]; t0[2] = bflo(gw.y) * v0[2]; t0[3] = bfhi(gw.y) * v0[3];
                    t1[0] = bflo(gw.z) * v1[0]; t1[1] = bfhi(gw.z) * v1[1]; t1[2] = bflo(gw.w) * v1[2]; t1[3] = bfhi(gw.w) * v1[3];
                    float* mp = M32 + row * 1024 + col;
                    if (P == 0) { *(f32x4*)mp = t0; *(f32x4*)(mp + 4) = t1; }
                    else if (P == 1) { *(f32x4*)mp = *(const f32x4*)mp + t0; *(f32x4*)(mp + 4) = *(const f32x4*)(mp + 4) + t1; }
                    else { t0 = *(const f32x4*)mp + t0; t1 = *(const f32x4*)(mp + 4) + t1;
                        u32x4 w; w.x = cvt_pk_bf16(t0[0], t0[1]); w.y = cvt_pk_bf16(t0[2], t0[3]); w.z = cvt_pk_bf16(t1[0], t1[1]); w.w = cvt_pk_bf16(t1[2], t1[3]);
                        *(u32x4*)(OUT + row * ZP + col) = w; } } }
    }
};

struct EpiGateF {
    static constexpr bool PERM = true, AFTER_DRAIN = false, MID = true;
    const unsigned char* G; bf16_t* OUT;
    __device__ __forceinline__ void mid(f32x4 (&acc)[2][2][4][2], const Unit& u, int wr, int wc, int fr_, int fq_, int s) const {
        int fr = fr_, fq = fq_; asm volatile("" : "+v"(fr), "+v"(fq));
        const int row0 = u.pm * BM + wr * 64 + fr, col0 = u.pn * BM + wc * 32 + 8 * fq;
        u32x2 ga[2][4][2], gb[2][4][2];
#pragma unroll
        for (int ai = 0; ai < 2; ++ai)
#pragma unroll
            for (int m = 0; m < 4; ++m)
#pragma unroll
                for (int bj = 0; bj < 2; ++bj) { const unsigned char* gp = G + (size_t)(row0 + ai * HALF + m * 16) * (ZP * 2) + s * 1024 + col0 + bj * HALF; ga[ai][m][bj] = *(const u32x2*)gp; gb[ai][m][bj] = *(const u32x2*)(gp + 1024); }
#pragma unroll
        for (int ai = 0; ai < 2; ++ai)
#pragma unroll
            for (int m = 0; m < 4; ++m)
#pragma unroll
                for (int bj = 0; bj < 2; ++bj) { const u32x2 a = ga[ai][m][bj], b = gb[ai][m][bj]; f32x4 r0, r1;
                    r0[0] = (float)(a.x & 255u) * __builtin_amdgcn_rcpf((float)(b.x & 255u)); r0[1] = (float)((a.x >> 8) & 255u) * __builtin_amdgcn_rcpf((float)((b.x >> 8) & 255u));
                    r0[2] = (float)((a.x >> 16) & 255u) * __builtin_amdgcn_rcpf((float)((b.x >> 16) & 255u)); r0[3] = (float)(a.x >> 24) * __builtin_amdgcn_rcpf((float)(b.x >> 24));
                    r1[0] = (float)(a.y & 255u) * __builtin_amdgcn_rcpf((float)(b.y & 255u)); r1[1] = (float)((a.y >> 8) & 255u) * __builtin_amdgcn_rcpf((float)((b.y >> 8) & 255u));
                    r1[2] = (float)((a.y >> 16) & 255u) * __builtin_amdgcn_rcpf((float)((b.y >> 16) & 255u)); r1[3] = (float)(a.y >> 24) * __builtin_amdgcn_rcpf((float)(b.y >> 24));
                    acc[ai][bj][m][0] = acc[ai][bj][m][0] * r0; acc[ai][bj][m][1] = acc[ai][bj][m][1] * r1; }
    }
    __device__ __forceinline__ void operator()(const f32x4 (&acc)[2][2][4][2], const Unit& u, int wr, int wc, int fr, int fq) const {
        const int row0 = u.pm * BM + wr * 64 + fr, col0 = u.pn * BM + wc * 32 + 8 * fq; const float k255 = 1.0f / 255.0f;
#pragma unroll
        for (int ai = 0; ai < 2; ++ai)
#pragma unroll
            for (int m = 0; m < 4; ++m) { const size_t row = (size_t)(row0 + ai * HALF + m * 16);
#pragma unroll
                for (int bj = 0; bj < 2; ++bj) { const int col = col0 + bj * HALF;
                    const u32x2 gw = *(const u32x2*)(G + row * (ZP * 2) + 2 * 1024 + col);
                    const f32x4 v0 = acc[ai][bj][m][0] * k255, v1 = acc[ai][bj][m][1] * k255;
                    u32x4 w; w.x = cvt_pk_bf16((float)(gw.x & 255u) * v0[0], (float)((gw.x >> 8) & 255u) * v0[1]); w.y = cvt_pk_bf16((float)((gw.x >> 16) & 255u) * v0[2], (float)(gw.x >> 24) * v0[3]);
                    w.z = cvt_pk_bf16((float)(gw.y & 255u) * v1[0], (float)((gw.y >> 8) & 255u) * v1[1]); w.w = cvt_pk_bf16((float)((gw.y >> 16) & 255u) * v1[2], (float)(gw.y >> 24) * v1[3]);
                    *(u32x4*)(OUT + row * ZP + col) = w; } }
    }
};

struct EpiRes {
    static constexpr bool PERM = true, AFTER_DRAIN = true, MID = false;
    const bf16_t* RES; bf16_t* OUT; float* OUT32; float* SS;
    __device__ __forceinline__ void fused(const f32x4 (&acc)[2][2][4][2], const Unit& u, int wr, int wc, int fr, int fq, PG8_LAS unsigned char* lds, int wid, int lane) const {
        const int row0 = u.pm * BM + wr * 64 + fr, col0 = u.pn * BM + wc * 32 + 8 * fq;
        PG8_LAS float* P = (PG8_LAS float*)lds;
#pragma unroll
        for (int ai = 0; ai < 2; ++ai)
#pragma unroll
            for (int m = 0; m < 4; ++m) { const int row = row0 + ai * HALF + m * 16; const size_t off = (size_t)row * 1024 + col0; float ss = 0.f;
#pragma unroll
                for (int bj = 0; bj < 2; ++bj) { const u32x4 r = *(const u32x4*)(RES + off + bj * HALF);
                    f32x4 v0 = acc[ai][bj][m][0], v1 = acc[ai][bj][m][1];
                    v0[0] += bflo(r.x); v0[1] += bfhi(r.x); v0[2] += bflo(r.y); v0[3] += bfhi(r.y); v1[0] += bflo(r.z); v1[1] += bfhi(r.z); v1[2] += bflo(r.w); v1[3] += bfhi(r.w);
                    ss += ((v0[0] * v0[0] + v0[1] * v0[1]) + (v0[2] * v0[2] + v0[3] * v0[3])) + ((v1[0] * v1[0] + v1[1] * v1[1]) + (v1[2] * v1[2] + v1[3] * v1[3]));
                    if (OUT32) { float* op = OUT32 + off + bj * HALF; *(f32x4*)op = v0; *(f32x4*)(op + 4) = v1; }
                    else { u32x4 w; w.x = cvt_pk_bf16(v0[0], v0[1]); w.y = cvt_pk_bf16(v0[2], v0[3]); w.z = cvt_pk_bf16(v1[0], v1[1]); w.w = cvt_pk_bf16(v1[2], v1[3]); *(u32x4*)(OUT + off + bj * HALF) = w; } }
                ss += sx<16>(ss); { unsigned a, b; swap32(__builtin_bit_cast(unsigned, ss), a, b); ss = __builtin_bit_cast(float, a) + __builtin_bit_cast(float, b); }
                if (fq == 0) P[(ai * HALF + wr * 64 + m * 16 + fr) * 4 + wc] = ss; }
        asm volatile("s_waitcnt lgkmcnt(0)\n\ts_barrier" ::: "memory");
        const int t = wid * 64 + lane;
        if (t < 256) { const f32x4 p = *(const PG8_LAS f32x4*)(P + t * 4); SS[(size_t)(u.pm * BM + t) * 4 + u.pn] = (p[0] + p[1]) + (p[2] + p[3]); }
    }
};

struct EpiSwi {
    static constexpr bool PERM = true, AFTER_DRAIN = false, MID = false;
    bf16_t* H; int ldh; int tsH; const float* SS; const PG8_LAS float* RT; int pmt;
    __device__ __forceinline__ void operator()(const f32x4 (&acc)[2][2][4][2], const Unit& u, int wr, int wc, int fr, int fq) const {
        const int row0 = u.pm * BM + wr * 64 + fr, col0 = u.pn * HALF + wc * 32 + 8 * fq;
        PRELOAD_RSTD(rsv, RT, pmt, SS, u, row0, wr, fr);
#pragma unroll
        for (int ai = 0; ai < 2; ++ai)
#pragma unroll
            for (int m = 0; m < 4; ++m) { bf16_t* hp = H + (size_t)u.pm * tsH + (size_t)(wr * 64 + fr + ai * HALF + m * 16) * ldh + col0; const float rs = rsv[ai][m];
                float o[8];
#pragma unroll
                for (int n = 0; n < 2; ++n)
#pragma unroll
                    for (int i = 0; i < 4; ++i) { const float g = acc[ai][0][m][n][i] * rs, up = acc[ai][1][m][n][i] * rs; o[4 * n + i] = g * sigmoidf_(g) * up; }
                u32x4 w; w.x = cvt_pk_bf16(o[0], o[1]); w.y = cvt_pk_bf16(o[2], o[3]); w.z = cvt_pk_bf16(o[4], o[5]); w.w = cvt_pk_bf16(o[6], o[7]);
                *(u32x4*)hp = w; }
    }
};

template <class Epi, class Sched, bool ALIGN_EPI = false, bool SP2 = false>
__device__ __forceinline__ void gemm_phase(PG8_LAS unsigned char* lds, Gemm g, const Sched& S0, const Epi& E, int wave_id) {
    int ovz, osz; asm volatile("v_mov_b32 %0, 0\n\ts_mov_b32 %1, 0" : "=v"(ovz), "=s"(osz));
    Sched S = S0; S.c += osz; g.lda += osz; g.ldb += osz; g.tsA += osz;
    const int tid = ((wave_id << 6) | lane_id_v()) + ovz,
         wid = __builtin_amdgcn_readfirstlane(tid >> 6), lane = tid & 63, wr = wid >> 2, wc = wid & 3, fr = lane & 15, fq = lane >> 4;
    const int K = g.K, nt = K / BK;
    unsigned voffA[2], voffB[2];
#pragma unroll
    for (int i = 0; i < 2; ++i) { int R, C; stage_rc(tid * 16 + i * 8192, R, C); const int Rb = Epi::PERM ? ((R & ~31) + perm32(R & 31)) : R;
        voffA[i] = (unsigned)(R * g.lda + C) * 2u; voffB[i] = (unsigned)(Rb * g.ldb + C) * 2u; }
    const size_t kstep = (size_t)(BK * 2);
    const size_t hstepA = (size_t)HALF * g.lda * 2, hstepB = (size_t)HALF * g.ldb * 2;
    const size_t tstepA = (size_t)g.tsA * 2, tstepB = 2 * hstepB;
    const unsigned ldsw = (unsigned)wid * 1024u;
    const int aoff = lds_byte(wr * 64 + fr, fq * 8), boff = lds_byte(wc * 32 + fr, fq * 8);
#define PG8_SA(b, h) (((b) * 2 + (h)) * HTB)
#define PG8_SB(b, h) ((4 + (b) * 2 + (h)) * HTB)
#define PG8_STAGE(bufoff, gbase, voff) do { _Pragma("unroll") for (int _i = 0; _i < 2; ++_i) \
        __builtin_amdgcn_global_load_lds((const unsigned*)((const char*)(gbase) + (voff)[_i]), (PG8_LAS unsigned*)(lds + (bufoff) + ldsw + _i * 8192), 16, 0, 0); } while (0)
#define PG8_LDA(dst, b, h) do { _Pragma("unroll") for (int m = 0; m < 4; ++m) _Pragma("unroll") for (int k = 0; k < 2; ++k) dst[m][k] = *(const PG8_LAS bf16x8*)(lds + PG8_SA(b, h) + aoff + m * 2048 + k * 1024); } while (0)
#define PG8_LDB(dst, b, h) do { _Pragma("unroll") for (int n = 0; n < 2; ++n) _Pragma("unroll") for (int k = 0; k < 2; ++k) dst[n][k] = *(const PG8_LAS bf16x8*)(lds + PG8_SB(b, h) + boff + n * 2048 + k * 1024); } while (0)
#define PG8_MMA(ai, bj, At, Bt) do { __builtin_amdgcn_s_setprio(1); _Pragma("unroll") for (int m = 0; m < 4; ++m) _Pragma("unroll") for (int n = 0; n < 2; ++n) _Pragma("unroll") for (int k = 0; k < 2; ++k) \
        acc[ai][bj][m][n] = __builtin_amdgcn_mfma_f32_16x16x32_bf16(Bt[n][k], At[m][k], acc[ai][bj][m][n], 0, 0, 0); __builtin_amdgcn_s_setprio(0); } while (0)
#define PG8_WAIT_V(n) asm volatile("s_waitcnt vmcnt(" #n ")" ::: "memory")
#define PG8_WAIT_L(n) asm volatile("s_waitcnt lgkmcnt(" #n ")" ::: "memory")
#define PG8_BAR __builtin_amdgcn_s_barrier()
#define PG8_SCHED __builtin_amdgcn_sched_barrier(0)
    Unit cur, nxt; int ui = 0;
    if (!S.next(0, cur)) return;
    f32x4 acc[2][2][4][2];
#pragma unroll
    for (int a = 0; a < 2; ++a)
#pragma unroll
        for (int b = 0; b < 2; ++b)
#pragma unroll
            for (int m = 0; m < 4; ++m)
#pragma unroll
                for (int n = 0; n < 2; ++n) acc[a][b][m][n] = (f32x4){0.f, 0.f, 0.f, 0.f};
    bf16x8 At[4][2], B0[2][2], B1[2][2];
    const char* cA = (const char*)g.A + (size_t)cur.pm * tstepA; const char* cB = (const char*)g.Bt + (size_t)cur.pn * tstepB;
    S.a_ready(cur);
    if constexpr (SP2) {
        PG8_STAGE(PG8_SB(0, 0), cB, voffB); PG8_STAGE(PG8_SB(0, 1), cB + hstepB, voffB); PG8_STAGE(PG8_SA(0, 0), cA, voffA); PG8_STAGE(PG8_SA(0, 1), cA + hstepA, voffA);
        if (wr == 1) PG8_BAR;
        PG8_WAIT_V(2); PG8_BAR;
        PG8_STAGE(PG8_SB(1, 0), cB + kstep, voffB); PG8_STAGE(PG8_SA(1, 0), cA + kstep, voffA); PG8_STAGE(PG8_SB(1, 1), cB + hstepB + kstep, voffB);
        PG8_WAIT_V(6); PG8_BAR;
    } else {
        PG8_STAGE(PG8_SB(0, 0), cB, voffB); PG8_STAGE(PG8_SA(0, 0), cA, voffA); PG8_STAGE(PG8_SB(0, 1), cB + hstepB, voffB); PG8_STAGE(PG8_SA(0, 1), cA + hstepA, voffA);
        if (wr == 1) PG8_BAR;
        PG8_WAIT_V(4); PG8_BAR;
        PG8_STAGE(PG8_SB(1, 0), cB + kstep, voffB); PG8_STAGE(PG8_SA(1, 0), cA + kstep, voffA); PG8_STAGE(PG8_SB(1, 1), cB + hstepB + kstep, voffB);
        PG8_WAIT_V(6); PG8_BAR;
    }
    for (;;) {
        const bool has_next = S.next(ui + 1, nxt);
        const char* nA = has_next ? (const char*)g.A + (size_t)nxt.pm * tstepA : cA; const char* nB = has_next ? (const char*)g.Bt + (size_t)nxt.pn * tstepB : cB;
        for (int t = 0; t < nt; t += 2) {
            if constexpr (Epi::MID) { if (t == 8 || t == 16) E.mid(acc, cur, wr, wc, fr, fq, (t >> 3) - 1); }
            const bool last = (t == nt - 2);
            const char* a1 = cA + (size_t)(t + 1) * kstep;
            const char* a2 = last ? nA : cA + (size_t)(t + 2) * kstep; const char* b2 = last ? nB : cB + (size_t)(t + 2) * kstep;
            const char* a3 = a2 + kstep; const char* b3 = b2 + kstep;
            if (last && has_next) S.a_ready(nxt);
            if constexpr (SP2) {
            PG8_LDB(B0, 0, 0); PG8_LDB(B1, 0, 1); PG8_SCHED; PG8_LDA(At, 0, 0); PG8_STAGE(PG8_SA(1, 1), a1 + hstepA, voffA);
            PG8_WAIT_V(8); PG8_WAIT_L(0); PG8_BAR; PG8_MMA(0, 0, At, B0); PG8_MMA(0, 1, At, B1); PG8_BAR; PG8_SCHED;
            PG8_LDA(At, 0, 1); PG8_STAGE(PG8_SB(0, 0), b2, voffB); PG8_STAGE(PG8_SB(0, 1), b2 + hstepB, voffB); PG8_STAGE(PG8_SA(0, 0), a2, voffA);
            PG8_WAIT_V(8); PG8_WAIT_L(0); PG8_BAR; PG8_MMA(1, 0, At, B0); PG8_MMA(1, 1, At, B1); PG8_BAR; PG8_SCHED;
            PG8_LDB(B0, 1, 0); PG8_LDB(B1, 1, 1); PG8_SCHED; PG8_LDA(At, 1, 0); PG8_STAGE(PG8_SA(0, 1), a2 + hstepA, voffA);
            PG8_WAIT_V(8); PG8_WAIT_L(0); PG8_BAR; PG8_MMA(0, 0, At, B0); PG8_MMA(0, 1, At, B1); PG8_BAR; PG8_SCHED;
            PG8_LDA(At, 1, 1); PG8_STAGE(PG8_SB(1, 0), b3, voffB); PG8_STAGE(PG8_SB(1, 1), b3 + hstepB, voffB); PG8_STAGE(PG8_SA(1, 0), a3, voffA);
            PG8_WAIT_V(8); PG8_WAIT_L(0); PG8_BAR; PG8_MMA(1, 0, At, B0); PG8_MMA(1, 1, At, B1); PG8_BAR; PG8_SCHED;
            } else {
            PG8_LDB(B0, 0, 0); PG8_SCHED; PG8_LDA(At, 0, 0); PG8_STAGE(PG8_SA(1, 1), a1 + hstepA, voffA);
            PG8_WAIT_L(8); PG8_BAR; PG8_WAIT_L(0); PG8_MMA(0, 0, At, B0); PG8_BAR; PG8_SCHED;
            PG8_LDB(B1, 0, 1); PG8_STAGE(PG8_SB(0, 0), b2, voffB);
            PG8_BAR; PG8_WAIT_L(0); PG8_MMA(0, 1, At, B1); PG8_BAR;
            PG8_LDA(At, 0, 1); PG8_STAGE(PG8_SA(0, 0), a2, voffA);
            PG8_BAR; PG8_WAIT_L(0); PG8_MMA(1, 0, At, B0); PG8_BAR; PG8_SCHED;
            PG8_STAGE(PG8_SB(0, 1), b2 + hstepB, voffB);
            PG8_WAIT_V(6); PG8_BAR; PG8_MMA(1, 1, At, B1); PG8_BAR;
            PG8_LDB(B0, 1, 0); PG8_SCHED; PG8_LDA(At, 1, 0); PG8_STAGE(PG8_SA(0, 1), a2 + hstepA, voffA);
            PG8_WAIT_L(8); PG8_BAR; PG8_WAIT_L(0); PG8_MMA(0, 0, At, B0); PG8_BAR; PG8_SCHED;
            PG8_LDB(B1, 1, 1); PG8_STAGE(PG8_SB(1, 0), b3, voffB);
            PG8_BAR; PG8_WAIT_L(0); PG8_MMA(0, 1, At, B1); PG8_BAR;
            PG8_LDA(At, 1, 1); PG8_STAGE(PG8_SA(1, 0), a3, voffA);
            PG8_BAR; PG8_WAIT_L(0); PG8_MMA(1, 0, At, B0); PG8_BAR; PG8_SCHED;
            PG8_STAGE(PG8_SB(1, 1), b3 + hstepB, voffB);
            PG8_WAIT_V(6); PG8_BAR; PG8_MMA(1, 1, At, B1); PG8_BAR;
            }
        }
        if constexpr (ALIGN_EPI) { if (wr == 0) PG8_BAR; }
        if constexpr (!Epi::AFTER_DRAIN) { E(acc, cur, wr, wc, fr, fq); S.done(cur); }
        if (!has_next) break;
#pragma unroll
        for (int a = 0; a < 2; ++a)
#pragma unroll
            for (int b = 0; b < 2; ++b)
#pragma unroll
                for (int m = 0; m < 4; ++m)
#pragma unroll
                    for (int n = 0; n < 2; ++n) acc[a][b][m][n] = (f32x4){0.f, 0.f, 0.f, 0.f};
        cur = nxt; cA = nA; cB = nB; ++ui;
        if constexpr (ALIGN_EPI) { if (wr == 1) PG8_BAR; }
    }
    PG8_WAIT_V(0);
    if constexpr (!ALIGN_EPI) { if (wr == 0) PG8_BAR; }
    PG8_BAR;
    if constexpr (Epi::AFTER_DRAIN) { E.fused(acc, cur, wr, wc, fr, fq, lds, wid, lane); S.done(cur); }
#undef PG8_SA
#undef PG8_SB
#undef PG8_STAGE
#undef PG8_LDA
#undef PG8_LDB
#undef PG8_MMA
#undef PG8_WAIT_V
#undef PG8_WAIT_L
#undef PG8_BAR
#undef PG8_SCHED
}
}

constexpr int NB = 4, SEQ = 4096, DM = 1024, DEPTH = 4, M = NB * SEQ;
constexpr int INC = 7088;
constexpr int NIN = 7168;
constexpr int FFH = 2816, FF2 = 5632;
constexpr int ZP = pg8::ZP, ZSP = pg8::ZSP;
constexpr int Z_FQ = 0, Z_DQ = 512, Z_RV = 1024, Z_FK = 1536, Z_FV = 2048,
     Z_RQ = 2560, Z_RK = 2816, Z_RG = 3072, Z_ZG = 3584, Z_MRG = 2560;
constexpr int S_IQ = 0, S_DK = 256, S_DV = 320, S_IK = 384, S_IW = 416, S_FF = 424;
constexpr float NORM_EPS = 1e-6f;
constexpr float LOG2E = 1.4426950408889634f;
constexpr float C2 = 0.125f * 1.4426950408889634f;

constexpr size_t MiB = 1u << 20;
constexpr size_t WS_CTL = 0, CTL_ZERO_BYTES = 1 * MiB;
constexpr size_t WS_ROPE64 = 1 * MiB;
constexpr size_t WS_ROPE32 = 2 * MiB;
constexpr size_t WS_LF = 2 * MiB + 512 * 1024;
constexpr size_t WS_CF = 3 * MiB;
constexpr size_t WS_ISG = 3 * MiB + 512 * 1024;
constexpr size_t WS_KD = 4 * MiB;
constexpr size_t WS_VD = 6 * MiB;
constexpr size_t WS_W = 8 * MiB;
constexpr size_t LW_IN = 0, LW_MIX = (size_t)NIN * 1024, LW_O = LW_MIX + 1536 * 1024, LW_FI = LW_O + 1024 * 1024, LW_FO = LW_FI + (size_t)FF2 * 1024, LW_STRIDE = LW_FO + (size_t)FFH * 1024;
constexpr size_t WS_Z = 150 * MiB;
constexpr size_t WS_HDN = 358 * MiB;
constexpr size_t WS_ZS = 390 * MiB;
constexpr size_t WS_IQB = 422 * MiB;
constexpr size_t WS_IKB = 430 * MiB;
constexpr size_t WS_SS = 431 * MiB;
constexpr size_t WS_END = 432 * MiB;
static_assert(WS_W + DEPTH * LW_STRIDE * 2 <= WS_Z && WS_Z + (size_t)M * ZP * 2 <= WS_HDN && WS_HDN + (size_t)M * 1024 * 2 == WS_ZS && WS_ZS + (size_t)M * ZSP * 4 == WS_IQB, "d_ws map");
constexpr int CW_BAR = 4096;

constexpr int RING_OFF = 0, RING_BYTES = 133120;
constexpr int LDSCTL_OFF = RING_BYTES, MISC_OFF = LDSCTL_OFF + 320;
constexpr int XTRA_OFF = RING_BYTES + 1024;
constexpr int LDS_BYTES = 147456;
constexpr int NWAVES = 8;
#define GAS __attribute__((address_space(1)))
#define LAS __attribute__((address_space(3)))
typedef unsigned short bf16;
typedef unsigned v4u __attribute__((ext_vector_type(4)));
typedef float f32x4 __attribute__((ext_vector_type(4)));
typedef short bf16x8 __attribute__((ext_vector_type(8)));
typedef GAS unsigned gu32;
typedef GAS unsigned long long gu64;
#define RLX_AGENT __ATOMIC_RELAXED, __HIP_MEMORY_SCOPE_AGENT
#define LDS_WAIT() asm volatile("s_waitcnt lgkmcnt(0)" ::: "memory")
#define VM_WAIT() asm volatile("s_waitcnt vmcnt(0)" ::: "memory")
__device__ __forceinline__ unsigned long long rt() { return __builtin_amdgcn_s_memrealtime(); }
__device__ __forceinline__ unsigned f2bf(float f) { unsigned u = __builtin_bit_cast(unsigned, f); return (u + 0x7fffu + ((u >> 16) & 1u)) >> 16; }
__device__ __forceinline__ unsigned pk2(float lo, float hi) { unsigned r; asm("v_cvt_pk_bf16_f32 %0, %1, %2" : "=v"(r) : "v"(lo), "v"(hi)); return r; }

#define XB_TMO      128
#define XB_XCNT(j)  (256  + 64 * (j))
#define XB_XSUB(j)  (1280 + 64 * (j))
#define XB_XGEN(j)  (2304 + 64 * (j))
#define XB_TOP      3328
#define XB_TOPGEN   3392
#define XCD_BAR_WORDS 3456
#define XB_LSUB(j)  (3456 + 64 * (j))
#define XB_LGEN(j)  (4480 + 64 * (j))
#define XB_SPIN_CAP (1u << 22)

__device__ __forceinline__ unsigned xb_ld(unsigned* p)              { return __hip_atomic_load(p, __ATOMIC_RELAXED, __HIP_MEMORY_SCOPE_AGENT); }
__device__ __forceinline__ unsigned xb_add(unsigned* p, unsigned v) { return __hip_atomic_fetch_add(p, v, __ATOMIC_RELAXED, __HIP_MEMORY_SCOPE_AGENT); }
__device__ __forceinline__ unsigned xb_xcc_id() { return (unsigned)__builtin_amdgcn_s_getreg((3 << 11) | 20) & 0xFu; }
#define XB_SPIN(cond, bar) do { unsigned _sp = 0; while (cond) { __builtin_amdgcn_s_sleep(1); \
    if ((++_sp & 255u) == 0u) { if (xb_ld(&(bar)[XB_TMO])) break; if (_sp > XB_SPIN_CAP) { atomicAdd(&(bar)[XB_TMO], 1u); break; } } } } while (0)

struct XcdBarrier {
    unsigned* bar; unsigned x; int w;
    volatile LAS unsigned* st;
};

__device__ __forceinline__ XcdBarrier xcd_barrier_post(unsigned* bar, volatile LAS unsigned* st) {
    XcdBarrier b; b.bar = bar; b.x = xb_xcc_id(); b.st = st; b.w = 0;
    if (threadIdx.x == 0) st[2] = xb_add(&bar[XB_XCNT(b.x)], 1u);
    return b;
}
__device__ __forceinline__ void xcd_barrier_complete(unsigned* bar, unsigned x, unsigned& nloc, unsigned& nx) {
    const unsigned G = gridDim.x * gridDim.y * gridDim.z;
    unsigned sum, cnt, mine, sp = 0u;
    for (;;) {
        sum = 0u; cnt = 0u; mine = 0u;
#pragma unroll
        for (unsigned j = 0; j < 16; ++j) { const unsigned c = xb_ld(&bar[XB_XCNT(j)]); sum += c; cnt += (c > 0u) ? 1u : 0u; mine = (j == x) ? c : mine; }
        if (sum == G) break;
        __builtin_amdgcn_s_sleep(1);
        if ((++sp & 255u) == 0u) { if (xb_ld(&bar[XB_TMO])) break; if (sp > XB_SPIN_CAP) { atomicAdd(&bar[XB_TMO], 1u); break; } }
    }
    nloc = mine > 0u ? mine : 1u; nx = cnt > 0u ? cnt : 1u;
}

__device__ __forceinline__ void xcd_barrier(const XcdBarrier& b) {
    asm volatile("s_waitcnt vmcnt(0)" ::: "memory");
    __syncthreads();
    if (b.w == 0 && lane_id_v() == 0) {
        unsigned* bar = b.bar;
        __builtin_amdgcn_s_waitcnt(0);
        unsigned nloc = b.st[0], nx = b.st[1];
        if (nloc == 0u) { xcd_barrier_complete(bar, b.x, nloc, nx); b.st[0] = nloc; b.st[1] = nx; }
        const unsigned old = xb_add(&bar[XB_XSUB(b.x)], 1u);
        const unsigned gen = old / nloc;
        if (old + 1u == (gen + 1u) * nloc) {
            __builtin_amdgcn_fence(__ATOMIC_RELEASE, "agent");
            asm volatile("s_waitcnt vmcnt(0)" ::: "memory");
            const unsigned og = xb_add(&bar[XB_TOP], 1u);
            const unsigned tg = og / nx;
            if (og + 1u == (tg + 1u) * nx) xb_add(&bar[XB_TOPGEN], 1u);
            else XB_SPIN(xb_ld(&bar[XB_TOPGEN]) == tg, bar);
            __builtin_amdgcn_fence(__ATOMIC_ACQUIRE, "agent");
            xb_add(&bar[XB_XGEN(b.x)], 1u);
            asm volatile("s_waitcnt vmcnt(0)" ::: "memory");
        } else {
            XB_SPIN(xb_ld(&bar[XB_XGEN(b.x)]) == gen, bar);
            __builtin_amdgcn_fence(__ATOMIC_ACQUIRE, "agent");
            asm volatile("s_waitcnt vmcnt(0)" ::: "memory");
        }
    }
    __syncthreads();
}

__device__ __forceinline__ void xcd_local_barrier(const XcdBarrier& b) {
    asm volatile("s_waitcnt vmcnt(0)" ::: "memory");
    __syncthreads();
    if (b.w == 0 && lane_id_v() == 0) {
        unsigned* bar = b.bar;
        __builtin_amdgcn_s_waitcnt(0);
        const unsigned nloc = b.st[0];
        const unsigned old = xb_add(&bar[XB_LSUB(b.x)], 1u);
        const unsigned gen = old / nloc;
        if (old + 1u == (gen + 1u) * nloc) xb_add(&bar[XB_LGEN(b.x)], 1u);
        else XB_SPIN(xb_ld(&bar[XB_LGEN(b.x)]) == gen, bar);
        __builtin_amdgcn_fence(__ATOMIC_ACQUIRE, "agent");
        asm volatile("s_waitcnt vmcnt(0)" ::: "memory");
    }
    __syncthreads();
}

typedef float f32x2 __attribute__((ext_vector_type(2)));
typedef unsigned u32x2 __attribute__((ext_vector_type(2)));
__device__ __forceinline__ float bflo(unsigned w) { return __builtin_bit_cast(float, w << 16); }
__device__ __forceinline__ float bfhi(unsigned w) { return __builtin_bit_cast(float, w & 0xffff0000u); }
__device__ __forceinline__ float bf2f(bf16 v) { return __builtin_bit_cast(float, (unsigned)v << 16); }
__device__ __forceinline__ void unpack8(const v4u w, float (&f)[8]) { f[0] = bflo(w.x); f[1] = bfhi(w.x); f[2] = bflo(w.y); f[3] = bfhi(w.y); f[4] = bflo(w.z); f[5] = bfhi(w.z); f[6] = bflo(w.w); f[7] = bfhi(w.w); }
__device__ __forceinline__ v4u pack8(const float (&f)[8]) { v4u w; w.x = pk2(f[0], f[1]); w.y = pk2(f[2], f[3]); w.z = pk2(f[4], f[5]); w.w = pk2(f[6], f[7]); return w; }
__device__ __forceinline__ float xor32(float v, int lane) {
    return __builtin_bit_cast(float, __builtin_amdgcn_ds_bpermute((lane ^ 32) << 2, __builtin_bit_cast(int, v)));
}
__device__ __forceinline__ float sigmoid_f(float x) { return 1.0f / (1.0f + __expf(-x)); }

struct Ctx {
    LAS unsigned char* lds;
    int tid, lane, wave, G, gw, NGW;
    float* out; unsigned char* ws;
};

__device__ __forceinline__ void conv_item(const float* W, int N, int sc, int nv, int k0, bf16* WT, int ldw, int dr, LAS float* scr, int lane, const float* gk = nullptr) {
    const int n_ = lane & 31;
    float wv[32];
#pragma unroll
    for (int i = 0; i < 32; ++i) { const int kk = 2 * i + (lane >> 5); wv[i] = (n_ < nv) ? W[(size_t)(k0 + kk) * N + sc + n_] : 0.f; }
#pragma unroll
    for (int i = 0; i < 32; ++i) { const int kk = 2 * i + (lane >> 5); scr[kk * 33 + n_] = gk ? wv[i] * gk[k0 + kk] : wv[i]; }
    LDS_WAIT(); asm volatile("" ::: "memory");
    const int c = lane & 7;
#pragma unroll
    for (int j = 0; j < 4; ++j) { const int n = (lane >> 3) + 8 * j; const LAS float* s = scr + (8 * c) * 33 + n;
        v4u o; o.x = pk2(s[0 * 33], s[1 * 33]); o.y = pk2(s[2 * 33], s[3 * 33]); o.z = pk2(s[4 * 33], s[5 * 33]); o.w = pk2(s[6 * 33], s[7 * 33]);
        if (n < nv) *(GAS v4u*)(WT + (size_t)(dr + n) * ldw + k0 + 8 * c) = o; }
    LDS_WAIT(); asm volatile("" ::: "memory");
}
__device__ const int SEG_IN[15][3] = {
    {0, Z_FQ, 512}, {512, Z_FK, 512}, {1024, Z_FV, 512}, {1536, 6656 + S_FF, 8}, {1544, Z_DQ, 512}, {2056, 6656 + S_DK, 64}, {2120, 6656 + S_DV, 64},
    {2184, 6656 + S_IQ, 256}, {2440, 6656 + S_IK, 32}, {2472, 6656 + S_IW, 8}, {2480, Z_RQ, 256}, {2736, Z_RK, 256}, {2992, Z_RV, 512}, {3504, Z_RG, 512}, {4016, Z_ZG, 3072}};
constexpr int IN_BLK = 223;
constexpr int IT_IN = 16 * IN_BLK, IT_MIX = 8 * 32, IT_O = 16 * 32, IT_FI = 16 * (FF2 / 32), IT_FO = (FFH / 64) * 32;
constexpr int IT_LAYER = IT_IN + 3 * IT_MIX + IT_O + IT_FI + IT_FO;

__device__ __forceinline__ void sincos_acc(float ang, float& c, float& s) {
    const double a = (double)ang;
    const double k = __builtin_rint(a * 0.6366197723675814);
    double y = a - k * 1.5707963267948966; y -= k * 6.123233995736766e-17;
    const double y2 = y * y;
    double sp = -7.647163731819816e-13; sp = sp * y2 + 1.6059043836821613e-10; sp = sp * y2 - 2.505210838544172e-08; sp = sp * y2 + 2.7557319223985893e-06; sp = sp * y2 - 1.984126984126984e-04; sp = sp * y2 + 8.333333333333333e-03; sp = sp * y2 - 1.6666666666666666e-01;
    const double sn = y + y * y2 * sp;
    double cp = 4.779477332387385e-14; cp = cp * y2 - 1.1470745597729725e-11; cp = cp * y2 + 2.08767569878681e-09; cp = cp * y2 - 2.755731922398589e-07; cp = cp * y2 + 2.48015873015873e-05; cp = cp * y2 - 1.388888888888889e-03; cp = cp * y2 + 4.1666666666666664e-02; cp = cp * y2 - 0.5;
    const double cs = 1.0 + y2 * cp;
    const int q = ((int)k) & 3;
    const double ss = (q & 1) ? cs : sn, cc = (q & 1) ? sn : cs;
    s = (float)((q & 2) ? -ss : ss);
    c = (float)(((q + 1) & 2) ? -cc : cc);
}

__device__ __forceinline__ void p0_prologue(const Ctx& F, const float* w_in, const float* w_fox, const float* w_dsa, const float* w_ret, const float* w_o, const float* w_fi, const float* w_fo, const float* ln1g, const float* ln2g) {
    LAS float* scr = (LAS float*)(F.lds + RING_OFF + F.wave * 16384);
    bf16* Wb = (bf16*)(F.ws + WS_W);
    for (int it = F.gw; it < DEPTH * IT_LAYER; it += F.NGW) {
        const int l = it / IT_LAYER; int r = it % IT_LAYER;
        bf16* L = Wb + (size_t)l * LW_STRIDE;
        if (r < IT_IN) {
            const int kb = r / IN_BLK; int blk = r % IN_BLK; int sc = 0, dr = 0, nv = 0;
            for (int s = 0; s < 15; ++s) { const int w = SEG_IN[s][2], nb = (w + 31) >> 5; if (blk < nb) { sc = SEG_IN[s][0] + 32 * blk; dr = SEG_IN[s][1] + 32 * blk; nv = (w - 32 * blk) < 32 ? (w - 32 * blk) : 32;
                if (s == 0 || s == 1 || s == 4) { const int hd = blk >> 1; dr = SEG_IN[s][1] + (hd >> 2) * 256 + 128 * (blk & 1) + 32 * (hd & 3); }
                break; } blk -= nb; }
            conv_item(w_in + (size_t)l * DM * INC, INC, sc, nv, 64 * kb, L + LW_IN, 1024, dr, scr, F.lane, ln1g + l * DM); continue; }
        r -= IT_IN;
        if (r < 3 * IT_MIX) { const int w = r / IT_MIX, q = r % IT_MIX, kb = q / 32, nb = q % 32;
            conv_item((w == 0 ? w_fox : w == 1 ? w_dsa : w_ret) + (size_t)l * 512 * DM, DM, 32 * nb, 32, 64 * kb, L + LW_MIX + (size_t)w * 512, 1536, 32 * nb, scr, F.lane); continue; }
        r -= 3 * IT_MIX;
        if (r < IT_O) { const int kb = r / 32, nb = r % 32;
            conv_item(w_o + (size_t)l * DM * DM, DM, 32 * nb, 32, 64 * kb, L + LW_O, 1024, 32 * nb, scr, F.lane); continue; }
        r -= IT_O;
        if (r < IT_FI) { const int kb = r / (FF2 / 32), nb = r % (FF2 / 32); const int n0 = 32 * nb;
            const int j = n0 < FFH ? n0 : n0 - FFH; const int dr = 256 * (j >> 7) + (j & 127) + (n0 < FFH ? 0 : 128);
            conv_item(w_fi + (size_t)l * DM * FF2, FF2, n0, 32, 64 * kb, L + LW_FI, 1024, dr, scr, F.lane, ln2g + l * DM); continue; }
        r -= IT_FI;
        { const int kb = r / 32, nb = r % 32;
            conv_item(w_fo + (size_t)l * FFH * DM, DM, 32 * nb, 32, 64 * kb, L + LW_FO, FFH, 32 * nb, scr, F.lane); }
    }
    for (int i = F.gw * 64 + F.lane; i < DEPTH * 80 * 128; i += F.NGW * 64) { const int l = i / (80 * 128), q = i % (80 * 128);
        *(GAS v4u*)(Wb + (size_t)l * LW_STRIDE + LW_IN + (size_t)INC * 1024 + (size_t)q * 8) = (v4u){0u, 0u, 0u, 0u}; }
    f32x2* R64 = (f32x2*)(F.ws + WS_ROPE64); f32x2* R32 = (f32x2*)(F.ws + WS_ROPE32);
    for (int i = F.gw * 64 + F.lane; i < SEQ * 32; i += F.NGW * 64) { const int pos = i >> 5, k = i & 31;
        double f = 1.0; for (int e = 0; e < k; ++e) f *= 0.7498942093324559;
        const float ang = (float)pos * (float)f; float c, s; sincos_acc(ang, c, s); R64[i] = (f32x2){c, s}; }
    for (int i = F.gw * 64 + F.lane; i < SEQ * 16; i += F.NGW * 64) { const int pos = i >> 4, k = i & 15;
        double f = 1.0; for (int e = 0; e < k; ++e) f *= 0.5623413251903491;
        const float ang = (float)pos * (float)f; float c, s; sincos_acc(ang, c, s); R32[i] = (f32x2){c, s}; }
}

__device__ __forceinline__ void norm0_phase(const Ctx& F, const float* x, bf16* o, float* SS) {
    for (int m0 = F.gw; m0 < M; m0 += 4 * F.NGW) {
        f32x4 v[4][4];
#pragma unroll
        for (int r = 0; r < 4; ++r) { const int m = m0 + r * F.NGW; const GAS f32x4* xr = (const GAS f32x4*)(x + (size_t)(m < M ? m : m0) * DM) + F.lane;
#pragma unroll
            for (int j = 0; j < 4; ++j) v[r][j] = xr[64 * j]; }
#pragma unroll
        for (int r = 0; r < 4; ++r) { const int m = m0 + r * F.NGW; if (m < M) { float s = 0.f;
#pragma unroll
            for (int j = 0; j < 4; ++j) s += (v[r][j].x * v[r][j].x + v[r][j].y * v[r][j].y) + (v[r][j].z * v[r][j].z + v[r][j].w * v[r][j].w);
            s = wave_sum(s);
            GAS unsigned long long* o8 = (GAS unsigned long long*)(o + (size_t)m * DM) + F.lane;
#pragma unroll
            for (int j = 0; j < 4; ++j) o8[64 * j] = (unsigned long long)pk2(v[r][j].x, v[r][j].y) | ((unsigned long long)pk2(v[r][j].z, v[r][j].w) << 32);
            if (F.lane < 4) SS[(size_t)m * 4 + F.lane] = (F.lane == 0) ? s : 0.f; } }
    }
}

__device__ __forceinline__ void post_phase(const Ctx& F, const float* g_fq, const float* g_fk, const float* g_dq, const float* g_dk, const float* b_f, bool dummy_out = false) {
    bf16* Z = (bf16*)(F.ws + WS_Z); const float* ZS = (const float*)(F.ws + WS_ZS);
    const f32x2* R64 = (const f32x2*)(F.ws + WS_ROPE64); const f32x2* R32 = (const f32x2*)(F.ws + WS_ROPE32);
    float* LF = (float*)(F.ws + WS_LF); unsigned* ISG = (unsigned*)(F.ws + WS_ISG);
    bf16* KD = (bf16*)(F.ws + WS_KD); bf16* VD = (bf16*)(F.ws + WS_VD); bf16* IQB = (bf16*)(F.ws + WS_IQB); bf16* IKB = (bf16*)(F.ws + WS_IKB);
    const int t0 = blockIdx.x * 512 + F.tid, NT = F.G * 512;
    for (int t = t0; t < M * 8; t += NT) { const int m = t >> 3, h = t & 7; const float* sp = ZS + (size_t)m * ZSP + S_IQ + h * 32;
        f32x4 v[8];
#pragma unroll
        for (int i = 0; i < 8; ++i) v[i] = *(const GAS f32x4*)(sp + 4 * i);
        const float aw = fabsf(ZS[(size_t)m * ZSP + S_IW + h]);
        const f32x2* cs = R32 + (m & (SEQ - 1)) * 16; float f[32];
#pragma unroll
        for (int i = 0; i < 8; ++i) { f[4 * i] = v[i].x; f[4 * i + 1] = v[i].y; f[4 * i + 2] = v[i].z; f[4 * i + 3] = v[i].w; }
#pragma unroll
        for (int d = 0; d < 16; ++d) { const f32x2 tt = cs[d]; const float x1 = f[d], x2 = f[d + 16]; f[d] = (x1 * tt.x - x2 * tt.y) * aw; f[d + 16] = (x2 * tt.x + x1 * tt.y) * aw; }
        bf16* op = IQB + (size_t)m * 256 + h * 32;
#pragma unroll
        for (int i = 0; i < 4; ++i) { float t8[8];
#pragma unroll
            for (int j = 0; j < 8; ++j) t8[j] = f[8 * i + j];
            *(GAS v4u*)(op + 8 * i) = pack8(t8); }
    }
    const int part = blockIdx.x & 3;
    for (int m = (blockIdx.x >> 2) * 512 + F.tid; m < M; m += (F.G >> 2) * 512) { const float* sr = ZS + (size_t)m * ZSP; const int pos = m & (SEQ - 1);
        if (part == 0) { float f[64]; float ss = 0.f;
#pragma unroll
            for (int i = 0; i < 16; ++i) { const f32x4 v = *(const GAS f32x4*)(sr + S_DK + 4 * i); f[4 * i] = v.x; f[4 * i + 1] = v.y; f[4 * i + 2] = v.z; f[4 * i + 3] = v.w; ss += (v.x * v.x + v.y * v.y) + (v.z * v.z + v.w * v.w); }
            const float rs = 1.0f / sqrtf(ss * (1.f / 64) + NORM_EPS); const f32x2* cs = R64 + pos * 32;
#pragma unroll
            for (int d = 0; d < 64; ++d) f[d] = f[d] * rs * g_dk[d];
#pragma unroll
            for (int d = 0; d < 32; ++d) { const f32x2 tt = cs[d]; const float x1 = f[d], x2 = f[d + 32]; f[d] = x1 * tt.x - x2 * tt.y; f[d + 32] = x2 * tt.x + x1 * tt.y; }
#pragma unroll
            for (int i = 0; i < 8; ++i) { float t8[8];
#pragma unroll
                for (int j = 0; j < 8; ++j) t8[j] = f[8 * i + j];
                *(GAS v4u*)(KD + (size_t)m * 64 + 8 * i) = pack8(t8); } }
        if (part == 1)
#pragma unroll
        for (int i = 0; i < 8; ++i) { const f32x4 a = *(const GAS f32x4*)(sr + S_DV + 8 * i), b = *(const GAS f32x4*)(sr + S_DV + 8 * i + 4); const float t8[8] = {a.x, a.y, a.z, a.w, b.x, b.y, b.z, b.w};
            *(GAS v4u*)(VD + (size_t)m * 64 + 8 * i) = pack8(t8); }
        if (part == 2) { float f[32]; const f32x2* cs = R32 + pos * 16;
#pragma unroll
            for (int i = 0; i < 8; ++i) { const f32x4 v = *(const GAS f32x4*)(sr + S_IK + 4 * i); f[4 * i] = v.x; f[4 * i + 1] = v.y; f[4 * i + 2] = v.z; f[4 * i + 3] = v.w; }
#pragma unroll
            for (int d = 0; d < 16; ++d) { const f32x2 tt = cs[d]; const float x1 = f[d], x2 = f[d + 16]; f[d] = x1 * tt.x - x2 * tt.y; f[d + 16] = x2 * tt.x + x1 * tt.y; }
#pragma unroll
            for (int i = 0; i < 4; ++i) { float t8[8];
#pragma unroll
                for (int j = 0; j < 8; ++j) t8[j] = f[8 * i + j];
                *(GAS v4u*)(IKB + (size_t)m * 32 + 8 * i) = pack8(t8); } }
        if (part == 3) { const f32x4 w0 = *(const GAS f32x4*)(sr + S_IW), w1 = *(const GAS f32x4*)(sr + S_IW + 4); const float iw[8] = {w0.x, w0.y, w0.z, w0.w, w1.x, w1.y, w1.z, w1.w}; unsigned sg = 0;
#pragma unroll
            for (int h = 0; h < 8; ++h) sg |= (iw[h] < 0.f ? 1u : 0u) << h;
            ISG[m] = sg;
            const f32x4 f0 = *(const GAS f32x4*)(sr + S_FF), f1 = *(const GAS f32x4*)(sr + S_FF + 4); const float ff[8] = {f0.x, f0.y, f0.z, f0.w, f1.x, f1.y, f1.z, f1.w}; float lf[8];
#pragma unroll
            for (int h = 0; h < 8; ++h) { const float xx = ff[h] + b_f[h]; lf[h] = (fminf(xx, 0.f) - __logf(1.0f + __expf(-fabsf(xx)))) * LOG2E; }
            *(GAS f32x4*)(LF + (size_t)m * 8) = (f32x4){lf[0], lf[1], lf[2], lf[3]}; *(GAS f32x4*)(LF + (size_t)m * 8 + 4) = (f32x4){lf[4], lf[5], lf[6], lf[7]}; }
    }
}

__device__ __forceinline__ float ret_l2g(int h) { return h == 0 ? -0.04580368961312479f : h == 1 ? -0.02272007650008353f : h == 2 ? -0.011315313227834146f : -0.005646563141142063f; }

__device__ __forceinline__ void scan_state_phase(const Ctx& F) {
    const float* LF = (const float*)(F.ws + WS_LF); float* CF = (float*)(F.ws + WS_CF);
    const bf16* Z = (const bf16*)(F.ws + WS_Z); float* RS = (float*)(F.ws + WS_HDN);
    if (F.gw < 32) {
        const int b = F.gw >> 3, h = F.gw & 7; const float* lp = LF + ((size_t)b * SEQ + F.lane * 64) * 8 + h; float s = 0.f;
        for (int i = 0; i < 64; ++i) s += lp[i * 8];
        float incl = s;
#pragma unroll
        for (int o = 1; o < 64; o <<= 1) { const float t = __builtin_bit_cast(float, __builtin_amdgcn_ds_bpermute(((F.lane - o) & 63) << 2, __builtin_bit_cast(int, incl))); if (F.lane >= o) incl += t; }
        float run = incl - s; float* cp = CF + (size_t)F.gw * SEQ + F.lane * 64;
        for (int i = 0; i < 64; ++i) { run += lp[i * 8]; cp[i] = run; }
    }
    for (int u = blockIdx.x; u < NB * 32 * 4; u += F.G) {
        const int h = u & 3, c = (u >> 2) & 31, b = u >> 7; const float l2g = ret_l2g(h);
        const int d = F.tid >> 3, e0 = (F.tid & 7) * 16; float acc[16];
#pragma unroll
        for (int i = 0; i < 16; ++i) acc[i] = 0.f;
        const bf16* base = Z + ((size_t)b * SEQ + c * 128) * ZP;
        for (int j = 0; j < 128; ++j) { const bf16* row = base + (size_t)j * ZP;
            const float kd = bf2f(row[Z_RK + h * 64 + d]) * exp2f((float)(127 - j) * l2g);
            const v4u w0 = *(const GAS v4u*)(row + Z_RV + h * 128 + e0), w1 = *(const GAS v4u*)(row + Z_RV + h * 128 + e0 + 8);
            float v0[8], v1[8]; unpack8(w0, v0); unpack8(w1, v1);
#pragma unroll
            for (int i = 0; i < 8; ++i) { acc[i] += kd * v0[i]; acc[8 + i] += kd * v1[i]; } }
        float* o = RS + (size_t)u * 8192 + d * 128 + e0;
#pragma unroll
        for (int i = 0; i < 4; ++i) *(GAS f32x4*)(o + 4 * i) = (f32x4){acc[4 * i], acc[4 * i + 1], acc[4 * i + 2], acc[4 * i + 3]};
    }
}

__device__ __forceinline__ void ret_out_naive(const Ctx& F, const float* gn) {
    bf16* Z = (bf16*)(F.ws + WS_Z); const float* RS = (const float*)(F.ws + WS_HDN);
    LAS float* S = (LAS float*)(F.lds);
    LAS bf16* Vt = (LAS bf16*)(F.lds + 32768);
    LAS float* Kt = (LAS float*)(F.lds + 65536);
    LAS float* aw = (LAS float*)(F.lds + 65536 + 33280) + F.wave * 128;
    LAS float* qw = (LAS float*)(F.lds + 65536 + 33280 + 4096) + F.wave * 64;
    for (int u = blockIdx.x; u < NB * 32 * 4; u += F.G) {
        const int h = u & 3, c = (u >> 2) & 31, b = u >> 7; const float l2g = ret_l2g(h); const float wch = exp2f(128.f * l2g);
        __syncthreads();
        { float s[16];
#pragma unroll
            for (int i = 0; i < 16; ++i) s[i] = 0.f;
            for (int cp = 0; cp < c; ++cp) { const float* L = RS + ((size_t)((b * 32 + cp) * 4 + h)) * 8192 + F.tid;
#pragma unroll
                for (int i = 0; i < 16; ++i) s[i] = wch * s[i] + L[i * 512]; }
#pragma unroll
            for (int i = 0; i < 16; ++i) S[F.tid + i * 512] = s[i]; }
        const bf16* base = Z + ((size_t)b * SEQ + c * 128) * ZP;
        for (int q = F.tid; q < 2048; q += 512) { const int r = q >> 4, ch = q & 15; *(LAS v4u*)(Vt + r * 128 + ch * 8) = *(const GAS v4u*)(base + (size_t)r * ZP + Z_RV + h * 128 + ch * 8); }
        for (int q = F.tid; q < 128 * 64; q += 512) { const int r = q >> 6, dd = q & 63; Kt[r * 65 + dd] = bf2f(base[(size_t)r * ZP + Z_RK + h * 64 + dd]); }
        __syncthreads();
        for (int i = F.wave; i < 128; i += NWAVES) {
            const size_t m = (size_t)b * SEQ + c * 128 + i; bf16* zr = Z + m * ZP;
            qw[F.lane] = bf2f(zr[Z_RQ + h * 64 + F.lane]);
            LDS_WAIT(); asm volatile("" ::: "memory");
#pragma unroll
            for (int jj = 0; jj < 2; ++jj) { const int j = F.lane + 64 * jj; float a = 0.f;
                if (j <= i) { float dot = 0.f; for (int dd = 0; dd < 64; ++dd) dot += qw[dd] * Kt[j * 65 + dd]; a = dot * exp2f((float)(i - j) * l2g); }
                aw[j] = a; }
            LDS_WAIT(); asm volatile("" ::: "memory");
            float o[2]; const float dq = exp2f((float)(i + 1) * l2g);
#pragma unroll
            for (int ee = 0; ee < 2; ++ee) { const int e = F.lane + 64 * ee; float acc = 0.f;
                for (int j = 0; j <= i; ++j) acc += aw[j] * bf2f(Vt[j * 128 + e]);
                float cr = 0.f; for (int dd = 0; dd < 64; ++dd) cr += qw[dd] * S[dd * 128 + e];
                o[ee] = acc + cr * dq; }
            const float ss = wave_sum(o[0] * o[0] + o[1] * o[1]); const float rstd = 1.0f / sqrtf(ss * (1.f / 128) + NORM_EPS);
#pragma unroll
            for (int ee = 0; ee < 2; ++ee) { const int e = F.lane + 64 * ee; const float rg = bf2f(zr[Z_RG + h * 128 + e]);
                zr[Z_RV + h * 128 + e] = (bf16)f2bf(o[ee] * rstd * gn[h * 128 + e] * rg * sigmoid_f(rg)); }
            LDS_WAIT(); asm volatile("" ::: "memory");
        }
    }
    __syncthreads();
}

__device__ __forceinline__ void fox_naive(const Ctx& F) {
    bf16* Z = (bf16*)(F.ws + WS_Z); const float* CF = (const float*)(F.ws + WS_CF);
    LAS float* sc = (LAS float*)(F.lds + F.wave * 16384);
    const int lane = F.lane;
    int it = 0;
    for (int r0 = 0; r0 < NB * 8 * SEQ; r0 += F.NGW, ++it) {
        const int r = r0 + ((it & 1) ? (F.NGW - 1 - F.gw) : F.gw);
        if (r >= NB * 8 * SEQ) continue;
        const int pos = r & (SEQ - 1), h = (r >> 12) & 7, b = r >> 15;
        const size_t m = (size_t)b * SEQ + pos;
        float qf[64];
        { const bf16* qp = Z + m * ZP + Z_FQ + h * 64;
#pragma unroll
            for (int i = 0; i < 8; ++i) { const v4u w = *(const GAS v4u*)(qp + 8 * i); float t[8]; unpack8(w, t);
#pragma unroll
                for (int j = 0; j < 8; ++j) qf[8 * i + j] = t[j]; } }
        const float* cf = CF + (size_t)(b * 8 + h) * SEQ;
        float mx = -INFINITY;
        for (int kk = lane; kk <= pos; kk += 64) { const bf16* kp = Z + ((size_t)b * SEQ + kk) * ZP + Z_FK + h * 64; float dot = 0.f;
#pragma unroll
            for (int i = 0; i < 8; ++i) { const v4u w = *(const GAS v4u*)(kp + 8 * i); float t[8]; unpack8(w, t);
#pragma unroll
                for (int j = 0; j < 8; ++j) dot += qf[8 * i + j] * t[j]; }
            const float s = dot - cf[kk]; sc[kk] = s; mx = fmaxf(mx, s); }
        mx = wave_max(mx);
        float sum = 0.f;
        for (int kk = lane; kk <= pos; kk += 64) { const float p = exp2f(sc[kk] - mx); sc[kk] = p; sum += p; }
        sum = wave_sum(sum);
        LDS_WAIT(); asm volatile("" ::: "memory");
        const bf16* vp = Z + (size_t)b * SEQ * ZP + Z_FV + h * 64 + lane;
        float o0 = 0.f, o1 = 0.f, o2 = 0.f, o3 = 0.f; int kk = 0;
        for (; kk + 3 <= pos; kk += 4) { o0 += sc[kk] * bf2f(vp[(size_t)kk * ZP]); o1 += sc[kk + 1] * bf2f(vp[(size_t)(kk + 1) * ZP]); o2 += sc[kk + 2] * bf2f(vp[(size_t)(kk + 2) * ZP]); o3 += sc[kk + 3] * bf2f(vp[(size_t)(kk + 3) * ZP]); }
        for (; kk <= pos; ++kk) o0 += sc[kk] * bf2f(vp[(size_t)kk * ZP]);
        Z[m * ZP + Z_FQ + h * 64 + lane] = (bf16)f2bf(((o0 + o1) + (o2 + o3)) / sum);
        LDS_WAIT(); asm volatile("" ::: "memory");
    }
}

__device__ __forceinline__ unsigned f2key(float s) { const unsigned u = __builtin_bit_cast(unsigned, s + 0.0f); return (u & 0x80000000u) ? ~u : (u | 0x80000000u); }
__device__ __forceinline__ void dsa_naive(const Ctx& F) {
    bf16* Z = (bf16*)(F.ws + WS_Z); const float* ZS = (const float*)(F.ws + WS_ZS);
    const unsigned* ISG = (const unsigned*)(F.ws + WS_ISG);
    const bf16* KD = (const bf16*)(F.ws + WS_KD); const bf16* VD = (const bf16*)(F.ws + WS_VD);
    LAS unsigned* kl = (LAS unsigned*)(F.lds + F.wave * 16384);
    LAS float* iqs = (LAS float*)(F.lds + XTRA_OFF + F.wave * 1536);
    const int lane = F.lane;
    int it = 0;
    for (int r0 = 0; r0 < M; r0 += F.NGW, ++it) {
        const int r = r0 + ((it & 1) ? (F.NGW - 1 - F.gw) : F.gw);
        if (r >= M) continue;
        const int pos = r & (SEQ - 1), b = r >> 12; const size_t m = (size_t)r;
        *(LAS f32x4*)(iqs + 4 * lane) = *(const GAS f32x4*)(ZS + m * ZSP + S_IQ + 4 * lane);
        const unsigned sg = ISG[m];
        LDS_WAIT(); asm volatile("" ::: "memory");
        for (int kk = lane; kk <= pos; kk += 64) { const float* ikp = ZS + ((size_t)b * SEQ + kk) * ZSP + S_IK; float ik[32];
#pragma unroll
            for (int i = 0; i < 8; ++i) { const f32x4 t = *(const GAS f32x4*)(ikp + 4 * i); ik[4 * i] = t.x; ik[4 * i + 1] = t.y; ik[4 * i + 2] = t.z; ik[4 * i + 3] = t.w; }
            float s = 0.f;
#pragma unroll 1
            for (int h = 0; h < 8; ++h) { float dot = 0.f;
#pragma unroll
                for (int dd = 0; dd < 32; ++dd) dot += iqs[h * 32 + dd] * ik[dd];
                dot = fmaxf(dot, 0.f); s += ((sg >> h) & 1u) ? -dot : dot; }
            kl[kk] = f2key(s); }
        LDS_WAIT(); asm volatile("" ::: "memory");
        unsigned key[64];
#pragma unroll
        for (int j = 0; j < 64; ++j) { const int kk = j * 64 + lane; key[j] = (kk <= pos) ? kl[kk] : 0u; }
        LDS_WAIT(); asm volatile("" ::: "memory");
        LAS unsigned* idx = kl; LAS float* pl = (LAS float*)(kl + 256); LAS bf16* qs = (LAS bf16*)(kl + 512);
        *(LAS v4u*)(qs + 8 * lane) = *(const GAS v4u*)(Z + m * ZP + Z_DQ + 8 * lane);
        unsigned T = 0u; int need = 0;
        if (pos + 1 > 256) {
            for (int bit = 31; bit >= 0; --bit) { const unsigned Tt = T | (1u << bit); int cnt = 0;
#pragma unroll
                for (int j = 0; j < 64; ++j) cnt += __builtin_popcountll(__ballot(key[j] >= Tt));
                if (cnt >= 256) T = Tt; }
            int ngt = 0;
#pragma unroll
            for (int j = 0; j < 64; ++j) ngt += __builtin_popcountll(__ballot(key[j] > T));
            need = 256 - ngt;
        }
        int nsel = 0, eqb = 0;
#pragma unroll
        for (int j = 0; j < 64; ++j) { const bool gt = key[j] > T, eq = (key[j] == T) && (T != 0u);
            const unsigned long long em = __ballot(eq); const int er = eqb + __builtin_amdgcn_mbcnt_hi((unsigned)(em >> 32), __builtin_amdgcn_mbcnt_lo((unsigned)em, 0u));
            const bool sel = gt || (eq && er < need); eqb += __builtin_popcountll(em);
            const unsigned long long sm = __ballot(sel); const int sp = nsel + __builtin_amdgcn_mbcnt_hi((unsigned)(sm >> 32), __builtin_amdgcn_mbcnt_lo((unsigned)sm, 0u));
            if (sel) idx[sp] = (unsigned)(j * 64 + lane); nsel += __builtin_popcountll(sm); }
        LDS_WAIT(); asm volatile("" ::: "memory");
        for (int h = 0; h < 8; ++h) {
            float sv[4]; float mx = -INFINITY;
#pragma unroll
            for (int i = 0; i < 4; ++i) { const int e = lane + 64 * i; sv[i] = -INFINITY;
                if (e < nsel) { const bf16* kp = KD + ((size_t)b * SEQ + idx[e]) * 64; float dot = 0.f;
#pragma unroll
                    for (int c = 0; c < 8; ++c) { const v4u w = *(const GAS v4u*)(kp + 8 * c); float t[8]; unpack8(w, t); const v4u qw = *(const LAS v4u*)(qs + h * 64 + 8 * c); float qq[8]; unpack8(qw, qq);
#pragma unroll
                        for (int j = 0; j < 8; ++j) dot += qq[j] * t[j]; }
                    sv[i] = dot; }
                mx = fmaxf(mx, sv[i]); }
            mx = wave_max(mx); float sum = 0.f;
#pragma unroll
            for (int i = 0; i < 4; ++i) { const int e = lane + 64 * i; const float p = (e < nsel) ? exp2f(sv[i] - mx) : 0.f; pl[e] = p; sum += p; }
            sum = wave_sum(sum);
            LDS_WAIT(); asm volatile("" ::: "memory");
            float o0 = 0.f, o1 = 0.f; int e = 0;
            for (; e + 1 < nsel; e += 2) { o0 += pl[e] * bf2f(VD[((size_t)b * SEQ + idx[e]) * 64 + lane]); o1 += pl[e + 1] * bf2f(VD[((size_t)b * SEQ + idx[e + 1]) * 64 + lane]); }
            if (e < nsel) o0 += pl[e] * bf2f(VD[((size_t)b * SEQ + idx[e]) * 64 + lane]);
            Z[m * ZP + Z_DQ + h * 64 + lane] = (bf16)f2bf((o0 + o1) / sum);
            LDS_WAIT(); asm volatile("" ::: "memory");
        }
    }
}
#ifndef PROBE_T
#define PROBE_T 0
#endif
#define PT_B(k) do { if (PROBE_T == (k)) { asm volatile("" ::: "memory"); pt_t0 = __builtin_amdgcn_s_memrealtime(); } } while (0)
#define PT_E(k) do { if (PROBE_T == (k)) { asm volatile("s_waitcnt lgkmcnt(0)" ::: "memory"); pt_acc += __builtin_amdgcn_s_memrealtime() - pt_t0; } } while (0)
#ifndef PROBE_D
#define PROBE_D 0
#endif

typedef short s16x8 __attribute__((ext_vector_type(8)));
typedef short s16x4 __attribute__((ext_vector_type(4)));
typedef short v4i16_t __attribute__((ext_vector_type(4)));
__device__ __forceinline__ s16x4 tr16(const LAS unsigned char* p) { return __builtin_bit_cast(s16x4, __builtin_amdgcn_ds_read_tr16_b64_v4i16((LAS v4i16_t*)p)); }
__device__ __forceinline__ float key2f(unsigned k) { return __builtin_bit_cast(float, (k & 0x80000000u) ? (k & 0x7fffffffu) : ~k); }

template <int NR> __device__ __forceinline__ int dsa_count_ge(const unsigned (&key)[64], unsigned T) {
    int c = 0;
#pragma unroll
    for (int j = 0; j < NR; ++j) c += __builtin_popcountll(__ballot(key[j] >= T));
    return c;
}
#define DSA_COUNT_GE(T_, out_) do { if (nq == 1) out_ = dsa_count_ge<16>(key, (T_)); else if (nq == 2) out_ = dsa_count_ge<32>(key, (T_)); else if (nq == 3) out_ = dsa_count_ge<48>(key, (T_)); else out_ = dsa_count_ge<64>(key, (T_)); } while (0)
__device__ __forceinline__ void dsa_select(const unsigned (&key)[64], int nvalid, unsigned& T, int& need) {
    const int nq = __builtin_amdgcn_readfirstlane((nvalid + 1023) >> 10);
    T = 0u; need = 0;
    if (nvalid <= 256) return;
    unsigned kmax = 0u;
#pragma unroll
    for (int j = 0; j < 64; ++j) kmax = key[j] > kmax ? key[j] : kmax;
#pragma unroll
    for (int o_ = 0; o_ < 1; ++o_) { unsigned t; t = sxu<1>(kmax); kmax = t > kmax ? t : kmax; t = sxu<2>(kmax); kmax = t > kmax ? t : kmax; t = sxu<4>(kmax); kmax = t > kmax ? t : kmax; t = sxu<8>(kmax); kmax = t > kmax ? t : kmax; t = sxu<16>(kmax); kmax = t > kmax ? t : kmax;
        unsigned a_, b_; swap32(kmax, a_, b_); kmax = a_ > b_ ? a_ : b_; }
    unsigned lo = 1u, hi = kmax + 1u; int hic = 0;
    { const float vm = fabsf(key2f(kmax)) + 1.0f; unsigned l2 = f2key(-vm * 64.0f); int c; DSA_COUNT_GE(l2, c); if (c >= 256) lo = l2; }
    int iter = 0; bool exact = false;
    while (hi - lo > 1u) {
        unsigned mid;
        if (iter < 24 && lo > 1u) { const float mv = 0.5f * key2f(lo) + 0.5f * key2f(hi - 1u); mid = f2key(mv); }
        else mid = lo + ((hi - lo) >> 1);
        if (mid <= lo) mid = lo + 1u; if (mid >= hi) mid = hi - 1u;
        int c; DSA_COUNT_GE(mid, c);
        if (c == 256) { T = mid; exact = true; break; }
        if (c > 256) lo = mid; else { hi = mid; hic = c; }
        ++iter;
    }
    if (exact) need = 256; else { T = lo; need = 256 - hic; }
}

template <bool SYNC_BEFORE_STAGE = false> __device__ __forceinline__ void dsa_attend(const bf16* zq, bf16* zo, const bf16* KDb, const bf16* VDb, const LAS unsigned short* idx, int nsel, LAS unsigned char* vst, int lane, unsigned long long& pt_acc, unsigned long long& pt_t0) {
    PT_B(5);
    const int g = lane >> 4, c = lane & 15;
    s16x8 qf[2];
#pragma unroll
    for (int ks = 0; ks < 2; ++ks) { qf[ks] = (s16x8){0, 0, 0, 0, 0, 0, 0, 0}; if (c < 8) qf[ks] = *(const GAS s16x8*)(zq + c * 64 + 32 * ks + 8 * g); }
    f32x4 acc[16];
    v4u vreg[16];
#pragma unroll
    for (int i = 0; i < 16; ++i) { const int pi = lane + 64 * i, r = pi >> 3, c16 = pi & 7; const int id = (r < nsel) ? (int)idx[r] : 0; vreg[i] = *(const GAS v4u*)(VDb + (size_t)id * 64 + c16 * 8); }
#pragma unroll
    for (int tb = 0; tb < 2; ++tb) {
        s16x8 kf[8][2];
#pragma unroll
        for (int tt = 0; tt < 8; ++tt) { const int e = 16 * (8 * tb + tt) + c; const int id = (e < nsel) ? (int)idx[e] : 0; const bf16* kp = KDb + (size_t)id * 64 + 8 * g;
            kf[tt][0] = *(const GAS s16x8*)kp; kf[tt][1] = *(const GAS s16x8*)(kp + 32); }
#pragma unroll
        for (int tt = 0; tt < 8; ++tt) { f32x4 a = (f32x4){0.f, 0.f, 0.f, 0.f};
            a = __builtin_amdgcn_mfma_f32_16x16x32_bf16(kf[tt][0], qf[0], a, 0, 0, 0); a = __builtin_amdgcn_mfma_f32_16x16x32_bf16(kf[tt][1], qf[1], a, 0, 0, 0); acc[8 * tb + tt] = a; }
    }
    if (nsel < 256) {
#pragma unroll
        for (int t = 0; t < 16; ++t)
#pragma unroll
            for (int i = 0; i < 4; ++i) { const int e = 16 * t + 4 * g + i; if (e >= nsel) acc[t][i] = -INFINITY; }
    }
    float mx = -INFINITY;
#pragma unroll
    for (int t = 0; t < 16; ++t)
#pragma unroll
        for (int i = 0; i < 4; ++i) mx = fmaxf(mx, acc[t][i]);
    mx = fmaxf(mx, sx<16>(mx)); mx = half_max(mx);
    typedef float f32x2_ __attribute__((ext_vector_type(2)));
    const f32x2_ mx2 = {mx, mx}; f32x2_ sum2 = {0.f, 0.f};
#pragma unroll
    for (int t = 0; t < 16; ++t)
#pragma unroll
        for (int i = 0; i < 4; i += 2) { f32x2_ d = (f32x2_){acc[t][i], acc[t][i + 1]} - mx2; d[0] = __builtin_amdgcn_exp2f(d[0]); d[1] = __builtin_amdgcn_exp2f(d[1]); acc[t][i] = d[0]; acc[t][i + 1] = d[1]; sum2 += d; }
    float sum = sum2[0] + sum2[1];
    sum += sx<16>(sum); sum = half_sum(sum);
    const float inv = 1.0f / sum; const f32x2_ inv2 = {inv, inv};
    s16x8 pf[8];
#pragma unroll
    for (int s = 0; s < 8; ++s) { const f32x2_ a0 = (f32x2_){acc[2 * s][0], acc[2 * s][1]} * inv2, a1 = (f32x2_){acc[2 * s][2], acc[2 * s][3]} * inv2, a2 = (f32x2_){acc[2 * s + 1][0], acc[2 * s + 1][1]} * inv2, a3 = (f32x2_){acc[2 * s + 1][2], acc[2 * s + 1][3]} * inv2;
        v4u w; w.x = pk2(a0[0], a0[1]); w.y = pk2(a1[0], a1[1]); w.z = pk2(a2[0], a2[1]); w.w = pk2(a3[0], a3[1]);
        pf[s] = __builtin_bit_cast(s16x8, w); }
    f32x4 o[4];
#pragma unroll
    for (int db = 0; db < 4; ++db) o[db] = (f32x4){0.f, 0.f, 0.f, 0.f};
    const int q = (lane >> 2) & 3, p = lane & 3, swz = 2 * (g & 1) + (q >> 1);
    const LAS unsigned char* rb = vst + (4 * g + q) * 128 + 8 * p;
    PT_E(5); PT_B(6);
    if constexpr (SYNC_BEFORE_STAGE) __syncthreads();
    PT_E(6); PT_B(7);
#pragma unroll
    for (int hh = 0; hh < 2; ++hh) {
        asm volatile("s_waitcnt lgkmcnt(0)" ::: "memory");
#pragma unroll
        for (int i = 0; i < 16; ++i) { const int pi = lane + 64 * i, r = pi >> 3, c16 = pi & 7;
            *(LAS v4u*)(vst + r * 128 + ((((c16 >> 1) ^ ((r >> 1) & 3))) << 5) + ((c16 & 1) << 4)) = vreg[i]; }
        if (hh == 0) {
#pragma unroll
            for (int i = 0; i < 16; ++i) { const int pi = lane + 64 * i, r = pi >> 3, c16 = pi & 7, e = 128 + r; const int id = (e < nsel) ? (int)idx[e] : 0; vreg[i] = *(const GAS v4u*)(VDb + (size_t)id * 64 + c16 * 8); } }
        asm volatile("s_waitcnt lgkmcnt(0)" ::: "memory");
#pragma unroll
        for (int s4 = 0; s4 < 4; ++s4)
#pragma unroll
            for (int db = 0; db < 4; ++db) { const LAS unsigned char* a1 = rb + s4 * 4096 + ((db ^ swz) << 5);
                const s16x4 lo = tr16(a1), hi = tr16(a1 + 2048);
                const s16x8 vf = (s16x8){lo[0], lo[1], lo[2], lo[3], hi[0], hi[1], hi[2], hi[3]};
                o[db] = __builtin_amdgcn_mfma_f32_16x16x32_bf16(pf[4 * hh + s4], vf, o[db], 0, 0, 0); }
    }
    if (g < 2) {
#pragma unroll
        for (int db = 0; db < 4; ++db)
#pragma unroll
            for (int i = 0; i < 4; ++i) zo[(4 * g + i) * 64 + 16 * db + c] = (bf16)f2bf(o[db][i]);
    }
    PT_E(7);
}

__device__ __forceinline__ void dsa_v2(const Ctx& F) {
    bf16* Z = (bf16*)(F.ws + WS_Z); const float* ZS = (const float*)(F.ws + WS_ZS);
    const unsigned* ISG = (const unsigned*)(F.ws + WS_ISG);
    const bf16* KD = (const bf16*)(F.ws + WS_KD); const bf16* VD = (const bf16*)(F.ws + WS_VD);
    LAS unsigned* kl = (LAS unsigned*)(F.lds + F.wave * 16384);
    LAS float* iqs = (LAS float*)(F.lds + XTRA_OFF + F.wave * 1536);
    LAS unsigned short* idx = (LAS unsigned short*)(F.lds + XTRA_OFF + F.wave * 1536 + 1024);
    const int lane = F.lane;
    int it = 0;
    for (int r0 = 0; r0 < M; r0 += F.NGW, ++it) {
        const int r = r0 + ((it & 1) ? (F.NGW - 1 - F.gw) : F.gw);
        if (r >= M) continue;
        const int pos = r & (SEQ - 1), b = r >> 12; const size_t m = (size_t)r;
        *(LAS f32x4*)(iqs + 4 * lane) = *(const GAS f32x4*)(ZS + m * ZSP + S_IQ + 4 * lane);
        const unsigned sg = ISG[m];
        LDS_WAIT(); asm volatile("" ::: "memory");
        for (int kk = lane; kk <= pos; kk += 64) { const float* ikp = ZS + ((size_t)b * SEQ + kk) * ZSP + S_IK; float ik[32];
#pragma unroll
            for (int i = 0; i < 8; ++i) { const f32x4 t = *(const GAS f32x4*)(ikp + 4 * i); ik[4 * i] = t.x; ik[4 * i + 1] = t.y; ik[4 * i + 2] = t.z; ik[4 * i + 3] = t.w; }
            float s = 0.f;
#pragma unroll 1
            for (int h = 0; h < 8; ++h) { float dot = 0.f;
#pragma unroll
                for (int dd = 0; dd < 32; ++dd) dot += iqs[h * 32 + dd] * ik[dd];
                dot = fmaxf(dot, 0.f); s += ((sg >> h) & 1u) ? -dot : dot; }
            kl[kk] = f2key(s); }
        LDS_WAIT(); asm volatile("" ::: "memory");
        unsigned key[64];
#pragma unroll
        for (int j = 0; j < 64; ++j) { const int kk = j * 64 + lane; key[j] = (kk <= pos) ? kl[kk] : 0u; }
        LDS_WAIT(); asm volatile("" ::: "memory");
        unsigned T; int need;
#ifdef DSA_OLDSEL
        T = 0u; need = 0;
        if (pos + 1 > 256) {
            for (int bit = 31; bit >= 0; --bit) { const unsigned Tt = T | (1u << bit); int cnt = 0;
#pragma unroll
                for (int j = 0; j < 64; ++j) cnt += __builtin_popcountll(__ballot(key[j] >= Tt));
                if (cnt >= 256) T = Tt; }
            int ngt = 0;
#pragma unroll
            for (int j = 0; j < 64; ++j) ngt += __builtin_popcountll(__ballot(key[j] > T));
            need = 256 - ngt;
        }
#else
        dsa_select(key, pos + 1, T, need);
#endif
        int nsel = 0, eqb = 0;
#pragma unroll
        for (int j = 0; j < 64; ++j) { const bool gt = key[j] > T, eq = (key[j] == T) && (T != 0u);
            const unsigned long long em = __ballot(eq); const int er = eqb + __builtin_amdgcn_mbcnt_hi((unsigned)(em >> 32), __builtin_amdgcn_mbcnt_lo((unsigned)em, 0u));
            const bool sel = gt || (eq && er < need); eqb += __builtin_popcountll(em);
            const unsigned long long sm = __ballot(sel); const int sp = nsel + __builtin_amdgcn_mbcnt_hi((unsigned)(sm >> 32), __builtin_amdgcn_mbcnt_lo((unsigned)sm, 0u));
            if (sel) idx[sp] = (unsigned short)(j * 64 + lane); nsel += __builtin_popcountll(sm); }
        LDS_WAIT(); asm volatile("" ::: "memory");
        { unsigned long long pa_ = 0, pb_ = 0; dsa_attend(Z + m * ZP + Z_DQ, Z + m * ZP + Z_DQ, KD + (size_t)b * SEQ * 64, VD + (size_t)b * SEQ * 64, idx, nsel, (LAS unsigned char*)kl, lane, pa_, pb_); }
        LDS_WAIT(); asm volatile("" ::: "memory");
    }
}

template <int NR> __device__ __forceinline__ int dsa_emit_n(const unsigned (&key)[64], unsigned T, int need, LAS unsigned short* idx, int lane) {
    int nsel = 0, eqb = 0;
#pragma unroll
    for (int j = 0; j < NR; ++j) { const bool gt = key[j] > T, eq = (key[j] == T) && (T != 0u);
        const unsigned long long em = __ballot(eq); const int er = eqb + __builtin_amdgcn_mbcnt_hi((unsigned)(em >> 32), __builtin_amdgcn_mbcnt_lo((unsigned)em, 0u));
        const bool sel = gt || (eq && er < need); eqb += __builtin_popcountll(em);
        const unsigned long long sm = __ballot(sel); const int sp = nsel + __builtin_amdgcn_mbcnt_hi((unsigned)(sm >> 32), __builtin_amdgcn_mbcnt_lo((unsigned)sm, 0u));
        if (sel) idx[sp] = (unsigned short)(j * 64 + lane); nsel += __builtin_popcountll(sm); }
    return nsel;
}
__device__ __forceinline__ int dsa_emit(const unsigned (&key)[64], int nvalid, unsigned T, int need, LAS unsigned short* idx, int lane) {
    const int nq = __builtin_amdgcn_readfirstlane((nvalid + 1023) >> 10);
    if (nq == 1) return dsa_emit_n<16>(key, T, need, idx, lane);
    if (nq == 2) return dsa_emit_n<32>(key, T, need, idx, lane);
    if (nq == 3) return dsa_emit_n<48>(key, T, need, idx, lane);
    return dsa_emit_n<64>(key, T, need, idx, lane);
}

#define DSA_CNT8(cnt_, k_, o_, T_) asm volatile( \
    "v_cmp_ge_u32_e64 s[60:61], %1, %9\n\tv_cmp_ge_u32_e64 s[62:63], %2, %9\n\tv_cmp_ge_u32_e64 s[64:65], %3, %9\n\tv_cmp_ge_u32_e64 s[66:67], %4, %9\n\t" \
    "v_cmp_ge_u32_e64 s[68:69], %5, %9\n\tv_cmp_ge_u32_e64 s[70:71], %6, %9\n\tv_cmp_ge_u32_e64 s[72:73], %7, %9\n\tv_cmp_ge_u32_e64 s[74:75], %8, %9\n\t" \
    "v_addc_co_u32_e64 %0, s[76:77], 0, %0, s[60:61]\n\tv_addc_co_u32_e64 %0, s[76:77], 0, %0, s[62:63]\n\tv_addc_co_u32_e64 %0, s[76:77], 0, %0, s[64:65]\n\tv_addc_co_u32_e64 %0, s[76:77], 0, %0, s[66:67]\n\t" \
    "v_addc_co_u32_e64 %0, s[76:77], 0, %0, s[68:69]\n\tv_addc_co_u32_e64 %0, s[76:77], 0, %0, s[70:71]\n\tv_addc_co_u32_e64 %0, s[76:77], 0, %0, s[72:73]\n\tv_addc_co_u32_e64 %0, s[76:77], 0, %0, s[74:75]" \
    : "+v"(cnt_) : "v"(k_[o_]), "v"(k_[o_ + 1]), "v"(k_[o_ + 2]), "v"(k_[o_ + 3]), "v"(k_[o_ + 4]), "v"(k_[o_ + 5]), "v"(k_[o_ + 6]), "v"(k_[o_ + 7]), "s"(T_) \
    : "s60", "s61", "s62", "s63", "s64", "s65", "s66", "s67", "s68", "s69", "s70", "s71", "s72", "s73", "s74", "s75", "s76", "s77")
template <int NR> __device__ __forceinline__ int dsa_lane_count(const unsigned (&key)[64], unsigned T) {
    int c = 0; const unsigned Ts = (unsigned)__builtin_amdgcn_readfirstlane((int)T);
#pragma unroll
    for (int j = 0; j < NR; j += 8) DSA_CNT8(c, key, j, Ts);
    return c;
}
#define DSA_LCOUNT(T_, lc_) do { if (nq == 1) lc_ = dsa_lane_count<16>(key, (T_)); else if (nq == 2) lc_ = dsa_lane_count<32>(key, (T_)); else if (nq == 3) lc_ = dsa_lane_count<48>(key, (T_)); else lc_ = dsa_lane_count<64>(key, (T_)); } while (0)
template <int NR> __device__ __forceinline__ void dsa_write_ge(const unsigned (&key)[64], unsigned T, int off, LAS unsigned short* idx, int lane) {
    const int dummy = 256 + lane;
#pragma unroll
    for (int j = 0; j < NR; ++j) { const bool s = key[j] >= T; idx[s ? off : dummy] = (unsigned short)(j * 64 + lane); off += s ? 1 : 0; }
}
__device__ __forceinline__ int dsa_select2(const unsigned (&key)[64], int nvalid, float s1, float s2, LAS unsigned short* idx, int lane, unsigned long long& pt_acc) {
    const int nq = __builtin_amdgcn_readfirstlane((nvalid + 1023) >> 10);
    unsigned T = 1u; int lc = 0; bool exact = true;
    if (nvalid > 256) {
        const float n = (float)nvalid, rn = __builtin_amdgcn_rcpf(n), mean = s1 * rn, sd = __builtin_amdgcn_sqrtf(fmaxf(s2 * rn - mean * mean, 1e-30f));
        const float pfrac = 256.0f * rn, pt = fminf(pfrac, 1.0f - pfrac);
        const float tt = __builtin_amdgcn_sqrtf(-2.0f * __logf(fmaxf(pt, 1e-6f)));
        float zn = (0.010328f * tt + 0.802853f) * tt + 2.515517f; asm volatile("" : "+v"(zn));
        float zd = ((0.001308f * tt + 0.189269f) * tt + 1.432788f) * tt + 1.0f; asm volatile("" : "+v"(zd));
        float z = tt - zn * __builtin_amdgcn_rcpf(zd);
        if (pfrac > 0.5f) z = -z;
        const float rdens = sd * __builtin_amdgcn_rcpf(n * __expf(-0.5f * z * z) * 0.3989423f);
        unsigned lo = 1u, hi = 0xffffffffu; int clo = nvalid, chi = 0;
        bool lop = false, hip = false; float lastv = mean + z * sd, lastc = 256.0f, grow = 1.3f;
        exact = false; int same = 0, last = 0;
        for (int it = 0; hi - lo > 1u; ++it) {
            unsigned mid;
            if (it == 0) mid = f2key(lastv);
            else if (!(lop && hip)) { lastv = lastv + grow * (lastc - 256.0f) * rdens; grow *= 2.0f; mid = f2key(lastv); }
            else if (it < 24 && same < 2) { const float vlo = key2f(lo), vhi = key2f(hi - 1u); mid = f2key(vlo + (vhi - vlo) * (((float)(clo - 256) + 0.5f) * __builtin_amdgcn_rcpf((float)(clo - chi)))); }
            else if (it < 48) { mid = f2key(0.5f * key2f(lo) + 0.5f * key2f(hi - 1u)); same = 0; }
            else mid = lo + ((hi - lo) >> 1);
            if (!(mid > lo)) mid = lo + 1u; if (!(mid < hi)) mid = hi - 1u;
            DSA_LCOUNT(mid, lc); const int c = wave_isum(lc); lastc = (float)c; lastv = key2f(mid);
            if (PROBE_T == 9) pt_acc += 100;
            if (c == 256) { T = mid; exact = true; break; }
            if (c > 256) { lo = mid; clo = c; lop = true; same = (last > 0) ? same + 1 : 0; last = 1; } else { hi = mid; chi = c; hip = true; same = (last < 0) ? same + 1 : 0; last = -1; }
        }
        if (!exact) {
            const int nsel = dsa_emit(key, nvalid, lo, 256 - chi, idx, lane);
            return nsel;
        }
    } else { DSA_LCOUNT(1u, lc); }
    int incl = lc;
#pragma unroll
    for (int o = 1; o < 64; o <<= 1) { const int t = __builtin_amdgcn_ds_bpermute(((lane - o) & 63) << 2, incl); if (lane >= o) incl += t; }
    const int total = __builtin_amdgcn_readlane(incl, 63);
    if (nq == 1) dsa_write_ge<16>(key, T, incl - lc, idx, lane); else if (nq == 2) dsa_write_ge<32>(key, T, incl - lc, idx, lane); else if (nq == 3) dsa_write_ge<48>(key, T, incl - lc, idx, lane); else dsa_write_ge<64>(key, T, incl - lc, idx, lane);
    return total;
}

__device__ __forceinline__ void fmac_(float& a, float x, float y) { asm("v_fmac_f32 %0, %1, %2" : "+v"(a) : "v"(x), "v"(y)); }
__device__ __forceinline__ unsigned f2key3(float s) { const unsigned u = __builtin_bit_cast(unsigned, s + 0.0f); return u ^ ((unsigned)((int)u >> 31) | 0x80000000u); }
constexpr int DSA_ROWF = 4100;
__device__ __forceinline__ void dsa_v3(const Ctx& F, int out_col = Z_DQ) {
    LAS unsigned* img = (LAS unsigned*)(F.lds);
    unsigned long long pt_acc = 0, pt_t0 = 0;
    const int v = (int)blockIdx.x;
    if (v < 256)
    for (int ui = 0; ui < 8; ++ui) {
        unsigned char* wsl = F.ws; asm volatile("" : "+s"(wsl));
        bf16* Z = (bf16*)(wsl + WS_Z); const unsigned* ISG = (const unsigned*)(wsl + WS_ISG);
        const bf16* KD = (const bf16*)(wsl + WS_KD); const bf16* VD = (const bf16*)(wsl + WS_VD);
        const bf16* IQB = (const bf16*)(wsl + WS_IQB); const bf16* IKB = (const bf16*)(wsl + WS_IKB);
        int w_ = F.wave; asm volatile("" : "+s"(w_)); const int w = w_;
        LAS unsigned short* idxw = (LAS unsigned short*)(F.lds + XTRA_OFF + w * 1536);
        const int lane = lane_id_v(), g = lane >> 4, c = lane & 15;
        const int b = (v & 7) >> 1, k = ((v >> 3) << 1) | (v & 1); const int pb = 128 * (ui >> 1) + ((ui & 1) ? 127 - k : k);
        const int q0 = pb * 8, kend = q0 + 8, ntile = (kend + 15) >> 4;
        const size_t mb = (size_t)b * SEQ;
#if PROBE_D == 1
        for (int rp_ = 0; rp_ < 2; ++rp_)
#endif
        PT_B(1);
        { s16x8 iqf[4]; float sgn[4]; s16x8 iqc;
          { const int qi = c & 7, hs = c >> 3; const int qq = q0 + qi; const bf16* qp = IQB + (mb + qq) * 256 + 8 * g; const unsigned sg = ISG[mb + qq];
            float cs[8];
#pragma unroll
            for (int e = 0; e < 8; ++e) cs[e] = 0.f;
#pragma unroll
            for (int j = 0; j < 4; ++j) { const int h = 2 * j + hs; iqf[j] = *(const GAS s16x8*)(qp + h * 32); sgn[j] = ((sg >> h) & 1u) ? -1.0f : 1.0f;
                float t8[8]; unpack8(__builtin_bit_cast(v4u, iqf[j]), t8);
#pragma unroll
                for (int e = 0; e < 8; ++e) cs[e] += sgn[j] * t8[e]; }
            iqc = __builtin_bit_cast(s16x8, pack8(cs)); }
          const bf16* ikp = IKB + (mb + c) * 32 + 8 * g;
          float st1 = 0.f, st2 = 0.f;
#pragma unroll 1
          for (int tg = 0; tg < 2; ++tg) { if (w + 128 * tg < ntile) {
          s16x8 kt[16];
#pragma unroll
          for (int i4 = 0; i4 < 4; ++i4) { if (w + 128 * tg + 32 * i4 < ntile) {
#pragma unroll
              for (int i = 4 * i4; i < 4 * i4 + 4; ++i) { const int t = w + 128 * tg + 8 * i; kt[i] = *(const GAS s16x8*)(ikp + (size_t)512 * (t < ntile ? t : 0)); } }
            else {
#pragma unroll
              for (int i = 4 * i4; i < 4 * i4 + 4; ++i) kt[i] = (s16x8){0, 0, 0, 0, 0, 0, 0, 0}; } }
#pragma unroll
          for (int i = 0; i < 16; ++i) { const int t = w + 128 * tg + 8 * i;
              if (t < ntile) {
                f32x4 xs[4]; f32x4 sc = __builtin_amdgcn_mfma_f32_16x16x32_bf16(kt[i], iqc, (f32x4){0.f, 0.f, 0.f, 0.f}, 0, 0, 0);
#pragma unroll
                for (int h = 0; h < 4; ++h) xs[h] = __builtin_amdgcn_mfma_f32_16x16x32_bf16(kt[i], iqf[h], (f32x4){0.f, 0.f, 0.f, 0.f}, 0, 0, 0);
                __builtin_amdgcn_sched_barrier(0);
#pragma unroll
                for (int h = 0; h < 4; ++h)
#pragma unroll
                    for (int r = 0; r < 4; ++r) { sc[r] = __builtin_fmaf(sgn[h], __builtin_fabsf(xs[h][r]), sc[r]); asm("" : "+v"(sc[r])); }
#pragma unroll
                for (int r = 0; r < 4; ++r) sc[r] += sx<8>(sc[r]);
                v4u kk; kk.x = f2key3(sc[0]); kk.y = f2key3(sc[1]); kk.z = f2key3(sc[2]); kk.w = f2key3(sc[3]);
                if (16 * t + 15 <= q0) {
                    st1 += (sc[0] + sc[1]) + (sc[2] + sc[3]); fmac_(st2, sc[0], sc[0]); fmac_(st2, sc[1], sc[1]); fmac_(st2, sc[2], sc[2]); fmac_(st2, sc[3], sc[3]);
                } else { const int kb = 16 * t + 4 * g, qa = q0 + (c & 7);
                    if (kb + 0 > qa) { kk.x = 0u; sc[0] = 0.f; } if (kb + 1 > qa) { kk.y = 0u; sc[1] = 0.f; } if (kb + 2 > qa) { kk.z = 0u; sc[2] = 0.f; } if (kb + 3 > qa) { kk.w = 0u; sc[3] = 0.f; }
                    st1 += (sc[0] + sc[1]) + (sc[2] + sc[3]); fmac_(st2, sc[0], sc[0]); fmac_(st2, sc[1], sc[1]); fmac_(st2, sc[2], sc[2]); fmac_(st2, sc[3], sc[3]); }
                if (c < 8) *(LAS v4u*)(img + c * DSA_ROWF + 16 * t + 4 * g) = kk; }
              __builtin_amdgcn_sched_barrier(0); } } }
          st1 += sx<16>(st1); st2 += sx<16>(st2); st1 = half_sum(st1); st2 = half_sum(st2);
          if (g == 0 && c < 8) *(LAS f32x2*)(F.lds + XTRA_OFF + w * 1536 + 640 + c * 8) = (f32x2){st1, st2}; }
        PT_E(1); PT_B(3);
        __syncthreads();
        PT_E(3); PT_B(4);
        const int pos = q0 + w; unsigned key[64];
#pragma unroll
        for (int j4 = 0; j4 < 4; ++j4) {
            if (1024 * j4 <= pos) {
#pragma unroll
                for (int j = 16 * j4; j < 16 * j4 + 16; ++j) { const int kidx = 64 * j + lane; const unsigned a = img[w * DSA_ROWF + kidx]; key[j] = (kidx <= pos) ? a : 0u; }
            } else {
#pragma unroll
                for (int j = 16 * j4; j < 16 * j4 + 16; ++j) key[j] = 0u;
            } }
        unsigned T; int need; int nsel;
        float rs1 = 0.f, rs2 = 0.f;
#pragma unroll
        for (int ww = 0; ww < 8; ++ww) { const f32x2 t = *(const LAS f32x2*)(F.lds + XTRA_OFF + ww * 1536 + 640 + w * 8); rs1 += t.x; rs2 += t.y; }
        { nsel = dsa_select2(key, pos + 1, rs1, rs2, idxw, lane, pt_acc); (void)T; (void)need; }
        PT_E(4);
#if PROBE_D == 3
        { const size_t m = mb + pos; dsa_attend(Z + m * ZP + Z_DQ, Z + m * ZP + Z_RG, KD + mb * 64, VD + mb * 64, idxw, nsel, F.lds + w * 16384, lane, pt_acc, pt_t0); }
#endif
        { const size_t m = mb + pos; dsa_attend<false>(Z + m * ZP + Z_DQ, Z + m * ZP + out_col, KD + mb * 64, VD + mb * 64, idxw, nsel, F.lds + w * (DSA_ROWF * 4), lane, pt_acc, pt_t0); }
        PT_B(8);
        __syncthreads();
        PT_E(8);
    }
    if (PROBE_T) { const unsigned long long te = __builtin_amdgcn_s_memrealtime() + pt_acc; while (__builtin_amdgcn_s_memrealtime() < te) __builtin_amdgcn_s_sleep(4); }
}

__device__ __forceinline__ void ret_rope_frag(const bf16* row, const f32x2* cs, float scale, int g, s16x8 (&f)[2]) {
    const u32x2 a0 = *(const GAS u32x2*)(row + 4 * g), a1 = *(const GAS u32x2*)(row + 16 + 4 * g), b0 = *(const GAS u32x2*)(row + 32 + 4 * g), b1 = *(const GAS u32x2*)(row + 48 + 4 * g);
    const float x1[8] = {bflo(a0.x), bfhi(a0.x), bflo(a0.y), bfhi(a0.y), bflo(a1.x), bfhi(a1.x), bflo(a1.y), bfhi(a1.y)};
    const float x2[8] = {bflo(b0.x), bfhi(b0.x), bflo(b0.y), bfhi(b0.y), bflo(b1.x), bfhi(b1.x), bflo(b1.y), bfhi(b1.y)};
    float o1[8], o2[8];
#pragma unroll
    for (int j = 0; j < 8; ++j) { const f32x2 t = cs[(j < 4 ? 4 * g + j : 16 + 4 * g + (j - 4))]; o1[j] = (x1[j] * t.x - x2[j] * t.y) * scale; o2[j] = (x2[j] * t.x + x1[j] * t.y) * scale; }
    f[0] = __builtin_bit_cast(s16x8, pack8(o1)); f[1] = __builtin_bit_cast(s16x8, pack8(o2));
}
__device__ __forceinline__ s16x8 ret_bfrag(const LAS unsigned char* img, int row0, int eb, int g, int q, int p) {
    const int r1 = row0 + 4 * g + q;
    const LAS unsigned char* a1 = img + r1 * 256 + ((eb ^ (r1 & 7)) << 5) + 8 * p;
    const LAS unsigned char* a2 = img + (r1 + 16) * 256 + ((eb ^ ((r1 + 16) & 7)) << 5) + 8 * p;
    const s16x4 lo = tr16(a1), hi = tr16(a2);
    return (s16x8){lo[0], lo[1], lo[2], lo[3], hi[0], hi[1], hi[2], hi[3]};
}

__device__ __forceinline__ void ret_state_mfma(const Ctx& F) {
    const bf16* Z = (const bf16*)(F.ws + WS_Z); float* RS = (float*)(F.ws + WS_HDN);
    const f32x2* R64 = (const f32x2*)(F.ws + WS_ROPE64);
    LAS unsigned char* Kimg = F.lds; LAS unsigned char* Vimg = F.lds + 16384;
    const int lane = F.lane, g = lane >> 4, c = lane & 15, q = (lane >> 2) & 3, p = lane & 3;
    for (int u = blockIdx.x; u < NB * 32 * 4; u += F.G) {
        const int h = u & 3, ch = (u >> 2) & 31, b = u >> 7; const float l2g = ret_l2g(h);
        const bf16* base = Z + ((size_t)b * SEQ + ch * 128) * ZP;
        __syncthreads();
        { v4u vv[4]; u32x2 ka[2], kb[2]; f32x2 kc[2][4];
#pragma unroll
          for (int it = 0; it < 4; ++it) { const int t = F.tid + 512 * it, r = t >> 4, c16 = t & 15; vv[it] = *(const GAS v4u*)(base + (size_t)r * ZP + Z_RV + h * 128 + c16 * 8); }
#pragma unroll
          for (int it = 0; it < 2; ++it) { const int t = F.tid + 512 * it, j = t >> 3, dg = t & 7; const bf16* row = base + (size_t)j * ZP + Z_RK + h * 64;
              ka[it] = *(const GAS u32x2*)(row + 4 * dg); kb[it] = *(const GAS u32x2*)(row + 32 + 4 * dg);
              const f32x2* cs = R64 + (ch * 128 + j) * 32 + 4 * dg;
#pragma unroll
              for (int e = 0; e < 4; ++e) kc[it][e] = cs[e]; }
#pragma unroll
          for (int it = 0; it < 4; ++it) { const int t = F.tid + 512 * it, r = t >> 4, c16 = t & 15;
              *(LAS v4u*)(Vimg + r * 256 + (((c16 >> 1) ^ (r & 7)) << 5) + ((c16 & 1) << 4)) = vv[it]; }
#pragma unroll
          for (int it = 0; it < 2; ++it) { const int t = F.tid + 512 * it, j = t >> 3, dg = t & 7; const u32x2 a = ka[it], bb = kb[it];
              const float x1[4] = {bflo(a.x), bfhi(a.x), bflo(a.y), bfhi(a.y)}, x2[4] = {bflo(bb.x), bfhi(bb.x), bflo(bb.y), bfhi(bb.y)};
              const float sc = exp2f((float)(127 - j) * l2g);
              float o1[4], o2[4];
#pragma unroll
              for (int e = 0; e < 4; ++e) { const f32x2 tt = kc[it][e]; o1[e] = (x1[e] * tt.x - x2[e] * tt.y) * sc; o2[e] = (x2[e] * tt.x + x1[e] * tt.y) * sc; }
              u32x2 w1, w2; w1.x = pk2(o1[0], o1[1]); w1.y = pk2(o1[2], o1[3]); w2.x = pk2(o2[0], o2[1]); w2.y = pk2(o2[2], o2[3]);
              const int sw = (j >> 1) & 3; const int d1 = 4 * dg, d2 = 32 + 4 * dg;
              *(LAS u32x2*)(Kimg + j * 128 + ((((2 * d1) >> 5) ^ sw) << 5) + ((2 * d1) & 31)) = w1;
              *(LAS u32x2*)(Kimg + j * 128 + ((((2 * d2) >> 5) ^ sw) << 5) + ((2 * d2) & 31)) = w2; } }
        __syncthreads();
        f32x4 acc[4];
#pragma unroll
        for (int db = 0; db < 4; ++db) acc[db] = (f32x4){0.f, 0.f, 0.f, 0.f};
#pragma unroll
        for (int s = 0; s < 4; ++s) {
            const s16x8 vb = ret_bfrag(Vimg, 32 * s, F.wave, g, q, p);
            const int r1 = 32 * s + 4 * g + q, sw = (r1 >> 1) & 3;
#pragma unroll
            for (int db = 0; db < 4; ++db) { const LAS unsigned char* a1 = Kimg + r1 * 128 + ((db ^ sw) << 5) + 8 * p;
                const s16x4 lo = tr16(a1), hi = tr16(a1 + 2048);
                const s16x8 ka = (s16x8){lo[0], lo[1], lo[2], lo[3], hi[0], hi[1], hi[2], hi[3]};
                acc[db] = __builtin_amdgcn_mfma_f32_16x16x32_bf16(ka, vb, acc[db], 0, 0, 0); }
        }
        float* o = RS + (size_t)u * 8192 + 16 * F.wave + c;
#pragma unroll
        for (int db = 0; db < 4; ++db)
#pragma unroll
            for (int r = 0; r < 4; ++r) o[(16 * db + 4 * g + r) * 128] = acc[db][r];
    }
    __syncthreads();
}

__device__ __forceinline__ void ret_scan(const Ctx& F) {
    const float* RS = (const float*)(F.ws + WS_HDN); float* SC = (float*)(F.ws + WS_HDN + 16 * MiB);
    for (int t = blockIdx.x * 512 + F.tid; t < NB * 4 * 8192; t += F.G * 512) {
        const int el = t & 8191, h = (t >> 13) & 3, b = t >> 15; const float wch = exp2f(128.f * ret_l2g(h)); float s = 0.f;
        float L[32];
#pragma unroll
        for (int ch = 0; ch < 32; ++ch) L[ch] = RS[(size_t)(((b * 32 + ch) * 4 + h)) * 8192 + el];
#pragma unroll
        for (int ch = 0; ch < 32; ++ch) { SC[(size_t)(((b * 32 + ch) * 4 + h)) * 8192 + el] = s; s = wch * s + L[ch]; }
    }
}

__device__ __forceinline__ void ret_out_mfma(const Ctx& F, const float* gn, bool dummy_out = false) {
    bf16* Z = (bf16*)(F.ws + WS_Z); const float* SC = (const float*)(F.ws + WS_HDN + 16 * MiB);
    const f32x2* R64 = (const f32x2*)(F.ws + WS_ROPE64);
    LAS unsigned char* Vimg = F.lds; LAS unsigned char* Simg = F.lds + 32768; LAS unsigned char* Kimg = F.lds + 49152;
    const int lane = F.lane, g = lane >> 4, c = lane & 15, q = (lane >> 2) & 3, p = lane & 3, w = F.wave;
    for (int u = blockIdx.x; u < NB * 32 * 4; u += F.G) {
        const int h = u & 3, ch = (u >> 2) & 31, b = u >> 7; const float l2g = ret_l2g(h); const float gam = exp2f(l2g);
        bf16* base = Z + ((size_t)b * SEQ + ch * 128) * ZP;
        __syncthreads();
        const int i = 16 * w + c; s16x8 qf[2];
        float sc8 = 0.125f; asm volatile("" : "+v"(sc8));
        ret_rope_frag(base + (size_t)i * ZP + Z_RQ + h * 64, R64 + (ch * 128 + i) * 32, sc8 * exp2f((float)i * l2g), g, qf);
        { v4u vv[4]; f32x4 ss[2][2]; u32x2 ka[2], kb[2]; f32x2 kc[2][4];
#pragma unroll
          for (int it = 0; it < 4; ++it) { const int t = F.tid + 512 * it, r = t >> 4, c16 = t & 15; vv[it] = *(const GAS v4u*)(base + (size_t)r * ZP + Z_RV + h * 128 + c16 * 8); }
#pragma unroll
          for (int it = 0; it < 2; ++it) { const int t = F.tid + 512 * it, r = t >> 4, c16 = t & 15; const float* sp = SC + (size_t)u * 8192 + r * 128 + c16 * 8;
              ss[it][0] = *(const GAS f32x4*)sp; ss[it][1] = *(const GAS f32x4*)(sp + 4); }
#pragma unroll
          for (int it = 0; it < 2; ++it) { const int t = F.tid + 512 * it, j = t >> 3, dg = t & 7; const bf16* row = base + (size_t)j * ZP + Z_RK + h * 64;
              ka[it] = *(const GAS u32x2*)(row + 4 * dg); kb[it] = *(const GAS u32x2*)(row + 32 + 4 * dg);
              const f32x2* cs = R64 + (ch * 128 + j) * 32 + 4 * dg;
#pragma unroll
              for (int e = 0; e < 4; ++e) kc[it][e] = cs[e]; }
#pragma unroll
          for (int it = 0; it < 4; ++it) { const int t = F.tid + 512 * it, r = t >> 4, c16 = t & 15;
              *(LAS v4u*)(Vimg + r * 256 + (((c16 >> 1) ^ (r & 7)) << 5) + ((c16 & 1) << 4)) = vv[it]; }
#pragma unroll
          for (int it = 0; it < 2; ++it) { const int t = F.tid + 512 * it, r = t >> 4, c16 = t & 15; const f32x4 s0 = ss[it][0], s1 = ss[it][1];
              v4u wv; wv.x = pk2(s0.x * gam, s0.y * gam); wv.y = pk2(s0.z * gam, s0.w * gam); wv.z = pk2(s1.x * gam, s1.y * gam); wv.w = pk2(s1.z * gam, s1.w * gam);
              *(LAS v4u*)(Simg + r * 256 + (((c16 >> 1) ^ (r & 7)) << 5) + ((c16 & 1) << 4)) = wv; }
#pragma unroll
          for (int it = 0; it < 2; ++it) { const int t = F.tid + 512 * it, j = t >> 3, dg = t & 7; const u32x2 a = ka[it], bb = kb[it];
              const float x1[4] = {bflo(a.x), bfhi(a.x), bflo(a.y), bfhi(a.y)}, x2[4] = {bflo(bb.x), bfhi(bb.x), bflo(bb.y), bfhi(bb.y)};
              const float sc = exp2f(-(float)j * l2g);
              float o1[4], o2[4];
#pragma unroll
              for (int e = 0; e < 4; ++e) { const f32x2 tt = kc[it][e]; o1[e] = (x1[e] * tt.x - x2[e] * tt.y) * sc; o2[e] = (x2[e] * tt.x + x1[e] * tt.y) * sc; }
              u32x2 w1, w2; w1.x = pk2(o1[0], o1[1]); w1.y = pk2(o1[2], o1[3]); w2.x = pk2(o2[0], o2[1]); w2.y = pk2(o2[2], o2[3]);
              const int sw = (j >> 1) & 3; const int d1 = 4 * dg, d2 = 32 + 4 * dg;
              *(LAS u32x2*)(Kimg + j * 128 + ((((2 * d1) >> 5) ^ sw) << 5) + ((2 * d1) & 31)) = w1;
              *(LAS u32x2*)(Kimg + j * 128 + ((((2 * d2) >> 5) ^ sw) << 5) + ((2 * d2) & 31)) = w2; } }
        __syncthreads();
        f32x4 acc[8];
#pragma unroll
        for (int t = 0; t < 8; ++t) { acc[t] = (f32x4){0.f, 0.f, 0.f, 0.f};
            if (t <= w) { const int j = 16 * t + c; const int sw = (j >> 1) & 3; const LAS unsigned char* kr = Kimg + j * 128;
                const u32x2 a0 = *(const LAS u32x2*)(kr + ((((8 * g) >> 5) ^ sw) << 5) + ((8 * g) & 31)), a1 = *(const LAS u32x2*)(kr + ((((32 + 8 * g) >> 5) ^ sw) << 5) + ((32 + 8 * g) & 31));
                const u32x2 b0 = *(const LAS u32x2*)(kr + ((((64 + 8 * g) >> 5) ^ sw) << 5) + ((64 + 8 * g) & 31)), b1 = *(const LAS u32x2*)(kr + ((((96 + 8 * g) >> 5) ^ sw) << 5) + ((96 + 8 * g) & 31));
                const s16x8 kf0 = __builtin_bit_cast(s16x8, (v4u){a0.x, a0.y, a1.x, a1.y}), kf1 = __builtin_bit_cast(s16x8, (v4u){b0.x, b0.y, b1.x, b1.y});
                acc[t] = __builtin_amdgcn_mfma_f32_16x16x32_bf16(kf0, qf[0], acc[t], 0, 0, 0); acc[t] = __builtin_amdgcn_mfma_f32_16x16x32_bf16(kf1, qf[1], acc[t], 0, 0, 0);
                if (t == w) {
#pragma unroll
                    for (int r = 0; r < 4; ++r) if (4 * g + r > c) acc[t][r] = 0.f; } } }
        s16x8 pf[4];
#pragma unroll
        for (int s = 0; s < 4; ++s) { v4u wv; wv.x = pk2(acc[2 * s][0], acc[2 * s][1]); wv.y = pk2(acc[2 * s][2], acc[2 * s][3]); wv.z = pk2(acc[2 * s + 1][0], acc[2 * s + 1][1]); wv.w = pk2(acc[2 * s + 1][2], acc[2 * s + 1][3]);
            pf[s] = __builtin_bit_cast(s16x8, wv); }
        f32x4 o[8];
#pragma unroll
        for (int eb = 0; eb < 8; ++eb) o[eb] = (f32x4){0.f, 0.f, 0.f, 0.f};
#pragma unroll
        for (int s = 0; s < 4; ++s) if (2 * s <= w) {
#pragma unroll
            for (int eb = 0; eb < 8; ++eb) o[eb] = __builtin_amdgcn_mfma_f32_16x16x32_bf16(pf[s], ret_bfrag(Vimg, 32 * s, eb, g, q, p), o[eb], 0, 0, 0); }
#pragma unroll
        for (int ks = 0; ks < 2; ++ks)
#pragma unroll
            for (int eb = 0; eb < 8; ++eb) o[eb] = __builtin_amdgcn_mfma_f32_16x16x32_bf16(qf[ks], ret_bfrag(Simg, 32 * ks, eb, g, q, p), o[eb], 0, 0, 0);
        float rs[4];
#pragma unroll
        for (int r = 0; r < 4; ++r) { float ss = 0.f;
#pragma unroll
            for (int eb = 0; eb < 8; ++eb) ss += o[eb][r] * o[eb][r];
            ss += sx<1>(ss); ss += sx<2>(ss); ss += sx<4>(ss); ss += sx<8>(ss);
            rs[r] = 1.0f / sqrtf(ss * (1.f / 128) + NORM_EPS); }
#pragma unroll
        for (int r = 0; r < 4; ++r) { bf16* zr = base + (size_t)(16 * w + 4 * g + r) * ZP; bf16* zw = dummy_out ? (bf16*)(F.ws + WS_ZS) + ((size_t)b * SEQ + ch * 128 + 16 * w + 4 * g + r) * 1024 - Z_RV : zr;
#pragma unroll
            for (int eb = 0; eb < 8; ++eb) { const int e = 16 * eb + c; const float rg = bf2f(zr[Z_RG + h * 128 + e]);
                zw[Z_RV + h * 128 + e] = (bf16)f2bf(o[eb][r] * rs[r] * gn[h * 128 + e] * rg * sigmoid_f(rg)); } }
    }
    __syncthreads();
}

__device__ __forceinline__ void fscan_phase(const Ctx& F) {
    const float* LF = (const float*)(F.ws + WS_LF); float* CF = (float*)(F.ws + WS_CF);
    LAS float* wsum = (LAS float*)(F.lds);
    const int seq = (int)blockIdx.x;
    if (seq < 32) {
        const int b = seq >> 3, h = seq & 7; const int p0 = F.tid * 8; const float* lp = LF + ((size_t)b * SEQ + p0) * 8 + h;
        float v[8]; float s = 0.f;
#pragma unroll
        for (int i = 0; i < 8; ++i) { v[i] = lp[i * 8]; }
#pragma unroll
        for (int i = 0; i < 8; ++i) { s += v[i]; v[i] = s; }
        float incl = s;
#pragma unroll
        for (int o = 1; o < 64; o <<= 1) { const float t = __builtin_bit_cast(float, __builtin_amdgcn_ds_bpermute(((F.lane - o) & 63) << 2, __builtin_bit_cast(int, incl))); if (F.lane >= o) incl += t; }
        if (F.lane == 63) wsum[F.wave] = incl;
        __syncthreads();
        float woff = 0.f;
#pragma unroll
        for (int ww = 0; ww < 8; ++ww) { const float t = wsum[ww]; if (ww < F.wave) woff += t; }
        const float base = woff + (incl - s);
        float* cp = CF + (size_t)seq * SEQ + p0;
        *(GAS f32x4*)cp = (f32x4){base + v[0], base + v[1], base + v[2], base + v[3]}; *(GAS f32x4*)(cp + 4) = (f32x4){base + v[4], base + v[5], base + v[6], base + v[7]};
    }
    __syncthreads();
}
#include <hip/hip_bf16.h>
#include <cmath>
namespace attn_body {
using bf16=__hip_bfloat16;
using bf16x8=__attribute__((ext_vector_type(8)))short;
using s16x4=__attribute__((ext_vector_type(4)))short;
using f32x16=__attribute__((ext_vector_type(16)))float;
using u32x4=__attribute__((ext_vector_type(4)))unsigned;
constexpr int BATCH=4,NHEAD=8,SEQ=4096,D=64,DM=6656;
constexpr int NW=8,QBLK=32,QB=QBLK*NW,KVBLK=64,NQB=SEQ/QB;
constexpr int ATTN_PITCH=DM, ATTN_UNIT_ROWS=QB;
__device__ __forceinline__ int crow(int r,int hi){return (r&3)+8*(r>>2)+4*hi;}
#define SBAR() __builtin_amdgcn_sched_barrier(0)
__device__ __forceinline__ void cmask(f32x16&p0,f32x16&p1,int jb,int qrel,int hi){
  const float NEG=-INFINITY; int kb=64*jb+4*hi;
  #pragma unroll
  for(int r=0;r<16;++r){int kv=kb+(r&3)+8*(r>>2); if(kv>qrel)p0[r]=NEG; if(kv+32>qrel)p1[r]=NEG;}
}

constexpr int NSLOT=3, SLOTB=8192;
constexpr int LDS_K=0, LDS_V=NSLOT*SLOTB, LDS_WS=2*NSLOT*SLOTB, LDS_OST=LDS_WS+NW*64*4, LDS_NC=LDS_OST+NW*4096, LDS_BYTES=LDS_NC+SEQ*4;
constexpr float C2=0.125f*1.4426950408889634f;
__device__ __forceinline__ void glds16(const void*gsrc,unsigned lds_dst){unsigned keep;
  asm volatile("s_mov_b32 %0, m0\n\ts_mov_b32 m0, %2\n\ts_nop 0\n\tglobal_load_lds_dwordx4 %1, off\n\ts_mov_b32 m0, %0":"=&s"(keep):"v"(gsrc),"s"(lds_dst):"memory");}
__device__ __forceinline__ float max3f(float a,float b,float c){float r;asm("v_max3_f32 %0, %1, %2, %3":"=v"(r):"v"(a),"v"(b),"v"(c));return r;}
__device__ __forceinline__ float max2f(float a,float b){float r;asm("v_max_f32_e32 %0, %1, %2":"=v"(r):"v"(a),"v"(b));return r;}
__device__ __forceinline__ float fadd_s(float a,float b){float r;asm("v_add_f32_e32 %0, %1, %2":"=v"(r):"v"(a),"v"(b));return r;}
__device__ __forceinline__ float fsub_s(float a,float b){float r;asm("v_sub_f32_e32 %0, %1, %2":"=v"(r):"v"(a),"v"(b));return r;}
typedef float f32x4_t __attribute__((ext_vector_type(4))); typedef float f32x2_t __attribute__((ext_vector_type(2))); typedef __bf16 bf16x2_t __attribute__((ext_vector_type(2)));
__device__ __forceinline__ unsigned cvtpk_s(float lo,float hi){f32x2_t v={lo,hi};bf16x2_t b=__builtin_convertvector(v,bf16x2_t);return __builtin_bit_cast(unsigned,b);}
#define WAIT_BAR(N) asm volatile("s_waitcnt vmcnt(" #N ") lgkmcnt(0)\n\ts_barrier":::"memory")

__device__ __forceinline__ void qkt(f32x16&p0,f32x16&p1,const char*Kslot,const bf16x8*qr,const f32x16&negm,int r32,int hi){
  const char*kb=Kslot+hi*1024+r32*16;
  #pragma unroll
  for(int d0=0;d0<4;++d0){
    const bf16x8 b0=*reinterpret_cast<const bf16x8*>(kb+d0*2048);
    const bf16x8 b1=*reinterpret_cast<const bf16x8*>(kb+d0*2048+512);
    if(d0==0){p0=__builtin_amdgcn_mfma_f32_32x32x16_bf16(b0,qr[0],negm,0,0,0);p1=__builtin_amdgcn_mfma_f32_32x32x16_bf16(b1,qr[0],negm,0,0,0);}
    else{p0=__builtin_amdgcn_mfma_f32_32x32x16_bf16(b0,qr[d0],p0,0,0,0);p1=__builtin_amdgcn_mfma_f32_32x32x16_bf16(b1,qr[d0],p1,0,0,0);}}
}
typedef __attribute__((address_space(3))) const char* lds_cptr;
typedef short v4i16_t __attribute__((ext_vector_type(4)));
__device__ __forceinline__ void kload8(bf16x8*kf,lds_cptr kp){
  kf[0]=*(const __attribute__((address_space(3))) bf16x8*)(kp);      kf[1]=*(const __attribute__((address_space(3))) bf16x8*)(kp+512);
  kf[2]=*(const __attribute__((address_space(3))) bf16x8*)(kp+2048); kf[3]=*(const __attribute__((address_space(3))) bf16x8*)(kp+2560);
  kf[4]=*(const __attribute__((address_space(3))) bf16x8*)(kp+4096); kf[5]=*(const __attribute__((address_space(3))) bf16x8*)(kp+4608);
  kf[6]=*(const __attribute__((address_space(3))) bf16x8*)(kp+6144); kf[7]=*(const __attribute__((address_space(3))) bf16x8*)(kp+6656);
}
__device__ __forceinline__ void kload2(bf16x8*kf,lds_cptr kp,int j){ kf[2*j]=*(const __attribute__((address_space(3))) bf16x8*)(kp+j*2048); kf[2*j+1]=*(const __attribute__((address_space(3))) bf16x8*)(kp+j*2048+512); }
__device__ __forceinline__ s16x4 vtr(lds_cptr p){ return __builtin_bit_cast(s16x4,__builtin_amdgcn_ds_read_tr16_b64_v4i16((__attribute__((address_space(3))) v4i16_t*)p)); }
__device__ __forceinline__ float rowmax(const f32x16&p0,const f32x16&p1){
  float a=max3f(p0[0],p0[1],p1[0]),b=max3f(p0[2],p0[3],p1[1]);a=max3f(a,p1[2],p1[3]);
  #pragma unroll
  for(int r=4;r<16;r+=4){a=max3f(a,p0[r],p0[r+1]);b=max3f(b,p0[r+2],p0[r+3]);a=max3f(a,p1[r],p1[r+1]);b=max3f(b,p1[r+2],p1[r+3]);}
  const float m=max2f(a,b);
  auto rr=__builtin_amdgcn_permlane32_swap(__float_as_uint(m),__float_as_uint(m),false,false);
  return max2f(__uint_as_float(rr[0]),__uint_as_float(rr[1]));
}
__device__ __forceinline__ void pv(f32x16*o,int vb,bf16x8 pa0,bf16x8 pa1,bf16x8 pa2,bf16x8 pa3){
  #pragma unroll
  for(int d0=0;d0<2;++d0){s16x4 lo[4],hi[4];
    #pragma unroll
    for(int ks=0;ks<4;++ks){
      asm volatile("ds_read_b64_tr_b16 %0,%1 offset:%c2":"=&v"(lo[ks]):"v"(vb),"i"(d0*4096+ks*1024):"memory");
      asm volatile("ds_read_b64_tr_b16 %0,%1 offset:%c2":"=&v"(hi[ks]):"v"(vb),"i"(d0*4096+ks*1024+512):"memory");}
    asm volatile("s_waitcnt lgkmcnt(0)":::"memory");SBAR();
    #define PK(k) (bf16x8){lo[k][0],lo[k][1],lo[k][2],lo[k][3],hi[k][0],hi[k][1],hi[k][2],hi[k][3]}
    o[d0]=__builtin_amdgcn_mfma_f32_32x32x16_bf16(pa0,PK(0),o[d0],0,0,0);
    o[d0]=__builtin_amdgcn_mfma_f32_32x32x16_bf16(pa1,PK(1),o[d0],0,0,0);
    o[d0]=__builtin_amdgcn_mfma_f32_32x32x16_bf16(pa2,PK(2),o[d0],0,0,0);
    o[d0]=__builtin_amdgcn_mfma_f32_32x32x16_bf16(pa3,PK(3),o[d0],0,0,0);
    #undef PK
  }
}

#ifndef ATTN_STORE16
#define ATTN_STORE16(p,v) (*(u32x4*)(p)=(v))
#endif
template<int THRL> __device__ __forceinline__ void attn_unit(int b,int h,int qb,const bf16*Q,const bf16*__restrict__ K,const bf16*__restrict__ V,bf16*O,const float*CF,float dskip,char*shm,int wave_id){
  int tid_=(wave_id<<6)|lane_id_v(); asm volatile("":"+v"(tid_));
  const int tid=tid_,lane=tid&63,r32=lane&31,hi=lane>>5; const int wid=__builtin_amdgcn_readfirstlane(tid>>6);
  const long rowbase=(long)b*SEQ; const int q0=qb*QB;
  const bf16*Qw=Q+(rowbase+q0+wid*QBLK)*DM+h*D;
  const float*cfp0=CF+(long)(b*NHEAD+h)*SEQ; const int NT0=(q0+QB)/KVBLK;
  int ts; { const float cq=cfp0[q0]; const int il=(lane<NT0)?64*lane+63:q0; const bool keep=(lane<NT0)&&(cfp0[il]<cq+dskip);
    const unsigned long long km=__ballot(keep); int t0=(int)__builtin_ctzll(km|(1ull<<63)); t0&=~1; ts=__builtin_amdgcn_readfirstlane(t0<NT0-4?t0:NT0-4); }
  const bf16*Kh=K+(rowbase+(long)ts*KVBLK)*DM+h*D,*Vh=V+(rowbase+(long)ts*KVBLK)*DM+h*D;
  const unsigned lds0=(unsigned)(uintptr_t)shm;
  float*wsf=(float*)(shm+LDS_WS)+wid*64;
  const bf16*ksrc=Kh+(long)lane*DM+wid*8;
  const bf16*vsrc=Vh+(long)(16*(wid&3)+(lane>>2))*DM+(wid>>2)*32+(lane&3)*8;
  const unsigned kdst=lds0+LDS_K+wid*1024, vdst=lds0+LDS_V+wid*1024;
  #define DMA_K(t,slot) glds16(ksrc+(long)(t)*KVBLK*DM,(unsigned)__builtin_amdgcn_readfirstlane(kdst+(slot)))
  #define DMA_V(t,slot) glds16(vsrc+(long)(t)*KVBLK*DM,(unsigned)__builtin_amdgcn_readfirstlane(vdst+(slot)))
  const char*Kbase=shm+LDS_K; bf16x8 kf[8];
  const lds_cptr shm3=(lds_cptr)shm; const lds_cptr kp0=shm3+LDS_K+hi*1024+r32*16; const lds_cptr vp0=shm3+LDS_V+((lane>>4)&1)*32+(lane&3)*8+(4*hi+((lane&15)>>2))*64;
  const int NT=NT0-ts;
  { const float*cfp=CF+(long)(b*NHEAD+h)*SEQ; float*ncw=(float*)(shm+LDS_NC);
    for(int i=tid+ts*KVBLK;i<q0+QB;i+=NW*64)ncw[i-ts*KVBLK]=-cfp[i]; }
  const lds_cptr ncp=(lds_cptr)shm+LDS_NC+hi*16;
  #define ADDC(P0,P1,t) do{ const lds_cptr np_=ncp+(t)*256; _Pragma("unroll") for(int g_=0;g_<4;++g_){ \
      const f32x4_t a_=*(const __attribute__((address_space(3))) f32x4_t*)(np_+g_*32), b_=*(const __attribute__((address_space(3))) f32x4_t*)(np_+g_*32+128); \
      P0[4*g_]+=a_[0];P0[4*g_+1]+=a_[1];P0[4*g_+2]+=a_[2];P0[4*g_+3]+=a_[3]; P1[4*g_]+=b_[0];P1[4*g_+1]+=b_[1];P1[4*g_+2]+=b_[2];P1[4*g_+3]+=b_[3]; } }while(0)
  DMA_K(0,0);DMA_V(0,0);DMA_K(1,SLOTB);
  bf16x8 qr[4];
  #pragma unroll
  for(int d0=0;d0<4;++d0)qr[d0]=*reinterpret_cast<const bf16x8*>(&Qw[(long)r32*DM+d0*16+hi*8]);
  float mhat=0.f,l_reg=0.f;f32x16 o[2];f32x16 negm; { float zz_; asm volatile("v_mov_b32 %0, 0":"=v"(zz_));
    _Pragma("unroll") for(int r=0;r<16;++r){o[0][r]=zz_;o[1][r]=zz_;negm[r]=zz_;} } asm volatile("":"+v"(negm));
  const int qrel=wid*QBLK+r32;
  #define CMASK(P0,P1,t) do{int jb_=(t)-(NT-4); if(jb_>=0)cmask(P0,P1,jb_,qrel,hi);}while(0)
  bool resc=false;
  #define START(P0,P1) do{ const float rm=rowmax(P0,P1); resc=false; \
    { const float dl=rm; mhat=fadd_s(mhat,dl); \
      _Pragma("unroll") for(int r=0;r<16;++r){P0[r]=fsub_s(P0[r],dl);P1[r]=fsub_s(P1[r],dl);} \
      _Pragma("unroll") for(int r=0;r<16;++r)negm[r]=-mhat; asm volatile("":"+v"(negm)); } \
    _Pragma("unroll") for(int r=0;r<16;++r)P0[r]=__builtin_amdgcn_exp2f(P0[r]); }while(0)
  #define RESC() do{ if(resc){ asm volatile("s_waitcnt lgkmcnt(0)":::"memory"); \
      _Pragma("unroll") for(int d_=0;d_<2;++d_) _Pragma("unroll") for(int r=0;r<16;++r)o[d_][r]*=wsf[crow(r,hi)]; } }while(0)
  f32x16 pA0,pA1,pB0,pB1;
  int sl_prev=0,sl_cur=0,sl_next=SLOTB;
  #define ROT() do{sl_prev=sl_cur;sl_cur=sl_next;sl_next=(sl_next==(NSLOT-1)*SLOTB)?0:sl_next+SLOTB;}while(0)
  DMA_K(2,2*SLOTB);
  WAIT_BAR(3);
  qkt(pA0,pA1,Kbase,qr,negm,r32,hi);asm volatile("s_nop 15\n\ts_nop 7":"+v"(pA0),"+v"(pA1));ADDC(pA0,pA1,0);CMASK(pA0,pA1,0);
  START(pA0,pA1);
  _Pragma("unroll") for(int r=0;r<16;++r)pA1[r]=__builtin_amdgcn_exp2f(pA1[r]);
  WAIT_BAR(0);
  DMA_K(3,0);DMA_V(1,SLOTB);
  ROT();
  kload8(kf,kp0+sl_cur);
  WAIT_BAR(2);
  s16x4 vlo[8],vhi[8]; u32x4 pw0,pw1,pw2,pw3;
  #define PKW(P,B) cvtpk_s(P[B],P[B+1])
  #define PAF(k) __builtin_bit_cast(bf16x8,pw##k)
  #define VFR(i) (bf16x8){vlo[i][0],vlo[i][1],vlo[i][2],vlo[i][3],vhi[i][0],vhi[i][1],vhi[i][2],vhi[i][3]}
  #define PIN(x) asm volatile("":"+v"(x))
  #define MX3(a,b,c) __builtin_fmaxf(__builtin_fmaxf((a),(b)),(c))
  #define GAPA(MF,A0,A1,A2,A3,W0,W1,PW) do{ MF; sacc+=A0; sacc+=A1; sacc+=A2; sacc+=A3; PIN(sacc); W0; W1; PIN(PW); SBAR(); }while(0)
  #define EX(v) __builtin_amdgcn_exp2f(v)
  #define GAPB(MF,X,B) do{ MF; X[B]=EX(X[B]); X[B+1]=EX(X[B+1]); X[B+2]=EX(X[B+2]); X[B+3]=EX(X[B+3]); PIN(X); SBAR(); }while(0)
  #define VRD(i) do{ vlo[i]=vtr(vp_+(((i)>>2)*4096+((i)&3)*1024)); vhi[i]=vtr(vp_+(((i)>>2)*4096+((i)&3)*1024+512)); }while(0)
  #define KRD(G,j) do{ if(G){ kload2(kf,kp0+sl_next,j); SBAR(); } }while(0)
  #define STEP(C0,C1,P0,P1,t,GK,GV,GL) do{ SBAR(); \
    const lds_cptr vp_=vp0+sl_prev; \
    VRD(0); SBAR(); float sacc=(P0[0]+P0[1]); \
    GAPA(C0=__builtin_amdgcn_mfma_f32_32x32x16_bf16(kf[0],qr[0],negm,0,0,0), P0[2],P0[3],P0[4],P0[5],     pw0[0]=PKW(P0,0), pw0[1]=PKW(P0,2), pw0); \
    VRD(4); SBAR(); GAPA(C1=__builtin_amdgcn_mfma_f32_32x32x16_bf16(kf[1],qr[0],negm,0,0,0), P0[6],P0[7],P0[8],P0[9],     pw0[2]=PKW(P0,4), pw0[3]=PKW(P0,6), pw0); \
    VRD(1); SBAR(); GAPA(C0=__builtin_amdgcn_mfma_f32_32x32x16_bf16(kf[2],qr[1],C0,0,0,0),   P0[10],P0[11],P0[12],P0[13], pw1[0]=PKW(P0,8), pw1[1]=PKW(P0,10), pw1); \
    VRD(5); SBAR(); GAPA(C1=__builtin_amdgcn_mfma_f32_32x32x16_bf16(kf[3],qr[1],C1,0,0,0),   P0[14],P0[15],P1[0],P1[1],   pw1[2]=PKW(P0,12),pw1[3]=PKW(P0,14), pw1); \
    VRD(2); SBAR(); GAPA(C0=__builtin_amdgcn_mfma_f32_32x32x16_bf16(kf[4],qr[2],C0,0,0,0),   P1[2],P1[3],P1[4],P1[5],     pw2[0]=PKW(P1,0), pw2[1]=PKW(P1,2), pw2); \
    VRD(6); SBAR(); GAPA(C1=__builtin_amdgcn_mfma_f32_32x32x16_bf16(kf[5],qr[2],C1,0,0,0),   P1[6],P1[7],P1[8],P1[9],     pw2[2]=PKW(P1,4), pw2[3]=PKW(P1,6), pw2); \
    VRD(3); SBAR(); GAPA(C0=__builtin_amdgcn_mfma_f32_32x32x16_bf16(kf[6],qr[3],C0,0,0,0),   P1[10],P1[11],P1[12],P1[13], pw3[0]=PKW(P1,8), pw3[1]=PKW(P1,10), pw3); \
    VRD(7); SBAR(); GAPA(C1=__builtin_amdgcn_mfma_f32_32x32x16_bf16(kf[7],qr[3],C1,0,0,0),   P1[14],P1[15],0.f,0.f,       pw3[2]=PKW(P1,12),pw3[3]=PKW(P1,14), pw3); \
    l_reg+=sacc; \
    if(GK){DMA_K((t)+3,sl_cur);} if(GV){DMA_V((t)+1,sl_next);} \
    ADDC(C0,C1,t); CMASK(C0,C1,t); \
    { float a=MX3(C0[0],C0[1],C1[0]),b=MX3(C0[2],C0[3],C1[1]); a=MX3(a,C1[2],C1[3]); \
      _Pragma("unroll") for(int r=4;r<16;r+=4){a=MX3(a,C0[r],C0[r+1]);b=MX3(b,C0[r+2],C0[r+3]);a=MX3(a,C1[r],C1[r+1]);b=MX3(b,C1[r+2],C1[r+3]);} \
      float rm=__builtin_fmaxf(a,b); { auto rr=__builtin_amdgcn_permlane32_swap(__float_as_uint(rm),__float_as_uint(rm),false,false); rm=__builtin_fmaxf(__uint_as_float(rr[0]),__uint_as_float(rr[1])); } \
      resc=false; \
      if(__builtin_expect(__any(rm>(float)THRL),0)){ const float dl=__builtin_fmaxf(rm,0.f); mhat+=dl; \
        _Pragma("unroll") for(int r=0;r<16;++r){C0[r]-=dl;C1[r]-=dl;} \
        _Pragma("unroll") for(int r=0;r<16;++r)negm[r]=-mhat; asm volatile("":"+v"(negm)); \
        const float f=__builtin_amdgcn_exp2f(-dl); l_reg*=f; if(hi==0)wsf[r32]=f; resc=true; } } \
    SBAR(); \
    GAPB(o[0]=__builtin_amdgcn_mfma_f32_32x32x16_bf16(PAF(0),VFR(0),o[0],0,0,0), C0,0); \
    GAPB(o[1]=__builtin_amdgcn_mfma_f32_32x32x16_bf16(PAF(0),VFR(4),o[1],0,0,0), C0,4); \
    KRD(GL,0); GAPB(o[0]=__builtin_amdgcn_mfma_f32_32x32x16_bf16(PAF(1),VFR(1),o[0],0,0,0), C0,8); \
    KRD(GL,1); GAPB(o[1]=__builtin_amdgcn_mfma_f32_32x32x16_bf16(PAF(1),VFR(5),o[1],0,0,0), C0,12); \
    KRD(GL,2); GAPB(o[0]=__builtin_amdgcn_mfma_f32_32x32x16_bf16(PAF(2),VFR(2),o[0],0,0,0), C1,0); \
    KRD(GL,3); GAPB(o[1]=__builtin_amdgcn_mfma_f32_32x32x16_bf16(PAF(2),VFR(6),o[1],0,0,0), C1,4); \
    GAPB(o[0]=__builtin_amdgcn_mfma_f32_32x32x16_bf16(PAF(3),VFR(3),o[0],0,0,0), C1,8); \
    GAPB(o[1]=__builtin_amdgcn_mfma_f32_32x32x16_bf16(PAF(3),VFR(7),o[1],0,0,0), C1,12); \
    }while(0)
  int t=1;
  #undef CMASK
  #define CMASK(P0,P1,t) do{}while(0)
  for(;t+5<NT;t+=2){
    STEP(pB0,pB1,pA0,pA1,t,true,true,true);     WAIT_BAR(2); RESC(); ROT();
    STEP(pA0,pA1,pB0,pB1,t+1,true,true,true);   WAIT_BAR(2); RESC(); ROT();
  }
  #undef CMASK
  #define CMASK(P0,P1,t) do{int jb_=(t)-(NT-4); if(jb_>=0)cmask(P0,P1,jb_,qrel,hi);}while(0)
  #define ENDW(tt) do{ if((tt)+3<NT){WAIT_BAR(2);} else if((tt)+2<NT){WAIT_BAR(1);} else {WAIT_BAR(0);} }while(0)
  for(;t+1<NT;t+=2){
    STEP(pB0,pB1,pA0,pA1,t,(t+3<NT),(t+1<NT),(t+1<NT));       ENDW(t);   RESC(); ROT();
    STEP(pA0,pA1,pB0,pB1,t+1,(t+4<NT),(t+2<NT),(t+2<NT));     ENDW(t+1); RESC(); ROT();
  }
  STEP(pB0,pB1,pA0,pA1,NT-1,false,false,false); RESC();
  { float sacc=pB0[0]+pB0[1]; _Pragma("unroll") for(int r=2;r<16;++r)sacc+=pB0[r]; _Pragma("unroll") for(int r=0;r<16;++r)sacc+=pB1[r]; l_reg+=sacc;
    pw0=(u32x4){PKW(pB0,0),PKW(pB0,2),PKW(pB0,4),PKW(pB0,6)};pw1=(u32x4){PKW(pB0,8),PKW(pB0,10),PKW(pB0,12),PKW(pB0,14)};pw2=(u32x4){PKW(pB1,0),PKW(pB1,2),PKW(pB1,4),PKW(pB1,6)};pw3=(u32x4){PKW(pB1,8),PKW(pB1,10),PKW(pB1,12),PKW(pB1,14)};
    int tl_=lane_id_v(); asm volatile("":"+v"(tl_)); const int ln_=tl_&63,hi_=ln_>>5; const int vb0e=(int)(lds0+LDS_V)+((ln_>>4)&1)*32+(ln_&3)*8+(4*hi_+((ln_&15)>>2))*64;
    SBAR(); pv(o,vb0e+sl_cur,PAF(0),PAF(1),PAF(2),PAF(3)); }
  #undef PKW
  #undef PAF
  #undef VFR
  #undef PIN
  #undef MX3
  #undef GAPA
  #undef GAPB
  #undef EX
  #undef VRD
  #undef KRD
  #undef STEP
  #undef ENDW
  {auto rr=__builtin_amdgcn_permlane32_swap(__float_as_uint(l_reg),__float_as_uint(l_reg),false,false);l_reg=__uint_as_float(rr[0])+__uint_as_float(rr[1]);}
  int te_=lane_id_v(); asm volatile("":"+v"(te_)); const int lane_e=te_&63,r32_e=lane_e&31,hi_e=lane_e>>5;
  if(hi_e==0)wsf[32+r32_e]=l_reg;asm volatile("s_waitcnt lgkmcnt(0)":::"memory");
  float rli[16];
  #pragma unroll
  for(int r=0;r<16;++r)rli[r]=__builtin_amdgcn_rcpf(wsf[32+crow(r,hi_e)]);
  bf16*Ow=O+(rowbase+q0+wid*QBLK)*DM+h*D;
  { bf16*stg=(bf16*)(shm+LDS_OST)+wid*2048;
    #pragma unroll
    for(int r=0;r<16;++r){const int orow=crow(r,hi_e);
      #pragma unroll
      for(int d0=0;d0<2;++d0)stg[orow*64+d0*32+r32_e]=__float2bfloat16(o[d0][r]*rli[r]);}
    asm volatile("s_waitcnt lgkmcnt(0)":::"memory");
    #pragma unroll
    for(int i=0;i<4;++i){const int row=i*8+(lane_e>>3),ch=lane_e&7; const u32x4 v=*(const u32x4*)(stg+row*64+ch*8); ATTN_STORE16(Ow+(long)row*DM+ch*8,v);} }
  asm volatile("s_waitcnt lgkmcnt(0)\n\ts_barrier":::"memory");
  #undef ADDC
  #undef DMA_K
  #undef DMA_V
  #undef CMASK
  #undef START
  #undef RESC
  #undef ROT
}
constexpr int ATTN_LDS_BYTES=LDS_BYTES;
struct AttnTensors { const bf16* Q; const bf16* K; const bf16* V; bf16* O; const float* CF; float dskip; };
struct AttnUnit { int bh; int qb; };
struct StaticOrder {
  int vcu;
  __device__ __forceinline__ explicit StaticOrder(int grid,int block):vcu((block%8)*(grid/8)+block/8){}
  __device__ __forceinline__ bool next(int i,AttnUnit&u)const{ if(i>=2)return false; const int s=vcu&7; u.bh=vcu>>3; u.qb=(i==0)?s:15-s; return true; }
  __device__ __forceinline__ void a_ready(const AttnUnit&)const{}
  __device__ __forceinline__ void done(const AttnUnit&)const{}
};
template<class Sched,int THRL=8> __device__ __forceinline__ void attn_phase(char*lds,const AttnTensors&T,const Sched&S,int wave_id){
  AttnUnit u;
  for(int i=0;S.next(i,u);++i){ S.a_ready(u); attn_unit<THRL>(u.bh/NHEAD,u.bh%NHEAD,u.qb,T.Q,T.K,T.V,T.O,T.CF,T.dskip,lds,wave_id); S.done(u); }
}
#undef SBAR
#undef WAIT_BAR
}

struct Args { const float* in[16]; float* out; unsigned char* ws; };
__global__ void __launch_bounds__(NWAVES * 64, 2) hyb_fwd(Args args) {
    extern __shared__ __attribute__((aligned(16))) unsigned char lds[];
    Ctx F;
    F.lds = (LAS unsigned char*)lds;
    F.tid = threadIdx.x; F.lane = F.tid & 63; F.wave = __builtin_amdgcn_readfirstlane(F.tid >> 6);
    F.G = gridDim.x; F.gw = blockIdx.x * NWAVES + F.wave; F.NGW = F.G * NWAVES;
    F.out = args.out; F.ws = args.ws;
    volatile LAS unsigned* MISC = (volatile LAS unsigned*)(F.lds + MISC_OFF);
    for (int u = F.tid; u < (LDS_BYTES - LDSCTL_OFF) / 4; u += NWAVES * 64) ((LAS unsigned*)(F.lds + LDSCTL_OFF))[u] = 0u;
    __syncthreads();
    gu32* ctl = (gu32*)(F.ws + WS_CTL);
    XcdBarrier bar = xcd_barrier_post((unsigned*)(ctl + CW_BAR), MISC + 8); bar.w = F.wave;
#define FRESH(P) Ctx P = F; P.tid = (F.wave << 6) | lane_id_v(); asm volatile("" : "+v"(P.tid), "+s"(P.wave), "+s"(P.gw), "+s"(P.ws), "+s"(P.out)); P.lane = P.tid & 63
#define GRID_BAR() do { XcdBarrier b_ = bar; asm volatile("" : "+s"(b_.bar), "+s"(b_.x)); xcd_barrier(b_); } while (0)

#ifndef PROBE_P
#define PROBE_P 0
#endif
    unsigned long long ph_acc = 0, ph_t0 = 0;
#define PH_B(k) do { if (PROBE_P == (k)) { asm volatile("" ::: "memory"); ph_t0 = __builtin_amdgcn_s_memrealtime(); } } while (0)
#define PH_E(k) do { if (PROBE_P == (k)) { asm volatile("s_waitcnt vmcnt(0) lgkmcnt(0)" ::: "memory"); ph_acc = __builtin_amdgcn_s_memrealtime() - ph_t0; const unsigned long long te_ = __builtin_amdgcn_s_memrealtime() + ph_acc; while (__builtin_amdgcn_s_memrealtime() < te_) __builtin_amdgcn_s_sleep(4); } } while (0)
    bf16* Wb = (bf16*)(F.ws + WS_W);
    bf16* Z = (bf16*)(F.ws + WS_Z); float* ZS = (float*)(F.ws + WS_ZS); bf16* HDN = (bf16*)(F.ws + WS_HDN);
    float* M32 = (float*)(F.ws + WS_HDN); bf16* HB = (bf16*)(F.ws + WS_Z);
    LAS unsigned char* ring = F.lds + RING_OFF; float* SSp = (float*)(F.ws + WS_SS); bf16* XA = (bf16*)F.out;

    { FRESH(P); p0_prologue(P, args.in[2], args.in[9], args.in[10], args.in[11], args.in[12], args.in[14], args.in[15], args.in[1], args.in[13]); }
    { FRESH(P); norm0_phase(P, args.in[0], (bf16*)P.out, (float*)(P.ws + WS_SS)); }
    GRID_BAR();
    if (F.wave == 0 && lane_id_v() == 0) { unsigned ok = (F.G == 256) ? 1u : 0u;
        for (unsigned j = 0; j < 16; ++j) { const unsigned c = xb_ld((unsigned*)(ctl + CW_BAR) + XB_XCNT(j)); if (c != (j < 8 ? 32u : 0u)) ok = 0u; }
        MISC[11] = ok; }
    __syncthreads();
    const int seam_loc = __builtin_amdgcn_readfirstlane((int)MISC[11]);
    const int cidx_ = __builtin_amdgcn_readfirstlane(seam_loc ? (int)(8u * MISC[10] + bar.x) : (int)blockIdx.x);
#define CIDX() cidx_
#define SEAM_BAR() do { XcdBarrier b_ = bar; asm volatile("" : "+s"(b_.bar), "+s"(b_.x)); if (seam_loc) xcd_local_barrier(b_); else xcd_barrier(b_); } while (0)

    #pragma unroll 1
    for (int layer = 0; layer < DEPTH; ++layer) {
        const bf16* L = Wb + (size_t)layer * LW_STRIDE;
        { pg8::Gemm g{XA, L + LW_IN, M, NIN, DM, DM, DM, 256 * DM}; pg8::StaticOrder S; S.init(M, NIN, F.G, CIDX());
          const pg8::PG8_LAS_F* RT = (const pg8::PG8_LAS_F*)(F.lds + XTRA_OFF); const int pmt = pg8::rstd_table((pg8::PG8_LAS_F*)(F.lds + XTRA_OFF), SSp, S, F.wave);
          pg8::EpiZ E{Z, ZS, SSp, args.in[4] + layer * 64, args.in[5] + layer * 64, args.in[6] + layer * 64, (const float*)(F.ws + WS_ROPE64), RT, pmt};
          pg8::gemm_phase<pg8::EpiZ, pg8::StaticOrder, true, true>(ring, g, S, E, F.wave); }
        GRID_BAR();
#ifdef PROBE_PP
        { FRESH(P); post_phase(P, args.in[4] + layer * 64, args.in[5] + layer * 64, args.in[6] + layer * 64, args.in[7] + layer * 64, args.in[3] + layer * 8, true); }
#endif
        PH_B(1); { FRESH(P); post_phase(P, args.in[4] + layer * 64, args.in[5] + layer * 64, args.in[6] + layer * 64, args.in[7] + layer * 64, args.in[3] + layer * 8); } PH_E(1);
        PH_B(2); { FRESH(P); ret_state_mfma(P); } PH_E(2);
        GRID_BAR();
        PH_B(3); { FRESH(P); fscan_phase(P); } PH_E(3);
        PH_B(4); { FRESH(P); ret_scan(P); } PH_E(4);
        GRID_BAR();
#ifdef PROBE_RO
        { FRESH(P); ret_out_mfma(P, args.in[8] + layer * 512, true); }
#endif
        PH_B(5); { FRESH(P); ret_out_mfma(P, args.in[8] + layer * 512); } PH_E(5);
#ifdef PROBE_X3
        for (int rep_ = 0; rep_ < 2; ++rep_)
        { static_assert(attn_body::ATTN_LDS_BYTES <= RING_BYTES, "attention scratch fits the ring region");
          unsigned char* wsl = F.ws; asm volatile("" : "+s"(wsl));
          bf16* Zl = (bf16*)(wsl + WS_Z);
          const attn_body::AttnTensors AT{(const attn_body::bf16*)(Zl + Z_FQ), (const attn_body::bf16*)(Zl + Z_FK), (const attn_body::bf16*)(Zl + Z_FV), (attn_body::bf16*)(Zl + (rep_ == 0 ? Z_RQ : Z_FQ)), (const float*)(wsl + WS_CF)};
          const attn_body::StaticOrder S((int)F.G, (int)blockIdx.x);
          attn_body::attn_phase<attn_body::StaticOrder, 20>((char*)lds + RING_OFF, AT, S, F.wave); }
#ifdef PROBE_X4
        { FRESH(P); dsa_v3(P); }
#else
        for (int rep_ = 0; rep_ < 2; ++rep_) { FRESH(P); dsa_v3(P, rep_ == 0 ? Z_RG : Z_DQ); }
#endif
#else
        { static_assert(attn_body::ATTN_LDS_BYTES <= RING_BYTES, "attention scratch fits the ring region");
          unsigned char* wsl = F.ws; asm volatile("" : "+s"(wsl));
          bf16* Zl = (bf16*)(wsl + WS_Z);
          float dskip; { const int ln = lane_id_v(); const float gq = wave_max(fabsf(args.in[4][layer * 64 + ln])), gk = wave_max(fabsf(args.in[5][layer * 64 + ln])); dskip = 2.0f * (64.0f * C2 * gq * gk * 1.02f) + 36.0f; }
          const attn_body::AttnTensors AT{(const attn_body::bf16*)(Zl + Z_FQ), (const attn_body::bf16*)(Zl + Z_FK), (const attn_body::bf16*)(Zl + Z_FV), (attn_body::bf16*)(Zl + Z_FQ), (const float*)(wsl + WS_CF), dskip};
          const attn_body::StaticOrder S((int)F.G, (int)blockIdx.x);
          PH_B(6); attn_body::attn_phase<attn_body::StaticOrder, 20>((char*)lds + RING_OFF, AT, S, F.wave); PH_E(6); }
        PH_B(7); { FRESH(P); dsa_v3(P); } PH_E(7);
#endif
        GRID_BAR();
        { pg8::Gemm g{Z + Z_FQ, L + LW_MIX, M, DM, 1536, ZP, 1536, 256 * ZP}; pg8::StaticOrder S; S.init(M, DM, F.G, CIDX());
          pg8::EpiGateF E{(const unsigned char*)(Z + Z_ZG), Z + Z_MRG};
          pg8::gemm_phase<pg8::EpiGateF, pg8::StaticOrder, false, true>(ring, g, S, E, F.wave); }
        SEAM_BAR();
        { pg8::Gemm g{Z + Z_MRG, L + LW_O, M, DM, DM, ZP, DM, 256 * ZP}; pg8::StaticOrder S; S.init(M, DM, F.G, CIDX());
          pg8::EpiRes E{XA, HDN, nullptr, SSp};
          pg8::gemm_phase<pg8::EpiRes, pg8::StaticOrder, false, true>(ring, g, S, E, F.wave); }
        SEAM_BAR();
        { pg8::Gemm g{HDN, L + LW_FI, M, FF2, DM, DM, DM, 256 * DM}; pg8::StaticOrder S; S.init(M, FF2, F.G, CIDX());
          const pg8::PG8_LAS_F* RT = (const pg8::PG8_LAS_F*)(F.lds + XTRA_OFF); const int pmt = pg8::rstd_table((pg8::PG8_LAS_F*)(F.lds + XTRA_OFF), SSp, S, F.wave);
          pg8::EpiSwi E{HB, FFH, 256 * ZP, SSp, RT, pmt};
          pg8::gemm_phase<pg8::EpiSwi, pg8::StaticOrder, true, true>(ring, g, S, E, F.wave); }
        SEAM_BAR();
        { pg8::Gemm g{HB, L + LW_FO, M, DM, FFH, FFH, FFH, 256 * ZP}; pg8::StaticOrder S; S.init(M, DM, F.G, CIDX());
          pg8::EpiRes E{HDN, XA, (layer + 1 < DEPTH) ? nullptr : F.out, SSp};
          pg8::gemm_phase<pg8::EpiRes, pg8::StaticOrder, false, true>(ring, g, S, E, F.wave); }
        if (layer + 1 < DEPTH) SEAM_BAR(); else GRID_BAR();
    }
    if (__hip_atomic_load((gu32*)((unsigned*)(ctl + CW_BAR) + XB_TMO), RLX_AGENT) != 0u) {
        const float q = __builtin_nanf("");
        for (int m = F.gw; m < M; m += F.NGW) { GAS f32x4* o = (GAS f32x4*)(F.out + (size_t)m * DM) + lane_id_v();
#pragma unroll
            for (int j = 0; j < 4; ++j) o[64 * j] = (f32x4){q, q, q, q}; }
    }
}

extern "C" void kernel_launch(void* const* d_in, const int* in_sizes, int n_in, void* d_out, int out_size, void* d_ws, size_t ws_size, hipStream_t stream) {
    static int grid = 0;
    if (grid == 0) {
        if (n_in != 16 || in_sizes[0] != M * DM || out_size != M * DM || ws_size < WS_END) { fprintf(stderr, "kernel_launch: unexpected shapes / workspace (n_in %d, in0 %d, out %d, ws %zu < %zu)\n", n_in, n_in > 0 ? in_sizes[0] : -1, out_size, ws_size, (size_t)WS_END); grid = -1; return; }
        int dev = 0, cus = 0, per_cu = 0;
        if (hipGetDevice(&dev) != hipSuccess || hipDeviceGetAttribute(&cus, hipDeviceAttributeMultiprocessorCount, dev) != hipSuccess) { grid = -1; return; }
        if (hipFuncSetAttribute((const void*)hyb_fwd, hipFuncAttributeMaxDynamicSharedMemorySize, LDS_BYTES) != hipSuccess) { fprintf(stderr, "kernel_launch: hipFuncSetAttribute failed\n"); grid = -1; return; }
        if (hipOccupancyMaxActiveBlocksPerMultiprocessor(&per_cu, (const void*)hyb_fwd, NWAVES * 64, LDS_BYTES) != hipSuccess || per_cu < 1) { fprintf(stderr, "kernel_launch: occupancy query reports %d blocks per CU\n", per_cu); }
        (void)hipGetLastError();
        grid = cus;
    }
    if (grid < 0) return;
    if (hipMemsetAsync((char*)d_ws + WS_CTL, 0, CTL_ZERO_BYTES, stream) != hipSuccess) return;
    Args a{};
    for (int i = 0; i < 16; ++i) a.in[i] = (const float*)d_in[i];
    a.out = (float*)d_out; a.ws = (unsigned char*)d_ws;
    hipLaunchKernelGGL(hyb_fwd, dim3(grid), dim3(NWAVES * 64), LDS_BYTES, stream, a);
}
```
